# Optimizing an MI355X kernel written in HIP

```python
import jax, jax.numpy as jnp
from jax import lax
import numpy as np

D_MODEL = 2048
BATCH = 4
SEQ = 2048
DEPTH = 1

N_META = 16
HEAD_DIM = 64
D_ATTN = D_MODEL // 2
ATTN_HEADS = D_ATTN // HEAD_DIM
ATTN_KV_HEADS = ATTN_HEADS // 4
ATTN_GROUP = ATTN_HEADS // ATTN_KV_HEADS
D_KV = ATTN_KV_HEADS * HEAD_DIM
WINDOW = 128
ATTN_BLOCK = 128
REL_BUCKETS = 32
REL_MAX_DIST = 128
SSM_D_INNER = D_MODEL - D_ATTN
SSM_HEAD_DIM = 64
SSM_HEADS = SSM_D_INNER // SSM_HEAD_DIM
SSM_GROUPS = 2
SSM_HPG = SSM_HEADS // SSM_GROUPS
SSM_STATE = 128
CONV_WIDTH = 4
SSD_CHUNK = 128
D_XBC = SSM_D_INNER + 2 * SSM_GROUPS * SSM_STATE
D_IN_PROJ = D_ATTN + 2 * D_KV + SSM_D_INNER + D_XBC + SSM_HEADS
D_MIX = D_ATTN + SSM_D_INNER
IN_SPLITS = (D_ATTN, D_ATTN + D_KV, D_ATTN + 2 * D_KV, D_ATTN + 2 * D_KV + SSM_D_INNER,
             D_ATTN + 2 * D_KV + SSM_D_INNER + D_XBC)
PEER_HEADS = 8
PEER_TOPK = 16
N_KEYS = 128
N_EXPERTS = N_KEYS * N_KEYS
PEER_HALF = 128
PEER_KEY_DIM = 2 * PEER_HALF
PEER_BLOCK = 128
EPS = 1e-6
NEG = -1e30

kernel_name = "hymba_swa_ssd_peer_block"


def rmsnorm(x, w):
    xf = x.astype(jnp.float32)
    y = xf * lax.rsqrt(jnp.mean(xf * xf, axis=-1, keepdims=True) + EPS)
    return (y * w.astype(jnp.float32)).astype(x.dtype)


def t5_bucket(dist):
    n = np.maximum(dist, 0)
    max_exact = REL_BUCKETS // 2
    large = max_exact + (np.log(np.maximum(n, 1) / max_exact) / np.log(REL_MAX_DIST / max_exact)
                         * (REL_BUCKETS - max_exact)).astype(np.int32)
    large = np.minimum(large, REL_BUCKETS - 1)
    return np.where(n < max_exact, n, large).astype(np.int32)


def band_structure(nb):
    blk = np.arange(nb)[:, None]
    kj = np.arange(ATTN_BLOCK)[None, :]
    qpos = N_META + blk[:, :, None] * ATTN_BLOCK + np.arange(ATTN_BLOCK)[None, :, None]
    kpos = np.concatenate([np.broadcast_to(np.arange(N_META)[None, :], (nb, N_META)),
                           N_META + (blk - 1) * ATTN_BLOCK + kj,
                           N_META + blk * ATTN_BLOCK + kj], axis=1)
    exists = np.concatenate([np.ones((nb, N_META), bool),
                             np.broadcast_to(blk > 0, (nb, ATTN_BLOCK)),
                             np.ones((nb, ATTN_BLOCK), bool)], axis=1)
    is_meta = np.concatenate([np.ones((nb, N_META), bool),
                              np.zeros((nb, 2 * ATTN_BLOCK), bool)], axis=1)
    dist = qpos - kpos[:, None, :]
    valid = exists[:, None, :] & (dist >= 0) & ((dist < WINDOW) | is_meta[:, None, :])
    return t5_bucket(dist), valid


def sink_softmax(logits, sink):
    s = sink.astype(jnp.float32)[..., None, None]
    m = jnp.maximum(jnp.max(logits, axis=-1, keepdims=True), s)
    e = jnp.exp(logits - m)
    return e / (jnp.sum(e, axis=-1, keepdims=True) + jnp.exp(s - m))


def swa_sink_attention(q, k, v, sinks, rel_bias):
    b, L, _ = q.shape
    S = L - N_META
    nb = S // ATTN_BLOCK
    q = q.reshape(b, L, ATTN_KV_HEADS, ATTN_GROUP, HEAD_DIM) * (HEAD_DIM ** -0.5)
    k = k.reshape(b, L, ATTN_KV_HEADS, HEAD_DIM)
    v = v.reshape(b, L, ATTN_KV_HEADS, HEAD_DIM)
    bias_tab = rel_bias.astype(jnp.float32).reshape(REL_BUCKETS, ATTN_KV_HEADS, ATTN_GROUP)
    sink = sinks.reshape(ATTN_KV_HEADS, ATTN_GROUP)
    qm, km, vm = q[:, :N_META], k[:, :N_META], v[:, :N_META]
    mi = np.arange(N_META)
    dist_m = mi[:, None] - mi[None, :]
    bias_m = jnp.transpose(bias_tab[t5_bucket(dist_m)], (2, 3, 0, 1))
    lm = jnp.einsum('bqhgd,bkhd->bhgqk', qm, km).astype(jnp.float32) + bias_m
    lm = jnp.where(dist_m >= 0, lm, NEG)
    om = jnp.einsum('bhgqk,bkhd->bqhgd', sink_softmax(lm, sink).astype(v.dtype), vm)
    qr = q[:, N_META:].reshape(b, nb, ATTN_BLOCK, ATTN_KV_HEADS, ATTN_GROUP, HEAD_DIM)
    kr = k[:, N_META:].reshape(b, nb, ATTN_BLOCK, ATTN_KV_HEADS, HEAD_DIM)
    vr = v[:, N_META:].reshape(b, nb, ATTN_BLOCK, ATTN_KV_HEADS, HEAD_DIM)

    def band_keys(t, tm):
        prev = jnp.concatenate([jnp.zeros_like(t[:, :1]), t[:, :-1]], axis=1)
        meta = jnp.broadcast_to(tm[:, None], (b, nb, N_META, ATTN_KV_HEADS, HEAD_DIM))
        return jnp.concatenate([meta, prev, t], axis=2)

    kb, vb = band_keys(kr, km), band_keys(vr, vm)
    bucket, valid = band_structure(nb)
    bias_b = jnp.transpose(bias_tab[bucket], (0, 3, 4, 1, 2))
    lr = jnp.einsum('bnqhgd,bnkhd->bnhgqk', qr, kb).astype(jnp.float32) + bias_b
    lr = jnp.where(valid[:, None, None], lr, NEG)
    orr = jnp.einsum('bnhgqk,bnkhd->bnqhgd', sink_softmax(lr, sink).astype(v.dtype), vb)
    return jnp.concatenate([om.reshape(b, N_META, D_ATTN), orr.reshape(b, S, D_ATTN)], axis=1)


def ssd_mixer(z, xbc, dt_raw, conv_w, conv_b, dt_bias, a_log, d_skip, norm_w):
    b, L, _ = xbc.shape
    xbc = lax.conv_general_dilated(xbc, conv_w[:, None, :], window_strides=(1,),
                                   padding=[(CONV_WIDTH - 1, 0)],
                                   dimension_numbers=('NWC', 'WIO', 'NWC'),
                                   feature_group_count=D_XBC) + conv_b
    xbc = jax.nn.silu(xbc)
    xs, Bm, Cm = jnp.split(xbc, [SSM_D_INNER, SSM_D_INNER + SSM_GROUPS * SSM_STATE], axis=-1)
    dt = jax.nn.softplus(dt_raw.astype(jnp.float32) + dt_bias.astype(jnp.float32))
    A = -jnp.exp(a_log.astype(jnp.float32)).reshape(SSM_GROUPS, SSM_HPG)
    pad = (-N_META) % SSD_CHUNK
    padf = lambda t: jnp.pad(t, ((0, 0), (pad, 0)) + ((0, 0),) * (t.ndim - 2))
    Lp = L + pad
    nc = Lp // SSD_CHUNK
    x = padf(xs).reshape(b, nc, SSD_CHUNK, SSM_GROUPS, SSM_HPG, SSM_HEAD_DIM)
    Bc = padf(Bm).reshape(b, nc, SSD_CHUNK, SSM_GROUPS, SSM_STATE)
    Cc = padf(Cm).reshape(b, nc, SSD_CHUNK, SSM_GROUPS, SSM_STATE)
    dtc = padf(dt).reshape(b, nc, SSD_CHUNK, SSM_GROUPS, SSM_HPG)
    xdt = x * dtc[..., None].astype(x.dtype)
    dA = jnp.transpose(dtc * A, (0, 3, 4, 1, 2))
    A_cs = jnp.cumsum(dA, axis=-1)
    tri = np.tril(np.ones((SSD_CHUNK, SSD_CHUNK), bool))
    Lmat = jnp.exp(jnp.where(tri, A_cs[..., :, None] - A_cs[..., None, :], -jnp.inf))
    CB = jnp.einsum('bclgn,bcsgn->bgcls', Cc, Bc)
    M = CB[:, :, None] * Lmat
    y_diag = jnp.einsum('bghcls,bcsghp->bclghp', M, xdt)
    decay_states = jnp.exp(A_cs[..., -1:] - A_cs)
    states = jnp.einsum('bcsgn,bghcs,bcsghp->bcghpn', Bc, decay_states, xdt).astype(jnp.float32)
    chunk_decay = jnp.exp(A_cs[..., -1])

    def step(h, inp):
        st, dec = inp
        return dec[..., None, None] * h + st, h

    h0 = jnp.zeros((b, SSM_GROUPS, SSM_HPG, SSM_HEAD_DIM, SSM_STATE), jnp.float32)
    _, states_prev = lax.scan(step, h0, (jnp.moveaxis(states, 1, 0), jnp.moveaxis(chunk_decay, -1, 0)))
    y_off = jnp.einsum('bclgn,bghcl,cbghpn->bclghp', Cc, jnp.exp(A_cs), states_prev)
    y = y_diag + y_off + x * d_skip.reshape(SSM_GROUPS, SSM_HPG)[..., None]
    y = y.reshape(b, Lp, SSM_D_INNER)[:, pad:].astype(xs.dtype)
    yg = (y * jax.nn.silu(z)).astype(jnp.float32).reshape(b, L, SSM_GROUPS, -1)
    yg = yg * lax.rsqrt(jnp.mean(yg * yg, axis=-1, keepdims=True) + EPS)
    return (yg.reshape(b, L, SSM_D_INNER) * norm_w.astype(jnp.float32)).astype(z.dtype)


def mixer_layer(hn, w_in, sinks, rel_bias, conv_w, conv_b, dt_bias, a_log, d_skip,
                attn_norm_w, ssm_norm_w, w_out):
    proj = hn @ w_in
    q, k, v, z, xbc, dt_raw = jnp.split(proj, list(IN_SPLITS), axis=-1)
    ya = rmsnorm(swa_sink_attention(q, k, v, sinks, rel_bias), attn_norm_w)
    ys = ssd_mixer(z, xbc, dt_raw, conv_w, conv_b, dt_bias, a_log, d_skip, ssm_norm_w)
    return jnp.concatenate([ya, ys], axis=-1) @ w_out


def peer_ffn(xn, wq, keys, u, v):
    b, t, d = xn.shape
    T = b * t
    xt = xn.reshape(T, d)
    q = (xt @ wq).reshape(T, PEER_HEADS, 2, PEER_HALF)
    s = jnp.einsum('thcd,hckd->thck', q, keys).astype(jnp.float32)
    s1, i1 = lax.top_k(s[:, :, 0], PEER_TOPK)
    s2, i2 = lax.top_k(s[:, :, 1], PEER_TOPK)
    cand = (s1[..., :, None] + s2[..., None, :]).reshape(T, PEER_HEADS, PEER_TOPK * PEER_TOPK)
    top, pos = lax.top_k(cand, PEER_TOPK)
    idx = (jnp.take_along_axis(i1, pos // PEER_TOPK, axis=-1) * N_KEYS
           + jnp.take_along_axis(i2, pos % PEER_TOPK, axis=-1))
    gates = jax.nn.softmax(top, axis=-1)
    nblk = -(-T // PEER_BLOCK)
    padT = nblk * PEER_BLOCK - T
    xb = jnp.pad(xt, ((0, padT), (0, 0))).reshape(nblk, PEER_BLOCK, d)
    ib = jnp.pad(idx, ((0, padT), (0, 0), (0, 0))).reshape(nblk, PEER_BLOCK, PEER_HEADS, PEER_TOPK)
    gb = jnp.pad(gates, ((0, padT), (0, 0), (0, 0))).reshape(nblk, PEER_BLOCK, PEER_HEADS, PEER_TOPK)

    def block(args):
        x_blk, i_blk, g_blk = args
        a = jnp.einsum('thkd,td->thk', u[i_blk], x_blk).astype(jnp.float32)
        w = (g_blk * jax.nn.gelu(a, approximate=False)).astype(x_blk.dtype)
        return jnp.einsum('thk,thkd->td', w, v[i_blk])

    out = lax.map(block, (xb, ib, gb)).reshape(nblk * PEER_BLOCK, d)[:T]
    return out.reshape(b, t, d)


def setup_inputs(seed: int = 0) -> dict:
    key = jax.random.key(seed)
    ks = jax.random.split(key, 20)
    f32 = jnp.float32
    nrm = lambda k, shape, scale: jax.random.normal(k, shape, f32) * scale
    dt0 = jnp.exp(jax.random.uniform(ks[8], (DEPTH, SSM_HEADS), f32, np.log(1e-3), np.log(1e-1)))
    return {
        "x": nrm(ks[0], (BATCH, SEQ, D_MODEL), 1.0),
        "meta_tokens": nrm(ks[1], (N_META, D_MODEL), 1.0),
        "rel_bias": nrm(ks[2], (REL_BUCKETS, ATTN_HEADS), 0.5),
        "ln_mix": 1.0 + nrm(ks[3], (DEPTH, D_MODEL), 0.02),
        "w_in": nrm(ks[4], (DEPTH, D_MODEL, D_IN_PROJ), D_MODEL ** -0.5),
        "attn_sinks": nrm(ks[5], (DEPTH, ATTN_HEADS), 0.5),
        "conv_w": nrm(ks[6], (DEPTH, CONV_WIDTH, D_XBC), CONV_WIDTH ** -0.5),
        "conv_b": nrm(ks[7], (DEPTH, D_XBC), 0.02),
        "dt_bias": dt0 + jnp.log(-jnp.expm1(-dt0)),
        "a_log": jnp.log(jax.random.uniform(ks[9], (DEPTH, SSM_HEADS), f32, 1.0, 16.0)),
        "d_skip": 1.0 + nrm(ks[10], (DEPTH, SSM_HEADS), 0.02),
        "attn_norm_w": 1.0 + nrm(ks[11], (DEPTH, D_ATTN), 0.02),
        "ssm_norm_w": 1.0 + nrm(ks[12], (DEPTH, SSM_D_INNER), 0.02),
        "w_out": nrm(ks[13], (DEPTH, D_MIX, D_MODEL), D_MIX ** -0.5),
        "ln_ffn": 1.0 + nrm(ks[14], (DEPTH, D_MODEL), 0.02),
        "peer_wq": nrm(ks[15], (DEPTH, D_MODEL, PEER_HEADS * PEER_KEY_DIM), D_MODEL ** -0.5),
        "peer_keys": nrm(ks[16], (DEPTH, PEER_HEADS, 2, N_KEYS, PEER_HALF), PEER_HALF ** -0.5),
        "peer_u": nrm(ks[17], (DEPTH, N_EXPERTS, D_MODEL), D_MODEL ** -0.5),
        "peer_v": nrm(ks[18], (DEPTH, N_EXPERTS, D_MODEL), PEER_HEADS ** -0.5),
        "ln_final": 1.0 + nrm(ks[19], (D_MODEL,), 0.02),
    }


def reference(x, meta_tokens, rel_bias, ln_mix, w_in, attn_sinks, conv_w, conv_b, dt_bias, a_log,
              d_skip, attn_norm_w, ssm_norm_w, w_out, ln_ffn, peer_wq, peer_keys, peer_u, peer_v,
              ln_final):
    b = x.shape[0]
    meta = jnp.broadcast_to(meta_tokens[None].astype(x.dtype), (b, N_META, D_MODEL))
    h = jnp.concatenate([meta, x], axis=1)
    for layer in range(DEPTH):
        h = h + mixer_layer(rmsnorm(h, ln_mix[layer]), w_in[layer], attn_sinks[layer], rel_bias,
                            conv_w[layer], conv_b[layer], dt_bias[layer], a_log[layer],
                            d_skip[layer], attn_norm_w[layer], ssm_norm_w[layer], w_out[layer])
        if layer == DEPTH - 1:
            h = h[:, N_META:]
        h = h + peer_ffn(rmsnorm(h, ln_ffn[layer]), peer_wq[layer], peer_keys[layer],
                         peer_u[layer], peer_v[layer])
    return rmsnorm(h, ln_final)
```

```cpp
#include <hip/hip_runtime.h>
#include <math.h>
#include <stdint.h>

namespace {
constexpr int BATCH = 4, SEQ = 2048, DM = 2048, NMETA = 16;
constexpr int T = BATCH * SEQ;
constexpr int TA = T + NMETA;
constexpr int DPROJ = 4112;
constexpr int OFF_Q = 0, OFF_K = 1024, OFF_V = 1280, OFF_Z = 1536, OFF_XBC = 2560, OFF_DT = 4096;
constexpr int D_XBC = 1536;
constexpr float EPS = 1e-6f;

__constant__ unsigned char kBucket[128] = {
    0, 1, 2, 3, 4, 5, 6, 7, 8, 9, 10, 11, 12, 13, 14, 15, 16, 16, 16, 17, 17, 18, 18, 18, 19, 19, 19, 20, 20, 20, 20, 21,
    21, 21, 21, 22, 22, 22, 22, 22, 23, 23, 23, 23, 23, 23, 24, 24, 24, 24, 24, 24, 25, 25, 25, 25, 25, 25, 25, 26, 26, 26, 26, 26,
    26, 26, 26, 27, 27, 27, 27, 27, 27, 27, 27, 27, 27, 28, 28, 28, 28, 28, 28, 28, 28, 28, 28, 29, 29, 29, 29, 29, 29, 29, 29, 29,
    29, 29, 29, 30, 30, 30, 30, 30, 30, 30, 30, 30, 30, 30, 30, 30, 30, 31, 31, 31, 31, 31, 31, 31, 31, 31, 31, 31, 31, 31, 31, 31};

__device__ __forceinline__ float wave_sum(float v) {
  for (int o = 32; o > 0; o >>= 1) v += __shfl_xor(v, o);
  return v;
}
__device__ __forceinline__ float wave_max(float v) {
  for (int o = 32; o > 0; o >>= 1) v = fmaxf(v, __shfl_xor(v, o));
  return v;
}
__device__ __forceinline__ float block_sum256(float v, float* red) {
  v = wave_sum(v);
  __syncthreads();
  if ((threadIdx.x & 63) == 0) red[threadIdx.x >> 6] = v;
  __syncthreads();
  return red[0] + red[1] + red[2] + red[3];
}
__device__ __forceinline__ float silu_f(float x) { return x / (1.f + expf(-x)); }
__device__ __forceinline__ float softplus_f(float x) { return fmaxf(x, 0.f) + log1pf(expf(-fabsf(x))); }

__global__ __launch_bounds__(256) void k_rmsnorm(const float* __restrict__ a, const float* __restrict__ bsrc,
                                                 const float* __restrict__ w, float* __restrict__ out) {
  __shared__ float red[4];
  int t = blockIdx.x;
  const float* src = t < T ? a + (size_t)t * DM : bsrc + (size_t)(t - T) * DM;
  int c = threadIdx.x * 4;
  float4 v0 = *(const float4*)(src + c);
  float4 v1 = *(const float4*)(src + 1024 + c);
  float ss = v0.x * v0.x + v0.y * v0.y + v0.z * v0.z + v0.w * v0.w + v1.x * v1.x + v1.y * v1.y + v1.z * v1.z + v1.w * v1.w;
  ss = block_sum256(ss, red);
  float r = rsqrtf(ss * (1.f / DM) + EPS);
  float4 w0 = *(const float4*)(w + c), w1 = *(const float4*)(w + 1024 + c);
  float4 o0 = {v0.x * r * w0.x, v0.y * r * w0.y, v0.z * r * w0.z, v0.w * r * w0.w};
  float4 o1 = {v1.x * r * w1.x, v1.y * r * w1.y, v1.z * r * w1.z, v1.w * r * w1.w};
  *(float4*)(out + (size_t)t * DM + c) = o0;
  *(float4*)(out + (size_t)t * DM + 1024 + c) = o1;
}

template <bool RES>
__global__ __launch_bounds__(256) void k_sgemm(const float* __restrict__ A, int lda, const float* __restrict__ B, int ldb,
                                               float* __restrict__ C, int ldc, const float* __restrict__ R, int ldr, int M,
                                               int N, int K) {
  __shared__ float As[16][132];
  __shared__ float Bs[16][132];
  int tid = threadIdx.x;
  int tx = tid & 15, ty = tid >> 4;
  int m0 = blockIdx.y * 128, n0 = blockIdx.x * 128;
  float acc[8][8];
#pragma unroll
  for (int i = 0; i < 8; i++)
#pragma unroll
    for (int j = 0; j < 8; j++) acc[i][j] = 0.f;
  int ar = tid >> 1, ak = (tid & 1) * 8;
  int bk = tid >> 4, bc = (tid & 15) * 8;
  for (int k0 = 0; k0 < K; k0 += 16) {
    float4 a0 = {0, 0, 0, 0}, a1 = {0, 0, 0, 0}, b0 = {0, 0, 0, 0}, b1 = {0, 0, 0, 0};
    if (m0 + ar < M) {
      const float* ap = A + (size_t)(m0 + ar) * lda + k0 + ak;
      a0 = *(const float4*)ap;
      a1 = *(const float4*)(ap + 4);
    }
    if (n0 + bc < N) {
      const float* bp = B + (size_t)(k0 + bk) * ldb + n0 + bc;
      b0 = *(const float4*)bp;
      b1 = *(const float4*)(bp + 4);
    }
    __syncthreads();
    As[ak + 0][ar] = a0.x; As[ak + 1][ar] = a0.y; As[ak + 2][ar] = a0.z; As[ak + 3][ar] = a0.w;
    As[ak + 4][ar] = a1.x; As[ak + 5][ar] = a1.y; As[ak + 6][ar] = a1.z; As[ak + 7][ar] = a1.w;
    *(float4*)&Bs[bk][bc] = b0;
    *(float4*)&Bs[bk][bc + 4] = b1;
    __syncthreads();
#pragma unroll
    for (int kk = 0; kk < 16; kk++) {
      float4 x0 = *(const float4*)&As[kk][ty * 8], x1 = *(const float4*)&As[kk][ty * 8 + 4];
      float4 y0 = *(const float4*)&Bs[kk][tx * 8], y1 = *(const float4*)&Bs[kk][tx * 8 + 4];
      float av[8] = {x0.x, x0.y, x0.z, x0.w, x1.x, x1.y, x1.z, x1.w};
      float bv[8] = {y0.x, y0.y, y0.z, y0.w, y1.x, y1.y, y1.z, y1.w};
#pragma unroll
      for (int i = 0; i < 8; i++)
#pragma unroll
        for (int j = 0; j < 8; j++) acc[i][j] = fmaf(av[i], bv[j], acc[i][j]);
    }
  }
#pragma unroll
  for (int i = 0; i < 8; i++) {
    int m = m0 + ty * 8 + i;
    if (m >= M) continue;
    int n = n0 + tx * 8;
    if (n >= N) continue;
    float4 o0 = {acc[i][0], acc[i][1], acc[i][2], acc[i][3]};
    float4 o1 = {acc[i][4], acc[i][5], acc[i][6], acc[i][7]};
    if (RES) {
      float4 r0 = *(const float4*)(R + (size_t)m * ldr + n), r1 = *(const float4*)(R + (size_t)m * ldr + n + 4);
      o0.x += r0.x; o0.y += r0.y; o0.z += r0.z; o0.w += r0.w;
      o1.x += r1.x; o1.y += r1.y; o1.z += r1.z; o1.w += r1.w;
    }
    *(float4*)(C + (size_t)m * ldc + n) = o0;
    *(float4*)(C + (size_t)m * ldc + n + 4) = o1;
  }
}

__global__ __launch_bounds__(64) void k_attn(const float* __restrict__ proj, const float* __restrict__ rel_bias,
                                             const float* __restrict__ sinks, float* __restrict__ attn_o) {
  __shared__ float qs[64];
  __shared__ float ps[192];
  int t = blockIdx.x >> 4, hq = blockIdx.x & 15, kvh = hq >> 2;
  int b = t / SEQ, s = t % SEQ;
  int lane = threadIdx.x;
  qs[lane] = proj[(size_t)t * DPROJ + OFF_Q + hq * 64 + lane] * 0.125f;
  __syncthreads();
  float lg0 = -1e30f, lg1 = -1e30f, lg2 = -1e30f;
#pragma unroll
  for (int r = 0; r < 3; r++) {
    int j = lane + r * 64;
    float l = -1e30f;
    if (j < 144) {
      int row, dist;
      bool valid;
      if (j < 16) { row = T + j; dist = 16 + s - j; valid = true; }
      else { int sp = s - 127 + (j - 16); valid = sp >= 0; row = b * SEQ + sp; dist = s - sp; }
      if (valid) {
        const float* kp = proj + (size_t)row * DPROJ + OFF_K + kvh * 64;
        float d = 0.f;
        for (int i = 0; i < 64; i += 4) {
          float4 kv = *(const float4*)(kp + i);
          d += qs[i] * kv.x + qs[i + 1] * kv.y + qs[i + 2] * kv.z + qs[i + 3] * kv.w;
        }
        int bk = dist < 128 ? (int)kBucket[dist] : 31;
        l = d + rel_bias[bk * 16 + hq];
      }
    }
    if (r == 0) lg0 = l; else if (r == 1) lg1 = l; else lg2 = l;
  }
  float sink = sinks[hq];
  float m = fmaxf(wave_max(fmaxf(lg0, fmaxf(lg1, lg2))), sink);
  float e0 = expf(lg0 - m), e1 = expf(lg1 - m), e2 = expf(lg2 - m);
  float den = wave_sum(e0 + e1 + e2) + expf(sink - m);
  float inv = 1.f / den;
  ps[lane] = e0 * inv; ps[lane + 64] = e1 * inv; ps[lane + 128] = e2 * inv;
  __syncthreads();
  float o = 0.f;
  for (int j = 0; j < 144; j++) {
    int row;
    if (j < 16) row = T + j;
    else { int sp = s - 127 + (j - 16); if (sp < 0) continue; row = b * SEQ + sp; }
    o += ps[j] * proj[(size_t)row * DPROJ + OFF_V + kvh * 64 + lane];
  }
  attn_o[(size_t)t * 1024 + hq * 64 + lane] = o;
}

__global__ __launch_bounds__(256) void k_conv(const float* __restrict__ proj, const float* __restrict__ cw,
                                              const float* __restrict__ cb, float* __restrict__ xc) {
  int t = blockIdx.x;
  for (int c = threadIdx.x; c < D_XBC; c += 256) {
    float acc = cb[c];
#pragma unroll
    for (int j = 0; j < 4; j++) {
      int row;
      if (t < T) { int s = t % SEQ; int sp = s - j; row = sp >= 0 ? t - j : T + 16 + sp; }
      else { int mi = t - T - j; row = mi >= 0 ? T + mi : -1; }
      if (row >= 0) acc += cw[(3 - j) * D_XBC + c] * proj[(size_t)row * DPROJ + OFF_XBC + c];
    }
    xc[(size_t)t * D_XBC + c] = silu_f(acc);
  }
}

__global__ __launch_bounds__(64) void k_ssd(const float* __restrict__ proj, const float* __restrict__ xc,
                                            const float* __restrict__ dt_bias, const float* __restrict__ a_log,
                                            const float* __restrict__ d_skip, float* __restrict__ ssm_y) {
  __shared__ float Bs[16][128];
  __shared__ float Cs[16][128];
  __shared__ float xs[16][64];
  __shared__ float zs[16][64];
  __shared__ float dts[16];
  int b = blockIdx.x >> 4, h = blockIdx.x & 15, g = h >> 3;
  int p = threadIdx.x;
  float st[128];
#pragma unroll
  for (int n = 0; n < 128; n++) st[n] = 0.f;
  float A = -expf(a_log[h]);
  float dsk = d_skip[h];
  float dtb = dt_bias[h];
  for (int u0 = 0; u0 < NMETA + SEQ; u0 += 16) {
    __syncthreads();
    int rowbase = (u0 == 0) ? T : b * SEQ + (u0 - 16);
    for (int i = 0; i < 16; i++) {
      const float* xr = xc + (size_t)(rowbase + i) * D_XBC;
      Bs[i][p] = xr[1024 + g * 128 + p];
      Bs[i][p + 64] = xr[1024 + g * 128 + 64 + p];
      Cs[i][p] = xr[1280 + g * 128 + p];
      Cs[i][p + 64] = xr[1280 + g * 128 + 64 + p];
      xs[i][p] = xr[h * 64 + p];
      zs[i][p] = proj[(size_t)(rowbase + i) * DPROJ + OFF_Z + h * 64 + p];
    }
    if (p < 16) dts[p] = softplus_f(proj[(size_t)(rowbase + p) * DPROJ + OFF_DT + h] + dtb);
    __syncthreads();
    for (int i = 0; i < 16; i++) {
      float dtv = dts[i];
      float dA = expf(dtv * A);
      float xv = xs[i][p];
      float xdt = xv * dtv;
      float y = 0.f;
#pragma unroll
      for (int n = 0; n < 128; n += 4) {
        float4 bv = *(const float4*)&Bs[i][n];
        float4 cv = *(const float4*)&Cs[i][n];
        st[n] = fmaf(st[n], dA, xdt * bv.x); y = fmaf(st[n], cv.x, y);
        st[n + 1] = fmaf(st[n + 1], dA, xdt * bv.y); y = fmaf(st[n + 1], cv.y, y);
        st[n + 2] = fmaf(st[n + 2], dA, xdt * bv.z); y = fmaf(st[n + 2], cv.z, y);
        st[n + 3] = fmaf(st[n + 3], dA, xdt * bv.w); y = fmaf(st[n + 3], cv.w, y);
      }
      y += xv * dsk;
      if (u0 > 0) ssm_y[(size_t)(rowbase + i) * 1024 + h * 64 + p] = y * silu_f(zs[i][p]);
    }
  }
}

__global__ __launch_bounds__(256) void k_mixnorm(const float* __restrict__ attn_o, const float* __restrict__ ssm_y,
                                                 const float* __restrict__ wa, const float* __restrict__ ws,
                                                 float* __restrict__ mixin) {
  __shared__ float red[4];
  __shared__ float red2[4];
  int t = blockIdx.x, c = threadIdx.x * 4;
  float4 a = *(const float4*)(attn_o + (size_t)t * 1024 + c);
  float ss = block_sum256(a.x * a.x + a.y * a.y + a.z * a.z + a.w * a.w, red);
  float r = rsqrtf(ss * (1.f / 1024) + EPS);
  float4 w = *(const float4*)(wa + c);
  float4 o = {a.x * r * w.x, a.y * r * w.y, a.z * r * w.z, a.w * r * w.w};
  *(float4*)(mixin + (size_t)t * DM + c) = o;
  float4 y = *(const float4*)(ssm_y + (size_t)t * 1024 + c);
  float s2 = wave_sum(y.x * y.x + y.y * y.y + y.z * y.z + y.w * y.w);
  if ((threadIdx.x & 63) == 0) red2[threadIdx.x >> 6] = s2;
  __syncthreads();
  int grp = threadIdx.x >> 7;
  float sg = red2[grp * 2] + red2[grp * 2 + 1];
  float rg = rsqrtf(sg * (1.f / 512) + EPS);
  float4 w2 = *(const float4*)(ws + c);
  float4 o2 = {y.x * rg * w2.x, y.y * rg * w2.y, y.z * rg * w2.z, y.w * rg * w2.w};
  *(float4*)(mixin + (size_t)t * DM + 1024 + c) = o2;
}

__global__ __launch_bounds__(256) void k_scores(const float* __restrict__ q, const float* __restrict__ keys,
                                                float* __restrict__ sc) {
  __shared__ float qs[2048];
  int t = blockIdx.x;
  for (int i = threadIdx.x; i < 2048; i += 256) qs[i] = q[(size_t)t * DM + i];
  __syncthreads();
  for (int r = 0; r < 8; r++) {
    int o = threadIdx.x + r * 256;
    int hc = o >> 7;
    const float* kp = keys + (size_t)o * 128;
    const float* qp = qs + hc * 128;
    float d = 0.f;
    for (int i = 0; i < 128; i += 4) {
      float4 kv = *(const float4*)(kp + i);
      d += qp[i] * kv.x + qp[i + 1] * kv.y + qp[i + 2] * kv.z + qp[i + 3] * kv.w;
    }
    sc[(size_t)t * 2048 + o] = d;
  }
}

__device__ __forceinline__ void wave_argmax(float& v, int& i) {
  for (int o = 32; o > 0; o >>= 1) {
    float ov = __shfl_xor(v, o);
    int oi = __shfl_xor(i, o);
    if (ov > v || (ov == v && oi < i)) { v = ov; i = oi; }
  }
}

__global__ __launch_bounds__(64) void k_topk(const float* __restrict__ sc, int* __restrict__ idx_out,
                                             float* __restrict__ gate_out) {
  __shared__ float s12[32];
  __shared__ int i12[32];
  int t = blockIdx.x >> 3, h = blockIdx.x & 7;
  int lane = threadIdx.x;
  for (int c = 0; c < 2; c++) {
    const float* sp = sc + (size_t)t * 2048 + (h * 2 + c) * 128;
    float v0 = sp[lane], v1 = sp[lane + 64];
    for (int r = 0; r < 16; r++) {
      float bv; int bi;
      if (v0 >= v1) { bv = v0; bi = lane; } else { bv = v1; bi = lane + 64; }
      wave_argmax(bv, bi);
      if (lane == r) { s12[c * 16 + r] = bv; i12[c * 16 + r] = bi; }
      if ((bi & 63) == lane) { if (bi < 64) v0 = -INFINITY; else v1 = -INFINITY; }
    }
  }
  __syncthreads();
  float c0 = s12[(lane >> 4)] + s12[16 + (lane & 15)];
  float c1 = s12[((lane + 64) >> 4)] + s12[16 + (lane & 15)];
  float c2 = s12[((lane + 128) >> 4)] + s12[16 + (lane & 15)];
  float c3 = s12[((lane + 192) >> 4)] + s12[16 + (lane & 15)];
  float mytop = 0.f; int mypos = 0;
  for (int r = 0; r < 16; r++) {
    float bv = c0; int bi = lane;
    if (c1 > bv) { bv = c1; bi = lane + 64; }
    if (c2 > bv) { bv = c2; bi = lane + 128; }
    if (c3 > bv) { bv = c3; bi = lane + 192; }
    wave_argmax(bv, bi);
    if (lane == r) { mytop = bv; mypos = bi; }
    if ((bi & 63) == lane) {
      int q = bi >> 6;
      if (q == 0) c0 = -INFINITY; else if (q == 1) c1 = -INFINITY; else if (q == 2) c2 = -INFINITY; else c3 = -INFINITY;
    }
  }
  float mx = __shfl(mytop, 0);
  float e = lane < 16 ? expf(mytop - mx) : 0.f;
  float den = wave_sum(e);
  if (lane < 16) {
    idx_out[(size_t)t * 128 + h * 16 + lane] = i12[mypos >> 4] * 128 + i12[16 + (mypos & 15)];
    gate_out[(size_t)t * 128 + h * 16 + lane] = e / den;
  }
}

__global__ __launch_bounds__(256) void k_peer(const float* __restrict__ xn, const float* __restrict__ h1,
                                              const int* __restrict__ idx, const float* __restrict__ gate,
                                              const float* __restrict__ U, const float* __restrict__ V,
                                              const float* __restrict__ lnf, float* __restrict__ out) {
  __shared__ float wts[128];
  __shared__ int ids[128];
  __shared__ float red[4];
  int t = blockIdx.x, tid = threadIdx.x, lane = tid & 63, w = tid >> 6;
  if (tid < 128) ids[tid] = idx[(size_t)t * 128 + tid];
  const float* xr = xn + (size_t)t * DM;
  float4 x0 = *(const float4*)(xr + (0 * 64 + lane) * 4), x1 = *(const float4*)(xr + (1 * 64 + lane) * 4);
  float4 x2 = *(const float4*)(xr + (2 * 64 + lane) * 4), x3 = *(const float4*)(xr + (3 * 64 + lane) * 4);
  float4 x4 = *(const float4*)(xr + (4 * 64 + lane) * 4), x5 = *(const float4*)(xr + (5 * 64 + lane) * 4);
  float4 x6 = *(const float4*)(xr + (6 * 64 + lane) * 4), x7 = *(const float4*)(xr + (7 * 64 + lane) * 4);
  __syncthreads();
  for (int k = w * 32; k < w * 32 + 32; k++) {
    const float* ur = U + (size_t)ids[k] * DM;
    float4 u0 = *(const float4*)(ur + (0 * 64 + lane) * 4), u1 = *(const float4*)(ur + (1 * 64 + lane) * 4);
    float4 u2 = *(const float4*)(ur + (2 * 64 + lane) * 4), u3 = *(const float4*)(ur + (3 * 64 + lane) * 4);
    float4 u4 = *(const float4*)(ur + (4 * 64 + lane) * 4), u5 = *(const float4*)(ur + (5 * 64 + lane) * 4);
    float4 u6 = *(const float4*)(ur + (6 * 64 + lane) * 4), u7 = *(const float4*)(ur + (7 * 64 + lane) * 4);
    float d = u0.x * x0.x + u0.y * x0.y + u0.z * x0.z + u0.w * x0.w + u1.x * x1.x + u1.y * x1.y + u1.z * x1.z + u1.w * x1.w +
              u2.x * x2.x + u2.y * x2.y + u2.z * x2.z + u2.w * x2.w + u3.x * x3.x + u3.y * x3.y + u3.z * x3.z + u3.w * x3.w +
              u4.x * x4.x + u4.y * x4.y + u4.z * x4.z + u4.w * x4.w + u5.x * x5.x + u5.y * x5.y + u5.z * x5.z + u5.w * x5.w +
              u6.x * x6.x + u6.y * x6.y + u6.z * x6.z + u6.w * x6.w + u7.x * x7.x + u7.y * x7.y + u7.z * x7.z + u7.w * x7.w;
    d = wave_sum(d);
    if (lane == 0) {
      float ge = 0.5f * d * (1.f + erff(d * 0.70710678118654752f));
      wts[k] = gate[(size_t)t * 128 + k] * ge;
    }
  }
  __syncthreads();
  int c = tid * 4;
  float4 a0 = {0, 0, 0, 0}, a1 = {0, 0, 0, 0};
  for (int k = 0; k < 128; k++) {
    const float* vr = V + (size_t)ids[k] * DM;
    float wk = wts[k];
    float4 v0 = *(const float4*)(vr + c), v1 = *(const float4*)(vr + 1024 + c);
    a0.x += wk * v0.x; a0.y += wk * v0.y; a0.z += wk * v0.z; a0.w += wk * v0.w;
    a1.x += wk * v1.x; a1.y += wk * v1.y; a1.z += wk * v1.z; a1.w += wk * v1.w;
  }
  float4 h0 = *(const float4*)(h1 + (size_t)t * DM + c), h1v = *(const float4*)(h1 + (size_t)t * DM + 1024 + c);
  a0.x += h0.x; a0.y += h0.y; a0.z += h0.z; a0.w += h0.w;
  a1.x += h1v.x; a1.y += h1v.y; a1.z += h1v.z; a1.w += h1v.w;
  float ss = a0.x * a0.x + a0.y * a0.y + a0.z * a0.z + a0.w * a0.w + a1.x * a1.x + a1.y * a1.y + a1.z * a1.z + a1.w * a1.w;
  ss = block_sum256(ss, red);
  float r = rsqrtf(ss * (1.f / DM) + EPS);
  float4 w0 = *(const float4*)(lnf + c), w1 = *(const float4*)(lnf + 1024 + c);
  float4 o0 = {a0.x * r * w0.x, a0.y * r * w0.y, a0.z * r * w0.z, a0.w * r * w0.w};
  float4 o1 = {a1.x * r * w1.x, a1.y * r * w1.y, a1.z * r * w1.z, a1.w * r * w1.w};
  *(float4*)(out + (size_t)t * DM + c) = o0;
  *(float4*)(out + (size_t)t * DM + 1024 + c) = o1;
}
}

extern "C" void kernel_launch(void* const* d_in, const int* in_sizes, int n_in, void* d_out, int out_size, void* d_ws,
                              size_t ws_size, hipStream_t stream) {
  const float* x = (const float*)d_in[0];
  const float* meta = (const float*)d_in[1];
  const float* rel_bias = (const float*)d_in[2];
  const float* ln_mix = (const float*)d_in[3];
  const float* w_in = (const float*)d_in[4];
  const float* sinks = (const float*)d_in[5];
  const float* conv_w = (const float*)d_in[6];
  const float* conv_b = (const float*)d_in[7];
  const float* dt_bias = (const float*)d_in[8];
  const float* a_log = (const float*)d_in[9];
  const float* d_skip = (const float*)d_in[10];
  const float* attn_norm_w = (const float*)d_in[11];
  const float* ssm_norm_w = (const float*)d_in[12];
  const float* w_out = (const float*)d_in[13];
  const float* ln_ffn = (const float*)d_in[14];
  const float* peer_wq = (const float*)d_in[15];
  const float* peer_keys = (const float*)d_in[16];
  const float* peer_u = (const float*)d_in[17];
  const float* peer_v = (const float*)d_in[18];
  const float* ln_final = (const float*)d_in[19];
  float* out = (float*)d_out;

  float* ws = (float*)d_ws;
  float* regA = ws;
  float* regB = regA + (size_t)TA * DM;
  float* regC = regB + (size_t)TA * DPROJ;
  float* regD = regC + (size_t)T * DM;
  float* regE = regD + (size_t)T * DM;
  float* hn = regA;
  float* proj = regB;
  float* attn_o = regC;
  float* ssm_y = regC + (size_t)T * 1024;
  float* xc = regD;
  float* mixin = regA;
  float* h1 = regD;
  float* xn = regA;
  float* q = regB;
  float* sc = regB + (size_t)T * DM;
  int* idx = (int*)regE;
  float* gates = regE + (size_t)T * 128;

  k_rmsnorm<<<TA, 256, 0, stream>>>(x, meta, ln_mix, hn);
  k_sgemm<false><<<dim3((DPROJ + 127) / 128, (TA + 127) / 128), 256, 0, stream>>>(hn, DM, w_in, DPROJ, proj, DPROJ, nullptr,
                                                                                 0, TA, DPROJ, DM);
  k_attn<<<T * 16, 64, 0, stream>>>(proj, rel_bias, sinks, attn_o);
  k_conv<<<TA, 256, 0, stream>>>(proj, conv_w, conv_b, xc);
  k_ssd<<<64, 64, 0, stream>>>(proj, xc, dt_bias, a_log, d_skip, ssm_y);
  k_mixnorm<<<T, 256, 0, stream>>>(attn_o, ssm_y, attn_norm_w, ssm_norm_w, mixin);
  k_sgemm<true><<<dim3(DM / 128, T / 128), 256, 0, stream>>>(mixin, DM, w_out, DM, h1, DM, x, DM, T, DM, DM);
  k_rmsnorm<<<T, 256, 0, stream>>>(h1, h1, ln_ffn, xn);
  k_sgemm<false><<<dim3(DM / 128, T / 128), 256, 0, stream>>>(xn, DM, peer_wq, DM, q, DM, nullptr, 0, T, DM, DM);
  k_scores<<<T, 256, 0, stream>>>(q, peer_keys, sc);
  k_topk<<<T * 8, 64, 0, stream>>>(sc, idx, gates);
  k_peer<<<T, 256, 0, stream>>>(xn, h1, idx, gates, peer_u, peer_v, ln_final, out);
}
```

```cpp
#include <hip/hip_runtime.h>
#include <hip/hip_cooperative_groups.h>
#include <math.h>
#include <stdio.h>
#include <stdint.h>

namespace {
constexpr int BATCH = 4, SEQ = 2048, DM = 2048, NMETA = 16;
constexpr int T = BATCH * SEQ;
constexpr int TA = T + NMETA;
constexpr int DPROJ = 4112;
constexpr int NPROJ = 4096;
constexpr int OFF_Q = 0, OFF_K = 1024, OFF_V = 1280, OFF_Z = 1536, OFF_XBC = 2560, OFF_DT = 4096;
constexpr int D_XBC = 1536;
constexpr int NEXP = 16384;
constexpr float EPS = 1e-6f;
constexpr int NTHREADS = 512;

typedef unsigned short bf16_t;
typedef short bf16x8 __attribute__((ext_vector_type(8)));
typedef float f32x4 __attribute__((ext_vector_type(4)));
typedef float f32x2 __attribute__((ext_vector_type(2)));
typedef unsigned u32x4 __attribute__((ext_vector_type(4)));
typedef unsigned u32x2 __attribute__((ext_vector_type(2)));
typedef __bf16 bf16v2 __attribute__((ext_vector_type(2)));
#define LAS __attribute__((address_space(3)))

__device__ __forceinline__ unsigned pack_bf16(float lo, float hi) {
  f32x2 v = {lo, hi};
  bf16v2 b = __builtin_convertvector(v, bf16v2);
  return *(unsigned*)&b;
}
__device__ __forceinline__ bf16_t f2bf(float f) { return (bf16_t)(pack_bf16(f, 0.f) & 0xffffu); }
__device__ __forceinline__ float bf2f(bf16_t b) { return __uint_as_float(((unsigned)b) << 16); }
__device__ __forceinline__ float bflo(unsigned u) { return __uint_as_float(u << 16); }
__device__ __forceinline__ float bfhi(unsigned u) { return __uint_as_float(u & 0xffff0000u); }

__constant__ unsigned char kBucket[128] = {
    0, 1, 2, 3, 4, 5, 6, 7, 8, 9, 10, 11, 12, 13, 14, 15, 16, 16, 16, 17, 17, 18, 18, 18, 19, 19, 19, 20, 20, 20, 20, 21,
    21, 21, 21, 22, 22, 22, 22, 22, 23, 23, 23, 23, 23, 23, 24, 24, 24, 24, 24, 24, 25, 25, 25, 25, 25, 25, 25, 26, 26, 26, 26, 26,
    26, 26, 26, 27, 27, 27, 27, 27, 27, 27, 27, 27, 27, 28, 28, 28, 28, 28, 28, 28, 28, 28, 28, 29, 29, 29, 29, 29, 29, 29, 29, 29,
    29, 29, 29, 30, 30, 30, 30, 30, 30, 30, 30, 30, 30, 30, 30, 30, 30, 31, 31, 31, 31, 31, 31, 31, 31, 31, 31, 31, 31, 31, 31, 31};

__constant__ unsigned char kCandI[64] = {0, 0, 0, 0, 0, 0, 0, 0, 0, 0, 0, 0, 0, 0, 0, 0, 1, 1, 1, 1, 1, 1, 1, 1, 2, 2, 2, 2, 2, 3, 3, 3, 3, 4, 4, 4, 5, 5, 6, 6, 7, 7, 8, 9, 10, 11, 12, 13, 14, 15, 15, 15, 15, 15, 15, 15, 15, 15, 15, 15, 15, 15, 15, 15};
__constant__ unsigned char kCandJ[64] = {0, 1, 2, 3, 4, 5, 6, 7, 8, 9, 10, 11, 12, 13, 14, 15, 0, 1, 2, 3, 4, 5, 6, 7, 0, 1, 2, 3, 4, 0, 1, 2, 3, 0, 1, 2, 0, 1, 0, 1, 0, 1, 0, 0, 0, 0, 0, 0, 0, 0, 15, 15, 15, 15, 15, 15, 15, 15, 15, 15, 15, 15, 15, 15};

__device__ __forceinline__ float wave_sum(float v) {
  for (int o = 32; o > 0; o >>= 1) v += __shfl_xor(v, o);
  return v;
}
__device__ __forceinline__ float wave_max(float v) {
  for (int o = 32; o > 0; o >>= 1) v = fmaxf(v, __shfl_xor(v, o));
  return v;
}
__device__ __forceinline__ float silu_f(float x) { return x / (1.f + expf(-x)); }
__device__ __forceinline__ float softplus_f(float x) { return fmaxf(x, 0.f) + log1pf(expf(-fabsf(x))); }

constexpr size_t al256(size_t x) { return (x + 255) & ~(size_t)255; }
constexpr size_t WS_CTL = 0;
constexpr size_t WS_WINT = 65536;
constexpr size_t WS_WDTT = WS_WINT + (size_t)NPROJ * DM * 2;
constexpr size_t WS_WOUTT = WS_WDTT + (size_t)16 * DM * 2;
constexpr size_t WS_WQT = WS_WOUTT + (size_t)DM * DM * 2;
constexpr size_t WS_KEYS = WS_WQT + (size_t)DM * DM * 2;
constexpr size_t WS_UB = WS_KEYS + (size_t)16 * 128 * 128 * 2;
constexpr size_t WS_VB = WS_UB + (size_t)NEXP * DM * 2;
constexpr size_t WS_HNB = WS_VB + (size_t)NEXP * DM * 2;
constexpr size_t WS_PROJ = WS_HNB + (size_t)(T + 16) * DM * 2;
constexpr size_t WS_DTRAW = WS_PROJ + (size_t)T * NPROJ * 2;
constexpr size_t WS_PROJM = WS_DTRAW + (size_t)T * 16 * 4;
constexpr size_t WS_H1B = al256(WS_PROJM + (size_t)16 * DPROJ * 4);
constexpr size_t WS_SSQH1 = WS_H1B + (size_t)T * DM * 2;
constexpr size_t WS_STOP = al256(WS_SSQH1 + (size_t)T * 32 * 4);
constexpr size_t WS_ITOP = WS_STOP + (size_t)T * 256 * 4;
constexpr size_t WS_ACSG = al256(WS_ITOP + (size_t)T * 256 * 4);
constexpr size_t WS_CCB = WS_ACSG + (size_t)T * 16 * 4;
constexpr size_t WS_YPART = WS_CCB + (size_t)T * 256 * 2;
constexpr size_t WS_SG = WS_YPART + (size_t)T * 1024 * 4;
constexpr size_t WS_SMETA = WS_SG + (size_t)1024 * 8192 * 4;
constexpr size_t WS_SCR = al256(WS_SMETA + (size_t)16 * 8192 * 4);
}

namespace pg8 {
#define PG8_LAS __attribute__((address_space(3)))
constexpr int BM = 256, BK = 64, HALF = 128, HTB = HALF * BK * 2, STAGE_BYTES = 8 * HTB, NXCD = 8, WGM = 8;
__host__ __device__ __forceinline__ int lds_byte(int r, int c) { const int st = (r >> 4) * 2 + (c >> 5), rr = r & 15, cc = c & 31, ob = rr * 64 + cc * 2; return st * 1024 + (ob ^ (((ob >> 9) & 1) << 5)); }
__host__ __device__ __forceinline__ void stage_rc(int b, int& R, int& C) { const int st = b / 1024, sb = b % 1024, swz = sb ^ (((sb >> 9) & 1) << 5); R = (st >> 1) * 16 + swz / 64; C = (st & 1) * 32 + (swz % 64) / 2; }
__host__ __device__ __forceinline__ int perm32(int rho) { const int n = rho >> 4, i = rho & 15; return 8 * (i >> 2) + 4 * n + (i & 3); }
struct Unit { int pm, pn; };
struct Gemm { const bf16_t* A; const bf16_t* Bt; int M, N, K; };
struct StaticOrder {
    int nM, nN, nwg, G, c;
    __host__ __device__ void init(int M, int N, int G_, int c_) { nM = M / BM; nN = N / BM; nwg = nM * nN; G = G_; c = c_; }
    __host__ __device__ bool next(int i, Unit& u) const {
        const long L = (long)i * G + c; if (L >= nwg) return false;
        int wgid = (int)L; { const int q = nwg / NXCD, r = nwg % NXCD, xcd = wgid % NXCD, off = wgid / NXCD; wgid = (xcd < r ? xcd * (q + 1) : r * (q + 1) + (xcd - r) * q) + off; }
        const int nig = WGM * nN, gid = wgid / nig, fm = gid * WGM, gsz = (nM - fm) < WGM ? (nM - fm) : WGM;
        u.pm = fm + ((wgid % nig) % gsz); u.pn = (wgid % nig) / gsz; return true;
    }
    __device__ __forceinline__ void a_ready(const Unit&) const {}
    __device__ __forceinline__ void done(const Unit&) const {}
};
struct EpiBf16 {
    static constexpr bool PERM = true, AFTER_DRAIN = false;
    bf16_t* O; int ldc;
    __device__ __forceinline__ void operator()(const f32x4 (&acc)[2][2][4][2], const Unit& u, int wr, int wc, int fr, int fq) const {
        const int row0 = u.pm * BM + wr * 64 + fr; const int col0 = u.pn * BM + wc * 32 + 8 * fq;
#pragma unroll
        for (int ai = 0; ai < 2; ++ai)
#pragma unroll
            for (int m = 0; m < 4; ++m) { bf16_t* rowp = O + (size_t)(row0 + ai * HALF + m * 16) * ldc + col0;
#pragma unroll
                for (int bj = 0; bj < 2; ++bj) { const f32x4 v0 = acc[ai][bj][m][0], v1 = acc[ai][bj][m][1];
                    u32x4 w; w.x = pack_bf16(v0[0], v0[1]); w.y = pack_bf16(v0[2], v0[3]); w.z = pack_bf16(v1[0], v1[1]); w.w = pack_bf16(v1[2], v1[3]);
                    *(u32x4*)(rowp + bj * HALF) = w; } }
    }
};

struct EpiRes {
    static constexpr bool PERM = true, AFTER_DRAIN = false;
    const float* X; float* H; bf16_t* HB; float* SSQ;
    __device__ __forceinline__ void operator()(const f32x4 (&acc)[2][2][4][2], const Unit& u, int wr, int wc, int fr, int fq) const {
        const int row0 = u.pm * BM + wr * 64 + fr; const int col0 = u.pn * BM + wc * 32 + 8 * fq;
#pragma unroll
        for (int ai = 0; ai < 2; ++ai)
#pragma unroll
            for (int m = 0; m < 4; ++m) { const int row = row0 + ai * HALF + m * 16; const size_t off = (size_t)row * DM + col0; float ss = 0.f;
#pragma unroll
                for (int bj = 0; bj < 2; ++bj) {
                    const f32x4 x0 = *(const f32x4*)(X + off + bj * HALF), x1 = *(const f32x4*)(X + off + bj * HALF + 4);
                    const f32x4 v0 = acc[ai][bj][m][0] + x0, v1 = acc[ai][bj][m][1] + x1;
                    *(f32x4*)(H + off + bj * HALF) = v0; *(f32x4*)(H + off + bj * HALF + 4) = v1;
                    u32x4 w; w.x = pack_bf16(v0[0], v0[1]); w.y = pack_bf16(v0[2], v0[3]); w.z = pack_bf16(v1[0], v1[1]); w.w = pack_bf16(v1[2], v1[3]);
                    *(u32x4*)(HB + off + bj * HALF) = w;
                    ss += v0[0] * v0[0] + v0[1] * v0[1] + v0[2] * v0[2] + v0[3] * v0[3] + v1[0] * v1[0] + v1[1] * v1[1] + v1[2] * v1[2] + v1[3] * v1[3]; }
                ss += __shfl_xor(ss, 16); ss += __shfl_xor(ss, 32);
                if (fq == 0) SSQ[(size_t)row * 32 + u.pn * 4 + wc] = ss; }
    }
};
struct EpiF32 {
    static constexpr bool PERM = true, AFTER_DRAIN = false;
    float* C; int ldc;
    __device__ __forceinline__ void operator()(const f32x4 (&acc)[2][2][4][2], const Unit& u, int wr, int wc, int fr, int fq) const {
        const int row0 = u.pm * BM + wr * 64 + fr; const int col0 = u.pn * BM + wc * 32 + 8 * fq;
#pragma unroll
        for (int ai = 0; ai < 2; ++ai)
#pragma unroll
            for (int m = 0; m < 4; ++m) { float* rowp = C + (size_t)(row0 + ai * HALF + m * 16) * ldc + col0;
#pragma unroll
                for (int bj = 0; bj < 2; ++bj) { *(f32x4*)(rowp + bj * HALF) = acc[ai][bj][m][0]; *(f32x4*)(rowp + bj * HALF + 4) = acc[ai][bj][m][1]; } }
    }
};

struct EpiScores {
    static constexpr bool PERM = true, AFTER_DRAIN = true;
    const bf16_t* KEYS;
    float* STOP; int* ITOP;
    static constexpr int QLD = 264;
    __device__ __forceinline__ void fused(f32x4 (&acc)[2][2][4][2], const Unit& u, int wr, int wc, int fr, int fq, PG8_LAS unsigned char* lds, int wid, int lane) const {
        PG8_LAS bf16_t* Q = (PG8_LAS bf16_t*)lds;
#pragma unroll
        for (int ai = 0; ai < 2; ++ai)
#pragma unroll
            for (int m = 0; m < 4; ++m) { const int row = ai * HALF + wr * 64 + m * 16 + fr;
#pragma unroll
                for (int bj = 0; bj < 2; ++bj) { const f32x4 v0 = acc[ai][bj][m][0], v1 = acc[ai][bj][m][1];
                    u32x4 w; w.x = pack_bf16(v0[0], v0[1]); w.y = pack_bf16(v0[2], v0[3]); w.z = pack_bf16(v1[0], v1[1]); w.w = pack_bf16(v1[2], v1[3]);
                    *(PG8_LAS u32x4*)(Q + row * QLD + bj * HALF + wc * 32 + 8 * fq) = w; } }
        __syncthreads();
        const int h = u.pn;
#pragma unroll 1
        for (int c = 0; c < 2; ++c) {
            f32x4 sc[8][2];
#pragma unroll
            for (int kf = 0; kf < 8; ++kf) { sc[kf][0] = (f32x4){0.f, 0.f, 0.f, 0.f}; sc[kf][1] = (f32x4){0.f, 0.f, 0.f, 0.f}; }
            const bf16_t* kb = KEYS + (size_t)((h * 2 + c) * 128 + fr) * 128 + 8 * fq;
            const PG8_LAS bf16_t* qb = Q + (wid * 32 + fr) * QLD + c * 128 + 8 * fq;
#pragma unroll
            for (int ks = 0; ks < 4; ++ks) {
                const bf16x8 q0 = *(const PG8_LAS bf16x8*)(qb + 32 * ks), q1 = *(const PG8_LAS bf16x8*)(qb + 16 * QLD + 32 * ks);
#pragma unroll
                for (int kf = 0; kf < 8; ++kf) { const bf16x8 kv = *(const bf16x8*)(kb + (size_t)kf * 16 * 128 + 32 * ks);
                    sc[kf][0] = __builtin_amdgcn_mfma_f32_16x16x32_bf16(kv, q0, sc[kf][0], 0, 0, 0);
                    sc[kf][1] = __builtin_amdgcn_mfma_f32_16x16x32_bf16(kv, q1, sc[kf][1], 0, 0, 0); }
            }
#pragma unroll
            for (int tf = 0; tf < 2; ++tf) {
                float v[32];
#pragma unroll
                for (int kf = 0; kf < 8; ++kf)
#pragma unroll
                    for (int r = 0; r < 4; ++r) v[kf * 4 + r] = __uint_as_float((__float_as_uint(sc[kf][tf][r]) & 0xffffff80u) | (unsigned)(16 * kf + r));
                const unsigned fqbits = 4u * fq;
                const size_t obase = ((size_t)(u.pm * BM + wid * 32 + tf * 16 + fr) * 16 + h * 2 + c) * 16;
#pragma unroll 1
                for (int r = 0; r < 16; ++r) {
                    float mx = v[0];
#pragma unroll
                    for (int i = 1; i < 32; ++i) mx = fmaxf(mx, v[i]);
                    float cand = __uint_as_float(__float_as_uint(mx) | fqbits);
                    float o = __shfl_xor(cand, 16); cand = fmaxf(cand, o);
                    o = __shfl_xor(cand, 32); cand = fmaxf(cand, o);
                    const unsigned cb = __float_as_uint(cand);
                    const bool mine = (cb & 12u) == fqbits;
                    const float rem = __uint_as_float(cb & ~12u);
#pragma unroll
                    for (int i = 0; i < 32; ++i) v[i] = (mine && v[i] == rem) ? -INFINITY : v[i];
                    if (fq == 0) { STOP[obase + r] = __uint_as_float(cb & 0xffffff80u); ITOP[obase + r] = (int)(cb & 127u); }
                }
            }
        }
    }
};

template <class Epi, class Sched>
__device__ __forceinline__ void gemm_phase(PG8_LAS unsigned char* lds, const Gemm g, const Sched& S, const Epi& E) {
    int tid_ = threadIdx.x; asm volatile("" : "+v"(tid_));
    const int tid = tid_, wid = __builtin_amdgcn_readfirstlane(tid >> 6), lane = tid & 63, wr = wid >> 2, wc = wid & 3, fr = lane & 15, fq = lane >> 4;
    const int K = g.K, nt = K / BK;
    unsigned voffA[2], voffB[2];
#pragma unroll
    for (int i = 0; i < 2; ++i) { int R, C; stage_rc(tid * 16 + i * 8192, R, C); const int Rb = Epi::PERM ? ((R & ~31) + perm32(R & 31)) : R;
        voffA[i] = (unsigned)(R * K + C) * 2u; voffB[i] = (unsigned)(Rb * K + C) * 2u; }
    const size_t kstep = (size_t)(BK * 2);
    const size_t hstep = (size_t)HALF * K * 2;
    const size_t tstep = 2 * hstep;
    const unsigned ldsw = (unsigned)wid * 1024u;
    const int aoff = lds_byte(wr * 64 + fr, fq * 8), boff = lds_byte(wc * 32 + fr, fq * 8);
#define PG8_SA(b, h) (((b) * 2 + (h)) * HTB)
#define PG8_SB(b, h) ((4 + (b) * 2 + (h)) * HTB)
#define PG8_STAGE(bufoff, gbase, voff) do { _Pragma("unroll") for (int _i = 0; _i < 2; ++_i) \
        __builtin_amdgcn_global_load_lds((const unsigned*)((const char*)(gbase) + (voff)[_i]), (PG8_LAS unsigned*)(lds + (bufoff) + ldsw + _i * 8192), 16, 0, 0); } while (0)
#define PG8_LDA(dst, b, h) do { _Pragma("unroll") for (int m = 0; m < 4; ++m) _Pragma("unroll") for (int k = 0; k < 2; ++k) dst[m][k] = *(const PG8_LAS bf16x8*)(lds + PG8_SA(b, h) + aoff + m * 2048 + k * 1024); } while (0)
#define PG8_LDB(dst, b, h) do { _Pragma("unroll") for (int n = 0; n < 2; ++n) _Pragma("unroll") for (int k = 0; k < 2; ++k) dst[n][k] = *(const PG8_LAS bf16x8*)(lds + PG8_SB(b, h) + boff + n * 2048 + k * 1024); } while (0)
#define PG8_MMA(ai, bj, At, Bt) do { __builtin_amdgcn_s_setprio(1); _Pragma("unroll") for (int m = 0; m < 4; ++m) _Pragma("unroll") for (int n = 0; n < 2; ++n) _Pragma("unroll") for (int k = 0; k < 2; ++k) \
        acc[ai][bj][m][n] = __builtin_amdgcn_mfma_f32_16x16x32_bf16(Bt[n][k], At[m][k], acc[ai][bj][m][n], 0, 0, 0); __builtin_amdgcn_s_setprio(0); } while (0)
#define PG8_WAIT_V(n) asm volatile("s_waitcnt vmcnt(" #n ")" ::: "memory")
#define PG8_WAIT_L(n) asm volatile("s_waitcnt lgkmcnt(" #n ")" ::: "memory")
#define PG8_BAR __builtin_amdgcn_s_barrier()
#define PG8_SCHED __builtin_amdgcn_sched_barrier(0)
    Unit cur, nxt; int ui = 0;
    if (!S.next(0, cur)) return;
    f32x4 acc[2][2][4][2];
#pragma unroll
    for (int a = 0; a < 2; ++a)
#pragma unroll
        for (int b = 0; b < 2; ++b)
#pragma unroll
            for (int m = 0; m < 4; ++m)
#pragma unroll
                for (int n = 0; n < 2; ++n) acc[a][b][m][n] = (f32x4){0.f, 0.f, 0.f, 0.f};
    bf16x8 At[4][2], B0[2][2], B1[2][2];
    const char* cA = (const char*)g.A + (size_t)cur.pm * tstep; const char* cB = (const char*)g.Bt + (size_t)cur.pn * tstep;
    S.a_ready(cur);
    PG8_STAGE(PG8_SB(0, 0), cB, voffB); PG8_STAGE(PG8_SA(0, 0), cA, voffA); PG8_STAGE(PG8_SB(0, 1), cB + hstep, voffB); PG8_STAGE(PG8_SA(0, 1), cA + hstep, voffA);
    if (wr == 1) PG8_BAR;
    PG8_WAIT_V(4); PG8_BAR;
    PG8_STAGE(PG8_SB(1, 0), cB + kstep, voffB); PG8_STAGE(PG8_SA(1, 0), cA + kstep, voffA); PG8_STAGE(PG8_SB(1, 1), cB + hstep + kstep, voffB);
    PG8_WAIT_V(6); PG8_BAR;
    for (;;) {
        const bool has_next = S.next(ui + 1, nxt);
        const char* nA = has_next ? (const char*)g.A + (size_t)nxt.pm * tstep : cA; const char* nB = has_next ? (const char*)g.Bt + (size_t)nxt.pn * tstep : cB;
        for (int t = 0; t < nt; t += 2) {
            const bool last = (t == nt - 2);
            const char* a1 = cA + (size_t)(t + 1) * kstep;
            const char* a2 = last ? nA : cA + (size_t)(t + 2) * kstep; const char* b2 = last ? nB : cB + (size_t)(t + 2) * kstep;
            const char* a3 = a2 + kstep; const char* b3 = b2 + kstep;
            if (last && has_next) S.a_ready(nxt);
            PG8_LDB(B0, 0, 0); PG8_SCHED; PG8_LDA(At, 0, 0); PG8_STAGE(PG8_SA(1, 1), a1 + hstep, voffA);
            PG8_WAIT_L(8); PG8_BAR; PG8_WAIT_L(0); PG8_MMA(0, 0, At, B0); PG8_BAR; PG8_SCHED;
            PG8_LDB(B1, 0, 1); PG8_STAGE(PG8_SB(0, 0), b2, voffB);
            PG8_BAR; PG8_WAIT_L(0); PG8_MMA(0, 1, At, B1); PG8_BAR;
            PG8_LDA(At, 0, 1); PG8_STAGE(PG8_SA(0, 0), a2, voffA);
            PG8_BAR; PG8_WAIT_L(0); PG8_MMA(1, 0, At, B0); PG8_BAR; PG8_SCHED;
            PG8_STAGE(PG8_SB(0, 1), b2 + hstep, voffB);
            PG8_WAIT_V(6); PG8_BAR; PG8_MMA(1, 1, At, B1); PG8_BAR;
            PG8_LDB(B0, 1, 0); PG8_SCHED; PG8_LDA(At, 1, 0); PG8_STAGE(PG8_SA(0, 1), a2 + hstep, voffA);
            PG8_WAIT_L(8); PG8_BAR; PG8_WAIT_L(0); PG8_MMA(0, 0, At, B0); PG8_BAR; PG8_SCHED;
            PG8_LDB(B1, 1, 1); PG8_STAGE(PG8_SB(1, 0), b3, voffB);
            PG8_BAR; PG8_WAIT_L(0); PG8_MMA(0, 1, At, B1); PG8_BAR;
            PG8_LDA(At, 1, 1); PG8_STAGE(PG8_SA(1, 0), a3, voffA);
            PG8_BAR; PG8_WAIT_L(0); PG8_MMA(1, 0, At, B0); PG8_BAR; PG8_SCHED;
            PG8_STAGE(PG8_SB(1, 1), b3 + hstep, voffB);
            PG8_WAIT_V(6); PG8_BAR; PG8_MMA(1, 1, At, B1); PG8_BAR;
        }
        if constexpr (!Epi::AFTER_DRAIN) { E(acc, cur, wr, wc, fr, fq); S.done(cur); }
        if (!has_next) break;
#pragma unroll
        for (int a = 0; a < 2; ++a)
#pragma unroll
            for (int b = 0; b < 2; ++b)
#pragma unroll
                for (int m = 0; m < 4; ++m)
#pragma unroll
                    for (int n = 0; n < 2; ++n) acc[a][b][m][n] = (f32x4){0.f, 0.f, 0.f, 0.f};
        cur = nxt; cA = nA; cB = nB; ++ui;
    }
    PG8_WAIT_V(0);
    if (wr == 0) PG8_BAR;
    PG8_BAR;
    if constexpr (Epi::AFTER_DRAIN) { E.fused(acc, cur, wr, wc, fr, fq, lds, wid, lane); S.done(cur); }
#undef PG8_SA
#undef PG8_SB
#undef PG8_STAGE
#undef PG8_LDA
#undef PG8_LDB
#undef PG8_MMA
#undef PG8_WAIT_V
#undef PG8_WAIT_L
#undef PG8_BAR
#undef PG8_SCHED
}
}

namespace {
struct Params {
  const float *x, *meta, *rel_bias, *ln_mix, *w_in, *sinks, *conv_w, *conv_b, *dt_bias, *a_log, *d_skip, *attn_norm_w,
      *ssm_norm_w, *w_out, *ln_ffn, *wq, *keys, *U, *V, *ln_final;
  float* out;
  unsigned char* ws;
};

__device__ __forceinline__ void p0_transpose_tile(const float* __restrict__ W, int ldw, bf16_t* __restrict__ Wt, const float* sc0,
                                                  const float* sc1, int k0, int n0, float* tile  ) {
  const int tid = threadIdx.x;
  {
    const int r = tid >> 4, c4 = (tid & 15) * 4;
    const float4 a = *(const float4*)(W + (size_t)(k0 + r) * ldw + n0 + c4);
    const float4 b = *(const float4*)(W + (size_t)(k0 + r + 32) * ldw + n0 + c4);
    float* p = tile + r * 65 + c4;
    p[0] = a.x; p[1] = a.y; p[2] = a.z; p[3] = a.w;
    float* q = tile + (r + 32) * 65 + c4;
    q[0] = b.x; q[1] = b.y; q[2] = b.z; q[3] = b.w;
  }
  __syncthreads();
  {
    const int n = tid >> 3, kc = (tid & 7) * 8;
    float v[8];
#pragma unroll
    for (int j = 0; j < 8; ++j) {
      float s = 1.f;
      const int k = k0 + kc + j;
      if (sc0) s = k < 1024 ? sc0[k] : sc1[k - 1024];
      v[j] = tile[(kc + j) * 65 + n] * s;
    }
    u32x4 w; w.x = pack_bf16(v[0], v[1]); w.y = pack_bf16(v[2], v[3]); w.z = pack_bf16(v[4], v[5]); w.w = pack_bf16(v[6], v[7]);
    *(u32x4*)(Wt + (size_t)(n0 + n) * DM + k0 + kc) = w;
  }
  __syncthreads();
}

__device__ __forceinline__ void phase0(const Params& p, float* ldsf, int bid, int nblk) {
  const int tid = threadIdx.x, lane = tid & 63, wid = tid >> 6;
  bf16_t* w_inT = (bf16_t*)(p.ws + WS_WINT);
  bf16_t* w_dtT = (bf16_t*)(p.ws + WS_WDTT);
  bf16_t* w_outT = (bf16_t*)(p.ws + WS_WOUTT);
  bf16_t* wqT = (bf16_t*)(p.ws + WS_WQT);
  bf16_t* keysb = (bf16_t*)(p.ws + WS_KEYS);
  bf16_t* ub = (bf16_t*)(p.ws + WS_UB);
  bf16_t* vb = (bf16_t*)(p.ws + WS_VB);
  bf16_t* hnb = (bf16_t*)(p.ws + WS_HNB);
  constexpr int U_HN = (TA + 7) / 8;
  constexpr int U_WIN = 32 * 64, U_WOUT = 32 * 32, U_WQ = 32 * 32, U_WDT = 1, U_KEYS = 64, U_U = NEXP / 8, U_V = NEXP / 8;
  constexpr int B_WIN = U_HN, B_WOUT = B_WIN + U_WIN, B_WQ = B_WOUT + U_WOUT, B_WDT = B_WQ + U_WQ, B_KEYS = B_WDT + U_WDT,
                B_U = B_KEYS + U_KEYS, B_V = B_U + U_U, B_END = B_V + U_V;
  for (int u = bid; u < B_END; u += nblk) {
    if (u < B_WIN) {
      const int t = u * 8 + wid;
      if (t < TA) {
        const float* src = t < T ? p.x + (size_t)t * DM : p.meta + (size_t)(t - T) * DM;
        float4 v[8];
        float ss = 0.f;
#pragma unroll
        for (int i = 0; i < 8; ++i) {
          v[i] = *(const float4*)(src + (i * 64 + lane) * 4);
          ss += v[i].x * v[i].x + v[i].y * v[i].y + v[i].z * v[i].z + v[i].w * v[i].w;
        }
        ss = wave_sum(ss);
        const float r = rsqrtf(ss * (1.f / DM) + EPS);
#pragma unroll
        for (int i = 0; i < 8; ++i) {
          const float4 w = *(const float4*)(p.ln_mix + (i * 64 + lane) * 4);
          u32x2 o; o.x = pack_bf16(v[i].x * r * w.x, v[i].y * r * w.y); o.y = pack_bf16(v[i].z * r * w.z, v[i].w * r * w.w);
          *(u32x2*)(hnb + (size_t)t * DM + (i * 64 + lane) * 4) = o;
        }
      }
    } else if (u < B_WOUT) {
      const int i = u - B_WIN;
      p0_transpose_tile(p.w_in, DPROJ, w_inT, nullptr, nullptr, (i & 31) * 64, (i >> 5) * 64, ldsf);
    } else if (u < B_WQ) {
      const int i = u - B_WOUT;
      p0_transpose_tile(p.w_out, DM, w_outT, p.attn_norm_w, p.ssm_norm_w, (i & 31) * 64, (i >> 5) * 64, ldsf);
    } else if (u < B_WDT) {
      const int i = u - B_WQ;
      p0_transpose_tile(p.wq, DM, wqT, p.ln_ffn, p.ln_ffn + 1024, (i & 31) * 64, (i >> 5) * 64, ldsf);
    } else if (u < B_KEYS) {
      for (int idx = tid; idx < DM * 16; idx += NTHREADS) {
        const int k = idx >> 4, j = idx & 15;
        w_dtT[(size_t)j * DM + k] = f2bf(p.w_in[(size_t)k * DPROJ + NPROJ + j]);
      }
    } else if (u < B_U) {
      const size_t base = (size_t)(u - B_KEYS) * 4096 + (size_t)tid * 8;
      const float4 a = *(const float4*)(p.keys + base), b = *(const float4*)(p.keys + base + 4);
      u32x4 w; w.x = pack_bf16(a.x, a.y); w.y = pack_bf16(a.z, a.w); w.z = pack_bf16(b.x, b.y); w.w = pack_bf16(b.z, b.w);
      *(u32x4*)(keysb + base) = w;
    } else {
      const bool isU = u < B_V;
      const float* src = isU ? p.U : p.V;
      bf16_t* dst = isU ? ub : vb;
      const size_t rowbase = (size_t)(isU ? (u - B_U) : (u - B_V)) * 8 * DM;
#pragma unroll
      for (int it = 0; it < 4; ++it) {
        const int idx = it * 4096 + tid * 8;
        const int col = idx & (DM - 1);
        float4 a = *(const float4*)(src + rowbase + idx), b = *(const float4*)(src + rowbase + idx + 4);
        if (isU) {
          const float4 s0 = *(const float4*)(p.ln_ffn + col), s1 = *(const float4*)(p.ln_ffn + col + 4);
          a.x *= s0.x; a.y *= s0.y; a.z *= s0.z; a.w *= s0.w; b.x *= s1.x; b.y *= s1.y; b.z *= s1.z; b.w *= s1.w;
        }
        u32x4 w; w.x = pack_bf16(a.x, a.y); w.y = pack_bf16(a.z, a.w); w.z = pack_bf16(b.x, b.y); w.w = pack_bf16(b.z, b.w);
        *(u32x4*)(dst + rowbase + idx) = w;
      }
    }
  }
}

__device__ __forceinline__ void mini_gemm(const bf16_t* __restrict__ A, const bf16_t* __restrict__ Bt, float* __restrict__ out, int ldo,
                                          float* red) {
  const int tid = threadIdx.x, lane = tid & 63, wid = tid >> 6, fr = lane & 15, fq = lane >> 4;
  f32x4 acc = {0.f, 0.f, 0.f, 0.f};
  const bf16_t* ap = A + (size_t)fr * DM + wid * 256 + fq * 8;
  const bf16_t* bp = Bt + (size_t)fr * DM + wid * 256 + fq * 8;
#pragma unroll
  for (int ks = 0; ks < 8; ++ks) {
    const bf16x8 a = *(const bf16x8*)(ap + ks * 32);
    const bf16x8 b = *(const bf16x8*)(bp + ks * 32);
    acc = __builtin_amdgcn_mfma_f32_16x16x32_bf16(a, b, acc, 0, 0, 0);
  }
#pragma unroll
  for (int r = 0; r < 4; ++r) red[wid * 256 + (4 * fq + r) * 16 + fr] = acc[r];
  __syncthreads();
  if (tid < 256) {
    float s = 0.f;
#pragma unroll
    for (int w = 0; w < 8; ++w) s += red[w * 256 + tid];
    out[(size_t)(tid >> 4) * ldo + (tid & 15)] = s;
  }
  __syncthreads();
}

__device__ __forceinline__ void phase1(const Params& p, unsigned char* lds, int bid, int nblk) {
  const bf16_t* hnb = (const bf16_t*)(p.ws + WS_HNB);
  const bf16_t* w_inT = (const bf16_t*)(p.ws + WS_WINT);
  const bf16_t* w_dtT = (const bf16_t*)(p.ws + WS_WDTT);
  float* dtraw = (float*)(p.ws + WS_DTRAW);
  float* projm = (float*)(p.ws + WS_PROJM);
  constexpr int NU = 512 + 32 + 96 + 1;
  for (int u = bid; u < NU; u += nblk) {
    if (u < 512) {
      mini_gemm(hnb + (size_t)u * 16 * DM, w_dtT, dtraw + (size_t)u * 16 * 16, 16, (float*)lds);
    } else {
      const int j = u - 512;
      const int cf = j < 32 ? 64 + j : (j < 128 ? 160 + (j - 32) : 256);
      const bf16_t* bt = cf < 256 ? w_inT + (size_t)cf * 16 * DM : w_dtT;
      mini_gemm(hnb + (size_t)T * DM, bt, projm + cf * 16, DPROJ, (float*)lds);
    }
  }
  pg8::Gemm g{hnb, w_inT, T, NPROJ, DM};
  pg8::StaticOrder S; S.init(T, NPROJ, nblk, bid);
  pg8::EpiBf16 E{(bf16_t*)(p.ws + WS_PROJ), NPROJ};
  pg8::gemm_phase<pg8::EpiBf16, pg8::StaticOrder>((PG8_LAS unsigned char*)lds, g, S, E);
}

__device__ __forceinline__ void phase4(const Params& p, unsigned char* lds, int bid, int nblk) {
  pg8::Gemm g{(const bf16_t*)(p.ws + WS_HNB), (const bf16_t*)(p.ws + WS_WOUTT), T, DM, DM};
  pg8::StaticOrder S; S.init(T, DM, nblk, bid);
  pg8::EpiRes E{p.x, (float*)(p.ws + WS_PROJ), (bf16_t*)(p.ws + WS_H1B), (float*)(p.ws + WS_SSQH1)};
  pg8::gemm_phase<pg8::EpiRes, pg8::StaticOrder>((PG8_LAS unsigned char*)lds, g, S, E);
}
__device__ __forceinline__ void phase5(const Params& p, unsigned char* lds, int bid, int nblk) {
  pg8::Gemm g{(const bf16_t*)(p.ws + WS_H1B), (const bf16_t*)(p.ws + WS_WQT), T, DM, DM};
  pg8::StaticOrder S; S.init(T, DM, nblk, bid);
  pg8::EpiScores E{(const bf16_t*)(p.ws + WS_KEYS), (float*)(p.ws + WS_STOP), (int*)(p.ws + WS_ITOP)};
  pg8::gemm_phase<pg8::EpiScores, pg8::StaticOrder>((PG8_LAS unsigned char*)lds, g, S, E);
}

__device__ __forceinline__ float dot2bf(unsigned a, unsigned b, float c) {
  return __builtin_amdgcn_fdot2_f32_bf16(*(bf16v2*)&a, *(bf16v2*)&b, c, false);
}
__device__ __forceinline__ void phase6(const Params& p, unsigned char* lds, int bid, int nblk) {
  const int tid = threadIdx.x, lane = tid & 63, wid = __builtin_amdgcn_readfirstlane(tid >> 6);
  float* red = (float*)lds;
  float* gts = (float*)(lds + 65536);
  int* ids = (int*)(lds + 65536 + 512);
  float* wts = (float*)(lds + 65536 + 1024);
  float* red2 = (float*)(lds + 65536 + 1536);
  const bf16_t* ub = (const bf16_t*)(p.ws + WS_UB);
  const bf16_t* vb = (const bf16_t*)(p.ws + WS_VB);
  const bf16_t* h1b = (const bf16_t*)(p.ws + WS_H1B);
  const float* h1 = (const float*)(p.ws + WS_PROJ);
  const float* ssq = (const float*)(p.ws + WS_SSQH1);
  const float* stop = (const float*)(p.ws + WS_STOP);
  const int* itop = (const int*)(p.ws + WS_ITOP);
  const int ci = kCandI[lane], cj = kCandJ[lane];
  const int kcode = 4 * ((lane >> 3) & 1) + 2 * ((lane >> 4) & 1) + ((lane >> 5) & 1);
  for (int t = bid; t < T; t += nblk) {
    const float part0 = lane < 32 ? ssq[(size_t)t * 32 + lane] : 0.f;
    const float rr = rsqrtf(wave_sum(part0) * (1.f / DM) + EPS);
    const size_t lbase = ((size_t)t * 16 + wid * 2) * 16;
    const float sv = lane < 32 ? stop[lbase + lane] : 0.f;
    const int iv = lane < 32 ? itop[lbase + lane] : 0;
    float cand = (__shfl(sv, ci) + __shfl(sv, 16 + cj)) * rr;
    if (lane >= 50) cand = -INFINITY;
    int rank = 0;
#pragma unroll
    for (int k = 0; k < 50; ++k) {
      const float ck = __int_as_float(__builtin_amdgcn_readlane(__float_as_int(cand), k));
      rank += ((ck > cand) || (ck == cand && k < lane)) ? 1 : 0;
    }
    const float cmax = wave_max(cand);
    const float ex = rank < 16 ? __expf(cand - cmax) : 0.f;
    const float den = wave_sum(ex);
    const int eidx = __shfl(iv, ci) * 128 + __shfl(iv, 16 + cj);
    if (rank < 16) { ids[wid * 16 + rank] = eidx; gts[wid * 16 + rank] = ex / den; }
    u32x4 xv[4];
#pragma unroll
    for (int c = 0; c < 4; ++c) xv[c] = *(const u32x4*)(h1b + (size_t)t * DM + (c * 64 + lane) * 8);
#pragma unroll 1
    for (int half = 0; half < 2; ++half) {
      u32x4 rows[8][4];
#pragma unroll
      for (int k = 0; k < 8; ++k) {
        const int e = __builtin_amdgcn_readfirstlane(ids[wid * 16 + half * 8 + k]);
        const bf16_t* rp = ub + (size_t)e * DM + lane * 8;
#pragma unroll
        for (int c = 0; c < 4; ++c) rows[k][c] = *(const u32x4*)(rp + c * 512);
      }
      float part[8];
#pragma unroll
      for (int k = 0; k < 8; ++k) {
        float d = 0.f;
#pragma unroll
        for (int c = 0; c < 4; ++c) {
          d = dot2bf(rows[k][c].x, xv[c].x, d); d = dot2bf(rows[k][c].y, xv[c].y, d);
          d = dot2bf(rows[k][c].z, xv[c].z, d); d = dot2bf(rows[k][c].w, xv[c].w, d);
        }
        part[k] = d;
      }
      float q4[4], q2[2], q1;
      { const bool hi = (lane >> 5) & 1;
#pragma unroll
        for (int i = 0; i < 4; ++i) { const float keep = hi ? part[2 * i + 1] : part[2 * i], send = hi ? part[2 * i] : part[2 * i + 1]; q4[i] = keep + __shfl_xor(send, 32); } }
      { const bool hi = (lane >> 4) & 1;
#pragma unroll
        for (int i = 0; i < 2; ++i) { const float keep = hi ? q4[2 * i + 1] : q4[2 * i], send = hi ? q4[2 * i] : q4[2 * i + 1]; q2[i] = keep + __shfl_xor(send, 16); } }
      { const bool hi = (lane >> 3) & 1;
        const float keep = hi ? q2[1] : q2[0], send = hi ? q2[0] : q2[1]; q1 = keep + __shfl_xor(send, 8); }
      q1 += __shfl_xor(q1, 4);
      q1 += __shfl_xor(q1, 2);
      q1 += __shfl_xor(q1, 1);
      {
        const int kk = half * 8 + kcode;
        const float a = q1 * rr;
        const float ge = 0.5f * a * (1.f + erff(a * 0.70710678118654752f));
        if ((lane & 7) == 0) wts[wid * 16 + kk] = gts[wid * 16 + kk] * ge;
      }
    }
    float acc[32];
#pragma unroll
    for (int i = 0; i < 32; ++i) acc[i] = 0.f;
#pragma unroll 1
    for (int half = 0; half < 2; ++half) {
      u32x4 rows[8][4];
#pragma unroll
      for (int k = 0; k < 8; ++k) {
        const int e = __builtin_amdgcn_readfirstlane(ids[wid * 16 + half * 8 + k]);
        const bf16_t* rp = vb + (size_t)e * DM + lane * 8;
#pragma unroll
        for (int c = 0; c < 4; ++c) rows[k][c] = *(const u32x4*)(rp + c * 512);
      }
#pragma unroll
      for (int k = 0; k < 8; ++k) {
        const float wk = wts[wid * 16 + half * 8 + k];
#pragma unroll
        for (int c = 0; c < 4; ++c) {
          acc[c * 8 + 0] = fmaf(wk, bflo(rows[k][c].x), acc[c * 8 + 0]); acc[c * 8 + 1] = fmaf(wk, bfhi(rows[k][c].x), acc[c * 8 + 1]);
          acc[c * 8 + 2] = fmaf(wk, bflo(rows[k][c].y), acc[c * 8 + 2]); acc[c * 8 + 3] = fmaf(wk, bfhi(rows[k][c].y), acc[c * 8 + 3]);
          acc[c * 8 + 4] = fmaf(wk, bflo(rows[k][c].z), acc[c * 8 + 4]); acc[c * 8 + 5] = fmaf(wk, bfhi(rows[k][c].z), acc[c * 8 + 5]);
          acc[c * 8 + 6] = fmaf(wk, bflo(rows[k][c].w), acc[c * 8 + 6]); acc[c * 8 + 7] = fmaf(wk, bfhi(rows[k][c].w), acc[c * 8 + 7]);
        }
      }
    }
#pragma unroll
    for (int c = 0; c < 4; ++c) {
      float* rp = red + wid * 2048 + (c * 64 + lane) * 8;
      *(f32x4*)rp = (f32x4){acc[c * 8 + 0], acc[c * 8 + 1], acc[c * 8 + 2], acc[c * 8 + 3]};
      *(f32x4*)(rp + 4) = (f32x4){acc[c * 8 + 4], acc[c * 8 + 5], acc[c * 8 + 6], acc[c * 8 + 7]};
    }
    __syncthreads();
    {
      const int col = tid * 4;
      f32x4 s = *(const f32x4*)(h1 + (size_t)t * DM + col);
#pragma unroll
      for (int w = 0; w < 8; ++w) s += *(const f32x4*)(red + w * 2048 + col);
      float ss = wave_sum(s[0] * s[0] + s[1] * s[1] + s[2] * s[2] + s[3] * s[3]);
      if (lane == 0) red2[wid] = ss;
      __syncthreads();
      float tot = 0.f;
#pragma unroll
      for (int w = 0; w < 8; ++w) tot += red2[w];
      const float rf = rsqrtf(tot * (1.f / DM) + EPS);
      const f32x4 lw = *(const f32x4*)(p.ln_final + col);
      *(f32x4*)(p.out + (size_t)t * DM + col) = s * rf * lw;
    }
    __syncthreads();
  }
}

typedef float f32x16 __attribute__((ext_vector_type(16)));
constexpr int VT_LD = 196;
constexpr int ATT_VT_BYTES = 4 * 64 * VT_LD * 2;
__device__ __forceinline__ void attn_item(const Params& p, unsigned char* lds, int item) {
  const int tid = threadIdx.x, lane = tid & 63, wid = __builtin_amdgcn_readfirstlane(tid >> 6);
  const int b = item >> 6, q0 = (item & 63) * 32;
  bf16_t* VT = (bf16_t*)lds;
  float* biasL = (float*)(lds + ATT_VT_BYTES);
  float* ssqw = biasL + 16 * 132;
  const bf16_t* proj = (const bf16_t*)(p.ws + WS_PROJ);
  const float* projm = (const float*)(p.ws + WS_PROJM);
  bf16_t* mixin = (bf16_t*)(p.ws + WS_HNB);
  for (int idx = tid; idx < 16 * 129; idx += NTHREADS) {
    const int hq = idx / 129, d = idx - hq * 129;
    const int bk = d < 128 ? (int)kBucket[d] : 31;
    biasL[hq * 132 + d] = p.rel_bias[bk * 16 + hq];
  }
#pragma unroll 1
  for (int task = tid; task < 96 * 32; task += NTHREADS) {
    const int pi = task >> 5, ch = task & 31, slot0 = 2 * pi;
    float v0[8], v1[8];
    if (slot0 < 16) {
      const float* r0 = projm + (size_t)slot0 * DPROJ + OFF_V + ch * 8;
      const float* r1 = r0 + DPROJ;
#pragma unroll
      for (int i = 0; i < 8; ++i) { v0[i] = r0[i]; v1[i] = r1[i]; }
    } else if (slot0 < 32) {
#pragma unroll
      for (int i = 0; i < 8; ++i) { v0[i] = 0.f; v1[i] = 0.f; }
    } else {
      const int s0 = q0 - 128 + slot0 - 32;
      if (s0 < 0) {
#pragma unroll
        for (int i = 0; i < 8; ++i) { v0[i] = 0.f; v1[i] = 0.f; }
      } else {
        const bf16_t* r0 = proj + (size_t)(b * SEQ + s0) * NPROJ + OFF_V + ch * 8;
        const u32x4 a = *(const u32x4*)r0, c = *(const u32x4*)(r0 + NPROJ);
        v0[0] = bflo(a.x); v0[1] = bfhi(a.x); v0[2] = bflo(a.y); v0[3] = bfhi(a.y); v0[4] = bflo(a.z); v0[5] = bfhi(a.z); v0[6] = bflo(a.w); v0[7] = bfhi(a.w);
        v1[0] = bflo(c.x); v1[1] = bfhi(c.x); v1[2] = bflo(c.y); v1[3] = bfhi(c.y); v1[4] = bflo(c.z); v1[5] = bfhi(c.z); v1[6] = bflo(c.w); v1[7] = bfhi(c.w);
      }
    }
    bf16_t* dst = VT + (size_t)((ch >> 3) * 64 + (ch & 7) * 8) * VT_LD + slot0;
#pragma unroll
    for (int i = 0; i < 8; ++i) *(unsigned*)(dst + i * VT_LD) = pack_bf16(v0[i], v1[i]);
  }
  __syncthreads();
  const int ql = lane & 31, hh = lane >> 5, kvh = wid >> 1;
  const int trow = b * SEQ + q0 + ql;
  float ssq = 0.f;
#pragma unroll 1
  for (int hsel = 0; hsel < 2; ++hsel) {
    const int hq = 2 * wid + hsel;
    bf16x8 qf[4];
#pragma unroll
    for (int ks = 0; ks < 4; ++ks) qf[ks] = *(const bf16x8*)(proj + (size_t)trow * NPROJ + OFF_Q + hq * 64 + ks * 16 + hh * 8);
    f32x16 sacc[6];
#pragma unroll
    for (int jt = 0; jt < 6; ++jt) {
      f32x16 acc;
#pragma unroll
      for (int r = 0; r < 16; ++r) acc[r] = 0.f;
      if (jt == 0) {
        const float* kr = projm + (size_t)(ql & 15) * DPROJ + OFF_K + kvh * 64 + hh * 8;
#pragma unroll
        for (int ks = 0; ks < 4; ++ks) {
          const f32x4 a = *(const f32x4*)(kr + ks * 16), c = *(const f32x4*)(kr + ks * 16 + 4);
          u32x4 w; w.x = pack_bf16(a[0], a[1]); w.y = pack_bf16(a[2], a[3]); w.z = pack_bf16(c[0], c[1]); w.w = pack_bf16(c[2], c[3]);
          acc = __builtin_amdgcn_mfma_f32_32x32x16_bf16(*(bf16x8*)&w, qf[ks], acc, 0, 0, 0);
        }
      } else {
        int sp = q0 - 128 + 32 * (jt - 1) + ql;
        sp = sp < 0 ? 0 : sp;
        const bf16_t* kr = proj + (size_t)(b * SEQ + sp) * NPROJ + OFF_K + kvh * 64 + hh * 8;
#pragma unroll
        for (int ks = 0; ks < 4; ++ks) acc = __builtin_amdgcn_mfma_f32_32x32x16_bf16(*(const bf16x8*)(kr + ks * 16), qf[ks], acc, 0, 0, 0);
      }
      sacc[jt] = acc;
      asm volatile("" ::: "memory");
    }
    const float* bl = biasL + hq * 132;
    int sq = q0 + ql, qh = ql - 4 * hh;
    asm volatile("" : "+v"(sq), "+v"(qh));
    const float sink = p.sinks[hq];
    float m = sink;
#pragma unroll
    for (int jt = 0; jt < 6; ++jt) {
      asm volatile("" ::: "memory");
#pragma unroll
      for (int r = 0; r < 16; ++r) {
        const int kr = (r & 3) + 8 * (r >> 2) + 4 * hh;
        int dist; bool valid;
        if (jt == 0) { dist = sq + (16 - ((r & 3) + 8 * (r >> 2))) - 4 * hh; valid = kr < 16; }
        else { dist = qh + (128 - 32 * (jt - 1) - ((r & 3) + 8 * (r >> 2))); valid = (dist >= 0) && (dist < 128) && (dist <= sq); }
        const int dc = dist < 0 ? 0 : (dist > 128 ? 128 : dist);
        const float l = valid ? 0.125f * sacc[jt][r] + bl[dc] : -1e30f;
        sacc[jt][r] = l;
        m = fmaxf(m, l);
      }
    }
    m = fmaxf(m, __shfl_xor(m, 32));
    float sum = 0.f;
    f32x16 oacc0, oacc1;
#pragma unroll
    for (int r = 0; r < 16; ++r) { oacc0[r] = 0.f; oacc1[r] = 0.f; }
    const bf16_t* vrow0 = VT + (size_t)(kvh * 64 + ql) * VT_LD + 4 * hh;
    const bf16_t* vrow1 = vrow0 + 32 * VT_LD;
#pragma unroll
    for (int jt = 0; jt < 6; ++jt) {
      u32x4 pw[2];
#pragma unroll
      for (int s2 = 0; s2 < 2; ++s2) {
        float e[8];
#pragma unroll
        for (int i = 0; i < 8; ++i) { e[i] = __expf(sacc[jt][8 * s2 + i] - m); sum += e[i]; }
        pw[s2].x = pack_bf16(e[0], e[1]); pw[s2].y = pack_bf16(e[2], e[3]); pw[s2].z = pack_bf16(e[4], e[5]); pw[s2].w = pack_bf16(e[6], e[7]);
      }
#pragma unroll
      for (int s2 = 0; s2 < 2; ++s2) {
        const u32x2 va = *(const u32x2*)(vrow0 + 32 * jt + 16 * s2), vc = *(const u32x2*)(vrow0 + 32 * jt + 16 * s2 + 8);
        const u32x2 vd = *(const u32x2*)(vrow1 + 32 * jt + 16 * s2), ve = *(const u32x2*)(vrow1 + 32 * jt + 16 * s2 + 8);
        u32x4 v0w; v0w.x = va.x; v0w.y = va.y; v0w.z = vc.x; v0w.w = vc.y;
        u32x4 v1w; v1w.x = vd.x; v1w.y = vd.y; v1w.z = ve.x; v1w.w = ve.y;
        oacc0 = __builtin_amdgcn_mfma_f32_32x32x16_bf16(*(bf16x8*)&v0w, *(bf16x8*)&pw[s2], oacc0, 0, 0, 0);
        oacc1 = __builtin_amdgcn_mfma_f32_32x32x16_bf16(*(bf16x8*)&v1w, *(bf16x8*)&pw[s2], oacc1, 0, 0, 0);
      }
    }
    sum += __shfl_xor(sum, 32);
    const float inv = 1.f / (sum + __expf(sink - m));
#pragma unroll
    for (int r = 0; r < 16; ++r) { oacc0[r] *= inv; oacc1[r] *= inv; ssq += oacc0[r] * oacc0[r] + oacc1[r] * oacc1[r]; }
#pragma unroll
    for (int rg = 0; rg < 4; ++rg) {
      u32x2 w; w.x = pack_bf16(oacc0[rg * 4 + 0], oacc0[rg * 4 + 1]); w.y = pack_bf16(oacc0[rg * 4 + 2], oacc0[rg * 4 + 3]);
      *(u32x2*)(mixin + (size_t)trow * DM + hq * 64 + 8 * rg + 4 * hh) = w;
      u32x2 w1; w1.x = pack_bf16(oacc1[rg * 4 + 0], oacc1[rg * 4 + 1]); w1.y = pack_bf16(oacc1[rg * 4 + 2], oacc1[rg * 4 + 3]);
      *(u32x2*)(mixin + (size_t)trow * DM + hq * 64 + 32 + 8 * rg + 4 * hh) = w1;
    }
  }
  ssq += __shfl_xor(ssq, 32);
  if (lane < 32) ssqw[wid * 32 + lane] = ssq;
  __syncthreads();
  float tot = 0.f;
#pragma unroll
  for (int w = 0; w < 8; ++w) tot += ssqw[w * 32 + ql];
  const float ra = rsqrtf(tot * (1.f / 1024) + EPS);
#pragma unroll
  for (int hsel = 0; hsel < 2; ++hsel)
#pragma unroll
    for (int dt = 0; dt < 2; ++dt)
#pragma unroll
      for (int rg = 0; rg < 4; ++rg) {
        bf16_t* op = mixin + (size_t)trow * DM + (2 * wid + hsel) * 64 + 32 * dt + 8 * rg + 4 * hh;
        const u32x2 v = *(const u32x2*)op;
        u32x2 w; w.x = pack_bf16(bflo(v.x) * ra, bfhi(v.x) * ra); w.y = pack_bf16(bflo(v.y) * ra, bfhi(v.y) * ra);
        *(u32x2*)op = w;
      }
  __syncthreads();
}
__device__ __forceinline__ void phase2_attn(const Params& p, unsigned char* lds, int bid, int nblk) {
  for (int item = bid; item < 256; item += nblk) attn_item(p, lds, item);
}

constexpr int SLD = 136;
__device__ __forceinline__ void unpack8(const u32x4 a, float (&v)[8]) {
  v[0] = bflo(a.x); v[1] = bfhi(a.x); v[2] = bflo(a.y); v[3] = bfhi(a.y); v[4] = bflo(a.z); v[5] = bfhi(a.z); v[6] = bflo(a.w); v[7] = bfhi(a.w);
}
__device__ __forceinline__ void ssd_a_item(const Params& p, unsigned char* lds, int item) {
  const int tid = threadIdx.x, lane = tid & 63, wid = __builtin_amdgcn_readfirstlane(tid >> 6);
  const int b = item >> 8, c = (item >> 4) & 15, h = item & 15, g = h >> 3;
  const int t0 = b * SEQ + c * 128;
  bf16_t* Bc = (bf16_t*)lds;
  bf16_t* Cc = Bc + 128 * SLD;
  bf16_t* BcTw = Cc + 128 * SLD;
  bf16_t* xT = BcTw + 128 * SLD;
  float* dtl = (float*)(xT + 64 * SLD);
  float* acs = dtl + 128;
  float* wl = acs + 128;
  float* scan = wl + 128;
  const bf16_t* proj = (const bf16_t*)(p.ws + WS_PROJ);
  const float* projm = (const float*)(p.ws + WS_PROJM);
  const float* dtraw = (const float*)(p.ws + WS_DTRAW);
  float* acsg = (float*)(p.ws + WS_ACSG);
  bf16_t* ccb = (bf16_t*)(p.ws + WS_CCB);
  float* ypart = (float*)(p.ws + WS_YPART);
  float* sg = (float*)(p.ws + WS_SG);
  const float Ah = -expf(p.a_log[h]);
  const float dskip = p.d_skip[h];
  float cum = 0.f;
  if (tid < 128) {
    const float dtv = softplus_f(dtraw[(size_t)(t0 + tid) * 16 + h] + p.dt_bias[h]);
    dtl[tid] = dtv;
    cum = dtv * Ah;
#pragma unroll
    for (int o = 1; o < 64; o <<= 1) { const float nb = __shfl_up(cum, o); if (lane >= o) cum += nb; }
    if (tid == 63) scan[0] = cum;
  }
  __syncthreads();
  if (tid < 128) {
    if (tid >= 64) cum += scan[0];
    acs[tid] = cum;
    acsg[(size_t)(t0 + tid) * 16 + h] = cum;
  }
  __syncthreads();
  if (tid < 128) wl[tid] = dtl[tid] * __expf(acs[127] - acs[tid]);
  __syncthreads();
#pragma unroll 1
  for (int task = tid; task < 16 * 320; task += NTHREADS) {
    const int tg = task / 320, ch = task - tg * 320;
    const int cch = ch < 64 ? h * 64 + ch : (ch < 192 ? 1024 + g * 128 + (ch - 64) : 1280 + g * 128 + (ch - 192));
    float raw[11];
#pragma unroll
    for (int i = 0; i < 11; ++i) {
      const int l = tg * 8 + i - 3;
      float v;
      if (l >= 0 || c > 0) v = bf2f(proj[(size_t)(t0 + l) * NPROJ + OFF_XBC + cch]);
      else v = projm[(size_t)(16 + l) * DPROJ + OFF_XBC + cch];
      raw[i] = v;
    }
    const float w0 = p.conv_w[cch], w1 = p.conv_w[D_XBC + cch], w2 = p.conv_w[2 * D_XBC + cch], w3 = p.conv_w[3 * D_XBC + cch], cb = p.conv_b[cch];
    float o[8];
#pragma unroll
    for (int i = 0; i < 8; ++i) o[i] = silu_f(cb + w0 * raw[i] + w1 * raw[i + 1] + w2 * raw[i + 2] + w3 * raw[i + 3]);
    if (ch < 64) {
      u32x4 w; w.x = pack_bf16(o[0], o[1]); w.y = pack_bf16(o[2], o[3]); w.z = pack_bf16(o[4], o[5]); w.w = pack_bf16(o[6], o[7]);
      *(u32x4*)(xT + ch * SLD + tg * 8) = w;
    } else if (ch < 192) {
      const int n = ch - 64;
#pragma unroll
      for (int i = 0; i < 8; ++i) Bc[(tg * 8 + i) * SLD + n] = f2bf(o[i]);
      const f32x4 wa = *(const f32x4*)(wl + tg * 8), wb = *(const f32x4*)(wl + tg * 8 + 4);
      u32x4 w; w.x = pack_bf16(o[0] * wa[0], o[1] * wa[1]); w.y = pack_bf16(o[2] * wa[2], o[3] * wa[3]);
      w.z = pack_bf16(o[4] * wb[0], o[5] * wb[1]); w.w = pack_bf16(o[6] * wb[2], o[7] * wb[3]);
      *(u32x4*)(BcTw + n * SLD + tg * 8) = w;
    } else {
      const int n = ch - 192;
#pragma unroll
      for (int i = 0; i < 8; ++i) {
        const bf16_t v = f2bf(o[i]);
        Cc[(tg * 8 + i) * SLD + n] = v;
        if ((h & 7) == 0) ccb[(size_t)(t0 + tg * 8 + i) * 256 + g * 128 + n] = v;
      }
    }
  }
  __syncthreads();
  const int ql = lane & 31, hh = lane >> 5;
  {
    const int ip = wid & 1, il = wid >> 1;
    const int l = 32 * il + ql;
    const float acl = acs[l];
    f32x16 yacc;
#pragma unroll
    for (int r = 0; r < 16; ++r) yacc[r] = 0.f;
    const bf16_t* xrow = xT + (32 * ip + ql) * SLD + 4 * hh;
#pragma unroll 1
    for (int is = 0; is <= il; ++is) {
      f32x16 x;
#pragma unroll
      for (int r = 0; r < 16; ++r) x[r] = 0.f;
      const bf16_t* ap = Bc + (32 * is + ql) * SLD + 8 * hh;
      const bf16_t* bp = Cc + l * SLD + 8 * hh;
#pragma unroll
      for (int ks = 0; ks < 8; ++ks) x = __builtin_amdgcn_mfma_f32_32x32x16_bf16(*(const bf16x8*)(ap + 16 * ks), *(const bf16x8*)(bp + 16 * ks), x, 0, 0, 0);
      u32x4 pw[2];
#pragma unroll
      for (int s2 = 0; s2 < 2; ++s2) {
        float mv[8];
#pragma unroll
        for (int q = 0; q < 2; ++q) {
          const int sb = 32 * is + 16 * s2 + 8 * q + 4 * hh;
          const f32x4 as4 = *(const f32x4*)(acs + sb), dt4 = *(const f32x4*)(dtl + sb);
#pragma unroll
          for (int j = 0; j < 4; ++j) {
            const int sr = sb + j;
            float v = sr <= l ? x[8 * s2 + 4 * q + j] * __expf(acl - as4[j]) * dt4[j] : 0.f;
            if (sr == l) v += dskip;
            mv[4 * q + j] = v;
          }
        }
        pw[s2].x = pack_bf16(mv[0], mv[1]); pw[s2].y = pack_bf16(mv[2], mv[3]); pw[s2].z = pack_bf16(mv[4], mv[5]); pw[s2].w = pack_bf16(mv[6], mv[7]);
      }
#pragma unroll
      for (int s2 = 0; s2 < 2; ++s2) {
        const u32x2 va = *(const u32x2*)(xrow + 32 * is + 16 * s2), vc = *(const u32x2*)(xrow + 32 * is + 16 * s2 + 8);
        u32x4 aw; aw.x = va.x; aw.y = va.y; aw.z = vc.x; aw.w = vc.y;
        yacc = __builtin_amdgcn_mfma_f32_32x32x16_bf16(*(bf16x8*)&aw, *(bf16x8*)&pw[s2], yacc, 0, 0, 0);
      }
    }
    float* yp = ypart + (size_t)(t0 + l) * 1024 + h * 64 + 32 * ip + 4 * hh;
#pragma unroll
    for (int rg = 0; rg < 4; ++rg) *(f32x4*)(yp + 8 * rg) = (f32x4){yacc[4 * rg], yacc[4 * rg + 1], yacc[4 * rg + 2], yacc[4 * rg + 3]};
  }
  {
    const int ip = wid & 1, in = wid >> 1;
    f32x16 sacc;
#pragma unroll
    for (int r = 0; r < 16; ++r) sacc[r] = 0.f;
    const bf16_t* ap = xT + (32 * ip + ql) * SLD + 8 * hh;
    const bf16_t* bp = BcTw + (32 * in + ql) * SLD + 8 * hh;
#pragma unroll
    for (int ks = 0; ks < 8; ++ks) sacc = __builtin_amdgcn_mfma_f32_32x32x16_bf16(*(const bf16x8*)(ap + 16 * ks), *(const bf16x8*)(bp + 16 * ks), sacc, 0, 0, 0);
    float* sp = sg + ((size_t)((b * 16 + c) * 16 + h) * 64 + 32 * ip + 4 * hh) * 128 + 32 * in + ql;
#pragma unroll
    for (int r = 0; r < 16; ++r) sp[((r & 3) + 8 * (r >> 2)) * 128] = sacc[r];
  }
  __syncthreads();
}

__device__ __forceinline__ void meta_state_item(const Params& p, unsigned char* lds, int h) {
  const int tid = threadIdx.x, g = h >> 3;
  float* xm = (float*)lds;
  float* bm = xm + 16 * 64;
  float* dtm = bm + 16 * 128;
  const float* projm = (const float*)(p.ws + WS_PROJM);
  float* smeta = (float*)(p.ws + WS_SMETA);
  for (int task = tid; task < 16 * 192; task += NTHREADS) {
    const int i = task / 192, ch = task - i * 192;
    const int cch = ch < 64 ? h * 64 + ch : 1024 + g * 128 + (ch - 64);
    float acc = p.conv_b[cch];
#pragma unroll
    for (int j = 0; j < 4; ++j) { const int mi = i - j; if (mi >= 0) acc += p.conv_w[(3 - j) * D_XBC + cch] * projm[(size_t)mi * DPROJ + OFF_XBC + cch]; }
    const float v = silu_f(acc);
    if (ch < 64) xm[i * 64 + ch] = v; else bm[i * 128 + ch - 64] = v;
  }
  if (tid < 16) dtm[tid] = softplus_f(projm[(size_t)tid * DPROJ + OFF_DT + h] + p.dt_bias[h]);
  __syncthreads();
  const float Ah = -expf(p.a_log[h]);
  const int pr = tid >> 3, n0 = (tid & 7) * 16;
  float st[16];
#pragma unroll
  for (int k = 0; k < 16; ++k) st[k] = 0.f;
  for (int i = 0; i < 16; ++i) {
    const float dtv = dtm[i], dA = expf(dtv * Ah), xdt = xm[i * 64 + pr] * dtv;
#pragma unroll
    for (int k = 0; k < 16; ++k) st[k] = fmaf(st[k], dA, xdt * bm[i * 128 + n0 + k]);
  }
#pragma unroll
  for (int k = 0; k < 16; ++k) smeta[(size_t)(h * 64 + pr) * 128 + n0 + k] = st[k];
  __syncthreads();
}

__device__ __forceinline__ void phase2(const Params& p, unsigned char* lds, int bid, int nblk) {
  for (int item = bid; item < 256; item += nblk) attn_item(p, lds, item);
  for (int item = bid; item < 1024; item += nblk) ssd_a_item(p, lds, item);
  for (int item = bid; item < 16; item += nblk) meta_state_item(p, lds, item);
}

__device__ __forceinline__ void ssd_b_item(const Params& p, unsigned char* lds, int item) {
  const int tid = threadIdx.x, lane = tid & 63, wid = __builtin_amdgcn_readfirstlane(tid >> 6);
  const int b = item >> 5, c = (item >> 1) & 15, g = item & 1, h = g * 8 + wid;
  const int t0 = b * SEQ + c * 128;
  const int ql = lane & 31, hh = lane >> 5;
  float* ssqg = (float*)lds;
  const bf16_t* proj = (const bf16_t*)(p.ws + WS_PROJ);
  const float* acsg = (const float*)(p.ws + WS_ACSG);
  const bf16_t* ccb = (const bf16_t*)(p.ws + WS_CCB);
  const float* ypart = (const float*)(p.ws + WS_YPART);
  const float* sg = (const float*)(p.ws + WS_SG);
  const float* smeta = (const float*)(p.ws + WS_SMETA);
  bf16_t* mixin = (bf16_t*)(p.ws + WS_HNB);
  float ssql[4] = {0.f, 0.f, 0.f, 0.f};
#pragma unroll 1
  for (int ip = 0; ip < 2; ++ip) {
    const size_t hoff = (size_t)(32 * ip + ql) * 128 + 8 * hh;
    float Hf[64];
    {
      const float* sp = smeta + (size_t)h * 8192 + hoff;
#pragma unroll
      for (int ks = 0; ks < 8; ++ks) {
        const f32x4 a = *(const f32x4*)(sp + 16 * ks), c4 = *(const f32x4*)(sp + 16 * ks + 4);
        Hf[8 * ks + 0] = a[0]; Hf[8 * ks + 1] = a[1]; Hf[8 * ks + 2] = a[2]; Hf[8 * ks + 3] = a[3];
        Hf[8 * ks + 4] = c4[0]; Hf[8 * ks + 5] = c4[1]; Hf[8 * ks + 6] = c4[2]; Hf[8 * ks + 7] = c4[3];
      }
    }
#pragma unroll 1
    for (int cp = 0; cp < c; ++cp) {
      const float D = __expf(acsg[(size_t)(b * SEQ + cp * 128 + 127) * 16 + h]);
      const float* sp = sg + (size_t)((b * 16 + cp) * 16 + h) * 8192 + hoff;
#pragma unroll
      for (int ks = 0; ks < 8; ++ks) {
        const f32x4 a = *(const f32x4*)(sp + 16 * ks), c4 = *(const f32x4*)(sp + 16 * ks + 4);
        Hf[8 * ks + 0] = fmaf(Hf[8 * ks + 0], D, a[0]); Hf[8 * ks + 1] = fmaf(Hf[8 * ks + 1], D, a[1]);
        Hf[8 * ks + 2] = fmaf(Hf[8 * ks + 2], D, a[2]); Hf[8 * ks + 3] = fmaf(Hf[8 * ks + 3], D, a[3]);
        Hf[8 * ks + 4] = fmaf(Hf[8 * ks + 4], D, c4[0]); Hf[8 * ks + 5] = fmaf(Hf[8 * ks + 5], D, c4[1]);
        Hf[8 * ks + 6] = fmaf(Hf[8 * ks + 6], D, c4[2]); Hf[8 * ks + 7] = fmaf(Hf[8 * ks + 7], D, c4[3]);
      }
    }
    u32x4 hfr[8];
#pragma unroll
    for (int ks = 0; ks < 8; ++ks) {
      hfr[ks].x = pack_bf16(Hf[8 * ks + 0], Hf[8 * ks + 1]); hfr[ks].y = pack_bf16(Hf[8 * ks + 2], Hf[8 * ks + 3]);
      hfr[ks].z = pack_bf16(Hf[8 * ks + 4], Hf[8 * ks + 5]); hfr[ks].w = pack_bf16(Hf[8 * ks + 6], Hf[8 * ks + 7]);
    }
#pragma unroll
    for (int il = 0; il < 4; ++il) {
      const int t = t0 + 32 * il + ql;
      f32x16 acc;
#pragma unroll
      for (int r = 0; r < 16; ++r) acc[r] = 0.f;
      const bf16_t* cp = ccb + (size_t)t * 256 + g * 128 + 8 * hh;
#pragma unroll
      for (int ks = 0; ks < 8; ++ks) acc = __builtin_amdgcn_mfma_f32_32x32x16_bf16(*(bf16x8*)&hfr[ks], *(const bf16x8*)(cp + 16 * ks), acc, 0, 0, 0);
      const float ea = __expf(acsg[(size_t)t * 16 + h]);
#pragma unroll
      for (int rg = 0; rg < 4; ++rg) {
        const int pp = h * 64 + 32 * ip + 8 * rg + 4 * hh;
        const f32x4 yp = *(const f32x4*)(ypart + (size_t)t * 1024 + pp);
        const u32x2 zz = *(const u32x2*)(proj + (size_t)t * NPROJ + OFF_Z + pp);
        const float y0 = (yp[0] + ea * acc[4 * rg + 0]) * silu_f(bflo(zz.x)), y1 = (yp[1] + ea * acc[4 * rg + 1]) * silu_f(bfhi(zz.x));
        const float y2 = (yp[2] + ea * acc[4 * rg + 2]) * silu_f(bflo(zz.y)), y3 = (yp[3] + ea * acc[4 * rg + 3]) * silu_f(bfhi(zz.y));
        ssql[il] += y0 * y0 + y1 * y1 + y2 * y2 + y3 * y3;
        u32x2 w; w.x = pack_bf16(y0, y1); w.y = pack_bf16(y2, y3);
        *(u32x2*)(mixin + (size_t)t * DM + 1024 + pp) = w;
      }
    }
  }
#pragma unroll
  for (int il = 0; il < 4; ++il) {
    float v = ssql[il];
    v += __shfl_xor(v, 32);
    if (lane < 32) ssqg[wid * 128 + 32 * il + lane] = v;
  }
  __syncthreads();
#pragma unroll
  for (int il = 0; il < 4; ++il) {
    float tot = 0.f;
#pragma unroll
    for (int w = 0; w < 8; ++w) tot += ssqg[w * 128 + 32 * il + ql];
    const float rg_ = rsqrtf(tot * (1.f / 512) + EPS);
    const int t = t0 + 32 * il + ql;
#pragma unroll
    for (int ip = 0; ip < 2; ++ip)
#pragma unroll
      for (int rg = 0; rg < 4; ++rg) {
        bf16_t* op = mixin + (size_t)t * DM + 1024 + h * 64 + 32 * ip + 8 * rg + 4 * hh;
        const u32x2 v = *(const u32x2*)op;
        u32x2 w; w.x = pack_bf16(bflo(v.x) * rg_, bfhi(v.x) * rg_); w.y = pack_bf16(bflo(v.y) * rg_, bfhi(v.y) * rg_);
        *(u32x2*)op = w;
      }
  }
  __syncthreads();
}
__device__ __forceinline__ void phase3(const Params& p, unsigned char* lds, int bid, int nblk) {
  for (int item = bid; item < 128; item += nblk) ssd_b_item(p, lds, item);
}

constexpr int LDS_BYTES = 144 * 1024;

#define PARAMS_PTR(pp) const Params* pp = (const Params*)__builtin_amdgcn_kernarg_segment_ptr(); asm volatile("" : "+s"(pp))
__global__ __launch_bounds__(512, 2) void k_mega(Params p_unused) {
  extern __shared__ __attribute__((aligned(16))) unsigned char shm[];
  cooperative_groups::grid_group grid = cooperative_groups::this_grid();
  const int bid = blockIdx.x, nblk = gridDim.x;
  { PARAMS_PTR(pp); phase0(*pp, (float*)shm, bid, nblk); }
  grid.sync();
  { PARAMS_PTR(pp); phase1(*pp, shm, bid, nblk); }
  grid.sync();
  { PARAMS_PTR(pp); phase2(*pp, shm, bid, nblk); }
  grid.sync();
  { PARAMS_PTR(pp); phase3(*pp, shm, bid, nblk); }
  grid.sync();
  { PARAMS_PTR(pp); phase4(*pp, shm, bid, nblk); }
  grid.sync();
  { PARAMS_PTR(pp); phase5(*pp, shm, bid, nblk); }
  grid.sync();
  { PARAMS_PTR(pp); phase6(*pp, shm, bid, nblk); }
}

}

extern "C" void kernel_launch(void* const* d_in, const int* in_sizes, int n_in, void* d_out, int out_size, void* d_ws,
                              size_t ws_size, hipStream_t stream) {
  Params p{};
  p.x = (const float*)d_in[0]; p.meta = (const float*)d_in[1]; p.rel_bias = (const float*)d_in[2];
  p.ln_mix = (const float*)d_in[3]; p.w_in = (const float*)d_in[4]; p.sinks = (const float*)d_in[5];
  p.conv_w = (const float*)d_in[6]; p.conv_b = (const float*)d_in[7]; p.dt_bias = (const float*)d_in[8];
  p.a_log = (const float*)d_in[9]; p.d_skip = (const float*)d_in[10]; p.attn_norm_w = (const float*)d_in[11];
  p.ssm_norm_w = (const float*)d_in[12]; p.w_out = (const float*)d_in[13]; p.ln_ffn = (const float*)d_in[14];
  p.wq = (const float*)d_in[15]; p.keys = (const float*)d_in[16]; p.U = (const float*)d_in[17];
  p.V = (const float*)d_in[18]; p.ln_final = (const float*)d_in[19];
  p.out = (float*)d_out;
  p.ws = (unsigned char*)d_ws;

  static int grid_blocks = 0;
  if (!grid_blocks) {
    int dev = 0, cus = 0, per_cu = 0;
    (void)hipGetDevice(&dev);
    (void)hipDeviceGetAttribute(&cus, hipDeviceAttributeMultiprocessorCount, dev);
    (void)hipFuncSetAttribute((const void*)k_mega, hipFuncAttributeMaxDynamicSharedMemorySize, LDS_BYTES);
    (void)hipOccupancyMaxActiveBlocksPerMultiprocessor(&per_cu, (const void*)k_mega, NTHREADS, LDS_BYTES);
    if (per_cu > 1) per_cu = 1;
    grid_blocks = cus * per_cu;
    if (grid_blocks != 256) fprintf(stderr, "kernel_launch: expected a 256-workgroup resident grid, got %d (cus %d, per_cu %d)\n", grid_blocks, cus, per_cu);
  }
  void* args[] = {&p};
  hipError_t e = hipLaunchCooperativeKernel((const void*)k_mega, dim3(grid_blocks), dim3(NTHREADS), args, LDS_BYTES, stream);
  if (e != hipSuccess) fprintf(stderr, "cooperative launch failed: %s (grid %d)\n", hipGetErrorString(e), grid_blocks);
}
```

```cpp
#include <hip/hip_runtime.h>
#include <hip/hip_cooperative_groups.h>
#include <math.h>
#include <stdio.h>
#include <stdint.h>

namespace {
constexpr int BATCH = 4, SEQ = 2048, DM = 2048, NMETA = 16;
constexpr int T = BATCH * SEQ;
constexpr int TA = T + NMETA;
constexpr int DPROJ = 4112;
constexpr int NPROJ = 4096;
constexpr int OFF_Q = 0, OFF_K = 1024, OFF_V = 1280, OFF_Z = 1536, OFF_XBC = 2560, OFF_DT = 4096;
constexpr int D_XBC = 1536;
constexpr int NEXP = 16384;
constexpr float EPS = 1e-6f;
constexpr int NTHREADS = 512;

typedef unsigned short bf16_t;
typedef short bf16x8 __attribute__((ext_vector_type(8)));
typedef float f32x4 __attribute__((ext_vector_type(4)));
typedef float f32x2 __attribute__((ext_vector_type(2)));
typedef unsigned u32x4 __attribute__((ext_vector_type(4)));
typedef unsigned u32x2 __attribute__((ext_vector_type(2)));
typedef __bf16 bf16v2 __attribute__((ext_vector_type(2)));
#define LAS __attribute__((address_space(3)))

__device__ __forceinline__ unsigned pack_bf16(float lo, float hi) {
  f32x2 v = {lo, hi};
  bf16v2 b = __builtin_convertvector(v, bf16v2);
  return *(unsigned*)&b;
}
__device__ __forceinline__ bf16_t f2bf(float f) { return (bf16_t)(pack_bf16(f, 0.f) & 0xffffu); }
__device__ __forceinline__ float bf2f(bf16_t b) { return __uint_as_float(((unsigned)b) << 16); }
__device__ __forceinline__ float bflo(unsigned u) { return __uint_as_float(u << 16); }
__device__ __forceinline__ float bfhi(unsigned u) { return __uint_as_float(u & 0xffff0000u); }

__constant__ unsigned char kBucket[128] = {
    0, 1, 2, 3, 4, 5, 6, 7, 8, 9, 10, 11, 12, 13, 14, 15, 16, 16, 16, 17, 17, 18, 18, 18, 19, 19, 19, 20, 20, 20, 20, 21,
    21, 21, 21, 22, 22, 22, 22, 22, 23, 23, 23, 23, 23, 23, 24, 24, 24, 24, 24, 24, 25, 25, 25, 25, 25, 25, 25, 26, 26, 26, 26, 26,
    26, 26, 26, 27, 27, 27, 27, 27, 27, 27, 27, 27, 27, 28, 28, 28, 28, 28, 28, 28, 28, 28, 28, 29, 29, 29, 29, 29, 29, 29, 29, 29,
    29, 29, 29, 30, 30, 30, 30, 30, 30, 30, 30, 30, 30, 30, 30, 30, 30, 31, 31, 31, 31, 31, 31, 31, 31, 31, 31, 31, 31, 31, 31, 31};

__constant__ unsigned char kCandI[64] = {0, 0, 0, 0, 0, 0, 0, 0, 0, 0, 0, 0, 0, 0, 0, 0, 1, 1, 1, 1, 1, 1, 1, 1, 2, 2, 2, 2, 2, 3, 3, 3, 3, 4, 4, 4, 5, 5, 6, 6, 7, 7, 8, 9, 10, 11, 12, 13, 14, 15, 15, 15, 15, 15, 15, 15, 15, 15, 15, 15, 15, 15, 15, 15};
__constant__ unsigned char kCandJ[64] = {0, 1, 2, 3, 4, 5, 6, 7, 8, 9, 10, 11, 12, 13, 14, 15, 0, 1, 2, 3, 4, 5, 6, 7, 0, 1, 2, 3, 4, 0, 1, 2, 3, 0, 1, 2, 0, 1, 0, 1, 0, 1, 0, 0, 0, 0, 0, 0, 0, 0, 15, 15, 15, 15, 15, 15, 15, 15, 15, 15, 15, 15, 15, 15};

__device__ __forceinline__ float wave_sum(float v) {
  for (int o = 32; o > 0; o >>= 1) v += __shfl_xor(v, o);
  return v;
}
__device__ __forceinline__ float wave_max(float v) {
  for (int o = 32; o > 0; o >>= 1) v = fmaxf(v, __shfl_xor(v, o));
  return v;
}
__device__ __forceinline__ float silu_f(float x) { return x / (1.f + expf(-x)); }
__device__ __forceinline__ float softplus_f(float x) { return fmaxf(x, 0.f) + log1pf(expf(-fabsf(x))); }

constexpr size_t al256(size_t x) { return (x + 255) & ~(size_t)255; }
constexpr size_t WS_CTL = 0;
constexpr size_t WS_WINT = 65536;
constexpr size_t WS_WDTT = WS_WINT + (size_t)NPROJ * DM * 2;
constexpr size_t WS_WOUTT = WS_WDTT + (size_t)16 * DM * 2;
constexpr size_t WS_WQT = WS_WOUTT + (size_t)DM * DM * 2;
constexpr size_t WS_KEYS = WS_WQT + (size_t)DM * DM * 2;
constexpr size_t WS_UB = WS_KEYS + (size_t)16 * 128 * 128 * 2;
constexpr size_t WS_VB = WS_UB + (size_t)NEXP * DM * 2;
constexpr size_t WS_HNB = WS_VB + (size_t)NEXP * DM * 2;
constexpr size_t WS_PROJ = WS_HNB + (size_t)(T + 16) * DM * 2;
constexpr size_t WS_DTRAW = WS_PROJ + (size_t)T * NPROJ * 2;
constexpr size_t WS_PROJM = WS_DTRAW + (size_t)T * 16 * 4;
constexpr size_t WS_H1B = al256(WS_PROJM + (size_t)16 * DPROJ * 4);
constexpr size_t WS_SSQH1 = WS_H1B + (size_t)T * DM * 2;
constexpr size_t WS_STOP = al256(WS_SSQH1 + (size_t)T * 32 * 4);
constexpr size_t WS_ITOP = WS_STOP + (size_t)T * 256 * 4;
constexpr size_t WS_ACSG = al256(WS_ITOP + (size_t)T * 256 * 4);
constexpr size_t WS_CCB = WS_ACSG + (size_t)T * 16 * 4;
constexpr size_t WS_YPART = WS_CCB + (size_t)T * 256 * 2;
constexpr size_t WS_SG = WS_YPART + (size_t)T * 1024 * 4;
constexpr size_t WS_SMETA = WS_SG + (size_t)1024 * 8192 * 4;
constexpr size_t WS_SCR = al256(WS_SMETA + (size_t)16 * 8192 * 4);
}

namespace pg8 {
#define PG8_LAS __attribute__((address_space(3)))
constexpr int BM = 256, BK = 64, HALF = 128, HTB = HALF * BK * 2, STAGE_BYTES = 8 * HTB, NXCD = 8, WGM = 8;
__host__ __device__ __forceinline__ int lds_byte(int r, int c) { const int st = (r >> 4) * 2 + (c >> 5), rr = r & 15, cc = c & 31, ob = rr * 64 + cc * 2; return st * 1024 + (ob ^ (((ob >> 9) & 1) << 5)); }
__host__ __device__ __forceinline__ void stage_rc(int b, int& R, int& C) { const int st = b / 1024, sb = b % 1024, swz = sb ^ (((sb >> 9) & 1) << 5); R = (st >> 1) * 16 + swz / 64; C = (st & 1) * 32 + (swz % 64) / 2; }
__host__ __device__ __forceinline__ int perm32(int rho) { const int n = rho >> 4, i = rho & 15; return 8 * (i >> 2) + 4 * n + (i & 3); }
struct Unit { int pm, pn; };
struct Gemm { const bf16_t* A; const bf16_t* Bt; int M, N, K; };
struct StaticOrder {
    int nM, nN, nwg, G, c;
    __host__ __device__ void init(int M, int N, int G_, int c_) { nM = M / BM; nN = N / BM; nwg = nM * nN; G = G_; c = c_; }
    __host__ __device__ bool next(int i, Unit& u) const {
        const long L = (long)i * G + c; if (L >= nwg) return false;
        int wgid = (int)L; { const int q = nwg / NXCD, r = nwg % NXCD, xcd = wgid % NXCD, off = wgid / NXCD; wgid = (xcd < r ? xcd * (q + 1) : r * (q + 1) + (xcd - r) * q) + off; }
        const int nig = WGM * nN, gid = wgid / nig, fm = gid * WGM, gsz = (nM - fm) < WGM ? (nM - fm) : WGM;
        u.pm = fm + ((wgid % nig) % gsz); u.pn = (wgid % nig) / gsz; return true;
    }
    __device__ __forceinline__ void a_ready(const Unit&) const {}
    __device__ __forceinline__ void done(const Unit&) const {}
};
struct EpiBf16 {
    static constexpr bool PERM = true, AFTER_DRAIN = false;
    bf16_t* O; int ldc;
    __device__ __forceinline__ void operator()(const f32x4 (&acc)[2][2][4][2], const Unit& u, int wr, int wc, int fr, int fq) const {
        const int row0 = u.pm * BM + wr * 64 + fr; const int col0 = u.pn * BM + wc * 32 + 8 * fq;
#pragma unroll
        for (int ai = 0; ai < 2; ++ai)
#pragma unroll
            for (int m = 0; m < 4; ++m) { bf16_t* rowp = O + (size_t)(row0 + ai * HALF + m * 16) * ldc + col0;
#pragma unroll
                for (int bj = 0; bj < 2; ++bj) { const f32x4 v0 = acc[ai][bj][m][0], v1 = acc[ai][bj][m][1];
                    u32x4 w; w.x = pack_bf16(v0[0], v0[1]); w.y = pack_bf16(v0[2], v0[3]); w.z = pack_bf16(v1[0], v1[1]); w.w = pack_bf16(v1[2], v1[3]);
                    *(u32x4*)(rowp + bj * HALF) = w; } }
    }
};

struct EpiRes {
    static constexpr bool PERM = true, AFTER_DRAIN = false;
    const float* X; float* H; bf16_t* HB; float* SSQ;
    __device__ __forceinline__ void operator()(const f32x4 (&acc)[2][2][4][2], const Unit& u, int wr, int wc, int fr, int fq) const {
        const int row0 = u.pm * BM + wr * 64 + fr; const int col0 = u.pn * BM + wc * 32 + 8 * fq;
#pragma unroll
        for (int ai = 0; ai < 2; ++ai)
#pragma unroll
            for (int m = 0; m < 4; ++m) { const int row = row0 + ai * HALF + m * 16; const size_t off = (size_t)row * DM + col0; float ss = 0.f;
#pragma unroll
                for (int bj = 0; bj < 2; ++bj) {
                    const f32x4 x0 = *(const f32x4*)(X + off + bj * HALF), x1 = *(const f32x4*)(X + off + bj * HALF + 4);
                    const f32x4 v0 = acc[ai][bj][m][0] + x0, v1 = acc[ai][bj][m][1] + x1;
                    *(f32x4*)(H + off + bj * HALF) = v0; *(f32x4*)(H + off + bj * HALF + 4) = v1;
                    u32x4 w; w.x = pack_bf16(v0[0], v0[1]); w.y = pack_bf16(v0[2], v0[3]); w.z = pack_bf16(v1[0], v1[1]); w.w = pack_bf16(v1[2], v1[3]);
                    *(u32x4*)(HB + off + bj * HALF) = w;
                    ss += v0[0] * v0[0] + v0[1] * v0[1] + v0[2] * v0[2] + v0[3] * v0[3] + v1[0] * v1[0] + v1[1] * v1[1] + v1[2] * v1[2] + v1[3] * v1[3]; }
                ss += __shfl_xor(ss, 16); ss += __shfl_xor(ss, 32);
                if (fq == 0) SSQ[(size_t)row * 32 + u.pn * 4 + wc] = ss; }
    }
};
struct EpiF32 {
    static constexpr bool PERM = true, AFTER_DRAIN = false;
    float* C; int ldc;
    __device__ __forceinline__ void operator()(const f32x4 (&acc)[2][2][4][2], const Unit& u, int wr, int wc, int fr, int fq) const {
        const int row0 = u.pm * BM + wr * 64 + fr; const int col0 = u.pn * BM + wc * 32 + 8 * fq;
#pragma unroll
        for (int ai = 0; ai < 2; ++ai)
#pragma unroll
            for (int m = 0; m < 4; ++m) { float* rowp = C + (size_t)(row0 + ai * HALF + m * 16) * ldc + col0;
#pragma unroll
                for (int bj = 0; bj < 2; ++bj) { *(f32x4*)(rowp + bj * HALF) = acc[ai][bj][m][0]; *(f32x4*)(rowp + bj * HALF + 4) = acc[ai][bj][m][1]; } }
    }
};

struct EpiScores {
    static constexpr bool PERM = true, AFTER_DRAIN = true;
    const bf16_t* KEYS;
    float* STOP; int* ITOP;
    static constexpr int QLD = 264;
    __device__ __forceinline__ void fused(f32x4 (&acc)[2][2][4][2], const Unit& u, int wr, int wc, int fr, int fq, PG8_LAS unsigned char* lds, int wid, int lane) const {
        PG8_LAS bf16_t* Q = (PG8_LAS bf16_t*)lds;
#pragma unroll
        for (int ai = 0; ai < 2; ++ai)
#pragma unroll
            for (int m = 0; m < 4; ++m) { const int row = ai * HALF + wr * 64 + m * 16 + fr;
#pragma unroll
                for (int bj = 0; bj < 2; ++bj) { const f32x4 v0 = acc[ai][bj][m][0], v1 = acc[ai][bj][m][1];
                    u32x4 w; w.x = pack_bf16(v0[0], v0[1]); w.y = pack_bf16(v0[2], v0[3]); w.z = pack_bf16(v1[0], v1[1]); w.w = pack_bf16(v1[2], v1[3]);
                    *(PG8_LAS u32x4*)(Q + row * QLD + bj * HALF + wc * 32 + 8 * fq) = w; } }
        __syncthreads();
        const int h = u.pn;
#pragma unroll 1
        for (int c = 0; c < 2; ++c) {
            f32x4 sc[8][2];
#pragma unroll
            for (int kf = 0; kf < 8; ++kf) { sc[kf][0] = (f32x4){0.f, 0.f, 0.f, 0.f}; sc[kf][1] = (f32x4){0.f, 0.f, 0.f, 0.f}; }
            const bf16_t* kb = KEYS + (size_t)((h * 2 + c) * 128 + fr) * 128 + 8 * fq;
            const PG8_LAS bf16_t* qb = Q + (wid * 32 + fr) * QLD + c * 128 + 8 * fq;
#pragma unroll
            for (int ks = 0; ks < 4; ++ks) {
                const bf16x8 q0 = *(const PG8_LAS bf16x8*)(qb + 32 * ks), q1 = *(const PG8_LAS bf16x8*)(qb + 16 * QLD + 32 * ks);
#pragma unroll
                for (int kf = 0; kf < 8; ++kf) { const bf16x8 kv = *(const bf16x8*)(kb + (size_t)kf * 16 * 128 + 32 * ks);
                    sc[kf][0] = __builtin_amdgcn_mfma_f32_16x16x32_bf16(kv, q0, sc[kf][0], 0, 0, 0);
                    sc[kf][1] = __builtin_amdgcn_mfma_f32_16x16x32_bf16(kv, q1, sc[kf][1], 0, 0, 0); }
            }
#pragma unroll
            for (int tf = 0; tf < 2; ++tf) {
                float v[32];
#pragma unroll
                for (int kf = 0; kf < 8; ++kf)
#pragma unroll
                    for (int r = 0; r < 4; ++r) v[kf * 4 + r] = __uint_as_float((__float_as_uint(sc[kf][tf][r]) & 0xffffff80u) | (unsigned)(16 * kf + r));
                const unsigned fqbits = 4u * fq;
                const size_t obase = ((size_t)(u.pm * BM + wid * 32 + tf * 16 + fr) * 16 + h * 2 + c) * 16;
#pragma unroll 1
                for (int r = 0; r < 16; ++r) {
                    float mx = v[0];
#pragma unroll
                    for (int i = 1; i < 32; ++i) mx = fmaxf(mx, v[i]);
                    float cand = __uint_as_float(__float_as_uint(mx) | fqbits);
                    float o = __shfl_xor(cand, 16); cand = fmaxf(cand, o);
                    o = __shfl_xor(cand, 32); cand = fmaxf(cand, o);
                    const unsigned cb = __float_as_uint(cand);
                    const bool mine = (cb & 12u) == fqbits;
                    const float rem = __uint_as_float(cb & ~12u);
#pragma unroll
                    for (int i = 0; i < 32; ++i) v[i] = (mine && v[i] == rem) ? -INFINITY : v[i];
                    if (fq == 0) { STOP[obase + r] = __uint_as_float(cb & 0xffffff80u); ITOP[obase + r] = (int)(cb & 127u); }
                }
            }
        }
    }
};

template <class Epi, class Sched>
__device__ __forceinline__ void gemm_phase(PG8_LAS unsigned char* lds, const Gemm g, const Sched& S, const Epi& E) {
    int tid_ = threadIdx.x; asm volatile("" : "+v"(tid_));
    const int tid = tid_, wid = __builtin_amdgcn_readfirstlane(tid >> 6), lane = tid & 63, wr = wid >> 2, wc = wid & 3, fr = lane & 15, fq = lane >> 4;
    const int K = g.K, nt = K / BK;
    unsigned voffA[2], voffB[2];
#pragma unroll
    for (int i = 0; i < 2; ++i) { int R, C; stage_rc(tid * 16 + i * 8192, R, C); const int Rb = Epi::PERM ? ((R & ~31) + perm32(R & 31)) : R;
        voffA[i] = (unsigned)(R * K + C) * 2u; voffB[i] = (unsigned)(Rb * K + C) * 2u; }
    const size_t kstep = (size_t)(BK * 2);
    const size_t hstep = (size_t)HALF * K * 2;
    const size_t tstep = 2 * hstep;
    const unsigned ldsw = (unsigned)wid * 1024u;
    const int aoff = lds_byte(wr * 64 + fr, fq * 8), boff = lds_byte(wc * 32 + fr, fq * 8);
#define PG8_SA(b, h) (((b) * 2 + (h)) * HTB)
#define PG8_SB(b, h) ((4 + (b) * 2 + (h)) * HTB)
#define PG8_STAGE(bufoff, gbase, voff) do { _Pragma("unroll") for (int _i = 0; _i < 2; ++_i) \
        __builtin_amdgcn_global_load_lds((const unsigned*)((const char*)(gbase) + (voff)[_i]), (PG8_LAS unsigned*)(lds + (bufoff) + ldsw + _i * 8192), 16, 0, 0); } while (0)
#define PG8_LDA(dst, b, h) do { _Pragma("unroll") for (int m = 0; m < 4; ++m) _Pragma("unroll") for (int k = 0; k < 2; ++k) dst[m][k] = *(const PG8_LAS bf16x8*)(lds + PG8_SA(b, h) + aoff + m * 2048 + k * 1024); } while (0)
#define PG8_LDB(dst, b, h) do { _Pragma("unroll") for (int n = 0; n < 2; ++n) _Pragma("unroll") for (int k = 0; k < 2; ++k) dst[n][k] = *(const PG8_LAS bf16x8*)(lds + PG8_SB(b, h) + boff + n * 2048 + k * 1024); } while (0)
#define PG8_MMA(ai, bj, At, Bt) do { __builtin_amdgcn_s_setprio(1); _Pragma("unroll") for (int m = 0; m < 4; ++m) _Pragma("unroll") for (int n = 0; n < 2; ++n) _Pragma("unroll") for (int k = 0; k < 2; ++k) \
        acc[ai][bj][m][n] = __builtin_amdgcn_mfma_f32_16x16x32_bf16(Bt[n][k], At[m][k], acc[ai][bj][m][n], 0, 0, 0); __builtin_amdgcn_s_setprio(0); } while (0)
#define PG8_WAIT_V(n) asm volatile("s_waitcnt vmcnt(" #n ")" ::: "memory")
#define PG8_WAIT_L(n) asm volatile("s_waitcnt lgkmcnt(" #n ")" ::: "memory")
#define PG8_BAR __builtin_amdgcn_s_barrier()
#define PG8_SCHED __builtin_amdgcn_sched_barrier(0)
    Unit cur, nxt; int ui = 0;
    if (!S.next(0, cur)) return;
    f32x4 acc[2][2][4][2];
#pragma unroll
    for (int a = 0; a < 2; ++a)
#pragma unroll
        for (int b = 0; b < 2; ++b)
#pragma unroll
            for (int m = 0; m < 4; ++m)
#pragma unroll
                for (int n = 0; n < 2; ++n) acc[a][b][m][n] = (f32x4){0.f, 0.f, 0.f, 0.f};
    bf16x8 At[4][2], B0[2][2], B1[2][2];
    const char* cA = (const char*)g.A + (size_t)cur.pm * tstep; const char* cB = (const char*)g.Bt + (size_t)cur.pn * tstep;
    S.a_ready(cur);
    PG8_STAGE(PG8_SB(0, 0), cB, voffB); PG8_STAGE(PG8_SA(0, 0), cA, voffA); PG8_STAGE(PG8_SB(0, 1), cB + hstep, voffB); PG8_STAGE(PG8_SA(0, 1), cA + hstep, voffA);
    if (wr == 1) PG8_BAR;
    PG8_WAIT_V(4); PG8_BAR;
    PG8_STAGE(PG8_SB(1, 0), cB + kstep, voffB); PG8_STAGE(PG8_SA(1, 0), cA + kstep, voffA); PG8_STAGE(PG8_SB(1, 1), cB + hstep + kstep, voffB);
    PG8_WAIT_V(6); PG8_BAR;
    for (;;) {
        const bool has_next = S.next(ui + 1, nxt);
        const char* nA = has_next ? (const char*)g.A + (size_t)nxt.pm * tstep : cA; const char* nB = has_next ? (const char*)g.Bt + (size_t)nxt.pn * tstep : cB;
        for (int t = 0; t < nt; t += 2) {
            const bool last = (t == nt - 2);
            const char* a1 = cA + (size_t)(t + 1) * kstep;
            const char* a2 = last ? nA : cA + (size_t)(t + 2) * kstep; const char* b2 = last ? nB : cB + (size_t)(t + 2) * kstep;
            const char* a3 = a2 + kstep; const char* b3 = b2 + kstep;
            if (last && has_next) S.a_ready(nxt);
            PG8_LDB(B0, 0, 0); PG8_SCHED; PG8_LDA(At, 0, 0); PG8_STAGE(PG8_SA(1, 1), a1 + hstep, voffA);
            PG8_WAIT_L(8); PG8_BAR; PG8_WAIT_L(0); PG8_MMA(0, 0, At, B0); PG8_BAR; PG8_SCHED;
            PG8_LDB(B1, 0, 1); PG8_STAGE(PG8_SB(0, 0), b2, voffB);
            PG8_BAR; PG8_WAIT_L(0); PG8_MMA(0, 1, At, B1); PG8_BAR;
            PG8_LDA(At, 0, 1); PG8_STAGE(PG8_SA(0, 0), a2, voffA);
            PG8_BAR; PG8_WAIT_L(0); PG8_MMA(1, 0, At, B0); PG8_BAR; PG8_SCHED;
            PG8_STAGE(PG8_SB(0, 1), b2 + hstep, voffB);
            PG8_WAIT_V(6); PG8_BAR; PG8_MMA(1, 1, At, B1); PG8_BAR;
            PG8_LDB(B0, 1, 0); PG8_SCHED; PG8_LDA(At, 1, 0); PG8_STAGE(PG8_SA(0, 1), a2 + hstep, voffA);
            PG8_WAIT_L(8); PG8_BAR; PG8_WAIT_L(0); PG8_MMA(0, 0, At, B0); PG8_BAR; PG8_SCHED;
            PG8_LDB(B1, 1, 1); PG8_STAGE(PG8_SB(1, 0), b3, voffB);
            PG8_BAR; PG8_WAIT_L(0); PG8_MMA(0, 1, At, B1); PG8_BAR;
            PG8_LDA(At, 1, 1); PG8_STAGE(PG8_SA(1, 0), a3, voffA);
            PG8_BAR; PG8_WAIT_L(0); PG8_MMA(1, 0, At, B0); PG8_BAR; PG8_SCHED;
            PG8_STAGE(PG8_SB(1, 1), b3 + hstep, voffB);
            PG8_WAIT_V(6); PG8_BAR; PG8_MMA(1, 1, At, B1); PG8_BAR;
        }
        if constexpr (!Epi::AFTER_DRAIN) { E(acc, cur, wr, wc, fr, fq); S.done(cur); }
        if (!has_next) break;
#pragma unroll
        for (int a = 0; a < 2; ++a)
#pragma unroll
            for (int b = 0; b < 2; ++b)
#pragma unroll
                for (int m = 0; m < 4; ++m)
#pragma unroll
                    for (int n = 0; n < 2; ++n) acc[a][b][m][n] = (f32x4){0.f, 0.f, 0.f, 0.f};
        cur = nxt; cA = nA; cB = nB; ++ui;
    }
    PG8_WAIT_V(0);
    if (wr == 0) PG8_BAR;
    PG8_BAR;
    if constexpr (Epi::AFTER_DRAIN) { E.fused(acc, cur, wr, wc, fr, fq, lds, wid, lane); S.done(cur); }
#undef PG8_SA
#undef PG8_SB
#undef PG8_STAGE
#undef PG8_LDA
#undef PG8_LDB
#undef PG8_MMA
#undef PG8_WAIT_V
#undef PG8_WAIT_L
#undef PG8_BAR
#undef PG8_SCHED
}
}

#define XB_TMO      128
#define XB_XCNT(j)  (256  + 64 * (j))
#define XB_XSUB(j)  (1280 + 64 * (j))
#define XB_XGEN(j)  (2304 + 64 * (j))
#define XB_TOP      3328
#define XB_TOPGEN   3392
#define XCD_BAR_WORDS 3456
#define XB_SPIN_CAP (1u << 22)
__device__ __forceinline__ unsigned xb_ld(unsigned* p)              { return __hip_atomic_load(p, __ATOMIC_RELAXED, __HIP_MEMORY_SCOPE_AGENT); }
__device__ __forceinline__ unsigned xb_add(unsigned* p, unsigned v) { return __hip_atomic_fetch_add(p, v, __ATOMIC_RELAXED, __HIP_MEMORY_SCOPE_AGENT); }
__device__ __forceinline__ unsigned xb_xcc_id() { return (unsigned)__builtin_amdgcn_s_getreg((3 << 11) | 20) & 0xFu; }
#define XB_SPIN(cond, bar) do { unsigned _sp = 0; while (cond) { __builtin_amdgcn_s_sleep(1); \
    if ((++_sp & 255u) == 0u) { if (xb_ld(&(bar)[XB_TMO])) break; if (_sp > XB_SPIN_CAP) { atomicAdd(&(bar)[XB_TMO], 1u); break; } } } } while (0)
struct XcdBarrier { unsigned* bar; unsigned x; volatile LAS unsigned* st; };
__device__ __forceinline__ XcdBarrier xcd_barrier_post(unsigned* bar, volatile LAS unsigned* st) {
    XcdBarrier b; b.bar = bar; b.x = xb_xcc_id(); b.st = st;
    if (threadIdx.x == 0) (void)xb_add(&bar[XB_XCNT(b.x)], 1u);
    return b;
}
__device__ __forceinline__ void xcd_barrier_complete(unsigned* bar, unsigned x, unsigned& nloc, unsigned& nx) {
    const unsigned G = gridDim.x * gridDim.y * gridDim.z;
    unsigned sum, cnt, mine, sp = 0u;
    for (;;) {
        sum = 0u; cnt = 0u; mine = 0u;
#pragma unroll
        for (unsigned j = 0; j < 16; ++j) { const unsigned c = xb_ld(&bar[XB_XCNT(j)]); sum += c; cnt += (c > 0u) ? 1u : 0u; mine = (j == x) ? c : mine; }
        if (sum == G) break;
        __builtin_amdgcn_s_sleep(1);
        if ((++sp & 255u) == 0u) { if (xb_ld(&bar[XB_TMO])) break; if (sp > XB_SPIN_CAP) { atomicAdd(&bar[XB_TMO], 1u); break; } }
    }
    nloc = mine > 0u ? mine : 1u; nx = cnt > 0u ? cnt : 1u;
}
__device__ __forceinline__ void xcd_barrier(const XcdBarrier& b) {
    asm volatile("s_waitcnt vmcnt(0)" ::: "memory");
    __syncthreads();
    if (threadIdx.x == 0) {
        unsigned* bar = b.bar;
        __builtin_amdgcn_s_waitcnt(0);
        unsigned nloc = b.st[0], nx = b.st[1];
        if (nloc == 0u) { xcd_barrier_complete(bar, b.x, nloc, nx); b.st[0] = nloc; b.st[1] = nx; }
        const unsigned old = xb_add(&bar[XB_XSUB(b.x)], 1u);
        const unsigned gen = old / nloc;
        if (old + 1u == (gen + 1u) * nloc) {
            __builtin_amdgcn_fence(__ATOMIC_RELEASE, "agent");
            asm volatile("s_waitcnt vmcnt(0)" ::: "memory");
            const unsigned og = xb_add(&bar[XB_TOP], 1u);
            const unsigned tg = og / nx;
            if (og + 1u == (tg + 1u) * nx) xb_add(&bar[XB_TOPGEN], 1u);
            else XB_SPIN(xb_ld(&bar[XB_TOPGEN]) == tg, bar);
            __builtin_amdgcn_fence(__ATOMIC_ACQUIRE, "agent");
            xb_add(&bar[XB_XGEN(b.x)], 1u);
            asm volatile("s_waitcnt vmcnt(0)" ::: "memory");
        } else {
            XB_SPIN(xb_ld(&bar[XB_XGEN(b.x)]) == gen, bar);
            __builtin_amdgcn_fence(__ATOMIC_ACQUIRE, "agent");
            asm volatile("s_waitcnt vmcnt(0)" ::: "memory");
        }
    }
    __syncthreads();
}

namespace {
struct Params {
  const float *x, *meta, *rel_bias, *ln_mix, *w_in, *sinks, *conv_w, *conv_b, *dt_bias, *a_log, *d_skip, *attn_norm_w,
      *ssm_norm_w, *w_out, *ln_ffn, *wq, *keys, *U, *V, *ln_final;
  float* out;
  unsigned char* ws;
};

__device__ __forceinline__ void p0_transpose_tile(const float* __restrict__ W, int ldw, bf16_t* __restrict__ Wt, const float* sc0,
                                                  const float* sc1, int k0, int n0, float* tile  ) {
  const int tid = threadIdx.x;
  {
    const int r = tid >> 4, c4 = (tid & 15) * 4;
    const float4 a = *(const float4*)(W + (size_t)(k0 + r) * ldw + n0 + c4);
    const float4 b = *(const float4*)(W + (size_t)(k0 + r + 32) * ldw + n0 + c4);
    float* p = tile + r * 65 + c4;
    p[0] = a.x; p[1] = a.y; p[2] = a.z; p[3] = a.w;
    float* q = tile + (r + 32) * 65 + c4;
    q[0] = b.x; q[1] = b.y; q[2] = b.z; q[3] = b.w;
  }
  __syncthreads();
  {
    const int n = tid >> 3, kc = (tid & 7) * 8;
    float v[8];
#pragma unroll
    for (int j = 0; j < 8; ++j) {
      float s = 1.f;
      const int k = k0 + kc + j;
      if (sc0) s = k < 1024 ? sc0[k] : sc1[k - 1024];
      v[j] = tile[(kc + j) * 65 + n] * s;
    }
    u32x4 w; w.x = pack_bf16(v[0], v[1]); w.y = pack_bf16(v[2], v[3]); w.z = pack_bf16(v[4], v[5]); w.w = pack_bf16(v[6], v[7]);
    *(u32x4*)(Wt + (size_t)(n0 + n) * DM + k0 + kc) = w;
  }
  __syncthreads();
}

__device__ __forceinline__ void phase0(const Params& p, float* ldsf, int bid, int nblk) {
  const int tid = threadIdx.x, lane = tid & 63, wid = tid >> 6;
  bf16_t* w_inT = (bf16_t*)(p.ws + WS_WINT);
  bf16_t* w_dtT = (bf16_t*)(p.ws + WS_WDTT);
  bf16_t* w_outT = (bf16_t*)(p.ws + WS_WOUTT);
  bf16_t* wqT = (bf16_t*)(p.ws + WS_WQT);
  bf16_t* keysb = (bf16_t*)(p.ws + WS_KEYS);
  unsigned char* ub = p.ws + WS_UB;
  unsigned char* vb = p.ws + WS_VB;
  bf16_t* hnb = (bf16_t*)(p.ws + WS_HNB);
  constexpr int U_HN = (TA + 7) / 8;
  constexpr int U_WIN = 32 * 64, U_WOUT = 32 * 32, U_WQ = 32 * 32, U_WDT = 1, U_KEYS = 64, U_U = NEXP / 8, U_V = NEXP / 8;
  constexpr int B_WIN = U_HN, B_WOUT = B_WIN + U_WIN, B_WQ = B_WOUT + U_WOUT, B_WDT = B_WQ + U_WQ, B_KEYS = B_WDT + U_WDT,
                B_U = B_KEYS + U_KEYS, B_V = B_U + U_U, B_END = B_V + U_V;
  for (int u = bid; u < B_END; u += nblk) {
    if (u < B_WIN) {
      const int t = u * 8 + wid;
      if (t < TA) {
        const float* src = t < T ? p.x + (size_t)t * DM : p.meta + (size_t)(t - T) * DM;
        float4 v[8];
        float ss = 0.f;
#pragma unroll
        for (int i = 0; i < 8; ++i) {
          v[i] = *(const float4*)(src + (i * 64 + lane) * 4);
          ss += v[i].x * v[i].x + v[i].y * v[i].y + v[i].z * v[i].z + v[i].w * v[i].w;
        }
        ss = wave_sum(ss);
        const float r = rsqrtf(ss * (1.f / DM) + EPS);
#pragma unroll
        for (int i = 0; i < 8; ++i) {
          const float4 w = *(const float4*)(p.ln_mix + (i * 64 + lane) * 4);
          u32x2 o; o.x = pack_bf16(v[i].x * r * w.x, v[i].y * r * w.y); o.y = pack_bf16(v[i].z * r * w.z, v[i].w * r * w.w);
          *(u32x2*)(hnb + (size_t)t * DM + (i * 64 + lane) * 4) = o;
        }
      }
    } else if (u < B_WOUT) {
      const int i = u - B_WIN;
      p0_transpose_tile(p.w_in, DPROJ, w_inT, nullptr, nullptr, (i & 31) * 64, (i >> 5) * 64, ldsf);
    } else if (u < B_WQ) {
      const int i = u - B_WOUT;
      p0_transpose_tile(p.w_out, DM, w_outT, p.attn_norm_w, p.ssm_norm_w, (i & 31) * 64, (i >> 5) * 64, ldsf);
    } else if (u < B_WDT) {
      const int i = u - B_WQ;
      p0_transpose_tile(p.wq, DM, wqT, p.ln_ffn, p.ln_ffn + 1024, (i & 31) * 64, (i >> 5) * 64, ldsf);
    } else if (u < B_KEYS) {
      for (int idx = tid; idx < DM * 16; idx += NTHREADS) {
        const int k = idx >> 4, j = idx & 15;
        w_dtT[(size_t)j * DM + k] = f2bf(p.w_in[(size_t)k * DPROJ + NPROJ + j]);
      }
    } else if (u < B_U) {
      const size_t base = (size_t)(u - B_KEYS) * 4096 + (size_t)tid * 8;
      const float4 a = *(const float4*)(p.keys + base), b = *(const float4*)(p.keys + base + 4);
      u32x4 w; w.x = pack_bf16(a.x, a.y); w.y = pack_bf16(a.z, a.w); w.z = pack_bf16(b.x, b.y); w.w = pack_bf16(b.z, b.w);
      *(u32x4*)(keysb + base) = w;
    } else {
      const bool isU = u < B_V;
      const float* src = isU ? p.U : p.V;
      unsigned char* dst = isU ? ub : vb;
      const float scl = isU ? 128.f : 8.f;
      const size_t rowbase = (size_t)(isU ? (u - B_U) : (u - B_V)) * 8 * DM;
#pragma unroll
      for (int it = 0; it < 2; ++it) {
        const int idx = it * 8192 + tid * 16;
        const int col = idx & (DM - 1);
        f32x4 a[4];
#pragma unroll
        for (int j = 0; j < 4; ++j) a[j] = *(const f32x4*)(src + rowbase + idx + 4 * j) * scl;
        if (isU) {
#pragma unroll
          for (int j = 0; j < 4; ++j) a[j] *= *(const f32x4*)(p.ln_ffn + col + 4 * j);
        }
        u32x4 w;
        w.x = (unsigned)__builtin_amdgcn_cvt_pk_fp8_f32(a[0][2], a[0][3], __builtin_amdgcn_cvt_pk_fp8_f32(a[0][0], a[0][1], 0, false), true);
        w.y = (unsigned)__builtin_amdgcn_cvt_pk_fp8_f32(a[1][2], a[1][3], __builtin_amdgcn_cvt_pk_fp8_f32(a[1][0], a[1][1], 0, false), true);
        w.z = (unsigned)__builtin_amdgcn_cvt_pk_fp8_f32(a[2][2], a[2][3], __builtin_amdgcn_cvt_pk_fp8_f32(a[2][0], a[2][1], 0, false), true);
        w.w = (unsigned)__builtin_amdgcn_cvt_pk_fp8_f32(a[3][2], a[3][3], __builtin_amdgcn_cvt_pk_fp8_f32(a[3][0], a[3][1], 0, false), true);
        *(u32x4*)(dst + rowbase + idx) = w;
      }
    }
  }
}

__device__ __forceinline__ void mini_gemm(const bf16_t* __restrict__ A, const bf16_t* __restrict__ Bt, float* __restrict__ out, int ldo,
                                          float* red) {
  const int tid = threadIdx.x, lane = tid & 63, wid = tid >> 6, fr = lane & 15, fq = lane >> 4;
  f32x4 acc = {0.f, 0.f, 0.f, 0.f};
  const bf16_t* ap = A + (size_t)fr * DM + wid * 256 + fq * 8;
  const bf16_t* bp = Bt + (size_t)fr * DM + wid * 256 + fq * 8;
#pragma unroll
  for (int ks = 0; ks < 8; ++ks) {
    const bf16x8 a = *(const bf16x8*)(ap + ks * 32);
    const bf16x8 b = *(const bf16x8*)(bp + ks * 32);
    acc = __builtin_amdgcn_mfma_f32_16x16x32_bf16(a, b, acc, 0, 0, 0);
  }
#pragma unroll
  for (int r = 0; r < 4; ++r) red[wid * 256 + (4 * fq + r) * 16 + fr] = acc[r];
  __syncthreads();
  if (tid < 256) {
    float s = 0.f;
#pragma unroll
    for (int w = 0; w < 8; ++w) s += red[w * 256 + tid];
    out[(size_t)(tid >> 4) * ldo + (tid & 15)] = s;
  }
  __syncthreads();
}

__device__ __forceinline__ void phase1(const Params& p, unsigned char* lds, int bid, int nblk) {
  const bf16_t* hnb = (const bf16_t*)(p.ws + WS_HNB);
  const bf16_t* w_inT = (const bf16_t*)(p.ws + WS_WINT);
  const bf16_t* w_dtT = (const bf16_t*)(p.ws + WS_WDTT);
  float* dtraw = (float*)(p.ws + WS_DTRAW);
  float* projm = (float*)(p.ws + WS_PROJM);
  constexpr int NU = 512 + 32 + 96 + 1;
  for (int u = bid; u < NU; u += nblk) {
    if (u < 512) {
      mini_gemm(hnb + (size_t)u * 16 * DM, w_dtT, dtraw + (size_t)u * 16 * 16, 16, (float*)lds);
    } else {
      const int j = u - 512;
      const int cf = j < 32 ? 64 + j : (j < 128 ? 160 + (j - 32) : 256);
      const bf16_t* bt = cf < 256 ? w_inT + (size_t)cf * 16 * DM : w_dtT;
      mini_gemm(hnb + (size_t)T * DM, bt, projm + cf * 16, DPROJ, (float*)lds);
    }
  }
  pg8::Gemm g{hnb, w_inT, T, NPROJ, DM};
  pg8::StaticOrder S; S.init(T, NPROJ, nblk, bid);
  pg8::EpiBf16 E{(bf16_t*)(p.ws + WS_PROJ), NPROJ};
  pg8::gemm_phase<pg8::EpiBf16, pg8::StaticOrder>((PG8_LAS unsigned char*)lds, g, S, E);
}

__device__ __forceinline__ void phase4(const Params& p, unsigned char* lds, int bid, int nblk) {
  pg8::Gemm g{(const bf16_t*)(p.ws + WS_HNB), (const bf16_t*)(p.ws + WS_WOUTT), T, DM, DM};
  pg8::StaticOrder S; S.init(T, DM, nblk, bid);
  pg8::EpiRes E{p.x, (float*)(p.ws + WS_PROJ), (bf16_t*)(p.ws + WS_H1B), (float*)(p.ws + WS_SSQH1)};
  pg8::gemm_phase<pg8::EpiRes, pg8::StaticOrder>((PG8_LAS unsigned char*)lds, g, S, E);
}
__device__ __forceinline__ void phase5(const Params& p, unsigned char* lds, int bid, int nblk) {
  pg8::Gemm g{(const bf16_t*)(p.ws + WS_H1B), (const bf16_t*)(p.ws + WS_WQT), T, DM, DM};
  pg8::StaticOrder S; S.init(T, DM, nblk, bid);
  pg8::EpiScores E{(const bf16_t*)(p.ws + WS_KEYS), (float*)(p.ws + WS_STOP), (int*)(p.ws + WS_ITOP)};
  pg8::gemm_phase<pg8::EpiScores, pg8::StaticOrder>((PG8_LAS unsigned char*)lds, g, S, E);
}

__device__ __forceinline__ float dot2bf(unsigned a, unsigned b, float c) {
  return __builtin_amdgcn_fdot2_f32_bf16(*(bf16v2*)&a, *(bf16v2*)&b, c, false);
}
__device__ __forceinline__ void phase6(const Params& p, unsigned char* lds, int bid, int nblk) {
  const int tid = threadIdx.x, lane = tid & 63, wid = __builtin_amdgcn_readfirstlane(tid >> 6);
  float* red = (float*)lds;
  float* gts = (float*)(lds + 65536);
  int* ids = (int*)(lds + 65536 + 512);
  float* wts = (float*)(lds + 65536 + 1024);
  float* red2 = (float*)(lds + 65536 + 1536);
  const unsigned char* ub = p.ws + WS_UB;
  const unsigned char* vb = p.ws + WS_VB;
  const bf16_t* h1b = (const bf16_t*)(p.ws + WS_H1B);
  const float* h1 = (const float*)(p.ws + WS_PROJ);
  const float* ssq = (const float*)(p.ws + WS_SSQH1);
  const float* stop = (const float*)(p.ws + WS_STOP);
  const int* itop = (const int*)(p.ws + WS_ITOP);
  const int ci = kCandI[lane], cj = kCandJ[lane];
  const int kcode = 8 * ((lane >> 2) & 1) + 4 * ((lane >> 3) & 1) + 2 * ((lane >> 4) & 1) + ((lane >> 5) & 1);
  for (int t = bid; t < T; t += nblk) {
    const float part0 = lane < 32 ? ssq[(size_t)t * 32 + lane] : 0.f;
    const float rr = rsqrtf(wave_sum(part0) * (1.f / DM) + EPS);
    const size_t lbase = ((size_t)t * 16 + wid * 2) * 16;
    const float sv = lane < 32 ? stop[lbase + lane] : 0.f;
    const int iv = lane < 32 ? itop[lbase + lane] : 0;
    float cand = (__shfl(sv, ci) + __shfl(sv, 16 + cj)) * rr;
    if (lane >= 50) cand = -INFINITY;
    int rank = 0;
#pragma unroll
    for (int k = 0; k < 50; ++k) {
      const float ck = __int_as_float(__builtin_amdgcn_readlane(__float_as_int(cand), k));
      rank += ((ck > cand) || (ck == cand && k < lane)) ? 1 : 0;
    }
    const float cmax = wave_max(cand);
    const float ex = rank < 16 ? __expf(cand - cmax) : 0.f;
    const float den = wave_sum(ex);
    const int eidx = __shfl(iv, ci) * 128 + __shfl(iv, 16 + cj);
    if (rank < 16) { ids[wid * 16 + rank] = eidx; gts[wid * 16 + rank] = ex / den; }
    float xf[32];
#pragma unroll
    for (int c = 0; c < 2; ++c) {
      const u32x4 xa = *(const u32x4*)(h1b + (size_t)t * DM + (c * 64 + lane) * 16), xb = *(const u32x4*)(h1b + (size_t)t * DM + (c * 64 + lane) * 16 + 8);
      xf[c * 16 + 0] = bflo(xa.x); xf[c * 16 + 1] = bfhi(xa.x); xf[c * 16 + 2] = bflo(xa.y); xf[c * 16 + 3] = bfhi(xa.y);
      xf[c * 16 + 4] = bflo(xa.z); xf[c * 16 + 5] = bfhi(xa.z); xf[c * 16 + 6] = bflo(xa.w); xf[c * 16 + 7] = bfhi(xa.w);
      xf[c * 16 + 8] = bflo(xb.x); xf[c * 16 + 9] = bfhi(xb.x); xf[c * 16 + 10] = bflo(xb.y); xf[c * 16 + 11] = bfhi(xb.y);
      xf[c * 16 + 12] = bflo(xb.z); xf[c * 16 + 13] = bfhi(xb.z); xf[c * 16 + 14] = bflo(xb.w); xf[c * 16 + 15] = bfhi(xb.w);
    }
    float part[16];
    {
      u32x4 rows[16][2];
#pragma unroll
      for (int k = 0; k < 16; ++k) {
        const int e = __builtin_amdgcn_readfirstlane(ids[wid * 16 + k]);
        const unsigned char* rp = ub + (size_t)e * DM + lane * 16;
        rows[k][0] = *(const u32x4*)rp; rows[k][1] = *(const u32x4*)(rp + 1024);
      }
#pragma unroll
      for (int k = 0; k < 16; ++k) {
        float d = 0.f;
#pragma unroll
        for (int c = 0; c < 2; ++c)
#pragma unroll
          for (int j = 0; j < 4; ++j) {
            const int wd = (int)rows[k][c][j];
            const f32x2 lo = __builtin_amdgcn_cvt_pk_f32_fp8(wd, false), hi = __builtin_amdgcn_cvt_pk_f32_fp8(wd, true);
            d = fmaf(lo[0], xf[c * 16 + 4 * j + 0], d); d = fmaf(lo[1], xf[c * 16 + 4 * j + 1], d);
            d = fmaf(hi[0], xf[c * 16 + 4 * j + 2], d); d = fmaf(hi[1], xf[c * 16 + 4 * j + 3], d);
          }
        part[k] = d;
      }
    }
    float q8[8], q4[4], q2[2], q1;
    { const bool hi = (lane >> 5) & 1;
#pragma unroll
      for (int i = 0; i < 8; ++i) { const float keep = hi ? part[2 * i + 1] : part[2 * i], send = hi ? part[2 * i] : part[2 * i + 1]; q8[i] = keep + __shfl_xor(send, 32); } }
    { const bool hi = (lane >> 4) & 1;
#pragma unroll
      for (int i = 0; i < 4; ++i) { const float keep = hi ? q8[2 * i + 1] : q8[2 * i], send = hi ? q8[2 * i] : q8[2 * i + 1]; q4[i] = keep + __shfl_xor(send, 16); } }
    { const bool hi = (lane >> 3) & 1;
#pragma unroll
      for (int i = 0; i < 2; ++i) { const float keep = hi ? q4[2 * i + 1] : q4[2 * i], send = hi ? q4[2 * i] : q4[2 * i + 1]; q2[i] = keep + __shfl_xor(send, 8); } }
    { const bool hi = (lane >> 2) & 1;
      const float keep = hi ? q2[1] : q2[0], send = hi ? q2[0] : q2[1]; q1 = keep + __shfl_xor(send, 4); }
    q1 += __shfl_xor(q1, 2);
    q1 += __shfl_xor(q1, 1);
    {
      const float a = q1 * rr * (1.f / 128.f);
      const float ge = 0.5f * a * (1.f + erff(a * 0.70710678118654752f));
      if ((lane & 3) == 0) wts[wid * 16 + kcode] = gts[wid * 16 + kcode] * ge * 0.125f;
    }
    float acc[32];
#pragma unroll
    for (int i = 0; i < 32; ++i) acc[i] = 0.f;
    {
      u32x4 rows[16][2];
#pragma unroll
      for (int k = 0; k < 16; ++k) {
        const int e = __builtin_amdgcn_readfirstlane(ids[wid * 16 + k]);
        const unsigned char* rp = vb + (size_t)e * DM + lane * 16;
        rows[k][0] = *(const u32x4*)rp; rows[k][1] = *(const u32x4*)(rp + 1024);
      }
#pragma unroll
      for (int k = 0; k < 16; ++k) {
        const float wk = wts[wid * 16 + k];
#pragma unroll
        for (int c = 0; c < 2; ++c)
#pragma unroll
          for (int j = 0; j < 4; ++j) {
            const int wd = (int)rows[k][c][j];
            const f32x2 lo = __builtin_amdgcn_cvt_pk_f32_fp8(wd, false), hi = __builtin_amdgcn_cvt_pk_f32_fp8(wd, true);
            acc[c * 16 + 4 * j + 0] = fmaf(wk, lo[0], acc[c * 16 + 4 * j + 0]); acc[c * 16 + 4 * j + 1] = fmaf(wk, lo[1], acc[c * 16 + 4 * j + 1]);
            acc[c * 16 + 4 * j + 2] = fmaf(wk, hi[0], acc[c * 16 + 4 * j + 2]); acc[c * 16 + 4 * j + 3] = fmaf(wk, hi[1], acc[c * 16 + 4 * j + 3]);
          }
      }
    }
#pragma unroll
    for (int c = 0; c < 2; ++c) {
      float* rp = red + wid * 2048 + (c * 64 + lane) * 16;
#pragma unroll
      for (int j = 0; j < 4; ++j) *(f32x4*)(rp + 4 * j) = (f32x4){acc[c * 16 + 4 * j], acc[c * 16 + 4 * j + 1], acc[c * 16 + 4 * j + 2], acc[c * 16 + 4 * j + 3]};
    }
    __syncthreads();
    {
      const int col = tid * 4;
      f32x4 s = *(const f32x4*)(h1 + (size_t)t * DM + col);
#pragma unroll
      for (int w = 0; w < 8; ++w) s += *(const f32x4*)(red + w * 2048 + col);
      float ss = wave_sum(s[0] * s[0] + s[1] * s[1] + s[2] * s[2] + s[3] * s[3]);
      if (lane == 0) red2[wid] = ss;
      __syncthreads();
      float tot = 0.f;
#pragma unroll
      for (int w = 0; w < 8; ++w) tot += red2[w];
      const float rf = rsqrtf(tot * (1.f / DM) + EPS);
      const f32x4 lw = *(const f32x4*)(p.ln_final + col);
      *(f32x4*)(p.out + (size_t)t * DM + col) = s * rf * lw;
    }
    __syncthreads();
  }
}

typedef float f32x16 __attribute__((ext_vector_type(16)));
constexpr int VT_LD = 196;
constexpr int ATT_VT_BYTES = 4 * 64 * VT_LD * 2;
__device__ __forceinline__ void attn_item(const Params& p, unsigned char* lds, int item) {
  const int tid = threadIdx.x, lane = tid & 63, wid = __builtin_amdgcn_readfirstlane(tid >> 6);
  const int b = item >> 6, q0 = (item & 63) * 32;
  bf16_t* VT = (bf16_t*)lds;
  float* biasL = (float*)(lds + ATT_VT_BYTES);
  float* ssqw = biasL + 16 * 132;
  const bf16_t* proj = (const bf16_t*)(p.ws + WS_PROJ);
  const float* projm = (const float*)(p.ws + WS_PROJM);
  bf16_t* mixin = (bf16_t*)(p.ws + WS_HNB);
  for (int idx = tid; idx < 16 * 129; idx += NTHREADS) {
    const int hq = idx / 129, d = idx - hq * 129;
    const int bk = d < 128 ? (int)kBucket[d] : 31;
    biasL[hq * 132 + d] = p.rel_bias[bk * 16 + hq];
  }
#pragma unroll 1
  for (int task = tid; task < 96 * 32; task += NTHREADS) {
    const int pi = task >> 5, ch = task & 31, slot0 = 2 * pi;
    float v0[8], v1[8];
    if (slot0 < 16) {
      const float* r0 = projm + (size_t)slot0 * DPROJ + OFF_V + ch * 8;
      const float* r1 = r0 + DPROJ;
#pragma unroll
      for (int i = 0; i < 8; ++i) { v0[i] = r0[i]; v1[i] = r1[i]; }
    } else if (slot0 < 32) {
#pragma unroll
      for (int i = 0; i < 8; ++i) { v0[i] = 0.f; v1[i] = 0.f; }
    } else {
      const int s0 = q0 - 128 + slot0 - 32;
      if (s0 < 0) {
#pragma unroll
        for (int i = 0; i < 8; ++i) { v0[i] = 0.f; v1[i] = 0.f; }
      } else {
        const bf16_t* r0 = proj + (size_t)(b * SEQ + s0) * NPROJ + OFF_V + ch * 8;
        const u32x4 a = *(const u32x4*)r0, c = *(const u32x4*)(r0 + NPROJ);
        v0[0] = bflo(a.x); v0[1] = bfhi(a.x); v0[2] = bflo(a.y); v0[3] = bfhi(a.y); v0[4] = bflo(a.z); v0[5] = bfhi(a.z); v0[6] = bflo(a.w); v0[7] = bfhi(a.w);
        v1[0] = bflo(c.x); v1[1] = bfhi(c.x); v1[2] = bflo(c.y); v1[3] = bfhi(c.y); v1[4] = bflo(c.z); v1[5] = bfhi(c.z); v1[6] = bflo(c.w); v1[7] = bfhi(c.w);
      }
    }
    bf16_t* dst = VT + (size_t)((ch >> 3) * 64 + (ch & 7) * 8) * VT_LD + slot0;
#pragma unroll
    for (int i = 0; i < 8; ++i) *(unsigned*)(dst + i * VT_LD) = pack_bf16(v0[i], v1[i]);
  }
  __syncthreads();
  const int ql = lane & 31, hh = lane >> 5, kvh = wid >> 1;
  const int trow = b * SEQ + q0 + ql;
  float ssq = 0.f;
#pragma unroll 1
  for (int hsel = 0; hsel < 2; ++hsel) {
    const int hq = 2 * wid + hsel;
    bf16x8 qf[4];
#pragma unroll
    for (int ks = 0; ks < 4; ++ks) qf[ks] = *(const bf16x8*)(proj + (size_t)trow * NPROJ + OFF_Q + hq * 64 + ks * 16 + hh * 8);
    f32x16 sacc[6];
#pragma unroll
    for (int jt = 0; jt < 6; ++jt) {
      f32x16 acc;
#pragma unroll
      for (int r = 0; r < 16; ++r) acc[r] = 0.f;
      if (jt == 0) {
        const float* kr = projm + (size_t)(ql & 15) * DPROJ + OFF_K + kvh * 64 + hh * 8;
#pragma unroll
        for (int ks = 0; ks < 4; ++ks) {
          const f32x4 a = *(const f32x4*)(kr + ks * 16), c = *(const f32x4*)(kr + ks * 16 + 4);
          u32x4 w; w.x = pack_bf16(a[0], a[1]); w.y = pack_bf16(a[2], a[3]); w.z = pack_bf16(c[0], c[1]); w.w = pack_bf16(c[2], c[3]);
          acc = __builtin_amdgcn_mfma_f32_32x32x16_bf16(*(bf16x8*)&w, qf[ks], acc, 0, 0, 0);
        }
      } else {
        int sp = q0 - 128 + 32 * (jt - 1) + ql;
        sp = sp < 0 ? 0 : sp;
        const bf16_t* kr = proj + (size_t)(b * SEQ + sp) * NPROJ + OFF_K + kvh * 64 + hh * 8;
#pragma unroll
        for (int ks = 0; ks < 4; ++ks) acc = __builtin_amdgcn_mfma_f32_32x32x16_bf16(*(const bf16x8*)(kr + ks * 16), qf[ks], acc, 0, 0, 0);
      }
      sacc[jt] = acc;
      asm volatile("" ::: "memory");
    }
    const float* bl = biasL + hq * 132;
    int sq = q0 + ql, qh = ql - 4 * hh;
    asm volatile("" : "+v"(sq), "+v"(qh));
    const float sink = p.sinks[hq];
    float m = sink;
#pragma unroll
    for (int jt = 0; jt < 6; ++jt) {
      asm volatile("" ::: "memory");
#pragma unroll
      for (int r = 0; r < 16; ++r) {
        const int kr = (r & 3) + 8 * (r >> 2) + 4 * hh;
        int dist; bool valid;
        if (jt == 0) { dist = sq + (16 - ((r & 3) + 8 * (r >> 2))) - 4 * hh; valid = kr < 16; }
        else { dist = qh + (128 - 32 * (jt - 1) - ((r & 3) + 8 * (r >> 2))); valid = (dist >= 0) && (dist < 128) && (dist <= sq); }
        const int dc = dist < 0 ? 0 : (dist > 128 ? 128 : dist);
        const float l = valid ? 0.125f * sacc[jt][r] + bl[dc] : -1e30f;
        sacc[jt][r] = l;
        m = fmaxf(m, l);
      }
    }
    m = fmaxf(m, __shfl_xor(m, 32));
    float sum = 0.f;
    f32x16 oacc0, oacc1;
#pragma unroll
    for (int r = 0; r < 16; ++r) { oacc0[r] = 0.f; oacc1[r] = 0.f; }
    const bf16_t* vrow0 = VT + (size_t)(kvh * 64 + ql) * VT_LD + 4 * hh;
    const bf16_t* vrow1 = vrow0 + 32 * VT_LD;
#pragma unroll
    for (int jt = 0; jt < 6; ++jt) {
      u32x4 pw[2];
#pragma unroll
      for (int s2 = 0; s2 < 2; ++s2) {
        float e[8];
#pragma unroll
        for (int i = 0; i < 8; ++i) { e[i] = __expf(sacc[jt][8 * s2 + i] - m); sum += e[i]; }
        pw[s2].x = pack_bf16(e[0], e[1]); pw[s2].y = pack_bf16(e[2], e[3]); pw[s2].z = pack_bf16(e[4], e[5]); pw[s2].w = pack_bf16(e[6], e[7]);
      }
#pragma unroll
      for (int s2 = 0; s2 < 2; ++s2) {
        const u32x2 va = *(const u32x2*)(vrow0 + 32 * jt + 16 * s2), vc = *(const u32x2*)(vrow0 + 32 * jt + 16 * s2 + 8);
        const u32x2 vd = *(const u32x2*)(vrow1 + 32 * jt + 16 * s2), ve = *(const u32x2*)(vrow1 + 32 * jt + 16 * s2 + 8);
        u32x4 v0w; v0w.x = va.x; v0w.y = va.y; v0w.z = vc.x; v0w.w = vc.y;
        u32x4 v1w; v1w.x = vd.x; v1w.y = vd.y; v1w.z = ve.x; v1w.w = ve.y;
        oacc0 = __builtin_amdgcn_mfma_f32_32x32x16_bf16(*(bf16x8*)&v0w, *(bf16x8*)&pw[s2], oacc0, 0, 0, 0);
        oacc1 = __builtin_amdgcn_mfma_f32_32x32x16_bf16(*(bf16x8*)&v1w, *(bf16x8*)&pw[s2], oacc1, 0, 0, 0);
      }
    }
    sum += __shfl_xor(sum, 32);
    const float inv = 1.f / (sum + __expf(sink - m));
#pragma unroll
    for (int r = 0; r < 16; ++r) { oacc0[r] *= inv; oacc1[r] *= inv; ssq += oacc0[r] * oacc0[r] + oacc1[r] * oacc1[r]; }
#pragma unroll
    for (int rg = 0; rg < 4; ++rg) {
      u32x2 w; w.x = pack_bf16(oacc0[rg * 4 + 0], oacc0[rg * 4 + 1]); w.y = pack_bf16(oacc0[rg * 4 + 2], oacc0[rg * 4 + 3]);
      *(u32x2*)(mixin + (size_t)trow * DM + hq * 64 + 8 * rg + 4 * hh) = w;
      u32x2 w1; w1.x = pack_bf16(oacc1[rg * 4 + 0], oacc1[rg * 4 + 1]); w1.y = pack_bf16(oacc1[rg * 4 + 2], oacc1[rg * 4 + 3]);
      *(u32x2*)(mixin + (size_t)trow * DM + hq * 64 + 32 + 8 * rg + 4 * hh) = w1;
    }
  }
  ssq += __shfl_xor(ssq, 32);
  if (lane < 32) ssqw[wid * 32 + lane] = ssq;
  __syncthreads();
  float tot = 0.f;
#pragma unroll
  for (int w = 0; w < 8; ++w) tot += ssqw[w * 32 + ql];
  const float ra = rsqrtf(tot * (1.f / 1024) + EPS);
#pragma unroll
  for (int hsel = 0; hsel < 2; ++hsel)
#pragma unroll
    for (int dt = 0; dt < 2; ++dt)
#pragma unroll
      for (int rg = 0; rg < 4; ++rg) {
        bf16_t* op = mixin + (size_t)trow * DM + (2 * wid + hsel) * 64 + 32 * dt + 8 * rg + 4 * hh;
        const u32x2 v = *(const u32x2*)op;
        u32x2 w; w.x = pack_bf16(bflo(v.x) * ra, bfhi(v.x) * ra); w.y = pack_bf16(bflo(v.y) * ra, bfhi(v.y) * ra);
        *(u32x2*)op = w;
      }
  __syncthreads();
}
__device__ __forceinline__ void phase2_attn(const Params& p, unsigned char* lds, int bid, int nblk) {
  for (int item = bid; item < 256; item += nblk) attn_item(p, lds, item);
}

constexpr int SLD = 136;
__device__ __forceinline__ void unpack8(const u32x4 a, float (&v)[8]) {
  v[0] = bflo(a.x); v[1] = bfhi(a.x); v[2] = bflo(a.y); v[3] = bfhi(a.y); v[4] = bflo(a.z); v[5] = bfhi(a.z); v[6] = bflo(a.w); v[7] = bfhi(a.w);
}
__device__ __forceinline__ void ssd_a_item(const Params& p, unsigned char* lds, int item) {
  const int tid = threadIdx.x, lane = tid & 63, wid = __builtin_amdgcn_readfirstlane(tid >> 6);
  const int b = item >> 8, c = (item >> 4) & 15, h = item & 15, g = h >> 3;
  const int t0 = b * SEQ + c * 128;
  bf16_t* Bc = (bf16_t*)lds;
  bf16_t* Cc = Bc + 128 * SLD;
  bf16_t* BcTw = Cc + 128 * SLD;
  bf16_t* xT = BcTw + 128 * SLD;
  float* dtl = (float*)(xT + 64 * SLD);
  float* acs = dtl + 128;
  float* wl = acs + 128;
  float* scan = wl + 128;
  const bf16_t* proj = (const bf16_t*)(p.ws + WS_PROJ);
  const float* projm = (const float*)(p.ws + WS_PROJM);
  const float* dtraw = (const float*)(p.ws + WS_DTRAW);
  float* acsg = (float*)(p.ws + WS_ACSG);
  bf16_t* ccb = (bf16_t*)(p.ws + WS_CCB);
  float* ypart = (float*)(p.ws + WS_YPART);
  float* sg = (float*)(p.ws + WS_SG);
  const float Ah = -expf(p.a_log[h]);
  const float dskip = p.d_skip[h];
  float cum = 0.f;
  if (tid < 128) {
    const float dtv = softplus_f(dtraw[(size_t)(t0 + tid) * 16 + h] + p.dt_bias[h]);
    dtl[tid] = dtv;
    cum = dtv * Ah;
#pragma unroll
    for (int o = 1; o < 64; o <<= 1) { const float nb = __shfl_up(cum, o); if (lane >= o) cum += nb; }
    if (tid == 63) scan[0] = cum;
  }
  __syncthreads();
  if (tid < 128) {
    if (tid >= 64) cum += scan[0];
    acs[tid] = cum;
    acsg[(size_t)(t0 + tid) * 16 + h] = cum;
  }
  __syncthreads();
  if (tid < 128) wl[tid] = dtl[tid] * __expf(acs[127] - acs[tid]);
  __syncthreads();
#pragma unroll 1
  for (int task = tid; task < 16 * 320; task += NTHREADS) {
    const int tg = task / 320, ch = task - tg * 320;
    const int cch = ch < 64 ? h * 64 + ch : (ch < 192 ? 1024 + g * 128 + (ch - 64) : 1280 + g * 128 + (ch - 192));
    float raw[11];
#pragma unroll
    for (int i = 0; i < 11; ++i) {
      const int l = tg * 8 + i - 3;
      float v;
      if (l >= 0 || c > 0) v = bf2f(proj[(size_t)(t0 + l) * NPROJ + OFF_XBC + cch]);
      else v = projm[(size_t)(16 + l) * DPROJ + OFF_XBC + cch];
      raw[i] = v;
    }
    const float w0 = p.conv_w[cch], w1 = p.conv_w[D_XBC + cch], w2 = p.conv_w[2 * D_XBC + cch], w3 = p.conv_w[3 * D_XBC + cch], cb = p.conv_b[cch];
    float o[8];
#pragma unroll
    for (int i = 0; i < 8; ++i) o[i] = silu_f(cb + w0 * raw[i] + w1 * raw[i + 1] + w2 * raw[i + 2] + w3 * raw[i + 3]);
    if (ch < 64) {
      u32x4 w; w.x = pack_bf16(o[0], o[1]); w.y = pack_bf16(o[2], o[3]); w.z = pack_bf16(o[4], o[5]); w.w = pack_bf16(o[6], o[7]);
      *(u32x4*)(xT + ch * SLD + tg * 8) = w;
    } else if (ch < 192) {
      const int n = ch - 64;
#pragma unroll
      for (int i = 0; i < 8; ++i) Bc[(tg * 8 + i) * SLD + n] = f2bf(o[i]);
      const f32x4 wa = *(const f32x4*)(wl + tg * 8), wb = *(const f32x4*)(wl + tg * 8 + 4);
      u32x4 w; w.x = pack_bf16(o[0] * wa[0], o[1] * wa[1]); w.y = pack_bf16(o[2] * wa[2], o[3] * wa[3]);
      w.z = pack_bf16(o[4] * wb[0], o[5] * wb[1]); w.w = pack_bf16(o[6] * wb[2], o[7] * wb[3]);
      *(u32x4*)(BcTw + n * SLD + tg * 8) = w;
    } else {
      const int n = ch - 192;
#pragma unroll
      for (int i = 0; i < 8; ++i) {
        const bf16_t v = f2bf(o[i]);
        Cc[(tg * 8 + i) * SLD + n] = v;
        if ((h & 7) == 0) ccb[(size_t)(t0 + tg * 8 + i) * 256 + g * 128 + n] = v;
      }
    }
  }
  __syncthreads();
  const int ql = lane & 31, hh = lane >> 5;
  {
    const int ip = wid & 1, il = wid >> 1;
    const int l = 32 * il + ql;
    const float acl = acs[l];
    f32x16 yacc;
#pragma unroll
    for (int r = 0; r < 16; ++r) yacc[r] = 0.f;
    const bf16_t* xrow = xT + (32 * ip + ql) * SLD + 4 * hh;
#pragma unroll 1
    for (int is = 0; is <= il; ++is) {
      f32x16 x;
#pragma unroll
      for (int r = 0; r < 16; ++r) x[r] = 0.f;
      const bf16_t* ap = Bc + (32 * is + ql) * SLD + 8 * hh;
      const bf16_t* bp = Cc + l * SLD + 8 * hh;
#pragma unroll
      for (int ks = 0; ks < 8; ++ks) x = __builtin_amdgcn_mfma_f32_32x32x16_bf16(*(const bf16x8*)(ap + 16 * ks), *(const bf16x8*)(bp + 16 * ks), x, 0, 0, 0);
      u32x4 pw[2];
#pragma unroll
      for (int s2 = 0; s2 < 2; ++s2) {
        float mv[8];
#pragma unroll
        for (int q = 0; q < 2; ++q) {
          const int sb = 32 * is + 16 * s2 + 8 * q + 4 * hh;
          const f32x4 as4 = *(const f32x4*)(acs + sb), dt4 = *(const f32x4*)(dtl + sb);
#pragma unroll
          for (int j = 0; j < 4; ++j) {
            const int sr = sb + j;
            float v = sr <= l ? x[8 * s2 + 4 * q + j] * __expf(acl - as4[j]) * dt4[j] : 0.f;
            if (sr == l) v += dskip;
            mv[4 * q + j] = v;
          }
        }
        pw[s2].x = pack_bf16(mv[0], mv[1]); pw[s2].y = pack_bf16(mv[2], mv[3]); pw[s2].z = pack_bf16(mv[4], mv[5]); pw[s2].w = pack_bf16(mv[6], mv[7]);
      }
#pragma unroll
      for (int s2 = 0; s2 < 2; ++s2) {
        const u32x2 va = *(const u32x2*)(xrow + 32 * is + 16 * s2), vc = *(const u32x2*)(xrow + 32 * is + 16 * s2 + 8);
        u32x4 aw; aw.x = va.x; aw.y = va.y; aw.z = vc.x; aw.w = vc.y;
        yacc = __builtin_amdgcn_mfma_f32_32x32x16_bf16(*(bf16x8*)&aw, *(bf16x8*)&pw[s2], yacc, 0, 0, 0);
      }
    }
    float* yp = ypart + (size_t)(t0 + l) * 1024 + h * 64 + 32 * ip + 4 * hh;
#pragma unroll
    for (int rg = 0; rg < 4; ++rg) *(f32x4*)(yp + 8 * rg) = (f32x4){yacc[4 * rg], yacc[4 * rg + 1], yacc[4 * rg + 2], yacc[4 * rg + 3]};
  }
  {
    const int ip = wid & 1, in = wid >> 1;
    f32x16 sacc;
#pragma unroll
    for (int r = 0; r < 16; ++r) sacc[r] = 0.f;
    const bf16_t* ap = xT + (32 * ip + ql) * SLD + 8 * hh;
    const bf16_t* bp = BcTw + (32 * in + ql) * SLD + 8 * hh;
#pragma unroll
    for (int ks = 0; ks < 8; ++ks) sacc = __builtin_amdgcn_mfma_f32_32x32x16_bf16(*(const bf16x8*)(ap + 16 * ks), *(const bf16x8*)(bp + 16 * ks), sacc, 0, 0, 0);
    float* sp = sg + ((size_t)((b * 16 + c) * 16 + h) * 64 + 32 * ip + 4 * hh) * 128 + 32 * in + ql;
#pragma unroll
    for (int r = 0; r < 16; ++r) sp[((r & 3) + 8 * (r >> 2)) * 128] = sacc[r];
  }
  __syncthreads();
}

__device__ __forceinline__ void meta_state_item(const Params& p, unsigned char* lds, int h) {
  const int tid = threadIdx.x, g = h >> 3;
  float* xm = (float*)lds;
  float* bm = xm + 16 * 64;
  float* dtm = bm + 16 * 128;
  const float* projm = (const float*)(p.ws + WS_PROJM);
  float* smeta = (float*)(p.ws + WS_SMETA);
  for (int task = tid; task < 16 * 192; task += NTHREADS) {
    const int i = task / 192, ch = task - i * 192;
    const int cch = ch < 64 ? h * 64 + ch : 1024 + g * 128 + (ch - 64);
    float acc = p.conv_b[cch];
#pragma unroll
    for (int j = 0; j < 4; ++j) { const int mi = i - j; if (mi >= 0) acc += p.conv_w[(3 - j) * D_XBC + cch] * projm[(size_t)mi * DPROJ + OFF_XBC + cch]; }
    const float v = silu_f(acc);
    if (ch < 64) xm[i * 64 + ch] = v; else bm[i * 128 + ch - 64] = v;
  }
  if (tid < 16) dtm[tid] = softplus_f(projm[(size_t)tid * DPROJ + OFF_DT + h] + p.dt_bias[h]);
  __syncthreads();
  const float Ah = -expf(p.a_log[h]);
  const int pr = tid >> 3, n0 = (tid & 7) * 16;
  float st[16];
#pragma unroll
  for (int k = 0; k < 16; ++k) st[k] = 0.f;
  for (int i = 0; i < 16; ++i) {
    const float dtv = dtm[i], dA = expf(dtv * Ah), xdt = xm[i * 64 + pr] * dtv;
#pragma unroll
    for (int k = 0; k < 16; ++k) st[k] = fmaf(st[k], dA, xdt * bm[i * 128 + n0 + k]);
  }
#pragma unroll
  for (int k = 0; k < 16; ++k) smeta[(size_t)(h * 64 + pr) * 128 + n0 + k] = st[k];
  __syncthreads();
}

__device__ __forceinline__ void phase2(const Params& p, unsigned char* lds, int bid, int nblk) {
  for (int item = bid; item < 256; item += nblk) attn_item(p, lds, item);
  for (int item = bid; item < 1024; item += nblk) ssd_a_item(p, lds, item);
  for (int item = bid; item < 16; item += nblk) meta_state_item(p, lds, item);
}

__device__ __forceinline__ void ssd_b_item(const Params& p, unsigned char* lds, int item) {
  const int tid = threadIdx.x, lane = tid & 63, wid = __builtin_amdgcn_readfirstlane(tid >> 6);
  const int b = item >> 5, c = (item >> 1) & 15, g = item & 1, h = g * 8 + wid;
  const int t0 = b * SEQ + c * 128;
  const int ql = lane & 31, hh = lane >> 5;
  float* ssqg = (float*)lds;
  const bf16_t* proj = (const bf16_t*)(p.ws + WS_PROJ);
  const float* acsg = (const float*)(p.ws + WS_ACSG);
  const bf16_t* ccb = (const bf16_t*)(p.ws + WS_CCB);
  const float* ypart = (const float*)(p.ws + WS_YPART);
  const float* sg = (const float*)(p.ws + WS_SG);
  const float* smeta = (const float*)(p.ws + WS_SMETA);
  bf16_t* mixin = (bf16_t*)(p.ws + WS_HNB);
  float ssql[4] = {0.f, 0.f, 0.f, 0.f};
#pragma unroll 1
  for (int ip = 0; ip < 2; ++ip) {
    const size_t hoff = (size_t)(32 * ip + ql) * 128 + 8 * hh;
    float Hf[64];
    {
      const float* sp = smeta + (size_t)h * 8192 + hoff;
#pragma unroll
      for (int ks = 0; ks < 8; ++ks) {
        const f32x4 a = *(const f32x4*)(sp + 16 * ks), c4 = *(const f32x4*)(sp + 16 * ks + 4);
        Hf[8 * ks + 0] = a[0]; Hf[8 * ks + 1] = a[1]; Hf[8 * ks + 2] = a[2]; Hf[8 * ks + 3] = a[3];
        Hf[8 * ks + 4] = c4[0]; Hf[8 * ks + 5] = c4[1]; Hf[8 * ks + 6] = c4[2]; Hf[8 * ks + 7] = c4[3];
      }
    }
#pragma unroll 1
    for (int cp = 0; cp < c; ++cp) {
      const float D = __expf(acsg[(size_t)(b * SEQ + cp * 128 + 127) * 16 + h]);
      const float* sp = sg + (size_t)((b * 16 + cp) * 16 + h) * 8192 + hoff;
#pragma unroll
      for (int ks = 0; ks < 8; ++ks) {
        const f32x4 a = *(const f32x4*)(sp + 16 * ks), c4 = *(const f32x4*)(sp + 16 * ks + 4);
        Hf[8 * ks + 0] = fmaf(Hf[8 * ks + 0], D, a[0]); Hf[8 * ks + 1] = fmaf(Hf[8 * ks + 1], D, a[1]);
        Hf[8 * ks + 2] = fmaf(Hf[8 * ks + 2], D, a[2]); Hf[8 * ks + 3] = fmaf(Hf[8 * ks + 3], D, a[3]);
        Hf[8 * ks + 4] = fmaf(Hf[8 * ks + 4], D, c4[0]); Hf[8 * ks + 5] = fmaf(Hf[8 * ks + 5], D, c4[1]);
        Hf[8 * ks + 6] = fmaf(Hf[8 * ks + 6], D, c4[2]); Hf[8 * ks + 7] = fmaf(Hf[8 * ks + 7], D, c4[3]);
      }
    }
    u32x4 hfr[8];
#pragma unroll
    for (int ks = 0; ks < 8; ++ks) {
      hfr[ks].x = pack_bf16(Hf[8 * ks + 0], Hf[8 * ks + 1]); hfr[ks].y = pack_bf16(Hf[8 * ks + 2], Hf[8 * ks + 3]);
      hfr[ks].z = pack_bf16(Hf[8 * ks + 4], Hf[8 * ks + 5]); hfr[ks].w = pack_bf16(Hf[8 * ks + 6], Hf[8 * ks + 7]);
    }
#pragma unroll
    for (int il = 0; il < 4; ++il) {
      const int t = t0 + 32 * il + ql;
      f32x16 acc;
#pragma unroll
      for (int r = 0; r < 16; ++r) acc[r] = 0.f;
      const bf16_t* cp = ccb + (size_t)t * 256 + g * 128 + 8 * hh;
#pragma unroll
      for (int ks = 0; ks < 8; ++ks) acc = __builtin_amdgcn_mfma_f32_32x32x16_bf16(*(bf16x8*)&hfr[ks], *(const bf16x8*)(cp + 16 * ks), acc, 0, 0, 0);
      const float ea = __expf(acsg[(size_t)t * 16 + h]);
#pragma unroll
      for (int rg = 0; rg < 4; ++rg) {
        const int pp = h * 64 + 32 * ip + 8 * rg + 4 * hh;
        const f32x4 yp = *(const f32x4*)(ypart + (size_t)t * 1024 + pp);
        const u32x2 zz = *(const u32x2*)(proj + (size_t)t * NPROJ + OFF_Z + pp);
        const float y0 = (yp[0] + ea * acc[4 * rg + 0]) * silu_f(bflo(zz.x)), y1 = (yp[1] + ea * acc[4 * rg + 1]) * silu_f(bfhi(zz.x));
        const float y2 = (yp[2] + ea * acc[4 * rg + 2]) * silu_f(bflo(zz.y)), y3 = (yp[3] + ea * acc[4 * rg + 3]) * silu_f(bfhi(zz.y));
        ssql[il] += y0 * y0 + y1 * y1 + y2 * y2 + y3 * y3;
        u32x2 w; w.x = pack_bf16(y0, y1); w.y = pack_bf16(y2, y3);
        *(u32x2*)(mixin + (size_t)t * DM + 1024 + pp) = w;
      }
    }
  }
#pragma unroll
  for (int il = 0; il < 4; ++il) {
    float v = ssql[il];
    v += __shfl_xor(v, 32);
    if (lane < 32) ssqg[wid * 128 + 32 * il + lane] = v;
  }
  __syncthreads();
#pragma unroll
  for (int il = 0; il < 4; ++il) {
    float tot = 0.f;
#pragma unroll
    for (int w = 0; w < 8; ++w) tot += ssqg[w * 128 + 32 * il + ql];
    const float rg_ = rsqrtf(tot * (1.f / 512) + EPS);
    const int t = t0 + 32 * il + ql;
#pragma unroll
    for (int ip = 0; ip < 2; ++ip)
#pragma unroll
      for (int rg = 0; rg < 4; ++rg) {
        bf16_t* op = mixin + (size_t)t * DM + 1024 + h * 64 + 32 * ip + 8 * rg + 4 * hh;
        const u32x2 v = *(const u32x2*)op;
        u32x2 w; w.x = pack_bf16(bflo(v.x) * rg_, bfhi(v.x) * rg_); w.y = pack_bf16(bflo(v.y) * rg_, bfhi(v.y) * rg_);
        *(u32x2*)op = w;
      }
  }
  __syncthreads();
}
__device__ __forceinline__ void phase3(const Params& p, unsigned char* lds, int bid, int nblk) {
  for (int item = bid; item < 128; item += nblk) ssd_b_item(p, lds, item);
}

constexpr int LDS_BYTES = 144 * 1024;

#define PARAMS_PTR(pp) const Params* pp = (const Params*)__builtin_amdgcn_kernarg_segment_ptr(); asm volatile("" : "+s"(pp))
__global__ __launch_bounds__(512, 2) void k_mega(Params p_unused) {
  extern __shared__ __attribute__((aligned(16))) unsigned char shm[];
  cooperative_groups::grid_group grid = cooperative_groups::this_grid();
  const int bid = blockIdx.x, nblk = gridDim.x;
  volatile LAS unsigned* xst = (volatile LAS unsigned*)(LAS unsigned char*)(shm + LDS_BYTES - 16);
  if (threadIdx.x == 0) { xst[0] = 0u; xst[1] = 0u; }
  __syncthreads();
  XcdBarrier xb;
  { PARAMS_PTR(pp); xb = xcd_barrier_post((unsigned*)(pp->ws + WS_CTL), xst); }
  { PARAMS_PTR(pp); phase0(*pp, (float*)shm, bid, nblk); }
  grid.sync();
  { PARAMS_PTR(pp); phase1(*pp, shm, bid, nblk); }
  xcd_barrier(xb);
  { PARAMS_PTR(pp); phase2(*pp, shm, bid, nblk); }
  xcd_barrier(xb);
  { PARAMS_PTR(pp); phase3(*pp, shm, bid, nblk); }
  xcd_barrier(xb);
  { PARAMS_PTR(pp); phase4(*pp, shm, bid, nblk); }
  xcd_barrier(xb);
  { PARAMS_PTR(pp); phase5(*pp, shm, bid, nblk); }
  xcd_barrier(xb);
  { PARAMS_PTR(pp); phase6(*pp, shm, bid, nblk); }
}

}

extern "C" void kernel_launch(void* const* d_in, const int* in_sizes, int n_in, void* d_out, int out_size, void* d_ws,
                              size_t ws_size, hipStream_t stream) {
  Params p{};
  p.x = (const float*)d_in[0]; p.meta = (const float*)d_in[1]; p.rel_bias = (const float*)d_in[2];
  p.ln_mix = (const float*)d_in[3]; p.w_in = (const float*)d_in[4]; p.sinks = (const float*)d_in[5];
  p.conv_w = (const float*)d_in[6]; p.conv_b = (const float*)d_in[7]; p.dt_bias = (const float*)d_in[8];
  p.a_log = (const float*)d_in[9]; p.d_skip = (const float*)d_in[10]; p.attn_norm_w = (const float*)d_in[11];
  p.ssm_norm_w = (const float*)d_in[12]; p.w_out = (const float*)d_in[13]; p.ln_ffn = (const float*)d_in[14];
  p.wq = (const float*)d_in[15]; p.keys = (const float*)d_in[16]; p.U = (const float*)d_in[17];
  p.V = (const float*)d_in[18]; p.ln_final = (const float*)d_in[19];
  p.out = (float*)d_out;
  p.ws = (unsigned char*)d_ws;

  static int grid_blocks = 0;
  if (!grid_blocks) {
    int dev = 0, cus = 0, per_cu = 0;
    (void)hipGetDevice(&dev);
    (void)hipDeviceGetAttribute(&cus, hipDeviceAttributeMultiprocessorCount, dev);
    (void)hipFuncSetAttribute((const void*)k_mega, hipFuncAttributeMaxDynamicSharedMemorySize, LDS_BYTES);
    (void)hipOccupancyMaxActiveBlocksPerMultiprocessor(&per_cu, (const void*)k_mega, NTHREADS, LDS_BYTES);
    if (per_cu > 1) per_cu = 1;
    grid_blocks = cus * per_cu;
    if (grid_blocks != 256) fprintf(stderr, "kernel_launch: expected a 256-workgroup resident grid, got %d (cus %d, per_cu %d)\n", grid_blocks, cus, per_cu);
  }
  (void)hipMemsetAsync(p.ws + WS_CTL, 0, XCD_BAR_WORDS * 4, stream);
  void* args[] = {&p};
  hipError_t e = hipLaunchCooperativeKernel((const void*)k_mega, dim3(grid_blocks), dim3(NTHREADS), args, LDS_BYTES, stream);
  if (e != hipSuccess) fprintf(stderr, "cooperative launch failed: %s (grid %d)\n", hipGetErrorString(e), grid_blocks);
}
```

```cpp
#include <hip/hip_runtime.h>
#include <hip/hip_cooperative_groups.h>
#include <math.h>
#include <stdio.h>
#include <stdint.h>

namespace {
constexpr int BATCH = 4, SEQ = 2048, DM = 2048, NMETA = 16;
constexpr int T = BATCH * SEQ;
constexpr int TA = T + NMETA;
constexpr int DPROJ = 4112;
constexpr int NPROJ = 4096;
constexpr int OFF_Q = 0, OFF_K = 1024, OFF_V = 1280, OFF_Z = 1536, OFF_XBC = 2560, OFF_DT = 4096;
constexpr int D_XBC = 1536;
constexpr int NEXP = 16384;
constexpr int ROW6 = 1536;
constexpr float EPS = 1e-6f;
constexpr int NTHREADS = 512;

typedef unsigned short bf16_t;
typedef short bf16x8 __attribute__((ext_vector_type(8)));
typedef float f32x4 __attribute__((ext_vector_type(4)));
typedef float f32x2 __attribute__((ext_vector_type(2)));
typedef unsigned u32x4 __attribute__((ext_vector_type(4)));
typedef unsigned u32x2 __attribute__((ext_vector_type(2)));
typedef __bf16 bf16v2 __attribute__((ext_vector_type(2)));
typedef float f32x16v __attribute__((ext_vector_type(16)));
typedef float f32x32v __attribute__((ext_vector_type(32)));
typedef unsigned u32x6 __attribute__((ext_vector_type(6)));
#define LAS __attribute__((address_space(3)))

__device__ __forceinline__ unsigned pack_bf16(float lo, float hi) {
  f32x2 v = {lo, hi};
  bf16v2 b = __builtin_convertvector(v, bf16v2);
  return *(unsigned*)&b;
}
__device__ __forceinline__ bf16_t f2bf(float f) { return (bf16_t)(pack_bf16(f, 0.f) & 0xffffu); }
__device__ __forceinline__ float bf2f(bf16_t b) { return __uint_as_float(((unsigned)b) << 16); }
__device__ __forceinline__ float bflo(unsigned u) { return __uint_as_float(u << 16); }
__device__ __forceinline__ float bfhi(unsigned u) { return __uint_as_float(u & 0xffff0000u); }

__constant__ unsigned char kBucket[128] = {
    0, 1, 2, 3, 4, 5, 6, 7, 8, 9, 10, 11, 12, 13, 14, 15, 16, 16, 16, 17, 17, 18, 18, 18, 19, 19, 19, 20, 20, 20, 20, 21,
    21, 21, 21, 22, 22, 22, 22, 22, 23, 23, 23, 23, 23, 23, 24, 24, 24, 24, 24, 24, 25, 25, 25, 25, 25, 25, 25, 26, 26, 26, 26, 26,
    26, 26, 26, 27, 27, 27, 27, 27, 27, 27, 27, 27, 27, 28, 28, 28, 28, 28, 28, 28, 28, 28, 28, 29, 29, 29, 29, 29, 29, 29, 29, 29,
    29, 29, 29, 30, 30, 30, 30, 30, 30, 30, 30, 30, 30, 30, 30, 30, 30, 31, 31, 31, 31, 31, 31, 31, 31, 31, 31, 31, 31, 31, 31, 31};

__constant__ unsigned char kCandI[64] = {0, 0, 0, 0, 0, 0, 0, 0, 0, 0, 0, 0, 0, 0, 0, 0, 1, 1, 1, 1, 1, 1, 1, 1, 2, 2, 2, 2, 2, 3, 3, 3, 3, 4, 4, 4, 5, 5, 6, 6, 7, 7, 8, 9, 10, 11, 12, 13, 14, 15, 15, 15, 15, 15, 15, 15, 15, 15, 15, 15, 15, 15, 15, 15};
__constant__ unsigned char kCandJ[64] = {0, 1, 2, 3, 4, 5, 6, 7, 8, 9, 10, 11, 12, 13, 14, 15, 0, 1, 2, 3, 4, 5, 6, 7, 0, 1, 2, 3, 4, 0, 1, 2, 3, 0, 1, 2, 0, 1, 0, 1, 0, 1, 0, 0, 0, 0, 0, 0, 0, 0, 15, 15, 15, 15, 15, 15, 15, 15, 15, 15, 15, 15, 15, 15};

__device__ __forceinline__ float wave_sum(float v) {
  for (int o = 32; o > 0; o >>= 1) v += __shfl_xor(v, o);
  return v;
}
__device__ __forceinline__ float wave_max(float v) {
  for (int o = 32; o > 0; o >>= 1) v = fmaxf(v, __shfl_xor(v, o));
  return v;
}
__device__ __forceinline__ float silu_f(float x) { return x / (1.f + expf(-x)); }
__device__ __forceinline__ float softplus_f(float x) { return fmaxf(x, 0.f) + log1pf(expf(-fabsf(x))); }

constexpr size_t al256(size_t x) { return (x + 255) & ~(size_t)255; }
constexpr size_t WS_CTL = 0;
constexpr size_t WS_WINT = 65536;
constexpr size_t WS_WDTT = WS_WINT + (size_t)NPROJ * DM * 2;
constexpr size_t WS_WOUTT = WS_WDTT + (size_t)16 * DM * 2;
constexpr size_t WS_WQT = WS_WOUTT + (size_t)DM * DM * 2;
constexpr size_t WS_KEYS = WS_WQT + (size_t)DM * DM * 2;
constexpr size_t WS_UB = WS_KEYS + (size_t)16 * 128 * 128 * 2;
constexpr size_t WS_VB = WS_UB + (size_t)NEXP * DM * 2;
constexpr size_t WS_HNB = WS_VB + (size_t)NEXP * DM * 2;
constexpr size_t WS_PROJ = WS_HNB + (size_t)(T + 16) * DM * 2;
constexpr size_t WS_DTRAW = WS_PROJ + (size_t)T * NPROJ * 2;
constexpr size_t WS_PROJM = WS_DTRAW + (size_t)T * 16 * 4;
constexpr size_t WS_PROJMB = al256(WS_PROJM + (size_t)16 * DPROJ * 4);
constexpr size_t WS_H1B = al256(WS_PROJMB + (size_t)16 * DPROJ * 2);
constexpr size_t WS_SSQH1 = WS_H1B + (size_t)T * DM * 2;
constexpr size_t WS_STOP = al256(WS_SSQH1 + (size_t)T * 32 * 4);
constexpr size_t WS_ITOP = WS_STOP + (size_t)T * 256 * 4;
constexpr size_t WS_ACSG = al256(WS_ITOP + (size_t)T * 256 * 4);
constexpr size_t WS_CCB = WS_ACSG + (size_t)T * 16 * 4;
constexpr size_t WS_YPART = WS_CCB + (size_t)T * 256 * 2;
constexpr size_t WS_SG = WS_YPART + (size_t)T * 1024 * 4;
constexpr size_t WS_SMETA = WS_SG + (size_t)1024 * 8192 * 4;
constexpr size_t WS_HPREV = al256(WS_SMETA + (size_t)16 * 8192 * 4);
constexpr size_t WS_USC = al256(WS_HPREV + (size_t)1024 * 8192 * 2);
constexpr size_t WS_VSC = WS_USC + (size_t)NEXP * 4;
constexpr size_t WS_SCR = al256(WS_VSC + (size_t)NEXP * 4);
}

namespace pg8 {
#define PG8_LAS __attribute__((address_space(3)))
constexpr int BM = 256, BK = 64, HALF = 128, HTB = HALF * BK * 2, STAGE_BYTES = 8 * HTB, NXCD = 8, WGM = 8;
__host__ __device__ __forceinline__ int lds_byte(int r, int c) { const int st = (r >> 4) * 2 + (c >> 5), rr = r & 15, cc = c & 31, ob = rr * 64 + cc * 2; return st * 1024 + (ob ^ (((ob >> 9) & 1) << 5)); }
__host__ __device__ __forceinline__ void stage_rc(int b, int& R, int& C) { const int st = b / 1024, sb = b % 1024, swz = sb ^ (((sb >> 9) & 1) << 5); R = (st >> 1) * 16 + swz / 64; C = (st & 1) * 32 + (swz % 64) / 2; }
__host__ __device__ __forceinline__ int perm32(int rho) { const int n = rho >> 4, i = rho & 15; return 8 * (i >> 2) + 4 * n + (i & 3); }
struct Unit { int pm, pn; };
struct Gemm { const bf16_t* A; const bf16_t* Bt; int M, N, K; };
struct StaticOrder {
    int nM, nN, nwg, G, c;
    __host__ __device__ void init(int M, int N, int G_, int c_) { nM = M / BM; nN = N / BM; nwg = nM * nN; G = G_; c = c_; }
    __host__ __device__ bool next(int i, Unit& u) const {
        const long L = (long)i * G + c; if (L >= nwg) return false;
        int wgid = (int)L; { const int q = nwg / NXCD, r = nwg % NXCD, xcd = wgid % NXCD, off = wgid / NXCD; wgid = (xcd < r ? xcd * (q + 1) : r * (q + 1) + (xcd - r) * q) + off; }
        const int nig = WGM * nN, gid = wgid / nig, fm = gid * WGM, gsz = (nM - fm) < WGM ? (nM - fm) : WGM;
        u.pm = fm + ((wgid % nig) % gsz); u.pn = (wgid % nig) / gsz; return true;
    }
    __device__ __forceinline__ void a_ready(const Unit&) const {}
    __device__ __forceinline__ void done(const Unit&) const {}
};
struct EpiBf16 {
    static constexpr bool PERM = true, AFTER_DRAIN = false;
    bf16_t* O; int ldc;
    __device__ __forceinline__ void operator()(const f32x4 (&acc)[2][2][4][2], const Unit& u, int wr, int wc, int fr, int fq) const {
        const int row0 = u.pm * BM + wr * 64 + fr; const int col0 = u.pn * BM + wc * 32 + 8 * fq;
#pragma unroll
        for (int ai = 0; ai < 2; ++ai)
#pragma unroll
            for (int m = 0; m < 4; ++m) { bf16_t* rowp = O + (size_t)(row0 + ai * HALF + m * 16) * ldc + col0;
#pragma unroll
                for (int bj = 0; bj < 2; ++bj) { const f32x4 v0 = acc[ai][bj][m][0], v1 = acc[ai][bj][m][1];
                    u32x4 w; w.x = pack_bf16(v0[0], v0[1]); w.y = pack_bf16(v0[2], v0[3]); w.z = pack_bf16(v1[0], v1[1]); w.w = pack_bf16(v1[2], v1[3]);
                    *(u32x4*)(rowp + bj * HALF) = w; } }
    }
};

struct EpiRes {
    static constexpr bool PERM = true, AFTER_DRAIN = false;
    const float* X; bf16_t* HB; float* SSQ;
    __device__ __forceinline__ void operator()(const f32x4 (&acc)[2][2][4][2], const Unit& u, int wr, int wc, int fr, int fq) const {
        const int row0 = u.pm * BM + wr * 64 + fr; const int col0 = u.pn * BM + wc * 32 + 8 * fq;
#pragma unroll
        for (int ai = 0; ai < 2; ++ai)
#pragma unroll
            for (int m = 0; m < 4; ++m) { const int row = row0 + ai * HALF + m * 16; const size_t off = (size_t)row * DM + col0; float ss = 0.f;
#pragma unroll
                for (int bj = 0; bj < 2; ++bj) {
                    const f32x4 x0 = *(const f32x4*)(X + off + bj * HALF), x1 = *(const f32x4*)(X + off + bj * HALF + 4);
                    const f32x4 v0 = acc[ai][bj][m][0] + x0, v1 = acc[ai][bj][m][1] + x1;
                    u32x4 w; w.x = pack_bf16(v0[0], v0[1]); w.y = pack_bf16(v0[2], v0[3]); w.z = pack_bf16(v1[0], v1[1]); w.w = pack_bf16(v1[2], v1[3]);
                    *(u32x4*)(HB + off + bj * HALF) = w;
                    ss += v0[0] * v0[0] + v0[1] * v0[1] + v0[2] * v0[2] + v0[3] * v0[3] + v1[0] * v1[0] + v1[1] * v1[1] + v1[2] * v1[2] + v1[3] * v1[3]; }
                ss += __shfl_xor(ss, 16); ss += __shfl_xor(ss, 32);
                if (fq == 0) SSQ[(size_t)row * 32 + u.pn * 4 + wc] = ss; }
    }
};
struct EpiF32 {
    static constexpr bool PERM = true, AFTER_DRAIN = false;
    float* C; int ldc;
    __device__ __forceinline__ void operator()(const f32x4 (&acc)[2][2][4][2], const Unit& u, int wr, int wc, int fr, int fq) const {
        const int row0 = u.pm * BM + wr * 64 + fr; const int col0 = u.pn * BM + wc * 32 + 8 * fq;
#pragma unroll
        for (int ai = 0; ai < 2; ++ai)
#pragma unroll
            for (int m = 0; m < 4; ++m) { float* rowp = C + (size_t)(row0 + ai * HALF + m * 16) * ldc + col0;
#pragma unroll
                for (int bj = 0; bj < 2; ++bj) { *(f32x4*)(rowp + bj * HALF) = acc[ai][bj][m][0]; *(f32x4*)(rowp + bj * HALF + 4) = acc[ai][bj][m][1]; } }
    }
};

struct EpiScores {
    static constexpr bool PERM = true, AFTER_DRAIN = true;
    const bf16_t* KEYS;
    float* STOP; int* ITOP;
    static constexpr int QLD = 264;
    __device__ __forceinline__ void fused(f32x4 (&acc)[2][2][4][2], const Unit& u, int wr, int wc, int fr, int fq, PG8_LAS unsigned char* lds, int wid, int lane) const {
        PG8_LAS bf16_t* Q = (PG8_LAS bf16_t*)lds;
#pragma unroll
        for (int ai = 0; ai < 2; ++ai)
#pragma unroll
            for (int m = 0; m < 4; ++m) { const int row = ai * HALF + wr * 64 + m * 16 + fr;
#pragma unroll
                for (int bj = 0; bj < 2; ++bj) { const f32x4 v0 = acc[ai][bj][m][0], v1 = acc[ai][bj][m][1];
                    u32x4 w; w.x = pack_bf16(v0[0], v0[1]); w.y = pack_bf16(v0[2], v0[3]); w.z = pack_bf16(v1[0], v1[1]); w.w = pack_bf16(v1[2], v1[3]);
                    *(PG8_LAS u32x4*)(Q + row * QLD + bj * HALF + wc * 32 + 8 * fq) = w; } }
        __syncthreads();
        const int h = u.pn;
#pragma unroll 1
        for (int c = 0; c < 2; ++c) {
            f32x4 sc[8][2];
#pragma unroll
            for (int kf = 0; kf < 8; ++kf) { sc[kf][0] = (f32x4){0.f, 0.f, 0.f, 0.f}; sc[kf][1] = (f32x4){0.f, 0.f, 0.f, 0.f}; }
            const bf16_t* kb = KEYS + (size_t)((h * 2 + c) * 128 + fr) * 128 + 8 * fq;
            const PG8_LAS bf16_t* qb = Q + (wid * 32 + fr) * QLD + c * 128 + 8 * fq;
#pragma unroll
            for (int ks = 0; ks < 4; ++ks) {
                const bf16x8 q0 = *(const PG8_LAS bf16x8*)(qb + 32 * ks), q1 = *(const PG8_LAS bf16x8*)(qb + 16 * QLD + 32 * ks);
#pragma unroll
                for (int kf = 0; kf < 8; ++kf) { const bf16x8 kv = *(const bf16x8*)(kb + (size_t)kf * 16 * 128 + 32 * ks);
                    sc[kf][0] = __builtin_amdgcn_mfma_f32_16x16x32_bf16(kv, q0, sc[kf][0], 0, 0, 0);
                    sc[kf][1] = __builtin_amdgcn_mfma_f32_16x16x32_bf16(kv, q1, sc[kf][1], 0, 0, 0); }
            }
#pragma unroll
            for (int tf = 0; tf < 2; ++tf) {
                float v[32];
#pragma unroll
                for (int kf = 0; kf < 8; ++kf)
#pragma unroll
                    for (int r = 0; r < 4; ++r) v[kf * 4 + r] = __uint_as_float((__float_as_uint(sc[kf][tf][r]) & 0xffffff80u) | (unsigned)(16 * kf + r));
                const unsigned fqbits = 4u * fq;
                const size_t obase = ((size_t)(u.pm * BM + wid * 32 + tf * 16 + fr) * 16 + h * 2 + c) * 16;
#pragma unroll 1
                for (int r = 0; r < 16; ++r) {
                    float mx = v[0];
#pragma unroll
                    for (int i = 1; i < 32; ++i) mx = fmaxf(mx, v[i]);
                    float cand = __uint_as_float(__float_as_uint(mx) | fqbits);
                    float o = __shfl_xor(cand, 16); cand = fmaxf(cand, o);
                    o = __shfl_xor(cand, 32); cand = fmaxf(cand, o);
                    const unsigned cb = __float_as_uint(cand);
                    const bool mine = (cb & 12u) == fqbits;
                    const float rem = __uint_as_float(cb & ~12u);
#pragma unroll
                    for (int i = 0; i < 32; ++i) v[i] = (mine && v[i] == rem) ? -INFINITY : v[i];
                    if (fq == 0) { STOP[obase + r] = __uint_as_float(cb & 0xffffff80u); ITOP[obase + r] = (int)(cb & 127u); }
                }
            }
        }
    }
};

template <class Epi, class Sched>
__device__ __forceinline__ void gemm_phase(PG8_LAS unsigned char* lds, const Gemm g, const Sched& S, const Epi& E) {
    int tid_ = threadIdx.x; asm volatile("" : "+v"(tid_));
    const int tid = tid_, wid = __builtin_amdgcn_readfirstlane(tid >> 6), lane = tid & 63, wr = wid >> 2, wc = wid & 3, fr = lane & 15, fq = lane >> 4;
    const int K = g.K, nt = K / BK;
    unsigned voffA[2], voffB[2];
#pragma unroll
    for (int i = 0; i < 2; ++i) { int R, C; stage_rc(tid * 16 + i * 8192, R, C); const int Rb = Epi::PERM ? ((R & ~31) + perm32(R & 31)) : R;
        voffA[i] = (unsigned)(R * K + C) * 2u; voffB[i] = (unsigned)(Rb * K + C) * 2u; }
    const size_t kstep = (size_t)(BK * 2);
    const size_t hstep = (size_t)HALF * K * 2;
    const size_t tstep = 2 * hstep;
    const unsigned ldsw = (unsigned)wid * 1024u;
    const int aoff = lds_byte(wr * 64 + fr, fq * 8), boff = lds_byte(wc * 32 + fr, fq * 8);
#define PG8_SA(b, h) (((b) * 2 + (h)) * HTB)
#define PG8_SB(b, h) ((4 + (b) * 2 + (h)) * HTB)
#define PG8_STAGE(bufoff, gbase, voff) do { _Pragma("unroll") for (int _i = 0; _i < 2; ++_i) \
        __builtin_amdgcn_global_load_lds((const unsigned*)((const char*)(gbase) + (voff)[_i]), (PG8_LAS unsigned*)(lds + (bufoff) + ldsw + _i * 8192), 16, 0, 0); } while (0)
#define PG8_LDA(dst, b, h) do { _Pragma("unroll") for (int m = 0; m < 4; ++m) _Pragma("unroll") for (int k = 0; k < 2; ++k) dst[m][k] = *(const PG8_LAS bf16x8*)(lds + PG8_SA(b, h) + aoff + m * 2048 + k * 1024); } while (0)
#define PG8_LDB(dst, b, h) do { _Pragma("unroll") for (int n = 0; n < 2; ++n) _Pragma("unroll") for (int k = 0; k < 2; ++k) dst[n][k] = *(const PG8_LAS bf16x8*)(lds + PG8_SB(b, h) + boff + n * 2048 + k * 1024); } while (0)
#define PG8_MMA(ai, bj, At, Bt) do { __builtin_amdgcn_s_setprio(1); _Pragma("unroll") for (int m = 0; m < 4; ++m) _Pragma("unroll") for (int n = 0; n < 2; ++n) _Pragma("unroll") for (int k = 0; k < 2; ++k) \
        acc[ai][bj][m][n] = __builtin_amdgcn_mfma_f32_16x16x32_bf16(Bt[n][k], At[m][k], acc[ai][bj][m][n], 0, 0, 0); __builtin_amdgcn_s_setprio(0); } while (0)
#define PG8_WAIT_V(n) asm volatile("s_waitcnt vmcnt(" #n ")" ::: "memory")
#define PG8_WAIT_L(n) asm volatile("s_waitcnt lgkmcnt(" #n ")" ::: "memory")
#define PG8_BAR __builtin_amdgcn_s_barrier()
#define PG8_SCHED __builtin_amdgcn_sched_barrier(0)
    Unit cur, nxt; int ui = 0;
    if (!S.next(0, cur)) return;
    f32x4 acc[2][2][4][2];
#pragma unroll
    for (int a = 0; a < 2; ++a)
#pragma unroll
        for (int b = 0; b < 2; ++b)
#pragma unroll
            for (int m = 0; m < 4; ++m)
#pragma unroll
                for (int n = 0; n < 2; ++n) acc[a][b][m][n] = (f32x4){0.f, 0.f, 0.f, 0.f};
    bf16x8 At[4][2], B0[2][2], B1[2][2];
    const char* cA = (const char*)g.A + (size_t)cur.pm * tstep; const char* cB = (const char*)g.Bt + (size_t)cur.pn * tstep;
    S.a_ready(cur);
    PG8_STAGE(PG8_SB(0, 0), cB, voffB); PG8_STAGE(PG8_SA(0, 0), cA, voffA); PG8_STAGE(PG8_SB(0, 1), cB + hstep, voffB); PG8_STAGE(PG8_SA(0, 1), cA + hstep, voffA);
    if (wr == 1) PG8_BAR;
    PG8_WAIT_V(4); PG8_BAR;
    PG8_STAGE(PG8_SB(1, 0), cB + kstep, voffB); PG8_STAGE(PG8_SA(1, 0), cA + kstep, voffA); PG8_STAGE(PG8_SB(1, 1), cB + hstep + kstep, voffB);
    PG8_WAIT_V(6); PG8_BAR;
    for (;;) {
        const bool has_next = S.next(ui + 1, nxt);
        const char* nA = has_next ? (const char*)g.A + (size_t)nxt.pm * tstep : cA; const char* nB = has_next ? (const char*)g.Bt + (size_t)nxt.pn * tstep : cB;
        for (int t = 0; t < nt; t += 2) {
            const bool last = (t == nt - 2);
            const char* a1 = cA + (size_t)(t + 1) * kstep;
            const char* a2 = last ? nA : cA + (size_t)(t + 2) * kstep; const char* b2 = last ? nB : cB + (size_t)(t + 2) * kstep;
            const char* a3 = a2 + kstep; const char* b3 = b2 + kstep;
            if (last && has_next) S.a_ready(nxt);
            PG8_LDB(B0, 0, 0); PG8_SCHED; PG8_LDA(At, 0, 0); PG8_STAGE(PG8_SA(1, 1), a1 + hstep, voffA);
            PG8_WAIT_L(8); PG8_BAR; PG8_WAIT_L(0); PG8_MMA(0, 0, At, B0); PG8_BAR; PG8_SCHED;
            PG8_LDB(B1, 0, 1); PG8_STAGE(PG8_SB(0, 0), b2, voffB);
            PG8_BAR; PG8_WAIT_L(0); PG8_MMA(0, 1, At, B1); PG8_BAR;
            PG8_LDA(At, 0, 1); PG8_STAGE(PG8_SA(0, 0), a2, voffA);
            PG8_BAR; PG8_WAIT_L(0); PG8_MMA(1, 0, At, B0); PG8_BAR; PG8_SCHED;
            PG8_STAGE(PG8_SB(0, 1), b2 + hstep, voffB);
            PG8_WAIT_V(6); PG8_BAR; PG8_MMA(1, 1, At, B1); PG8_BAR;
            PG8_LDB(B0, 1, 0); PG8_SCHED; PG8_LDA(At, 1, 0); PG8_STAGE(PG8_SA(0, 1), a2 + hstep, voffA);
            PG8_WAIT_L(8); PG8_BAR; PG8_WAIT_L(0); PG8_MMA(0, 0, At, B0); PG8_BAR; PG8_SCHED;
            PG8_LDB(B1, 1, 1); PG8_STAGE(PG8_SB(1, 0), b3, voffB);
            PG8_BAR; PG8_WAIT_L(0); PG8_MMA(0, 1, At, B1); PG8_BAR;
            PG8_LDA(At, 1, 1); PG8_STAGE(PG8_SA(1, 0), a3, voffA);
            PG8_BAR; PG8_WAIT_L(0); PG8_MMA(1, 0, At, B0); PG8_BAR; PG8_SCHED;
            PG8_STAGE(PG8_SB(1, 1), b3 + hstep, voffB);
            PG8_WAIT_V(6); PG8_BAR; PG8_MMA(1, 1, At, B1); PG8_BAR;
        }
        if constexpr (!Epi::AFTER_DRAIN) { E(acc, cur, wr, wc, fr, fq); S.done(cur); }
        if (!has_next) break;
#pragma unroll
        for (int a = 0; a < 2; ++a)
#pragma unroll
            for (int b = 0; b < 2; ++b)
#pragma unroll
                for (int m = 0; m < 4; ++m)
#pragma unroll
                    for (int n = 0; n < 2; ++n) acc[a][b][m][n] = (f32x4){0.f, 0.f, 0.f, 0.f};
        cur = nxt; cA = nA; cB = nB; ++ui;
    }
    PG8_WAIT_V(0);
    if (wr == 0) PG8_BAR;
    PG8_BAR;
    if constexpr (Epi::AFTER_DRAIN) { E.fused(acc, cur, wr, wc, fr, fq, lds, wid, lane); S.done(cur); }
#undef PG8_SA
#undef PG8_SB
#undef PG8_STAGE
#undef PG8_LDA
#undef PG8_LDB
#undef PG8_MMA
#undef PG8_WAIT_V
#undef PG8_WAIT_L
#undef PG8_BAR
#undef PG8_SCHED
}
}

#define XB_TMO      128
#define XB_XCNT(j)  (256  + 64 * (j))
#define XB_XSUB(j)  (1280 + 64 * (j))
#define XB_XGEN(j)  (2304 + 64 * (j))
#define XB_TOP      3328
#define XB_TOPGEN   3392
#define XCD_BAR_WORDS 3456
#define XB_SPIN_CAP (1u << 22)
__device__ __forceinline__ unsigned xb_ld(unsigned* p)              { return __hip_atomic_load(p, __ATOMIC_RELAXED, __HIP_MEMORY_SCOPE_AGENT); }
__device__ __forceinline__ unsigned xb_add(unsigned* p, unsigned v) { return __hip_atomic_fetch_add(p, v, __ATOMIC_RELAXED, __HIP_MEMORY_SCOPE_AGENT); }
__device__ __forceinline__ unsigned xb_xcc_id() { return (unsigned)__builtin_amdgcn_s_getreg((3 << 11) | 20) & 0xFu; }
#define XB_SPIN(cond, bar) do { unsigned _sp = 0; while (cond) { __builtin_amdgcn_s_sleep(1); \
    if ((++_sp & 255u) == 0u) { if (xb_ld(&(bar)[XB_TMO])) break; if (_sp > XB_SPIN_CAP) { atomicAdd(&(bar)[XB_TMO], 1u); break; } } } } while (0)
struct XcdBarrier { unsigned* bar; unsigned x; volatile LAS unsigned* st; };
__device__ __forceinline__ XcdBarrier xcd_barrier_post(unsigned* bar, volatile LAS unsigned* st) {
    XcdBarrier b; b.bar = bar; b.x = xb_xcc_id(); b.st = st;
    if (threadIdx.x == 0) (void)xb_add(&bar[XB_XCNT(b.x)], 1u);
    return b;
}
__device__ __forceinline__ void xcd_barrier_complete(unsigned* bar, unsigned x, unsigned& nloc, unsigned& nx) {
    const unsigned G = gridDim.x * gridDim.y * gridDim.z;
    unsigned sum, cnt, mine, sp = 0u;
    for (;;) {
        sum = 0u; cnt = 0u; mine = 0u;
#pragma unroll
        for (unsigned j = 0; j < 16; ++j) { const unsigned c = xb_ld(&bar[XB_XCNT(j)]); sum += c; cnt += (c > 0u) ? 1u : 0u; mine = (j == x) ? c : mine; }
        if (sum == G) break;
        __builtin_amdgcn_s_sleep(1);
        if ((++sp & 255u) == 0u) { if (xb_ld(&bar[XB_TMO])) break; if (sp > XB_SPIN_CAP) { atomicAdd(&bar[XB_TMO], 1u); break; } }
    }
    nloc = mine > 0u ? mine : 1u; nx = cnt > 0u ? cnt : 1u;
}
__device__ __forceinline__ void xcd_barrier(const XcdBarrier& b) {
    asm volatile("s_waitcnt vmcnt(0)" ::: "memory");
    __syncthreads();
    if (threadIdx.x == 0) {
        unsigned* bar = b.bar;
        __builtin_amdgcn_s_waitcnt(0);
        unsigned nloc = b.st[0], nx = b.st[1];
        if (nloc == 0u) { xcd_barrier_complete(bar, b.x, nloc, nx); b.st[0] = nloc; b.st[1] = nx; }
        const unsigned old = xb_add(&bar[XB_XSUB(b.x)], 1u);
        const unsigned gen = old / nloc;
        if (old + 1u == (gen + 1u) * nloc) {
            __builtin_amdgcn_fence(__ATOMIC_RELEASE, "agent");
            asm volatile("s_waitcnt vmcnt(0)" ::: "memory");
            const unsigned og = xb_add(&bar[XB_TOP], 1u);
            const unsigned tg = og / nx;
            if (og + 1u == (tg + 1u) * nx) xb_add(&bar[XB_TOPGEN], 1u);
            else XB_SPIN(xb_ld(&bar[XB_TOPGEN]) == tg, bar);
            __builtin_amdgcn_fence(__ATOMIC_ACQUIRE, "agent");
            xb_add(&bar[XB_XGEN(b.x)], 1u);
            asm volatile("s_waitcnt vmcnt(0)" ::: "memory");
        } else {
            XB_SPIN(xb_ld(&bar[XB_XGEN(b.x)]) == gen, bar);
            __builtin_amdgcn_fence(__ATOMIC_ACQUIRE, "agent");
            asm volatile("s_waitcnt vmcnt(0)" ::: "memory");
        }
    }
    __syncthreads();
}

namespace {
struct Params {
  const float *x, *meta, *rel_bias, *ln_mix, *w_in, *sinks, *conv_w, *conv_b, *dt_bias, *a_log, *d_skip, *attn_norm_w,
      *ssm_norm_w, *w_out, *ln_ffn, *wq, *keys, *U, *V, *ln_final;
  float* out;
  unsigned char* ws;
};

__device__ __forceinline__ void p0_transpose_tile(const float* __restrict__ W, int ldw, bf16_t* __restrict__ Wt, const float* sc0,
                                                  const float* sc1, int k0, int n0, float* tile  ) {
  const int tid = threadIdx.x;
  {
    const int r = tid >> 4, c4 = (tid & 15) * 4;
    const float4 a = *(const float4*)(W + (size_t)(k0 + r) * ldw + n0 + c4);
    const float4 b = *(const float4*)(W + (size_t)(k0 + r + 32) * ldw + n0 + c4);
    float* p = tile + r * 65 + c4;
    p[0] = a.x; p[1] = a.y; p[2] = a.z; p[3] = a.w;
    float* q = tile + (r + 32) * 65 + c4;
    q[0] = b.x; q[1] = b.y; q[2] = b.z; q[3] = b.w;
  }
  __syncthreads();
  {
    const int n = tid >> 3, kc = (tid & 7) * 8;
    float v[8];
#pragma unroll
    for (int j = 0; j < 8; ++j) {
      float s = 1.f;
      const int k = k0 + kc + j;
      if (sc0) s = k < 1024 ? sc0[k] : sc1[k - 1024];
      v[j] = tile[(kc + j) * 65 + n] * s;
    }
    u32x4 w; w.x = pack_bf16(v[0], v[1]); w.y = pack_bf16(v[2], v[3]); w.z = pack_bf16(v[4], v[5]); w.w = pack_bf16(v[6], v[7]);
    *(u32x4*)(Wt + (size_t)(n0 + n) * DM + k0 + kc) = w;
  }
  __syncthreads();
}

__device__ __forceinline__ void phase0(const Params& p, float* ldsf, int bid, int nblk) {
  const int tid = threadIdx.x, lane = tid & 63, wid = tid >> 6;
  bf16_t* w_inT = (bf16_t*)(p.ws + WS_WINT);
  bf16_t* w_dtT = (bf16_t*)(p.ws + WS_WDTT);
  bf16_t* w_outT = (bf16_t*)(p.ws + WS_WOUTT);
  bf16_t* wqT = (bf16_t*)(p.ws + WS_WQT);
  bf16_t* keysb = (bf16_t*)(p.ws + WS_KEYS);
  unsigned char* ub = p.ws + WS_UB;
  unsigned char* vb = p.ws + WS_VB;
  bf16_t* hnb = (bf16_t*)(p.ws + WS_HNB);
  constexpr int U_HN = (TA + 7) / 8;
  constexpr int U_WIN = 32 * 64, U_WOUT = 32 * 32, U_WQ = 32 * 32, U_WDT = 1, U_KEYS = 64, U_U = NEXP / 8, U_V = NEXP / 8;
  constexpr int B_WIN = U_HN, B_WOUT = B_WIN + U_WIN, B_WQ = B_WOUT + U_WOUT, B_WDT = B_WQ + U_WQ, B_KEYS = B_WDT + U_WDT,
                B_U = B_KEYS + U_KEYS, B_V = B_U + U_U, B_END = B_V + U_V;
  for (int u = bid; u < B_END; u += nblk) {
    if (u < B_WIN) {
      const int t = u * 8 + wid;
      if (t < TA) {
        const float* src = t < T ? p.x + (size_t)t * DM : p.meta + (size_t)(t - T) * DM;
        float4 v[8];
        float ss = 0.f;
#pragma unroll
        for (int i = 0; i < 8; ++i) {
          v[i] = *(const float4*)(src + (i * 64 + lane) * 4);
          ss += v[i].x * v[i].x + v[i].y * v[i].y + v[i].z * v[i].z + v[i].w * v[i].w;
        }
        ss = wave_sum(ss);
        const float r = rsqrtf(ss * (1.f / DM) + EPS);
#pragma unroll
        for (int i = 0; i < 8; ++i) {
          const float4 w = *(const float4*)(p.ln_mix + (i * 64 + lane) * 4);
          u32x2 o; o.x = pack_bf16(v[i].x * r * w.x, v[i].y * r * w.y); o.y = pack_bf16(v[i].z * r * w.z, v[i].w * r * w.w);
          *(u32x2*)(hnb + (size_t)t * DM + (i * 64 + lane) * 4) = o;
        }
      }
    } else if (u < B_WOUT) {
      const int i = u - B_WIN;
      p0_transpose_tile(p.w_in, DPROJ, w_inT, nullptr, nullptr, (i & 31) * 64, (i >> 5) * 64, ldsf);
    } else if (u < B_WQ) {
      const int i = u - B_WOUT;
      p0_transpose_tile(p.w_out, DM, w_outT, p.attn_norm_w, p.ssm_norm_w, (i & 31) * 64, (i >> 5) * 64, ldsf);
    } else if (u < B_WDT) {
      const int i = u - B_WQ;
      p0_transpose_tile(p.wq, DM, wqT, p.ln_ffn, p.ln_ffn + 1024, (i & 31) * 64, (i >> 5) * 64, ldsf);
    } else if (u < B_KEYS) {
      for (int idx = tid; idx < DM * 16; idx += NTHREADS) {
        const int k = idx >> 4, j = idx & 15;
        w_dtT[(size_t)j * DM + k] = f2bf(p.w_in[(size_t)k * DPROJ + NPROJ + j]);
      }
    } else if (u < B_U) {
      const size_t base = (size_t)(u - B_KEYS) * 4096 + (size_t)tid * 8;
      const float4 a = *(const float4*)(p.keys + base), b = *(const float4*)(p.keys + base + 4);
      u32x4 w; w.x = pack_bf16(a.x, a.y); w.y = pack_bf16(a.z, a.w); w.z = pack_bf16(b.x, b.y); w.w = pack_bf16(b.z, b.w);
      *(u32x4*)(keysb + base) = w;
    } else {
      const bool isU = u < B_V;
      const int row = (isU ? (u - B_U) : (u - B_V)) * 8 + wid;
      const float* src = (isU ? p.U : p.V) + (size_t)row * DM + lane * 32;
      f32x4 a[8];
#pragma unroll
      for (int j = 0; j < 8; ++j) a[j] = *(const f32x4*)(src + 4 * j);
      if (isU) {
#pragma unroll
        for (int j = 0; j < 8; ++j) a[j] *= *(const f32x4*)(p.ln_ffn + lane * 32 + 4 * j);
      }
      float amax = 0.f;
#pragma unroll
      for (int j = 0; j < 8; ++j) amax = fmaxf(amax, fmaxf(fmaxf(fabsf(a[j][0]), fabsf(a[j][1])), fmaxf(fabsf(a[j][2]), fabsf(a[j][3]))));
      amax = wave_max(amax);
      const float scl = amax > 0.f ? 7.5f / amax : 1.f;
      f32x16v v0, v1;
#pragma unroll
      for (int j = 0; j < 8; ++j) {
        v0[2 * j + 0] = a[j][0] * scl; v1[2 * j + 0] = a[j][1] * scl; v0[2 * j + 1] = a[j][2] * scl; v1[2 * j + 1] = a[j][3] * scl;
      }
      const u32x6 pk = __builtin_amdgcn_cvt_scalef32_2xpk16_fp6_f32(v0, v1, 1.0f);
      unsigned char* dst = (isU ? ub : vb) + (size_t)row * ROW6;
      *(u32x4*)(dst + lane * 16) = (u32x4){pk[0], pk[1], pk[2], pk[3]};
      *(u32x2*)(dst + 1024 + lane * 8) = (u32x2){pk[4], pk[5]};
      if (lane == 0) ((float*)(p.ws + (isU ? WS_USC : WS_VSC)))[row] = amax > 0.f ? amax * (1.f / 7.5f) : 1.f;
    }
  }
}

__device__ __forceinline__ void mini_gemm(const bf16_t* __restrict__ A, const bf16_t* __restrict__ Bt, float* __restrict__ out, int ldo,
                                          float* red, bf16_t* __restrict__ outb = nullptr) {
  const int tid = threadIdx.x, lane = tid & 63, wid = tid >> 6, fr = lane & 15, fq = lane >> 4;
  f32x4 acc = {0.f, 0.f, 0.f, 0.f};
  const bf16_t* ap = A + (size_t)fr * DM + wid * 256 + fq * 8;
  const bf16_t* bp = Bt + (size_t)fr * DM + wid * 256 + fq * 8;
#pragma unroll
  for (int ks = 0; ks < 8; ++ks) {
    const bf16x8 a = *(const bf16x8*)(ap + ks * 32);
    const bf16x8 b = *(const bf16x8*)(bp + ks * 32);
    acc = __builtin_amdgcn_mfma_f32_16x16x32_bf16(a, b, acc, 0, 0, 0);
  }
#pragma unroll
  for (int r = 0; r < 4; ++r) red[wid * 256 + (4 * fq + r) * 16 + fr] = acc[r];
  __syncthreads();
  if (tid < 256) {
    float s = 0.f;
#pragma unroll
    for (int w = 0; w < 8; ++w) s += red[w * 256 + tid];
    out[(size_t)(tid >> 4) * ldo + (tid & 15)] = s;
    if (outb) outb[(size_t)(tid >> 4) * ldo + (tid & 15)] = f2bf(s);
  }
  __syncthreads();
}

__device__ __forceinline__ void phase1(const Params& p, unsigned char* lds, int bid, int nblk) {
  const bf16_t* hnb = (const bf16_t*)(p.ws + WS_HNB);
  const bf16_t* w_inT = (const bf16_t*)(p.ws + WS_WINT);
  const bf16_t* w_dtT = (const bf16_t*)(p.ws + WS_WDTT);
  float* dtraw = (float*)(p.ws + WS_DTRAW);
  float* projm = (float*)(p.ws + WS_PROJM);
  constexpr int NU = 512 + 32 + 96 + 1;
  for (int u = bid; u < NU; u += nblk) {
    if (u < 512) {
      mini_gemm(hnb + (size_t)u * 16 * DM, w_dtT, dtraw + (size_t)u * 16 * 16, 16, (float*)lds);
    } else {
      const int j = u - 512;
      const int cf = j < 32 ? 64 + j : (j < 128 ? 160 + (j - 32) : 256);
      const bf16_t* bt = cf < 256 ? w_inT + (size_t)cf * 16 * DM : w_dtT;
      mini_gemm(hnb + (size_t)T * DM, bt, projm + cf * 16, DPROJ, (float*)lds, (bf16_t*)(p.ws + WS_PROJMB) + cf * 16);
    }
  }
  pg8::Gemm g{hnb, w_inT, T, NPROJ, DM};
  pg8::StaticOrder S; S.init(T, NPROJ, nblk, bid);
  pg8::EpiBf16 E{(bf16_t*)(p.ws + WS_PROJ), NPROJ};
  pg8::gemm_phase<pg8::EpiBf16, pg8::StaticOrder>((PG8_LAS unsigned char*)lds, g, S, E);
}

__device__ __forceinline__ void phase4(const Params& p, unsigned char* lds, int bid, int nblk) {
  pg8::Gemm g{(const bf16_t*)(p.ws + WS_HNB), (const bf16_t*)(p.ws + WS_WOUTT), T, DM, DM};
  pg8::StaticOrder S; S.init(T, DM, nblk, bid);
  pg8::EpiRes E{p.x, (bf16_t*)(p.ws + WS_H1B), (float*)(p.ws + WS_SSQH1)};
  pg8::gemm_phase<pg8::EpiRes, pg8::StaticOrder>((PG8_LAS unsigned char*)lds, g, S, E);
}
__device__ __forceinline__ void phase5(const Params& p, unsigned char* lds, int bid, int nblk) {
  pg8::Gemm g{(const bf16_t*)(p.ws + WS_H1B), (const bf16_t*)(p.ws + WS_WQT), T, DM, DM};
  pg8::StaticOrder S; S.init(T, DM, nblk, bid);
  pg8::EpiScores E{(const bf16_t*)(p.ws + WS_KEYS), (float*)(p.ws + WS_STOP), (int*)(p.ws + WS_ITOP)};
  pg8::gemm_phase<pg8::EpiScores, pg8::StaticOrder>((PG8_LAS unsigned char*)lds, g, S, E);
}

__device__ __forceinline__ float dot2bf(unsigned a, unsigned b, float c) {
  return __builtin_amdgcn_fdot2_f32_bf16(*(bf16v2*)&a, *(bf16v2*)&b, c, false);
}
__device__ __forceinline__ void phase6(const Params& p, unsigned char* lds, int bid, int nblk) {
  const int tid0 = threadIdx.x, lane0 = tid0 & 63, wid = __builtin_amdgcn_readfirstlane(tid0 >> 6);
  float* red = (float*)lds;
  float* gts = (float*)(lds + 65536);
  int* ids = (int*)(lds + 65536 + 512);
  float* wts = (float*)(lds + 65536 + 1024);
  float* red2 = (float*)(lds + 65536 + 1536);
  const unsigned char* ub = p.ws + WS_UB;
  const unsigned char* vb = p.ws + WS_VB;
  const bf16_t* h1b = (const bf16_t*)(p.ws + WS_H1B);
  const float* usc = (const float*)(p.ws + WS_USC);
  const float* vsc = (const float*)(p.ws + WS_VSC);
  const float* ssq = (const float*)(p.ws + WS_SSQH1);
  const float* stop = (const float*)(p.ws + WS_STOP);
  const int* itop = (const int*)(p.ws + WS_ITOP);
  const int ci = kCandI[lane0], cj = kCandJ[lane0];
  for (int t = bid; t < T; t += nblk) {
    int tid = tid0; asm volatile("" : "+v"(tid));
    const int lane = tid & 63;
    const int kcode = 8 * ((lane >> 2) & 1) + 4 * ((lane >> 3) & 1) + 2 * ((lane >> 4) & 1) + ((lane >> 5) & 1);
    const float part0 = lane < 32 ? ssq[(size_t)t * 32 + lane] : 0.f;
    const float rr = rsqrtf(wave_sum(part0) * (1.f / DM) + EPS);
    const size_t lbase = ((size_t)t * 16 + wid * 2) * 16;
    const float sv = lane < 32 ? stop[lbase + lane] : 0.f;
    const int iv = lane < 32 ? itop[lbase + lane] : 0;
    float cand = (__shfl(sv, ci) + __shfl(sv, 16 + cj)) * rr;
    if (lane >= 50) cand = -INFINITY;
    unsigned key = __float_as_uint(cand);
    key = (key & 0x80000000u) ? ~key : (key | 0x80000000u);
    key = (key & ~63u) | (unsigned)(63 - lane);
    int rank = 0;
#pragma unroll
    for (int k = 0; k < 50; ++k) {
      const unsigned kk = (unsigned)__builtin_amdgcn_readlane((int)key, k);
      rank += kk > key ? 1 : 0;
    }
    const float cmax = wave_max(cand);
    const float ex = rank < 16 ? __expf(cand - cmax) : 0.f;
    const float den = wave_sum(ex);
    const int eidx = __shfl(iv, ci) * 128 + __shfl(iv, 16 + cj);
    if (rank < 16) { ids[wid * 16 + rank] = eidx; gts[wid * 16 + rank] = ex / den; }
    float xf[32];
    {
      const bf16_t* xp = h1b + (size_t)t * DM + lane * 32;
#pragma unroll
      for (int j = 0; j < 4; ++j) {
        const u32x4 xa = *(const u32x4*)(xp + 8 * j);
        xf[8 * j + 0] = bflo(xa.x); xf[8 * j + 1] = bfhi(xa.x); xf[8 * j + 2] = bflo(xa.y); xf[8 * j + 3] = bfhi(xa.y);
        xf[8 * j + 4] = bflo(xa.z); xf[8 * j + 5] = bfhi(xa.z); xf[8 * j + 6] = bflo(xa.w); xf[8 * j + 7] = bfhi(xa.w);
      }
    }
    float part[16];
    {
      u32x4 ra[16]; u32x2 rb[16];
#pragma unroll
      for (int k = 0; k < 16; ++k) {
        const int e = __builtin_amdgcn_readfirstlane(ids[wid * 16 + k]);
        const unsigned char* rp = ub + (size_t)e * ROW6;
        ra[k] = *(const u32x4*)(rp + lane * 16); rb[k] = *(const u32x2*)(rp + 1024 + lane * 8);
      }
      float prev = 0.f;
#pragma unroll
      for (int k = 0; k < 16; ++k) {
        asm volatile("" : "+v"(ra[k]), "+v"(rb[k]) : "v"(prev));
        const u32x6 pk = {ra[k].x, ra[k].y, ra[k].z, ra[k].w, rb[k].x, rb[k].y};
        const f32x32v r = __builtin_amdgcn_cvt_scalef32_pk32_f32_fp6(pk, 1.0f);
        float d0 = 0.f, d1 = 0.f;
#pragma unroll
        for (int i = 0; i < 32; i += 2) { d0 = fmaf(r[i], xf[i], d0); d1 = fmaf(r[i + 1], xf[i + 1], d1); }
        prev = d0 + d1;
        part[k] = prev;
      }
    }
    float q8[8], q4[4], q2[2], q1;
    { const bool hi = (lane >> 5) & 1;
#pragma unroll
      for (int i = 0; i < 8; ++i) { const float keep = hi ? part[2 * i + 1] : part[2 * i], send = hi ? part[2 * i] : part[2 * i + 1]; q8[i] = keep + __shfl_xor(send, 32); } }
    { const bool hi = (lane >> 4) & 1;
#pragma unroll
      for (int i = 0; i < 4; ++i) { const float keep = hi ? q8[2 * i + 1] : q8[2 * i], send = hi ? q8[2 * i] : q8[2 * i + 1]; q4[i] = keep + __shfl_xor(send, 16); } }
    { const bool hi = (lane >> 3) & 1;
#pragma unroll
      for (int i = 0; i < 2; ++i) { const float keep = hi ? q4[2 * i + 1] : q4[2 * i], send = hi ? q4[2 * i] : q4[2 * i + 1]; q2[i] = keep + __shfl_xor(send, 8); } }
    { const bool hi = (lane >> 2) & 1;
      const float keep = hi ? q2[1] : q2[0], send = hi ? q2[0] : q2[1]; q1 = keep + __shfl_xor(send, 4); }
    q1 += __shfl_xor(q1, 2);
    q1 += __shfl_xor(q1, 1);
    {
      const int eid = ids[wid * 16 + kcode];
      const float a = q1 * rr * usc[eid];
      const float ge = 0.5f * a * (1.f + erff(a * 0.70710678118654752f));
      if ((lane & 3) == 0) wts[wid * 16 + kcode] = gts[wid * 16 + kcode] * ge * vsc[eid];
    }
    float acc[32];
#pragma unroll
    for (int i = 0; i < 32; ++i) acc[i] = 0.f;
    {
      u32x4 ra[16]; u32x2 rb[16];
#pragma unroll
      for (int k = 0; k < 16; ++k) {
        const int e = __builtin_amdgcn_readfirstlane(ids[wid * 16 + k]);
        const unsigned char* rp = vb + (size_t)e * ROW6;
        ra[k] = *(const u32x4*)(rp + lane * 16); rb[k] = *(const u32x2*)(rp + 1024 + lane * 8);
      }
#pragma unroll
      for (int k = 0; k < 16; ++k) {
        const float wk = wts[wid * 16 + k];
        asm volatile("" : "+v"(ra[k]), "+v"(rb[k]) : "v"(acc[0]), "v"(acc[15]), "v"(acc[16]), "v"(acc[31]));
        const u32x6 pk = {ra[k].x, ra[k].y, ra[k].z, ra[k].w, rb[k].x, rb[k].y};
        const f32x32v r = __builtin_amdgcn_cvt_scalef32_pk32_f32_fp6(pk, 1.0f);
#pragma unroll
        for (int i = 0; i < 32; ++i) acc[i] = fmaf(wk, r[i], acc[i]);
      }
    }
#pragma unroll
    for (int j = 0; j < 8; ++j) *(f32x4*)(red + ((wid * 8 + j) * 64 + lane) * 4) = (f32x4){acc[4 * j], acc[4 * j + 1], acc[4 * j + 2], acc[4 * j + 3]};
    __syncthreads();
    {
      const int col = 32 * lane + 4 * wid;
      const u32x2 hb = *(const u32x2*)(h1b + (size_t)t * DM + col);
      f32x4 s = {bflo(hb.x), bfhi(hb.x), bflo(hb.y), bfhi(hb.y)};
#pragma unroll
      for (int w = 0; w < 8; ++w) s += *(const f32x4*)(red + ((w * 8 + wid) * 64 + lane) * 4);
      float ss = wave_sum(s[0] * s[0] + s[1] * s[1] + s[2] * s[2] + s[3] * s[3]);
      if (lane == 0) red2[wid] = ss;
      __syncthreads();
      float tot = 0.f;
#pragma unroll
      for (int w = 0; w < 8; ++w) tot += red2[w];
      const float rf = rsqrtf(tot * (1.f / DM) + EPS);
      const f32x4 lw = *(const f32x4*)(p.ln_final + col);
      *(f32x4*)(p.out + (size_t)t * DM + col) = s * rf * lw;
    }
    __syncthreads();
  }
}

typedef float f32x16 __attribute__((ext_vector_type(16)));
constexpr int VT_LD = 196;
constexpr int ATT_VT_BYTES = 4 * 64 * VT_LD * 2;
__device__ __forceinline__ void attn_item(const Params& p, unsigned char* lds, int item) {
  const int tid = threadIdx.x, lane = tid & 63, wid = __builtin_amdgcn_readfirstlane(tid >> 6);
  const int b = item >> 6, q0 = (item & 63) * 32;
  bf16_t* VT = (bf16_t*)lds;
  float* biasL = (float*)(lds + ATT_VT_BYTES);
  float* ssqw = biasL + 16 * 132;
  const bf16_t* proj = (const bf16_t*)(p.ws + WS_PROJ);
  const float* projm = (const float*)(p.ws + WS_PROJM);
  bf16_t* mixin = (bf16_t*)(p.ws + WS_HNB);
  for (int idx = tid; idx < 16 * 129; idx += NTHREADS) {
    const int hq = idx / 129, d = idx - hq * 129;
    const int bk = d < 128 ? (int)kBucket[d] : 31;
    biasL[hq * 132 + d] = p.rel_bias[bk * 16 + hq];
  }
#pragma unroll 1
  for (int task = tid; task < 96 * 32; task += NTHREADS) {
    const int pi = task >> 5, ch = task & 31, slot0 = 2 * pi;
    float v0[8], v1[8];
    if (slot0 < 16) {
      const float* r0 = projm + (size_t)slot0 * DPROJ + OFF_V + ch * 8;
      const float* r1 = r0 + DPROJ;
#pragma unroll
      for (int i = 0; i < 8; ++i) { v0[i] = r0[i]; v1[i] = r1[i]; }
    } else if (slot0 < 32) {
#pragma unroll
      for (int i = 0; i < 8; ++i) { v0[i] = 0.f; v1[i] = 0.f; }
    } else {
      const int s0 = q0 - 128 + slot0 - 32;
      if (s0 < 0) {
#pragma unroll
        for (int i = 0; i < 8; ++i) { v0[i] = 0.f; v1[i] = 0.f; }
      } else {
        const bf16_t* r0 = proj + (size_t)(b * SEQ + s0) * NPROJ + OFF_V + ch * 8;
        const u32x4 a = *(const u32x4*)r0, c = *(const u32x4*)(r0 + NPROJ);
        v0[0] = bflo(a.x); v0[1] = bfhi(a.x); v0[2] = bflo(a.y); v0[3] = bfhi(a.y); v0[4] = bflo(a.z); v0[5] = bfhi(a.z); v0[6] = bflo(a.w); v0[7] = bfhi(a.w);
        v1[0] = bflo(c.x); v1[1] = bfhi(c.x); v1[2] = bflo(c.y); v1[3] = bfhi(c.y); v1[4] = bflo(c.z); v1[5] = bfhi(c.z); v1[6] = bflo(c.w); v1[7] = bfhi(c.w);
      }
    }
    bf16_t* dst = VT + (size_t)((ch >> 3) * 64 + (ch & 7) * 8) * VT_LD + slot0;
#pragma unroll
    for (int i = 0; i < 8; ++i) *(unsigned*)(dst + i * VT_LD) = pack_bf16(v0[i], v1[i]);
  }
  __syncthreads();
  const int ql = lane & 31, hh = lane >> 5, kvh = wid >> 1;
  const int trow = b * SEQ + q0 + ql;
  float ssq = 0.f;
#pragma unroll 1
  for (int hsel = 0; hsel < 2; ++hsel) {
    const int hq = 2 * wid + hsel;
    bf16x8 qf[4];
#pragma unroll
    for (int ks = 0; ks < 4; ++ks) qf[ks] = *(const bf16x8*)(proj + (size_t)trow * NPROJ + OFF_Q + hq * 64 + ks * 16 + hh * 8);
    f32x16 sacc[6];
#pragma unroll
    for (int jt = 0; jt < 6; ++jt) {
      f32x16 acc;
#pragma unroll
      for (int r = 0; r < 16; ++r) acc[r] = 0.f;
      if (jt == 0) {
        const float* kr = projm + (size_t)(ql & 15) * DPROJ + OFF_K + kvh * 64 + hh * 8;
#pragma unroll
        for (int ks = 0; ks < 4; ++ks) {
          const f32x4 a = *(const f32x4*)(kr + ks * 16), c = *(const f32x4*)(kr + ks * 16 + 4);
          u32x4 w; w.x = pack_bf16(a[0], a[1]); w.y = pack_bf16(a[2], a[3]); w.z = pack_bf16(c[0], c[1]); w.w = pack_bf16(c[2], c[3]);
          acc = __builtin_amdgcn_mfma_f32_32x32x16_bf16(*(bf16x8*)&w, qf[ks], acc, 0, 0, 0);
        }
      } else {
        int sp = q0 - 128 + 32 * (jt - 1) + ql;
        sp = sp < 0 ? 0 : sp;
        const bf16_t* kr = proj + (size_t)(b * SEQ + sp) * NPROJ + OFF_K + kvh * 64 + hh * 8;
#pragma unroll
        for (int ks = 0; ks < 4; ++ks) acc = __builtin_amdgcn_mfma_f32_32x32x16_bf16(*(const bf16x8*)(kr + ks * 16), qf[ks], acc, 0, 0, 0);
      }
      sacc[jt] = acc;
      asm volatile("" ::: "memory");
    }
    const float* bl = biasL + hq * 132;
    int sq = q0 + ql, qh = ql - 4 * hh;
    asm volatile("" : "+v"(sq), "+v"(qh));
    const float sink = p.sinks[hq];
    float m = sink;
#pragma unroll
    for (int jt = 0; jt < 6; ++jt) {
      asm volatile("" ::: "memory");
#pragma unroll
      for (int r = 0; r < 16; ++r) {
        const int kr = (r & 3) + 8 * (r >> 2) + 4 * hh;
        int dist; bool valid;
        if (jt == 0) { dist = sq + (16 - ((r & 3) + 8 * (r >> 2))) - 4 * hh; valid = kr < 16; }
        else { dist = qh + (128 - 32 * (jt - 1) - ((r & 3) + 8 * (r >> 2))); valid = (dist >= 0) && (dist < 128) && (dist <= sq); }
        const int dc = dist < 0 ? 0 : (dist > 128 ? 128 : dist);
        const float l = valid ? 0.125f * sacc[jt][r] + bl[dc] : -1e30f;
        sacc[jt][r] = l;
        m = fmaxf(m, l);
      }
    }
    m = fmaxf(m, __shfl_xor(m, 32));
    float sum = 0.f;
    f32x16 oacc0, oacc1;
#pragma unroll
    for (int r = 0; r < 16; ++r) { oacc0[r] = 0.f; oacc1[r] = 0.f; }
    const bf16_t* vrow0 = VT + (size_t)(kvh * 64 + ql) * VT_LD + 4 * hh;
    const bf16_t* vrow1 = vrow0 + 32 * VT_LD;
#pragma unroll
    for (int jt = 0; jt < 6; ++jt) {
      u32x4 pw[2];
#pragma unroll
      for (int s2 = 0; s2 < 2; ++s2) {
        float e[8];
#pragma unroll
        for (int i = 0; i < 8; ++i) { e[i] = __expf(sacc[jt][8 * s2 + i] - m); sum += e[i]; }
        pw[s2].x = pack_bf16(e[0], e[1]); pw[s2].y = pack_bf16(e[2], e[3]); pw[s2].z = pack_bf16(e[4], e[5]); pw[s2].w = pack_bf16(e[6], e[7]);
      }
#pragma unroll
      for (int s2 = 0; s2 < 2; ++s2) {
        const u32x2 va = *(const u32x2*)(vrow0 + 32 * jt + 16 * s2), vc = *(const u32x2*)(vrow0 + 32 * jt + 16 * s2 + 8);
        const u32x2 vd = *(const u32x2*)(vrow1 + 32 * jt + 16 * s2), ve = *(const u32x2*)(vrow1 + 32 * jt + 16 * s2 + 8);
        u32x4 v0w; v0w.x = va.x; v0w.y = va.y; v0w.z = vc.x; v0w.w = vc.y;
        u32x4 v1w; v1w.x = vd.x; v1w.y = vd.y; v1w.z = ve.x; v1w.w = ve.y;
        oacc0 = __builtin_amdgcn_mfma_f32_32x32x16_bf16(*(bf16x8*)&v0w, *(bf16x8*)&pw[s2], oacc0, 0, 0, 0);
        oacc1 = __builtin_amdgcn_mfma_f32_32x32x16_bf16(*(bf16x8*)&v1w, *(bf16x8*)&pw[s2], oacc1, 0, 0, 0);
      }
    }
    sum += __shfl_xor(sum, 32);
    const float inv = 1.f / (sum + __expf(sink - m));
#pragma unroll
    for (int r = 0; r < 16; ++r) { oacc0[r] *= inv; oacc1[r] *= inv; ssq += oacc0[r] * oacc0[r] + oacc1[r] * oacc1[r]; }
#pragma unroll
    for (int rg = 0; rg < 4; ++rg) {
      u32x2 w; w.x = pack_bf16(oacc0[rg * 4 + 0], oacc0[rg * 4 + 1]); w.y = pack_bf16(oacc0[rg * 4 + 2], oacc0[rg * 4 + 3]);
      *(u32x2*)(mixin + (size_t)trow * DM + hq * 64 + 8 * rg + 4 * hh) = w;
      u32x2 w1; w1.x = pack_bf16(oacc1[rg * 4 + 0], oacc1[rg * 4 + 1]); w1.y = pack_bf16(oacc1[rg * 4 + 2], oacc1[rg * 4 + 3]);
      *(u32x2*)(mixin + (size_t)trow * DM + hq * 64 + 32 + 8 * rg + 4 * hh) = w1;
    }
  }
  ssq += __shfl_xor(ssq, 32);
  if (lane < 32) ssqw[wid * 32 + lane] = ssq;
  __syncthreads();
  float tot = 0.f;
#pragma unroll
  for (int w = 0; w < 8; ++w) tot += ssqw[w * 32 + ql];
  const float ra = rsqrtf(tot * (1.f / 1024) + EPS);
#pragma unroll
  for (int hsel = 0; hsel < 2; ++hsel)
#pragma unroll
    for (int dt = 0; dt < 2; ++dt)
#pragma unroll
      for (int rg = 0; rg < 4; ++rg) {
        bf16_t* op = mixin + (size_t)trow * DM + (2 * wid + hsel) * 64 + 32 * dt + 8 * rg + 4 * hh;
        const u32x2 v = *(const u32x2*)op;
        u32x2 w; w.x = pack_bf16(bflo(v.x) * ra, bfhi(v.x) * ra); w.y = pack_bf16(bflo(v.y) * ra, bfhi(v.y) * ra);
        *(u32x2*)op = w;
      }
  __syncthreads();
}
__device__ __forceinline__ void phase2_attn(const Params& p, unsigned char* lds, int bid, int nblk) {
  for (int item = bid; item < 256; item += nblk) attn_item(p, lds, item);
}

constexpr int SLD = 136;
__device__ __forceinline__ void unpack8(const u32x4 a, float (&v)[8]) {
  v[0] = bflo(a.x); v[1] = bfhi(a.x); v[2] = bflo(a.y); v[3] = bfhi(a.y); v[4] = bflo(a.z); v[5] = bfhi(a.z); v[6] = bflo(a.w); v[7] = bfhi(a.w);
}
__device__ __forceinline__ float conv_silu(const float (&raw)[11], int i, float w0, float w1, float w2, float w3, float cb) {
  return silu_f(cb + w0 * raw[i] + w1 * raw[i + 1] + w2 * raw[i + 2] + w3 * raw[i + 3]);
}
__device__ __forceinline__ void ssd_a_item(const Params& p, unsigned char* lds, int item) {
  const int tid = threadIdx.x, lane = tid & 63, wid = __builtin_amdgcn_readfirstlane(tid >> 6);
  const int b = item >> 6, c = (item >> 2) & 15, g = (item >> 1) & 1, hsel = item & 1;
  const int h0 = g * 8 + hsel * 4;
  const int t0 = b * SEQ + c * 128;
  bf16_t* Bc = (bf16_t*)lds;
  bf16_t* Cc = Bc + 128 * SLD;
  bf16_t* BcT = Cc + 128 * SLD;
  bf16_t* xT = BcT + 128 * SLD;
  float* dtl = (float*)(xT + 2 * 64 * SLD);
  float* acs = dtl + 512;
  float* wl = acs + 512;
  float* scan = wl + 512;
  const bf16_t* __restrict__ proj = (const bf16_t*)(p.ws + WS_PROJ);
  const bf16_t* __restrict__ projmb = (const bf16_t*)(p.ws + WS_PROJMB);
  const float* __restrict__ dtraw = (const float*)(p.ws + WS_DTRAW);
  float* __restrict__ acsg = (float*)(p.ws + WS_ACSG);
  bf16_t* __restrict__ ccb = (bf16_t*)(p.ws + WS_CCB);
  float* __restrict__ ypart = (float*)(p.ws + WS_YPART);
  float* __restrict__ sg = (float*)(p.ws + WS_SG);
  {
    const int hi = tid >> 7, l = tid & 127, h = h0 + hi;
    const float Ah = -expf(p.a_log[h]);
    const float dtv = softplus_f(dtraw[(size_t)(t0 + l) * 16 + h] + p.dt_bias[h]);
    dtl[tid] = dtv;
    float cum = dtv * Ah;
#pragma unroll
    for (int o = 1; o < 64; o <<= 1) { const float nb = __shfl_up(cum, o); if (lane >= o) cum += nb; }
    if ((tid & 127) == 63) scan[hi] = cum;
    __syncthreads();
    if (l >= 64) cum += scan[hi];
    acs[tid] = cum;
    acsg[(size_t)(t0 + l) * 16 + h] = cum;
    __syncthreads();
    wl[tid] = dtv * __expf(acs[hi * 128 + 127] - cum);
  }
#pragma unroll 1
  for (int rnd = 0; rnd < 2; ++rnd) {
    float raw[4][11];
#pragma unroll
    for (int q = 0; q < 4; ++q) {
      const int task = (rnd * 4 + q) * NTHREADS + tid;
      const int tg = task >> 8, ch = task & 255;
      const int cch = 1024 + (ch >> 7) * 256 + g * 128 + (ch & 127);
#pragma unroll
      for (int i = 0; i < 11; ++i) {
        const int l = tg * 8 + i - 3;
        const bf16_t* src = (l >= 0 || c > 0) ? proj + (size_t)(t0 + l) * NPROJ : projmb + (size_t)(16 + l) * DPROJ;
        raw[q][i] = bf2f(src[OFF_XBC + cch]);
      }
    }
#pragma unroll
    for (int q = 0; q < 4; ++q) {
      const int task = (rnd * 4 + q) * NTHREADS + tid;
      const int tg = task >> 8, ch = task & 255, n = ch & 127;
      const int cch = 1024 + (ch >> 7) * 256 + g * 128 + n;
      const float w0 = p.conv_w[cch], w1 = p.conv_w[D_XBC + cch], w2 = p.conv_w[2 * D_XBC + cch], w3 = p.conv_w[3 * D_XBC + cch], cb = p.conv_b[cch];
      float o[8];
#pragma unroll
      for (int i = 0; i < 8; ++i) o[i] = conv_silu(raw[q], i, w0, w1, w2, w3, cb);
      if (ch < 128) {
#pragma unroll
        for (int i = 0; i < 8; ++i) Bc[(tg * 8 + i) * SLD + n] = f2bf(o[i]);
        u32x4 w; w.x = pack_bf16(o[0], o[1]); w.y = pack_bf16(o[2], o[3]); w.z = pack_bf16(o[4], o[5]); w.w = pack_bf16(o[6], o[7]);
        *(u32x4*)(BcT + n * SLD + tg * 8) = w;
      } else {
#pragma unroll
        for (int i = 0; i < 8; ++i) Cc[(tg * 8 + i) * SLD + n] = f2bf(o[i]);
      }
    }
  }
  float xraw[2][11];
#define SSD_LOAD_X(hi_)                                                                                             \
  _Pragma("unroll") for (int q = 0; q < 2; ++q) {                                                                   \
    const int task = q * NTHREADS + tid; const int tg = task >> 6, cch = (h0 + (hi_)) * 64 + (task & 63);           \
    _Pragma("unroll") for (int i = 0; i < 11; ++i) { const int l = tg * 8 + i - 3;                                  \
      const bf16_t* src = (l >= 0 || c > 0) ? proj + (size_t)(t0 + l) * NPROJ : projmb + (size_t)(16 + l) * DPROJ;          \
      xraw[q][i] = bf2f(src[OFF_XBC + cch]); } }
  SSD_LOAD_X(0)
  __syncthreads();
  if (hsel == 0) {
#pragma unroll
    for (int q = 0; q < 4; ++q) {
      const int idx = q * NTHREADS + tid, row = idx >> 4, ck = idx & 15;
      *(u32x4*)(ccb + (size_t)(t0 + row) * 256 + g * 128 + ck * 8) = *(const u32x4*)(Cc + row * SLD + ck * 8);
    }
  }
  const int ql = lane & 31, hh = lane >> 5;
#pragma unroll 1
  for (int hi = 0; hi < 4; ++hi) {
    const int h = h0 + hi;
    bf16_t* xTb = xT + (hi & 1) * 64 * SLD;
#pragma unroll
    for (int q = 0; q < 2; ++q) {
      const int task = q * NTHREADS + tid; const int tg = task >> 6, pch = task & 63, cch = h * 64 + pch;
      const float w0 = p.conv_w[cch], w1 = p.conv_w[D_XBC + cch], w2 = p.conv_w[2 * D_XBC + cch], w3 = p.conv_w[3 * D_XBC + cch], cb = p.conv_b[cch];
      float o[8];
#pragma unroll
      for (int i = 0; i < 8; ++i) o[i] = conv_silu(xraw[q], i, w0, w1, w2, w3, cb);
      u32x4 w; w.x = pack_bf16(o[0], o[1]); w.y = pack_bf16(o[2], o[3]); w.z = pack_bf16(o[4], o[5]); w.w = pack_bf16(o[6], o[7]);
      *(u32x4*)(xTb + pch * SLD + tg * 8) = w;
    }
    if (hi < 3) { SSD_LOAD_X(hi + 1) }
    __syncthreads();
    const float dskip = p.d_skip[h];
    const float* acsh = acs + hi * 128;
    const float* dtlh = dtl + hi * 128;
    const float* wlh = wl + hi * 128;
    {
      const int ip = wid & 1, il = wid >> 1;
      const int l = 32 * il + ql;
      const float acl = acsh[l];
      f32x16 yacc;
#pragma unroll
      for (int r = 0; r < 16; ++r) yacc[r] = 0.f;
      const bf16_t* xrow = xTb + (32 * ip + ql) * SLD + 4 * hh;
#pragma unroll 1
      for (int is = 0; is <= il; ++is) {
        f32x16 x;
#pragma unroll
        for (int r = 0; r < 16; ++r) x[r] = 0.f;
        const bf16_t* ap = Bc + (32 * is + ql) * SLD + 8 * hh;
        const bf16_t* bp = Cc + l * SLD + 8 * hh;
#pragma unroll
        for (int ks = 0; ks < 8; ++ks) x = __builtin_amdgcn_mfma_f32_32x32x16_bf16(*(const bf16x8*)(ap + 16 * ks), *(const bf16x8*)(bp + 16 * ks), x, 0, 0, 0);
        u32x4 pw[2];
#pragma unroll
        for (int s2 = 0; s2 < 2; ++s2) {
          float mv[8];
#pragma unroll
          for (int q = 0; q < 2; ++q) {
            const int sb = 32 * is + 16 * s2 + 8 * q + 4 * hh;
            const f32x4 as4 = *(const f32x4*)(acsh + sb), dt4 = *(const f32x4*)(dtlh + sb);
#pragma unroll
            for (int j = 0; j < 4; ++j) {
              const int sr = sb + j;
              float v = sr <= l ? x[8 * s2 + 4 * q + j] * __expf(acl - as4[j]) * dt4[j] : 0.f;
              if (sr == l) v += dskip;
              mv[4 * q + j] = v;
            }
          }
          pw[s2].x = pack_bf16(mv[0], mv[1]); pw[s2].y = pack_bf16(mv[2], mv[3]); pw[s2].z = pack_bf16(mv[4], mv[5]); pw[s2].w = pack_bf16(mv[6], mv[7]);
        }
#pragma unroll
        for (int s2 = 0; s2 < 2; ++s2) {
          const u32x2 va = *(const u32x2*)(xrow + 32 * is + 16 * s2), vc = *(const u32x2*)(xrow + 32 * is + 16 * s2 + 8);
          u32x4 aw; aw.x = va.x; aw.y = va.y; aw.z = vc.x; aw.w = vc.y;
          yacc = __builtin_amdgcn_mfma_f32_32x32x16_bf16(*(bf16x8*)&aw, *(bf16x8*)&pw[s2], yacc, 0, 0, 0);
        }
      }
      float* yp = ypart + (size_t)(t0 + l) * 1024 + h * 64 + 32 * ip + 4 * hh;
#pragma unroll
      for (int rg = 0; rg < 4; ++rg) *(f32x4*)(yp + 8 * rg) = (f32x4){yacc[4 * rg], yacc[4 * rg + 1], yacc[4 * rg + 2], yacc[4 * rg + 3]};
    }
    {
      const int ip = wid & 1, in = wid >> 1;
      f32x16 sacc;
#pragma unroll
      for (int r = 0; r < 16; ++r) sacc[r] = 0.f;
      const bf16_t* ap = xTb + (32 * ip + ql) * SLD + 8 * hh;
      const bf16_t* bp = BcT + (32 * in + ql) * SLD + 8 * hh;
#pragma unroll
      for (int ks = 0; ks < 8; ++ks) {
        const u32x4 xa = *(const u32x4*)(ap + 16 * ks);
        const f32x4 wa = *(const f32x4*)(wlh + 16 * ks + 8 * hh), wb = *(const f32x4*)(wlh + 16 * ks + 8 * hh + 4);
        u32x4 aw;
        aw.x = pack_bf16(bflo(xa.x) * wa[0], bfhi(xa.x) * wa[1]); aw.y = pack_bf16(bflo(xa.y) * wa[2], bfhi(xa.y) * wa[3]);
        aw.z = pack_bf16(bflo(xa.z) * wb[0], bfhi(xa.z) * wb[1]); aw.w = pack_bf16(bflo(xa.w) * wb[2], bfhi(xa.w) * wb[3]);
        sacc = __builtin_amdgcn_mfma_f32_32x32x16_bf16(*(bf16x8*)&aw, *(const bf16x8*)(bp + 16 * ks), sacc, 0, 0, 0);
      }
      float* sp = sg + ((size_t)((b * 16 + c) * 16 + h) * 64 + 32 * ip + 4 * hh) * 128 + 32 * in + ql;
#pragma unroll
      for (int r = 0; r < 16; ++r) sp[((r & 3) + 8 * (r >> 2)) * 128] = sacc[r];
    }
  }
#undef SSD_LOAD_X
  __syncthreads();
}

__device__ __forceinline__ void meta_state_item(const Params& p, unsigned char* lds, int h) {
  const int tid = threadIdx.x, g = h >> 3;
  float* xm = (float*)lds;
  float* bm = xm + 16 * 64;
  float* dtm = bm + 16 * 128;
  const float* projm = (const float*)(p.ws + WS_PROJM);
  float* smeta = (float*)(p.ws + WS_SMETA);
  for (int task = tid; task < 16 * 192; task += NTHREADS) {
    const int i = task / 192, ch = task - i * 192;
    const int cch = ch < 64 ? h * 64 + ch : 1024 + g * 128 + (ch - 64);
    float acc = p.conv_b[cch];
#pragma unroll
    for (int j = 0; j < 4; ++j) { const int mi = i - j; if (mi >= 0) acc += p.conv_w[(3 - j) * D_XBC + cch] * projm[(size_t)mi * DPROJ + OFF_XBC + cch]; }
    const float v = silu_f(acc);
    if (ch < 64) xm[i * 64 + ch] = v; else bm[i * 128 + ch - 64] = v;
  }
  if (tid < 16) dtm[tid] = softplus_f(projm[(size_t)tid * DPROJ + OFF_DT + h] + p.dt_bias[h]);
  __syncthreads();
  const float Ah = -expf(p.a_log[h]);
  const int pr = tid >> 3, n0 = (tid & 7) * 16;
  float st[16];
#pragma unroll
  for (int k = 0; k < 16; ++k) st[k] = 0.f;
  for (int i = 0; i < 16; ++i) {
    const float dtv = dtm[i], dA = expf(dtv * Ah), xdt = xm[i * 64 + pr] * dtv;
#pragma unroll
    for (int k = 0; k < 16; ++k) st[k] = fmaf(st[k], dA, xdt * bm[i * 128 + n0 + k]);
  }
#pragma unroll
  for (int k = 0; k < 16; ++k) smeta[(size_t)(h * 64 + pr) * 128 + n0 + k] = st[k];
  __syncthreads();
}

__device__ __forceinline__ void phase2(const Params& p, unsigned char* lds, int bid, int nblk) {
#ifndef REP_SUB
#define REP_SUB -1
#endif
#pragma unroll 1
  for (int rep = 0; rep < (REP_SUB == 0 ? 2 : 1); ++rep)
    for (int item = bid; item < 256; item += nblk) attn_item(p, lds, item);
#pragma unroll 1
  for (int rep = 0; rep < (REP_SUB == 1 ? 2 : 1); ++rep)
    for (int item = bid; item < 256; item += nblk) ssd_a_item(p, lds, item);
  for (int item = bid; item < 16; item += nblk) meta_state_item(p, lds, item);
}

__device__ __forceinline__ void phase_scan(const Params& p, int bid, int nblk) {
  const float* __restrict__ sg = (const float*)(p.ws + WS_SG);
  const float* __restrict__ smeta = (const float*)(p.ws + WS_SMETA);
  const float* __restrict__ acsg = (const float*)(p.ws + WS_ACSG);
  bf16_t* __restrict__ hprev = (bf16_t*)(p.ws + WS_HPREV);
  for (int task = bid * NTHREADS + threadIdx.x; task < 64 * 2048; task += nblk * NTHREADS) {
    const int bh = task >> 11, e4 = (task & 2047) * 4;
    const int b = bh >> 4, h = bh & 15;
    f32x4 sv[16];
    float dv[16];
#pragma unroll
    for (int c = 0; c < 16; ++c) {
      sv[c] = *(const f32x4*)(sg + (size_t)((b * 16 + c) * 16 + h) * 8192 + e4);
      dv[c] = acsg[(size_t)(b * SEQ + c * 128 + 127) * 16 + h];
    }
    f32x4 H = *(const f32x4*)(smeta + (size_t)h * 8192 + e4);
#pragma unroll
    for (int c = 0; c < 16; ++c) {
      u32x2 w; w.x = pack_bf16(H[0], H[1]); w.y = pack_bf16(H[2], H[3]);
      *(u32x2*)(hprev + (size_t)((b * 16 + c) * 16 + h) * 8192 + e4) = w;
      H = H * __expf(dv[c]) + sv[c];
    }
  }
}

__device__ __forceinline__ void ssd_b_item(const Params& p, unsigned char* lds, int item) {
  const int tid = threadIdx.x, lane = tid & 63, wid = __builtin_amdgcn_readfirstlane(tid >> 6);
  const int b = item >> 5, c = (item >> 1) & 15, g = item & 1, h = g * 8 + wid;
  const int t0 = b * SEQ + c * 128;
  const int ql = lane & 31, hh = lane >> 5;
  float* ssqg = (float*)lds;
  const bf16_t* proj = (const bf16_t*)(p.ws + WS_PROJ);
  const float* acsg = (const float*)(p.ws + WS_ACSG);
  const bf16_t* ccb = (const bf16_t*)(p.ws + WS_CCB);
  const float* ypart = (const float*)(p.ws + WS_YPART);
  const bf16_t* hprev = (const bf16_t*)(p.ws + WS_HPREV);
  bf16_t* mixin = (bf16_t*)(p.ws + WS_HNB);
  float ssql[4] = {0.f, 0.f, 0.f, 0.f};
#pragma unroll 1
  for (int ip = 0; ip < 2; ++ip) {
    u32x4 hfr[8];
    {
      const bf16_t* hp = hprev + (size_t)((b * 16 + c) * 16 + h) * 8192 + (size_t)(32 * ip + ql) * 128 + 8 * hh;
#pragma unroll
      for (int ks = 0; ks < 8; ++ks) hfr[ks] = *(const u32x4*)(hp + 16 * ks);
    }
#pragma unroll
    for (int il = 0; il < 4; ++il) {
      const int t = t0 + 32 * il + ql;
      f32x16 acc;
#pragma unroll
      for (int r = 0; r < 16; ++r) acc[r] = 0.f;
      const bf16_t* cp = ccb + (size_t)t * 256 + g * 128 + 8 * hh;
#pragma unroll
      for (int ks = 0; ks < 8; ++ks) acc = __builtin_amdgcn_mfma_f32_32x32x16_bf16(*(bf16x8*)&hfr[ks], *(const bf16x8*)(cp + 16 * ks), acc, 0, 0, 0);
      const float ea = __expf(acsg[(size_t)t * 16 + h]);
#pragma unroll
      for (int rg = 0; rg < 4; ++rg) {
        const int pp = h * 64 + 32 * ip + 8 * rg + 4 * hh;
        const f32x4 yp = *(const f32x4*)(ypart + (size_t)t * 1024 + pp);
        const u32x2 zz = *(const u32x2*)(proj + (size_t)t * NPROJ + OFF_Z + pp);
        const float y0 = (yp[0] + ea * acc[4 * rg + 0]) * silu_f(bflo(zz.x)), y1 = (yp[1] + ea * acc[4 * rg + 1]) * silu_f(bfhi(zz.x));
        const float y2 = (yp[2] + ea * acc[4 * rg + 2]) * silu_f(bflo(zz.y)), y3 = (yp[3] + ea * acc[4 * rg + 3]) * silu_f(bfhi(zz.y));
        ssql[il] += y0 * y0 + y1 * y1 + y2 * y2 + y3 * y3;
        u32x2 w; w.x = pack_bf16(y0, y1); w.y = pack_bf16(y2, y3);
        *(u32x2*)(mixin + (size_t)t * DM + 1024 + pp) = w;
      }
    }
  }
#pragma unroll
  for (int il = 0; il < 4; ++il) {
    float v = ssql[il];
    v += __shfl_xor(v, 32);
    if (lane < 32) ssqg[wid * 128 + 32 * il + lane] = v;
  }
  __syncthreads();
#pragma unroll
  for (int il = 0; il < 4; ++il) {
    float tot = 0.f;
#pragma unroll
    for (int w = 0; w < 8; ++w) tot += ssqg[w * 128 + 32 * il + ql];
    const float rg_ = rsqrtf(tot * (1.f / 512) + EPS);
    const int t = t0 + 32 * il + ql;
#pragma unroll
    for (int ip = 0; ip < 2; ++ip)
#pragma unroll
      for (int rg = 0; rg < 4; ++rg) {
        bf16_t* op = mixin + (size_t)t * DM + 1024 + h * 64 + 32 * ip + 8 * rg + 4 * hh;
        const u32x2 v = *(const u32x2*)op;
        u32x2 w; w.x = pack_bf16(bflo(v.x) * rg_, bfhi(v.x) * rg_); w.y = pack_bf16(bflo(v.y) * rg_, bfhi(v.y) * rg_);
        *(u32x2*)op = w;
      }
  }
  __syncthreads();
}
__device__ __forceinline__ void phase3(const Params& p, unsigned char* lds, int bid, int nblk) {
  for (int item = bid; item < 128; item += nblk) ssd_b_item(p, lds, item);
}

constexpr int LDS_BYTES = 144 * 1024;

typedef const Params __attribute__((address_space(4))) * KArgPtr;
__device__ __forceinline__ Params load_params(KArgPtr k) {
  Params q;
#if defined(__HIP_DEVICE_COMPILE__)
  __builtin_memcpy(&q, k, sizeof(Params));
#endif
  return q;
}
#define PARAMS_PTR(pp) KArgPtr pp##_k = (KArgPtr)__builtin_amdgcn_kernarg_segment_ptr(); asm volatile("" : "+s"(pp##_k)); const Params pp##_v = load_params(pp##_k); const Params* pp = &pp##_v
__global__ __launch_bounds__(512, 2) void k_mega(Params p_unused) {
  extern __shared__ __attribute__((aligned(16))) unsigned char shm[];
  cooperative_groups::grid_group grid = cooperative_groups::this_grid();
  const int bid = blockIdx.x, nblk = gridDim.x;
  volatile LAS unsigned* xst = (volatile LAS unsigned*)(LAS unsigned char*)(shm + LDS_BYTES - 16);
  if (threadIdx.x == 0) { xst[0] = 0u; xst[1] = 0u; }
  __syncthreads();
  XcdBarrier xb;
  { PARAMS_PTR(pp); xb = xcd_barrier_post((unsigned*)(pp->ws + WS_CTL), xst); }
#ifndef REP_PHASE
#define REP_PHASE -1
#endif
#define NREP(k) ((REP_PHASE == (k)) ? 2 : 1)
#pragma unroll 1
  for (int rep = 0; rep < NREP(0); ++rep) { { PARAMS_PTR(pp); phase0(*pp, (float*)shm, bid, nblk); } if (rep + 1 < NREP(0)) xcd_barrier(xb); }
  grid.sync();
#pragma unroll 1
  for (int rep = 0; rep < NREP(1); ++rep) { { PARAMS_PTR(pp); phase1(*pp, shm, bid, nblk); } xcd_barrier(xb); }
#pragma unroll 1
  for (int rep = 0; rep < NREP(2); ++rep) { { PARAMS_PTR(pp); phase2(*pp, shm, bid, nblk); } xcd_barrier(xb); }
#pragma unroll 1
  for (int rep = 0; rep < NREP(7); ++rep) { { PARAMS_PTR(pp); phase_scan(*pp, bid, nblk); } xcd_barrier(xb); }
#pragma unroll 1
  for (int rep = 0; rep < NREP(3); ++rep) { { PARAMS_PTR(pp); phase3(*pp, shm, bid, nblk); } xcd_barrier(xb); }
#pragma unroll 1
  for (int rep = 0; rep < NREP(4); ++rep) { { PARAMS_PTR(pp); phase4(*pp, shm, bid, nblk); } xcd_barrier(xb); }
#pragma unroll 1
  for (int rep = 0; rep < NREP(5); ++rep) { { PARAMS_PTR(pp); phase5(*pp, shm, bid, nblk); } xcd_barrier(xb); }
#pragma unroll 1
  for (int rep = 0; rep < NREP(6); ++rep) { { PARAMS_PTR(pp); phase6(*pp, shm, bid, nblk); } if (rep + 1 < NREP(6)) xcd_barrier(xb); }
}

}

extern "C" void kernel_launch(void* const* d_in, const int* in_sizes, int n_in, void* d_out, int out_size, void* d_ws,
                              size_t ws_size, hipStream_t stream) {
  Params p{};
  p.x = (const float*)d_in[0]; p.meta = (const float*)d_in[1]; p.rel_bias = (const float*)d_in[2];
  p.ln_mix = (const float*)d_in[3]; p.w_in = (const float*)d_in[4]; p.sinks = (const float*)d_in[5];
  p.conv_w = (const float*)d_in[6]; p.conv_b = (const float*)d_in[7]; p.dt_bias = (const float*)d_in[8];
  p.a_log = (const float*)d_in[9]; p.d_skip = (const float*)d_in[10]; p.attn_norm_w = (const float*)d_in[11];
  p.ssm_norm_w = (const float*)d_in[12]; p.w_out = (const float*)d_in[13]; p.ln_ffn = (const float*)d_in[14];
  p.wq = (const float*)d_in[15]; p.keys = (const float*)d_in[16]; p.U = (const float*)d_in[17];
  p.V = (const float*)d_in[18]; p.ln_final = (const float*)d_in[19];
  p.out = (float*)d_out;
  p.ws = (unsigned char*)d_ws;

  static int grid_blocks = 0;
  if (!grid_blocks) {
    int dev = 0, cus = 0, per_cu = 0;
    (void)hipGetDevice(&dev);
    (void)hipDeviceGetAttribute(&cus, hipDeviceAttributeMultiprocessorCount, dev);
    (void)hipFuncSetAttribute((const void*)k_mega, hipFuncAttributeMaxDynamicSharedMemorySize, LDS_BYTES);
    (void)hipOccupancyMaxActiveBlocksPerMultiprocessor(&per_cu, (const void*)k_mega, NTHREADS, LDS_BYTES);
    if (per_cu > 1) per_cu = 1;
    grid_blocks = cus * per_cu;
    if (grid_blocks != 256) fprintf(stderr, "kernel_launch: expected a 256-workgroup resident grid, got %d (cus %d, per_cu %d)\n", grid_blocks, cus, per_cu);
  }
  (void)hipMemsetAsync(p.ws + WS_CTL, 0, XCD_BAR_WORDS * 4, stream);
  void* args[] = {&p};
  hipError_t e = hipLaunchCooperativeKernel((const void*)k_mega, dim3(grid_blocks), dim3(NTHREADS), args, LDS_BYTES, stream);
  if (e != hipSuccess) fprintf(stderr, "cooperative launch failed: %s (grid %d)\n", hipGetErrorString(e), grid_blocks);
}
```

```cpp
#include <hip/hip_runtime.h>
#include <hip/hip_cooperative_groups.h>
#include <math.h>
#include <stdio.h>
#include <stdint.h>

namespace {
constexpr int BATCH = 4, SEQ = 2048, DM = 2048, NMETA = 16;
constexpr int T = BATCH * SEQ;
constexpr int TA = T + NMETA;
constexpr int DPROJ = 4112;
constexpr int NPROJ = 4096;
constexpr int OFF_Q = 0, OFF_K = 1024, OFF_V = 1280, OFF_Z = 1536, OFF_XBC = 2560, OFF_DT = 4096;
constexpr int D_XBC = 1536;
constexpr int NEXP = 16384;
constexpr int ROW4 = 1024;
constexpr int ROW6 = 1536;
constexpr float EPS = 1e-6f;
constexpr int NTHREADS = 512;

typedef unsigned short bf16_t;
typedef short bf16x8 __attribute__((ext_vector_type(8)));
typedef float f32x4 __attribute__((ext_vector_type(4)));
typedef float f32x2 __attribute__((ext_vector_type(2)));
typedef unsigned u32x4 __attribute__((ext_vector_type(4)));
typedef unsigned u32x2 __attribute__((ext_vector_type(2)));
typedef __bf16 bf16v2 __attribute__((ext_vector_type(2)));
typedef float f32x16v __attribute__((ext_vector_type(16)));
typedef float f32x32v __attribute__((ext_vector_type(32)));
typedef unsigned u32x6 __attribute__((ext_vector_type(6)));
#define LAS __attribute__((address_space(3)))

__device__ __forceinline__ unsigned pack_bf16(float lo, float hi) {
  f32x2 v = {lo, hi};
  bf16v2 b = __builtin_convertvector(v, bf16v2);
  return *(unsigned*)&b;
}
__device__ __forceinline__ bf16_t f2bf(float f) { return (bf16_t)(pack_bf16(f, 0.f) & 0xffffu); }
__device__ __forceinline__ float bf2f(bf16_t b) { return __uint_as_float(((unsigned)b) << 16); }
__device__ __forceinline__ float bflo(unsigned u) { return __uint_as_float(u << 16); }
__device__ __forceinline__ float bfhi(unsigned u) { return __uint_as_float(u & 0xffff0000u); }

__constant__ unsigned char kBucket[128] = {
    0, 1, 2, 3, 4, 5, 6, 7, 8, 9, 10, 11, 12, 13, 14, 15, 16, 16, 16, 17, 17, 18, 18, 18, 19, 19, 19, 20, 20, 20, 20, 21,
    21, 21, 21, 22, 22, 22, 22, 22, 23, 23, 23, 23, 23, 23, 24, 24, 24, 24, 24, 24, 25, 25, 25, 25, 25, 25, 25, 26, 26, 26, 26, 26,
    26, 26, 26, 27, 27, 27, 27, 27, 27, 27, 27, 27, 27, 28, 28, 28, 28, 28, 28, 28, 28, 28, 28, 29, 29, 29, 29, 29, 29, 29, 29, 29,
    29, 29, 29, 30, 30, 30, 30, 30, 30, 30, 30, 30, 30, 30, 30, 30, 30, 31, 31, 31, 31, 31, 31, 31, 31, 31, 31, 31, 31, 31, 31, 31};

__constant__ unsigned char kCandI[64] = {0, 0, 0, 0, 0, 0, 0, 0, 0, 0, 0, 0, 0, 0, 0, 0, 1, 1, 1, 1, 1, 1, 1, 1, 2, 2, 2, 2, 2, 3, 3, 3, 3, 4, 4, 4, 5, 5, 6, 6, 7, 7, 8, 9, 10, 11, 12, 13, 14, 15, 15, 15, 15, 15, 15, 15, 15, 15, 15, 15, 15, 15, 15, 15};
__constant__ unsigned char kCandJ[64] = {0, 1, 2, 3, 4, 5, 6, 7, 8, 9, 10, 11, 12, 13, 14, 15, 0, 1, 2, 3, 4, 5, 6, 7, 0, 1, 2, 3, 4, 0, 1, 2, 3, 0, 1, 2, 0, 1, 0, 1, 0, 1, 0, 0, 0, 0, 0, 0, 0, 0, 15, 15, 15, 15, 15, 15, 15, 15, 15, 15, 15, 15, 15, 15};

__device__ __forceinline__ float wave_sum(float v) {
  for (int o = 32; o > 0; o >>= 1) v += __shfl_xor(v, o);
  return v;
}
__device__ __forceinline__ float wave_max(float v) {
  for (int o = 32; o > 0; o >>= 1) v = fmaxf(v, __shfl_xor(v, o));
  return v;
}
__device__ __forceinline__ float silu_f(float x) { return x / (1.f + expf(-x)); }
__device__ __forceinline__ float softplus_f(float x) { return fmaxf(x, 0.f) + log1pf(expf(-fabsf(x))); }

constexpr size_t al256(size_t x) { return (x + 255) & ~(size_t)255; }
constexpr size_t WS_CTL = 0;
constexpr size_t WS_WINT = 65536;
constexpr size_t WS_WDTT = WS_WINT + (size_t)NPROJ * DM * 2;
constexpr size_t WS_WOUTT = WS_WDTT + (size_t)16 * DM * 2;
constexpr size_t WS_WQT = WS_WOUTT + (size_t)DM * DM * 2;
constexpr size_t WS_KEYS = WS_WQT + (size_t)DM * DM * 2;
constexpr size_t WS_UB = WS_KEYS + (size_t)16 * 128 * 128 * 2;
constexpr size_t WS_VB = WS_UB + (size_t)NEXP * DM * 2;
constexpr size_t WS_HNB = WS_VB + (size_t)NEXP * DM * 2;
constexpr size_t WS_PROJ = WS_HNB + (size_t)(T + 16) * DM * 2;
constexpr size_t WS_DTRAW = WS_PROJ + (size_t)T * NPROJ * 2;
constexpr size_t WS_PROJM = WS_DTRAW + (size_t)T * 16 * 4;
constexpr size_t WS_PROJMB = al256(WS_PROJM + (size_t)16 * DPROJ * 4);
constexpr size_t WS_H1B = al256(WS_PROJMB + (size_t)16 * DPROJ * 2);
constexpr size_t WS_SSQH1 = WS_H1B + (size_t)T * DM * 2;
constexpr size_t WS_STOP = al256(WS_SSQH1 + (size_t)T * 32 * 4);
constexpr size_t WS_ITOP = WS_STOP + (size_t)T * 256 * 4;
constexpr size_t WS_ACSG = al256(WS_ITOP + (size_t)T * 256 * 4);
constexpr size_t WS_CCB = WS_ACSG + (size_t)T * 16 * 4;
constexpr size_t WS_YPART = WS_CCB + (size_t)T * 256 * 2;
constexpr size_t WS_SG = WS_YPART + (size_t)T * 1024 * 4;
constexpr size_t WS_SMETA = WS_SG + (size_t)1024 * 8192 * 4;
constexpr size_t WS_HPREV = al256(WS_SMETA + (size_t)16 * 8192 * 4);
constexpr size_t WS_USC = al256(WS_HPREV + (size_t)1024 * 8192 * 2);
constexpr size_t WS_VSC = WS_USC + (size_t)NEXP * 4;
constexpr size_t WS_SCR = al256(WS_VSC + (size_t)NEXP * 4);
}

namespace pg8 {
#define PG8_LAS __attribute__((address_space(3)))
constexpr int BM = 256, BK = 64, HALF = 128, HTB = HALF * BK * 2, STAGE_BYTES = 8 * HTB, NXCD = 8, WGM = 8;
__host__ __device__ __forceinline__ int lds_byte(int r, int c) { const int st = (r >> 4) * 2 + (c >> 5), rr = r & 15, cc = c & 31, ob = rr * 64 + cc * 2; return st * 1024 + (ob ^ (((ob >> 9) & 1) << 5)); }
__host__ __device__ __forceinline__ void stage_rc(int b, int& R, int& C) { const int st = b / 1024, sb = b % 1024, swz = sb ^ (((sb >> 9) & 1) << 5); R = (st >> 1) * 16 + swz / 64; C = (st & 1) * 32 + (swz % 64) / 2; }
__host__ __device__ __forceinline__ int perm32(int rho) { const int n = rho >> 4, i = rho & 15; return 8 * (i >> 2) + 4 * n + (i & 3); }
struct Unit { int pm, pn; };
struct Gemm { const bf16_t* A; const bf16_t* Bt; int M, N, K; };
struct StaticOrder {
    int nM, nN, nwg, G, c;
    __host__ __device__ void init(int M, int N, int G_, int c_) { nM = M / BM; nN = N / BM; nwg = nM * nN; G = G_; c = c_; }
    __host__ __device__ bool next(int i, Unit& u) const {
        const long L = (long)i * G + c; if (L >= nwg) return false;
        int wgid = (int)L; { const int q = nwg / NXCD, r = nwg % NXCD, xcd = wgid % NXCD, off = wgid / NXCD; wgid = (xcd < r ? xcd * (q + 1) : r * (q + 1) + (xcd - r) * q) + off; }
        const int nig = WGM * nN, gid = wgid / nig, fm = gid * WGM, gsz = (nM - fm) < WGM ? (nM - fm) : WGM;
        u.pm = fm + ((wgid % nig) % gsz); u.pn = (wgid % nig) / gsz; return true;
    }
    __device__ __forceinline__ void a_ready(const Unit&) const {}
    __device__ __forceinline__ void done(const Unit&) const {}
};
struct EpiBf16 {
    static constexpr bool PERM = true, AFTER_DRAIN = false;
    bf16_t* O; int ldc;
    __device__ __forceinline__ void operator()(const f32x4 (&acc)[2][2][4][2], const Unit& u, int wr, int wc, int fr, int fq) const {
        const int row0 = u.pm * BM + wr * 64 + fr; const int col0 = u.pn * BM + wc * 32 + 8 * fq;
#pragma unroll
        for (int ai = 0; ai < 2; ++ai)
#pragma unroll
            for (int m = 0; m < 4; ++m) { bf16_t* rowp = O + (size_t)(row0 + ai * HALF + m * 16) * ldc + col0;
#pragma unroll
                for (int bj = 0; bj < 2; ++bj) { const f32x4 v0 = acc[ai][bj][m][0], v1 = acc[ai][bj][m][1];
                    u32x4 w; w.x = pack_bf16(v0[0], v0[1]); w.y = pack_bf16(v0[2], v0[3]); w.z = pack_bf16(v1[0], v1[1]); w.w = pack_bf16(v1[2], v1[3]);
                    *(u32x4*)(rowp + bj * HALF) = w; } }
    }
};

struct EpiRes {
    static constexpr bool PERM = true, AFTER_DRAIN = false;
    const float* X; bf16_t* HB; float* SSQ;
    __device__ __forceinline__ void operator()(const f32x4 (&acc)[2][2][4][2], const Unit& u, int wr, int wc, int fr, int fq) const {
        const int row0 = u.pm * BM + wr * 64 + fr; const int col0 = u.pn * BM + wc * 32 + 8 * fq;
#pragma unroll
        for (int ai = 0; ai < 2; ++ai)
#pragma unroll
            for (int m = 0; m < 4; ++m) { const int row = row0 + ai * HALF + m * 16; const size_t off = (size_t)row * DM + col0; float ss = 0.f;
#pragma unroll
                for (int bj = 0; bj < 2; ++bj) {
                    const f32x4 x0 = *(const f32x4*)(X + off + bj * HALF), x1 = *(const f32x4*)(X + off + bj * HALF + 4);
                    const f32x4 v0 = acc[ai][bj][m][0] + x0, v1 = acc[ai][bj][m][1] + x1;
                    u32x4 w; w.x = pack_bf16(v0[0], v0[1]); w.y = pack_bf16(v0[2], v0[3]); w.z = pack_bf16(v1[0], v1[1]); w.w = pack_bf16(v1[2], v1[3]);
                    *(u32x4*)(HB + off + bj * HALF) = w;
                    ss += v0[0] * v0[0] + v0[1] * v0[1] + v0[2] * v0[2] + v0[3] * v0[3] + v1[0] * v1[0] + v1[1] * v1[1] + v1[2] * v1[2] + v1[3] * v1[3]; }
                ss += __shfl_xor(ss, 16); ss += __shfl_xor(ss, 32);
                if (fq == 0) SSQ[(size_t)row * 32 + u.pn * 4 + wc] = ss; }
    }
};
struct EpiF32 {
    static constexpr bool PERM = true, AFTER_DRAIN = false;
    float* C; int ldc;
    __device__ __forceinline__ void operator()(const f32x4 (&acc)[2][2][4][2], const Unit& u, int wr, int wc, int fr, int fq) const {
        const int row0 = u.pm * BM + wr * 64 + fr; const int col0 = u.pn * BM + wc * 32 + 8 * fq;
#pragma unroll
        for (int ai = 0; ai < 2; ++ai)
#pragma unroll
            for (int m = 0; m < 4; ++m) { float* rowp = C + (size_t)(row0 + ai * HALF + m * 16) * ldc + col0;
#pragma unroll
                for (int bj = 0; bj < 2; ++bj) { *(f32x4*)(rowp + bj * HALF) = acc[ai][bj][m][0]; *(f32x4*)(rowp + bj * HALF + 4) = acc[ai][bj][m][1]; } }
    }
};

struct EpiScores {
    static constexpr bool PERM = true, AFTER_DRAIN = true;
    const bf16_t* KEYS;
    float* STOP; int* ITOP;
    static constexpr int QLD = 264;
    __device__ __forceinline__ void fused(f32x4 (&acc)[2][2][4][2], const Unit& u, int wr, int wc, int fr, int fq, PG8_LAS unsigned char* lds, int wid, int lane) const {
        PG8_LAS bf16_t* Q = (PG8_LAS bf16_t*)lds;
#pragma unroll
        for (int ai = 0; ai < 2; ++ai)
#pragma unroll
            for (int m = 0; m < 4; ++m) { const int row = ai * HALF + wr * 64 + m * 16 + fr;
#pragma unroll
                for (int bj = 0; bj < 2; ++bj) { const f32x4 v0 = acc[ai][bj][m][0], v1 = acc[ai][bj][m][1];
                    u32x4 w; w.x = pack_bf16(v0[0], v0[1]); w.y = pack_bf16(v0[2], v0[3]); w.z = pack_bf16(v1[0], v1[1]); w.w = pack_bf16(v1[2], v1[3]);
                    *(PG8_LAS u32x4*)(Q + row * QLD + bj * HALF + wc * 32 + 8 * fq) = w; } }
        __syncthreads();
        const int h = u.pn;
#pragma unroll 1
        for (int c = 0; c < 2; ++c) {
            f32x4 sc[8][2];
#pragma unroll
            for (int kf = 0; kf < 8; ++kf) { sc[kf][0] = (f32x4){0.f, 0.f, 0.f, 0.f}; sc[kf][1] = (f32x4){0.f, 0.f, 0.f, 0.f}; }
            const bf16_t* kb = KEYS + (size_t)((h * 2 + c) * 128 + fr) * 128 + 8 * fq;
            const PG8_LAS bf16_t* qb = Q + (wid * 32 + fr) * QLD + c * 128 + 8 * fq;
#pragma unroll
            for (int ks = 0; ks < 4; ++ks) {
                const bf16x8 q0 = *(const PG8_LAS bf16x8*)(qb + 32 * ks), q1 = *(const PG8_LAS bf16x8*)(qb + 16 * QLD + 32 * ks);
#pragma unroll
                for (int kf = 0; kf < 8; ++kf) { const bf16x8 kv = *(const bf16x8*)(kb + (size_t)kf * 16 * 128 + 32 * ks);
                    sc[kf][0] = __builtin_amdgcn_mfma_f32_16x16x32_bf16(kv, q0, sc[kf][0], 0, 0, 0);
                    sc[kf][1] = __builtin_amdgcn_mfma_f32_16x16x32_bf16(kv, q1, sc[kf][1], 0, 0, 0); }
            }
#pragma unroll
            for (int tf = 0; tf < 2; ++tf) {
                float v[32];
#pragma unroll
                for (int kf = 0; kf < 8; ++kf)
#pragma unroll
                    for (int r = 0; r < 4; ++r) v[kf * 4 + r] = __uint_as_float((__float_as_uint(sc[kf][tf][r]) & 0xffffff80u) | (unsigned)(16 * kf + r));
                const unsigned fqbits = 4u * fq;
                const size_t obase = ((size_t)(u.pm * BM + wid * 32 + tf * 16 + fr) * 16 + h * 2 + c) * 16;
#pragma unroll 1
                for (int r = 0; r < 16; ++r) {
                    float mx = v[0];
#pragma unroll
                    for (int i = 1; i < 32; ++i) mx = fmaxf(mx, v[i]);
                    float cand = __uint_as_float(__float_as_uint(mx) | fqbits);
                    float o = __shfl_xor(cand, 16); cand = fmaxf(cand, o);
                    o = __shfl_xor(cand, 32); cand = fmaxf(cand, o);
                    const unsigned cb = __float_as_uint(cand);
                    const bool mine = (cb & 12u) == fqbits;
                    const float rem = __uint_as_float(cb & ~12u);
#pragma unroll
                    for (int i = 0; i < 32; ++i) v[i] = (mine && v[i] == rem) ? -INFINITY : v[i];
                    if (fq == 0) { STOP[obase + r] = __uint_as_float(cb & 0xffffff80u); ITOP[obase + r] = (int)(cb & 127u); }
                }
            }
        }
    }
};

template <class Epi, class Sched>
__device__ __forceinline__ void gemm_phase(PG8_LAS unsigned char* lds, const Gemm g, const Sched& S, const Epi& E) {
    int tid_ = threadIdx.x; asm volatile("" : "+v"(tid_));
    const int tid = tid_, wid = __builtin_amdgcn_readfirstlane(tid >> 6), lane = tid & 63, wr = wid >> 2, wc = wid & 3, fr = lane & 15, fq = lane >> 4;
    const int K = g.K, nt = K / BK;
    unsigned voffA[2], voffB[2];
#pragma unroll
    for (int i = 0; i < 2; ++i) { int R, C; stage_rc(tid * 16 + i * 8192, R, C); const int Rb = Epi::PERM ? ((R & ~31) + perm32(R & 31)) : R;
        voffA[i] = (unsigned)(R * K + C) * 2u; voffB[i] = (unsigned)(Rb * K + C) * 2u; }
    const size_t kstep = (size_t)(BK * 2);
    const size_t hstep = (size_t)HALF * K * 2;
    const size_t tstep = 2 * hstep;
    const unsigned ldsw = (unsigned)wid * 1024u;
    const int aoff = lds_byte(wr * 64 + fr, fq * 8), boff = lds_byte(wc * 32 + fr, fq * 8);
#define PG8_SA(b, h) (((b) * 2 + (h)) * HTB)
#define PG8_SB(b, h) ((4 + (b) * 2 + (h)) * HTB)
#define PG8_STAGE(bufoff, gbase, voff) do { _Pragma("unroll") for (int _i = 0; _i < 2; ++_i) \
        __builtin_amdgcn_global_load_lds((const unsigned*)((const char*)(gbase) + (voff)[_i]), (PG8_LAS unsigned*)(lds + (bufoff) + ldsw + _i * 8192), 16, 0, 0); } while (0)
#define PG8_LDA(dst, b, h) do { _Pragma("unroll") for (int m = 0; m < 4; ++m) _Pragma("unroll") for (int k = 0; k < 2; ++k) dst[m][k] = *(const PG8_LAS bf16x8*)(lds + PG8_SA(b, h) + aoff + m * 2048 + k * 1024); } while (0)
#define PG8_LDB(dst, b, h) do { _Pragma("unroll") for (int n = 0; n < 2; ++n) _Pragma("unroll") for (int k = 0; k < 2; ++k) dst[n][k] = *(const PG8_LAS bf16x8*)(lds + PG8_SB(b, h) + boff + n * 2048 + k * 1024); } while (0)
#define PG8_MMA(ai, bj, At, Bt) do { __builtin_amdgcn_s_setprio(1); _Pragma("unroll") for (int m = 0; m < 4; ++m) _Pragma("unroll") for (int n = 0; n < 2; ++n) _Pragma("unroll") for (int k = 0; k < 2; ++k) \
        acc[ai][bj][m][n] = __builtin_amdgcn_mfma_f32_16x16x32_bf16(Bt[n][k], At[m][k], acc[ai][bj][m][n], 0, 0, 0); __builtin_amdgcn_s_setprio(0); } while (0)
#define PG8_WAIT_V(n) asm volatile("s_waitcnt vmcnt(" #n ")" ::: "memory")
#define PG8_WAIT_L(n) asm volatile("s_waitcnt lgkmcnt(" #n ")" ::: "memory")
#define PG8_BAR __builtin_amdgcn_s_barrier()
#define PG8_SCHED __builtin_amdgcn_sched_barrier(0)
    Unit cur, nxt; int ui = 0;
    if (!S.next(0, cur)) return;
    f32x4 acc[2][2][4][2];
#pragma unroll
    for (int a = 0; a < 2; ++a)
#pragma unroll
        for (int b = 0; b < 2; ++b)
#pragma unroll
            for (int m = 0; m < 4; ++m)
#pragma unroll
                for (int n = 0; n < 2; ++n) acc[a][b][m][n] = (f32x4){0.f, 0.f, 0.f, 0.f};
    bf16x8 At[4][2], B0[2][2], B1[2][2];
    const char* cA = (const char*)g.A + (size_t)cur.pm * tstep; const char* cB = (const char*)g.Bt + (size_t)cur.pn * tstep;
    S.a_ready(cur);
    PG8_STAGE(PG8_SB(0, 0), cB, voffB); PG8_STAGE(PG8_SA(0, 0), cA, voffA); PG8_STAGE(PG8_SB(0, 1), cB + hstep, voffB); PG8_STAGE(PG8_SA(0, 1), cA + hstep, voffA);
    if (wr == 1) PG8_BAR;
    PG8_WAIT_V(4); PG8_BAR;
    PG8_STAGE(PG8_SB(1, 0), cB + kstep, voffB); PG8_STAGE(PG8_SA(1, 0), cA + kstep, voffA); PG8_STAGE(PG8_SB(1, 1), cB + hstep + kstep, voffB);
    PG8_WAIT_V(6); PG8_BAR;
    for (;;) {
        const bool has_next = S.next(ui + 1, nxt);
        const char* nA = has_next ? (const char*)g.A + (size_t)nxt.pm * tstep : cA; const char* nB = has_next ? (const char*)g.Bt + (size_t)nxt.pn * tstep : cB;
        for (int t = 0; t < nt; t += 2) {
            const bool last = (t == nt - 2);
            const char* a1 = cA + (size_t)(t + 1) * kstep;
            const char* a2 = last ? nA : cA + (size_t)(t + 2) * kstep; const char* b2 = last ? nB : cB + (size_t)(t + 2) * kstep;
            const char* a3 = a2 + kstep; const char* b3 = b2 + kstep;
            if (last && has_next) S.a_ready(nxt);
            PG8_LDB(B0, 0, 0); PG8_SCHED; PG8_LDA(At, 0, 0); PG8_STAGE(PG8_SA(1, 1), a1 + hstep, voffA);
            PG8_WAIT_L(8); PG8_BAR; PG8_WAIT_L(0); PG8_MMA(0, 0, At, B0); PG8_BAR; PG8_SCHED;
            PG8_LDB(B1, 0, 1); PG8_STAGE(PG8_SB(0, 0), b2, voffB);
            PG8_BAR; PG8_WAIT_L(0); PG8_MMA(0, 1, At, B1); PG8_BAR;
            PG8_LDA(At, 0, 1); PG8_STAGE(PG8_SA(0, 0), a2, voffA);
            PG8_BAR; PG8_WAIT_L(0); PG8_MMA(1, 0, At, B0); PG8_BAR; PG8_SCHED;
            PG8_STAGE(PG8_SB(0, 1), b2 + hstep, voffB);
            PG8_WAIT_V(6); PG8_BAR; PG8_MMA(1, 1, At, B1); PG8_BAR;
            PG8_LDB(B0, 1, 0); PG8_SCHED; PG8_LDA(At, 1, 0); PG8_STAGE(PG8_SA(0, 1), a2 + hstep, voffA);
            PG8_WAIT_L(8); PG8_BAR; PG8_WAIT_L(0); PG8_MMA(0, 0, At, B0); PG8_BAR; PG8_SCHED;
            PG8_LDB(B1, 1, 1); PG8_STAGE(PG8_SB(1, 0), b3, voffB);
            PG8_BAR; PG8_WAIT_L(0); PG8_MMA(0, 1, At, B1); PG8_BAR;
            PG8_LDA(At, 1, 1); PG8_STAGE(PG8_SA(1, 0), a3, voffA);
            PG8_BAR; PG8_WAIT_L(0); PG8_MMA(1, 0, At, B0); PG8_BAR; PG8_SCHED;
            PG8_STAGE(PG8_SB(1, 1), b3 + hstep, voffB);
            PG8_WAIT_V(6); PG8_BAR; PG8_MMA(1, 1, At, B1); PG8_BAR;
        }
        if constexpr (!Epi::AFTER_DRAIN) { E(acc, cur, wr, wc, fr, fq); S.done(cur); }
        if (!has_next) break;
#pragma unroll
        for (int a = 0; a < 2; ++a)
#pragma unroll
            for (int b = 0; b < 2; ++b)
#pragma unroll
                for (int m = 0; m < 4; ++m)
#pragma unroll
                    for (int n = 0; n < 2; ++n) acc[a][b][m][n] = (f32x4){0.f, 0.f, 0.f, 0.f};
        cur = nxt; cA = nA; cB = nB; ++ui;
    }
    PG8_WAIT_V(0);
    if (wr == 0) PG8_BAR;
    PG8_BAR;
    if constexpr (Epi::AFTER_DRAIN) { E.fused(acc, cur, wr, wc, fr, fq, lds, wid, lane); S.done(cur); }
#undef PG8_SA
#undef PG8_SB
#undef PG8_STAGE
#undef PG8_LDA
#undef PG8_LDB
#undef PG8_MMA
#undef PG8_WAIT_V
#undef PG8_WAIT_L
#undef PG8_BAR
#undef PG8_SCHED
}
}

#define XB_TMO      128
#define XB_XCNT(j)  (256  + 64 * (j))
#define XB_XSUB(j)  (1280 + 64 * (j))
#define XB_XGEN(j)  (2304 + 64 * (j))
#define XB_TOP      3328
#define XB_TOPGEN   3392
#define XCD_BAR_WORDS 3456
#define XB_SPIN_CAP (1u << 22)
__device__ __forceinline__ unsigned xb_ld(unsigned* p)              { return __hip_atomic_load(p, __ATOMIC_RELAXED, __HIP_MEMORY_SCOPE_AGENT); }
__device__ __forceinline__ unsigned xb_add(unsigned* p, unsigned v) { return __hip_atomic_fetch_add(p, v, __ATOMIC_RELAXED, __HIP_MEMORY_SCOPE_AGENT); }
__device__ __forceinline__ unsigned xb_xcc_id() { return (unsigned)__builtin_amdgcn_s_getreg((3 << 11) | 20) & 0xFu; }
#define XB_SPIN(cond, bar) do { unsigned _sp = 0; while (cond) { __builtin_amdgcn_s_sleep(1); \
    if ((++_sp & 255u) == 0u) { if (xb_ld(&(bar)[XB_TMO])) break; if (_sp > XB_SPIN_CAP) { atomicAdd(&(bar)[XB_TMO], 1u); break; } } } } while (0)
struct XcdBarrier { unsigned* bar; unsigned x; volatile LAS unsigned* st; };
__device__ __forceinline__ XcdBarrier xcd_barrier_post(unsigned* bar, volatile LAS unsigned* st) {
    XcdBarrier b; b.bar = bar; b.x = xb_xcc_id(); b.st = st;
    if (threadIdx.x == 0) (void)xb_add(&bar[XB_XCNT(b.x)], 1u);
    return b;
}
__device__ __forceinline__ void xcd_barrier_complete(unsigned* bar, unsigned x, unsigned& nloc, unsigned& nx) {
    const unsigned G = gridDim.x * gridDim.y * gridDim.z;
    unsigned sum, cnt, mine, sp = 0u;
    for (;;) {
        sum = 0u; cnt = 0u; mine = 0u;
#pragma unroll
        for (unsigned j = 0; j < 16; ++j) { const unsigned c = xb_ld(&bar[XB_XCNT(j)]); sum += c; cnt += (c > 0u) ? 1u : 0u; mine = (j == x) ? c : mine; }
        if (sum == G) break;
        __builtin_amdgcn_s_sleep(1);
        if ((++sp & 255u) == 0u) { if (xb_ld(&bar[XB_TMO])) break; if (sp > XB_SPIN_CAP) { atomicAdd(&bar[XB_TMO], 1u); break; } }
    }
    nloc = mine > 0u ? mine : 1u; nx = cnt > 0u ? cnt : 1u;
}
__device__ __forceinline__ void xcd_barrier(const XcdBarrier& b) {
    asm volatile("s_waitcnt vmcnt(0)" ::: "memory");
    __syncthreads();
    if (threadIdx.x == 0) {
        unsigned* bar = b.bar;
        __builtin_amdgcn_s_waitcnt(0);
        unsigned nloc = b.st[0], nx = b.st[1];
        if (nloc == 0u) { xcd_barrier_complete(bar, b.x, nloc, nx); b.st[0] = nloc; b.st[1] = nx; }
        const unsigned old = xb_add(&bar[XB_XSUB(b.x)], 1u);
        const unsigned gen = old / nloc;
        if (old + 1u == (gen + 1u) * nloc) {
            __builtin_amdgcn_fence(__ATOMIC_RELEASE, "agent");
            asm volatile("s_waitcnt vmcnt(0)" ::: "memory");
            const unsigned og = xb_add(&bar[XB_TOP], 1u);
            const unsigned tg = og / nx;
            if (og + 1u == (tg + 1u) * nx) xb_add(&bar[XB_TOPGEN], 1u);
            else XB_SPIN(xb_ld(&bar[XB_TOPGEN]) == tg, bar);
            __builtin_amdgcn_fence(__ATOMIC_ACQUIRE, "agent");
            xb_add(&bar[XB_XGEN(b.x)], 1u);
            asm volatile("s_waitcnt vmcnt(0)" ::: "memory");
        } else {
            XB_SPIN(xb_ld(&bar[XB_XGEN(b.x)]) == gen, bar);
            __builtin_amdgcn_fence(__ATOMIC_ACQUIRE, "agent");
            asm volatile("s_waitcnt vmcnt(0)" ::: "memory");
        }
    }
    __syncthreads();
}

namespace {
struct Params {
  const float *x, *meta, *rel_bias, *ln_mix, *w_in, *sinks, *conv_w, *conv_b, *dt_bias, *a_log, *d_skip, *attn_norm_w,
      *ssm_norm_w, *w_out, *ln_ffn, *wq, *keys, *U, *V, *ln_final;
  float* out;
  unsigned char* ws;
};

__device__ __forceinline__ void p0_transpose_tile(const float* __restrict__ W, int ldw, bf16_t* __restrict__ Wt, const float* sc0,
                                                  const float* sc1, int k0, int n0, float* tile  ) {
  const int tid = threadIdx.x;
  {
    const int r = tid >> 4, c4 = (tid & 15) * 4;
    const float4 a = *(const float4*)(W + (size_t)(k0 + r) * ldw + n0 + c4);
    const float4 b = *(const float4*)(W + (size_t)(k0 + r + 32) * ldw + n0 + c4);
    float* p = tile + r * 65 + c4;
    p[0] = a.x; p[1] = a.y; p[2] = a.z; p[3] = a.w;
    float* q = tile + (r + 32) * 65 + c4;
    q[0] = b.x; q[1] = b.y; q[2] = b.z; q[3] = b.w;
  }
  __syncthreads();
  {
    const int n = tid >> 3, kc = (tid & 7) * 8;
    float v[8];
#pragma unroll
    for (int j = 0; j < 8; ++j) {
      float s = 1.f;
      const int k = k0 + kc + j;
      if (sc0) s = k < 1024 ? sc0[k] : sc1[k - 1024];
      v[j] = tile[(kc + j) * 65 + n] * s;
    }
    u32x4 w; w.x = pack_bf16(v[0], v[1]); w.y = pack_bf16(v[2], v[3]); w.z = pack_bf16(v[4], v[5]); w.w = pack_bf16(v[6], v[7]);
    *(u32x4*)(Wt + (size_t)(n0 + n) * DM + k0 + kc) = w;
  }
  __syncthreads();
}

__device__ __forceinline__ void phase0(const Params& p, float* ldsf, int bid, int nblk) {
  const int tid = threadIdx.x, lane = tid & 63, wid = tid >> 6;
  bf16_t* w_inT = (bf16_t*)(p.ws + WS_WINT);
  bf16_t* w_dtT = (bf16_t*)(p.ws + WS_WDTT);
  bf16_t* w_outT = (bf16_t*)(p.ws + WS_WOUTT);
  bf16_t* wqT = (bf16_t*)(p.ws + WS_WQT);
  bf16_t* keysb = (bf16_t*)(p.ws + WS_KEYS);
  unsigned char* ub = p.ws + WS_UB;
  unsigned char* vb = p.ws + WS_VB;
  bf16_t* hnb = (bf16_t*)(p.ws + WS_HNB);
  constexpr int U_HN = (TA + 7) / 8;
  constexpr int U_WIN = 32 * 64, U_WOUT = 32 * 32, U_WQ = 32 * 32, U_WDT = 1, U_KEYS = 64, U_U = NEXP / 8, U_V = NEXP / 8;
  constexpr int B_WIN = U_HN, B_WOUT = B_WIN + U_WIN, B_WQ = B_WOUT + U_WOUT, B_WDT = B_WQ + U_WQ, B_KEYS = B_WDT + U_WDT,
                B_U = B_KEYS + U_KEYS, B_V = B_U + U_U, B_END = B_V + U_V;
  for (int u = bid; u < B_END; u += nblk) {
    if (u < B_WIN) {
      const int t = u * 8 + wid;
      if (t < TA) {
        const float* src = t < T ? p.x + (size_t)t * DM : p.meta + (size_t)(t - T) * DM;
        float4 v[8];
        float ss = 0.f;
#pragma unroll
        for (int i = 0; i < 8; ++i) {
          v[i] = *(const float4*)(src + (i * 64 + lane) * 4);
          ss += v[i].x * v[i].x + v[i].y * v[i].y + v[i].z * v[i].z + v[i].w * v[i].w;
        }
        ss = wave_sum(ss);
        const float r = rsqrtf(ss * (1.f / DM) + EPS);
#pragma unroll
        for (int i = 0; i < 8; ++i) {
          const float4 w = *(const float4*)(p.ln_mix + (i * 64 + lane) * 4);
          u32x2 o; o.x = pack_bf16(v[i].x * r * w.x, v[i].y * r * w.y); o.y = pack_bf16(v[i].z * r * w.z, v[i].w * r * w.w);
          *(u32x2*)(hnb + (size_t)t * DM + (i * 64 + lane) * 4) = o;
        }
      }
    } else if (u < B_WOUT) {
      const int i = u - B_WIN;
      p0_transpose_tile(p.w_in, DPROJ, w_inT, nullptr, nullptr, (i & 31) * 64, (i >> 5) * 64, ldsf);
    } else if (u < B_WQ) {
      const int i = u - B_WOUT;
      p0_transpose_tile(p.w_out, DM, w_outT, p.attn_norm_w, p.ssm_norm_w, (i & 31) * 64, (i >> 5) * 64, ldsf);
    } else if (u < B_WDT) {
      const int i = u - B_WQ;
      p0_transpose_tile(p.wq, DM, wqT, p.ln_ffn, p.ln_ffn + 1024, (i & 31) * 64, (i >> 5) * 64, ldsf);
    } else if (u < B_KEYS) {
      for (int idx = tid; idx < DM * 16; idx += NTHREADS) {
        const int k = idx >> 4, j = idx & 15;
        w_dtT[(size_t)j * DM + k] = f2bf(p.w_in[(size_t)k * DPROJ + NPROJ + j]);
      }
    } else if (u < B_U) {
      const size_t base = (size_t)(u - B_KEYS) * 4096 + (size_t)tid * 8;
      const float4 a = *(const float4*)(p.keys + base), b = *(const float4*)(p.keys + base + 4);
      u32x4 w; w.x = pack_bf16(a.x, a.y); w.y = pack_bf16(a.z, a.w); w.z = pack_bf16(b.x, b.y); w.w = pack_bf16(b.z, b.w);
      *(u32x4*)(keysb + base) = w;
    } else {
      const bool isU = u < B_V;
      const int row = (isU ? (u - B_U) : (u - B_V)) * 8 + wid;
      const float* src = (isU ? p.U : p.V) + (size_t)row * DM + lane * 32;
      f32x4 a[8];
#pragma unroll
      for (int j = 0; j < 8; ++j) a[j] = *(const f32x4*)(src + 4 * j);
      if (isU) {
#pragma unroll
        for (int j = 0; j < 8; ++j) a[j] *= *(const f32x4*)(p.ln_ffn + lane * 32 + 4 * j);
      }
      float amax = 0.f;
#pragma unroll
      for (int j = 0; j < 8; ++j) amax = fmaxf(amax, fmaxf(fmaxf(fabsf(a[j][0]), fabsf(a[j][1])), fmaxf(fabsf(a[j][2]), fabsf(a[j][3]))));
      amax = wave_max(amax);
      if (!isU) {
        const float s4 = amax > 0.f ? 6.f / amax : 1.f;
        u32x4 w4;
#pragma unroll
        for (int j = 0; j < 4; ++j) {
          unsigned w = 0;
          w = __builtin_amdgcn_cvt_scalef32_pk_fp4_f32(w, a[2 * j][0] * s4, a[2 * j][1] * s4, 1.0f, 0);
          w = __builtin_amdgcn_cvt_scalef32_pk_fp4_f32(w, a[2 * j][2] * s4, a[2 * j][3] * s4, 1.0f, 1);
          w = __builtin_amdgcn_cvt_scalef32_pk_fp4_f32(w, a[2 * j + 1][0] * s4, a[2 * j + 1][1] * s4, 1.0f, 2);
          w = __builtin_amdgcn_cvt_scalef32_pk_fp4_f32(w, a[2 * j + 1][2] * s4, a[2 * j + 1][3] * s4, 1.0f, 3);
          w4[j] = w;
        }
        *(u32x4*)(vb + (size_t)row * ROW4 + lane * 16) = w4;
        if (lane == 0) ((float*)(p.ws + WS_VSC))[row] = amax > 0.f ? amax * (1.f / 6.f) : 1.f;
        continue;
      }
      const float scl = amax > 0.f ? 7.5f / amax : 1.f;
      f32x16v v0, v1;
#pragma unroll
      for (int j = 0; j < 8; ++j) {
        v0[2 * j + 0] = a[j][0] * scl; v1[2 * j + 0] = a[j][1] * scl; v0[2 * j + 1] = a[j][2] * scl; v1[2 * j + 1] = a[j][3] * scl;
      }
      const u32x6 pk = __builtin_amdgcn_cvt_scalef32_2xpk16_fp6_f32(v0, v1, 1.0f);
      unsigned char* dst = (isU ? ub : vb) + (size_t)row * ROW6;
      *(u32x4*)(dst + lane * 16) = (u32x4){pk[0], pk[1], pk[2], pk[3]};
      *(u32x2*)(dst + 1024 + lane * 8) = (u32x2){pk[4], pk[5]};
      if (lane == 0) ((float*)(p.ws + (isU ? WS_USC : WS_VSC)))[row] = amax > 0.f ? amax * (1.f / 7.5f) : 1.f;
    }
  }
}

__device__ __forceinline__ void mini_gemm(const bf16_t* __restrict__ A, const bf16_t* __restrict__ Bt, float* __restrict__ out, int ldo,
                                          float* red, bf16_t* __restrict__ outb = nullptr) {
  const int tid = threadIdx.x, lane = tid & 63, wid = tid >> 6, fr = lane & 15, fq = lane >> 4;
  f32x4 acc = {0.f, 0.f, 0.f, 0.f};
  const bf16_t* ap = A + (size_t)fr * DM + wid * 256 + fq * 8;
  const bf16_t* bp = Bt + (size_t)fr * DM + wid * 256 + fq * 8;
#pragma unroll
  for (int ks = 0; ks < 8; ++ks) {
    const bf16x8 a = *(const bf16x8*)(ap + ks * 32);
    const bf16x8 b = *(const bf16x8*)(bp + ks * 32);
    acc = __builtin_amdgcn_mfma_f32_16x16x32_bf16(a, b, acc, 0, 0, 0);
  }
#pragma unroll
  for (int r = 0; r < 4; ++r) red[wid * 256 + (4 * fq + r) * 16 + fr] = acc[r];
  __syncthreads();
  if (tid < 256) {
    float s = 0.f;
#pragma unroll
    for (int w = 0; w < 8; ++w) s += red[w * 256 + tid];
    out[(size_t)(tid >> 4) * ldo + (tid & 15)] = s;
    if (outb) outb[(size_t)(tid >> 4) * ldo + (tid & 15)] = f2bf(s);
  }
  __syncthreads();
}

__device__ __forceinline__ void phase1(const Params& p, unsigned char* lds, int bid, int nblk) {
  const bf16_t* hnb = (const bf16_t*)(p.ws + WS_HNB);
  const bf16_t* w_inT = (const bf16_t*)(p.ws + WS_WINT);
  const bf16_t* w_dtT = (const bf16_t*)(p.ws + WS_WDTT);
  float* dtraw = (float*)(p.ws + WS_DTRAW);
  float* projm = (float*)(p.ws + WS_PROJM);
  constexpr int NU = 512 + 32 + 96 + 1;
  for (int u = bid; u < NU; u += nblk) {
    if (u < 512) {
      mini_gemm(hnb + (size_t)u * 16 * DM, w_dtT, dtraw + (size_t)u * 16 * 16, 16, (float*)lds);
    } else {
      const int j = u - 512;
      const int cf = j < 32 ? 64 + j : (j < 128 ? 160 + (j - 32) : 256);
      const bf16_t* bt = cf < 256 ? w_inT + (size_t)cf * 16 * DM : w_dtT;
      mini_gemm(hnb + (size_t)T * DM, bt, projm + cf * 16, DPROJ, (float*)lds, (bf16_t*)(p.ws + WS_PROJMB) + cf * 16);
    }
  }
  pg8::Gemm g{hnb, w_inT, T, NPROJ, DM};
  pg8::StaticOrder S; S.init(T, NPROJ, nblk, bid);
  pg8::EpiBf16 E{(bf16_t*)(p.ws + WS_PROJ), NPROJ};
  pg8::gemm_phase<pg8::EpiBf16, pg8::StaticOrder>((PG8_LAS unsigned char*)lds, g, S, E);
}

__device__ __forceinline__ void phase4(const Params& p, unsigned char* lds, int bid, int nblk) {
  pg8::Gemm g{(const bf16_t*)(p.ws + WS_HNB), (const bf16_t*)(p.ws + WS_WOUTT), T, DM, DM};
  pg8::StaticOrder S; S.init(T, DM, nblk, bid);
  pg8::EpiRes E{p.x, (bf16_t*)(p.ws + WS_H1B), (float*)(p.ws + WS_SSQH1)};
  pg8::gemm_phase<pg8::EpiRes, pg8::StaticOrder>((PG8_LAS unsigned char*)lds, g, S, E);
}
__device__ __forceinline__ void phase5(const Params& p, unsigned char* lds, int bid, int nblk) {
  pg8::Gemm g{(const bf16_t*)(p.ws + WS_H1B), (const bf16_t*)(p.ws + WS_WQT), T, DM, DM};
  pg8::StaticOrder S; S.init(T, DM, nblk, bid);
  pg8::EpiScores E{(const bf16_t*)(p.ws + WS_KEYS), (float*)(p.ws + WS_STOP), (int*)(p.ws + WS_ITOP)};
  pg8::gemm_phase<pg8::EpiScores, pg8::StaticOrder>((PG8_LAS unsigned char*)lds, g, S, E);
}

__device__ __forceinline__ float dot2bf(unsigned a, unsigned b, float c) {
  return __builtin_amdgcn_fdot2_f32_bf16(*(bf16v2*)&a, *(bf16v2*)&b, c, false);
}
__device__ __forceinline__ void phase6(const Params& p, unsigned char* lds, int bid, int nblk) {
  const int tid0 = threadIdx.x, lane0 = tid0 & 63, wid = __builtin_amdgcn_readfirstlane(tid0 >> 6);
  float* red = (float*)lds;
  float* gts = (float*)(lds + 65536);
  int* ids = (int*)(lds + 65536 + 512);
  float* wts = (float*)(lds + 65536 + 1024);
  float* red2 = (float*)(lds + 65536 + 1536);
  const unsigned char* ub = p.ws + WS_UB;
  const unsigned char* vb = p.ws + WS_VB;
  const bf16_t* h1b = (const bf16_t*)(p.ws + WS_H1B);
  const float* usc = (const float*)(p.ws + WS_USC);
  const float* vsc = (const float*)(p.ws + WS_VSC);
  const float* ssq = (const float*)(p.ws + WS_SSQH1);
  const float* stop = (const float*)(p.ws + WS_STOP);
  const int* itop = (const int*)(p.ws + WS_ITOP);
  const int ci = kCandI[lane0], cj = kCandJ[lane0];
  for (int t = bid; t < T; t += nblk) {
    int tid = tid0; asm volatile("" : "+v"(tid));
    const int lane = tid & 63;
    const int kcode = 4 * ((lane >> 3) & 1) + 2 * ((lane >> 4) & 1) + ((lane >> 5) & 1);
    const float part0 = lane < 32 ? ssq[(size_t)t * 32 + lane] : 0.f;
    const float rr = rsqrtf(wave_sum(part0) * (1.f / DM) + EPS);
    const size_t lbase = ((size_t)t * 16 + wid * 2) * 16;
    const float sv = lane < 32 ? stop[lbase + lane] : 0.f;
    const int iv = lane < 32 ? itop[lbase + lane] : 0;
    float cand = (__shfl(sv, ci) + __shfl(sv, 16 + cj)) * rr;
    if (lane >= 50) cand = -INFINITY;
    unsigned key = __float_as_uint(cand);
    key = (key & 0x80000000u) ? ~key : (key | 0x80000000u);
    key = (key & ~63u) | (unsigned)(63 - lane);
    int rank = 0;
#pragma unroll
    for (int k = 0; k < 50; ++k) {
      const unsigned kk = (unsigned)__builtin_amdgcn_readlane((int)key, k);
      rank += kk > key ? 1 : 0;
    }
    const float cmax = wave_max(cand);
    const float ex = rank < 16 ? __expf(cand - cmax) : 0.f;
    const float den = wave_sum(ex);
    const int eidx = __shfl(iv, ci) * 128 + __shfl(iv, 16 + cj);
    if (rank < 16) { ids[wid * 16 + rank] = eidx; gts[wid * 16 + rank] = ex / den; }
    float xf[32];
    {
      const bf16_t* xp = h1b + (size_t)t * DM + lane * 32;
#pragma unroll
      for (int j = 0; j < 4; ++j) {
        const u32x4 xa = *(const u32x4*)(xp + 8 * j);
        xf[8 * j + 0] = bflo(xa.x); xf[8 * j + 1] = bfhi(xa.x); xf[8 * j + 2] = bflo(xa.y); xf[8 * j + 3] = bfhi(xa.y);
        xf[8 * j + 4] = bflo(xa.z); xf[8 * j + 5] = bfhi(xa.z); xf[8 * j + 6] = bflo(xa.w); xf[8 * j + 7] = bfhi(xa.w);
      }
    }
#pragma unroll 1
    for (int half = 0; half < 2; ++half) {
      u32x4 ra[8]; u32x2 rb[8];
#pragma unroll
      for (int k = 0; k < 8; ++k) {
        const int e = __builtin_amdgcn_readfirstlane(ids[wid * 16 + half * 8 + k]);
        const unsigned char* rp = ub + (size_t)e * ROW6;
        ra[k] = *(const u32x4*)(rp + lane * 16); rb[k] = *(const u32x2*)(rp + 1024 + lane * 8);
      }
      float part[8];
      float prev = 0.f;
#pragma unroll
      for (int k = 0; k < 8; ++k) {
        asm volatile("" : "+v"(ra[k]), "+v"(rb[k]) : "v"(prev));
        const u32x6 pk = {ra[k].x, ra[k].y, ra[k].z, ra[k].w, rb[k].x, rb[k].y};
        const f32x32v r = __builtin_amdgcn_cvt_scalef32_pk32_f32_fp6(pk, 1.0f);
        float d0 = 0.f, d1 = 0.f;
#pragma unroll
        for (int i = 0; i < 32; i += 2) { d0 = fmaf(r[i], xf[i], d0); d1 = fmaf(r[i + 1], xf[i + 1], d1); }
        prev = d0 + d1;
        part[k] = prev;
      }
      float q4[4], q2[2], q1;
      { const bool hi = (lane >> 5) & 1;
#pragma unroll
        for (int i = 0; i < 4; ++i) { const float keep = hi ? part[2 * i + 1] : part[2 * i], send = hi ? part[2 * i] : part[2 * i + 1]; q4[i] = keep + __shfl_xor(send, 32); } }
      { const bool hi = (lane >> 4) & 1;
#pragma unroll
        for (int i = 0; i < 2; ++i) { const float keep = hi ? q4[2 * i + 1] : q4[2 * i], send = hi ? q4[2 * i] : q4[2 * i + 1]; q2[i] = keep + __shfl_xor(send, 16); } }
      { const bool hi = (lane >> 3) & 1;
        const float keep = hi ? q2[1] : q2[0], send = hi ? q2[0] : q2[1]; q1 = keep + __shfl_xor(send, 8); }
      q1 += __shfl_xor(q1, 4);
      q1 += __shfl_xor(q1, 2);
      q1 += __shfl_xor(q1, 1);
      {
        const int kk = half * 8 + kcode;
        const int eid = ids[wid * 16 + kk];
        const float a = q1 * rr * usc[eid];
        const float ge = 0.5f * a * (1.f + erff(a * 0.70710678118654752f));
        if ((lane & 7) == 0) wts[wid * 16 + kk] = gts[wid * 16 + kk] * ge * vsc[eid];
      }
    }
    float acc[32];
#pragma unroll
    for (int i = 0; i < 32; ++i) acc[i] = 0.f;
    {
      u32x4 ra[16];
#pragma unroll
      for (int k = 0; k < 16; ++k) {
        const int e = __builtin_amdgcn_readfirstlane(ids[wid * 16 + k]);
        ra[k] = *(const u32x4*)(vb + (size_t)e * ROW4 + lane * 16);
      }
      f32x4 wv[4];
#pragma unroll
      for (int j = 0; j < 4; ++j) wv[j] = *(const f32x4*)(wts + wid * 16 + 4 * j);
#pragma unroll
      for (int k = 0; k < 16; ++k) {
        const float wk = wv[k >> 2][k & 3];
        asm volatile("" : "+v"(ra[k]) : "v"(acc[1]), "v"(acc[3]), "v"(acc[5]), "v"(acc[7]), "v"(acc[9]), "v"(acc[11]), "v"(acc[13]), "v"(acc[15]),
                                        "v"(acc[17]), "v"(acc[19]), "v"(acc[21]), "v"(acc[23]), "v"(acc[25]), "v"(acc[27]), "v"(acc[29]), "v"(acc[31]));
#define V4_STEP(j, i) { const f32x2 r = __builtin_amdgcn_cvt_scalef32_pk_f32_fp4(ra[k][j], 1.0f, i); \
            acc[8 * (j) + 2 * (i)] = fmaf(wk, r[0], acc[8 * (j) + 2 * (i)]); acc[8 * (j) + 2 * (i) + 1] = fmaf(wk, r[1], acc[8 * (j) + 2 * (i) + 1]); }
#pragma unroll
        for (int j = 0; j < 4; ++j) { V4_STEP(j, 0) V4_STEP(j, 1) V4_STEP(j, 2) V4_STEP(j, 3) }
#undef V4_STEP
      }
    }
#pragma unroll
    for (int j = 0; j < 8; ++j) *(f32x4*)(red + ((wid * 8 + j) * 64 + lane) * 4) = (f32x4){acc[4 * j], acc[4 * j + 1], acc[4 * j + 2], acc[4 * j + 3]};
    __syncthreads();
    {
      const int col = 32 * lane + 4 * wid;
      const u32x2 hb = *(const u32x2*)(h1b + (size_t)t * DM + col);
      f32x4 s = {bflo(hb.x), bfhi(hb.x), bflo(hb.y), bfhi(hb.y)};
#pragma unroll
      for (int w = 0; w < 8; ++w) s += *(const f32x4*)(red + ((w * 8 + wid) * 64 + lane) * 4);
      float ss = wave_sum(s[0] * s[0] + s[1] * s[1] + s[2] * s[2] + s[3] * s[3]);
      if (lane == 0) red2[wid] = ss;
      __syncthreads();
      float tot = 0.f;
#pragma unroll
      for (int w = 0; w < 8; ++w) tot += red2[w];
      const float rf = rsqrtf(tot * (1.f / DM) + EPS);
      const f32x4 lw = *(const f32x4*)(p.ln_final + col);
      *(f32x4*)(p.out + (size_t)t * DM + col) = s * rf * lw;
    }
    __syncthreads();
  }
}

typedef float f32x16 __attribute__((ext_vector_type(16)));
constexpr int VT_LD = 196;
constexpr int ATT_VT_BYTES = 4 * 64 * VT_LD * 2;
__device__ __forceinline__ void attn_item(const Params& p, unsigned char* lds, int item) {
  const int tid = threadIdx.x, lane = tid & 63, wid = __builtin_amdgcn_readfirstlane(tid >> 6);
  const int b = item >> 6, q0 = (item & 63) * 32;
  bf16_t* VT = (bf16_t*)lds;
  float* biasL = (float*)(lds + ATT_VT_BYTES);
  float* ssqw = biasL + 16 * 132;
  const bf16_t* proj = (const bf16_t*)(p.ws + WS_PROJ);
  const float* projm = (const float*)(p.ws + WS_PROJM);
  bf16_t* mixin = (bf16_t*)(p.ws + WS_HNB);
  for (int idx = tid; idx < 16 * 129; idx += NTHREADS) {
    const int hq = idx / 129, d = idx - hq * 129;
    const int bk = d < 128 ? (int)kBucket[d] : 31;
    biasL[hq * 132 + d] = p.rel_bias[bk * 16 + hq];
  }
#pragma unroll 1
  for (int task = tid; task < 96 * 32; task += NTHREADS) {
    const int pi = task >> 5, ch = task & 31, slot0 = 2 * pi;
    float v0[8], v1[8];
    if (slot0 < 16) {
      const float* r0 = projm + (size_t)slot0 * DPROJ + OFF_V + ch * 8;
      const float* r1 = r0 + DPROJ;
#pragma unroll
      for (int i = 0; i < 8; ++i) { v0[i] = r0[i]; v1[i] = r1[i]; }
    } else if (slot0 < 32) {
#pragma unroll
      for (int i = 0; i < 8; ++i) { v0[i] = 0.f; v1[i] = 0.f; }
    } else {
      const int s0 = q0 - 128 + slot0 - 32;
      if (s0 < 0) {
#pragma unroll
        for (int i = 0; i < 8; ++i) { v0[i] = 0.f; v1[i] = 0.f; }
      } else {
        const bf16_t* r0 = proj + (size_t)(b * SEQ + s0) * NPROJ + OFF_V + ch * 8;
        const u32x4 a = *(const u32x4*)r0, c = *(const u32x4*)(r0 + NPROJ);
        v0[0] = bflo(a.x); v0[1] = bfhi(a.x); v0[2] = bflo(a.y); v0[3] = bfhi(a.y); v0[4] = bflo(a.z); v0[5] = bfhi(a.z); v0[6] = bflo(a.w); v0[7] = bfhi(a.w);
        v1[0] = bflo(c.x); v1[1] = bfhi(c.x); v1[2] = bflo(c.y); v1[3] = bfhi(c.y); v1[4] = bflo(c.z); v1[5] = bfhi(c.z); v1[6] = bflo(c.w); v1[7] = bfhi(c.w);
      }
    }
    bf16_t* dst = VT + (size_t)((ch >> 3) * 64 + (ch & 7) * 8) * VT_LD + slot0;
#pragma unroll
    for (int i = 0; i < 8; ++i) *(unsigned*)(dst + i * VT_LD) = pack_bf16(v0[i], v1[i]);
  }
  __syncthreads();
  const int ql = lane & 31, hh = lane >> 5, kvh = wid >> 1;
  const int trow = b * SEQ + q0 + ql;
  float ssq = 0.f;
#pragma unroll 1
  for (int hsel = 0; hsel < 2; ++hsel) {
    const int hq = 2 * wid + hsel;
    bf16x8 qf[4];
#pragma unroll
    for (int ks = 0; ks < 4; ++ks) qf[ks] = *(const bf16x8*)(proj + (size_t)trow * NPROJ + OFF_Q + hq * 64 + ks * 16 + hh * 8);
    f32x16 sacc[6];
#pragma unroll
    for (int jt = 0; jt < 6; ++jt) {
      f32x16 acc;
#pragma unroll
      for (int r = 0; r < 16; ++r) acc[r] = 0.f;
      if (jt == 0) {
        const float* kr = projm + (size_t)(ql & 15) * DPROJ + OFF_K + kvh * 64 + hh * 8;
#pragma unroll
        for (int ks = 0; ks < 4; ++ks) {
          const f32x4 a = *(const f32x4*)(kr + ks * 16), c = *(const f32x4*)(kr + ks * 16 + 4);
          u32x4 w; w.x = pack_bf16(a[0], a[1]); w.y = pack_bf16(a[2], a[3]); w.z = pack_bf16(c[0], c[1]); w.w = pack_bf16(c[2], c[3]);
          acc = __builtin_amdgcn_mfma_f32_32x32x16_bf16(*(bf16x8*)&w, qf[ks], acc, 0, 0, 0);
        }
      } else {
        int sp = q0 - 128 + 32 * (jt - 1) + ql;
        sp = sp < 0 ? 0 : sp;
        const bf16_t* kr = proj + (size_t)(b * SEQ + sp) * NPROJ + OFF_K + kvh * 64 + hh * 8;
#pragma unroll
        for (int ks = 0; ks < 4; ++ks) acc = __builtin_amdgcn_mfma_f32_32x32x16_bf16(*(const bf16x8*)(kr + ks * 16), qf[ks], acc, 0, 0, 0);
      }
      sacc[jt] = acc;
      asm volatile("" ::: "memory");
    }
    const float* bl = biasL + hq * 132;
    int sq = q0 + ql, qh = ql - 4 * hh;
    asm volatile("" : "+v"(sq), "+v"(qh));
    const float sink = p.sinks[hq];
    float m = sink;
#pragma unroll
    for (int jt = 0; jt < 6; ++jt) {
      asm volatile("" ::: "memory");
#pragma unroll
      for (int r = 0; r < 16; ++r) {
        const int kr = (r & 3) + 8 * (r >> 2) + 4 * hh;
        int dist; bool valid;
        if (jt == 0) { dist = sq + (16 - ((r & 3) + 8 * (r >> 2))) - 4 * hh; valid = kr < 16; }
        else { dist = qh + (128 - 32 * (jt - 1) - ((r & 3) + 8 * (r >> 2))); valid = (dist >= 0) && (dist < 128) && (dist <= sq); }
        const int dc = dist < 0 ? 0 : (dist > 128 ? 128 : dist);
        const float l = valid ? 0.125f * sacc[jt][r] + bl[dc] : -1e30f;
        sacc[jt][r] = l;
        m = fmaxf(m, l);
      }
    }
    m = fmaxf(m, __shfl_xor(m, 32));
    float sum = 0.f;
    f32x16 oacc0, oacc1;
#pragma unroll
    for (int r = 0; r < 16; ++r) { oacc0[r] = 0.f; oacc1[r] = 0.f; }
    const bf16_t* vrow0 = VT + (size_t)(kvh * 64 + ql) * VT_LD + 4 * hh;
    const bf16_t* vrow1 = vrow0 + 32 * VT_LD;
#pragma unroll
    for (int jt = 0; jt < 6; ++jt) {
      u32x4 pw[2];
#pragma unroll
      for (int s2 = 0; s2 < 2; ++s2) {
        float e[8];
#pragma unroll
        for (int i = 0; i < 8; ++i) { e[i] = __expf(sacc[jt][8 * s2 + i] - m); sum += e[i]; }
        pw[s2].x = pack_bf16(e[0], e[1]); pw[s2].y = pack_bf16(e[2], e[3]); pw[s2].z = pack_bf16(e[4], e[5]); pw[s2].w = pack_bf16(e[6], e[7]);
      }
#pragma unroll
      for (int s2 = 0; s2 < 2; ++s2) {
        const u32x2 va = *(const u32x2*)(vrow0 + 32 * jt + 16 * s2), vc = *(const u32x2*)(vrow0 + 32 * jt + 16 * s2 + 8);
        const u32x2 vd = *(const u32x2*)(vrow1 + 32 * jt + 16 * s2), ve = *(const u32x2*)(vrow1 + 32 * jt + 16 * s2 + 8);
        u32x4 v0w; v0w.x = va.x; v0w.y = va.y; v0w.z = vc.x; v0w.w = vc.y;
        u32x4 v1w; v1w.x = vd.x; v1w.y = vd.y; v1w.z = ve.x; v1w.w = ve.y;
        oacc0 = __builtin_amdgcn_mfma_f32_32x32x16_bf16(*(bf16x8*)&v0w, *(bf16x8*)&pw[s2], oacc0, 0, 0, 0);
        oacc1 = __builtin_amdgcn_mfma_f32_32x32x16_bf16(*(bf16x8*)&v1w, *(bf16x8*)&pw[s2], oacc1, 0, 0, 0);
      }
    }
    sum += __shfl_xor(sum, 32);
    const float inv = 1.f / (sum + __expf(sink - m));
#pragma unroll
    for (int r = 0; r < 16; ++r) { oacc0[r] *= inv; oacc1[r] *= inv; ssq += oacc0[r] * oacc0[r] + oacc1[r] * oacc1[r]; }
#pragma unroll
    for (int rg = 0; rg < 4; ++rg) {
      u32x2 w; w.x = pack_bf16(oacc0[rg * 4 + 0], oacc0[rg * 4 + 1]); w.y = pack_bf16(oacc0[rg * 4 + 2], oacc0[rg * 4 + 3]);
      *(u32x2*)(mixin + (size_t)trow * DM + hq * 64 + 8 * rg + 4 * hh) = w;
      u32x2 w1; w1.x = pack_bf16(oacc1[rg * 4 + 0], oacc1[rg * 4 + 1]); w1.y = pack_bf16(oacc1[rg * 4 + 2], oacc1[rg * 4 + 3]);
      *(u32x2*)(mixin + (size_t)trow * DM + hq * 64 + 32 + 8 * rg + 4 * hh) = w1;
    }
  }
  ssq += __shfl_xor(ssq, 32);
  if (lane < 32) ssqw[wid * 32 + lane] = ssq;
  __syncthreads();
  float tot = 0.f;
#pragma unroll
  for (int w = 0; w < 8; ++w) tot += ssqw[w * 32 + ql];
  const float ra = rsqrtf(tot * (1.f / 1024) + EPS);
#pragma unroll
  for (int hsel = 0; hsel < 2; ++hsel)
#pragma unroll
    for (int dt = 0; dt < 2; ++dt)
#pragma unroll
      for (int rg = 0; rg < 4; ++rg) {
        bf16_t* op = mixin + (size_t)trow * DM + (2 * wid + hsel) * 64 + 32 * dt + 8 * rg + 4 * hh;
        const u32x2 v = *(const u32x2*)op;
        u32x2 w; w.x = pack_bf16(bflo(v.x) * ra, bfhi(v.x) * ra); w.y = pack_bf16(bflo(v.y) * ra, bfhi(v.y) * ra);
        *(u32x2*)op = w;
      }
  __syncthreads();
}
__device__ __forceinline__ void phase2_attn(const Params& p, unsigned char* lds, int bid, int nblk) {
  for (int item = bid; item < 256; item += nblk) attn_item(p, lds, item);
}

constexpr int SLD = 136;
__device__ __forceinline__ void unpack8(const u32x4 a, float (&v)[8]) {
  v[0] = bflo(a.x); v[1] = bfhi(a.x); v[2] = bflo(a.y); v[3] = bfhi(a.y); v[4] = bflo(a.z); v[5] = bfhi(a.z); v[6] = bflo(a.w); v[7] = bfhi(a.w);
}
__device__ __forceinline__ float conv_silu(const float (&raw)[11], int i, float w0, float w1, float w2, float w3, float cb) {
  return silu_f(cb + w0 * raw[i] + w1 * raw[i + 1] + w2 * raw[i + 2] + w3 * raw[i + 3]);
}
__device__ __forceinline__ void ssd_a_item(const Params& p, unsigned char* lds, int item) {
  const int tid = threadIdx.x, lane = tid & 63, wid = __builtin_amdgcn_readfirstlane(tid >> 6);
  const int b = item >> 6, c = (item >> 2) & 15, g = (item >> 1) & 1, hsel = item & 1;
  const int h0 = g * 8 + hsel * 4;
  const int t0 = b * SEQ + c * 128;
  bf16_t* Bc = (bf16_t*)lds;
  bf16_t* Cc = Bc + 128 * SLD;
  bf16_t* BcT = Cc + 128 * SLD;
  bf16_t* xT = BcT + 128 * SLD;
  float* dtl = (float*)(xT + 2 * 64 * SLD);
  float* acs = dtl + 512;
  float* wl = acs + 512;
  float* scan = wl + 512;
  const bf16_t* __restrict__ proj = (const bf16_t*)(p.ws + WS_PROJ);
  const bf16_t* __restrict__ projmb = (const bf16_t*)(p.ws + WS_PROJMB);
  const float* __restrict__ dtraw = (const float*)(p.ws + WS_DTRAW);
  float* __restrict__ acsg = (float*)(p.ws + WS_ACSG);
  bf16_t* __restrict__ ccb = (bf16_t*)(p.ws + WS_CCB);
  float* __restrict__ ypart = (float*)(p.ws + WS_YPART);
  float* __restrict__ sg = (float*)(p.ws + WS_SG);
  {
    const int hi = tid >> 7, l = tid & 127, h = h0 + hi;
    const float Ah = -expf(p.a_log[h]);
    const float dtv = softplus_f(dtraw[(size_t)(t0 + l) * 16 + h] + p.dt_bias[h]);
    dtl[tid] = dtv;
    float cum = dtv * Ah;
#pragma unroll
    for (int o = 1; o < 64; o <<= 1) { const float nb = __shfl_up(cum, o); if (lane >= o) cum += nb; }
    if ((tid & 127) == 63) scan[hi] = cum;
    __syncthreads();
    if (l >= 64) cum += scan[hi];
    acs[tid] = cum;
    acsg[(size_t)(t0 + l) * 16 + h] = cum;
    __syncthreads();
    wl[tid] = dtv * __expf(acs[hi * 128 + 127] - cum);
  }
#pragma unroll 1
  for (int rnd = 0; rnd < 2; ++rnd) {
    float raw[4][11];
#pragma unroll
    for (int q = 0; q < 4; ++q) {
      const int task = (rnd * 4 + q) * NTHREADS + tid;
      const int tg = task >> 8, ch = task & 255;
      const int cch = 1024 + (ch >> 7) * 256 + g * 128 + (ch & 127);
#pragma unroll
      for (int i = 0; i < 11; ++i) {
        const int l = tg * 8 + i - 3;
        const bf16_t* src = (l >= 0 || c > 0) ? proj + (size_t)(t0 + l) * NPROJ : projmb + (size_t)(16 + l) * DPROJ;
        raw[q][i] = bf2f(src[OFF_XBC + cch]);
      }
    }
#pragma unroll
    for (int q = 0; q < 4; ++q) {
      const int task = (rnd * 4 + q) * NTHREADS + tid;
      const int tg = task >> 8, ch = task & 255, n = ch & 127;
      const int cch = 1024 + (ch >> 7) * 256 + g * 128 + n;
      const float w0 = p.conv_w[cch], w1 = p.conv_w[D_XBC + cch], w2 = p.conv_w[2 * D_XBC + cch], w3 = p.conv_w[3 * D_XBC + cch], cb = p.conv_b[cch];
      float o[8];
#pragma unroll
      for (int i = 0; i < 8; ++i) o[i] = conv_silu(raw[q], i, w0, w1, w2, w3, cb);
      if (ch < 128) {
#pragma unroll
        for (int i = 0; i < 8; ++i) Bc[(tg * 8 + i) * SLD + n] = f2bf(o[i]);
        u32x4 w; w.x = pack_bf16(o[0], o[1]); w.y = pack_bf16(o[2], o[3]); w.z = pack_bf16(o[4], o[5]); w.w = pack_bf16(o[6], o[7]);
        *(u32x4*)(BcT + n * SLD + tg * 8) = w;
      } else {
#pragma unroll
        for (int i = 0; i < 8; ++i) Cc[(tg * 8 + i) * SLD + n] = f2bf(o[i]);
      }
    }
  }
  float xraw[2][11];
#define SSD_LOAD_X(hi_)                                                                                             \
  _Pragma("unroll") for (int q = 0; q < 2; ++q) {                                                                   \
    const int task = q * NTHREADS + tid; const int tg = task >> 6, cch = (h0 + (hi_)) * 64 + (task & 63);           \
    _Pragma("unroll") for (int i = 0; i < 11; ++i) { const int l = tg * 8 + i - 3;                                  \
      const bf16_t* src = (l >= 0 || c > 0) ? proj + (size_t)(t0 + l) * NPROJ : projmb + (size_t)(16 + l) * DPROJ;          \
      xraw[q][i] = bf2f(src[OFF_XBC + cch]); } }
  SSD_LOAD_X(0)
  __syncthreads();
  if (hsel == 0) {
#pragma unroll
    for (int q = 0; q < 4; ++q) {
      const int idx = q * NTHREADS + tid, row = idx >> 4, ck = idx & 15;
      *(u32x4*)(ccb + (size_t)(t0 + row) * 256 + g * 128 + ck * 8) = *(const u32x4*)(Cc + row * SLD + ck * 8);
    }
  }
  const int ql = lane & 31, hh = lane >> 5;
#pragma unroll 1
  for (int hi = 0; hi < 4; ++hi) {
    const int h = h0 + hi;
    bf16_t* xTb = xT + (hi & 1) * 64 * SLD;
#pragma unroll
    for (int q = 0; q < 2; ++q) {
      const int task = q * NTHREADS + tid; const int tg = task >> 6, pch = task & 63, cch = h * 64 + pch;
      const float w0 = p.conv_w[cch], w1 = p.conv_w[D_XBC + cch], w2 = p.conv_w[2 * D_XBC + cch], w3 = p.conv_w[3 * D_XBC + cch], cb = p.conv_b[cch];
      float o[8];
#pragma unroll
      for (int i = 0; i < 8; ++i) o[i] = conv_silu(xraw[q], i, w0, w1, w2, w3, cb);
      u32x4 w; w.x = pack_bf16(o[0], o[1]); w.y = pack_bf16(o[2], o[3]); w.z = pack_bf16(o[4], o[5]); w.w = pack_bf16(o[6], o[7]);
      *(u32x4*)(xTb + pch * SLD + tg * 8) = w;
    }
    if (hi < 3) { SSD_LOAD_X(hi + 1) }
    __syncthreads();
    const float dskip = p.d_skip[h];
    const float* acsh = acs + hi * 128;
    const float* dtlh = dtl + hi * 128;
    const float* wlh = wl + hi * 128;
    {
      const int ip = wid & 1, il = wid >> 1;
      const int l = 32 * il + ql;
      const float acl = acsh[l];
      f32x16 yacc;
#pragma unroll
      for (int r = 0; r < 16; ++r) yacc[r] = 0.f;
      const bf16_t* xrow = xTb + (32 * ip + ql) * SLD + 4 * hh;
#pragma unroll 1
      for (int is = 0; is <= il; ++is) {
        f32x16 x;
#pragma unroll
        for (int r = 0; r < 16; ++r) x[r] = 0.f;
        const bf16_t* ap = Bc + (32 * is + ql) * SLD + 8 * hh;
        const bf16_t* bp = Cc + l * SLD + 8 * hh;
#pragma unroll
        for (int ks = 0; ks < 8; ++ks) x = __builtin_amdgcn_mfma_f32_32x32x16_bf16(*(const bf16x8*)(ap + 16 * ks), *(const bf16x8*)(bp + 16 * ks), x, 0, 0, 0);
        u32x4 pw[2];
#pragma unroll
        for (int s2 = 0; s2 < 2; ++s2) {
          float mv[8];
#pragma unroll
          for (int q = 0; q < 2; ++q) {
            const int sb = 32 * is + 16 * s2 + 8 * q + 4 * hh;
            const f32x4 as4 = *(const f32x4*)(acsh + sb), dt4 = *(const f32x4*)(dtlh + sb);
#pragma unroll
            for (int j = 0; j < 4; ++j) {
              const int sr = sb + j;
              float v = sr <= l ? x[8 * s2 + 4 * q + j] * __expf(acl - as4[j]) * dt4[j] : 0.f;
              if (sr == l) v += dskip;
              mv[4 * q + j] = v;
            }
          }
          pw[s2].x = pack_bf16(mv[0], mv[1]); pw[s2].y = pack_bf16(mv[2], mv[3]); pw[s2].z = pack_bf16(mv[4], mv[5]); pw[s2].w = pack_bf16(mv[6], mv[7]);
        }
#pragma unroll
        for (int s2 = 0; s2 < 2; ++s2) {
          const u32x2 va = *(const u32x2*)(xrow + 32 * is + 16 * s2), vc = *(const u32x2*)(xrow + 32 * is + 16 * s2 + 8);
          u32x4 aw; aw.x = va.x; aw.y = va.y; aw.z = vc.x; aw.w = vc.y;
          yacc = __builtin_amdgcn_mfma_f32_32x32x16_bf16(*(bf16x8*)&aw, *(bf16x8*)&pw[s2], yacc, 0, 0, 0);
        }
      }
      float* yp = ypart + (size_t)(t0 + l) * 1024 + h * 64 + 32 * ip + 4 * hh;
#pragma unroll
      for (int rg = 0; rg < 4; ++rg) *(f32x4*)(yp + 8 * rg) = (f32x4){yacc[4 * rg], yacc[4 * rg + 1], yacc[4 * rg + 2], yacc[4 * rg + 3]};
    }
    {
      const int ip = wid & 1, in = wid >> 1;
      f32x16 sacc;
#pragma unroll
      for (int r = 0; r < 16; ++r) sacc[r] = 0.f;
      const bf16_t* ap = xTb + (32 * ip + ql) * SLD + 8 * hh;
      const bf16_t* bp = BcT + (32 * in + ql) * SLD + 8 * hh;
#pragma unroll
      for (int ks = 0; ks < 8; ++ks) {
        const u32x4 xa = *(const u32x4*)(ap + 16 * ks);
        const f32x4 wa = *(const f32x4*)(wlh + 16 * ks + 8 * hh), wb = *(const f32x4*)(wlh + 16 * ks + 8 * hh + 4);
        u32x4 aw;
        aw.x = pack_bf16(bflo(xa.x) * wa[0], bfhi(xa.x) * wa[1]); aw.y = pack_bf16(bflo(xa.y) * wa[2], bfhi(xa.y) * wa[3]);
        aw.z = pack_bf16(bflo(xa.z) * wb[0], bfhi(xa.z) * wb[1]); aw.w = pack_bf16(bflo(xa.w) * wb[2], bfhi(xa.w) * wb[3]);
        sacc = __builtin_amdgcn_mfma_f32_32x32x16_bf16(*(bf16x8*)&aw, *(const bf16x8*)(bp + 16 * ks), sacc, 0, 0, 0);
      }
      float* sp = sg + ((size_t)((b * 16 + c) * 16 + h) * 64 + 32 * ip + 4 * hh) * 128 + 32 * in + ql;
#pragma unroll
      for (int r = 0; r < 16; ++r) sp[((r & 3) + 8 * (r >> 2)) * 128] = sacc[r];
    }
  }
#undef SSD_LOAD_X
  __syncthreads();
}

__device__ __forceinline__ void meta_state_item(const Params& p, unsigned char* lds, int h) {
  const int tid = threadIdx.x, g = h >> 3;
  float* xm = (float*)lds;
  float* bm = xm + 16 * 64;
  float* dtm = bm + 16 * 128;
  const float* projm = (const float*)(p.ws + WS_PROJM);
  float* smeta = (float*)(p.ws + WS_SMETA);
  for (int task = tid; task < 16 * 192; task += NTHREADS) {
    const int i = task / 192, ch = task - i * 192;
    const int cch = ch < 64 ? h * 64 + ch : 1024 + g * 128 + (ch - 64);
    float acc = p.conv_b[cch];
#pragma unroll
    for (int j = 0; j < 4; ++j) { const int mi = i - j; if (mi >= 0) acc += p.conv_w[(3 - j) * D_XBC + cch] * projm[(size_t)mi * DPROJ + OFF_XBC + cch]; }
    const float v = silu_f(acc);
    if (ch < 64) xm[i * 64 + ch] = v; else bm[i * 128 + ch - 64] = v;
  }
  if (tid < 16) dtm[tid] = softplus_f(projm[(size_t)tid * DPROJ + OFF_DT + h] + p.dt_bias[h]);
  __syncthreads();
  const float Ah = -expf(p.a_log[h]);
  const int pr = tid >> 3, n0 = (tid & 7) * 16;
  float st[16];
#pragma unroll
  for (int k = 0; k < 16; ++k) st[k] = 0.f;
  for (int i = 0; i < 16; ++i) {
    const float dtv = dtm[i], dA = expf(dtv * Ah), xdt = xm[i * 64 + pr] * dtv;
#pragma unroll
    for (int k = 0; k < 16; ++k) st[k] = fmaf(st[k], dA, xdt * bm[i * 128 + n0 + k]);
  }
#pragma unroll
  for (int k = 0; k < 16; ++k) smeta[(size_t)(h * 64 + pr) * 128 + n0 + k] = st[k];
  __syncthreads();
}

__device__ __forceinline__ void phase2(const Params& p, unsigned char* lds, int bid, int nblk) {
#ifndef REP_SUB
#define REP_SUB -1
#endif
#pragma unroll 1
  for (int rep = 0; rep < (REP_SUB == 0 ? 2 : 1); ++rep)
    for (int item = bid; item < 256; item += nblk) attn_item(p, lds, item);
#pragma unroll 1
  for (int rep = 0; rep < (REP_SUB == 1 ? 2 : 1); ++rep)
    for (int item = bid; item < 256; item += nblk) ssd_a_item(p, lds, item);
  for (int item = bid; item < 16; item += nblk) meta_state_item(p, lds, item);
}

__device__ __forceinline__ void phase_scan(const Params& p, int bid, int nblk) {
  const float* __restrict__ sg = (const float*)(p.ws + WS_SG);
  const float* __restrict__ smeta = (const float*)(p.ws + WS_SMETA);
  const float* __restrict__ acsg = (const float*)(p.ws + WS_ACSG);
  bf16_t* __restrict__ hprev = (bf16_t*)(p.ws + WS_HPREV);
  for (int task = bid * NTHREADS + threadIdx.x; task < 64 * 2048; task += nblk * NTHREADS) {
    const int bh = task >> 11, e4 = (task & 2047) * 4;
    const int b = bh >> 4, h = bh & 15;
    f32x4 sv[16];
    float dv[16];
#pragma unroll
    for (int c = 0; c < 16; ++c) {
      sv[c] = *(const f32x4*)(sg + (size_t)((b * 16 + c) * 16 + h) * 8192 + e4);
      dv[c] = acsg[(size_t)(b * SEQ + c * 128 + 127) * 16 + h];
    }
    f32x4 H = *(const f32x4*)(smeta + (size_t)h * 8192 + e4);
#pragma unroll
    for (int c = 0; c < 16; ++c) {
      u32x2 w; w.x = pack_bf16(H[0], H[1]); w.y = pack_bf16(H[2], H[3]);
      *(u32x2*)(hprev + (size_t)((b * 16 + c) * 16 + h) * 8192 + e4) = w;
      H = H * __expf(dv[c]) + sv[c];
    }
  }
}

__device__ __forceinline__ void ssd_b_item(const Params& p, unsigned char* lds, int item) {
  const int tid = threadIdx.x, lane = tid & 63, wid = __builtin_amdgcn_readfirstlane(tid >> 6);
  const int b = item >> 5, c = (item >> 1) & 15, g = item & 1, h = g * 8 + wid;
  const int t0 = b * SEQ + c * 128;
  const int ql = lane & 31, hh = lane >> 5;
  float* ssqg = (float*)lds;
  const bf16_t* proj = (const bf16_t*)(p.ws + WS_PROJ);
  const float* acsg = (const float*)(p.ws + WS_ACSG);
  const bf16_t* ccb = (const bf16_t*)(p.ws + WS_CCB);
  const float* ypart = (const float*)(p.ws + WS_YPART);
  const bf16_t* hprev = (const bf16_t*)(p.ws + WS_HPREV);
  bf16_t* mixin = (bf16_t*)(p.ws + WS_HNB);
  float ssql[4] = {0.f, 0.f, 0.f, 0.f};
#pragma unroll 1
  for (int ip = 0; ip < 2; ++ip) {
    u32x4 hfr[8];
    {
      const bf16_t* hp = hprev + (size_t)((b * 16 + c) * 16 + h) * 8192 + (size_t)(32 * ip + ql) * 128 + 8 * hh;
#pragma unroll
      for (int ks = 0; ks < 8; ++ks) hfr[ks] = *(const u32x4*)(hp + 16 * ks);
    }
#pragma unroll
    for (int il = 0; il < 4; ++il) {
      const int t = t0 + 32 * il + ql;
      f32x16 acc;
#pragma unroll
      for (int r = 0; r < 16; ++r) acc[r] = 0.f;
      const bf16_t* cp = ccb + (size_t)t * 256 + g * 128 + 8 * hh;
#pragma unroll
      for (int ks = 0; ks < 8; ++ks) acc = __builtin_amdgcn_mfma_f32_32x32x16_bf16(*(bf16x8*)&hfr[ks], *(const bf16x8*)(cp + 16 * ks), acc, 0, 0, 0);
      const float ea = __expf(acsg[(size_t)t * 16 + h]);
#pragma unroll
      for (int rg = 0; rg < 4; ++rg) {
        const int pp = h * 64 + 32 * ip + 8 * rg + 4 * hh;
        const f32x4 yp = *(const f32x4*)(ypart + (size_t)t * 1024 + pp);
        const u32x2 zz = *(const u32x2*)(proj + (size_t)t * NPROJ + OFF_Z + pp);
        const float y0 = (yp[0] + ea * acc[4 * rg + 0]) * silu_f(bflo(zz.x)), y1 = (yp[1] + ea * acc[4 * rg + 1]) * silu_f(bfhi(zz.x));
        const float y2 = (yp[2] + ea * acc[4 * rg + 2]) * silu_f(bflo(zz.y)), y3 = (yp[3] + ea * acc[4 * rg + 3]) * silu_f(bfhi(zz.y));
        ssql[il] += y0 * y0 + y1 * y1 + y2 * y2 + y3 * y3;
        u32x2 w; w.x = pack_bf16(y0, y1); w.y = pack_bf16(y2, y3);
        *(u32x2*)(mixin + (size_t)t * DM + 1024 + pp) = w;
      }
    }
  }
#pragma unroll
  for (int il = 0; il < 4; ++il) {
    float v = ssql[il];
    v += __shfl_xor(v, 32);
    if (lane < 32) ssqg[wid * 128 + 32 * il + lane] = v;
  }
  __syncthreads();
#pragma unroll
  for (int il = 0; il < 4; ++il) {
    float tot = 0.f;
#pragma unroll
    for (int w = 0; w < 8; ++w) tot += ssqg[w * 128 + 32 * il + ql];
    const float rg_ = rsqrtf(tot * (1.f / 512) + EPS);
    const int t = t0 + 32 * il + ql;
#pragma unroll
    for (int ip = 0; ip < 2; ++ip)
#pragma unroll
      for (int rg = 0; rg < 4; ++rg) {
        bf16_t* op = mixin + (size_t)t * DM + 1024 + h * 64 + 32 * ip + 8 * rg + 4 * hh;
        const u32x2 v = *(const u32x2*)op;
        u32x2 w; w.x = pack_bf16(bflo(v.x) * rg_, bfhi(v.x) * rg_); w.y = pack_bf16(bflo(v.y) * rg_, bfhi(v.y) * rg_);
        *(u32x2*)op = w;
      }
  }
  __syncthreads();
}
__device__ __forceinline__ void phase3(const Params& p, unsigned char* lds, int bid, int nblk) {
  for (int item = bid; item < 128; item += nblk) ssd_b_item(p, lds, item);
}

constexpr int LDS_BYTES = 144 * 1024;

typedef const Params __attribute__((address_space(4))) * KArgPtr;
__device__ __forceinline__ Params load_params(KArgPtr k) {
  Params q;
#if defined(__HIP_DEVICE_COMPILE__)
  __builtin_memcpy(&q, k, sizeof(Params));
#endif
  return q;
}
#define PARAMS_PTR(pp) KArgPtr pp##_k = (KArgPtr)__builtin_amdgcn_kernarg_segment_ptr(); asm volatile("" : "+s"(pp##_k)); const Params pp##_v = load_params(pp##_k); const Params* pp = &pp##_v
__global__ __launch_bounds__(512, 2) void k_mega(Params p_unused) {
  extern __shared__ __attribute__((aligned(16))) unsigned char shm[];
  cooperative_groups::grid_group grid = cooperative_groups::this_grid();
  const int bid = blockIdx.x, nblk = gridDim.x;
  volatile LAS unsigned* xst = (volatile LAS unsigned*)(LAS unsigned char*)(shm + LDS_BYTES - 16);
  if (threadIdx.x == 0) { xst[0] = 0u; xst[1] = 0u; }
  __syncthreads();
  XcdBarrier xb;
  { PARAMS_PTR(pp); xb = xcd_barrier_post((unsigned*)(pp->ws + WS_CTL), xst); }
#ifndef REP_PHASE
#define REP_PHASE -1
#endif
#define NREP(k) ((REP_PHASE == (k)) ? 2 : 1)
#pragma unroll 1
  for (int rep = 0; rep < NREP(0); ++rep) { { PARAMS_PTR(pp); phase0(*pp, (float*)shm, bid, nblk); } if (rep + 1 < NREP(0)) xcd_barrier(xb); }
  grid.sync();
#pragma unroll 1
  for (int rep = 0; rep < NREP(1); ++rep) { { PARAMS_PTR(pp); phase1(*pp, shm, bid, nblk); } xcd_barrier(xb); }
#pragma unroll 1
  for (int rep = 0; rep < NREP(2); ++rep) { { PARAMS_PTR(pp); phase2(*pp, shm, bid, nblk); } xcd_barrier(xb); }
#pragma unroll 1
  for (int rep = 0; rep < NREP(7); ++rep) { { PARAMS_PTR(pp); phase_scan(*pp, bid, nblk); } xcd_barrier(xb); }
#pragma unroll 1
  for (int rep = 0; rep < NREP(3); ++rep) { { PARAMS_PTR(pp); phase3(*pp, shm, bid, nblk); } xcd_barrier(xb); }
#pragma unroll 1
  for (int rep = 0; rep < NREP(4); ++rep) { { PARAMS_PTR(pp); phase4(*pp, shm, bid, nblk); } xcd_barrier(xb); }
#pragma unroll 1
  for (int rep = 0; rep < NREP(5); ++rep) { { PARAMS_PTR(pp); phase5(*pp, shm, bid, nblk); } xcd_barrier(xb); }
#pragma unroll 1
  for (int rep = 0; rep < NREP(6); ++rep) { { PARAMS_PTR(pp); phase6(*pp, shm, bid, nblk); } if (rep + 1 < NREP(6)) xcd_barrier(xb); }
}

}

extern "C" void kernel_launch(void* const* d_in, const int* in_sizes, int n_in, void* d_out, int out_size, void* d_ws,
                              size_t ws_size, hipStream_t stream) {
  Params p{};
  p.x = (const float*)d_in[0]; p.meta = (const float*)d_in[1]; p.rel_bias = (const float*)d_in[2];
  p.ln_mix = (const float*)d_in[3]; p.w_in = (const float*)d_in[4]; p.sinks = (const float*)d_in[5];
  p.conv_w = (const float*)d_in[6]; p.conv_b = (const float*)d_in[7]; p.dt_bias = (const float*)d_in[8];
  p.a_log = (const float*)d_in[9]; p.d_skip = (const float*)d_in[10]; p.attn_norm_w = (const float*)d_in[11];
  p.ssm_norm_w = (const float*)d_in[12]; p.w_out = (const float*)d_in[13]; p.ln_ffn = (const float*)d_in[14];
  p.wq = (const float*)d_in[15]; p.keys = (const float*)d_in[16]; p.U = (const float*)d_in[17];
  p.V = (const float*)d_in[18]; p.ln_final = (const float*)d_in[19];
  p.out = (float*)d_out;
  p.ws = (unsigned char*)d_ws;

  static int grid_blocks = 0;
  if (!grid_blocks) {
    int dev = 0, cus = 0, per_cu = 0;
    (void)hipGetDevice(&dev);
    (void)hipDeviceGetAttribute(&cus, hipDeviceAttributeMultiprocessorCount, dev);
    (void)hipFuncSetAttribute((const void*)k_mega, hipFuncAttributeMaxDynamicSharedMemorySize, LDS_BYTES);
    (void)hipOccupancyMaxActiveBlocksPerMultiprocessor(&per_cu, (const void*)k_mega, NTHREADS, LDS_BYTES);
    if (per_cu > 1) per_cu = 1;
    grid_blocks = cus * per_cu;
    if (grid_blocks != 256) fprintf(stderr, "kernel_launch: expected a 256-workgroup resident grid, got %d (cus %d, per_cu %d)\n", grid_blocks, cus, per_cu);
  }
  (void)hipMemsetAsync(p.ws + WS_CTL, 0, XCD_BAR_WORDS * 4, stream);
  void* args[] = {&p};
  hipError_t e = hipLaunchCooperativeKernel((const void*)k_mega, dim3(grid_blocks), dim3(NTHREADS), args, LDS_BYTES, stream);
  if (e != hipSuccess) fprintf(stderr, "cooperative launch failed: %s (grid %d)\n", hipGetErrorString(e), grid_blocks);
}
```

```cpp
#include <hip/hip_runtime.h>
#include <hip/hip_cooperative_groups.h>
#include <math.h>
#include <stdio.h>
#include <stdint.h>

namespace {
constexpr int BATCH = 4, SEQ = 2048, DM = 2048, NMETA = 16;
constexpr int T = BATCH * SEQ;
constexpr int TA = T + NMETA;
constexpr int DPROJ = 4112;
constexpr int NPROJ = 4096;
constexpr int OFF_Q = 0, OFF_K = 1024, OFF_V = 1280, OFF_Z = 1536, OFF_XBC = 2560, OFF_DT = 4096;
constexpr int D_XBC = 1536;
constexpr int NEXP = 16384;
constexpr int ROW4 = 1024;
constexpr int ROW6 = 1536;
constexpr float EPS = 1e-6f;
constexpr int NTHREADS = 512;

typedef unsigned short bf16_t;
typedef short bf16x8 __attribute__((ext_vector_type(8)));
typedef float f32x4 __attribute__((ext_vector_type(4)));
typedef float f32x2 __attribute__((ext_vector_type(2)));
typedef unsigned u32x4 __attribute__((ext_vector_type(4)));
typedef unsigned u32x2 __attribute__((ext_vector_type(2)));
typedef __bf16 bf16v2 __attribute__((ext_vector_type(2)));
typedef float f32x16v __attribute__((ext_vector_type(16)));
typedef float f32x32v __attribute__((ext_vector_type(32)));
typedef unsigned u32x6 __attribute__((ext_vector_type(6)));
#define LAS __attribute__((address_space(3)))

__device__ __forceinline__ unsigned pack_bf16(float lo, float hi) {
  f32x2 v = {lo, hi};
  bf16v2 b = __builtin_convertvector(v, bf16v2);
  return *(unsigned*)&b;
}
__device__ __forceinline__ bf16_t f2bf(float f) { return (bf16_t)(pack_bf16(f, 0.f) & 0xffffu); }
__device__ __forceinline__ float bf2f(bf16_t b) { return __uint_as_float(((unsigned)b) << 16); }
__device__ __forceinline__ float bflo(unsigned u) { return __uint_as_float(u << 16); }
__device__ __forceinline__ float bfhi(unsigned u) { return __uint_as_float(u & 0xffff0000u); }

__constant__ unsigned char kBucket[128] = {
    0, 1, 2, 3, 4, 5, 6, 7, 8, 9, 10, 11, 12, 13, 14, 15, 16, 16, 16, 17, 17, 18, 18, 18, 19, 19, 19, 20, 20, 20, 20, 21,
    21, 21, 21, 22, 22, 22, 22, 22, 23, 23, 23, 23, 23, 23, 24, 24, 24, 24, 24, 24, 25, 25, 25, 25, 25, 25, 25, 26, 26, 26, 26, 26,
    26, 26, 26, 27, 27, 27, 27, 27, 27, 27, 27, 27, 27, 28, 28, 28, 28, 28, 28, 28, 28, 28, 28, 29, 29, 29, 29, 29, 29, 29, 29, 29,
    29, 29, 29, 30, 30, 30, 30, 30, 30, 30, 30, 30, 30, 30, 30, 30, 30, 31, 31, 31, 31, 31, 31, 31, 31, 31, 31, 31, 31, 31, 31, 31};

__constant__ unsigned char kCandI[64] = {0, 0, 0, 0, 0, 0, 0, 0, 0, 0, 0, 0, 0, 0, 0, 0, 1, 1, 1, 1, 1, 1, 1, 1, 2, 2, 2, 2, 2, 3, 3, 3, 3, 4, 4, 4, 5, 5, 6, 6, 7, 7, 8, 9, 10, 11, 12, 13, 14, 15, 15, 15, 15, 15, 15, 15, 15, 15, 15, 15, 15, 15, 15, 15};
__constant__ unsigned char kCandJ[64] = {0, 1, 2, 3, 4, 5, 6, 7, 8, 9, 10, 11, 12, 13, 14, 15, 0, 1, 2, 3, 4, 5, 6, 7, 0, 1, 2, 3, 4, 0, 1, 2, 3, 0, 1, 2, 0, 1, 0, 1, 0, 1, 0, 0, 0, 0, 0, 0, 0, 0, 15, 15, 15, 15, 15, 15, 15, 15, 15, 15, 15, 15, 15, 15};

__device__ __forceinline__ float wave_sum(float v) {
  for (int o = 32; o > 0; o >>= 1) v += __shfl_xor(v, o);
  return v;
}
__device__ __forceinline__ float wave_max(float v) {
  for (int o = 32; o > 0; o >>= 1) v = fmaxf(v, __shfl_xor(v, o));
  return v;
}
__device__ __forceinline__ float silu_f(float x) { return x / (1.f + expf(-x)); }
__device__ __forceinline__ float softplus_f(float x) { return fmaxf(x, 0.f) + log1pf(expf(-fabsf(x))); }

constexpr size_t al256(size_t x) { return (x + 255) & ~(size_t)255; }
constexpr size_t WS_CTL = 0;
constexpr size_t WS_WINT = 65536;
constexpr size_t WS_WDTT = WS_WINT + (size_t)NPROJ * DM * 2;
constexpr size_t WS_WOUTT = WS_WDTT + (size_t)16 * DM * 2;
constexpr size_t WS_WQT = WS_WOUTT + (size_t)DM * DM * 2;
constexpr size_t WS_KEYS = WS_WQT + (size_t)DM * DM * 2;
constexpr size_t WS_UB = WS_KEYS + (size_t)16 * 128 * 128 * 2;
constexpr size_t WS_VB = WS_UB + (size_t)NEXP * DM * 2;
constexpr size_t WS_HNB = WS_VB + (size_t)NEXP * DM * 2;
constexpr size_t WS_PROJ = WS_HNB + (size_t)(T + 16) * DM * 2;
constexpr size_t WS_DTRAW = WS_PROJ + (size_t)T * NPROJ * 2;
constexpr size_t WS_PROJM = WS_DTRAW + (size_t)T * 16 * 4;
constexpr size_t WS_PROJMB = al256(WS_PROJM + (size_t)16 * DPROJ * 4);
constexpr size_t WS_H1B = al256(WS_PROJMB + (size_t)16 * DPROJ * 2);
constexpr size_t WS_SSQH1 = WS_H1B + (size_t)T * DM * 2;
constexpr size_t WS_STOP = al256(WS_SSQH1 + (size_t)T * 32 * 4);
constexpr size_t WS_ITOP = WS_STOP + (size_t)T * 256 * 4;
constexpr size_t WS_ACSG = al256(WS_ITOP + (size_t)T * 256 * 4);
constexpr size_t WS_CCB = WS_ACSG + (size_t)T * 16 * 4;
constexpr size_t WS_YPART = WS_CCB + (size_t)T * 256 * 2;
constexpr size_t WS_SG = WS_YPART + (size_t)T * 1024 * 4;
constexpr size_t WS_SMETA = WS_SG + (size_t)1024 * 8192 * 4;
constexpr size_t WS_HPREV = al256(WS_SMETA + (size_t)16 * 8192 * 4);
constexpr size_t WS_USC = al256(WS_HPREV + (size_t)1024 * 8192 * 2);
constexpr size_t WS_VSC = WS_USC + (size_t)NEXP * 4;
constexpr size_t WS_SCR = al256(WS_VSC + (size_t)NEXP * 4);
}

namespace pg8 {
#define PG8_LAS __attribute__((address_space(3)))
constexpr int BM = 256, BK = 64, HALF = 128, HTB = HALF * BK * 2, STAGE_BYTES = 8 * HTB, NXCD = 8, WGM = 8;
__host__ __device__ __forceinline__ int lds_byte(int r, int c) { const int st = (r >> 4) * 2 + (c >> 5), rr = r & 15, cc = c & 31, ob = rr * 64 + cc * 2; return st * 1024 + (ob ^ (((ob >> 9) & 1) << 5)); }
__host__ __device__ __forceinline__ void stage_rc(int b, int& R, int& C) { const int st = b / 1024, sb = b % 1024, swz = sb ^ (((sb >> 9) & 1) << 5); R = (st >> 1) * 16 + swz / 64; C = (st & 1) * 32 + (swz % 64) / 2; }
__host__ __device__ __forceinline__ int perm32(int rho) { const int n = rho >> 4, i = rho & 15; return 8 * (i >> 2) + 4 * n + (i & 3); }
struct Unit { int pm, pn; };
struct Gemm { const bf16_t* A; const bf16_t* Bt; int M, N, K; };
struct StaticOrder {
    int nM, nN, nwg, G, c;
    __host__ __device__ void init(int M, int N, int G_, int c_) { nM = M / BM; nN = N / BM; nwg = nM * nN; G = G_; c = c_; }
    __host__ __device__ bool next(int i, Unit& u) const {
        const long L = (long)i * G + c; if (L >= nwg) return false;
        int wgid = (int)L; { const int q = nwg / NXCD, r = nwg % NXCD, xcd = wgid % NXCD, off = wgid / NXCD; wgid = (xcd < r ? xcd * (q + 1) : r * (q + 1) + (xcd - r) * q) + off; }
        const int nig = WGM * nN, gid = wgid / nig, fm = gid * WGM, gsz = (nM - fm) < WGM ? (nM - fm) : WGM;
        u.pm = fm + ((wgid % nig) % gsz); u.pn = (wgid % nig) / gsz; return true;
    }
    __device__ __forceinline__ void a_ready(const Unit&) const {}
    __device__ __forceinline__ void done(const Unit&) const {}
};
struct EpiBf16 {
    static constexpr bool PERM = true, AFTER_DRAIN = false;
    bf16_t* O; int ldc;
    __device__ __forceinline__ void operator()(const f32x4 (&acc)[2][2][4][2], const Unit& u, int wr, int wc, int fr, int fq) const {
        const int row0 = u.pm * BM + wr * 64 + fr; const int col0 = u.pn * BM + wc * 32 + 8 * fq;
#pragma unroll
        for (int ai = 0; ai < 2; ++ai)
#pragma unroll
            for (int m = 0; m < 4; ++m) { bf16_t* rowp = O + (size_t)(row0 + ai * HALF + m * 16) * ldc + col0;
#pragma unroll
                for (int bj = 0; bj < 2; ++bj) { const f32x4 v0 = acc[ai][bj][m][0], v1 = acc[ai][bj][m][1];
                    u32x4 w; w.x = pack_bf16(v0[0], v0[1]); w.y = pack_bf16(v0[2], v0[3]); w.z = pack_bf16(v1[0], v1[1]); w.w = pack_bf16(v1[2], v1[3]);
                    *(u32x4*)(rowp + bj * HALF) = w; } }
    }
};

struct EpiRes {
    static constexpr bool PERM = true, AFTER_DRAIN = false;
    const float* X; bf16_t* HB; float* SSQ;
    __device__ __forceinline__ void operator()(const f32x4 (&acc)[2][2][4][2], const Unit& u, int wr, int wc, int fr, int fq) const {
        const int row0 = u.pm * BM + wr * 64 + fr; const int col0 = u.pn * BM + wc * 32 + 8 * fq;
#pragma unroll
        for (int ai = 0; ai < 2; ++ai)
#pragma unroll
            for (int m = 0; m < 4; ++m) { const int row = row0 + ai * HALF + m * 16; const size_t off = (size_t)row * DM + col0; float ss = 0.f;
#pragma unroll
                for (int bj = 0; bj < 2; ++bj) {
                    const f32x4 x0 = *(const f32x4*)(X + off + bj * HALF), x1 = *(const f32x4*)(X + off + bj * HALF + 4);
                    const f32x4 v0 = acc[ai][bj][m][0] + x0, v1 = acc[ai][bj][m][1] + x1;
                    u32x4 w; w.x = pack_bf16(v0[0], v0[1]); w.y = pack_bf16(v0[2], v0[3]); w.z = pack_bf16(v1[0], v1[1]); w.w = pack_bf16(v1[2], v1[3]);
                    *(u32x4*)(HB + off + bj * HALF) = w;
                    ss += v0[0] * v0[0] + v0[1] * v0[1] + v0[2] * v0[2] + v0[3] * v0[3] + v1[0] * v1[0] + v1[1] * v1[1] + v1[2] * v1[2] + v1[3] * v1[3]; }
                ss += __shfl_xor(ss, 16); ss += __shfl_xor(ss, 32);
                if (fq == 0) SSQ[(size_t)row * 32 + u.pn * 4 + wc] = ss; }
    }
};
struct EpiF32 {
    static constexpr bool PERM = true, AFTER_DRAIN = false;
    float* C; int ldc;
    __device__ __forceinline__ void operator()(const f32x4 (&acc)[2][2][4][2], const Unit& u, int wr, int wc, int fr, int fq) const {
        const int row0 = u.pm * BM + wr * 64 + fr; const int col0 = u.pn * BM + wc * 32 + 8 * fq;
#pragma unroll
        for (int ai = 0; ai < 2; ++ai)
#pragma unroll
            for (int m = 0; m < 4; ++m) { float* rowp = C + (size_t)(row0 + ai * HALF + m * 16) * ldc + col0;
#pragma unroll
                for (int bj = 0; bj < 2; ++bj) { *(f32x4*)(rowp + bj * HALF) = acc[ai][bj][m][0]; *(f32x4*)(rowp + bj * HALF + 4) = acc[ai][bj][m][1]; } }
    }
};

struct EpiScores {
    static constexpr bool PERM = true, AFTER_DRAIN = true;
    const bf16_t* KEYS;
    float* STOP; int* ITOP;
    static constexpr int QLD = 264;
    __device__ __forceinline__ void fused(f32x4 (&acc)[2][2][4][2], const Unit& u, int wr, int wc, int fr, int fq, PG8_LAS unsigned char* lds, int wid, int lane) const {
        PG8_LAS bf16_t* Q = (PG8_LAS bf16_t*)lds;
#pragma unroll
        for (int ai = 0; ai < 2; ++ai)
#pragma unroll
            for (int m = 0; m < 4; ++m) { const int row = ai * HALF + wr * 64 + m * 16 + fr;
#pragma unroll
                for (int bj = 0; bj < 2; ++bj) { const f32x4 v0 = acc[ai][bj][m][0], v1 = acc[ai][bj][m][1];
                    u32x4 w; w.x = pack_bf16(v0[0], v0[1]); w.y = pack_bf16(v0[2], v0[3]); w.z = pack_bf16(v1[0], v1[1]); w.w = pack_bf16(v1[2], v1[3]);
                    *(PG8_LAS u32x4*)(Q + row * QLD + bj * HALF + wc * 32 + 8 * fq) = w; } }
        __syncthreads();
        const int h = u.pn;
#pragma unroll 1
        for (int c = 0; c < 2; ++c) {
            f32x4 sc[8][2];
#pragma unroll
            for (int kf = 0; kf < 8; ++kf) { sc[kf][0] = (f32x4){0.f, 0.f, 0.f, 0.f}; sc[kf][1] = (f32x4){0.f, 0.f, 0.f, 0.f}; }
            const bf16_t* kb = KEYS + (size_t)((h * 2 + c) * 128 + fr) * 128 + 8 * fq;
            const PG8_LAS bf16_t* qb = Q + (wid * 32 + fr) * QLD + c * 128 + 8 * fq;
#pragma unroll
            for (int ks = 0; ks < 4; ++ks) {
                const bf16x8 q0 = *(const PG8_LAS bf16x8*)(qb + 32 * ks), q1 = *(const PG8_LAS bf16x8*)(qb + 16 * QLD + 32 * ks);
#pragma unroll
                for (int kf = 0; kf < 8; ++kf) { const bf16x8 kv = *(const bf16x8*)(kb + (size_t)kf * 16 * 128 + 32 * ks);
                    sc[kf][0] = __builtin_amdgcn_mfma_f32_16x16x32_bf16(kv, q0, sc[kf][0], 0, 0, 0);
                    sc[kf][1] = __builtin_amdgcn_mfma_f32_16x16x32_bf16(kv, q1, sc[kf][1], 0, 0, 0); }
            }
#pragma unroll
            for (int tf = 0; tf < 2; ++tf) {
                float v[32];
#pragma unroll
                for (int kf = 0; kf < 8; ++kf)
#pragma unroll
                    for (int r = 0; r < 4; ++r) v[kf * 4 + r] = __uint_as_float((__float_as_uint(sc[kf][tf][r]) & 0xffffff80u) | (unsigned)(16 * kf + r));
                const unsigned fqbits = 4u * fq;
                const size_t obase = ((size_t)(u.pm * BM + wid * 32 + tf * 16 + fr) * 16 + h * 2 + c) * 16;
#pragma unroll 1
                for (int r = 0; r < 16; ++r) {
                    float mx = v[0];
#pragma unroll
                    for (int i = 1; i < 32; ++i) mx = fmaxf(mx, v[i]);
                    float cand = __uint_as_float(__float_as_uint(mx) | fqbits);
                    float o = __shfl_xor(cand, 16); cand = fmaxf(cand, o);
                    o = __shfl_xor(cand, 32); cand = fmaxf(cand, o);
                    const unsigned cb = __float_as_uint(cand);
                    const bool mine = (cb & 12u) == fqbits;
                    const float rem = __uint_as_float(cb & ~12u);
#pragma unroll
                    for (int i = 0; i < 32; ++i) v[i] = (mine && v[i] == rem) ? -INFINITY : v[i];
                    if (fq == 0) { STOP[obase + r] = __uint_as_float(cb & 0xffffff80u); ITOP[obase + r] = (int)(cb & 127u); }
                }
            }
        }
    }
};

template <class Epi, class Sched>
__device__ __forceinline__ void gemm_phase(PG8_LAS unsigned char* lds, const Gemm g, const Sched& S, const Epi& E) {
    int tid_ = threadIdx.x; asm volatile("" : "+v"(tid_));
    const int tid = tid_, wid = __builtin_amdgcn_readfirstlane(tid >> 6), lane = tid & 63, wr = wid >> 2, wc = wid & 3, fr = lane & 15, fq = lane >> 4;
    const int K = g.K, nt = K / BK;
    unsigned voffA[2], voffB[2];
#pragma unroll
    for (int i = 0; i < 2; ++i) { int R, C; stage_rc(tid * 16 + i * 8192, R, C); const int Rb = Epi::PERM ? ((R & ~31) + perm32(R & 31)) : R;
        voffA[i] = (unsigned)(R * K + C) * 2u; voffB[i] = (unsigned)(Rb * K + C) * 2u; }
    const size_t kstep = (size_t)(BK * 2);
    const size_t hstep = (size_t)HALF * K * 2;
    const size_t tstep = 2 * hstep;
    const unsigned ldsw = (unsigned)wid * 1024u;
    const int aoff = lds_byte(wr * 64 + fr, fq * 8), boff = lds_byte(wc * 32 + fr, fq * 8);
#define PG8_SA(b, h) (((b) * 2 + (h)) * HTB)
#define PG8_SB(b, h) ((4 + (b) * 2 + (h)) * HTB)
#define PG8_STAGE(bufoff, gbase, voff) do { _Pragma("unroll") for (int _i = 0; _i < 2; ++_i) \
        __builtin_amdgcn_global_load_lds((const unsigned*)((const char*)(gbase) + (voff)[_i]), (PG8_LAS unsigned*)(lds + (bufoff) + ldsw + _i * 8192), 16, 0, 0); } while (0)
#define PG8_LDA(dst, b, h) do { _Pragma("unroll") for (int m = 0; m < 4; ++m) _Pragma("unroll") for (int k = 0; k < 2; ++k) dst[m][k] = *(const PG8_LAS bf16x8*)(lds + PG8_SA(b, h) + aoff + m * 2048 + k * 1024); } while (0)
#define PG8_LDB(dst, b, h) do { _Pragma("unroll") for (int n = 0; n < 2; ++n) _Pragma("unroll") for (int k = 0; k < 2; ++k) dst[n][k] = *(const PG8_LAS bf16x8*)(lds + PG8_SB(b, h) + boff + n * 2048 + k * 1024); } while (0)
#define PG8_MMA(ai, bj, At, Bt) do { __builtin_amdgcn_s_setprio(1); _Pragma("unroll") for (int m = 0; m < 4; ++m) _Pragma("unroll") for (int n = 0; n < 2; ++n) _Pragma("unroll") for (int k = 0; k < 2; ++k) \
        acc[ai][bj][m][n] = __builtin_amdgcn_mfma_f32_16x16x32_bf16(Bt[n][k], At[m][k], acc[ai][bj][m][n], 0, 0, 0); __builtin_amdgcn_s_setprio(0); } while (0)
#define PG8_WAIT_V(n) asm volatile("s_waitcnt vmcnt(" #n ")" ::: "memory")
#define PG8_WAIT_L(n) asm volatile("s_waitcnt lgkmcnt(" #n ")" ::: "memory")
#define PG8_BAR __builtin_amdgcn_s_barrier()
#define PG8_SCHED __builtin_amdgcn_sched_barrier(0)
    Unit cur, nxt; int ui = 0;
    if (!S.next(0, cur)) return;
    f32x4 acc[2][2][4][2];
#pragma unroll
    for (int a = 0; a < 2; ++a)
#pragma unroll
        for (int b = 0; b < 2; ++b)
#pragma unroll
            for (int m = 0; m < 4; ++m)
#pragma unroll
                for (int n = 0; n < 2; ++n) acc[a][b][m][n] = (f32x4){0.f, 0.f, 0.f, 0.f};
    bf16x8 At[4][2], B0[2][2], B1[2][2];
    const char* cA = (const char*)g.A + (size_t)cur.pm * tstep; const char* cB = (const char*)g.Bt + (size_t)cur.pn * tstep;
    S.a_ready(cur);
    PG8_STAGE(PG8_SB(0, 0), cB, voffB); PG8_STAGE(PG8_SA(0, 0), cA, voffA); PG8_STAGE(PG8_SB(0, 1), cB + hstep, voffB); PG8_STAGE(PG8_SA(0, 1), cA + hstep, voffA);
    if (wr == 1) PG8_BAR;
    PG8_WAIT_V(4); PG8_BAR;
    PG8_STAGE(PG8_SB(1, 0), cB + kstep, voffB); PG8_STAGE(PG8_SA(1, 0), cA + kstep, voffA); PG8_STAGE(PG8_SB(1, 1), cB + hstep + kstep, voffB);
    PG8_WAIT_V(6); PG8_BAR;
    for (;;) {
        const bool has_next = S.next(ui + 1, nxt);
        const char* nA = has_next ? (const char*)g.A + (size_t)nxt.pm * tstep : cA; const char* nB = has_next ? (const char*)g.Bt + (size_t)nxt.pn * tstep : cB;
        for (int t = 0; t < nt; t += 2) {
            const bool last = (t == nt - 2);
            const char* a1 = cA + (size_t)(t + 1) * kstep;
            const char* a2 = last ? nA : cA + (size_t)(t + 2) * kstep; const char* b2 = last ? nB : cB + (size_t)(t + 2) * kstep;
            const char* a3 = a2 + kstep; const char* b3 = b2 + kstep;
            if (last && has_next) S.a_ready(nxt);
            PG8_LDB(B0, 0, 0); PG8_SCHED; PG8_LDA(At, 0, 0); PG8_STAGE(PG8_SA(1, 1), a1 + hstep, voffA);
            PG8_WAIT_L(8); PG8_BAR; PG8_WAIT_L(0); PG8_MMA(0, 0, At, B0); PG8_BAR; PG8_SCHED;
            PG8_LDB(B1, 0, 1); PG8_STAGE(PG8_SB(0, 0), b2, voffB);
            PG8_BAR; PG8_WAIT_L(0); PG8_MMA(0, 1, At, B1); PG8_BAR;
            PG8_LDA(At, 0, 1); PG8_STAGE(PG8_SA(0, 0), a2, voffA);
            PG8_BAR; PG8_WAIT_L(0); PG8_MMA(1, 0, At, B0); PG8_BAR; PG8_SCHED;
            PG8_STAGE(PG8_SB(0, 1), b2 + hstep, voffB);
            PG8_WAIT_V(6); PG8_BAR; PG8_MMA(1, 1, At, B1); PG8_BAR;
            PG8_LDB(B0, 1, 0); PG8_SCHED; PG8_LDA(At, 1, 0); PG8_STAGE(PG8_SA(0, 1), a2 + hstep, voffA);
            PG8_WAIT_L(8); PG8_BAR; PG8_WAIT_L(0); PG8_MMA(0, 0, At, B0); PG8_BAR; PG8_SCHED;
            PG8_LDB(B1, 1, 1); PG8_STAGE(PG8_SB(1, 0), b3, voffB);
            PG8_BAR; PG8_WAIT_L(0); PG8_MMA(0, 1, At, B1); PG8_BAR;
            PG8_LDA(At, 1, 1); PG8_STAGE(PG8_SA(1, 0), a3, voffA);
            PG8_BAR; PG8_WAIT_L(0); PG8_MMA(1, 0, At, B0); PG8_BAR; PG8_SCHED;
            PG8_STAGE(PG8_SB(1, 1), b3 + hstep, voffB);
            PG8_WAIT_V(6); PG8_BAR; PG8_MMA(1, 1, At, B1); PG8_BAR;
        }
        if constexpr (!Epi::AFTER_DRAIN) { E(acc, cur, wr, wc, fr, fq); S.done(cur); }
        if (!has_next) break;
#pragma unroll
        for (int a = 0; a < 2; ++a)
#pragma unroll
            for (int b = 0; b < 2; ++b)
#pragma unroll
                for (int m = 0; m < 4; ++m)
#pragma unroll
                    for (int n = 0; n < 2; ++n) acc[a][b][m][n] = (f32x4){0.f, 0.f, 0.f, 0.f};
        cur = nxt; cA = nA; cB = nB; ++ui;
    }
    PG8_WAIT_V(0);
    if (wr == 0) PG8_BAR;
    PG8_BAR;
    if constexpr (Epi::AFTER_DRAIN) { E.fused(acc, cur, wr, wc, fr, fq, lds, wid, lane); S.done(cur); }
#undef PG8_SA
#undef PG8_SB
#undef PG8_STAGE
#undef PG8_LDA
#undef PG8_LDB
#undef PG8_MMA
#undef PG8_WAIT_V
#undef PG8_WAIT_L
#undef PG8_BAR
#undef PG8_SCHED
}
}

#define XB_TMO      128
#define XB_XCNT(j)  (256  + 64 * (j))
#define XB_XSUB(j)  (1280 + 64 * (j))
#define XB_XGEN(j)  (2304 + 64 * (j))
#define XB_TOP      3328
#define XB_TOPGEN   3392
#define XCD_BAR_WORDS 3456
#define XB_SPIN_CAP (1u << 22)
__device__ __forceinline__ unsigned xb_ld(unsigned* p)              { return __hip_atomic_load(p, __ATOMIC_RELAXED, __HIP_MEMORY_SCOPE_AGENT); }
__device__ __forceinline__ unsigned xb_add(unsigned* p, unsigned v) { return __hip_atomic_fetch_add(p, v, __ATOMIC_RELAXED, __HIP_MEMORY_SCOPE_AGENT); }
__device__ __forceinline__ unsigned xb_xcc_id() { return (unsigned)__builtin_amdgcn_s_getreg((3 << 11) | 20) & 0xFu; }
#define XB_SPIN(cond, bar) do { unsigned _sp = 0; while (cond) { __builtin_amdgcn_s_sleep(1); \
    if ((++_sp & 255u) == 0u) { if (xb_ld(&(bar)[XB_TMO])) break; if (_sp > XB_SPIN_CAP) { atomicAdd(&(bar)[XB_TMO], 1u); break; } } } } while (0)
struct XcdBarrier { unsigned* bar; unsigned x; volatile LAS unsigned* st; };
__device__ __forceinline__ XcdBarrier xcd_barrier_post(unsigned* bar, volatile LAS unsigned* st) {
    XcdBarrier b; b.bar = bar; b.x = xb_xcc_id(); b.st = st;
    if (threadIdx.x == 0) (void)xb_add(&bar[XB_XCNT(b.x)], 1u);
    return b;
}
__device__ __forceinline__ void xcd_barrier_complete(unsigned* bar, unsigned x, unsigned& nloc, unsigned& nx) {
    const unsigned G = gridDim.x * gridDim.y * gridDim.z;
    unsigned sum, cnt, mine, sp = 0u;
    for (;;) {
        sum = 0u; cnt = 0u; mine = 0u;
#pragma unroll
        for (unsigned j = 0; j < 16; ++j) { const unsigned c = xb_ld(&bar[XB_XCNT(j)]); sum += c; cnt += (c > 0u) ? 1u : 0u; mine = (j == x) ? c : mine; }
        if (sum == G) break;
        __builtin_amdgcn_s_sleep(1);
        if ((++sp & 255u) == 0u) { if (xb_ld(&bar[XB_TMO])) break; if (sp > XB_SPIN_CAP) { atomicAdd(&bar[XB_TMO], 1u); break; } }
    }
    nloc = mine > 0u ? mine : 1u; nx = cnt > 0u ? cnt : 1u;
}
__device__ __forceinline__ void xcd_barrier(const XcdBarrier& b) {
    asm volatile("s_waitcnt vmcnt(0)" ::: "memory");
    __syncthreads();
    if (threadIdx.x == 0) {
        unsigned* bar = b.bar;
        __builtin_amdgcn_s_waitcnt(0);
        unsigned nloc = b.st[0], nx = b.st[1];
        if (nloc == 0u) { xcd_barrier_complete(bar, b.x, nloc, nx); b.st[0] = nloc; b.st[1] = nx; }
        const unsigned old = xb_add(&bar[XB_XSUB(b.x)], 1u);
        const unsigned gen = old / nloc;
        if (old + 1u == (gen + 1u) * nloc) {
            __builtin_amdgcn_fence(__ATOMIC_RELEASE, "agent");
            asm volatile("s_waitcnt vmcnt(0)" ::: "memory");
            const unsigned og = xb_add(&bar[XB_TOP], 1u);
            const unsigned tg = og / nx;
            if (og + 1u == (tg + 1u) * nx) xb_add(&bar[XB_TOPGEN], 1u);
            else XB_SPIN(xb_ld(&bar[XB_TOPGEN]) == tg, bar);
            __builtin_amdgcn_fence(__ATOMIC_ACQUIRE, "agent");
            xb_add(&bar[XB_XGEN(b.x)], 1u);
            asm volatile("s_waitcnt vmcnt(0)" ::: "memory");
        } else {
            XB_SPIN(xb_ld(&bar[XB_XGEN(b.x)]) == gen, bar);
            __builtin_amdgcn_fence(__ATOMIC_ACQUIRE, "agent");
            asm volatile("s_waitcnt vmcnt(0)" ::: "memory");
        }
    }
    __syncthreads();
}

namespace {
struct Params {
  const float *x, *meta, *rel_bias, *ln_mix, *w_in, *sinks, *conv_w, *conv_b, *dt_bias, *a_log, *d_skip, *attn_norm_w,
      *ssm_norm_w, *w_out, *ln_ffn, *wq, *keys, *U, *V, *ln_final;
  float* out;
  unsigned char* ws;
};

__device__ __forceinline__ void p0_transpose_tile(const float* __restrict__ W, int ldw, bf16_t* __restrict__ Wt, const float* sc0,
                                                  const float* sc1, int k0, int n0, float* tile) {
  const int tid = threadIdx.x;
  {
    const int r = tid >> 6, c4 = (tid & 63) * 4;
    f32x4 v[8];
#pragma unroll
    for (int i = 0; i < 8; ++i) v[i] = *(const f32x4*)(W + (size_t)(k0 + r + 8 * i) * ldw + n0 + c4);
#pragma unroll
    for (int i = 0; i < 8; ++i) {
      float s = 1.f;
      const int k = k0 + r + 8 * i;
      if (sc0) s = k < 1024 ? sc0[k] : sc1[k - 1024];
      float* q = tile + (r + 8 * i) * 257 + c4;
      q[0] = v[i][0] * s; q[1] = v[i][1] * s; q[2] = v[i][2] * s; q[3] = v[i][3] * s;
    }
  }
  __syncthreads();
#pragma unroll
  for (int it = 0; it < 4; ++it) {
    const int task = it * NTHREADS + tid;
    const int n = task >> 3, kc = (task & 7) * 8;
    float v[8];
#pragma unroll
    for (int j = 0; j < 8; ++j) v[j] = tile[(kc + j) * 257 + n];
    u32x4 w; w.x = pack_bf16(v[0], v[1]); w.y = pack_bf16(v[2], v[3]); w.z = pack_bf16(v[4], v[5]); w.w = pack_bf16(v[6], v[7]);
    *(u32x4*)(Wt + (size_t)(n0 + n) * DM + k0 + kc) = w;
  }
  __syncthreads();
}

__device__ __forceinline__ void phase0(const Params& p, float* ldsf, int bid, int nblk) {
  const int tid = threadIdx.x, lane = tid & 63, wid = tid >> 6;
  bf16_t* w_inT = (bf16_t*)(p.ws + WS_WINT);
  bf16_t* w_dtT = (bf16_t*)(p.ws + WS_WDTT);
  bf16_t* w_outT = (bf16_t*)(p.ws + WS_WOUTT);
  bf16_t* wqT = (bf16_t*)(p.ws + WS_WQT);
  bf16_t* keysb = (bf16_t*)(p.ws + WS_KEYS);
  unsigned char* ub = p.ws + WS_UB;
  unsigned char* vb = p.ws + WS_VB;
  bf16_t* hnb = (bf16_t*)(p.ws + WS_HNB);
  constexpr int U_HN = (TA + 7) / 8;
  constexpr int U_WIN = 32 * 16, U_WOUT = 32 * 8, U_WQ = 32 * 8, U_WDT = 1, U_KEYS = 64, U_U = NEXP / 8, U_V = NEXP / 8;
  constexpr int B_WIN = U_HN, B_WOUT = B_WIN + U_WIN, B_WQ = B_WOUT + U_WOUT, B_WDT = B_WQ + U_WQ, B_KEYS = B_WDT + U_WDT,
                B_U = B_KEYS + U_KEYS, B_V = B_U + U_U, B_END = B_V + U_V;
  for (int u = bid; u < B_END; u += nblk) {
    if (u < B_WIN) {
      const int t = u * 8 + wid;
      if (t < TA) {
        const float* src = t < T ? p.x + (size_t)t * DM : p.meta + (size_t)(t - T) * DM;
        float4 v[8];
        float ss = 0.f;
#pragma unroll
        for (int i = 0; i < 8; ++i) {
          v[i] = *(const float4*)(src + (i * 64 + lane) * 4);
          ss += v[i].x * v[i].x + v[i].y * v[i].y + v[i].z * v[i].z + v[i].w * v[i].w;
        }
        ss = wave_sum(ss);
        const float r = rsqrtf(ss * (1.f / DM) + EPS);
#pragma unroll
        for (int i = 0; i < 8; ++i) {
          const float4 w = *(const float4*)(p.ln_mix + (i * 64 + lane) * 4);
          u32x2 o; o.x = pack_bf16(v[i].x * r * w.x, v[i].y * r * w.y); o.y = pack_bf16(v[i].z * r * w.z, v[i].w * r * w.w);
          *(u32x2*)(hnb + (size_t)t * DM + (i * 64 + lane) * 4) = o;
        }
      }
    } else if (u < B_WOUT) {
      const int i = u - B_WIN;
      p0_transpose_tile(p.w_in, DPROJ, w_inT, nullptr, nullptr, (i & 31) * 64, (i >> 5) * 256, ldsf);
    } else if (u < B_WQ) {
      const int i = u - B_WOUT;
      p0_transpose_tile(p.w_out, DM, w_outT, p.attn_norm_w, p.ssm_norm_w, (i & 31) * 64, (i >> 5) * 256, ldsf);
    } else if (u < B_WDT) {
      const int i = u - B_WQ;
      p0_transpose_tile(p.wq, DM, wqT, p.ln_ffn, p.ln_ffn + 1024, (i & 31) * 64, (i >> 5) * 256, ldsf);
    } else if (u < B_KEYS) {
      for (int idx = tid; idx < DM * 16; idx += NTHREADS) {
        const int k = idx >> 4, j = idx & 15;
        w_dtT[(size_t)j * DM + k] = f2bf(p.w_in[(size_t)k * DPROJ + NPROJ + j]);
      }
    } else if (u < B_U) {
      const size_t base = (size_t)(u - B_KEYS) * 4096 + (size_t)tid * 8;
      const float4 a = *(const float4*)(p.keys + base), b = *(const float4*)(p.keys + base + 4);
      u32x4 w; w.x = pack_bf16(a.x, a.y); w.y = pack_bf16(a.z, a.w); w.z = pack_bf16(b.x, b.y); w.w = pack_bf16(b.z, b.w);
      *(u32x4*)(keysb + base) = w;
    } else {
      const bool isU = u < B_V;
      const int row = (isU ? (u - B_U) : (u - B_V)) * 8 + wid;
      const float* src = (isU ? p.U : p.V) + (size_t)row * DM + lane * 4;
      f32x4 a[8];
#pragma unroll
      for (int j = 0; j < 8; ++j) a[j] = *(const f32x4*)(src + 256 * j);
      if (isU) {
#pragma unroll
        for (int j = 0; j < 8; ++j) a[j] *= *(const f32x4*)(p.ln_ffn + lane * 4 + 256 * j);
      }
      float amax = 0.f;
#pragma unroll
      for (int j = 0; j < 8; ++j) amax = fmaxf(amax, fmaxf(fmaxf(fabsf(a[j][0]), fabsf(a[j][1])), fmaxf(fabsf(a[j][2]), fabsf(a[j][3]))));
      amax = wave_max(amax);
      if (!isU) {
        const float s4 = amax > 0.f ? 6.f / amax : 1.f;
        u32x4 w4;
#pragma unroll
        for (int j = 0; j < 4; ++j) {
          unsigned w = 0;
          w = __builtin_amdgcn_cvt_scalef32_pk_fp4_f32(w, a[2 * j][0] * s4, a[2 * j][1] * s4, 1.0f, 0);
          w = __builtin_amdgcn_cvt_scalef32_pk_fp4_f32(w, a[2 * j][2] * s4, a[2 * j][3] * s4, 1.0f, 1);
          w = __builtin_amdgcn_cvt_scalef32_pk_fp4_f32(w, a[2 * j + 1][0] * s4, a[2 * j + 1][1] * s4, 1.0f, 2);
          w = __builtin_amdgcn_cvt_scalef32_pk_fp4_f32(w, a[2 * j + 1][2] * s4, a[2 * j + 1][3] * s4, 1.0f, 3);
          w4[j] = w;
        }
        *(u32x4*)(vb + (size_t)row * ROW4 + lane * 16) = w4;
        if (lane == 0) ((float*)(p.ws + WS_VSC))[row] = amax > 0.f ? amax * (1.f / 6.f) : 1.f;
        continue;
      }
      const float scl = amax > 0.f ? 7.5f / amax : 1.f;
      f32x16v v0, v1;
#pragma unroll
      for (int j = 0; j < 8; ++j) {
        v0[2 * j + 0] = a[j][0] * scl; v1[2 * j + 0] = a[j][1] * scl; v0[2 * j + 1] = a[j][2] * scl; v1[2 * j + 1] = a[j][3] * scl;
      }
      const u32x6 pk = __builtin_amdgcn_cvt_scalef32_2xpk16_fp6_f32(v0, v1, 1.0f);
      unsigned char* dst = (isU ? ub : vb) + (size_t)row * ROW6;
      *(u32x4*)(dst + lane * 16) = (u32x4){pk[0], pk[1], pk[2], pk[3]};
      *(u32x2*)(dst + 1024 + lane * 8) = (u32x2){pk[4], pk[5]};
      if (lane == 0) ((float*)(p.ws + (isU ? WS_USC : WS_VSC)))[row] = amax > 0.f ? amax * (1.f / 7.5f) : 1.f;
    }
  }
}

__device__ __forceinline__ void mini_gemm(const bf16_t* __restrict__ A, const bf16_t* __restrict__ Bt, float* __restrict__ out, int ldo,
                                          float* red, bf16_t* __restrict__ outb = nullptr) {
  const int tid = threadIdx.x, lane = tid & 63, wid = tid >> 6, fr = lane & 15, fq = lane >> 4;
  f32x4 acc = {0.f, 0.f, 0.f, 0.f};
  const bf16_t* ap = A + (size_t)fr * DM + wid * 256 + fq * 8;
  const bf16_t* bp = Bt + (size_t)fr * DM + wid * 256 + fq * 8;
#pragma unroll
  for (int ks = 0; ks < 8; ++ks) {
    const bf16x8 a = *(const bf16x8*)(ap + ks * 32);
    const bf16x8 b = *(const bf16x8*)(bp + ks * 32);
    acc = __builtin_amdgcn_mfma_f32_16x16x32_bf16(a, b, acc, 0, 0, 0);
  }
#pragma unroll
  for (int r = 0; r < 4; ++r) red[wid * 256 + (4 * fq + r) * 16 + fr] = acc[r];
  __syncthreads();
  if (tid < 256) {
    float s = 0.f;
#pragma unroll
    for (int w = 0; w < 8; ++w) s += red[w * 256 + tid];
    out[(size_t)(tid >> 4) * ldo + (tid & 15)] = s;
    if (outb) outb[(size_t)(tid >> 4) * ldo + (tid & 15)] = f2bf(s);
  }
  __syncthreads();
}

__device__ __forceinline__ void phase1(const Params& p, unsigned char* lds, int bid, int nblk) {
  const bf16_t* hnb = (const bf16_t*)(p.ws + WS_HNB);
  const bf16_t* w_inT = (const bf16_t*)(p.ws + WS_WINT);
  const bf16_t* w_dtT = (const bf16_t*)(p.ws + WS_WDTT);
  float* dtraw = (float*)(p.ws + WS_DTRAW);
  float* projm = (float*)(p.ws + WS_PROJM);
  constexpr int NU = 512 + 32 + 96 + 1;
  for (int u = bid; u < NU; u += nblk) {
    if (u < 512) {
      mini_gemm(hnb + (size_t)u * 16 * DM, w_dtT, dtraw + (size_t)u * 16 * 16, 16, (float*)lds);
    } else {
      const int j = u - 512;
      const int cf = j < 32 ? 64 + j : (j < 128 ? 160 + (j - 32) : 256);
      const bf16_t* bt = cf < 256 ? w_inT + (size_t)cf * 16 * DM : w_dtT;
      mini_gemm(hnb + (size_t)T * DM, bt, projm + cf * 16, DPROJ, (float*)lds, (bf16_t*)(p.ws + WS_PROJMB) + cf * 16);
    }
  }
  pg8::Gemm g{hnb, w_inT, T, NPROJ, DM};
  pg8::StaticOrder S; S.init(T, NPROJ, nblk, bid);
  pg8::EpiBf16 E{(bf16_t*)(p.ws + WS_PROJ), NPROJ};
  pg8::gemm_phase<pg8::EpiBf16, pg8::StaticOrder>((PG8_LAS unsigned char*)lds, g, S, E);
}

__device__ __forceinline__ void phase4(const Params& p, unsigned char* lds, int bid, int nblk) {
  pg8::Gemm g{(const bf16_t*)(p.ws + WS_HNB), (const bf16_t*)(p.ws + WS_WOUTT), T, DM, DM};
  pg8::StaticOrder S; S.init(T, DM, nblk, bid);
  pg8::EpiRes E{p.x, (bf16_t*)(p.ws + WS_H1B), (float*)(p.ws + WS_SSQH1)};
  pg8::gemm_phase<pg8::EpiRes, pg8::StaticOrder>((PG8_LAS unsigned char*)lds, g, S, E);
}
__device__ __forceinline__ void phase5(const Params& p, unsigned char* lds, int bid, int nblk) {
  pg8::Gemm g{(const bf16_t*)(p.ws + WS_H1B), (const bf16_t*)(p.ws + WS_WQT), T, DM, DM};
  pg8::StaticOrder S; S.init(T, DM, nblk, bid);
  pg8::EpiScores E{(const bf16_t*)(p.ws + WS_KEYS), (float*)(p.ws + WS_STOP), (int*)(p.ws + WS_ITOP)};
  pg8::gemm_phase<pg8::EpiScores, pg8::StaticOrder>((PG8_LAS unsigned char*)lds, g, S, E);
}

__device__ __forceinline__ float dot2bf(unsigned a, unsigned b, float c) {
  return __builtin_amdgcn_fdot2_f32_bf16(*(bf16v2*)&a, *(bf16v2*)&b, c, false);
}
__device__ __forceinline__ void phase6(const Params& p, unsigned char* lds, int bid, int nblk) {
  const int tid0 = threadIdx.x, lane0 = tid0 & 63, wid = __builtin_amdgcn_readfirstlane(tid0 >> 6);
  int* ids = (int*)(lds + wid * 2048);
  float* gts = (float*)(lds + wid * 2048 + 512);
  float* wts = (float*)(lds + wid * 2048 + 1024);
  const unsigned char* ub = p.ws + WS_UB;
  const unsigned char* vb = p.ws + WS_VB;
  const bf16_t* h1b = (const bf16_t*)(p.ws + WS_H1B);
  const float* usc = (const float*)(p.ws + WS_USC);
  const float* vsc = (const float*)(p.ws + WS_VSC);
  const float* ssq = (const float*)(p.ws + WS_SSQH1);
  const float* stop = (const float*)(p.ws + WS_STOP);
  const int* itop = (const int*)(p.ws + WS_ITOP);
  const int ci = kCandI[lane0], cj = kCandJ[lane0];
#pragma unroll 1
  for (int t = bid * 8 + wid; t < T; t += nblk * 8) {
    int tid = tid0; asm volatile("" : "+v"(tid));
    const int lane = tid & 63;
    const int kcode = 8 * ((lane >> 2) & 1) + 4 * ((lane >> 3) & 1) + 2 * ((lane >> 4) & 1) + ((lane >> 5) & 1);
    const float part0 = lane < 32 ? ssq[(size_t)t * 32 + lane] : 0.f;
    const float rr = rsqrtf(wave_sum(part0) * (1.f / DM) + EPS);
#pragma unroll 1
    for (int h = 0; h < 8; ++h) {
      const size_t lbase = ((size_t)t * 16 + h * 2) * 16;
      const float sv = lane < 32 ? stop[lbase + lane] : 0.f;
      const int iv = lane < 32 ? itop[lbase + lane] : 0;
      float cand = (__shfl(sv, ci) + __shfl(sv, 16 + cj)) * rr;
      if (lane >= 50) cand = -INFINITY;
      unsigned key = __float_as_uint(cand);
      key = (key & 0x80000000u) ? ~key : (key | 0x80000000u);
      key = (key & ~63u) | (unsigned)(63 - lane);
      int rank = 0;
#pragma unroll
      for (int k = 0; k < 50; ++k) {
        const unsigned kk = (unsigned)__builtin_amdgcn_readlane((int)key, k);
        rank += kk > key ? 1 : 0;
      }
      const float cmax = wave_max(cand);
      const float ex = rank < 16 ? __expf(cand - cmax) : 0.f;
      const float den = wave_sum(ex);
      const int eidx = __shfl(iv, ci) * 128 + __shfl(iv, 16 + cj);
      if (rank < 16) { ids[h * 16 + rank] = eidx; gts[h * 16 + rank] = ex / den; }
    }
    float xf[32];
    {
      const bf16_t* xp = h1b + (size_t)t * DM + lane * 4;
#pragma unroll
      for (int j = 0; j < 8; ++j) {
        const u32x2 xa = *(const u32x2*)(xp + 256 * j);
        xf[4 * j + 0] = bflo(xa.x); xf[4 * j + 1] = bfhi(xa.x); xf[4 * j + 2] = bflo(xa.y); xf[4 * j + 3] = bfhi(xa.y);
      }
    }
#pragma unroll 1
    for (int rnd = 0; rnd < 8; ++rnd) {
      u32x4 ra[16]; u32x2 rb[16];
#pragma unroll
      for (int k = 0; k < 16; ++k) {
        const int e = __builtin_amdgcn_readfirstlane(ids[rnd * 16 + k]);
        const unsigned char* rp = ub + (size_t)e * ROW6;
        ra[k] = *(const u32x4*)(rp + lane * 16); rb[k] = *(const u32x2*)(rp + 1024 + lane * 8);
      }
      float part[16];
      float prev = 0.f;
#pragma unroll
      for (int k = 0; k < 16; ++k) {
        asm volatile("" : "+v"(ra[k]), "+v"(rb[k]) : "v"(prev));
        const u32x6 pk = {ra[k].x, ra[k].y, ra[k].z, ra[k].w, rb[k].x, rb[k].y};
        const f32x32v r = __builtin_amdgcn_cvt_scalef32_pk32_f32_fp6(pk, 1.0f);
        float d0 = 0.f, d1 = 0.f;
#pragma unroll
        for (int i = 0; i < 32; i += 2) { d0 = fmaf(r[i], xf[i], d0); d1 = fmaf(r[i + 1], xf[i + 1], d1); }
        prev = d0 + d1;
        part[k] = prev;
      }
      float q8[8], q4[4], q2[2], q1;
      { const bool hi = (lane >> 5) & 1;
#pragma unroll
        for (int i = 0; i < 8; ++i) { const float keep = hi ? part[2 * i + 1] : part[2 * i], send = hi ? part[2 * i] : part[2 * i + 1]; q8[i] = keep + __shfl_xor(send, 32); } }
      { const bool hi = (lane >> 4) & 1;
#pragma unroll
        for (int i = 0; i < 4; ++i) { const float keep = hi ? q8[2 * i + 1] : q8[2 * i], send = hi ? q8[2 * i] : q8[2 * i + 1]; q4[i] = keep + __shfl_xor(send, 16); } }
      { const bool hi = (lane >> 3) & 1;
#pragma unroll
        for (int i = 0; i < 2; ++i) { const float keep = hi ? q4[2 * i + 1] : q4[2 * i], send = hi ? q4[2 * i] : q4[2 * i + 1]; q2[i] = keep + __shfl_xor(send, 8); } }
      { const bool hi = (lane >> 2) & 1;
        const float keep = hi ? q2[1] : q2[0], send = hi ? q2[0] : q2[1]; q1 = keep + __shfl_xor(send, 4); }
      q1 += __shfl_xor(q1, 2);
      q1 += __shfl_xor(q1, 1);
      {
        const int kk = rnd * 16 + kcode;
        const int eid = ids[kk];
        const float a = q1 * rr * usc[eid];
        const float ge = 0.5f * a * (1.f + erff(a * 0.70710678118654752f));
        if ((lane & 3) == 0) wts[kk] = gts[kk] * ge * vsc[eid];
      }
    }
    float acc[32];
#pragma unroll
    for (int i = 0; i < 32; ++i) acc[i] = 0.f;
#pragma unroll 1
    for (int rnd = 0; rnd < 8; ++rnd) {
      u32x4 ra[16];
#pragma unroll
      for (int k = 0; k < 16; ++k) {
        const int e = __builtin_amdgcn_readfirstlane(ids[rnd * 16 + k]);
        ra[k] = *(const u32x4*)(vb + (size_t)e * ROW4 + lane * 16);
      }
      f32x4 wv[4];
#pragma unroll
      for (int j = 0; j < 4; ++j) wv[j] = *(const f32x4*)(wts + rnd * 16 + 4 * j);
#pragma unroll
      for (int k = 0; k < 16; ++k) {
        const float wk = wv[k >> 2][k & 3];
        asm volatile("" : "+v"(ra[k]) : "v"(acc[1]), "v"(acc[3]), "v"(acc[5]), "v"(acc[7]), "v"(acc[9]), "v"(acc[11]), "v"(acc[13]), "v"(acc[15]),
                                        "v"(acc[17]), "v"(acc[19]), "v"(acc[21]), "v"(acc[23]), "v"(acc[25]), "v"(acc[27]), "v"(acc[29]), "v"(acc[31]));
#define V4_STEP(j, i) { const f32x2 r = __builtin_amdgcn_cvt_scalef32_pk_f32_fp4(ra[k][j], 1.0f, i); \
            acc[8 * (j) + 2 * (i)] = fmaf(wk, r[0], acc[8 * (j) + 2 * (i)]); acc[8 * (j) + 2 * (i) + 1] = fmaf(wk, r[1], acc[8 * (j) + 2 * (i) + 1]); }
#pragma unroll
        for (int j = 0; j < 4; ++j) { V4_STEP(j, 0) V4_STEP(j, 1) V4_STEP(j, 2) V4_STEP(j, 3) }
#undef V4_STEP
      }
    }
    float ss = 0.f;
#pragma unroll
    for (int i = 0; i < 32; ++i) { acc[i] += xf[i]; ss += acc[i] * acc[i]; }
    ss = wave_sum(ss);
    const float rf = rsqrtf(ss * (1.f / DM) + EPS);
#pragma unroll
    for (int j = 0; j < 8; ++j) {
      const f32x4 lw = *(const f32x4*)(p.ln_final + 256 * j + lane * 4);
      *(f32x4*)(p.out + (size_t)t * DM + 256 * j + lane * 4) = (f32x4){acc[4 * j] * rf * lw[0], acc[4 * j + 1] * rf * lw[1], acc[4 * j + 2] * rf * lw[2], acc[4 * j + 3] * rf * lw[3]};
    }
  }
}

typedef float f32x16 __attribute__((ext_vector_type(16)));
constexpr int VT_LD = 196;
constexpr int ATT_VT_BYTES = 4 * 64 * VT_LD * 2;
__device__ __forceinline__ void attn_item(const Params& p, unsigned char* lds, int item) {
  const int tid = threadIdx.x, lane = tid & 63, wid = __builtin_amdgcn_readfirstlane(tid >> 6);
  const int b = item >> 6, q0 = (item & 63) * 32;
  bf16_t* VT = (bf16_t*)lds;
  float* biasL = (float*)(lds + ATT_VT_BYTES);
  float* ssqw = biasL + 16 * 132;
  const bf16_t* proj = (const bf16_t*)(p.ws + WS_PROJ);
  const float* projm = (const float*)(p.ws + WS_PROJM);
  bf16_t* mixin = (bf16_t*)(p.ws + WS_HNB);
  for (int idx = tid; idx < 16 * 129; idx += NTHREADS) {
    const int hq = idx / 129, d = idx - hq * 129;
    const int bk = d < 128 ? (int)kBucket[d] : 31;
    biasL[hq * 132 + d] = p.rel_bias[bk * 16 + hq];
  }
#pragma unroll 1
  for (int task = tid; task < 96 * 32; task += NTHREADS) {
    const int pi = task >> 5, ch = task & 31, slot0 = 2 * pi;
    float v0[8], v1[8];
    if (slot0 < 16) {
      const float* r0 = projm + (size_t)slot0 * DPROJ + OFF_V + ch * 8;
      const float* r1 = r0 + DPROJ;
#pragma unroll
      for (int i = 0; i < 8; ++i) { v0[i] = r0[i]; v1[i] = r1[i]; }
    } else if (slot0 < 32) {
#pragma unroll
      for (int i = 0; i < 8; ++i) { v0[i] = 0.f; v1[i] = 0.f; }
    } else {
      const int s0 = q0 - 128 + slot0 - 32;
      if (s0 < 0) {
#pragma unroll
        for (int i = 0; i < 8; ++i) { v0[i] = 0.f; v1[i] = 0.f; }
      } else {
        const bf16_t* r0 = proj + (size_t)(b * SEQ + s0) * NPROJ + OFF_V + ch * 8;
        const u32x4 a = *(const u32x4*)r0, c = *(const u32x4*)(r0 + NPROJ);
        v0[0] = bflo(a.x); v0[1] = bfhi(a.x); v0[2] = bflo(a.y); v0[3] = bfhi(a.y); v0[4] = bflo(a.z); v0[5] = bfhi(a.z); v0[6] = bflo(a.w); v0[7] = bfhi(a.w);
        v1[0] = bflo(c.x); v1[1] = bfhi(c.x); v1[2] = bflo(c.y); v1[3] = bfhi(c.y); v1[4] = bflo(c.z); v1[5] = bfhi(c.z); v1[6] = bflo(c.w); v1[7] = bfhi(c.w);
      }
    }
    bf16_t* dst = VT + (size_t)((ch >> 3) * 64 + (ch & 7) * 8) * VT_LD + slot0;
#pragma unroll
    for (int i = 0; i < 8; ++i) *(unsigned*)(dst + i * VT_LD) = pack_bf16(v0[i], v1[i]);
  }
  __syncthreads();
  const int ql = lane & 31, hh = lane >> 5, kvh = wid >> 1;
  const int trow = b * SEQ + q0 + ql;
  float ssq = 0.f;
#pragma unroll 1
  for (int hsel = 0; hsel < 2; ++hsel) {
    const int hq = 2 * wid + hsel;
    bf16x8 qf[4];
#pragma unroll
    for (int ks = 0; ks < 4; ++ks) qf[ks] = *(const bf16x8*)(proj + (size_t)trow * NPROJ + OFF_Q + hq * 64 + ks * 16 + hh * 8);
    f32x16 sacc[6];
#pragma unroll
    for (int jt = 0; jt < 6; ++jt) {
      f32x16 acc;
#pragma unroll
      for (int r = 0; r < 16; ++r) acc[r] = 0.f;
      if (jt == 0) {
        const float* kr = projm + (size_t)(ql & 15) * DPROJ + OFF_K + kvh * 64 + hh * 8;
#pragma unroll
        for (int ks = 0; ks < 4; ++ks) {
          const f32x4 a = *(const f32x4*)(kr + ks * 16), c = *(const f32x4*)(kr + ks * 16 + 4);
          u32x4 w; w.x = pack_bf16(a[0], a[1]); w.y = pack_bf16(a[2], a[3]); w.z = pack_bf16(c[0], c[1]); w.w = pack_bf16(c[2], c[3]);
          acc = __builtin_amdgcn_mfma_f32_32x32x16_bf16(*(bf16x8*)&w, qf[ks], acc, 0, 0, 0);
        }
      } else {
        int sp = q0 - 128 + 32 * (jt - 1) + ql;
        sp = sp < 0 ? 0 : sp;
        const bf16_t* kr = proj + (size_t)(b * SEQ + sp) * NPROJ + OFF_K + kvh * 64 + hh * 8;
#pragma unroll
        for (int ks = 0; ks < 4; ++ks) acc = __builtin_amdgcn_mfma_f32_32x32x16_bf16(*(const bf16x8*)(kr + ks * 16), qf[ks], acc, 0, 0, 0);
      }
      sacc[jt] = acc;
      asm volatile("" ::: "memory");
    }
    const float* bl = biasL + hq * 132;
    int sq = q0 + ql, qh = ql - 4 * hh;
    asm volatile("" : "+v"(sq), "+v"(qh));
    const float sink = p.sinks[hq];
    float m = sink;
#pragma unroll
    for (int jt = 0; jt < 6; ++jt) {
      asm volatile("" ::: "memory");
#pragma unroll
      for (int r = 0; r < 16; ++r) {
        const int kr = (r & 3) + 8 * (r >> 2) + 4 * hh;
        int dist; bool valid;
        if (jt == 0) { dist = sq + (16 - ((r & 3) + 8 * (r >> 2))) - 4 * hh; valid = kr < 16; }
        else { dist = qh + (128 - 32 * (jt - 1) - ((r & 3) + 8 * (r >> 2))); valid = (dist >= 0) && (dist < 128) && (dist <= sq); }
        const int dc = dist < 0 ? 0 : (dist > 128 ? 128 : dist);
        const float l = valid ? 0.125f * sacc[jt][r] + bl[dc] : -1e30f;
        sacc[jt][r] = l;
        m = fmaxf(m, l);
      }
    }
    m = fmaxf(m, __shfl_xor(m, 32));
    float sum = 0.f;
    f32x16 oacc0, oacc1;
#pragma unroll
    for (int r = 0; r < 16; ++r) { oacc0[r] = 0.f; oacc1[r] = 0.f; }
    const bf16_t* vrow0 = VT + (size_t)(kvh * 64 + ql) * VT_LD + 4 * hh;
    const bf16_t* vrow1 = vrow0 + 32 * VT_LD;
#pragma unroll
    for (int jt = 0; jt < 6; ++jt) {
      u32x4 pw[2];
#pragma unroll
      for (int s2 = 0; s2 < 2; ++s2) {
        float e[8];
#pragma unroll
        for (int i = 0; i < 8; ++i) { e[i] = __expf(sacc[jt][8 * s2 + i] - m); sum += e[i]; }
        pw[s2].x = pack_bf16(e[0], e[1]); pw[s2].y = pack_bf16(e[2], e[3]); pw[s2].z = pack_bf16(e[4], e[5]); pw[s2].w = pack_bf16(e[6], e[7]);
      }
#pragma unroll
      for (int s2 = 0; s2 < 2; ++s2) {
        const u32x2 va = *(const u32x2*)(vrow0 + 32 * jt + 16 * s2), vc = *(const u32x2*)(vrow0 + 32 * jt + 16 * s2 + 8);
        const u32x2 vd = *(const u32x2*)(vrow1 + 32 * jt + 16 * s2), ve = *(const u32x2*)(vrow1 + 32 * jt + 16 * s2 + 8);
        u32x4 v0w; v0w.x = va.x; v0w.y = va.y; v0w.z = vc.x; v0w.w = vc.y;
        u32x4 v1w; v1w.x = vd.x; v1w.y = vd.y; v1w.z = ve.x; v1w.w = ve.y;
        oacc0 = __builtin_amdgcn_mfma_f32_32x32x16_bf16(*(bf16x8*)&v0w, *(bf16x8*)&pw[s2], oacc0, 0, 0, 0);
        oacc1 = __builtin_amdgcn_mfma_f32_32x32x16_bf16(*(bf16x8*)&v1w, *(bf16x8*)&pw[s2], oacc1, 0, 0, 0);
      }
    }
    sum += __shfl_xor(sum, 32);
    const float inv = 1.f / (sum + __expf(sink - m));
#pragma unroll
    for (int r = 0; r < 16; ++r) { oacc0[r] *= inv; oacc1[r] *= inv; ssq += oacc0[r] * oacc0[r] + oacc1[r] * oacc1[r]; }
#pragma unroll
    for (int rg = 0; rg < 4; ++rg) {
      u32x2 w; w.x = pack_bf16(oacc0[rg * 4 + 0], oacc0[rg * 4 + 1]); w.y = pack_bf16(oacc0[rg * 4 + 2], oacc0[rg * 4 + 3]);
      *(u32x2*)(mixin + (size_t)trow * DM + hq * 64 + 8 * rg + 4 * hh) = w;
      u32x2 w1; w1.x = pack_bf16(oacc1[rg * 4 + 0], oacc1[rg * 4 + 1]); w1.y = pack_bf16(oacc1[rg * 4 + 2], oacc1[rg * 4 + 3]);
      *(u32x2*)(mixin + (size_t)trow * DM + hq * 64 + 32 + 8 * rg + 4 * hh) = w1;
    }
  }
  ssq += __shfl_xor(ssq, 32);
  if (lane < 32) ssqw[wid * 32 + lane] = ssq;
  __syncthreads();
  float tot = 0.f;
#pragma unroll
  for (int w = 0; w < 8; ++w) tot += ssqw[w * 32 + ql];
  const float ra = rsqrtf(tot * (1.f / 1024) + EPS);
#pragma unroll
  for (int hsel = 0; hsel < 2; ++hsel)
#pragma unroll
    for (int dt = 0; dt < 2; ++dt)
#pragma unroll
      for (int rg = 0; rg < 4; ++rg) {
        bf16_t* op = mixin + (size_t)trow * DM + (2 * wid + hsel) * 64 + 32 * dt + 8 * rg + 4 * hh;
        const u32x2 v = *(const u32x2*)op;
        u32x2 w; w.x = pack_bf16(bflo(v.x) * ra, bfhi(v.x) * ra); w.y = pack_bf16(bflo(v.y) * ra, bfhi(v.y) * ra);
        *(u32x2*)op = w;
      }
  __syncthreads();
}
__device__ __forceinline__ void phase2_attn(const Params& p, unsigned char* lds, int bid, int nblk) {
  for (int item = bid; item < 256; item += nblk) attn_item(p, lds, item);
}

constexpr int SLD = 136;
__device__ __forceinline__ void unpack8(const u32x4 a, float (&v)[8]) {
  v[0] = bflo(a.x); v[1] = bfhi(a.x); v[2] = bflo(a.y); v[3] = bfhi(a.y); v[4] = bflo(a.z); v[5] = bfhi(a.z); v[6] = bflo(a.w); v[7] = bfhi(a.w);
}
__device__ __forceinline__ float conv_silu(const float (&raw)[11], int i, float w0, float w1, float w2, float w3, float cb) {
  return silu_f(cb + w0 * raw[i] + w1 * raw[i + 1] + w2 * raw[i + 2] + w3 * raw[i + 3]);
}
__device__ __forceinline__ void ssd_a_item(const Params& p, unsigned char* lds, int item) {
  const int tid = threadIdx.x, lane = tid & 63, wid = __builtin_amdgcn_readfirstlane(tid >> 6);
  const int b = item >> 6, c = (item >> 2) & 15, g = (item >> 1) & 1, hsel = item & 1;
  const int h0 = g * 8 + hsel * 4;
  const int t0 = b * SEQ + c * 128;
  bf16_t* Bc = (bf16_t*)lds;
  bf16_t* Cc = Bc + 128 * SLD;
  bf16_t* BcT = Cc + 128 * SLD;
  bf16_t* xT = BcT + 128 * SLD;
  float* dtl = (float*)(xT + 2 * 64 * SLD);
  float* acs = dtl + 512;
  float* wl = acs + 512;
  float* scan = wl + 512;
  const bf16_t* __restrict__ proj = (const bf16_t*)(p.ws + WS_PROJ);
  const bf16_t* __restrict__ projmb = (const bf16_t*)(p.ws + WS_PROJMB);
  const float* __restrict__ dtraw = (const float*)(p.ws + WS_DTRAW);
  float* __restrict__ acsg = (float*)(p.ws + WS_ACSG);
  bf16_t* __restrict__ ccb = (bf16_t*)(p.ws + WS_CCB);
  float* __restrict__ ypart = (float*)(p.ws + WS_YPART);
  float* __restrict__ sg = (float*)(p.ws + WS_SG);
  {
    const int hi = tid >> 7, l = tid & 127, h = h0 + hi;
    const float Ah = -expf(p.a_log[h]);
    const float dtv = softplus_f(dtraw[(size_t)(t0 + l) * 16 + h] + p.dt_bias[h]);
    dtl[tid] = dtv;
    float cum = dtv * Ah;
#pragma unroll
    for (int o = 1; o < 64; o <<= 1) { const float nb = __shfl_up(cum, o); if (lane >= o) cum += nb; }
    if ((tid & 127) == 63) scan[hi] = cum;
    __syncthreads();
    if (l >= 64) cum += scan[hi];
    acs[tid] = cum;
    acsg[(size_t)(t0 + l) * 16 + h] = cum;
    __syncthreads();
    wl[tid] = dtv * __expf(acs[hi * 128 + 127] - cum);
  }
#pragma unroll 1
  for (int rnd = 0; rnd < 2; ++rnd) {
    float raw[4][11];
#pragma unroll
    for (int q = 0; q < 4; ++q) {
      const int task = (rnd * 4 + q) * NTHREADS + tid;
      const int tg = task >> 8, ch = task & 255;
      const int cch = 1024 + (ch >> 7) * 256 + g * 128 + (ch & 127);
#pragma unroll
      for (int i = 0; i < 11; ++i) {
        const int l = tg * 8 + i - 3;
        const bf16_t* src = (l >= 0 || c > 0) ? proj + (size_t)(t0 + l) * NPROJ : projmb + (size_t)(16 + l) * DPROJ;
        raw[q][i] = bf2f(src[OFF_XBC + cch]);
      }
    }
#pragma unroll
    for (int q = 0; q < 4; ++q) {
      const int task = (rnd * 4 + q) * NTHREADS + tid;
      const int tg = task >> 8, ch = task & 255, n = ch & 127;
      const int cch = 1024 + (ch >> 7) * 256 + g * 128 + n;
      const float w0 = p.conv_w[cch], w1 = p.conv_w[D_XBC + cch], w2 = p.conv_w[2 * D_XBC + cch], w3 = p.conv_w[3 * D_XBC + cch], cb = p.conv_b[cch];
      float o[8];
#pragma unroll
      for (int i = 0; i < 8; ++i) o[i] = conv_silu(raw[q], i, w0, w1, w2, w3, cb);
      if (ch < 128) {
#pragma unroll
        for (int i = 0; i < 8; ++i) Bc[(tg * 8 + i) * SLD + n] = f2bf(o[i]);
        u32x4 w; w.x = pack_bf16(o[0], o[1]); w.y = pack_bf16(o[2], o[3]); w.z = pack_bf16(o[4], o[5]); w.w = pack_bf16(o[6], o[7]);
        *(u32x4*)(BcT + n * SLD + tg * 8) = w;
      } else {
#pragma unroll
        for (int i = 0; i < 8; ++i) Cc[(tg * 8 + i) * SLD + n] = f2bf(o[i]);
      }
    }
  }
  float xraw[2][11];
#define SSD_LOAD_X(hi_)                                                                                             \
  _Pragma("unroll") for (int q = 0; q < 2; ++q) {                                                                   \
    const int task = q * NTHREADS + tid; const int tg = task >> 6, cch = (h0 + (hi_)) * 64 + (task & 63);           \
    _Pragma("unroll") for (int i = 0; i < 11; ++i) { const int l = tg * 8 + i - 3;                                  \
      const bf16_t* src = (l >= 0 || c > 0) ? proj + (size_t)(t0 + l) * NPROJ : projmb + (size_t)(16 + l) * DPROJ;          \
      xraw[q][i] = bf2f(src[OFF_XBC + cch]); } }
  SSD_LOAD_X(0)
  __syncthreads();
  if (hsel == 0) {
#pragma unroll
    for (int q = 0; q < 4; ++q) {
      const int idx = q * NTHREADS + tid, row = idx >> 4, ck = idx & 15;
      *(u32x4*)(ccb + (size_t)(t0 + row) * 256 + g * 128 + ck * 8) = *(const u32x4*)(Cc + row * SLD + ck * 8);
    }
  }
  const int ql = lane & 31, hh = lane >> 5;
#pragma unroll 1
  for (int hi = 0; hi < 4; ++hi) {
    const int h = h0 + hi;
    bf16_t* xTb = xT + (hi & 1) * 64 * SLD;
#pragma unroll
    for (int q = 0; q < 2; ++q) {
      const int task = q * NTHREADS + tid; const int tg = task >> 6, pch = task & 63, cch = h * 64 + pch;
      const float w0 = p.conv_w[cch], w1 = p.conv_w[D_XBC + cch], w2 = p.conv_w[2 * D_XBC + cch], w3 = p.conv_w[3 * D_XBC + cch], cb = p.conv_b[cch];
      float o[8];
#pragma unroll
      for (int i = 0; i < 8; ++i) o[i] = conv_silu(xraw[q], i, w0, w1, w2, w3, cb);
      u32x4 w; w.x = pack_bf16(o[0], o[1]); w.y = pack_bf16(o[2], o[3]); w.z = pack_bf16(o[4], o[5]); w.w = pack_bf16(o[6], o[7]);
      *(u32x4*)(xTb + pch * SLD + tg * 8) = w;
    }
    if (hi < 3) { SSD_LOAD_X(hi + 1) }
    __syncthreads();
    const float dskip = p.d_skip[h];
    const float* acsh = acs + hi * 128;
    const float* dtlh = dtl + hi * 128;
    const float* wlh = wl + hi * 128;
    {
      const int ip = wid & 1, il = wid >> 1;
      const int l = 32 * il + ql;
      const float acl = acsh[l];
      f32x16 yacc;
#pragma unroll
      for (int r = 0; r < 16; ++r) yacc[r] = 0.f;
      const bf16_t* xrow = xTb + (32 * ip + ql) * SLD + 4 * hh;
#pragma unroll 1
      for (int is = 0; is <= il; ++is) {
        f32x16 x;
#pragma unroll
        for (int r = 0; r < 16; ++r) x[r] = 0.f;
        const bf16_t* ap = Bc + (32 * is + ql) * SLD + 8 * hh;
        const bf16_t* bp = Cc + l * SLD + 8 * hh;
#pragma unroll
        for (int ks = 0; ks < 8; ++ks) x = __builtin_amdgcn_mfma_f32_32x32x16_bf16(*(const bf16x8*)(ap + 16 * ks), *(const bf16x8*)(bp + 16 * ks), x, 0, 0, 0);
        u32x4 pw[2];
#pragma unroll
        for (int s2 = 0; s2 < 2; ++s2) {
          float mv[8];
#pragma unroll
          for (int q = 0; q < 2; ++q) {
            const int sb = 32 * is + 16 * s2 + 8 * q + 4 * hh;
            const f32x4 as4 = *(const f32x4*)(acsh + sb), dt4 = *(const f32x4*)(dtlh + sb);
#pragma unroll
            for (int j = 0; j < 4; ++j) {
              const int sr = sb + j;
              float v = sr <= l ? x[8 * s2 + 4 * q + j] * __expf(acl - as4[j]) * dt4[j] : 0.f;
              if (sr == l) v += dskip;
              mv[4 * q + j] = v;
            }
          }
          pw[s2].x = pack_bf16(mv[0], mv[1]); pw[s2].y = pack_bf16(mv[2], mv[3]); pw[s2].z = pack_bf16(mv[4], mv[5]); pw[s2].w = pack_bf16(mv[6], mv[7]);
        }
#pragma unroll
        for (int s2 = 0; s2 < 2; ++s2) {
          const u32x2 va = *(const u32x2*)(xrow + 32 * is + 16 * s2), vc = *(const u32x2*)(xrow + 32 * is + 16 * s2 + 8);
          u32x4 aw; aw.x = va.x; aw.y = va.y; aw.z = vc.x; aw.w = vc.y;
          yacc = __builtin_amdgcn_mfma_f32_32x32x16_bf16(*(bf16x8*)&aw, *(bf16x8*)&pw[s2], yacc, 0, 0, 0);
        }
      }
      float* yp = ypart + (size_t)(t0 + l) * 1024 + h * 64 + 32 * ip + 4 * hh;
#pragma unroll
      for (int rg = 0; rg < 4; ++rg) *(f32x4*)(yp + 8 * rg) = (f32x4){yacc[4 * rg], yacc[4 * rg + 1], yacc[4 * rg + 2], yacc[4 * rg + 3]};
    }
    {
      const int ip = wid & 1, in = wid >> 1;
      f32x16 sacc;
#pragma unroll
      for (int r = 0; r < 16; ++r) sacc[r] = 0.f;
      const bf16_t* ap = xTb + (32 * ip + ql) * SLD + 8 * hh;
      const bf16_t* bp = BcT + (32 * in + ql) * SLD + 8 * hh;
#pragma unroll
      for (int ks = 0; ks < 8; ++ks) {
        const u32x4 xa = *(const u32x4*)(ap + 16 * ks);
        const f32x4 wa = *(const f32x4*)(wlh + 16 * ks + 8 * hh), wb = *(const f32x4*)(wlh + 16 * ks + 8 * hh + 4);
        u32x4 aw;
        aw.x = pack_bf16(bflo(xa.x) * wa[0], bfhi(xa.x) * wa[1]); aw.y = pack_bf16(bflo(xa.y) * wa[2], bfhi(xa.y) * wa[3]);
        aw.z = pack_bf16(bflo(xa.z) * wb[0], bfhi(xa.z) * wb[1]); aw.w = pack_bf16(bflo(xa.w) * wb[2], bfhi(xa.w) * wb[3]);
        sacc = __builtin_amdgcn_mfma_f32_32x32x16_bf16(*(bf16x8*)&aw, *(const bf16x8*)(bp + 16 * ks), sacc, 0, 0, 0);
      }
      float* sp = sg + ((size_t)((b * 16 + c) * 16 + h) * 64 + 32 * ip + 4 * hh) * 128 + 32 * in + ql;
#pragma unroll
      for (int r = 0; r < 16; ++r) sp[((r & 3) + 8 * (r >> 2)) * 128] = sacc[r];
    }
  }
#undef SSD_LOAD_X
  __syncthreads();
}

__device__ __forceinline__ void meta_state_item(const Params& p, unsigned char* lds, int h) {
  const int tid = threadIdx.x, g = h >> 3;
  float* xm = (float*)lds;
  float* bm = xm + 16 * 64;
  float* dtm = bm + 16 * 128;
  const float* projm = (const float*)(p.ws + WS_PROJM);
  float* smeta = (float*)(p.ws + WS_SMETA);
  for (int task = tid; task < 16 * 192; task += NTHREADS) {
    const int i = task / 192, ch = task - i * 192;
    const int cch = ch < 64 ? h * 64 + ch : 1024 + g * 128 + (ch - 64);
    float acc = p.conv_b[cch];
#pragma unroll
    for (int j = 0; j < 4; ++j) { const int mi = i - j; if (mi >= 0) acc += p.conv_w[(3 - j) * D_XBC + cch] * projm[(size_t)mi * DPROJ + OFF_XBC + cch]; }
    const float v = silu_f(acc);
    if (ch < 64) xm[i * 64 + ch] = v; else bm[i * 128 + ch - 64] = v;
  }
  if (tid < 16) dtm[tid] = softplus_f(projm[(size_t)tid * DPROJ + OFF_DT + h] + p.dt_bias[h]);
  __syncthreads();
  const float Ah = -expf(p.a_log[h]);
  const int pr = tid >> 3, n0 = (tid & 7) * 16;
  float st[16];
#pragma unroll
  for (int k = 0; k < 16; ++k) st[k] = 0.f;
  for (int i = 0; i < 16; ++i) {
    const float dtv = dtm[i], dA = expf(dtv * Ah), xdt = xm[i * 64 + pr] * dtv;
#pragma unroll
    for (int k = 0; k < 16; ++k) st[k] = fmaf(st[k], dA, xdt * bm[i * 128 + n0 + k]);
  }
#pragma unroll
  for (int k = 0; k < 16; ++k) smeta[(size_t)(h * 64 + pr) * 128 + n0 + k] = st[k];
  __syncthreads();
}

__device__ __forceinline__ void phase2(const Params& p, unsigned char* lds, int bid, int nblk) {
#ifndef REP_SUB
#define REP_SUB -1
#endif
#pragma unroll 1
  for (int rep = 0; rep < (REP_SUB == 0 ? 2 : 1); ++rep)
    for (int item = bid; item < 256; item += nblk) attn_item(p, lds, item);
#pragma unroll 1
  for (int rep = 0; rep < (REP_SUB == 1 ? 2 : 1); ++rep)
    for (int item = bid; item < 256; item += nblk) ssd_a_item(p, lds, item);
  for (int item = bid; item < 16; item += nblk) meta_state_item(p, lds, item);
}

__device__ __forceinline__ void phase_scan(const Params& p, int bid, int nblk) {
  const float* __restrict__ sg = (const float*)(p.ws + WS_SG);
  const float* __restrict__ smeta = (const float*)(p.ws + WS_SMETA);
  const float* __restrict__ acsg = (const float*)(p.ws + WS_ACSG);
  bf16_t* __restrict__ hprev = (bf16_t*)(p.ws + WS_HPREV);
  for (int task = bid * NTHREADS + threadIdx.x; task < 64 * 2048; task += nblk * NTHREADS) {
    const int bh = task >> 11, e4 = (task & 2047) * 4;
    const int b = bh >> 4, h = bh & 15;
    f32x4 sv[16];
    float dv[16];
#pragma unroll
    for (int c = 0; c < 16; ++c) {
      sv[c] = *(const f32x4*)(sg + (size_t)((b * 16 + c) * 16 + h) * 8192 + e4);
      dv[c] = acsg[(size_t)(b * SEQ + c * 128 + 127) * 16 + h];
    }
    f32x4 H = *(const f32x4*)(smeta + (size_t)h * 8192 + e4);
#pragma unroll
    for (int c = 0; c < 16; ++c) {
      u32x2 w; w.x = pack_bf16(H[0], H[1]); w.y = pack_bf16(H[2], H[3]);
      *(u32x2*)(hprev + (size_t)((b * 16 + c) * 16 + h) * 8192 + e4) = w;
      H = H * __expf(dv[c]) + sv[c];
    }
  }
}

__device__ __forceinline__ void ssd_b_item(const Params& p, unsigned char* lds, int item) {
  const int tid = threadIdx.x, lane = tid & 63, wid = __builtin_amdgcn_readfirstlane(tid >> 6);
  const int b = item >> 5, c = (item >> 1) & 15, g = item & 1, h = g * 8 + wid;
  const int t0 = b * SEQ + c * 128;
  const int ql = lane & 31, hh = lane >> 5;
  float* ssqg = (float*)lds;
  const bf16_t* proj = (const bf16_t*)(p.ws + WS_PROJ);
  const float* acsg = (const float*)(p.ws + WS_ACSG);
  const bf16_t* ccb = (const bf16_t*)(p.ws + WS_CCB);
  const float* ypart = (const float*)(p.ws + WS_YPART);
  const bf16_t* hprev = (const bf16_t*)(p.ws + WS_HPREV);
  bf16_t* mixin = (bf16_t*)(p.ws + WS_HNB);
  float ssql[4] = {0.f, 0.f, 0.f, 0.f};
#pragma unroll 1
  for (int ip = 0; ip < 2; ++ip) {
    u32x4 hfr[8];
    {
      const bf16_t* hp = hprev + (size_t)((b * 16 + c) * 16 + h) * 8192 + (size_t)(32 * ip + ql) * 128 + 8 * hh;
#pragma unroll
      for (int ks = 0; ks < 8; ++ks) hfr[ks] = *(const u32x4*)(hp + 16 * ks);
    }
#pragma unroll
    for (int il = 0; il < 4; ++il) {
      const int t = t0 + 32 * il + ql;
      f32x16 acc;
#pragma unroll
      for (int r = 0; r < 16; ++r) acc[r] = 0.f;
      const bf16_t* cp = ccb + (size_t)t * 256 + g * 128 + 8 * hh;
#pragma unroll
      for (int ks = 0; ks < 8; ++ks) acc = __builtin_amdgcn_mfma_f32_32x32x16_bf16(*(bf16x8*)&hfr[ks], *(const bf16x8*)(cp + 16 * ks), acc, 0, 0, 0);
      const float ea = __expf(acsg[(size_t)t * 16 + h]);
#pragma unroll
      for (int rg = 0; rg < 4; ++rg) {
        const int pp = h * 64 + 32 * ip + 8 * rg + 4 * hh;
        const f32x4 yp = *(const f32x4*)(ypart + (size_t)t * 1024 + pp);
        const u32x2 zz = *(const u32x2*)(proj + (size_t)t * NPROJ + OFF_Z + pp);
        const float y0 = (yp[0] + ea * acc[4 * rg + 0]) * silu_f(bflo(zz.x)), y1 = (yp[1] + ea * acc[4 * rg + 1]) * silu_f(bfhi(zz.x));
        const float y2 = (yp[2] + ea * acc[4 * rg + 2]) * silu_f(bflo(zz.y)), y3 = (yp[3] + ea * acc[4 * rg + 3]) * silu_f(bfhi(zz.y));
        ssql[il] += y0 * y0 + y1 * y1 + y2 * y2 + y3 * y3;
        u32x2 w; w.x = pack_bf16(y0, y1); w.y = pack_bf16(y2, y3);
        *(u32x2*)(mixin + (size_t)t * DM + 1024 + pp) = w;
      }
    }
  }
#pragma unroll
  for (int il = 0; il < 4; ++il) {
    float v = ssql[il];
    v += __shfl_xor(v, 32);
    if (lane < 32) ssqg[wid * 128 + 32 * il + lane] = v;
  }
  __syncthreads();
#pragma unroll
  for (int il = 0; il < 4; ++il) {
    float tot = 0.f;
#pragma unroll
    for (int w = 0; w < 8; ++w) tot += ssqg[w * 128 + 32 * il + ql];
    const float rg_ = rsqrtf(tot * (1.f / 512) + EPS);
    const int t = t0 + 32 * il + ql;
#pragma unroll
    for (int ip = 0; ip < 2; ++ip)
#pragma unroll
      for (int rg = 0; rg < 4; ++rg) {
        bf16_t* op = mixin + (size_t)t * DM + 1024 + h * 64 + 32 * ip + 8 * rg + 4 * hh;
        const u32x2 v = *(const u32x2*)op;
        u32x2 w; w.x = pack_bf16(bflo(v.x) * rg_, bfhi(v.x) * rg_); w.y = pack_bf16(bflo(v.y) * rg_, bfhi(v.y) * rg_);
        *(u32x2*)op = w;
      }
  }
  __syncthreads();
}
__device__ __forceinline__ void phase3(const Params& p, unsigned char* lds, int bid, int nblk) {
  for (int item = bid; item < 128; item += nblk) ssd_b_item(p, lds, item);
}

constexpr int LDS_BYTES = 144 * 1024;

typedef const Params __attribute__((address_space(4))) * KArgPtr;
__device__ __forceinline__ Params load_params(KArgPtr k) {
  Params q;
#if defined(__HIP_DEVICE_COMPILE__)
  __builtin_memcpy(&q, k, sizeof(Params));
#endif
  return q;
}
#define PARAMS_PTR(pp) KArgPtr pp##_k = (KArgPtr)__builtin_amdgcn_kernarg_segment_ptr(); asm volatile("" : "+s"(pp##_k)); const Params pp##_v = load_params(pp##_k); const Params* pp = &pp##_v
__global__ __launch_bounds__(512, 2) void k_mega(Params p_unused) {
  extern __shared__ __attribute__((aligned(16))) unsigned char shm[];
  const int bid = blockIdx.x, nblk = gridDim.x;
  volatile LAS unsigned* xst = (volatile LAS unsigned*)(LAS unsigned char*)(shm + LDS_BYTES - 16);
  if (threadIdx.x == 0) { xst[0] = 0u; xst[1] = 0u; }
  __syncthreads();
  XcdBarrier xb;
  { PARAMS_PTR(pp); xb = xcd_barrier_post((unsigned*)(pp->ws + WS_CTL), xst); }
#ifndef REP_PHASE
#define REP_PHASE -1
#endif
#define NREP(k) ((REP_PHASE == (k)) ? 2 : 1)
#pragma unroll 1
  for (int rep = 0; rep < NREP(0); ++rep) { { PARAMS_PTR(pp); phase0(*pp, (float*)shm, bid, nblk); } if (rep + 1 < NREP(0)) xcd_barrier(xb); }
  xcd_barrier(xb);
#pragma unroll 1
  for (int rep = 0; rep < NREP(1); ++rep) { { PARAMS_PTR(pp); phase1(*pp, shm, bid, nblk); } xcd_barrier(xb); }
#pragma unroll 1
  for (int rep = 0; rep < NREP(2); ++rep) { { PARAMS_PTR(pp); phase2(*pp, shm, bid, nblk); } xcd_barrier(xb); }
#pragma unroll 1
  for (int rep = 0; rep < NREP(7); ++rep) { { PARAMS_PTR(pp); phase_scan(*pp, bid, nblk); } xcd_barrier(xb); }
#pragma unroll 1
  for (int rep = 0; rep < NREP(3); ++rep) { { PARAMS_PTR(pp); phase3(*pp, shm, bid, nblk); } xcd_barrier(xb); }
#pragma unroll 1
  for (int rep = 0; rep < NREP(4); ++rep) { { PARAMS_PTR(pp); phase4(*pp, shm, bid, nblk); } xcd_barrier(xb); }
#pragma unroll 1
  for (int rep = 0; rep < NREP(5); ++rep) { { PARAMS_PTR(pp); phase5(*pp, shm, bid, nblk); } xcd_barrier(xb); }
#pragma unroll 1
  for (int rep = 0; rep < NREP(6); ++rep) { { PARAMS_PTR(pp); phase6(*pp, shm, bid, nblk); } if (rep + 1 < NREP(6)) xcd_barrier(xb); }
}

}

extern "C" void kernel_launch(void* const* d_in, const int* in_sizes, int n_in, void* d_out, int out_size, void* d_ws,
                              size_t ws_size, hipStream_t stream) {
  Params p{};
  p.x = (const float*)d_in[0]; p.meta = (const float*)d_in[1]; p.rel_bias = (const float*)d_in[2];
  p.ln_mix = (const float*)d_in[3]; p.w_in = (const float*)d_in[4]; p.sinks = (const float*)d_in[5];
  p.conv_w = (const float*)d_in[6]; p.conv_b = (const float*)d_in[7]; p.dt_bias = (const float*)d_in[8];
  p.a_log = (const float*)d_in[9]; p.d_skip = (const float*)d_in[10]; p.attn_norm_w = (const float*)d_in[11];
  p.ssm_norm_w = (const float*)d_in[12]; p.w_out = (const float*)d_in[13]; p.ln_ffn = (const float*)d_in[14];
  p.wq = (const float*)d_in[15]; p.keys = (const float*)d_in[16]; p.U = (const float*)d_in[17];
  p.V = (const float*)d_in[18]; p.ln_final = (const float*)d_in[19];
  p.out = (float*)d_out;
  p.ws = (unsigned char*)d_ws;

  static int grid_blocks = 0;
  if (!grid_blocks) {
    int dev = 0, cus = 0, per_cu = 0;
    (void)hipGetDevice(&dev);
    (void)hipDeviceGetAttribute(&cus, hipDeviceAttributeMultiprocessorCount, dev);
    (void)hipFuncSetAttribute((const void*)k_mega, hipFuncAttributeMaxDynamicSharedMemorySize, LDS_BYTES);
    (void)hipOccupancyMaxActiveBlocksPerMultiprocessor(&per_cu, (const void*)k_mega, NTHREADS, LDS_BYTES);
    if (per_cu > 1) per_cu = 1;
    grid_blocks = cus * per_cu;
    if (grid_blocks != 256) fprintf(stderr, "kernel_launch: expected a 256-workgroup resident grid, got %d (cus %d, per_cu %d)\n", grid_blocks, cus, per_cu);
  }
  (void)hipMemsetAsync(p.ws + WS_CTL, 0, XCD_BAR_WORDS * 4, stream);
  void* args[] = {&p};
  hipError_t e = hipLaunchCooperativeKernel((const void*)k_mega, dim3(grid_blocks), dim3(NTHREADS), args, LDS_BYTES, stream);
  if (e != hipSuccess) fprintf(stderr, "cooperative launch failed: %s (grid %d)\n", hipGetErrorString(e), grid_blocks);
}
```

```cpp
#include <hip/hip_runtime.h>
#include <hip/hip_cooperative_groups.h>
#include <math.h>
#include <stdio.h>
#include <stdint.h>

#ifndef REP_SUB
#define REP_SUB -1
#endif
namespace {
constexpr int BATCH = 4, SEQ = 2048, DM = 2048, NMETA = 16;
constexpr int T = BATCH * SEQ;
constexpr int TA = T + NMETA;
constexpr int DPROJ = 4112;
constexpr int NPROJ = 4096;
constexpr int OFF_Q = 0, OFF_K = 1024, OFF_V = 1280, OFF_Z = 1536, OFF_XBC = 2560, OFF_DT = 4096;
constexpr int D_XBC = 1536;
constexpr int NEXP = 16384;
constexpr int ROW4 = 1024;
constexpr int ROW6 = 1536;
constexpr float EPS = 1e-6f;
constexpr int NTHREADS = 512;

typedef unsigned short bf16_t;
typedef short bf16x8 __attribute__((ext_vector_type(8)));
typedef float f32x4 __attribute__((ext_vector_type(4)));
typedef float f32x2 __attribute__((ext_vector_type(2)));
typedef unsigned u32x4 __attribute__((ext_vector_type(4)));
typedef unsigned u32x2 __attribute__((ext_vector_type(2)));
typedef __bf16 bf16v2 __attribute__((ext_vector_type(2)));
typedef float f32x16v __attribute__((ext_vector_type(16)));
typedef float f32x32v __attribute__((ext_vector_type(32)));
typedef unsigned u32x6 __attribute__((ext_vector_type(6)));
#define LAS __attribute__((address_space(3)))

__device__ __forceinline__ unsigned pack_bf16(float lo, float hi) {
  f32x2 v = {lo, hi};
  bf16v2 b = __builtin_convertvector(v, bf16v2);
  return *(unsigned*)&b;
}
__device__ __forceinline__ bf16_t f2bf(float f) { return (bf16_t)(pack_bf16(f, 0.f) & 0xffffu); }
__device__ __forceinline__ float bf2f(bf16_t b) { return __uint_as_float(((unsigned)b) << 16); }
__device__ __forceinline__ float bflo(unsigned u) { return __uint_as_float(u << 16); }
__device__ __forceinline__ float bfhi(unsigned u) { return __uint_as_float(u & 0xffff0000u); }

__constant__ unsigned char kBucket[128] = {
    0, 1, 2, 3, 4, 5, 6, 7, 8, 9, 10, 11, 12, 13, 14, 15, 16, 16, 16, 17, 17, 18, 18, 18, 19, 19, 19, 20, 20, 20, 20, 21,
    21, 21, 21, 22, 22, 22, 22, 22, 23, 23, 23, 23, 23, 23, 24, 24, 24, 24, 24, 24, 25, 25, 25, 25, 25, 25, 25, 26, 26, 26, 26, 26,
    26, 26, 26, 27, 27, 27, 27, 27, 27, 27, 27, 27, 27, 28, 28, 28, 28, 28, 28, 28, 28, 28, 28, 29, 29, 29, 29, 29, 29, 29, 29, 29,
    29, 29, 29, 30, 30, 30, 30, 30, 30, 30, 30, 30, 30, 30, 30, 30, 30, 31, 31, 31, 31, 31, 31, 31, 31, 31, 31, 31, 31, 31, 31, 31};

__constant__ unsigned char kCandI[64] = {0, 0, 0, 0, 0, 0, 0, 0, 0, 0, 0, 0, 0, 0, 0, 0, 1, 1, 1, 1, 1, 1, 1, 1, 2, 2, 2, 2, 2, 3, 3, 3, 3, 4, 4, 4, 5, 5, 6, 6, 7, 7, 8, 9, 10, 11, 12, 13, 14, 15, 15, 15, 15, 15, 15, 15, 15, 15, 15, 15, 15, 15, 15, 15};
__constant__ unsigned char kCandJ[64] = {0, 1, 2, 3, 4, 5, 6, 7, 8, 9, 10, 11, 12, 13, 14, 15, 0, 1, 2, 3, 4, 5, 6, 7, 0, 1, 2, 3, 4, 0, 1, 2, 3, 0, 1, 2, 0, 1, 0, 1, 0, 1, 0, 0, 0, 0, 0, 0, 0, 0, 15, 15, 15, 15, 15, 15, 15, 15, 15, 15, 15, 15, 15, 15};

__device__ __forceinline__ float wave_sum(float v) {
  for (int o = 32; o > 0; o >>= 1) v += __shfl_xor(v, o);
  return v;
}
__device__ __forceinline__ float wave_max(float v) {
  for (int o = 32; o > 0; o >>= 1) v = fmaxf(v, __shfl_xor(v, o));
  return v;
}
__device__ __forceinline__ float silu_f(float x) { return x / (1.f + expf(-x)); }
__device__ __forceinline__ float softplus_f(float x) { return fmaxf(x, 0.f) + log1pf(expf(-fabsf(x))); }

constexpr size_t al256(size_t x) { return (x + 255) & ~(size_t)255; }
constexpr size_t WS_CTL = 0;
constexpr size_t WS_WINT = 65536;
constexpr size_t WS_WDTT = WS_WINT + (size_t)NPROJ * DM * 2;
constexpr size_t WS_WOUTT = WS_WDTT + (size_t)16 * DM * 2;
constexpr size_t WS_WQT = WS_WOUTT + (size_t)DM * DM * 2;
constexpr size_t WS_KEYS = WS_WQT + (size_t)DM * DM * 2;
constexpr size_t WS_UB = WS_KEYS + (size_t)16 * 128 * 128 * 2;
constexpr size_t WS_VB = WS_UB + (size_t)NEXP * DM * 2;
constexpr size_t WS_HNB = WS_VB + (size_t)NEXP * DM * 2;
constexpr size_t WS_PROJ = WS_HNB + (size_t)(T + 16) * DM * 2;
constexpr size_t WS_DTRAW = WS_PROJ + (size_t)T * NPROJ * 2;
constexpr size_t WS_PROJM = WS_DTRAW + (size_t)T * 16 * 4;
constexpr size_t WS_PROJMB = al256(WS_PROJM + (size_t)16 * DPROJ * 4);
constexpr size_t WS_H1B = al256(WS_PROJMB + (size_t)16 * DPROJ * 2);
constexpr size_t WS_SSQH1 = WS_H1B + (size_t)T * DM * 2;
constexpr size_t WS_STOP = al256(WS_SSQH1 + (size_t)T * 32 * 4);
constexpr size_t WS_ITOP = WS_STOP + (size_t)T * 256 * 4;
constexpr size_t WS_ACSG = al256(WS_ITOP + (size_t)T * 256 * 4);
constexpr size_t WS_CCB = WS_ACSG + (size_t)T * 16 * 4;
constexpr size_t WS_YPART = WS_CCB + (size_t)T * 256 * 2;
constexpr size_t WS_SG = WS_YPART + (size_t)T * 1024 * 4;
constexpr size_t WS_SMETA = WS_SG + (size_t)1024 * 8192 * 4;
constexpr size_t WS_HPREV = al256(WS_SMETA + (size_t)16 * 8192 * 4);
constexpr size_t WS_USC = al256(WS_HPREV + (size_t)1024 * 8192 * 2);
constexpr size_t WS_VSC = WS_USC + (size_t)NEXP * 4;
constexpr size_t WS_SCR = al256(WS_VSC + (size_t)NEXP * 4);
}

namespace pg8 {
#define PG8_LAS __attribute__((address_space(3)))
constexpr int BM = 256, BK = 64, HALF = 128, HTB = HALF * BK * 2, STAGE_BYTES = 8 * HTB, NXCD = 8, WGM = 8;
__host__ __device__ __forceinline__ int lds_byte(int r, int c) { const int st = (r >> 4) * 2 + (c >> 5), rr = r & 15, cc = c & 31, ob = rr * 64 + cc * 2; return st * 1024 + (ob ^ (((ob >> 9) & 1) << 5)); }
__host__ __device__ __forceinline__ void stage_rc(int b, int& R, int& C) { const int st = b / 1024, sb = b % 1024, swz = sb ^ (((sb >> 9) & 1) << 5); R = (st >> 1) * 16 + swz / 64; C = (st & 1) * 32 + (swz % 64) / 2; }
__host__ __device__ __forceinline__ int perm32(int rho) { const int n = rho >> 4, i = rho & 15; return 8 * (i >> 2) + 4 * n + (i & 3); }
struct Unit { int pm, pn; };
struct Gemm { const bf16_t* A; const bf16_t* Bt; int M, N, K; };
struct StaticOrder {
    int nM, nN, nwg, G, c;
    __host__ __device__ void init(int M, int N, int G_, int c_) { nM = M / BM; nN = N / BM; nwg = nM * nN; G = G_; c = c_; }
    __host__ __device__ bool next(int i, Unit& u) const {
        const long L = (long)i * G + c; if (L >= nwg) return false;
        int wgid = (int)L; { const int q = nwg / NXCD, r = nwg % NXCD, xcd = wgid % NXCD, off = wgid / NXCD; wgid = (xcd < r ? xcd * (q + 1) : r * (q + 1) + (xcd - r) * q) + off; }
        const int nig = WGM * nN, gid = wgid / nig, fm = gid * WGM, gsz = (nM - fm) < WGM ? (nM - fm) : WGM;
        u.pm = fm + ((wgid % nig) % gsz); u.pn = (wgid % nig) / gsz; return true;
    }
    __device__ __forceinline__ void a_ready(const Unit&) const {}
    __device__ __forceinline__ void done(const Unit&) const {}
};
struct EpiBf16 {
    static constexpr bool PERM = true, AFTER_DRAIN = false;
    bf16_t* O; int ldc;
    __device__ __forceinline__ void operator()(const f32x4 (&acc)[2][2][4][2], const Unit& u, int wr, int wc, int fr, int fq) const {
        const int row0 = u.pm * BM + wr * 64 + fr; const int col0 = u.pn * BM + wc * 32 + 8 * fq;
#pragma unroll
        for (int ai = 0; ai < 2; ++ai)
#pragma unroll
            for (int m = 0; m < 4; ++m) { bf16_t* rowp = O + (size_t)(row0 + ai * HALF + m * 16) * ldc + col0;
#pragma unroll
                for (int bj = 0; bj < 2; ++bj) { const f32x4 v0 = acc[ai][bj][m][0], v1 = acc[ai][bj][m][1];
                    u32x4 w; w.x = pack_bf16(v0[0], v0[1]); w.y = pack_bf16(v0[2], v0[3]); w.z = pack_bf16(v1[0], v1[1]); w.w = pack_bf16(v1[2], v1[3]);
                    *(u32x4*)(rowp + bj * HALF) = w; } }
    }
};

struct EpiRes {
    static constexpr bool PERM = true, AFTER_DRAIN = false;
    const float* X; bf16_t* HB; float* SSQ;
    __device__ __forceinline__ void operator()(const f32x4 (&acc)[2][2][4][2], const Unit& u, int wr, int wc, int fr, int fq) const {
        const int row0 = u.pm * BM + wr * 64 + fr; const int col0 = u.pn * BM + wc * 32 + 8 * fq;
#pragma unroll
        for (int ai = 0; ai < 2; ++ai)
#pragma unroll
            for (int m = 0; m < 4; ++m) { const int row = row0 + ai * HALF + m * 16; const size_t off = (size_t)row * DM + col0; float ss = 0.f;
#pragma unroll
                for (int bj = 0; bj < 2; ++bj) {
                    const f32x4 x0 = *(const f32x4*)(X + off + bj * HALF), x1 = *(const f32x4*)(X + off + bj * HALF + 4);
                    const f32x4 v0 = acc[ai][bj][m][0] + x0, v1 = acc[ai][bj][m][1] + x1;
                    u32x4 w; w.x = pack_bf16(v0[0], v0[1]); w.y = pack_bf16(v0[2], v0[3]); w.z = pack_bf16(v1[0], v1[1]); w.w = pack_bf16(v1[2], v1[3]);
                    *(u32x4*)(HB + off + bj * HALF) = w;
                    ss += v0[0] * v0[0] + v0[1] * v0[1] + v0[2] * v0[2] + v0[3] * v0[3] + v1[0] * v1[0] + v1[1] * v1[1] + v1[2] * v1[2] + v1[3] * v1[3]; }
                ss += __shfl_xor(ss, 16); ss += __shfl_xor(ss, 32);
                if (fq == 0) SSQ[(size_t)row * 32 + u.pn * 4 + wc] = ss; }
    }
};
struct EpiF32 {
    static constexpr bool PERM = true, AFTER_DRAIN = false;
    float* C; int ldc;
    __device__ __forceinline__ void operator()(const f32x4 (&acc)[2][2][4][2], const Unit& u, int wr, int wc, int fr, int fq) const {
        const int row0 = u.pm * BM + wr * 64 + fr; const int col0 = u.pn * BM + wc * 32 + 8 * fq;
#pragma unroll
        for (int ai = 0; ai < 2; ++ai)
#pragma unroll
            for (int m = 0; m < 4; ++m) { float* rowp = C + (size_t)(row0 + ai * HALF + m * 16) * ldc + col0;
#pragma unroll
                for (int bj = 0; bj < 2; ++bj) { *(f32x4*)(rowp + bj * HALF) = acc[ai][bj][m][0]; *(f32x4*)(rowp + bj * HALF + 4) = acc[ai][bj][m][1]; } }
    }
};

struct EpiScores {
    static constexpr bool PERM = true, AFTER_DRAIN = true;
    const bf16_t* KEYS;
    float* STOP; int* ITOP;
    static constexpr int QLD = 264;
    __device__ __forceinline__ void fused(f32x4 (&acc)[2][2][4][2], const Unit& u, int wr, int wc, int fr, int fq, PG8_LAS unsigned char* lds, int wid, int lane) const {
        PG8_LAS bf16_t* Q = (PG8_LAS bf16_t*)lds;
#pragma unroll
        for (int ai = 0; ai < 2; ++ai)
#pragma unroll
            for (int m = 0; m < 4; ++m) { const int row = ai * HALF + wr * 64 + m * 16 + fr;
#pragma unroll
                for (int bj = 0; bj < 2; ++bj) { const f32x4 v0 = acc[ai][bj][m][0], v1 = acc[ai][bj][m][1];
                    u32x4 w; w.x = pack_bf16(v0[0], v0[1]); w.y = pack_bf16(v0[2], v0[3]); w.z = pack_bf16(v1[0], v1[1]); w.w = pack_bf16(v1[2], v1[3]);
                    *(PG8_LAS u32x4*)(Q + row * QLD + bj * HALF + wc * 32 + 8 * fq) = w; } }
        __syncthreads();
        const int h = u.pn;
#pragma unroll 1
        for (int c = 0; c < 2; ++c) {
            f32x4 sc[8][2];
#pragma unroll
            for (int kf = 0; kf < 8; ++kf) { sc[kf][0] = (f32x4){0.f, 0.f, 0.f, 0.f}; sc[kf][1] = (f32x4){0.f, 0.f, 0.f, 0.f}; }
            const bf16_t* kb = KEYS + (size_t)((h * 2 + c) * 128 + fr) * 128 + 8 * fq;
            const PG8_LAS bf16_t* qb = Q + (wid * 32 + fr) * QLD + c * 128 + 8 * fq;
#pragma unroll
            for (int ks = 0; ks < 4; ++ks) {
                const bf16x8 q0 = *(const PG8_LAS bf16x8*)(qb + 32 * ks), q1 = *(const PG8_LAS bf16x8*)(qb + 16 * QLD + 32 * ks);
#pragma unroll
                for (int kf = 0; kf < 8; ++kf) { const bf16x8 kv = *(const bf16x8*)(kb + (size_t)kf * 16 * 128 + 32 * ks);
                    sc[kf][0] = __builtin_amdgcn_mfma_f32_16x16x32_bf16(kv, q0, sc[kf][0], 0, 0, 0);
                    sc[kf][1] = __builtin_amdgcn_mfma_f32_16x16x32_bf16(kv, q1, sc[kf][1], 0, 0, 0); }
            }
#pragma unroll
            for (int tf = 0; tf < 2; ++tf) {
                float v[32];
#pragma unroll
                for (int kf = 0; kf < 8; ++kf)
#pragma unroll
                    for (int r = 0; r < 4; ++r) v[kf * 4 + r] = __uint_as_float((__float_as_uint(sc[kf][tf][r]) & 0xffffff80u) | (unsigned)(16 * kf + r));
                const unsigned fqbits = 4u * fq;
                const size_t obase = ((size_t)(u.pm * BM + wid * 32 + tf * 16 + fr) * 16 + h * 2 + c) * 16;
#pragma unroll 1
                for (int r = 0; r < 16; ++r) {
                    float mx = v[0];
#pragma unroll
                    for (int i = 1; i < 32; ++i) mx = fmaxf(mx, v[i]);
                    float cand = __uint_as_float(__float_as_uint(mx) | fqbits);
                    float o = __shfl_xor(cand, 16); cand = fmaxf(cand, o);
                    o = __shfl_xor(cand, 32); cand = fmaxf(cand, o);
                    const unsigned cb = __float_as_uint(cand);
                    const bool mine = (cb & 12u) == fqbits;
                    const float rem = __uint_as_float(cb & ~12u);
#pragma unroll
                    for (int i = 0; i < 32; ++i) v[i] = (mine && v[i] == rem) ? -INFINITY : v[i];
                    if (fq == 0) { STOP[obase + r] = __uint_as_float(cb & 0xffffff80u); ITOP[obase + r] = (int)(cb & 127u); }
                }
            }
        }
    }
};

template <class Epi, class Sched>
__device__ __forceinline__ void gemm_phase(PG8_LAS unsigned char* lds, const Gemm g, const Sched& S, const Epi& E) {
    int tid_ = threadIdx.x; asm volatile("" : "+v"(tid_));
    const int tid = tid_, wid = __builtin_amdgcn_readfirstlane(tid >> 6), lane = tid & 63, wr = wid >> 2, wc = wid & 3, fr = lane & 15, fq = lane >> 4;
    const int K = g.K, nt = K / BK;
    unsigned voffA[2], voffB[2];
#pragma unroll
    for (int i = 0; i < 2; ++i) { int R, C; stage_rc(tid * 16 + i * 8192, R, C); const int Rb = Epi::PERM ? ((R & ~31) + perm32(R & 31)) : R;
        voffA[i] = (unsigned)(R * K + C) * 2u; voffB[i] = (unsigned)(Rb * K + C) * 2u; }
    const size_t kstep = (size_t)(BK * 2);
    const size_t hstep = (size_t)HALF * K * 2;
    const size_t tstep = 2 * hstep;
    const unsigned ldsw = (unsigned)wid * 1024u;
    const int aoff = lds_byte(wr * 64 + fr, fq * 8), boff = lds_byte(wc * 32 + fr, fq * 8);
#define PG8_SA(b, h) (((b) * 2 + (h)) * HTB)
#define PG8_SB(b, h) ((4 + (b) * 2 + (h)) * HTB)
#define PG8_STAGE(bufoff, gbase, voff) do { _Pragma("unroll") for (int _i = 0; _i < 2; ++_i) \
        __builtin_amdgcn_global_load_lds((const unsigned*)((const char*)(gbase) + (voff)[_i]), (PG8_LAS unsigned*)(lds + (bufoff) + ldsw + _i * 8192), 16, 0, 0); } while (0)
#define PG8_LDA(dst, b, h) do { _Pragma("unroll") for (int m = 0; m < 4; ++m) _Pragma("unroll") for (int k = 0; k < 2; ++k) dst[m][k] = *(const PG8_LAS bf16x8*)(lds + PG8_SA(b, h) + aoff + m * 2048 + k * 1024); } while (0)
#define PG8_LDB(dst, b, h) do { _Pragma("unroll") for (int n = 0; n < 2; ++n) _Pragma("unroll") for (int k = 0; k < 2; ++k) dst[n][k] = *(const PG8_LAS bf16x8*)(lds + PG8_SB(b, h) + boff + n * 2048 + k * 1024); } while (0)
#define PG8_MMA(ai, bj, At, Bt) do { __builtin_amdgcn_s_setprio(1); _Pragma("unroll") for (int m = 0; m < 4; ++m) _Pragma("unroll") for (int n = 0; n < 2; ++n) _Pragma("unroll") for (int k = 0; k < 2; ++k) \
        acc[ai][bj][m][n] = __builtin_amdgcn_mfma_f32_16x16x32_bf16(Bt[n][k], At[m][k], acc[ai][bj][m][n], 0, 0, 0); __builtin_amdgcn_s_setprio(0); } while (0)
#define PG8_WAIT_V(n) asm volatile("s_waitcnt vmcnt(" #n ")" ::: "memory")
#define PG8_WAIT_L(n) asm volatile("s_waitcnt lgkmcnt(" #n ")" ::: "memory")
#define PG8_BAR __builtin_amdgcn_s_barrier()
#define PG8_SCHED __builtin_amdgcn_sched_barrier(0)
    Unit cur, nxt; int ui = 0;
    if (!S.next(0, cur)) return;
    f32x4 acc[2][2][4][2];
#pragma unroll
    for (int a = 0; a < 2; ++a)
#pragma unroll
        for (int b = 0; b < 2; ++b)
#pragma unroll
            for (int m = 0; m < 4; ++m)
#pragma unroll
                for (int n = 0; n < 2; ++n) acc[a][b][m][n] = (f32x4){0.f, 0.f, 0.f, 0.f};
    bf16x8 At[4][2], B0[2][2], B1[2][2];
    const char* cA = (const char*)g.A + (size_t)cur.pm * tstep; const char* cB = (const char*)g.Bt + (size_t)cur.pn * tstep;
    S.a_ready(cur);
    PG8_STAGE(PG8_SB(0, 0), cB, voffB); PG8_STAGE(PG8_SA(0, 0), cA, voffA); PG8_STAGE(PG8_SB(0, 1), cB + hstep, voffB); PG8_STAGE(PG8_SA(0, 1), cA + hstep, voffA);
    if (wr == 1) PG8_BAR;
    PG8_WAIT_V(4); PG8_BAR;
    PG8_STAGE(PG8_SB(1, 0), cB + kstep, voffB); PG8_STAGE(PG8_SA(1, 0), cA + kstep, voffA); PG8_STAGE(PG8_SB(1, 1), cB + hstep + kstep, voffB);
    PG8_WAIT_V(6); PG8_BAR;
    for (;;) {
        const bool has_next = S.next(ui + 1, nxt);
        const char* nA = has_next ? (const char*)g.A + (size_t)nxt.pm * tstep : cA; const char* nB = has_next ? (const char*)g.Bt + (size_t)nxt.pn * tstep : cB;
        for (int t = 0; t < nt; t += 2) {
            const bool last = (t == nt - 2);
            const char* a1 = cA + (size_t)(t + 1) * kstep;
            const char* a2 = last ? nA : cA + (size_t)(t + 2) * kstep; const char* b2 = last ? nB : cB + (size_t)(t + 2) * kstep;
            const char* a3 = a2 + kstep; const char* b3 = b2 + kstep;
            if (last && has_next) S.a_ready(nxt);
            PG8_LDB(B0, 0, 0); PG8_SCHED; PG8_LDA(At, 0, 0); PG8_STAGE(PG8_SA(1, 1), a1 + hstep, voffA);
            PG8_WAIT_L(8); PG8_BAR; PG8_WAIT_L(0); PG8_MMA(0, 0, At, B0); PG8_BAR; PG8_SCHED;
            PG8_LDB(B1, 0, 1); PG8_STAGE(PG8_SB(0, 0), b2, voffB);
            PG8_BAR; PG8_WAIT_L(0); PG8_MMA(0, 1, At, B1); PG8_BAR;
            PG8_LDA(At, 0, 1); PG8_STAGE(PG8_SA(0, 0), a2, voffA);
            PG8_BAR; PG8_WAIT_L(0); PG8_MMA(1, 0, At, B0); PG8_BAR; PG8_SCHED;
            PG8_STAGE(PG8_SB(0, 1), b2 + hstep, voffB);
            PG8_WAIT_V(6); PG8_BAR; PG8_MMA(1, 1, At, B1); PG8_BAR;
            PG8_LDB(B0, 1, 0); PG8_SCHED; PG8_LDA(At, 1, 0); PG8_STAGE(PG8_SA(0, 1), a2 + hstep, voffA);
            PG8_WAIT_L(8); PG8_BAR; PG8_WAIT_L(0); PG8_MMA(0, 0, At, B0); PG8_BAR; PG8_SCHED;
            PG8_LDB(B1, 1, 1); PG8_STAGE(PG8_SB(1, 0), b3, voffB);
            PG8_BAR; PG8_WAIT_L(0); PG8_MMA(0, 1, At, B1); PG8_BAR;
            PG8_LDA(At, 1, 1); PG8_STAGE(PG8_SA(1, 0), a3, voffA);
            PG8_BAR; PG8_WAIT_L(0); PG8_MMA(1, 0, At, B0); PG8_BAR; PG8_SCHED;
            PG8_STAGE(PG8_SB(1, 1), b3 + hstep, voffB);
            PG8_WAIT_V(6); PG8_BAR; PG8_MMA(1, 1, At, B1); PG8_BAR;
        }
        if constexpr (!Epi::AFTER_DRAIN) { E(acc, cur, wr, wc, fr, fq); S.done(cur); }
        if (!has_next) break;
#pragma unroll
        for (int a = 0; a < 2; ++a)
#pragma unroll
            for (int b = 0; b < 2; ++b)
#pragma unroll
                for (int m = 0; m < 4; ++m)
#pragma unroll
                    for (int n = 0; n < 2; ++n) acc[a][b][m][n] = (f32x4){0.f, 0.f, 0.f, 0.f};
        cur = nxt; cA = nA; cB = nB; ++ui;
    }
    PG8_WAIT_V(0);
    if (wr == 0) PG8_BAR;
    PG8_BAR;
    if constexpr (Epi::AFTER_DRAIN) { E.fused(acc, cur, wr, wc, fr, fq, lds, wid, lane); S.done(cur); }
#undef PG8_SA
#undef PG8_SB
#undef PG8_STAGE
#undef PG8_LDA
#undef PG8_LDB
#undef PG8_MMA
#undef PG8_WAIT_V
#undef PG8_WAIT_L
#undef PG8_BAR
#undef PG8_SCHED
}
}

#define XB_TMO      128
#define XB_XCNT(j)  (256  + 64 * (j))
#define XB_XSUB(j)  (1280 + 64 * (j))
#define XB_XGEN(j)  (2304 + 64 * (j))
#define XB_TOP      3328
#define XB_TOPGEN   3392
#define XCD_BAR_WORDS 3456
#define XB_SPIN_CAP (1u << 22)
__device__ __forceinline__ unsigned xb_ld(unsigned* p)              { return __hip_atomic_load(p, __ATOMIC_RELAXED, __HIP_MEMORY_SCOPE_AGENT); }
__device__ __forceinline__ unsigned xb_add(unsigned* p, unsigned v) { return __hip_atomic_fetch_add(p, v, __ATOMIC_RELAXED, __HIP_MEMORY_SCOPE_AGENT); }
__device__ __forceinline__ unsigned xb_xcc_id() { return (unsigned)__builtin_amdgcn_s_getreg((3 << 11) | 20) & 0xFu; }
#define XB_SPIN(cond, bar) do { unsigned _sp = 0; while (cond) { __builtin_amdgcn_s_sleep(1); \
    if ((++_sp & 255u) == 0u) { if (xb_ld(&(bar)[XB_TMO])) break; if (_sp > XB_SPIN_CAP) { atomicAdd(&(bar)[XB_TMO], 1u); break; } } } } while (0)
struct XcdBarrier { unsigned* bar; unsigned x; volatile LAS unsigned* st; };
__device__ __forceinline__ XcdBarrier xcd_barrier_post(unsigned* bar, volatile LAS unsigned* st) {
    XcdBarrier b; b.bar = bar; b.x = xb_xcc_id(); b.st = st;
    if (threadIdx.x == 0) (void)xb_add(&bar[XB_XCNT(b.x)], 1u);
    return b;
}
__device__ __forceinline__ void xcd_barrier_complete(unsigned* bar, unsigned x, unsigned& nloc, unsigned& nx) {
    const unsigned G = gridDim.x * gridDim.y * gridDim.z;
    unsigned sum, cnt, mine, sp = 0u;
    for (;;) {
        sum = 0u; cnt = 0u; mine = 0u;
#pragma unroll
        for (unsigned j = 0; j < 16; ++j) { const unsigned c = xb_ld(&bar[XB_XCNT(j)]); sum += c; cnt += (c > 0u) ? 1u : 0u; mine = (j == x) ? c : mine; }
        if (sum == G) break;
        __builtin_amdgcn_s_sleep(1);
        if ((++sp & 255u) == 0u) { if (xb_ld(&bar[XB_TMO])) break; if (sp > XB_SPIN_CAP) { atomicAdd(&bar[XB_TMO], 1u); break; } }
    }
    nloc = mine > 0u ? mine : 1u; nx = cnt > 0u ? cnt : 1u;
}
__device__ __forceinline__ void xcd_barrier(const XcdBarrier& b) {
    asm volatile("s_waitcnt vmcnt(0)" ::: "memory");
    __syncthreads();
    if (threadIdx.x == 0) {
        unsigned* bar = b.bar;
        const unsigned bx = xb_xcc_id();
        __builtin_amdgcn_s_waitcnt(0);
        unsigned nloc = b.st[0], nx = b.st[1];
        if (nloc == 0u) { xcd_barrier_complete(bar, bx, nloc, nx); b.st[0] = nloc; b.st[1] = nx; }
        const unsigned old = xb_add(&bar[XB_XSUB(bx)], 1u);
        const unsigned gen = old / nloc;
        if (old + 1u == (gen + 1u) * nloc) {
            __builtin_amdgcn_fence(__ATOMIC_RELEASE, "agent");
            asm volatile("s_waitcnt vmcnt(0)" ::: "memory");
            const unsigned og = xb_add(&bar[XB_TOP], 1u);
            const unsigned tg = og / nx;
            if (og + 1u == (tg + 1u) * nx) xb_add(&bar[XB_TOPGEN], 1u);
            else XB_SPIN(xb_ld(&bar[XB_TOPGEN]) == tg, bar);
            __builtin_amdgcn_fence(__ATOMIC_ACQUIRE, "agent");
            xb_add(&bar[XB_XGEN(bx)], 1u);
            asm volatile("s_waitcnt vmcnt(0)" ::: "memory");
        } else {
            XB_SPIN(xb_ld(&bar[XB_XGEN(bx)]) == gen, bar);
            __builtin_amdgcn_fence(__ATOMIC_ACQUIRE, "agent");
            asm volatile("s_waitcnt vmcnt(0)" ::: "memory");
        }
    }
    __syncthreads();
}

namespace {
struct Params {
  const float *x, *meta, *rel_bias, *ln_mix, *w_in, *sinks, *conv_w, *conv_b, *dt_bias, *a_log, *d_skip, *attn_norm_w,
      *ssm_norm_w, *w_out, *ln_ffn, *wq, *keys, *U, *V, *ln_final;
  float* out;
  unsigned char* ws;
};

__device__ __forceinline__ void p0_transpose_tile(const float* __restrict__ W, int ldw, bf16_t* __restrict__ Wt, const float* sc0,
                                                  const float* sc1, int k0, int n0, float* tile) {
  const int tid = threadIdx.x;
  {
    const int r = tid >> 6, c4 = (tid & 63) * 4;
    f32x4 v[8];
#pragma unroll
    for (int i = 0; i < 8; ++i) v[i] = *(const f32x4*)(W + (size_t)(k0 + r + 8 * i) * ldw + n0 + c4);
#pragma unroll
    for (int i = 0; i < 8; ++i) {
      float s = 1.f;
      const int k = k0 + r + 8 * i;
      if (sc0) s = k < 1024 ? sc0[k] : sc1[k - 1024];
      float* q = tile + (r + 8 * i) * 257 + c4;
      q[0] = v[i][0] * s; q[1] = v[i][1] * s; q[2] = v[i][2] * s; q[3] = v[i][3] * s;
    }
  }
  __syncthreads();
#pragma unroll
  for (int it = 0; it < 4; ++it) {
    const int task = it * NTHREADS + tid;
    const int n = task >> 3, kc = (task & 7) * 8;
    float v[8];
#pragma unroll
    for (int j = 0; j < 8; ++j) v[j] = tile[(kc + j) * 257 + n];
    u32x4 w; w.x = pack_bf16(v[0], v[1]); w.y = pack_bf16(v[2], v[3]); w.z = pack_bf16(v[4], v[5]); w.w = pack_bf16(v[6], v[7]);
    *(u32x4*)(Wt + (size_t)(n0 + n) * DM + k0 + kc) = w;
  }
  __syncthreads();
}

__device__ __forceinline__ void phase0(const Params& p, float* ldsf, int bid, int nblk) {
  const int tid = threadIdx.x, lane = tid & 63, wid = tid >> 6;
  bf16_t* w_inT = (bf16_t*)(p.ws + WS_WINT);
  bf16_t* w_dtT = (bf16_t*)(p.ws + WS_WDTT);
  bf16_t* w_outT = (bf16_t*)(p.ws + WS_WOUTT);
  bf16_t* wqT = (bf16_t*)(p.ws + WS_WQT);
  bf16_t* keysb = (bf16_t*)(p.ws + WS_KEYS);
  unsigned char* ub = p.ws + WS_UB;
  unsigned char* vb = p.ws + WS_VB;
  bf16_t* hnb = (bf16_t*)(p.ws + WS_HNB);
  constexpr int U_HN = (TA + 7) / 8;
  constexpr int U_WIN = 32 * 16, U_WOUT = 32 * 8, U_WQ = 32 * 8, U_WDT = 1, U_KEYS = 64, U_U = NEXP / 8, U_V = NEXP / 8;
  constexpr int B_WIN = U_HN, B_WOUT = B_WIN + U_WIN, B_WQ = B_WOUT + U_WOUT, B_WDT = B_WQ + U_WQ, B_KEYS = B_WDT + U_WDT,
                B_U = B_KEYS + U_KEYS, B_V = B_U + U_U, B_END = B_V + U_V;
  for (int u = bid; u < B_END; u += nblk) {
    if (u < B_WIN) {
      const int t = u * 8 + wid;
      if (t < TA) {
        const float* src = t < T ? p.x + (size_t)t * DM : p.meta + (size_t)(t - T) * DM;
        float4 v[8];
        float ss = 0.f;
#pragma unroll
        for (int i = 0; i < 8; ++i) {
          v[i] = *(const float4*)(src + (i * 64 + lane) * 4);
          ss += v[i].x * v[i].x + v[i].y * v[i].y + v[i].z * v[i].z + v[i].w * v[i].w;
        }
        ss = wave_sum(ss);
        const float r = rsqrtf(ss * (1.f / DM) + EPS);
#pragma unroll
        for (int i = 0; i < 8; ++i) {
          const float4 w = *(const float4*)(p.ln_mix + (i * 64 + lane) * 4);
          u32x2 o; o.x = pack_bf16(v[i].x * r * w.x, v[i].y * r * w.y); o.y = pack_bf16(v[i].z * r * w.z, v[i].w * r * w.w);
          *(u32x2*)(hnb + (size_t)t * DM + (i * 64 + lane) * 4) = o;
        }
      }
    } else if (u < B_WOUT) {
      const int i = u - B_WIN;
      p0_transpose_tile(p.w_in, DPROJ, w_inT, nullptr, nullptr, (i & 31) * 64, (i >> 5) * 256, ldsf);
    } else if (u < B_WQ) {
      const int i = u - B_WOUT;
      p0_transpose_tile(p.w_out, DM, w_outT, p.attn_norm_w, p.ssm_norm_w, (i & 31) * 64, (i >> 5) * 256, ldsf);
    } else if (u < B_WDT) {
      const int i = u - B_WQ;
      p0_transpose_tile(p.wq, DM, wqT, p.ln_ffn, p.ln_ffn + 1024, (i & 31) * 64, (i >> 5) * 256, ldsf);
    } else if (u < B_KEYS) {
      for (int idx = tid; idx < DM * 16; idx += NTHREADS) {
        const int k = idx >> 4, j = idx & 15;
        w_dtT[(size_t)j * DM + k] = f2bf(p.w_in[(size_t)k * DPROJ + NPROJ + j]);
      }
    } else if (u < B_U) {
      const size_t base = (size_t)(u - B_KEYS) * 4096 + (size_t)tid * 8;
      const float4 a = *(const float4*)(p.keys + base), b = *(const float4*)(p.keys + base + 4);
      u32x4 w; w.x = pack_bf16(a.x, a.y); w.y = pack_bf16(a.z, a.w); w.z = pack_bf16(b.x, b.y); w.w = pack_bf16(b.z, b.w);
      *(u32x4*)(keysb + base) = w;
    } else {
      const bool isU = u < B_V;
      const int row = (isU ? (u - B_U) : (u - B_V)) * 8 + wid;
      const float* src = (isU ? p.U : p.V) + (size_t)row * DM + lane * 4;
      f32x4 a[8];
#pragma unroll
      for (int j = 0; j < 8; ++j) a[j] = *(const f32x4*)(src + 256 * j);
      if (isU) {
#pragma unroll
        for (int j = 0; j < 8; ++j) a[j] *= *(const f32x4*)(p.ln_ffn + lane * 4 + 256 * j);
      }
      float amax = 0.f;
#pragma unroll
      for (int j = 0; j < 8; ++j) amax = fmaxf(amax, fmaxf(fmaxf(fabsf(a[j][0]), fabsf(a[j][1])), fmaxf(fabsf(a[j][2]), fabsf(a[j][3]))));
      amax = wave_max(amax);
      if (true) {
        const float s4 = amax > 0.f ? 6.f / amax : 1.f;
        u32x4 w4;
#pragma unroll
        for (int j = 0; j < 4; ++j) {
          unsigned w = 0;
          w = __builtin_amdgcn_cvt_scalef32_pk_fp4_f32(w, a[2 * j][0] * s4, a[2 * j][1] * s4, 1.0f, 0);
          w = __builtin_amdgcn_cvt_scalef32_pk_fp4_f32(w, a[2 * j][2] * s4, a[2 * j][3] * s4, 1.0f, 1);
          w = __builtin_amdgcn_cvt_scalef32_pk_fp4_f32(w, a[2 * j + 1][0] * s4, a[2 * j + 1][1] * s4, 1.0f, 2);
          w = __builtin_amdgcn_cvt_scalef32_pk_fp4_f32(w, a[2 * j + 1][2] * s4, a[2 * j + 1][3] * s4, 1.0f, 3);
          w4[j] = w;
        }
        *(u32x4*)((isU ? ub : vb) + (size_t)row * ROW4 + lane * 16) = w4;
        if (lane == 0) ((float*)(p.ws + (isU ? WS_USC : WS_VSC)))[row] = amax > 0.f ? amax * (1.f / 6.f) : 1.f;
        continue;
      }
      const float scl = amax > 0.f ? 7.5f / amax : 1.f;
      f32x16v v0, v1;
#pragma unroll
      for (int j = 0; j < 8; ++j) {
        v0[2 * j + 0] = a[j][0] * scl; v1[2 * j + 0] = a[j][1] * scl; v0[2 * j + 1] = a[j][2] * scl; v1[2 * j + 1] = a[j][3] * scl;
      }
      const u32x6 pk = __builtin_amdgcn_cvt_scalef32_2xpk16_fp6_f32(v0, v1, 1.0f);
      unsigned char* dst = (isU ? ub : vb) + (size_t)row * ROW6;
      *(u32x4*)(dst + lane * 16) = (u32x4){pk[0], pk[1], pk[2], pk[3]};
      *(u32x2*)(dst + 1024 + lane * 8) = (u32x2){pk[4], pk[5]};
      if (lane == 0) ((float*)(p.ws + (isU ? WS_USC : WS_VSC)))[row] = amax > 0.f ? amax * (1.f / 7.5f) : 1.f;
    }
  }
}

__device__ __forceinline__ void mini_gemm(const bf16_t* __restrict__ A, const bf16_t* __restrict__ Bt, float* __restrict__ out, int ldo,
                                          float* red, bf16_t* __restrict__ outb = nullptr) {
  const int tid = threadIdx.x, lane = tid & 63, wid = tid >> 6, fr = lane & 15, fq = lane >> 4;
  f32x4 acc = {0.f, 0.f, 0.f, 0.f};
  const bf16_t* ap = A + (size_t)fr * DM + wid * 256 + fq * 8;
  const bf16_t* bp = Bt + (size_t)fr * DM + wid * 256 + fq * 8;
#pragma unroll
  for (int ks = 0; ks < 8; ++ks) {
    const bf16x8 a = *(const bf16x8*)(ap + ks * 32);
    const bf16x8 b = *(const bf16x8*)(bp + ks * 32);
    acc = __builtin_amdgcn_mfma_f32_16x16x32_bf16(a, b, acc, 0, 0, 0);
  }
#pragma unroll
  for (int r = 0; r < 4; ++r) red[wid * 256 + (4 * fq + r) * 16 + fr] = acc[r];
  __syncthreads();
  if (tid < 256) {
    float s = 0.f;
#pragma unroll
    for (int w = 0; w < 8; ++w) s += red[w * 256 + tid];
    out[(size_t)(tid >> 4) * ldo + (tid & 15)] = s;
    if (outb) outb[(size_t)(tid >> 4) * ldo + (tid & 15)] = f2bf(s);
  }
  __syncthreads();
}

__device__ __forceinline__ void phase1(const Params& p, unsigned char* lds, int bid, int nblk) {
  const bf16_t* hnb = (const bf16_t*)(p.ws + WS_HNB);
  const bf16_t* w_inT = (const bf16_t*)(p.ws + WS_WINT);
  const bf16_t* w_dtT = (const bf16_t*)(p.ws + WS_WDTT);
  float* dtraw = (float*)(p.ws + WS_DTRAW);
  float* projm = (float*)(p.ws + WS_PROJM);
  constexpr int NU = 512 + 32 + 96 + 1;
  for (int u = bid; u < NU; u += nblk) {
    if (u < 512) {
      mini_gemm(hnb + (size_t)u * 16 * DM, w_dtT, dtraw + (size_t)u * 16 * 16, 16, (float*)lds);
    } else {
      const int j = u - 512;
      const int cf = j < 32 ? 64 + j : (j < 128 ? 160 + (j - 32) : 256);
      const bf16_t* bt = cf < 256 ? w_inT + (size_t)cf * 16 * DM : w_dtT;
      mini_gemm(hnb + (size_t)T * DM, bt, projm + cf * 16, DPROJ, (float*)lds, (bf16_t*)(p.ws + WS_PROJMB) + cf * 16);
    }
  }
  pg8::Gemm g{hnb, w_inT, T, NPROJ, DM};
  pg8::StaticOrder S; S.init(T, NPROJ, nblk, bid);
  pg8::EpiBf16 E{(bf16_t*)(p.ws + WS_PROJ), NPROJ};
  pg8::gemm_phase<pg8::EpiBf16, pg8::StaticOrder>((PG8_LAS unsigned char*)lds, g, S, E);
}

__device__ __forceinline__ void phase4(const Params& p, unsigned char* lds, int bid, int nblk) {
  pg8::Gemm g{(const bf16_t*)(p.ws + WS_HNB), (const bf16_t*)(p.ws + WS_WOUTT), T, DM, DM};
  pg8::StaticOrder S; S.init(T, DM, nblk, bid);
  pg8::EpiRes E{p.x, (bf16_t*)(p.ws + WS_H1B), (float*)(p.ws + WS_SSQH1)};
  pg8::gemm_phase<pg8::EpiRes, pg8::StaticOrder>((PG8_LAS unsigned char*)lds, g, S, E);
}
__device__ __forceinline__ void phase5(const Params& p, unsigned char* lds, int bid, int nblk) {
  pg8::Gemm g{(const bf16_t*)(p.ws + WS_H1B), (const bf16_t*)(p.ws + WS_WQT), T, DM, DM};
  pg8::StaticOrder S; S.init(T, DM, nblk, bid);
  pg8::EpiScores E{(const bf16_t*)(p.ws + WS_KEYS), (float*)(p.ws + WS_STOP), (int*)(p.ws + WS_ITOP)};
  pg8::gemm_phase<pg8::EpiScores, pg8::StaticOrder>((PG8_LAS unsigned char*)lds, g, S, E);
}

__device__ __forceinline__ float dot2bf(unsigned a, unsigned b, float c) {
  return __builtin_amdgcn_fdot2_f32_bf16(*(bf16v2*)&a, *(bf16v2*)&b, c, false);
}
__device__ __forceinline__ void phase6(const Params& p, unsigned char* lds, int bid, int nblk) {
  const int tid0 = threadIdx.x, lane0 = tid0 & 63, wid = __builtin_amdgcn_readfirstlane(tid0 >> 6);
  int* ids = (int*)(lds + wid * 2048);
  float* gts = (float*)(lds + wid * 2048 + 512);
  float* wts = (float*)(lds + wid * 2048 + 1024);
  const unsigned char* ub = p.ws + WS_UB;
  const unsigned char* vb = p.ws + WS_VB;
  const bf16_t* h1b = (const bf16_t*)(p.ws + WS_H1B);
  const float* usc = (const float*)(p.ws + WS_USC);
  const float* vsc = (const float*)(p.ws + WS_VSC);
  const float* ssq = (const float*)(p.ws + WS_SSQH1);
  const float* stop = (const float*)(p.ws + WS_STOP);
  const int* itop = (const int*)(p.ws + WS_ITOP);
  const int ci = kCandI[lane0], cj = kCandJ[lane0];
#pragma unroll 1
  for (int t = bid * 8 + wid; t < T; t += nblk * 8) {
    int tid = tid0; asm volatile("" : "+v"(tid));
    const int lane = tid & 63;
    const int kcode = 8 * ((lane >> 2) & 1) + 4 * ((lane >> 3) & 1) + 2 * ((lane >> 4) & 1) + ((lane >> 5) & 1);
    const float part0 = lane < 32 ? ssq[(size_t)t * 32 + lane] : 0.f;
    const float rr = rsqrtf(wave_sum(part0) * (1.f / DM) + EPS);
#pragma unroll 1
    for (int h = 0; h < 8; ++h) {
      const size_t lbase = ((size_t)t * 16 + h * 2) * 16;
      const float sv = lane < 32 ? stop[lbase + lane] : 0.f;
      const int iv = lane < 32 ? itop[lbase + lane] : 0;
      float cand = (__shfl(sv, ci) + __shfl(sv, 16 + cj)) * rr;
      if (lane >= 50) cand = -INFINITY;
      unsigned key = __float_as_uint(cand);
      key = (key & 0x80000000u) ? ~key : (key | 0x80000000u);
      key = (key & ~63u) | (unsigned)(63 - lane);
      int rank = 0;
#pragma unroll
      for (int k = 0; k < 50; ++k) {
        const unsigned kk = (unsigned)__builtin_amdgcn_readlane((int)key, k);
        rank += kk > key ? 1 : 0;
      }
      const float cmax = wave_max(cand);
      const float ex = rank < 16 ? __expf(cand - cmax) : 0.f;
      const float den = wave_sum(ex);
      const int eidx = __shfl(iv, ci) * 128 + __shfl(iv, 16 + cj);
      if (rank < 16) { ids[h * 16 + rank] = eidx; gts[h * 16 + rank] = ex / den; }
    }
    float xf[32];
    {
      const bf16_t* xp = h1b + (size_t)t * DM + lane * 4;
#pragma unroll
      for (int j = 0; j < 8; ++j) {
        const u32x2 xa = *(const u32x2*)(xp + 256 * j);
        xf[4 * j + 0] = bflo(xa.x); xf[4 * j + 1] = bfhi(xa.x); xf[4 * j + 2] = bflo(xa.y); xf[4 * j + 3] = bfhi(xa.y);
      }
    }
#pragma unroll 1
    for (int rnd = 0; rnd < 8; ++rnd) {
      u32x4 ra[16];
#pragma unroll
      for (int k = 0; k < 16; ++k) {
        const int e = __builtin_amdgcn_readfirstlane(ids[rnd * 16 + k]);
        ra[k] = *(const u32x4*)(ub + (size_t)e * ROW4 + lane * 16);
      }
      float part[16];
      float prev = 0.f;
#pragma unroll
      for (int k = 0; k < 16; ++k) {
        asm volatile("" : "+v"(ra[k]) : "v"(prev));
        float d0 = 0.f, d1 = 0.f;
#define U4_STEP(j, i) { const f32x2 r = __builtin_amdgcn_cvt_scalef32_pk_f32_fp4(ra[k][j], 1.0f, i); \
          d0 = fmaf(r[0], xf[8 * (j) + 2 * (i)], d0); d1 = fmaf(r[1], xf[8 * (j) + 2 * (i) + 1], d1); }
#pragma unroll
        for (int j = 0; j < 4; ++j) { U4_STEP(j, 0) U4_STEP(j, 1) U4_STEP(j, 2) U4_STEP(j, 3) }
#undef U4_STEP
        prev = d0 + d1;
        part[k] = prev;
      }
      float q8[8], q4[4], q2[2], q1;
      { const bool hi = (lane >> 5) & 1;
#pragma unroll
        for (int i = 0; i < 8; ++i) { const float keep = hi ? part[2 * i + 1] : part[2 * i], send = hi ? part[2 * i] : part[2 * i + 1]; q8[i] = keep + __shfl_xor(send, 32); } }
      { const bool hi = (lane >> 4) & 1;
#pragma unroll
        for (int i = 0; i < 4; ++i) { const float keep = hi ? q8[2 * i + 1] : q8[2 * i], send = hi ? q8[2 * i] : q8[2 * i + 1]; q4[i] = keep + __shfl_xor(send, 16); } }
      { const bool hi = (lane >> 3) & 1;
#pragma unroll
        for (int i = 0; i < 2; ++i) { const float keep = hi ? q4[2 * i + 1] : q4[2 * i], send = hi ? q4[2 * i] : q4[2 * i + 1]; q2[i] = keep + __shfl_xor(send, 8); } }
      { const bool hi = (lane >> 2) & 1;
        const float keep = hi ? q2[1] : q2[0], send = hi ? q2[0] : q2[1]; q1 = keep + __shfl_xor(send, 4); }
      q1 += __shfl_xor(q1, 2);
      q1 += __shfl_xor(q1, 1);
      {
        const int kk = rnd * 16 + kcode;
        const int eid = ids[kk];
        const float a = q1 * rr * usc[eid];
        const float ge = 0.5f * a * (1.f + erff(a * 0.70710678118654752f));
        if ((lane & 3) == 0) wts[kk] = gts[kk] * ge * vsc[eid];
      }
    }
    float acc[32];
#pragma unroll
    for (int i = 0; i < 32; ++i) acc[i] = 0.f;
#pragma unroll 1
    for (int rnd = 0; rnd < 8; ++rnd) {
      u32x4 ra[16];
#pragma unroll
      for (int k = 0; k < 16; ++k) {
        const int e = __builtin_amdgcn_readfirstlane(ids[rnd * 16 + k]);
        ra[k] = *(const u32x4*)(vb + (size_t)e * ROW4 + lane * 16);
      }
      f32x4 wv[4];
#pragma unroll
      for (int j = 0; j < 4; ++j) wv[j] = *(const f32x4*)(wts + rnd * 16 + 4 * j);
#pragma unroll
      for (int k = 0; k < 16; ++k) {
        const float wk = wv[k >> 2][k & 3];
        asm volatile("" : "+v"(ra[k]) : "v"(acc[1]), "v"(acc[3]), "v"(acc[5]), "v"(acc[7]), "v"(acc[9]), "v"(acc[11]), "v"(acc[13]), "v"(acc[15]),
                                        "v"(acc[17]), "v"(acc[19]), "v"(acc[21]), "v"(acc[23]), "v"(acc[25]), "v"(acc[27]), "v"(acc[29]), "v"(acc[31]));
#define V4_STEP(j, i) { const f32x2 r = __builtin_amdgcn_cvt_scalef32_pk_f32_fp4(ra[k][j], 1.0f, i); \
            acc[8 * (j) + 2 * (i)] = fmaf(wk, r[0], acc[8 * (j) + 2 * (i)]); acc[8 * (j) + 2 * (i) + 1] = fmaf(wk, r[1], acc[8 * (j) + 2 * (i) + 1]); }
#pragma unroll
        for (int j = 0; j < 4; ++j) { V4_STEP(j, 0) V4_STEP(j, 1) V4_STEP(j, 2) V4_STEP(j, 3) }
#undef V4_STEP
      }
    }
    float ss = 0.f;
#pragma unroll
    for (int i = 0; i < 32; ++i) { acc[i] += xf[i]; ss += acc[i] * acc[i]; }
    ss = wave_sum(ss);
    const float rf = rsqrtf(ss * (1.f / DM) + EPS);
#pragma unroll
    for (int j = 0; j < 8; ++j) {
      const f32x4 lw = *(const f32x4*)(p.ln_final + 256 * j + lane * 4);
      *(f32x4*)(p.out + (size_t)t * DM + 256 * j + lane * 4) = (f32x4){acc[4 * j] * rf * lw[0], acc[4 * j + 1] * rf * lw[1], acc[4 * j + 2] * rf * lw[2], acc[4 * j + 3] * rf * lw[3]};
    }
  }
}

typedef float f32x16 __attribute__((ext_vector_type(16)));
__device__ __forceinline__ void unpack8(const u32x4 a, float (&v)[8]) {
  v[0] = bflo(a.x); v[1] = bfhi(a.x); v[2] = bflo(a.y); v[3] = bfhi(a.y); v[4] = bflo(a.z); v[5] = bfhi(a.z); v[6] = bflo(a.w); v[7] = bfhi(a.w);
}
constexpr int VT_LD = 196;
constexpr int ATT_VT_BYTES = 4 * 64 * VT_LD * 2;
__device__ __forceinline__ void attn_item(const Params& p, unsigned char* lds, int item) {
  const int tid = threadIdx.x, lane = tid & 63, wid = __builtin_amdgcn_readfirstlane(tid >> 6);
  const int b = item >> 6, q0 = (item & 63) * 32;
  bf16_t* VT = (bf16_t*)lds;
  float* biasL = (float*)(lds + ATT_VT_BYTES);
  float* ssqw = biasL + 16 * 132;
  const bf16_t* proj = (const bf16_t*)(p.ws + WS_PROJ);
  const float* projm = (const float*)(p.ws + WS_PROJM);
  bf16_t* mixin = (bf16_t*)(p.ws + WS_HNB);
#pragma unroll
  for (int it = 0; it < 5; ++it) {
    const int idx = it * NTHREADS + tid;
    if (idx >= 16 * 129) break;
    const int hq = idx / 129, d = idx - hq * 129;
    const int bk = d < 128 ? (int)kBucket[d] : 31;
    biasL[hq * 132 + d] = p.rel_bias[bk * 16 + hq];
  }
  const int ql = lane & 31, ql0 = ql, hh = lane >> 5, kvh = wid >> 1;
  const int trow = b * SEQ + q0 + ql;
  bf16x8 qf[4];
  u32x4 kf[6][4];
#define ATT_LOAD_Q(hq_)                                                                                                           \
  { _Pragma("unroll") for (int ks = 0; ks < 4; ++ks) qf[ks] = *(const bf16x8*)(proj + (size_t)trow * NPROJ + OFF_Q + (hq_) * 64 + ks * 16 + hh * 8); }
#define ATT_LOAD_K()                                                                                                              \
  {                                                                                                                               \
    int ql = ql0; asm volatile("" : "+v"(ql));     \
    const float* kr_ = projm + (size_t)(ql & 15) * DPROJ + OFF_K + kvh * 64 + hh * 8;                                             \
    _Pragma("unroll") for (int ks = 0; ks < 4; ++ks) {                                                                            \
      const f32x4 a_ = *(const f32x4*)(kr_ + ks * 16), c_ = *(const f32x4*)(kr_ + ks * 16 + 4);                                   \
      kf[0][ks].x = pack_bf16(a_[0], a_[1]); kf[0][ks].y = pack_bf16(a_[2], a_[3]); kf[0][ks].z = pack_bf16(c_[0], c_[1]); kf[0][ks].w = pack_bf16(c_[2], c_[3]); } \
    _Pragma("unroll") for (int jt = 1; jt < 6; ++jt) {                                                                            \
      int sp_ = q0 - 128 + 32 * (jt - 1) + ql; sp_ = sp_ < 0 ? 0 : sp_;                                                           \
      const bf16_t* kp_ = proj + (size_t)(b * SEQ + sp_) * NPROJ + OFF_K + kvh * 64 + hh * 8;                                     \
      _Pragma("unroll") for (int ks = 0; ks < 4; ++ks) kf[jt][ks] = *(const u32x4*)(kp_ + ks * 16); }                             \
  }
  ATT_LOAD_Q(2 * wid)
#pragma unroll 1
  for (int rep_ = 0; rep_ < (REP_SUB == 2 ? 2 : 1); ++rep_) {
    u32x4 ra[5], rc[5];
#pragma unroll
    for (int q = 0; q < 5; ++q) {
      const int task = q * NTHREADS + tid, ch = task / 80, pi = task - ch * 80;
      int s0 = q0 - 128 + 2 * pi;
      s0 = s0 < 0 ? 0 : s0;
      const bf16_t* r0 = proj + (size_t)(b * SEQ + s0) * NPROJ + OFF_V + ch * 8;
      ra[q] = *(const u32x4*)r0; rc[q] = *(const u32x4*)(r0 + NPROJ);
    }
    float m0[8], m1[8];
    {
      const int pi = tid & 7, ch = (tid >> 3) & 31;
      const float* r0 = projm + (size_t)(2 * pi) * DPROJ + OFF_V + ch * 8;
      const f32x4 ma = *(const f32x4*)r0, mb = *(const f32x4*)(r0 + 4), mc = *(const f32x4*)(r0 + DPROJ), md = *(const f32x4*)(r0 + DPROJ + 4);
      const float keep = tid < 256 ? 1.f : 0.f;
#pragma unroll
      for (int i = 0; i < 4; ++i) { m0[i] = ma[i] * keep; m0[4 + i] = mb[i] * keep; m1[i] = mc[i] * keep; m1[4 + i] = md[i] * keep; }
      bf16_t* dst = VT + (size_t)((ch >> 3) * 64 + (ch & 7) * 8) * VT_LD + 2 * pi + (tid < 256 ? 0 : 16);
#pragma unroll
      for (int i = 0; i < 8; ++i) *(unsigned*)(dst + i * VT_LD) = pack_bf16(m0[i], m1[i]);
    }
#pragma unroll
    for (int q = 0; q < 5; ++q) {
      const int task = q * NTHREADS + tid, ch = task / 80, pi = task - ch * 80;
      float v0[8], v1[8];
      unpack8(ra[q], v0); unpack8(rc[q], v1);
      bf16_t* dst = VT + (size_t)((ch >> 3) * 64 + (ch & 7) * 8) * VT_LD + 32 + 2 * pi;
#pragma unroll
      for (int i = 0; i < 8; ++i) *(unsigned*)(dst + i * VT_LD) = pack_bf16(v0[i], v1[i]);
    }
  }
  __syncthreads();
  float ssq = 0.f;
#pragma unroll 1
  for (int rep_ = 0; rep_ < (REP_SUB == 3 ? 2 : 1); ++rep_) {
  ssq = 0.f;
  auto do_head = [&](const int hsel) __attribute__((always_inline)) {
    const int hq = 2 * wid + hsel;
    f32x16 sacc[6];
#pragma unroll
    for (int jt = 0; jt < 6; ++jt) {
      f32x16 acc;
#pragma unroll
      for (int r = 0; r < 16; ++r) acc[r] = 0.f;
#pragma unroll
      for (int ks = 0; ks < 4; ++ks) acc = __builtin_amdgcn_mfma_f32_32x32x16_bf16(*(bf16x8*)&kf[jt][ks], qf[ks], acc, 0, 0, 0);
      sacc[jt] = acc;
    }
    if (hsel == 0) { ATT_LOAD_Q(2 * wid + 1) }
    const float* bl = biasL + hq * 132;
    int sq = q0 + ql, qh = ql - 4 * hh;
    asm volatile("" : "+v"(sq), "+v"(qh));
    const float sink = p.sinks[hq];
    float m = sink;
#pragma unroll
    for (int jt = 0; jt < 6; ++jt) {
      asm volatile("" ::: "memory");
#pragma unroll
      for (int r = 0; r < 16; ++r) {
        const int kr = (r & 3) + 8 * (r >> 2) + 4 * hh;
        int dist; bool valid;
        if (jt == 0) { dist = sq + (16 - ((r & 3) + 8 * (r >> 2))) - 4 * hh; valid = kr < 16; }
        else { dist = qh + (128 - 32 * (jt - 1) - ((r & 3) + 8 * (r >> 2))); valid = (dist >= 0) && (dist < 128) && (dist <= sq); }
        const int dc = dist < 0 ? 0 : (dist > 128 ? 128 : dist);
        const float l = valid ? 0.125f * sacc[jt][r] + bl[dc] : -1e30f;
        sacc[jt][r] = l;
        m = fmaxf(m, l);
      }
    }
    m = fmaxf(m, __shfl_xor(m, 32));
    float sum = 0.f;
    f32x16 oacc0, oacc1;
#pragma unroll
    for (int r = 0; r < 16; ++r) { oacc0[r] = 0.f; oacc1[r] = 0.f; }
    const bf16_t* vrow0 = VT + (size_t)(kvh * 64 + ql) * VT_LD + 4 * hh;
    const bf16_t* vrow1 = vrow0 + 32 * VT_LD;
#pragma unroll
    for (int jt = 0; jt < 6; ++jt) {
      u32x4 pw[2];
#pragma unroll
      for (int s2 = 0; s2 < 2; ++s2) {
        float e[8];
#pragma unroll
        for (int i = 0; i < 8; ++i) { e[i] = __expf(sacc[jt][8 * s2 + i] - m); sum += e[i]; }
        pw[s2].x = pack_bf16(e[0], e[1]); pw[s2].y = pack_bf16(e[2], e[3]); pw[s2].z = pack_bf16(e[4], e[5]); pw[s2].w = pack_bf16(e[6], e[7]);
      }
#pragma unroll
      for (int s2 = 0; s2 < 2; ++s2) {
        const u32x2 va = *(const u32x2*)(vrow0 + 32 * jt + 16 * s2), vc = *(const u32x2*)(vrow0 + 32 * jt + 16 * s2 + 8);
        const u32x2 vd = *(const u32x2*)(vrow1 + 32 * jt + 16 * s2), ve = *(const u32x2*)(vrow1 + 32 * jt + 16 * s2 + 8);
        u32x4 v0w; v0w.x = va.x; v0w.y = va.y; v0w.z = vc.x; v0w.w = vc.y;
        u32x4 v1w; v1w.x = vd.x; v1w.y = vd.y; v1w.z = ve.x; v1w.w = ve.y;
        oacc0 = __builtin_amdgcn_mfma_f32_32x32x16_bf16(*(bf16x8*)&v0w, *(bf16x8*)&pw[s2], oacc0, 0, 0, 0);
        oacc1 = __builtin_amdgcn_mfma_f32_32x32x16_bf16(*(bf16x8*)&v1w, *(bf16x8*)&pw[s2], oacc1, 0, 0, 0);
      }
    }
    sum += __shfl_xor(sum, 32);
    const float inv = 1.f / (sum + __expf(sink - m));
#pragma unroll
    for (int r = 0; r < 16; ++r) { oacc0[r] *= inv; oacc1[r] *= inv; ssq += oacc0[r] * oacc0[r] + oacc1[r] * oacc1[r]; }
#pragma unroll
    for (int rg = 0; rg < 4; ++rg) {
      u32x2 w; w.x = pack_bf16(oacc0[rg * 4 + 0], oacc0[rg * 4 + 1]); w.y = pack_bf16(oacc0[rg * 4 + 2], oacc0[rg * 4 + 3]);
      *(u32x2*)(mixin + (size_t)trow * DM + hq * 64 + 8 * rg + 4 * hh) = w;
      u32x2 w1; w1.x = pack_bf16(oacc1[rg * 4 + 0], oacc1[rg * 4 + 1]); w1.y = pack_bf16(oacc1[rg * 4 + 2], oacc1[rg * 4 + 3]);
      *(u32x2*)(mixin + (size_t)trow * DM + hq * 64 + 32 + 8 * rg + 4 * hh) = w1;
    }
  };
  ATT_LOAD_K()
  do_head(0);
  asm volatile("" ::: "memory");
  ATT_LOAD_K()
  do_head(1);
  }
  ssq += __shfl_xor(ssq, 32);
  if (lane < 32) ssqw[wid * 32 + lane] = ssq;
  __syncthreads();
  float tot = 0.f;
#pragma unroll
  for (int w = 0; w < 8; ++w) tot += ssqw[w * 32 + ql];
  const float ra = rsqrtf(tot * (1.f / 1024) + EPS);
#pragma unroll
  for (int hsel = 0; hsel < 2; ++hsel)
#pragma unroll
    for (int dt = 0; dt < 2; ++dt)
#pragma unroll
      for (int rg = 0; rg < 4; ++rg) {
        bf16_t* op = mixin + (size_t)trow * DM + (2 * wid + hsel) * 64 + 32 * dt + 8 * rg + 4 * hh;
        const u32x2 v = *(const u32x2*)op;
        u32x2 w; w.x = pack_bf16(bflo(v.x) * ra, bfhi(v.x) * ra); w.y = pack_bf16(bflo(v.y) * ra, bfhi(v.y) * ra);
        *(u32x2*)op = w;
      }
  __syncthreads();
}
#undef ATT_LOAD_Q
#undef ATT_LOAD_K
__device__ __forceinline__ void phase2_attn(const Params& p, unsigned char* lds, int bid, int nblk) {
  for (int item = bid; item < 256; item += nblk) attn_item(p, lds, item);
}

constexpr int SLD = 136;
__device__ __forceinline__ float conv_silu(const float (&raw)[11], int i, float w0, float w1, float w2, float w3, float cb) {
  return silu_f(cb + w0 * raw[i] + w1 * raw[i + 1] + w2 * raw[i + 2] + w3 * raw[i + 3]);
}
__device__ __forceinline__ void ssd_a_item(const Params& p, unsigned char* lds, int item) {
  const int tid = threadIdx.x, lane = tid & 63, wid = __builtin_amdgcn_readfirstlane(tid >> 6);
  const int b = item >> 6, c = (item >> 2) & 15, g = (item >> 1) & 1, hsel = item & 1;
  const int h0 = g * 8 + hsel * 4;
  const int t0 = b * SEQ + c * 128;
  bf16_t* Bc = (bf16_t*)lds;
  bf16_t* Cc = Bc + 128 * SLD;
  bf16_t* BcT = Cc + 128 * SLD;
  bf16_t* xT = BcT + 128 * SLD;
  float* dtl = (float*)(xT + 2 * 64 * SLD);
  float* acs = dtl + 512;
  float* wl = acs + 512;
  float* scan = wl + 512;
  const bf16_t* __restrict__ proj = (const bf16_t*)(p.ws + WS_PROJ);
  const bf16_t* __restrict__ projmb = (const bf16_t*)(p.ws + WS_PROJMB);
  const float* __restrict__ dtraw = (const float*)(p.ws + WS_DTRAW);
  float* __restrict__ acsg = (float*)(p.ws + WS_ACSG);
  bf16_t* __restrict__ ccb = (bf16_t*)(p.ws + WS_CCB);
  float* __restrict__ ypart = (float*)(p.ws + WS_YPART);
  float* __restrict__ sg = (float*)(p.ws + WS_SG);
  {
    const int hi = tid >> 7, l = tid & 127, h = h0 + hi;
    const float Ah = -expf(p.a_log[h]);
    const float dtv = softplus_f(dtraw[(size_t)(t0 + l) * 16 + h] + p.dt_bias[h]);
    dtl[tid] = dtv;
    float cum = dtv * Ah;
#pragma unroll
    for (int o = 1; o < 64; o <<= 1) { const float nb = __shfl_up(cum, o); if (lane >= o) cum += nb; }
    if ((tid & 127) == 63) scan[hi] = cum;
    __syncthreads();
    if (l >= 64) cum += scan[hi];
    acs[tid] = cum;
    acsg[(size_t)(t0 + l) * 16 + h] = cum;
    __syncthreads();
    wl[tid] = dtv * __expf(acs[hi * 128 + 127] - cum);
  }
#pragma unroll 1
  for (int rnd = 0; rnd < 2; ++rnd) {
    float raw[4][11];
#pragma unroll
    for (int q = 0; q < 4; ++q) {
      const int task = (rnd * 4 + q) * NTHREADS + tid;
      const int tg = task >> 8, ch = task & 255;
      const int cch = 1024 + (ch >> 7) * 256 + g * 128 + (ch & 127);
#pragma unroll
      for (int i = 0; i < 11; ++i) {
        const int l = tg * 8 + i - 3;
        const bf16_t* src = (l >= 0 || c > 0) ? proj + (size_t)(t0 + l) * NPROJ : projmb + (size_t)(16 + l) * DPROJ;
        raw[q][i] = bf2f(src[OFF_XBC + cch]);
      }
    }
#pragma unroll
    for (int q = 0; q < 4; ++q) {
      const int task = (rnd * 4 + q) * NTHREADS + tid;
      const int tg = task >> 8, ch = task & 255, n = ch & 127;
      const int cch = 1024 + (ch >> 7) * 256 + g * 128 + n;
      const float w0 = p.conv_w[cch], w1 = p.conv_w[D_XBC + cch], w2 = p.conv_w[2 * D_XBC + cch], w3 = p.conv_w[3 * D_XBC + cch], cb = p.conv_b[cch];
      float o[8];
#pragma unroll
      for (int i = 0; i < 8; ++i) o[i] = conv_silu(raw[q], i, w0, w1, w2, w3, cb);
      if (ch < 128) {
#pragma unroll
        for (int i = 0; i < 8; ++i) Bc[(tg * 8 + i) * SLD + n] = f2bf(o[i]);
        u32x4 w; w.x = pack_bf16(o[0], o[1]); w.y = pack_bf16(o[2], o[3]); w.z = pack_bf16(o[4], o[5]); w.w = pack_bf16(o[6], o[7]);
        *(u32x4*)(BcT + n * SLD + tg * 8) = w;
      } else {
#pragma unroll
        for (int i = 0; i < 8; ++i) Cc[(tg * 8 + i) * SLD + n] = f2bf(o[i]);
      }
    }
  }
  float xraw[2][11];
#define SSD_LOAD_X(hi_)                                                                                             \
  _Pragma("unroll") for (int q = 0; q < 2; ++q) {                                                                   \
    const int task = q * NTHREADS + tid; const int tg = task >> 6, cch = (h0 + (hi_)) * 64 + (task & 63);           \
    _Pragma("unroll") for (int i = 0; i < 11; ++i) { const int l = tg * 8 + i - 3;                                  \
      const bf16_t* src = (l >= 0 || c > 0) ? proj + (size_t)(t0 + l) * NPROJ : projmb + (size_t)(16 + l) * DPROJ;          \
      xraw[q][i] = bf2f(src[OFF_XBC + cch]); } }
  SSD_LOAD_X(0)
  __syncthreads();
  if (hsel == 0) {
#pragma unroll
    for (int q = 0; q < 4; ++q) {
      const int idx = q * NTHREADS + tid, row = idx >> 4, ck = idx & 15;
      *(u32x4*)(ccb + (size_t)(t0 + row) * 256 + g * 128 + ck * 8) = *(const u32x4*)(Cc + row * SLD + ck * 8);
    }
  }
  const int ql = lane & 31, hh = lane >> 5;
#pragma unroll 1
  for (int hi = 0; hi < 4; ++hi) {
    const int h = h0 + hi;
    bf16_t* xTb = xT + (hi & 1) * 64 * SLD;
#pragma unroll
    for (int q = 0; q < 2; ++q) {
      const int task = q * NTHREADS + tid; const int tg = task >> 6, pch = task & 63, cch = h * 64 + pch;
      const float w0 = p.conv_w[cch], w1 = p.conv_w[D_XBC + cch], w2 = p.conv_w[2 * D_XBC + cch], w3 = p.conv_w[3 * D_XBC + cch], cb = p.conv_b[cch];
      float o[8];
#pragma unroll
      for (int i = 0; i < 8; ++i) o[i] = conv_silu(xraw[q], i, w0, w1, w2, w3, cb);
      u32x4 w; w.x = pack_bf16(o[0], o[1]); w.y = pack_bf16(o[2], o[3]); w.z = pack_bf16(o[4], o[5]); w.w = pack_bf16(o[6], o[7]);
      *(u32x4*)(xTb + pch * SLD + tg * 8) = w;
    }
    if (hi < 3) { SSD_LOAD_X(hi + 1) }
    __syncthreads();
    const float dskip = p.d_skip[h];
    const float* acsh = acs + hi * 128;
    const float* dtlh = dtl + hi * 128;
    const float* wlh = wl + hi * 128;
    {
      const int ip = wid & 1, il = wid >> 1;
      const int l = 32 * il + ql;
      const float acl = acsh[l];
      f32x16 yacc;
#pragma unroll
      for (int r = 0; r < 16; ++r) yacc[r] = 0.f;
      const bf16_t* xrow = xTb + (32 * ip + ql) * SLD + 4 * hh;
#pragma unroll 1
      for (int is = 0; is <= il; ++is) {
        f32x16 x;
#pragma unroll
        for (int r = 0; r < 16; ++r) x[r] = 0.f;
        const bf16_t* ap = Bc + (32 * is + ql) * SLD + 8 * hh;
        const bf16_t* bp = Cc + l * SLD + 8 * hh;
#pragma unroll
        for (int ks = 0; ks < 8; ++ks) x = __builtin_amdgcn_mfma_f32_32x32x16_bf16(*(const bf16x8*)(ap + 16 * ks), *(const bf16x8*)(bp + 16 * ks), x, 0, 0, 0);
        u32x4 pw[2];
#pragma unroll
        for (int s2 = 0; s2 < 2; ++s2) {
          float mv[8];
#pragma unroll
          for (int q = 0; q < 2; ++q) {
            const int sb = 32 * is + 16 * s2 + 8 * q + 4 * hh;
            const f32x4 as4 = *(const f32x4*)(acsh + sb), dt4 = *(const f32x4*)(dtlh + sb);
#pragma unroll
            for (int j = 0; j < 4; ++j) {
              const int sr = sb + j;
              float v = sr <= l ? x[8 * s2 + 4 * q + j] * __expf(acl - as4[j]) * dt4[j] : 0.f;
              if (sr == l) v += dskip;
              mv[4 * q + j] = v;
            }
          }
          pw[s2].x = pack_bf16(mv[0], mv[1]); pw[s2].y = pack_bf16(mv[2], mv[3]); pw[s2].z = pack_bf16(mv[4], mv[5]); pw[s2].w = pack_bf16(mv[6], mv[7]);
        }
#pragma unroll
        for (int s2 = 0; s2 < 2; ++s2) {
          const u32x2 va = *(const u32x2*)(xrow + 32 * is + 16 * s2), vc = *(const u32x2*)(xrow + 32 * is + 16 * s2 + 8);
          u32x4 aw; aw.x = va.x; aw.y = va.y; aw.z = vc.x; aw.w = vc.y;
          yacc = __builtin_amdgcn_mfma_f32_32x32x16_bf16(*(bf16x8*)&aw, *(bf16x8*)&pw[s2], yacc, 0, 0, 0);
        }
      }
      float* yp = ypart + (size_t)(t0 + l) * 1024 + h * 64 + 32 * ip + 4 * hh;
#pragma unroll
      for (int rg = 0; rg < 4; ++rg) *(f32x4*)(yp + 8 * rg) = (f32x4){yacc[4 * rg], yacc[4 * rg + 1], yacc[4 * rg + 2], yacc[4 * rg + 3]};
    }
    {
      const int ip = wid & 1, in = wid >> 1;
      f32x16 sacc;
#pragma unroll
      for (int r = 0; r < 16; ++r) sacc[r] = 0.f;
      const bf16_t* ap = xTb + (32 * ip + ql) * SLD + 8 * hh;
      const bf16_t* bp = BcT + (32 * in + ql) * SLD + 8 * hh;
#pragma unroll
      for (int ks = 0; ks < 8; ++ks) {
        const u32x4 xa = *(const u32x4*)(ap + 16 * ks);
        const f32x4 wa = *(const f32x4*)(wlh + 16 * ks + 8 * hh), wb = *(const f32x4*)(wlh + 16 * ks + 8 * hh + 4);
        u32x4 aw;
        aw.x = pack_bf16(bflo(xa.x) * wa[0], bfhi(xa.x) * wa[1]); aw.y = pack_bf16(bflo(xa.y) * wa[2], bfhi(xa.y) * wa[3]);
        aw.z = pack_bf16(bflo(xa.z) * wb[0], bfhi(xa.z) * wb[1]); aw.w = pack_bf16(bflo(xa.w) * wb[2], bfhi(xa.w) * wb[3]);
        sacc = __builtin_amdgcn_mfma_f32_32x32x16_bf16(*(bf16x8*)&aw, *(const bf16x8*)(bp + 16 * ks), sacc, 0, 0, 0);
      }
      float* sp = sg + ((size_t)((b * 16 + c) * 16 + h) * 64 + 32 * ip + 4 * hh) * 128 + 32 * in + ql;
#pragma unroll
      for (int r = 0; r < 16; ++r) sp[((r & 3) + 8 * (r >> 2)) * 128] = sacc[r];
    }
  }
#undef SSD_LOAD_X
  __syncthreads();
}

__device__ __forceinline__ void meta_state_item(const Params& p, unsigned char* lds, int h) {
  const int tid = threadIdx.x, g = h >> 3;
  float* xm = (float*)lds;
  float* bm = xm + 16 * 64;
  float* dtm = bm + 16 * 128;
  const float* projm = (const float*)(p.ws + WS_PROJM);
  float* smeta = (float*)(p.ws + WS_SMETA);
  for (int task = tid; task < 16 * 192; task += NTHREADS) {
    const int i = task / 192, ch = task - i * 192;
    const int cch = ch < 64 ? h * 64 + ch : 1024 + g * 128 + (ch - 64);
    float acc = p.conv_b[cch];
#pragma unroll
    for (int j = 0; j < 4; ++j) { const int mi = i - j; if (mi >= 0) acc += p.conv_w[(3 - j) * D_XBC + cch] * projm[(size_t)mi * DPROJ + OFF_XBC + cch]; }
    const float v = silu_f(acc);
    if (ch < 64) xm[i * 64 + ch] = v; else bm[i * 128 + ch - 64] = v;
  }
  if (tid < 16) dtm[tid] = softplus_f(projm[(size_t)tid * DPROJ + OFF_DT + h] + p.dt_bias[h]);
  __syncthreads();
  const float Ah = -expf(p.a_log[h]);
  const int pr = tid >> 3, n0 = (tid & 7) * 16;
  float st[16];
#pragma unroll
  for (int k = 0; k < 16; ++k) st[k] = 0.f;
  for (int i = 0; i < 16; ++i) {
    const float dtv = dtm[i], dA = expf(dtv * Ah), xdt = xm[i * 64 + pr] * dtv;
#pragma unroll
    for (int k = 0; k < 16; ++k) st[k] = fmaf(st[k], dA, xdt * bm[i * 128 + n0 + k]);
  }
#pragma unroll
  for (int k = 0; k < 16; ++k) smeta[(size_t)(h * 64 + pr) * 128 + n0 + k] = st[k];
  __syncthreads();
}

__device__ __forceinline__ void phase2(const Params& p, unsigned char* lds, int bid, int nblk) {
#pragma unroll 1
  for (int rep = 0; rep < (REP_SUB == 0 ? 2 : 1); ++rep)
    for (int item = bid; item < 256; item += nblk) attn_item(p, lds, item);
#pragma unroll 1
  for (int rep = 0; rep < (REP_SUB == 1 ? 2 : 1); ++rep)
    for (int item = bid; item < 256; item += nblk) ssd_a_item(p, lds, item);
  for (int item = bid; item < 16; item += nblk) meta_state_item(p, lds, item);
}

__device__ __forceinline__ void phase_scan(const Params& p, int bid, int nblk) {
  const float* __restrict__ sg = (const float*)(p.ws + WS_SG);
  const float* __restrict__ smeta = (const float*)(p.ws + WS_SMETA);
  const float* __restrict__ acsg = (const float*)(p.ws + WS_ACSG);
  bf16_t* __restrict__ hprev = (bf16_t*)(p.ws + WS_HPREV);
  for (int task = bid * NTHREADS + threadIdx.x; task < 64 * 2048; task += nblk * NTHREADS) {
    const int bh = task >> 11, e4 = (task & 2047) * 4;
    const int b = bh >> 4, h = bh & 15;
    f32x4 sv[16];
    float dv[16];
#pragma unroll
    for (int c = 0; c < 16; ++c) {
      sv[c] = *(const f32x4*)(sg + (size_t)((b * 16 + c) * 16 + h) * 8192 + e4);
      dv[c] = acsg[(size_t)(b * SEQ + c * 128 + 127) * 16 + h];
    }
    f32x4 H = *(const f32x4*)(smeta + (size_t)h * 8192 + e4);
#pragma unroll
    for (int c = 0; c < 16; ++c) {
      u32x2 w; w.x = pack_bf16(H[0], H[1]); w.y = pack_bf16(H[2], H[3]);
      *(u32x2*)(hprev + (size_t)((b * 16 + c) * 16 + h) * 8192 + e4) = w;
      H = H * __expf(dv[c]) + sv[c];
    }
  }
}

__device__ __forceinline__ void ssd_b_item(const Params& p, unsigned char* lds, int item) {
  const int tid = threadIdx.x, lane = tid & 63, wid = __builtin_amdgcn_readfirstlane(tid >> 6);
  const int b = item >> 6, c = (item >> 2) & 15, g = (item >> 1) & 1, lh = item & 1, h = g * 8 + wid;
  const int t0 = b * SEQ + c * 128 + lh * 64;
  const int ql = lane & 31, hh = lane >> 5;
  constexpr int YLD = 520;
  bf16_t* yoff = (bf16_t*)lds;
  const bf16_t* __restrict__ proj = (const bf16_t*)(p.ws + WS_PROJ);
  const float* __restrict__ acsg = (const float*)(p.ws + WS_ACSG);
  const bf16_t* __restrict__ ccb = (const bf16_t*)(p.ws + WS_CCB);
  const float* __restrict__ ypart = (const float*)(p.ws + WS_YPART);
  const bf16_t* __restrict__ hprev = (const bf16_t*)(p.ws + WS_HPREV);
  bf16_t* __restrict__ mixin = (bf16_t*)(p.ws + WS_HNB);
  {
    const bf16_t* hp = hprev + (size_t)((b * 16 + c) * 16 + h) * 8192 + (size_t)ql * 128 + 8 * hh;
    u32x4 hf0[8], hf1[8];
#pragma unroll
    for (int ks = 0; ks < 8; ++ks) { hf0[ks] = *(const u32x4*)(hp + 16 * ks); hf1[ks] = *(const u32x4*)(hp + 32 * 128 + 16 * ks); }
#pragma unroll
    for (int il = 0; il < 2; ++il) {
      const int lt = 32 * il + ql, t = t0 + lt;
      const bf16_t* cp = ccb + (size_t)t * 256 + g * 128 + 8 * hh;
      u32x4 cf[8];
#pragma unroll
      for (int ks = 0; ks < 8; ++ks) cf[ks] = *(const u32x4*)(cp + 16 * ks);
      const float ea = __expf(acsg[(size_t)t * 16 + h]);
      f32x16 a0, a1;
#pragma unroll
      for (int r = 0; r < 16; ++r) { a0[r] = 0.f; a1[r] = 0.f; }
#pragma unroll
      for (int ks = 0; ks < 8; ++ks) {
        a0 = __builtin_amdgcn_mfma_f32_32x32x16_bf16(*(bf16x8*)&hf0[ks], *(bf16x8*)&cf[ks], a0, 0, 0, 0);
        a1 = __builtin_amdgcn_mfma_f32_32x32x16_bf16(*(bf16x8*)&hf1[ks], *(bf16x8*)&cf[ks], a1, 0, 0, 0);
      }
      bf16_t* yr = yoff + lt * YLD + wid * 64 + 4 * hh;
#pragma unroll
      for (int rg = 0; rg < 4; ++rg) {
        u32x2 w0; w0.x = pack_bf16(ea * a0[4 * rg], ea * a0[4 * rg + 1]); w0.y = pack_bf16(ea * a0[4 * rg + 2], ea * a0[4 * rg + 3]);
        u32x2 w1; w1.x = pack_bf16(ea * a1[4 * rg], ea * a1[4 * rg + 1]); w1.y = pack_bf16(ea * a1[4 * rg + 2], ea * a1[4 * rg + 3]);
        *(u32x2*)(yr + 8 * rg) = w0;
        *(u32x2*)(yr + 32 + 8 * rg) = w1;
      }
    }
  }
  __syncthreads();
#pragma unroll
  for (int bt = 0; bt < 2; ++bt) {
    f32x4 ya[4], yb[4]; u32x4 zz[4], yo[4];
#pragma unroll
    for (int q = 0; q < 4; ++q) {
      const int lt = wid * 8 + bt * 4 + q, t = t0 + lt;
      const float* yp = ypart + (size_t)t * 1024 + g * 512 + lane * 8;
      ya[q] = *(const f32x4*)yp; yb[q] = *(const f32x4*)(yp + 4);
      zz[q] = *(const u32x4*)(proj + (size_t)t * NPROJ + OFF_Z + g * 512 + lane * 8);
      yo[q] = *(const u32x4*)(yoff + lt * YLD + lane * 8);
    }
#pragma unroll
    for (int q = 0; q < 4; ++q) {
      const int t = t0 + wid * 8 + bt * 4 + q;
      float zv[8], ov[8], y[8];
      unpack8(zz[q], zv); unpack8(yo[q], ov);
      y[0] = (ya[q][0] + ov[0]) * silu_f(zv[0]); y[1] = (ya[q][1] + ov[1]) * silu_f(zv[1]);
      y[2] = (ya[q][2] + ov[2]) * silu_f(zv[2]); y[3] = (ya[q][3] + ov[3]) * silu_f(zv[3]);
      y[4] = (yb[q][0] + ov[4]) * silu_f(zv[4]); y[5] = (yb[q][1] + ov[5]) * silu_f(zv[5]);
      y[6] = (yb[q][2] + ov[6]) * silu_f(zv[6]); y[7] = (yb[q][3] + ov[7]) * silu_f(zv[7]);
      float ss = 0.f;
#pragma unroll
      for (int i = 0; i < 8; ++i) ss += y[i] * y[i];
      ss = wave_sum(ss);
      const float rn = rsqrtf(ss * (1.f / 512) + EPS);
      u32x4 w; w.x = pack_bf16(y[0] * rn, y[1] * rn); w.y = pack_bf16(y[2] * rn, y[3] * rn); w.z = pack_bf16(y[4] * rn, y[5] * rn); w.w = pack_bf16(y[6] * rn, y[7] * rn);
      *(u32x4*)(mixin + (size_t)t * DM + 1024 + g * 512 + lane * 8) = w;
    }
  }
  __syncthreads();
}
__device__ __forceinline__ void phase3(const Params& p, unsigned char* lds, int bid, int nblk) {
  for (int item = bid; item < 256; item += nblk) ssd_b_item(p, lds, item);
}

constexpr int LDS_BYTES = 144 * 1024;

typedef const Params __attribute__((address_space(4))) * KArgPtr;
__device__ __forceinline__ Params load_params(KArgPtr k) {
  Params q;
#if defined(__HIP_DEVICE_COMPILE__)
  __builtin_memcpy(&q, k, sizeof(Params));
#endif
  return q;
}
#define PARAMS_PTR(pp) KArgPtr pp##_k = (KArgPtr)__builtin_amdgcn_kernarg_segment_ptr(); asm volatile("" : "+s"(pp##_k)); const Params pp##_v = load_params(pp##_k); const Params* pp = &pp##_v
__global__ __launch_bounds__(512, 2) void k_mega(Params p_unused) {
  extern __shared__ __attribute__((aligned(16))) unsigned char shm[];
  const int bid = blockIdx.x, nblk = gridDim.x;
  volatile LAS unsigned* xst = (volatile LAS unsigned*)(LAS unsigned char*)(shm + LDS_BYTES - 16);
  if (threadIdx.x == 0) { xst[0] = 0u; xst[1] = 0u; }
  __syncthreads();
  XcdBarrier xb;
  { PARAMS_PTR(pp); xb = xcd_barrier_post((unsigned*)(pp->ws + WS_CTL), xst); }
#ifndef REP_PHASE
#define REP_PHASE -1
#endif
#define NREP(k) ((REP_PHASE == (k)) ? 2 : 1)
#pragma unroll 1
  for (int rep = 0; rep < NREP(0); ++rep) { { PARAMS_PTR(pp); phase0(*pp, (float*)shm, bid, nblk); } if (rep + 1 < NREP(0)) xcd_barrier(xb); }
  xcd_barrier(xb);
#pragma unroll 1
  for (int rep = 0; rep < NREP(1); ++rep) { { PARAMS_PTR(pp); phase1(*pp, shm, bid, nblk); } xcd_barrier(xb); }
#pragma unroll 1
  for (int rep = 0; rep < NREP(2); ++rep) { { PARAMS_PTR(pp); phase2(*pp, shm, bid, nblk); } xcd_barrier(xb); }
#pragma unroll 1
  for (int rep = 0; rep < NREP(7); ++rep) { { PARAMS_PTR(pp); phase_scan(*pp, bid, nblk); } xcd_barrier(xb); }
#pragma unroll 1
  for (int rep = 0; rep < NREP(3); ++rep) { { PARAMS_PTR(pp); phase3(*pp, shm, bid, nblk); } xcd_barrier(xb); }
#pragma unroll 1
  for (int rep = 0; rep < NREP(4); ++rep) { { PARAMS_PTR(pp); phase4(*pp, shm, bid, nblk); } xcd_barrier(xb); }
#pragma unroll 1
  for (int rep = 0; rep < NREP(5); ++rep) { { PARAMS_PTR(pp); phase5(*pp, shm, bid, nblk); } xcd_barrier(xb); }
#pragma unroll 1
  for (int rep = 0; rep < NREP(6); ++rep) { { PARAMS_PTR(pp); phase6(*pp, shm, bid, nblk); } if (rep + 1 < NREP(6)) xcd_barrier(xb); }
}

}

extern "C" void kernel_launch(void* const* d_in, const int* in_sizes, int n_in, void* d_out, int out_size, void* d_ws,
                              size_t ws_size, hipStream_t stream) {
  Params p{};
  p.x = (const float*)d_in[0]; p.meta = (const float*)d_in[1]; p.rel_bias = (const float*)d_in[2];
  p.ln_mix = (const float*)d_in[3]; p.w_in = (const float*)d_in[4]; p.sinks = (const float*)d_in[5];
  p.conv_w = (const float*)d_in[6]; p.conv_b = (const float*)d_in[7]; p.dt_bias = (const float*)d_in[8];
  p.a_log = (const float*)d_in[9]; p.d_skip = (const float*)d_in[10]; p.attn_norm_w = (const float*)d_in[11];
  p.ssm_norm_w = (const float*)d_in[12]; p.w_out = (const float*)d_in[13]; p.ln_ffn = (const float*)d_in[14];
  p.wq = (const float*)d_in[15]; p.keys = (const float*)d_in[16]; p.U = (const float*)d_in[17];
  p.V = (const float*)d_in[18]; p.ln_final = (const float*)d_in[19];
  p.out = (float*)d_out;
  p.ws = (unsigned char*)d_ws;

  static int grid_blocks = 0;
  if (!grid_blocks) {
    int dev = 0, cus = 0, per_cu = 0;
    (void)hipGetDevice(&dev);
    (void)hipDeviceGetAttribute(&cus, hipDeviceAttributeMultiprocessorCount, dev);
    (void)hipFuncSetAttribute((const void*)k_mega, hipFuncAttributeMaxDynamicSharedMemorySize, LDS_BYTES);
    (void)hipOccupancyMaxActiveBlocksPerMultiprocessor(&per_cu, (const void*)k_mega, NTHREADS, LDS_BYTES);
    if (per_cu > 1) per_cu = 1;
    grid_blocks = cus * per_cu;
    if (grid_blocks != 256) fprintf(stderr, "kernel_launch: expected a 256-workgroup resident grid, got %d (cus %d, per_cu %d)\n", grid_blocks, cus, per_cu);
  }
  (void)hipMemsetAsync(p.ws + WS_CTL, 0, XCD_BAR_WORDS * 4, stream);
  void* args[] = {&p};
  hipError_t e = hipLaunchCooperativeKernel((const void*)k_mega, dim3(grid_blocks), dim3(NTHREADS), args, LDS_BYTES, stream);
  if (e != hipSuccess) fprintf(stderr, "cooperative launch failed: %s (grid %d)\n", hipGetErrorString(e), grid_blocks);
}
```

```cpp
#include <hip/hip_runtime.h>
#include <hip/hip_cooperative_groups.h>
#include <math.h>
#include <stdio.h>
#include <stdint.h>

#ifndef REP_SUB
#define REP_SUB -1
#endif
namespace {
constexpr int BATCH = 4, SEQ = 2048, DM = 2048, NMETA = 16;
constexpr int T = BATCH * SEQ;
constexpr int TA = T + NMETA;
constexpr int DPROJ = 4112;
constexpr int NPROJ = 4096;
constexpr int OFF_Q = 0, OFF_K = 1024, OFF_V = 1280, OFF_Z = 1536, OFF_XBC = 2560, OFF_DT = 4096;
constexpr int D_XBC = 1536;
constexpr int NEXP = 16384;
constexpr int ROW4 = 1024;
constexpr int ROW6 = 1536;
constexpr float EPS = 1e-6f;
constexpr int NTHREADS = 512;

typedef unsigned short bf16_t;
typedef short bf16x8 __attribute__((ext_vector_type(8)));
typedef float f32x4 __attribute__((ext_vector_type(4)));
typedef float f32x2 __attribute__((ext_vector_type(2)));
typedef unsigned u32x4 __attribute__((ext_vector_type(4)));
typedef unsigned u32x2 __attribute__((ext_vector_type(2)));
typedef __bf16 bf16v2 __attribute__((ext_vector_type(2)));
typedef float f32x16v __attribute__((ext_vector_type(16)));
typedef float f32x32v __attribute__((ext_vector_type(32)));
typedef unsigned u32x6 __attribute__((ext_vector_type(6)));
#define LAS __attribute__((address_space(3)))

__device__ __forceinline__ unsigned pack_bf16(float lo, float hi) {
  f32x2 v = {lo, hi};
  bf16v2 b = __builtin_convertvector(v, bf16v2);
  return *(unsigned*)&b;
}
__device__ __forceinline__ bf16_t f2bf(float f) { return (bf16_t)(pack_bf16(f, 0.f) & 0xffffu); }
__device__ __forceinline__ float bf2f(bf16_t b) { return __uint_as_float(((unsigned)b) << 16); }
__device__ __forceinline__ float bflo(unsigned u) { return __uint_as_float(u << 16); }
__device__ __forceinline__ float bfhi(unsigned u) { return __uint_as_float(u & 0xffff0000u); }

__constant__ unsigned char kBucket[128] = {
    0, 1, 2, 3, 4, 5, 6, 7, 8, 9, 10, 11, 12, 13, 14, 15, 16, 16, 16, 17, 17, 18, 18, 18, 19, 19, 19, 20, 20, 20, 20, 21,
    21, 21, 21, 22, 22, 22, 22, 22, 23, 23, 23, 23, 23, 23, 24, 24, 24, 24, 24, 24, 25, 25, 25, 25, 25, 25, 25, 26, 26, 26, 26, 26,
    26, 26, 26, 27, 27, 27, 27, 27, 27, 27, 27, 27, 27, 28, 28, 28, 28, 28, 28, 28, 28, 28, 28, 29, 29, 29, 29, 29, 29, 29, 29, 29,
    29, 29, 29, 30, 30, 30, 30, 30, 30, 30, 30, 30, 30, 30, 30, 30, 30, 31, 31, 31, 31, 31, 31, 31, 31, 31, 31, 31, 31, 31, 31, 31};

__constant__ unsigned char kCandI[64] = {0, 0, 0, 0, 0, 0, 0, 0, 0, 0, 0, 0, 0, 0, 0, 0, 1, 1, 1, 1, 1, 1, 1, 1, 2, 2, 2, 2, 2, 3, 3, 3, 3, 4, 4, 4, 5, 5, 6, 6, 7, 7, 8, 9, 10, 11, 12, 13, 14, 15, 15, 15, 15, 15, 15, 15, 15, 15, 15, 15, 15, 15, 15, 15};
__constant__ unsigned char kCandJ[64] = {0, 1, 2, 3, 4, 5, 6, 7, 8, 9, 10, 11, 12, 13, 14, 15, 0, 1, 2, 3, 4, 5, 6, 7, 0, 1, 2, 3, 4, 0, 1, 2, 3, 0, 1, 2, 0, 1, 0, 1, 0, 1, 0, 0, 0, 0, 0, 0, 0, 0, 15, 15, 15, 15, 15, 15, 15, 15, 15, 15, 15, 15, 15, 15};

__device__ __forceinline__ float wave_sum(float v) {
  for (int o = 32; o > 0; o >>= 1) v += __shfl_xor(v, o);
  return v;
}
__device__ __forceinline__ float wave_max(float v) {
  for (int o = 32; o > 0; o >>= 1) v = fmaxf(v, __shfl_xor(v, o));
  return v;
}
__device__ __forceinline__ float silu_f(float x) { return x / (1.f + expf(-x)); }
__device__ __forceinline__ float softplus_f(float x) { return fmaxf(x, 0.f) + log1pf(expf(-fabsf(x))); }

constexpr size_t al256(size_t x) { return (x + 255) & ~(size_t)255; }
constexpr size_t WS_CTL = 0;
constexpr size_t WS_WINT = 65536;
constexpr size_t WS_WDTT = WS_WINT + (size_t)NPROJ * DM * 2;
constexpr size_t WS_WOUTT = WS_WDTT + (size_t)16 * DM * 2;
constexpr size_t WS_WQT = WS_WOUTT + (size_t)DM * DM * 2;
constexpr size_t WS_KEYS = WS_WQT + (size_t)DM * DM * 2;
constexpr size_t WS_UB = WS_KEYS + (size_t)16 * 128 * 128 * 2;
constexpr size_t WS_VB = WS_UB + (size_t)NEXP * DM * 2;
constexpr size_t WS_HNB = WS_VB + (size_t)NEXP * DM * 2;
constexpr size_t WS_PROJ = WS_HNB + (size_t)(T + 16) * DM * 2;
constexpr size_t WS_DTRAW = WS_PROJ + (size_t)T * NPROJ * 2;
constexpr size_t WS_PROJM = WS_DTRAW + (size_t)T * 16 * 4;
constexpr size_t WS_PROJMB = al256(WS_PROJM + (size_t)16 * DPROJ * 4);
constexpr size_t WS_H1B = al256(WS_PROJMB + (size_t)16 * DPROJ * 2);
constexpr size_t WS_SSQH1 = WS_H1B + (size_t)T * DM * 2;
constexpr size_t WS_STOP = al256(WS_SSQH1 + (size_t)T * 32 * 4);
constexpr size_t WS_ITOP = WS_STOP + (size_t)T * 256 * 4;
constexpr size_t WS_ACSG = al256(WS_ITOP + (size_t)T * 256 * 4);
constexpr size_t WS_CCB = WS_ACSG + (size_t)T * 16 * 4;
constexpr size_t WS_YPART = WS_CCB + (size_t)T * 256 * 2;
constexpr size_t WS_SG = WS_YPART + (size_t)T * 1024 * 4;
constexpr size_t WS_SMETA = WS_SG + (size_t)1024 * 8192 * 4;
constexpr size_t WS_HPREV = al256(WS_SMETA + (size_t)16 * 8192 * 4);
constexpr size_t WS_USC = al256(WS_HPREV + (size_t)1024 * 8192 * 2);
constexpr size_t WS_VSC = WS_USC + (size_t)NEXP * 4;
constexpr size_t WS_SCR = al256(WS_VSC + (size_t)NEXP * 4);
}

namespace pg8 {
#define PG8_LAS __attribute__((address_space(3)))
constexpr int BM = 256, BK = 64, HALF = 128, HTB = HALF * BK * 2, STAGE_BYTES = 8 * HTB, NXCD = 8, WGM = 8;
__host__ __device__ __forceinline__ int lds_byte(int r, int c) { const int st = (r >> 4) * 2 + (c >> 5), rr = r & 15, cc = c & 31, ob = rr * 64 + cc * 2; return st * 1024 + (ob ^ (((ob >> 9) & 1) << 5)); }
__host__ __device__ __forceinline__ void stage_rc(int b, int& R, int& C) { const int st = b / 1024, sb = b % 1024, swz = sb ^ (((sb >> 9) & 1) << 5); R = (st >> 1) * 16 + swz / 64; C = (st & 1) * 32 + (swz % 64) / 2; }
__host__ __device__ __forceinline__ int perm32(int rho) { const int n = rho >> 4, i = rho & 15; return 8 * (i >> 2) + 4 * n + (i & 3); }
struct Unit { int pm, pn; };
struct Gemm { const bf16_t* A; const bf16_t* Bt; int M, N, K; };
struct StaticOrder {
    int nM, nN, nwg, G, c;
    __host__ __device__ void init(int M, int N, int G_, int c_) { nM = M / BM; nN = N / BM; nwg = nM * nN; G = G_; c = c_; }
    __host__ __device__ bool next(int i, Unit& u) const {
        const long L = (long)i * G + c; if (L >= nwg) return false;
        int wgid = (int)L; { const int q = nwg / NXCD, r = nwg % NXCD, xcd = wgid % NXCD, off = wgid / NXCD; wgid = (xcd < r ? xcd * (q + 1) : r * (q + 1) + (xcd - r) * q) + off; }
        const int nig = WGM * nN, gid = wgid / nig, fm = gid * WGM, gsz = (nM - fm) < WGM ? (nM - fm) : WGM;
        u.pm = fm + ((wgid % nig) % gsz); u.pn = (wgid % nig) / gsz; return true;
    }
    __device__ __forceinline__ void a_ready(const Unit&) const {}
    __device__ __forceinline__ void done(const Unit&) const {}
};
struct EpiBf16 {
    static constexpr bool PERM = true, AFTER_DRAIN = false;
    bf16_t* O; int ldc;
    __device__ __forceinline__ void operator()(const f32x4 (&acc)[2][2][4][2], const Unit& u, int wr, int wc, int fr, int fq) const {
        const int row0 = u.pm * BM + wr * 64 + fr; const int col0 = u.pn * BM + wc * 32 + 8 * fq;
#pragma unroll
        for (int ai = 0; ai < 2; ++ai)
#pragma unroll
            for (int m = 0; m < 4; ++m) { bf16_t* rowp = O + (size_t)(row0 + ai * HALF + m * 16) * ldc + col0;
#pragma unroll
                for (int bj = 0; bj < 2; ++bj) { const f32x4 v0 = acc[ai][bj][m][0], v1 = acc[ai][bj][m][1];
                    u32x4 w; w.x = pack_bf16(v0[0], v0[1]); w.y = pack_bf16(v0[2], v0[3]); w.z = pack_bf16(v1[0], v1[1]); w.w = pack_bf16(v1[2], v1[3]);
                    *(u32x4*)(rowp + bj * HALF) = w; } }
    }
};

struct EpiRes {
    static constexpr bool PERM = true, AFTER_DRAIN = false;
    const float* X; bf16_t* HB; float* SSQ;
    __device__ __forceinline__ void operator()(const f32x4 (&acc)[2][2][4][2], const Unit& u, int wr, int wc, int fr, int fq) const {
        const int row0 = u.pm * BM + wr * 64 + fr; const int col0 = u.pn * BM + wc * 32 + 8 * fq;
#pragma unroll
        for (int ai = 0; ai < 2; ++ai)
#pragma unroll
            for (int m = 0; m < 4; ++m) { const int row = row0 + ai * HALF + m * 16; const size_t off = (size_t)row * DM + col0; float ss = 0.f;
#pragma unroll
                for (int bj = 0; bj < 2; ++bj) {
                    const f32x4 x0 = *(const f32x4*)(X + off + bj * HALF), x1 = *(const f32x4*)(X + off + bj * HALF + 4);
                    const f32x4 v0 = acc[ai][bj][m][0] + x0, v1 = acc[ai][bj][m][1] + x1;
                    u32x4 w; w.x = pack_bf16(v0[0], v0[1]); w.y = pack_bf16(v0[2], v0[3]); w.z = pack_bf16(v1[0], v1[1]); w.w = pack_bf16(v1[2], v1[3]);
                    *(u32x4*)(HB + off + bj * HALF) = w;
                    ss += v0[0] * v0[0] + v0[1] * v0[1] + v0[2] * v0[2] + v0[3] * v0[3] + v1[0] * v1[0] + v1[1] * v1[1] + v1[2] * v1[2] + v1[3] * v1[3]; }
                ss += __shfl_xor(ss, 16); ss += __shfl_xor(ss, 32);
                if (fq == 0) SSQ[(size_t)row * 32 + u.pn * 4 + wc] = ss; }
    }
};
struct EpiF32 {
    static constexpr bool PERM = true, AFTER_DRAIN = false;
    float* C; int ldc;
    __device__ __forceinline__ void operator()(const f32x4 (&acc)[2][2][4][2], const Unit& u, int wr, int wc, int fr, int fq) const {
        const int row0 = u.pm * BM + wr * 64 + fr; const int col0 = u.pn * BM + wc * 32 + 8 * fq;
#pragma unroll
        for (int ai = 0; ai < 2; ++ai)
#pragma unroll
            for (int m = 0; m < 4; ++m) { float* rowp = C + (size_t)(row0 + ai * HALF + m * 16) * ldc + col0;
#pragma unroll
                for (int bj = 0; bj < 2; ++bj) { *(f32x4*)(rowp + bj * HALF) = acc[ai][bj][m][0]; *(f32x4*)(rowp + bj * HALF + 4) = acc[ai][bj][m][1]; } }
    }
};

struct EpiScores {
    static constexpr bool PERM = true, AFTER_DRAIN = true;
    const bf16_t* KEYS;
    float* STOP; int* ITOP;
    static constexpr int QLD = 264;
    __device__ __forceinline__ void fused(f32x4 (&acc)[2][2][4][2], const Unit& u, int wr, int wc, int fr, int fq, PG8_LAS unsigned char* lds, int wid, int lane) const {
        PG8_LAS bf16_t* Q = (PG8_LAS bf16_t*)lds;
#pragma unroll
        for (int ai = 0; ai < 2; ++ai)
#pragma unroll
            for (int m = 0; m < 4; ++m) { const int row = ai * HALF + wr * 64 + m * 16 + fr;
#pragma unroll
                for (int bj = 0; bj < 2; ++bj) { const f32x4 v0 = acc[ai][bj][m][0], v1 = acc[ai][bj][m][1];
                    u32x4 w; w.x = pack_bf16(v0[0], v0[1]); w.y = pack_bf16(v0[2], v0[3]); w.z = pack_bf16(v1[0], v1[1]); w.w = pack_bf16(v1[2], v1[3]);
                    *(PG8_LAS u32x4*)(Q + row * QLD + bj * HALF + wc * 32 + 8 * fq) = w; } }
        __syncthreads();
        const int h = u.pn;
#pragma unroll 1
        for (int c = 0; c < 2; ++c) {
            f32x4 sc[8][2];
#pragma unroll
            for (int kf = 0; kf < 8; ++kf) { sc[kf][0] = (f32x4){0.f, 0.f, 0.f, 0.f}; sc[kf][1] = (f32x4){0.f, 0.f, 0.f, 0.f}; }
            const bf16_t* kb = KEYS + (size_t)((h * 2 + c) * 128 + fr) * 128 + 8 * fq;
            const PG8_LAS bf16_t* qb = Q + (wid * 32 + fr) * QLD + c * 128 + 8 * fq;
#pragma unroll
            for (int ks = 0; ks < 4; ++ks) {
                const bf16x8 q0 = *(const PG8_LAS bf16x8*)(qb + 32 * ks), q1 = *(const PG8_LAS bf16x8*)(qb + 16 * QLD + 32 * ks);
#pragma unroll
                for (int kf = 0; kf < 8; ++kf) { const bf16x8 kv = *(const bf16x8*)(kb + (size_t)kf * 16 * 128 + 32 * ks);
                    sc[kf][0] = __builtin_amdgcn_mfma_f32_16x16x32_bf16(kv, q0, sc[kf][0], 0, 0, 0);
                    sc[kf][1] = __builtin_amdgcn_mfma_f32_16x16x32_bf16(kv, q1, sc[kf][1], 0, 0, 0); }
            }
#pragma unroll
            for (int tf = 0; tf < 2; ++tf) {
                int v[32];
#pragma unroll
                for (int kf = 0; kf < 8; ++kf)
#pragma unroll
                    for (int r = 0; r < 4; ++r) {
                        const int bts = (int)__float_as_uint(sc[kf][tf][r]);
                        const int srt = bts ^ ((bts >> 31) & 0x7fffffff);
                        v[kf * 4 + r] = (srt & ~127) | (16 * kf + 4 * fq + r);
                    }
#pragma unroll
                for (int k = 2; k <= 32; k <<= 1)
#pragma unroll
                    for (int j = k >> 1; j > 0; j >>= 1)
#pragma unroll
                        for (int i = 0; i < 32; ++i) {
                            const int l = i ^ j;
                            if (l > i) {
                                const int x = v[i], y = v[l];
                                const int hi_ = x > y ? x : y, lo_ = x > y ? y : x;
                                if ((i & k) == 0) { v[i] = hi_; v[l] = lo_; } else { v[i] = lo_; v[l] = hi_; }
                            }
                        }
#pragma unroll
                for (int step = 0; step < 2; ++step) {
                    const int xm = step == 0 ? 16 : 32;
                    int m[16];
#pragma unroll
                    for (int i = 0; i < 16; ++i) { const int o = __shfl_xor(v[15 - i], xm); m[i] = v[i] > o ? v[i] : o; }
#pragma unroll
                    for (int j = 8; j > 0; j >>= 1)
#pragma unroll
                        for (int i = 0; i < 16; ++i) {
                            const int l = i ^ j;
                            if (l > i) { const int x = m[i], y = m[l]; m[i] = x > y ? x : y; m[l] = x > y ? y : x; }
                        }
#pragma unroll
                    for (int i = 0; i < 16; ++i) v[i] = m[i];
                }
                if (fq == 0) {
                    const size_t obase = ((size_t)(u.pm * BM + wid * 32 + tf * 16 + fr) * 16 + h * 2 + c) * 16;
#pragma unroll
                    for (int q4 = 0; q4 < 4; ++q4) {
                        f32x4 sv; u32x4 iv;
#pragma unroll
                        for (int i = 0; i < 4; ++i) {
                            const int key = v[4 * q4 + i], srt = key & ~127;
                            sv[i] = __uint_as_float((unsigned)(srt ^ ((srt >> 31) & 0x7fffffff)));
                            iv[i] = (unsigned)(key & 127);
                        }
                        *(f32x4*)(STOP + obase + 4 * q4) = sv;
                        *(u32x4*)(ITOP + obase + 4 * q4) = iv;
                    }
                }
            }
        }
    }
};

template <class Epi, class Sched>
__device__ __forceinline__ void gemm_phase(PG8_LAS unsigned char* lds, const Gemm g, const Sched& S, const Epi& E) {
    int tid_ = threadIdx.x; asm volatile("" : "+v"(tid_));
    const int tid = tid_, wid = __builtin_amdgcn_readfirstlane(tid >> 6), lane = tid & 63, wr = wid >> 2, wc = wid & 3, fr = lane & 15, fq = lane >> 4;
    const int K = g.K, nt = K / BK;
    unsigned voffA[2], voffB[2];
#pragma unroll
    for (int i = 0; i < 2; ++i) { int R, C; stage_rc(tid * 16 + i * 8192, R, C); const int Rb = Epi::PERM ? ((R & ~31) + perm32(R & 31)) : R;
        voffA[i] = (unsigned)(R * K + C) * 2u; voffB[i] = (unsigned)(Rb * K + C) * 2u; }
    const size_t kstep = (size_t)(BK * 2);
    const size_t hstep = (size_t)HALF * K * 2;
    const size_t tstep = 2 * hstep;
    const unsigned ldsw = (unsigned)wid * 1024u;
    const int aoff = lds_byte(wr * 64 + fr, fq * 8), boff = lds_byte(wc * 32 + fr, fq * 8);
#define PG8_SA(b, h) (((b) * 2 + (h)) * HTB)
#define PG8_SB(b, h) ((4 + (b) * 2 + (h)) * HTB)
#define PG8_STAGE(bufoff, gbase, voff) do { _Pragma("unroll") for (int _i = 0; _i < 2; ++_i) \
        __builtin_amdgcn_global_load_lds((const unsigned*)((const char*)(gbase) + (voff)[_i]), (PG8_LAS unsigned*)(lds + (bufoff) + ldsw + _i * 8192), 16, 0, 0); } while (0)
#define PG8_LDA(dst, b, h) do { _Pragma("unroll") for (int m = 0; m < 4; ++m) _Pragma("unroll") for (int k = 0; k < 2; ++k) dst[m][k] = *(const PG8_LAS bf16x8*)(lds + PG8_SA(b, h) + aoff + m * 2048 + k * 1024); } while (0)
#define PG8_LDB(dst, b, h) do { _Pragma("unroll") for (int n = 0; n < 2; ++n) _Pragma("unroll") for (int k = 0; k < 2; ++k) dst[n][k] = *(const PG8_LAS bf16x8*)(lds + PG8_SB(b, h) + boff + n * 2048 + k * 1024); } while (0)
#define PG8_MMA(ai, bj, At, Bt) do { __builtin_amdgcn_s_setprio(1); _Pragma("unroll") for (int m = 0; m < 4; ++m) _Pragma("unroll") for (int n = 0; n < 2; ++n) _Pragma("unroll") for (int k = 0; k < 2; ++k) \
        acc[ai][bj][m][n] = __builtin_amdgcn_mfma_f32_16x16x32_bf16(Bt[n][k], At[m][k], acc[ai][bj][m][n], 0, 0, 0); __builtin_amdgcn_s_setprio(0); } while (0)
#define PG8_WAIT_V(n) asm volatile("s_waitcnt vmcnt(" #n ")" ::: "memory")
#define PG8_WAIT_L(n) asm volatile("s_waitcnt lgkmcnt(" #n ")" ::: "memory")
#define PG8_BAR __builtin_amdgcn_s_barrier()
#define PG8_SCHED __builtin_amdgcn_sched_barrier(0)
    Unit cur, nxt; int ui = 0;
    if (!S.next(0, cur)) return;
    f32x4 acc[2][2][4][2];
#pragma unroll
    for (int a = 0; a < 2; ++a)
#pragma unroll
        for (int b = 0; b < 2; ++b)
#pragma unroll
            for (int m = 0; m < 4; ++m)
#pragma unroll
                for (int n = 0; n < 2; ++n) acc[a][b][m][n] = (f32x4){0.f, 0.f, 0.f, 0.f};
    bf16x8 At[4][2], B0[2][2], B1[2][2];
    const char* cA = (const char*)g.A + (size_t)cur.pm * tstep; const char* cB = (const char*)g.Bt + (size_t)cur.pn * tstep;
    S.a_ready(cur);
    PG8_STAGE(PG8_SB(0, 0), cB, voffB); PG8_STAGE(PG8_SA(0, 0), cA, voffA); PG8_STAGE(PG8_SB(0, 1), cB + hstep, voffB); PG8_STAGE(PG8_SA(0, 1), cA + hstep, voffA);
    if (wr == 1) PG8_BAR;
    PG8_WAIT_V(4); PG8_BAR;
    PG8_STAGE(PG8_SB(1, 0), cB + kstep, voffB); PG8_STAGE(PG8_SA(1, 0), cA + kstep, voffA); PG8_STAGE(PG8_SB(1, 1), cB + hstep + kstep, voffB);
    PG8_WAIT_V(6); PG8_BAR;
    for (;;) {
        const bool has_next = S.next(ui + 1, nxt);
        const char* nA = has_next ? (const char*)g.A + (size_t)nxt.pm * tstep : cA; const char* nB = has_next ? (const char*)g.Bt + (size_t)nxt.pn * tstep : cB;
        for (int t = 0; t < nt; t += 2) {
            const bool last = (t == nt - 2);
            const char* a1 = cA + (size_t)(t + 1) * kstep;
            const char* a2 = last ? nA : cA + (size_t)(t + 2) * kstep; const char* b2 = last ? nB : cB + (size_t)(t + 2) * kstep;
            const char* a3 = a2 + kstep; const char* b3 = b2 + kstep;
            if (last && has_next) S.a_ready(nxt);
            PG8_LDB(B0, 0, 0); PG8_SCHED; PG8_LDA(At, 0, 0); PG8_STAGE(PG8_SA(1, 1), a1 + hstep, voffA);
            PG8_WAIT_L(8); PG8_BAR; PG8_WAIT_L(0); PG8_MMA(0, 0, At, B0); PG8_BAR; PG8_SCHED;
            PG8_LDB(B1, 0, 1); PG8_STAGE(PG8_SB(0, 0), b2, voffB);
            PG8_BAR; PG8_WAIT_L(0); PG8_MMA(0, 1, At, B1); PG8_BAR;
            PG8_LDA(At, 0, 1); PG8_STAGE(PG8_SA(0, 0), a2, voffA);
            PG8_BAR; PG8_WAIT_L(0); PG8_MMA(1, 0, At, B0); PG8_BAR; PG8_SCHED;
            PG8_STAGE(PG8_SB(0, 1), b2 + hstep, voffB);
            PG8_WAIT_V(6); PG8_BAR; PG8_MMA(1, 1, At, B1); PG8_BAR;
            PG8_LDB(B0, 1, 0); PG8_SCHED; PG8_LDA(At, 1, 0); PG8_STAGE(PG8_SA(0, 1), a2 + hstep, voffA);
            PG8_WAIT_L(8); PG8_BAR; PG8_WAIT_L(0); PG8_MMA(0, 0, At, B0); PG8_BAR; PG8_SCHED;
            PG8_LDB(B1, 1, 1); PG8_STAGE(PG8_SB(1, 0), b3, voffB);
            PG8_BAR; PG8_WAIT_L(0); PG8_MMA(0, 1, At, B1); PG8_BAR;
            PG8_LDA(At, 1, 1); PG8_STAGE(PG8_SA(1, 0), a3, voffA);
            PG8_BAR; PG8_WAIT_L(0); PG8_MMA(1, 0, At, B0); PG8_BAR; PG8_SCHED;
            PG8_STAGE(PG8_SB(1, 1), b3 + hstep, voffB);
            PG8_WAIT_V(6); PG8_BAR; PG8_MMA(1, 1, At, B1); PG8_BAR;
        }
        if constexpr (!Epi::AFTER_DRAIN) { E(acc, cur, wr, wc, fr, fq); S.done(cur); }
        if (!has_next) break;
#pragma unroll
        for (int a = 0; a < 2; ++a)
#pragma unroll
            for (int b = 0; b < 2; ++b)
#pragma unroll
                for (int m = 0; m < 4; ++m)
#pragma unroll
                    for (int n = 0; n < 2; ++n) acc[a][b][m][n] = (f32x4){0.f, 0.f, 0.f, 0.f};
        cur = nxt; cA = nA; cB = nB; ++ui;
    }
    PG8_WAIT_V(0);
    if (wr == 0) PG8_BAR;
    PG8_BAR;
    if constexpr (Epi::AFTER_DRAIN) { E.fused(acc, cur, wr, wc, fr, fq, lds, wid, lane); S.done(cur); }
#undef PG8_SA
#undef PG8_SB
#undef PG8_STAGE
#undef PG8_LDA
#undef PG8_LDB
#undef PG8_MMA
#undef PG8_WAIT_V
#undef PG8_WAIT_L
#undef PG8_BAR
#undef PG8_SCHED
}
}

#define XB_TMO      128
#define XB_XCNT(j)  (256  + 64 * (j))
#define XB_XSUB(j)  (1280 + 64 * (j))
#define XB_XGEN(j)  (2304 + 64 * (j))
#define XB_TOP      3328
#define XB_TOPGEN   3392
#define XCD_BAR_WORDS 3456
#define XB_SPIN_CAP (1u << 22)
__device__ __forceinline__ unsigned xb_ld(unsigned* p)              { return __hip_atomic_load(p, __ATOMIC_RELAXED, __HIP_MEMORY_SCOPE_AGENT); }
__device__ __forceinline__ unsigned xb_add(unsigned* p, unsigned v) { return __hip_atomic_fetch_add(p, v, __ATOMIC_RELAXED, __HIP_MEMORY_SCOPE_AGENT); }
__device__ __forceinline__ unsigned xb_xcc_id() { return (unsigned)__builtin_amdgcn_s_getreg((3 << 11) | 20) & 0xFu; }
#define XB_SPIN(cond, bar) do { unsigned _sp = 0; while (cond) { __builtin_amdgcn_s_sleep(1); \
    if ((++_sp & 255u) == 0u) { if (xb_ld(&(bar)[XB_TMO])) break; if (_sp > XB_SPIN_CAP) { atomicAdd(&(bar)[XB_TMO], 1u); break; } } } } while (0)
struct XcdBarrier { unsigned* bar; unsigned x; volatile LAS unsigned* st; };
__device__ __forceinline__ XcdBarrier xcd_barrier_post(unsigned* bar, volatile LAS unsigned* st) {
    XcdBarrier b; b.bar = bar; b.x = xb_xcc_id(); b.st = st;
    if (threadIdx.x == 0) (void)xb_add(&bar[XB_XCNT(b.x)], 1u);
    return b;
}
__device__ __forceinline__ void xcd_barrier_complete(unsigned* bar, unsigned x, unsigned& nloc, unsigned& nx) {
    const unsigned G = gridDim.x * gridDim.y * gridDim.z;
    unsigned sum, cnt, mine, sp = 0u;
    for (;;) {
        sum = 0u; cnt = 0u; mine = 0u;
#pragma unroll
        for (unsigned j = 0; j < 16; ++j) { const unsigned c = xb_ld(&bar[XB_XCNT(j)]); sum += c; cnt += (c > 0u) ? 1u : 0u; mine = (j == x) ? c : mine; }
        if (sum == G) break;
        __builtin_amdgcn_s_sleep(1);
        if ((++sp & 255u) == 0u) { if (xb_ld(&bar[XB_TMO])) break; if (sp > XB_SPIN_CAP) { atomicAdd(&bar[XB_TMO], 1u); break; } }
    }
    nloc = mine > 0u ? mine : 1u; nx = cnt > 0u ? cnt : 1u;
}
__device__ __forceinline__ void xcd_barrier(const XcdBarrier& b) {
    asm volatile("s_waitcnt vmcnt(0)" ::: "memory");
    __syncthreads();
    if (threadIdx.x == 0) {
        unsigned* bar = b.bar;
        const unsigned bx = xb_xcc_id();
        __builtin_amdgcn_s_waitcnt(0);
        unsigned nloc = b.st[0], nx = b.st[1];
        if (nloc == 0u) { xcd_barrier_complete(bar, bx, nloc, nx); b.st[0] = nloc; b.st[1] = nx; }
        const unsigned old = xb_add(&bar[XB_XSUB(bx)], 1u);
        const unsigned gen = old / nloc;
        if (old + 1u == (gen + 1u) * nloc) {
            __builtin_amdgcn_fence(__ATOMIC_RELEASE, "agent");
            asm volatile("s_waitcnt vmcnt(0)" ::: "memory");
            const unsigned og = xb_add(&bar[XB_TOP], 1u);
            const unsigned tg = og / nx;
            if (og + 1u == (tg + 1u) * nx) xb_add(&bar[XB_TOPGEN], 1u);
            else XB_SPIN(xb_ld(&bar[XB_TOPGEN]) == tg, bar);
            __builtin_amdgcn_fence(__ATOMIC_ACQUIRE, "agent");
            xb_add(&bar[XB_XGEN(bx)], 1u);
            asm volatile("s_waitcnt vmcnt(0)" ::: "memory");
        } else {
            XB_SPIN(xb_ld(&bar[XB_XGEN(bx)]) == gen, bar);
            __builtin_amdgcn_fence(__ATOMIC_ACQUIRE, "agent");
            asm volatile("s_waitcnt vmcnt(0)" ::: "memory");
        }
    }
    __syncthreads();
}

namespace {
struct Params {
  const float *x, *meta, *rel_bias, *ln_mix, *w_in, *sinks, *conv_w, *conv_b, *dt_bias, *a_log, *d_skip, *attn_norm_w,
      *ssm_norm_w, *w_out, *ln_ffn, *wq, *keys, *U, *V, *ln_final;
  float* out;
  unsigned char* ws;
};

__device__ __forceinline__ void p0_transpose_tile(const float* __restrict__ W, int ldw, bf16_t* __restrict__ Wt, const float* sc0,
                                                  const float* sc1, int k0, int n0, float* tile) {
  const int tid = threadIdx.x;
  {
    const int r = tid >> 6, c4 = (tid & 63) * 4;
    f32x4 v[8];
#pragma unroll
    for (int i = 0; i < 8; ++i) v[i] = *(const f32x4*)(W + (size_t)(k0 + r + 8 * i) * ldw + n0 + c4);
#pragma unroll
    for (int i = 0; i < 8; ++i) {
      float s = 1.f;
      const int k = k0 + r + 8 * i;
      if (sc0) s = k < 1024 ? sc0[k] : sc1[k - 1024];
      float* q = tile + (r + 8 * i) * 257 + c4;
      q[0] = v[i][0] * s; q[1] = v[i][1] * s; q[2] = v[i][2] * s; q[3] = v[i][3] * s;
    }
  }
  __syncthreads();
#pragma unroll
  for (int it = 0; it < 4; ++it) {
    const int task = it * NTHREADS + tid;
    const int n = task >> 3, kc = (task & 7) * 8;
    float v[8];
#pragma unroll
    for (int j = 0; j < 8; ++j) v[j] = tile[(kc + j) * 257 + n];
    u32x4 w; w.x = pack_bf16(v[0], v[1]); w.y = pack_bf16(v[2], v[3]); w.z = pack_bf16(v[4], v[5]); w.w = pack_bf16(v[6], v[7]);
    *(u32x4*)(Wt + (size_t)(n0 + n) * DM + k0 + kc) = w;
  }
  __syncthreads();
}

__device__ __forceinline__ void phase0(const Params& p, float* ldsf, int bid, int nblk) {
  const int tid = threadIdx.x, lane = tid & 63, wid = tid >> 6;
  bf16_t* w_inT = (bf16_t*)(p.ws + WS_WINT);
  bf16_t* w_dtT = (bf16_t*)(p.ws + WS_WDTT);
  bf16_t* w_outT = (bf16_t*)(p.ws + WS_WOUTT);
  bf16_t* wqT = (bf16_t*)(p.ws + WS_WQT);
  bf16_t* keysb = (bf16_t*)(p.ws + WS_KEYS);
  unsigned char* ub = p.ws + WS_UB;
  unsigned char* vb = p.ws + WS_VB;
  bf16_t* hnb = (bf16_t*)(p.ws + WS_HNB);
  constexpr int U_HN = (TA + 7) / 8;
  constexpr int U_WIN = 32 * 16, U_WOUT = 32 * 8, U_WQ = 32 * 8, U_WDT = 1, U_KEYS = 64;
  constexpr int B_WIN = U_HN, B_WOUT = B_WIN + U_WIN, B_WQ = B_WOUT + U_WOUT, B_WDT = B_WQ + U_WQ, B_KEYS = B_WDT + U_WDT,
                B_U = B_KEYS + U_KEYS, B_END = B_U;
  for (int u = bid; u < B_END; u += nblk) {
    if (u < B_WIN) {
      const int t = u * 8 + wid;
      if (t < TA) {
        const float* src = t < T ? p.x + (size_t)t * DM : p.meta + (size_t)(t - T) * DM;
        float4 v[8];
        float ss = 0.f;
#pragma unroll
        for (int i = 0; i < 8; ++i) {
          v[i] = *(const float4*)(src + (i * 64 + lane) * 4);
          ss += v[i].x * v[i].x + v[i].y * v[i].y + v[i].z * v[i].z + v[i].w * v[i].w;
        }
        ss = wave_sum(ss);
        const float r = rsqrtf(ss * (1.f / DM) + EPS);
#pragma unroll
        for (int i = 0; i < 8; ++i) {
          const float4 w = *(const float4*)(p.ln_mix + (i * 64 + lane) * 4);
          u32x2 o; o.x = pack_bf16(v[i].x * r * w.x, v[i].y * r * w.y); o.y = pack_bf16(v[i].z * r * w.z, v[i].w * r * w.w);
          *(u32x2*)(hnb + (size_t)t * DM + (i * 64 + lane) * 4) = o;
        }
      }
    } else if (u < B_WOUT) {
      const int i = u - B_WIN;
      p0_transpose_tile(p.w_in, DPROJ, w_inT, nullptr, nullptr, (i & 31) * 64, (i >> 5) * 256, ldsf);
    } else if (u < B_WQ) {
      const int i = u - B_WOUT;
      p0_transpose_tile(p.w_out, DM, w_outT, p.attn_norm_w, p.ssm_norm_w, (i & 31) * 64, (i >> 5) * 256, ldsf);
    } else if (u < B_WDT) {
      const int i = u - B_WQ;
      p0_transpose_tile(p.wq, DM, wqT, p.ln_ffn, p.ln_ffn + 1024, (i & 31) * 64, (i >> 5) * 256, ldsf);
    } else if (u < B_KEYS) {
      for (int idx = tid; idx < DM * 16; idx += NTHREADS) {
        const int k = idx >> 4, j = idx & 15;
        w_dtT[(size_t)j * DM + k] = f2bf(p.w_in[(size_t)k * DPROJ + NPROJ + j]);
      }
    } else if (u < B_U) {
      const size_t base = (size_t)(u - B_KEYS) * 4096 + (size_t)tid * 8;
      const float4 a = *(const float4*)(p.keys + base), b = *(const float4*)(p.keys + base + 4);
      u32x4 w; w.x = pack_bf16(a.x, a.y); w.y = pack_bf16(a.z, a.w); w.z = pack_bf16(b.x, b.y); w.w = pack_bf16(b.z, b.w);
      *(u32x4*)(keysb + base) = w;
    }
  }
  {
    const int gw = bid * 8 + wid, nw = nblk * 8;
    auto load_row = [&](f32x4 (&a)[8], const int r2) __attribute__((always_inline)) {
      const float* src = (r2 < NEXP ? p.U + (size_t)r2 * DM : p.V + (size_t)(r2 - NEXP) * DM) + lane * 4;
#pragma unroll
      for (int j = 0; j < 8; ++j) a[j] = *(const f32x4*)(src + 256 * j);
    };
    auto conv_row = [&](f32x4 (&a)[8], const int r2) __attribute__((always_inline)) {
      const bool isU = r2 < NEXP;
      const int row = isU ? r2 : r2 - NEXP;
      if (isU) {
#pragma unroll
        for (int j = 0; j < 8; ++j) a[j] *= *(const f32x4*)(p.ln_ffn + lane * 4 + 256 * j);
      }
      float amax = 0.f;
#pragma unroll
      for (int j = 0; j < 8; ++j) amax = fmaxf(amax, fmaxf(fmaxf(fabsf(a[j][0]), fabsf(a[j][1])), fmaxf(fabsf(a[j][2]), fabsf(a[j][3]))));
      amax = wave_max(amax);
      const float s4 = amax > 0.f ? 6.f / amax : 1.f;
      u32x4 w4;
#pragma unroll
      for (int j = 0; j < 4; ++j) {
        unsigned w = 0;
        w = __builtin_amdgcn_cvt_scalef32_pk_fp4_f32(w, a[2 * j][0] * s4, a[2 * j][1] * s4, 1.0f, 0);
        w = __builtin_amdgcn_cvt_scalef32_pk_fp4_f32(w, a[2 * j][2] * s4, a[2 * j][3] * s4, 1.0f, 1);
        w = __builtin_amdgcn_cvt_scalef32_pk_fp4_f32(w, a[2 * j + 1][0] * s4, a[2 * j + 1][1] * s4, 1.0f, 2);
        w = __builtin_amdgcn_cvt_scalef32_pk_fp4_f32(w, a[2 * j + 1][2] * s4, a[2 * j + 1][3] * s4, 1.0f, 3);
        w4[j] = w;
      }
      *(u32x4*)((isU ? ub : vb) + (size_t)row * ROW4 + lane * 16) = w4;
      if (lane == 0) ((float*)(p.ws + (isU ? WS_USC : WS_VSC)))[row] = amax > 0.f ? amax * (1.f / 6.f) : 1.f;
    };
    f32x4 ra[8], rb[8];
    int r2 = gw;
    if (r2 < 2 * NEXP) load_row(ra, r2);
#pragma unroll 1
    for (; r2 < 2 * NEXP; r2 += 2 * nw) {
      if (r2 + nw < 2 * NEXP) load_row(rb, r2 + nw);
      conv_row(ra, r2);
      if (r2 + nw < 2 * NEXP) {
        if (r2 + 2 * nw < 2 * NEXP) load_row(ra, r2 + 2 * nw);
        conv_row(rb, r2 + nw);
      }
    }
  }
}

__device__ __forceinline__ void mini_gemm(const bf16_t* __restrict__ A, const bf16_t* __restrict__ Bt, float* __restrict__ out, int ldo,
                                          float* red, bf16_t* __restrict__ outb = nullptr) {
  const int tid = threadIdx.x, lane = tid & 63, wid = tid >> 6, fr = lane & 15, fq = lane >> 4;
  f32x4 acc = {0.f, 0.f, 0.f, 0.f};
  const bf16_t* ap = A + (size_t)fr * DM + wid * 256 + fq * 8;
  const bf16_t* bp = Bt + (size_t)fr * DM + wid * 256 + fq * 8;
#pragma unroll
  for (int ks = 0; ks < 8; ++ks) {
    const bf16x8 a = *(const bf16x8*)(ap + ks * 32);
    const bf16x8 b = *(const bf16x8*)(bp + ks * 32);
    acc = __builtin_amdgcn_mfma_f32_16x16x32_bf16(a, b, acc, 0, 0, 0);
  }
#pragma unroll
  for (int r = 0; r < 4; ++r) red[wid * 256 + (4 * fq + r) * 16 + fr] = acc[r];
  __syncthreads();
  if (tid < 256) {
    float s = 0.f;
#pragma unroll
    for (int w = 0; w < 8; ++w) s += red[w * 256 + tid];
    out[(size_t)(tid >> 4) * ldo + (tid & 15)] = s;
    if (outb) outb[(size_t)(tid >> 4) * ldo + (tid & 15)] = f2bf(s);
  }
  __syncthreads();
}

__device__ __forceinline__ void phase1(const Params& p, unsigned char* lds, int bid, int nblk) {
  const bf16_t* hnb = (const bf16_t*)(p.ws + WS_HNB);
  const bf16_t* w_inT = (const bf16_t*)(p.ws + WS_WINT);
  const bf16_t* w_dtT = (const bf16_t*)(p.ws + WS_WDTT);
  float* dtraw = (float*)(p.ws + WS_DTRAW);
  float* projm = (float*)(p.ws + WS_PROJM);
  constexpr int NU = 512 + 32 + 96 + 1;
  for (int u = bid; u < NU; u += nblk) {
    if (u < 512) {
      mini_gemm(hnb + (size_t)u * 16 * DM, w_dtT, dtraw + (size_t)u * 16 * 16, 16, (float*)lds);
    } else {
      const int j = u - 512;
      const int cf = j < 32 ? 64 + j : (j < 128 ? 160 + (j - 32) : 256);
      const bf16_t* bt = cf < 256 ? w_inT + (size_t)cf * 16 * DM : w_dtT;
      mini_gemm(hnb + (size_t)T * DM, bt, projm + cf * 16, DPROJ, (float*)lds, (bf16_t*)(p.ws + WS_PROJMB) + cf * 16);
    }
  }
  pg8::Gemm g{hnb, w_inT, T, NPROJ, DM};
  pg8::StaticOrder S; S.init(T, NPROJ, nblk, bid);
  pg8::EpiBf16 E{(bf16_t*)(p.ws + WS_PROJ), NPROJ};
  pg8::gemm_phase<pg8::EpiBf16, pg8::StaticOrder>((PG8_LAS unsigned char*)lds, g, S, E);
}

__device__ __forceinline__ void phase4(const Params& p, unsigned char* lds, int bid, int nblk) {
  pg8::Gemm g{(const bf16_t*)(p.ws + WS_HNB), (const bf16_t*)(p.ws + WS_WOUTT), T, DM, DM};
  pg8::StaticOrder S; S.init(T, DM, nblk, bid);
  pg8::EpiRes E{p.x, (bf16_t*)(p.ws + WS_H1B), (float*)(p.ws + WS_SSQH1)};
  pg8::gemm_phase<pg8::EpiRes, pg8::StaticOrder>((PG8_LAS unsigned char*)lds, g, S, E);
}
__device__ __forceinline__ void phase5(const Params& p, unsigned char* lds, int bid, int nblk) {
  pg8::Gemm g{(const bf16_t*)(p.ws + WS_H1B), (const bf16_t*)(p.ws + WS_WQT), T, DM, DM};
  pg8::StaticOrder S; S.init(T, DM, nblk, bid);
  pg8::EpiScores E{(const bf16_t*)(p.ws + WS_KEYS), (float*)(p.ws + WS_STOP), (int*)(p.ws + WS_ITOP)};
  pg8::gemm_phase<pg8::EpiScores, pg8::StaticOrder>((PG8_LAS unsigned char*)lds, g, S, E);
}

__device__ __forceinline__ float dot2bf(unsigned a, unsigned b, float c) {
  return __builtin_amdgcn_fdot2_f32_bf16(*(bf16v2*)&a, *(bf16v2*)&b, c, false);
}
__device__ __forceinline__ void phase6(const Params& p, unsigned char* lds, int bid, int nblk) {
  const int tid0 = threadIdx.x, lane0 = tid0 & 63, wid = __builtin_amdgcn_readfirstlane(tid0 >> 6);
  int* ids = (int*)(lds + wid * 2048);
  float* gts = (float*)(lds + wid * 2048 + 512);
  float* wts = (float*)(lds + wid * 2048 + 1024);
  int* rid = (int*)(lds + 16384 + wid * 1024);
  float* rgt = (float*)(lds + 16384 + wid * 1024 + 512);
  const unsigned char* ub = p.ws + WS_UB;
  const unsigned char* vb = p.ws + WS_VB;
  const bf16_t* h1b = (const bf16_t*)(p.ws + WS_H1B);
  const float* usc = (const float*)(p.ws + WS_USC);
  const float* vsc = (const float*)(p.ws + WS_VSC);
  const float* ssq = (const float*)(p.ws + WS_SSQH1);
  const float* stop = (const float*)(p.ws + WS_STOP);
  const int* itop = (const int*)(p.ws + WS_ITOP);
  const int ci = kCandI[lane0], cj = kCandJ[lane0];
#pragma unroll 1
  for (int t = bid * 8 + wid; t < T; t += nblk * 8) {
    int tid = tid0; asm volatile("" : "+v"(tid));
    const int lane = tid & 63;
    const int kcode = 8 * ((lane >> 2) & 1) + 4 * ((lane >> 3) & 1) + 2 * ((lane >> 4) & 1) + ((lane >> 5) & 1);
    const float part0 = lane < 32 ? ssq[(size_t)t * 32 + lane] : 0.f;
    const float rr = rsqrtf(wave_sum(part0) * (1.f / DM) + EPS);
#pragma unroll 1
    for (int h = 0; h < 8; ++h) {
      const size_t lbase = ((size_t)t * 16 + h * 2) * 16;
      const float sv = lane < 32 ? stop[lbase + lane] : 0.f;
      const int iv = lane < 32 ? itop[lbase + lane] : 0;
      float cand = (__shfl(sv, ci) + __shfl(sv, 16 + cj)) * rr;
      if (lane >= 50) cand = -INFINITY;
      unsigned key = __float_as_uint(cand);
      key = (key & 0x80000000u) ? ~key : (key | 0x80000000u);
      key = (key & ~63u) | (unsigned)(63 - lane);
      int rank = 0;
#pragma unroll
      for (int k = 0; k < 50; ++k) {
        const unsigned kk = (unsigned)__builtin_amdgcn_readlane((int)key, k);
        rank += kk > key ? 1 : 0;
      }
      const float cmax = wave_max(cand);
      const float ex = rank < 16 ? __expf(cand - cmax) : 0.f;
      const float den = wave_sum(ex);
      const int eidx = __shfl(iv, ci) * 128 + __shfl(iv, 16 + cj);
      if (rank < 16) { rid[h * 16 + rank] = eidx; rgt[h * 16 + rank] = ex / den; }
    }
    {
      const int e0 = rid[lane], e1 = rid[lane + 64];
      const float g0 = rgt[lane], g1 = rgt[lane + 64];
      const int r0 = e0 >> 10, r1 = e1 >> 10;
      const unsigned long long ltm = (1ull << lane) - 1ull;
      int run = 0, pos0 = 0, pos1 = 0;
#pragma unroll
      for (int R = 0; R < 16; ++R) {
        const unsigned long long m0 = __ballot(r0 == R), m1 = __ballot(r1 == R);
        const int c0 = __popcll(m0), c1 = __popcll(m1);
        if (r0 == R) pos0 = run + __popcll(m0 & ltm);
        if (r1 == R) pos1 = run + c0 + __popcll(m1 & ltm);
        run += c0 + c1;
      }
      ids[pos0] = e0; gts[pos0] = g0;
      ids[pos1] = e1; gts[pos1] = g1;
    }
    float xf[32];
    {
      const bf16_t* xp = h1b + (size_t)t * DM + lane * 4;
#pragma unroll
      for (int j = 0; j < 8; ++j) {
        const u32x2 xa = *(const u32x2*)(xp + 256 * j);
        xf[4 * j + 0] = bflo(xa.x); xf[4 * j + 1] = bfhi(xa.x); xf[4 * j + 2] = bflo(xa.y); xf[4 * j + 3] = bfhi(xa.y);
      }
    }
#pragma unroll 1
    for (int rnd = 0; rnd < 8; ++rnd) {
      u32x4 ra[16];
#pragma unroll
      for (int k = 0; k < 16; ++k) {
        const int e = __builtin_amdgcn_readfirstlane(ids[rnd * 16 + k]);
        ra[k] = *(const u32x4*)(ub + (size_t)e * ROW4 + lane * 16);
      }
      float part[16];
      float prev = 0.f;
#pragma unroll
      for (int k = 0; k < 16; ++k) {
        asm volatile("" : "+v"(ra[k]) : "v"(prev));
        float d0 = 0.f, d1 = 0.f;
#define U4_STEP(j, i) { const f32x2 r = __builtin_amdgcn_cvt_scalef32_pk_f32_fp4(ra[k][j], 1.0f, i); \
          d0 = fmaf(r[0], xf[8 * (j) + 2 * (i)], d0); d1 = fmaf(r[1], xf[8 * (j) + 2 * (i) + 1], d1); }
#pragma unroll
        for (int j = 0; j < 4; ++j) { U4_STEP(j, 0) U4_STEP(j, 1) U4_STEP(j, 2) U4_STEP(j, 3) }
#undef U4_STEP
        prev = d0 + d1;
        part[k] = prev;
      }
      float q8[8], q4[4], q2[2], q1;
      { const bool hi = (lane >> 5) & 1;
#pragma unroll
        for (int i = 0; i < 8; ++i) { const float keep = hi ? part[2 * i + 1] : part[2 * i], send = hi ? part[2 * i] : part[2 * i + 1]; q8[i] = keep + __shfl_xor(send, 32); } }
      { const bool hi = (lane >> 4) & 1;
#pragma unroll
        for (int i = 0; i < 4; ++i) { const float keep = hi ? q8[2 * i + 1] : q8[2 * i], send = hi ? q8[2 * i] : q8[2 * i + 1]; q4[i] = keep + __shfl_xor(send, 16); } }
      { const bool hi = (lane >> 3) & 1;
#pragma unroll
        for (int i = 0; i < 2; ++i) { const float keep = hi ? q4[2 * i + 1] : q4[2 * i], send = hi ? q4[2 * i] : q4[2 * i + 1]; q2[i] = keep + __shfl_xor(send, 8); } }
      { const bool hi = (lane >> 2) & 1;
        const float keep = hi ? q2[1] : q2[0], send = hi ? q2[0] : q2[1]; q1 = keep + __shfl_xor(send, 4); }
      q1 += __shfl_xor(q1, 2);
      q1 += __shfl_xor(q1, 1);
      {
        const int kk = rnd * 16 + kcode;
        const int eid = ids[kk];
        const float a = q1 * rr * usc[eid];
        const float ge = 0.5f * a * (1.f + erff(a * 0.70710678118654752f));
        if ((lane & 3) == 0) wts[kk] = gts[kk] * ge * vsc[eid];
      }
    }
    float acc[32];
#pragma unroll
    for (int i = 0; i < 32; ++i) acc[i] = 0.f;
#pragma unroll 1
    for (int rnd = 0; rnd < 8; ++rnd) {
      u32x4 ra[16];
#pragma unroll
      for (int k = 0; k < 16; ++k) {
        const int e = __builtin_amdgcn_readfirstlane(ids[rnd * 16 + k]);
        ra[k] = *(const u32x4*)(vb + (size_t)e * ROW4 + lane * 16);
      }
      f32x4 wv[4];
#pragma unroll
      for (int j = 0; j < 4; ++j) wv[j] = *(const f32x4*)(wts + rnd * 16 + 4 * j);
#pragma unroll
      for (int k = 0; k < 16; ++k) {
        const float wk = wv[k >> 2][k & 3];
        asm volatile("" : "+v"(ra[k]) : "v"(acc[1]), "v"(acc[3]), "v"(acc[5]), "v"(acc[7]), "v"(acc[9]), "v"(acc[11]), "v"(acc[13]), "v"(acc[15]),
                                        "v"(acc[17]), "v"(acc[19]), "v"(acc[21]), "v"(acc[23]), "v"(acc[25]), "v"(acc[27]), "v"(acc[29]), "v"(acc[31]));
#define V4_STEP(j, i) { const f32x2 r = __builtin_amdgcn_cvt_scalef32_pk_f32_fp4(ra[k][j], 1.0f, i); \
            acc[8 * (j) + 2 * (i)] = fmaf(wk, r[0], acc[8 * (j) + 2 * (i)]); acc[8 * (j) + 2 * (i) + 1] = fmaf(wk, r[1], acc[8 * (j) + 2 * (i) + 1]); }
#pragma unroll
        for (int j = 0; j < 4; ++j) { V4_STEP(j, 0) V4_STEP(j, 1) V4_STEP(j, 2) V4_STEP(j, 3) }
#undef V4_STEP
      }
    }
    float ss = 0.f;
#pragma unroll
    for (int i = 0; i < 32; ++i) { acc[i] += xf[i]; ss += acc[i] * acc[i]; }
    ss = wave_sum(ss);
    const float rf = rsqrtf(ss * (1.f / DM) + EPS);
#pragma unroll
    for (int j = 0; j < 8; ++j) {
      const f32x4 lw = *(const f32x4*)(p.ln_final + 256 * j + lane * 4);
      *(f32x4*)(p.out + (size_t)t * DM + 256 * j + lane * 4) = (f32x4){acc[4 * j] * rf * lw[0], acc[4 * j + 1] * rf * lw[1], acc[4 * j + 2] * rf * lw[2], acc[4 * j + 3] * rf * lw[3]};
    }
  }
}

typedef float f32x16 __attribute__((ext_vector_type(16)));
__device__ __forceinline__ void unpack8(const u32x4 a, float (&v)[8]) {
  v[0] = bflo(a.x); v[1] = bfhi(a.x); v[2] = bflo(a.y); v[3] = bfhi(a.y); v[4] = bflo(a.z); v[5] = bfhi(a.z); v[6] = bflo(a.w); v[7] = bfhi(a.w);
}
constexpr int VT_LD = 196;
constexpr int ATT_VT_BYTES = 4 * 64 * VT_LD * 2;
__device__ __forceinline__ void attn_item(const Params& p, unsigned char* lds, int item) {
  const int tid = threadIdx.x, lane = tid & 63, wid = __builtin_amdgcn_readfirstlane(tid >> 6);
  const int b = item >> 6, q0 = (item & 63) * 32;
  bf16_t* VT = (bf16_t*)lds;
  float* biasL = (float*)(lds + ATT_VT_BYTES);
  float* ssqw = biasL + 16 * 132;
  const bf16_t* proj = (const bf16_t*)(p.ws + WS_PROJ);
  const float* projm = (const float*)(p.ws + WS_PROJM);
  bf16_t* mixin = (bf16_t*)(p.ws + WS_HNB);
#pragma unroll
  for (int it = 0; it < 5; ++it) {
    const int idx = it * NTHREADS + tid;
    if (idx >= 16 * 129) break;
    const int hq = idx / 129, d = idx - hq * 129;
    const int bk = d < 128 ? (int)kBucket[d] : 31;
    biasL[hq * 132 + d] = p.rel_bias[bk * 16 + hq];
  }
  const int ql = lane & 31, ql0 = ql, hh = lane >> 5, kvh = wid >> 1;
  const int trow = b * SEQ + q0 + ql;
  bf16x8 qf[4];
  u32x4 kf[6][4];
#define ATT_LOAD_Q(hq_)                                                                                                           \
  { _Pragma("unroll") for (int ks = 0; ks < 4; ++ks) qf[ks] = *(const bf16x8*)(proj + (size_t)trow * NPROJ + OFF_Q + (hq_) * 64 + ks * 16 + hh * 8); }
#define ATT_LOAD_K()                                                                                                              \
  {                                                                                                                               \
    int ql = ql0; asm volatile("" : "+v"(ql));     \
    const float* kr_ = projm + (size_t)(ql & 15) * DPROJ + OFF_K + kvh * 64 + hh * 8;                                             \
    _Pragma("unroll") for (int ks = 0; ks < 4; ++ks) {                                                                            \
      const f32x4 a_ = *(const f32x4*)(kr_ + ks * 16), c_ = *(const f32x4*)(kr_ + ks * 16 + 4);                                   \
      kf[0][ks].x = pack_bf16(a_[0], a_[1]); kf[0][ks].y = pack_bf16(a_[2], a_[3]); kf[0][ks].z = pack_bf16(c_[0], c_[1]); kf[0][ks].w = pack_bf16(c_[2], c_[3]); } \
    _Pragma("unroll") for (int jt = 1; jt < 6; ++jt) {                                                                            \
      int sp_ = q0 - 128 + 32 * (jt - 1) + ql; sp_ = sp_ < 0 ? 0 : sp_;                                                           \
      const bf16_t* kp_ = proj + (size_t)(b * SEQ + sp_) * NPROJ + OFF_K + kvh * 64 + hh * 8;                                     \
      _Pragma("unroll") for (int ks = 0; ks < 4; ++ks) kf[jt][ks] = *(const u32x4*)(kp_ + ks * 16); }                             \
  }
  ATT_LOAD_Q(2 * wid)
#pragma unroll 1
  for (int rep_ = 0; rep_ < (REP_SUB == 2 ? 2 : 1); ++rep_) {
    u32x4 ra[5], rc[5];
#pragma unroll
    for (int q = 0; q < 5; ++q) {
      const int task = q * NTHREADS + tid, ch = task / 80, pi = task - ch * 80;
      int s0 = q0 - 128 + 2 * pi;
      s0 = s0 < 0 ? 0 : s0;
      const bf16_t* r0 = proj + (size_t)(b * SEQ + s0) * NPROJ + OFF_V + ch * 8;
      ra[q] = *(const u32x4*)r0; rc[q] = *(const u32x4*)(r0 + NPROJ);
    }
    float m0[8], m1[8];
    {
      const int pi = tid & 7, ch = (tid >> 3) & 31;
      const float* r0 = projm + (size_t)(2 * pi) * DPROJ + OFF_V + ch * 8;
      const f32x4 ma = *(const f32x4*)r0, mb = *(const f32x4*)(r0 + 4), mc = *(const f32x4*)(r0 + DPROJ), md = *(const f32x4*)(r0 + DPROJ + 4);
      const float keep = tid < 256 ? 1.f : 0.f;
#pragma unroll
      for (int i = 0; i < 4; ++i) { m0[i] = ma[i] * keep; m0[4 + i] = mb[i] * keep; m1[i] = mc[i] * keep; m1[4 + i] = md[i] * keep; }
      bf16_t* dst = VT + (size_t)((ch >> 3) * 64 + (ch & 7) * 8) * VT_LD + 2 * pi + (tid < 256 ? 0 : 16);
#pragma unroll
      for (int i = 0; i < 8; ++i) *(unsigned*)(dst + i * VT_LD) = pack_bf16(m0[i], m1[i]);
    }
#pragma unroll
    for (int q = 0; q < 5; ++q) {
      const int task = q * NTHREADS + tid, ch = task / 80, pi = task - ch * 80;
      float v0[8], v1[8];
      unpack8(ra[q], v0); unpack8(rc[q], v1);
      bf16_t* dst = VT + (size_t)((ch >> 3) * 64 + (ch & 7) * 8) * VT_LD + 32 + 2 * pi;
#pragma unroll
      for (int i = 0; i < 8; ++i) *(unsigned*)(dst + i * VT_LD) = pack_bf16(v0[i], v1[i]);
    }
  }
  __syncthreads();
  float ssq = 0.f;
#pragma unroll 1
  for (int rep_ = 0; rep_ < (REP_SUB == 3 ? 2 : 1); ++rep_) {
  ssq = 0.f;
  auto do_head = [&](const int hsel) __attribute__((always_inline)) {
    const int hq = 2 * wid + hsel;
    f32x16 sacc[6];
#pragma unroll
    for (int jt = 0; jt < 6; ++jt) {
      f32x16 acc;
#pragma unroll
      for (int r = 0; r < 16; ++r) acc[r] = 0.f;
#pragma unroll
      for (int ks = 0; ks < 4; ++ks) acc = __builtin_amdgcn_mfma_f32_32x32x16_bf16(*(bf16x8*)&kf[jt][ks], qf[ks], acc, 0, 0, 0);
      sacc[jt] = acc;
    }
    if (hsel == 0) { ATT_LOAD_Q(2 * wid + 1) }
    const float* bl = biasL + hq * 132;
    int sq = q0 + ql, qh = ql - 4 * hh;
    asm volatile("" : "+v"(sq), "+v"(qh));
    const float sink = p.sinks[hq];
    float m = sink;
#pragma unroll
    for (int jt = 0; jt < 6; ++jt) {
      asm volatile("" ::: "memory");
#pragma unroll
      for (int r = 0; r < 16; ++r) {
        const int kr = (r & 3) + 8 * (r >> 2) + 4 * hh;
        int dist; bool valid;
        if (jt == 0) { dist = sq + (16 - ((r & 3) + 8 * (r >> 2))) - 4 * hh; valid = kr < 16; }
        else { dist = qh + (128 - 32 * (jt - 1) - ((r & 3) + 8 * (r >> 2))); valid = (dist >= 0) && (dist < 128) && (dist <= sq); }
        const int dc = dist < 0 ? 0 : (dist > 128 ? 128 : dist);
        const float l = valid ? 0.125f * sacc[jt][r] + bl[dc] : -1e30f;
        sacc[jt][r] = l;
        m = fmaxf(m, l);
      }
    }
    m = fmaxf(m, __shfl_xor(m, 32));
    float sum = 0.f;
    f32x16 oacc0, oacc1;
#pragma unroll
    for (int r = 0; r < 16; ++r) { oacc0[r] = 0.f; oacc1[r] = 0.f; }
    const bf16_t* vrow0 = VT + (size_t)(kvh * 64 + ql) * VT_LD + 4 * hh;
    const bf16_t* vrow1 = vrow0 + 32 * VT_LD;
#pragma unroll
    for (int jt = 0; jt < 6; ++jt) {
      u32x4 pw[2];
#pragma unroll
      for (int s2 = 0; s2 < 2; ++s2) {
        float e[8];
#pragma unroll
        for (int i = 0; i < 8; ++i) { e[i] = __expf(sacc[jt][8 * s2 + i] - m); sum += e[i]; }
        pw[s2].x = pack_bf16(e[0], e[1]); pw[s2].y = pack_bf16(e[2], e[3]); pw[s2].z = pack_bf16(e[4], e[5]); pw[s2].w = pack_bf16(e[6], e[7]);
      }
#pragma unroll
      for (int s2 = 0; s2 < 2; ++s2) {
        const u32x2 va = *(const u32x2*)(vrow0 + 32 * jt + 16 * s2), vc = *(const u32x2*)(vrow0 + 32 * jt + 16 * s2 + 8);
        const u32x2 vd = *(const u32x2*)(vrow1 + 32 * jt + 16 * s2), ve = *(const u32x2*)(vrow1 + 32 * jt + 16 * s2 + 8);
        u32x4 v0w; v0w.x = va.x; v0w.y = va.y; v0w.z = vc.x; v0w.w = vc.y;
        u32x4 v1w; v1w.x = vd.x; v1w.y = vd.y; v1w.z = ve.x; v1w.w = ve.y;
        oacc0 = __builtin_amdgcn_mfma_f32_32x32x16_bf16(*(bf16x8*)&v0w, *(bf16x8*)&pw[s2], oacc0, 0, 0, 0);
        oacc1 = __builtin_amdgcn_mfma_f32_32x32x16_bf16(*(bf16x8*)&v1w, *(bf16x8*)&pw[s2], oacc1, 0, 0, 0);
      }
    }
    sum += __shfl_xor(sum, 32);
    const float inv = 1.f / (sum + __expf(sink - m));
#pragma unroll
    for (int r = 0; r < 16; ++r) { oacc0[r] *= inv; oacc1[r] *= inv; ssq += oacc0[r] * oacc0[r] + oacc1[r] * oacc1[r]; }
#pragma unroll
    for (int rg = 0; rg < 4; ++rg) {
      u32x2 w; w.x = pack_bf16(oacc0[rg * 4 + 0], oacc0[rg * 4 + 1]); w.y = pack_bf16(oacc0[rg * 4 + 2], oacc0[rg * 4 + 3]);
      *(u32x2*)(mixin + (size_t)trow * DM + hq * 64 + 8 * rg + 4 * hh) = w;
      u32x2 w1; w1.x = pack_bf16(oacc1[rg * 4 + 0], oacc1[rg * 4 + 1]); w1.y = pack_bf16(oacc1[rg * 4 + 2], oacc1[rg * 4 + 3]);
      *(u32x2*)(mixin + (size_t)trow * DM + hq * 64 + 32 + 8 * rg + 4 * hh) = w1;
    }
  };
  ATT_LOAD_K()
  do_head(0);
  asm volatile("" ::: "memory");
  ATT_LOAD_K()
  do_head(1);
  }
  ssq += __shfl_xor(ssq, 32);
  if (lane < 32) ssqw[wid * 32 + lane] = ssq;
  __syncthreads();
  float tot = 0.f;
#pragma unroll
  for (int w = 0; w < 8; ++w) tot += ssqw[w * 32 + ql];
  const float ra = rsqrtf(tot * (1.f / 1024) + EPS);
#pragma unroll
  for (int hsel = 0; hsel < 2; ++hsel)
#pragma unroll
    for (int dt = 0; dt < 2; ++dt)
#pragma unroll
      for (int rg = 0; rg < 4; ++rg) {
        bf16_t* op = mixin + (size_t)trow * DM + (2 * wid + hsel) * 64 + 32 * dt + 8 * rg + 4 * hh;
        const u32x2 v = *(const u32x2*)op;
        u32x2 w; w.x = pack_bf16(bflo(v.x) * ra, bfhi(v.x) * ra); w.y = pack_bf16(bflo(v.y) * ra, bfhi(v.y) * ra);
        *(u32x2*)op = w;
      }
  __syncthreads();
}
#undef ATT_LOAD_Q
#undef ATT_LOAD_K
__device__ __forceinline__ void phase2_attn(const Params& p, unsigned char* lds, int bid, int nblk) {
  for (int item = bid; item < 256; item += nblk) attn_item(p, lds, item);
}

constexpr int SLD = 136;
__device__ __forceinline__ float conv_silu(const float (&raw)[11], int i, float w0, float w1, float w2, float w3, float cb) {
  return silu_f(cb + w0 * raw[i] + w1 * raw[i + 1] + w2 * raw[i + 2] + w3 * raw[i + 3]);
}
__device__ __forceinline__ void ssd_a_item(const Params& p, unsigned char* lds, int item) {
  const int tid = threadIdx.x, lane = tid & 63, wid = __builtin_amdgcn_readfirstlane(tid >> 6);
  const int b = item >> 6, c = (item >> 2) & 15, g = (item >> 1) & 1, hsel = item & 1;
  const int h0 = g * 8 + hsel * 4;
  const int t0 = b * SEQ + c * 128;
  bf16_t* Bc = (bf16_t*)lds;
  bf16_t* Cc = Bc + 128 * SLD;
  bf16_t* BcT = Cc + 128 * SLD;
  bf16_t* xT = BcT + 128 * SLD;
  float* dtl = (float*)(xT + 2 * 64 * SLD);
  float* acs = dtl + 512;
  float* wl = acs + 512;
  float* scan = wl + 512;
  const bf16_t* __restrict__ proj = (const bf16_t*)(p.ws + WS_PROJ);
  const bf16_t* __restrict__ projmb = (const bf16_t*)(p.ws + WS_PROJMB);
  const float* __restrict__ dtraw = (const float*)(p.ws + WS_DTRAW);
  float* __restrict__ acsg = (float*)(p.ws + WS_ACSG);
  bf16_t* __restrict__ ccb = (bf16_t*)(p.ws + WS_CCB);
  float* __restrict__ ypart = (float*)(p.ws + WS_YPART);
  float* __restrict__ sg = (float*)(p.ws + WS_SG);
  {
    const int hi = tid >> 7, l = tid & 127, h = h0 + hi;
    const float Ah = -expf(p.a_log[h]);
    const float dtv = softplus_f(dtraw[(size_t)(t0 + l) * 16 + h] + p.dt_bias[h]);
    dtl[tid] = dtv;
    float cum = dtv * Ah;
#pragma unroll
    for (int o = 1; o < 64; o <<= 1) { const float nb = __shfl_up(cum, o); if (lane >= o) cum += nb; }
    if ((tid & 127) == 63) scan[hi] = cum;
    __syncthreads();
    if (l >= 64) cum += scan[hi];
    acs[tid] = cum;
    acsg[(size_t)(t0 + l) * 16 + h] = cum;
    __syncthreads();
    wl[tid] = dtv * __expf(acs[hi * 128 + 127] - cum);
  }
#pragma unroll 1
  for (int rnd = 0; rnd < (REP_SUB == 4 ? 4 : 2); ++rnd) {
    float raw[4][11];
#pragma unroll
    for (int q = 0; q < 4; ++q) {
      const int task = ((rnd & 1) * 4 + q) * NTHREADS + tid;
      const int tg = task >> 8, ch = task & 255;
      const int cch = 1024 + (ch >> 7) * 256 + g * 128 + (ch & 127);
#pragma unroll
      for (int i = 0; i < 11; ++i) {
        const int l = tg * 8 + i - 3;
        const bf16_t* src = (l >= 0 || c > 0) ? proj + (size_t)(t0 + l) * NPROJ : projmb + (size_t)(16 + l) * DPROJ;
        raw[q][i] = bf2f(src[OFF_XBC + cch]);
      }
    }
#pragma unroll
    for (int q = 0; q < 4; ++q) {
      const int task = ((rnd & 1) * 4 + q) * NTHREADS + tid;
      const int tg = task >> 8, ch = task & 255, n = ch & 127;
      const int cch = 1024 + (ch >> 7) * 256 + g * 128 + n;
      const float w0 = p.conv_w[cch], w1 = p.conv_w[D_XBC + cch], w2 = p.conv_w[2 * D_XBC + cch], w3 = p.conv_w[3 * D_XBC + cch], cb = p.conv_b[cch];
      float o[8];
#pragma unroll
      for (int i = 0; i < 8; ++i) o[i] = conv_silu(raw[q], i, w0, w1, w2, w3, cb);
      if (ch < 128) {
#pragma unroll
        for (int i = 0; i < 8; ++i) Bc[(tg * 8 + i) * SLD + n] = f2bf(o[i]);
        u32x4 w; w.x = pack_bf16(o[0], o[1]); w.y = pack_bf16(o[2], o[3]); w.z = pack_bf16(o[4], o[5]); w.w = pack_bf16(o[6], o[7]);
        *(u32x4*)(BcT + n * SLD + tg * 8) = w;
      } else {
#pragma unroll
        for (int i = 0; i < 8; ++i) Cc[(tg * 8 + i) * SLD + n] = f2bf(o[i]);
      }
    }
  }
  float xraw[4][11];
#define SSD_LOAD_X(r_)                                                                                              \
  _Pragma("unroll") for (int q = 0; q < 4; ++q) {                                                                   \
    const int task = (q & 1) * NTHREADS + tid; const int tg = task >> 6, cch = (h0 + 2 * (r_) + (q >> 1)) * 64 + (task & 63); \
    _Pragma("unroll") for (int i = 0; i < 11; ++i) { const int l = tg * 8 + i - 3;                                  \
      const bf16_t* src = (l >= 0 || c > 0) ? proj + (size_t)(t0 + l) * NPROJ : projmb + (size_t)(16 + l) * DPROJ;  \
      xraw[q][i] = bf2f(src[OFF_XBC + cch]); } }
  SSD_LOAD_X(0)
  __syncthreads();
  if (hsel == 0) {
#pragma unroll
    for (int q = 0; q < 4; ++q) {
      const int idx = q * NTHREADS + tid, row = idx >> 4, ck = idx & 15;
      *(u32x4*)(ccb + (size_t)(t0 + row) * 256 + g * 128 + ck * 8) = *(const u32x4*)(Cc + row * SLD + ck * 8);
    }
  }
  const int ql = lane & 31, hh = lane >> 5;
  auto ydiag = [&](const int hi, const int il) __attribute__((always_inline)) {
    const int h = h0 + hi, ip = wid & 1;
    const bf16_t* xTb = xT + (hi & 1) * 64 * SLD;
    const float dskip = p.d_skip[h];
    const float* acsh = acs + hi * 128;
    const float* dtlh = dtl + hi * 128;
    const int l = 32 * il + ql;
    const float acl = acsh[l];
    f32x16 yacc;
#pragma unroll
    for (int r = 0; r < 16; ++r) yacc[r] = 0.f;
    const bf16_t* xrow = xTb + (32 * ip + ql) * SLD + 4 * hh;
#pragma unroll 1
    for (int is = 0; is <= il; ++is) {
      f32x16 x;
#pragma unroll
      for (int r = 0; r < 16; ++r) x[r] = 0.f;
      const bf16_t* ap = Bc + (32 * is + ql) * SLD + 8 * hh;
      const bf16_t* bp = Cc + l * SLD + 8 * hh;
#pragma unroll
      for (int ks = 0; ks < 8; ++ks) x = __builtin_amdgcn_mfma_f32_32x32x16_bf16(*(const bf16x8*)(ap + 16 * ks), *(const bf16x8*)(bp + 16 * ks), x, 0, 0, 0);
      u32x4 pw[2];
#pragma unroll
      for (int s2 = 0; s2 < 2; ++s2) {
        float mv[8];
#pragma unroll
        for (int q = 0; q < 2; ++q) {
          const int sb = 32 * is + 16 * s2 + 8 * q + 4 * hh;
          const f32x4 as4 = *(const f32x4*)(acsh + sb), dt4 = *(const f32x4*)(dtlh + sb);
#pragma unroll
          for (int j = 0; j < 4; ++j) {
            const int sr = sb + j;
            float v = sr <= l ? x[8 * s2 + 4 * q + j] * __expf(acl - as4[j]) * dt4[j] : 0.f;
            if (sr == l) v += dskip;
            mv[4 * q + j] = v;
          }
        }
        pw[s2].x = pack_bf16(mv[0], mv[1]); pw[s2].y = pack_bf16(mv[2], mv[3]); pw[s2].z = pack_bf16(mv[4], mv[5]); pw[s2].w = pack_bf16(mv[6], mv[7]);
      }
#pragma unroll
      for (int s2 = 0; s2 < 2; ++s2) {
        const u32x2 va = *(const u32x2*)(xrow + 32 * is + 16 * s2), vc = *(const u32x2*)(xrow + 32 * is + 16 * s2 + 8);
        u32x4 aw; aw.x = va.x; aw.y = va.y; aw.z = vc.x; aw.w = vc.y;
        yacc = __builtin_amdgcn_mfma_f32_32x32x16_bf16(*(bf16x8*)&aw, *(bf16x8*)&pw[s2], yacc, 0, 0, 0);
      }
    }
    float* yp = ypart + (size_t)(t0 + l) * 1024 + h * 64 + 32 * ip + 4 * hh;
#pragma unroll
    for (int rg = 0; rg < 4; ++rg) *(f32x4*)(yp + 8 * rg) = (f32x4){yacc[4 * rg], yacc[4 * rg + 1], yacc[4 * rg + 2], yacc[4 * rg + 3]};
  };
  auto states = [&](const int hi) __attribute__((always_inline)) {
    const int h = h0 + hi, ip = wid & 1, in = wid >> 1;
    const bf16_t* xTb = xT + (hi & 1) * 64 * SLD;
    const float* wlh = wl + hi * 128;
    f32x16 sacc;
#pragma unroll
    for (int r = 0; r < 16; ++r) sacc[r] = 0.f;
    const bf16_t* ap = xTb + (32 * ip + ql) * SLD + 8 * hh;
    const bf16_t* bp = BcT + (32 * in + ql) * SLD + 8 * hh;
#pragma unroll
    for (int ks = 0; ks < 8; ++ks) {
      const u32x4 xa = *(const u32x4*)(ap + 16 * ks);
      const f32x4 wa = *(const f32x4*)(wlh + 16 * ks + 8 * hh), wb = *(const f32x4*)(wlh + 16 * ks + 8 * hh + 4);
      u32x4 aw;
      aw.x = pack_bf16(bflo(xa.x) * wa[0], bfhi(xa.x) * wa[1]); aw.y = pack_bf16(bflo(xa.y) * wa[2], bfhi(xa.y) * wa[3]);
      aw.z = pack_bf16(bflo(xa.z) * wb[0], bfhi(xa.z) * wb[1]); aw.w = pack_bf16(bflo(xa.w) * wb[2], bfhi(xa.w) * wb[3]);
      sacc = __builtin_amdgcn_mfma_f32_32x32x16_bf16(*(bf16x8*)&aw, *(const bf16x8*)(bp + 16 * ks), sacc, 0, 0, 0);
    }
    float* sp = sg + ((size_t)((b * 16 + c) * 16 + h) * 64 + 32 * ip + 4 * hh) * 128 + 32 * in + ql;
#pragma unroll
    for (int r = 0; r < 16; ++r) sp[((r & 3) + 8 * (r >> 2)) * 128] = sacc[r];
  };
#pragma unroll 1
  for (int rnd_ = 0; rnd_ < (REP_SUB == 5 ? 4 : 2); ++rnd_) {
    const int rnd = rnd_ & 1;
#pragma unroll
    for (int q = 0; q < 4; ++q) {
      const int task = (q & 1) * NTHREADS + tid; const int tg = task >> 6, pch = task & 63, cch = (h0 + 2 * rnd + (q >> 1)) * 64 + pch;
      const float w0 = p.conv_w[cch], w1 = p.conv_w[D_XBC + cch], w2 = p.conv_w[2 * D_XBC + cch], w3 = p.conv_w[3 * D_XBC + cch], cb = p.conv_b[cch];
      float o[8];
#pragma unroll
      for (int i = 0; i < 8; ++i) o[i] = conv_silu(xraw[q], i, w0, w1, w2, w3, cb);
      u32x4 w; w.x = pack_bf16(o[0], o[1]); w.y = pack_bf16(o[2], o[3]); w.z = pack_bf16(o[4], o[5]); w.w = pack_bf16(o[6], o[7]);
      *(u32x4*)(xT + (q >> 1) * 64 * SLD + pch * SLD + tg * 8) = w;
    }
    { SSD_LOAD_X((rnd + 1) & 1) }
    __syncthreads();
    ydiag(2 * rnd, wid >> 1);
    ydiag(2 * rnd + 1, 3 - (wid >> 1));
    states(2 * rnd);
    states(2 * rnd + 1);
    __syncthreads();
  }
#undef SSD_LOAD_X
  __syncthreads();
}

__device__ __forceinline__ void meta_state_item(const Params& p, unsigned char* lds, int h) {
  const int tid = threadIdx.x, g = h >> 3;
  float* xm = (float*)lds;
  float* bm = xm + 16 * 64;
  float* dtm = bm + 16 * 128;
  const float* projm = (const float*)(p.ws + WS_PROJM);
  float* smeta = (float*)(p.ws + WS_SMETA);
  for (int task = tid; task < 16 * 192; task += NTHREADS) {
    const int i = task / 192, ch = task - i * 192;
    const int cch = ch < 64 ? h * 64 + ch : 1024 + g * 128 + (ch - 64);
    float acc = p.conv_b[cch];
#pragma unroll
    for (int j = 0; j < 4; ++j) { const int mi = i - j; if (mi >= 0) acc += p.conv_w[(3 - j) * D_XBC + cch] * projm[(size_t)mi * DPROJ + OFF_XBC + cch]; }
    const float v = silu_f(acc);
    if (ch < 64) xm[i * 64 + ch] = v; else bm[i * 128 + ch - 64] = v;
  }
  if (tid < 16) dtm[tid] = softplus_f(projm[(size_t)tid * DPROJ + OFF_DT + h] + p.dt_bias[h]);
  __syncthreads();
  const float Ah = -expf(p.a_log[h]);
  const int pr = tid >> 3, n0 = (tid & 7) * 16;
  float st[16];
#pragma unroll
  for (int k = 0; k < 16; ++k) st[k] = 0.f;
  for (int i = 0; i < 16; ++i) {
    const float dtv = dtm[i], dA = expf(dtv * Ah), xdt = xm[i * 64 + pr] * dtv;
#pragma unroll
    for (int k = 0; k < 16; ++k) st[k] = fmaf(st[k], dA, xdt * bm[i * 128 + n0 + k]);
  }
#pragma unroll
  for (int k = 0; k < 16; ++k) smeta[(size_t)(h * 64 + pr) * 128 + n0 + k] = st[k];
  __syncthreads();
}

__device__ __forceinline__ void phase2(const Params& p, unsigned char* lds, int bid, int nblk) {
#pragma unroll 1
  for (int rep = 0; rep < (REP_SUB == 0 ? 2 : 1); ++rep)
    for (int item = bid; item < 256; item += nblk) attn_item(p, lds, item);
#pragma unroll 1
  for (int rep = 0; rep < (REP_SUB == 1 ? 2 : 1); ++rep)
    for (int item = bid; item < 256; item += nblk) ssd_a_item(p, lds, item);
  for (int item = bid; item < 16; item += nblk) meta_state_item(p, lds, item);
}

__device__ __forceinline__ void phase_scan(const Params& p, int bid, int nblk) {
  const float* __restrict__ sg = (const float*)(p.ws + WS_SG);
  const float* __restrict__ smeta = (const float*)(p.ws + WS_SMETA);
  const float* __restrict__ acsg = (const float*)(p.ws + WS_ACSG);
  bf16_t* __restrict__ hprev = (bf16_t*)(p.ws + WS_HPREV);
  for (int task = bid * NTHREADS + threadIdx.x; task < 64 * 2048; task += nblk * NTHREADS) {
    const int bh = task >> 11, e4 = (task & 2047) * 4;
    const int b = bh >> 4, h = bh & 15;
    f32x4 sv[16];
    float dv[16];
#pragma unroll
    for (int c = 0; c < 16; ++c) {
      sv[c] = *(const f32x4*)(sg + (size_t)((b * 16 + c) * 16 + h) * 8192 + e4);
      dv[c] = acsg[(size_t)(b * SEQ + c * 128 + 127) * 16 + h];
    }
    f32x4 H = *(const f32x4*)(smeta + (size_t)h * 8192 + e4);
#pragma unroll
    for (int c = 0; c < 16; ++c) {
      u32x2 w; w.x = pack_bf16(H[0], H[1]); w.y = pack_bf16(H[2], H[3]);
      *(u32x2*)(hprev + (size_t)((b * 16 + c) * 16 + h) * 8192 + e4) = w;
      H = H * __expf(dv[c]) + sv[c];
    }
  }
}

__device__ __forceinline__ void ssd_b_item(const Params& p, unsigned char* lds, int item) {
  const int tid = threadIdx.x, lane = tid & 63, wid = __builtin_amdgcn_readfirstlane(tid >> 6);
  const int b = item >> 6, c = (item >> 2) & 15, g = (item >> 1) & 1, lh = item & 1, h = g * 8 + wid;
  const int t0 = b * SEQ + c * 128 + lh * 64;
  const int ql = lane & 31, hh = lane >> 5;
  constexpr int YLD = 520;
  bf16_t* yoff = (bf16_t*)lds;
  const bf16_t* __restrict__ proj = (const bf16_t*)(p.ws + WS_PROJ);
  const float* __restrict__ acsg = (const float*)(p.ws + WS_ACSG);
  const bf16_t* __restrict__ ccb = (const bf16_t*)(p.ws + WS_CCB);
  const float* __restrict__ ypart = (const float*)(p.ws + WS_YPART);
  const bf16_t* __restrict__ hprev = (const bf16_t*)(p.ws + WS_HPREV);
  bf16_t* __restrict__ mixin = (bf16_t*)(p.ws + WS_HNB);
  {
    const bf16_t* hp = hprev + (size_t)((b * 16 + c) * 16 + h) * 8192 + (size_t)ql * 128 + 8 * hh;
    u32x4 hf0[8], hf1[8];
#pragma unroll
    for (int ks = 0; ks < 8; ++ks) { hf0[ks] = *(const u32x4*)(hp + 16 * ks); hf1[ks] = *(const u32x4*)(hp + 32 * 128 + 16 * ks); }
#pragma unroll
    for (int il = 0; il < 2; ++il) {
      const int lt = 32 * il + ql, t = t0 + lt;
      const bf16_t* cp = ccb + (size_t)t * 256 + g * 128 + 8 * hh;
      u32x4 cf[8];
#pragma unroll
      for (int ks = 0; ks < 8; ++ks) cf[ks] = *(const u32x4*)(cp + 16 * ks);
      const float ea = __expf(acsg[(size_t)t * 16 + h]);
      f32x16 a0, a1;
#pragma unroll
      for (int r = 0; r < 16; ++r) { a0[r] = 0.f; a1[r] = 0.f; }
#pragma unroll
      for (int ks = 0; ks < 8; ++ks) {
        a0 = __builtin_amdgcn_mfma_f32_32x32x16_bf16(*(bf16x8*)&hf0[ks], *(bf16x8*)&cf[ks], a0, 0, 0, 0);
        a1 = __builtin_amdgcn_mfma_f32_32x32x16_bf16(*(bf16x8*)&hf1[ks], *(bf16x8*)&cf[ks], a1, 0, 0, 0);
      }
      bf16_t* yr = yoff + lt * YLD + wid * 64 + 4 * hh;
#pragma unroll
      for (int rg = 0; rg < 4; ++rg) {
        u32x2 w0; w0.x = pack_bf16(ea * a0[4 * rg], ea * a0[4 * rg + 1]); w0.y = pack_bf16(ea * a0[4 * rg + 2], ea * a0[4 * rg + 3]);
        u32x2 w1; w1.x = pack_bf16(ea * a1[4 * rg], ea * a1[4 * rg + 1]); w1.y = pack_bf16(ea * a1[4 * rg + 2], ea * a1[4 * rg + 3]);
        *(u32x2*)(yr + 8 * rg) = w0;
        *(u32x2*)(yr + 32 + 8 * rg) = w1;
      }
    }
  }
  __syncthreads();
#pragma unroll
  for (int bt = 0; bt < 2; ++bt) {
    f32x4 ya[4], yb[4]; u32x4 zz[4], yo[4];
#pragma unroll
    for (int q = 0; q < 4; ++q) {
      const int lt = wid * 8 + bt * 4 + q, t = t0 + lt;
      const float* yp = ypart + (size_t)t * 1024 + g * 512 + lane * 8;
      ya[q] = *(const f32x4*)yp; yb[q] = *(const f32x4*)(yp + 4);
      zz[q] = *(const u32x4*)(proj + (size_t)t * NPROJ + OFF_Z + g * 512 + lane * 8);
      yo[q] = *(const u32x4*)(yoff + lt * YLD + lane * 8);
    }
#pragma unroll
    for (int q = 0; q < 4; ++q) {
      const int t = t0 + wid * 8 + bt * 4 + q;
      float zv[8], ov[8], y[8];
      unpack8(zz[q], zv); unpack8(yo[q], ov);
      y[0] = (ya[q][0] + ov[0]) * silu_f(zv[0]); y[1] = (ya[q][1] + ov[1]) * silu_f(zv[1]);
      y[2] = (ya[q][2] + ov[2]) * silu_f(zv[2]); y[3] = (ya[q][3] + ov[3]) * silu_f(zv[3]);
      y[4] = (yb[q][0] + ov[4]) * silu_f(zv[4]); y[5] = (yb[q][1] + ov[5]) * silu_f(zv[5]);
      y[6] = (yb[q][2] + ov[6]) * silu_f(zv[6]); y[7] = (yb[q][3] + ov[7]) * silu_f(zv[7]);
      float ss = 0.f;
#pragma unroll
      for (int i = 0; i < 8; ++i) ss += y[i] * y[i];
      ss = wave_sum(ss);
      const float rn = rsqrtf(ss * (1.f / 512) + EPS);
      u32x4 w; w.x = pack_bf16(y[0] * rn, y[1] * rn); w.y = pack_bf16(y[2] * rn, y[3] * rn); w.z = pack_bf16(y[4] * rn, y[5] * rn); w.w = pack_bf16(y[6] * rn, y[7] * rn);
      *(u32x4*)(mixin + (size_t)t * DM + 1024 + g * 512 + lane * 8) = w;
    }
  }
  __syncthreads();
}
__device__ __forceinline__ void phase3(const Params& p, unsigned char* lds, int bid, int nblk) {
  for (int item = bid; item < 256; item += nblk) ssd_b_item(p, lds, item);
}

constexpr int LDS_BYTES = 144 * 1024;

typedef const Params __attribute__((address_space(4))) * KArgPtr;
__device__ __forceinline__ Params load_params(KArgPtr k) {
  Params q;
#if defined(__HIP_DEVICE_COMPILE__)
  __builtin_memcpy(&q, k, sizeof(Params));
#endif
  return q;
}
#define PARAMS_PTR(pp) KArgPtr pp##_k = (KArgPtr)__builtin_amdgcn_kernarg_segment_ptr(); asm volatile("" : "+s"(pp##_k)); const Params pp##_v = load_params(pp##_k); const Params* pp = &pp##_v
__global__ __launch_bounds__(512, 2) void k_mega(Params p_unused) {
  extern __shared__ __attribute__((aligned(16))) unsigned char shm[];
  const int bid = blockIdx.x, nblk = gridDim.x;
  volatile LAS unsigned* xst = (volatile LAS unsigned*)(LAS unsigned char*)(shm + LDS_BYTES - 16);
  if (threadIdx.x == 0) { xst[0] = 0u; xst[1] = 0u; }
  __syncthreads();
  XcdBarrier xb;
  { PARAMS_PTR(pp); xb = xcd_barrier_post((unsigned*)(pp->ws + WS_CTL), xst); }
#ifndef REP_PHASE
#define REP_PHASE -1
#endif
#define NREP(k) ((REP_PHASE == (k)) ? 2 : 1)
#ifndef REP_ALL
#define REP_ALL 1
#endif
#pragma unroll 1
  for (int pass = 0; pass < REP_ALL; ++pass) {
  if (pass) xcd_barrier(xb);
#pragma unroll 1
  for (int rep = 0; rep < NREP(0); ++rep) { { PARAMS_PTR(pp); phase0(*pp, (float*)shm, bid, nblk); } if (rep + 1 < NREP(0)) xcd_barrier(xb); }
  xcd_barrier(xb);
#pragma unroll 1
  for (int rep = 0; rep < NREP(1); ++rep) { { PARAMS_PTR(pp); phase1(*pp, shm, bid, nblk); } xcd_barrier(xb); }
#pragma unroll 1
  for (int rep = 0; rep < NREP(2); ++rep) { { PARAMS_PTR(pp); phase2(*pp, shm, bid, nblk); } xcd_barrier(xb); }
#pragma unroll 1
  for (int rep = 0; rep < NREP(7); ++rep) { { PARAMS_PTR(pp); phase_scan(*pp, bid, nblk); } xcd_barrier(xb); }
#pragma unroll 1
  for (int rep = 0; rep < NREP(3); ++rep) { { PARAMS_PTR(pp); phase3(*pp, shm, bid, nblk); } xcd_barrier(xb); }
#pragma unroll 1
  for (int rep = 0; rep < NREP(4); ++rep) { { PARAMS_PTR(pp); phase4(*pp, shm, bid, nblk); } xcd_barrier(xb); }
#pragma unroll 1
  for (int rep = 0; rep < NREP(5); ++rep) { { PARAMS_PTR(pp); phase5(*pp, shm, bid, nblk); } xcd_barrier(xb); }
#pragma unroll 1
  for (int rep = 0; rep < NREP(6); ++rep) { { PARAMS_PTR(pp); phase6(*pp, shm, bid, nblk); } if (rep + 1 < NREP(6)) xcd_barrier(xb); }
  }
}

}

extern "C" void kernel_launch(void* const* d_in, const int* in_sizes, int n_in, void* d_out, int out_size, void* d_ws,
                              size_t ws_size, hipStream_t stream) {
  Params p{};
  p.x = (const float*)d_in[0]; p.meta = (const float*)d_in[1]; p.rel_bias = (const float*)d_in[2];
  p.ln_mix = (const float*)d_in[3]; p.w_in = (const float*)d_in[4]; p.sinks = (const float*)d_in[5];
  p.conv_w = (const float*)d_in[6]; p.conv_b = (const float*)d_in[7]; p.dt_bias = (const float*)d_in[8];
  p.a_log = (const float*)d_in[9]; p.d_skip = (const float*)d_in[10]; p.attn_norm_w = (const float*)d_in[11];
  p.ssm_norm_w = (const float*)d_in[12]; p.w_out = (const float*)d_in[13]; p.ln_ffn = (const float*)d_in[14];
  p.wq = (const float*)d_in[15]; p.keys = (const float*)d_in[16]; p.U = (const float*)d_in[17];
  p.V = (const float*)d_in[18]; p.ln_final = (const float*)d_in[19];
  p.out = (float*)d_out;
  p.ws = (unsigned char*)d_ws;

  static int grid_blocks = 0;
  if (!grid_blocks) {
    int dev = 0, cus = 0, per_cu = 0;
    (void)hipGetDevice(&dev);
    (void)hipDeviceGetAttribute(&cus, hipDeviceAttributeMultiprocessorCount, dev);
    (void)hipFuncSetAttribute((const void*)k_mega, hipFuncAttributeMaxDynamicSharedMemorySize, LDS_BYTES);
    (void)hipOccupancyMaxActiveBlocksPerMultiprocessor(&per_cu, (const void*)k_mega, NTHREADS, LDS_BYTES);
    if (per_cu > 1) per_cu = 1;
    grid_blocks = cus * per_cu;
    if (grid_blocks != 256) fprintf(stderr, "kernel_launch: expected a 256-workgroup resident grid, got %d (cus %d, per_cu %d)\n", grid_blocks, cus, per_cu);
  }
  (void)hipMemsetAsync(p.ws + WS_CTL, 0, XCD_BAR_WORDS * 4, stream);
  void* args[] = {&p};
  hipError_t e = hipLaunchCooperativeKernel((const void*)k_mega, dim3(grid_blocks), dim3(NTHREADS), args, LDS_BYTES, stream);
  if (e != hipSuccess) fprintf(stderr, "cooperative launch failed: %s (grid %d)\n", hipGetErrorString(e), grid_blocks);
}
```

```cpp
#include <hip/hip_runtime.h>
#include <math.h>
#include <stdio.h>
#include <stdint.h>

#ifndef REP_SUB
#define REP_SUB -1
#endif
namespace {
constexpr int BATCH = 4, SEQ = 2048, DM = 2048, NMETA = 16;
constexpr int T = BATCH * SEQ;
constexpr int TA = T + NMETA;
constexpr int DPROJ = 4112;
constexpr int NPROJ = 4096;
constexpr int OFF_Q = 0, OFF_K = 1024, OFF_V = 1280, OFF_Z = 1536, OFF_XBC = 2560, OFF_DT = 4096;
constexpr int D_XBC = 1536;
constexpr int NEXP = 16384;
constexpr int ROW4 = 1024;
constexpr int ROW6 = 1536;
constexpr float EPS = 1e-6f;
constexpr int NTHREADS = 512;

typedef unsigned short bf16_t;
typedef short bf16x8 __attribute__((ext_vector_type(8)));
typedef float f32x4 __attribute__((ext_vector_type(4)));
typedef float f32x2 __attribute__((ext_vector_type(2)));
typedef unsigned u32x4 __attribute__((ext_vector_type(4)));
typedef unsigned u32x2 __attribute__((ext_vector_type(2)));
typedef __bf16 bf16v2 __attribute__((ext_vector_type(2)));
typedef float f32x16v __attribute__((ext_vector_type(16)));
typedef float f32x32v __attribute__((ext_vector_type(32)));
typedef unsigned u32x6 __attribute__((ext_vector_type(6)));
#define LAS __attribute__((address_space(3)))

__device__ __forceinline__ unsigned pack_bf16(float lo, float hi) {
  f32x2 v = {lo, hi};
  bf16v2 b = __builtin_convertvector(v, bf16v2);
  return *(unsigned*)&b;
}
__device__ __forceinline__ bf16_t f2bf(float f) { return (bf16_t)(pack_bf16(f, 0.f) & 0xffffu); }
__device__ __forceinline__ float bf2f(bf16_t b) { return __uint_as_float(((unsigned)b) << 16); }
__device__ __forceinline__ float bflo(unsigned u) { return __uint_as_float(u << 16); }
__device__ __forceinline__ float bfhi(unsigned u) { return __uint_as_float(u & 0xffff0000u); }

__constant__ unsigned char kBucket[128] = {
    0, 1, 2, 3, 4, 5, 6, 7, 8, 9, 10, 11, 12, 13, 14, 15, 16, 16, 16, 17, 17, 18, 18, 18, 19, 19, 19, 20, 20, 20, 20, 21,
    21, 21, 21, 22, 22, 22, 22, 22, 23, 23, 23, 23, 23, 23, 24, 24, 24, 24, 24, 24, 25, 25, 25, 25, 25, 25, 25, 26, 26, 26, 26, 26,
    26, 26, 26, 27, 27, 27, 27, 27, 27, 27, 27, 27, 27, 28, 28, 28, 28, 28, 28, 28, 28, 28, 28, 29, 29, 29, 29, 29, 29, 29, 29, 29,
    29, 29, 29, 30, 30, 30, 30, 30, 30, 30, 30, 30, 30, 30, 30, 30, 30, 31, 31, 31, 31, 31, 31, 31, 31, 31, 31, 31, 31, 31, 31, 31};

__constant__ unsigned char kCandI[64] = {0, 0, 0, 0, 0, 0, 0, 0, 0, 0, 0, 0, 0, 0, 0, 0, 1, 1, 1, 1, 1, 1, 1, 1, 2, 2, 2, 2, 2, 3, 3, 3, 3, 4, 4, 4, 5, 5, 6, 6, 7, 7, 8, 9, 10, 11, 12, 13, 14, 15, 15, 15, 15, 15, 15, 15, 15, 15, 15, 15, 15, 15, 15, 15};
__constant__ unsigned char kCandJ[64] = {0, 1, 2, 3, 4, 5, 6, 7, 8, 9, 10, 11, 12, 13, 14, 15, 0, 1, 2, 3, 4, 5, 6, 7, 0, 1, 2, 3, 4, 0, 1, 2, 3, 0, 1, 2, 0, 1, 0, 1, 0, 1, 0, 0, 0, 0, 0, 0, 0, 0, 15, 15, 15, 15, 15, 15, 15, 15, 15, 15, 15, 15, 15, 15};

__device__ __forceinline__ float wave_sum(float v) {
  for (int o = 32; o > 0; o >>= 1) v += __shfl_xor(v, o);
  return v;
}
__device__ __forceinline__ float wave_max(float v) {
  for (int o = 32; o > 0; o >>= 1) v = fmaxf(v, __shfl_xor(v, o));
  return v;
}
__device__ __forceinline__ float silu_f(float x) { return x / (1.f + expf(-x)); }
__device__ __forceinline__ float softplus_f(float x) { return fmaxf(x, 0.f) + log1pf(expf(-fabsf(x))); }

constexpr size_t al256(size_t x) { return (x + 255) & ~(size_t)255; }
constexpr size_t WS_CTL = 0;
constexpr size_t WS_WINT = 65536;
constexpr size_t WS_WDTT = WS_WINT + (size_t)NPROJ * DM * 2;
constexpr size_t WS_WOUTT = WS_WDTT + (size_t)16 * DM * 2;
constexpr size_t WS_WQT = WS_WOUTT + (size_t)DM * DM * 2;
constexpr size_t WS_KEYS = WS_WQT + (size_t)DM * DM * 2;
constexpr size_t WS_UB = WS_KEYS + (size_t)16 * 128 * 128 * 2;
constexpr size_t WS_VB = WS_UB + (size_t)NEXP * DM * 2;
constexpr size_t WS_HNB = WS_VB + (size_t)NEXP * DM * 2;
constexpr size_t WS_PROJ = WS_HNB + (size_t)(T + 16) * DM * 2;
constexpr size_t WS_DTRAW = WS_PROJ + (size_t)T * NPROJ * 2;
constexpr size_t WS_PROJM = WS_DTRAW + (size_t)T * 16 * 4;
constexpr size_t WS_PROJMB = al256(WS_PROJM + (size_t)16 * DPROJ * 4);
constexpr size_t WS_H1B = al256(WS_PROJMB + (size_t)16 * DPROJ * 2);
constexpr size_t WS_SSQH1 = WS_H1B + (size_t)T * DM * 2;
constexpr size_t WS_STOP = al256(WS_SSQH1 + (size_t)T * 32 * 4);
constexpr size_t WS_ITOP = WS_STOP + (size_t)T * 256 * 4;
constexpr size_t WS_ACSG = al256(WS_ITOP + (size_t)T * 256 * 4);
constexpr size_t WS_CCB = WS_ACSG + (size_t)T * 16 * 4;
constexpr size_t WS_YPART = WS_CCB + (size_t)T * 256 * 2;
constexpr size_t WS_SG = WS_YPART + (size_t)T * 1024 * 4;
constexpr size_t WS_SMETA = WS_SG + (size_t)1024 * 8192 * 4;
constexpr size_t WS_HPREV = al256(WS_SMETA + (size_t)16 * 8192 * 4);
constexpr size_t WS_USC = al256(WS_HPREV + (size_t)1024 * 8192 * 2);
constexpr size_t WS_VSC = WS_USC + (size_t)NEXP * 4;
constexpr size_t WS_SCR = al256(WS_VSC + (size_t)NEXP * 4);
}

namespace pg8 {
#define PG8_LAS __attribute__((address_space(3)))
constexpr int BM = 256, BK = 64, HALF = 128, HTB = HALF * BK * 2, STAGE_BYTES = 8 * HTB, NXCD = 8, WGM = 8;
__host__ __device__ __forceinline__ int lds_byte(int r, int c) { const int st = (r >> 4) * 2 + (c >> 5), rr = r & 15, cc = c & 31, ob = rr * 64 + cc * 2; return st * 1024 + (ob ^ (((ob >> 9) & 1) << 5)); }
__host__ __device__ __forceinline__ void stage_rc(int b, int& R, int& C) { const int st = b / 1024, sb = b % 1024, swz = sb ^ (((sb >> 9) & 1) << 5); R = (st >> 1) * 16 + swz / 64; C = (st & 1) * 32 + (swz % 64) / 2; }
__host__ __device__ __forceinline__ int perm32(int rho) { const int n = rho >> 4, i = rho & 15; return 8 * (i >> 2) + 4 * n + (i & 3); }
struct Unit { int pm, pn; };
struct Gemm { const bf16_t* A; const bf16_t* Bt; int M, N, K; };
struct StaticOrder {
    int nM, nN, nwg, G, c;
    __host__ __device__ void init(int M, int N, int G_, int c_) { nM = M / BM; nN = N / BM; nwg = nM * nN; G = G_; c = c_; }
    __host__ __device__ bool next(int i, Unit& u) const {
        const long L = (long)i * G + c; if (L >= nwg) return false;
        int wgid = (int)L; { const int q = nwg / NXCD, r = nwg % NXCD, xcd = wgid % NXCD, off = wgid / NXCD; wgid = (xcd < r ? xcd * (q + 1) : r * (q + 1) + (xcd - r) * q) + off; }
        const int nig = WGM * nN, gid = wgid / nig, fm = gid * WGM, gsz = (nM - fm) < WGM ? (nM - fm) : WGM;
        u.pm = fm + ((wgid % nig) % gsz); u.pn = (wgid % nig) / gsz; return true;
    }
    __device__ __forceinline__ void a_ready(const Unit&) const {}
    __device__ __forceinline__ void done(const Unit&) const {}
};
struct EpiBf16 {
    static constexpr bool PERM = true, AFTER_DRAIN = false;
    bf16_t* O; int ldc;
    __device__ __forceinline__ void operator()(const f32x4 (&acc)[2][2][4][2], const Unit& u, int wr, int wc, int fr, int fq) const {
        const int row0 = u.pm * BM + wr * 64 + fr; const int col0 = u.pn * BM + wc * 32 + 8 * fq;
#pragma unroll
        for (int ai = 0; ai < 2; ++ai)
#pragma unroll
            for (int m = 0; m < 4; ++m) { bf16_t* rowp = O + (size_t)(row0 + ai * HALF + m * 16) * ldc + col0;
#pragma unroll
                for (int bj = 0; bj < 2; ++bj) { const f32x4 v0 = acc[ai][bj][m][0], v1 = acc[ai][bj][m][1];
                    u32x4 w; w.x = pack_bf16(v0[0], v0[1]); w.y = pack_bf16(v0[2], v0[3]); w.z = pack_bf16(v1[0], v1[1]); w.w = pack_bf16(v1[2], v1[3]);
                    *(u32x4*)(rowp + bj * HALF) = w; } }
    }
};

struct EpiRes {
    static constexpr bool PERM = true, AFTER_DRAIN = false;
    const float* X; bf16_t* HB; float* SSQ;
    __device__ __forceinline__ void operator()(const f32x4 (&acc)[2][2][4][2], const Unit& u, int wr, int wc, int fr, int fq) const {
        const int row0 = u.pm * BM + wr * 64 + fr; const int col0 = u.pn * BM + wc * 32 + 8 * fq;
#pragma unroll
        for (int ai = 0; ai < 2; ++ai)
#pragma unroll
            for (int m = 0; m < 4; ++m) { const int row = row0 + ai * HALF + m * 16; const size_t off = (size_t)row * DM + col0; float ss = 0.f;
#pragma unroll
                for (int bj = 0; bj < 2; ++bj) {
                    const f32x4 x0 = *(const f32x4*)(X + off + bj * HALF), x1 = *(const f32x4*)(X + off + bj * HALF + 4);
                    const f32x4 v0 = acc[ai][bj][m][0] + x0, v1 = acc[ai][bj][m][1] + x1;
                    u32x4 w; w.x = pack_bf16(v0[0], v0[1]); w.y = pack_bf16(v0[2], v0[3]); w.z = pack_bf16(v1[0], v1[1]); w.w = pack_bf16(v1[2], v1[3]);
                    *(u32x4*)(HB + off + bj * HALF) = w;
                    ss += v0[0] * v0[0] + v0[1] * v0[1] + v0[2] * v0[2] + v0[3] * v0[3] + v1[0] * v1[0] + v1[1] * v1[1] + v1[2] * v1[2] + v1[3] * v1[3]; }
                ss += __shfl_xor(ss, 16); ss += __shfl_xor(ss, 32);
                if (fq == 0) SSQ[(size_t)row * 32 + u.pn * 4 + wc] = ss; }
    }
};
struct EpiF32 {
    static constexpr bool PERM = true, AFTER_DRAIN = false;
    float* C; int ldc;
    __device__ __forceinline__ void operator()(const f32x4 (&acc)[2][2][4][2], const Unit& u, int wr, int wc, int fr, int fq) const {
        const int row0 = u.pm * BM + wr * 64 + fr; const int col0 = u.pn * BM + wc * 32 + 8 * fq;
#pragma unroll
        for (int ai = 0; ai < 2; ++ai)
#pragma unroll
            for (int m = 0; m < 4; ++m) { float* rowp = C + (size_t)(row0 + ai * HALF + m * 16) * ldc + col0;
#pragma unroll
                for (int bj = 0; bj < 2; ++bj) { *(f32x4*)(rowp + bj * HALF) = acc[ai][bj][m][0]; *(f32x4*)(rowp + bj * HALF + 4) = acc[ai][bj][m][1]; } }
    }
};

struct EpiScores {
    static constexpr bool PERM = true, AFTER_DRAIN = true;
    const bf16_t* KEYS;
    float* STOP; int* ITOP;
    static constexpr int QLD = 264;
    __device__ __forceinline__ void fused(f32x4 (&acc)[2][2][4][2], const Unit& u, int wr, int wc, int fr, int fq, PG8_LAS unsigned char* lds, int wid, int lane) const {
        PG8_LAS bf16_t* Q = (PG8_LAS bf16_t*)lds;
#pragma unroll
        for (int ai = 0; ai < 2; ++ai)
#pragma unroll
            for (int m = 0; m < 4; ++m) { const int row = ai * HALF + wr * 64 + m * 16 + fr;
#pragma unroll
                for (int bj = 0; bj < 2; ++bj) { const f32x4 v0 = acc[ai][bj][m][0], v1 = acc[ai][bj][m][1];
                    u32x4 w; w.x = pack_bf16(v0[0], v0[1]); w.y = pack_bf16(v0[2], v0[3]); w.z = pack_bf16(v1[0], v1[1]); w.w = pack_bf16(v1[2], v1[3]);
                    *(PG8_LAS u32x4*)(Q + row * QLD + bj * HALF + wc * 32 + 8 * fq) = w; } }
        __syncthreads();
        const int h = u.pn;
#pragma unroll 1
        for (int c = 0; c < 2; ++c) {
            f32x4 sc[8][2];
#pragma unroll
            for (int kf = 0; kf < 8; ++kf) { sc[kf][0] = (f32x4){0.f, 0.f, 0.f, 0.f}; sc[kf][1] = (f32x4){0.f, 0.f, 0.f, 0.f}; }
            const bf16_t* kb = KEYS + (size_t)((h * 2 + c) * 128 + fr) * 128 + 8 * fq;
            const PG8_LAS bf16_t* qb = Q + (wid * 32 + fr) * QLD + c * 128 + 8 * fq;
#pragma unroll
            for (int ks = 0; ks < 4; ++ks) {
                const bf16x8 q0 = *(const PG8_LAS bf16x8*)(qb + 32 * ks), q1 = *(const PG8_LAS bf16x8*)(qb + 16 * QLD + 32 * ks);
#pragma unroll
                for (int kf = 0; kf < 8; ++kf) { const bf16x8 kv = *(const bf16x8*)(kb + (size_t)kf * 16 * 128 + 32 * ks);
                    sc[kf][0] = __builtin_amdgcn_mfma_f32_16x16x32_bf16(kv, q0, sc[kf][0], 0, 0, 0);
                    sc[kf][1] = __builtin_amdgcn_mfma_f32_16x16x32_bf16(kv, q1, sc[kf][1], 0, 0, 0); }
            }
#pragma unroll
            for (int tf = 0; tf < 2; ++tf) {
                int v[32];
#pragma unroll
                for (int kf = 0; kf < 8; ++kf)
#pragma unroll
                    for (int r = 0; r < 4; ++r) {
                        const int bts = (int)__float_as_uint(sc[kf][tf][r]);
                        const int srt = bts ^ ((bts >> 31) & 0x7fffffff);
                        v[kf * 4 + r] = (srt & ~127) | (16 * kf + 4 * fq + r);
                    }
#pragma unroll
                for (int k = 2; k <= 32; k <<= 1)
#pragma unroll
                    for (int j = k >> 1; j > 0; j >>= 1)
#pragma unroll
                        for (int i = 0; i < 32; ++i) {
                            const int l = i ^ j;
                            if (l > i) {
                                const int x = v[i], y = v[l];
                                const int hi_ = x > y ? x : y, lo_ = x > y ? y : x;
                                if ((i & k) == 0) { v[i] = hi_; v[l] = lo_; } else { v[i] = lo_; v[l] = hi_; }
                            }
                        }
#pragma unroll
                for (int step = 0; step < 2; ++step) {
                    const int xm = step == 0 ? 16 : 32;
                    int m[16];
#pragma unroll
                    for (int i = 0; i < 16; ++i) { const int o = __shfl_xor(v[15 - i], xm); m[i] = v[i] > o ? v[i] : o; }
#pragma unroll
                    for (int j = 8; j > 0; j >>= 1)
#pragma unroll
                        for (int i = 0; i < 16; ++i) {
                            const int l = i ^ j;
                            if (l > i) { const int x = m[i], y = m[l]; m[i] = x > y ? x : y; m[l] = x > y ? y : x; }
                        }
#pragma unroll
                    for (int i = 0; i < 16; ++i) v[i] = m[i];
                }
                if (fq == 0) {
                    const size_t obase = ((size_t)(u.pm * BM + wid * 32 + tf * 16 + fr) * 16 + h * 2 + c) * 16;
#pragma unroll
                    for (int q4 = 0; q4 < 4; ++q4) {
                        f32x4 sv; u32x4 iv;
#pragma unroll
                        for (int i = 0; i < 4; ++i) {
                            const int key = v[4 * q4 + i], srt = key & ~127;
                            sv[i] = __uint_as_float((unsigned)(srt ^ ((srt >> 31) & 0x7fffffff)));
                            iv[i] = (unsigned)(key & 127);
                        }
                        *(f32x4*)(STOP + obase + 4 * q4) = sv;
                        *(u32x4*)(ITOP + obase + 4 * q4) = iv;
                    }
                }
            }
        }
    }
};

template <class Epi, class Sched>
__device__ __forceinline__ void gemm_phase(PG8_LAS unsigned char* lds, const Gemm g, const Sched& S, const Epi& E) {
    int tid_ = threadIdx.x; asm volatile("" : "+v"(tid_));
    const int tid = tid_, wid = __builtin_amdgcn_readfirstlane(tid >> 6), lane = tid & 63, wr = wid >> 2, wc = wid & 3, fr = lane & 15, fq = lane >> 4;
    const int K = g.K, nt = K / BK;
    unsigned voffA[2], voffB[2];
#pragma unroll
    for (int i = 0; i < 2; ++i) { int R, C; stage_rc(tid * 16 + i * 8192, R, C); const int Rb = Epi::PERM ? ((R & ~31) + perm32(R & 31)) : R;
        voffA[i] = (unsigned)(R * K + C) * 2u; voffB[i] = (unsigned)(Rb * K + C) * 2u; }
    const size_t kstep = (size_t)(BK * 2);
    const size_t hstep = (size_t)HALF * K * 2;
    const size_t tstep = 2 * hstep;
    const unsigned ldsw = (unsigned)wid * 1024u;
    const int aoff = lds_byte(wr * 64 + fr, fq * 8), boff = lds_byte(wc * 32 + fr, fq * 8);
#define PG8_SA(b, h) (((b) * 2 + (h)) * HTB)
#define PG8_SB(b, h) ((4 + (b) * 2 + (h)) * HTB)
#define PG8_STAGE(bufoff, gbase, voff) do { _Pragma("unroll") for (int _i = 0; _i < 2; ++_i) \
        __builtin_amdgcn_global_load_lds((const unsigned*)((const char*)(gbase) + (voff)[_i]), (PG8_LAS unsigned*)(lds + (bufoff) + ldsw + _i * 8192), 16, 0, 0); } while (0)
#define PG8_LDA(dst, b, h) do { _Pragma("unroll") for (int m = 0; m < 4; ++m) _Pragma("unroll") for (int k = 0; k < 2; ++k) dst[m][k] = *(const PG8_LAS bf16x8*)(lds + PG8_SA(b, h) + aoff + m * 2048 + k * 1024); } while (0)
#define PG8_LDB(dst, b, h) do { _Pragma("unroll") for (int n = 0; n < 2; ++n) _Pragma("unroll") for (int k = 0; k < 2; ++k) dst[n][k] = *(const PG8_LAS bf16x8*)(lds + PG8_SB(b, h) + boff + n * 2048 + k * 1024); } while (0)
#define PG8_MMA(ai, bj, At, Bt) do { __builtin_amdgcn_s_setprio(1); _Pragma("unroll") for (int m = 0; m < 4; ++m) _Pragma("unroll") for (int n = 0; n < 2; ++n) _Pragma("unroll") for (int k = 0; k < 2; ++k) \
        acc[ai][bj][m][n] = __builtin_amdgcn_mfma_f32_16x16x32_bf16(Bt[n][k], At[m][k], acc[ai][bj][m][n], 0, 0, 0); __builtin_amdgcn_s_setprio(0); } while (0)
#define PG8_WAIT_V(n) asm volatile("s_waitcnt vmcnt(" #n ")" ::: "memory")
#define PG8_WAIT_L(n) asm volatile("s_waitcnt lgkmcnt(" #n ")" ::: "memory")
#define PG8_BAR __builtin_amdgcn_s_barrier()
#define PG8_SCHED __builtin_amdgcn_sched_barrier(0)
    Unit cur, nxt; int ui = 0;
    if (!S.next(0, cur)) return;
    f32x4 acc[2][2][4][2];
#pragma unroll
    for (int a = 0; a < 2; ++a)
#pragma unroll
        for (int b = 0; b < 2; ++b)
#pragma unroll
            for (int m = 0; m < 4; ++m)
#pragma unroll
                for (int n = 0; n < 2; ++n) acc[a][b][m][n] = (f32x4){0.f, 0.f, 0.f, 0.f};
    bf16x8 At[4][2], B0[2][2], B1[2][2];
    const char* cA = (const char*)g.A + (size_t)cur.pm * tstep; const char* cB = (const char*)g.Bt + (size_t)cur.pn * tstep;
    S.a_ready(cur);
    PG8_STAGE(PG8_SB(0, 0), cB, voffB); PG8_STAGE(PG8_SA(0, 0), cA, voffA); PG8_STAGE(PG8_SB(0, 1), cB + hstep, voffB); PG8_STAGE(PG8_SA(0, 1), cA + hstep, voffA);
    if (wr == 1) PG8_BAR;
    PG8_WAIT_V(4); PG8_BAR;
    PG8_STAGE(PG8_SB(1, 0), cB + kstep, voffB); PG8_STAGE(PG8_SA(1, 0), cA + kstep, voffA); PG8_STAGE(PG8_SB(1, 1), cB + hstep + kstep, voffB);
    PG8_WAIT_V(6); PG8_BAR;
    for (;;) {
        const bool has_next = S.next(ui + 1, nxt);
        const char* nA = has_next ? (const char*)g.A + (size_t)nxt.pm * tstep : cA; const char* nB = has_next ? (const char*)g.Bt + (size_t)nxt.pn * tstep : cB;
        for (int t = 0; t < nt; t += 2) {
            const bool last = (t == nt - 2);
            const char* a1 = cA + (size_t)(t + 1) * kstep;
            const char* a2 = last ? nA : cA + (size_t)(t + 2) * kstep; const char* b2 = last ? nB : cB + (size_t)(t + 2) * kstep;
            const char* a3 = a2 + kstep; const char* b3 = b2 + kstep;
            if (last && has_next) S.a_ready(nxt);
            PG8_LDB(B0, 0, 0); PG8_SCHED; PG8_LDA(At, 0, 0); PG8_STAGE(PG8_SA(1, 1), a1 + hstep, voffA);
            PG8_WAIT_L(8); PG8_BAR; PG8_WAIT_L(0); PG8_MMA(0, 0, At, B0); PG8_BAR; PG8_SCHED;
            PG8_LDB(B1, 0, 1); PG8_STAGE(PG8_SB(0, 0), b2, voffB);
            PG8_BAR; PG8_WAIT_L(0); PG8_MMA(0, 1, At, B1); PG8_BAR;
            PG8_LDA(At, 0, 1); PG8_STAGE(PG8_SA(0, 0), a2, voffA);
            PG8_BAR; PG8_WAIT_L(0); PG8_MMA(1, 0, At, B0); PG8_BAR; PG8_SCHED;
            PG8_STAGE(PG8_SB(0, 1), b2 + hstep, voffB);
            PG8_WAIT_V(6); PG8_BAR; PG8_MMA(1, 1, At, B1); PG8_BAR;
            PG8_LDB(B0, 1, 0); PG8_SCHED; PG8_LDA(At, 1, 0); PG8_STAGE(PG8_SA(0, 1), a2 + hstep, voffA);
            PG8_WAIT_L(8); PG8_BAR; PG8_WAIT_L(0); PG8_MMA(0, 0, At, B0); PG8_BAR; PG8_SCHED;
            PG8_LDB(B1, 1, 1); PG8_STAGE(PG8_SB(1, 0), b3, voffB);
            PG8_BAR; PG8_WAIT_L(0); PG8_MMA(0, 1, At, B1); PG8_BAR;
            PG8_LDA(At, 1, 1); PG8_STAGE(PG8_SA(1, 0), a3, voffA);
            PG8_BAR; PG8_WAIT_L(0); PG8_MMA(1, 0, At, B0); PG8_BAR; PG8_SCHED;
            PG8_STAGE(PG8_SB(1, 1), b3 + hstep, voffB);
            PG8_WAIT_V(6); PG8_BAR; PG8_MMA(1, 1, At, B1); PG8_BAR;
        }
        if constexpr (!Epi::AFTER_DRAIN) { E(acc, cur, wr, wc, fr, fq); S.done(cur); }
        if (!has_next) break;
#pragma unroll
        for (int a = 0; a < 2; ++a)
#pragma unroll
            for (int b = 0; b < 2; ++b)
#pragma unroll
                for (int m = 0; m < 4; ++m)
#pragma unroll
                    for (int n = 0; n < 2; ++n) acc[a][b][m][n] = (f32x4){0.f, 0.f, 0.f, 0.f};
        cur = nxt; cA = nA; cB = nB; ++ui;
    }
    PG8_WAIT_V(0);
    if (wr == 0) PG8_BAR;
    PG8_BAR;
    if constexpr (Epi::AFTER_DRAIN) { E.fused(acc, cur, wr, wc, fr, fq, lds, wid, lane); S.done(cur); }
#undef PG8_SA
#undef PG8_SB
#undef PG8_STAGE
#undef PG8_LDA
#undef PG8_LDB
#undef PG8_MMA
#undef PG8_WAIT_V
#undef PG8_WAIT_L
#undef PG8_BAR
#undef PG8_SCHED
}
}

#define XB_TMO      128
#define XB_XCNT(j)  (256  + 64 * (j))
#define XB_XSUB(j)  (1280 + 64 * (j))
#define XB_XGEN(j)  (2304 + 64 * (j))
#define XB_TOP      3328
#define XB_TOPGEN   3392
#define XCD_BAR_WORDS 3456
#define XB_SPIN_CAP (1u << 22)
__device__ __forceinline__ unsigned xb_ld(unsigned* p)              { return __hip_atomic_load(p, __ATOMIC_RELAXED, __HIP_MEMORY_SCOPE_AGENT); }
__device__ __forceinline__ unsigned xb_add(unsigned* p, unsigned v) { return __hip_atomic_fetch_add(p, v, __ATOMIC_RELAXED, __HIP_MEMORY_SCOPE_AGENT); }
__device__ __forceinline__ unsigned xb_xcc_id() { return (unsigned)__builtin_amdgcn_s_getreg((3 << 11) | 20) & 0xFu; }
#define XB_SPIN(cond, bar) do { unsigned _sp = 0; while (cond) { __builtin_amdgcn_s_sleep(1); \
    if ((++_sp & 255u) == 0u) { if (xb_ld(&(bar)[XB_TMO])) break; if (_sp > XB_SPIN_CAP) { atomicAdd(&(bar)[XB_TMO], 1u); break; } } } } while (0)
struct XcdBarrier { unsigned* bar; unsigned x; volatile LAS unsigned* st; };
__device__ __forceinline__ XcdBarrier xcd_barrier_post(unsigned* bar, volatile LAS unsigned* st) {
    XcdBarrier b; b.bar = bar; b.x = xb_xcc_id(); b.st = st;
    if (threadIdx.x == 0) (void)xb_add(&bar[XB_XCNT(b.x)], 1u);
    return b;
}
__device__ __forceinline__ void xcd_barrier_complete(unsigned* bar, unsigned x, unsigned& nloc, unsigned& nx) {
    const unsigned G = gridDim.x * gridDim.y * gridDim.z;
    unsigned sum, cnt, mine, sp = 0u;
    for (;;) {
        sum = 0u; cnt = 0u; mine = 0u;
#pragma unroll
        for (unsigned j = 0; j < 16; ++j) { const unsigned c = xb_ld(&bar[XB_XCNT(j)]); sum += c; cnt += (c > 0u) ? 1u : 0u; mine = (j == x) ? c : mine; }
        if (sum == G) break;
        __builtin_amdgcn_s_sleep(1);
        if ((++sp & 255u) == 0u) { if (xb_ld(&bar[XB_TMO])) break; if (sp > XB_SPIN_CAP) { atomicAdd(&bar[XB_TMO], 1u); break; } }
    }
    nloc = mine > 0u ? mine : 1u; nx = cnt > 0u ? cnt : 1u;
}
__device__ __forceinline__ void xcd_barrier(const XcdBarrier& b) {
    asm volatile("s_waitcnt vmcnt(0)" ::: "memory");
    __syncthreads();
    if (threadIdx.x == 0) {
        unsigned* bar = b.bar;
        const unsigned bx = xb_xcc_id();
        __builtin_amdgcn_s_waitcnt(0);
        unsigned nloc = b.st[0], nx = b.st[1];
        if (nloc == 0u) { xcd_barrier_complete(bar, bx, nloc, nx); b.st[0] = nloc; b.st[1] = nx; }
        const unsigned old = xb_add(&bar[XB_XSUB(bx)], 1u);
        const unsigned gen = old / nloc;
        if (old + 1u == (gen + 1u) * nloc) {
            __builtin_amdgcn_fence(__ATOMIC_RELEASE, "agent");
            asm volatile("s_waitcnt vmcnt(0)" ::: "memory");
            const unsigned og = xb_add(&bar[XB_TOP], 1u);
            const unsigned tg = og / nx;
            if (og + 1u == (tg + 1u) * nx) xb_add(&bar[XB_TOPGEN], 1u);
            else XB_SPIN(xb_ld(&bar[XB_TOPGEN]) == tg, bar);
            __builtin_amdgcn_fence(__ATOMIC_ACQUIRE, "agent");
            xb_add(&bar[XB_XGEN(bx)], 1u);
            asm volatile("s_waitcnt vmcnt(0)" ::: "memory");
        } else {
            XB_SPIN(xb_ld(&bar[XB_XGEN(bx)]) == gen, bar);
            __builtin_amdgcn_fence(__ATOMIC_ACQUIRE, "agent");
            asm volatile("s_waitcnt vmcnt(0)" ::: "memory");
        }
    }
    __syncthreads();
}

namespace {
struct Params {
  const float *x, *meta, *rel_bias, *ln_mix, *w_in, *sinks, *conv_w, *conv_b, *dt_bias, *a_log, *d_skip, *attn_norm_w,
      *ssm_norm_w, *w_out, *ln_ffn, *wq, *keys, *U, *V, *ln_final;
  float* out;
  unsigned char* ws;
};

__device__ __forceinline__ void p0_transpose_tile(const float* __restrict__ W, int ldw, bf16_t* __restrict__ Wt, const float* sc0,
                                                  const float* sc1, int k0, int n0, float* tile) {
  const int tid = threadIdx.x;
  {
    const int r = tid >> 6, c4 = (tid & 63) * 4;
    f32x4 v[8];
#pragma unroll
    for (int i = 0; i < 8; ++i) v[i] = *(const f32x4*)(W + (size_t)(k0 + r + 8 * i) * ldw + n0 + c4);
#pragma unroll
    for (int i = 0; i < 8; ++i) {
      float s = 1.f;
      const int k = k0 + r + 8 * i;
      if (sc0) s = k < 1024 ? sc0[k] : sc1[k - 1024];
      float* q = tile + (r + 8 * i) * 257 + c4;
      q[0] = v[i][0] * s; q[1] = v[i][1] * s; q[2] = v[i][2] * s; q[3] = v[i][3] * s;
    }
  }
  __syncthreads();
#pragma unroll
  for (int it = 0; it < 4; ++it) {
    const int task = it * NTHREADS + tid;
    const int n = task >> 3, kc = (task & 7) * 8;
    float v[8];
#pragma unroll
    for (int j = 0; j < 8; ++j) v[j] = tile[(kc + j) * 257 + n];
    u32x4 w; w.x = pack_bf16(v[0], v[1]); w.y = pack_bf16(v[2], v[3]); w.z = pack_bf16(v[4], v[5]); w.w = pack_bf16(v[6], v[7]);
    *(u32x4*)(Wt + (size_t)(n0 + n) * DM + k0 + kc) = w;
  }
  __syncthreads();
}

__device__ __forceinline__ void phase0(const Params& p, float* ldsf, int bid, int nblk) {
  const int tid = threadIdx.x, lane = tid & 63, wid = tid >> 6;
  bf16_t* w_inT = (bf16_t*)(p.ws + WS_WINT);
  bf16_t* w_dtT = (bf16_t*)(p.ws + WS_WDTT);
  bf16_t* w_outT = (bf16_t*)(p.ws + WS_WOUTT);
  bf16_t* wqT = (bf16_t*)(p.ws + WS_WQT);
  bf16_t* keysb = (bf16_t*)(p.ws + WS_KEYS);
  unsigned char* ub = p.ws + WS_UB;
  unsigned char* vb = p.ws + WS_VB;
  bf16_t* hnb = (bf16_t*)(p.ws + WS_HNB);
  constexpr int U_HN = (TA + 7) / 8;
  constexpr int U_WIN = 32 * 16, U_WOUT = 32 * 8, U_WQ = 32 * 8, U_WDT = 1, U_KEYS = 64;
  constexpr int B_WIN = U_HN, B_WOUT = B_WIN + U_WIN, B_WQ = B_WOUT + U_WOUT, B_WDT = B_WQ + U_WQ, B_KEYS = B_WDT + U_WDT,
                B_U = B_KEYS + U_KEYS, B_END = B_U;
  for (int u = bid; u < B_END; u += nblk) {
    if (u < B_WIN) {
      const int t = u * 8 + wid;
      if (t < TA) {
        const float* src = t < T ? p.x + (size_t)t * DM : p.meta + (size_t)(t - T) * DM;
        float4 v[8];
        float ss = 0.f;
#pragma unroll
        for (int i = 0; i < 8; ++i) {
          v[i] = *(const float4*)(src + (i * 64 + lane) * 4);
          ss += v[i].x * v[i].x + v[i].y * v[i].y + v[i].z * v[i].z + v[i].w * v[i].w;
        }
        ss = wave_sum(ss);
        const float r = rsqrtf(ss * (1.f / DM) + EPS);
#pragma unroll
        for (int i = 0; i < 8; ++i) {
          const float4 w = *(const float4*)(p.ln_mix + (i * 64 + lane) * 4);
          u32x2 o; o.x = pack_bf16(v[i].x * r * w.x, v[i].y * r * w.y); o.y = pack_bf16(v[i].z * r * w.z, v[i].w * r * w.w);
          *(u32x2*)(hnb + (size_t)t * DM + (i * 64 + lane) * 4) = o;
        }
      }
    } else if (u < B_WOUT) {
      const int i = u - B_WIN;
      p0_transpose_tile(p.w_in, DPROJ, w_inT, nullptr, nullptr, (i & 31) * 64, (i >> 5) * 256, ldsf);
    } else if (u < B_WQ) {
      const int i = u - B_WOUT;
      p0_transpose_tile(p.w_out, DM, w_outT, p.attn_norm_w, p.ssm_norm_w, (i & 31) * 64, (i >> 5) * 256, ldsf);
    } else if (u < B_WDT) {
      const int i = u - B_WQ;
      p0_transpose_tile(p.wq, DM, wqT, p.ln_ffn, p.ln_ffn + 1024, (i & 31) * 64, (i >> 5) * 256, ldsf);
    } else if (u < B_KEYS) {
      for (int idx = tid; idx < DM * 16; idx += NTHREADS) {
        const int k = idx >> 4, j = idx & 15;
        w_dtT[(size_t)j * DM + k] = f2bf(p.w_in[(size_t)k * DPROJ + NPROJ + j]);
      }
    } else if (u < B_U) {
      const size_t base = (size_t)(u - B_KEYS) * 4096 + (size_t)tid * 8;
      const float4 a = *(const float4*)(p.keys + base), b = *(const float4*)(p.keys + base + 4);
      u32x4 w; w.x = pack_bf16(a.x, a.y); w.y = pack_bf16(a.z, a.w); w.z = pack_bf16(b.x, b.y); w.w = pack_bf16(b.z, b.w);
      *(u32x4*)(keysb + base) = w;
    }
  }
  {
    const int gw = bid * 8 + wid, nw = nblk * 8;
    auto load_row = [&](f32x4 (&a)[8], const int r2) __attribute__((always_inline)) {
      const float* src = (r2 < NEXP ? p.U + (size_t)r2 * DM : p.V + (size_t)(r2 - NEXP) * DM) + lane * 4;
#pragma unroll
      for (int j = 0; j < 8; ++j) a[j] = *(const f32x4*)(src + 256 * j);
    };
    auto conv_row = [&](f32x4 (&a)[8], const int r2) __attribute__((always_inline)) {
      const bool isU = r2 < NEXP;
      const int row = isU ? r2 : r2 - NEXP;
      if (isU) {
#pragma unroll
        for (int j = 0; j < 8; ++j) a[j] *= *(const f32x4*)(p.ln_ffn + lane * 4 + 256 * j);
      }
      float amax = 0.f;
#pragma unroll
      for (int j = 0; j < 8; ++j) amax = fmaxf(amax, fmaxf(fmaxf(fabsf(a[j][0]), fabsf(a[j][1])), fmaxf(fabsf(a[j][2]), fabsf(a[j][3]))));
      amax = wave_max(amax);
      const float s4 = amax > 0.f ? 6.f / amax : 1.f;
      u32x4 w4;
#pragma unroll
      for (int j = 0; j < 4; ++j) {
        unsigned w = 0;
        w = __builtin_amdgcn_cvt_scalef32_pk_fp4_f32(w, a[2 * j][0] * s4, a[2 * j][1] * s4, 1.0f, 0);
        w = __builtin_amdgcn_cvt_scalef32_pk_fp4_f32(w, a[2 * j][2] * s4, a[2 * j][3] * s4, 1.0f, 1);
        w = __builtin_amdgcn_cvt_scalef32_pk_fp4_f32(w, a[2 * j + 1][0] * s4, a[2 * j + 1][1] * s4, 1.0f, 2);
        w = __builtin_amdgcn_cvt_scalef32_pk_fp4_f32(w, a[2 * j + 1][2] * s4, a[2 * j + 1][3] * s4, 1.0f, 3);
        w4[j] = w;
      }
      *(u32x4*)((isU ? ub : vb) + (size_t)row * ROW4 + lane * 16) = w4;
      if (lane == 0) ((float*)(p.ws + (isU ? WS_USC : WS_VSC)))[row] = amax > 0.f ? amax * (1.f / 6.f) : 1.f;
    };
    f32x4 ra[8], rb[8];
    int r2 = gw;
    if (r2 < 2 * NEXP) load_row(ra, r2);
#pragma unroll 1
    for (; r2 < 2 * NEXP; r2 += 2 * nw) {
      if (r2 + nw < 2 * NEXP) load_row(rb, r2 + nw);
      conv_row(ra, r2);
      if (r2 + nw < 2 * NEXP) {
        if (r2 + 2 * nw < 2 * NEXP) load_row(ra, r2 + 2 * nw);
        conv_row(rb, r2 + nw);
      }
    }
  }
}

__device__ __forceinline__ void mini_gemm(const bf16_t* __restrict__ A, const bf16_t* __restrict__ Bt, float* __restrict__ out, int ldo,
                                          float* red, bf16_t* __restrict__ outb = nullptr) {
  const int tid = threadIdx.x, lane = tid & 63, wid = tid >> 6, fr = lane & 15, fq = lane >> 4;
  f32x4 acc = {0.f, 0.f, 0.f, 0.f};
  const bf16_t* ap = A + (size_t)fr * DM + wid * 256 + fq * 8;
  const bf16_t* bp = Bt + (size_t)fr * DM + wid * 256 + fq * 8;
#pragma unroll
  for (int ks = 0; ks < 8; ++ks) {
    const bf16x8 a = *(const bf16x8*)(ap + ks * 32);
    const bf16x8 b = *(const bf16x8*)(bp + ks * 32);
    acc = __builtin_amdgcn_mfma_f32_16x16x32_bf16(a, b, acc, 0, 0, 0);
  }
#pragma unroll
  for (int r = 0; r < 4; ++r) red[wid * 256 + (4 * fq + r) * 16 + fr] = acc[r];
  __syncthreads();
  if (tid < 256) {
    float s = 0.f;
#pragma unroll
    for (int w = 0; w < 8; ++w) s += red[w * 256 + tid];
    out[(size_t)(tid >> 4) * ldo + (tid & 15)] = s;
    if (outb) outb[(size_t)(tid >> 4) * ldo + (tid & 15)] = f2bf(s);
  }
  __syncthreads();
}

__device__ __forceinline__ void phase1(const Params& p, unsigned char* lds, int bid, int nblk) {
  const bf16_t* hnb = (const bf16_t*)(p.ws + WS_HNB);
  const bf16_t* w_inT = (const bf16_t*)(p.ws + WS_WINT);
  const bf16_t* w_dtT = (const bf16_t*)(p.ws + WS_WDTT);
  float* dtraw = (float*)(p.ws + WS_DTRAW);
  float* projm = (float*)(p.ws + WS_PROJM);
  constexpr int NU = 512 + 32 + 96 + 1;
  for (int u = bid; u < NU; u += nblk) {
    if (u < 512) {
      mini_gemm(hnb + (size_t)u * 16 * DM, w_dtT, dtraw + (size_t)u * 16 * 16, 16, (float*)lds);
    } else {
      const int j = u - 512;
      const int cf = j < 32 ? 64 + j : (j < 128 ? 160 + (j - 32) : 256);
      const bf16_t* bt = cf < 256 ? w_inT + (size_t)cf * 16 * DM : w_dtT;
      mini_gemm(hnb + (size_t)T * DM, bt, projm + cf * 16, DPROJ, (float*)lds, (bf16_t*)(p.ws + WS_PROJMB) + cf * 16);
    }
  }
  pg8::Gemm g{hnb, w_inT, T, NPROJ, DM};
  pg8::StaticOrder S; S.init(T, NPROJ, nblk, bid);
  pg8::EpiBf16 E{(bf16_t*)(p.ws + WS_PROJ), NPROJ};
  pg8::gemm_phase<pg8::EpiBf16, pg8::StaticOrder>((PG8_LAS unsigned char*)lds, g, S, E);
}

__device__ __forceinline__ void phase4(const Params& p, unsigned char* lds, int bid, int nblk) {
  pg8::Gemm g{(const bf16_t*)(p.ws + WS_HNB), (const bf16_t*)(p.ws + WS_WOUTT), T, DM, DM};
  pg8::StaticOrder S; S.init(T, DM, nblk, bid);
  pg8::EpiRes E{p.x, (bf16_t*)(p.ws + WS_H1B), (float*)(p.ws + WS_SSQH1)};
  pg8::gemm_phase<pg8::EpiRes, pg8::StaticOrder>((PG8_LAS unsigned char*)lds, g, S, E);
}
__device__ __forceinline__ void phase5(const Params& p, unsigned char* lds, int bid, int nblk) {
  pg8::Gemm g{(const bf16_t*)(p.ws + WS_H1B), (const bf16_t*)(p.ws + WS_WQT), T, DM, DM};
  pg8::StaticOrder S; S.init(T, DM, nblk, bid);
  pg8::EpiScores E{(const bf16_t*)(p.ws + WS_KEYS), (float*)(p.ws + WS_STOP), (int*)(p.ws + WS_ITOP)};
  pg8::gemm_phase<pg8::EpiScores, pg8::StaticOrder>((PG8_LAS unsigned char*)lds, g, S, E);
}

__device__ __forceinline__ float dot2bf(unsigned a, unsigned b, float c) {
  return __builtin_amdgcn_fdot2_f32_bf16(*(bf16v2*)&a, *(bf16v2*)&b, c, false);
}
__device__ __forceinline__ void phase6(const Params& p, unsigned char* lds, int bid, int nblk) {
  const int tid0 = threadIdx.x, lane0 = tid0 & 63, wid = __builtin_amdgcn_readfirstlane(tid0 >> 6);
  int* ids = (int*)(lds + wid * 2048);
  float* gts = (float*)(lds + wid * 2048 + 512);
  float* wts = (float*)(lds + wid * 2048 + 1024);
  int* rid = (int*)(lds + 16384 + wid * 1024);
  float* rgt = (float*)(lds + 16384 + wid * 1024 + 512);
  const unsigned char* ub = p.ws + WS_UB;
  const unsigned char* vb = p.ws + WS_VB;
  const bf16_t* h1b = (const bf16_t*)(p.ws + WS_H1B);
  const float* usc = (const float*)(p.ws + WS_USC);
  const float* vsc = (const float*)(p.ws + WS_VSC);
  const float* ssq = (const float*)(p.ws + WS_SSQH1);
  const float* stop = (const float*)(p.ws + WS_STOP);
  const int* itop = (const int*)(p.ws + WS_ITOP);
  const int ci = kCandI[lane0], cj = kCandJ[lane0];
#pragma unroll 1
  for (int t = bid * 8 + wid; t < T; t += nblk * 8) {
    int tid = tid0; asm volatile("" : "+v"(tid));
    const int lane = tid & 63;
    const int kcode = 8 * ((lane >> 2) & 1) + 4 * ((lane >> 3) & 1) + 2 * ((lane >> 4) & 1) + ((lane >> 5) & 1);
    const float part0 = lane < 32 ? ssq[(size_t)t * 32 + lane] : 0.f;
    const float rr = rsqrtf(wave_sum(part0) * (1.f / DM) + EPS);
#pragma unroll 1
    for (int h = 0; h < 8; ++h) {
      const size_t lbase = ((size_t)t * 16 + h * 2) * 16;
      const float sv = lane < 32 ? stop[lbase + lane] : 0.f;
      const int iv = lane < 32 ? itop[lbase + lane] : 0;
      float cand = (__shfl(sv, ci) + __shfl(sv, 16 + cj)) * rr;
      if (lane >= 50) cand = -INFINITY;
      unsigned key = __float_as_uint(cand);
      key = (key & 0x80000000u) ? ~key : (key | 0x80000000u);
      key = (key & ~63u) | (unsigned)(63 - lane);
      int rank = 0;
#pragma unroll
      for (int k = 0; k < 50; ++k) {
        const unsigned kk = (unsigned)__builtin_amdgcn_readlane((int)key, k);
        rank += kk > key ? 1 : 0;
      }
      const float cmax = wave_max(cand);
      const float ex = rank < 16 ? __expf(cand - cmax) : 0.f;
      const float den = wave_sum(ex);
      const int eidx = __shfl(iv, ci) * 128 + __shfl(iv, 16 + cj);
      if (rank < 16) { rid[h * 16 + rank] = eidx; rgt[h * 16 + rank] = ex / den; }
    }
    {
      const int e0 = rid[lane], e1 = rid[lane + 64];
      const float g0 = rgt[lane], g1 = rgt[lane + 64];
      const int r0 = e0 >> 10, r1 = e1 >> 10;
      const unsigned long long ltm = (1ull << lane) - 1ull;
      int run = 0, pos0 = 0, pos1 = 0;
#pragma unroll
      for (int R = 0; R < 16; ++R) {
        const unsigned long long m0 = __ballot(r0 == R), m1 = __ballot(r1 == R);
        const int c0 = __popcll(m0), c1 = __popcll(m1);
        if (r0 == R) pos0 = run + __popcll(m0 & ltm);
        if (r1 == R) pos1 = run + c0 + __popcll(m1 & ltm);
        run += c0 + c1;
      }
      ids[pos0] = e0; gts[pos0] = g0;
      ids[pos1] = e1; gts[pos1] = g1;
    }
    float xf[32];
    {
      const bf16_t* xp = h1b + (size_t)t * DM + lane * 4;
#pragma unroll
      for (int j = 0; j < 8; ++j) {
        const u32x2 xa = *(const u32x2*)(xp + 256 * j);
        xf[4 * j + 0] = bflo(xa.x); xf[4 * j + 1] = bfhi(xa.x); xf[4 * j + 2] = bflo(xa.y); xf[4 * j + 3] = bfhi(xa.y);
      }
    }
#pragma unroll 1
    for (int rnd = 0; rnd < 8; ++rnd) {
      u32x4 ra[16];
#pragma unroll
      for (int k = 0; k < 16; ++k) {
        const int e = __builtin_amdgcn_readfirstlane(ids[rnd * 16 + k]);
        ra[k] = *(const u32x4*)(ub + (size_t)e * ROW4 + lane * 16);
      }
      float part[16];
      float prev = 0.f;
#pragma unroll
      for (int k = 0; k < 16; ++k) {
        asm volatile("" : "+v"(ra[k]) : "v"(prev));
        float d0 = 0.f, d1 = 0.f;
#define U4_STEP(j, i) { const f32x2 r = __builtin_amdgcn_cvt_scalef32_pk_f32_fp4(ra[k][j], 1.0f, i); \
          d0 = fmaf(r[0], xf[8 * (j) + 2 * (i)], d0); d1 = fmaf(r[1], xf[8 * (j) + 2 * (i) + 1], d1); }
#pragma unroll
        for (int j = 0; j < 4; ++j) { U4_STEP(j, 0) U4_STEP(j, 1) U4_STEP(j, 2) U4_STEP(j, 3) }
#undef U4_STEP
        prev = d0 + d1;
        part[k] = prev;
      }
      float q8[8], q4[4], q2[2], q1;
      { const bool hi = (lane >> 5) & 1;
#pragma unroll
        for (int i = 0; i < 8; ++i) { const float keep = hi ? part[2 * i + 1] : part[2 * i], send = hi ? part[2 * i] : part[2 * i + 1]; q8[i] = keep + __shfl_xor(send, 32); } }
      { const bool hi = (lane >> 4) & 1;
#pragma unroll
        for (int i = 0; i < 4; ++i) { const float keep = hi ? q8[2 * i + 1] : q8[2 * i], send = hi ? q8[2 * i] : q8[2 * i + 1]; q4[i] = keep + __shfl_xor(send, 16); } }
      { const bool hi = (lane >> 3) & 1;
#pragma unroll
        for (int i = 0; i < 2; ++i) { const float keep = hi ? q4[2 * i + 1] : q4[2 * i], send = hi ? q4[2 * i] : q4[2 * i + 1]; q2[i] = keep + __shfl_xor(send, 8); } }
      { const bool hi = (lane >> 2) & 1;
        const float keep = hi ? q2[1] : q2[0], send = hi ? q2[0] : q2[1]; q1 = keep + __shfl_xor(send, 4); }
      q1 += __shfl_xor(q1, 2);
      q1 += __shfl_xor(q1, 1);
      {
        const int kk = rnd * 16 + kcode;
        const int eid = ids[kk];
        const float a = q1 * rr * usc[eid];
        const float ge = 0.5f * a * (1.f + erff(a * 0.70710678118654752f));
        if ((lane & 3) == 0) wts[kk] = gts[kk] * ge * vsc[eid];
      }
    }
    float acc[32];
#pragma unroll
    for (int i = 0; i < 32; ++i) acc[i] = 0.f;
#pragma unroll 1
    for (int rnd = 0; rnd < 8; ++rnd) {
      u32x4 ra[16];
#pragma unroll
      for (int k = 0; k < 16; ++k) {
        const int e = __builtin_amdgcn_readfirstlane(ids[rnd * 16 + k]);
        ra[k] = *(const u32x4*)(vb + (size_t)e * ROW4 + lane * 16);
      }
      f32x4 wv[4];
#pragma unroll
      for (int j = 0; j < 4; ++j) wv[j] = *(const f32x4*)(wts + rnd * 16 + 4 * j);
#pragma unroll
      for (int k = 0; k < 16; ++k) {
        const float wk = wv[k >> 2][k & 3];
        asm volatile("" : "+v"(ra[k]) : "v"(acc[1]), "v"(acc[3]), "v"(acc[5]), "v"(acc[7]), "v"(acc[9]), "v"(acc[11]), "v"(acc[13]), "v"(acc[15]),
                                        "v"(acc[17]), "v"(acc[19]), "v"(acc[21]), "v"(acc[23]), "v"(acc[25]), "v"(acc[27]), "v"(acc[29]), "v"(acc[31]));
#define V4_STEP(j, i) { const f32x2 r = __builtin_amdgcn_cvt_scalef32_pk_f32_fp4(ra[k][j], 1.0f, i); \
            acc[8 * (j) + 2 * (i)] = fmaf(wk, r[0], acc[8 * (j) + 2 * (i)]); acc[8 * (j) + 2 * (i) + 1] = fmaf(wk, r[1], acc[8 * (j) + 2 * (i) + 1]); }
#pragma unroll
        for (int j = 0; j < 4; ++j) { V4_STEP(j, 0) V4_STEP(j, 1) V4_STEP(j, 2) V4_STEP(j, 3) }
#undef V4_STEP
      }
    }
    float ss = 0.f;
#pragma unroll
    for (int i = 0; i < 32; ++i) { acc[i] += xf[i]; ss += acc[i] * acc[i]; }
    ss = wave_sum(ss);
    const float rf = rsqrtf(ss * (1.f / DM) + EPS);
#pragma unroll
    for (int j = 0; j < 8; ++j) {
      const f32x4 lw = *(const f32x4*)(p.ln_final + 256 * j + lane * 4);
      *(f32x4*)(p.out + (size_t)t * DM + 256 * j + lane * 4) = (f32x4){acc[4 * j] * rf * lw[0], acc[4 * j + 1] * rf * lw[1], acc[4 * j + 2] * rf * lw[2], acc[4 * j + 3] * rf * lw[3]};
    }
  }
}

typedef float f32x16 __attribute__((ext_vector_type(16)));
__device__ __forceinline__ void unpack8(const u32x4 a, float (&v)[8]) {
  v[0] = bflo(a.x); v[1] = bfhi(a.x); v[2] = bflo(a.y); v[3] = bfhi(a.y); v[4] = bflo(a.z); v[5] = bfhi(a.z); v[6] = bflo(a.w); v[7] = bfhi(a.w);
}
constexpr int VT_LD = 196;
constexpr int ATT_VT_BYTES = 4 * 64 * VT_LD * 2;
__device__ __forceinline__ void attn_item(const Params& p, unsigned char* lds, int item) {
  const int tid = threadIdx.x, lane = tid & 63, wid = __builtin_amdgcn_readfirstlane(tid >> 6);
  const int b = item >> 6, q0 = (item & 63) * 32;
  bf16_t* VT = (bf16_t*)lds;
  float* biasL = (float*)(lds + ATT_VT_BYTES);
  float* ssqw = biasL + 16 * 132;
  const bf16_t* proj = (const bf16_t*)(p.ws + WS_PROJ);
  const float* projm = (const float*)(p.ws + WS_PROJM);
  bf16_t* mixin = (bf16_t*)(p.ws + WS_HNB);
#pragma unroll
  for (int it = 0; it < 5; ++it) {
    const int idx = it * NTHREADS + tid;
    if (idx >= 16 * 129) break;
    const int hq = idx / 129, d = idx - hq * 129;
    const int bk = d < 128 ? (int)kBucket[d] : 31;
    biasL[hq * 132 + d] = p.rel_bias[bk * 16 + hq];
  }
  const int ql = lane & 31, ql0 = ql, hh = lane >> 5, kvh = wid >> 1;
  const int trow = b * SEQ + q0 + ql;
  bf16x8 qf[4];
  u32x4 kf[6][4];
#define ATT_LOAD_Q(hq_)                                                                                                           \
  { _Pragma("unroll") for (int ks = 0; ks < 4; ++ks) qf[ks] = *(const bf16x8*)(proj + (size_t)trow * NPROJ + OFF_Q + (hq_) * 64 + ks * 16 + hh * 8); }
#define ATT_LOAD_K()                                                                                                              \
  {                                                                                                                               \
    int ql = ql0; asm volatile("" : "+v"(ql));     \
    const float* kr_ = projm + (size_t)(ql & 15) * DPROJ + OFF_K + kvh * 64 + hh * 8;                                             \
    _Pragma("unroll") for (int ks = 0; ks < 4; ++ks) {                                                                            \
      const f32x4 a_ = *(const f32x4*)(kr_ + ks * 16), c_ = *(const f32x4*)(kr_ + ks * 16 + 4);                                   \
      kf[0][ks].x = pack_bf16(a_[0], a_[1]); kf[0][ks].y = pack_bf16(a_[2], a_[3]); kf[0][ks].z = pack_bf16(c_[0], c_[1]); kf[0][ks].w = pack_bf16(c_[2], c_[3]); } \
    _Pragma("unroll") for (int jt = 1; jt < 6; ++jt) {                                                                            \
      int sp_ = q0 - 128 + 32 * (jt - 1) + ql; sp_ = sp_ < 0 ? 0 : sp_;                                                           \
      const bf16_t* kp_ = proj + (size_t)(b * SEQ + sp_) * NPROJ + OFF_K + kvh * 64 + hh * 8;                                     \
      _Pragma("unroll") for (int ks = 0; ks < 4; ++ks) kf[jt][ks] = *(const u32x4*)(kp_ + ks * 16); }                             \
  }
  ATT_LOAD_Q(2 * wid)
#pragma unroll 1
  for (int rep_ = 0; rep_ < (REP_SUB == 2 ? 2 : 1); ++rep_) {
    u32x4 ra[5], rc[5];
#pragma unroll
    for (int q = 0; q < 5; ++q) {
      const int task = q * NTHREADS + tid, ch = task / 80, pi = task - ch * 80;
      int s0 = q0 - 128 + 2 * pi;
      s0 = s0 < 0 ? 0 : s0;
      const bf16_t* r0 = proj + (size_t)(b * SEQ + s0) * NPROJ + OFF_V + ch * 8;
      ra[q] = *(const u32x4*)r0; rc[q] = *(const u32x4*)(r0 + NPROJ);
    }
    float m0[8], m1[8];
    {
      const int pi = tid & 7, ch = (tid >> 3) & 31;
      const float* r0 = projm + (size_t)(2 * pi) * DPROJ + OFF_V + ch * 8;
      const f32x4 ma = *(const f32x4*)r0, mb = *(const f32x4*)(r0 + 4), mc = *(const f32x4*)(r0 + DPROJ), md = *(const f32x4*)(r0 + DPROJ + 4);
      const float keep = tid < 256 ? 1.f : 0.f;
#pragma unroll
      for (int i = 0; i < 4; ++i) { m0[i] = ma[i] * keep; m0[4 + i] = mb[i] * keep; m1[i] = mc[i] * keep; m1[4 + i] = md[i] * keep; }
      bf16_t* dst = VT + (size_t)((ch >> 3) * 64 + (ch & 7) * 8) * VT_LD + 2 * pi + (tid < 256 ? 0 : 16);
#pragma unroll
      for (int i = 0; i < 8; ++i) *(unsigned*)(dst + i * VT_LD) = pack_bf16(m0[i], m1[i]);
    }
#pragma unroll
    for (int q = 0; q < 5; ++q) {
      const int task = q * NTHREADS + tid, ch = task / 80, pi = task - ch * 80;
      float v0[8], v1[8];
      unpack8(ra[q], v0); unpack8(rc[q], v1);
      bf16_t* dst = VT + (size_t)((ch >> 3) * 64 + (ch & 7) * 8) * VT_LD + 32 + 2 * pi;
#pragma unroll
      for (int i = 0; i < 8; ++i) *(unsigned*)(dst + i * VT_LD) = pack_bf16(v0[i], v1[i]);
    }
  }
  __syncthreads();
  float ssq = 0.f;
#pragma unroll 1
  for (int rep_ = 0; rep_ < (REP_SUB == 3 ? 2 : 1); ++rep_) {
  ssq = 0.f;
  auto do_head = [&](const int hsel) __attribute__((always_inline)) {
    const int hq = 2 * wid + hsel;
    f32x16 sacc[6];
#pragma unroll
    for (int jt = 0; jt < 6; ++jt) {
      f32x16 acc;
#pragma unroll
      for (int r = 0; r < 16; ++r) acc[r] = 0.f;
#pragma unroll
      for (int ks = 0; ks < 4; ++ks) acc = __builtin_amdgcn_mfma_f32_32x32x16_bf16(*(bf16x8*)&kf[jt][ks], qf[ks], acc, 0, 0, 0);
      sacc[jt] = acc;
    }
    if (hsel == 0) { ATT_LOAD_Q(2 * wid + 1) }
    const float* bl = biasL + hq * 132;
    int sq = q0 + ql, qh = ql - 4 * hh;
    asm volatile("" : "+v"(sq), "+v"(qh));
    const float sink = p.sinks[hq];
    float m = sink;
#pragma unroll
    for (int jt = 0; jt < 6; ++jt) {
      asm volatile("" ::: "memory");
#pragma unroll
      for (int r = 0; r < 16; ++r) {
        const int kr = (r & 3) + 8 * (r >> 2) + 4 * hh;
        int dist; bool valid;
        if (jt == 0) { dist = sq + (16 - ((r & 3) + 8 * (r >> 2))) - 4 * hh; valid = kr < 16; }
        else { dist = qh + (128 - 32 * (jt - 1) - ((r & 3) + 8 * (r >> 2))); valid = (dist >= 0) && (dist < 128) && (dist <= sq); }
        const int dc = dist < 0 ? 0 : (dist > 128 ? 128 : dist);
        const float l = valid ? 0.125f * sacc[jt][r] + bl[dc] : -1e30f;
        sacc[jt][r] = l;
        m = fmaxf(m, l);
      }
    }
    m = fmaxf(m, __shfl_xor(m, 32));
    float sum = 0.f;
    f32x16 oacc0, oacc1;
#pragma unroll
    for (int r = 0; r < 16; ++r) { oacc0[r] = 0.f; oacc1[r] = 0.f; }
    const bf16_t* vrow0 = VT + (size_t)(kvh * 64 + ql) * VT_LD + 4 * hh;
    const bf16_t* vrow1 = vrow0 + 32 * VT_LD;
#pragma unroll
    for (int jt = 0; jt < 6; ++jt) {
      u32x4 pw[2];
#pragma unroll
      for (int s2 = 0; s2 < 2; ++s2) {
        float e[8];
#pragma unroll
        for (int i = 0; i < 8; ++i) { e[i] = __expf(sacc[jt][8 * s2 + i] - m); sum += e[i]; }
        pw[s2].x = pack_bf16(e[0], e[1]); pw[s2].y = pack_bf16(e[2], e[3]); pw[s2].z = pack_bf16(e[4], e[5]); pw[s2].w = pack_bf16(e[6], e[7]);
      }
#pragma unroll
      for (int s2 = 0; s2 < 2; ++s2) {
        const u32x2 va = *(const u32x2*)(vrow0 + 32 * jt + 16 * s2), vc = *(const u32x2*)(vrow0 + 32 * jt + 16 * s2 + 8);
        const u32x2 vd = *(const u32x2*)(vrow1 + 32 * jt + 16 * s2), ve = *(const u32x2*)(vrow1 + 32 * jt + 16 * s2 + 8);
        u32x4 v0w; v0w.x = va.x; v0w.y = va.y; v0w.z = vc.x; v0w.w = vc.y;
        u32x4 v1w; v1w.x = vd.x; v1w.y = vd.y; v1w.z = ve.x; v1w.w = ve.y;
        oacc0 = __builtin_amdgcn_mfma_f32_32x32x16_bf16(*(bf16x8*)&v0w, *(bf16x8*)&pw[s2], oacc0, 0, 0, 0);
        oacc1 = __builtin_amdgcn_mfma_f32_32x32x16_bf16(*(bf16x8*)&v1w, *(bf16x8*)&pw[s2], oacc1, 0, 0, 0);
      }
    }
    sum += __shfl_xor(sum, 32);
    const float inv = 1.f / (sum + __expf(sink - m));
#pragma unroll
    for (int r = 0; r < 16; ++r) { oacc0[r] *= inv; oacc1[r] *= inv; ssq += oacc0[r] * oacc0[r] + oacc1[r] * oacc1[r]; }
#pragma unroll
    for (int rg = 0; rg < 4; ++rg) {
      u32x2 w; w.x = pack_bf16(oacc0[rg * 4 + 0], oacc0[rg * 4 + 1]); w.y = pack_bf16(oacc0[rg * 4 + 2], oacc0[rg * 4 + 3]);
      *(u32x2*)(mixin + (size_t)trow * DM + hq * 64 + 8 * rg + 4 * hh) = w;
      u32x2 w1; w1.x = pack_bf16(oacc1[rg * 4 + 0], oacc1[rg * 4 + 1]); w1.y = pack_bf16(oacc1[rg * 4 + 2], oacc1[rg * 4 + 3]);
      *(u32x2*)(mixin + (size_t)trow * DM + hq * 64 + 32 + 8 * rg + 4 * hh) = w1;
    }
  };
  ATT_LOAD_K()
  do_head(0);
  asm volatile("" ::: "memory");
  ATT_LOAD_K()
  do_head(1);
  }
  ssq += __shfl_xor(ssq, 32);
  if (lane < 32) ssqw[wid * 32 + lane] = ssq;
  __syncthreads();
  float tot = 0.f;
#pragma unroll
  for (int w = 0; w < 8; ++w) tot += ssqw[w * 32 + ql];
  const float ra = rsqrtf(tot * (1.f / 1024) + EPS);
#pragma unroll
  for (int hsel = 0; hsel < 2; ++hsel)
#pragma unroll
    for (int dt = 0; dt < 2; ++dt)
#pragma unroll
      for (int rg = 0; rg < 4; ++rg) {
        bf16_t* op = mixin + (size_t)trow * DM + (2 * wid + hsel) * 64 + 32 * dt + 8 * rg + 4 * hh;
        const u32x2 v = *(const u32x2*)op;
        u32x2 w; w.x = pack_bf16(bflo(v.x) * ra, bfhi(v.x) * ra); w.y = pack_bf16(bflo(v.y) * ra, bfhi(v.y) * ra);
        *(u32x2*)op = w;
      }
  __syncthreads();
}
#undef ATT_LOAD_Q
#undef ATT_LOAD_K
__device__ __forceinline__ void phase2_attn(const Params& p, unsigned char* lds, int bid, int nblk) {
  for (int item = bid; item < 256; item += nblk) attn_item(p, lds, item);
}

constexpr int SLD = 136;
__device__ __forceinline__ float conv_silu(const float (&raw)[11], int i, float w0, float w1, float w2, float w3, float cb) {
  return silu_f(cb + w0 * raw[i] + w1 * raw[i + 1] + w2 * raw[i + 2] + w3 * raw[i + 3]);
}
__device__ __forceinline__ void ssd_a_item(const Params& p, unsigned char* lds, int item) {
  const int tid = threadIdx.x, lane = tid & 63, wid = __builtin_amdgcn_readfirstlane(tid >> 6);
  const int b = item >> 6, c = (item >> 2) & 15, g = (item >> 1) & 1, hsel = item & 1;
  const int h0 = g * 8 + hsel * 4;
  const int t0 = b * SEQ + c * 128;
  bf16_t* Bc = (bf16_t*)lds;
  bf16_t* Cc = Bc + 128 * SLD;
  bf16_t* BcT = Cc + 128 * SLD;
  bf16_t* xT = BcT + 128 * SLD;
  float* dtl = (float*)(xT + 2 * 64 * SLD);
  float* acs = dtl + 512;
  float* wl = acs + 512;
  float* scan = wl + 512;
  const bf16_t* __restrict__ proj = (const bf16_t*)(p.ws + WS_PROJ);
  const bf16_t* __restrict__ projmb = (const bf16_t*)(p.ws + WS_PROJMB);
  const float* __restrict__ dtraw = (const float*)(p.ws + WS_DTRAW);
  float* __restrict__ acsg = (float*)(p.ws + WS_ACSG);
  bf16_t* __restrict__ ccb = (bf16_t*)(p.ws + WS_CCB);
  float* __restrict__ ypart = (float*)(p.ws + WS_YPART);
  float* __restrict__ sg = (float*)(p.ws + WS_SG);
  {
    const int hi = tid >> 7, l = tid & 127, h = h0 + hi;
    const float Ah = -expf(p.a_log[h]);
    const float dtv = softplus_f(dtraw[(size_t)(t0 + l) * 16 + h] + p.dt_bias[h]);
    dtl[tid] = dtv;
    float cum = dtv * Ah;
#pragma unroll
    for (int o = 1; o < 64; o <<= 1) { const float nb = __shfl_up(cum, o); if (lane >= o) cum += nb; }
    if ((tid & 127) == 63) scan[hi] = cum;
    __syncthreads();
    if (l >= 64) cum += scan[hi];
    acs[tid] = cum;
    acsg[(size_t)(t0 + l) * 16 + h] = cum;
    __syncthreads();
    wl[tid] = dtv * __expf(acs[hi * 128 + 127] - cum);
  }
  {
    unsigned raw[4][11];
#pragma unroll
    for (int q = 0; q < 4; ++q) {
      const int task = q * NTHREADS + tid;
      const int tg = task >> 7, cp = task & 127;
      const int cch = 1024 + (cp >> 6) * 256 + g * 128 + 2 * (cp & 63);
#pragma unroll
      for (int i = 0; i < 11; ++i) {
        const int l = tg * 8 + i - 3;
        const bf16_t* src = (l >= 0 || c > 0) ? proj + (size_t)(t0 + l) * NPROJ : projmb + (size_t)(16 + l) * DPROJ;
        raw[q][i] = *(const unsigned*)(src + OFF_XBC + cch);
      }
    }
#pragma unroll
    for (int q = 0; q < 4; ++q) {
      const int task = q * NTHREADS + tid;
      const int tg = task >> 7, cp = task & 127, n = 2 * (cp & 63);
      const int cch = 1024 + (cp >> 6) * 256 + g * 128 + n;
      float o0[8], o1[8];
      {
        float r0[11], r1[11];
#pragma unroll
        for (int i = 0; i < 11; ++i) { r0[i] = bflo(raw[q][i]); r1[i] = bfhi(raw[q][i]); }
        const float w0 = p.conv_w[cch], w1 = p.conv_w[D_XBC + cch], w2 = p.conv_w[2 * D_XBC + cch], w3 = p.conv_w[3 * D_XBC + cch], cb = p.conv_b[cch];
        const float v0 = p.conv_w[cch + 1], v1 = p.conv_w[D_XBC + cch + 1], v2 = p.conv_w[2 * D_XBC + cch + 1], v3 = p.conv_w[3 * D_XBC + cch + 1], vb_ = p.conv_b[cch + 1];
#pragma unroll
        for (int i = 0; i < 8; ++i) { o0[i] = conv_silu(r0, i, w0, w1, w2, w3, cb); o1[i] = conv_silu(r1, i, v0, v1, v2, v3, vb_); }
      }
      bf16_t* rowm = (cp < 64 ? Bc : Cc) + (tg * 8) * SLD + n;
#pragma unroll
      for (int i = 0; i < 8; ++i) *(unsigned*)(rowm + i * SLD) = pack_bf16(o0[i], o1[i]);
      if (cp < 64) {
        u32x4 w; w.x = pack_bf16(o0[0], o0[1]); w.y = pack_bf16(o0[2], o0[3]); w.z = pack_bf16(o0[4], o0[5]); w.w = pack_bf16(o0[6], o0[7]);
        *(u32x4*)(BcT + n * SLD + tg * 8) = w;
        u32x4 w2_; w2_.x = pack_bf16(o1[0], o1[1]); w2_.y = pack_bf16(o1[2], o1[3]); w2_.z = pack_bf16(o1[4], o1[5]); w2_.w = pack_bf16(o1[6], o1[7]);
        *(u32x4*)(BcT + (n + 1) * SLD + tg * 8) = w2_;
      }
    }
  }
  float xraw[4][11];
#define SSD_LOAD_X(r_)                                                                                              \
  _Pragma("unroll") for (int q = 0; q < 4; ++q) {                                                                   \
    const int task = (q & 1) * NTHREADS + tid; const int tg = task >> 6, cch = (h0 + 2 * (r_) + (q >> 1)) * 64 + (task & 63); \
    _Pragma("unroll") for (int i = 0; i < 11; ++i) { const int l = tg * 8 + i - 3;                                  \
      const bf16_t* src = (l >= 0 || c > 0) ? proj + (size_t)(t0 + l) * NPROJ : projmb + (size_t)(16 + l) * DPROJ;  \
      xraw[q][i] = bf2f(src[OFF_XBC + cch]); } }
  SSD_LOAD_X(0)
  __syncthreads();
  if (hsel == 0) {
#pragma unroll
    for (int q = 0; q < 4; ++q) {
      const int idx = q * NTHREADS + tid, row = idx >> 4, ck = idx & 15;
      *(u32x4*)(ccb + (size_t)(t0 + row) * 256 + g * 128 + ck * 8) = *(const u32x4*)(Cc + row * SLD + ck * 8);
    }
  }
  const int ql = lane & 31, hh = lane >> 5;
  auto ydiag = [&](const int hi, const int il) __attribute__((always_inline)) {
    const int h = h0 + hi, ip = wid & 1;
    const bf16_t* xTb = xT + (hi & 1) * 64 * SLD;
    const float dskip = p.d_skip[h];
    const float* acsh = acs + hi * 128;
    const float* dtlh = dtl + hi * 128;
    const int l = 32 * il + ql;
    const float acl = acsh[l];
    f32x16 yacc;
#pragma unroll
    for (int r = 0; r < 16; ++r) yacc[r] = 0.f;
    const bf16_t* xrow = xTb + (32 * ip + ql) * SLD + 4 * hh;
#pragma unroll 1
    for (int is = 0; is <= il; ++is) {
      f32x16 x;
#pragma unroll
      for (int r = 0; r < 16; ++r) x[r] = 0.f;
      const bf16_t* ap = Bc + (32 * is + ql) * SLD + 8 * hh;
      const bf16_t* bp = Cc + l * SLD + 8 * hh;
#pragma unroll
      for (int ks = 0; ks < 8; ++ks) x = __builtin_amdgcn_mfma_f32_32x32x16_bf16(*(const bf16x8*)(ap + 16 * ks), *(const bf16x8*)(bp + 16 * ks), x, 0, 0, 0);
      u32x4 pw[2];
#pragma unroll
      for (int s2 = 0; s2 < 2; ++s2) {
        float mv[8];
#pragma unroll
        for (int q = 0; q < 2; ++q) {
          const int sb = 32 * is + 16 * s2 + 8 * q + 4 * hh;
          const f32x4 as4 = *(const f32x4*)(acsh + sb), dt4 = *(const f32x4*)(dtlh + sb);
#pragma unroll
          for (int j = 0; j < 4; ++j) {
            const int sr = sb + j;
            float v = sr <= l ? x[8 * s2 + 4 * q + j] * __expf(acl - as4[j]) * dt4[j] : 0.f;
            if (sr == l) v += dskip;
            mv[4 * q + j] = v;
          }
        }
        pw[s2].x = pack_bf16(mv[0], mv[1]); pw[s2].y = pack_bf16(mv[2], mv[3]); pw[s2].z = pack_bf16(mv[4], mv[5]); pw[s2].w = pack_bf16(mv[6], mv[7]);
      }
#pragma unroll
      for (int s2 = 0; s2 < 2; ++s2) {
        const u32x2 va = *(const u32x2*)(xrow + 32 * is + 16 * s2), vc = *(const u32x2*)(xrow + 32 * is + 16 * s2 + 8);
        u32x4 aw; aw.x = va.x; aw.y = va.y; aw.z = vc.x; aw.w = vc.y;
        yacc = __builtin_amdgcn_mfma_f32_32x32x16_bf16(*(bf16x8*)&aw, *(bf16x8*)&pw[s2], yacc, 0, 0, 0);
      }
    }
    float* yp = ypart + (size_t)(t0 + l) * 1024 + h * 64 + 32 * ip + 4 * hh;
#pragma unroll
    for (int rg = 0; rg < 4; ++rg) *(f32x4*)(yp + 8 * rg) = (f32x4){yacc[4 * rg], yacc[4 * rg + 1], yacc[4 * rg + 2], yacc[4 * rg + 3]};
  };
  auto states = [&](const int hi) __attribute__((always_inline)) {
    const int h = h0 + hi, ip = wid & 1, in = wid >> 1;
    const bf16_t* xTb = xT + (hi & 1) * 64 * SLD;
    const float* wlh = wl + hi * 128;
    f32x16 sacc;
#pragma unroll
    for (int r = 0; r < 16; ++r) sacc[r] = 0.f;
    const bf16_t* ap = xTb + (32 * ip + ql) * SLD + 8 * hh;
    const bf16_t* bp = BcT + (32 * in + ql) * SLD + 8 * hh;
#pragma unroll
    for (int ks = 0; ks < 8; ++ks) {
      const u32x4 xa = *(const u32x4*)(ap + 16 * ks);
      const f32x4 wa = *(const f32x4*)(wlh + 16 * ks + 8 * hh), wb = *(const f32x4*)(wlh + 16 * ks + 8 * hh + 4);
      u32x4 aw;
      aw.x = pack_bf16(bflo(xa.x) * wa[0], bfhi(xa.x) * wa[1]); aw.y = pack_bf16(bflo(xa.y) * wa[2], bfhi(xa.y) * wa[3]);
      aw.z = pack_bf16(bflo(xa.z) * wb[0], bfhi(xa.z) * wb[1]); aw.w = pack_bf16(bflo(xa.w) * wb[2], bfhi(xa.w) * wb[3]);
      sacc = __builtin_amdgcn_mfma_f32_32x32x16_bf16(*(bf16x8*)&aw, *(const bf16x8*)(bp + 16 * ks), sacc, 0, 0, 0);
    }
    float* sp = sg + ((size_t)((b * 16 + c) * 16 + h) * 64 + 32 * ip + 4 * hh) * 128 + 32 * in + ql;
#pragma unroll
    for (int r = 0; r < 16; ++r) sp[((r & 3) + 8 * (r >> 2)) * 128] = sacc[r];
  };
#pragma unroll 1
  for (int rnd_ = 0; rnd_ < (REP_SUB == 5 ? 4 : 2); ++rnd_) {
    const int rnd = rnd_ & 1;
#pragma unroll
    for (int q = 0; q < 4; ++q) {
      const int task = (q & 1) * NTHREADS + tid; const int tg = task >> 6, pch = task & 63, cch = (h0 + 2 * rnd + (q >> 1)) * 64 + pch;
      const float w0 = p.conv_w[cch], w1 = p.conv_w[D_XBC + cch], w2 = p.conv_w[2 * D_XBC + cch], w3 = p.conv_w[3 * D_XBC + cch], cb = p.conv_b[cch];
      float o[8];
#pragma unroll
      for (int i = 0; i < 8; ++i) o[i] = conv_silu(xraw[q], i, w0, w1, w2, w3, cb);
      u32x4 w; w.x = pack_bf16(o[0], o[1]); w.y = pack_bf16(o[2], o[3]); w.z = pack_bf16(o[4], o[5]); w.w = pack_bf16(o[6], o[7]);
      *(u32x4*)(xT + (q >> 1) * 64 * SLD + pch * SLD + tg * 8) = w;
    }
    { SSD_LOAD_X((rnd + 1) & 1) }
    __syncthreads();
    ydiag(2 * rnd, wid >> 1);
    ydiag(2 * rnd + 1, 3 - (wid >> 1));
    states(2 * rnd);
    states(2 * rnd + 1);
    __syncthreads();
  }
#undef SSD_LOAD_X
  __syncthreads();
}

__device__ __forceinline__ void meta_state_item(const Params& p, unsigned char* lds, int h) {
  const int tid = threadIdx.x, g = h >> 3;
  float* xm = (float*)lds;
  float* bm = xm + 16 * 64;
  float* dtm = bm + 16 * 128;
  const float* projm = (const float*)(p.ws + WS_PROJM);
  float* smeta = (float*)(p.ws + WS_SMETA);
  for (int task = tid; task < 16 * 192; task += NTHREADS) {
    const int i = task / 192, ch = task - i * 192;
    const int cch = ch < 64 ? h * 64 + ch : 1024 + g * 128 + (ch - 64);
    float acc = p.conv_b[cch];
#pragma unroll
    for (int j = 0; j < 4; ++j) { const int mi = i - j; if (mi >= 0) acc += p.conv_w[(3 - j) * D_XBC + cch] * projm[(size_t)mi * DPROJ + OFF_XBC + cch]; }
    const float v = silu_f(acc);
    if (ch < 64) xm[i * 64 + ch] = v; else bm[i * 128 + ch - 64] = v;
  }
  if (tid < 16) dtm[tid] = softplus_f(projm[(size_t)tid * DPROJ + OFF_DT + h] + p.dt_bias[h]);
  __syncthreads();
  const float Ah = -expf(p.a_log[h]);
  const int pr = tid >> 3, n0 = (tid & 7) * 16;
  float st[16];
#pragma unroll
  for (int k = 0; k < 16; ++k) st[k] = 0.f;
  for (int i = 0; i < 16; ++i) {
    const float dtv = dtm[i], dA = expf(dtv * Ah), xdt = xm[i * 64 + pr] * dtv;
#pragma unroll
    for (int k = 0; k < 16; ++k) st[k] = fmaf(st[k], dA, xdt * bm[i * 128 + n0 + k]);
  }
#pragma unroll
  for (int k = 0; k < 16; ++k) smeta[(size_t)(h * 64 + pr) * 128 + n0 + k] = st[k];
  __syncthreads();
}

__device__ __forceinline__ void phase2(const Params& p, unsigned char* lds, int bid, int nblk) {
#pragma unroll 1
  for (int rep = 0; rep < (REP_SUB == 0 ? 2 : 1); ++rep)
    for (int item = bid; item < 256; item += nblk) attn_item(p, lds, item);
#pragma unroll 1
  for (int rep = 0; rep < (REP_SUB == 1 ? 2 : 1); ++rep)
    for (int item = bid; item < 256; item += nblk) ssd_a_item(p, lds, item);
  for (int item = bid; item < 16; item += nblk) meta_state_item(p, lds, item);
}

__device__ __forceinline__ void phase_scan(const Params& p, int bid, int nblk) {
  const float* __restrict__ sg = (const float*)(p.ws + WS_SG);
  const float* __restrict__ smeta = (const float*)(p.ws + WS_SMETA);
  const float* __restrict__ acsg = (const float*)(p.ws + WS_ACSG);
  bf16_t* __restrict__ hprev = (bf16_t*)(p.ws + WS_HPREV);
  for (int task = bid * NTHREADS + threadIdx.x; task < 64 * 2048; task += nblk * NTHREADS) {
    const int bh = task >> 11, e4 = (task & 2047) * 4;
    const int b = bh >> 4, h = bh & 15;
    f32x4 sv[16];
    float dv[16];
#pragma unroll
    for (int c = 0; c < 16; ++c) {
      sv[c] = *(const f32x4*)(sg + (size_t)((b * 16 + c) * 16 + h) * 8192 + e4);
      dv[c] = acsg[(size_t)(b * SEQ + c * 128 + 127) * 16 + h];
    }
    f32x4 H = *(const f32x4*)(smeta + (size_t)h * 8192 + e4);
#pragma unroll
    for (int c = 0; c < 16; ++c) {
      u32x2 w; w.x = pack_bf16(H[0], H[1]); w.y = pack_bf16(H[2], H[3]);
      *(u32x2*)(hprev + (size_t)((b * 16 + c) * 16 + h) * 8192 + e4) = w;
      H = H * __expf(dv[c]) + sv[c];
    }
  }
}

__device__ __forceinline__ void ssd_b_item(const Params& p, unsigned char* lds, int item) {
  const int tid = threadIdx.x, lane = tid & 63, wid = __builtin_amdgcn_readfirstlane(tid >> 6);
  const int b = item >> 6, c = (item >> 2) & 15, g = (item >> 1) & 1, lh = item & 1, h = g * 8 + wid;
  const int t0 = b * SEQ + c * 128 + lh * 64;
  const int ql = lane & 31, hh = lane >> 5;
  constexpr int YLD = 520;
  bf16_t* yoff = (bf16_t*)lds;
  const bf16_t* __restrict__ proj = (const bf16_t*)(p.ws + WS_PROJ);
  const float* __restrict__ acsg = (const float*)(p.ws + WS_ACSG);
  const bf16_t* __restrict__ ccb = (const bf16_t*)(p.ws + WS_CCB);
  const float* __restrict__ ypart = (const float*)(p.ws + WS_YPART);
  const bf16_t* __restrict__ hprev = (const bf16_t*)(p.ws + WS_HPREV);
  bf16_t* __restrict__ mixin = (bf16_t*)(p.ws + WS_HNB);
  {
    const bf16_t* hp = hprev + (size_t)((b * 16 + c) * 16 + h) * 8192 + (size_t)ql * 128 + 8 * hh;
    u32x4 hf0[8], hf1[8];
#pragma unroll
    for (int ks = 0; ks < 8; ++ks) { hf0[ks] = *(const u32x4*)(hp + 16 * ks); hf1[ks] = *(const u32x4*)(hp + 32 * 128 + 16 * ks); }
#pragma unroll
    for (int il = 0; il < 2; ++il) {
      const int lt = 32 * il + ql, t = t0 + lt;
      const bf16_t* cp = ccb + (size_t)t * 256 + g * 128 + 8 * hh;
      u32x4 cf[8];
#pragma unroll
      for (int ks = 0; ks < 8; ++ks) cf[ks] = *(const u32x4*)(cp + 16 * ks);
      const float ea = __expf(acsg[(size_t)t * 16 + h]);
      f32x16 a0, a1;
#pragma unroll
      for (int r = 0; r < 16; ++r) { a0[r] = 0.f; a1[r] = 0.f; }
#pragma unroll
      for (int ks = 0; ks < 8; ++ks) {
        a0 = __builtin_amdgcn_mfma_f32_32x32x16_bf16(*(bf16x8*)&hf0[ks], *(bf16x8*)&cf[ks], a0, 0, 0, 0);
        a1 = __builtin_amdgcn_mfma_f32_32x32x16_bf16(*(bf16x8*)&hf1[ks], *(bf16x8*)&cf[ks], a1, 0, 0, 0);
      }
      bf16_t* yr = yoff + lt * YLD + wid * 64 + 4 * hh;
#pragma unroll
      for (int rg = 0; rg < 4; ++rg) {
        u32x2 w0; w0.x = pack_bf16(ea * a0[4 * rg], ea * a0[4 * rg + 1]); w0.y = pack_bf16(ea * a0[4 * rg + 2], ea * a0[4 * rg + 3]);
        u32x2 w1; w1.x = pack_bf16(ea * a1[4 * rg], ea * a1[4 * rg + 1]); w1.y = pack_bf16(ea * a1[4 * rg + 2], ea * a1[4 * rg + 3]);
        *(u32x2*)(yr + 8 * rg) = w0;
        *(u32x2*)(yr + 32 + 8 * rg) = w1;
      }
    }
  }
  __syncthreads();
#pragma unroll
  for (int bt = 0; bt < 2; ++bt) {
    f32x4 ya[4], yb[4]; u32x4 zz[4], yo[4];
#pragma unroll
    for (int q = 0; q < 4; ++q) {
      const int lt = wid * 8 + bt * 4 + q, t = t0 + lt;
      const float* yp = ypart + (size_t)t * 1024 + g * 512 + lane * 8;
      ya[q] = *(const f32x4*)yp; yb[q] = *(const f32x4*)(yp + 4);
      zz[q] = *(const u32x4*)(proj + (size_t)t * NPROJ + OFF_Z + g * 512 + lane * 8);
      yo[q] = *(const u32x4*)(yoff + lt * YLD + lane * 8);
    }
#pragma unroll
    for (int q = 0; q < 4; ++q) {
      const int t = t0 + wid * 8 + bt * 4 + q;
      float zv[8], ov[8], y[8];
      unpack8(zz[q], zv); unpack8(yo[q], ov);
      y[0] = (ya[q][0] + ov[0]) * silu_f(zv[0]); y[1] = (ya[q][1] + ov[1]) * silu_f(zv[1]);
      y[2] = (ya[q][2] + ov[2]) * silu_f(zv[2]); y[3] = (ya[q][3] + ov[3]) * silu_f(zv[3]);
      y[4] = (yb[q][0] + ov[4]) * silu_f(zv[4]); y[5] = (yb[q][1] + ov[5]) * silu_f(zv[5]);
      y[6] = (yb[q][2] + ov[6]) * silu_f(zv[6]); y[7] = (yb[q][3] + ov[7]) * silu_f(zv[7]);
      float ss = 0.f;
#pragma unroll
      for (int i = 0; i < 8; ++i) ss += y[i] * y[i];
      ss = wave_sum(ss);
      const float rn = rsqrtf(ss * (1.f / 512) + EPS);
      u32x4 w; w.x = pack_bf16(y[0] * rn, y[1] * rn); w.y = pack_bf16(y[2] * rn, y[3] * rn); w.z = pack_bf16(y[4] * rn, y[5] * rn); w.w = pack_bf16(y[6] * rn, y[7] * rn);
      *(u32x4*)(mixin + (size_t)t * DM + 1024 + g * 512 + lane * 8) = w;
    }
  }
  __syncthreads();
}
__device__ __forceinline__ void phase3(const Params& p, unsigned char* lds, int bid, int nblk) {
  for (int item = bid; item < 256; item += nblk) ssd_b_item(p, lds, item);
}

constexpr int LDS_BYTES = 144 * 1024;

typedef const Params __attribute__((address_space(4))) * KArgPtr;
__device__ __forceinline__ Params load_params(KArgPtr k) {
  Params q;
#if defined(__HIP_DEVICE_COMPILE__)
  __builtin_memcpy(&q, k, sizeof(Params));
#endif
  return q;
}
#define PARAMS_PTR(pp) KArgPtr pp##_k = (KArgPtr)__builtin_amdgcn_kernarg_segment_ptr(); asm volatile("" : "+s"(pp##_k)); const Params pp##_v = load_params(pp##_k); const Params* pp = &pp##_v
__global__ __launch_bounds__(512, 2) void k_mega(Params p_unused) {
  extern __shared__ __attribute__((aligned(16))) unsigned char shm[];
  const int bid = blockIdx.x, nblk = gridDim.x;
  volatile LAS unsigned* xst = (volatile LAS unsigned*)(LAS unsigned char*)(shm + LDS_BYTES - 16);
  if (threadIdx.x == 0) { xst[0] = 0u; xst[1] = 0u; }
  __syncthreads();
  XcdBarrier xb;
  { PARAMS_PTR(pp); xb = xcd_barrier_post((unsigned*)(pp->ws + WS_CTL), xst); }
#ifndef REP_PHASE
#define REP_PHASE -1
#endif
#define NREP(k) ((REP_PHASE == (k)) ? 2 : 1)
#ifndef REP_ALL
#define REP_ALL 1
#endif
#pragma unroll 1
  for (int pass = 0; pass < REP_ALL; ++pass) {
  if (pass) xcd_barrier(xb);
#pragma unroll 1
  for (int rep = 0; rep < NREP(0); ++rep) { { PARAMS_PTR(pp); phase0(*pp, (float*)shm, bid, nblk); } if (rep + 1 < NREP(0)) xcd_barrier(xb); }
  xcd_barrier(xb);
#pragma unroll 1
  for (int rep = 0; rep < NREP(1); ++rep) { { PARAMS_PTR(pp); phase1(*pp, shm, bid, nblk); } xcd_barrier(xb); }
#pragma unroll 1
  for (int rep = 0; rep < NREP(2); ++rep) { { PARAMS_PTR(pp); phase2(*pp, shm, bid, nblk); } xcd_barrier(xb); }
#pragma unroll 1
  for (int rep = 0; rep < NREP(7); ++rep) { { PARAMS_PTR(pp); phase_scan(*pp, bid, nblk); } xcd_barrier(xb); }
#pragma unroll 1
  for (int rep = 0; rep < NREP(3); ++rep) { { PARAMS_PTR(pp); phase3(*pp, shm, bid, nblk); } xcd_barrier(xb); }
#pragma unroll 1
  for (int rep = 0; rep < NREP(4); ++rep) { { PARAMS_PTR(pp); phase4(*pp, shm, bid, nblk); } xcd_barrier(xb); }
#pragma unroll 1
  for (int rep = 0; rep < NREP(5); ++rep) { { PARAMS_PTR(pp); phase5(*pp, shm, bid, nblk); } xcd_barrier(xb); }
#pragma unroll 1
  for (int rep = 0; rep < NREP(6); ++rep) { { PARAMS_PTR(pp); phase6(*pp, shm, bid, nblk); } if (rep + 1 < NREP(6)) xcd_barrier(xb); }
  }
}

}

extern "C" void kernel_launch(void* const* d_in, const int* in_sizes, int n_in, void* d_out, int out_size, void* d_ws,
                              size_t ws_size, hipStream_t stream) {
  Params p{};
  p.x = (const float*)d_in[0]; p.meta = (const float*)d_in[1]; p.rel_bias = (const float*)d_in[2];
  p.ln_mix = (const float*)d_in[3]; p.w_in = (const float*)d_in[4]; p.sinks = (const float*)d_in[5];
  p.conv_w = (const float*)d_in[6]; p.conv_b = (const float*)d_in[7]; p.dt_bias = (const float*)d_in[8];
  p.a_log = (const float*)d_in[9]; p.d_skip = (const float*)d_in[10]; p.attn_norm_w = (const float*)d_in[11];
  p.ssm_norm_w = (const float*)d_in[12]; p.w_out = (const float*)d_in[13]; p.ln_ffn = (const float*)d_in[14];
  p.wq = (const float*)d_in[15]; p.keys = (const float*)d_in[16]; p.U = (const float*)d_in[17];
  p.V = (const float*)d_in[18]; p.ln_final = (const float*)d_in[19];
  p.out = (float*)d_out;
  p.ws = (unsigned char*)d_ws;

  static int grid_blocks = 0;
  if (!grid_blocks) {
    int dev = 0, cus = 0, per_cu = 0;
    (void)hipGetDevice(&dev);
    (void)hipDeviceGetAttribute(&cus, hipDeviceAttributeMultiprocessorCount, dev);
    (void)hipFuncSetAttribute((const void*)k_mega, hipFuncAttributeMaxDynamicSharedMemorySize, LDS_BYTES);
    (void)hipOccupancyMaxActiveBlocksPerMultiprocessor(&per_cu, (const void*)k_mega, NTHREADS, LDS_BYTES);
    if (per_cu > 1) per_cu = 1;
    grid_blocks = cus * per_cu;
    if (grid_blocks != 256) fprintf(stderr, "kernel_launch: expected a 256-workgroup resident grid, got %d (cus %d, per_cu %d)\n", grid_blocks, cus, per_cu);
  }
  (void)hipMemsetAsync(p.ws + WS_CTL, 0, XCD_BAR_WORDS * 4, stream);
  void* args[] = {&p};
  hipError_t e = hipLaunchCooperativeKernel((const void*)k_mega, dim3(grid_blocks), dim3(NTHREADS), args, LDS_BYTES, stream);
  if (e != hipSuccess) fprintf(stderr, "cooperative launch failed: %s (grid %d)\n", hipGetErrorString(e), grid_blocks);
}
```

```cpp
#include <hip/hip_runtime.h>
#include <math.h>
#include <stdio.h>
#include <stdint.h>

#ifndef REP_SUB
#define REP_SUB -1
#endif
namespace {
constexpr int BATCH = 4, SEQ = 2048, DM = 2048, NMETA = 16;
constexpr int T = BATCH * SEQ;
constexpr int TA = T + NMETA;
constexpr int DPROJ = 4112;
constexpr int NPROJ = 4096;
constexpr int OFF_Q = 0, OFF_K = 1024, OFF_V = 1280, OFF_Z = 1536, OFF_XBC = 2560, OFF_DT = 4096;
constexpr int D_XBC = 1536;
constexpr int NEXP = 16384;
constexpr int ROW4 = 1024;
constexpr int ROW6 = 1536;
constexpr float EPS = 1e-6f;
constexpr int NTHREADS = 512;

typedef unsigned short bf16_t;
typedef short bf16x8 __attribute__((ext_vector_type(8)));
typedef float f32x4 __attribute__((ext_vector_type(4)));
typedef float f32x2 __attribute__((ext_vector_type(2)));
typedef unsigned u32x4 __attribute__((ext_vector_type(4)));
typedef unsigned u32x2 __attribute__((ext_vector_type(2)));
typedef __bf16 bf16v2 __attribute__((ext_vector_type(2)));
typedef float f32x16v __attribute__((ext_vector_type(16)));
typedef float f32x32v __attribute__((ext_vector_type(32)));
typedef unsigned u32x6 __attribute__((ext_vector_type(6)));
#define LAS __attribute__((address_space(3)))

__device__ __forceinline__ unsigned pack_bf16(float lo, float hi) {
  f32x2 v = {lo, hi};
  bf16v2 b = __builtin_convertvector(v, bf16v2);
  return *(unsigned*)&b;
}
__device__ __forceinline__ bf16_t f2bf(float f) { return (bf16_t)(pack_bf16(f, 0.f) & 0xffffu); }
__device__ __forceinline__ float bf2f(bf16_t b) { return __uint_as_float(((unsigned)b) << 16); }
__device__ __forceinline__ float bflo(unsigned u) { return __uint_as_float(u << 16); }
__device__ __forceinline__ float bfhi(unsigned u) { return __uint_as_float(u & 0xffff0000u); }

__constant__ unsigned char kBucket[128] = {
    0, 1, 2, 3, 4, 5, 6, 7, 8, 9, 10, 11, 12, 13, 14, 15, 16, 16, 16, 17, 17, 18, 18, 18, 19, 19, 19, 20, 20, 20, 20, 21,
    21, 21, 21, 22, 22, 22, 22, 22, 23, 23, 23, 23, 23, 23, 24, 24, 24, 24, 24, 24, 25, 25, 25, 25, 25, 25, 25, 26, 26, 26, 26, 26,
    26, 26, 26, 27, 27, 27, 27, 27, 27, 27, 27, 27, 27, 28, 28, 28, 28, 28, 28, 28, 28, 28, 28, 29, 29, 29, 29, 29, 29, 29, 29, 29,
    29, 29, 29, 30, 30, 30, 30, 30, 30, 30, 30, 30, 30, 30, 30, 30, 30, 31, 31, 31, 31, 31, 31, 31, 31, 31, 31, 31, 31, 31, 31, 31};

__constant__ unsigned char kCandI[64] = {0, 0, 0, 0, 0, 0, 0, 0, 0, 0, 0, 0, 0, 0, 0, 0, 1, 1, 1, 1, 1, 1, 1, 1, 2, 2, 2, 2, 2, 3, 3, 3, 3, 4, 4, 4, 5, 5, 6, 6, 7, 7, 8, 9, 10, 11, 12, 13, 14, 15, 15, 15, 15, 15, 15, 15, 15, 15, 15, 15, 15, 15, 15, 15};
__constant__ unsigned char kCandJ[64] = {0, 1, 2, 3, 4, 5, 6, 7, 8, 9, 10, 11, 12, 13, 14, 15, 0, 1, 2, 3, 4, 5, 6, 7, 0, 1, 2, 3, 4, 0, 1, 2, 3, 0, 1, 2, 0, 1, 0, 1, 0, 1, 0, 0, 0, 0, 0, 0, 0, 0, 15, 15, 15, 15, 15, 15, 15, 15, 15, 15, 15, 15, 15, 15};

__device__ __forceinline__ float wave_sum(float v) {
  for (int o = 32; o > 0; o >>= 1) v += __shfl_xor(v, o);
  return v;
}
__device__ __forceinline__ float wave_max(float v) {
  for (int o = 32; o > 0; o >>= 1) v = fmaxf(v, __shfl_xor(v, o));
  return v;
}
__device__ __forceinline__ float silu_f(float x) { return x / (1.f + expf(-x)); }
__device__ __forceinline__ float softplus_f(float x) { return fmaxf(x, 0.f) + log1pf(expf(-fabsf(x))); }

constexpr size_t al256(size_t x) { return (x + 255) & ~(size_t)255; }
constexpr size_t WS_CTL = 0;
constexpr size_t WS_WINT = 65536;
constexpr size_t WS_WDTT = WS_WINT + (size_t)NPROJ * DM * 2;
constexpr size_t WS_WOUTT = WS_WDTT + (size_t)16 * DM * 2;
constexpr size_t WS_WQT = WS_WOUTT + (size_t)DM * DM * 2;
constexpr size_t WS_KEYS = WS_WQT + (size_t)DM * DM * 2;
constexpr size_t WS_UB = WS_KEYS + (size_t)16 * 128 * 128 * 2;
constexpr size_t WS_VB = WS_UB + (size_t)NEXP * DM * 2;
constexpr size_t WS_HNB = WS_VB + (size_t)NEXP * DM * 2;
constexpr size_t WS_PROJ = WS_HNB + (size_t)(T + 16) * DM * 2;
constexpr size_t WS_DTRAW = WS_PROJ + (size_t)T * NPROJ * 2;
constexpr size_t WS_PROJM = WS_DTRAW + (size_t)T * 16 * 4;
constexpr size_t WS_PROJMB = al256(WS_PROJM + (size_t)16 * DPROJ * 4);
constexpr size_t WS_H1B = al256(WS_PROJMB + (size_t)16 * DPROJ * 2);
constexpr size_t WS_SSQH1 = WS_H1B + (size_t)T * DM * 2;
constexpr size_t WS_STOP = al256(WS_SSQH1 + (size_t)T * 32 * 4);
constexpr size_t WS_ITOP = WS_STOP + (size_t)T * 256 * 4;
constexpr size_t WS_ACSG = al256(WS_ITOP + (size_t)T * 256 * 4);
constexpr size_t WS_CCB = WS_ACSG + (size_t)T * 16 * 4;
constexpr size_t WS_YPART = WS_CCB + (size_t)T * 256 * 2;
constexpr size_t WS_SG = WS_YPART + (size_t)T * 1024 * 4;
constexpr size_t WS_SMETA = WS_SG + (size_t)1024 * 8192 * 4;
constexpr size_t WS_HPREV = al256(WS_SMETA + (size_t)16 * 8192 * 4);
constexpr size_t WS_USC = al256(WS_HPREV + (size_t)1024 * 8192 * 2);
constexpr size_t WS_VSC = WS_USC + (size_t)NEXP * 4;
constexpr size_t WS_SCR = al256(WS_VSC + (size_t)NEXP * 4);
}

namespace pg8 {
#define PG8_LAS __attribute__((address_space(3)))
constexpr int BM = 256, BK = 64, HALF = 128, HTB = HALF * BK * 2, STAGE_BYTES = 8 * HTB, NXCD = 8, WGM = 8;
__host__ __device__ __forceinline__ int lds_byte(int r, int c) { const int st = (r >> 4) * 2 + (c >> 5), rr = r & 15, cc = c & 31, ob = rr * 64 + cc * 2; return st * 1024 + (ob ^ (((ob >> 9) & 1) << 5)); }
__host__ __device__ __forceinline__ void stage_rc(int b, int& R, int& C) { const int st = b / 1024, sb = b % 1024, swz = sb ^ (((sb >> 9) & 1) << 5); R = (st >> 1) * 16 + swz / 64; C = (st & 1) * 32 + (swz % 64) / 2; }
__host__ __device__ __forceinline__ int perm32(int rho) { const int n = rho >> 4, i = rho & 15; return 8 * (i >> 2) + 4 * n + (i & 3); }
struct Unit { int pm, pn; };
struct Gemm { const bf16_t* A; const bf16_t* Bt; int M, N, K; };
struct StaticOrder {
    int nM, nN, nwg, G, c;
    __host__ __device__ void init(int M, int N, int G_, int c_) { nM = M / BM; nN = N / BM; nwg = nM * nN; G = G_; c = c_; }
    __host__ __device__ bool next(int i, Unit& u) const {
        const long L = (long)i * G + c; if (L >= nwg) return false;
        int wgid = (int)L; { const int q = nwg / NXCD, r = nwg % NXCD, xcd = wgid % NXCD, off = wgid / NXCD; wgid = (xcd < r ? xcd * (q + 1) : r * (q + 1) + (xcd - r) * q) + off; }
        const int nig = WGM * nN, gid = wgid / nig, fm = gid * WGM, gsz = (nM - fm) < WGM ? (nM - fm) : WGM;
        u.pm = fm + ((wgid % nig) % gsz); u.pn = (wgid % nig) / gsz; return true;
    }
    __device__ __forceinline__ void a_ready(const Unit&) const {}
    __device__ __forceinline__ void done(const Unit&) const {}
};
struct EpiBf16 {
    static constexpr bool PERM = true, AFTER_DRAIN = false;
    bf16_t* O; int ldc;
    __device__ __forceinline__ void operator()(const f32x4 (&acc)[2][2][4][2], const Unit& u, int wr, int wc, int fr, int fq) const {
        const int row0 = u.pm * BM + wr * 64 + fr; const int col0 = u.pn * BM + wc * 32 + 8 * fq;
#pragma unroll
        for (int ai = 0; ai < 2; ++ai)
#pragma unroll
            for (int m = 0; m < 4; ++m) { bf16_t* rowp = O + (size_t)(row0 + ai * HALF + m * 16) * ldc + col0;
#pragma unroll
                for (int bj = 0; bj < 2; ++bj) { const f32x4 v0 = acc[ai][bj][m][0], v1 = acc[ai][bj][m][1];
                    u32x4 w; w.x = pack_bf16(v0[0], v0[1]); w.y = pack_bf16(v0[2], v0[3]); w.z = pack_bf16(v1[0], v1[1]); w.w = pack_bf16(v1[2], v1[3]);
                    *(u32x4*)(rowp + bj * HALF) = w; } }
    }
};

struct EpiRes {
    static constexpr bool PERM = true, AFTER_DRAIN = false;
    const float* X; bf16_t* HB; float* SSQ;
    __device__ __forceinline__ void operator()(const f32x4 (&acc)[2][2][4][2], const Unit& u, int wr, int wc, int fr, int fq) const {
        const int row0 = u.pm * BM + wr * 64 + fr; const int col0 = u.pn * BM + wc * 32 + 8 * fq;
#pragma unroll
        for (int ai = 0; ai < 2; ++ai) {
            f32x4 xr[4][2][2];
#pragma unroll
            for (int m = 0; m < 4; ++m) { const size_t off = (size_t)(row0 + ai * HALF + m * 16) * DM + col0;
#pragma unroll
                for (int bj = 0; bj < 2; ++bj) { xr[m][bj][0] = *(const f32x4*)(X + off + bj * HALF); xr[m][bj][1] = *(const f32x4*)(X + off + bj * HALF + 4); } }
#pragma unroll
            for (int m = 0; m < 4; ++m) { const int row = row0 + ai * HALF + m * 16; const size_t off = (size_t)row * DM + col0; float ss = 0.f;
#pragma unroll
                for (int bj = 0; bj < 2; ++bj) {
                    const f32x4 v0 = acc[ai][bj][m][0] + xr[m][bj][0], v1 = acc[ai][bj][m][1] + xr[m][bj][1];
                    u32x4 w; w.x = pack_bf16(v0[0], v0[1]); w.y = pack_bf16(v0[2], v0[3]); w.z = pack_bf16(v1[0], v1[1]); w.w = pack_bf16(v1[2], v1[3]);
                    *(u32x4*)(HB + off + bj * HALF) = w;
                    ss += v0[0] * v0[0] + v0[1] * v0[1] + v0[2] * v0[2] + v0[3] * v0[3] + v1[0] * v1[0] + v1[1] * v1[1] + v1[2] * v1[2] + v1[3] * v1[3]; }
                ss += __shfl_xor(ss, 16); ss += __shfl_xor(ss, 32);
                if (fq == 0) SSQ[(size_t)row * 32 + u.pn * 4 + wc] = ss; }
        }
    }
};
struct EpiF32 {
    static constexpr bool PERM = true, AFTER_DRAIN = false;
    float* C; int ldc;
    __device__ __forceinline__ void operator()(const f32x4 (&acc)[2][2][4][2], const Unit& u, int wr, int wc, int fr, int fq) const {
        const int row0 = u.pm * BM + wr * 64 + fr; const int col0 = u.pn * BM + wc * 32 + 8 * fq;
#pragma unroll
        for (int ai = 0; ai < 2; ++ai)
#pragma unroll
            for (int m = 0; m < 4; ++m) { float* rowp = C + (size_t)(row0 + ai * HALF + m * 16) * ldc + col0;
#pragma unroll
                for (int bj = 0; bj < 2; ++bj) { *(f32x4*)(rowp + bj * HALF) = acc[ai][bj][m][0]; *(f32x4*)(rowp + bj * HALF + 4) = acc[ai][bj][m][1]; } }
    }
};

struct EpiScores {
    static constexpr bool PERM = true, AFTER_DRAIN = true;
    const bf16_t* KEYS;
    float* STOP; int* ITOP;
    static constexpr int QLD = 264;
    __device__ __forceinline__ void fused(f32x4 (&acc)[2][2][4][2], const Unit& u, int wr, int wc, int fr, int fq, PG8_LAS unsigned char* lds, int wid, int lane) const {
        PG8_LAS bf16_t* Q = (PG8_LAS bf16_t*)lds;
#pragma unroll
        for (int ai = 0; ai < 2; ++ai)
#pragma unroll
            for (int m = 0; m < 4; ++m) { const int row = ai * HALF + wr * 64 + m * 16 + fr;
#pragma unroll
                for (int bj = 0; bj < 2; ++bj) { const f32x4 v0 = acc[ai][bj][m][0], v1 = acc[ai][bj][m][1];
                    u32x4 w; w.x = pack_bf16(v0[0], v0[1]); w.y = pack_bf16(v0[2], v0[3]); w.z = pack_bf16(v1[0], v1[1]); w.w = pack_bf16(v1[2], v1[3]);
                    *(PG8_LAS u32x4*)(Q + row * QLD + bj * HALF + wc * 32 + 8 * fq) = w; } }
        __syncthreads();
        const int h = u.pn;
#pragma unroll 1
        for (int c = 0; c < 2; ++c) {
            f32x4 sc[8][2];
#pragma unroll
            for (int kf = 0; kf < 8; ++kf) { sc[kf][0] = (f32x4){0.f, 0.f, 0.f, 0.f}; sc[kf][1] = (f32x4){0.f, 0.f, 0.f, 0.f}; }
            const bf16_t* kb = KEYS + (size_t)((h * 2 + c) * 128 + fr) * 128 + 8 * fq;
            const PG8_LAS bf16_t* qb = Q + (wid * 32 + fr) * QLD + c * 128 + 8 * fq;
#pragma unroll
            for (int ks = 0; ks < 4; ++ks) {
                const bf16x8 q0 = *(const PG8_LAS bf16x8*)(qb + 32 * ks), q1 = *(const PG8_LAS bf16x8*)(qb + 16 * QLD + 32 * ks);
#pragma unroll
                for (int kf = 0; kf < 8; ++kf) { const bf16x8 kv = *(const bf16x8*)(kb + (size_t)kf * 16 * 128 + 32 * ks);
                    sc[kf][0] = __builtin_amdgcn_mfma_f32_16x16x32_bf16(kv, q0, sc[kf][0], 0, 0, 0);
                    sc[kf][1] = __builtin_amdgcn_mfma_f32_16x16x32_bf16(kv, q1, sc[kf][1], 0, 0, 0); }
            }
#pragma unroll
            for (int tf = 0; tf < 2; ++tf) {
                int v[32];
#pragma unroll
                for (int kf = 0; kf < 8; ++kf)
#pragma unroll
                    for (int r = 0; r < 4; ++r) {
                        const int bts = (int)__float_as_uint(sc[kf][tf][r]);
                        const int srt = bts ^ ((bts >> 31) & 0x7fffffff);
                        v[kf * 4 + r] = (srt & ~127) | (16 * kf + 4 * fq + r);
                    }
#pragma unroll
                for (int k = 2; k <= 32; k <<= 1)
#pragma unroll
                    for (int j = k >> 1; j > 0; j >>= 1)
#pragma unroll
                        for (int i = 0; i < 32; ++i) {
                            const int l = i ^ j;
                            if (l > i) {
                                const int x = v[i], y = v[l];
                                const int hi_ = x > y ? x : y, lo_ = x > y ? y : x;
                                if ((i & k) == 0) { v[i] = hi_; v[l] = lo_; } else { v[i] = lo_; v[l] = hi_; }
                            }
                        }
#pragma unroll
                for (int step = 0; step < 2; ++step) {
                    const int xm = step == 0 ? 16 : 32;
                    int m[16];
#pragma unroll
                    for (int i = 0; i < 16; ++i) { const int o = __shfl_xor(v[15 - i], xm); m[i] = v[i] > o ? v[i] : o; }
#pragma unroll
                    for (int j = 8; j > 0; j >>= 1)
#pragma unroll
                        for (int i = 0; i < 16; ++i) {
                            const int l = i ^ j;
                            if (l > i) { const int x = m[i], y = m[l]; m[i] = x > y ? x : y; m[l] = x > y ? y : x; }
                        }
#pragma unroll
                    for (int i = 0; i < 16; ++i) v[i] = m[i];
                }
                if (fq == 0) {
                    const size_t obase = ((size_t)(u.pm * BM + wid * 32 + tf * 16 + fr) * 16 + h * 2 + c) * 16;
#pragma unroll
                    for (int q4 = 0; q4 < 4; ++q4) {
                        f32x4 sv; u32x4 iv;
#pragma unroll
                        for (int i = 0; i < 4; ++i) {
                            const int key = v[4 * q4 + i], srt = key & ~127;
                            sv[i] = __uint_as_float((unsigned)(srt ^ ((srt >> 31) & 0x7fffffff)));
                            iv[i] = (unsigned)(key & 127);
                        }
                        *(f32x4*)(STOP + obase + 4 * q4) = sv;
                        *(u32x4*)(ITOP + obase + 4 * q4) = iv;
                    }
                }
            }
        }
    }
};

template <class Epi, class Sched>
__device__ __forceinline__ void gemm_phase(PG8_LAS unsigned char* lds, const Gemm g, const Sched& S, const Epi& E) {
    int tid_ = threadIdx.x; asm volatile("" : "+v"(tid_));
    const int tid = tid_, wid = __builtin_amdgcn_readfirstlane(tid >> 6), lane = tid & 63, wr = wid >> 2, wc = wid & 3, fr = lane & 15, fq = lane >> 4;
    const int K = g.K, nt = K / BK;
    unsigned voffA[2], voffB[2];
#pragma unroll
    for (int i = 0; i < 2; ++i) { int R, C; stage_rc(tid * 16 + i * 8192, R, C); const int Rb = Epi::PERM ? ((R & ~31) + perm32(R & 31)) : R;
        voffA[i] = (unsigned)(R * K + C) * 2u; voffB[i] = (unsigned)(Rb * K + C) * 2u; }
    const size_t kstep = (size_t)(BK * 2);
    const size_t hstep = (size_t)HALF * K * 2;
    const size_t tstep = 2 * hstep;
    const unsigned ldsw = (unsigned)wid * 1024u;
    const int aoff = lds_byte(wr * 64 + fr, fq * 8), boff = lds_byte(wc * 32 + fr, fq * 8);
#define PG8_SA(b, h) (((b) * 2 + (h)) * HTB)
#define PG8_SB(b, h) ((4 + (b) * 2 + (h)) * HTB)
#define PG8_STAGE(bufoff, gbase, voff) do { _Pragma("unroll") for (int _i = 0; _i < 2; ++_i) \
        __builtin_amdgcn_global_load_lds((const unsigned*)((const char*)(gbase) + (voff)[_i]), (PG8_LAS unsigned*)(lds + (bufoff) + ldsw + _i * 8192), 16, 0, 0); } while (0)
#define PG8_LDA(dst, b, h) do { _Pragma("unroll") for (int m = 0; m < 4; ++m) _Pragma("unroll") for (int k = 0; k < 2; ++k) dst[m][k] = *(const PG8_LAS bf16x8*)(lds + PG8_SA(b, h) + aoff + m * 2048 + k * 1024); } while (0)
#define PG8_LDB(dst, b, h) do { _Pragma("unroll") for (int n = 0; n < 2; ++n) _Pragma("unroll") for (int k = 0; k < 2; ++k) dst[n][k] = *(const PG8_LAS bf16x8*)(lds + PG8_SB(b, h) + boff + n * 2048 + k * 1024); } while (0)
#define PG8_MMA(ai, bj, At, Bt) do { __builtin_amdgcn_s_setprio(1); _Pragma("unroll") for (int m = 0; m < 4; ++m) _Pragma("unroll") for (int n = 0; n < 2; ++n) _Pragma("unroll") for (int k = 0; k < 2; ++k) \
        acc[ai][bj][m][n] = __builtin_amdgcn_mfma_f32_16x16x32_bf16(Bt[n][k], At[m][k], acc[ai][bj][m][n], 0, 0, 0); __builtin_amdgcn_s_setprio(0); } while (0)
#define PG8_WAIT_V(n) asm volatile("s_waitcnt vmcnt(" #n ")" ::: "memory")
#define PG8_WAIT_L(n) asm volatile("s_waitcnt lgkmcnt(" #n ")" ::: "memory")
#define PG8_BAR __builtin_amdgcn_s_barrier()
#define PG8_SCHED __builtin_amdgcn_sched_barrier(0)
    Unit cur, nxt; int ui = 0;
    if (!S.next(0, cur)) return;
    f32x4 acc[2][2][4][2];
#pragma unroll
    for (int a = 0; a < 2; ++a)
#pragma unroll
        for (int b = 0; b < 2; ++b)
#pragma unroll
            for (int m = 0; m < 4; ++m)
#pragma unroll
                for (int n = 0; n < 2; ++n) acc[a][b][m][n] = (f32x4){0.f, 0.f, 0.f, 0.f};
    bf16x8 At[4][2], B0[2][2], B1[2][2];
    const char* cA = (const char*)g.A + (size_t)cur.pm * tstep; const char* cB = (const char*)g.Bt + (size_t)cur.pn * tstep;
    S.a_ready(cur);
    PG8_STAGE(PG8_SB(0, 0), cB, voffB); PG8_STAGE(PG8_SA(0, 0), cA, voffA); PG8_STAGE(PG8_SB(0, 1), cB + hstep, voffB); PG8_STAGE(PG8_SA(0, 1), cA + hstep, voffA);
    if (wr == 1) PG8_BAR;
    PG8_WAIT_V(4); PG8_BAR;
    PG8_STAGE(PG8_SB(1, 0), cB + kstep, voffB); PG8_STAGE(PG8_SA(1, 0), cA + kstep, voffA); PG8_STAGE(PG8_SB(1, 1), cB + hstep + kstep, voffB);
    PG8_WAIT_V(6); PG8_BAR;
    for (;;) {
        const bool has_next = S.next(ui + 1, nxt);
        const char* nA = has_next ? (const char*)g.A + (size_t)nxt.pm * tstep : cA; const char* nB = has_next ? (const char*)g.Bt + (size_t)nxt.pn * tstep : cB;
        for (int t = 0; t < nt; t += 2) {
            const bool last = (t == nt - 2);
            const char* a1 = cA + (size_t)(t + 1) * kstep;
            const char* a2 = last ? nA : cA + (size_t)(t + 2) * kstep; const char* b2 = last ? nB : cB + (size_t)(t + 2) * kstep;
            const char* a3 = a2 + kstep; const char* b3 = b2 + kstep;
            if (last && has_next) S.a_ready(nxt);
            PG8_LDB(B0, 0, 0); PG8_SCHED; PG8_LDA(At, 0, 0); PG8_STAGE(PG8_SA(1, 1), a1 + hstep, voffA);
            PG8_WAIT_L(8); PG8_BAR; PG8_WAIT_L(0); PG8_MMA(0, 0, At, B0); PG8_BAR; PG8_SCHED;
            PG8_LDB(B1, 0, 1); PG8_STAGE(PG8_SB(0, 0), b2, voffB);
            PG8_BAR; PG8_WAIT_L(0); PG8_MMA(0, 1, At, B1); PG8_BAR;
            PG8_LDA(At, 0, 1); PG8_STAGE(PG8_SA(0, 0), a2, voffA);
            PG8_BAR; PG8_WAIT_L(0); PG8_MMA(1, 0, At, B0); PG8_BAR; PG8_SCHED;
            PG8_STAGE(PG8_SB(0, 1), b2 + hstep, voffB);
            PG8_WAIT_V(6); PG8_BAR; PG8_MMA(1, 1, At, B1); PG8_BAR;
            PG8_LDB(B0, 1, 0); PG8_SCHED; PG8_LDA(At, 1, 0); PG8_STAGE(PG8_SA(0, 1), a2 + hstep, voffA);
            PG8_WAIT_L(8); PG8_BAR; PG8_WAIT_L(0); PG8_MMA(0, 0, At, B0); PG8_BAR; PG8_SCHED;
            PG8_LDB(B1, 1, 1); PG8_STAGE(PG8_SB(1, 0), b3, voffB);
            PG8_BAR; PG8_WAIT_L(0); PG8_MMA(0, 1, At, B1); PG8_BAR;
            PG8_LDA(At, 1, 1); PG8_STAGE(PG8_SA(1, 0), a3, voffA);
            PG8_BAR; PG8_WAIT_L(0); PG8_MMA(1, 0, At, B0); PG8_BAR; PG8_SCHED;
            PG8_STAGE(PG8_SB(1, 1), b3 + hstep, voffB);
            PG8_WAIT_V(6); PG8_BAR; PG8_MMA(1, 1, At, B1); PG8_BAR;
        }
        if constexpr (!Epi::AFTER_DRAIN) { E(acc, cur, wr, wc, fr, fq); S.done(cur); }
        if (!has_next) break;
#pragma unroll
        for (int a = 0; a < 2; ++a)
#pragma unroll
            for (int b = 0; b < 2; ++b)
#pragma unroll
                for (int m = 0; m < 4; ++m)
#pragma unroll
                    for (int n = 0; n < 2; ++n) acc[a][b][m][n] = (f32x4){0.f, 0.f, 0.f, 0.f};
        cur = nxt; cA = nA; cB = nB; ++ui;
    }
    PG8_WAIT_V(0);
    if (wr == 0) PG8_BAR;
    PG8_BAR;
    if constexpr (Epi::AFTER_DRAIN) { E.fused(acc, cur, wr, wc, fr, fq, lds, wid, lane); S.done(cur); }
#undef PG8_SA
#undef PG8_SB
#undef PG8_STAGE
#undef PG8_LDA
#undef PG8_LDB
#undef PG8_MMA
#undef PG8_WAIT_V
#undef PG8_WAIT_L
#undef PG8_BAR
#undef PG8_SCHED
}
}

#define XB_TMO      128
#define XB_XCNT(j)  (256  + 64 * (j))
#define XB_XSUB(j)  (1280 + 64 * (j))
#define XB_XGEN(j)  (2304 + 64 * (j))
#define XB_TOP      3328
#define XB_TOPGEN   3392
#define XCD_BAR_WORDS 3456
#define XB_SPIN_CAP (1u << 22)
__device__ __forceinline__ unsigned xb_ld(unsigned* p)              { return __hip_atomic_load(p, __ATOMIC_RELAXED, __HIP_MEMORY_SCOPE_AGENT); }
__device__ __forceinline__ unsigned xb_add(unsigned* p, unsigned v) { return __hip_atomic_fetch_add(p, v, __ATOMIC_RELAXED, __HIP_MEMORY_SCOPE_AGENT); }
__device__ __forceinline__ unsigned xb_xcc_id() { return (unsigned)__builtin_amdgcn_s_getreg((3 << 11) | 20) & 0xFu; }
#define XB_SPIN(cond, bar) do { unsigned _sp = 0; while (cond) { __builtin_amdgcn_s_sleep(1); \
    if ((++_sp & 255u) == 0u) { if (xb_ld(&(bar)[XB_TMO])) break; if (_sp > XB_SPIN_CAP) { atomicAdd(&(bar)[XB_TMO], 1u); break; } } } } while (0)
struct XcdBarrier { unsigned* bar; unsigned x; volatile LAS unsigned* st; };
__device__ __forceinline__ XcdBarrier xcd_barrier_post(unsigned* bar, volatile LAS unsigned* st) {
    XcdBarrier b; b.bar = bar; b.x = xb_xcc_id(); b.st = st;
    if (threadIdx.x == 0) (void)xb_add(&bar[XB_XCNT(b.x)], 1u);
    return b;
}
__device__ __forceinline__ void xcd_barrier_complete(unsigned* bar, unsigned x, unsigned& nloc, unsigned& nx) {
    const unsigned G = gridDim.x * gridDim.y * gridDim.z;
    unsigned sum, cnt, mine, sp = 0u;
    for (;;) {
        sum = 0u; cnt = 0u; mine = 0u;
#pragma unroll
        for (unsigned j = 0; j < 16; ++j) { const unsigned c = xb_ld(&bar[XB_XCNT(j)]); sum += c; cnt += (c > 0u) ? 1u : 0u; mine = (j == x) ? c : mine; }
        if (sum == G) break;
        __builtin_amdgcn_s_sleep(1);
        if ((++sp & 255u) == 0u) { if (xb_ld(&bar[XB_TMO])) break; if (sp > XB_SPIN_CAP) { atomicAdd(&bar[XB_TMO], 1u); break; } }
    }
    nloc = mine > 0u ? mine : 1u; nx = cnt > 0u ? cnt : 1u;
}
__device__ __forceinline__ void xcd_barrier(const XcdBarrier& b) {
    asm volatile("s_waitcnt vmcnt(0)" ::: "memory");
    __syncthreads();
    if (threadIdx.x == 0) {
        unsigned* bar = b.bar;
        const unsigned bx = xb_xcc_id();
        __builtin_amdgcn_s_waitcnt(0);
        unsigned nloc = b.st[0], nx = b.st[1];
        if (nloc == 0u) { xcd_barrier_complete(bar, bx, nloc, nx); b.st[0] = nloc; b.st[1] = nx; }
        const unsigned old = xb_add(&bar[XB_XSUB(bx)], 1u);
        const unsigned gen = old / nloc;
        if (old + 1u == (gen + 1u) * nloc) {
            __builtin_amdgcn_fence(__ATOMIC_RELEASE, "agent");
            asm volatile("s_waitcnt vmcnt(0)" ::: "memory");
            const unsigned og = xb_add(&bar[XB_TOP], 1u);
            const unsigned tg = og / nx;
            if (og + 1u == (tg + 1u) * nx) xb_add(&bar[XB_TOPGEN], 1u);
            else XB_SPIN(xb_ld(&bar[XB_TOPGEN]) == tg, bar);
            __builtin_amdgcn_fence(__ATOMIC_ACQUIRE, "agent");
            xb_add(&bar[XB_XGEN(bx)], 1u);
            asm volatile("s_waitcnt vmcnt(0)" ::: "memory");
        } else {
            XB_SPIN(xb_ld(&bar[XB_XGEN(bx)]) == gen, bar);
            __builtin_amdgcn_fence(__ATOMIC_ACQUIRE, "agent");
            asm volatile("s_waitcnt vmcnt(0)" ::: "memory");
        }
    }
    __syncthreads();
}

namespace {
struct Params {
  const float *x, *meta, *rel_bias, *ln_mix, *w_in, *sinks, *conv_w, *conv_b, *dt_bias, *a_log, *d_skip, *attn_norm_w,
      *ssm_norm_w, *w_out, *ln_ffn, *wq, *keys, *U, *V, *ln_final;
  float* out;
  unsigned char* ws;
};

__device__ __forceinline__ void p0_transpose_tile(const float* __restrict__ W, int ldw, bf16_t* __restrict__ Wt, const float* sc0,
                                                  const float* sc1, int k0, int n0, float* tile) {
  const int tid = threadIdx.x;
  {
    const int r = tid >> 6, c4 = (tid & 63) * 4;
    f32x4 v[8];
#pragma unroll
    for (int i = 0; i < 8; ++i) v[i] = *(const f32x4*)(W + (size_t)(k0 + r + 8 * i) * ldw + n0 + c4);
#pragma unroll
    for (int i = 0; i < 8; ++i) {
      float s = 1.f;
      const int k = k0 + r + 8 * i;
      if (sc0) s = k < 1024 ? sc0[k] : sc1[k - 1024];
      float* q = tile + (r + 8 * i) * 257 + c4;
      q[0] = v[i][0] * s; q[1] = v[i][1] * s; q[2] = v[i][2] * s; q[3] = v[i][3] * s;
    }
  }
  __syncthreads();
#pragma unroll
  for (int it = 0; it < 4; ++it) {
    const int task = it * NTHREADS + tid;
    const int n = task >> 3, kc = (task & 7) * 8;
    float v[8];
#pragma unroll
    for (int j = 0; j < 8; ++j) v[j] = tile[(kc + j) * 257 + n];
    u32x4 w; w.x = pack_bf16(v[0], v[1]); w.y = pack_bf16(v[2], v[3]); w.z = pack_bf16(v[4], v[5]); w.w = pack_bf16(v[6], v[7]);
    *(u32x4*)(Wt + (size_t)(n0 + n) * DM + k0 + kc) = w;
  }
  __syncthreads();
}

__device__ __forceinline__ void phase0(const Params& p, float* ldsf, int bid, int nblk) {
  const int tid = threadIdx.x, lane = tid & 63, wid = tid >> 6;
  bf16_t* w_inT = (bf16_t*)(p.ws + WS_WINT);
  bf16_t* w_dtT = (bf16_t*)(p.ws + WS_WDTT);
  bf16_t* w_outT = (bf16_t*)(p.ws + WS_WOUTT);
  bf16_t* wqT = (bf16_t*)(p.ws + WS_WQT);
  bf16_t* keysb = (bf16_t*)(p.ws + WS_KEYS);
  unsigned char* ub = p.ws + WS_UB;
  unsigned char* vb = p.ws + WS_VB;
  bf16_t* hnb = (bf16_t*)(p.ws + WS_HNB);
  constexpr int U_HN = (TA + 7) / 8;
  constexpr int U_WIN = 32 * 16, U_WOUT = 32 * 8, U_WQ = 32 * 8, U_WDT = 1, U_KEYS = 64;
  constexpr int B_WIN = U_HN, B_WOUT = B_WIN + U_WIN, B_WQ = B_WOUT + U_WOUT, B_WDT = B_WQ + U_WQ, B_KEYS = B_WDT + U_WDT,
                B_U = B_KEYS + U_KEYS, B_END = B_U;
  for (int u = bid; u < B_END; u += nblk) {
    if (u < B_WIN) {
      const int t = u * 8 + wid;
      if (t < TA) {
        const float* src = t < T ? p.x + (size_t)t * DM : p.meta + (size_t)(t - T) * DM;
        float4 v[8];
        float ss = 0.f;
#pragma unroll
        for (int i = 0; i < 8; ++i) {
          v[i] = *(const float4*)(src + (i * 64 + lane) * 4);
          ss += v[i].x * v[i].x + v[i].y * v[i].y + v[i].z * v[i].z + v[i].w * v[i].w;
        }
        ss = wave_sum(ss);
        const float r = rsqrtf(ss * (1.f / DM) + EPS);
#pragma unroll
        for (int i = 0; i < 8; ++i) {
          const float4 w = *(const float4*)(p.ln_mix + (i * 64 + lane) * 4);
          u32x2 o; o.x = pack_bf16(v[i].x * r * w.x, v[i].y * r * w.y); o.y = pack_bf16(v[i].z * r * w.z, v[i].w * r * w.w);
          *(u32x2*)(hnb + (size_t)t * DM + (i * 64 + lane) * 4) = o;
        }
      }
    } else if (u < B_WOUT) {
      const int i = u - B_WIN;
      p0_transpose_tile(p.w_in, DPROJ, w_inT, nullptr, nullptr, (i & 31) * 64, (i >> 5) * 256, ldsf);
    } else if (u < B_WQ) {
      const int i = u - B_WOUT;
      p0_transpose_tile(p.w_out, DM, w_outT, p.attn_norm_w, p.ssm_norm_w, (i & 31) * 64, (i >> 5) * 256, ldsf);
    } else if (u < B_WDT) {
      const int i = u - B_WQ;
      p0_transpose_tile(p.wq, DM, wqT, p.ln_ffn, p.ln_ffn + 1024, (i & 31) * 64, (i >> 5) * 256, ldsf);
    } else if (u < B_KEYS) {
      for (int idx = tid; idx < DM * 16; idx += NTHREADS) {
        const int k = idx >> 4, j = idx & 15;
        w_dtT[(size_t)j * DM + k] = f2bf(p.w_in[(size_t)k * DPROJ + NPROJ + j]);
      }
    } else if (u < B_U) {
      const size_t base = (size_t)(u - B_KEYS) * 4096 + (size_t)tid * 8;
      const float4 a = *(const float4*)(p.keys + base), b = *(const float4*)(p.keys + base + 4);
      u32x4 w; w.x = pack_bf16(a.x, a.y); w.y = pack_bf16(a.z, a.w); w.z = pack_bf16(b.x, b.y); w.w = pack_bf16(b.z, b.w);
      *(u32x4*)(keysb + base) = w;
    }
  }
  {
    const int gw = bid * 8 + wid, nw = nblk * 8;
    auto load_row = [&](f32x4 (&a)[8], const int r2) __attribute__((always_inline)) {
      const float* src = (r2 < NEXP ? p.U + (size_t)r2 * DM : p.V + (size_t)(r2 - NEXP) * DM) + lane * 4;
#pragma unroll
      for (int j = 0; j < 8; ++j) a[j] = *(const f32x4*)(src + 256 * j);
    };
    auto conv_row = [&](f32x4 (&a)[8], const int r2) __attribute__((always_inline)) {
      const bool isU = r2 < NEXP;
      const int row = isU ? r2 : r2 - NEXP;
      if (isU) {
#pragma unroll
        for (int j = 0; j < 8; ++j) a[j] *= *(const f32x4*)(p.ln_ffn + lane * 4 + 256 * j);
      }
      float amax = 0.f;
#pragma unroll
      for (int j = 0; j < 8; ++j) amax = fmaxf(amax, fmaxf(fmaxf(fabsf(a[j][0]), fabsf(a[j][1])), fmaxf(fabsf(a[j][2]), fabsf(a[j][3]))));
      amax = wave_max(amax);
      const float s4 = amax > 0.f ? 6.f / amax : 1.f;
      u32x4 w4;
#pragma unroll
      for (int j = 0; j < 4; ++j) {
        unsigned w = 0;
        w = __builtin_amdgcn_cvt_scalef32_pk_fp4_f32(w, a[2 * j][0] * s4, a[2 * j][1] * s4, 1.0f, 0);
        w = __builtin_amdgcn_cvt_scalef32_pk_fp4_f32(w, a[2 * j][2] * s4, a[2 * j][3] * s4, 1.0f, 1);
        w = __builtin_amdgcn_cvt_scalef32_pk_fp4_f32(w, a[2 * j + 1][0] * s4, a[2 * j + 1][1] * s4, 1.0f, 2);
        w = __builtin_amdgcn_cvt_scalef32_pk_fp4_f32(w, a[2 * j + 1][2] * s4, a[2 * j + 1][3] * s4, 1.0f, 3);
        w4[j] = w;
      }
      *(u32x4*)((isU ? ub : vb) + (size_t)row * ROW4 + lane * 16) = w4;
      if (lane == 0) ((float*)(p.ws + (isU ? WS_USC : WS_VSC)))[row] = amax > 0.f ? amax * (1.f / 6.f) : 1.f;
    };
    f32x4 ra[8], rb[8];
    int r2 = gw;
    if (r2 < 2 * NEXP) load_row(ra, r2);
#pragma unroll 1
    for (; r2 < 2 * NEXP; r2 += 2 * nw) {
      if (r2 + nw < 2 * NEXP) load_row(rb, r2 + nw);
      conv_row(ra, r2);
      if (r2 + nw < 2 * NEXP) {
        if (r2 + 2 * nw < 2 * NEXP) load_row(ra, r2 + 2 * nw);
        conv_row(rb, r2 + nw);
      }
    }
  }
}

__device__ __forceinline__ void mini_gemm(const bf16_t* __restrict__ A, const bf16_t* __restrict__ Bt, float* __restrict__ out, int ldo,
                                          float* red, bf16_t* __restrict__ outb = nullptr) {
  const int tid = threadIdx.x, lane = tid & 63, wid = tid >> 6, fr = lane & 15, fq = lane >> 4;
  f32x4 acc = {0.f, 0.f, 0.f, 0.f};
  const bf16_t* ap = A + (size_t)fr * DM + wid * 256 + fq * 8;
  const bf16_t* bp = Bt + (size_t)fr * DM + wid * 256 + fq * 8;
#pragma unroll
  for (int ks = 0; ks < 8; ++ks) {
    const bf16x8 a = *(const bf16x8*)(ap + ks * 32);
    const bf16x8 b = *(const bf16x8*)(bp + ks * 32);
    acc = __builtin_amdgcn_mfma_f32_16x16x32_bf16(a, b, acc, 0, 0, 0);
  }
#pragma unroll
  for (int r = 0; r < 4; ++r) red[wid * 256 + (4 * fq + r) * 16 + fr] = acc[r];
  __syncthreads();
  if (tid < 256) {
    float s = 0.f;
#pragma unroll
    for (int w = 0; w < 8; ++w) s += red[w * 256 + tid];
    out[(size_t)(tid >> 4) * ldo + (tid & 15)] = s;
    if (outb) outb[(size_t)(tid >> 4) * ldo + (tid & 15)] = f2bf(s);
  }
  __syncthreads();
}

__device__ __forceinline__ void phase1(const Params& p, unsigned char* lds, int bid, int nblk) {
  const bf16_t* hnb = (const bf16_t*)(p.ws + WS_HNB);
  const bf16_t* w_inT = (const bf16_t*)(p.ws + WS_WINT);
  const bf16_t* w_dtT = (const bf16_t*)(p.ws + WS_WDTT);
  float* dtraw = (float*)(p.ws + WS_DTRAW);
  float* projm = (float*)(p.ws + WS_PROJM);
  constexpr int NU = 512 + 32 + 96 + 1;
  for (int u = bid; u < NU; u += nblk) {
    if (u < 512) {
      mini_gemm(hnb + (size_t)u * 16 * DM, w_dtT, dtraw + (size_t)u * 16 * 16, 16, (float*)lds);
    } else {
      const int j = u - 512;
      const int cf = j < 32 ? 64 + j : (j < 128 ? 160 + (j - 32) : 256);
      const bf16_t* bt = cf < 256 ? w_inT + (size_t)cf * 16 * DM : w_dtT;
      mini_gemm(hnb + (size_t)T * DM, bt, projm + cf * 16, DPROJ, (float*)lds, (bf16_t*)(p.ws + WS_PROJMB) + cf * 16);
    }
  }
  pg8::Gemm g{hnb, w_inT, T, NPROJ, DM};
  pg8::StaticOrder S; S.init(T, NPROJ, nblk, bid);
  pg8::EpiBf16 E{(bf16_t*)(p.ws + WS_PROJ), NPROJ};
  pg8::gemm_phase<pg8::EpiBf16, pg8::StaticOrder>((PG8_LAS unsigned char*)lds, g, S, E);
}

__device__ __forceinline__ void phase4(const Params& p, unsigned char* lds, int bid, int nblk) {
  pg8::Gemm g{(const bf16_t*)(p.ws + WS_HNB), (const bf16_t*)(p.ws + WS_WOUTT), T, DM, DM};
  pg8::StaticOrder S; S.init(T, DM, nblk, bid);
  pg8::EpiRes E{p.x, (bf16_t*)(p.ws + WS_H1B), (float*)(p.ws + WS_SSQH1)};
  pg8::gemm_phase<pg8::EpiRes, pg8::StaticOrder>((PG8_LAS unsigned char*)lds, g, S, E);
}
__device__ __forceinline__ void phase5(const Params& p, unsigned char* lds, int bid, int nblk) {
  pg8::Gemm g{(const bf16_t*)(p.ws + WS_H1B), (const bf16_t*)(p.ws + WS_WQT), T, DM, DM};
  pg8::StaticOrder S; S.init(T, DM, nblk, bid);
  pg8::EpiScores E{(const bf16_t*)(p.ws + WS_KEYS), (float*)(p.ws + WS_STOP), (int*)(p.ws + WS_ITOP)};
  pg8::gemm_phase<pg8::EpiScores, pg8::StaticOrder>((PG8_LAS unsigned char*)lds, g, S, E);
}

__device__ __forceinline__ float dot2bf(unsigned a, unsigned b, float c) {
  return __builtin_amdgcn_fdot2_f32_bf16(*(bf16v2*)&a, *(bf16v2*)&b, c, false);
}
__device__ __forceinline__ void phase6(const Params& p, unsigned char* lds, int bid, int nblk) {
  const int tid0 = threadIdx.x, lane0 = tid0 & 63, wid = __builtin_amdgcn_readfirstlane(tid0 >> 6);
  int* ids = (int*)(lds + wid * 2048);
  float* gts = (float*)(lds + wid * 2048 + 512);
  float* wts = (float*)(lds + wid * 2048 + 1024);
  int* rid = (int*)(lds + 16384 + wid * 1024);
  float* rgt = (float*)(lds + 16384 + wid * 1024 + 512);
  const unsigned char* ub = p.ws + WS_UB;
  const unsigned char* vb = p.ws + WS_VB;
  const bf16_t* h1b = (const bf16_t*)(p.ws + WS_H1B);
  const float* usc = (const float*)(p.ws + WS_USC);
  const float* vsc = (const float*)(p.ws + WS_VSC);
  const float* ssq = (const float*)(p.ws + WS_SSQH1);
  const float* stop = (const float*)(p.ws + WS_STOP);
  const int* itop = (const int*)(p.ws + WS_ITOP);
  const int ci = kCandI[lane0], cj = kCandJ[lane0];
#pragma unroll 1
  for (int t = bid * 8 + wid; t < T; t += nblk * 8) {
    int tid = tid0; asm volatile("" : "+v"(tid));
    const int lane = tid & 63;
    const int kcode = 8 * ((lane >> 2) & 1) + 4 * ((lane >> 3) & 1) + 2 * ((lane >> 4) & 1) + ((lane >> 5) & 1);
    const float part0 = lane < 32 ? ssq[(size_t)t * 32 + lane] : 0.f;
    const float rr = rsqrtf(wave_sum(part0) * (1.f / DM) + EPS);
#pragma unroll 1
    for (int h = 0; h < 8; ++h) {
      const size_t lbase = ((size_t)t * 16 + h * 2) * 16;
      const float sv = lane < 32 ? stop[lbase + lane] : 0.f;
      const int iv = lane < 32 ? itop[lbase + lane] : 0;
      float cand = (__shfl(sv, ci) + __shfl(sv, 16 + cj)) * rr;
      if (lane >= 50) cand = -INFINITY;
      unsigned key = __float_as_uint(cand);
      key = (key & 0x80000000u) ? ~key : (key | 0x80000000u);
      key = (key & ~63u) | (unsigned)(63 - lane);
      int rank = 0;
#pragma unroll
      for (int k = 0; k < 50; ++k) {
        const unsigned kk = (unsigned)__builtin_amdgcn_readlane((int)key, k);
        rank += kk > key ? 1 : 0;
      }
      const float cmax = wave_max(cand);
      const float ex = rank < 16 ? __expf(cand - cmax) : 0.f;
      const float den = wave_sum(ex);
      const int eidx = __shfl(iv, ci) * 128 + __shfl(iv, 16 + cj);
      if (rank < 16) { rid[h * 16 + rank] = eidx; rgt[h * 16 + rank] = ex / den; }
    }
    {
      const int e0 = rid[lane], e1 = rid[lane + 64];
      const float g0 = rgt[lane], g1 = rgt[lane + 64];
      const int r0 = e0 >> 10, r1 = e1 >> 10;
      const unsigned long long ltm = (1ull << lane) - 1ull;
      int run = 0, pos0 = 0, pos1 = 0;
#pragma unroll
      for (int R = 0; R < 16; ++R) {
        const unsigned long long m0 = __ballot(r0 == R), m1 = __ballot(r1 == R);
        const int c0 = __popcll(m0), c1 = __popcll(m1);
        if (r0 == R) pos0 = run + __popcll(m0 & ltm);
        if (r1 == R) pos1 = run + c0 + __popcll(m1 & ltm);
        run += c0 + c1;
      }
      ids[pos0] = e0; gts[pos0] = g0;
      ids[pos1] = e1; gts[pos1] = g1;
    }
    float xf[32];
    {
      const bf16_t* xp = h1b + (size_t)t * DM + lane * 4;
#pragma unroll
      for (int j = 0; j < 8; ++j) {
        const u32x2 xa = *(const u32x2*)(xp + 256 * j);
        xf[4 * j + 0] = bflo(xa.x); xf[4 * j + 1] = bfhi(xa.x); xf[4 * j + 2] = bflo(xa.y); xf[4 * j + 3] = bfhi(xa.y);
      }
    }
#pragma unroll 1
    for (int rnd = 0; rnd < 8; ++rnd) {
      u32x4 ra[16];
#pragma unroll
      for (int k = 0; k < 16; ++k) {
        const int e = __builtin_amdgcn_readfirstlane(ids[rnd * 16 + k]);
        ra[k] = *(const u32x4*)(ub + (size_t)e * ROW4 + lane * 16);
      }
      float part[16];
      float prev = 0.f;
#pragma unroll
      for (int k = 0; k < 16; ++k) {
        asm volatile("" : "+v"(ra[k]) : "v"(prev));
        float d0 = 0.f, d1 = 0.f;
#define U4_STEP(j, i) { const f32x2 r = __builtin_amdgcn_cvt_scalef32_pk_f32_fp4(ra[k][j], 1.0f, i); \
          d0 = fmaf(r[0], xf[8 * (j) + 2 * (i)], d0); d1 = fmaf(r[1], xf[8 * (j) + 2 * (i) + 1], d1); }
#pragma unroll
        for (int j = 0; j < 4; ++j) { U4_STEP(j, 0) U4_STEP(j, 1) U4_STEP(j, 2) U4_STEP(j, 3) }
#undef U4_STEP
        prev = d0 + d1;
        part[k] = prev;
      }
      float q8[8], q4[4], q2[2], q1;
      { const bool hi = (lane >> 5) & 1;
#pragma unroll
        for (int i = 0; i < 8; ++i) { const float keep = hi ? part[2 * i + 1] : part[2 * i], send = hi ? part[2 * i] : part[2 * i + 1]; q8[i] = keep + __shfl_xor(send, 32); } }
      { const bool hi = (lane >> 4) & 1;
#pragma unroll
        for (int i = 0; i < 4; ++i) { const float keep = hi ? q8[2 * i + 1] : q8[2 * i], send = hi ? q8[2 * i] : q8[2 * i + 1]; q4[i] = keep + __shfl_xor(send, 16); } }
      { const bool hi = (lane >> 3) & 1;
#pragma unroll
        for (int i = 0; i < 2; ++i) { const float keep = hi ? q4[2 * i + 1] : q4[2 * i], send = hi ? q4[2 * i] : q4[2 * i + 1]; q2[i] = keep + __shfl_xor(send, 8); } }
      { const bool hi = (lane >> 2) & 1;
        const float keep = hi ? q2[1] : q2[0], send = hi ? q2[0] : q2[1]; q1 = keep + __shfl_xor(send, 4); }
      q1 += __shfl_xor(q1, 2);
      q1 += __shfl_xor(q1, 1);
      {
        const int kk = rnd * 16 + kcode;
        const int eid = ids[kk];
        const float a = q1 * rr * usc[eid];
        const float ge = 0.5f * a * (1.f + erff(a * 0.70710678118654752f));
        if ((lane & 3) == 0) wts[kk] = gts[kk] * ge * vsc[eid];
      }
    }
    float acc[32];
#pragma unroll
    for (int i = 0; i < 32; ++i) acc[i] = 0.f;
#pragma unroll 1
    for (int rnd = 0; rnd < 8; ++rnd) {
      u32x4 ra[16];
#pragma unroll
      for (int k = 0; k < 16; ++k) {
        const int e = __builtin_amdgcn_readfirstlane(ids[rnd * 16 + k]);
        ra[k] = *(const u32x4*)(vb + (size_t)e * ROW4 + lane * 16);
      }
      f32x4 wv[4];
#pragma unroll
      for (int j = 0; j < 4; ++j) wv[j] = *(const f32x4*)(wts + rnd * 16 + 4 * j);
#pragma unroll
      for (int k = 0; k < 16; ++k) {
        const float wk = wv[k >> 2][k & 3];
        asm volatile("" : "+v"(ra[k]) : "v"(acc[1]), "v"(acc[3]), "v"(acc[5]), "v"(acc[7]), "v"(acc[9]), "v"(acc[11]), "v"(acc[13]), "v"(acc[15]),
                                        "v"(acc[17]), "v"(acc[19]), "v"(acc[21]), "v"(acc[23]), "v"(acc[25]), "v"(acc[27]), "v"(acc[29]), "v"(acc[31]));
#define V4_STEP(j, i) { const f32x2 r = __builtin_amdgcn_cvt_scalef32_pk_f32_fp4(ra[k][j], 1.0f, i); \
            acc[8 * (j) + 2 * (i)] = fmaf(wk, r[0], acc[8 * (j) + 2 * (i)]); acc[8 * (j) + 2 * (i) + 1] = fmaf(wk, r[1], acc[8 * (j) + 2 * (i) + 1]); }
#pragma unroll
        for (int j = 0; j < 4; ++j) { V4_STEP(j, 0) V4_STEP(j, 1) V4_STEP(j, 2) V4_STEP(j, 3) }
#undef V4_STEP
      }
    }
    float ss = 0.f;
#pragma unroll
    for (int i = 0; i < 32; ++i) { acc[i] += xf[i]; ss += acc[i] * acc[i]; }
    ss = wave_sum(ss);
    const float rf = rsqrtf(ss * (1.f / DM) + EPS);
#pragma unroll
    for (int j = 0; j < 8; ++j) {
      const f32x4 lw = *(const f32x4*)(p.ln_final + 256 * j + lane * 4);
      *(f32x4*)(p.out + (size_t)t * DM + 256 * j + lane * 4) = (f32x4){acc[4 * j] * rf * lw[0], acc[4 * j + 1] * rf * lw[1], acc[4 * j + 2] * rf * lw[2], acc[4 * j + 3] * rf * lw[3]};
    }
  }
}

typedef float f32x16 __attribute__((ext_vector_type(16)));
__device__ __forceinline__ void unpack8(const u32x4 a, float (&v)[8]) {
  v[0] = bflo(a.x); v[1] = bfhi(a.x); v[2] = bflo(a.y); v[3] = bfhi(a.y); v[4] = bflo(a.z); v[5] = bfhi(a.z); v[6] = bflo(a.w); v[7] = bfhi(a.w);
}
constexpr int VT_LD = 196;
constexpr int ATT_VT_BYTES = 4 * 64 * VT_LD * 2;
__device__ __forceinline__ void attn_item(const Params& p, unsigned char* lds, int item) {
  const int tid = threadIdx.x, lane = tid & 63, wid = __builtin_amdgcn_readfirstlane(tid >> 6);
  const int b = item >> 6, q0 = (item & 63) * 32;
  bf16_t* VT = (bf16_t*)lds;
  float* biasL = (float*)(lds + ATT_VT_BYTES);
  float* ssqw = biasL + 16 * 132;
  const bf16_t* proj = (const bf16_t*)(p.ws + WS_PROJ);
  const float* projm = (const float*)(p.ws + WS_PROJM);
  bf16_t* mixin = (bf16_t*)(p.ws + WS_HNB);
#pragma unroll
  for (int it = 0; it < 5; ++it) {
    const int idx = it * NTHREADS + tid;
    if (idx >= 16 * 129) break;
    const int hq = idx / 129, d = idx - hq * 129;
    const int bk = d < 128 ? (int)kBucket[d] : 31;
    biasL[hq * 132 + d] = p.rel_bias[bk * 16 + hq];
  }
  const int ql = lane & 31, ql0 = ql, hh = lane >> 5, kvh = wid >> 1;
  const int trow = b * SEQ + q0 + ql;
  bf16x8 qf[4];
  u32x4 kf[6][4];
#define ATT_LOAD_Q(hq_)                                                                                                           \
  { _Pragma("unroll") for (int ks = 0; ks < 4; ++ks) qf[ks] = *(const bf16x8*)(proj + (size_t)trow * NPROJ + OFF_Q + (hq_) * 64 + ks * 16 + hh * 8); }
#define ATT_LOAD_K()                                                                                                              \
  {                                                                                                                               \
    int ql = ql0; asm volatile("" : "+v"(ql));     \
    const float* kr_ = projm + (size_t)(ql & 15) * DPROJ + OFF_K + kvh * 64 + hh * 8;                                             \
    _Pragma("unroll") for (int ks = 0; ks < 4; ++ks) {                                                                            \
      const f32x4 a_ = *(const f32x4*)(kr_ + ks * 16), c_ = *(const f32x4*)(kr_ + ks * 16 + 4);                                   \
      kf[0][ks].x = pack_bf16(a_[0], a_[1]); kf[0][ks].y = pack_bf16(a_[2], a_[3]); kf[0][ks].z = pack_bf16(c_[0], c_[1]); kf[0][ks].w = pack_bf16(c_[2], c_[3]); } \
    _Pragma("unroll") for (int jt = 1; jt < 6; ++jt) {                                                                            \
      int sp_ = q0 - 128 + 32 * (jt - 1) + ql; sp_ = sp_ < 0 ? 0 : sp_;                                                           \
      const bf16_t* kp_ = proj + (size_t)(b * SEQ + sp_) * NPROJ + OFF_K + kvh * 64 + hh * 8;                                     \
      _Pragma("unroll") for (int ks = 0; ks < 4; ++ks) kf[jt][ks] = *(const u32x4*)(kp_ + ks * 16); }                             \
  }
  ATT_LOAD_Q(2 * wid)
#pragma unroll 1
  for (int rep_ = 0; rep_ < (REP_SUB == 2 ? 2 : 1); ++rep_) {
    u32x4 ra[5], rc[5];
#pragma unroll
    for (int q = 0; q < 5; ++q) {
      const int task = q * NTHREADS + tid, ch = task / 80, pi = task - ch * 80;
      int s0 = q0 - 128 + 2 * pi;
      s0 = s0 < 0 ? 0 : s0;
      const bf16_t* r0 = proj + (size_t)(b * SEQ + s0) * NPROJ + OFF_V + ch * 8;
      ra[q] = *(const u32x4*)r0; rc[q] = *(const u32x4*)(r0 + NPROJ);
    }
    float m0[8], m1[8];
    {
      const int pi = tid & 7, ch = (tid >> 3) & 31;
      const float* r0 = projm + (size_t)(2 * pi) * DPROJ + OFF_V + ch * 8;
      const f32x4 ma = *(const f32x4*)r0, mb = *(const f32x4*)(r0 + 4), mc = *(const f32x4*)(r0 + DPROJ), md = *(const f32x4*)(r0 + DPROJ + 4);
      const float keep = tid < 256 ? 1.f : 0.f;
#pragma unroll
      for (int i = 0; i < 4; ++i) { m0[i] = ma[i] * keep; m0[4 + i] = mb[i] * keep; m1[i] = mc[i] * keep; m1[4 + i] = md[i] * keep; }
      bf16_t* dst = VT + (size_t)((ch >> 3) * 64 + (ch & 7) * 8) * VT_LD + 2 * pi + (tid < 256 ? 0 : 16);
#pragma unroll
      for (int i = 0; i < 8; ++i) *(unsigned*)(dst + i * VT_LD) = pack_bf16(m0[i], m1[i]);
    }
#pragma unroll
    for (int q = 0; q < 5; ++q) {
      const int task = q * NTHREADS + tid, ch = task / 80, pi = task - ch * 80;
      float v0[8], v1[8];
      unpack8(ra[q], v0); unpack8(rc[q], v1);
      bf16_t* dst = VT + (size_t)((ch >> 3) * 64 + (ch & 7) * 8) * VT_LD + 32 + 2 * pi;
#pragma unroll
      for (int i = 0; i < 8; ++i) *(unsigned*)(dst + i * VT_LD) = pack_bf16(v0[i], v1[i]);
    }
  }
  __syncthreads();
  float ssq = 0.f;
#pragma unroll 1
  for (int rep_ = 0; rep_ < (REP_SUB == 3 ? 2 : 1); ++rep_) {
  ssq = 0.f;
  auto do_head = [&](const int hsel) __attribute__((always_inline)) {
    const int hq = 2 * wid + hsel;
    f32x16 sacc[6];
#pragma unroll
    for (int jt = 0; jt < 6; ++jt) {
      f32x16 acc;
#pragma unroll
      for (int r = 0; r < 16; ++r) acc[r] = 0.f;
#pragma unroll
      for (int ks = 0; ks < 4; ++ks) acc = __builtin_amdgcn_mfma_f32_32x32x16_bf16(*(bf16x8*)&kf[jt][ks], qf[ks], acc, 0, 0, 0);
      sacc[jt] = acc;
    }
    if (hsel == 0) { ATT_LOAD_Q(2 * wid + 1) }
    const float* bl = biasL + hq * 132;
    int sq = q0 + ql, qh = ql - 4 * hh;
    asm volatile("" : "+v"(sq), "+v"(qh));
    const float sink = p.sinks[hq];
    float m = sink;
#pragma unroll
    for (int jt = 0; jt < 6; ++jt) {
      asm volatile("" ::: "memory");
#pragma unroll
      for (int r = 0; r < 16; ++r) {
        const int kr = (r & 3) + 8 * (r >> 2) + 4 * hh;
        int dist; bool valid;
        if (jt == 0) { dist = sq + (16 - ((r & 3) + 8 * (r >> 2))) - 4 * hh; valid = kr < 16; }
        else { dist = qh + (128 - 32 * (jt - 1) - ((r & 3) + 8 * (r >> 2))); valid = (dist >= 0) && (dist < 128) && (dist <= sq); }
        const int dc = dist < 0 ? 0 : (dist > 128 ? 128 : dist);
        const float l = valid ? 0.125f * sacc[jt][r] + bl[dc] : -1e30f;
        sacc[jt][r] = l;
        m = fmaxf(m, l);
      }
    }
    m = fmaxf(m, __shfl_xor(m, 32));
    float sum = 0.f;
    f32x16 oacc0, oacc1;
#pragma unroll
    for (int r = 0; r < 16; ++r) { oacc0[r] = 0.f; oacc1[r] = 0.f; }
    const bf16_t* vrow0 = VT + (size_t)(kvh * 64 + ql) * VT_LD + 4 * hh;
    const bf16_t* vrow1 = vrow0 + 32 * VT_LD;
#pragma unroll
    for (int jt = 0; jt < 6; ++jt) {
      u32x4 pw[2];
#pragma unroll
      for (int s2 = 0; s2 < 2; ++s2) {
        float e[8];
#pragma unroll
        for (int i = 0; i < 8; ++i) { e[i] = __expf(sacc[jt][8 * s2 + i] - m); sum += e[i]; }
        pw[s2].x = pack_bf16(e[0], e[1]); pw[s2].y = pack_bf16(e[2], e[3]); pw[s2].z = pack_bf16(e[4], e[5]); pw[s2].w = pack_bf16(e[6], e[7]);
      }
#pragma unroll
      for (int s2 = 0; s2 < 2; ++s2) {
        const u32x2 va = *(const u32x2*)(vrow0 + 32 * jt + 16 * s2), vc = *(const u32x2*)(vrow0 + 32 * jt + 16 * s2 + 8);
        const u32x2 vd = *(const u32x2*)(vrow1 + 32 * jt + 16 * s2), ve = *(const u32x2*)(vrow1 + 32 * jt + 16 * s2 + 8);
        u32x4 v0w; v0w.x = va.x; v0w.y = va.y; v0w.z = vc.x; v0w.w = vc.y;
        u32x4 v1w; v1w.x = vd.x; v1w.y = vd.y; v1w.z = ve.x; v1w.w = ve.y;
        oacc0 = __builtin_amdgcn_mfma_f32_32x32x16_bf16(*(bf16x8*)&v0w, *(bf16x8*)&pw[s2], oacc0, 0, 0, 0);
        oacc1 = __builtin_amdgcn_mfma_f32_32x32x16_bf16(*(bf16x8*)&v1w, *(bf16x8*)&pw[s2], oacc1, 0, 0, 0);
      }
    }
    sum += __shfl_xor(sum, 32);
    const float inv = 1.f / (sum + __expf(sink - m));
#pragma unroll
    for (int r = 0; r < 16; ++r) { oacc0[r] *= inv; oacc1[r] *= inv; ssq += oacc0[r] * oacc0[r] + oacc1[r] * oacc1[r]; }
#pragma unroll
    for (int rg = 0; rg < 4; ++rg) {
      u32x2 w; w.x = pack_bf16(oacc0[rg * 4 + 0], oacc0[rg * 4 + 1]); w.y = pack_bf16(oacc0[rg * 4 + 2], oacc0[rg * 4 + 3]);
      *(u32x2*)(mixin + (size_t)trow * DM + hq * 64 + 8 * rg + 4 * hh) = w;
      u32x2 w1; w1.x = pack_bf16(oacc1[rg * 4 + 0], oacc1[rg * 4 + 1]); w1.y = pack_bf16(oacc1[rg * 4 + 2], oacc1[rg * 4 + 3]);
      *(u32x2*)(mixin + (size_t)trow * DM + hq * 64 + 32 + 8 * rg + 4 * hh) = w1;
    }
  };
  ATT_LOAD_K()
  do_head(0);
  asm volatile("" ::: "memory");
  ATT_LOAD_K()
  do_head(1);
  }
  ssq += __shfl_xor(ssq, 32);
  if (lane < 32) ssqw[wid * 32 + lane] = ssq;
  __syncthreads();
  float tot = 0.f;
#pragma unroll
  for (int w = 0; w < 8; ++w) tot += ssqw[w * 32 + ql];
  const float ra = rsqrtf(tot * (1.f / 1024) + EPS);
#pragma unroll
  for (int hsel = 0; hsel < 2; ++hsel)
#pragma unroll
    for (int dt = 0; dt < 2; ++dt)
#pragma unroll
      for (int rg = 0; rg < 4; ++rg) {
        bf16_t* op = mixin + (size_t)trow * DM + (2 * wid + hsel) * 64 + 32 * dt + 8 * rg + 4 * hh;
        const u32x2 v = *(const u32x2*)op;
        u32x2 w; w.x = pack_bf16(bflo(v.x) * ra, bfhi(v.x) * ra); w.y = pack_bf16(bflo(v.y) * ra, bfhi(v.y) * ra);
        *(u32x2*)op = w;
      }
  __syncthreads();
}
#undef ATT_LOAD_Q
#undef ATT_LOAD_K
__device__ __forceinline__ void phase2_attn(const Params& p, unsigned char* lds, int bid, int nblk) {
  for (int item = bid; item < 256; item += nblk) attn_item(p, lds, item);
}

constexpr int SLD = 136;
__device__ __forceinline__ float conv_silu(const float (&raw)[11], int i, float w0, float w1, float w2, float w3, float cb) {
  return silu_f(cb + w0 * raw[i] + w1 * raw[i + 1] + w2 * raw[i + 2] + w3 * raw[i + 3]);
}
__device__ __forceinline__ void ssd_a_item(const Params& p, unsigned char* lds, int item) {
  const int tid = threadIdx.x, lane = tid & 63, wid = __builtin_amdgcn_readfirstlane(tid >> 6);
  const int b = item >> 6, c = (item >> 2) & 15, g = (item >> 1) & 1, hsel = item & 1;
  const int h0 = g * 8 + hsel * 4;
  const int t0 = b * SEQ + c * 128;
  bf16_t* Bc = (bf16_t*)lds;
  bf16_t* Cc = Bc + 128 * SLD;
  bf16_t* BcT = Cc + 128 * SLD;
  bf16_t* xT = BcT + 128 * SLD;
  float* dtl = (float*)(xT + 2 * 64 * SLD);
  float* acs = dtl + 512;
  float* wl = acs + 512;
  float* scan = wl + 512;
  const bf16_t* __restrict__ proj = (const bf16_t*)(p.ws + WS_PROJ);
  const bf16_t* __restrict__ projmb = (const bf16_t*)(p.ws + WS_PROJMB);
  const float* __restrict__ dtraw = (const float*)(p.ws + WS_DTRAW);
  float* __restrict__ acsg = (float*)(p.ws + WS_ACSG);
  bf16_t* __restrict__ ccb = (bf16_t*)(p.ws + WS_CCB);
  float* __restrict__ ypart = (float*)(p.ws + WS_YPART);
  float* __restrict__ sg = (float*)(p.ws + WS_SG);
  {
    const int hi = tid >> 7, l = tid & 127, h = h0 + hi;
    const float Ah = -expf(p.a_log[h]);
    const float dtv = softplus_f(dtraw[(size_t)(t0 + l) * 16 + h] + p.dt_bias[h]);
    dtl[tid] = dtv;
    float cum = dtv * Ah;
#pragma unroll
    for (int o = 1; o < 64; o <<= 1) { const float nb = __shfl_up(cum, o); if (lane >= o) cum += nb; }
    if ((tid & 127) == 63) scan[hi] = cum;
    __syncthreads();
    if (l >= 64) cum += scan[hi];
    acs[tid] = cum;
    acsg[(size_t)(t0 + l) * 16 + h] = cum;
    __syncthreads();
    wl[tid] = dtv * __expf(acs[hi * 128 + 127] - cum);
  }
  {
    unsigned raw[4][11];
#pragma unroll
    for (int q = 0; q < 4; ++q) {
      const int task = q * NTHREADS + tid;
      const int tg = task >> 7, cp = task & 127;
      const int cch = 1024 + (cp >> 6) * 256 + g * 128 + 2 * (cp & 63);
#pragma unroll
      for (int i = 0; i < 11; ++i) {
        const int l = tg * 8 + i - 3;
        const bf16_t* src = (l >= 0 || c > 0) ? proj + (size_t)(t0 + l) * NPROJ : projmb + (size_t)(16 + l) * DPROJ;
        raw[q][i] = *(const unsigned*)(src + OFF_XBC + cch);
      }
    }
#pragma unroll
    for (int q = 0; q < 4; ++q) {
      const int task = q * NTHREADS + tid;
      const int tg = task >> 7, cp = task & 127, n = 2 * (cp & 63);
      const int cch = 1024 + (cp >> 6) * 256 + g * 128 + n;
      float o0[8], o1[8];
      {
        float r0[11], r1[11];
#pragma unroll
        for (int i = 0; i < 11; ++i) { r0[i] = bflo(raw[q][i]); r1[i] = bfhi(raw[q][i]); }
        const float w0 = p.conv_w[cch], w1 = p.conv_w[D_XBC + cch], w2 = p.conv_w[2 * D_XBC + cch], w3 = p.conv_w[3 * D_XBC + cch], cb = p.conv_b[cch];
        const float v0 = p.conv_w[cch + 1], v1 = p.conv_w[D_XBC + cch + 1], v2 = p.conv_w[2 * D_XBC + cch + 1], v3 = p.conv_w[3 * D_XBC + cch + 1], vb_ = p.conv_b[cch + 1];
#pragma unroll
        for (int i = 0; i < 8; ++i) { o0[i] = conv_silu(r0, i, w0, w1, w2, w3, cb); o1[i] = conv_silu(r1, i, v0, v1, v2, v3, vb_); }
      }
      bf16_t* rowm = (cp < 64 ? Bc : Cc) + (tg * 8) * SLD + n;
#pragma unroll
      for (int i = 0; i < 8; ++i) *(unsigned*)(rowm + i * SLD) = pack_bf16(o0[i], o1[i]);
      if (cp < 64) {
        u32x4 w; w.x = pack_bf16(o0[0], o0[1]); w.y = pack_bf16(o0[2], o0[3]); w.z = pack_bf16(o0[4], o0[5]); w.w = pack_bf16(o0[6], o0[7]);
        *(u32x4*)(BcT + n * SLD + tg * 8) = w;
        u32x4 w2_; w2_.x = pack_bf16(o1[0], o1[1]); w2_.y = pack_bf16(o1[2], o1[3]); w2_.z = pack_bf16(o1[4], o1[5]); w2_.w = pack_bf16(o1[6], o1[7]);
        *(u32x4*)(BcT + (n + 1) * SLD + tg * 8) = w2_;
      }
    }
  }
  float xraw[4][11];
#define SSD_LOAD_X(r_)                                                                                              \
  _Pragma("unroll") for (int q = 0; q < 4; ++q) {                                                                   \
    const int task = (q & 1) * NTHREADS + tid; const int tg = task >> 6, cch = (h0 + 2 * (r_) + (q >> 1)) * 64 + (task & 63); \
    _Pragma("unroll") for (int i = 0; i < 11; ++i) { const int l = tg * 8 + i - 3;                                  \
      const bf16_t* src = (l >= 0 || c > 0) ? proj + (size_t)(t0 + l) * NPROJ : projmb + (size_t)(16 + l) * DPROJ;  \
      xraw[q][i] = bf2f(src[OFF_XBC + cch]); } }
  SSD_LOAD_X(0)
  __syncthreads();
  if (hsel == 0) {
#pragma unroll
    for (int q = 0; q < 4; ++q) {
      const int idx = q * NTHREADS + tid, row = idx >> 4, ck = idx & 15;
      *(u32x4*)(ccb + (size_t)(t0 + row) * 256 + g * 128 + ck * 8) = *(const u32x4*)(Cc + row * SLD + ck * 8);
    }
  }
  const int ql = lane & 31, hh = lane >> 5;
  auto ydiag = [&](const int hi, const int il) __attribute__((always_inline)) {
    const int h = h0 + hi, ip = wid & 1;
    const bf16_t* xTb = xT + (hi & 1) * 64 * SLD;
    const float dskip = p.d_skip[h];
    const float* acsh = acs + hi * 128;
    const float* dtlh = dtl + hi * 128;
    const int l = 32 * il + ql;
    const float acl = acsh[l];
    f32x16 yacc;
#pragma unroll
    for (int r = 0; r < 16; ++r) yacc[r] = 0.f;
    const bf16_t* xrow = xTb + (32 * ip + ql) * SLD + 4 * hh;
#pragma unroll 1
    for (int is = 0; is <= il; ++is) {
      f32x16 x;
#pragma unroll
      for (int r = 0; r < 16; ++r) x[r] = 0.f;
      const bf16_t* ap = Bc + (32 * is + ql) * SLD + 8 * hh;
      const bf16_t* bp = Cc + l * SLD + 8 * hh;
#pragma unroll
      for (int ks = 0; ks < 8; ++ks) x = __builtin_amdgcn_mfma_f32_32x32x16_bf16(*(const bf16x8*)(ap + 16 * ks), *(const bf16x8*)(bp + 16 * ks), x, 0, 0, 0);
      u32x4 pw[2];
#pragma unroll
      for (int s2 = 0; s2 < 2; ++s2) {
        float mv[8];
#pragma unroll
        for (int q = 0; q < 2; ++q) {
          const int sb = 32 * is + 16 * s2 + 8 * q + 4 * hh;
          const f32x4 as4 = *(const f32x4*)(acsh + sb), dt4 = *(const f32x4*)(dtlh + sb);
#pragma unroll
          for (int j = 0; j < 4; ++j) {
            const int sr = sb + j;
            float v = sr <= l ? x[8 * s2 + 4 * q + j] * __expf(acl - as4[j]) * dt4[j] : 0.f;
            if (sr == l) v += dskip;
            mv[4 * q + j] = v;
          }
        }
        pw[s2].x = pack_bf16(mv[0], mv[1]); pw[s2].y = pack_bf16(mv[2], mv[3]); pw[s2].z = pack_bf16(mv[4], mv[5]); pw[s2].w = pack_bf16(mv[6], mv[7]);
      }
#pragma unroll
      for (int s2 = 0; s2 < 2; ++s2) {
        const u32x2 va = *(const u32x2*)(xrow + 32 * is + 16 * s2), vc = *(const u32x2*)(xrow + 32 * is + 16 * s2 + 8);
        u32x4 aw; aw.x = va.x; aw.y = va.y; aw.z = vc.x; aw.w = vc.y;
        yacc = __builtin_amdgcn_mfma_f32_32x32x16_bf16(*(bf16x8*)&aw, *(bf16x8*)&pw[s2], yacc, 0, 0, 0);
      }
    }
    float* yp = ypart + (size_t)(t0 + l) * 1024 + h * 64 + 32 * ip + 4 * hh;
#pragma unroll
    for (int rg = 0; rg < 4; ++rg) *(f32x4*)(yp + 8 * rg) = (f32x4){yacc[4 * rg], yacc[4 * rg + 1], yacc[4 * rg + 2], yacc[4 * rg + 3]};
  };
  auto states = [&](const int hi) __attribute__((always_inline)) {
    const int h = h0 + hi, ip = wid & 1, in = wid >> 1;
    const bf16_t* xTb = xT + (hi & 1) * 64 * SLD;
    const float* wlh = wl + hi * 128;
    f32x16 sacc;
#pragma unroll
    for (int r = 0; r < 16; ++r) sacc[r] = 0.f;
    const bf16_t* ap = xTb + (32 * ip + ql) * SLD + 8 * hh;
    const bf16_t* bp = BcT + (32 * in + ql) * SLD + 8 * hh;
#pragma unroll
    for (int ks = 0; ks < 8; ++ks) {
      const u32x4 xa = *(const u32x4*)(ap + 16 * ks);
      const f32x4 wa = *(const f32x4*)(wlh + 16 * ks + 8 * hh), wb = *(const f32x4*)(wlh + 16 * ks + 8 * hh + 4);
      u32x4 aw;
      aw.x = pack_bf16(bflo(xa.x) * wa[0], bfhi(xa.x) * wa[1]); aw.y = pack_bf16(bflo(xa.y) * wa[2], bfhi(xa.y) * wa[3]);
      aw.z = pack_bf16(bflo(xa.z) * wb[0], bfhi(xa.z) * wb[1]); aw.w = pack_bf16(bflo(xa.w) * wb[2], bfhi(xa.w) * wb[3]);
      sacc = __builtin_amdgcn_mfma_f32_32x32x16_bf16(*(bf16x8*)&aw, *(const bf16x8*)(bp + 16 * ks), sacc, 0, 0, 0);
    }
    float* sp = sg + ((size_t)((b * 16 + c) * 16 + h) * 64 + 32 * ip + 4 * hh) * 128 + 32 * in + ql;
#pragma unroll
    for (int r = 0; r < 16; ++r) sp[((r & 3) + 8 * (r >> 2)) * 128] = sacc[r];
  };
#pragma unroll 1
  for (int rnd_ = 0; rnd_ < (REP_SUB == 5 ? 4 : 2); ++rnd_) {
    const int rnd = rnd_ & 1;
#pragma unroll
    for (int q = 0; q < 4; ++q) {
      const int task = (q & 1) * NTHREADS + tid; const int tg = task >> 6, pch = task & 63, cch = (h0 + 2 * rnd + (q >> 1)) * 64 + pch;
      const float w0 = p.conv_w[cch], w1 = p.conv_w[D_XBC + cch], w2 = p.conv_w[2 * D_XBC + cch], w3 = p.conv_w[3 * D_XBC + cch], cb = p.conv_b[cch];
      float o[8];
#pragma unroll
      for (int i = 0; i < 8; ++i) o[i] = conv_silu(xraw[q], i, w0, w1, w2, w3, cb);
      u32x4 w; w.x = pack_bf16(o[0], o[1]); w.y = pack_bf16(o[2], o[3]); w.z = pack_bf16(o[4], o[5]); w.w = pack_bf16(o[6], o[7]);
      *(u32x4*)(xT + (q >> 1) * 64 * SLD + pch * SLD + tg * 8) = w;
    }
    { SSD_LOAD_X((rnd + 1) & 1) }
    __syncthreads();
    ydiag(2 * rnd, wid >> 1);
    ydiag(2 * rnd + 1, 3 - (wid >> 1));
    states(2 * rnd);
    states(2 * rnd + 1);
    __syncthreads();
  }
#undef SSD_LOAD_X
  __syncthreads();
}

__device__ __forceinline__ void meta_state_item(const Params& p, unsigned char* lds, int h) {
  const int tid = threadIdx.x, g = h >> 3;
  float* xm = (float*)lds;
  float* bm = xm + 16 * 64;
  float* dtm = bm + 16 * 128;
  const float* projm = (const float*)(p.ws + WS_PROJM);
  float* smeta = (float*)(p.ws + WS_SMETA);
  for (int task = tid; task < 16 * 192; task += NTHREADS) {
    const int i = task / 192, ch = task - i * 192;
    const int cch = ch < 64 ? h * 64 + ch : 1024 + g * 128 + (ch - 64);
    float acc = p.conv_b[cch];
#pragma unroll
    for (int j = 0; j < 4; ++j) { const int mi = i - j; if (mi >= 0) acc += p.conv_w[(3 - j) * D_XBC + cch] * projm[(size_t)mi * DPROJ + OFF_XBC + cch]; }
    const float v = silu_f(acc);
    if (ch < 64) xm[i * 64 + ch] = v; else bm[i * 128 + ch - 64] = v;
  }
  if (tid < 16) dtm[tid] = softplus_f(projm[(size_t)tid * DPROJ + OFF_DT + h] + p.dt_bias[h]);
  __syncthreads();
  const float Ah = -expf(p.a_log[h]);
  const int pr = tid >> 3, n0 = (tid & 7) * 16;
  float st[16];
#pragma unroll
  for (int k = 0; k < 16; ++k) st[k] = 0.f;
  for (int i = 0; i < 16; ++i) {
    const float dtv = dtm[i], dA = expf(dtv * Ah), xdt = xm[i * 64 + pr] * dtv;
#pragma unroll
    for (int k = 0; k < 16; ++k) st[k] = fmaf(st[k], dA, xdt * bm[i * 128 + n0 + k]);
  }
#pragma unroll
  for (int k = 0; k < 16; ++k) smeta[(size_t)(h * 64 + pr) * 128 + n0 + k] = st[k];
  __syncthreads();
}

__device__ __forceinline__ void phase2(const Params& p, unsigned char* lds, int bid, int nblk) {
#pragma unroll 1
  for (int rep = 0; rep < (REP_SUB == 0 ? 2 : 1); ++rep)
    for (int item = bid; item < 256; item += nblk) attn_item(p, lds, item);
#pragma unroll 1
  for (int rep = 0; rep < (REP_SUB == 1 ? 2 : 1); ++rep)
    for (int item = bid; item < 256; item += nblk) ssd_a_item(p, lds, item);
  for (int item = bid; item < 16; item += nblk) meta_state_item(p, lds, item);
}

__device__ __forceinline__ void phase_scan(const Params& p, int bid, int nblk) {
  const float* __restrict__ sg = (const float*)(p.ws + WS_SG);
  const float* __restrict__ smeta = (const float*)(p.ws + WS_SMETA);
  const float* __restrict__ acsg = (const float*)(p.ws + WS_ACSG);
  bf16_t* __restrict__ hprev = (bf16_t*)(p.ws + WS_HPREV);
  for (int task = bid * NTHREADS + threadIdx.x; task < 64 * 2048; task += nblk * NTHREADS) {
    const int bh = task >> 11, e4 = (task & 2047) * 4;
    const int b = bh >> 4, h = bh & 15;
    f32x4 sv[16];
    float dv[16];
#pragma unroll
    for (int c = 0; c < 16; ++c) {
      sv[c] = *(const f32x4*)(sg + (size_t)((b * 16 + c) * 16 + h) * 8192 + e4);
      dv[c] = acsg[(size_t)(b * SEQ + c * 128 + 127) * 16 + h];
    }
    f32x4 H = *(const f32x4*)(smeta + (size_t)h * 8192 + e4);
#pragma unroll
    for (int c = 0; c < 16; ++c) {
      u32x2 w; w.x = pack_bf16(H[0], H[1]); w.y = pack_bf16(H[2], H[3]);
      *(u32x2*)(hprev + (size_t)((b * 16 + c) * 16 + h) * 8192 + e4) = w;
      H = H * __expf(dv[c]) + sv[c];
    }
  }
}

__device__ __forceinline__ void ssd_b_item(const Params& p, unsigned char* lds, int item) {
  const int tid = threadIdx.x, lane = tid & 63, wid = __builtin_amdgcn_readfirstlane(tid >> 6);
  const int b = item >> 6, c = (item >> 2) & 15, g = (item >> 1) & 1, lh = item & 1, h = g * 8 + wid;
  const int t0 = b * SEQ + c * 128 + lh * 64;
  const int ql = lane & 31, hh = lane >> 5;
  constexpr int YLD = 520;
  bf16_t* yoff = (bf16_t*)lds;
  const bf16_t* __restrict__ proj = (const bf16_t*)(p.ws + WS_PROJ);
  const float* __restrict__ acsg = (const float*)(p.ws + WS_ACSG);
  const bf16_t* __restrict__ ccb = (const bf16_t*)(p.ws + WS_CCB);
  const float* __restrict__ ypart = (const float*)(p.ws + WS_YPART);
  const bf16_t* __restrict__ hprev = (const bf16_t*)(p.ws + WS_HPREV);
  bf16_t* __restrict__ mixin = (bf16_t*)(p.ws + WS_HNB);
  {
    const bf16_t* hp = hprev + (size_t)((b * 16 + c) * 16 + h) * 8192 + (size_t)ql * 128 + 8 * hh;
    u32x4 hf0[8], hf1[8];
#pragma unroll
    for (int ks = 0; ks < 8; ++ks) { hf0[ks] = *(const u32x4*)(hp + 16 * ks); hf1[ks] = *(const u32x4*)(hp + 32 * 128 + 16 * ks); }
#pragma unroll
    for (int il = 0; il < 2; ++il) {
      const int lt = 32 * il + ql, t = t0 + lt;
      const bf16_t* cp = ccb + (size_t)t * 256 + g * 128 + 8 * hh;
      u32x4 cf[8];
#pragma unroll
      for (int ks = 0; ks < 8; ++ks) cf[ks] = *(const u32x4*)(cp + 16 * ks);
      const float ea = __expf(acsg[(size_t)t * 16 + h]);
      f32x16 a0, a1;
#pragma unroll
      for (int r = 0; r < 16; ++r) { a0[r] = 0.f; a1[r] = 0.f; }
#pragma unroll
      for (int ks = 0; ks < 8; ++ks) {
        a0 = __builtin_amdgcn_mfma_f32_32x32x16_bf16(*(bf16x8*)&hf0[ks], *(bf16x8*)&cf[ks], a0, 0, 0, 0);
        a1 = __builtin_amdgcn_mfma_f32_32x32x16_bf16(*(bf16x8*)&hf1[ks], *(bf16x8*)&cf[ks], a1, 0, 0, 0);
      }
      bf16_t* yr = yoff + lt * YLD + wid * 64 + 4 * hh;
#pragma unroll
      for (int rg = 0; rg < 4; ++rg) {
        u32x2 w0; w0.x = pack_bf16(ea * a0[4 * rg], ea * a0[4 * rg + 1]); w0.y = pack_bf16(ea * a0[4 * rg + 2], ea * a0[4 * rg + 3]);
        u32x2 w1; w1.x = pack_bf16(ea * a1[4 * rg], ea * a1[4 * rg + 1]); w1.y = pack_bf16(ea * a1[4 * rg + 2], ea * a1[4 * rg + 3]);
        *(u32x2*)(yr + 8 * rg) = w0;
        *(u32x2*)(yr + 32 + 8 * rg) = w1;
      }
    }
  }
  __syncthreads();
#pragma unroll
  for (int bt = 0; bt < 2; ++bt) {
    f32x4 ya[4], yb[4]; u32x4 zz[4], yo[4];
#pragma unroll
    for (int q = 0; q < 4; ++q) {
      const int lt = wid * 8 + bt * 4 + q, t = t0 + lt;
      const float* yp = ypart + (size_t)t * 1024 + g * 512 + lane * 8;
      ya[q] = *(const f32x4*)yp; yb[q] = *(const f32x4*)(yp + 4);
      zz[q] = *(const u32x4*)(proj + (size_t)t * NPROJ + OFF_Z + g * 512 + lane * 8);
      yo[q] = *(const u32x4*)(yoff + lt * YLD + lane * 8);
    }
#pragma unroll
    for (int q = 0; q < 4; ++q) {
      const int t = t0 + wid * 8 + bt * 4 + q;
      float zv[8], ov[8], y[8];
      unpack8(zz[q], zv); unpack8(yo[q], ov);
      y[0] = (ya[q][0] + ov[0]) * silu_f(zv[0]); y[1] = (ya[q][1] + ov[1]) * silu_f(zv[1]);
      y[2] = (ya[q][2] + ov[2]) * silu_f(zv[2]); y[3] = (ya[q][3] + ov[3]) * silu_f(zv[3]);
      y[4] = (yb[q][0] + ov[4]) * silu_f(zv[4]); y[5] = (yb[q][1] + ov[5]) * silu_f(zv[5]);
      y[6] = (yb[q][2] + ov[6]) * silu_f(zv[6]); y[7] = (yb[q][3] + ov[7]) * silu_f(zv[7]);
      float ss = 0.f;
#pragma unroll
      for (int i = 0; i < 8; ++i) ss += y[i] * y[i];
      ss = wave_sum(ss);
      const float rn = rsqrtf(ss * (1.f / 512) + EPS);
      u32x4 w; w.x = pack_bf16(y[0] * rn, y[1] * rn); w.y = pack_bf16(y[2] * rn, y[3] * rn); w.z = pack_bf16(y[4] * rn, y[5] * rn); w.w = pack_bf16(y[6] * rn, y[7] * rn);
      *(u32x4*)(mixin + (size_t)t * DM + 1024 + g * 512 + lane * 8) = w;
    }
  }
  __syncthreads();
}
__device__ __forceinline__ void phase3(const Params& p, unsigned char* lds, int bid, int nblk) {
  for (int item = bid; item < 256; item += nblk) ssd_b_item(p, lds, item);
}

constexpr int LDS_BYTES = 144 * 1024;

typedef const Params __attribute__((address_space(4))) * KArgPtr;
__device__ __forceinline__ Params load_params(KArgPtr k) {
  Params q;
#if defined(__HIP_DEVICE_COMPILE__)
  __builtin_memcpy(&q, k, sizeof(Params));
#endif
  return q;
}
#define PARAMS_PTR(pp) KArgPtr pp##_k = (KArgPtr)__builtin_amdgcn_kernarg_segment_ptr(); asm volatile("" : "+s"(pp##_k)); const Params pp##_v = load_params(pp##_k); const Params* pp = &pp##_v
__global__ __launch_bounds__(512, 2) void k_mega(Params p_unused) {
  extern __shared__ __attribute__((aligned(16))) unsigned char shm[];
  const int bid = blockIdx.x, nblk = gridDim.x;
  volatile LAS unsigned* xst = (volatile LAS unsigned*)(LAS unsigned char*)(shm + LDS_BYTES - 16);
  if (threadIdx.x == 0) { xst[0] = 0u; xst[1] = 0u; }
  __syncthreads();
  XcdBarrier xb;
  { PARAMS_PTR(pp); xb = xcd_barrier_post((unsigned*)(pp->ws + WS_CTL), xst); }
#ifndef REP_PHASE
#define REP_PHASE -1
#endif
#define NREP(k) ((REP_PHASE == (k)) ? 2 : 1)
#ifndef REP_ALL
#define REP_ALL 1
#endif
#pragma unroll 1
  for (int pass = 0; pass < REP_ALL; ++pass) {
  if (pass) xcd_barrier(xb);
#pragma unroll 1
  for (int rep = 0; rep < NREP(0); ++rep) { { PARAMS_PTR(pp); phase0(*pp, (float*)shm, bid, nblk); } if (rep + 1 < NREP(0)) xcd_barrier(xb); }
  xcd_barrier(xb);
#pragma unroll 1
  for (int rep = 0; rep < NREP(1); ++rep) { { PARAMS_PTR(pp); phase1(*pp, shm, bid, nblk); } xcd_barrier(xb); }
#pragma unroll 1
  for (int rep = 0; rep < NREP(2); ++rep) { { PARAMS_PTR(pp); phase2(*pp, shm, bid, nblk); } xcd_barrier(xb); }
#pragma unroll 1
  for (int rep = 0; rep < NREP(7); ++rep) { { PARAMS_PTR(pp); phase_scan(*pp, bid, nblk); } xcd_barrier(xb); }
#pragma unroll 1
  for (int rep = 0; rep < NREP(3); ++rep) { { PARAMS_PTR(pp); phase3(*pp, shm, bid, nblk); } xcd_barrier(xb); }
#pragma unroll 1
  for (int rep = 0; rep < NREP(4); ++rep) { { PARAMS_PTR(pp); phase4(*pp, shm, bid, nblk); } xcd_barrier(xb); }
#pragma unroll 1
  for (int rep = 0; rep < NREP(5); ++rep) { { PARAMS_PTR(pp); phase5(*pp, shm, bid, nblk); } xcd_barrier(xb); }
#pragma unroll 1
  for (int rep = 0; rep < NREP(6); ++rep) { { PARAMS_PTR(pp); phase6(*pp, shm, bid, nblk); } if (rep + 1 < NREP(6)) xcd_barrier(xb); }
  }
}

}

extern "C" void kernel_launch(void* const* d_in, const int* in_sizes, int n_in, void* d_out, int out_size, void* d_ws,
                              size_t ws_size, hipStream_t stream) {
  Params p{};
  p.x = (const float*)d_in[0]; p.meta = (const float*)d_in[1]; p.rel_bias = (const float*)d_in[2];
  p.ln_mix = (const float*)d_in[3]; p.w_in = (const float*)d_in[4]; p.sinks = (const float*)d_in[5];
  p.conv_w = (const float*)d_in[6]; p.conv_b = (const float*)d_in[7]; p.dt_bias = (const float*)d_in[8];
  p.a_log = (const float*)d_in[9]; p.d_skip = (const float*)d_in[10]; p.attn_norm_w = (const float*)d_in[11];
  p.ssm_norm_w = (const float*)d_in[12]; p.w_out = (const float*)d_in[13]; p.ln_ffn = (const float*)d_in[14];
  p.wq = (const float*)d_in[15]; p.keys = (const float*)d_in[16]; p.U = (const float*)d_in[17];
  p.V = (const float*)d_in[18]; p.ln_final = (const float*)d_in[19];
  p.out = (float*)d_out;
  p.ws = (unsigned char*)d_ws;

  static int grid_blocks = 0;
  if (!grid_blocks) {
    int dev = 0, cus = 0, per_cu = 0;
    (void)hipGetDevice(&dev);
    (void)hipDeviceGetAttribute(&cus, hipDeviceAttributeMultiprocessorCount, dev);
    (void)hipFuncSetAttribute((const void*)k_mega, hipFuncAttributeMaxDynamicSharedMemorySize, LDS_BYTES);
    (void)hipOccupancyMaxActiveBlocksPerMultiprocessor(&per_cu, (const void*)k_mega, NTHREADS, LDS_BYTES);
    if (per_cu > 1) per_cu = 1;
    grid_blocks = cus * per_cu;
    if (grid_blocks != 256) fprintf(stderr, "kernel_launch: expected a 256-workgroup resident grid, got %d (cus %d, per_cu %d)\n", grid_blocks, cus, per_cu);
  }
  (void)hipMemsetAsync(p.ws + WS_CTL, 0, XCD_BAR_WORDS * 4, stream);
  void* args[] = {&p};
  hipError_t e = hipLaunchCooperativeKernel((const void*)k_mega, dim3(grid_blocks), dim3(NTHREADS), args, LDS_BYTES, stream);
  if (e != hipSuccess) fprintf(stderr, "cooperative launch failed: %s (grid %d)\n", hipGetErrorString(e), grid_blocks);
}
```

```cpp
#include <hip/hip_runtime.h>
#include <math.h>
#include <stdio.h>
#include <stdint.h>

#ifndef REP_SUB
#define REP_SUB -1
#endif
namespace {
constexpr int BATCH = 4, SEQ = 2048, DM = 2048, NMETA = 16;
constexpr int T = BATCH * SEQ;
constexpr int TA = T + NMETA;
constexpr int DPROJ = 4112;
constexpr int NPROJ = 4096;
constexpr int OFF_Q = 0, OFF_K = 1024, OFF_V = 1280, OFF_Z = 1536, OFF_XBC = 2560, OFF_DT = 4096;
constexpr int D_XBC = 1536;
constexpr int NEXP = 16384;
constexpr int ROW4 = 1024;
constexpr int ROW6 = 1536;
constexpr float EPS = 1e-6f;
constexpr int NTHREADS = 512;

typedef unsigned short bf16_t;
typedef short bf16x8 __attribute__((ext_vector_type(8)));
typedef float f32x4 __attribute__((ext_vector_type(4)));
typedef float f32x2 __attribute__((ext_vector_type(2)));
typedef unsigned u32x4 __attribute__((ext_vector_type(4)));
typedef unsigned u32x2 __attribute__((ext_vector_type(2)));
typedef __bf16 bf16v2 __attribute__((ext_vector_type(2)));
typedef float f32x16v __attribute__((ext_vector_type(16)));
typedef float f32x32v __attribute__((ext_vector_type(32)));
typedef unsigned u32x6 __attribute__((ext_vector_type(6)));
#define LAS __attribute__((address_space(3)))

__device__ __forceinline__ unsigned pack_bf16(float lo, float hi) {
  f32x2 v = {lo, hi};
  bf16v2 b = __builtin_convertvector(v, bf16v2);
  return *(unsigned*)&b;
}
__device__ __forceinline__ bf16_t f2bf(float f) { return (bf16_t)(pack_bf16(f, 0.f) & 0xffffu); }
__device__ __forceinline__ float bf2f(bf16_t b) { return __uint_as_float(((unsigned)b) << 16); }
__device__ __forceinline__ float bflo(unsigned u) { return __uint_as_float(u << 16); }
__device__ __forceinline__ float bfhi(unsigned u) { return __uint_as_float(u & 0xffff0000u); }

__constant__ unsigned char kBucket[128] = {
    0, 1, 2, 3, 4, 5, 6, 7, 8, 9, 10, 11, 12, 13, 14, 15, 16, 16, 16, 17, 17, 18, 18, 18, 19, 19, 19, 20, 20, 20, 20, 21,
    21, 21, 21, 22, 22, 22, 22, 22, 23, 23, 23, 23, 23, 23, 24, 24, 24, 24, 24, 24, 25, 25, 25, 25, 25, 25, 25, 26, 26, 26, 26, 26,
    26, 26, 26, 27, 27, 27, 27, 27, 27, 27, 27, 27, 27, 28, 28, 28, 28, 28, 28, 28, 28, 28, 28, 29, 29, 29, 29, 29, 29, 29, 29, 29,
    29, 29, 29, 30, 30, 30, 30, 30, 30, 30, 30, 30, 30, 30, 30, 30, 30, 31, 31, 31, 31, 31, 31, 31, 31, 31, 31, 31, 31, 31, 31, 31};

__constant__ unsigned char kCandI[64] = {0, 0, 0, 0, 0, 0, 0, 0, 0, 0, 0, 0, 0, 0, 0, 0, 1, 1, 1, 1, 1, 1, 1, 1, 2, 2, 2, 2, 2, 3, 3, 3, 3, 4, 4, 4, 5, 5, 6, 6, 7, 7, 8, 9, 10, 11, 12, 13, 14, 15, 15, 15, 15, 15, 15, 15, 15, 15, 15, 15, 15, 15, 15, 15};
__constant__ unsigned char kCandJ[64] = {0, 1, 2, 3, 4, 5, 6, 7, 8, 9, 10, 11, 12, 13, 14, 15, 0, 1, 2, 3, 4, 5, 6, 7, 0, 1, 2, 3, 4, 0, 1, 2, 3, 0, 1, 2, 0, 1, 0, 1, 0, 1, 0, 0, 0, 0, 0, 0, 0, 0, 15, 15, 15, 15, 15, 15, 15, 15, 15, 15, 15, 15, 15, 15};

__device__ __forceinline__ float wave_sum(float v) {
  for (int o = 32; o > 0; o >>= 1) v += __shfl_xor(v, o);
  return v;
}
__device__ __forceinline__ float wave_max(float v) {
  for (int o = 32; o > 0; o >>= 1) v = fmaxf(v, __shfl_xor(v, o));
  return v;
}
__device__ __forceinline__ float silu_f(float x) { return x / (1.f + expf(-x)); }
__device__ __forceinline__ float softplus_f(float x) { return fmaxf(x, 0.f) + log1pf(expf(-fabsf(x))); }

constexpr size_t al256(size_t x) { return (x + 255) & ~(size_t)255; }
constexpr size_t WS_CTL = 0;
constexpr size_t WS_WINT = 65536;
constexpr size_t WS_WDTT = WS_WINT + (size_t)NPROJ * DM * 2;
constexpr size_t WS_WOUTT = WS_WDTT + (size_t)16 * DM * 2;
constexpr size_t WS_WQT = WS_WOUTT + (size_t)DM * DM * 2;
constexpr size_t WS_KEYS = WS_WQT + (size_t)DM * DM * 2;
constexpr size_t WS_UB = WS_KEYS + (size_t)16 * 128 * 128 * 2;
constexpr size_t WS_VB = WS_UB + (size_t)NEXP * DM * 2;
constexpr size_t WS_HNB = WS_VB + (size_t)NEXP * DM * 2;
constexpr size_t WS_PROJ = WS_HNB + (size_t)(T + 16) * DM * 2;
constexpr size_t WS_DTRAW = WS_PROJ + (size_t)T * NPROJ * 2;
constexpr size_t WS_PROJM = WS_DTRAW + (size_t)T * 16 * 4;
constexpr size_t WS_PROJMB = al256(WS_PROJM + (size_t)16 * DPROJ * 4);
constexpr size_t WS_H1B = al256(WS_PROJMB + (size_t)16 * DPROJ * 2);
constexpr size_t WS_SSQH1 = WS_H1B + (size_t)T * DM * 2;
constexpr size_t WS_STOP = al256(WS_SSQH1 + (size_t)T * 32 * 4);
constexpr size_t WS_ITOP = WS_STOP + (size_t)T * 256 * 4;
constexpr size_t WS_ACSG = al256(WS_ITOP + (size_t)T * 256 * 4);
constexpr size_t WS_CCB = WS_ACSG + (size_t)T * 16 * 4;
constexpr size_t WS_YPART = WS_CCB + (size_t)T * 256 * 2;
constexpr size_t WS_SG = WS_YPART + (size_t)T * 1024 * 4;
constexpr size_t WS_SMETA = WS_SG + (size_t)1024 * 8192 * 4;
constexpr size_t WS_HPREV = al256(WS_SMETA + (size_t)16 * 8192 * 4);
constexpr size_t WS_USC = al256(WS_HPREV + (size_t)1024 * 8192 * 2);
constexpr size_t WS_VSC = WS_USC + (size_t)NEXP * 4;
constexpr size_t WS_SCR = al256(WS_VSC + (size_t)NEXP * 4);
}

namespace pg8 {
#define PG8_LAS __attribute__((address_space(3)))
constexpr int BM = 256, BK = 64, HALF = 128, HTB = HALF * BK * 2, STAGE_BYTES = 8 * HTB, NXCD = 8, WGM = 8;
__host__ __device__ __forceinline__ int lds_byte(int r, int c) { const int st = (r >> 4) * 2 + (c >> 5), rr = r & 15, cc = c & 31, ob = rr * 64 + cc * 2; return st * 1024 + (ob ^ (((ob >> 9) & 1) << 5)); }
__host__ __device__ __forceinline__ void stage_rc(int b, int& R, int& C) { const int st = b / 1024, sb = b % 1024, swz = sb ^ (((sb >> 9) & 1) << 5); R = (st >> 1) * 16 + swz / 64; C = (st & 1) * 32 + (swz % 64) / 2; }
__host__ __device__ __forceinline__ int perm32(int rho) { const int n = rho >> 4, i = rho & 15; return 8 * (i >> 2) + 4 * n + (i & 3); }
struct Unit { int pm, pn; };
struct Gemm { const bf16_t* A; const bf16_t* Bt; int M, N, K; };
struct StaticOrder {
    int nM, nN, nwg, G, c;
    __host__ __device__ void init(int M, int N, int G_, int c_) { nM = M / BM; nN = N / BM; nwg = nM * nN; G = G_; c = c_; }
    __host__ __device__ bool next(int i, Unit& u) const {
        const long L = (long)i * G + c; if (L >= nwg) return false;
        int wgid = (int)L; { const int q = nwg / NXCD, r = nwg % NXCD, xcd = wgid % NXCD, off = wgid / NXCD; wgid = (xcd < r ? xcd * (q + 1) : r * (q + 1) + (xcd - r) * q) + off; }
        const int nig = WGM * nN, gid = wgid / nig, fm = gid * WGM, gsz = (nM - fm) < WGM ? (nM - fm) : WGM;
        u.pm = fm + ((wgid % nig) % gsz); u.pn = (wgid % nig) / gsz; return true;
    }
    __device__ __forceinline__ void a_ready(const Unit&) const {}
    __device__ __forceinline__ void done(const Unit&) const {}
};
struct EpiBf16 {
    static constexpr bool PERM = true, AFTER_DRAIN = false;
    bf16_t* O; int ldc;
    __device__ __forceinline__ void operator()(const f32x4 (&acc)[2][2][4][2], const Unit& u, int wr, int wc, int fr, int fq) const {
        const int row0 = u.pm * BM + wr * 64 + fr; const int col0 = u.pn * BM + wc * 32 + 8 * fq;
#pragma unroll
        for (int ai = 0; ai < 2; ++ai)
#pragma unroll
            for (int m = 0; m < 4; ++m) { bf16_t* rowp = O + (size_t)(row0 + ai * HALF + m * 16) * ldc + col0;
#pragma unroll
                for (int bj = 0; bj < 2; ++bj) { const f32x4 v0 = acc[ai][bj][m][0], v1 = acc[ai][bj][m][1];
                    u32x4 w; w.x = pack_bf16(v0[0], v0[1]); w.y = pack_bf16(v0[2], v0[3]); w.z = pack_bf16(v1[0], v1[1]); w.w = pack_bf16(v1[2], v1[3]);
                    *(u32x4*)(rowp + bj * HALF) = w; } }
    }
};

struct EpiRes {
    static constexpr bool PERM = true, AFTER_DRAIN = false;
    const float* X; bf16_t* HB; float* SSQ;
    __device__ __forceinline__ void operator()(const f32x4 (&acc)[2][2][4][2], const Unit& u, int wr, int wc, int fr, int fq) const {
        const int row0 = u.pm * BM + wr * 64 + fr; const int col0 = u.pn * BM + wc * 32 + 8 * fq;
#pragma unroll
        for (int ai = 0; ai < 2; ++ai) {
            f32x4 xr[4][2][2];
#pragma unroll
            for (int m = 0; m < 4; ++m) { const size_t off = (size_t)(row0 + ai * HALF + m * 16) * DM + col0;
#pragma unroll
                for (int bj = 0; bj < 2; ++bj) { xr[m][bj][0] = __builtin_nontemporal_load((const f32x4*)(X + off + bj * HALF)); xr[m][bj][1] = __builtin_nontemporal_load((const f32x4*)(X + off + bj * HALF + 4)); } }
#pragma unroll
            for (int m = 0; m < 4; ++m) { const int row = row0 + ai * HALF + m * 16; const size_t off = (size_t)row * DM + col0; float ss = 0.f;
#pragma unroll
                for (int bj = 0; bj < 2; ++bj) {
                    const f32x4 v0 = acc[ai][bj][m][0] + xr[m][bj][0], v1 = acc[ai][bj][m][1] + xr[m][bj][1];
                    u32x4 w; w.x = pack_bf16(v0[0], v0[1]); w.y = pack_bf16(v0[2], v0[3]); w.z = pack_bf16(v1[0], v1[1]); w.w = pack_bf16(v1[2], v1[3]);
                    *(u32x4*)(HB + off + bj * HALF) = w;
                    ss += v0[0] * v0[0] + v0[1] * v0[1] + v0[2] * v0[2] + v0[3] * v0[3] + v1[0] * v1[0] + v1[1] * v1[1] + v1[2] * v1[2] + v1[3] * v1[3]; }
                ss += __shfl_xor(ss, 16); ss += __shfl_xor(ss, 32);
                if (fq == 0) SSQ[(size_t)row * 32 + u.pn * 4 + wc] = ss; }
        }
    }
};
struct EpiF32 {
    static constexpr bool PERM = true, AFTER_DRAIN = false;
    float* C; int ldc;
    __device__ __forceinline__ void operator()(const f32x4 (&acc)[2][2][4][2], const Unit& u, int wr, int wc, int fr, int fq) const {
        const int row0 = u.pm * BM + wr * 64 + fr; const int col0 = u.pn * BM + wc * 32 + 8 * fq;
#pragma unroll
        for (int ai = 0; ai < 2; ++ai)
#pragma unroll
            for (int m = 0; m < 4; ++m) { float* rowp = C + (size_t)(row0 + ai * HALF + m * 16) * ldc + col0;
#pragma unroll
                for (int bj = 0; bj < 2; ++bj) { *(f32x4*)(rowp + bj * HALF) = acc[ai][bj][m][0]; *(f32x4*)(rowp + bj * HALF + 4) = acc[ai][bj][m][1]; } }
    }
};

struct EpiScores {
    static constexpr bool PERM = true, AFTER_DRAIN = true;
    const bf16_t* KEYS;
    float* STOP; int* ITOP;
    static constexpr int QLD = 264;
    __device__ __forceinline__ void fused(f32x4 (&acc)[2][2][4][2], const Unit& u, int wr, int wc, int fr, int fq, PG8_LAS unsigned char* lds, int wid, int lane) const {
        PG8_LAS bf16_t* Q = (PG8_LAS bf16_t*)lds;
#pragma unroll
        for (int ai = 0; ai < 2; ++ai)
#pragma unroll
            for (int m = 0; m < 4; ++m) { const int row = ai * HALF + wr * 64 + m * 16 + fr;
#pragma unroll
                for (int bj = 0; bj < 2; ++bj) { const f32x4 v0 = acc[ai][bj][m][0], v1 = acc[ai][bj][m][1];
                    u32x4 w; w.x = pack_bf16(v0[0], v0[1]); w.y = pack_bf16(v0[2], v0[3]); w.z = pack_bf16(v1[0], v1[1]); w.w = pack_bf16(v1[2], v1[3]);
                    *(PG8_LAS u32x4*)(Q + row * QLD + bj * HALF + wc * 32 + 8 * fq) = w; } }
        __syncthreads();
        const int h = u.pn;
#pragma unroll 1
        for (int c = 0; c < 2; ++c) {
            f32x4 sc[8][2];
#pragma unroll
            for (int kf = 0; kf < 8; ++kf) { sc[kf][0] = (f32x4){0.f, 0.f, 0.f, 0.f}; sc[kf][1] = (f32x4){0.f, 0.f, 0.f, 0.f}; }
            const bf16_t* kb = KEYS + (size_t)((h * 2 + c) * 128 + fr) * 128 + 8 * fq;
            const PG8_LAS bf16_t* qb = Q + (wid * 32 + fr) * QLD + c * 128 + 8 * fq;
#pragma unroll
            for (int ks = 0; ks < 4; ++ks) {
                const bf16x8 q0 = *(const PG8_LAS bf16x8*)(qb + 32 * ks), q1 = *(const PG8_LAS bf16x8*)(qb + 16 * QLD + 32 * ks);
#pragma unroll
                for (int kf = 0; kf < 8; ++kf) { const bf16x8 kv = *(const bf16x8*)(kb + (size_t)kf * 16 * 128 + 32 * ks);
                    sc[kf][0] = __builtin_amdgcn_mfma_f32_16x16x32_bf16(kv, q0, sc[kf][0], 0, 0, 0);
                    sc[kf][1] = __builtin_amdgcn_mfma_f32_16x16x32_bf16(kv, q1, sc[kf][1], 0, 0, 0); }
            }
#pragma unroll
            for (int tf = 0; tf < 2; ++tf) {
                int v[32];
#pragma unroll
                for (int kf = 0; kf < 8; ++kf)
#pragma unroll
                    for (int r = 0; r < 4; ++r) {
                        const int bts = (int)__float_as_uint(sc[kf][tf][r]);
                        const int srt = bts ^ ((bts >> 31) & 0x7fffffff);
                        v[kf * 4 + r] = (srt & ~127) | (16 * kf + 4 * fq + r);
                    }
#pragma unroll
                for (int k = 2; k <= 32; k <<= 1)
#pragma unroll
                    for (int j = k >> 1; j > 0; j >>= 1)
#pragma unroll
                        for (int i = 0; i < 32; ++i) {
                            const int l = i ^ j;
                            if (l > i) {
                                const int x = v[i], y = v[l];
                                const int hi_ = x > y ? x : y, lo_ = x > y ? y : x;
                                if ((i & k) == 0) { v[i] = hi_; v[l] = lo_; } else { v[i] = lo_; v[l] = hi_; }
                            }
                        }
#pragma unroll
                for (int step = 0; step < 2; ++step) {
                    const int xm = step == 0 ? 16 : 32;
                    int m[16];
#pragma unroll
                    for (int i = 0; i < 16; ++i) { const int o = __shfl_xor(v[15 - i], xm); m[i] = v[i] > o ? v[i] : o; }
#pragma unroll
                    for (int j = 8; j > 0; j >>= 1)
#pragma unroll
                        for (int i = 0; i < 16; ++i) {
                            const int l = i ^ j;
                            if (l > i) { const int x = m[i], y = m[l]; m[i] = x > y ? x : y; m[l] = x > y ? y : x; }
                        }
#pragma unroll
                    for (int i = 0; i < 16; ++i) v[i] = m[i];
                }
                if (fq == 0) {
                    const size_t obase = ((size_t)(u.pm * BM + wid * 32 + tf * 16 + fr) * 16 + h * 2 + c) * 16;
#pragma unroll
                    for (int q4 = 0; q4 < 4; ++q4) {
                        f32x4 sv; u32x4 iv;
#pragma unroll
                        for (int i = 0; i < 4; ++i) {
                            const int key = v[4 * q4 + i], srt = key & ~127;
                            sv[i] = __uint_as_float((unsigned)(srt ^ ((srt >> 31) & 0x7fffffff)));
                            iv[i] = (unsigned)(key & 127);
                        }
                        *(f32x4*)(STOP + obase + 4 * q4) = sv;
                        *(u32x4*)(ITOP + obase + 4 * q4) = iv;
                    }
                }
            }
        }
    }
};

template <class Epi, class Sched>
__device__ __forceinline__ void gemm_phase(PG8_LAS unsigned char* lds, const Gemm g, const Sched& S, const Epi& E) {
    int tid_ = threadIdx.x; asm volatile("" : "+v"(tid_));
    const int tid = tid_, wid = __builtin_amdgcn_readfirstlane(tid >> 6), lane = tid & 63, wr = wid >> 2, wc = wid & 3, fr = lane & 15, fq = lane >> 4;
    const int K = g.K, nt = K / BK;
    unsigned voffA[2], voffB[2];
#pragma unroll
    for (int i = 0; i < 2; ++i) { int R, C; stage_rc(tid * 16 + i * 8192, R, C); const int Rb = Epi::PERM ? ((R & ~31) + perm32(R & 31)) : R;
        voffA[i] = (unsigned)(R * K + C) * 2u; voffB[i] = (unsigned)(Rb * K + C) * 2u; }
    const size_t kstep = (size_t)(BK * 2);
    const size_t hstep = (size_t)HALF * K * 2;
    const size_t tstep = 2 * hstep;
    const unsigned ldsw = (unsigned)wid * 1024u;
    const int aoff = lds_byte(wr * 64 + fr, fq * 8), boff = lds_byte(wc * 32 + fr, fq * 8);
#define PG8_SA(b, h) (((b) * 2 + (h)) * HTB)
#define PG8_SB(b, h) ((4 + (b) * 2 + (h)) * HTB)
#define PG8_STAGE(bufoff, gbase, voff) do { _Pragma("unroll") for (int _i = 0; _i < 2; ++_i) \
        __builtin_amdgcn_global_load_lds((const unsigned*)((const char*)(gbase) + (voff)[_i]), (PG8_LAS unsigned*)(lds + (bufoff) + ldsw + _i * 8192), 16, 0, 0); } while (0)
#define PG8_LDA(dst, b, h) do { _Pragma("unroll") for (int m = 0; m < 4; ++m) _Pragma("unroll") for (int k = 0; k < 2; ++k) dst[m][k] = *(const PG8_LAS bf16x8*)(lds + PG8_SA(b, h) + aoff + m * 2048 + k * 1024); } while (0)
#define PG8_LDB(dst, b, h) do { _Pragma("unroll") for (int n = 0; n < 2; ++n) _Pragma("unroll") for (int k = 0; k < 2; ++k) dst[n][k] = *(const PG8_LAS bf16x8*)(lds + PG8_SB(b, h) + boff + n * 2048 + k * 1024); } while (0)
#define PG8_MMA(ai, bj, At, Bt) do { __builtin_amdgcn_s_setprio(1); _Pragma("unroll") for (int m = 0; m < 4; ++m) _Pragma("unroll") for (int n = 0; n < 2; ++n) _Pragma("unroll") for (int k = 0; k < 2; ++k) \
        acc[ai][bj][m][n] = __builtin_amdgcn_mfma_f32_16x16x32_bf16(Bt[n][k], At[m][k], acc[ai][bj][m][n], 0, 0, 0); __builtin_amdgcn_s_setprio(0); } while (0)
#define PG8_WAIT_V(n) asm volatile("s_waitcnt vmcnt(" #n ")" ::: "memory")
#define PG8_WAIT_L(n) asm volatile("s_waitcnt lgkmcnt(" #n ")" ::: "memory")
#define PG8_BAR __builtin_amdgcn_s_barrier()
#define PG8_SCHED __builtin_amdgcn_sched_barrier(0)
    Unit cur, nxt; int ui = 0;
    if (!S.next(0, cur)) return;
    f32x4 acc[2][2][4][2];
#pragma unroll
    for (int a = 0; a < 2; ++a)
#pragma unroll
        for (int b = 0; b < 2; ++b)
#pragma unroll
            for (int m = 0; m < 4; ++m)
#pragma unroll
                for (int n = 0; n < 2; ++n) acc[a][b][m][n] = (f32x4){0.f, 0.f, 0.f, 0.f};
    bf16x8 At[4][2], B0[2][2], B1[2][2];
    const char* cA = (const char*)g.A + (size_t)cur.pm * tstep; const char* cB = (const char*)g.Bt + (size_t)cur.pn * tstep;
    S.a_ready(cur);
    PG8_STAGE(PG8_SB(0, 0), cB, voffB); PG8_STAGE(PG8_SA(0, 0), cA, voffA); PG8_STAGE(PG8_SB(0, 1), cB + hstep, voffB); PG8_STAGE(PG8_SA(0, 1), cA + hstep, voffA);
    if (wr == 1) PG8_BAR;
    PG8_WAIT_V(4); PG8_BAR;
    PG8_STAGE(PG8_SB(1, 0), cB + kstep, voffB); PG8_STAGE(PG8_SA(1, 0), cA + kstep, voffA); PG8_STAGE(PG8_SB(1, 1), cB + hstep + kstep, voffB);
    PG8_WAIT_V(6); PG8_BAR;
    for (;;) {
        const bool has_next = S.next(ui + 1, nxt);
        const char* nA = has_next ? (const char*)g.A + (size_t)nxt.pm * tstep : cA; const char* nB = has_next ? (const char*)g.Bt + (size_t)nxt.pn * tstep : cB;
        for (int t = 0; t < nt; t += 2) {
            const bool last = (t == nt - 2);
            const char* a1 = cA + (size_t)(t + 1) * kstep;
            const char* a2 = last ? nA : cA + (size_t)(t + 2) * kstep; const char* b2 = last ? nB : cB + (size_t)(t + 2) * kstep;
            const char* a3 = a2 + kstep; const char* b3 = b2 + kstep;
            if (last && has_next) S.a_ready(nxt);
            PG8_LDB(B0, 0, 0); PG8_SCHED; PG8_LDA(At, 0, 0); PG8_STAGE(PG8_SA(1, 1), a1 + hstep, voffA);
            PG8_WAIT_L(8); PG8_BAR; PG8_WAIT_L(0); PG8_MMA(0, 0, At, B0); PG8_BAR; PG8_SCHED;
            PG8_LDB(B1, 0, 1); PG8_STAGE(PG8_SB(0, 0), b2, voffB);
            PG8_BAR; PG8_WAIT_L(0); PG8_MMA(0, 1, At, B1); PG8_BAR;
            PG8_LDA(At, 0, 1); PG8_STAGE(PG8_SA(0, 0), a2, voffA);
            PG8_BAR; PG8_WAIT_L(0); PG8_MMA(1, 0, At, B0); PG8_BAR; PG8_SCHED;
            PG8_STAGE(PG8_SB(0, 1), b2 + hstep, voffB);
            PG8_WAIT_V(6); PG8_BAR; PG8_MMA(1, 1, At, B1); PG8_BAR;
            PG8_LDB(B0, 1, 0); PG8_SCHED; PG8_LDA(At, 1, 0); PG8_STAGE(PG8_SA(0, 1), a2 + hstep, voffA);
            PG8_WAIT_L(8); PG8_BAR; PG8_WAIT_L(0); PG8_MMA(0, 0, At, B0); PG8_BAR; PG8_SCHED;
            PG8_LDB(B1, 1, 1); PG8_STAGE(PG8_SB(1, 0), b3, voffB);
            PG8_BAR; PG8_WAIT_L(0); PG8_MMA(0, 1, At, B1); PG8_BAR;
            PG8_LDA(At, 1, 1); PG8_STAGE(PG8_SA(1, 0), a3, voffA);
            PG8_BAR; PG8_WAIT_L(0); PG8_MMA(1, 0, At, B0); PG8_BAR; PG8_SCHED;
            PG8_STAGE(PG8_SB(1, 1), b3 + hstep, voffB);
            PG8_WAIT_V(6); PG8_BAR; PG8_MMA(1, 1, At, B1); PG8_BAR;
        }
        if constexpr (!Epi::AFTER_DRAIN) { E(acc, cur, wr, wc, fr, fq); S.done(cur); }
        if (!has_next) break;
#pragma unroll
        for (int a = 0; a < 2; ++a)
#pragma unroll
            for (int b = 0; b < 2; ++b)
#pragma unroll
                for (int m = 0; m < 4; ++m)
#pragma unroll
                    for (int n = 0; n < 2; ++n) acc[a][b][m][n] = (f32x4){0.f, 0.f, 0.f, 0.f};
        cur = nxt; cA = nA; cB = nB; ++ui;
    }
    PG8_WAIT_V(0);
    if (wr == 0) PG8_BAR;
    PG8_BAR;
    if constexpr (Epi::AFTER_DRAIN) { E.fused(acc, cur, wr, wc, fr, fq, lds, wid, lane); S.done(cur); }
#undef PG8_SA
#undef PG8_SB
#undef PG8_STAGE
#undef PG8_LDA
#undef PG8_LDB
#undef PG8_MMA
#undef PG8_WAIT_V
#undef PG8_WAIT_L
#undef PG8_BAR
#undef PG8_SCHED
}
}

#define XB_TMO      128
#define XB_XCNT(j)  (256  + 64 * (j))
#define XB_XSUB(j)  (1280 + 64 * (j))
#define XB_XGEN(j)  (2304 + 64 * (j))
#define XB_TOP      3328
#define XB_TOPGEN   3392
#define XCD_BAR_WORDS 3456
#define XB_SPIN_CAP (1u << 22)
__device__ __forceinline__ unsigned xb_ld(unsigned* p)              { return __hip_atomic_load(p, __ATOMIC_RELAXED, __HIP_MEMORY_SCOPE_AGENT); }
__device__ __forceinline__ unsigned xb_add(unsigned* p, unsigned v) { return __hip_atomic_fetch_add(p, v, __ATOMIC_RELAXED, __HIP_MEMORY_SCOPE_AGENT); }
__device__ __forceinline__ unsigned xb_xcc_id() { return (unsigned)__builtin_amdgcn_s_getreg((3 << 11) | 20) & 0xFu; }
#define XB_SPIN(cond, bar) do { unsigned _sp = 0; while (cond) { __builtin_amdgcn_s_sleep(1); \
    if ((++_sp & 255u) == 0u) { if (xb_ld(&(bar)[XB_TMO])) break; if (_sp > XB_SPIN_CAP) { atomicAdd(&(bar)[XB_TMO], 1u); break; } } } } while (0)
struct XcdBarrier { unsigned* bar; unsigned x; volatile LAS unsigned* st; };
__device__ __forceinline__ XcdBarrier xcd_barrier_post(unsigned* bar, volatile LAS unsigned* st) {
    XcdBarrier b; b.bar = bar; b.x = xb_xcc_id(); b.st = st;
    if (threadIdx.x == 0) (void)xb_add(&bar[XB_XCNT(b.x)], 1u);
    return b;
}
__device__ __forceinline__ void xcd_barrier_complete(unsigned* bar, unsigned x, unsigned& nloc, unsigned& nx) {
    const unsigned G = gridDim.x * gridDim.y * gridDim.z;
    unsigned sum, cnt, mine, sp = 0u;
    for (;;) {
        sum = 0u; cnt = 0u; mine = 0u;
#pragma unroll
        for (unsigned j = 0; j < 16; ++j) { const unsigned c = xb_ld(&bar[XB_XCNT(j)]); sum += c; cnt += (c > 0u) ? 1u : 0u; mine = (j == x) ? c : mine; }
        if (sum == G) break;
        __builtin_amdgcn_s_sleep(1);
        if ((++sp & 255u) == 0u) { if (xb_ld(&bar[XB_TMO])) break; if (sp > XB_SPIN_CAP) { atomicAdd(&bar[XB_TMO], 1u); break; } }
    }
    nloc = mine > 0u ? mine : 1u; nx = cnt > 0u ? cnt : 1u;
}
__device__ __forceinline__ void xcd_barrier(const XcdBarrier& b) {
    asm volatile("s_waitcnt vmcnt(0)" ::: "memory");
    __syncthreads();
    if (threadIdx.x == 0) {
        unsigned* bar = b.bar;
        const unsigned bx = xb_xcc_id();
        __builtin_amdgcn_s_waitcnt(0);
        unsigned nloc = b.st[0], nx = b.st[1];
        if (nloc == 0u) { xcd_barrier_complete(bar, bx, nloc, nx); b.st[0] = nloc; b.st[1] = nx; }
        const unsigned old = xb_add(&bar[XB_XSUB(bx)], 1u);
        const unsigned gen = old / nloc;
        if (old + 1u == (gen + 1u) * nloc) {
            __builtin_amdgcn_fence(__ATOMIC_RELEASE, "agent");
            asm volatile("s_waitcnt vmcnt(0)" ::: "memory");
            const unsigned og = xb_add(&bar[XB_TOP], 1u);
            const unsigned tg = og / nx;
            if (og + 1u == (tg + 1u) * nx) xb_add(&bar[XB_TOPGEN], 1u);
            else XB_SPIN(xb_ld(&bar[XB_TOPGEN]) == tg, bar);
            __builtin_amdgcn_fence(__ATOMIC_ACQUIRE, "agent");
            xb_add(&bar[XB_XGEN(bx)], 1u);
            asm volatile("s_waitcnt vmcnt(0)" ::: "memory");
        } else {
            XB_SPIN(xb_ld(&bar[XB_XGEN(bx)]) == gen, bar);
            __builtin_amdgcn_fence(__ATOMIC_ACQUIRE, "agent");
            asm volatile("s_waitcnt vmcnt(0)" ::: "memory");
        }
    }
    __syncthreads();
}

namespace {
struct Params {
  const float *x, *meta, *rel_bias, *ln_mix, *w_in, *sinks, *conv_w, *conv_b, *dt_bias, *a_log, *d_skip, *attn_norm_w,
      *ssm_norm_w, *w_out, *ln_ffn, *wq, *keys, *U, *V, *ln_final;
  float* out;
  unsigned char* ws;
};

__device__ __forceinline__ void p0_transpose_tile(const float* __restrict__ W, int ldw, bf16_t* __restrict__ Wt, const float* sc0,
                                                  const float* sc1, int k0, int n0, float* tile) {
  const int tid = threadIdx.x;
  {
    const int r = tid >> 6, c4 = (tid & 63) * 4;
    f32x4 v[8];
#pragma unroll
    for (int i = 0; i < 8; ++i) v[i] = __builtin_nontemporal_load((const f32x4*)(W + (size_t)(k0 + r + 8 * i) * ldw + n0 + c4));
#pragma unroll
    for (int i = 0; i < 8; ++i) {
      float s = 1.f;
      const int k = k0 + r + 8 * i;
      if (sc0) s = k < 1024 ? sc0[k] : sc1[k - 1024];
      float* q = tile + (r + 8 * i) * 257 + c4;
      q[0] = v[i][0] * s; q[1] = v[i][1] * s; q[2] = v[i][2] * s; q[3] = v[i][3] * s;
    }
  }
  __syncthreads();
#pragma unroll
  for (int it = 0; it < 4; ++it) {
    const int task = it * NTHREADS + tid;
    const int n = task >> 3, kc = (task & 7) * 8;
    float v[8];
#pragma unroll
    for (int j = 0; j < 8; ++j) v[j] = tile[(kc + j) * 257 + n];
    u32x4 w; w.x = pack_bf16(v[0], v[1]); w.y = pack_bf16(v[2], v[3]); w.z = pack_bf16(v[4], v[5]); w.w = pack_bf16(v[6], v[7]);
    *(u32x4*)(Wt + (size_t)(n0 + n) * DM + k0 + kc) = w;
  }
  __syncthreads();
}

__device__ __forceinline__ void phase0(const Params& p, float* ldsf, int bid, int nblk) {
  const int tid = threadIdx.x, lane = tid & 63, wid = tid >> 6;
  bf16_t* w_inT = (bf16_t*)(p.ws + WS_WINT);
  bf16_t* w_dtT = (bf16_t*)(p.ws + WS_WDTT);
  bf16_t* w_outT = (bf16_t*)(p.ws + WS_WOUTT);
  bf16_t* wqT = (bf16_t*)(p.ws + WS_WQT);
  bf16_t* keysb = (bf16_t*)(p.ws + WS_KEYS);
  unsigned char* ub = p.ws + WS_UB;
  unsigned char* vb = p.ws + WS_VB;
  bf16_t* hnb = (bf16_t*)(p.ws + WS_HNB);
  constexpr int U_HN = (TA + 7) / 8;
  constexpr int U_WIN = 32 * 16, U_WOUT = 32 * 8, U_WQ = 32 * 8, U_WDT = 1, U_KEYS = 64;
  constexpr int B_WIN = U_HN, B_WOUT = B_WIN + U_WIN, B_WQ = B_WOUT + U_WOUT, B_WDT = B_WQ + U_WQ, B_KEYS = B_WDT + U_WDT,
                B_U = B_KEYS + U_KEYS, B_END = B_U;
  for (int u = bid; u < B_END; u += nblk) {
    if (u < B_WIN) {
      const int t = u * 8 + wid;
      if (t < TA) {
        const float* src = t < T ? p.x + (size_t)t * DM : p.meta + (size_t)(t - T) * DM;
        float4 v[8];
        float ss = 0.f;
#pragma unroll
        for (int i = 0; i < 8; ++i) {
          { const f32x4 q_ = __builtin_nontemporal_load((const f32x4*)(src + (i * 64 + lane) * 4)); v[i].x = q_[0]; v[i].y = q_[1]; v[i].z = q_[2]; v[i].w = q_[3]; }
          ss += v[i].x * v[i].x + v[i].y * v[i].y + v[i].z * v[i].z + v[i].w * v[i].w;
        }
        ss = wave_sum(ss);
        const float r = rsqrtf(ss * (1.f / DM) + EPS);
#pragma unroll
        for (int i = 0; i < 8; ++i) {
          const float4 w = *(const float4*)(p.ln_mix + (i * 64 + lane) * 4);
          u32x2 o; o.x = pack_bf16(v[i].x * r * w.x, v[i].y * r * w.y); o.y = pack_bf16(v[i].z * r * w.z, v[i].w * r * w.w);
          *(u32x2*)(hnb + (size_t)t * DM + (i * 64 + lane) * 4) = o;
        }
      }
    } else if (u < B_WOUT) {
      const int i = u - B_WIN;
      p0_transpose_tile(p.w_in, DPROJ, w_inT, nullptr, nullptr, (i & 31) * 64, (i >> 5) * 256, ldsf);
    } else if (u < B_WQ) {
      const int i = u - B_WOUT;
      p0_transpose_tile(p.w_out, DM, w_outT, p.attn_norm_w, p.ssm_norm_w, (i & 31) * 64, (i >> 5) * 256, ldsf);
    } else if (u < B_WDT) {
      const int i = u - B_WQ;
      p0_transpose_tile(p.wq, DM, wqT, p.ln_ffn, p.ln_ffn + 1024, (i & 31) * 64, (i >> 5) * 256, ldsf);
    } else if (u < B_KEYS) {
      for (int idx = tid; idx < DM * 16; idx += NTHREADS) {
        const int k = idx >> 4, j = idx & 15;
        w_dtT[(size_t)j * DM + k] = f2bf(p.w_in[(size_t)k * DPROJ + NPROJ + j]);
      }
    } else if (u < B_U) {
      const size_t base = (size_t)(u - B_KEYS) * 4096 + (size_t)tid * 8;
      const float4 a = *(const float4*)(p.keys + base), b = *(const float4*)(p.keys + base + 4);
      u32x4 w; w.x = pack_bf16(a.x, a.y); w.y = pack_bf16(a.z, a.w); w.z = pack_bf16(b.x, b.y); w.w = pack_bf16(b.z, b.w);
      *(u32x4*)(keysb + base) = w;
    }
  }
  {
    const int gw = bid * 8 + wid, nw = nblk * 8;
    auto load_row = [&](f32x4 (&a)[8], const int r2) __attribute__((always_inline)) {
      const float* src = (r2 < NEXP ? p.U + (size_t)r2 * DM : p.V + (size_t)(r2 - NEXP) * DM) + lane * 4;
#pragma unroll
      for (int j = 0; j < 8; ++j) a[j] = __builtin_nontemporal_load((const f32x4*)(src + 256 * j));
    };
    auto conv_row = [&](f32x4 (&a)[8], const int r2) __attribute__((always_inline)) {
      const bool isU = r2 < NEXP;
      const int row = isU ? r2 : r2 - NEXP;
      if (isU) {
#pragma unroll
        for (int j = 0; j < 8; ++j) a[j] *= *(const f32x4*)(p.ln_ffn + lane * 4 + 256 * j);
      }
      float amax = 0.f;
#pragma unroll
      for (int j = 0; j < 8; ++j) amax = fmaxf(amax, fmaxf(fmaxf(fabsf(a[j][0]), fabsf(a[j][1])), fmaxf(fabsf(a[j][2]), fabsf(a[j][3]))));
      amax = wave_max(amax);
      const float s4 = amax > 0.f ? 6.f / amax : 1.f;
      u32x4 w4;
#pragma unroll
      for (int j = 0; j < 4; ++j) {
        unsigned w = 0;
        w = __builtin_amdgcn_cvt_scalef32_pk_fp4_f32(w, a[2 * j][0] * s4, a[2 * j][1] * s4, 1.0f, 0);
        w = __builtin_amdgcn_cvt_scalef32_pk_fp4_f32(w, a[2 * j][2] * s4, a[2 * j][3] * s4, 1.0f, 1);
        w = __builtin_amdgcn_cvt_scalef32_pk_fp4_f32(w, a[2 * j + 1][0] * s4, a[2 * j + 1][1] * s4, 1.0f, 2);
        w = __builtin_amdgcn_cvt_scalef32_pk_fp4_f32(w, a[2 * j + 1][2] * s4, a[2 * j + 1][3] * s4, 1.0f, 3);
        w4[j] = w;
      }
      *(u32x4*)((isU ? ub : vb) + (size_t)row * ROW4 + lane * 16) = w4;
      if (lane == 0) ((float*)(p.ws + (isU ? WS_USC : WS_VSC)))[row] = amax > 0.f ? amax * (1.f / 6.f) : 1.f;
    };
    f32x4 ra[8], rb[8];
    int r2 = gw;
    if (r2 < 2 * NEXP) load_row(ra, r2);
#pragma unroll 1
    for (; r2 < 2 * NEXP; r2 += 2 * nw) {
      if (r2 + nw < 2 * NEXP) load_row(rb, r2 + nw);
      conv_row(ra, r2);
      if (r2 + nw < 2 * NEXP) {
        if (r2 + 2 * nw < 2 * NEXP) load_row(ra, r2 + 2 * nw);
        conv_row(rb, r2 + nw);
      }
    }
  }
}

__device__ __forceinline__ void mini_gemm(const bf16_t* __restrict__ A, const bf16_t* __restrict__ Bt, float* __restrict__ out, int ldo,
                                          float* red, bf16_t* __restrict__ outb = nullptr) {
  const int tid = threadIdx.x, lane = tid & 63, wid = tid >> 6, fr = lane & 15, fq = lane >> 4;
  f32x4 acc = {0.f, 0.f, 0.f, 0.f};
  const bf16_t* ap = A + (size_t)fr * DM + wid * 256 + fq * 8;
  const bf16_t* bp = Bt + (size_t)fr * DM + wid * 256 + fq * 8;
#pragma unroll
  for (int ks = 0; ks < 8; ++ks) {
    const bf16x8 a = *(const bf16x8*)(ap + ks * 32);
    const bf16x8 b = *(const bf16x8*)(bp + ks * 32);
    acc = __builtin_amdgcn_mfma_f32_16x16x32_bf16(a, b, acc, 0, 0, 0);
  }
#pragma unroll
  for (int r = 0; r < 4; ++r) red[wid * 256 + (4 * fq + r) * 16 + fr] = acc[r];
  __syncthreads();
  if (tid < 256) {
    float s = 0.f;
#pragma unroll
    for (int w = 0; w < 8; ++w) s += red[w * 256 + tid];
    out[(size_t)(tid >> 4) * ldo + (tid & 15)] = s;
    if (outb) outb[(size_t)(tid >> 4) * ldo + (tid & 15)] = f2bf(s);
  }
  __syncthreads();
}

__device__ __forceinline__ void phase1(const Params& p, unsigned char* lds, int bid, int nblk) {
  const bf16_t* hnb = (const bf16_t*)(p.ws + WS_HNB);
  const bf16_t* w_inT = (const bf16_t*)(p.ws + WS_WINT);
  const bf16_t* w_dtT = (const bf16_t*)(p.ws + WS_WDTT);
  float* dtraw = (float*)(p.ws + WS_DTRAW);
  float* projm = (float*)(p.ws + WS_PROJM);
  constexpr int NU = 512 + 32 + 96 + 1;
  for (int u = bid; u < NU; u += nblk) {
    if (u < 512) {
      mini_gemm(hnb + (size_t)u * 16 * DM, w_dtT, dtraw + (size_t)u * 16 * 16, 16, (float*)lds);
    } else {
      const int j = u - 512;
      const int cf = j < 32 ? 64 + j : (j < 128 ? 160 + (j - 32) : 256);
      const bf16_t* bt = cf < 256 ? w_inT + (size_t)cf * 16 * DM : w_dtT;
      mini_gemm(hnb + (size_t)T * DM, bt, projm + cf * 16, DPROJ, (float*)lds, (bf16_t*)(p.ws + WS_PROJMB) + cf * 16);
    }
  }
  pg8::Gemm g{hnb, w_inT, T, NPROJ, DM};
  pg8::StaticOrder S; S.init(T, NPROJ, nblk, bid);
  pg8::EpiBf16 E{(bf16_t*)(p.ws + WS_PROJ), NPROJ};
  pg8::gemm_phase<pg8::EpiBf16, pg8::StaticOrder>((PG8_LAS unsigned char*)lds, g, S, E);
}

__device__ __forceinline__ void phase4(const Params& p, unsigned char* lds, int bid, int nblk) {
  pg8::Gemm g{(const bf16_t*)(p.ws + WS_HNB), (const bf16_t*)(p.ws + WS_WOUTT), T, DM, DM};
  pg8::StaticOrder S; S.init(T, DM, nblk, bid);
  pg8::EpiRes E{p.x, (bf16_t*)(p.ws + WS_H1B), (float*)(p.ws + WS_SSQH1)};
  pg8::gemm_phase<pg8::EpiRes, pg8::StaticOrder>((PG8_LAS unsigned char*)lds, g, S, E);
}
__device__ __forceinline__ void phase5(const Params& p, unsigned char* lds, int bid, int nblk) {
  pg8::Gemm g{(const bf16_t*)(p.ws + WS_H1B), (const bf16_t*)(p.ws + WS_WQT), T, DM, DM};
  pg8::StaticOrder S; S.init(T, DM, nblk, bid);
  pg8::EpiScores E{(const bf16_t*)(p.ws + WS_KEYS), (float*)(p.ws + WS_STOP), (int*)(p.ws + WS_ITOP)};
  pg8::gemm_phase<pg8::EpiScores, pg8::StaticOrder>((PG8_LAS unsigned char*)lds, g, S, E);
}

__device__ __forceinline__ float dot2bf(unsigned a, unsigned b, float c) {
  return __builtin_amdgcn_fdot2_f32_bf16(*(bf16v2*)&a, *(bf16v2*)&b, c, false);
}
__device__ __forceinline__ void phase6(const Params& p, unsigned char* lds, int bid, int nblk) {
  const int tid0 = threadIdx.x, lane0 = tid0 & 63, wid = __builtin_amdgcn_readfirstlane(tid0 >> 6);
  int* ids = (int*)(lds + wid * 2048);
  float* gts = (float*)(lds + wid * 2048 + 512);
  float* wts = (float*)(lds + wid * 2048 + 1024);
  int* rid = (int*)(lds + 16384 + wid * 1024);
  float* rgt = (float*)(lds + 16384 + wid * 1024 + 512);
  const unsigned char* ub = p.ws + WS_UB;
  const unsigned char* vb = p.ws + WS_VB;
  const bf16_t* h1b = (const bf16_t*)(p.ws + WS_H1B);
  const float* usc = (const float*)(p.ws + WS_USC);
  const float* vsc = (const float*)(p.ws + WS_VSC);
  const float* ssq = (const float*)(p.ws + WS_SSQH1);
  const float* stop = (const float*)(p.ws + WS_STOP);
  const int* itop = (const int*)(p.ws + WS_ITOP);
  const int ci = kCandI[lane0], cj = kCandJ[lane0];
#pragma unroll 1
  for (int t = bid * 8 + wid; t < T; t += nblk * 8) {
    int tid = tid0; asm volatile("" : "+v"(tid));
    const int lane = tid & 63;
    const int kcode = 8 * ((lane >> 2) & 1) + 4 * ((lane >> 3) & 1) + 2 * ((lane >> 4) & 1) + ((lane >> 5) & 1);
    const float part0 = lane < 32 ? ssq[(size_t)t * 32 + lane] : 0.f;
    const float rr = rsqrtf(wave_sum(part0) * (1.f / DM) + EPS);
#pragma unroll 1
    for (int h = 0; h < 8; ++h) {
      const size_t lbase = ((size_t)t * 16 + h * 2) * 16;
      const float sv = lane < 32 ? __builtin_nontemporal_load(stop + lbase + lane) : 0.f;
      const int iv = lane < 32 ? __builtin_nontemporal_load(itop + lbase + lane) : 0;
      float cand = (__shfl(sv, ci) + __shfl(sv, 16 + cj)) * rr;
      if (lane >= 50) cand = -INFINITY;
      unsigned key = __float_as_uint(cand);
      key = (key & 0x80000000u) ? ~key : (key | 0x80000000u);
      key = (key & ~63u) | (unsigned)(63 - lane);
      int rank = 0;
#pragma unroll
      for (int k = 0; k < 50; ++k) {
        const unsigned kk = (unsigned)__builtin_amdgcn_readlane((int)key, k);
        rank += kk > key ? 1 : 0;
      }
      const float cmax = wave_max(cand);
      const float ex = rank < 16 ? __expf(cand - cmax) : 0.f;
      const float den = wave_sum(ex);
      const int eidx = __shfl(iv, ci) * 128 + __shfl(iv, 16 + cj);
      if (rank < 16) { rid[h * 16 + rank] = eidx; rgt[h * 16 + rank] = ex / den; }
    }
    {
      const int e0 = rid[lane], e1 = rid[lane + 64];
      const float g0 = rgt[lane], g1 = rgt[lane + 64];
      const int r0 = e0 >> 10, r1 = e1 >> 10;
      const unsigned long long ltm = (1ull << lane) - 1ull;
      int run = 0, pos0 = 0, pos1 = 0;
#pragma unroll
      for (int R = 0; R < 16; ++R) {
        const unsigned long long m0 = __ballot(r0 == R), m1 = __ballot(r1 == R);
        const int c0 = __popcll(m0), c1 = __popcll(m1);
        if (r0 == R) pos0 = run + __popcll(m0 & ltm);
        if (r1 == R) pos1 = run + c0 + __popcll(m1 & ltm);
        run += c0 + c1;
      }
      ids[pos0] = e0; gts[pos0] = g0;
      ids[pos1] = e1; gts[pos1] = g1;
    }
    float xf[32];
    {
      const bf16_t* xp = h1b + (size_t)t * DM + lane * 4;
#pragma unroll
      for (int j = 0; j < 8; ++j) {
        const u32x2 xa = *(const u32x2*)(xp + 256 * j);
        xf[4 * j + 0] = bflo(xa.x); xf[4 * j + 1] = bfhi(xa.x); xf[4 * j + 2] = bflo(xa.y); xf[4 * j + 3] = bfhi(xa.y);
      }
    }
#pragma unroll 1
    for (int rnd = 0; rnd < 8; ++rnd) {
      u32x4 ra[16];
#pragma unroll
      for (int k = 0; k < 16; ++k) {
        const int e = __builtin_amdgcn_readfirstlane(ids[rnd * 16 + k]);
        ra[k] = *(const u32x4*)(ub + (size_t)e * ROW4 + lane * 16);
      }
      float part[16];
      float prev = 0.f;
#pragma unroll
      for (int k = 0; k < 16; ++k) {
        asm volatile("" : "+v"(ra[k]) : "v"(prev));
        float d0 = 0.f, d1 = 0.f;
#define U4_STEP(j, i) { const f32x2 r = __builtin_amdgcn_cvt_scalef32_pk_f32_fp4(ra[k][j], 1.0f, i); \
          d0 = fmaf(r[0], xf[8 * (j) + 2 * (i)], d0); d1 = fmaf(r[1], xf[8 * (j) + 2 * (i) + 1], d1); }
#pragma unroll
        for (int j = 0; j < 4; ++j) { U4_STEP(j, 0) U4_STEP(j, 1) U4_STEP(j, 2) U4_STEP(j, 3) }
#undef U4_STEP
        prev = d0 + d1;
        part[k] = prev;
      }
      float q8[8], q4[4], q2[2], q1;
      { const bool hi = (lane >> 5) & 1;
#pragma unroll
        for (int i = 0; i < 8; ++i) { const float keep = hi ? part[2 * i + 1] : part[2 * i], send = hi ? part[2 * i] : part[2 * i + 1]; q8[i] = keep + __shfl_xor(send, 32); } }
      { const bool hi = (lane >> 4) & 1;
#pragma unroll
        for (int i = 0; i < 4; ++i) { const float keep = hi ? q8[2 * i + 1] : q8[2 * i], send = hi ? q8[2 * i] : q8[2 * i + 1]; q4[i] = keep + __shfl_xor(send, 16); } }
      { const bool hi = (lane >> 3) & 1;
#pragma unroll
        for (int i = 0; i < 2; ++i) { const float keep = hi ? q4[2 * i + 1] : q4[2 * i], send = hi ? q4[2 * i] : q4[2 * i + 1]; q2[i] = keep + __shfl_xor(send, 8); } }
      { const bool hi = (lane >> 2) & 1;
        const float keep = hi ? q2[1] : q2[0], send = hi ? q2[0] : q2[1]; q1 = keep + __shfl_xor(send, 4); }
      q1 += __shfl_xor(q1, 2);
      q1 += __shfl_xor(q1, 1);
      {
        const int kk = rnd * 16 + kcode;
        const int eid = ids[kk];
        const float a = q1 * rr * usc[eid];
        const float ge = 0.5f * a * (1.f + erff(a * 0.70710678118654752f));
        if ((lane & 3) == 0) wts[kk] = gts[kk] * ge * vsc[eid];
      }
    }
    float acc[32];
#pragma unroll
    for (int i = 0; i < 32; ++i) acc[i] = 0.f;
#pragma unroll 1
    for (int rnd = 0; rnd < 8; ++rnd) {
      u32x4 ra[16];
#pragma unroll
      for (int k = 0; k < 16; ++k) {
        const int e = __builtin_amdgcn_readfirstlane(ids[rnd * 16 + k]);
        ra[k] = *(const u32x4*)(vb + (size_t)e * ROW4 + lane * 16);
      }
      f32x4 wv[4];
#pragma unroll
      for (int j = 0; j < 4; ++j) wv[j] = *(const f32x4*)(wts + rnd * 16 + 4 * j);
#pragma unroll
      for (int k = 0; k < 16; ++k) {
        const float wk = wv[k >> 2][k & 3];
        asm volatile("" : "+v"(ra[k]) : "v"(acc[1]), "v"(acc[3]), "v"(acc[5]), "v"(acc[7]), "v"(acc[9]), "v"(acc[11]), "v"(acc[13]), "v"(acc[15]),
                                        "v"(acc[17]), "v"(acc[19]), "v"(acc[21]), "v"(acc[23]), "v"(acc[25]), "v"(acc[27]), "v"(acc[29]), "v"(acc[31]));
#define V4_STEP(j, i) { const f32x2 r = __builtin_amdgcn_cvt_scalef32_pk_f32_fp4(ra[k][j], 1.0f, i); \
            acc[8 * (j) + 2 * (i)] = fmaf(wk, r[0], acc[8 * (j) + 2 * (i)]); acc[8 * (j) + 2 * (i) + 1] = fmaf(wk, r[1], acc[8 * (j) + 2 * (i) + 1]); }
#pragma unroll
        for (int j = 0; j < 4; ++j) { V4_STEP(j, 0) V4_STEP(j, 1) V4_STEP(j, 2) V4_STEP(j, 3) }
#undef V4_STEP
      }
    }
    float ss = 0.f;
#pragma unroll
    for (int i = 0; i < 32; ++i) { acc[i] += xf[i]; ss += acc[i] * acc[i]; }
    ss = wave_sum(ss);
    const float rf = rsqrtf(ss * (1.f / DM) + EPS);
#pragma unroll
    for (int j = 0; j < 8; ++j) {
      const f32x4 lw = *(const f32x4*)(p.ln_final + 256 * j + lane * 4);
      const f32x4 o = {acc[4 * j] * rf * lw[0], acc[4 * j + 1] * rf * lw[1], acc[4 * j + 2] * rf * lw[2], acc[4 * j + 3] * rf * lw[3]};
      __builtin_nontemporal_store(o, (f32x4*)(p.out + (size_t)t * DM + 256 * j + lane * 4));
    }
  }
}

typedef float f32x16 __attribute__((ext_vector_type(16)));
__device__ __forceinline__ void unpack8(const u32x4 a, float (&v)[8]) {
  v[0] = bflo(a.x); v[1] = bfhi(a.x); v[2] = bflo(a.y); v[3] = bfhi(a.y); v[4] = bflo(a.z); v[5] = bfhi(a.z); v[6] = bflo(a.w); v[7] = bfhi(a.w);
}
constexpr int VT_LD = 196;
constexpr int ATT_VT_BYTES = 4 * 64 * VT_LD * 2;
__device__ __forceinline__ void attn_item(const Params& p, unsigned char* lds, int item) {
  const int tid = threadIdx.x, lane = tid & 63, wid = __builtin_amdgcn_readfirstlane(tid >> 6);
  const int b = item >> 6, q0 = (item & 63) * 32;
  bf16_t* VT = (bf16_t*)lds;
  float* biasL = (float*)(lds + ATT_VT_BYTES);
  float* ssqw = biasL + 16 * 132;
  const bf16_t* proj = (const bf16_t*)(p.ws + WS_PROJ);
  const float* projm = (const float*)(p.ws + WS_PROJM);
  bf16_t* mixin = (bf16_t*)(p.ws + WS_HNB);
#pragma unroll
  for (int it = 0; it < 5; ++it) {
    const int idx = it * NTHREADS + tid;
    if (idx >= 16 * 129) break;
    const int hq = idx / 129, d = idx - hq * 129;
    const int bk = d < 128 ? (int)kBucket[d] : 31;
    biasL[hq * 132 + d] = p.rel_bias[bk * 16 + hq];
  }
  const int ql = lane & 31, ql0 = ql, hh = lane >> 5, kvh = wid >> 1;
  const int trow = b * SEQ + q0 + ql;
  bf16x8 qf[4];
  u32x4 kf[6][4];
#define ATT_LOAD_Q(hq_)                                                                                                           \
  { _Pragma("unroll") for (int ks = 0; ks < 4; ++ks) qf[ks] = *(const bf16x8*)(proj + (size_t)trow * NPROJ + OFF_Q + (hq_) * 64 + ks * 16 + hh * 8); }
#define ATT_LOAD_K()                                                                                                              \
  {                                                                                                                               \
    int ql = ql0; asm volatile("" : "+v"(ql));     \
    const float* kr_ = projm + (size_t)(ql & 15) * DPROJ + OFF_K + kvh * 64 + hh * 8;                                             \
    _Pragma("unroll") for (int ks = 0; ks < 4; ++ks) {                                                                            \
      const f32x4 a_ = *(const f32x4*)(kr_ + ks * 16), c_ = *(const f32x4*)(kr_ + ks * 16 + 4);                                   \
      kf[0][ks].x = pack_bf16(a_[0], a_[1]); kf[0][ks].y = pack_bf16(a_[2], a_[3]); kf[0][ks].z = pack_bf16(c_[0], c_[1]); kf[0][ks].w = pack_bf16(c_[2], c_[3]); } \
    _Pragma("unroll") for (int jt = 1; jt < 6; ++jt) {                                                                            \
      int sp_ = q0 - 128 + 32 * (jt - 1) + ql; sp_ = sp_ < 0 ? 0 : sp_;                                                           \
      const bf16_t* kp_ = proj + (size_t)(b * SEQ + sp_) * NPROJ + OFF_K + kvh * 64 + hh * 8;                                     \
      _Pragma("unroll") for (int ks = 0; ks < 4; ++ks) kf[jt][ks] = *(const u32x4*)(kp_ + ks * 16); }                             \
  }
  ATT_LOAD_Q(2 * wid)
#pragma unroll 1
  for (int rep_ = 0; rep_ < (REP_SUB == 2 ? 2 : 1); ++rep_) {
    u32x4 ra[5], rc[5];
#pragma unroll
    for (int q = 0; q < 5; ++q) {
      const int task = q * NTHREADS + tid, ch = task / 80, pi = task - ch * 80;
      int s0 = q0 - 128 + 2 * pi;
      s0 = s0 < 0 ? 0 : s0;
      const bf16_t* r0 = proj + (size_t)(b * SEQ + s0) * NPROJ + OFF_V + ch * 8;
      ra[q] = *(const u32x4*)r0; rc[q] = *(const u32x4*)(r0 + NPROJ);
    }
    float m0[8], m1[8];
    {
      const int pi = tid & 7, ch = (tid >> 3) & 31;
      const float* r0 = projm + (size_t)(2 * pi) * DPROJ + OFF_V + ch * 8;
      const f32x4 ma = *(const f32x4*)r0, mb = *(const f32x4*)(r0 + 4), mc = *(const f32x4*)(r0 + DPROJ), md = *(const f32x4*)(r0 + DPROJ + 4);
      const float keep = tid < 256 ? 1.f : 0.f;
#pragma unroll
      for (int i = 0; i < 4; ++i) { m0[i] = ma[i] * keep; m0[4 + i] = mb[i] * keep; m1[i] = mc[i] * keep; m1[4 + i] = md[i] * keep; }
      bf16_t* dst = VT + (size_t)((ch >> 3) * 64 + (ch & 7) * 8) * VT_LD + 2 * pi + (tid < 256 ? 0 : 16);
#pragma unroll
      for (int i = 0; i < 8; ++i) *(unsigned*)(dst + i * VT_LD) = pack_bf16(m0[i], m1[i]);
    }
#pragma unroll
    for (int q = 0; q < 5; ++q) {
      const int task = q * NTHREADS + tid, ch = task / 80, pi = task - ch * 80;
      float v0[8], v1[8];
      unpack8(ra[q], v0); unpack8(rc[q], v1);
      bf16_t* dst = VT + (size_t)((ch >> 3) * 64 + (ch & 7) * 8) * VT_LD + 32 + 2 * pi;
#pragma unroll
      for (int i = 0; i < 8; ++i) *(unsigned*)(dst + i * VT_LD) = pack_bf16(v0[i], v1[i]);
    }
  }
  __syncthreads();
  float ssq = 0.f;
#pragma unroll 1
  for (int rep_ = 0; rep_ < (REP_SUB == 3 ? 2 : 1); ++rep_) {
  ssq = 0.f;
  auto do_head = [&](const int hsel) __attribute__((always_inline)) {
    const int hq = 2 * wid + hsel;
    f32x16 sacc[6];
#pragma unroll
    for (int jt = 0; jt < 6; ++jt) {
      f32x16 acc;
#pragma unroll
      for (int r = 0; r < 16; ++r) acc[r] = 0.f;
#pragma unroll
      for (int ks = 0; ks < 4; ++ks) acc = __builtin_amdgcn_mfma_f32_32x32x16_bf16(*(bf16x8*)&kf[jt][ks], qf[ks], acc, 0, 0, 0);
      sacc[jt] = acc;
    }
    if (hsel == 0) { ATT_LOAD_Q(2 * wid + 1) }
    const float* bl = biasL + hq * 132;
    int sq = q0 + ql, qh = ql - 4 * hh;
    asm volatile("" : "+v"(sq), "+v"(qh));
    const float sink = p.sinks[hq];
    float m = sink;
#pragma unroll
    for (int jt = 0; jt < 6; ++jt) {
      asm volatile("" ::: "memory");
#pragma unroll
      for (int r = 0; r < 16; ++r) {
        const int kr = (r & 3) + 8 * (r >> 2) + 4 * hh;
        int dist; bool valid;
        if (jt == 0) { dist = sq + (16 - ((r & 3) + 8 * (r >> 2))) - 4 * hh; valid = kr < 16; }
        else { dist = qh + (128 - 32 * (jt - 1) - ((r & 3) + 8 * (r >> 2))); valid = (dist >= 0) && (dist < 128) && (dist <= sq); }
        const int dc = dist < 0 ? 0 : (dist > 128 ? 128 : dist);
        const float l = valid ? 0.125f * sacc[jt][r] + bl[dc] : -1e30f;
        sacc[jt][r] = l;
        m = fmaxf(m, l);
      }
    }
    m = fmaxf(m, __shfl_xor(m, 32));
    float sum = 0.f;
    f32x16 oacc0, oacc1;
#pragma unroll
    for (int r = 0; r < 16; ++r) { oacc0[r] = 0.f; oacc1[r] = 0.f; }
    const bf16_t* vrow0 = VT + (size_t)(kvh * 64 + ql) * VT_LD + 4 * hh;
    const bf16_t* vrow1 = vrow0 + 32 * VT_LD;
#pragma unroll
    for (int jt = 0; jt < 6; ++jt) {
      u32x4 pw[2];
#pragma unroll
      for (int s2 = 0; s2 < 2; ++s2) {
        float e[8];
#pragma unroll
        for (int i = 0; i < 8; ++i) { e[i] = __expf(sacc[jt][8 * s2 + i] - m); sum += e[i]; }
        pw[s2].x = pack_bf16(e[0], e[1]); pw[s2].y = pack_bf16(e[2], e[3]); pw[s2].z = pack_bf16(e[4], e[5]); pw[s2].w = pack_bf16(e[6], e[7]);
      }
#pragma unroll
      for (int s2 = 0; s2 < 2; ++s2) {
        const u32x2 va = *(const u32x2*)(vrow0 + 32 * jt + 16 * s2), vc = *(const u32x2*)(vrow0 + 32 * jt + 16 * s2 + 8);
        const u32x2 vd = *(const u32x2*)(vrow1 + 32 * jt + 16 * s2), ve = *(const u32x2*)(vrow1 + 32 * jt + 16 * s2 + 8);
        u32x4 v0w; v0w.x = va.x; v0w.y = va.y; v0w.z = vc.x; v0w.w = vc.y;
        u32x4 v1w; v1w.x = vd.x; v1w.y = vd.y; v1w.z = ve.x; v1w.w = ve.y;
        oacc0 = __builtin_amdgcn_mfma_f32_32x32x16_bf16(*(bf16x8*)&v0w, *(bf16x8*)&pw[s2], oacc0, 0, 0, 0);
        oacc1 = __builtin_amdgcn_mfma_f32_32x32x16_bf16(*(bf16x8*)&v1w, *(bf16x8*)&pw[s2], oacc1, 0, 0, 0);
      }
    }
    sum += __shfl_xor(sum, 32);
    const float inv = 1.f / (sum + __expf(sink - m));
#pragma unroll
    for (int r = 0; r < 16; ++r) { oacc0[r] *= inv; oacc1[r] *= inv; ssq += oacc0[r] * oacc0[r] + oacc1[r] * oacc1[r]; }
#pragma unroll
    for (int rg = 0; rg < 4; ++rg) {
      u32x2 w; w.x = pack_bf16(oacc0[rg * 4 + 0], oacc0[rg * 4 + 1]); w.y = pack_bf16(oacc0[rg * 4 + 2], oacc0[rg * 4 + 3]);
      *(u32x2*)(mixin + (size_t)trow * DM + hq * 64 + 8 * rg + 4 * hh) = w;
      u32x2 w1; w1.x = pack_bf16(oacc1[rg * 4 + 0], oacc1[rg * 4 + 1]); w1.y = pack_bf16(oacc1[rg * 4 + 2], oacc1[rg * 4 + 3]);
      *(u32x2*)(mixin + (size_t)trow * DM + hq * 64 + 32 + 8 * rg + 4 * hh) = w1;
    }
  };
  ATT_LOAD_K()
  do_head(0);
  asm volatile("" ::: "memory");
  ATT_LOAD_K()
  do_head(1);
  }
  ssq += __shfl_xor(ssq, 32);
  if (lane < 32) ssqw[wid * 32 + lane] = ssq;
  __syncthreads();
  float tot = 0.f;
#pragma unroll
  for (int w = 0; w < 8; ++w) tot += ssqw[w * 32 + ql];
  const float ra = rsqrtf(tot * (1.f / 1024) + EPS);
#pragma unroll
  for (int hsel = 0; hsel < 2; ++hsel)
#pragma unroll
    for (int dt = 0; dt < 2; ++dt)
#pragma unroll
      for (int rg = 0; rg < 4; ++rg) {
        bf16_t* op = mixin + (size_t)trow * DM + (2 * wid + hsel) * 64 + 32 * dt + 8 * rg + 4 * hh;
        const u32x2 v = *(const u32x2*)op;
        u32x2 w; w.x = pack_bf16(bflo(v.x) * ra, bfhi(v.x) * ra); w.y = pack_bf16(bflo(v.y) * ra, bfhi(v.y) * ra);
        *(u32x2*)op = w;
      }
  __syncthreads();
}
#undef ATT_LOAD_Q
#undef ATT_LOAD_K
__device__ __forceinline__ void phase2_attn(const Params& p, unsigned char* lds, int bid, int nblk) {
  for (int item = bid; item < 256; item += nblk) attn_item(p, lds, item);
}

constexpr int SLD = 136;
__device__ __forceinline__ float conv_silu(const float (&raw)[11], int i, float w0, float w1, float w2, float w3, float cb) {
  return silu_f(cb + w0 * raw[i] + w1 * raw[i + 1] + w2 * raw[i + 2] + w3 * raw[i + 3]);
}
__device__ __forceinline__ void ssd_a_item(const Params& p, unsigned char* lds, int item) {
  const int tid = threadIdx.x, lane = tid & 63, wid = __builtin_amdgcn_readfirstlane(tid >> 6);
  const int b = item >> 6, c = (item >> 2) & 15, g = (item >> 1) & 1, hsel = item & 1;
  const int h0 = g * 8 + hsel * 4;
  const int t0 = b * SEQ + c * 128;
  bf16_t* Bc = (bf16_t*)lds;
  bf16_t* Cc = Bc + 128 * SLD;
  bf16_t* BcT = Cc + 128 * SLD;
  bf16_t* xT = BcT + 128 * SLD;
  float* dtl = (float*)(xT + 2 * 64 * SLD);
  float* acs = dtl + 512;
  float* wl = acs + 512;
  float* scan = wl + 512;
  const bf16_t* __restrict__ proj = (const bf16_t*)(p.ws + WS_PROJ);
  const bf16_t* __restrict__ projmb = (const bf16_t*)(p.ws + WS_PROJMB);
  const float* __restrict__ dtraw = (const float*)(p.ws + WS_DTRAW);
  float* __restrict__ acsg = (float*)(p.ws + WS_ACSG);
  bf16_t* __restrict__ ccb = (bf16_t*)(p.ws + WS_CCB);
  float* __restrict__ ypart = (float*)(p.ws + WS_YPART);
  float* __restrict__ sg = (float*)(p.ws + WS_SG);
  {
    const int hi = tid >> 7, l = tid & 127, h = h0 + hi;
    const float Ah = -expf(p.a_log[h]);
    const float dtv = softplus_f(dtraw[(size_t)(t0 + l) * 16 + h] + p.dt_bias[h]);
    dtl[tid] = dtv;
    float cum = dtv * Ah;
#pragma unroll
    for (int o = 1; o < 64; o <<= 1) { const float nb = __shfl_up(cum, o); if (lane >= o) cum += nb; }
    if ((tid & 127) == 63) scan[hi] = cum;
    __syncthreads();
    if (l >= 64) cum += scan[hi];
    acs[tid] = cum;
    acsg[(size_t)(t0 + l) * 16 + h] = cum;
    __syncthreads();
    wl[tid] = dtv * __expf(acs[hi * 128 + 127] - cum);
  }
  {
    unsigned raw[4][11];
#pragma unroll
    for (int q = 0; q < 4; ++q) {
      const int task = q * NTHREADS + tid;
      const int tg = task >> 7, cp = task & 127;
      const int cch = 1024 + (cp >> 6) * 256 + g * 128 + 2 * (cp & 63);
#pragma unroll
      for (int i = 0; i < 11; ++i) {
        const int l = tg * 8 + i - 3;
        const bf16_t* src = (l >= 0 || c > 0) ? proj + (size_t)(t0 + l) * NPROJ : projmb + (size_t)(16 + l) * DPROJ;
        raw[q][i] = *(const unsigned*)(src + OFF_XBC + cch);
      }
    }
#pragma unroll
    for (int q = 0; q < 4; ++q) {
      const int task = q * NTHREADS + tid;
      const int tg = task >> 7, cp = task & 127, n = 2 * (cp & 63);
      const int cch = 1024 + (cp >> 6) * 256 + g * 128 + n;
      float o0[8], o1[8];
      {
        float r0[11], r1[11];
#pragma unroll
        for (int i = 0; i < 11; ++i) { r0[i] = bflo(raw[q][i]); r1[i] = bfhi(raw[q][i]); }
        const float w0 = p.conv_w[cch], w1 = p.conv_w[D_XBC + cch], w2 = p.conv_w[2 * D_XBC + cch], w3 = p.conv_w[3 * D_XBC + cch], cb = p.conv_b[cch];
        const float v0 = p.conv_w[cch + 1], v1 = p.conv_w[D_XBC + cch + 1], v2 = p.conv_w[2 * D_XBC + cch + 1], v3 = p.conv_w[3 * D_XBC + cch + 1], vb_ = p.conv_b[cch + 1];
#pragma unroll
        for (int i = 0; i < 8; ++i) { o0[i] = conv_silu(r0, i, w0, w1, w2, w3, cb); o1[i] = conv_silu(r1, i, v0, v1, v2, v3, vb_); }
      }
      bf16_t* rowm = (cp < 64 ? Bc : Cc) + (tg * 8) * SLD + n;
#pragma unroll
      for (int i = 0; i < 8; ++i) *(unsigned*)(rowm + i * SLD) = pack_bf16(o0[i], o1[i]);
      if (cp < 64) {
        u32x4 w; w.x = pack_bf16(o0[0], o0[1]); w.y = pack_bf16(o0[2], o0[3]); w.z = pack_bf16(o0[4], o0[5]); w.w = pack_bf16(o0[6], o0[7]);
        *(u32x4*)(BcT + n * SLD + tg * 8) = w;
        u32x4 w2_; w2_.x = pack_bf16(o1[0], o1[1]); w2_.y = pack_bf16(o1[2], o1[3]); w2_.z = pack_bf16(o1[4], o1[5]); w2_.w = pack_bf16(o1[6], o1[7]);
        *(u32x4*)(BcT + (n + 1) * SLD + tg * 8) = w2_;
      }
    }
  }
  float xraw[4][11];
#define SSD_LOAD_X(r_)                                                                                              \
  _Pragma("unroll") for (int q = 0; q < 4; ++q) {                                                                   \
    const int task = (q & 1) * NTHREADS + tid; const int tg = task >> 6, cch = (h0 + 2 * (r_) + (q >> 1)) * 64 + (task & 63); \
    _Pragma("unroll") for (int i = 0; i < 11; ++i) { const int l = tg * 8 + i - 3;                                  \
      const bf16_t* src = (l >= 0 || c > 0) ? proj + (size_t)(t0 + l) * NPROJ : projmb + (size_t)(16 + l) * DPROJ;  \
      xraw[q][i] = bf2f(src[OFF_XBC + cch]); } }
  SSD_LOAD_X(0)
  __syncthreads();
  if (hsel == 0) {
#pragma unroll
    for (int q = 0; q < 4; ++q) {
      const int idx = q * NTHREADS + tid, row = idx >> 4, ck = idx & 15;
      *(u32x4*)(ccb + (size_t)(t0 + row) * 256 + g * 128 + ck * 8) = *(const u32x4*)(Cc + row * SLD + ck * 8);
    }
  }
  const int ql = lane & 31, hh = lane >> 5;
  auto ydiag = [&](const int hi, const int il) __attribute__((always_inline)) {
    const int h = h0 + hi, ip = wid & 1;
    const bf16_t* xTb = xT + (hi & 1) * 64 * SLD;
    const float dskip = p.d_skip[h];
    const float* acsh = acs + hi * 128;
    const float* dtlh = dtl + hi * 128;
    const int l = 32 * il + ql;
    const float acl = acsh[l];
    f32x16 yacc;
#pragma unroll
    for (int r = 0; r < 16; ++r) yacc[r] = 0.f;
    const bf16_t* xrow = xTb + (32 * ip + ql) * SLD + 4 * hh;
#pragma unroll 1
    for (int is = 0; is <= il; ++is) {
      f32x16 x;
#pragma unroll
      for (int r = 0; r < 16; ++r) x[r] = 0.f;
      const bf16_t* ap = Bc + (32 * is + ql) * SLD + 8 * hh;
      const bf16_t* bp = Cc + l * SLD + 8 * hh;
#pragma unroll
      for (int ks = 0; ks < 8; ++ks) x = __builtin_amdgcn_mfma_f32_32x32x16_bf16(*(const bf16x8*)(ap + 16 * ks), *(const bf16x8*)(bp + 16 * ks), x, 0, 0, 0);
      u32x4 pw[2];
#pragma unroll
      for (int s2 = 0; s2 < 2; ++s2) {
        float mv[8];
#pragma unroll
        for (int q = 0; q < 2; ++q) {
          const int sb = 32 * is + 16 * s2 + 8 * q + 4 * hh;
          const f32x4 as4 = *(const f32x4*)(acsh + sb), dt4 = *(const f32x4*)(dtlh + sb);
#pragma unroll
          for (int j = 0; j < 4; ++j) {
            const int sr = sb + j;
            float v = sr <= l ? x[8 * s2 + 4 * q + j] * __expf(acl - as4[j]) * dt4[j] : 0.f;
            if (sr == l) v += dskip;
            mv[4 * q + j] = v;
          }
        }
        pw[s2].x = pack_bf16(mv[0], mv[1]); pw[s2].y = pack_bf16(mv[2], mv[3]); pw[s2].z = pack_bf16(mv[4], mv[5]); pw[s2].w = pack_bf16(mv[6], mv[7]);
      }
#pragma unroll
      for (int s2 = 0; s2 < 2; ++s2) {
        const u32x2 va = *(const u32x2*)(xrow + 32 * is + 16 * s2), vc = *(const u32x2*)(xrow + 32 * is + 16 * s2 + 8);
        u32x4 aw; aw.x = va.x; aw.y = va.y; aw.z = vc.x; aw.w = vc.y;
        yacc = __builtin_amdgcn_mfma_f32_32x32x16_bf16(*(bf16x8*)&aw, *(bf16x8*)&pw[s2], yacc, 0, 0, 0);
      }
    }
    float* yp = ypart + (size_t)(t0 + l) * 1024 + h * 64 + 32 * ip + 4 * hh;
#pragma unroll
    for (int rg = 0; rg < 4; ++rg) *(f32x4*)(yp + 8 * rg) = (f32x4){yacc[4 * rg], yacc[4 * rg + 1], yacc[4 * rg + 2], yacc[4 * rg + 3]};
  };
  auto states = [&](const int hi) __attribute__((always_inline)) {
    const int h = h0 + hi, ip = wid & 1, in = wid >> 1;
    const bf16_t* xTb = xT + (hi & 1) * 64 * SLD;
    const float* wlh = wl + hi * 128;
    f32x16 sacc;
#pragma unroll
    for (int r = 0; r < 16; ++r) sacc[r] = 0.f;
    const bf16_t* ap = xTb + (32 * ip + ql) * SLD + 8 * hh;
    const bf16_t* bp = BcT + (32 * in + ql) * SLD + 8 * hh;
#pragma unroll
    for (int ks = 0; ks < 8; ++ks) {
      const u32x4 xa = *(const u32x4*)(ap + 16 * ks);
      const f32x4 wa = *(const f32x4*)(wlh + 16 * ks + 8 * hh), wb = *(const f32x4*)(wlh + 16 * ks + 8 * hh + 4);
      u32x4 aw;
      aw.x = pack_bf16(bflo(xa.x) * wa[0], bfhi(xa.x) * wa[1]); aw.y = pack_bf16(bflo(xa.y) * wa[2], bfhi(xa.y) * wa[3]);
      aw.z = pack_bf16(bflo(xa.z) * wb[0], bfhi(xa.z) * wb[1]); aw.w = pack_bf16(bflo(xa.w) * wb[2], bfhi(xa.w) * wb[3]);
      sacc = __builtin_amdgcn_mfma_f32_32x32x16_bf16(*(bf16x8*)&aw, *(const bf16x8*)(bp + 16 * ks), sacc, 0, 0, 0);
    }
    float* sp = sg + ((size_t)((b * 16 + c) * 16 + h) * 64 + 32 * ip + 4 * hh) * 128 + 32 * in + ql;
#pragma unroll
    for (int r = 0; r < 16; ++r) sp[((r & 3) + 8 * (r >> 2)) * 128] = sacc[r];
  };
#pragma unroll 1
  for (int rnd_ = 0; rnd_ < (REP_SUB == 5 ? 4 : 2); ++rnd_) {
    const int rnd = rnd_ & 1;
#pragma unroll
    for (int q = 0; q < 4; ++q) {
      const int task = (q & 1) * NTHREADS + tid; const int tg = task >> 6, pch = task & 63, cch = (h0 + 2 * rnd + (q >> 1)) * 64 + pch;
      const float w0 = p.conv_w[cch], w1 = p.conv_w[D_XBC + cch], w2 = p.conv_w[2 * D_XBC + cch], w3 = p.conv_w[3 * D_XBC + cch], cb = p.conv_b[cch];
      float o[8];
#pragma unroll
      for (int i = 0; i < 8; ++i) o[i] = conv_silu(xraw[q], i, w0, w1, w2, w3, cb);
      u32x4 w; w.x = pack_bf16(o[0], o[1]); w.y = pack_bf16(o[2], o[3]); w.z = pack_bf16(o[4], o[5]); w.w = pack_bf16(o[6], o[7]);
      *(u32x4*)(xT + (q >> 1) * 64 * SLD + pch * SLD + tg * 8) = w;
    }
    { SSD_LOAD_X((rnd + 1) & 1) }
    __syncthreads();
    ydiag(2 * rnd, wid >> 1);
    ydiag(2 * rnd + 1, 3 - (wid >> 1));
    states(2 * rnd);
    states(2 * rnd + 1);
    __syncthreads();
  }
#undef SSD_LOAD_X
  __syncthreads();
}

__device__ __forceinline__ void meta_state_item(const Params& p, unsigned char* lds, int h) {
  const int tid = threadIdx.x, g = h >> 3;
  float* xm = (float*)lds;
  float* bm = xm + 16 * 64;
  float* dtm = bm + 16 * 128;
  const float* projm = (const float*)(p.ws + WS_PROJM);
  float* smeta = (float*)(p.ws + WS_SMETA);
  for (int task = tid; task < 16 * 192; task += NTHREADS) {
    const int i = task / 192, ch = task - i * 192;
    const int cch = ch < 64 ? h * 64 + ch : 1024 + g * 128 + (ch - 64);
    float acc = p.conv_b[cch];
#pragma unroll
    for (int j = 0; j < 4; ++j) { const int mi = i - j; if (mi >= 0) acc += p.conv_w[(3 - j) * D_XBC + cch] * projm[(size_t)mi * DPROJ + OFF_XBC + cch]; }
    const float v = silu_f(acc);
    if (ch < 64) xm[i * 64 + ch] = v; else bm[i * 128 + ch - 64] = v;
  }
  if (tid < 16) dtm[tid] = softplus_f(projm[(size_t)tid * DPROJ + OFF_DT + h] + p.dt_bias[h]);
  __syncthreads();
  const float Ah = -expf(p.a_log[h]);
  const int pr = tid >> 3, n0 = (tid & 7) * 16;
  float st[16];
#pragma unroll
  for (int k = 0; k < 16; ++k) st[k] = 0.f;
  for (int i = 0; i < 16; ++i) {
    const float dtv = dtm[i], dA = expf(dtv * Ah), xdt = xm[i * 64 + pr] * dtv;
#pragma unroll
    for (int k = 0; k < 16; ++k) st[k] = fmaf(st[k], dA, xdt * bm[i * 128 + n0 + k]);
  }
#pragma unroll
  for (int k = 0; k < 16; ++k) smeta[(size_t)(h * 64 + pr) * 128 + n0 + k] = st[k];
  __syncthreads();
}

__device__ __forceinline__ void phase2(const Params& p, unsigned char* lds, int bid, int nblk) {
#pragma unroll 1
  for (int rep = 0; rep < (REP_SUB == 0 ? 2 : 1); ++rep)
    for (int item = bid; item < 256; item += nblk) attn_item(p, lds, item);
#pragma unroll 1
  for (int rep = 0; rep < (REP_SUB == 1 ? 2 : 1); ++rep)
    for (int item = bid; item < 256; item += nblk) ssd_a_item(p, lds, item);
  for (int item = bid; item < 16; item += nblk) meta_state_item(p, lds, item);
}

__device__ __forceinline__ void phase_scan(const Params& p, int bid, int nblk) {
  const float* __restrict__ sg = (const float*)(p.ws + WS_SG);
  const float* __restrict__ smeta = (const float*)(p.ws + WS_SMETA);
  const float* __restrict__ acsg = (const float*)(p.ws + WS_ACSG);
  bf16_t* __restrict__ hprev = (bf16_t*)(p.ws + WS_HPREV);
  for (int task = bid * NTHREADS + threadIdx.x; task < 64 * 2048; task += nblk * NTHREADS) {
    const int bh = task >> 11, e4 = (task & 2047) * 4;
    const int b = bh >> 4, h = bh & 15;
    f32x4 sv[16];
    float dv[16];
#pragma unroll
    for (int c = 0; c < 16; ++c) {
      sv[c] = *(const f32x4*)(sg + (size_t)((b * 16 + c) * 16 + h) * 8192 + e4);
      dv[c] = acsg[(size_t)(b * SEQ + c * 128 + 127) * 16 + h];
    }
    f32x4 H = *(const f32x4*)(smeta + (size_t)h * 8192 + e4);
#pragma unroll
    for (int c = 0; c < 16; ++c) {
      u32x2 w; w.x = pack_bf16(H[0], H[1]); w.y = pack_bf16(H[2], H[3]);
      *(u32x2*)(hprev + (size_t)((b * 16 + c) * 16 + h) * 8192 + e4) = w;
      H = H * __expf(dv[c]) + sv[c];
    }
  }
}

__device__ __forceinline__ void ssd_b_item(const Params& p, unsigned char* lds, int item) {
  const int tid = threadIdx.x, lane = tid & 63, wid = __builtin_amdgcn_readfirstlane(tid >> 6);
  const int b = item >> 6, c = (item >> 2) & 15, g = (item >> 1) & 1, lh = item & 1, h = g * 8 + wid;
  const int t0 = b * SEQ + c * 128 + lh * 64;
  const int ql = lane & 31, hh = lane >> 5;
  constexpr int YLD = 520;
  bf16_t* yoff = (bf16_t*)lds;
  const bf16_t* __restrict__ proj = (const bf16_t*)(p.ws + WS_PROJ);
  const float* __restrict__ acsg = (const float*)(p.ws + WS_ACSG);
  const bf16_t* __restrict__ ccb = (const bf16_t*)(p.ws + WS_CCB);
  const float* __restrict__ ypart = (const float*)(p.ws + WS_YPART);
  const bf16_t* __restrict__ hprev = (const bf16_t*)(p.ws + WS_HPREV);
  bf16_t* __restrict__ mixin = (bf16_t*)(p.ws + WS_HNB);
  {
    const bf16_t* hp = hprev + (size_t)((b * 16 + c) * 16 + h) * 8192 + (size_t)ql * 128 + 8 * hh;
    u32x4 hf0[8], hf1[8];
#pragma unroll
    for (int ks = 0; ks < 8; ++ks) { hf0[ks] = *(const u32x4*)(hp + 16 * ks); hf1[ks] = *(const u32x4*)(hp + 32 * 128 + 16 * ks); }
#pragma unroll
    for (int il = 0; il < 2; ++il) {
      const int lt = 32 * il + ql, t = t0 + lt;
      const bf16_t* cp = ccb + (size_t)t * 256 + g * 128 + 8 * hh;
      u32x4 cf[8];
#pragma unroll
      for (int ks = 0; ks < 8; ++ks) cf[ks] = *(const u32x4*)(cp + 16 * ks);
      const float ea = __expf(acsg[(size_t)t * 16 + h]);
      f32x16 a0, a1;
#pragma unroll
      for (int r = 0; r < 16; ++r) { a0[r] = 0.f; a1[r] = 0.f; }
#pragma unroll
      for (int ks = 0; ks < 8; ++ks) {
        a0 = __builtin_amdgcn_mfma_f32_32x32x16_bf16(*(bf16x8*)&hf0[ks], *(bf16x8*)&cf[ks], a0, 0, 0, 0);
        a1 = __builtin_amdgcn_mfma_f32_32x32x16_bf16(*(bf16x8*)&hf1[ks], *(bf16x8*)&cf[ks], a1, 0, 0, 0);
      }
      bf16_t* yr = yoff + lt * YLD + wid * 64 + 4 * hh;
#pragma unroll
      for (int rg = 0; rg < 4; ++rg) {
        u32x2 w0; w0.x = pack_bf16(ea * a0[4 * rg], ea * a0[4 * rg + 1]); w0.y = pack_bf16(ea * a0[4 * rg + 2], ea * a0[4 * rg + 3]);
        u32x2 w1; w1.x = pack_bf16(ea * a1[4 * rg], ea * a1[4 * rg + 1]); w1.y = pack_bf16(ea * a1[4 * rg + 2], ea * a1[4 * rg + 3]);
        *(u32x2*)(yr + 8 * rg) = w0;
        *(u32x2*)(yr + 32 + 8 * rg) = w1;
      }
    }
  }
  __syncthreads();
#pragma unroll
  for (int bt = 0; bt < 2; ++bt) {
    f32x4 ya[4], yb[4]; u32x4 zz[4], yo[4];
#pragma unroll
    for (int q = 0; q < 4; ++q) {
      const int lt = wid * 8 + bt * 4 + q, t = t0 + lt;
      const float* yp = ypart + (size_t)t * 1024 + g * 512 + lane * 8;
      ya[q] = __builtin_nontemporal_load((const f32x4*)yp); yb[q] = __builtin_nontemporal_load((const f32x4*)(yp + 4));
      zz[q] = __builtin_nontemporal_load((const u32x4*)(proj + (size_t)t * NPROJ + OFF_Z + g * 512 + lane * 8));
      yo[q] = *(const u32x4*)(yoff + lt * YLD + lane * 8);
    }
#pragma unroll
    for (int q = 0; q < 4; ++q) {
      const int t = t0 + wid * 8 + bt * 4 + q;
      float zv[8], ov[8], y[8];
      unpack8(zz[q], zv); unpack8(yo[q], ov);
      y[0] = (ya[q][0] + ov[0]) * silu_f(zv[0]); y[1] = (ya[q][1] + ov[1]) * silu_f(zv[1]);
      y[2] = (ya[q][2] + ov[2]) * silu_f(zv[2]); y[3] = (ya[q][3] + ov[3]) * silu_f(zv[3]);
      y[4] = (yb[q][0] + ov[4]) * silu_f(zv[4]); y[5] = (yb[q][1] + ov[5]) * silu_f(zv[5]);
      y[6] = (yb[q][2] + ov[6]) * silu_f(zv[6]); y[7] = (yb[q][3] + ov[7]) * silu_f(zv[7]);
      float ss = 0.f;
#pragma unroll
      for (int i = 0; i < 8; ++i) ss += y[i] * y[i];
      ss = wave_sum(ss);
      const float rn = rsqrtf(ss * (1.f / 512) + EPS);
      u32x4 w; w.x = pack_bf16(y[0] * rn, y[1] * rn); w.y = pack_bf16(y[2] * rn, y[3] * rn); w.z = pack_bf16(y[4] * rn, y[5] * rn); w.w = pack_bf16(y[6] * rn, y[7] * rn);
      *(u32x4*)(mixin + (size_t)t * DM + 1024 + g * 512 + lane * 8) = w;
    }
  }
  __syncthreads();
}
__device__ __forceinline__ void phase3(const Params& p, unsigned char* lds, int bid, int nblk) {
  for (int item = bid; item < 256; item += nblk) ssd_b_item(p, lds, item);
}

constexpr int LDS_BYTES = 144 * 1024;

typedef const Params __attribute__((address_space(4))) * KArgPtr;
__device__ __forceinline__ Params load_params(KArgPtr k) {
  Params q;
#if defined(__HIP_DEVICE_COMPILE__)
  __builtin_memcpy(&q, k, sizeof(Params));
#endif
  return q;
}
#define PARAMS_PTR(pp) KArgPtr pp##_k = (KArgPtr)__builtin_amdgcn_kernarg_segment_ptr(); asm volatile("" : "+s"(pp##_k)); const Params pp##_v = load_params(pp##_k); const Params* pp = &pp##_v
__global__ __launch_bounds__(512, 2) void k_mega(Params p_unused) {
  extern __shared__ __attribute__((aligned(16))) unsigned char shm[];
  const int bid = blockIdx.x, nblk = gridDim.x;
  volatile LAS unsigned* xst = (volatile LAS unsigned*)(LAS unsigned char*)(shm + LDS_BYTES - 16);
  if (threadIdx.x == 0) { xst[0] = 0u; xst[1] = 0u; }
  __syncthreads();
  XcdBarrier xb;
  { PARAMS_PTR(pp); xb = xcd_barrier_post((unsigned*)(pp->ws + WS_CTL), xst); }
#ifndef REP_PHASE
#define REP_PHASE -1
#endif
#define NREP(k) ((REP_PHASE == (k)) ? 2 : 1)
#ifndef REP_ALL
#define REP_ALL 1
#endif
#pragma unroll 1
  for (int pass = 0; pass < REP_ALL; ++pass) {
  if (pass) xcd_barrier(xb);
#pragma unroll 1
  for (int rep = 0; rep < NREP(0); ++rep) { { PARAMS_PTR(pp); phase0(*pp, (float*)shm, bid, nblk); } if (rep + 1 < NREP(0)) xcd_barrier(xb); }
  xcd_barrier(xb);
#pragma unroll 1
  for (int rep = 0; rep < NREP(1); ++rep) { { PARAMS_PTR(pp); phase1(*pp, shm, bid, nblk); } xcd_barrier(xb); }
#pragma unroll 1
  for (int rep = 0; rep < NREP(2); ++rep) { { PARAMS_PTR(pp); phase2(*pp, shm, bid, nblk); } xcd_barrier(xb); }
#pragma unroll 1
  for (int rep = 0; rep < NREP(7); ++rep) { { PARAMS_PTR(pp); phase_scan(*pp, bid, nblk); } xcd_barrier(xb); }
#pragma unroll 1
  for (int rep = 0; rep < NREP(3); ++rep) { { PARAMS_PTR(pp); phase3(*pp, shm, bid, nblk); } xcd_barrier(xb); }
#pragma unroll 1
  for (int rep = 0; rep < NREP(4); ++rep) { { PARAMS_PTR(pp); phase4(*pp, shm, bid, nblk); } xcd_barrier(xb); }
#pragma unroll 1
  for (int rep = 0; rep < NREP(5); ++rep) { { PARAMS_PTR(pp); phase5(*pp, shm, bid, nblk); } xcd_barrier(xb); }
#pragma unroll 1
  for (int rep = 0; rep < NREP(6); ++rep) { { PARAMS_PTR(pp); phase6(*pp, shm, bid, nblk); } if (rep + 1 < NREP(6)) xcd_barrier(xb); }
  }
}

}

extern "C" void kernel_launch(void* const* d_in, const int* in_sizes, int n_in, void* d_out, int out_size, void* d_ws,
                              size_t ws_size, hipStream_t stream) {
  Params p{};
  p.x = (const float*)d_in[0]; p.meta = (const float*)d_in[1]; p.rel_bias = (const float*)d_in[2];
  p.ln_mix = (const float*)d_in[3]; p.w_in = (const float*)d_in[4]; p.sinks = (const float*)d_in[5];
  p.conv_w = (const float*)d_in[6]; p.conv_b = (const float*)d_in[7]; p.dt_bias = (const float*)d_in[8];
  p.a_log = (const float*)d_in[9]; p.d_skip = (const float*)d_in[10]; p.attn_norm_w = (const float*)d_in[11];
  p.ssm_norm_w = (const float*)d_in[12]; p.w_out = (const float*)d_in[13]; p.ln_ffn = (const float*)d_in[14];
  p.wq = (const float*)d_in[15]; p.keys = (const float*)d_in[16]; p.U = (const float*)d_in[17];
  p.V = (const float*)d_in[18]; p.ln_final = (const float*)d_in[19];
  p.out = (float*)d_out;
  p.ws = (unsigned char*)d_ws;

  static int grid_blocks = 0;
  if (!grid_blocks) {
    int dev = 0, cus = 0, per_cu = 0;
    (void)hipGetDevice(&dev);
    (void)hipDeviceGetAttribute(&cus, hipDeviceAttributeMultiprocessorCount, dev);
    (void)hipFuncSetAttribute((const void*)k_mega, hipFuncAttributeMaxDynamicSharedMemorySize, LDS_BYTES);
    (void)hipOccupancyMaxActiveBlocksPerMultiprocessor(&per_cu, (const void*)k_mega, NTHREADS, LDS_BYTES);
    if (per_cu > 1) per_cu = 1;
    grid_blocks = cus * per_cu;
    if (grid_blocks != 256) fprintf(stderr, "kernel_launch: expected a 256-workgroup resident grid, got %d (cus %d, per_cu %d)\n", grid_blocks, cus, per_cu);
  }
  (void)hipMemsetAsync(p.ws + WS_CTL, 0, XCD_BAR_WORDS * 4, stream);
  void* args[] = {&p};
  hipError_t e = hipLaunchCooperativeKernel((const void*)k_mega, dim3(grid_blocks), dim3(NTHREADS), args, LDS_BYTES, stream);
  if (e != hipSuccess) fprintf(stderr, "cooperative launch failed: %s (grid %d)\n", hipGetErrorString(e), grid_blocks);
}
```

```cpp
#include <hip/hip_runtime.h>
#include <math.h>
#include <stdio.h>
#include <stdint.h>

#ifndef REP_SUB
#define REP_SUB -1
#endif
namespace {
constexpr int BATCH = 4, SEQ = 2048, DM = 2048, NMETA = 16;
constexpr int T = BATCH * SEQ;
constexpr int TA = T + NMETA;
constexpr int DPROJ = 4112;
constexpr int NPROJ = 4096;
constexpr int OFF_Q = 0, OFF_K = 1024, OFF_V = 1280, OFF_Z = 1536, OFF_XBC = 2560, OFF_DT = 4096;
constexpr int D_XBC = 1536;
constexpr int NEXP = 16384;
constexpr int ROW4 = 1024;
constexpr int ROW6 = 1536;
constexpr float EPS = 1e-6f;
constexpr int NTHREADS = 512;

typedef unsigned short bf16_t;
typedef short bf16x8 __attribute__((ext_vector_type(8)));
typedef float f32x4 __attribute__((ext_vector_type(4)));
typedef float f32x2 __attribute__((ext_vector_type(2)));
typedef unsigned u32x4 __attribute__((ext_vector_type(4)));
typedef unsigned u32x2 __attribute__((ext_vector_type(2)));
typedef __bf16 bf16v2 __attribute__((ext_vector_type(2)));
typedef float f32x16v __attribute__((ext_vector_type(16)));
typedef float f32x32v __attribute__((ext_vector_type(32)));
typedef unsigned u32x6 __attribute__((ext_vector_type(6)));
#define LAS __attribute__((address_space(3)))

__device__ __forceinline__ unsigned pack_bf16(float lo, float hi) {
  f32x2 v = {lo, hi};
  bf16v2 b = __builtin_convertvector(v, bf16v2);
  return *(unsigned*)&b;
}
__device__ __forceinline__ bf16_t f2bf(float f) { return (bf16_t)(pack_bf16(f, 0.f) & 0xffffu); }
__device__ __forceinline__ float bf2f(bf16_t b) { return __uint_as_float(((unsigned)b) << 16); }
__device__ __forceinline__ float bflo(unsigned u) { return __uint_as_float(u << 16); }
__device__ __forceinline__ float bfhi(unsigned u) { return __uint_as_float(u & 0xffff0000u); }

__constant__ unsigned char kBucket[128] = {
    0, 1, 2, 3, 4, 5, 6, 7, 8, 9, 10, 11, 12, 13, 14, 15, 16, 16, 16, 17, 17, 18, 18, 18, 19, 19, 19, 20, 20, 20, 20, 21,
    21, 21, 21, 22, 22, 22, 22, 22, 23, 23, 23, 23, 23, 23, 24, 24, 24, 24, 24, 24, 25, 25, 25, 25, 25, 25, 25, 26, 26, 26, 26, 26,
    26, 26, 26, 27, 27, 27, 27, 27, 27, 27, 27, 27, 27, 28, 28, 28, 28, 28, 28, 28, 28, 28, 28, 29, 29, 29, 29, 29, 29, 29, 29, 29,
    29, 29, 29, 30, 30, 30, 30, 30, 30, 30, 30, 30, 30, 30, 30, 30, 30, 31, 31, 31, 31, 31, 31, 31, 31, 31, 31, 31, 31, 31, 31, 31};

__constant__ unsigned char kCandI[64] = {0, 0, 0, 0, 0, 0, 0, 0, 0, 0, 0, 0, 0, 0, 0, 0, 1, 1, 1, 1, 1, 1, 1, 1, 2, 2, 2, 2, 2, 3, 3, 3, 3, 4, 4, 4, 5, 5, 6, 6, 7, 7, 8, 9, 10, 11, 12, 13, 14, 15, 15, 15, 15, 15, 15, 15, 15, 15, 15, 15, 15, 15, 15, 15};
__constant__ unsigned char kCandJ[64] = {0, 1, 2, 3, 4, 5, 6, 7, 8, 9, 10, 11, 12, 13, 14, 15, 0, 1, 2, 3, 4, 5, 6, 7, 0, 1, 2, 3, 4, 0, 1, 2, 3, 0, 1, 2, 0, 1, 0, 1, 0, 1, 0, 0, 0, 0, 0, 0, 0, 0, 15, 15, 15, 15, 15, 15, 15, 15, 15, 15, 15, 15, 15, 15};

__device__ __forceinline__ float wave_sum(float v) {
  for (int o = 32; o > 0; o >>= 1) v += __shfl_xor(v, o);
  return v;
}
__device__ __forceinline__ float wave_max(float v) {
  for (int o = 32; o > 0; o >>= 1) v = fmaxf(v, __shfl_xor(v, o));
  return v;
}
__device__ __forceinline__ float silu_f(float x) { return x / (1.f + expf(-x)); }
__device__ __forceinline__ float softplus_f(float x) { return fmaxf(x, 0.f) + log1pf(expf(-fabsf(x))); }

constexpr size_t al256(size_t x) { return (x + 255) & ~(size_t)255; }
constexpr size_t WS_CTL = 0;
constexpr size_t WS_WINT = 65536;
constexpr size_t WS_WDTT = WS_WINT + (size_t)NPROJ * DM * 2;
constexpr size_t WS_WOUTT = WS_WDTT + (size_t)16 * DM * 2;
constexpr size_t WS_WQT = WS_WOUTT + (size_t)DM * DM * 2;
constexpr size_t WS_KEYS = WS_WQT + (size_t)DM * DM * 2;
constexpr size_t WS_UB = WS_KEYS + (size_t)16 * 128 * 128 * 2;
constexpr size_t WS_VB = WS_UB + (size_t)NEXP * DM * 2;
constexpr size_t WS_HNB = WS_VB + (size_t)NEXP * DM * 2;
constexpr size_t WS_PROJ = WS_HNB + (size_t)(T + 16) * DM * 2;
constexpr size_t WS_DTRAW = WS_PROJ + (size_t)T * NPROJ * 2;
constexpr size_t WS_PROJM = WS_DTRAW + (size_t)T * 16 * 4;
constexpr size_t WS_PROJMB = al256(WS_PROJM + (size_t)16 * DPROJ * 4);
constexpr size_t WS_H1B = al256(WS_PROJMB + (size_t)16 * DPROJ * 2);
constexpr size_t WS_SSQH1 = WS_H1B + (size_t)T * DM * 2;
constexpr size_t WS_STOP = al256(WS_SSQH1 + (size_t)T * 32 * 4);
constexpr size_t WS_ITOP = WS_STOP + (size_t)T * 256 * 4;
constexpr size_t WS_ACSG = al256(WS_ITOP + (size_t)T * 256 * 4);
constexpr size_t WS_CCB = WS_ACSG + (size_t)T * 16 * 4;
constexpr size_t WS_YPART = WS_CCB + (size_t)T * 256 * 2;
constexpr size_t WS_SG = WS_YPART + (size_t)T * 1024 * 4;
constexpr size_t WS_SMETA = WS_SG + (size_t)1024 * 8192 * 4;
constexpr size_t WS_HPREV = al256(WS_SMETA + (size_t)16 * 8192 * 4);
constexpr size_t WS_USC = al256(WS_HPREV + (size_t)1024 * 8192 * 2);
constexpr size_t WS_VSC = WS_USC + (size_t)NEXP * 4;
constexpr size_t WS_SCR = al256(WS_VSC + (size_t)NEXP * 4);
}

namespace pg8 {
#define PG8_LAS __attribute__((address_space(3)))
constexpr int BM = 256, BK = 64, HALF = 128, HTB = HALF * BK * 2, STAGE_BYTES = 8 * HTB, NXCD = 8, WGM = 8;
__host__ __device__ __forceinline__ int lds_byte(int r, int c) { const int st = (r >> 4) * 2 + (c >> 5), rr = r & 15, cc = c & 31, ob = rr * 64 + cc * 2; return st * 1024 + (ob ^ (((ob >> 9) & 1) << 5)); }
__host__ __device__ __forceinline__ void stage_rc(int b, int& R, int& C) { const int st = b / 1024, sb = b % 1024, swz = sb ^ (((sb >> 9) & 1) << 5); R = (st >> 1) * 16 + swz / 64; C = (st & 1) * 32 + (swz % 64) / 2; }
__host__ __device__ __forceinline__ int perm32(int rho) { const int n = rho >> 4, i = rho & 15; return 8 * (i >> 2) + 4 * n + (i & 3); }
struct Unit { int pm, pn; };
struct Gemm { const bf16_t* A; const bf16_t* Bt; int M, N, K; };
struct StaticOrder {
    int nM, nN, nwg, G, c;
    __host__ __device__ void init(int M, int N, int G_, int c_) { nM = M / BM; nN = N / BM; nwg = nM * nN; G = G_; c = c_; }
    __host__ __device__ bool next(int i, Unit& u) const {
        const long L = (long)i * G + c; if (L >= nwg) return false;
        int wgid = (int)L; { const int q = nwg / NXCD, r = nwg % NXCD, xcd = wgid % NXCD, off = wgid / NXCD; wgid = (xcd < r ? xcd * (q + 1) : r * (q + 1) + (xcd - r) * q) + off; }
        const int nig = WGM * nN, gid = wgid / nig, fm = gid * WGM, gsz = (nM - fm) < WGM ? (nM - fm) : WGM;
        u.pm = fm + ((wgid % nig) % gsz); u.pn = (wgid % nig) / gsz; return true;
    }
    __device__ __forceinline__ void a_ready(const Unit&) const {}
    __device__ __forceinline__ void done(const Unit&) const {}
};
struct EpiBf16 {
    static constexpr bool PERM = true, AFTER_DRAIN = false;
    bf16_t* O; int ldc;
    __device__ __forceinline__ void operator()(const f32x4 (&acc)[2][2][4][2], const Unit& u, int wr, int wc, int fr, int fq) const {
        const int row0 = u.pm * BM + wr * 64 + fr; const int col0 = u.pn * BM + wc * 32 + 8 * fq;
#pragma unroll
        for (int ai = 0; ai < 2; ++ai)
#pragma unroll
            for (int m = 0; m < 4; ++m) { bf16_t* rowp = O + (size_t)(row0 + ai * HALF + m * 16) * ldc + col0;
#pragma unroll
                for (int bj = 0; bj < 2; ++bj) { const f32x4 v0 = acc[ai][bj][m][0], v1 = acc[ai][bj][m][1];
                    u32x4 w; w.x = pack_bf16(v0[0], v0[1]); w.y = pack_bf16(v0[2], v0[3]); w.z = pack_bf16(v1[0], v1[1]); w.w = pack_bf16(v1[2], v1[3]);
                    *(u32x4*)(rowp + bj * HALF) = w; } }
    }
};

struct EpiRes {
    static constexpr bool PERM = true, AFTER_DRAIN = false;
    const float* X; bf16_t* HB; float* SSQ;
    __device__ __forceinline__ void operator()(const f32x4 (&acc)[2][2][4][2], const Unit& u, int wr, int wc, int fr, int fq) const {
        const int row0 = u.pm * BM + wr * 64 + fr; const int col0 = u.pn * BM + wc * 32 + 8 * fq;
#pragma unroll
        for (int ai = 0; ai < 2; ++ai) {
            f32x4 xr[4][2][2];
#pragma unroll
            for (int m = 0; m < 4; ++m) { const size_t off = (size_t)(row0 + ai * HALF + m * 16) * DM + col0;
#pragma unroll
                for (int bj = 0; bj < 2; ++bj) { xr[m][bj][0] = __builtin_nontemporal_load((const f32x4*)(X + off + bj * HALF)); xr[m][bj][1] = __builtin_nontemporal_load((const f32x4*)(X + off + bj * HALF + 4)); } }
#pragma unroll
            for (int m = 0; m < 4; ++m) { const int row = row0 + ai * HALF + m * 16; const size_t off = (size_t)row * DM + col0; float ss = 0.f;
#pragma unroll
                for (int bj = 0; bj < 2; ++bj) {
                    const f32x4 v0 = acc[ai][bj][m][0] + xr[m][bj][0], v1 = acc[ai][bj][m][1] + xr[m][bj][1];
                    u32x4 w; w.x = pack_bf16(v0[0], v0[1]); w.y = pack_bf16(v0[2], v0[3]); w.z = pack_bf16(v1[0], v1[1]); w.w = pack_bf16(v1[2], v1[3]);
                    *(u32x4*)(HB + off + bj * HALF) = w;
                    ss += v0[0] * v0[0] + v0[1] * v0[1] + v0[2] * v0[2] + v0[3] * v0[3] + v1[0] * v1[0] + v1[1] * v1[1] + v1[2] * v1[2] + v1[3] * v1[3]; }
                ss += __shfl_xor(ss, 16); ss += __shfl_xor(ss, 32);
                if (fq == 0) SSQ[(size_t)row * 32 + u.pn * 4 + wc] = ss; }
        }
    }
};
struct EpiF32 {
    static constexpr bool PERM = true, AFTER_DRAIN = false;
    float* C; int ldc;
    __device__ __forceinline__ void operator()(const f32x4 (&acc)[2][2][4][2], const Unit& u, int wr, int wc, int fr, int fq) const {
        const int row0 = u.pm * BM + wr * 64 + fr; const int col0 = u.pn * BM + wc * 32 + 8 * fq;
#pragma unroll
        for (int ai = 0; ai < 2; ++ai)
#pragma unroll
            for (int m = 0; m < 4; ++m) { float* rowp = C + (size_t)(row0 + ai * HALF + m * 16) * ldc + col0;
#pragma unroll
                for (int bj = 0; bj < 2; ++bj) { *(f32x4*)(rowp + bj * HALF) = acc[ai][bj][m][0]; *(f32x4*)(rowp + bj * HALF + 4) = acc[ai][bj][m][1]; } }
    }
};

struct EpiScores {
    static constexpr bool PERM = true, AFTER_DRAIN = true;
    const bf16_t* KEYS;
    float* STOP; int* ITOP;
    static constexpr int QLD = 264;
    __device__ __forceinline__ void fused(f32x4 (&acc)[2][2][4][2], const Unit& u, int wr, int wc, int fr, int fq, PG8_LAS unsigned char* lds, int wid, int lane) const {
        PG8_LAS bf16_t* Q = (PG8_LAS bf16_t*)lds;
#pragma unroll
        for (int ai = 0; ai < 2; ++ai)
#pragma unroll
            for (int m = 0; m < 4; ++m) { const int row = ai * HALF + wr * 64 + m * 16 + fr;
#pragma unroll
                for (int bj = 0; bj < 2; ++bj) { const f32x4 v0 = acc[ai][bj][m][0], v1 = acc[ai][bj][m][1];
                    u32x4 w; w.x = pack_bf16(v0[0], v0[1]); w.y = pack_bf16(v0[2], v0[3]); w.z = pack_bf16(v1[0], v1[1]); w.w = pack_bf16(v1[2], v1[3]);
                    *(PG8_LAS u32x4*)(Q + row * QLD + bj * HALF + wc * 32 + 8 * fq) = w; } }
        __syncthreads();
        const int h = u.pn;
#pragma unroll 1
        for (int c = 0; c < 2; ++c) {
            f32x4 sc[8][2];
#pragma unroll
            for (int kf = 0; kf < 8; ++kf) { sc[kf][0] = (f32x4){0.f, 0.f, 0.f, 0.f}; sc[kf][1] = (f32x4){0.f, 0.f, 0.f, 0.f}; }
            const bf16_t* kb = KEYS + (size_t)((h * 2 + c) * 128 + fr) * 128 + 8 * fq;
            const PG8_LAS bf16_t* qb = Q + (wid * 32 + fr) * QLD + c * 128 + 8 * fq;
#pragma unroll
            for (int ks = 0; ks < 4; ++ks) {
                const bf16x8 q0 = *(const PG8_LAS bf16x8*)(qb + 32 * ks), q1 = *(const PG8_LAS bf16x8*)(qb + 16 * QLD + 32 * ks);
#pragma unroll
                for (int kf = 0; kf < 8; ++kf) { const bf16x8 kv = *(const bf16x8*)(kb + (size_t)kf * 16 * 128 + 32 * ks);
                    sc[kf][0] = __builtin_amdgcn_mfma_f32_16x16x32_bf16(kv, q0, sc[kf][0], 0, 0, 0);
                    sc[kf][1] = __builtin_amdgcn_mfma_f32_16x16x32_bf16(kv, q1, sc[kf][1], 0, 0, 0); }
            }
#pragma unroll
            for (int tf = 0; tf < 2; ++tf) {
                int v[32];
#pragma unroll
                for (int kf = 0; kf < 8; ++kf)
#pragma unroll
                    for (int r = 0; r < 4; ++r) {
                        const int bts = (int)__float_as_uint(sc[kf][tf][r]);
                        const int srt = bts ^ ((bts >> 31) & 0x7fffffff);
                        v[kf * 4 + r] = (srt & ~127) | (16 * kf + 4 * fq + r);
                    }
#pragma unroll
                for (int k = 2; k <= 32; k <<= 1)
#pragma unroll
                    for (int j = k >> 1; j > 0; j >>= 1)
#pragma unroll
                        for (int i = 0; i < 32; ++i) {
                            const int l = i ^ j;
                            if (l > i) {
                                const int x = v[i], y = v[l];
                                const int hi_ = x > y ? x : y, lo_ = x > y ? y : x;
                                if ((i & k) == 0) { v[i] = hi_; v[l] = lo_; } else { v[i] = lo_; v[l] = hi_; }
                            }
                        }
#pragma unroll
                for (int step = 0; step < 2; ++step) {
                    const int xm = step == 0 ? 16 : 32;
                    int m[16];
#pragma unroll
                    for (int i = 0; i < 16; ++i) { const int o = __shfl_xor(v[15 - i], xm); m[i] = v[i] > o ? v[i] : o; }
#pragma unroll
                    for (int j = 8; j > 0; j >>= 1)
#pragma unroll
                        for (int i = 0; i < 16; ++i) {
                            const int l = i ^ j;
                            if (l > i) { const int x = m[i], y = m[l]; m[i] = x > y ? x : y; m[l] = x > y ? y : x; }
                        }
#pragma unroll
                    for (int i = 0; i < 16; ++i) v[i] = m[i];
                }
                if (fq == 0) {
                    const size_t obase = ((size_t)(u.pm * BM + wid * 32 + tf * 16 + fr) * 16 + h * 2 + c) * 16;
#pragma unroll
                    for (int q4 = 0; q4 < 4; ++q4) {
                        f32x4 sv; u32x4 iv;
#pragma unroll
                        for (int i = 0; i < 4; ++i) {
                            const int key = v[4 * q4 + i], srt = key & ~127;
                            sv[i] = __uint_as_float((unsigned)(srt ^ ((srt >> 31) & 0x7fffffff)));
                            iv[i] = (unsigned)(key & 127);
                        }
                        *(f32x4*)(STOP + obase + 4 * q4) = sv;
                        *(u32x4*)(ITOP + obase + 4 * q4) = iv;
                    }
                }
            }
        }
    }
};

template <class Epi, class Sched>
__device__ __forceinline__ void gemm_phase(PG8_LAS unsigned char* lds, const Gemm g, const Sched& S, const Epi& E) {
    int tid_ = threadIdx.x; asm volatile("" : "+v"(tid_));
    const int tid = tid_, wid = __builtin_amdgcn_readfirstlane(tid >> 6), lane = tid & 63, wr = wid >> 2, wc = wid & 3, fr = lane & 15, fq = lane >> 4;
    const int K = g.K, nt = K / BK;
    unsigned voffA[2], voffB[2];
#pragma unroll
    for (int i = 0; i < 2; ++i) { int R, C; stage_rc(tid * 16 + i * 8192, R, C); const int Rb = Epi::PERM ? ((R & ~31) + perm32(R & 31)) : R;
        voffA[i] = (unsigned)(R * K + C) * 2u; voffB[i] = (unsigned)(Rb * K + C) * 2u; }
    const size_t kstep = (size_t)(BK * 2);
    const size_t hstep = (size_t)HALF * K * 2;
    const size_t tstep = 2 * hstep;
    const unsigned ldsw = (unsigned)wid * 1024u;
    const int aoff = lds_byte(wr * 64 + fr, fq * 8), boff = lds_byte(wc * 32 + fr, fq * 8);
#define PG8_SA(b, h) (((b) * 2 + (h)) * HTB)
#define PG8_SB(b, h) ((4 + (b) * 2 + (h)) * HTB)
#define PG8_STAGE(bufoff, gbase, voff) do { _Pragma("unroll") for (int _i = 0; _i < 2; ++_i) \
        __builtin_amdgcn_global_load_lds((const unsigned*)((const char*)(gbase) + (voff)[_i]), (PG8_LAS unsigned*)(lds + (bufoff) + ldsw + _i * 8192), 16, 0, 0); } while (0)
#define PG8_LDA(dst, b, h) do { _Pragma("unroll") for (int m = 0; m < 4; ++m) _Pragma("unroll") for (int k = 0; k < 2; ++k) dst[m][k] = *(const PG8_LAS bf16x8*)(lds + PG8_SA(b, h) + aoff + m * 2048 + k * 1024); } while (0)
#define PG8_LDB(dst, b, h) do { _Pragma("unroll") for (int n = 0; n < 2; ++n) _Pragma("unroll") for (int k = 0; k < 2; ++k) dst[n][k] = *(const PG8_LAS bf16x8*)(lds + PG8_SB(b, h) + boff + n * 2048 + k * 1024); } while (0)
#define PG8_MMA(ai, bj, At, Bt) do { __builtin_amdgcn_s_setprio(1); _Pragma("unroll") for (int m = 0; m < 4; ++m) _Pragma("unroll") for (int n = 0; n < 2; ++n) _Pragma("unroll") for (int k = 0; k < 2; ++k) \
        acc[ai][bj][m][n] = __builtin_amdgcn_mfma_f32_16x16x32_bf16(Bt[n][k], At[m][k], acc[ai][bj][m][n], 0, 0, 0); __builtin_amdgcn_s_setprio(0); } while (0)
#define PG8_WAIT_V(n) asm volatile("s_waitcnt vmcnt(" #n ")" ::: "memory")
#define PG8_WAIT_L(n) asm volatile("s_waitcnt lgkmcnt(" #n ")" ::: "memory")
#define PG8_BAR __builtin_amdgcn_s_barrier()
#define PG8_SCHED __builtin_amdgcn_sched_barrier(0)
    Unit cur, nxt; int ui = 0;
    if (!S.next(0, cur)) return;
    f32x4 acc[2][2][4][2];
#pragma unroll
    for (int a = 0; a < 2; ++a)
#pragma unroll
        for (int b = 0; b < 2; ++b)
#pragma unroll
            for (int m = 0; m < 4; ++m)
#pragma unroll
                for (int n = 0; n < 2; ++n) acc[a][b][m][n] = (f32x4){0.f, 0.f, 0.f, 0.f};
    bf16x8 At[4][2], B0[2][2], B1[2][2];
    const char* cA = (const char*)g.A + (size_t)cur.pm * tstep; const char* cB = (const char*)g.Bt + (size_t)cur.pn * tstep;
    S.a_ready(cur);
    PG8_STAGE(PG8_SB(0, 0), cB, voffB); PG8_STAGE(PG8_SA(0, 0), cA, voffA); PG8_STAGE(PG8_SB(0, 1), cB + hstep, voffB); PG8_STAGE(PG8_SA(0, 1), cA + hstep, voffA);
    if (wr == 1) PG8_BAR;
    PG8_WAIT_V(4); PG8_BAR;
    PG8_STAGE(PG8_SB(1, 0), cB + kstep, voffB); PG8_STAGE(PG8_SA(1, 0), cA + kstep, voffA); PG8_STAGE(PG8_SB(1, 1), cB + hstep + kstep, voffB);
    PG8_WAIT_V(6); PG8_BAR;
    for (;;) {
        const bool has_next = S.next(ui + 1, nxt);
        const char* nA = has_next ? (const char*)g.A + (size_t)nxt.pm * tstep : cA; const char* nB = has_next ? (const char*)g.Bt + (size_t)nxt.pn * tstep : cB;
        for (int t = 0; t < nt; t += 2) {
            const bool last = (t == nt - 2);
            const char* a1 = cA + (size_t)(t + 1) * kstep;
            const char* a2 = last ? nA : cA + (size_t)(t + 2) * kstep; const char* b2 = last ? nB : cB + (size_t)(t + 2) * kstep;
            const char* a3 = a2 + kstep; const char* b3 = b2 + kstep;
            if (last && has_next) S.a_ready(nxt);
            PG8_LDB(B0, 0, 0); PG8_SCHED; PG8_LDA(At, 0, 0); PG8_STAGE(PG8_SA(1, 1), a1 + hstep, voffA);
            PG8_WAIT_L(8); PG8_BAR; PG8_WAIT_L(0); PG8_MMA(0, 0, At, B0); PG8_BAR; PG8_SCHED;
            PG8_LDB(B1, 0, 1); PG8_STAGE(PG8_SB(0, 0), b2, voffB);
            PG8_BAR; PG8_WAIT_L(0); PG8_MMA(0, 1, At, B1); PG8_BAR;
            PG8_LDA(At, 0, 1); PG8_STAGE(PG8_SA(0, 0), a2, voffA);
            PG8_BAR; PG8_WAIT_L(0); PG8_MMA(1, 0, At, B0); PG8_BAR; PG8_SCHED;
            PG8_STAGE(PG8_SB(0, 1), b2 + hstep, voffB);
            PG8_WAIT_V(6); PG8_BAR; PG8_MMA(1, 1, At, B1); PG8_BAR;
            PG8_LDB(B0, 1, 0); PG8_SCHED; PG8_LDA(At, 1, 0); PG8_STAGE(PG8_SA(0, 1), a2 + hstep, voffA);
            PG8_WAIT_L(8); PG8_BAR; PG8_WAIT_L(0); PG8_MMA(0, 0, At, B0); PG8_BAR; PG8_SCHED;
            PG8_LDB(B1, 1, 1); PG8_STAGE(PG8_SB(1, 0), b3, voffB);
            PG8_BAR; PG8_WAIT_L(0); PG8_MMA(0, 1, At, B1); PG8_BAR;
            PG8_LDA(At, 1, 1); PG8_STAGE(PG8_SA(1, 0), a3, voffA);
            PG8_BAR; PG8_WAIT_L(0); PG8_MMA(1, 0, At, B0); PG8_BAR; PG8_SCHED;
            PG8_STAGE(PG8_SB(1, 1), b3 + hstep, voffB);
            PG8_WAIT_V(6); PG8_BAR; PG8_MMA(1, 1, At, B1); PG8_BAR;
        }
        if constexpr (!Epi::AFTER_DRAIN) { E(acc, cur, wr, wc, fr, fq); S.done(cur); }
        if (!has_next) break;
#pragma unroll
        for (int a = 0; a < 2; ++a)
#pragma unroll
            for (int b = 0; b < 2; ++b)
#pragma unroll
                for (int m = 0; m < 4; ++m)
#pragma unroll
                    for (int n = 0; n < 2; ++n) acc[a][b][m][n] = (f32x4){0.f, 0.f, 0.f, 0.f};
        cur = nxt; cA = nA; cB = nB; ++ui;
    }
    PG8_WAIT_V(0);
    if (wr == 0) PG8_BAR;
    PG8_BAR;
    if constexpr (Epi::AFTER_DRAIN) { E.fused(acc, cur, wr, wc, fr, fq, lds, wid, lane); S.done(cur); }
#undef PG8_SA
#undef PG8_SB
#undef PG8_STAGE
#undef PG8_LDA
#undef PG8_LDB
#undef PG8_MMA
#undef PG8_WAIT_V
#undef PG8_WAIT_L
#undef PG8_BAR
#undef PG8_SCHED
}
}

#define XB_TMO      128
#define XB_XCNT(j)  (256  + 64 * (j))
#define XB_XSUB(j)  (1280 + 64 * (j))
#define XB_XGEN(j)  (2304 + 64 * (j))
#define XB_TOP      3328
#define XB_TOPGEN   3392
#define XCD_BAR_WORDS 3456
#define XB_SPIN_CAP (1u << 22)
__device__ __forceinline__ unsigned xb_ld(unsigned* p)              { return __hip_atomic_load(p, __ATOMIC_RELAXED, __HIP_MEMORY_SCOPE_AGENT); }
__device__ __forceinline__ unsigned xb_add(unsigned* p, unsigned v) { return __hip_atomic_fetch_add(p, v, __ATOMIC_RELAXED, __HIP_MEMORY_SCOPE_AGENT); }
__device__ __forceinline__ unsigned xb_xcc_id() { return (unsigned)__builtin_amdgcn_s_getreg((3 << 11) | 20) & 0xFu; }
#define XB_SPIN(cond, bar) do { unsigned _sp = 0; while (cond) { __builtin_amdgcn_s_sleep(1); \
    if ((++_sp & 255u) == 0u) { if (xb_ld(&(bar)[XB_TMO])) break; if (_sp > XB_SPIN_CAP) { atomicAdd(&(bar)[XB_TMO], 1u); break; } } } } while (0)
struct XcdBarrier { unsigned* bar; unsigned x; volatile LAS unsigned* st; };
__device__ __forceinline__ XcdBarrier xcd_barrier_post(unsigned* bar, volatile LAS unsigned* st) {
    XcdBarrier b; b.bar = bar; b.x = xb_xcc_id(); b.st = st;
    if (threadIdx.x == 0) (void)xb_add(&bar[XB_XCNT(b.x)], 1u);
    return b;
}
__device__ __forceinline__ void xcd_barrier_complete(unsigned* bar, unsigned x, unsigned& nloc, unsigned& nx) {
    const unsigned G = gridDim.x * gridDim.y * gridDim.z;
    unsigned sum, cnt, mine, sp = 0u;
    for (;;) {
        sum = 0u; cnt = 0u; mine = 0u;
#pragma unroll
        for (unsigned j = 0; j < 16; ++j) { const unsigned c = xb_ld(&bar[XB_XCNT(j)]); sum += c; cnt += (c > 0u) ? 1u : 0u; mine = (j == x) ? c : mine; }
        if (sum == G) break;
        __builtin_amdgcn_s_sleep(1);
        if ((++sp & 255u) == 0u) { if (xb_ld(&bar[XB_TMO])) break; if (sp > XB_SPIN_CAP) { atomicAdd(&bar[XB_TMO], 1u); break; } }
    }
    nloc = mine > 0u ? mine : 1u; nx = cnt > 0u ? cnt : 1u;
}
__device__ __forceinline__ void xcd_barrier(const XcdBarrier& b) {
    asm volatile("s_waitcnt vmcnt(0)" ::: "memory");
    __syncthreads();
    if (threadIdx.x == 0) {
        unsigned* bar = b.bar;
        const unsigned bx = xb_xcc_id();
        __builtin_amdgcn_s_waitcnt(0);
        unsigned nloc = b.st[0], nx = b.st[1];
        if (nloc == 0u) { xcd_barrier_complete(bar, bx, nloc, nx); b.st[0] = nloc; b.st[1] = nx; }
        const unsigned old = xb_add(&bar[XB_XSUB(bx)], 1u);
        const unsigned gen = old / nloc;
        if (old + 1u == (gen + 1u) * nloc) {
            __builtin_amdgcn_fence(__ATOMIC_RELEASE, "agent");
            asm volatile("s_waitcnt vmcnt(0)" ::: "memory");
            const unsigned og = xb_add(&bar[XB_TOP], 1u);
            const unsigned tg = og / nx;
            if (og + 1u == (tg + 1u) * nx) xb_add(&bar[XB_TOPGEN], 1u);
            else XB_SPIN(xb_ld(&bar[XB_TOPGEN]) == tg, bar);
            __builtin_amdgcn_fence(__ATOMIC_ACQUIRE, "agent");
            xb_add(&bar[XB_XGEN(bx)], 1u);
            asm volatile("s_waitcnt vmcnt(0)" ::: "memory");
        } else {
            XB_SPIN(xb_ld(&bar[XB_XGEN(bx)]) == gen, bar);
            __builtin_amdgcn_fence(__ATOMIC_ACQUIRE, "agent");
            asm volatile("s_waitcnt vmcnt(0)" ::: "memory");
        }
    }
    __syncthreads();
}

namespace {
struct Params {
  const float *x, *meta, *rel_bias, *ln_mix, *w_in, *sinks, *conv_w, *conv_b, *dt_bias, *a_log, *d_skip, *attn_norm_w,
      *ssm_norm_w, *w_out, *ln_ffn, *wq, *keys, *U, *V, *ln_final;
  float* out;
  unsigned char* ws;
};

__device__ __forceinline__ void p0_transpose_tile(const float* __restrict__ W, int ldw, bf16_t* __restrict__ Wt, const float* sc0,
                                                  const float* sc1, int k0, int n0, float* tile) {
  const int tid = threadIdx.x;
  {
    const int r = tid >> 6, c4 = (tid & 63) * 4;
    f32x4 v[8];
#pragma unroll
    for (int i = 0; i < 8; ++i) v[i] = __builtin_nontemporal_load((const f32x4*)(W + (size_t)(k0 + r + 8 * i) * ldw + n0 + c4));
#pragma unroll
    for (int i = 0; i < 8; ++i) {
      float s = 1.f;
      const int k = k0 + r + 8 * i;
      if (sc0) s = k < 1024 ? sc0[k] : sc1[k - 1024];
      float* q = tile + (r + 8 * i) * 257 + c4;
      q[0] = v[i][0] * s; q[1] = v[i][1] * s; q[2] = v[i][2] * s; q[3] = v[i][3] * s;
    }
  }
  __syncthreads();
#pragma unroll
  for (int it = 0; it < 4; ++it) {
    const int task = it * NTHREADS + tid;
    const int n = task >> 3, kc = (task & 7) * 8;
    float v[8];
#pragma unroll
    for (int j = 0; j < 8; ++j) v[j] = tile[(kc + j) * 257 + n];
    u32x4 w; w.x = pack_bf16(v[0], v[1]); w.y = pack_bf16(v[2], v[3]); w.z = pack_bf16(v[4], v[5]); w.w = pack_bf16(v[6], v[7]);
    *(u32x4*)(Wt + (size_t)(n0 + n) * DM + k0 + kc) = w;
  }
  __syncthreads();
}

__device__ __forceinline__ void phase0(const Params& p, float* ldsf, int bid, int nblk) {
  const int tid = threadIdx.x, lane = tid & 63, wid = tid >> 6;
  bf16_t* w_inT = (bf16_t*)(p.ws + WS_WINT);
  bf16_t* w_dtT = (bf16_t*)(p.ws + WS_WDTT);
  bf16_t* w_outT = (bf16_t*)(p.ws + WS_WOUTT);
  bf16_t* wqT = (bf16_t*)(p.ws + WS_WQT);
  bf16_t* keysb = (bf16_t*)(p.ws + WS_KEYS);
  unsigned char* ub = p.ws + WS_UB;
  unsigned char* vb = p.ws + WS_VB;
  bf16_t* hnb = (bf16_t*)(p.ws + WS_HNB);
  constexpr int U_HN = (TA + 7) / 8;
  constexpr int U_WIN = 32 * 16, U_WOUT = 32 * 8, U_WQ = 32 * 8, U_WDT = 1, U_KEYS = 64;
  constexpr int B_WIN = U_HN, B_WOUT = B_WIN + U_WIN, B_WQ = B_WOUT + U_WOUT, B_WDT = B_WQ + U_WQ, B_KEYS = B_WDT + U_WDT,
                B_U = B_KEYS + U_KEYS, B_END = B_U;
  for (int u = bid; u < B_END; u += nblk) {
    if (u < B_WIN) {
      const int t = u * 8 + wid;
      if (t < TA) {
        const float* src = t < T ? p.x + (size_t)t * DM : p.meta + (size_t)(t - T) * DM;
        float4 v[8];
        float ss = 0.f;
#pragma unroll
        for (int i = 0; i < 8; ++i) {
          { const f32x4 q_ = __builtin_nontemporal_load((const f32x4*)(src + (i * 64 + lane) * 4)); v[i].x = q_[0]; v[i].y = q_[1]; v[i].z = q_[2]; v[i].w = q_[3]; }
          ss += v[i].x * v[i].x + v[i].y * v[i].y + v[i].z * v[i].z + v[i].w * v[i].w;
        }
        ss = wave_sum(ss);
        const float r = rsqrtf(ss * (1.f / DM) + EPS);
#pragma unroll
        for (int i = 0; i < 8; ++i) {
          const float4 w = *(const float4*)(p.ln_mix + (i * 64 + lane) * 4);
          u32x2 o; o.x = pack_bf16(v[i].x * r * w.x, v[i].y * r * w.y); o.y = pack_bf16(v[i].z * r * w.z, v[i].w * r * w.w);
          *(u32x2*)(hnb + (size_t)t * DM + (i * 64 + lane) * 4) = o;
        }
      }
    } else if (u < B_WOUT) {
      const int i = u - B_WIN;
      p0_transpose_tile(p.w_in, DPROJ, w_inT, nullptr, nullptr, (i & 31) * 64, (i >> 5) * 256, ldsf);
    } else if (u < B_WQ) {
      const int i = u - B_WOUT;
      p0_transpose_tile(p.w_out, DM, w_outT, p.attn_norm_w, p.ssm_norm_w, (i & 31) * 64, (i >> 5) * 256, ldsf);
    } else if (u < B_WDT) {
      const int i = u - B_WQ;
      p0_transpose_tile(p.wq, DM, wqT, p.ln_ffn, p.ln_ffn + 1024, (i & 31) * 64, (i >> 5) * 256, ldsf);
    } else if (u < B_KEYS) {
      for (int idx = tid; idx < DM * 16; idx += NTHREADS) {
        const int k = idx >> 4, j = idx & 15;
        w_dtT[(size_t)j * DM + k] = f2bf(p.w_in[(size_t)k * DPROJ + NPROJ + j]);
      }
    } else if (u < B_U) {
      const size_t base = (size_t)(u - B_KEYS) * 4096 + (size_t)tid * 8;
      const float4 a = *(const float4*)(p.keys + base), b = *(const float4*)(p.keys + base + 4);
      u32x4 w; w.x = pack_bf16(a.x, a.y); w.y = pack_bf16(a.z, a.w); w.z = pack_bf16(b.x, b.y); w.w = pack_bf16(b.z, b.w);
      *(u32x4*)(keysb + base) = w;
    }
  }
  {
    const int gw = bid * 8 + wid, nw = nblk * 8;
    auto load_row = [&](f32x4 (&a)[8], const int r2) __attribute__((always_inline)) {
      const float* src = (r2 < NEXP ? p.U + (size_t)r2 * DM : p.V + (size_t)(r2 - NEXP) * DM) + lane * 4;
#pragma unroll
      for (int j = 0; j < 8; ++j) a[j] = __builtin_nontemporal_load((const f32x4*)(src + 256 * j));
    };
    auto conv_row = [&](f32x4 (&a)[8], const int r2) __attribute__((always_inline)) {
      const bool isU = r2 < NEXP;
      const int row = isU ? r2 : r2 - NEXP;
      if (isU) {
#pragma unroll
        for (int j = 0; j < 8; ++j) a[j] *= *(const f32x4*)(p.ln_ffn + lane * 4 + 256 * j);
      }
      float amax = 0.f;
#pragma unroll
      for (int j = 0; j < 8; ++j) amax = fmaxf(amax, fmaxf(fmaxf(fabsf(a[j][0]), fabsf(a[j][1])), fmaxf(fabsf(a[j][2]), fabsf(a[j][3]))));
      amax = wave_max(amax);
      const float s4 = amax > 0.f ? 6.f / amax : 1.f;
      u32x4 w4;
#pragma unroll
      for (int j = 0; j < 4; ++j) {
        unsigned w = 0;
        w = __builtin_amdgcn_cvt_scalef32_pk_fp4_f32(w, a[2 * j][0] * s4, a[2 * j][1] * s4, 1.0f, 0);
        w = __builtin_amdgcn_cvt_scalef32_pk_fp4_f32(w, a[2 * j][2] * s4, a[2 * j][3] * s4, 1.0f, 1);
        w = __builtin_amdgcn_cvt_scalef32_pk_fp4_f32(w, a[2 * j + 1][0] * s4, a[2 * j + 1][1] * s4, 1.0f, 2);
        w = __builtin_amdgcn_cvt_scalef32_pk_fp4_f32(w, a[2 * j + 1][2] * s4, a[2 * j + 1][3] * s4, 1.0f, 3);
        w4[j] = w;
      }
      *(u32x4*)((isU ? ub : vb) + (size_t)row * ROW4 + lane * 16) = w4;
      if (lane == 0) ((float*)(p.ws + (isU ? WS_USC : WS_VSC)))[row] = amax > 0.f ? amax * (1.f / 6.f) : 1.f;
    };
    f32x4 ra[8], rb[8];
    int r2 = gw;
    if (r2 < 2 * NEXP) load_row(ra, r2);
#pragma unroll 1
    for (; r2 < 2 * NEXP; r2 += 2 * nw) {
      if (r2 + nw < 2 * NEXP) load_row(rb, r2 + nw);
      conv_row(ra, r2);
      if (r2 + nw < 2 * NEXP) {
        if (r2 + 2 * nw < 2 * NEXP) load_row(ra, r2 + 2 * nw);
        conv_row(rb, r2 + nw);
      }
    }
  }
}

__device__ __forceinline__ void mini_gemm(const bf16_t* __restrict__ A, const bf16_t* __restrict__ Bt, float* __restrict__ out, int ldo,
                                          float* red, bf16_t* __restrict__ outb = nullptr) {
  const int tid = threadIdx.x, lane = tid & 63, wid = tid >> 6, fr = lane & 15, fq = lane >> 4;
  f32x4 acc = {0.f, 0.f, 0.f, 0.f};
  const bf16_t* ap = A + (size_t)fr * DM + wid * 256 + fq * 8;
  const bf16_t* bp = Bt + (size_t)fr * DM + wid * 256 + fq * 8;
#pragma unroll
  for (int ks = 0; ks < 8; ++ks) {
    const bf16x8 a = *(const bf16x8*)(ap + ks * 32);
    const bf16x8 b = *(const bf16x8*)(bp + ks * 32);
    acc = __builtin_amdgcn_mfma_f32_16x16x32_bf16(a, b, acc, 0, 0, 0);
  }
#pragma unroll
  for (int r = 0; r < 4; ++r) red[wid * 256 + (4 * fq + r) * 16 + fr] = acc[r];
  __syncthreads();
  if (tid < 256) {
    float s = 0.f;
#pragma unroll
    for (int w = 0; w < 8; ++w) s += red[w * 256 + tid];
    out[(size_t)(tid >> 4) * ldo + (tid & 15)] = s;
    if (outb) outb[(size_t)(tid >> 4) * ldo + (tid & 15)] = f2bf(s);
  }
  __syncthreads();
}

__device__ __forceinline__ void phase1(const Params& p, unsigned char* lds, int bid, int nblk) {
  const bf16_t* hnb = (const bf16_t*)(p.ws + WS_HNB);
  const bf16_t* w_inT = (const bf16_t*)(p.ws + WS_WINT);
  const bf16_t* w_dtT = (const bf16_t*)(p.ws + WS_WDTT);
  float* dtraw = (float*)(p.ws + WS_DTRAW);
  float* projm = (float*)(p.ws + WS_PROJM);
  constexpr int NU = 512 + 32 + 96 + 1;
  for (int u = bid; u < NU; u += nblk) {
    if (u < 512) {
      mini_gemm(hnb + (size_t)u * 16 * DM, w_dtT, dtraw + (size_t)u * 16 * 16, 16, (float*)lds);
    } else {
      const int j = u - 512;
      const int cf = j < 32 ? 64 + j : (j < 128 ? 160 + (j - 32) : 256);
      const bf16_t* bt = cf < 256 ? w_inT + (size_t)cf * 16 * DM : w_dtT;
      mini_gemm(hnb + (size_t)T * DM, bt, projm + cf * 16, DPROJ, (float*)lds, (bf16_t*)(p.ws + WS_PROJMB) + cf * 16);
    }
  }
  pg8::Gemm g{hnb, w_inT, T, NPROJ, DM};
  pg8::StaticOrder S; S.init(T, NPROJ, nblk, bid);
  pg8::EpiBf16 E{(bf16_t*)(p.ws + WS_PROJ), NPROJ};
  pg8::gemm_phase<pg8::EpiBf16, pg8::StaticOrder>((PG8_LAS unsigned char*)lds, g, S, E);
}

__device__ __forceinline__ void phase4(const Params& p, unsigned char* lds, int bid, int nblk) {
  pg8::Gemm g{(const bf16_t*)(p.ws + WS_HNB), (const bf16_t*)(p.ws + WS_WOUTT), T, DM, DM};
  pg8::StaticOrder S; S.init(T, DM, nblk, bid);
  pg8::EpiRes E{p.x, (bf16_t*)(p.ws + WS_H1B), (float*)(p.ws + WS_SSQH1)};
  pg8::gemm_phase<pg8::EpiRes, pg8::StaticOrder>((PG8_LAS unsigned char*)lds, g, S, E);
}
__device__ __forceinline__ void phase5(const Params& p, unsigned char* lds, int bid, int nblk) {
  pg8::Gemm g{(const bf16_t*)(p.ws + WS_H1B), (const bf16_t*)(p.ws + WS_WQT), T, DM, DM};
  pg8::StaticOrder S; S.init(T, DM, nblk, bid);
  pg8::EpiScores E{(const bf16_t*)(p.ws + WS_KEYS), (float*)(p.ws + WS_STOP), (int*)(p.ws + WS_ITOP)};
  pg8::gemm_phase<pg8::EpiScores, pg8::StaticOrder>((PG8_LAS unsigned char*)lds, g, S, E);
}

__device__ __forceinline__ float dot2bf(unsigned a, unsigned b, float c) {
  return __builtin_amdgcn_fdot2_f32_bf16(*(bf16v2*)&a, *(bf16v2*)&b, c, false);
}
__device__ __forceinline__ void phase6(const Params& p, unsigned char* lds, int bid, int nblk) {
  const int tid0 = threadIdx.x, lane0 = tid0 & 63, wid = __builtin_amdgcn_readfirstlane(tid0 >> 6);
  int* ids = (int*)(lds + wid * 2048);
  float* gts = (float*)(lds + wid * 2048 + 512);
  float* wts = (float*)(lds + wid * 2048 + 1024);
  int* rid = (int*)(lds + 16384 + wid * 1024);
  float* rgt = (float*)(lds + 16384 + wid * 1024 + 512);
  const unsigned char* ub = p.ws + WS_UB;
  const unsigned char* vb = p.ws + WS_VB;
  const bf16_t* h1b = (const bf16_t*)(p.ws + WS_H1B);
  const float* usc = (const float*)(p.ws + WS_USC);
  const float* vsc = (const float*)(p.ws + WS_VSC);
  const float* ssq = (const float*)(p.ws + WS_SSQH1);
  const float* stop = (const float*)(p.ws + WS_STOP);
  const int* itop = (const int*)(p.ws + WS_ITOP);
  const int ci = kCandI[lane0], cj = kCandJ[lane0];
#pragma unroll 1
  for (int t = bid * 8 + wid; t < T; t += nblk * 8) {
    int tid = tid0; asm volatile("" : "+v"(tid));
    const int lane = tid & 63;
    const int kcode = 8 * ((lane >> 2) & 1) + 4 * ((lane >> 3) & 1) + 2 * ((lane >> 4) & 1) + ((lane >> 5) & 1);
    const float part0 = lane < 32 ? ssq[(size_t)t * 32 + lane] : 0.f;
    const float rr = rsqrtf(wave_sum(part0) * (1.f / DM) + EPS);
#pragma unroll 1
    for (int h = 0; h < 8; ++h) {
      const size_t lbase = ((size_t)t * 16 + h * 2) * 16;
      const float sv = lane < 32 ? __builtin_nontemporal_load(stop + lbase + lane) : 0.f;
      const int iv = lane < 32 ? __builtin_nontemporal_load(itop + lbase + lane) : 0;
      float cand = (__shfl(sv, ci) + __shfl(sv, 16 + cj)) * rr;
      if (lane >= 50) cand = -INFINITY;
      unsigned key = __float_as_uint(cand);
      key = (key & 0x80000000u) ? ~key : (key | 0x80000000u);
      key = (key & ~63u) | (unsigned)(63 - lane);
      int rank = 0;
#pragma unroll
      for (int k = 0; k < 50; ++k) {
        const unsigned kk = (unsigned)__builtin_amdgcn_readlane((int)key, k);
        rank += kk > key ? 1 : 0;
      }
      const float cmax = wave_max(cand);
      const float ex = rank < 16 ? __expf(cand - cmax) : 0.f;
      const float den = wave_sum(ex);
      const int eidx = __shfl(iv, ci) * 128 + __shfl(iv, 16 + cj);
      if (rank < 16) { rid[h * 16 + rank] = eidx; rgt[h * 16 + rank] = ex / den; }
    }
    {
      const int e0 = rid[lane], e1 = rid[lane + 64];
      const float g0 = rgt[lane], g1 = rgt[lane + 64];
      const int r0 = e0 >> 10, r1 = e1 >> 10;
      const unsigned long long ltm = (1ull << lane) - 1ull;
      int run = 0, pos0 = 0, pos1 = 0;
#pragma unroll
      for (int R = 0; R < 16; ++R) {
        const unsigned long long m0 = __ballot(r0 == R), m1 = __ballot(r1 == R);
        const int c0 = __popcll(m0), c1 = __popcll(m1);
        if (r0 == R) pos0 = run + __popcll(m0 & ltm);
        if (r1 == R) pos1 = run + c0 + __popcll(m1 & ltm);
        run += c0 + c1;
      }
      ids[pos0] = e0; gts[pos0] = g0;
      ids[pos1] = e1; gts[pos1] = g1;
    }
    float xf[32];
    {
      const bf16_t* xp = h1b + (size_t)t * DM + lane * 4;
#pragma unroll
      for (int j = 0; j < 8; ++j) {
        const u32x2 xa = *(const u32x2*)(xp + 256 * j);
        xf[4 * j + 0] = bflo(xa.x); xf[4 * j + 1] = bfhi(xa.x); xf[4 * j + 2] = bflo(xa.y); xf[4 * j + 3] = bfhi(xa.y);
      }
    }
#pragma unroll 1
    for (int rnd = 0; rnd < 8; ++rnd) {
      u32x4 ra[16];
#pragma unroll
      for (int k = 0; k < 16; ++k) {
        const int e = __builtin_amdgcn_readfirstlane(ids[rnd * 16 + k]);
        ra[k] = *(const u32x4*)(ub + (size_t)e * ROW4 + lane * 16);
      }
      float part[16];
      float prev = 0.f;
#pragma unroll
      for (int k = 0; k < 16; ++k) {
        asm volatile("" : "+v"(ra[k]) : "v"(prev));
        float d0 = 0.f, d1 = 0.f;
#define U4_STEP(j, i) { const f32x2 r = __builtin_amdgcn_cvt_scalef32_pk_f32_fp4(ra[k][j], 1.0f, i); \
          d0 = fmaf(r[0], xf[8 * (j) + 2 * (i)], d0); d1 = fmaf(r[1], xf[8 * (j) + 2 * (i) + 1], d1); }
#pragma unroll
        for (int j = 0; j < 4; ++j) { U4_STEP(j, 0) U4_STEP(j, 1) U4_STEP(j, 2) U4_STEP(j, 3) }
#undef U4_STEP
        prev = d0 + d1;
        part[k] = prev;
      }
      float q8[8], q4[4], q2[2], q1;
      { const bool hi = (lane >> 5) & 1;
#pragma unroll
        for (int i = 0; i < 8; ++i) { const float keep = hi ? part[2 * i + 1] : part[2 * i], send = hi ? part[2 * i] : part[2 * i + 1]; q8[i] = keep + __shfl_xor(send, 32); } }
      { const bool hi = (lane >> 4) & 1;
#pragma unroll
        for (int i = 0; i < 4; ++i) { const float keep = hi ? q8[2 * i + 1] : q8[2 * i], send = hi ? q8[2 * i] : q8[2 * i + 1]; q4[i] = keep + __shfl_xor(send, 16); } }
      { const bool hi = (lane >> 3) & 1;
#pragma unroll
        for (int i = 0; i < 2; ++i) { const float keep = hi ? q4[2 * i + 1] : q4[2 * i], send = hi ? q4[2 * i] : q4[2 * i + 1]; q2[i] = keep + __shfl_xor(send, 8); } }
      { const bool hi = (lane >> 2) & 1;
        const float keep = hi ? q2[1] : q2[0], send = hi ? q2[0] : q2[1]; q1 = keep + __shfl_xor(send, 4); }
      q1 += __shfl_xor(q1, 2);
      q1 += __shfl_xor(q1, 1);
      {
        const int kk = rnd * 16 + kcode;
        const int eid = ids[kk];
        const float a = q1 * rr * usc[eid];
        const float ge = 0.5f * a * (1.f + erff(a * 0.70710678118654752f));
        if ((lane & 3) == 0) wts[kk] = gts[kk] * ge * vsc[eid];
      }
    }
    float acc[32];
#pragma unroll
    for (int i = 0; i < 32; ++i) acc[i] = 0.f;
#pragma unroll 1
    for (int rnd = 0; rnd < 8; ++rnd) {
      u32x4 ra[16];
#pragma unroll
      for (int k = 0; k < 16; ++k) {
        const int e = __builtin_amdgcn_readfirstlane(ids[rnd * 16 + k]);
        ra[k] = *(const u32x4*)(vb + (size_t)e * ROW4 + lane * 16);
      }
      f32x4 wv[4];
#pragma unroll
      for (int j = 0; j < 4; ++j) wv[j] = *(const f32x4*)(wts + rnd * 16 + 4 * j);
#pragma unroll
      for (int k = 0; k < 16; ++k) {
        const float wk = wv[k >> 2][k & 3];
        asm volatile("" : "+v"(ra[k]) : "v"(acc[1]), "v"(acc[3]), "v"(acc[5]), "v"(acc[7]), "v"(acc[9]), "v"(acc[11]), "v"(acc[13]), "v"(acc[15]),
                                        "v"(acc[17]), "v"(acc[19]), "v"(acc[21]), "v"(acc[23]), "v"(acc[25]), "v"(acc[27]), "v"(acc[29]), "v"(acc[31]));
#define V4_STEP(j, i) { const f32x2 r = __builtin_amdgcn_cvt_scalef32_pk_f32_fp4(ra[k][j], 1.0f, i); \
            acc[8 * (j) + 2 * (i)] = fmaf(wk, r[0], acc[8 * (j) + 2 * (i)]); acc[8 * (j) + 2 * (i) + 1] = fmaf(wk, r[1], acc[8 * (j) + 2 * (i) + 1]); }
#pragma unroll
        for (int j = 0; j < 4; ++j) { V4_STEP(j, 0) V4_STEP(j, 1) V4_STEP(j, 2) V4_STEP(j, 3) }
#undef V4_STEP
      }
    }
    float ss = 0.f;
#pragma unroll
    for (int i = 0; i < 32; ++i) { acc[i] += xf[i]; ss += acc[i] * acc[i]; }
    ss = wave_sum(ss);
    const float rf = rsqrtf(ss * (1.f / DM) + EPS);
#pragma unroll
    for (int j = 0; j < 8; ++j) {
      const f32x4 lw = *(const f32x4*)(p.ln_final + 256 * j + lane * 4);
      const f32x4 o = {acc[4 * j] * rf * lw[0], acc[4 * j + 1] * rf * lw[1], acc[4 * j + 2] * rf * lw[2], acc[4 * j + 3] * rf * lw[3]};
      __builtin_nontemporal_store(o, (f32x4*)(p.out + (size_t)t * DM + 256 * j + lane * 4));
    }
  }
}

typedef float f32x16 __attribute__((ext_vector_type(16)));
__device__ __forceinline__ void unpack8(const u32x4 a, float (&v)[8]) {
  v[0] = bflo(a.x); v[1] = bfhi(a.x); v[2] = bflo(a.y); v[3] = bfhi(a.y); v[4] = bflo(a.z); v[5] = bfhi(a.z); v[6] = bflo(a.w); v[7] = bfhi(a.w);
}
constexpr int VT_LD = 196;
constexpr int ATT_VT_BYTES = 4 * 64 * VT_LD * 2;
__device__ __forceinline__ void attn_item(const Params& p, unsigned char* lds, int item) {
  const int tid = threadIdx.x, lane = tid & 63, wid = __builtin_amdgcn_readfirstlane(tid >> 6);
  const int b = item >> 6, q0 = (item & 63) * 32;
  bf16_t* VT = (bf16_t*)lds;
  float* biasL = (float*)(lds + ATT_VT_BYTES);
  float* ssqw = biasL + 16 * 132;
  const bf16_t* proj = (const bf16_t*)(p.ws + WS_PROJ);
  const float* projm = (const float*)(p.ws + WS_PROJM);
  bf16_t* mixin = (bf16_t*)(p.ws + WS_HNB);
#pragma unroll
  for (int it = 0; it < 5; ++it) {
    const int idx = it * NTHREADS + tid;
    if (idx >= 16 * 129) break;
    const int hq = idx / 129, d = idx - hq * 129;
    const int bk = d < 128 ? (int)kBucket[d] : 31;
    biasL[hq * 132 + d] = p.rel_bias[bk * 16 + hq];
  }
  const int ql = lane & 31, ql0 = ql, hh = lane >> 5, kvh = wid >> 1;
  const int trow = b * SEQ + q0 + ql;
  bf16x8 qf[4];
  u32x4 kf[6][4];
#define ATT_LOAD_Q(hq_)                                                                                                           \
  { _Pragma("unroll") for (int ks = 0; ks < 4; ++ks) qf[ks] = *(const bf16x8*)(proj + (size_t)trow * NPROJ + OFF_Q + (hq_) * 64 + ks * 16 + hh * 8); }
#define ATT_LOAD_K()                                                                                                              \
  {                                                                                                                               \
    int ql = ql0; asm volatile("" : "+v"(ql));     \
    const float* kr_ = projm + (size_t)(ql & 15) * DPROJ + OFF_K + kvh * 64 + hh * 8;                                             \
    _Pragma("unroll") for (int ks = 0; ks < 4; ++ks) {                                                                            \
      const f32x4 a_ = *(const f32x4*)(kr_ + ks * 16), c_ = *(const f32x4*)(kr_ + ks * 16 + 4);                                   \
      kf[0][ks].x = pack_bf16(a_[0], a_[1]); kf[0][ks].y = pack_bf16(a_[2], a_[3]); kf[0][ks].z = pack_bf16(c_[0], c_[1]); kf[0][ks].w = pack_bf16(c_[2], c_[3]); } \
    _Pragma("unroll") for (int jt = 1; jt < 6; ++jt) {                                                                            \
      int sp_ = q0 - 128 + 32 * (jt - 1) + ql; sp_ = sp_ < 0 ? 0 : sp_;                                                           \
      const bf16_t* kp_ = proj + (size_t)(b * SEQ + sp_) * NPROJ + OFF_K + kvh * 64 + hh * 8;                                     \
      _Pragma("unroll") for (int ks = 0; ks < 4; ++ks) kf[jt][ks] = *(const u32x4*)(kp_ + ks * 16); }                             \
  }
  ATT_LOAD_Q(2 * wid)
#pragma unroll 1
  for (int rep_ = 0; rep_ < (REP_SUB == 2 ? 2 : 1); ++rep_) {
    u32x4 ra[5], rc[5];
#pragma unroll
    for (int q = 0; q < 5; ++q) {
      const int task = q * NTHREADS + tid, ch = task / 80, pi = task - ch * 80;
      int s0 = q0 - 128 + 2 * pi;
      s0 = s0 < 0 ? 0 : s0;
      const bf16_t* r0 = proj + (size_t)(b * SEQ + s0) * NPROJ + OFF_V + ch * 8;
      ra[q] = *(const u32x4*)r0; rc[q] = *(const u32x4*)(r0 + NPROJ);
    }
    float m0[8], m1[8];
    {
      const int pi = tid & 7, ch = (tid >> 3) & 31;
      const float* r0 = projm + (size_t)(2 * pi) * DPROJ + OFF_V + ch * 8;
      const f32x4 ma = *(const f32x4*)r0, mb = *(const f32x4*)(r0 + 4), mc = *(const f32x4*)(r0 + DPROJ), md = *(const f32x4*)(r0 + DPROJ + 4);
      const float keep = tid < 256 ? 1.f : 0.f;
#pragma unroll
      for (int i = 0; i < 4; ++i) { m0[i] = ma[i] * keep; m0[4 + i] = mb[i] * keep; m1[i] = mc[i] * keep; m1[4 + i] = md[i] * keep; }
      bf16_t* dst = VT + (size_t)((ch >> 3) * 64 + (ch & 7) * 8) * VT_LD + 2 * pi + (tid < 256 ? 0 : 16);
#pragma unroll
      for (int i = 0; i < 8; ++i) *(unsigned*)(dst + i * VT_LD) = pack_bf16(m0[i], m1[i]);
    }
#pragma unroll
    for (int q = 0; q < 5; ++q) {
      const int task = q * NTHREADS + tid, ch = task / 80, pi = task - ch * 80;
      float v0[8], v1[8];
      unpack8(ra[q], v0); unpack8(rc[q], v1);
      bf16_t* dst = VT + (size_t)((ch >> 3) * 64 + (ch & 7) * 8) * VT_LD + 32 + 2 * pi;
#pragma unroll
      for (int i = 0; i < 8; ++i) *(unsigned*)(dst + i * VT_LD) = pack_bf16(v0[i], v1[i]);
    }
  }
  __syncthreads();
  float ssq = 0.f;
#pragma unroll 1
  for (int rep_ = 0; rep_ < (REP_SUB == 3 ? 2 : 1); ++rep_) {
  ssq = 0.f;
  auto do_head = [&](const int hsel) __attribute__((always_inline)) {
    const int hq = 2 * wid + hsel;
    f32x16 sacc[6];
#pragma unroll
    for (int jt = 0; jt < 6; ++jt) {
      f32x16 acc;
#pragma unroll
      for (int r = 0; r < 16; ++r) acc[r] = 0.f;
#pragma unroll
      for (int ks = 0; ks < 4; ++ks) acc = __builtin_amdgcn_mfma_f32_32x32x16_bf16(*(bf16x8*)&kf[jt][ks], qf[ks], acc, 0, 0, 0);
      sacc[jt] = acc;
    }
    if (hsel == 0) { ATT_LOAD_Q(2 * wid + 1) }
    const float* bl = biasL + hq * 132;
    int sq = q0 + ql, qh = ql - 4 * hh;
    asm volatile("" : "+v"(sq), "+v"(qh));
    const float sink = p.sinks[hq];
    float m = sink;
#pragma unroll
    for (int jt = 0; jt < 6; ++jt) {
      asm volatile("" ::: "memory");
#pragma unroll
      for (int r = 0; r < 16; ++r) {
        const int kr = (r & 3) + 8 * (r >> 2) + 4 * hh;
        int dist; bool valid;
        if (jt == 0) { dist = sq + (16 - ((r & 3) + 8 * (r >> 2))) - 4 * hh; valid = kr < 16; }
        else { dist = qh + (128 - 32 * (jt - 1) - ((r & 3) + 8 * (r >> 2))); valid = (dist >= 0) && (dist < 128) && (dist <= sq); }
        const int dc = dist < 0 ? 0 : (dist > 128 ? 128 : dist);
        const float l = valid ? 0.125f * sacc[jt][r] + bl[dc] : -1e30f;
        sacc[jt][r] = l;
        m = fmaxf(m, l);
      }
    }
    m = fmaxf(m, __shfl_xor(m, 32));
    float sum = 0.f;
    f32x16 oacc0, oacc1;
#pragma unroll
    for (int r = 0; r < 16; ++r) { oacc0[r] = 0.f; oacc1[r] = 0.f; }
    const bf16_t* vrow0 = VT + (size_t)(kvh * 64 + ql) * VT_LD + 4 * hh;
    const bf16_t* vrow1 = vrow0 + 32 * VT_LD;
#pragma unroll
    for (int jt = 0; jt < 6; ++jt) {
      u32x4 pw[2];
#pragma unroll
      for (int s2 = 0; s2 < 2; ++s2) {
        float e[8];
#pragma unroll
        for (int i = 0; i < 8; ++i) { e[i] = __expf(sacc[jt][8 * s2 + i] - m); sum += e[i]; }
        pw[s2].x = pack_bf16(e[0], e[1]); pw[s2].y = pack_bf16(e[2], e[3]); pw[s2].z = pack_bf16(e[4], e[5]); pw[s2].w = pack_bf16(e[6], e[7]);
      }
#pragma unroll
      for (int s2 = 0; s2 < 2; ++s2) {
        const u32x2 va = *(const u32x2*)(vrow0 + 32 * jt + 16 * s2), vc = *(const u32x2*)(vrow0 + 32 * jt + 16 * s2 + 8);
        const u32x2 vd = *(const u32x2*)(vrow1 + 32 * jt + 16 * s2), ve = *(const u32x2*)(vrow1 + 32 * jt + 16 * s2 + 8);
        u32x4 v0w; v0w.x = va.x; v0w.y = va.y; v0w.z = vc.x; v0w.w = vc.y;
        u32x4 v1w; v1w.x = vd.x; v1w.y = vd.y; v1w.z = ve.x; v1w.w = ve.y;
        oacc0 = __builtin_amdgcn_mfma_f32_32x32x16_bf16(*(bf16x8*)&v0w, *(bf16x8*)&pw[s2], oacc0, 0, 0, 0);
        oacc1 = __builtin_amdgcn_mfma_f32_32x32x16_bf16(*(bf16x8*)&v1w, *(bf16x8*)&pw[s2], oacc1, 0, 0, 0);
      }
    }
    sum += __shfl_xor(sum, 32);
    const float inv = 1.f / (sum + __expf(sink - m));
#pragma unroll
    for (int r = 0; r < 16; ++r) { oacc0[r] *= inv; oacc1[r] *= inv; ssq += oacc0[r] * oacc0[r] + oacc1[r] * oacc1[r]; }
#pragma unroll
    for (int rg = 0; rg < 4; ++rg) {
      u32x2 w; w.x = pack_bf16(oacc0[rg * 4 + 0], oacc0[rg * 4 + 1]); w.y = pack_bf16(oacc0[rg * 4 + 2], oacc0[rg * 4 + 3]);
      *(u32x2*)(mixin + (size_t)trow * DM + hq * 64 + 8 * rg + 4 * hh) = w;
      u32x2 w1; w1.x = pack_bf16(oacc1[rg * 4 + 0], oacc1[rg * 4 + 1]); w1.y = pack_bf16(oacc1[rg * 4 + 2], oacc1[rg * 4 + 3]);
      *(u32x2*)(mixin + (size_t)trow * DM + hq * 64 + 32 + 8 * rg + 4 * hh) = w1;
    }
  };
  ATT_LOAD_K()
  do_head(0);
  asm volatile("" ::: "memory");
  ATT_LOAD_K()
  do_head(1);
  }
  ssq += __shfl_xor(ssq, 32);
  if (lane < 32) ssqw[wid * 32 + lane] = ssq;
  __syncthreads();
  float tot = 0.f;
#pragma unroll
  for (int w = 0; w < 8; ++w) tot += ssqw[w * 32 + ql];
  const float ra = rsqrtf(tot * (1.f / 1024) + EPS);
#pragma unroll
  for (int hsel = 0; hsel < 2; ++hsel)
#pragma unroll
    for (int dt = 0; dt < 2; ++dt)
#pragma unroll
      for (int rg = 0; rg < 4; ++rg) {
        bf16_t* op = mixin + (size_t)trow * DM + (2 * wid + hsel) * 64 + 32 * dt + 8 * rg + 4 * hh;
        const u32x2 v = *(const u32x2*)op;
        u32x2 w; w.x = pack_bf16(bflo(v.x) * ra, bfhi(v.x) * ra); w.y = pack_bf16(bflo(v.y) * ra, bfhi(v.y) * ra);
        *(u32x2*)op = w;
      }
  __syncthreads();
}
#undef ATT_LOAD_Q
#undef ATT_LOAD_K
__device__ __forceinline__ void phase2_attn(const Params& p, unsigned char* lds, int bid, int nblk) {
  for (int item = bid; item < 256; item += nblk) attn_item(p, lds, item);
}

constexpr int SLD = 136;
__device__ __forceinline__ float conv_silu(const float (&raw)[11], int i, float w0, float w1, float w2, float w3, float cb) {
  return silu_f(cb + w0 * raw[i] + w1 * raw[i + 1] + w2 * raw[i + 2] + w3 * raw[i + 3]);
}
__device__ __forceinline__ void ssd_a_item(const Params& p, unsigned char* lds, int item) {
  const int tid = threadIdx.x, lane = tid & 63, wid = __builtin_amdgcn_readfirstlane(tid >> 6);
  const int b = item >> 6, c = (item >> 2) & 15, g = (item >> 1) & 1, hsel = item & 1;
  const int h0 = g * 8 + hsel * 4;
  const int t0 = b * SEQ + c * 128;
  bf16_t* Bc = (bf16_t*)lds;
  bf16_t* Cc = Bc + 128 * SLD;
  bf16_t* BcT = Cc + 128 * SLD;
  bf16_t* xT = BcT + 128 * SLD;
  float* dtl = (float*)(xT + 2 * 64 * SLD);
  float* acs = dtl + 512;
  float* wl = acs + 512;
  float* scan = wl + 512;
  const bf16_t* __restrict__ proj = (const bf16_t*)(p.ws + WS_PROJ);
  const bf16_t* __restrict__ projmb = (const bf16_t*)(p.ws + WS_PROJMB);
  const float* __restrict__ dtraw = (const float*)(p.ws + WS_DTRAW);
  float* __restrict__ acsg = (float*)(p.ws + WS_ACSG);
  bf16_t* __restrict__ ccb = (bf16_t*)(p.ws + WS_CCB);
  float* __restrict__ ypart = (float*)(p.ws + WS_YPART);
  float* __restrict__ sg = (float*)(p.ws + WS_SG);
  {
    const int hi = tid >> 7, l = tid & 127, h = h0 + hi;
    const float Ah = -expf(p.a_log[h]);
    const float dtv = softplus_f(dtraw[(size_t)(t0 + l) * 16 + h] + p.dt_bias[h]);
    dtl[tid] = dtv;
    float cum = dtv * Ah;
#pragma unroll
    for (int o = 1; o < 64; o <<= 1) { const float nb = __shfl_up(cum, o); if (lane >= o) cum += nb; }
    if ((tid & 127) == 63) scan[hi] = cum;
    __syncthreads();
    if (l >= 64) cum += scan[hi];
    acs[tid] = cum;
    acsg[(size_t)(t0 + l) * 16 + h] = cum;
    __syncthreads();
    wl[tid] = dtv * __expf(acs[hi * 128 + 127] - cum);
  }
  {
    unsigned raw[4][11];
#pragma unroll
    for (int q = 0; q < 4; ++q) {
      const int task = q * NTHREADS + tid;
      const int tg = task >> 7, cp = task & 127;
      const int cch = 1024 + (cp >> 6) * 256 + g * 128 + 2 * (cp & 63);
#pragma unroll
      for (int i = 0; i < 11; ++i) {
        const int l = tg * 8 + i - 3;
        const bf16_t* src = (l >= 0 || c > 0) ? proj + (size_t)(t0 + l) * NPROJ : projmb + (size_t)(16 + l) * DPROJ;
        raw[q][i] = *(const unsigned*)(src + OFF_XBC + cch);
      }
    }
#pragma unroll
    for (int q = 0; q < 4; ++q) {
      const int task = q * NTHREADS + tid;
      const int tg = task >> 7, cp = task & 127, n = 2 * (cp & 63);
      const int cch = 1024 + (cp >> 6) * 256 + g * 128 + n;
      float o0[8], o1[8];
      {
        float r0[11], r1[11];
#pragma unroll
        for (int i = 0; i < 11; ++i) { r0[i] = bflo(raw[q][i]); r1[i] = bfhi(raw[q][i]); }
        const float w0 = p.conv_w[cch], w1 = p.conv_w[D_XBC + cch], w2 = p.conv_w[2 * D_XBC + cch], w3 = p.conv_w[3 * D_XBC + cch], cb = p.conv_b[cch];
        const float v0 = p.conv_w[cch + 1], v1 = p.conv_w[D_XBC + cch + 1], v2 = p.conv_w[2 * D_XBC + cch + 1], v3 = p.conv_w[3 * D_XBC + cch + 1], vb_ = p.conv_b[cch + 1];
#pragma unroll
        for (int i = 0; i < 8; ++i) { o0[i] = conv_silu(r0, i, w0, w1, w2, w3, cb); o1[i] = conv_silu(r1, i, v0, v1, v2, v3, vb_); }
      }
      bf16_t* rowm = (cp < 64 ? Bc : Cc) + (tg * 8) * SLD + n;
#pragma unroll
      for (int i = 0; i < 8; ++i) *(unsigned*)(rowm + i * SLD) = pack_bf16(o0[i], o1[i]);
      if (cp < 64) {
        u32x4 w; w.x = pack_bf16(o0[0], o0[1]); w.y = pack_bf16(o0[2], o0[3]); w.z = pack_bf16(o0[4], o0[5]); w.w = pack_bf16(o0[6], o0[7]);
        *(u32x4*)(BcT + n * SLD + tg * 8) = w;
        u32x4 w2_; w2_.x = pack_bf16(o1[0], o1[1]); w2_.y = pack_bf16(o1[2], o1[3]); w2_.z = pack_bf16(o1[4], o1[5]); w2_.w = pack_bf16(o1[6], o1[7]);
        *(u32x4*)(BcT + (n + 1) * SLD + tg * 8) = w2_;
      }
    }
  }
  float xraw[4][11];
#define SSD_LOAD_X(r_)                                                                                              \
  _Pragma("unroll") for (int q = 0; q < 4; ++q) {                                                                   \
    const int task = (q & 1) * NTHREADS + tid; const int tg = task >> 6, cch = (h0 + 2 * (r_) + (q >> 1)) * 64 + (task & 63); \
    _Pragma("unroll") for (int i = 0; i < 11; ++i) { const int l = tg * 8 + i - 3;                                  \
      const bf16_t* src = (l >= 0 || c > 0) ? proj + (size_t)(t0 + l) * NPROJ : projmb + (size_t)(16 + l) * DPROJ;  \
      xraw[q][i] = bf2f(src[OFF_XBC + cch]); } }
  SSD_LOAD_X(0)
  __syncthreads();
  if (hsel == 0) {
#pragma unroll
    for (int q = 0; q < 4; ++q) {
      const int idx = q * NTHREADS + tid, row = idx >> 4, ck = idx & 15;
      *(u32x4*)(ccb + (size_t)(t0 + row) * 256 + g * 128 + ck * 8) = *(const u32x4*)(Cc + row * SLD + ck * 8);
    }
  }
  const int ql = lane & 31, hh = lane >> 5;
  auto ydiag = [&](const int hi, const int il) __attribute__((always_inline)) {
    const int h = h0 + hi, ip = wid & 1;
    const bf16_t* xTb = xT + (hi & 1) * 64 * SLD;
    const float dskip = p.d_skip[h];
    const float* acsh = acs + hi * 128;
    const float* dtlh = dtl + hi * 128;
    const int l = 32 * il + ql;
    const float acl = acsh[l];
    f32x16 yacc;
#pragma unroll
    for (int r = 0; r < 16; ++r) yacc[r] = 0.f;
    const bf16_t* xrow = xTb + (32 * ip + ql) * SLD + 4 * hh;
#pragma unroll 1
    for (int is = 0; is <= il; ++is) {
      f32x16 x;
#pragma unroll
      for (int r = 0; r < 16; ++r) x[r] = 0.f;
      const bf16_t* ap = Bc + (32 * is + ql) * SLD + 8 * hh;
      const bf16_t* bp = Cc + l * SLD + 8 * hh;
#pragma unroll
      for (int ks = 0; ks < 8; ++ks) x = __builtin_amdgcn_mfma_f32_32x32x16_bf16(*(const bf16x8*)(ap + 16 * ks), *(const bf16x8*)(bp + 16 * ks), x, 0, 0, 0);
      u32x4 pw[2];
#pragma unroll
      for (int s2 = 0; s2 < 2; ++s2) {
        float mv[8];
#pragma unroll
        for (int q = 0; q < 2; ++q) {
          const int sb = 32 * is + 16 * s2 + 8 * q + 4 * hh;
          const f32x4 as4 = *(const f32x4*)(acsh + sb), dt4 = *(const f32x4*)(dtlh + sb);
#pragma unroll
          for (int j = 0; j < 4; ++j) {
            const int sr = sb + j;
            float v = sr <= l ? x[8 * s2 + 4 * q + j] * __expf(acl - as4[j]) * dt4[j] : 0.f;
            if (sr == l) v += dskip;
            mv[4 * q + j] = v;
          }
        }
        pw[s2].x = pack_bf16(mv[0], mv[1]); pw[s2].y = pack_bf16(mv[2], mv[3]); pw[s2].z = pack_bf16(mv[4], mv[5]); pw[s2].w = pack_bf16(mv[6], mv[7]);
      }
#pragma unroll
      for (int s2 = 0; s2 < 2; ++s2) {
        const u32x2 va = *(const u32x2*)(xrow + 32 * is + 16 * s2), vc = *(const u32x2*)(xrow + 32 * is + 16 * s2 + 8);
        u32x4 aw; aw.x = va.x; aw.y = va.y; aw.z = vc.x; aw.w = vc.y;
        yacc = __builtin_amdgcn_mfma_f32_32x32x16_bf16(*(bf16x8*)&aw, *(bf16x8*)&pw[s2], yacc, 0, 0, 0);
      }
    }
    float* yp = ypart + (size_t)(t0 + l) * 1024 + h * 64 + 32 * ip + 4 * hh;
#pragma unroll
    for (int rg = 0; rg < 4; ++rg) *(f32x4*)(yp + 8 * rg) = (f32x4){yacc[4 * rg], yacc[4 * rg + 1], yacc[4 * rg + 2], yacc[4 * rg + 3]};
  };
  auto states = [&](const int hi) __attribute__((always_inline)) {
    const int h = h0 + hi, ip = wid & 1, in = wid >> 1;
    const bf16_t* xTb = xT + (hi & 1) * 64 * SLD;
    const float* wlh = wl + hi * 128;
    f32x16 sacc;
#pragma unroll
    for (int r = 0; r < 16; ++r) sacc[r] = 0.f;
    const bf16_t* ap = xTb + (32 * ip + ql) * SLD + 8 * hh;
    const bf16_t* bp = BcT + (32 * in + ql) * SLD + 8 * hh;
#pragma unroll
    for (int ks = 0; ks < 8; ++ks) {
      const u32x4 xa = *(const u32x4*)(ap + 16 * ks);
      const f32x4 wa = *(const f32x4*)(wlh + 16 * ks + 8 * hh), wb = *(const f32x4*)(wlh + 16 * ks + 8 * hh + 4);
      u32x4 aw;
      aw.x = pack_bf16(bflo(xa.x) * wa[0], bfhi(xa.x) * wa[1]); aw.y = pack_bf16(bflo(xa.y) * wa[2], bfhi(xa.y) * wa[3]);
      aw.z = pack_bf16(bflo(xa.z) * wb[0], bfhi(xa.z) * wb[1]); aw.w = pack_bf16(bflo(xa.w) * wb[2], bfhi(xa.w) * wb[3]);
      sacc = __builtin_amdgcn_mfma_f32_32x32x16_bf16(*(bf16x8*)&aw, *(const bf16x8*)(bp + 16 * ks), sacc, 0, 0, 0);
    }
    float* sp = sg + ((size_t)((b * 16 + c) * 16 + h) * 64 + 32 * ip + 4 * hh) * 128 + 32 * in + ql;
#pragma unroll
    for (int r = 0; r < 16; ++r) sp[((r & 3) + 8 * (r >> 2)) * 128] = sacc[r];
  };
#pragma unroll 1
  for (int rnd_ = 0; rnd_ < (REP_SUB == 5 ? 4 : 2); ++rnd_) {
    const int rnd = rnd_ & 1;
#pragma unroll
    for (int q = 0; q < 4; ++q) {
      const int task = (q & 1) * NTHREADS + tid; const int tg = task >> 6, pch = task & 63, cch = (h0 + 2 * rnd + (q >> 1)) * 64 + pch;
      const float w0 = p.conv_w[cch], w1 = p.conv_w[D_XBC + cch], w2 = p.conv_w[2 * D_XBC + cch], w3 = p.conv_w[3 * D_XBC + cch], cb = p.conv_b[cch];
      float o[8];
#pragma unroll
      for (int i = 0; i < 8; ++i) o[i] = conv_silu(xraw[q], i, w0, w1, w2, w3, cb);
      u32x4 w; w.x = pack_bf16(o[0], o[1]); w.y = pack_bf16(o[2], o[3]); w.z = pack_bf16(o[4], o[5]); w.w = pack_bf16(o[6], o[7]);
      *(u32x4*)(xT + (q >> 1) * 64 * SLD + pch * SLD + tg * 8) = w;
    }
    { SSD_LOAD_X((rnd + 1) & 1) }
    __syncthreads();
    ydiag(2 * rnd, wid >> 1);
    ydiag(2 * rnd + 1, 3 - (wid >> 1));
    states(2 * rnd);
    states(2 * rnd + 1);
    __syncthreads();
  }
#undef SSD_LOAD_X
  __syncthreads();
}

__device__ __forceinline__ void meta_state_item(const Params& p, unsigned char* lds, int h) {
  const int tid = threadIdx.x, g = h >> 3;
  float* xm = (float*)lds;
  float* bm = xm + 16 * 64;
  float* dtm = bm + 16 * 128;
  const float* projm = (const float*)(p.ws + WS_PROJM);
  float* smeta = (float*)(p.ws + WS_SMETA);
  for (int task = tid; task < 16 * 192; task += NTHREADS) {
    const int i = task / 192, ch = task - i * 192;
    const int cch = ch < 64 ? h * 64 + ch : 1024 + g * 128 + (ch - 64);
    float acc = p.conv_b[cch];
#pragma unroll
    for (int j = 0; j < 4; ++j) { const int mi = i - j; if (mi >= 0) acc += p.conv_w[(3 - j) * D_XBC + cch] * projm[(size_t)mi * DPROJ + OFF_XBC + cch]; }
    const float v = silu_f(acc);
    if (ch < 64) xm[i * 64 + ch] = v; else bm[i * 128 + ch - 64] = v;
  }
  if (tid < 16) dtm[tid] = softplus_f(projm[(size_t)tid * DPROJ + OFF_DT + h] + p.dt_bias[h]);
  __syncthreads();
  const float Ah = -expf(p.a_log[h]);
  const int pr = tid >> 3, n0 = (tid & 7) * 16;
  float st[16];
#pragma unroll
  for (int k = 0; k < 16; ++k) st[k] = 0.f;
  for (int i = 0; i < 16; ++i) {
    const float dtv = dtm[i], dA = expf(dtv * Ah), xdt = xm[i * 64 + pr] * dtv;
#pragma unroll
    for (int k = 0; k < 16; ++k) st[k] = fmaf(st[k], dA, xdt * bm[i * 128 + n0 + k]);
  }
#pragma unroll
  for (int k = 0; k < 16; ++k) smeta[(size_t)(h * 64 + pr) * 128 + n0 + k] = st[k];
  __syncthreads();
}

__device__ __forceinline__ void phase2(const Params& p, unsigned char* lds, int bid, int nblk) {
  const bool remap = (nblk == 256);
#pragma unroll 1
  for (int rep = 0; rep < (REP_SUB == 0 ? 2 : 1); ++rep)
    for (int it = bid; it < 256; it += nblk) attn_item(p, lds, remap ? ((it & 7) * 32 + (it >> 3)) : it);
#pragma unroll 1
  for (int rep = 0; rep < (REP_SUB == 1 ? 2 : 1); ++rep)
    for (int it = bid; it < 256; it += nblk) ssd_a_item(p, lds, remap ? ((it & 7) * 32 + (it >> 3)) : it);
  for (int item = bid; item < 16; item += nblk) meta_state_item(p, lds, item);
}

__device__ __forceinline__ void phase_scan(const Params& p, int bid, int nblk) {
  const float* __restrict__ sg = (const float*)(p.ws + WS_SG);
  const float* __restrict__ smeta = (const float*)(p.ws + WS_SMETA);
  const float* __restrict__ acsg = (const float*)(p.ws + WS_ACSG);
  bf16_t* __restrict__ hprev = (bf16_t*)(p.ws + WS_HPREV);
  for (int task = bid * NTHREADS + threadIdx.x; task < 64 * 2048; task += nblk * NTHREADS) {
    const int bh = task >> 11, e4 = (task & 2047) * 4;
    const int b = bh >> 4, h = bh & 15;
    f32x4 sv[16];
    float dv[16];
#pragma unroll
    for (int c = 0; c < 16; ++c) {
      sv[c] = *(const f32x4*)(sg + (size_t)((b * 16 + c) * 16 + h) * 8192 + e4);
      dv[c] = acsg[(size_t)(b * SEQ + c * 128 + 127) * 16 + h];
    }
    f32x4 H = *(const f32x4*)(smeta + (size_t)h * 8192 + e4);
#pragma unroll
    for (int c = 0; c < 16; ++c) {
      u32x2 w; w.x = pack_bf16(H[0], H[1]); w.y = pack_bf16(H[2], H[3]);
      *(u32x2*)(hprev + (size_t)((b * 16 + c) * 16 + h) * 8192 + e4) = w;
      H = H * __expf(dv[c]) + sv[c];
    }
  }
}

__device__ __forceinline__ void ssd_b_item(const Params& p, unsigned char* lds, int item) {
  const int tid = threadIdx.x, lane = tid & 63, wid = __builtin_amdgcn_readfirstlane(tid >> 6);
  const int b = item >> 6, c = (item >> 2) & 15, g = (item >> 1) & 1, lh = item & 1, h = g * 8 + wid;
  const int t0 = b * SEQ + c * 128 + lh * 64;
  const int ql = lane & 31, hh = lane >> 5;
  constexpr int YLD = 520;
  bf16_t* yoff = (bf16_t*)lds;
  const bf16_t* __restrict__ proj = (const bf16_t*)(p.ws + WS_PROJ);
  const float* __restrict__ acsg = (const float*)(p.ws + WS_ACSG);
  const bf16_t* __restrict__ ccb = (const bf16_t*)(p.ws + WS_CCB);
  const float* __restrict__ ypart = (const float*)(p.ws + WS_YPART);
  const bf16_t* __restrict__ hprev = (const bf16_t*)(p.ws + WS_HPREV);
  bf16_t* __restrict__ mixin = (bf16_t*)(p.ws + WS_HNB);
  {
    const bf16_t* hp = hprev + (size_t)((b * 16 + c) * 16 + h) * 8192 + (size_t)ql * 128 + 8 * hh;
    u32x4 hf0[8], hf1[8];
#pragma unroll
    for (int ks = 0; ks < 8; ++ks) { hf0[ks] = *(const u32x4*)(hp + 16 * ks); hf1[ks] = *(const u32x4*)(hp + 32 * 128 + 16 * ks); }
#pragma unroll
    for (int il = 0; il < 2; ++il) {
      const int lt = 32 * il + ql, t = t0 + lt;
      const bf16_t* cp = ccb + (size_t)t * 256 + g * 128 + 8 * hh;
      u32x4 cf[8];
#pragma unroll
      for (int ks = 0; ks < 8; ++ks) cf[ks] = *(const u32x4*)(cp + 16 * ks);
      const float ea = __expf(acsg[(size_t)t * 16 + h]);
      f32x16 a0, a1;
#pragma unroll
      for (int r = 0; r < 16; ++r) { a0[r] = 0.f; a1[r] = 0.f; }
#pragma unroll
      for (int ks = 0; ks < 8; ++ks) {
        a0 = __builtin_amdgcn_mfma_f32_32x32x16_bf16(*(bf16x8*)&hf0[ks], *(bf16x8*)&cf[ks], a0, 0, 0, 0);
        a1 = __builtin_amdgcn_mfma_f32_32x32x16_bf16(*(bf16x8*)&hf1[ks], *(bf16x8*)&cf[ks], a1, 0, 0, 0);
      }
      bf16_t* yr = yoff + lt * YLD + wid * 64 + 4 * hh;
#pragma unroll
      for (int rg = 0; rg < 4; ++rg) {
        u32x2 w0; w0.x = pack_bf16(ea * a0[4 * rg], ea * a0[4 * rg + 1]); w0.y = pack_bf16(ea * a0[4 * rg + 2], ea * a0[4 * rg + 3]);
        u32x2 w1; w1.x = pack_bf16(ea * a1[4 * rg], ea * a1[4 * rg + 1]); w1.y = pack_bf16(ea * a1[4 * rg + 2], ea * a1[4 * rg + 3]);
        *(u32x2*)(yr + 8 * rg) = w0;
        *(u32x2*)(yr + 32 + 8 * rg) = w1;
      }
    }
  }
  __syncthreads();
#pragma unroll
  for (int bt = 0; bt < 2; ++bt) {
    f32x4 ya[4], yb[4]; u32x4 zz[4], yo[4];
#pragma unroll
    for (int q = 0; q < 4; ++q) {
      const int lt = wid * 8 + bt * 4 + q, t = t0 + lt;
      const float* yp = ypart + (size_t)t * 1024 + g * 512 + lane * 8;
      ya[q] = __builtin_nontemporal_load((const f32x4*)yp); yb[q] = __builtin_nontemporal_load((const f32x4*)(yp + 4));
      zz[q] = __builtin_nontemporal_load((const u32x4*)(proj + (size_t)t * NPROJ + OFF_Z + g * 512 + lane * 8));
      yo[q] = *(const u32x4*)(yoff + lt * YLD + lane * 8);
    }
#pragma unroll
    for (int q = 0; q < 4; ++q) {
      const int t = t0 + wid * 8 + bt * 4 + q;
      float zv[8], ov[8], y[8];
      unpack8(zz[q], zv); unpack8(yo[q], ov);
      y[0] = (ya[q][0] + ov[0]) * silu_f(zv[0]); y[1] = (ya[q][1] + ov[1]) * silu_f(zv[1]);
      y[2] = (ya[q][2] + ov[2]) * silu_f(zv[2]); y[3] = (ya[q][3] + ov[3]) * silu_f(zv[3]);
      y[4] = (yb[q][0] + ov[4]) * silu_f(zv[4]); y[5] = (yb[q][1] + ov[5]) * silu_f(zv[5]);
      y[6] = (yb[q][2] + ov[6]) * silu_f(zv[6]); y[7] = (yb[q][3] + ov[7]) * silu_f(zv[7]);
      float ss = 0.f;
#pragma unroll
      for (int i = 0; i < 8; ++i) ss += y[i] * y[i];
      ss = wave_sum(ss);
      const float rn = rsqrtf(ss * (1.f / 512) + EPS);
      u32x4 w; w.x = pack_bf16(y[0] * rn, y[1] * rn); w.y = pack_bf16(y[2] * rn, y[3] * rn); w.z = pack_bf16(y[4] * rn, y[5] * rn); w.w = pack_bf16(y[6] * rn, y[7] * rn);
      *(u32x4*)(mixin + (size_t)t * DM + 1024 + g * 512 + lane * 8) = w;
    }
  }
  __syncthreads();
}
__device__ __forceinline__ void phase3(const Params& p, unsigned char* lds, int bid, int nblk) {
  for (int it = bid; it < 256; it += nblk) ssd_b_item(p, lds, (nblk == 256) ? ((it & 7) * 32 + (it >> 3)) : it);
}

constexpr int LDS_BYTES = 144 * 1024;

typedef const Params __attribute__((address_space(4))) * KArgPtr;
__device__ __forceinline__ Params load_params(KArgPtr k) {
  Params q;
#if defined(__HIP_DEVICE_COMPILE__)
  __builtin_memcpy(&q, k, sizeof(Params));
#endif
  return q;
}
#define PARAMS_PTR(pp) KArgPtr pp##_k = (KArgPtr)__builtin_amdgcn_kernarg_segment_ptr(); asm volatile("" : "+s"(pp##_k)); const Params pp##_v = load_params(pp##_k); const Params* pp = &pp##_v
__global__ __launch_bounds__(512, 2) void k_mega(Params p_unused) {
  extern __shared__ __attribute__((aligned(16))) unsigned char shm[];
  const int bid = blockIdx.x, nblk = gridDim.x;
  volatile LAS unsigned* xst = (volatile LAS unsigned*)(LAS unsigned char*)(shm + LDS_BYTES - 16);
  if (threadIdx.x == 0) { xst[0] = 0u; xst[1] = 0u; }
  __syncthreads();
  XcdBarrier xb;
  { PARAMS_PTR(pp); xb = xcd_barrier_post((unsigned*)(pp->ws + WS_CTL), xst); }
#ifndef REP_PHASE
#define REP_PHASE -1
#endif
#define NREP(k) ((REP_PHASE == (k)) ? 2 : 1)
#ifndef REP_ALL
#define REP_ALL 1
#endif
#pragma unroll 1
  for (int pass = 0; pass < REP_ALL; ++pass) {
  if (pass) xcd_barrier(xb);
#pragma unroll 1
  for (int rep = 0; rep < NREP(0); ++rep) { { PARAMS_PTR(pp); phase0(*pp, (float*)shm, bid, nblk); } if (rep + 1 < NREP(0)) xcd_barrier(xb); }
  xcd_barrier(xb);
#pragma unroll 1
  for (int rep = 0; rep < NREP(1); ++rep) { { PARAMS_PTR(pp); phase1(*pp, shm, bid, nblk); } xcd_barrier(xb); }
#pragma unroll 1
  for (int rep = 0; rep < NREP(2); ++rep) { { PARAMS_PTR(pp); phase2(*pp, shm, bid, nblk); } xcd_barrier(xb); }
#pragma unroll 1
  for (int rep = 0; rep < NREP(7); ++rep) { { PARAMS_PTR(pp); phase_scan(*pp, bid, nblk); } xcd_barrier(xb); }
#pragma unroll 1
  for (int rep = 0; rep < NREP(3); ++rep) { { PARAMS_PTR(pp); phase3(*pp, shm, bid, nblk); } xcd_barrier(xb); }
#pragma unroll 1
  for (int rep = 0; rep < NREP(4); ++rep) { { PARAMS_PTR(pp); phase4(*pp, shm, bid, nblk); } xcd_barrier(xb); }
#pragma unroll 1
  for (int rep = 0; rep < NREP(5); ++rep) { { PARAMS_PTR(pp); phase5(*pp, shm, bid, nblk); } xcd_barrier(xb); }
#pragma unroll 1
  for (int rep = 0; rep < NREP(6); ++rep) { { PARAMS_PTR(pp); phase6(*pp, shm, bid, nblk); } if (rep + 1 < NREP(6)) xcd_barrier(xb); }
  }
}

}

extern "C" void kernel_launch(void* const* d_in, const int* in_sizes, int n_in, void* d_out, int out_size, void* d_ws,
                              size_t ws_size, hipStream_t stream) {
  Params p{};
  p.x = (const float*)d_in[0]; p.meta = (const float*)d_in[1]; p.rel_bias = (const float*)d_in[2];
  p.ln_mix = (const float*)d_in[3]; p.w_in = (const float*)d_in[4]; p.sinks = (const float*)d_in[5];
  p.conv_w = (const float*)d_in[6]; p.conv_b = (const float*)d_in[7]; p.dt_bias = (const float*)d_in[8];
  p.a_log = (const float*)d_in[9]; p.d_skip = (const float*)d_in[10]; p.attn_norm_w = (const float*)d_in[11];
  p.ssm_norm_w = (const float*)d_in[12]; p.w_out = (const float*)d_in[13]; p.ln_ffn = (const float*)d_in[14];
  p.wq = (const float*)d_in[15]; p.keys = (const float*)d_in[16]; p.U = (const float*)d_in[17];
  p.V = (const float*)d_in[18]; p.ln_final = (const float*)d_in[19];
  p.out = (float*)d_out;
  p.ws = (unsigned char*)d_ws;

  static int grid_blocks = 0;
  if (!grid_blocks) {
    int dev = 0, cus = 0, per_cu = 0;
    (void)hipGetDevice(&dev);
    (void)hipDeviceGetAttribute(&cus, hipDeviceAttributeMultiprocessorCount, dev);
    (void)hipFuncSetAttribute((const void*)k_mega, hipFuncAttributeMaxDynamicSharedMemorySize, LDS_BYTES);
    (void)hipOccupancyMaxActiveBlocksPerMultiprocessor(&per_cu, (const void*)k_mega, NTHREADS, LDS_BYTES);
    if (per_cu > 1) per_cu = 1;
    grid_blocks = cus * per_cu;
    if (grid_blocks != 256) fprintf(stderr, "kernel_launch: expected a 256-workgroup resident grid, got %d (cus %d, per_cu %d)\n", grid_blocks, cus, per_cu);
  }
  (void)hipMemsetAsync(p.ws + WS_CTL, 0, XCD_BAR_WORDS * 4, stream);
  void* args[] = {&p};
  hipError_t e = hipLaunchCooperativeKernel((const void*)k_mega, dim3(grid_blocks), dim3(NTHREADS), args, LDS_BYTES, stream);
  if (e != hipSuccess) fprintf(stderr, "cooperative launch failed: %s (grid %d)\n", hipGetErrorString(e), grid_blocks);
}
```

```cpp
#include <hip/hip_runtime.h>
#include <math.h>
#include <stdio.h>
#include <stdint.h>

#ifndef REP_SUB
#define REP_SUB -1
#endif
namespace {
constexpr int BATCH = 4, SEQ = 2048, DM = 2048, NMETA = 16;
constexpr int T = BATCH * SEQ;
constexpr int TA = T + NMETA;
constexpr int DPROJ = 4112;
constexpr int NPROJ = 4096;
constexpr int OFF_Q = 0, OFF_K = 1024, OFF_V = 1280, OFF_Z = 1536, OFF_XBC = 2560, OFF_DT = 4096;
constexpr int D_XBC = 1536;
constexpr int NEXP = 16384;
constexpr int ROW4 = 1024;
constexpr int ROW6 = 1536;
constexpr float EPS = 1e-6f;
constexpr int NTHREADS = 512;

typedef unsigned short bf16_t;
typedef short bf16x8 __attribute__((ext_vector_type(8)));
typedef float f32x4 __attribute__((ext_vector_type(4)));
typedef float f32x2 __attribute__((ext_vector_type(2)));
typedef unsigned u32x4 __attribute__((ext_vector_type(4)));
typedef unsigned u32x2 __attribute__((ext_vector_type(2)));
typedef __bf16 bf16v2 __attribute__((ext_vector_type(2)));
typedef float f32x16v __attribute__((ext_vector_type(16)));
typedef float f32x32v __attribute__((ext_vector_type(32)));
typedef unsigned u32x6 __attribute__((ext_vector_type(6)));
#define LAS __attribute__((address_space(3)))

__device__ __forceinline__ unsigned pack_bf16(float lo, float hi) {
  f32x2 v = {lo, hi};
  bf16v2 b = __builtin_convertvector(v, bf16v2);
  return *(unsigned*)&b;
}
__device__ __forceinline__ bf16_t f2bf(float f) { return (bf16_t)(pack_bf16(f, 0.f) & 0xffffu); }
__device__ __forceinline__ float bf2f(bf16_t b) { return __uint_as_float(((unsigned)b) << 16); }
__device__ __forceinline__ float bflo(unsigned u) { return __uint_as_float(u << 16); }
__device__ __forceinline__ float bfhi(unsigned u) { return __uint_as_float(u & 0xffff0000u); }

__constant__ unsigned char kBucket[128] = {
    0, 1, 2, 3, 4, 5, 6, 7, 8, 9, 10, 11, 12, 13, 14, 15, 16, 16, 16, 17, 17, 18, 18, 18, 19, 19, 19, 20, 20, 20, 20, 21,
    21, 21, 21, 22, 22, 22, 22, 22, 23, 23, 23, 23, 23, 23, 24, 24, 24, 24, 24, 24, 25, 25, 25, 25, 25, 25, 25, 26, 26, 26, 26, 26,
    26, 26, 26, 27, 27, 27, 27, 27, 27, 27, 27, 27, 27, 28, 28, 28, 28, 28, 28, 28, 28, 28, 28, 29, 29, 29, 29, 29, 29, 29, 29, 29,
    29, 29, 29, 30, 30, 30, 30, 30, 30, 30, 30, 30, 30, 30, 30, 30, 30, 31, 31, 31, 31, 31, 31, 31, 31, 31, 31, 31, 31, 31, 31, 31};

__constant__ unsigned char kCandI[64] = {0, 0, 0, 0, 0, 0, 0, 0, 0, 0, 0, 0, 0, 0, 0, 0, 1, 1, 1, 1, 1, 1, 1, 1, 2, 2, 2, 2, 2, 3, 3, 3, 3, 4, 4, 4, 5, 5, 6, 6, 7, 7, 8, 9, 10, 11, 12, 13, 14, 15, 15, 15, 15, 15, 15, 15, 15, 15, 15, 15, 15, 15, 15, 15};
__constant__ unsigned char kCandJ[64] = {0, 1, 2, 3, 4, 5, 6, 7, 8, 9, 10, 11, 12, 13, 14, 15, 0, 1, 2, 3, 4, 5, 6, 7, 0, 1, 2, 3, 4, 0, 1, 2, 3, 0, 1, 2, 0, 1, 0, 1, 0, 1, 0, 0, 0, 0, 0, 0, 0, 0, 15, 15, 15, 15, 15, 15, 15, 15, 15, 15, 15, 15, 15, 15};

__device__ __forceinline__ float wave_sum(float v) {
  for (int o = 32; o > 0; o >>= 1) v += __shfl_xor(v, o);
  return v;
}
__device__ __forceinline__ float wave_max(float v) {
  for (int o = 32; o > 0; o >>= 1) v = fmaxf(v, __shfl_xor(v, o));
  return v;
}
__device__ __forceinline__ float silu_f(float x) { return x / (1.f + expf(-x)); }
__device__ __forceinline__ float softplus_f(float x) { return fmaxf(x, 0.f) + log1pf(expf(-fabsf(x))); }

constexpr size_t al256(size_t x) { return (x + 255) & ~(size_t)255; }
constexpr size_t WS_CTL = 0;
constexpr size_t WS_WINT = 65536;
constexpr size_t WS_WDTT = WS_WINT + (size_t)NPROJ * DM * 2;
constexpr size_t WS_WOUTT = WS_WDTT + (size_t)16 * DM * 2;
constexpr size_t WS_WQT = WS_WOUTT + (size_t)DM * DM * 2;
constexpr size_t WS_KEYS = WS_WQT + (size_t)DM * DM * 2;
constexpr size_t WS_UB = WS_KEYS + (size_t)16 * 128 * 128 * 2;
constexpr size_t WS_VB = WS_UB + (size_t)NEXP * DM * 2;
constexpr size_t WS_HNB = WS_VB + (size_t)NEXP * DM * 2;
constexpr size_t WS_PROJ = WS_HNB + (size_t)(T + 16) * DM * 2;
constexpr size_t WS_DTRAW = WS_PROJ + (size_t)T * NPROJ * 2;
constexpr size_t WS_PROJM = WS_DTRAW + (size_t)T * 16 * 4;
constexpr size_t WS_PROJMB = al256(WS_PROJM + (size_t)16 * DPROJ * 4);
constexpr size_t WS_H1B = al256(WS_PROJMB + (size_t)16 * DPROJ * 2);
constexpr size_t WS_SSQH1 = WS_H1B + (size_t)T * DM * 2;
constexpr size_t WS_STOP = al256(WS_SSQH1 + (size_t)T * 32 * 4);
constexpr size_t WS_ITOP = WS_STOP + (size_t)T * 256 * 4;
constexpr size_t WS_ACSG = al256(WS_ITOP + (size_t)T * 256 * 4);
constexpr size_t WS_CCB = WS_ACSG + (size_t)T * 16 * 4;
constexpr size_t WS_YPART = WS_CCB + (size_t)T * 256 * 2;
constexpr size_t WS_SG = WS_YPART + (size_t)T * 1024 * 4;
constexpr size_t WS_SMETA = WS_SG + (size_t)1024 * 8192 * 4;
constexpr size_t WS_HPREV = al256(WS_SMETA + (size_t)16 * 8192 * 4);
constexpr size_t WS_USC = al256(WS_HPREV + (size_t)1024 * 8192 * 2);
constexpr size_t WS_VSC = WS_USC + (size_t)NEXP * 4;
constexpr size_t WS_SCR = al256(WS_VSC + (size_t)NEXP * 4);
}

namespace pg8 {
#define PG8_LAS __attribute__((address_space(3)))
constexpr int BM = 256, BK = 64, HALF = 128, HTB = HALF * BK * 2, STAGE_BYTES = 8 * HTB, NXCD = 8, WGM = 8;
__host__ __device__ __forceinline__ int lds_byte(int r, int c) { const int st = (r >> 4) * 2 + (c >> 5), rr = r & 15, cc = c & 31, ob = rr * 64 + cc * 2; return st * 1024 + (ob ^ (((ob >> 9) & 1) << 5)); }
__host__ __device__ __forceinline__ void stage_rc(int b, int& R, int& C) { const int st = b / 1024, sb = b % 1024, swz = sb ^ (((sb >> 9) & 1) << 5); R = (st >> 1) * 16 + swz / 64; C = (st & 1) * 32 + (swz % 64) / 2; }
__host__ __device__ __forceinline__ int perm32(int rho) { const int n = rho >> 4, i = rho & 15; return 8 * (i >> 2) + 4 * n + (i & 3); }
struct Unit { int pm, pn; };
struct Gemm { const bf16_t* A; const bf16_t* Bt; int M, N, K; };
struct StaticOrder {
    int nM, nN, nwg, G, c;
    __host__ __device__ void init(int M, int N, int G_, int c_) { nM = M / BM; nN = N / BM; nwg = nM * nN; G = G_; c = c_; }
    __host__ __device__ bool next(int i, Unit& u) const {
        const long L = (long)i * G + c; if (L >= nwg) return false;
        int wgid = (int)L; { const int q = nwg / NXCD, r = nwg % NXCD, xcd = wgid % NXCD, off = wgid / NXCD; wgid = (xcd < r ? xcd * (q + 1) : r * (q + 1) + (xcd - r) * q) + off; }
        const int nig = WGM * nN, gid = wgid / nig, fm = gid * WGM, gsz = (nM - fm) < WGM ? (nM - fm) : WGM;
        u.pm = fm + ((wgid % nig) % gsz); u.pn = (wgid % nig) / gsz; return true;
    }
    __device__ __forceinline__ void a_ready(const Unit&) const {}
    __device__ __forceinline__ void done(const Unit&) const {}
};
struct EpiBf16 {
    static constexpr bool PERM = true, AFTER_DRAIN = false;
    bf16_t* O; int ldc;
    __device__ __forceinline__ void operator()(const f32x4 (&acc)[2][2][4][2], const Unit& u, int wr, int wc, int fr, int fq) const {
        const int row0 = u.pm * BM + wr * 64 + fr; const int col0 = u.pn * BM + wc * 32 + 8 * fq;
        const __amdgpu_buffer_rsrc_t rsrc = __builtin_amdgcn_make_buffer_rsrc(O, 0, 0x7fffffff, 0x00020000);
#pragma unroll
        for (int ai = 0; ai < 2; ++ai)
#pragma unroll
            for (int m = 0; m < 4; ++m) { const unsigned boff = (unsigned)(((size_t)(row0 + ai * HALF + m * 16) * ldc + col0) * 2);
#pragma unroll
                for (int bj = 0; bj < 2; ++bj) { const f32x4 v0 = acc[ai][bj][m][0], v1 = acc[ai][bj][m][1];
                    u32x4 w; w.x = pack_bf16(v0[0], v0[1]); w.y = pack_bf16(v0[2], v0[3]); w.z = pack_bf16(v1[0], v1[1]); w.w = pack_bf16(v1[2], v1[3]);
                    __builtin_amdgcn_raw_buffer_store_b128(w, rsrc, boff + bj * HALF * 2, 0, 16); } }
    }
};

struct EpiRes {
    static constexpr bool PERM = true, AFTER_DRAIN = false;
    const float* X; bf16_t* HB; float* SSQ;
    __device__ __forceinline__ void operator()(const f32x4 (&acc)[2][2][4][2], const Unit& u, int wr, int wc, int fr, int fq) const {
        const int row0 = u.pm * BM + wr * 64 + fr; const int col0 = u.pn * BM + wc * 32 + 8 * fq;
#pragma unroll
        for (int ai = 0; ai < 2; ++ai) {
            f32x4 xr[4][2][2];
#pragma unroll
            for (int m = 0; m < 4; ++m) { const size_t off = (size_t)(row0 + ai * HALF + m * 16) * DM + col0;
#pragma unroll
                for (int bj = 0; bj < 2; ++bj) { xr[m][bj][0] = __builtin_nontemporal_load((const f32x4*)(X + off + bj * HALF)); xr[m][bj][1] = __builtin_nontemporal_load((const f32x4*)(X + off + bj * HALF + 4)); } }
#pragma unroll
            for (int m = 0; m < 4; ++m) { const int row = row0 + ai * HALF + m * 16; const size_t off = (size_t)row * DM + col0; float ss = 0.f;
#pragma unroll
                for (int bj = 0; bj < 2; ++bj) {
                    const f32x4 v0 = acc[ai][bj][m][0] + xr[m][bj][0], v1 = acc[ai][bj][m][1] + xr[m][bj][1];
                    u32x4 w; w.x = pack_bf16(v0[0], v0[1]); w.y = pack_bf16(v0[2], v0[3]); w.z = pack_bf16(v1[0], v1[1]); w.w = pack_bf16(v1[2], v1[3]);
                    *(u32x4*)(HB + off + bj * HALF) = w;
                    ss += v0[0] * v0[0] + v0[1] * v0[1] + v0[2] * v0[2] + v0[3] * v0[3] + v1[0] * v1[0] + v1[1] * v1[1] + v1[2] * v1[2] + v1[3] * v1[3]; }
                ss += __shfl_xor(ss, 16); ss += __shfl_xor(ss, 32);
                if (fq == 0) SSQ[(size_t)row * 32 + u.pn * 4 + wc] = ss; }
        }
    }
};
struct EpiF32 {
    static constexpr bool PERM = true, AFTER_DRAIN = false;
    float* C; int ldc;
    __device__ __forceinline__ void operator()(const f32x4 (&acc)[2][2][4][2], const Unit& u, int wr, int wc, int fr, int fq) const {
        const int row0 = u.pm * BM + wr * 64 + fr; const int col0 = u.pn * BM + wc * 32 + 8 * fq;
#pragma unroll
        for (int ai = 0; ai < 2; ++ai)
#pragma unroll
            for (int m = 0; m < 4; ++m) { float* rowp = C + (size_t)(row0 + ai * HALF + m * 16) * ldc + col0;
#pragma unroll
                for (int bj = 0; bj < 2; ++bj) { *(f32x4*)(rowp + bj * HALF) = acc[ai][bj][m][0]; *(f32x4*)(rowp + bj * HALF + 4) = acc[ai][bj][m][1]; } }
    }
};

struct EpiScores {
    static constexpr bool PERM = true, AFTER_DRAIN = true;
    const bf16_t* KEYS;
    float* STOP; int* ITOP;
    static constexpr int QLD = 264;
    __device__ __forceinline__ void fused(f32x4 (&acc)[2][2][4][2], const Unit& u, int wr, int wc, int fr, int fq, PG8_LAS unsigned char* lds, int wid, int lane) const {
        PG8_LAS bf16_t* Q = (PG8_LAS bf16_t*)lds;
#pragma unroll
        for (int ai = 0; ai < 2; ++ai)
#pragma unroll
            for (int m = 0; m < 4; ++m) { const int row = ai * HALF + wr * 64 + m * 16 + fr;
#pragma unroll
                for (int bj = 0; bj < 2; ++bj) { const f32x4 v0 = acc[ai][bj][m][0], v1 = acc[ai][bj][m][1];
                    u32x4 w; w.x = pack_bf16(v0[0], v0[1]); w.y = pack_bf16(v0[2], v0[3]); w.z = pack_bf16(v1[0], v1[1]); w.w = pack_bf16(v1[2], v1[3]);
                    *(PG8_LAS u32x4*)(Q + row * QLD + bj * HALF + wc * 32 + 8 * fq) = w; } }
        __syncthreads();
        const int h = u.pn;
#pragma unroll 1
        for (int c = 0; c < 2; ++c) {
            f32x4 sc[8][2];
#pragma unroll
            for (int kf = 0; kf < 8; ++kf) { sc[kf][0] = (f32x4){0.f, 0.f, 0.f, 0.f}; sc[kf][1] = (f32x4){0.f, 0.f, 0.f, 0.f}; }
            const bf16_t* kb = KEYS + (size_t)((h * 2 + c) * 128 + fr) * 128 + 8 * fq;
            const PG8_LAS bf16_t* qb = Q + (wid * 32 + fr) * QLD + c * 128 + 8 * fq;
#pragma unroll
            for (int ks = 0; ks < 4; ++ks) {
                const bf16x8 q0 = *(const PG8_LAS bf16x8*)(qb + 32 * ks), q1 = *(const PG8_LAS bf16x8*)(qb + 16 * QLD + 32 * ks);
#pragma unroll
                for (int kf = 0; kf < 8; ++kf) { const bf16x8 kv = *(const bf16x8*)(kb + (size_t)kf * 16 * 128 + 32 * ks);
                    sc[kf][0] = __builtin_amdgcn_mfma_f32_16x16x32_bf16(kv, q0, sc[kf][0], 0, 0, 0);
                    sc[kf][1] = __builtin_amdgcn_mfma_f32_16x16x32_bf16(kv, q1, sc[kf][1], 0, 0, 0); }
            }
#pragma unroll
            for (int tf = 0; tf < 2; ++tf) {
                int v[32];
#pragma unroll
                for (int kf = 0; kf < 8; ++kf)
#pragma unroll
                    for (int r = 0; r < 4; ++r) {
                        const int bts = (int)__float_as_uint(sc[kf][tf][r]);
                        const int srt = bts ^ ((bts >> 31) & 0x7fffffff);
                        v[kf * 4 + r] = (srt & ~127) | (16 * kf + 4 * fq + r);
                    }
#pragma unroll
                for (int k = 2; k <= 32; k <<= 1)
#pragma unroll
                    for (int j = k >> 1; j > 0; j >>= 1)
#pragma unroll
                        for (int i = 0; i < 32; ++i) {
                            const int l = i ^ j;
                            if (l > i) {
                                const int x = v[i], y = v[l];
                                const int hi_ = x > y ? x : y, lo_ = x > y ? y : x;
                                if ((i & k) == 0) { v[i] = hi_; v[l] = lo_; } else { v[i] = lo_; v[l] = hi_; }
                            }
                        }
#pragma unroll
                for (int step = 0; step < 2; ++step) {
                    const int xm = step == 0 ? 16 : 32;
                    int m[16];
#pragma unroll
                    for (int i = 0; i < 16; ++i) { const int o = __shfl_xor(v[15 - i], xm); m[i] = v[i] > o ? v[i] : o; }
#pragma unroll
                    for (int j = 8; j > 0; j >>= 1)
#pragma unroll
                        for (int i = 0; i < 16; ++i) {
                            const int l = i ^ j;
                            if (l > i) { const int x = m[i], y = m[l]; m[i] = x > y ? x : y; m[l] = x > y ? y : x; }
                        }
#pragma unroll
                    for (int i = 0; i < 16; ++i) v[i] = m[i];
                }
                if (fq == 0) {
                    const size_t obase = ((size_t)(u.pm * BM + wid * 32 + tf * 16 + fr) * 16 + h * 2 + c) * 16;
#pragma unroll
                    for (int q4 = 0; q4 < 4; ++q4) {
                        f32x4 sv; u32x4 iv;
#pragma unroll
                        for (int i = 0; i < 4; ++i) {
                            const int key = v[4 * q4 + i], srt = key & ~127;
                            sv[i] = __uint_as_float((unsigned)(srt ^ ((srt >> 31) & 0x7fffffff)));
                            iv[i] = (unsigned)(key & 127);
                        }
                        *(f32x4*)(STOP + obase + 4 * q4) = sv;
                        *(u32x4*)(ITOP + obase + 4 * q4) = iv;
                    }
                }
            }
        }
    }
};

template <class Epi, class Sched>
__device__ __forceinline__ void gemm_phase(PG8_LAS unsigned char* lds, const Gemm g, const Sched& S, const Epi& E) {
    int tid_ = threadIdx.x; asm volatile("" : "+v"(tid_));
    const int tid = tid_, wid = __builtin_amdgcn_readfirstlane(tid >> 6), lane = tid & 63, wr = wid >> 2, wc = wid & 3, fr = lane & 15, fq = lane >> 4;
    const int K = g.K, nt = K / BK;
    unsigned voffA[2], voffB[2];
#pragma unroll
    for (int i = 0; i < 2; ++i) { int R, C; stage_rc(tid * 16 + i * 8192, R, C); const int Rb = Epi::PERM ? ((R & ~31) + perm32(R & 31)) : R;
        voffA[i] = (unsigned)(R * K + C) * 2u; voffB[i] = (unsigned)(Rb * K + C) * 2u; }
    const size_t kstep = (size_t)(BK * 2);
    const size_t hstep = (size_t)HALF * K * 2;
    const size_t tstep = 2 * hstep;
    const unsigned ldsw = (unsigned)wid * 1024u;
    const int aoff = lds_byte(wr * 64 + fr, fq * 8), boff = lds_byte(wc * 32 + fr, fq * 8);
#define PG8_SA(b, h) (((b) * 2 + (h)) * HTB)
#define PG8_SB(b, h) ((4 + (b) * 2 + (h)) * HTB)
#define PG8_STAGE(bufoff, gbase, voff) do { _Pragma("unroll") for (int _i = 0; _i < 2; ++_i) \
        __builtin_amdgcn_global_load_lds((const unsigned*)((const char*)(gbase) + (voff)[_i]), (PG8_LAS unsigned*)(lds + (bufoff) + ldsw + _i * 8192), 16, 0, 0); } while (0)
#define PG8_LDA(dst, b, h) do { _Pragma("unroll") for (int m = 0; m < 4; ++m) _Pragma("unroll") for (int k = 0; k < 2; ++k) dst[m][k] = *(const PG8_LAS bf16x8*)(lds + PG8_SA(b, h) + aoff + m * 2048 + k * 1024); } while (0)
#define PG8_LDB(dst, b, h) do { _Pragma("unroll") for (int n = 0; n < 2; ++n) _Pragma("unroll") for (int k = 0; k < 2; ++k) dst[n][k] = *(const PG8_LAS bf16x8*)(lds + PG8_SB(b, h) + boff + n * 2048 + k * 1024); } while (0)
#define PG8_MMA(ai, bj, At, Bt) do { __builtin_amdgcn_s_setprio(1); _Pragma("unroll") for (int m = 0; m < 4; ++m) _Pragma("unroll") for (int n = 0; n < 2; ++n) _Pragma("unroll") for (int k = 0; k < 2; ++k) \
        acc[ai][bj][m][n] = __builtin_amdgcn_mfma_f32_16x16x32_bf16(Bt[n][k], At[m][k], acc[ai][bj][m][n], 0, 0, 0); __builtin_amdgcn_s_setprio(0); } while (0)
#define PG8_WAIT_V(n) asm volatile("s_waitcnt vmcnt(" #n ")" ::: "memory")
#define PG8_WAIT_L(n) asm volatile("s_waitcnt lgkmcnt(" #n ")" ::: "memory")
#define PG8_BAR __builtin_amdgcn_s_barrier()
#define PG8_SCHED __builtin_amdgcn_sched_barrier(0)
    Unit cur, nxt; int ui = 0;
    if (!S.next(0, cur)) return;
    f32x4 acc[2][2][4][2];
#pragma unroll
    for (int a = 0; a < 2; ++a)
#pragma unroll
        for (int b = 0; b < 2; ++b)
#pragma unroll
            for (int m = 0; m < 4; ++m)
#pragma unroll
                for (int n = 0; n < 2; ++n) acc[a][b][m][n] = (f32x4){0.f, 0.f, 0.f, 0.f};
    bf16x8 At[4][2], B0[2][2], B1[2][2];
    const char* cA = (const char*)g.A + (size_t)cur.pm * tstep; const char* cB = (const char*)g.Bt + (size_t)cur.pn * tstep;
    S.a_ready(cur);
    PG8_STAGE(PG8_SB(0, 0), cB, voffB); PG8_STAGE(PG8_SA(0, 0), cA, voffA); PG8_STAGE(PG8_SB(0, 1), cB + hstep, voffB); PG8_STAGE(PG8_SA(0, 1), cA + hstep, voffA);
    if (wr == 1) PG8_BAR;
    PG8_WAIT_V(4); PG8_BAR;
    PG8_STAGE(PG8_SB(1, 0), cB + kstep, voffB); PG8_STAGE(PG8_SA(1, 0), cA + kstep, voffA); PG8_STAGE(PG8_SB(1, 1), cB + hstep + kstep, voffB);
    PG8_WAIT_V(6); PG8_BAR;
    for (;;) {
        const bool has_next = S.next(ui + 1, nxt);
        const char* nA = has_next ? (const char*)g.A + (size_t)nxt.pm * tstep : cA; const char* nB = has_next ? (const char*)g.Bt + (size_t)nxt.pn * tstep : cB;
        for (int t = 0; t < nt; t += 2) {
            const bool last = (t == nt - 2);
            const char* a1 = cA + (size_t)(t + 1) * kstep;
            const char* a2 = last ? nA : cA + (size_t)(t + 2) * kstep; const char* b2 = last ? nB : cB + (size_t)(t + 2) * kstep;
            const char* a3 = a2 + kstep; const char* b3 = b2 + kstep;
            if (last && has_next) S.a_ready(nxt);
            PG8_LDB(B0, 0, 0); PG8_SCHED; PG8_LDA(At, 0, 0); PG8_STAGE(PG8_SA(1, 1), a1 + hstep, voffA);
            PG8_WAIT_L(8); PG8_BAR; PG8_WAIT_L(0); PG8_MMA(0, 0, At, B0); PG8_BAR; PG8_SCHED;
            PG8_LDB(B1, 0, 1); PG8_STAGE(PG8_SB(0, 0), b2, voffB);
            PG8_BAR; PG8_WAIT_L(0); PG8_MMA(0, 1, At, B1); PG8_BAR;
            PG8_LDA(At, 0, 1); PG8_STAGE(PG8_SA(0, 0), a2, voffA);
            PG8_BAR; PG8_WAIT_L(0); PG8_MMA(1, 0, At, B0); PG8_BAR; PG8_SCHED;
            PG8_STAGE(PG8_SB(0, 1), b2 + hstep, voffB);
            PG8_WAIT_V(6); PG8_BAR; PG8_MMA(1, 1, At, B1); PG8_BAR;
            PG8_LDB(B0, 1, 0); PG8_SCHED; PG8_LDA(At, 1, 0); PG8_STAGE(PG8_SA(0, 1), a2 + hstep, voffA);
            PG8_WAIT_L(8); PG8_BAR; PG8_WAIT_L(0); PG8_MMA(0, 0, At, B0); PG8_BAR; PG8_SCHED;
            PG8_LDB(B1, 1, 1); PG8_STAGE(PG8_SB(1, 0), b3, voffB);
            PG8_BAR; PG8_WAIT_L(0); PG8_MMA(0, 1, At, B1); PG8_BAR;
            PG8_LDA(At, 1, 1); PG8_STAGE(PG8_SA(1, 0), a3, voffA);
            PG8_BAR; PG8_WAIT_L(0); PG8_MMA(1, 0, At, B0); PG8_BAR; PG8_SCHED;
            PG8_STAGE(PG8_SB(1, 1), b3 + hstep, voffB);
            PG8_WAIT_V(6); PG8_BAR; PG8_MMA(1, 1, At, B1); PG8_BAR;
        }
        if constexpr (!Epi::AFTER_DRAIN) { E(acc, cur, wr, wc, fr, fq); S.done(cur); }
        if (!has_next) break;
#pragma unroll
        for (int a = 0; a < 2; ++a)
#pragma unroll
            for (int b = 0; b < 2; ++b)
#pragma unroll
                for (int m = 0; m < 4; ++m)
#pragma unroll
                    for (int n = 0; n < 2; ++n) acc[a][b][m][n] = (f32x4){0.f, 0.f, 0.f, 0.f};
        cur = nxt; cA = nA; cB = nB; ++ui;
    }
    PG8_WAIT_V(0);
    if (wr == 0) PG8_BAR;
    PG8_BAR;
    if constexpr (Epi::AFTER_DRAIN) { E.fused(acc, cur, wr, wc, fr, fq, lds, wid, lane); S.done(cur); }
#undef PG8_SA
#undef PG8_SB
#undef PG8_STAGE
#undef PG8_LDA
#undef PG8_LDB
#undef PG8_MMA
#undef PG8_WAIT_V
#undef PG8_WAIT_L
#undef PG8_BAR
#undef PG8_SCHED
}
}

#define XB_TMO      128
#define XB_XCNT(j)  (256  + 64 * (j))
#define XB_XSUB(j)  (1280 + 64 * (j))
#define XB_XGEN(j)  (2304 + 64 * (j))
#define XB_TOP      3328
#define XB_TOPGEN   3392
#define XCD_BAR_WORDS 3456
#define XB_SPIN_CAP (1u << 22)
__device__ __forceinline__ unsigned xb_ld(unsigned* p)              { return __hip_atomic_load(p, __ATOMIC_RELAXED, __HIP_MEMORY_SCOPE_AGENT); }
__device__ __forceinline__ unsigned xb_add(unsigned* p, unsigned v) { return __hip_atomic_fetch_add(p, v, __ATOMIC_RELAXED, __HIP_MEMORY_SCOPE_AGENT); }
__device__ __forceinline__ unsigned xb_xcc_id() { return (unsigned)__builtin_amdgcn_s_getreg((3 << 11) | 20) & 0xFu; }
#define XB_SPIN(cond, bar) do { unsigned _sp = 0; while (cond) { __builtin_amdgcn_s_sleep(1); \
    if ((++_sp & 255u) == 0u) { if (xb_ld(&(bar)[XB_TMO])) break; if (_sp > XB_SPIN_CAP) { atomicAdd(&(bar)[XB_TMO], 1u); break; } } } } while (0)
struct XcdBarrier { unsigned* bar; unsigned x; volatile LAS unsigned* st; };
__device__ __forceinline__ XcdBarrier xcd_barrier_post(unsigned* bar, volatile LAS unsigned* st) {
    XcdBarrier b; b.bar = bar; b.x = xb_xcc_id(); b.st = st;
    if (threadIdx.x == 0) (void)xb_add(&bar[XB_XCNT(b.x)], 1u);
    return b;
}
__device__ __forceinline__ void xcd_barrier_complete(unsigned* bar, unsigned x, unsigned& nloc, unsigned& nx) {
    const unsigned G = gridDim.x * gridDim.y * gridDim.z;
    unsigned sum, cnt, mine, sp = 0u;
    for (;;) {
        sum = 0u; cnt = 0u; mine = 0u;
#pragma unroll
        for (unsigned j = 0; j < 16; ++j) { const unsigned c = xb_ld(&bar[XB_XCNT(j)]); sum += c; cnt += (c > 0u) ? 1u : 0u; mine = (j == x) ? c : mine; }
        if (sum == G) break;
        __builtin_amdgcn_s_sleep(1);
        if ((++sp & 255u) == 0u) { if (xb_ld(&bar[XB_TMO])) break; if (sp > XB_SPIN_CAP) { atomicAdd(&bar[XB_TMO], 1u); break; } }
    }
    nloc = mine > 0u ? mine : 1u; nx = cnt > 0u ? cnt : 1u;
}
__device__ __forceinline__ void xcd_barrier(const XcdBarrier& b) {
    asm volatile("s_waitcnt vmcnt(0)" ::: "memory");
    __syncthreads();
    if (threadIdx.x == 0) {
        unsigned* bar = b.bar;
        const unsigned bx = xb_xcc_id();
        __builtin_amdgcn_s_waitcnt(0);
        unsigned nloc = b.st[0], nx = b.st[1];
        if (nloc == 0u) { xcd_barrier_complete(bar, bx, nloc, nx); b.st[0] = nloc; b.st[1] = nx; }
        const unsigned old = xb_add(&bar[XB_XSUB(bx)], 1u);
        const unsigned gen = old / nloc;
        if (old + 1u == (gen + 1u) * nloc) {
            __builtin_amdgcn_fence(__ATOMIC_RELEASE, "agent");
            asm volatile("s_waitcnt vmcnt(0)" ::: "memory");
            const unsigned og = xb_add(&bar[XB_TOP], 1u);
            const unsigned tg = og / nx;
            if (og + 1u == (tg + 1u) * nx) xb_add(&bar[XB_TOPGEN], 1u);
            else XB_SPIN(xb_ld(&bar[XB_TOPGEN]) == tg, bar);
            __builtin_amdgcn_fence(__ATOMIC_ACQUIRE, "agent");
            xb_add(&bar[XB_XGEN(bx)], 1u);
            asm volatile("s_waitcnt vmcnt(0)" ::: "memory");
        } else {
            XB_SPIN(xb_ld(&bar[XB_XGEN(bx)]) == gen, bar);
            __builtin_amdgcn_fence(__ATOMIC_ACQUIRE, "agent");
            asm volatile("s_waitcnt vmcnt(0)" ::: "memory");
        }
    }
    __syncthreads();
}

namespace {
struct Params {
  const float *x, *meta, *rel_bias, *ln_mix, *w_in, *sinks, *conv_w, *conv_b, *dt_bias, *a_log, *d_skip, *attn_norm_w,
      *ssm_norm_w, *w_out, *ln_ffn, *wq, *keys, *U, *V, *ln_final;
  float* out;
  unsigned char* ws;
};

__device__ __forceinline__ void p0_transpose_tile(const float* __restrict__ W, int ldw, bf16_t* __restrict__ Wt, const float* sc0,
                                                  const float* sc1, int k0, int n0, float* tile) {
  const int tid = threadIdx.x;
  {
    const int r = tid >> 6, c4 = (tid & 63) * 4;
    f32x4 v[8];
#pragma unroll
    for (int i = 0; i < 8; ++i) v[i] = __builtin_nontemporal_load((const f32x4*)(W + (size_t)(k0 + r + 8 * i) * ldw + n0 + c4));
#pragma unroll
    for (int i = 0; i < 8; ++i) {
      float s = 1.f;
      const int k = k0 + r + 8 * i;
      if (sc0) s = k < 1024 ? sc0[k] : sc1[k - 1024];
      float* q = tile + (r + 8 * i) * 257 + c4;
      q[0] = v[i][0] * s; q[1] = v[i][1] * s; q[2] = v[i][2] * s; q[3] = v[i][3] * s;
    }
  }
  __syncthreads();
#pragma unroll
  for (int it = 0; it < 4; ++it) {
    const int task = it * NTHREADS + tid;
    const int n = task >> 3, kc = (task & 7) * 8;
    float v[8];
#pragma unroll
    for (int j = 0; j < 8; ++j) v[j] = tile[(kc + j) * 257 + n];
    u32x4 w; w.x = pack_bf16(v[0], v[1]); w.y = pack_bf16(v[2], v[3]); w.z = pack_bf16(v[4], v[5]); w.w = pack_bf16(v[6], v[7]);
    *(u32x4*)(Wt + (size_t)(n0 + n) * DM + k0 + kc) = w;
  }
  __syncthreads();
}

__device__ __forceinline__ void phase0(const Params& p, float* ldsf, int bid, int nblk) {
  const int tid = threadIdx.x, lane = tid & 63, wid = tid >> 6;
  bf16_t* w_inT = (bf16_t*)(p.ws + WS_WINT);
  bf16_t* w_dtT = (bf16_t*)(p.ws + WS_WDTT);
  bf16_t* w_outT = (bf16_t*)(p.ws + WS_WOUTT);
  bf16_t* wqT = (bf16_t*)(p.ws + WS_WQT);
  bf16_t* keysb = (bf16_t*)(p.ws + WS_KEYS);
  unsigned char* ub = p.ws + WS_UB;
  unsigned char* vb = p.ws + WS_VB;
  bf16_t* hnb = (bf16_t*)(p.ws + WS_HNB);
  constexpr int U_HN = (TA + 7) / 8;
  constexpr int U_WIN = 32 * 16, U_WOUT = 32 * 8, U_WQ = 32 * 8, U_WDT = 1, U_KEYS = 64;
  constexpr int B_WIN = U_HN, B_WOUT = B_WIN + U_WIN, B_WQ = B_WOUT + U_WOUT, B_WDT = B_WQ + U_WQ, B_KEYS = B_WDT + U_WDT,
                B_U = B_KEYS + U_KEYS, B_END = B_U;
  for (int u = bid; u < B_END; u += nblk) {
    if (u < B_WIN) {
      const int t = u * 8 + wid;
      if (t < TA) {
        const float* src = t < T ? p.x + (size_t)t * DM : p.meta + (size_t)(t - T) * DM;
        float4 v[8];
        float ss = 0.f;
#pragma unroll
        for (int i = 0; i < 8; ++i) {
          { const f32x4 q_ = __builtin_nontemporal_load((const f32x4*)(src + (i * 64 + lane) * 4)); v[i].x = q_[0]; v[i].y = q_[1]; v[i].z = q_[2]; v[i].w = q_[3]; }
          ss += v[i].x * v[i].x + v[i].y * v[i].y + v[i].z * v[i].z + v[i].w * v[i].w;
        }
        ss = wave_sum(ss);
        const float r = rsqrtf(ss * (1.f / DM) + EPS);
#pragma unroll
        for (int i = 0; i < 8; ++i) {
          const float4 w = *(const float4*)(p.ln_mix + (i * 64 + lane) * 4);
          u32x2 o; o.x = pack_bf16(v[i].x * r * w.x, v[i].y * r * w.y); o.y = pack_bf16(v[i].z * r * w.z, v[i].w * r * w.w);
          *(u32x2*)(hnb + (size_t)t * DM + (i * 64 + lane) * 4) = o;
        }
      }
    } else if (u < B_WOUT) {
      const int i = u - B_WIN;
      p0_transpose_tile(p.w_in, DPROJ, w_inT, nullptr, nullptr, (i & 31) * 64, (i >> 5) * 256, ldsf);
    } else if (u < B_WQ) {
      const int i = u - B_WOUT;
      p0_transpose_tile(p.w_out, DM, w_outT, p.attn_norm_w, p.ssm_norm_w, (i & 31) * 64, (i >> 5) * 256, ldsf);
    } else if (u < B_WDT) {
      const int i = u - B_WQ;
      p0_transpose_tile(p.wq, DM, wqT, p.ln_ffn, p.ln_ffn + 1024, (i & 31) * 64, (i >> 5) * 256, ldsf);
    } else if (u < B_KEYS) {
      for (int idx = tid; idx < DM * 16; idx += NTHREADS) {
        const int k = idx >> 4, j = idx & 15;
        w_dtT[(size_t)j * DM + k] = f2bf(p.w_in[(size_t)k * DPROJ + NPROJ + j]);
      }
    } else if (u < B_U) {
      const size_t base = (size_t)(u - B_KEYS) * 4096 + (size_t)tid * 8;
      const float4 a = *(const float4*)(p.keys + base), b = *(const float4*)(p.keys + base + 4);
      u32x4 w; w.x = pack_bf16(a.x, a.y); w.y = pack_bf16(a.z, a.w); w.z = pack_bf16(b.x, b.y); w.w = pack_bf16(b.z, b.w);
      *(u32x4*)(keysb + base) = w;
    }
  }
  {
    const int gw = bid * 8 + wid, nw = nblk * 8;
    auto load_row = [&](f32x4 (&a)[8], const int r2) __attribute__((always_inline)) {
      const float* src = (r2 < NEXP ? p.U + (size_t)r2 * DM : p.V + (size_t)(r2 - NEXP) * DM) + lane * 4;
#pragma unroll
      for (int j = 0; j < 8; ++j) a[j] = __builtin_nontemporal_load((const f32x4*)(src + 256 * j));
    };
    auto conv_row = [&](f32x4 (&a)[8], const int r2) __attribute__((always_inline)) {
      const bool isU = r2 < NEXP;
      const int row = isU ? r2 : r2 - NEXP;
      if (isU) {
#pragma unroll
        for (int j = 0; j < 8; ++j) a[j] *= *(const f32x4*)(p.ln_ffn + lane * 4 + 256 * j);
      }
      float amax = 0.f;
#pragma unroll
      for (int j = 0; j < 8; ++j) amax = fmaxf(amax, fmaxf(fmaxf(fabsf(a[j][0]), fabsf(a[j][1])), fmaxf(fabsf(a[j][2]), fabsf(a[j][3]))));
      amax = wave_max(amax);
      const float s4 = amax > 0.f ? 6.f / amax : 1.f;
      u32x4 w4;
#pragma unroll
      for (int j = 0; j < 4; ++j) {
        unsigned w = 0;
        w = __builtin_amdgcn_cvt_scalef32_pk_fp4_f32(w, a[2 * j][0] * s4, a[2 * j][1] * s4, 1.0f, 0);
        w = __builtin_amdgcn_cvt_scalef32_pk_fp4_f32(w, a[2 * j][2] * s4, a[2 * j][3] * s4, 1.0f, 1);
        w = __builtin_amdgcn_cvt_scalef32_pk_fp4_f32(w, a[2 * j + 1][0] * s4, a[2 * j + 1][1] * s4, 1.0f, 2);
        w = __builtin_amdgcn_cvt_scalef32_pk_fp4_f32(w, a[2 * j + 1][2] * s4, a[2 * j + 1][3] * s4, 1.0f, 3);
        w4[j] = w;
      }
      *(u32x4*)((isU ? ub : vb) + (size_t)row * ROW4 + lane * 16) = w4;
      if (lane == 0) ((float*)(p.ws + (isU ? WS_USC : WS_VSC)))[row] = amax > 0.f ? amax * (1.f / 6.f) : 1.f;
    };
    f32x4 ra[8], rb[8];
    int r2 = gw;
    if (r2 < 2 * NEXP) load_row(ra, r2);
#pragma unroll 1
    for (; r2 < 2 * NEXP; r2 += 2 * nw) {
      if (r2 + nw < 2 * NEXP) load_row(rb, r2 + nw);
      conv_row(ra, r2);
      if (r2 + nw < 2 * NEXP) {
        if (r2 + 2 * nw < 2 * NEXP) load_row(ra, r2 + 2 * nw);
        conv_row(rb, r2 + nw);
      }
    }
  }
}

__device__ __forceinline__ void mini_gemm(const bf16_t* __restrict__ A, const bf16_t* __restrict__ Bt, float* __restrict__ out, int ldo,
                                          float* red, bf16_t* __restrict__ outb = nullptr) {
  const int tid = threadIdx.x, lane = tid & 63, wid = tid >> 6, fr = lane & 15, fq = lane >> 4;
  f32x4 acc = {0.f, 0.f, 0.f, 0.f};
  const bf16_t* ap = A + (size_t)fr * DM + wid * 256 + fq * 8;
  const bf16_t* bp = Bt + (size_t)fr * DM + wid * 256 + fq * 8;
#pragma unroll
  for (int ks = 0; ks < 8; ++ks) {
    const bf16x8 a = *(const bf16x8*)(ap + ks * 32);
    const bf16x8 b = *(const bf16x8*)(bp + ks * 32);
    acc = __builtin_amdgcn_mfma_f32_16x16x32_bf16(a, b, acc, 0, 0, 0);
  }
#pragma unroll
  for (int r = 0; r < 4; ++r) red[wid * 256 + (4 * fq + r) * 16 + fr] = acc[r];
  __syncthreads();
  if (tid < 256) {
    float s = 0.f;
#pragma unroll
    for (int w = 0; w < 8; ++w) s += red[w * 256 + tid];
    out[(size_t)(tid >> 4) * ldo + (tid & 15)] = s;
    if (outb) outb[(size_t)(tid >> 4) * ldo + (tid & 15)] = f2bf(s);
  }
  __syncthreads();
}

__device__ __forceinline__ void phase1(const Params& p, unsigned char* lds, int bid, int nblk) {
  const bf16_t* hnb = (const bf16_t*)(p.ws + WS_HNB);
  const bf16_t* w_inT = (const bf16_t*)(p.ws + WS_WINT);
  const bf16_t* w_dtT = (const bf16_t*)(p.ws + WS_WDTT);
  float* dtraw = (float*)(p.ws + WS_DTRAW);
  float* projm = (float*)(p.ws + WS_PROJM);
  constexpr int NU = 512 + 32 + 96 + 1;
  for (int u = bid; u < NU; u += nblk) {
    if (u < 512) {
      mini_gemm(hnb + (size_t)u * 16 * DM, w_dtT, dtraw + (size_t)u * 16 * 16, 16, (float*)lds);
    } else {
      const int j = u - 512;
      const int cf = j < 32 ? 64 + j : (j < 128 ? 160 + (j - 32) : 256);
      const bf16_t* bt = cf < 256 ? w_inT + (size_t)cf * 16 * DM : w_dtT;
      mini_gemm(hnb + (size_t)T * DM, bt, projm + cf * 16, DPROJ, (float*)lds, (bf16_t*)(p.ws + WS_PROJMB) + cf * 16);
    }
  }
  pg8::Gemm g{hnb, w_inT, T, NPROJ, DM};
  pg8::StaticOrder S; S.init(T, NPROJ, nblk, bid);
  pg8::EpiBf16 E{(bf16_t*)(p.ws + WS_PROJ), NPROJ};
  pg8::gemm_phase<pg8::EpiBf16, pg8::StaticOrder>((PG8_LAS unsigned char*)lds, g, S, E);
}

__device__ __forceinline__ void phase4(const Params& p, unsigned char* lds, int bid, int nblk) {
  pg8::Gemm g{(const bf16_t*)(p.ws + WS_HNB), (const bf16_t*)(p.ws + WS_WOUTT), T, DM, DM};
  pg8::StaticOrder S; S.init(T, DM, nblk, bid);
  pg8::EpiRes E{p.x, (bf16_t*)(p.ws + WS_H1B), (float*)(p.ws + WS_SSQH1)};
  pg8::gemm_phase<pg8::EpiRes, pg8::StaticOrder>((PG8_LAS unsigned char*)lds, g, S, E);
}
__device__ __forceinline__ void phase5(const Params& p, unsigned char* lds, int bid, int nblk) {
  pg8::Gemm g{(const bf16_t*)(p.ws + WS_H1B), (const bf16_t*)(p.ws + WS_WQT), T, DM, DM};
  pg8::StaticOrder S; S.init(T, DM, nblk, bid);
  pg8::EpiScores E{(const bf16_t*)(p.ws + WS_KEYS), (float*)(p.ws + WS_STOP), (int*)(p.ws + WS_ITOP)};
  pg8::gemm_phase<pg8::EpiScores, pg8::StaticOrder>((PG8_LAS unsigned char*)lds, g, S, E);
}

__device__ __forceinline__ float dot2bf(unsigned a, unsigned b, float c) {
  return __builtin_amdgcn_fdot2_f32_bf16(*(bf16v2*)&a, *(bf16v2*)&b, c, false);
}
__device__ __forceinline__ void phase6(const Params& p, unsigned char* lds, int bid, int nblk) {
  const int tid0 = threadIdx.x, lane0 = tid0 & 63, wid = __builtin_amdgcn_readfirstlane(tid0 >> 6);
  int* ids = (int*)(lds + wid * 2048);
  float* gts = (float*)(lds + wid * 2048 + 512);
  float* wts = (float*)(lds + wid * 2048 + 1024);
  int* rid = (int*)(lds + 16384 + wid * 1024);
  float* rgt = (float*)(lds + 16384 + wid * 1024 + 512);
  const unsigned char* ub = p.ws + WS_UB;
  const unsigned char* vb = p.ws + WS_VB;
  const bf16_t* h1b = (const bf16_t*)(p.ws + WS_H1B);
  const float* usc = (const float*)(p.ws + WS_USC);
  const float* vsc = (const float*)(p.ws + WS_VSC);
  const float* ssq = (const float*)(p.ws + WS_SSQH1);
  const float* stop = (const float*)(p.ws + WS_STOP);
  const int* itop = (const int*)(p.ws + WS_ITOP);
  const int ci = kCandI[lane0], cj = kCandJ[lane0];
#pragma unroll 1
  for (int t = bid * 8 + wid; t < T; t += nblk * 8) {
    int tid = tid0; asm volatile("" : "+v"(tid));
    const int lane = tid & 63;
    const int kcode = 8 * ((lane >> 2) & 1) + 4 * ((lane >> 3) & 1) + 2 * ((lane >> 4) & 1) + ((lane >> 5) & 1);
    const float part0 = lane < 32 ? ssq[(size_t)t * 32 + lane] : 0.f;
    const float rr = rsqrtf(wave_sum(part0) * (1.f / DM) + EPS);
#pragma unroll 1
    for (int h = 0; h < 8; ++h) {
      const size_t lbase = ((size_t)t * 16 + h * 2) * 16;
      const float sv = lane < 32 ? __builtin_nontemporal_load(stop + lbase + lane) : 0.f;
      const int iv = lane < 32 ? __builtin_nontemporal_load(itop + lbase + lane) : 0;
      float cand = (__shfl(sv, ci) + __shfl(sv, 16 + cj)) * rr;
      if (lane >= 50) cand = -INFINITY;
      unsigned key = __float_as_uint(cand);
      key = (key & 0x80000000u) ? ~key : (key | 0x80000000u);
      key = (key & ~63u) | (unsigned)(63 - lane);
      int rank = 0;
#pragma unroll
      for (int k = 0; k < 50; ++k) {
        const unsigned kk = (unsigned)__builtin_amdgcn_readlane((int)key, k);
        rank += kk > key ? 1 : 0;
      }
      const float cmax = wave_max(cand);
      const float ex = rank < 16 ? __expf(cand - cmax) : 0.f;
      const float den = wave_sum(ex);
      const int eidx = __shfl(iv, ci) * 128 + __shfl(iv, 16 + cj);
      if (rank < 16) { rid[h * 16 + rank] = eidx; rgt[h * 16 + rank] = ex / den; }
    }
    {
      const int e0 = rid[lane], e1 = rid[lane + 64];
      const float g0 = rgt[lane], g1 = rgt[lane + 64];
      const int r0 = e0 >> 10, r1 = e1 >> 10;
      const unsigned long long ltm = (1ull << lane) - 1ull;
      int run = 0, pos0 = 0, pos1 = 0;
#pragma unroll
      for (int R = 0; R < 16; ++R) {
        const unsigned long long m0 = __ballot(r0 == R), m1 = __ballot(r1 == R);
        const int c0 = __popcll(m0), c1 = __popcll(m1);
        if (r0 == R) pos0 = run + __popcll(m0 & ltm);
        if (r1 == R) pos1 = run + c0 + __popcll(m1 & ltm);
        run += c0 + c1;
      }
      ids[pos0] = e0; gts[pos0] = g0;
      ids[pos1] = e1; gts[pos1] = g1;
    }
    float xf[32];
    {
      const bf16_t* xp = h1b + (size_t)t * DM + lane * 4;
#pragma unroll
      for (int j = 0; j < 8; ++j) {
        const u32x2 xa = *(const u32x2*)(xp + 256 * j);
        xf[4 * j + 0] = bflo(xa.x); xf[4 * j + 1] = bfhi(xa.x); xf[4 * j + 2] = bflo(xa.y); xf[4 * j + 3] = bfhi(xa.y);
      }
    }
#pragma unroll 1
    for (int rnd = 0; rnd < 8; ++rnd) {
      u32x4 ra[16];
#pragma unroll
      for (int k = 0; k < 16; ++k) {
        const int e = __builtin_amdgcn_readfirstlane(ids[rnd * 16 + k]);
        ra[k] = *(const u32x4*)(ub + (size_t)e * ROW4 + lane * 16);
      }
      float part[16];
      float prev = 0.f;
#pragma unroll
      for (int k = 0; k < 16; ++k) {
        asm volatile("" : "+v"(ra[k]) : "v"(prev));
        float d0 = 0.f, d1 = 0.f;
#define U4_STEP(j, i) { const f32x2 r = __builtin_amdgcn_cvt_scalef32_pk_f32_fp4(ra[k][j], 1.0f, i); \
          d0 = fmaf(r[0], xf[8 * (j) + 2 * (i)], d0); d1 = fmaf(r[1], xf[8 * (j) + 2 * (i) + 1], d1); }
#pragma unroll
        for (int j = 0; j < 4; ++j) { U4_STEP(j, 0) U4_STEP(j, 1) U4_STEP(j, 2) U4_STEP(j, 3) }
#undef U4_STEP
        prev = d0 + d1;
        part[k] = prev;
      }
      float q8[8], q4[4], q2[2], q1;
      { const bool hi = (lane >> 5) & 1;
#pragma unroll
        for (int i = 0; i < 8; ++i) { const float keep = hi ? part[2 * i + 1] : part[2 * i], send = hi ? part[2 * i] : part[2 * i + 1]; q8[i] = keep + __shfl_xor(send, 32); } }
      { const bool hi = (lane >> 4) & 1;
#pragma unroll
        for (int i = 0; i < 4; ++i) { const float keep = hi ? q8[2 * i + 1] : q8[2 * i], send = hi ? q8[2 * i] : q8[2 * i + 1]; q4[i] = keep + __shfl_xor(send, 16); } }
      { const bool hi = (lane >> 3) & 1;
#pragma unroll
        for (int i = 0; i < 2; ++i) { const float keep = hi ? q4[2 * i + 1] : q4[2 * i], send = hi ? q4[2 * i] : q4[2 * i + 1]; q2[i] = keep + __shfl_xor(send, 8); } }
      { const bool hi = (lane >> 2) & 1;
        const float keep = hi ? q2[1] : q2[0], send = hi ? q2[0] : q2[1]; q1 = keep + __shfl_xor(send, 4); }
      q1 += __shfl_xor(q1, 2);
      q1 += __shfl_xor(q1, 1);
      {
        const int kk = rnd * 16 + kcode;
        const int eid = ids[kk];
        const float a = q1 * rr * usc[eid];
        const float ge = 0.5f * a * (1.f + erff(a * 0.70710678118654752f));
        if ((lane & 3) == 0) wts[kk] = gts[kk] * ge * vsc[eid];
      }
    }
    float acc[32];
#pragma unroll
    for (int i = 0; i < 32; ++i) acc[i] = 0.f;
#pragma unroll 1
    for (int rnd = 0; rnd < 8; ++rnd) {
      u32x4 ra[16];
#pragma unroll
      for (int k = 0; k < 16; ++k) {
        const int e = __builtin_amdgcn_readfirstlane(ids[rnd * 16 + k]);
        ra[k] = *(const u32x4*)(vb + (size_t)e * ROW4 + lane * 16);
      }
      f32x4 wv[4];
#pragma unroll
      for (int j = 0; j < 4; ++j) wv[j] = *(const f32x4*)(wts + rnd * 16 + 4 * j);
#pragma unroll
      for (int k = 0; k < 16; ++k) {
        const float wk = wv[k >> 2][k & 3];
        asm volatile("" : "+v"(ra[k]) : "v"(acc[1]), "v"(acc[3]), "v"(acc[5]), "v"(acc[7]), "v"(acc[9]), "v"(acc[11]), "v"(acc[13]), "v"(acc[15]),
                                        "v"(acc[17]), "v"(acc[19]), "v"(acc[21]), "v"(acc[23]), "v"(acc[25]), "v"(acc[27]), "v"(acc[29]), "v"(acc[31]));
#define V4_STEP(j, i) { const f32x2 r = __builtin_amdgcn_cvt_scalef32_pk_f32_fp4(ra[k][j], 1.0f, i); \
            acc[8 * (j) + 2 * (i)] = fmaf(wk, r[0], acc[8 * (j) + 2 * (i)]); acc[8 * (j) + 2 * (i) + 1] = fmaf(wk, r[1], acc[8 * (j) + 2 * (i) + 1]); }
#pragma unroll
        for (int j = 0; j < 4; ++j) { V4_STEP(j, 0) V4_STEP(j, 1) V4_STEP(j, 2) V4_STEP(j, 3) }
#undef V4_STEP
      }
    }
    float ss = 0.f;
#pragma unroll
    for (int i = 0; i < 32; ++i) { acc[i] += xf[i]; ss += acc[i] * acc[i]; }
    ss = wave_sum(ss);
    const float rf = rsqrtf(ss * (1.f / DM) + EPS);
#pragma unroll
    for (int j = 0; j < 8; ++j) {
      const f32x4 lw = *(const f32x4*)(p.ln_final + 256 * j + lane * 4);
      const f32x4 o = {acc[4 * j] * rf * lw[0], acc[4 * j + 1] * rf * lw[1], acc[4 * j + 2] * rf * lw[2], acc[4 * j + 3] * rf * lw[3]};
      __builtin_nontemporal_store(o, (f32x4*)(p.out + (size_t)t * DM + 256 * j + lane * 4));
    }
  }
}

typedef float f32x16 __attribute__((ext_vector_type(16)));
__device__ __forceinline__ void unpack8(const u32x4 a, float (&v)[8]) {
  v[0] = bflo(a.x); v[1] = bfhi(a.x); v[2] = bflo(a.y); v[3] = bfhi(a.y); v[4] = bflo(a.z); v[5] = bfhi(a.z); v[6] = bflo(a.w); v[7] = bfhi(a.w);
}
constexpr int VT_LD = 196;
constexpr int ATT_VT_BYTES = 4 * 64 * VT_LD * 2;
__device__ __forceinline__ void attn_item(const Params& p, unsigned char* lds, int item) {
  const int tid = threadIdx.x, lane = tid & 63, wid = __builtin_amdgcn_readfirstlane(tid >> 6);
  const int b = item >> 6, q0 = (item & 63) * 32;
  bf16_t* VT = (bf16_t*)lds;
  float* biasL = (float*)(lds + ATT_VT_BYTES);
  float* ssqw = biasL + 16 * 132;
  const bf16_t* proj = (const bf16_t*)(p.ws + WS_PROJ);
  const float* projm = (const float*)(p.ws + WS_PROJM);
  bf16_t* mixin = (bf16_t*)(p.ws + WS_HNB);
#pragma unroll
  for (int it = 0; it < 5; ++it) {
    const int idx = it * NTHREADS + tid;
    if (idx >= 16 * 129) break;
    const int hq = idx / 129, d = idx - hq * 129;
    const int bk = d < 128 ? (int)kBucket[d] : 31;
    biasL[hq * 132 + d] = p.rel_bias[bk * 16 + hq];
  }
  const int ql = lane & 31, ql0 = ql, hh = lane >> 5, kvh = wid >> 1;
  const int trow = b * SEQ + q0 + ql;
  bf16x8 qf[4];
  u32x4 kf[6][4];
#define ATT_LOAD_Q(hq_)                                                                                                           \
  { _Pragma("unroll") for (int ks = 0; ks < 4; ++ks) qf[ks] = *(const bf16x8*)(proj + (size_t)trow * NPROJ + OFF_Q + (hq_) * 64 + ks * 16 + hh * 8); }
#define ATT_LOAD_K()                                                                                                              \
  {                                                                                                                               \
    int ql = ql0; asm volatile("" : "+v"(ql));     \
    const float* kr_ = projm + (size_t)(ql & 15) * DPROJ + OFF_K + kvh * 64 + hh * 8;                                             \
    _Pragma("unroll") for (int ks = 0; ks < 4; ++ks) {                                                                            \
      const f32x4 a_ = *(const f32x4*)(kr_ + ks * 16), c_ = *(const f32x4*)(kr_ + ks * 16 + 4);                                   \
      kf[0][ks].x = pack_bf16(a_[0], a_[1]); kf[0][ks].y = pack_bf16(a_[2], a_[3]); kf[0][ks].z = pack_bf16(c_[0], c_[1]); kf[0][ks].w = pack_bf16(c_[2], c_[3]); } \
    _Pragma("unroll") for (int jt = 1; jt < 6; ++jt) {                                                                            \
      int sp_ = q0 - 128 + 32 * (jt - 1) + ql; sp_ = sp_ < 0 ? 0 : sp_;                                                           \
      const bf16_t* kp_ = proj + (size_t)(b * SEQ + sp_) * NPROJ + OFF_K + kvh * 64 + hh * 8;                                     \
      _Pragma("unroll") for (int ks = 0; ks < 4; ++ks) kf[jt][ks] = *(const u32x4*)(kp_ + ks * 16); }                             \
  }
  ATT_LOAD_Q(2 * wid)
#pragma unroll 1
  for (int rep_ = 0; rep_ < (REP_SUB == 2 ? 2 : 1); ++rep_) {
    u32x4 ra[5], rc[5];
#pragma unroll
    for (int q = 0; q < 5; ++q) {
      const int task = q * NTHREADS + tid, ch = task / 80, pi = task - ch * 80;
      int s0 = q0 - 128 + 2 * pi;
      s0 = s0 < 0 ? 0 : s0;
      const bf16_t* r0 = proj + (size_t)(b * SEQ + s0) * NPROJ + OFF_V + ch * 8;
      ra[q] = *(const u32x4*)r0; rc[q] = *(const u32x4*)(r0 + NPROJ);
    }
    float m0[8], m1[8];
    {
      const int pi = tid & 7, ch = (tid >> 3) & 31;
      const float* r0 = projm + (size_t)(2 * pi) * DPROJ + OFF_V + ch * 8;
      const f32x4 ma = *(const f32x4*)r0, mb = *(const f32x4*)(r0 + 4), mc = *(const f32x4*)(r0 + DPROJ), md = *(const f32x4*)(r0 + DPROJ + 4);
      const float keep = tid < 256 ? 1.f : 0.f;
#pragma unroll
      for (int i = 0; i < 4; ++i) { m0[i] = ma[i] * keep; m0[4 + i] = mb[i] * keep; m1[i] = mc[i] * keep; m1[4 + i] = md[i] * keep; }
      bf16_t* dst = VT + (size_t)((ch >> 3) * 64 + (ch & 7) * 8) * VT_LD + 2 * pi + (tid < 256 ? 0 : 16);
#pragma unroll
      for (int i = 0; i < 8; ++i) *(unsigned*)(dst + i * VT_LD) = pack_bf16(m0[i], m1[i]);
    }
#pragma unroll
    for (int q = 0; q < 5; ++q) {
      const int task = q * NTHREADS + tid, ch = task / 80, pi = task - ch * 80;
      float v0[8], v1[8];
      unpack8(ra[q], v0); unpack8(rc[q], v1);
      bf16_t* dst = VT + (size_t)((ch >> 3) * 64 + (ch & 7) * 8) * VT_LD + 32 + 2 * pi;
#pragma unroll
      for (int i = 0; i < 8; ++i) *(unsigned*)(dst + i * VT_LD) = pack_bf16(v0[i], v1[i]);
    }
  }
  __syncthreads();
  float ssq = 0.f;
#pragma unroll 1
  for (int rep_ = 0; rep_ < (REP_SUB == 3 ? 2 : 1); ++rep_) {
  ssq = 0.f;
  auto do_head = [&](const int hsel) __attribute__((always_inline)) {
    const int hq = 2 * wid + hsel;
    f32x16 sacc[6];
#pragma unroll
    for (int jt = 0; jt < 6; ++jt) {
      f32x16 acc;
#pragma unroll
      for (int r = 0; r < 16; ++r) acc[r] = 0.f;
#pragma unroll
      for (int ks = 0; ks < 4; ++ks) acc = __builtin_amdgcn_mfma_f32_32x32x16_bf16(*(bf16x8*)&kf[jt][ks], qf[ks], acc, 0, 0, 0);
      sacc[jt] = acc;
    }
    if (hsel == 0) { ATT_LOAD_Q(2 * wid + 1) }
    const float* bl = biasL + hq * 132;
    int sq = q0 + ql, qh = ql - 4 * hh;
    asm volatile("" : "+v"(sq), "+v"(qh));
    const float sink = p.sinks[hq];
    float m = sink;
#pragma unroll
    for (int jt = 0; jt < 6; ++jt) {
      asm volatile("" ::: "memory");
#pragma unroll
      for (int r = 0; r < 16; ++r) {
        const int kr = (r & 3) + 8 * (r >> 2) + 4 * hh;
        int dist; bool valid;
        if (jt == 0) { dist = sq + (16 - ((r & 3) + 8 * (r >> 2))) - 4 * hh; valid = kr < 16; }
        else { dist = qh + (128 - 32 * (jt - 1) - ((r & 3) + 8 * (r >> 2))); valid = (dist >= 0) && (dist < 128) && (dist <= sq); }
        const int dc = dist < 0 ? 0 : (dist > 128 ? 128 : dist);
        const float l = valid ? 0.125f * sacc[jt][r] + bl[dc] : -1e30f;
        sacc[jt][r] = l;
        m = fmaxf(m, l);
      }
    }
    m = fmaxf(m, __shfl_xor(m, 32));
    float sum = 0.f;
    f32x16 oacc0, oacc1;
#pragma unroll
    for (int r = 0; r < 16; ++r) { oacc0[r] = 0.f; oacc1[r] = 0.f; }
    const bf16_t* vrow0 = VT + (size_t)(kvh * 64 + ql) * VT_LD + 4 * hh;
    const bf16_t* vrow1 = vrow0 + 32 * VT_LD;
#pragma unroll
    for (int jt = 0; jt < 6; ++jt) {
      u32x4 pw[2];
#pragma unroll
      for (int s2 = 0; s2 < 2; ++s2) {
        float e[8];
#pragma unroll
        for (int i = 0; i < 8; ++i) { e[i] = __expf(sacc[jt][8 * s2 + i] - m); sum += e[i]; }
        pw[s2].x = pack_bf16(e[0], e[1]); pw[s2].y = pack_bf16(e[2], e[3]); pw[s2].z = pack_bf16(e[4], e[5]); pw[s2].w = pack_bf16(e[6], e[7]);
      }
#pragma unroll
      for (int s2 = 0; s2 < 2; ++s2) {
        const u32x2 va = *(const u32x2*)(vrow0 + 32 * jt + 16 * s2), vc = *(const u32x2*)(vrow0 + 32 * jt + 16 * s2 + 8);
        const u32x2 vd = *(const u32x2*)(vrow1 + 32 * jt + 16 * s2), ve = *(const u32x2*)(vrow1 + 32 * jt + 16 * s2 + 8);
        u32x4 v0w; v0w.x = va.x; v0w.y = va.y; v0w.z = vc.x; v0w.w = vc.y;
        u32x4 v1w; v1w.x = vd.x; v1w.y = vd.y; v1w.z = ve.x; v1w.w = ve.y;
        oacc0 = __builtin_amdgcn_mfma_f32_32x32x16_bf16(*(bf16x8*)&v0w, *(bf16x8*)&pw[s2], oacc0, 0, 0, 0);
        oacc1 = __builtin_amdgcn_mfma_f32_32x32x16_bf16(*(bf16x8*)&v1w, *(bf16x8*)&pw[s2], oacc1, 0, 0, 0);
      }
    }
    sum += __shfl_xor(sum, 32);
    const float inv = 1.f / (sum + __expf(sink - m));
#pragma unroll
    for (int r = 0; r < 16; ++r) { oacc0[r] *= inv; oacc1[r] *= inv; ssq += oacc0[r] * oacc0[r] + oacc1[r] * oacc1[r]; }
#pragma unroll
    for (int rg = 0; rg < 4; ++rg) {
      u32x2 w; w.x = pack_bf16(oacc0[rg * 4 + 0], oacc0[rg * 4 + 1]); w.y = pack_bf16(oacc0[rg * 4 + 2], oacc0[rg * 4 + 3]);
      *(u32x2*)(mixin + (size_t)trow * DM + hq * 64 + 8 * rg + 4 * hh) = w;
      u32x2 w1; w1.x = pack_bf16(oacc1[rg * 4 + 0], oacc1[rg * 4 + 1]); w1.y = pack_bf16(oacc1[rg * 4 + 2], oacc1[rg * 4 + 3]);
      *(u32x2*)(mixin + (size_t)trow * DM + hq * 64 + 32 + 8 * rg + 4 * hh) = w1;
    }
  };
  ATT_LOAD_K()
  do_head(0);
  asm volatile("" ::: "memory");
  ATT_LOAD_K()
  do_head(1);
  }
  ssq += __shfl_xor(ssq, 32);
  if (lane < 32) ssqw[wid * 32 + lane] = ssq;
  __syncthreads();
  float tot = 0.f;
#pragma unroll
  for (int w = 0; w < 8; ++w) tot += ssqw[w * 32 + ql];
  const float ra = rsqrtf(tot * (1.f / 1024) + EPS);
#pragma unroll
  for (int hsel = 0; hsel < 2; ++hsel)
#pragma unroll
    for (int dt = 0; dt < 2; ++dt)
#pragma unroll
      for (int rg = 0; rg < 4; ++rg) {
        bf16_t* op = mixin + (size_t)trow * DM + (2 * wid + hsel) * 64 + 32 * dt + 8 * rg + 4 * hh;
        const u32x2 v = *(const u32x2*)op;
        u32x2 w; w.x = pack_bf16(bflo(v.x) * ra, bfhi(v.x) * ra); w.y = pack_bf16(bflo(v.y) * ra, bfhi(v.y) * ra);
        *(u32x2*)op = w;
      }
  __syncthreads();
}
#undef ATT_LOAD_Q
#undef ATT_LOAD_K
__device__ __forceinline__ void phase2_attn(const Params& p, unsigned char* lds, int bid, int nblk) {
  for (int item = bid; item < 256; item += nblk) attn_item(p, lds, item);
}

constexpr int SLD = 136;
__device__ __forceinline__ float conv_silu(const float (&raw)[11], int i, float w0, float w1, float w2, float w3, float cb) {
  return silu_f(cb + w0 * raw[i] + w1 * raw[i + 1] + w2 * raw[i + 2] + w3 * raw[i + 3]);
}
__device__ __forceinline__ void ssd_a_item(const Params& p, unsigned char* lds, int item) {
  const int tid = threadIdx.x, lane = tid & 63, wid = __builtin_amdgcn_readfirstlane(tid >> 6);
  const int b = item >> 6, c = (item >> 2) & 15, g = (item >> 1) & 1, hsel = item & 1;
  const int h0 = g * 8 + hsel * 4;
  const int t0 = b * SEQ + c * 128;
  bf16_t* Bc = (bf16_t*)lds;
  bf16_t* Cc = Bc + 128 * SLD;
  bf16_t* BcT = Cc + 128 * SLD;
  bf16_t* xT = BcT + 128 * SLD;
  float* dtl = (float*)(xT + 2 * 64 * SLD);
  float* acs = dtl + 512;
  float* wl = acs + 512;
  float* scan = wl + 512;
  const bf16_t* __restrict__ proj = (const bf16_t*)(p.ws + WS_PROJ);
  const bf16_t* __restrict__ projmb = (const bf16_t*)(p.ws + WS_PROJMB);
  const float* __restrict__ dtraw = (const float*)(p.ws + WS_DTRAW);
  float* __restrict__ acsg = (float*)(p.ws + WS_ACSG);
  bf16_t* __restrict__ ccb = (bf16_t*)(p.ws + WS_CCB);
  bf16_t* __restrict__ ypart = (bf16_t*)(p.ws + WS_YPART);
  float* __restrict__ sg = (float*)(p.ws + WS_SG);
  {
    const int hi = tid >> 7, l = tid & 127, h = h0 + hi;
    const float Ah = -expf(p.a_log[h]);
    const float dtv = softplus_f(dtraw[(size_t)(t0 + l) * 16 + h] + p.dt_bias[h]);
    dtl[tid] = dtv;
    float cum = dtv * Ah;
#pragma unroll
    for (int o = 1; o < 64; o <<= 1) { const float nb = __shfl_up(cum, o); if (lane >= o) cum += nb; }
    if ((tid & 127) == 63) scan[hi] = cum;
    __syncthreads();
    if (l >= 64) cum += scan[hi];
    acs[tid] = cum;
    acsg[(size_t)(t0 + l) * 16 + h] = cum;
    __syncthreads();
    wl[tid] = dtv * __expf(acs[hi * 128 + 127] - cum);
  }
  {
    unsigned raw[4][11];
#pragma unroll
    for (int q = 0; q < 4; ++q) {
      const int task = q * NTHREADS + tid;
      const int tg = task >> 7, cp = task & 127;
      const int cch = 1024 + (cp >> 6) * 256 + g * 128 + 2 * (cp & 63);
#pragma unroll
      for (int i = 0; i < 11; ++i) {
        const int l = tg * 8 + i - 3;
        const bf16_t* src = (l >= 0 || c > 0) ? proj + (size_t)(t0 + l) * NPROJ : projmb + (size_t)(16 + l) * DPROJ;
        raw[q][i] = *(const unsigned*)(src + OFF_XBC + cch);
      }
    }
#pragma unroll
    for (int q = 0; q < 4; ++q) {
      const int task = q * NTHREADS + tid;
      const int tg = task >> 7, cp = task & 127, n = 2 * (cp & 63);
      const int cch = 1024 + (cp >> 6) * 256 + g * 128 + n;
      float o0[8], o1[8];
      {
        float r0[11], r1[11];
#pragma unroll
        for (int i = 0; i < 11; ++i) { r0[i] = bflo(raw[q][i]); r1[i] = bfhi(raw[q][i]); }
        const float w0 = p.conv_w[cch], w1 = p.conv_w[D_XBC + cch], w2 = p.conv_w[2 * D_XBC + cch], w3 = p.conv_w[3 * D_XBC + cch], cb = p.conv_b[cch];
        const float v0 = p.conv_w[cch + 1], v1 = p.conv_w[D_XBC + cch + 1], v2 = p.conv_w[2 * D_XBC + cch + 1], v3 = p.conv_w[3 * D_XBC + cch + 1], vb_ = p.conv_b[cch + 1];
#pragma unroll
        for (int i = 0; i < 8; ++i) { o0[i] = conv_silu(r0, i, w0, w1, w2, w3, cb); o1[i] = conv_silu(r1, i, v0, v1, v2, v3, vb_); }
      }
      bf16_t* rowm = (cp < 64 ? Bc : Cc) + (tg * 8) * SLD + n;
#pragma unroll
      for (int i = 0; i < 8; ++i) *(unsigned*)(rowm + i * SLD) = pack_bf16(o0[i], o1[i]);
      if (cp < 64) {
        u32x4 w; w.x = pack_bf16(o0[0], o0[1]); w.y = pack_bf16(o0[2], o0[3]); w.z = pack_bf16(o0[4], o0[5]); w.w = pack_bf16(o0[6], o0[7]);
        *(u32x4*)(BcT + n * SLD + tg * 8) = w;
        u32x4 w2_; w2_.x = pack_bf16(o1[0], o1[1]); w2_.y = pack_bf16(o1[2], o1[3]); w2_.z = pack_bf16(o1[4], o1[5]); w2_.w = pack_bf16(o1[6], o1[7]);
        *(u32x4*)(BcT + (n + 1) * SLD + tg * 8) = w2_;
      }
    }
  }
  float xraw[4][11];
#define SSD_LOAD_X(r_)                                                                                              \
  _Pragma("unroll") for (int q = 0; q < 4; ++q) {                                                                   \
    const int task = (q & 1) * NTHREADS + tid; const int tg = task >> 6, cch = (h0 + 2 * (r_) + (q >> 1)) * 64 + (task & 63); \
    _Pragma("unroll") for (int i = 0; i < 11; ++i) { const int l = tg * 8 + i - 3;                                  \
      const bf16_t* src = (l >= 0 || c > 0) ? proj + (size_t)(t0 + l) * NPROJ : projmb + (size_t)(16 + l) * DPROJ;  \
      xraw[q][i] = bf2f(src[OFF_XBC + cch]); } }
  SSD_LOAD_X(0)
  __syncthreads();
  if (hsel == 0) {
#pragma unroll
    for (int q = 0; q < 4; ++q) {
      const int idx = q * NTHREADS + tid, row = idx >> 4, ck = idx & 15;
      *(u32x4*)(ccb + (size_t)(t0 + row) * 256 + g * 128 + ck * 8) = *(const u32x4*)(Cc + row * SLD + ck * 8);
    }
  }
  const int ql = lane & 31, hh = lane >> 5;
  auto ydiag = [&](const int hi, const int il) __attribute__((always_inline)) {
    const int h = h0 + hi, ip = wid & 1;
    const bf16_t* xTb = xT + (hi & 1) * 64 * SLD;
    const float dskip = p.d_skip[h];
    const float* acsh = acs + hi * 128;
    const float* dtlh = dtl + hi * 128;
    const int l = 32 * il + ql;
    const float acl = acsh[l];
    f32x16 yacc;
#pragma unroll
    for (int r = 0; r < 16; ++r) yacc[r] = 0.f;
    const bf16_t* xrow = xTb + (32 * ip + ql) * SLD + 4 * hh;
#pragma unroll 1
    for (int is = 0; is <= il; ++is) {
      f32x16 x;
#pragma unroll
      for (int r = 0; r < 16; ++r) x[r] = 0.f;
      const bf16_t* ap = Bc + (32 * is + ql) * SLD + 8 * hh;
      const bf16_t* bp = Cc + l * SLD + 8 * hh;
#pragma unroll
      for (int ks = 0; ks < 8; ++ks) x = __builtin_amdgcn_mfma_f32_32x32x16_bf16(*(const bf16x8*)(ap + 16 * ks), *(const bf16x8*)(bp + 16 * ks), x, 0, 0, 0);
      u32x4 pw[2];
#pragma unroll
      for (int s2 = 0; s2 < 2; ++s2) {
        float mv[8];
#pragma unroll
        for (int q = 0; q < 2; ++q) {
          const int sb = 32 * is + 16 * s2 + 8 * q + 4 * hh;
          const f32x4 as4 = *(const f32x4*)(acsh + sb), dt4 = *(const f32x4*)(dtlh + sb);
#pragma unroll
          for (int j = 0; j < 4; ++j) {
            const int sr = sb + j;
            float v = sr <= l ? x[8 * s2 + 4 * q + j] * __expf(acl - as4[j]) * dt4[j] : 0.f;
            if (sr == l) v += dskip;
            mv[4 * q + j] = v;
          }
        }
        pw[s2].x = pack_bf16(mv[0], mv[1]); pw[s2].y = pack_bf16(mv[2], mv[3]); pw[s2].z = pack_bf16(mv[4], mv[5]); pw[s2].w = pack_bf16(mv[6], mv[7]);
      }
#pragma unroll
      for (int s2 = 0; s2 < 2; ++s2) {
        const u32x2 va = *(const u32x2*)(xrow + 32 * is + 16 * s2), vc = *(const u32x2*)(xrow + 32 * is + 16 * s2 + 8);
        u32x4 aw; aw.x = va.x; aw.y = va.y; aw.z = vc.x; aw.w = vc.y;
        yacc = __builtin_amdgcn_mfma_f32_32x32x16_bf16(*(bf16x8*)&aw, *(bf16x8*)&pw[s2], yacc, 0, 0, 0);
      }
    }
    bf16_t* yp = ypart + (size_t)(t0 + l) * 1024 + h * 64 + 32 * ip + 4 * hh;
#pragma unroll
    for (int rg = 0; rg < 4; ++rg) { u32x2 w; w.x = pack_bf16(yacc[4 * rg], yacc[4 * rg + 1]); w.y = pack_bf16(yacc[4 * rg + 2], yacc[4 * rg + 3]); *(u32x2*)(yp + 8 * rg) = w; }
  };
  auto states = [&](const int hi) __attribute__((always_inline)) {
    const int h = h0 + hi, ip = wid & 1, in = wid >> 1;
    const bf16_t* xTb = xT + (hi & 1) * 64 * SLD;
    const float* wlh = wl + hi * 128;
    f32x16 sacc;
#pragma unroll
    for (int r = 0; r < 16; ++r) sacc[r] = 0.f;
    const bf16_t* ap = xTb + (32 * ip + ql) * SLD + 8 * hh;
    const bf16_t* bp = BcT + (32 * in + ql) * SLD + 8 * hh;
#pragma unroll
    for (int ks = 0; ks < 8; ++ks) {
      const u32x4 xa = *(const u32x4*)(ap + 16 * ks);
      const f32x4 wa = *(const f32x4*)(wlh + 16 * ks + 8 * hh), wb = *(const f32x4*)(wlh + 16 * ks + 8 * hh + 4);
      u32x4 aw;
      aw.x = pack_bf16(bflo(xa.x) * wa[0], bfhi(xa.x) * wa[1]); aw.y = pack_bf16(bflo(xa.y) * wa[2], bfhi(xa.y) * wa[3]);
      aw.z = pack_bf16(bflo(xa.z) * wb[0], bfhi(xa.z) * wb[1]); aw.w = pack_bf16(bflo(xa.w) * wb[2], bfhi(xa.w) * wb[3]);
      sacc = __builtin_amdgcn_mfma_f32_32x32x16_bf16(*(bf16x8*)&aw, *(const bf16x8*)(bp + 16 * ks), sacc, 0, 0, 0);
    }
    float* sp = sg + ((size_t)((b * 16 + c) * 16 + h) * 64 + 32 * ip + 4 * hh) * 128 + 32 * in + ql;
#pragma unroll
    for (int r = 0; r < 16; ++r) sp[((r & 3) + 8 * (r >> 2)) * 128] = sacc[r];
  };
#pragma unroll 1
  for (int rnd_ = 0; rnd_ < (REP_SUB == 5 ? 4 : 2); ++rnd_) {
    const int rnd = rnd_ & 1;
#pragma unroll
    for (int q = 0; q < 4; ++q) {
      const int task = (q & 1) * NTHREADS + tid; const int tg = task >> 6, pch = task & 63, cch = (h0 + 2 * rnd + (q >> 1)) * 64 + pch;
      const float w0 = p.conv_w[cch], w1 = p.conv_w[D_XBC + cch], w2 = p.conv_w[2 * D_XBC + cch], w3 = p.conv_w[3 * D_XBC + cch], cb = p.conv_b[cch];
      float o[8];
#pragma unroll
      for (int i = 0; i < 8; ++i) o[i] = conv_silu(xraw[q], i, w0, w1, w2, w3, cb);
      u32x4 w; w.x = pack_bf16(o[0], o[1]); w.y = pack_bf16(o[2], o[3]); w.z = pack_bf16(o[4], o[5]); w.w = pack_bf16(o[6], o[7]);
      *(u32x4*)(xT + (q >> 1) * 64 * SLD + pch * SLD + tg * 8) = w;
    }
    { SSD_LOAD_X((rnd + 1) & 1) }
    __syncthreads();
    ydiag(2 * rnd, wid >> 1);
    ydiag(2 * rnd + 1, 3 - (wid >> 1));
    states(2 * rnd);
    states(2 * rnd + 1);
    __syncthreads();
  }
#undef SSD_LOAD_X
  __syncthreads();
}

__device__ __forceinline__ void meta_state_item(const Params& p, unsigned char* lds, int h) {
  const int tid = threadIdx.x, g = h >> 3;
  float* xm = (float*)lds;
  float* bm = xm + 16 * 64;
  float* dtm = bm + 16 * 128;
  const float* projm = (const float*)(p.ws + WS_PROJM);
  float* smeta = (float*)(p.ws + WS_SMETA);
  for (int task = tid; task < 16 * 192; task += NTHREADS) {
    const int i = task / 192, ch = task - i * 192;
    const int cch = ch < 64 ? h * 64 + ch : 1024 + g * 128 + (ch - 64);
    float acc = p.conv_b[cch];
#pragma unroll
    for (int j = 0; j < 4; ++j) { const int mi = i - j; if (mi >= 0) acc += p.conv_w[(3 - j) * D_XBC + cch] * projm[(size_t)mi * DPROJ + OFF_XBC + cch]; }
    const float v = silu_f(acc);
    if (ch < 64) xm[i * 64 + ch] = v; else bm[i * 128 + ch - 64] = v;
  }
  if (tid < 16) dtm[tid] = softplus_f(projm[(size_t)tid * DPROJ + OFF_DT + h] + p.dt_bias[h]);
  __syncthreads();
  const float Ah = -expf(p.a_log[h]);
  const int pr = tid >> 3, n0 = (tid & 7) * 16;
  float st[16];
#pragma unroll
  for (int k = 0; k < 16; ++k) st[k] = 0.f;
  for (int i = 0; i < 16; ++i) {
    const float dtv = dtm[i], dA = expf(dtv * Ah), xdt = xm[i * 64 + pr] * dtv;
#pragma unroll
    for (int k = 0; k < 16; ++k) st[k] = fmaf(st[k], dA, xdt * bm[i * 128 + n0 + k]);
  }
#pragma unroll
  for (int k = 0; k < 16; ++k) smeta[(size_t)(h * 64 + pr) * 128 + n0 + k] = st[k];
  __syncthreads();
}

__device__ __forceinline__ void phase2(const Params& p, unsigned char* lds, int bid, int nblk) {
  const bool remap = (nblk == 256);
#pragma unroll 1
  for (int rep = 0; rep < (REP_SUB == 0 ? 2 : 1); ++rep)
    for (int it = bid; it < 256; it += nblk) attn_item(p, lds, remap ? ((it & 7) * 32 + (it >> 3)) : it);
#pragma unroll 1
  for (int rep = 0; rep < (REP_SUB == 1 ? 2 : 1); ++rep)
    for (int it = bid; it < 256; it += nblk) ssd_a_item(p, lds, remap ? ((it & 7) * 32 + (it >> 3)) : it);
  for (int item = bid; item < 16; item += nblk) meta_state_item(p, lds, item);
}

__device__ __forceinline__ void phase_scan(const Params& p, int bid, int nblk) {
  const float* __restrict__ sg = (const float*)(p.ws + WS_SG);
  const float* __restrict__ smeta = (const float*)(p.ws + WS_SMETA);
  const float* __restrict__ acsg = (const float*)(p.ws + WS_ACSG);
  bf16_t* __restrict__ hprev = (bf16_t*)(p.ws + WS_HPREV);
  for (int task = bid * NTHREADS + threadIdx.x; task < 64 * 2048; task += nblk * NTHREADS) {
    const int bh = task >> 11, e4 = (task & 2047) * 4;
    const int b = bh >> 4, h = bh & 15;
    f32x4 sv[16];
    float dv[16];
#pragma unroll
    for (int c = 0; c < 16; ++c) {
      sv[c] = *(const f32x4*)(sg + (size_t)((b * 16 + c) * 16 + h) * 8192 + e4);
      dv[c] = acsg[(size_t)(b * SEQ + c * 128 + 127) * 16 + h];
    }
    f32x4 H = *(const f32x4*)(smeta + (size_t)h * 8192 + e4);
#pragma unroll
    for (int c = 0; c < 16; ++c) {
      u32x2 w; w.x = pack_bf16(H[0], H[1]); w.y = pack_bf16(H[2], H[3]);
      *(u32x2*)(hprev + (size_t)((b * 16 + c) * 16 + h) * 8192 + e4) = w;
      H = H * __expf(dv[c]) + sv[c];
    }
  }
}

__device__ __forceinline__ void ssd_b_item(const Params& p, unsigned char* lds, int item) {
  const int tid = threadIdx.x, lane = tid & 63, wid = __builtin_amdgcn_readfirstlane(tid >> 6);
  const int b = item >> 6, c = (item >> 2) & 15, g = (item >> 1) & 1, lh = item & 1, h = g * 8 + wid;
  const int t0 = b * SEQ + c * 128 + lh * 64;
  const int ql = lane & 31, hh = lane >> 5;
  constexpr int YLD = 520;
  bf16_t* yoff = (bf16_t*)lds;
  const bf16_t* __restrict__ proj = (const bf16_t*)(p.ws + WS_PROJ);
  const float* __restrict__ acsg = (const float*)(p.ws + WS_ACSG);
  const bf16_t* __restrict__ ccb = (const bf16_t*)(p.ws + WS_CCB);
  const bf16_t* __restrict__ ypart = (const bf16_t*)(p.ws + WS_YPART);
  const bf16_t* __restrict__ hprev = (const bf16_t*)(p.ws + WS_HPREV);
  bf16_t* __restrict__ mixin = (bf16_t*)(p.ws + WS_HNB);
  {
    const bf16_t* hp = hprev + (size_t)((b * 16 + c) * 16 + h) * 8192 + (size_t)ql * 128 + 8 * hh;
    u32x4 hf0[8], hf1[8];
#pragma unroll
    for (int ks = 0; ks < 8; ++ks) { hf0[ks] = *(const u32x4*)(hp + 16 * ks); hf1[ks] = *(const u32x4*)(hp + 32 * 128 + 16 * ks); }
#pragma unroll
    for (int il = 0; il < 2; ++il) {
      const int lt = 32 * il + ql, t = t0 + lt;
      const bf16_t* cp = ccb + (size_t)t * 256 + g * 128 + 8 * hh;
      u32x4 cf[8];
#pragma unroll
      for (int ks = 0; ks < 8; ++ks) cf[ks] = *(const u32x4*)(cp + 16 * ks);
      const float ea = __expf(acsg[(size_t)t * 16 + h]);
      f32x16 a0, a1;
#pragma unroll
      for (int r = 0; r < 16; ++r) { a0[r] = 0.f; a1[r] = 0.f; }
#pragma unroll
      for (int ks = 0; ks < 8; ++ks) {
        a0 = __builtin_amdgcn_mfma_f32_32x32x16_bf16(*(bf16x8*)&hf0[ks], *(bf16x8*)&cf[ks], a0, 0, 0, 0);
        a1 = __builtin_amdgcn_mfma_f32_32x32x16_bf16(*(bf16x8*)&hf1[ks], *(bf16x8*)&cf[ks], a1, 0, 0, 0);
      }
      bf16_t* yr = yoff + lt * YLD + wid * 64 + 4 * hh;
#pragma unroll
      for (int rg = 0; rg < 4; ++rg) {
        u32x2 w0; w0.x = pack_bf16(ea * a0[4 * rg], ea * a0[4 * rg + 1]); w0.y = pack_bf16(ea * a0[4 * rg + 2], ea * a0[4 * rg + 3]);
        u32x2 w1; w1.x = pack_bf16(ea * a1[4 * rg], ea * a1[4 * rg + 1]); w1.y = pack_bf16(ea * a1[4 * rg + 2], ea * a1[4 * rg + 3]);
        *(u32x2*)(yr + 8 * rg) = w0;
        *(u32x2*)(yr + 32 + 8 * rg) = w1;
      }
    }
  }
  __syncthreads();
#pragma unroll
  for (int bt = 0; bt < 2; ++bt) {
    u32x4 yy[4], zz[4], yo[4];
#pragma unroll
    for (int q = 0; q < 4; ++q) {
      const int lt = wid * 8 + bt * 4 + q, t = t0 + lt;
      yy[q] = __builtin_nontemporal_load((const u32x4*)(ypart + (size_t)t * 1024 + g * 512 + lane * 8));
      zz[q] = __builtin_nontemporal_load((const u32x4*)(proj + (size_t)t * NPROJ + OFF_Z + g * 512 + lane * 8));
      yo[q] = *(const u32x4*)(yoff + lt * YLD + lane * 8);
    }
#pragma unroll
    for (int q = 0; q < 4; ++q) {
      const int t = t0 + wid * 8 + bt * 4 + q;
      float zv[8], ov[8], yv[8], y[8];
      unpack8(zz[q], zv); unpack8(yo[q], ov); unpack8(yy[q], yv);
#pragma unroll
      for (int i = 0; i < 8; ++i) y[i] = (yv[i] + ov[i]) * silu_f(zv[i]);
      float ss = 0.f;
#pragma unroll
      for (int i = 0; i < 8; ++i) ss += y[i] * y[i];
      ss = wave_sum(ss);
      const float rn = rsqrtf(ss * (1.f / 512) + EPS);
      u32x4 w; w.x = pack_bf16(y[0] * rn, y[1] * rn); w.y = pack_bf16(y[2] * rn, y[3] * rn); w.z = pack_bf16(y[4] * rn, y[5] * rn); w.w = pack_bf16(y[6] * rn, y[7] * rn);
      *(u32x4*)(mixin + (size_t)t * DM + 1024 + g * 512 + lane * 8) = w;
    }
  }
  __syncthreads();
}
__device__ __forceinline__ void phase3(const Params& p, unsigned char* lds, int bid, int nblk) {
  for (int it = bid; it < 256; it += nblk) ssd_b_item(p, lds, (nblk == 256) ? ((it & 7) * 32 + (it >> 3)) : it);
}

constexpr int LDS_BYTES = 144 * 1024;

typedef const Params __attribute__((address_space(4))) * KArgPtr;
__device__ __forceinline__ Params load_params(KArgPtr k) {
  Params q;
#if defined(__HIP_DEVICE_COMPILE__)
  __builtin_memcpy(&q, k, sizeof(Params));
#endif
  return q;
}
#define PARAMS_PTR(pp) KArgPtr pp##_k = (KArgPtr)__builtin_amdgcn_kernarg_segment_ptr(); asm volatile("" : "+s"(pp##_k)); const Params pp##_v = load_params(pp##_k); const Params* pp = &pp##_v
__global__ __launch_bounds__(512, 2) void k_mega(Params p_unused) {
  extern __shared__ __attribute__((aligned(16))) unsigned char shm[];
  const int bid = blockIdx.x, nblk = gridDim.x;
  volatile LAS unsigned* xst = (volatile LAS unsigned*)(LAS unsigned char*)(shm + LDS_BYTES - 16);
  if (threadIdx.x == 0) { xst[0] = 0u; xst[1] = 0u; }
  __syncthreads();
  XcdBarrier xb;
  { PARAMS_PTR(pp); xb = xcd_barrier_post((unsigned*)(pp->ws + WS_CTL), xst); }
#ifndef REP_PHASE
#define REP_PHASE -1
#endif
#define NREP(k) ((REP_PHASE == (k)) ? 2 : 1)
#ifndef REP_ALL
#define REP_ALL 1
#endif
#pragma unroll 1
  for (int pass = 0; pass < REP_ALL; ++pass) {
  if (pass) xcd_barrier(xb);
#pragma unroll 1
  for (int rep = 0; rep < NREP(0); ++rep) { { PARAMS_PTR(pp); phase0(*pp, (float*)shm, bid, nblk); } if (rep + 1 < NREP(0)) xcd_barrier(xb); }
  xcd_barrier(xb);
#pragma unroll 1
  for (int rep = 0; rep < NREP(1); ++rep) { { PARAMS_PTR(pp); phase1(*pp, shm, bid, nblk); } xcd_barrier(xb); }
#pragma unroll 1
  for (int rep = 0; rep < NREP(2); ++rep) { { PARAMS_PTR(pp); phase2(*pp, shm, bid, nblk); } xcd_barrier(xb); }
#pragma unroll 1
  for (int rep = 0; rep < NREP(7); ++rep) { { PARAMS_PTR(pp); phase_scan(*pp, bid, nblk); } xcd_barrier(xb); }
#pragma unroll 1
  for (int rep = 0; rep < NREP(3); ++rep) { { PARAMS_PTR(pp); phase3(*pp, shm, bid, nblk); } xcd_barrier(xb); }
#pragma unroll 1
  for (int rep = 0; rep < NREP(4); ++rep) { { PARAMS_PTR(pp); phase4(*pp, shm, bid, nblk); } xcd_barrier(xb); }
#pragma unroll 1
  for (int rep = 0; rep < NREP(5); ++rep) { { PARAMS_PTR(pp); phase5(*pp, shm, bid, nblk); } xcd_barrier(xb); }
#pragma unroll 1
  for (int rep = 0; rep < NREP(6); ++rep) { { PARAMS_PTR(pp); phase6(*pp, shm, bid, nblk); } if (rep + 1 < NREP(6)) xcd_barrier(xb); }
  }
}

}

extern "C" void kernel_launch(void* const* d_in, const int* in_sizes, int n_in, void* d_out, int out_size, void* d_ws,
                              size_t ws_size, hipStream_t stream) {
  Params p{};
  p.x = (const float*)d_in[0]; p.meta = (const float*)d_in[1]; p.rel_bias = (const float*)d_in[2];
  p.ln_mix = (const float*)d_in[3]; p.w_in = (const float*)d_in[4]; p.sinks = (const float*)d_in[5];
  p.conv_w = (const float*)d_in[6]; p.conv_b = (const float*)d_in[7]; p.dt_bias = (const float*)d_in[8];
  p.a_log = (const float*)d_in[9]; p.d_skip = (const float*)d_in[10]; p.attn_norm_w = (const float*)d_in[11];
  p.ssm_norm_w = (const float*)d_in[12]; p.w_out = (const float*)d_in[13]; p.ln_ffn = (const float*)d_in[14];
  p.wq = (const float*)d_in[15]; p.keys = (const float*)d_in[16]; p.U = (const float*)d_in[17];
  p.V = (const float*)d_in[18]; p.ln_final = (const float*)d_in[19];
  p.out = (float*)d_out;
  p.ws = (unsigned char*)d_ws;

  static int grid_blocks = 0;
  if (!grid_blocks) {
    int dev = 0, cus = 0, per_cu = 0;
    (void)hipGetDevice(&dev);
    (void)hipDeviceGetAttribute(&cus, hipDeviceAttributeMultiprocessorCount, dev);
    (void)hipFuncSetAttribute((const void*)k_mega, hipFuncAttributeMaxDynamicSharedMemorySize, LDS_BYTES);
    (void)hipOccupancyMaxActiveBlocksPerMultiprocessor(&per_cu, (const void*)k_mega, NTHREADS, LDS_BYTES);
    if (per_cu > 1) per_cu = 1;
    grid_blocks = cus * per_cu;
    if (grid_blocks != 256) fprintf(stderr, "kernel_launch: expected a 256-workgroup resident grid, got %d (cus %d, per_cu %d)\n", grid_blocks, cus, per_cu);
  }
  (void)hipMemsetAsync(p.ws + WS_CTL, 0, XCD_BAR_WORDS * 4, stream);
  void* args[] = {&p};
  hipError_t e = hipLaunchCooperativeKernel((const void*)k_mega, dim3(grid_blocks), dim3(NTHREADS), args, LDS_BYTES, stream);
  if (e != hipSuccess) fprintf(stderr, "cooperative launch failed: %s (grid %d)\n", hipGetErrorString(e), grid_blocks);
}
```

```cpp
#include <hip/hip_runtime.h>
#include <math.h>
#include <stdio.h>
#include <stdint.h>

#ifndef REP_SUB
#define REP_SUB -1
#endif
namespace {
constexpr int BATCH = 4, SEQ = 2048, DM = 2048, NMETA = 16;
constexpr int T = BATCH * SEQ;
constexpr int TA = T + NMETA;
constexpr int DPROJ = 4112;
constexpr int NPROJ = 4096;
constexpr int OFF_Q = 0, OFF_K = 1024, OFF_V = 1280, OFF_Z = 1536, OFF_XBC = 2560, OFF_DT = 4096;
constexpr int D_XBC = 1536;
constexpr int NEXP = 16384;
constexpr int ROW4 = 1024;
constexpr int ROW6 = 1536;
constexpr float EPS = 1e-6f;
constexpr int NTHREADS = 512;

typedef unsigned short bf16_t;
typedef short bf16x8 __attribute__((ext_vector_type(8)));
typedef float f32x4 __attribute__((ext_vector_type(4)));
typedef float f32x2 __attribute__((ext_vector_type(2)));
typedef unsigned u32x4 __attribute__((ext_vector_type(4)));
typedef unsigned u32x2 __attribute__((ext_vector_type(2)));
typedef __bf16 bf16v2 __attribute__((ext_vector_type(2)));
typedef float f32x16v __attribute__((ext_vector_type(16)));
typedef float f32x32v __attribute__((ext_vector_type(32)));
typedef unsigned u32x6 __attribute__((ext_vector_type(6)));
#define LAS __attribute__((address_space(3)))

__device__ __forceinline__ unsigned pack_bf16(float lo, float hi) {
  f32x2 v = {lo, hi};
  bf16v2 b = __builtin_convertvector(v, bf16v2);
  return *(unsigned*)&b;
}
__device__ __forceinline__ bf16_t f2bf(float f) { return (bf16_t)(pack_bf16(f, 0.f) & 0xffffu); }
__device__ __forceinline__ float bf2f(bf16_t b) { return __uint_as_float(((unsigned)b) << 16); }
__device__ __forceinline__ float bflo(unsigned u) { return __uint_as_float(u << 16); }
__device__ __forceinline__ float bfhi(unsigned u) { return __uint_as_float(u & 0xffff0000u); }

__constant__ unsigned char kBucket[128] = {
    0, 1, 2, 3, 4, 5, 6, 7, 8, 9, 10, 11, 12, 13, 14, 15, 16, 16, 16, 17, 17, 18, 18, 18, 19, 19, 19, 20, 20, 20, 20, 21,
    21, 21, 21, 22, 22, 22, 22, 22, 23, 23, 23, 23, 23, 23, 24, 24, 24, 24, 24, 24, 25, 25, 25, 25, 25, 25, 25, 26, 26, 26, 26, 26,
    26, 26, 26, 27, 27, 27, 27, 27, 27, 27, 27, 27, 27, 28, 28, 28, 28, 28, 28, 28, 28, 28, 28, 29, 29, 29, 29, 29, 29, 29, 29, 29,
    29, 29, 29, 30, 30, 30, 30, 30, 30, 30, 30, 30, 30, 30, 30, 30, 30, 31, 31, 31, 31, 31, 31, 31, 31, 31, 31, 31, 31, 31, 31, 31};

__constant__ unsigned char kCandI[64] = {0, 0, 0, 0, 0, 0, 0, 0, 0, 0, 0, 0, 0, 0, 0, 0, 1, 1, 1, 1, 1, 1, 1, 1, 2, 2, 2, 2, 2, 3, 3, 3, 3, 4, 4, 4, 5, 5, 6, 6, 7, 7, 8, 9, 10, 11, 12, 13, 14, 15, 15, 15, 15, 15, 15, 15, 15, 15, 15, 15, 15, 15, 15, 15};
__constant__ unsigned char kCandJ[64] = {0, 1, 2, 3, 4, 5, 6, 7, 8, 9, 10, 11, 12, 13, 14, 15, 0, 1, 2, 3, 4, 5, 6, 7, 0, 1, 2, 3, 4, 0, 1, 2, 3, 0, 1, 2, 0, 1, 0, 1, 0, 1, 0, 0, 0, 0, 0, 0, 0, 0, 15, 15, 15, 15, 15, 15, 15, 15, 15, 15, 15, 15, 15, 15};

__device__ __forceinline__ float wave_sum(float v) {
  for (int o = 32; o > 0; o >>= 1) v += __shfl_xor(v, o);
  return v;
}
__device__ __forceinline__ float wave_max(float v) {
  for (int o = 32; o > 0; o >>= 1) v = fmaxf(v, __shfl_xor(v, o));
  return v;
}
__device__ __forceinline__ float silu_f(float x) { return x / (1.f + expf(-x)); }
__device__ __forceinline__ float softplus_f(float x) { return fmaxf(x, 0.f) + log1pf(expf(-fabsf(x))); }

constexpr size_t al256(size_t x) { return (x + 255) & ~(size_t)255; }
constexpr size_t WS_CTL = 0;
constexpr size_t WS_WINT = 65536;
constexpr size_t WS_WDTT = WS_WINT + (size_t)NPROJ * DM * 2;
constexpr size_t WS_WOUTT = WS_WDTT + (size_t)16 * DM * 2;
constexpr size_t WS_WQT = WS_WOUTT + (size_t)DM * DM * 2;
constexpr size_t WS_KEYS = WS_WQT + (size_t)DM * DM * 2;
constexpr size_t WS_UB = WS_KEYS + (size_t)16 * 128 * 128 * 2;
constexpr size_t WS_VB = WS_UB + (size_t)NEXP * DM * 2;
constexpr size_t WS_HNB = WS_VB + (size_t)NEXP * DM * 2;
constexpr size_t WS_PROJ = WS_HNB + (size_t)(T + 16) * DM * 2;
constexpr size_t WS_DTRAW = WS_PROJ + (size_t)T * NPROJ * 2;
constexpr size_t WS_PROJM = WS_DTRAW + (size_t)T * 16 * 4;
constexpr size_t WS_PROJMB = al256(WS_PROJM + (size_t)16 * DPROJ * 4);
constexpr size_t WS_H1B = al256(WS_PROJMB + (size_t)16 * DPROJ * 2);
constexpr size_t WS_SSQH1 = WS_H1B + (size_t)T * DM * 2;
constexpr size_t WS_STOP = al256(WS_SSQH1 + (size_t)T * 32 * 4);
constexpr size_t WS_ITOP = WS_STOP + (size_t)T * 256 * 4;
constexpr size_t WS_ACSG = al256(WS_ITOP + (size_t)T * 256 * 4);
constexpr size_t WS_CCB = WS_ACSG + (size_t)T * 16 * 4;
constexpr size_t WS_YPART = WS_CCB + (size_t)T * 256 * 2;
constexpr size_t WS_SG = WS_YPART + (size_t)T * 1024 * 4;
constexpr size_t WS_SMETA = WS_SG + (size_t)1024 * 8192 * 4;
constexpr size_t WS_HPREV = al256(WS_SMETA + (size_t)16 * 8192 * 4);
constexpr size_t WS_USC = al256(WS_HPREV + (size_t)1024 * 8192 * 2);
constexpr size_t WS_VSC = WS_USC + (size_t)NEXP * 4;
constexpr size_t WS_SCR = al256(WS_VSC + (size_t)NEXP * 4);
}

namespace pg8 {
#define PG8_LAS __attribute__((address_space(3)))
constexpr int BM = 256, BK = 64, HALF = 128, HTB = HALF * BK * 2, STAGE_BYTES = 8 * HTB, NXCD = 8, WGM = 8;
__host__ __device__ __forceinline__ int lds_byte(int r, int c) { const int st = (r >> 4) * 2 + (c >> 5), rr = r & 15, cc = c & 31, ob = rr * 64 + cc * 2; return st * 1024 + (ob ^ (((ob >> 9) & 1) << 5)); }
__host__ __device__ __forceinline__ void stage_rc(int b, int& R, int& C) { const int st = b / 1024, sb = b % 1024, swz = sb ^ (((sb >> 9) & 1) << 5); R = (st >> 1) * 16 + swz / 64; C = (st & 1) * 32 + (swz % 64) / 2; }
__host__ __device__ __forceinline__ int perm32(int rho) { const int n = rho >> 4, i = rho & 15; return 8 * (i >> 2) + 4 * n + (i & 3); }
struct Unit { int pm, pn; };
struct Gemm { const bf16_t* A; const bf16_t* Bt; int M, N, K; };
struct StaticOrder {
    int nM, nN, nwg, G, c;
    __host__ __device__ void init(int M, int N, int G_, int c_) { nM = M / BM; nN = N / BM; nwg = nM * nN; G = G_; c = c_; }
    __host__ __device__ bool next(int i, Unit& u) const {
        const long L = (long)i * G + c; if (L >= nwg) return false;
        int wgid = (int)L; { const int q = nwg / NXCD, r = nwg % NXCD, xcd = wgid % NXCD, off = wgid / NXCD; wgid = (xcd < r ? xcd * (q + 1) : r * (q + 1) + (xcd - r) * q) + off; }
        const int nig = WGM * nN, gid = wgid / nig, fm = gid * WGM, gsz = (nM - fm) < WGM ? (nM - fm) : WGM;
        u.pm = fm + ((wgid % nig) % gsz); u.pn = (wgid % nig) / gsz; return true;
    }
    __device__ __forceinline__ void a_ready(const Unit&) const {}
    __device__ __forceinline__ void done(const Unit&) const {}
};
struct EpiBf16 {
    static constexpr bool PERM = true, AFTER_DRAIN = false;
    bf16_t* O; int ldc;
    __device__ __forceinline__ void operator()(const f32x4 (&acc)[2][2][4][2], const Unit& u, int wr, int wc, int fr, int fq) const {
        const int row0 = u.pm * BM + wr * 64 + fr; const int col0 = u.pn * BM + wc * 32 + 8 * fq;
        const __amdgpu_buffer_rsrc_t rsrc = __builtin_amdgcn_make_buffer_rsrc(O, 0, 0x7fffffff, 0x00020000);
#pragma unroll
        for (int ai = 0; ai < 2; ++ai)
#pragma unroll
            for (int m = 0; m < 4; ++m) { const unsigned boff = (unsigned)(((size_t)(row0 + ai * HALF + m * 16) * ldc + col0) * 2);
#pragma unroll
                for (int bj = 0; bj < 2; ++bj) { const f32x4 v0 = acc[ai][bj][m][0], v1 = acc[ai][bj][m][1];
                    u32x4 w; w.x = pack_bf16(v0[0], v0[1]); w.y = pack_bf16(v0[2], v0[3]); w.z = pack_bf16(v1[0], v1[1]); w.w = pack_bf16(v1[2], v1[3]);
                    __builtin_amdgcn_raw_buffer_store_b128(w, rsrc, boff + bj * HALF * 2, 0, 16); } }
    }
};

struct EpiRes {
    static constexpr bool PERM = true, AFTER_DRAIN = false;
    const float* X; bf16_t* HB; float* SSQ;
    __device__ __forceinline__ void operator()(const f32x4 (&acc)[2][2][4][2], const Unit& u, int wr, int wc, int fr, int fq) const {
        const int row0 = u.pm * BM + wr * 64 + fr; const int col0 = u.pn * BM + wc * 32 + 8 * fq;
#pragma unroll
        for (int ai = 0; ai < 2; ++ai) {
            f32x4 xr[4][2][2];
#pragma unroll
            for (int m = 0; m < 4; ++m) { const size_t off = (size_t)(row0 + ai * HALF + m * 16) * DM + col0;
#pragma unroll
                for (int bj = 0; bj < 2; ++bj) { xr[m][bj][0] = __builtin_nontemporal_load((const f32x4*)(X + off + bj * HALF)); xr[m][bj][1] = __builtin_nontemporal_load((const f32x4*)(X + off + bj * HALF + 4)); } }
#pragma unroll
            for (int m = 0; m < 4; ++m) { const int row = row0 + ai * HALF + m * 16; const size_t off = (size_t)row * DM + col0; float ss = 0.f;
#pragma unroll
                for (int bj = 0; bj < 2; ++bj) {
                    const f32x4 v0 = acc[ai][bj][m][0] + xr[m][bj][0], v1 = acc[ai][bj][m][1] + xr[m][bj][1];
                    u32x4 w; w.x = pack_bf16(v0[0], v0[1]); w.y = pack_bf16(v0[2], v0[3]); w.z = pack_bf16(v1[0], v1[1]); w.w = pack_bf16(v1[2], v1[3]);
                    *(u32x4*)(HB + off + bj * HALF) = w;
                    ss += v0[0] * v0[0] + v0[1] * v0[1] + v0[2] * v0[2] + v0[3] * v0[3] + v1[0] * v1[0] + v1[1] * v1[1] + v1[2] * v1[2] + v1[3] * v1[3]; }
                ss += __shfl_xor(ss, 16); ss += __shfl_xor(ss, 32);
                if (fq == 0) SSQ[(size_t)row * 32 + u.pn * 4 + wc] = ss; }
        }
    }
};
struct EpiF32 {
    static constexpr bool PERM = true, AFTER_DRAIN = false;
    float* C; int ldc;
    __device__ __forceinline__ void operator()(const f32x4 (&acc)[2][2][4][2], const Unit& u, int wr, int wc, int fr, int fq) const {
        const int row0 = u.pm * BM + wr * 64 + fr; const int col0 = u.pn * BM + wc * 32 + 8 * fq;
#pragma unroll
        for (int ai = 0; ai < 2; ++ai)
#pragma unroll
            for (int m = 0; m < 4; ++m) { float* rowp = C + (size_t)(row0 + ai * HALF + m * 16) * ldc + col0;
#pragma unroll
                for (int bj = 0; bj < 2; ++bj) { *(f32x4*)(rowp + bj * HALF) = acc[ai][bj][m][0]; *(f32x4*)(rowp + bj * HALF + 4) = acc[ai][bj][m][1]; } }
    }
};

struct EpiScores {
    static constexpr bool PERM = true, AFTER_DRAIN = true;
    const bf16_t* KEYS;
    float* STOP; int* ITOP;
    static constexpr int QLD = 264;
    __device__ __forceinline__ void fused(f32x4 (&acc)[2][2][4][2], const Unit& u, int wr, int wc, int fr, int fq, PG8_LAS unsigned char* lds, int wid, int lane) const {
        PG8_LAS bf16_t* Q = (PG8_LAS bf16_t*)lds;
#pragma unroll
        for (int ai = 0; ai < 2; ++ai)
#pragma unroll
            for (int m = 0; m < 4; ++m) { const int row = ai * HALF + wr * 64 + m * 16 + fr;
#pragma unroll
                for (int bj = 0; bj < 2; ++bj) { const f32x4 v0 = acc[ai][bj][m][0], v1 = acc[ai][bj][m][1];
                    u32x4 w; w.x = pack_bf16(v0[0], v0[1]); w.y = pack_bf16(v0[2], v0[3]); w.z = pack_bf16(v1[0], v1[1]); w.w = pack_bf16(v1[2], v1[3]);
                    *(PG8_LAS u32x4*)(Q + row * QLD + bj * HALF + wc * 32 + 8 * fq) = w; } }
        __syncthreads();
        const int h = u.pn;
#pragma unroll 1
        for (int c = 0; c < 2; ++c) {
            f32x4 sc[8][2];
#pragma unroll
            for (int kf = 0; kf < 8; ++kf) { sc[kf][0] = (f32x4){0.f, 0.f, 0.f, 0.f}; sc[kf][1] = (f32x4){0.f, 0.f, 0.f, 0.f}; }
            const bf16_t* kb = KEYS + (size_t)((h * 2 + c) * 128 + fr) * 128 + 8 * fq;
            const PG8_LAS bf16_t* qb = Q + (wid * 32 + fr) * QLD + c * 128 + 8 * fq;
#pragma unroll
            for (int ks = 0; ks < 4; ++ks) {
                const bf16x8 q0 = *(const PG8_LAS bf16x8*)(qb + 32 * ks), q1 = *(const PG8_LAS bf16x8*)(qb + 16 * QLD + 32 * ks);
#pragma unroll
                for (int kf = 0; kf < 8; ++kf) { const bf16x8 kv = *(const bf16x8*)(kb + (size_t)kf * 16 * 128 + 32 * ks);
                    sc[kf][0] = __builtin_amdgcn_mfma_f32_16x16x32_bf16(kv, q0, sc[kf][0], 0, 0, 0);
                    sc[kf][1] = __builtin_amdgcn_mfma_f32_16x16x32_bf16(kv, q1, sc[kf][1], 0, 0, 0); }
            }
#pragma unroll
            for (int tf = 0; tf < 2; ++tf) {
                int v[32];
#pragma unroll
                for (int kf = 0; kf < 8; ++kf)
#pragma unroll
                    for (int r = 0; r < 4; ++r) {
                        const int bts = (int)__float_as_uint(sc[kf][tf][r]);
                        const int srt = bts ^ ((bts >> 31) & 0x7fffffff);
                        v[kf * 4 + r] = (srt & ~127) | (16 * kf + 4 * fq + r);
                    }
#pragma unroll
                for (int k = 2; k <= 32; k <<= 1)
#pragma unroll
                    for (int j = k >> 1; j > 0; j >>= 1)
#pragma unroll
                        for (int i = 0; i < 32; ++i) {
                            const int l = i ^ j;
                            if (l > i) {
                                const int x = v[i], y = v[l];
                                const int hi_ = x > y ? x : y, lo_ = x > y ? y : x;
                                if ((i & k) == 0) { v[i] = hi_; v[l] = lo_; } else { v[i] = lo_; v[l] = hi_; }
                            }
                        }
#pragma unroll
                for (int step = 0; step < 2; ++step) {
                    const int xm = step == 0 ? 16 : 32;
                    int m[16];
#pragma unroll
                    for (int i = 0; i < 16; ++i) { const int o = __shfl_xor(v[15 - i], xm); m[i] = v[i] > o ? v[i] : o; }
#pragma unroll
                    for (int j = 8; j > 0; j >>= 1)
#pragma unroll
                        for (int i = 0; i < 16; ++i) {
                            const int l = i ^ j;
                            if (l > i) { const int x = m[i], y = m[l]; m[i] = x > y ? x : y; m[l] = x > y ? y : x; }
                        }
#pragma unroll
                    for (int i = 0; i < 16; ++i) v[i] = m[i];
                }
                if (fq == 0) {
                    const size_t obase = ((size_t)(u.pm * BM + wid * 32 + tf * 16 + fr) * 16 + h * 2 + c) * 16;
#pragma unroll
                    for (int q4 = 0; q4 < 4; ++q4) {
                        f32x4 sv; u32x4 iv;
#pragma unroll
                        for (int i = 0; i < 4; ++i) {
                            const int key = v[4 * q4 + i], srt = key & ~127;
                            sv[i] = __uint_as_float((unsigned)(srt ^ ((srt >> 31) & 0x7fffffff)));
                            iv[i] = (unsigned)(key & 127);
                        }
                        *(f32x4*)(STOP + obase + 4 * q4) = sv;
                        *(u32x4*)(ITOP + obase + 4 * q4) = iv;
                    }
                }
            }
        }
    }
};

template <class Epi, class Sched>
__device__ __forceinline__ void gemm_phase(PG8_LAS unsigned char* lds, const Gemm g, const Sched& S, const Epi& E) {
    int tid_ = threadIdx.x; asm volatile("" : "+v"(tid_));
    const int tid = tid_, wid = __builtin_amdgcn_readfirstlane(tid >> 6), lane = tid & 63, wr = wid >> 2, wc = wid & 3, fr = lane & 15, fq = lane >> 4;
    const int K = g.K, nt = K / BK;
    unsigned voffA[2], voffB[2];
#pragma unroll
    for (int i = 0; i < 2; ++i) { int R, C; stage_rc(tid * 16 + i * 8192, R, C); const int Rb = Epi::PERM ? ((R & ~31) + perm32(R & 31)) : R;
        voffA[i] = (unsigned)(R * K + C) * 2u; voffB[i] = (unsigned)(Rb * K + C) * 2u; }
    const size_t kstep = (size_t)(BK * 2);
    const size_t hstep = (size_t)HALF * K * 2;
    const size_t tstep = 2 * hstep;
    const unsigned ldsw = (unsigned)wid * 1024u;
    const int aoff = lds_byte(wr * 64 + fr, fq * 8), boff = lds_byte(wc * 32 + fr, fq * 8);
#define PG8_SA(b, h) (((b) * 2 + (h)) * HTB)
#define PG8_SB(b, h) ((4 + (b) * 2 + (h)) * HTB)
#define PG8_STAGE(bufoff, gbase, voff) do { _Pragma("unroll") for (int _i = 0; _i < 2; ++_i) \
        __builtin_amdgcn_global_load_lds((const unsigned*)((const char*)(gbase) + (voff)[_i]), (PG8_LAS unsigned*)(lds + (bufoff) + ldsw + _i * 8192), 16, 0, 0); } while (0)
#define PG8_LDA(dst, b, h) do { _Pragma("unroll") for (int m = 0; m < 4; ++m) _Pragma("unroll") for (int k = 0; k < 2; ++k) dst[m][k] = *(const PG8_LAS bf16x8*)(lds + PG8_SA(b, h) + aoff + m * 2048 + k * 1024); } while (0)
#define PG8_LDB(dst, b, h) do { _Pragma("unroll") for (int n = 0; n < 2; ++n) _Pragma("unroll") for (int k = 0; k < 2; ++k) dst[n][k] = *(const PG8_LAS bf16x8*)(lds + PG8_SB(b, h) + boff + n * 2048 + k * 1024); } while (0)
#define PG8_MMA(ai, bj, At, Bt) do { __builtin_amdgcn_s_setprio(1); _Pragma("unroll") for (int m = 0; m < 4; ++m) _Pragma("unroll") for (int n = 0; n < 2; ++n) _Pragma("unroll") for (int k = 0; k < 2; ++k) \
        acc[ai][bj][m][n] = __builtin_amdgcn_mfma_f32_16x16x32_bf16(Bt[n][k], At[m][k], acc[ai][bj][m][n], 0, 0, 0); __builtin_amdgcn_s_setprio(0); } while (0)
#define PG8_WAIT_V(n) asm volatile("s_waitcnt vmcnt(" #n ")" ::: "memory")
#define PG8_WAIT_L(n) asm volatile("s_waitcnt lgkmcnt(" #n ")" ::: "memory")
#define PG8_BAR __builtin_amdgcn_s_barrier()
#define PG8_SCHED __builtin_amdgcn_sched_barrier(0)
    Unit cur, nxt; int ui = 0;
    if (!S.next(0, cur)) return;
    f32x4 acc[2][2][4][2];
#pragma unroll
    for (int a = 0; a < 2; ++a)
#pragma unroll
        for (int b = 0; b < 2; ++b)
#pragma unroll
            for (int m = 0; m < 4; ++m)
#pragma unroll
                for (int n = 0; n < 2; ++n) acc[a][b][m][n] = (f32x4){0.f, 0.f, 0.f, 0.f};
    bf16x8 At[4][2], B0[2][2], B1[2][2];
    const char* cA = (const char*)g.A + (size_t)cur.pm * tstep; const char* cB = (const char*)g.Bt + (size_t)cur.pn * tstep;
    S.a_ready(cur);
    PG8_STAGE(PG8_SB(0, 0), cB, voffB); PG8_STAGE(PG8_SA(0, 0), cA, voffA); PG8_STAGE(PG8_SB(0, 1), cB + hstep, voffB); PG8_STAGE(PG8_SA(0, 1), cA + hstep, voffA);
    if (wr == 1) PG8_BAR;
    PG8_WAIT_V(4); PG8_BAR;
    PG8_STAGE(PG8_SB(1, 0), cB + kstep, voffB); PG8_STAGE(PG8_SA(1, 0), cA + kstep, voffA); PG8_STAGE(PG8_SB(1, 1), cB + hstep + kstep, voffB);
    PG8_WAIT_V(6); PG8_BAR;
    for (;;) {
        const bool has_next = S.next(ui + 1, nxt);
        const char* nA = has_next ? (const char*)g.A + (size_t)nxt.pm * tstep : cA; const char* nB = has_next ? (const char*)g.Bt + (size_t)nxt.pn * tstep : cB;
        for (int t = 0; t < nt; t += 2) {
            const bool last = (t == nt - 2);
            const char* a1 = cA + (size_t)(t + 1) * kstep;
            const char* a2 = last ? nA : cA + (size_t)(t + 2) * kstep; const char* b2 = last ? nB : cB + (size_t)(t + 2) * kstep;
            const char* a3 = a2 + kstep; const char* b3 = b2 + kstep;
            if (last && has_next) S.a_ready(nxt);
            PG8_LDB(B0, 0, 0); PG8_SCHED; PG8_LDA(At, 0, 0); PG8_STAGE(PG8_SA(1, 1), a1 + hstep, voffA);
            PG8_WAIT_L(8); PG8_BAR; PG8_WAIT_L(0); PG8_MMA(0, 0, At, B0); PG8_BAR; PG8_SCHED;
            PG8_LDB(B1, 0, 1); PG8_STAGE(PG8_SB(0, 0), b2, voffB);
            PG8_BAR; PG8_WAIT_L(0); PG8_MMA(0, 1, At, B1); PG8_BAR;
            PG8_LDA(At, 0, 1); PG8_STAGE(PG8_SA(0, 0), a2, voffA);
            PG8_BAR; PG8_WAIT_L(0); PG8_MMA(1, 0, At, B0); PG8_BAR; PG8_SCHED;
            PG8_STAGE(PG8_SB(0, 1), b2 + hstep, voffB);
            PG8_WAIT_V(6); PG8_BAR; PG8_MMA(1, 1, At, B1); PG8_BAR;
            PG8_LDB(B0, 1, 0); PG8_SCHED; PG8_LDA(At, 1, 0); PG8_STAGE(PG8_SA(0, 1), a2 + hstep, voffA);
            PG8_WAIT_L(8); PG8_BAR; PG8_WAIT_L(0); PG8_MMA(0, 0, At, B0); PG8_BAR; PG8_SCHED;
            PG8_LDB(B1, 1, 1); PG8_STAGE(PG8_SB(1, 0), b3, voffB);
            PG8_BAR; PG8_WAIT_L(0); PG8_MMA(0, 1, At, B1); PG8_BAR;
            PG8_LDA(At, 1, 1); PG8_STAGE(PG8_SA(1, 0), a3, voffA);
            PG8_BAR; PG8_WAIT_L(0); PG8_MMA(1, 0, At, B0); PG8_BAR; PG8_SCHED;
            PG8_STAGE(PG8_SB(1, 1), b3 + hstep, voffB);
            PG8_WAIT_V(6); PG8_BAR; PG8_MMA(1, 1, At, B1); PG8_BAR;
        }
        if constexpr (!Epi::AFTER_DRAIN) { E(acc, cur, wr, wc, fr, fq); S.done(cur); }
        if (!has_next) break;
#pragma unroll
        for (int a = 0; a < 2; ++a)
#pragma unroll
            for (int b = 0; b < 2; ++b)
#pragma unroll
                for (int m = 0; m < 4; ++m)
#pragma unroll
                    for (int n = 0; n < 2; ++n) acc[a][b][m][n] = (f32x4){0.f, 0.f, 0.f, 0.f};
        cur = nxt; cA = nA; cB = nB; ++ui;
    }
    PG8_WAIT_V(0);
    if (wr == 0) PG8_BAR;
    PG8_BAR;
    if constexpr (Epi::AFTER_DRAIN) { E.fused(acc, cur, wr, wc, fr, fq, lds, wid, lane); S.done(cur); }
#undef PG8_SA
#undef PG8_SB
#undef PG8_STAGE
#undef PG8_LDA
#undef PG8_LDB
#undef PG8_MMA
#undef PG8_WAIT_V
#undef PG8_WAIT_L
#undef PG8_BAR
#undef PG8_SCHED
}
}

#define XB_TMO      128
#define XB_XCNT(j)  (256  + 64 * (j))
#define XB_XSUB(j)  (1280 + 64 * (j))
#define XB_XGEN(j)  (2304 + 64 * (j))
#define XB_TOP      3328
#define XB_TOPGEN   3392
#define XCD_BAR_WORDS 3456
#define XB_SPIN_CAP (1u << 22)
__device__ __forceinline__ unsigned xb_ld(unsigned* p)              { return __hip_atomic_load(p, __ATOMIC_RELAXED, __HIP_MEMORY_SCOPE_AGENT); }
__device__ __forceinline__ unsigned xb_add(unsigned* p, unsigned v) { return __hip_atomic_fetch_add(p, v, __ATOMIC_RELAXED, __HIP_MEMORY_SCOPE_AGENT); }
__device__ __forceinline__ unsigned xb_xcc_id() { return (unsigned)__builtin_amdgcn_s_getreg((3 << 11) | 20) & 0xFu; }
#define XB_SPIN(cond, bar) do { unsigned _sp = 0; while (cond) { __builtin_amdgcn_s_sleep(1); \
    if ((++_sp & 255u) == 0u) { if (xb_ld(&(bar)[XB_TMO])) break; if (_sp > XB_SPIN_CAP) { atomicAdd(&(bar)[XB_TMO], 1u); break; } } } } while (0)
struct XcdBarrier { unsigned* bar; unsigned x; volatile LAS unsigned* st; };
__device__ __forceinline__ XcdBarrier xcd_barrier_post(unsigned* bar, volatile LAS unsigned* st) {
    XcdBarrier b; b.bar = bar; b.x = xb_xcc_id(); b.st = st;
    if (threadIdx.x == 0) (void)xb_add(&bar[XB_XCNT(b.x)], 1u);
    return b;
}
__device__ __forceinline__ void xcd_barrier_complete(unsigned* bar, unsigned x, unsigned& nloc, unsigned& nx) {
    const unsigned G = gridDim.x * gridDim.y * gridDim.z;
    unsigned sum, cnt, mine, sp = 0u;
    for (;;) {
        sum = 0u; cnt = 0u; mine = 0u;
#pragma unroll
        for (unsigned j = 0; j < 16; ++j) { const unsigned c = xb_ld(&bar[XB_XCNT(j)]); sum += c; cnt += (c > 0u) ? 1u : 0u; mine = (j == x) ? c : mine; }
        if (sum == G) break;
        __builtin_amdgcn_s_sleep(1);
        if ((++sp & 255u) == 0u) { if (xb_ld(&bar[XB_TMO])) break; if (sp > XB_SPIN_CAP) { atomicAdd(&bar[XB_TMO], 1u); break; } }
    }
    nloc = mine > 0u ? mine : 1u; nx = cnt > 0u ? cnt : 1u;
}
__device__ __forceinline__ void xcd_barrier(const XcdBarrier& b) {
    asm volatile("s_waitcnt vmcnt(0)" ::: "memory");
    __syncthreads();
    if (threadIdx.x == 0) {
        unsigned* bar = b.bar;
        const unsigned bx = xb_xcc_id();
        __builtin_amdgcn_s_waitcnt(0);
        unsigned nloc = b.st[0], nx = b.st[1];
        if (nloc == 0u) { xcd_barrier_complete(bar, bx, nloc, nx); b.st[0] = nloc; b.st[1] = nx; }
        const unsigned old = xb_add(&bar[XB_XSUB(bx)], 1u);
        const unsigned gen = old / nloc;
        if (old + 1u == (gen + 1u) * nloc) {
            __builtin_amdgcn_fence(__ATOMIC_RELEASE, "agent");
            asm volatile("s_waitcnt vmcnt(0)" ::: "memory");
            const unsigned og = xb_add(&bar[XB_TOP], 1u);
            const unsigned tg = og / nx;
            if (og + 1u == (tg + 1u) * nx) xb_add(&bar[XB_TOPGEN], 1u);
            else XB_SPIN(xb_ld(&bar[XB_TOPGEN]) == tg, bar);
            __builtin_amdgcn_fence(__ATOMIC_ACQUIRE, "agent");
            xb_add(&bar[XB_XGEN(bx)], 1u);
            asm volatile("s_waitcnt vmcnt(0)" ::: "memory");
        } else {
            XB_SPIN(xb_ld(&bar[XB_XGEN(bx)]) == gen, bar);
            __builtin_amdgcn_fence(__ATOMIC_ACQUIRE, "agent");
            asm volatile("s_waitcnt vmcnt(0)" ::: "memory");
        }
    }
    __syncthreads();
}

namespace {
struct Params {
  const float *x, *meta, *rel_bias, *ln_mix, *w_in, *sinks, *conv_w, *conv_b, *dt_bias, *a_log, *d_skip, *attn_norm_w,
      *ssm_norm_w, *w_out, *ln_ffn, *wq, *keys, *U, *V, *ln_final;
  float* out;
  unsigned char* ws;
};

__device__ __forceinline__ void p0_transpose_tile(const float* __restrict__ W, int ldw, bf16_t* __restrict__ Wt, const float* sc0,
                                                  const float* sc1, int k0, int n0, float* tile) {
  const int tid = threadIdx.x;
  {
    const int r = tid >> 6, c4 = (tid & 63) * 4;
    f32x4 v[8];
#pragma unroll
    for (int i = 0; i < 8; ++i) v[i] = __builtin_nontemporal_load((const f32x4*)(W + (size_t)(k0 + r + 8 * i) * ldw + n0 + c4));
#pragma unroll
    for (int i = 0; i < 8; ++i) {
      float s = 1.f;
      const int k = k0 + r + 8 * i;
      if (sc0) s = k < 1024 ? sc0[k] : sc1[k - 1024];
      float* q = tile + (r + 8 * i) * 257 + c4;
      q[0] = v[i][0] * s; q[1] = v[i][1] * s; q[2] = v[i][2] * s; q[3] = v[i][3] * s;
    }
  }
  __syncthreads();
#pragma unroll
  for (int it = 0; it < 4; ++it) {
    const int task = it * NTHREADS + tid;
    const int n = task >> 3, kc = (task & 7) * 8;
    float v[8];
#pragma unroll
    for (int j = 0; j < 8; ++j) v[j] = tile[(kc + j) * 257 + n];
    u32x4 w; w.x = pack_bf16(v[0], v[1]); w.y = pack_bf16(v[2], v[3]); w.z = pack_bf16(v[4], v[5]); w.w = pack_bf16(v[6], v[7]);
    *(u32x4*)(Wt + (size_t)(n0 + n) * DM + k0 + kc) = w;
  }
  __syncthreads();
}

__device__ __forceinline__ void phase0(const Params& p, float* ldsf, int bid, int nblk) {
  const int tid = threadIdx.x, lane = tid & 63, wid = tid >> 6;
  bf16_t* w_inT = (bf16_t*)(p.ws + WS_WINT);
  bf16_t* w_dtT = (bf16_t*)(p.ws + WS_WDTT);
  bf16_t* w_outT = (bf16_t*)(p.ws + WS_WOUTT);
  bf16_t* wqT = (bf16_t*)(p.ws + WS_WQT);
  bf16_t* keysb = (bf16_t*)(p.ws + WS_KEYS);
  unsigned char* ub = p.ws + WS_UB;
  unsigned char* vb = p.ws + WS_VB;
  bf16_t* hnb = (bf16_t*)(p.ws + WS_HNB);
  constexpr int U_HN = (TA + 7) / 8;
  constexpr int U_WIN = 32 * 16, U_WOUT = 32 * 8, U_WQ = 32 * 8, U_WDT = 1, U_KEYS = 64;
  constexpr int B_WIN = U_HN, B_WOUT = B_WIN + U_WIN, B_WQ = B_WOUT + U_WOUT, B_WDT = B_WQ + U_WQ, B_KEYS = B_WDT + U_WDT,
                B_U = B_KEYS + U_KEYS, B_END = B_U;
  for (int u = bid; u < B_END; u += nblk) {
    if (u < B_WIN) {
      const int t = u * 8 + wid;
      if (t < TA) {
        const float* src = t < T ? p.x + (size_t)t * DM : p.meta + (size_t)(t - T) * DM;
        float4 v[8];
        float ss = 0.f;
#pragma unroll
        for (int i = 0; i < 8; ++i) {
          { const f32x4 q_ = __builtin_nontemporal_load((const f32x4*)(src + (i * 64 + lane) * 4)); v[i].x = q_[0]; v[i].y = q_[1]; v[i].z = q_[2]; v[i].w = q_[3]; }
          ss += v[i].x * v[i].x + v[i].y * v[i].y + v[i].z * v[i].z + v[i].w * v[i].w;
        }
        ss = wave_sum(ss);
        const float r = rsqrtf(ss * (1.f / DM) + EPS);
#pragma unroll
        for (int i = 0; i < 8; ++i) {
          const float4 w = *(const float4*)(p.ln_mix + (i * 64 + lane) * 4);
          u32x2 o; o.x = pack_bf16(v[i].x * r * w.x, v[i].y * r * w.y); o.y = pack_bf16(v[i].z * r * w.z, v[i].w * r * w.w);
          *(u32x2*)(hnb + (size_t)t * DM + (i * 64 + lane) * 4) = o;
        }
      }
    } else if (u < B_WOUT) {
      const int i = u - B_WIN;
      p0_transpose_tile(p.w_in, DPROJ, w_inT, nullptr, nullptr, (i & 31) * 64, (i >> 5) * 256, ldsf);
    } else if (u < B_WQ) {
      const int i = u - B_WOUT;
      p0_transpose_tile(p.w_out, DM, w_outT, p.attn_norm_w, p.ssm_norm_w, (i & 31) * 64, (i >> 5) * 256, ldsf);
    } else if (u < B_WDT) {
      const int i = u - B_WQ;
      p0_transpose_tile(p.wq, DM, wqT, p.ln_ffn, p.ln_ffn + 1024, (i & 31) * 64, (i >> 5) * 256, ldsf);
    } else if (u < B_KEYS) {
      for (int idx = tid; idx < DM * 16; idx += NTHREADS) {
        const int k = idx >> 4, j = idx & 15;
        w_dtT[(size_t)j * DM + k] = f2bf(p.w_in[(size_t)k * DPROJ + NPROJ + j]);
      }
    } else if (u < B_U) {
      const size_t base = (size_t)(u - B_KEYS) * 4096 + (size_t)tid * 8;
      const float4 a = *(const float4*)(p.keys + base), b = *(const float4*)(p.keys + base + 4);
      u32x4 w; w.x = pack_bf16(a.x, a.y); w.y = pack_bf16(a.z, a.w); w.z = pack_bf16(b.x, b.y); w.w = pack_bf16(b.z, b.w);
      *(u32x4*)(keysb + base) = w;
    }
  }
}

__device__ __forceinline__ void convert_tables(const Params& p, int bid, int nblk) {
  const int tid = threadIdx.x, lane = tid & 63, wid = tid >> 6;
  unsigned char* ub = p.ws + WS_UB;
  unsigned char* vb = p.ws + WS_VB;
  {
    const int gw = bid * 8 + wid, nw = nblk * 8;
    auto load_row = [&](f32x4 (&a)[8], const int r2) __attribute__((always_inline)) {
      const float* src = (r2 < NEXP ? p.U + (size_t)r2 * DM : p.V + (size_t)(r2 - NEXP) * DM) + lane * 4;
#pragma unroll
      for (int j = 0; j < 8; ++j) a[j] = __builtin_nontemporal_load((const f32x4*)(src + 256 * j));
    };
    auto conv_row = [&](f32x4 (&a)[8], const int r2) __attribute__((always_inline)) {
      const bool isU = r2 < NEXP;
      const int row = isU ? r2 : r2 - NEXP;
      if (isU) {
#pragma unroll
        for (int j = 0; j < 8; ++j) a[j] *= *(const f32x4*)(p.ln_ffn + lane * 4 + 256 * j);
      }
      float amax = 0.f;
#pragma unroll
      for (int j = 0; j < 8; ++j) amax = fmaxf(amax, fmaxf(fmaxf(fabsf(a[j][0]), fabsf(a[j][1])), fmaxf(fabsf(a[j][2]), fabsf(a[j][3]))));
      amax = wave_max(amax);
      const float s4 = amax > 0.f ? 6.f / amax : 1.f;
      u32x4 w4;
#pragma unroll
      for (int j = 0; j < 4; ++j) {
        unsigned w = 0;
        w = __builtin_amdgcn_cvt_scalef32_pk_fp4_f32(w, a[2 * j][0] * s4, a[2 * j][1] * s4, 1.0f, 0);
        w = __builtin_amdgcn_cvt_scalef32_pk_fp4_f32(w, a[2 * j][2] * s4, a[2 * j][3] * s4, 1.0f, 1);
        w = __builtin_amdgcn_cvt_scalef32_pk_fp4_f32(w, a[2 * j + 1][0] * s4, a[2 * j + 1][1] * s4, 1.0f, 2);
        w = __builtin_amdgcn_cvt_scalef32_pk_fp4_f32(w, a[2 * j + 1][2] * s4, a[2 * j + 1][3] * s4, 1.0f, 3);
        w4[j] = w;
      }
      *(u32x4*)((isU ? ub : vb) + (size_t)row * ROW4 + lane * 16) = w4;
      if (lane == 0) ((float*)(p.ws + (isU ? WS_USC : WS_VSC)))[row] = amax > 0.f ? amax * (1.f / 6.f) : 1.f;
    };
    f32x4 ra[8], rb[8];
    int r2 = gw;
    if (r2 < 2 * NEXP) load_row(ra, r2);
#pragma unroll 1
    for (; r2 < 2 * NEXP; r2 += 2 * nw) {
      if (r2 + nw < 2 * NEXP) load_row(rb, r2 + nw);
      conv_row(ra, r2);
      if (r2 + nw < 2 * NEXP) {
        if (r2 + 2 * nw < 2 * NEXP) load_row(ra, r2 + 2 * nw);
        conv_row(rb, r2 + nw);
      }
    }
  }
}

__device__ __forceinline__ void mini_gemm(const bf16_t* __restrict__ A, const bf16_t* __restrict__ Bt, float* __restrict__ out, int ldo,
                                          float* red, bf16_t* __restrict__ outb = nullptr) {
  const int tid = threadIdx.x, lane = tid & 63, wid = tid >> 6, fr = lane & 15, fq = lane >> 4;
  f32x4 acc = {0.f, 0.f, 0.f, 0.f};
  const bf16_t* ap = A + (size_t)fr * DM + wid * 256 + fq * 8;
  const bf16_t* bp = Bt + (size_t)fr * DM + wid * 256 + fq * 8;
#pragma unroll
  for (int ks = 0; ks < 8; ++ks) {
    const bf16x8 a = *(const bf16x8*)(ap + ks * 32);
    const bf16x8 b = *(const bf16x8*)(bp + ks * 32);
    acc = __builtin_amdgcn_mfma_f32_16x16x32_bf16(a, b, acc, 0, 0, 0);
  }
#pragma unroll
  for (int r = 0; r < 4; ++r) red[wid * 256 + (4 * fq + r) * 16 + fr] = acc[r];
  __syncthreads();
  if (tid < 256) {
    float s = 0.f;
#pragma unroll
    for (int w = 0; w < 8; ++w) s += red[w * 256 + tid];
    out[(size_t)(tid >> 4) * ldo + (tid & 15)] = s;
    if (outb) outb[(size_t)(tid >> 4) * ldo + (tid & 15)] = f2bf(s);
  }
  __syncthreads();
}

__device__ __forceinline__ void phase1(const Params& p, unsigned char* lds, int bid, int nblk) {
  const bool stream_first = ((bid >> 3) & 1) != 0;
  if (stream_first) convert_tables(p, bid, nblk);
  const bf16_t* hnb = (const bf16_t*)(p.ws + WS_HNB);
  const bf16_t* w_inT = (const bf16_t*)(p.ws + WS_WINT);
  const bf16_t* w_dtT = (const bf16_t*)(p.ws + WS_WDTT);
  float* dtraw = (float*)(p.ws + WS_DTRAW);
  float* projm = (float*)(p.ws + WS_PROJM);
  constexpr int NU = 512 + 32 + 96 + 1;
  for (int u = bid; u < NU; u += nblk) {
    if (u < 512) {
      mini_gemm(hnb + (size_t)u * 16 * DM, w_dtT, dtraw + (size_t)u * 16 * 16, 16, (float*)lds);
    } else {
      const int j = u - 512;
      const int cf = j < 32 ? 64 + j : (j < 128 ? 160 + (j - 32) : 256);
      const bf16_t* bt = cf < 256 ? w_inT + (size_t)cf * 16 * DM : w_dtT;
      mini_gemm(hnb + (size_t)T * DM, bt, projm + cf * 16, DPROJ, (float*)lds, (bf16_t*)(p.ws + WS_PROJMB) + cf * 16);
    }
  }
  pg8::Gemm g{hnb, w_inT, T, NPROJ, DM};
  pg8::StaticOrder S; S.init(T, NPROJ, nblk, bid);
  pg8::EpiBf16 E{(bf16_t*)(p.ws + WS_PROJ), NPROJ};
  pg8::gemm_phase<pg8::EpiBf16, pg8::StaticOrder>((PG8_LAS unsigned char*)lds, g, S, E);
  if (!stream_first) convert_tables(p, bid, nblk);
}

__device__ __forceinline__ void phase4(const Params& p, unsigned char* lds, int bid, int nblk) {
  pg8::Gemm g{(const bf16_t*)(p.ws + WS_HNB), (const bf16_t*)(p.ws + WS_WOUTT), T, DM, DM};
  pg8::StaticOrder S; S.init(T, DM, nblk, bid);
  pg8::EpiRes E{p.x, (bf16_t*)(p.ws + WS_H1B), (float*)(p.ws + WS_SSQH1)};
  pg8::gemm_phase<pg8::EpiRes, pg8::StaticOrder>((PG8_LAS unsigned char*)lds, g, S, E);
}
__device__ __forceinline__ void phase5(const Params& p, unsigned char* lds, int bid, int nblk) {
  pg8::Gemm g{(const bf16_t*)(p.ws + WS_H1B), (const bf16_t*)(p.ws + WS_WQT), T, DM, DM};
  pg8::StaticOrder S; S.init(T, DM, nblk, bid);
  pg8::EpiScores E{(const bf16_t*)(p.ws + WS_KEYS), (float*)(p.ws + WS_STOP), (int*)(p.ws + WS_ITOP)};
  pg8::gemm_phase<pg8::EpiScores, pg8::StaticOrder>((PG8_LAS unsigned char*)lds, g, S, E);
}

__device__ __forceinline__ float dot2bf(unsigned a, unsigned b, float c) {
  return __builtin_amdgcn_fdot2_f32_bf16(*(bf16v2*)&a, *(bf16v2*)&b, c, false);
}
__device__ __forceinline__ void phase6(const Params& p, unsigned char* lds, int bid, int nblk) {
  const int tid0 = threadIdx.x, lane0 = tid0 & 63, wid = __builtin_amdgcn_readfirstlane(tid0 >> 6);
  int* ids = (int*)(lds + wid * 2048);
  float* gts = (float*)(lds + wid * 2048 + 512);
  float* wts = (float*)(lds + wid * 2048 + 1024);
  int* rid = (int*)(lds + 16384 + wid * 1024);
  float* rgt = (float*)(lds + 16384 + wid * 1024 + 512);
  const unsigned char* ub = p.ws + WS_UB;
  const unsigned char* vb = p.ws + WS_VB;
  const bf16_t* h1b = (const bf16_t*)(p.ws + WS_H1B);
  const float* usc = (const float*)(p.ws + WS_USC);
  const float* vsc = (const float*)(p.ws + WS_VSC);
  const float* ssq = (const float*)(p.ws + WS_SSQH1);
  const float* stop = (const float*)(p.ws + WS_STOP);
  const int* itop = (const int*)(p.ws + WS_ITOP);
  const int ci = kCandI[lane0], cj = kCandJ[lane0];
#pragma unroll 1
  for (int t = bid * 8 + wid; t < T; t += nblk * 8) {
    int tid = tid0; asm volatile("" : "+v"(tid));
    const int lane = tid & 63;
    const int kcode = 8 * ((lane >> 2) & 1) + 4 * ((lane >> 3) & 1) + 2 * ((lane >> 4) & 1) + ((lane >> 5) & 1);
    const float part0 = lane < 32 ? ssq[(size_t)t * 32 + lane] : 0.f;
    const float rr = rsqrtf(wave_sum(part0) * (1.f / DM) + EPS);
#pragma unroll 1
    for (int h = 0; h < 8; ++h) {
      const size_t lbase = ((size_t)t * 16 + h * 2) * 16;
      const float sv = lane < 32 ? __builtin_nontemporal_load(stop + lbase + lane) : 0.f;
      const int iv = lane < 32 ? __builtin_nontemporal_load(itop + lbase + lane) : 0;
      float cand = (__shfl(sv, ci) + __shfl(sv, 16 + cj)) * rr;
      if (lane >= 50) cand = -INFINITY;
      unsigned key = __float_as_uint(cand);
      key = (key & 0x80000000u) ? ~key : (key | 0x80000000u);
      key = (key & ~63u) | (unsigned)(63 - lane);
      int rank = 0;
#pragma unroll
      for (int k = 0; k < 50; ++k) {
        const unsigned kk = (unsigned)__builtin_amdgcn_readlane((int)key, k);
        rank += kk > key ? 1 : 0;
      }
      const float cmax = wave_max(cand);
      const float ex = rank < 16 ? __expf(cand - cmax) : 0.f;
      const float den = wave_sum(ex);
      const int eidx = __shfl(iv, ci) * 128 + __shfl(iv, 16 + cj);
      if (rank < 16) { rid[h * 16 + rank] = eidx; rgt[h * 16 + rank] = ex / den; }
    }
    {
      const int e0 = rid[lane], e1 = rid[lane + 64];
      const float g0 = rgt[lane], g1 = rgt[lane + 64];
      const int r0 = e0 >> 10, r1 = e1 >> 10;
      const unsigned long long ltm = (1ull << lane) - 1ull;
      int run = 0, pos0 = 0, pos1 = 0;
#pragma unroll
      for (int R = 0; R < 16; ++R) {
        const unsigned long long m0 = __ballot(r0 == R), m1 = __ballot(r1 == R);
        const int c0 = __popcll(m0), c1 = __popcll(m1);
        if (r0 == R) pos0 = run + __popcll(m0 & ltm);
        if (r1 == R) pos1 = run + c0 + __popcll(m1 & ltm);
        run += c0 + c1;
      }
      ids[pos0] = e0; gts[pos0] = g0;
      ids[pos1] = e1; gts[pos1] = g1;
    }
    float xf[32];
    {
      const bf16_t* xp = h1b + (size_t)t * DM + lane * 4;
#pragma unroll
      for (int j = 0; j < 8; ++j) {
        const u32x2 xa = *(const u32x2*)(xp + 256 * j);
        xf[4 * j + 0] = bflo(xa.x); xf[4 * j + 1] = bfhi(xa.x); xf[4 * j + 2] = bflo(xa.y); xf[4 * j + 3] = bfhi(xa.y);
      }
    }
#pragma unroll 1
    for (int rnd = 0; rnd < 8; ++rnd) {
      u32x4 ra[16];
#pragma unroll
      for (int k = 0; k < 16; ++k) {
        const int e = __builtin_amdgcn_readfirstlane(ids[rnd * 16 + k]);
        ra[k] = *(const u32x4*)(ub + (size_t)e * ROW4 + lane * 16);
      }
      float part[16];
      float prev = 0.f;
#pragma unroll
      for (int k = 0; k < 16; ++k) {
        asm volatile("" : "+v"(ra[k]) : "v"(prev));
        float d0 = 0.f, d1 = 0.f;
#define U4_STEP(j, i) { const f32x2 r = __builtin_amdgcn_cvt_scalef32_pk_f32_fp4(ra[k][j], 1.0f, i); \
          d0 = fmaf(r[0], xf[8 * (j) + 2 * (i)], d0); d1 = fmaf(r[1], xf[8 * (j) + 2 * (i) + 1], d1); }
#pragma unroll
        for (int j = 0; j < 4; ++j) { U4_STEP(j, 0) U4_STEP(j, 1) U4_STEP(j, 2) U4_STEP(j, 3) }
#undef U4_STEP
        prev = d0 + d1;
        part[k] = prev;
      }
      float q8[8], q4[4], q2[2], q1;
      { const bool hi = (lane >> 5) & 1;
#pragma unroll
        for (int i = 0; i < 8; ++i) { const float keep = hi ? part[2 * i + 1] : part[2 * i], send = hi ? part[2 * i] : part[2 * i + 1]; q8[i] = keep + __shfl_xor(send, 32); } }
      { const bool hi = (lane >> 4) & 1;
#pragma unroll
        for (int i = 0; i < 4; ++i) { const float keep = hi ? q8[2 * i + 1] : q8[2 * i], send = hi ? q8[2 * i] : q8[2 * i + 1]; q4[i] = keep + __shfl_xor(send, 16); } }
      { const bool hi = (lane >> 3) & 1;
#pragma unroll
        for (int i = 0; i < 2; ++i) { const float keep = hi ? q4[2 * i + 1] : q4[2 * i], send = hi ? q4[2 * i] : q4[2 * i + 1]; q2[i] = keep + __shfl_xor(send, 8); } }
      { const bool hi = (lane >> 2) & 1;
        const float keep = hi ? q2[1] : q2[0], send = hi ? q2[0] : q2[1]; q1 = keep + __shfl_xor(send, 4); }
      q1 += __shfl_xor(q1, 2);
      q1 += __shfl_xor(q1, 1);
      {
        const int kk = rnd * 16 + kcode;
        const int eid = ids[kk];
        const float a = q1 * rr * usc[eid];
        const float ge = 0.5f * a * (1.f + erff(a * 0.70710678118654752f));
        if ((lane & 3) == 0) wts[kk] = gts[kk] * ge * vsc[eid];
      }
    }
    float acc[32];
#pragma unroll
    for (int i = 0; i < 32; ++i) acc[i] = 0.f;
#pragma unroll 1
    for (int rnd = 0; rnd < 8; ++rnd) {
      u32x4 ra[16];
#pragma unroll
      for (int k = 0; k < 16; ++k) {
        const int e = __builtin_amdgcn_readfirstlane(ids[rnd * 16 + k]);
        ra[k] = *(const u32x4*)(vb + (size_t)e * ROW4 + lane * 16);
      }
      f32x4 wv[4];
#pragma unroll
      for (int j = 0; j < 4; ++j) wv[j] = *(const f32x4*)(wts + rnd * 16 + 4 * j);
#pragma unroll
      for (int k = 0; k < 16; ++k) {
        const float wk = wv[k >> 2][k & 3];
        asm volatile("" : "+v"(ra[k]) : "v"(acc[1]), "v"(acc[3]), "v"(acc[5]), "v"(acc[7]), "v"(acc[9]), "v"(acc[11]), "v"(acc[13]), "v"(acc[15]),
                                        "v"(acc[17]), "v"(acc[19]), "v"(acc[21]), "v"(acc[23]), "v"(acc[25]), "v"(acc[27]), "v"(acc[29]), "v"(acc[31]));
#define V4_STEP(j, i) { const f32x2 r = __builtin_amdgcn_cvt_scalef32_pk_f32_fp4(ra[k][j], 1.0f, i); \
            acc[8 * (j) + 2 * (i)] = fmaf(wk, r[0], acc[8 * (j) + 2 * (i)]); acc[8 * (j) + 2 * (i) + 1] = fmaf(wk, r[1], acc[8 * (j) + 2 * (i) + 1]); }
#pragma unroll
        for (int j = 0; j < 4; ++j) { V4_STEP(j, 0) V4_STEP(j, 1) V4_STEP(j, 2) V4_STEP(j, 3) }
#undef V4_STEP
      }
    }
    float ss = 0.f;
#pragma unroll
    for (int i = 0; i < 32; ++i) { acc[i] += xf[i]; ss += acc[i] * acc[i]; }
    ss = wave_sum(ss);
    const float rf = rsqrtf(ss * (1.f / DM) + EPS);
#pragma unroll
    for (int j = 0; j < 8; ++j) {
      const f32x4 lw = *(const f32x4*)(p.ln_final + 256 * j + lane * 4);
      const f32x4 o = {acc[4 * j] * rf * lw[0], acc[4 * j + 1] * rf * lw[1], acc[4 * j + 2] * rf * lw[2], acc[4 * j + 3] * rf * lw[3]};
      __builtin_nontemporal_store(o, (f32x4*)(p.out + (size_t)t * DM + 256 * j + lane * 4));
    }
  }
}

typedef float f32x16 __attribute__((ext_vector_type(16)));
__device__ __forceinline__ void unpack8(const u32x4 a, float (&v)[8]) {
  v[0] = bflo(a.x); v[1] = bfhi(a.x); v[2] = bflo(a.y); v[3] = bfhi(a.y); v[4] = bflo(a.z); v[5] = bfhi(a.z); v[6] = bflo(a.w); v[7] = bfhi(a.w);
}
constexpr int VT_LD = 196;
constexpr int ATT_VT_BYTES = 4 * 64 * VT_LD * 2;
__device__ __forceinline__ void attn_item(const Params& p, unsigned char* lds, int item) {
  const int tid = threadIdx.x, lane = tid & 63, wid = __builtin_amdgcn_readfirstlane(tid >> 6);
  const int b = item >> 6, q0 = (item & 63) * 32;
  bf16_t* VT = (bf16_t*)lds;
  float* biasL = (float*)(lds + ATT_VT_BYTES);
  float* ssqw = biasL + 16 * 132;
  const bf16_t* proj = (const bf16_t*)(p.ws + WS_PROJ);
  const float* projm = (const float*)(p.ws + WS_PROJM);
  bf16_t* mixin = (bf16_t*)(p.ws + WS_HNB);
#pragma unroll
  for (int it = 0; it < 5; ++it) {
    const int idx = it * NTHREADS + tid;
    if (idx >= 16 * 129) break;
    const int hq = idx / 129, d = idx - hq * 129;
    const int bk = d < 128 ? (int)kBucket[d] : 31;
    biasL[hq * 132 + d] = p.rel_bias[bk * 16 + hq];
  }
  const int ql = lane & 31, ql0 = ql, hh = lane >> 5, kvh = wid >> 1;
  const int trow = b * SEQ + q0 + ql;
  bf16x8 qf[4];
  u32x4 kf[6][4];
#define ATT_LOAD_Q(hq_)                                                                                                           \
  { _Pragma("unroll") for (int ks = 0; ks < 4; ++ks) qf[ks] = *(const bf16x8*)(proj + (size_t)trow * NPROJ + OFF_Q + (hq_) * 64 + ks * 16 + hh * 8); }
#define ATT_LOAD_K()                                                                                                              \
  {                                                                                                                               \
    int ql = ql0; asm volatile("" : "+v"(ql));     \
    const float* kr_ = projm + (size_t)(ql & 15) * DPROJ + OFF_K + kvh * 64 + hh * 8;                                             \
    _Pragma("unroll") for (int ks = 0; ks < 4; ++ks) {                                                                            \
      const f32x4 a_ = *(const f32x4*)(kr_ + ks * 16), c_ = *(const f32x4*)(kr_ + ks * 16 + 4);                                   \
      kf[0][ks].x = pack_bf16(a_[0], a_[1]); kf[0][ks].y = pack_bf16(a_[2], a_[3]); kf[0][ks].z = pack_bf16(c_[0], c_[1]); kf[0][ks].w = pack_bf16(c_[2], c_[3]); } \
    _Pragma("unroll") for (int jt = 1; jt < 6; ++jt) {                                                                            \
      int sp_ = q0 - 128 + 32 * (jt - 1) + ql; sp_ = sp_ < 0 ? 0 : sp_;                                                           \
      const bf16_t* kp_ = proj + (size_t)(b * SEQ + sp_) * NPROJ + OFF_K + kvh * 64 + hh * 8;                                     \
      _Pragma("unroll") for (int ks = 0; ks < 4; ++ks) kf[jt][ks] = *(const u32x4*)(kp_ + ks * 16); }                             \
  }
  ATT_LOAD_Q(2 * wid)
#pragma unroll 1
  for (int rep_ = 0; rep_ < (REP_SUB == 2 ? 2 : 1); ++rep_) {
    u32x4 ra[5], rc[5];
#pragma unroll
    for (int q = 0; q < 5; ++q) {
      const int task = q * NTHREADS + tid, ch = task / 80, pi = task - ch * 80;
      int s0 = q0 - 128 + 2 * pi;
      s0 = s0 < 0 ? 0 : s0;
      const bf16_t* r0 = proj + (size_t)(b * SEQ + s0) * NPROJ + OFF_V + ch * 8;
      ra[q] = *(const u32x4*)r0; rc[q] = *(const u32x4*)(r0 + NPROJ);
    }
    float m0[8], m1[8];
    {
      const int pi = tid & 7, ch = (tid >> 3) & 31;
      const float* r0 = projm + (size_t)(2 * pi) * DPROJ + OFF_V + ch * 8;
      const f32x4 ma = *(const f32x4*)r0, mb = *(const f32x4*)(r0 + 4), mc = *(const f32x4*)(r0 + DPROJ), md = *(const f32x4*)(r0 + DPROJ + 4);
      const float keep = tid < 256 ? 1.f : 0.f;
#pragma unroll
      for (int i = 0; i < 4; ++i) { m0[i] = ma[i] * keep; m0[4 + i] = mb[i] * keep; m1[i] = mc[i] * keep; m1[4 + i] = md[i] * keep; }
      bf16_t* dst = VT + (size_t)((ch >> 3) * 64 + (ch & 7) * 8) * VT_LD + 2 * pi + (tid < 256 ? 0 : 16);
#pragma unroll
      for (int i = 0; i < 8; ++i) *(unsigned*)(dst + i * VT_LD) = pack_bf16(m0[i], m1[i]);
    }
#pragma unroll
    for (int q = 0; q < 5; ++q) {
      const int task = q * NTHREADS + tid, ch = task / 80, pi = task - ch * 80;
      float v0[8], v1[8];
      unpack8(ra[q], v0); unpack8(rc[q], v1);
      bf16_t* dst = VT + (size_t)((ch >> 3) * 64 + (ch & 7) * 8) * VT_LD + 32 + 2 * pi;
#pragma unroll
      for (int i = 0; i < 8; ++i) *(unsigned*)(dst + i * VT_LD) = pack_bf16(v0[i], v1[i]);
    }
  }
  __syncthreads();
  float ssq = 0.f;
#pragma unroll 1
  for (int rep_ = 0; rep_ < (REP_SUB == 3 ? 2 : 1); ++rep_) {
  ssq = 0.f;
  auto do_head = [&](const int hsel) __attribute__((always_inline)) {
    const int hq = 2 * wid + hsel;
    f32x16 sacc[6];
#pragma unroll
    for (int jt = 0; jt < 6; ++jt) {
      f32x16 acc;
#pragma unroll
      for (int r = 0; r < 16; ++r) acc[r] = 0.f;
#pragma unroll
      for (int ks = 0; ks < 4; ++ks) acc = __builtin_amdgcn_mfma_f32_32x32x16_bf16(*(bf16x8*)&kf[jt][ks], qf[ks], acc, 0, 0, 0);
      sacc[jt] = acc;
    }
    if (hsel == 0) { ATT_LOAD_Q(2 * wid + 1) }
    const float* bl = biasL + hq * 132;
    int sq = q0 + ql, qh = ql - 4 * hh;
    asm volatile("" : "+v"(sq), "+v"(qh));
    const float sink = p.sinks[hq];
    float m = sink;
#pragma unroll
    for (int jt = 0; jt < 6; ++jt) {
      asm volatile("" ::: "memory");
#pragma unroll
      for (int r = 0; r < 16; ++r) {
        const int kr = (r & 3) + 8 * (r >> 2) + 4 * hh;
        int dist; bool valid;
        if (jt == 0) { dist = sq + (16 - ((r & 3) + 8 * (r >> 2))) - 4 * hh; valid = kr < 16; }
        else { dist = qh + (128 - 32 * (jt - 1) - ((r & 3) + 8 * (r >> 2))); valid = (dist >= 0) && (dist < 128) && (dist <= sq); }
        const int dc = dist < 0 ? 0 : (dist > 128 ? 128 : dist);
        const float l = valid ? 0.125f * sacc[jt][r] + bl[dc] : -1e30f;
        sacc[jt][r] = l;
        m = fmaxf(m, l);
      }
    }
    m = fmaxf(m, __shfl_xor(m, 32));
    float sum = 0.f;
    f32x16 oacc0, oacc1;
#pragma unroll
    for (int r = 0; r < 16; ++r) { oacc0[r] = 0.f; oacc1[r] = 0.f; }
    const bf16_t* vrow0 = VT + (size_t)(kvh * 64 + ql) * VT_LD + 4 * hh;
    const bf16_t* vrow1 = vrow0 + 32 * VT_LD;
#pragma unroll
    for (int jt = 0; jt < 6; ++jt) {
      u32x4 pw[2];
#pragma unroll
      for (int s2 = 0; s2 < 2; ++s2) {
        float e[8];
#pragma unroll
        for (int i = 0; i < 8; ++i) { e[i] = __expf(sacc[jt][8 * s2 + i] - m); sum += e[i]; }
        pw[s2].x = pack_bf16(e[0], e[1]); pw[s2].y = pack_bf16(e[2], e[3]); pw[s2].z = pack_bf16(e[4], e[5]); pw[s2].w = pack_bf16(e[6], e[7]);
      }
#pragma unroll
      for (int s2 = 0; s2 < 2; ++s2) {
        const u32x2 va = *(const u32x2*)(vrow0 + 32 * jt + 16 * s2), vc = *(const u32x2*)(vrow0 + 32 * jt + 16 * s2 + 8);
        const u32x2 vd = *(const u32x2*)(vrow1 + 32 * jt + 16 * s2), ve = *(const u32x2*)(vrow1 + 32 * jt + 16 * s2 + 8);
        u32x4 v0w; v0w.x = va.x; v0w.y = va.y; v0w.z = vc.x; v0w.w = vc.y;
        u32x4 v1w; v1w.x = vd.x; v1w.y = vd.y; v1w.z = ve.x; v1w.w = ve.y;
        oacc0 = __builtin_amdgcn_mfma_f32_32x32x16_bf16(*(bf16x8*)&v0w, *(bf16x8*)&pw[s2], oacc0, 0, 0, 0);
        oacc1 = __builtin_amdgcn_mfma_f32_32x32x16_bf16(*(bf16x8*)&v1w, *(bf16x8*)&pw[s2], oacc1, 0, 0, 0);
      }
    }
    sum += __shfl_xor(sum, 32);
    const float inv = 1.f / (sum + __expf(sink - m));
#pragma unroll
    for (int r = 0; r < 16; ++r) { oacc0[r] *= inv; oacc1[r] *= inv; ssq += oacc0[r] * oacc0[r] + oacc1[r] * oacc1[r]; }
#pragma unroll
    for (int rg = 0; rg < 4; ++rg) {
      u32x2 w; w.x = pack_bf16(oacc0[rg * 4 + 0], oacc0[rg * 4 + 1]); w.y = pack_bf16(oacc0[rg * 4 + 2], oacc0[rg * 4 + 3]);
      *(u32x2*)(mixin + (size_t)trow * DM + hq * 64 + 8 * rg + 4 * hh) = w;
      u32x2 w1; w1.x = pack_bf16(oacc1[rg * 4 + 0], oacc1[rg * 4 + 1]); w1.y = pack_bf16(oacc1[rg * 4 + 2], oacc1[rg * 4 + 3]);
      *(u32x2*)(mixin + (size_t)trow * DM + hq * 64 + 32 + 8 * rg + 4 * hh) = w1;
    }
  };
  ATT_LOAD_K()
  do_head(0);
  asm volatile("" ::: "memory");
  ATT_LOAD_K()
  do_head(1);
  }
  ssq += __shfl_xor(ssq, 32);
  if (lane < 32) ssqw[wid * 32 + lane] = ssq;
  __syncthreads();
  float tot = 0.f;
#pragma unroll
  for (int w = 0; w < 8; ++w) tot += ssqw[w * 32 + ql];
  const float ra = rsqrtf(tot * (1.f / 1024) + EPS);
#pragma unroll
  for (int hsel = 0; hsel < 2; ++hsel)
#pragma unroll
    for (int dt = 0; dt < 2; ++dt)
#pragma unroll
      for (int rg = 0; rg < 4; ++rg) {
        bf16_t* op = mixin + (size_t)trow * DM + (2 * wid + hsel) * 64 + 32 * dt + 8 * rg + 4 * hh;
        const u32x2 v = *(const u32x2*)op;
        u32x2 w; w.x = pack_bf16(bflo(v.x) * ra, bfhi(v.x) * ra); w.y = pack_bf16(bflo(v.y) * ra, bfhi(v.y) * ra);
        *(u32x2*)op = w;
      }
  __syncthreads();
}
#undef ATT_LOAD_Q
#undef ATT_LOAD_K
__device__ __forceinline__ void phase2_attn(const Params& p, unsigned char* lds, int bid, int nblk) {
  for (int item = bid; item < 256; item += nblk) attn_item(p, lds, item);
}

constexpr int SLD = 136;
__device__ __forceinline__ float conv_silu(const float (&raw)[11], int i, float w0, float w1, float w2, float w3, float cb) {
  return silu_f(cb + w0 * raw[i] + w1 * raw[i + 1] + w2 * raw[i + 2] + w3 * raw[i + 3]);
}
__device__ __forceinline__ void ssd_a_item(const Params& p, unsigned char* lds, int item) {
  const int tid = threadIdx.x, lane = tid & 63, wid = __builtin_amdgcn_readfirstlane(tid >> 6);
  const int b = item >> 6, c = (item >> 2) & 15, g = (item >> 1) & 1, hsel = item & 1;
  const int h0 = g * 8 + hsel * 4;
  const int t0 = b * SEQ + c * 128;
  bf16_t* Bc = (bf16_t*)lds;
  bf16_t* Cc = Bc + 128 * SLD;
  bf16_t* BcT = Cc + 128 * SLD;
  bf16_t* xT = BcT + 128 * SLD;
  float* dtl = (float*)(xT + 2 * 64 * SLD);
  float* acs = dtl + 512;
  float* wl = acs + 512;
  float* scan = wl + 512;
  const bf16_t* __restrict__ proj = (const bf16_t*)(p.ws + WS_PROJ);
  const bf16_t* __restrict__ projmb = (const bf16_t*)(p.ws + WS_PROJMB);
  const float* __restrict__ dtraw = (const float*)(p.ws + WS_DTRAW);
  float* __restrict__ acsg = (float*)(p.ws + WS_ACSG);
  bf16_t* __restrict__ ccb = (bf16_t*)(p.ws + WS_CCB);
  bf16_t* __restrict__ ypart = (bf16_t*)(p.ws + WS_YPART);
  float* __restrict__ sg = (float*)(p.ws + WS_SG);
  {
    const int hi = tid >> 7, l = tid & 127, h = h0 + hi;
    const float Ah = -expf(p.a_log[h]);
    const float dtv = softplus_f(dtraw[(size_t)(t0 + l) * 16 + h] + p.dt_bias[h]);
    dtl[tid] = dtv;
    float cum = dtv * Ah;
#pragma unroll
    for (int o = 1; o < 64; o <<= 1) { const float nb = __shfl_up(cum, o); if (lane >= o) cum += nb; }
    if ((tid & 127) == 63) scan[hi] = cum;
    __syncthreads();
    if (l >= 64) cum += scan[hi];
    acs[tid] = cum;
    acsg[(size_t)(t0 + l) * 16 + h] = cum;
    __syncthreads();
    wl[tid] = dtv * __expf(acs[hi * 128 + 127] - cum);
  }
  {
    unsigned raw[4][11];
#pragma unroll
    for (int q = 0; q < 4; ++q) {
      const int task = q * NTHREADS + tid;
      const int tg = task >> 7, cp = task & 127;
      const int cch = 1024 + (cp >> 6) * 256 + g * 128 + 2 * (cp & 63);
#pragma unroll
      for (int i = 0; i < 11; ++i) {
        const int l = tg * 8 + i - 3;
        const bf16_t* src = (l >= 0 || c > 0) ? proj + (size_t)(t0 + l) * NPROJ : projmb + (size_t)(16 + l) * DPROJ;
        raw[q][i] = *(const unsigned*)(src + OFF_XBC + cch);
      }
    }
#pragma unroll
    for (int q = 0; q < 4; ++q) {
      const int task = q * NTHREADS + tid;
      const int tg = task >> 7, cp = task & 127, n = 2 * (cp & 63);
      const int cch = 1024 + (cp >> 6) * 256 + g * 128 + n;
      float o0[8], o1[8];
      {
        float r0[11], r1[11];
#pragma unroll
        for (int i = 0; i < 11; ++i) { r0[i] = bflo(raw[q][i]); r1[i] = bfhi(raw[q][i]); }
        const float w0 = p.conv_w[cch], w1 = p.conv_w[D_XBC + cch], w2 = p.conv_w[2 * D_XBC + cch], w3 = p.conv_w[3 * D_XBC + cch], cb = p.conv_b[cch];
        const float v0 = p.conv_w[cch + 1], v1 = p.conv_w[D_XBC + cch + 1], v2 = p.conv_w[2 * D_XBC + cch + 1], v3 = p.conv_w[3 * D_XBC + cch + 1], vb_ = p.conv_b[cch + 1];
#pragma unroll
        for (int i = 0; i < 8; ++i) { o0[i] = conv_silu(r0, i, w0, w1, w2, w3, cb); o1[i] = conv_silu(r1, i, v0, v1, v2, v3, vb_); }
      }
      bf16_t* rowm = (cp < 64 ? Bc : Cc) + (tg * 8) * SLD + n;
#pragma unroll
      for (int i = 0; i < 8; ++i) *(unsigned*)(rowm + i * SLD) = pack_bf16(o0[i], o1[i]);
      if (cp < 64) {
        u32x4 w; w.x = pack_bf16(o0[0], o0[1]); w.y = pack_bf16(o0[2], o0[3]); w.z = pack_bf16(o0[4], o0[5]); w.w = pack_bf16(o0[6], o0[7]);
        *(u32x4*)(BcT + n * SLD + tg * 8) = w;
        u32x4 w2_; w2_.x = pack_bf16(o1[0], o1[1]); w2_.y = pack_bf16(o1[2], o1[3]); w2_.z = pack_bf16(o1[4], o1[5]); w2_.w = pack_bf16(o1[6], o1[7]);
        *(u32x4*)(BcT + (n + 1) * SLD + tg * 8) = w2_;
      }
    }
  }
  float xraw[4][11];
#define SSD_LOAD_X(r_)                                                                                              \
  _Pragma("unroll") for (int q = 0; q < 4; ++q) {                                                                   \
    const int task = (q & 1) * NTHREADS + tid; const int tg = task >> 6, cch = (h0 + 2 * (r_) + (q >> 1)) * 64 + (task & 63); \
    _Pragma("unroll") for (int i = 0; i < 11; ++i) { const int l = tg * 8 + i - 3;                                  \
      const bf16_t* src = (l >= 0 || c > 0) ? proj + (size_t)(t0 + l) * NPROJ : projmb + (size_t)(16 + l) * DPROJ;  \
      xraw[q][i] = bf2f(src[OFF_XBC + cch]); } }
  SSD_LOAD_X(0)
  __syncthreads();
  if (hsel == 0) {
#pragma unroll
    for (int q = 0; q < 4; ++q) {
      const int idx = q * NTHREADS + tid, row = idx >> 4, ck = idx & 15;
      *(u32x4*)(ccb + (size_t)(t0 + row) * 256 + g * 128 + ck * 8) = *(const u32x4*)(Cc + row * SLD + ck * 8);
    }
  }
  const int ql = lane & 31, hh = lane >> 5;
  auto ydiag = [&](const int hi, const int il) __attribute__((always_inline)) {
    const int h = h0 + hi, ip = wid & 1;
    const bf16_t* xTb = xT + (hi & 1) * 64 * SLD;
    const float dskip = p.d_skip[h];
    const float* acsh = acs + hi * 128;
    const float* dtlh = dtl + hi * 128;
    const int l = 32 * il + ql;
    const float acl = acsh[l];
    f32x16 yacc;
#pragma unroll
    for (int r = 0; r < 16; ++r) yacc[r] = 0.f;
    const bf16_t* xrow = xTb + (32 * ip + ql) * SLD + 4 * hh;
#pragma unroll 1
    for (int is = 0; is <= il; ++is) {
      f32x16 x;
#pragma unroll
      for (int r = 0; r < 16; ++r) x[r] = 0.f;
      const bf16_t* ap = Bc + (32 * is + ql) * SLD + 8 * hh;
      const bf16_t* bp = Cc + l * SLD + 8 * hh;
#pragma unroll
      for (int ks = 0; ks < 8; ++ks) x = __builtin_amdgcn_mfma_f32_32x32x16_bf16(*(const bf16x8*)(ap + 16 * ks), *(const bf16x8*)(bp + 16 * ks), x, 0, 0, 0);
      u32x4 pw[2];
#pragma unroll
      for (int s2 = 0; s2 < 2; ++s2) {
        float mv[8];
#pragma unroll
        for (int q = 0; q < 2; ++q) {
          const int sb = 32 * is + 16 * s2 + 8 * q + 4 * hh;
          const f32x4 as4 = *(const f32x4*)(acsh + sb), dt4 = *(const f32x4*)(dtlh + sb);
#pragma unroll
          for (int j = 0; j < 4; ++j) {
            const int sr = sb + j;
            float v = sr <= l ? x[8 * s2 + 4 * q + j] * __expf(acl - as4[j]) * dt4[j] : 0.f;
            if (sr == l) v += dskip;
            mv[4 * q + j] = v;
          }
        }
        pw[s2].x = pack_bf16(mv[0], mv[1]); pw[s2].y = pack_bf16(mv[2], mv[3]); pw[s2].z = pack_bf16(mv[4], mv[5]); pw[s2].w = pack_bf16(mv[6], mv[7]);
      }
#pragma unroll
      for (int s2 = 0; s2 < 2; ++s2) {
        const u32x2 va = *(const u32x2*)(xrow + 32 * is + 16 * s2), vc = *(const u32x2*)(xrow + 32 * is + 16 * s2 + 8);
        u32x4 aw; aw.x = va.x; aw.y = va.y; aw.z = vc.x; aw.w = vc.y;
        yacc = __builtin_amdgcn_mfma_f32_32x32x16_bf16(*(bf16x8*)&aw, *(bf16x8*)&pw[s2], yacc, 0, 0, 0);
      }
    }
    bf16_t* yp = ypart + (size_t)(t0 + l) * 1024 + h * 64 + 32 * ip + 4 * hh;
#pragma unroll
    for (int rg = 0; rg < 4; ++rg) { u32x2 w; w.x = pack_bf16(yacc[4 * rg], yacc[4 * rg + 1]); w.y = pack_bf16(yacc[4 * rg + 2], yacc[4 * rg + 3]); *(u32x2*)(yp + 8 * rg) = w; }
  };
  auto states = [&](const int hi) __attribute__((always_inline)) {
    const int h = h0 + hi, ip = wid & 1, in = wid >> 1;
    const bf16_t* xTb = xT + (hi & 1) * 64 * SLD;
    const float* wlh = wl + hi * 128;
    f32x16 sacc;
#pragma unroll
    for (int r = 0; r < 16; ++r) sacc[r] = 0.f;
    const bf16_t* ap = xTb + (32 * ip + ql) * SLD + 8 * hh;
    const bf16_t* bp = BcT + (32 * in + ql) * SLD + 8 * hh;
#pragma unroll
    for (int ks = 0; ks < 8; ++ks) {
      const u32x4 xa = *(const u32x4*)(ap + 16 * ks);
      const f32x4 wa = *(const f32x4*)(wlh + 16 * ks + 8 * hh), wb = *(const f32x4*)(wlh + 16 * ks + 8 * hh + 4);
      u32x4 aw;
      aw.x = pack_bf16(bflo(xa.x) * wa[0], bfhi(xa.x) * wa[1]); aw.y = pack_bf16(bflo(xa.y) * wa[2], bfhi(xa.y) * wa[3]);
      aw.z = pack_bf16(bflo(xa.z) * wb[0], bfhi(xa.z) * wb[1]); aw.w = pack_bf16(bflo(xa.w) * wb[2], bfhi(xa.w) * wb[3]);
      sacc = __builtin_amdgcn_mfma_f32_32x32x16_bf16(*(bf16x8*)&aw, *(const bf16x8*)(bp + 16 * ks), sacc, 0, 0, 0);
    }
    float* sp = sg + ((size_t)((b * 16 + c) * 16 + h) * 64 + 32 * ip + 4 * hh) * 128 + 32 * in + ql;
#pragma unroll
    for (int r = 0; r < 16; ++r) sp[((r & 3) + 8 * (r >> 2)) * 128] = sacc[r];
  };
#pragma unroll 1
  for (int rnd_ = 0; rnd_ < (REP_SUB == 5 ? 4 : 2); ++rnd_) {
    const int rnd = rnd_ & 1;
#pragma unroll
    for (int q = 0; q < 4; ++q) {
      const int task = (q & 1) * NTHREADS + tid; const int tg = task >> 6, pch = task & 63, cch = (h0 + 2 * rnd + (q >> 1)) * 64 + pch;
      const float w0 = p.conv_w[cch], w1 = p.conv_w[D_XBC + cch], w2 = p.conv_w[2 * D_XBC + cch], w3 = p.conv_w[3 * D_XBC + cch], cb = p.conv_b[cch];
      float o[8];
#pragma unroll
      for (int i = 0; i < 8; ++i) o[i] = conv_silu(xraw[q], i, w0, w1, w2, w3, cb);
      u32x4 w; w.x = pack_bf16(o[0], o[1]); w.y = pack_bf16(o[2], o[3]); w.z = pack_bf16(o[4], o[5]); w.w = pack_bf16(o[6], o[7]);
      *(u32x4*)(xT + (q >> 1) * 64 * SLD + pch * SLD + tg * 8) = w;
    }
    { SSD_LOAD_X((rnd + 1) & 1) }
    __syncthreads();
    ydiag(2 * rnd, wid >> 1);
    ydiag(2 * rnd + 1, 3 - (wid >> 1));
    states(2 * rnd);
    states(2 * rnd + 1);
    __syncthreads();
  }
#undef SSD_LOAD_X
  __syncthreads();
}

__device__ __forceinline__ void meta_state_item(const Params& p, unsigned char* lds, int h) {
  const int tid = threadIdx.x, g = h >> 3;
  float* xm = (float*)lds;
  float* bm = xm + 16 * 64;
  float* dtm = bm + 16 * 128;
  const float* projm = (const float*)(p.ws + WS_PROJM);
  float* smeta = (float*)(p.ws + WS_SMETA);
  for (int task = tid; task < 16 * 192; task += NTHREADS) {
    const int i = task / 192, ch = task - i * 192;
    const int cch = ch < 64 ? h * 64 + ch : 1024 + g * 128 + (ch - 64);
    float acc = p.conv_b[cch];
#pragma unroll
    for (int j = 0; j < 4; ++j) { const int mi = i - j; if (mi >= 0) acc += p.conv_w[(3 - j) * D_XBC + cch] * projm[(size_t)mi * DPROJ + OFF_XBC + cch]; }
    const float v = silu_f(acc);
    if (ch < 64) xm[i * 64 + ch] = v; else bm[i * 128 + ch - 64] = v;
  }
  if (tid < 16) dtm[tid] = softplus_f(projm[(size_t)tid * DPROJ + OFF_DT + h] + p.dt_bias[h]);
  __syncthreads();
  const float Ah = -expf(p.a_log[h]);
  const int pr = tid >> 3, n0 = (tid & 7) * 16;
  float st[16];
#pragma unroll
  for (int k = 0; k < 16; ++k) st[k] = 0.f;
  for (int i = 0; i < 16; ++i) {
    const float dtv = dtm[i], dA = expf(dtv * Ah), xdt = xm[i * 64 + pr] * dtv;
#pragma unroll
    for (int k = 0; k < 16; ++k) st[k] = fmaf(st[k], dA, xdt * bm[i * 128 + n0 + k]);
  }
#pragma unroll
  for (int k = 0; k < 16; ++k) smeta[(size_t)(h * 64 + pr) * 128 + n0 + k] = st[k];
  __syncthreads();
}

__device__ __forceinline__ void phase2(const Params& p, unsigned char* lds, int bid, int nblk) {
  const bool remap = (nblk == 256);
#pragma unroll 1
  for (int rep = 0; rep < (REP_SUB == 0 ? 2 : 1); ++rep)
    for (int it = bid; it < 256; it += nblk) attn_item(p, lds, remap ? ((it & 7) * 32 + (it >> 3)) : it);
#pragma unroll 1
  for (int rep = 0; rep < (REP_SUB == 1 ? 2 : 1); ++rep)
    for (int it = bid; it < 256; it += nblk) ssd_a_item(p, lds, remap ? ((it & 7) * 32 + (it >> 3)) : it);
  for (int item = bid; item < 16; item += nblk) meta_state_item(p, lds, item);
}

__device__ __forceinline__ void phase_scan(const Params& p, int bid, int nblk) {
  const float* __restrict__ sg = (const float*)(p.ws + WS_SG);
  const float* __restrict__ smeta = (const float*)(p.ws + WS_SMETA);
  const float* __restrict__ acsg = (const float*)(p.ws + WS_ACSG);
  bf16_t* __restrict__ hprev = (bf16_t*)(p.ws + WS_HPREV);
  for (int task = bid * NTHREADS + threadIdx.x; task < 64 * 2048; task += nblk * NTHREADS) {
    const int bh = task >> 11, e4 = (task & 2047) * 4;
    const int b = bh >> 4, h = bh & 15;
    f32x4 sv[16];
    float dv[16];
#pragma unroll
    for (int c = 0; c < 16; ++c) {
      sv[c] = *(const f32x4*)(sg + (size_t)((b * 16 + c) * 16 + h) * 8192 + e4);
      dv[c] = acsg[(size_t)(b * SEQ + c * 128 + 127) * 16 + h];
    }
    f32x4 H = *(const f32x4*)(smeta + (size_t)h * 8192 + e4);
#pragma unroll
    for (int c = 0; c < 16; ++c) {
      u32x2 w; w.x = pack_bf16(H[0], H[1]); w.y = pack_bf16(H[2], H[3]);
      *(u32x2*)(hprev + (size_t)((b * 16 + c) * 16 + h) * 8192 + e4) = w;
      H = H * __expf(dv[c]) + sv[c];
    }
  }
}

__device__ __forceinline__ void ssd_b_item(const Params& p, unsigned char* lds, int item) {
  const int tid = threadIdx.x, lane = tid & 63, wid = __builtin_amdgcn_readfirstlane(tid >> 6);
  const int b = item >> 6, c = (item >> 2) & 15, g = (item >> 1) & 1, lh = item & 1, h = g * 8 + wid;
  const int t0 = b * SEQ + c * 128 + lh * 64;
  const int ql = lane & 31, hh = lane >> 5;
  constexpr int YLD = 520;
  bf16_t* yoff = (bf16_t*)lds;
  const bf16_t* __restrict__ proj = (const bf16_t*)(p.ws + WS_PROJ);
  const float* __restrict__ acsg = (const float*)(p.ws + WS_ACSG);
  const bf16_t* __restrict__ ccb = (const bf16_t*)(p.ws + WS_CCB);
  const bf16_t* __restrict__ ypart = (const bf16_t*)(p.ws + WS_YPART);
  const bf16_t* __restrict__ hprev = (const bf16_t*)(p.ws + WS_HPREV);
  bf16_t* __restrict__ mixin = (bf16_t*)(p.ws + WS_HNB);
  {
    const bf16_t* hp = hprev + (size_t)((b * 16 + c) * 16 + h) * 8192 + (size_t)ql * 128 + 8 * hh;
    u32x4 hf0[8], hf1[8];
#pragma unroll
    for (int ks = 0; ks < 8; ++ks) { hf0[ks] = *(const u32x4*)(hp + 16 * ks); hf1[ks] = *(const u32x4*)(hp + 32 * 128 + 16 * ks); }
#pragma unroll
    for (int il = 0; il < 2; ++il) {
      const int lt = 32 * il + ql, t = t0 + lt;
      const bf16_t* cp = ccb + (size_t)t * 256 + g * 128 + 8 * hh;
      u32x4 cf[8];
#pragma unroll
      for (int ks = 0; ks < 8; ++ks) cf[ks] = *(const u32x4*)(cp + 16 * ks);
      const float ea = __expf(acsg[(size_t)t * 16 + h]);
      f32x16 a0, a1;
#pragma unroll
      for (int r = 0; r < 16; ++r) { a0[r] = 0.f; a1[r] = 0.f; }
#pragma unroll
      for (int ks = 0; ks < 8; ++ks) {
        a0 = __builtin_amdgcn_mfma_f32_32x32x16_bf16(*(bf16x8*)&hf0[ks], *(bf16x8*)&cf[ks], a0, 0, 0, 0);
        a1 = __builtin_amdgcn_mfma_f32_32x32x16_bf16(*(bf16x8*)&hf1[ks], *(bf16x8*)&cf[ks], a1, 0, 0, 0);
      }
      bf16_t* yr = yoff + lt * YLD + wid * 64 + 4 * hh;
#pragma unroll
      for (int rg = 0; rg < 4; ++rg) {
        u32x2 w0; w0.x = pack_bf16(ea * a0[4 * rg], ea * a0[4 * rg + 1]); w0.y = pack_bf16(ea * a0[4 * rg + 2], ea * a0[4 * rg + 3]);
        u32x2 w1; w1.x = pack_bf16(ea * a1[4 * rg], ea * a1[4 * rg + 1]); w1.y = pack_bf16(ea * a1[4 * rg + 2], ea * a1[4 * rg + 3]);
        *(u32x2*)(yr + 8 * rg) = w0;
        *(u32x2*)(yr + 32 + 8 * rg) = w1;
      }
    }
  }
  __syncthreads();
#pragma unroll
  for (int bt = 0; bt < 2; ++bt) {
    u32x4 yy[4], zz[4], yo[4];
#pragma unroll
    for (int q = 0; q < 4; ++q) {
      const int lt = wid * 8 + bt * 4 + q, t = t0 + lt;
      yy[q] = __builtin_nontemporal_load((const u32x4*)(ypart + (size_t)t * 1024 + g * 512 + lane * 8));
      zz[q] = __builtin_nontemporal_load((const u32x4*)(proj + (size_t)t * NPROJ + OFF_Z + g * 512 + lane * 8));
      yo[q] = *(const u32x4*)(yoff + lt * YLD + lane * 8);
    }
#pragma unroll
    for (int q = 0; q < 4; ++q) {
      const int t = t0 + wid * 8 + bt * 4 + q;
      float zv[8], ov[8], yv[8], y[8];
      unpack8(zz[q], zv); unpack8(yo[q], ov); unpack8(yy[q], yv);
#pragma unroll
      for (int i = 0; i < 8; ++i) y[i] = (yv[i] + ov[i]) * silu_f(zv[i]);
      float ss = 0.f;
#pragma unroll
      for (int i = 0; i < 8; ++i) ss += y[i] * y[i];
      ss = wave_sum(ss);
      const float rn = rsqrtf(ss * (1.f / 512) + EPS);
      u32x4 w; w.x = pack_bf16(y[0] * rn, y[1] * rn); w.y = pack_bf16(y[2] * rn, y[3] * rn); w.z = pack_bf16(y[4] * rn, y[5] * rn); w.w = pack_bf16(y[6] * rn, y[7] * rn);
      *(u32x4*)(mixin + (size_t)t * DM + 1024 + g * 512 + lane * 8) = w;
    }
  }
  __syncthreads();
}
__device__ __forceinline__ void phase3(const Params& p, unsigned char* lds, int bid, int nblk) {
  for (int it = bid; it < 256; it += nblk) ssd_b_item(p, lds, (nblk == 256) ? ((it & 7) * 32 + (it >> 3)) : it);
}

constexpr int LDS_BYTES = 144 * 1024;

typedef const Params __attribute__((address_space(4))) * KArgPtr;
__device__ __forceinline__ Params load_params(KArgPtr k) {
  Params q;
#if defined(__HIP_DEVICE_COMPILE__)
  __builtin_memcpy(&q, k, sizeof(Params));
#endif
  return q;
}
#define PARAMS_PTR(pp) KArgPtr pp##_k = (KArgPtr)__builtin_amdgcn_kernarg_segment_ptr(); asm volatile("" : "+s"(pp##_k)); const Params pp##_v = load_params(pp##_k); const Params* pp = &pp##_v
__global__ __launch_bounds__(512, 2) void k_mega(Params p_unused) {
  extern __shared__ __attribute__((aligned(16))) unsigned char shm[];
  const int bid = blockIdx.x, nblk = gridDim.x;
  volatile LAS unsigned* xst = (volatile LAS unsigned*)(LAS unsigned char*)(shm + LDS_BYTES - 16);
  if (threadIdx.x == 0) { xst[0] = 0u; xst[1] = 0u; }
  __syncthreads();
  XcdBarrier xb;
  { PARAMS_PTR(pp); xb = xcd_barrier_post((unsigned*)(pp->ws + WS_CTL), xst); }
#ifndef REP_PHASE
#define REP_PHASE -1
#endif
#define NREP(k) ((REP_PHASE == (k)) ? 2 : 1)
#ifndef REP_ALL
#define REP_ALL 1
#endif
#pragma unroll 1
  for (int pass = 0; pass < REP_ALL; ++pass) {
  if (pass) xcd_barrier(xb);
#pragma unroll 1
  for (int rep = 0; rep < NREP(0); ++rep) { { PARAMS_PTR(pp); phase0(*pp, (float*)shm, bid, nblk); } if (rep + 1 < NREP(0)) xcd_barrier(xb); }
  xcd_barrier(xb);
#pragma unroll 1
  for (int rep = 0; rep < NREP(1); ++rep) { { PARAMS_PTR(pp); phase1(*pp, shm, bid, nblk); } xcd_barrier(xb); }
#pragma unroll 1
  for (int rep = 0; rep < NREP(2); ++rep) { { PARAMS_PTR(pp); phase2(*pp, shm, bid, nblk); } xcd_barrier(xb); }
#pragma unroll 1
  for (int rep = 0; rep < NREP(7); ++rep) { { PARAMS_PTR(pp); phase_scan(*pp, bid, nblk); } xcd_barrier(xb); }
#pragma unroll 1
  for (int rep = 0; rep < NREP(3); ++rep) { { PARAMS_PTR(pp); phase3(*pp, shm, bid, nblk); } xcd_barrier(xb); }
#pragma unroll 1
  for (int rep = 0; rep < NREP(4); ++rep) { { PARAMS_PTR(pp); phase4(*pp, shm, bid, nblk); } xcd_barrier(xb); }
#pragma unroll 1
  for (int rep = 0; rep < NREP(5); ++rep) { { PARAMS_PTR(pp); phase5(*pp, shm, bid, nblk); } xcd_barrier(xb); }
#pragma unroll 1
  for (int rep = 0; rep < NREP(6); ++rep) { { PARAMS_PTR(pp); phase6(*pp, shm, bid, nblk); } if (rep + 1 < NREP(6)) xcd_barrier(xb); }
  }
}

}

extern "C" void kernel_launch(void* const* d_in, const int* in_sizes, int n_in, void* d_out, int out_size, void* d_ws,
                              size_t ws_size, hipStream_t stream) {
  Params p{};
  p.x = (const float*)d_in[0]; p.meta = (const float*)d_in[1]; p.rel_bias = (const float*)d_in[2];
  p.ln_mix = (const float*)d_in[3]; p.w_in = (const float*)d_in[4]; p.sinks = (const float*)d_in[5];
  p.conv_w = (const float*)d_in[6]; p.conv_b = (const float*)d_in[7]; p.dt_bias = (const float*)d_in[8];
  p.a_log = (const float*)d_in[9]; p.d_skip = (const float*)d_in[10]; p.attn_norm_w = (const float*)d_in[11];
  p.ssm_norm_w = (const float*)d_in[12]; p.w_out = (const float*)d_in[13]; p.ln_ffn = (const float*)d_in[14];
  p.wq = (const float*)d_in[15]; p.keys = (const float*)d_in[16]; p.U = (const float*)d_in[17];
  p.V = (const float*)d_in[18]; p.ln_final = (const float*)d_in[19];
  p.out = (float*)d_out;
  p.ws = (unsigned char*)d_ws;

  static int grid_blocks = 0;
  if (!grid_blocks) {
    int dev = 0, cus = 0, per_cu = 0;
    (void)hipGetDevice(&dev);
    (void)hipDeviceGetAttribute(&cus, hipDeviceAttributeMultiprocessorCount, dev);
    (void)hipFuncSetAttribute((const void*)k_mega, hipFuncAttributeMaxDynamicSharedMemorySize, LDS_BYTES);
    (void)hipOccupancyMaxActiveBlocksPerMultiprocessor(&per_cu, (const void*)k_mega, NTHREADS, LDS_BYTES);
    if (per_cu > 1) per_cu = 1;
    grid_blocks = cus * per_cu;
    if (grid_blocks != 256) fprintf(stderr, "kernel_launch: expected a 256-workgroup resident grid, got %d (cus %d, per_cu %d)\n", grid_blocks, cus, per_cu);
  }
  (void)hipMemsetAsync(p.ws + WS_CTL, 0, XCD_BAR_WORDS * 4, stream);
  void* args[] = {&p};
  hipError_t e = hipLaunchCooperativeKernel((const void*)k_mega, dim3(grid_blocks), dim3(NTHREADS), args, LDS_BYTES, stream);
  if (e != hipSuccess) fprintf(stderr, "cooperative launch failed: %s (grid %d)\n", hipGetErrorString(e), grid_blocks);
}
```

```cpp
#include <hip/hip_runtime.h>
#include <math.h>
#include <stdio.h>
#include <stdint.h>

#ifndef REP_SUB
#define REP_SUB -1
#endif
namespace {
constexpr int BATCH = 4, SEQ = 2048, DM = 2048, NMETA = 16;
constexpr int T = BATCH * SEQ;
constexpr int TA = T + NMETA;
constexpr int DPROJ = 4112;
constexpr int NPROJ = 4096;
constexpr int OFF_Q = 0, OFF_K = 1024, OFF_V = 1280, OFF_Z = 1536, OFF_XBC = 2560, OFF_DT = 4096;
constexpr int D_XBC = 1536;
constexpr int NEXP = 16384;
constexpr int ROW4 = 1024;
constexpr int ROW6 = 1536;
constexpr float EPS = 1e-6f;
constexpr int NTHREADS = 512;

typedef unsigned short bf16_t;
typedef short bf16x8 __attribute__((ext_vector_type(8)));
typedef float f32x4 __attribute__((ext_vector_type(4)));
typedef float f32x2 __attribute__((ext_vector_type(2)));
typedef unsigned u32x4 __attribute__((ext_vector_type(4)));
typedef unsigned u32x2 __attribute__((ext_vector_type(2)));
typedef __bf16 bf16v2 __attribute__((ext_vector_type(2)));
typedef float f32x16v __attribute__((ext_vector_type(16)));
typedef float f32x32v __attribute__((ext_vector_type(32)));
typedef unsigned u32x6 __attribute__((ext_vector_type(6)));
#define LAS __attribute__((address_space(3)))

__device__ __forceinline__ unsigned pack_bf16(float lo, float hi) {
  f32x2 v = {lo, hi};
  bf16v2 b = __builtin_convertvector(v, bf16v2);
  return *(unsigned*)&b;
}
__device__ __forceinline__ bf16_t f2bf(float f) { return (bf16_t)(pack_bf16(f, 0.f) & 0xffffu); }
__device__ __forceinline__ float bf2f(bf16_t b) { return __uint_as_float(((unsigned)b) << 16); }
__device__ __forceinline__ float bflo(unsigned u) { return __uint_as_float(u << 16); }
__device__ __forceinline__ float bfhi(unsigned u) { return __uint_as_float(u & 0xffff0000u); }

__constant__ unsigned char kBucket[128] = {
    0, 1, 2, 3, 4, 5, 6, 7, 8, 9, 10, 11, 12, 13, 14, 15, 16, 16, 16, 17, 17, 18, 18, 18, 19, 19, 19, 20, 20, 20, 20, 21,
    21, 21, 21, 22, 22, 22, 22, 22, 23, 23, 23, 23, 23, 23, 24, 24, 24, 24, 24, 24, 25, 25, 25, 25, 25, 25, 25, 26, 26, 26, 26, 26,
    26, 26, 26, 27, 27, 27, 27, 27, 27, 27, 27, 27, 27, 28, 28, 28, 28, 28, 28, 28, 28, 28, 28, 29, 29, 29, 29, 29, 29, 29, 29, 29,
    29, 29, 29, 30, 30, 30, 30, 30, 30, 30, 30, 30, 30, 30, 30, 30, 30, 31, 31, 31, 31, 31, 31, 31, 31, 31, 31, 31, 31, 31, 31, 31};

__constant__ unsigned char kCandI[64] = {0, 0, 0, 0, 0, 0, 0, 0, 0, 0, 0, 0, 0, 0, 0, 0, 1, 1, 1, 1, 1, 1, 1, 1, 2, 2, 2, 2, 2, 3, 3, 3, 3, 4, 4, 4, 5, 5, 6, 6, 7, 7, 8, 9, 10, 11, 12, 13, 14, 15, 15, 15, 15, 15, 15, 15, 15, 15, 15, 15, 15, 15, 15, 15};
__constant__ unsigned char kCandJ[64] = {0, 1, 2, 3, 4, 5, 6, 7, 8, 9, 10, 11, 12, 13, 14, 15, 0, 1, 2, 3, 4, 5, 6, 7, 0, 1, 2, 3, 4, 0, 1, 2, 3, 0, 1, 2, 0, 1, 0, 1, 0, 1, 0, 0, 0, 0, 0, 0, 0, 0, 15, 15, 15, 15, 15, 15, 15, 15, 15, 15, 15, 15, 15, 15};

__device__ __forceinline__ float wave_sum(float v) {
  for (int o = 32; o > 0; o >>= 1) v += __shfl_xor(v, o);
  return v;
}
__device__ __forceinline__ float wave_max(float v) {
  for (int o = 32; o > 0; o >>= 1) v = fmaxf(v, __shfl_xor(v, o));
  return v;
}
__device__ __forceinline__ float silu_f(float x) { return x / (1.f + expf(-x)); }
__device__ __forceinline__ float softplus_f(float x) { return fmaxf(x, 0.f) + log1pf(expf(-fabsf(x))); }

constexpr size_t al256(size_t x) { return (x + 255) & ~(size_t)255; }
constexpr size_t WS_CTL = 0;
constexpr size_t WS_WINT = 65536;
constexpr size_t WS_WDTT = WS_WINT + (size_t)NPROJ * DM * 2;
constexpr size_t WS_WOUTT = WS_WDTT + (size_t)16 * DM * 2;
constexpr size_t WS_WQT = WS_WOUTT + (size_t)DM * DM * 2;
constexpr size_t WS_KEYS = WS_WQT + (size_t)DM * DM * 2;
constexpr size_t WS_UB = WS_KEYS + (size_t)16 * 128 * 128 * 2;
constexpr size_t WS_VB = WS_UB + (size_t)NEXP * DM * 2;
constexpr size_t WS_HNB = WS_VB + (size_t)NEXP * DM * 2;
constexpr size_t WS_PROJ = WS_HNB + (size_t)(T + 16) * DM * 2;
constexpr size_t WS_DTRAW = WS_PROJ + (size_t)T * NPROJ * 2;
constexpr size_t WS_PROJM = WS_DTRAW + (size_t)T * 16 * 4;
constexpr size_t WS_PROJMB = al256(WS_PROJM + (size_t)16 * DPROJ * 4);
constexpr size_t WS_H1B = al256(WS_PROJMB + (size_t)16 * DPROJ * 2);
constexpr size_t WS_SSQH1 = WS_H1B + (size_t)T * DM * 2;
constexpr size_t WS_STOP = al256(WS_SSQH1 + (size_t)T * 32 * 4);
constexpr size_t WS_ITOP = WS_STOP + (size_t)T * 256 * 4;
constexpr size_t WS_ACSG = al256(WS_ITOP + (size_t)T * 256 * 4);
constexpr size_t WS_CCB = WS_ACSG + (size_t)T * 16 * 4;
constexpr size_t WS_YPART = WS_CCB + (size_t)T * 256 * 2;
constexpr size_t WS_SG = WS_YPART + (size_t)T * 1024 * 4;
constexpr size_t WS_SMETA = WS_SG + (size_t)1024 * 8192 * 4;
constexpr size_t WS_HPREV = al256(WS_SMETA + (size_t)16 * 8192 * 4);
constexpr size_t WS_USC = al256(WS_HPREV + (size_t)1024 * 8192 * 2);
constexpr size_t WS_VSC = WS_USC + (size_t)NEXP * 4;
constexpr size_t WS_SCR = al256(WS_VSC + (size_t)NEXP * 4);
}

namespace pg8 {
#define PG8_LAS __attribute__((address_space(3)))
constexpr int BM = 256, BK = 64, HALF = 128, HTB = HALF * BK * 2, STAGE_BYTES = 8 * HTB, NXCD = 8, WGM = 8;
__host__ __device__ __forceinline__ int lds_byte(int r, int c) { const int st = (r >> 4) * 2 + (c >> 5), rr = r & 15, cc = c & 31, ob = rr * 64 + cc * 2; return st * 1024 + (ob ^ (((ob >> 9) & 1) << 5)); }
__host__ __device__ __forceinline__ void stage_rc(int b, int& R, int& C) { const int st = b / 1024, sb = b % 1024, swz = sb ^ (((sb >> 9) & 1) << 5); R = (st >> 1) * 16 + swz / 64; C = (st & 1) * 32 + (swz % 64) / 2; }
__host__ __device__ __forceinline__ int perm32(int rho) { const int n = rho >> 4, i = rho & 15; return 8 * (i >> 2) + 4 * n + (i & 3); }
struct Unit { int pm, pn; };
struct Gemm { const bf16_t* A; const bf16_t* Bt; int M, N, K; };
struct StaticOrder {
    int nM, nN, nwg, G, c;
    __host__ __device__ void init(int M, int N, int G_, int c_) { nM = M / BM; nN = N / BM; nwg = nM * nN; G = G_; c = c_; }
    __host__ __device__ bool next(int i, Unit& u) const {
        const long L = (long)i * G + c; if (L >= nwg) return false;
        int wgid = (int)L; { const int q = nwg / NXCD, r = nwg % NXCD, xcd = wgid % NXCD, off = wgid / NXCD; wgid = (xcd < r ? xcd * (q + 1) : r * (q + 1) + (xcd - r) * q) + off; }
        const int nig = WGM * nN, gid = wgid / nig, fm = gid * WGM, gsz = (nM - fm) < WGM ? (nM - fm) : WGM;
        u.pm = fm + ((wgid % nig) % gsz); u.pn = (wgid % nig) / gsz; return true;
    }
    __device__ __forceinline__ void a_ready(const Unit&) const {}
    __device__ __forceinline__ void done(const Unit&) const {}
};
struct EpiBf16 {
    static constexpr bool PERM = true, AFTER_DRAIN = false;
    bf16_t* O; int ldc;
    __device__ __forceinline__ void operator()(const f32x4 (&acc)[2][2][4][2], const Unit& u, int wr, int wc, int fr, int fq) const {
        const int row0 = u.pm * BM + wr * 64 + fr; const int col0 = u.pn * BM + wc * 32 + 8 * fq;
        const __amdgpu_buffer_rsrc_t rsrc = __builtin_amdgcn_make_buffer_rsrc(O, 0, 0x7fffffff, 0x00020000);
#pragma unroll
        for (int ai = 0; ai < 2; ++ai)
#pragma unroll
            for (int m = 0; m < 4; ++m) { const unsigned boff = (unsigned)(((size_t)(row0 + ai * HALF + m * 16) * ldc + col0) * 2);
#pragma unroll
                for (int bj = 0; bj < 2; ++bj) { const f32x4 v0 = acc[ai][bj][m][0], v1 = acc[ai][bj][m][1];
                    u32x4 w; w.x = pack_bf16(v0[0], v0[1]); w.y = pack_bf16(v0[2], v0[3]); w.z = pack_bf16(v1[0], v1[1]); w.w = pack_bf16(v1[2], v1[3]);
                    __builtin_amdgcn_raw_buffer_store_b128(w, rsrc, boff + bj * HALF * 2, 0, 16); } }
    }
};

struct EpiRes {
    static constexpr bool PERM = true, AFTER_DRAIN = false;
    const float* X; bf16_t* HB; float* SSQ;
    __device__ __forceinline__ void operator()(const f32x4 (&acc)[2][2][4][2], const Unit& u, int wr, int wc, int fr, int fq) const {
        const int row0 = u.pm * BM + wr * 64 + fr; const int col0 = u.pn * BM + wc * 32 + 8 * fq;
#pragma unroll
        for (int ai = 0; ai < 2; ++ai) {
            f32x4 xr[4][2][2];
#pragma unroll
            for (int m = 0; m < 4; ++m) { const size_t off = (size_t)(row0 + ai * HALF + m * 16) * DM + col0;
#pragma unroll
                for (int bj = 0; bj < 2; ++bj) { xr[m][bj][0] = __builtin_nontemporal_load((const f32x4*)(X + off + bj * HALF)); xr[m][bj][1] = __builtin_nontemporal_load((const f32x4*)(X + off + bj * HALF + 4)); } }
#pragma unroll
            for (int m = 0; m < 4; ++m) { const int row = row0 + ai * HALF + m * 16; const size_t off = (size_t)row * DM + col0; float ss = 0.f;
#pragma unroll
                for (int bj = 0; bj < 2; ++bj) {
                    const f32x4 v0 = acc[ai][bj][m][0] + xr[m][bj][0], v1 = acc[ai][bj][m][1] + xr[m][bj][1];
                    u32x4 w; w.x = pack_bf16(v0[0], v0[1]); w.y = pack_bf16(v0[2], v0[3]); w.z = pack_bf16(v1[0], v1[1]); w.w = pack_bf16(v1[2], v1[3]);
                    *(u32x4*)(HB + off + bj * HALF) = w;
                    ss += v0[0] * v0[0] + v0[1] * v0[1] + v0[2] * v0[2] + v0[3] * v0[3] + v1[0] * v1[0] + v1[1] * v1[1] + v1[2] * v1[2] + v1[3] * v1[3]; }
                ss += __shfl_xor(ss, 16); ss += __shfl_xor(ss, 32);
                if (fq == 0) SSQ[(size_t)row * 32 + u.pn * 4 + wc] = ss; }
        }
    }
};
struct EpiF32 {
    static constexpr bool PERM = true, AFTER_DRAIN = false;
    float* C; int ldc;
    __device__ __forceinline__ void operator()(const f32x4 (&acc)[2][2][4][2], const Unit& u, int wr, int wc, int fr, int fq) const {
        const int row0 = u.pm * BM + wr * 64 + fr; const int col0 = u.pn * BM + wc * 32 + 8 * fq;
#pragma unroll
        for (int ai = 0; ai < 2; ++ai)
#pragma unroll
            for (int m = 0; m < 4; ++m) { float* rowp = C + (size_t)(row0 + ai * HALF + m * 16) * ldc + col0;
#pragma unroll
                for (int bj = 0; bj < 2; ++bj) { *(f32x4*)(rowp + bj * HALF) = acc[ai][bj][m][0]; *(f32x4*)(rowp + bj * HALF + 4) = acc[ai][bj][m][1]; } }
    }
};

struct EpiScores {
    static constexpr bool PERM = true, AFTER_DRAIN = true;
    const bf16_t* KEYS;
    float* STOP; int* ITOP;
    static constexpr int QLD = 264;
    __device__ __forceinline__ void fused(f32x4 (&acc)[2][2][4][2], const Unit& u, int wr, int wc, int fr, int fq, PG8_LAS unsigned char* lds, int wid, int lane) const {
        PG8_LAS bf16_t* Q = (PG8_LAS bf16_t*)lds;
#pragma unroll
        for (int ai = 0; ai < 2; ++ai)
#pragma unroll
            for (int m = 0; m < 4; ++m) { const int row = ai * HALF + wr * 64 + m * 16 + fr;
#pragma unroll
                for (int bj = 0; bj < 2; ++bj) { const f32x4 v0 = acc[ai][bj][m][0], v1 = acc[ai][bj][m][1];
                    u32x4 w; w.x = pack_bf16(v0[0], v0[1]); w.y = pack_bf16(v0[2], v0[3]); w.z = pack_bf16(v1[0], v1[1]); w.w = pack_bf16(v1[2], v1[3]);
                    *(PG8_LAS u32x4*)(Q + row * QLD + bj * HALF + wc * 32 + 8 * fq) = w; } }
        __syncthreads();
        const int h = u.pn;
#pragma unroll 1
        for (int c = 0; c < 2; ++c) {
            f32x4 sc[8][2];
#pragma unroll
            for (int kf = 0; kf < 8; ++kf) { sc[kf][0] = (f32x4){0.f, 0.f, 0.f, 0.f}; sc[kf][1] = (f32x4){0.f, 0.f, 0.f, 0.f}; }
            const bf16_t* kb = KEYS + (size_t)((h * 2 + c) * 128 + fr) * 128 + 8 * fq;
            const PG8_LAS bf16_t* qb = Q + (wid * 32 + fr) * QLD + c * 128 + 8 * fq;
#pragma unroll
            for (int ks = 0; ks < 4; ++ks) {
                const bf16x8 q0 = *(const PG8_LAS bf16x8*)(qb + 32 * ks), q1 = *(const PG8_LAS bf16x8*)(qb + 16 * QLD + 32 * ks);
#pragma unroll
                for (int kf = 0; kf < 8; ++kf) { const bf16x8 kv = *(const bf16x8*)(kb + (size_t)kf * 16 * 128 + 32 * ks);
                    sc[kf][0] = __builtin_amdgcn_mfma_f32_16x16x32_bf16(kv, q0, sc[kf][0], 0, 0, 0);
                    sc[kf][1] = __builtin_amdgcn_mfma_f32_16x16x32_bf16(kv, q1, sc[kf][1], 0, 0, 0); }
            }
#pragma unroll
            for (int tf = 0; tf < 2; ++tf) {
                int v[32];
#pragma unroll
                for (int kf = 0; kf < 8; ++kf)
#pragma unroll
                    for (int r = 0; r < 4; ++r) {
                        const int bts = (int)__float_as_uint(sc[kf][tf][r]);
                        const int srt = bts ^ ((bts >> 31) & 0x7fffffff);
                        v[kf * 4 + r] = (srt & ~127) | (16 * kf + 4 * fq + r);
                    }
#pragma unroll
                for (int k = 2; k <= 32; k <<= 1)
#pragma unroll
                    for (int j = k >> 1; j > 0; j >>= 1)
#pragma unroll
                        for (int i = 0; i < 32; ++i) {
                            const int l = i ^ j;
                            if (l > i) {
                                const int x = v[i], y = v[l];
                                const int hi_ = x > y ? x : y, lo_ = x > y ? y : x;
                                if ((i & k) == 0) { v[i] = hi_; v[l] = lo_; } else { v[i] = lo_; v[l] = hi_; }
                            }
                        }
#pragma unroll
                for (int step = 0; step < 2; ++step) {
                    const int xm = step == 0 ? 16 : 32;
                    int m[16];
#pragma unroll
                    for (int i = 0; i < 16; ++i) { const int o = __shfl_xor(v[15 - i], xm); m[i] = v[i] > o ? v[i] : o; }
#pragma unroll
                    for (int j = 8; j > 0; j >>= 1)
#pragma unroll
                        for (int i = 0; i < 16; ++i) {
                            const int l = i ^ j;
                            if (l > i) { const int x = m[i], y = m[l]; m[i] = x > y ? x : y; m[l] = x > y ? y : x; }
                        }
#pragma unroll
                    for (int i = 0; i < 16; ++i) v[i] = m[i];
                }
                if (fq == 0) {
                    const size_t obase = ((size_t)(u.pm * BM + wid * 32 + tf * 16 + fr) * 16 + h * 2 + c) * 16;
#pragma unroll
                    for (int q4 = 0; q4 < 4; ++q4) {
                        f32x4 sv; u32x4 iv;
#pragma unroll
                        for (int i = 0; i < 4; ++i) {
                            const int key = v[4 * q4 + i], srt = key & ~127;
                            sv[i] = __uint_as_float((unsigned)(srt ^ ((srt >> 31) & 0x7fffffff)));
                            iv[i] = (unsigned)(key & 127);
                        }
                        *(f32x4*)(STOP + obase + 4 * q4) = sv;
                        *(u32x4*)(ITOP + obase + 4 * q4) = iv;
                    }
                }
            }
        }
    }
};

template <class Epi, class Sched>
__device__ __forceinline__ void gemm_phase(PG8_LAS unsigned char* lds, const Gemm g, const Sched& S, const Epi& E) {
    int tid_ = threadIdx.x; asm volatile("" : "+v"(tid_));
    const int tid = tid_, wid = __builtin_amdgcn_readfirstlane(tid >> 6), lane = tid & 63, wr = wid >> 2, wc = wid & 3, fr = lane & 15, fq = lane >> 4;
    const int K = g.K, nt = K / BK;
    unsigned voffA[2], voffB[2];
#pragma unroll
    for (int i = 0; i < 2; ++i) { int R, C; stage_rc(tid * 16 + i * 8192, R, C); const int Rb = Epi::PERM ? ((R & ~31) + perm32(R & 31)) : R;
        voffA[i] = (unsigned)(R * K + C) * 2u; voffB[i] = (unsigned)(Rb * K + C) * 2u; }
    const size_t kstep = (size_t)(BK * 2);
    const size_t hstep = (size_t)HALF * K * 2;
    const size_t tstep = 2 * hstep;
    const unsigned ldsw = (unsigned)wid * 1024u;
    const int aoff = lds_byte(wr * 64 + fr, fq * 8), boff = lds_byte(wc * 32 + fr, fq * 8);
#define PG8_SA(b, h) (((b) * 2 + (h)) * HTB)
#define PG8_SB(b, h) ((4 + (b) * 2 + (h)) * HTB)
#define PG8_STAGE(bufoff, gbase, voff) do { _Pragma("unroll") for (int _i = 0; _i < 2; ++_i) \
        __builtin_amdgcn_global_load_lds((const unsigned*)((const char*)(gbase) + (voff)[_i]), (PG8_LAS unsigned*)(lds + (bufoff) + ldsw + _i * 8192), 16, 0, 0); } while (0)
#define PG8_LDA(dst, b, h) do { _Pragma("unroll") for (int m = 0; m < 4; ++m) _Pragma("unroll") for (int k = 0; k < 2; ++k) dst[m][k] = *(const PG8_LAS bf16x8*)(lds + PG8_SA(b, h) + aoff + m * 2048 + k * 1024); } while (0)
#define PG8_LDB(dst, b, h) do { _Pragma("unroll") for (int n = 0; n < 2; ++n) _Pragma("unroll") for (int k = 0; k < 2; ++k) dst[n][k] = *(const PG8_LAS bf16x8*)(lds + PG8_SB(b, h) + boff + n * 2048 + k * 1024); } while (0)
#define PG8_MMA(ai, bj, At, Bt) do { __builtin_amdgcn_s_setprio(1); _Pragma("unroll") for (int m = 0; m < 4; ++m) _Pragma("unroll") for (int n = 0; n < 2; ++n) _Pragma("unroll") for (int k = 0; k < 2; ++k) \
        acc[ai][bj][m][n] = __builtin_amdgcn_mfma_f32_16x16x32_bf16(Bt[n][k], At[m][k], acc[ai][bj][m][n], 0, 0, 0); __builtin_amdgcn_s_setprio(0); } while (0)
#define PG8_WAIT_V(n) asm volatile("s_waitcnt vmcnt(" #n ")" ::: "memory")
#define PG8_WAIT_L(n) asm volatile("s_waitcnt lgkmcnt(" #n ")" ::: "memory")
#define PG8_BAR __builtin_amdgcn_s_barrier()
#define PG8_SCHED __builtin_amdgcn_sched_barrier(0)
    Unit cur, nxt; int ui = 0;
    if (!S.next(0, cur)) return;
    f32x4 acc[2][2][4][2];
#pragma unroll
    for (int a = 0; a < 2; ++a)
#pragma unroll
        for (int b = 0; b < 2; ++b)
#pragma unroll
            for (int m = 0; m < 4; ++m)
#pragma unroll
                for (int n = 0; n < 2; ++n) acc[a][b][m][n] = (f32x4){0.f, 0.f, 0.f, 0.f};
    bf16x8 At[4][2], B0[2][2], B1[2][2];
    const char* cA = (const char*)g.A + (size_t)cur.pm * tstep; const char* cB = (const char*)g.Bt + (size_t)cur.pn * tstep;
    S.a_ready(cur);
    PG8_STAGE(PG8_SB(0, 0), cB, voffB); PG8_STAGE(PG8_SA(0, 0), cA, voffA); PG8_STAGE(PG8_SB(0, 1), cB + hstep, voffB); PG8_STAGE(PG8_SA(0, 1), cA + hstep, voffA);
    if (wr == 1) PG8_BAR;
    PG8_WAIT_V(4); PG8_BAR;
    PG8_STAGE(PG8_SB(1, 0), cB + kstep, voffB); PG8_STAGE(PG8_SA(1, 0), cA + kstep, voffA); PG8_STAGE(PG8_SB(1, 1), cB + hstep + kstep, voffB);
    PG8_WAIT_V(6); PG8_BAR;
    for (;;) {
        const bool has_next = S.next(ui + 1, nxt);
        const char* nA = has_next ? (const char*)g.A + (size_t)nxt.pm * tstep : cA; const char* nB = has_next ? (const char*)g.Bt + (size_t)nxt.pn * tstep : cB;
        for (int t = 0; t < nt; t += 2) {
            const bool last = (t == nt - 2);
            const char* a1 = cA + (size_t)(t + 1) * kstep;
            const char* a2 = last ? nA : cA + (size_t)(t + 2) * kstep; const char* b2 = last ? nB : cB + (size_t)(t + 2) * kstep;
            const char* a3 = a2 + kstep; const char* b3 = b2 + kstep;
            if (last && has_next) S.a_ready(nxt);
            PG8_LDB(B0, 0, 0); PG8_SCHED; PG8_LDA(At, 0, 0); PG8_STAGE(PG8_SA(1, 1), a1 + hstep, voffA);
            PG8_WAIT_L(8); PG8_BAR; PG8_WAIT_L(0); PG8_MMA(0, 0, At, B0); PG8_BAR; PG8_SCHED;
            PG8_LDB(B1, 0, 1); PG8_STAGE(PG8_SB(0, 0), b2, voffB);
            PG8_BAR; PG8_WAIT_L(0); PG8_MMA(0, 1, At, B1); PG8_BAR;
            PG8_LDA(At, 0, 1); PG8_STAGE(PG8_SA(0, 0), a2, voffA);
            PG8_BAR; PG8_WAIT_L(0); PG8_MMA(1, 0, At, B0); PG8_BAR; PG8_SCHED;
            PG8_STAGE(PG8_SB(0, 1), b2 + hstep, voffB);
            PG8_WAIT_V(6); PG8_BAR; PG8_MMA(1, 1, At, B1); PG8_BAR;
            PG8_LDB(B0, 1, 0); PG8_SCHED; PG8_LDA(At, 1, 0); PG8_STAGE(PG8_SA(0, 1), a2 + hstep, voffA);
            PG8_WAIT_L(8); PG8_BAR; PG8_WAIT_L(0); PG8_MMA(0, 0, At, B0); PG8_BAR; PG8_SCHED;
            PG8_LDB(B1, 1, 1); PG8_STAGE(PG8_SB(1, 0), b3, voffB);
            PG8_BAR; PG8_WAIT_L(0); PG8_MMA(0, 1, At, B1); PG8_BAR;
            PG8_LDA(At, 1, 1); PG8_STAGE(PG8_SA(1, 0), a3, voffA);
            PG8_BAR; PG8_WAIT_L(0); PG8_MMA(1, 0, At, B0); PG8_BAR; PG8_SCHED;
            PG8_STAGE(PG8_SB(1, 1), b3 + hstep, voffB);
            PG8_WAIT_V(6); PG8_BAR; PG8_MMA(1, 1, At, B1); PG8_BAR;
        }
        if constexpr (!Epi::AFTER_DRAIN) { E(acc, cur, wr, wc, fr, fq); S.done(cur); }
        if (!has_next) break;
#pragma unroll
        for (int a = 0; a < 2; ++a)
#pragma unroll
            for (int b = 0; b < 2; ++b)
#pragma unroll
                for (int m = 0; m < 4; ++m)
#pragma unroll
                    for (int n = 0; n < 2; ++n) acc[a][b][m][n] = (f32x4){0.f, 0.f, 0.f, 0.f};
        cur = nxt; cA = nA; cB = nB; ++ui;
    }
    PG8_WAIT_V(0);
    if (wr == 0) PG8_BAR;
    PG8_BAR;
    if constexpr (Epi::AFTER_DRAIN) { E.fused(acc, cur, wr, wc, fr, fq, lds, wid, lane); S.done(cur); }
#undef PG8_SA
#undef PG8_SB
#undef PG8_STAGE
#undef PG8_LDA
#undef PG8_LDB
#undef PG8_MMA
#undef PG8_WAIT_V
#undef PG8_WAIT_L
#undef PG8_BAR
#undef PG8_SCHED
}
}

#define XB_TMO      128
#define XB_XCNT(j)  (256  + 64 * (j))
#define XB_XSUB(j)  (1280 + 64 * (j))
#define XB_XGEN(j)  (2304 + 64 * (j))
#define XB_TOP      3328
#define XB_TOPGEN   3392
#define XCD_BAR_WORDS 3456
#define XB_SPIN_CAP (1u << 22)
__device__ __forceinline__ unsigned xb_ld(unsigned* p)              { return __hip_atomic_load(p, __ATOMIC_RELAXED, __HIP_MEMORY_SCOPE_AGENT); }
__device__ __forceinline__ unsigned xb_add(unsigned* p, unsigned v) { return __hip_atomic_fetch_add(p, v, __ATOMIC_RELAXED, __HIP_MEMORY_SCOPE_AGENT); }
__device__ __forceinline__ unsigned xb_xcc_id() { return (unsigned)__builtin_amdgcn_s_getreg((3 << 11) | 20) & 0xFu; }
#define XB_SPIN(cond, bar) do { unsigned _sp = 0; while (cond) { __builtin_amdgcn_s_sleep(1); \
    if ((++_sp & 255u) == 0u) { if (xb_ld(&(bar)[XB_TMO])) break; if (_sp > XB_SPIN_CAP) { atomicAdd(&(bar)[XB_TMO], 1u); break; } } } } while (0)
struct XcdBarrier { unsigned* bar; unsigned x; volatile LAS unsigned* st; };
__device__ __forceinline__ XcdBarrier xcd_barrier_post(unsigned* bar, volatile LAS unsigned* st) {
    XcdBarrier b; b.bar = bar; b.x = xb_xcc_id(); b.st = st;
    if (threadIdx.x == 0) (void)xb_add(&bar[XB_XCNT(b.x)], 1u);
    return b;
}
__device__ __forceinline__ void xcd_barrier_complete(unsigned* bar, unsigned x, unsigned& nloc, unsigned& nx) {
    const unsigned G = gridDim.x * gridDim.y * gridDim.z;
    unsigned sum, cnt, mine, sp = 0u;
    for (;;) {
        sum = 0u; cnt = 0u; mine = 0u;
#pragma unroll
        for (unsigned j = 0; j < 16; ++j) { const unsigned c = xb_ld(&bar[XB_XCNT(j)]); sum += c; cnt += (c > 0u) ? 1u : 0u; mine = (j == x) ? c : mine; }
        if (sum == G) break;
        __builtin_amdgcn_s_sleep(1);
        if ((++sp & 255u) == 0u) { if (xb_ld(&bar[XB_TMO])) break; if (sp > XB_SPIN_CAP) { atomicAdd(&bar[XB_TMO], 1u); break; } }
    }
    nloc = mine > 0u ? mine : 1u; nx = cnt > 0u ? cnt : 1u;
}
__device__ __forceinline__ void xcd_barrier(const XcdBarrier& b) {
    asm volatile("s_waitcnt vmcnt(0)" ::: "memory");
    __syncthreads();
    if (threadIdx.x == 0) {
        unsigned* bar = b.bar;
        const unsigned bx = xb_xcc_id();
        __builtin_amdgcn_s_waitcnt(0);
        unsigned nloc = b.st[0], nx = b.st[1];
        if (nloc == 0u) { xcd_barrier_complete(bar, bx, nloc, nx); b.st[0] = nloc; b.st[1] = nx; }
        const unsigned old = xb_add(&bar[XB_XSUB(bx)], 1u);
        const unsigned gen = old / nloc;
        if (old + 1u == (gen + 1u) * nloc) {
            __builtin_amdgcn_fence(__ATOMIC_RELEASE, "agent");
            asm volatile("s_waitcnt vmcnt(0)" ::: "memory");
            const unsigned og = xb_add(&bar[XB_TOP], 1u);
            const unsigned tg = og / nx;
            if (og + 1u == (tg + 1u) * nx) xb_add(&bar[XB_TOPGEN], 1u);
            else XB_SPIN(xb_ld(&bar[XB_TOPGEN]) == tg, bar);
            __builtin_amdgcn_fence(__ATOMIC_ACQUIRE, "agent");
            xb_add(&bar[XB_XGEN(bx)], 1u);
            asm volatile("s_waitcnt vmcnt(0)" ::: "memory");
        } else {
            XB_SPIN(xb_ld(&bar[XB_XGEN(bx)]) == gen, bar);
            __builtin_amdgcn_fence(__ATOMIC_ACQUIRE, "agent");
            asm volatile("s_waitcnt vmcnt(0)" ::: "memory");
        }
    }
    __syncthreads();
}

namespace {
struct Params {
  const float *x, *meta, *rel_bias, *ln_mix, *w_in, *sinks, *conv_w, *conv_b, *dt_bias, *a_log, *d_skip, *attn_norm_w,
      *ssm_norm_w, *w_out, *ln_ffn, *wq, *keys, *U, *V, *ln_final;
  float* out;
  unsigned char* ws;
};

__device__ __forceinline__ void p0_transpose_tile(const float* __restrict__ W, int ldw, bf16_t* __restrict__ Wt, const float* sc0,
                                                  const float* sc1, int k0, int n0, float* tile) {
  const int tid = threadIdx.x;
  {
    const int r = tid >> 6, c4 = (tid & 63) * 4;
    f32x4 v[8];
#pragma unroll
    for (int i = 0; i < 8; ++i) v[i] = __builtin_nontemporal_load((const f32x4*)(W + (size_t)(k0 + r + 8 * i) * ldw + n0 + c4));
#pragma unroll
    for (int i = 0; i < 8; ++i) {
      float s = 1.f;
      const int k = k0 + r + 8 * i;
      if (sc0) s = k < 1024 ? sc0[k] : sc1[k - 1024];
      float* q = tile + (r + 8 * i) * 257 + c4;
      q[0] = v[i][0] * s; q[1] = v[i][1] * s; q[2] = v[i][2] * s; q[3] = v[i][3] * s;
    }
  }
  __syncthreads();
#pragma unroll
  for (int it = 0; it < 4; ++it) {
    const int task = it * NTHREADS + tid;
    const int n = task >> 3, kc = (task & 7) * 8;
    float v[8];
#pragma unroll
    for (int j = 0; j < 8; ++j) v[j] = tile[(kc + j) * 257 + n];
    u32x4 w; w.x = pack_bf16(v[0], v[1]); w.y = pack_bf16(v[2], v[3]); w.z = pack_bf16(v[4], v[5]); w.w = pack_bf16(v[6], v[7]);
    *(u32x4*)(Wt + (size_t)(n0 + n) * DM + k0 + kc) = w;
  }
  __syncthreads();
}

__device__ __forceinline__ void phase0(const Params& p, float* ldsf, int bid, int nblk) {
  const int tid = threadIdx.x, lane = tid & 63, wid = tid >> 6;
  bf16_t* w_inT = (bf16_t*)(p.ws + WS_WINT);
  bf16_t* w_dtT = (bf16_t*)(p.ws + WS_WDTT);
  bf16_t* w_outT = (bf16_t*)(p.ws + WS_WOUTT);
  bf16_t* wqT = (bf16_t*)(p.ws + WS_WQT);
  bf16_t* keysb = (bf16_t*)(p.ws + WS_KEYS);
  unsigned char* ub = p.ws + WS_UB;
  unsigned char* vb = p.ws + WS_VB;
  bf16_t* hnb = (bf16_t*)(p.ws + WS_HNB);
  constexpr int U_HN = (TA + 7) / 8;
  constexpr int U_WIN = 32 * 16, U_WOUT = 32 * 8, U_WQ = 32 * 8, U_WDT = 1, U_KEYS = 64;
  constexpr int B_WIN = U_HN, B_WOUT = B_WIN + U_WIN, B_WQ = B_WOUT + U_WOUT, B_WDT = B_WQ + U_WQ, B_KEYS = B_WDT + U_WDT,
                B_U = B_KEYS + U_KEYS, B_END = B_U;
  for (int u = bid; u < B_END; u += nblk) {
    if (u < B_WIN) {
      const int t = u * 8 + wid;
      if (t < TA) {
        const float* src = t < T ? p.x + (size_t)t * DM : p.meta + (size_t)(t - T) * DM;
        float4 v[8];
        float ss = 0.f;
#pragma unroll
        for (int i = 0; i < 8; ++i) {
          { const f32x4 q_ = __builtin_nontemporal_load((const f32x4*)(src + (i * 64 + lane) * 4)); v[i].x = q_[0]; v[i].y = q_[1]; v[i].z = q_[2]; v[i].w = q_[3]; }
          ss += v[i].x * v[i].x + v[i].y * v[i].y + v[i].z * v[i].z + v[i].w * v[i].w;
        }
        ss = wave_sum(ss);
        const float r = rsqrtf(ss * (1.f / DM) + EPS);
#pragma unroll
        for (int i = 0; i < 8; ++i) {
          const float4 w = *(const float4*)(p.ln_mix + (i * 64 + lane) * 4);
          u32x2 o; o.x = pack_bf16(v[i].x * r * w.x, v[i].y * r * w.y); o.y = pack_bf16(v[i].z * r * w.z, v[i].w * r * w.w);
          *(u32x2*)(hnb + (size_t)t * DM + (i * 64 + lane) * 4) = o;
        }
      }
    } else if (u < B_WOUT) {
      const int i = u - B_WIN;
      p0_transpose_tile(p.w_in, DPROJ, w_inT, nullptr, nullptr, (i & 31) * 64, (i >> 5) * 256, ldsf);
    } else if (u < B_WQ) {
      const int i = u - B_WOUT;
      p0_transpose_tile(p.w_out, DM, w_outT, p.attn_norm_w, p.ssm_norm_w, (i & 31) * 64, (i >> 5) * 256, ldsf);
    } else if (u < B_WDT) {
      const int i = u - B_WQ;
      p0_transpose_tile(p.wq, DM, wqT, p.ln_ffn, p.ln_ffn + 1024, (i & 31) * 64, (i >> 5) * 256, ldsf);
    } else if (u < B_KEYS) {
      for (int idx = tid; idx < DM * 16; idx += NTHREADS) {
        const int k = idx >> 4, j = idx & 15;
        w_dtT[(size_t)j * DM + k] = f2bf(p.w_in[(size_t)k * DPROJ + NPROJ + j]);
      }
    } else if (u < B_U) {
      const size_t base = (size_t)(u - B_KEYS) * 4096 + (size_t)tid * 8;
      const float4 a = *(const float4*)(p.keys + base), b = *(const float4*)(p.keys + base + 4);
      u32x4 w; w.x = pack_bf16(a.x, a.y); w.y = pack_bf16(a.z, a.w); w.z = pack_bf16(b.x, b.y); w.w = pack_bf16(b.z, b.w);
      *(u32x4*)(keysb + base) = w;
    }
  }
}

__device__ __forceinline__ void convert_tables(const Params& p, int bid, int nblk) {
  const int tid = threadIdx.x, lane = tid & 63, wid = tid >> 6;
  unsigned char* ub = p.ws + WS_UB;
  unsigned char* vb = p.ws + WS_VB;
  {
    const int gw = bid * 8 + wid, nw = nblk * 8;
    auto load_row = [&](f32x4 (&a)[8], const int r2) __attribute__((always_inline)) {
      const float* src = (r2 < NEXP ? p.U + (size_t)r2 * DM : p.V + (size_t)(r2 - NEXP) * DM) + lane * 4;
#pragma unroll
      for (int j = 0; j < 8; ++j) a[j] = __builtin_nontemporal_load((const f32x4*)(src + 256 * j));
    };
    auto conv_row = [&](f32x4 (&a)[8], const int r2) __attribute__((always_inline)) {
      const bool isU = r2 < NEXP;
      const int row = isU ? r2 : r2 - NEXP;
      if (isU) {
#pragma unroll
        for (int j = 0; j < 8; ++j) a[j] *= *(const f32x4*)(p.ln_ffn + lane * 4 + 256 * j);
      }
      float amax = 0.f;
#pragma unroll
      for (int j = 0; j < 8; ++j) amax = fmaxf(amax, fmaxf(fmaxf(fabsf(a[j][0]), fabsf(a[j][1])), fmaxf(fabsf(a[j][2]), fabsf(a[j][3]))));
      amax = wave_max(amax);
      const float s4 = amax > 0.f ? 6.f / amax : 1.f;
      u32x4 w4;
#pragma unroll
      for (int j = 0; j < 4; ++j) {
        unsigned w = 0;
        w = __builtin_amdgcn_cvt_scalef32_pk_fp4_f32(w, a[2 * j][0] * s4, a[2 * j][1] * s4, 1.0f, 0);
        w = __builtin_amdgcn_cvt_scalef32_pk_fp4_f32(w, a[2 * j][2] * s4, a[2 * j][3] * s4, 1.0f, 1);
        w = __builtin_amdgcn_cvt_scalef32_pk_fp4_f32(w, a[2 * j + 1][0] * s4, a[2 * j + 1][1] * s4, 1.0f, 2);
        w = __builtin_amdgcn_cvt_scalef32_pk_fp4_f32(w, a[2 * j + 1][2] * s4, a[2 * j + 1][3] * s4, 1.0f, 3);
        w4[j] = w;
      }
      *(u32x4*)((isU ? ub : vb) + (size_t)row * ROW4 + lane * 16) = w4;
      if (lane == 0) ((float*)(p.ws + (isU ? WS_USC : WS_VSC)))[row] = amax > 0.f ? amax * (1.f / 6.f) : 1.f;
    };
    f32x4 ra[8], rb[8];
    int r2 = gw;
    if (r2 < 2 * NEXP) load_row(ra, r2);
#pragma unroll 1
    for (; r2 < 2 * NEXP; r2 += 2 * nw) {
      if (r2 + nw < 2 * NEXP) load_row(rb, r2 + nw);
      conv_row(ra, r2);
      if (r2 + nw < 2 * NEXP) {
        if (r2 + 2 * nw < 2 * NEXP) load_row(ra, r2 + 2 * nw);
        conv_row(rb, r2 + nw);
      }
    }
  }
}

__device__ __forceinline__ void mini_gemm(const bf16_t* __restrict__ A, const bf16_t* __restrict__ Bt, float* __restrict__ out, int ldo,
                                          float* red, bf16_t* __restrict__ outb = nullptr) {
  const int tid = threadIdx.x, lane = tid & 63, wid = tid >> 6, fr = lane & 15, fq = lane >> 4;
  f32x4 acc = {0.f, 0.f, 0.f, 0.f};
  const bf16_t* ap = A + (size_t)fr * DM + wid * 256 + fq * 8;
  const bf16_t* bp = Bt + (size_t)fr * DM + wid * 256 + fq * 8;
#pragma unroll
  for (int ks = 0; ks < 8; ++ks) {
    const bf16x8 a = *(const bf16x8*)(ap + ks * 32);
    const bf16x8 b = *(const bf16x8*)(bp + ks * 32);
    acc = __builtin_amdgcn_mfma_f32_16x16x32_bf16(a, b, acc, 0, 0, 0);
  }
#pragma unroll
  for (int r = 0; r < 4; ++r) red[wid * 256 + (4 * fq + r) * 16 + fr] = acc[r];
  __syncthreads();
  if (tid < 256) {
    float s = 0.f;
#pragma unroll
    for (int w = 0; w < 8; ++w) s += red[w * 256 + tid];
    out[(size_t)(tid >> 4) * ldo + (tid & 15)] = s;
    if (outb) outb[(size_t)(tid >> 4) * ldo + (tid & 15)] = f2bf(s);
  }
  __syncthreads();
}

__device__ __forceinline__ void phase1(const Params& p, unsigned char* lds, int bid, int nblk) {
  const bool stream_first = ((bid >> 3) & 1) != 0;
  if (stream_first) convert_tables(p, bid, nblk);
  const bf16_t* hnb = (const bf16_t*)(p.ws + WS_HNB);
  const bf16_t* w_inT = (const bf16_t*)(p.ws + WS_WINT);
  const bf16_t* w_dtT = (const bf16_t*)(p.ws + WS_WDTT);
  float* dtraw = (float*)(p.ws + WS_DTRAW);
  float* projm = (float*)(p.ws + WS_PROJM);
  constexpr int NU = 512 + 32 + 96 + 1;
  for (int u = bid; u < NU; u += nblk) {
    if (u < 512) {
      mini_gemm(hnb + (size_t)u * 16 * DM, w_dtT, dtraw + (size_t)u * 16 * 16, 16, (float*)lds);
    } else {
      const int j = u - 512;
      const int cf = j < 32 ? 64 + j : (j < 128 ? 160 + (j - 32) : 256);
      const bf16_t* bt = cf < 256 ? w_inT + (size_t)cf * 16 * DM : w_dtT;
      mini_gemm(hnb + (size_t)T * DM, bt, projm + cf * 16, DPROJ, (float*)lds, (bf16_t*)(p.ws + WS_PROJMB) + cf * 16);
    }
  }
  pg8::Gemm g{hnb, w_inT, T, NPROJ, DM};
  pg8::StaticOrder S; S.init(T, NPROJ, nblk, bid);
  pg8::EpiBf16 E{(bf16_t*)(p.ws + WS_PROJ), NPROJ};
  pg8::gemm_phase<pg8::EpiBf16, pg8::StaticOrder>((PG8_LAS unsigned char*)lds, g, S, E);
  if (!stream_first) convert_tables(p, bid, nblk);
}

__device__ __forceinline__ void phase4(const Params& p, unsigned char* lds, int bid, int nblk) {
  pg8::Gemm g{(const bf16_t*)(p.ws + WS_HNB), (const bf16_t*)(p.ws + WS_WOUTT), T, DM, DM};
  pg8::StaticOrder S; S.init(T, DM, nblk, bid);
  pg8::EpiRes E{p.x, (bf16_t*)(p.ws + WS_H1B), (float*)(p.ws + WS_SSQH1)};
  pg8::gemm_phase<pg8::EpiRes, pg8::StaticOrder>((PG8_LAS unsigned char*)lds, g, S, E);
}
__device__ __forceinline__ void phase5(const Params& p, unsigned char* lds, int bid, int nblk) {
  pg8::Gemm g{(const bf16_t*)(p.ws + WS_H1B), (const bf16_t*)(p.ws + WS_WQT), T, DM, DM};
  pg8::StaticOrder S; S.init(T, DM, nblk, bid);
  pg8::EpiScores E{(const bf16_t*)(p.ws + WS_KEYS), (float*)(p.ws + WS_STOP), (int*)(p.ws + WS_ITOP)};
  pg8::gemm_phase<pg8::EpiScores, pg8::StaticOrder>((PG8_LAS unsigned char*)lds, g, S, E);
}

__device__ __forceinline__ float dot2bf(unsigned a, unsigned b, float c) {
  return __builtin_amdgcn_fdot2_f32_bf16(*(bf16v2*)&a, *(bf16v2*)&b, c, false);
}
__device__ __forceinline__ void phase6(const Params& p, unsigned char* lds, int bid, int nblk) {
  const int tid0 = threadIdx.x, lane0 = tid0 & 63, wid = __builtin_amdgcn_readfirstlane(tid0 >> 6);
  int* ids = (int*)(lds + wid * 2048);
  float* gts = (float*)(lds + wid * 2048 + 512);
  float* wts = (float*)(lds + wid * 2048 + 1024);
  int* rid = (int*)(lds + 16384 + wid * 1024);
  float* rgt = (float*)(lds + 16384 + wid * 1024 + 512);
  const unsigned char* ub = p.ws + WS_UB;
  const unsigned char* vb = p.ws + WS_VB;
  const bf16_t* h1b = (const bf16_t*)(p.ws + WS_H1B);
  const float* usc = (const float*)(p.ws + WS_USC);
  const float* vsc = (const float*)(p.ws + WS_VSC);
  const float* ssq = (const float*)(p.ws + WS_SSQH1);
  const float* stop = (const float*)(p.ws + WS_STOP);
  const int* itop = (const int*)(p.ws + WS_ITOP);
  const int ci = kCandI[lane0], cj = kCandJ[lane0];
#pragma unroll 1
  for (int t = bid * 8 + wid; t < T; t += nblk * 8) {
    int tid = tid0; asm volatile("" : "+v"(tid));
    const int lane = tid & 63;
    const int kcode = 8 * ((lane >> 2) & 1) + 4 * ((lane >> 3) & 1) + 2 * ((lane >> 4) & 1) + ((lane >> 5) & 1);
    const float part0 = lane < 32 ? ssq[(size_t)t * 32 + lane] : 0.f;
    const float rr = rsqrtf(wave_sum(part0) * (1.f / DM) + EPS);
#pragma unroll 1
    for (int h = 0; h < 8; ++h) {
      const size_t lbase = ((size_t)t * 16 + h * 2) * 16;
      const float sv = lane < 32 ? __builtin_nontemporal_load(stop + lbase + lane) : 0.f;
      const int iv = lane < 32 ? __builtin_nontemporal_load(itop + lbase + lane) : 0;
      float cand = (__shfl(sv, ci) + __shfl(sv, 16 + cj)) * rr;
      if (lane >= 50) cand = -INFINITY;
      unsigned key = __float_as_uint(cand);
      key = (key & 0x80000000u) ? ~key : (key | 0x80000000u);
      key = (key & ~63u) | (unsigned)(63 - lane);
      int rank = 0;
#pragma unroll
      for (int k = 0; k < 50; ++k) {
        const unsigned kk = (unsigned)__builtin_amdgcn_readlane((int)key, k);
        rank += kk > key ? 1 : 0;
      }
      const float cmax = wave_max(cand);
      const float ex = rank < 16 ? __expf(cand - cmax) : 0.f;
      const float den = wave_sum(ex);
      const int eidx = __shfl(iv, ci) * 128 + __shfl(iv, 16 + cj);
      if (rank < 16) { rid[h * 16 + rank] = eidx; rgt[h * 16 + rank] = ex / den; }
    }
    {
      const int e0 = rid[lane], e1 = rid[lane + 64];
      const float g0 = rgt[lane], g1 = rgt[lane + 64];
      const int r0 = e0 >> 10, r1 = e1 >> 10;
      const unsigned long long ltm = (1ull << lane) - 1ull;
      int run = 0, pos0 = 0, pos1 = 0;
#pragma unroll
      for (int R = 0; R < 16; ++R) {
        const unsigned long long m0 = __ballot(r0 == R), m1 = __ballot(r1 == R);
        const int c0 = __popcll(m0), c1 = __popcll(m1);
        if (r0 == R) pos0 = run + __popcll(m0 & ltm);
        if (r1 == R) pos1 = run + c0 + __popcll(m1 & ltm);
        run += c0 + c1;
      }
      ids[pos0] = e0; gts[pos0] = g0;
      ids[pos1] = e1; gts[pos1] = g1;
    }
    float xf[32];
    {
      const bf16_t* xp = h1b + (size_t)t * DM + lane * 4;
#pragma unroll
      for (int j = 0; j < 8; ++j) {
        const u32x2 xa = *(const u32x2*)(xp + 256 * j);
        xf[4 * j + 0] = bflo(xa.x); xf[4 * j + 1] = bfhi(xa.x); xf[4 * j + 2] = bflo(xa.y); xf[4 * j + 3] = bfhi(xa.y);
      }
    }
#pragma unroll 1
    for (int rnd = 0; rnd < 8; ++rnd) {
      u32x4 ra[16];
#pragma unroll
      for (int k = 0; k < 16; ++k) {
        const int e = __builtin_amdgcn_readfirstlane(ids[rnd * 16 + k]);
        ra[k] = *(const u32x4*)(ub + (size_t)e * ROW4 + lane * 16);
      }
      float part[16];
      float prev = 0.f;
#pragma unroll
      for (int k = 0; k < 16; ++k) {
        asm volatile("" : "+v"(ra[k]) : "v"(prev));
        float d0 = 0.f, d1 = 0.f;
#define U4_STEP(j, i) { const f32x2 r = __builtin_amdgcn_cvt_scalef32_pk_f32_fp4(ra[k][j], 1.0f, i); \
          d0 = fmaf(r[0], xf[8 * (j) + 2 * (i)], d0); d1 = fmaf(r[1], xf[8 * (j) + 2 * (i) + 1], d1); }
#pragma unroll
        for (int j = 0; j < 4; ++j) { U4_STEP(j, 0) U4_STEP(j, 1) U4_STEP(j, 2) U4_STEP(j, 3) }
#undef U4_STEP
        prev = d0 + d1;
        part[k] = prev;
      }
      float q8[8], q4[4], q2[2], q1;
      { const bool hi = (lane >> 5) & 1;
#pragma unroll
        for (int i = 0; i < 8; ++i) { const float keep = hi ? part[2 * i + 1] : part[2 * i], send = hi ? part[2 * i] : part[2 * i + 1]; q8[i] = keep + __shfl_xor(send, 32); } }
      { const bool hi = (lane >> 4) & 1;
#pragma unroll
        for (int i = 0; i < 4; ++i) { const float keep = hi ? q8[2 * i + 1] : q8[2 * i], send = hi ? q8[2 * i] : q8[2 * i + 1]; q4[i] = keep + __shfl_xor(send, 16); } }
      { const bool hi = (lane >> 3) & 1;
#pragma unroll
        for (int i = 0; i < 2; ++i) { const float keep = hi ? q4[2 * i + 1] : q4[2 * i], send = hi ? q4[2 * i] : q4[2 * i + 1]; q2[i] = keep + __shfl_xor(send, 8); } }
      { const bool hi = (lane >> 2) & 1;
        const float keep = hi ? q2[1] : q2[0], send = hi ? q2[0] : q2[1]; q1 = keep + __shfl_xor(send, 4); }
      q1 += __shfl_xor(q1, 2);
      q1 += __shfl_xor(q1, 1);
      {
        const int kk = rnd * 16 + kcode;
        const int eid = ids[kk];
        const float a = q1 * rr * usc[eid];
        const float ge = 0.5f * a * (1.f + erff(a * 0.70710678118654752f));
        if ((lane & 3) == 0) wts[kk] = gts[kk] * ge * vsc[eid];
      }
    }
    float acc[32];
#pragma unroll
    for (int i = 0; i < 32; ++i) acc[i] = 0.f;
#pragma unroll 1
    for (int rnd = 0; rnd < 8; ++rnd) {
      u32x4 ra[16];
#pragma unroll
      for (int k = 0; k < 16; ++k) {
        const int e = __builtin_amdgcn_readfirstlane(ids[rnd * 16 + k]);
        ra[k] = *(const u32x4*)(vb + (size_t)e * ROW4 + lane * 16);
      }
      f32x4 wv[4];
#pragma unroll
      for (int j = 0; j < 4; ++j) wv[j] = *(const f32x4*)(wts + rnd * 16 + 4 * j);
#pragma unroll
      for (int k = 0; k < 16; ++k) {
        const float wk = wv[k >> 2][k & 3];
        asm volatile("" : "+v"(ra[k]) : "v"(acc[1]), "v"(acc[3]), "v"(acc[5]), "v"(acc[7]), "v"(acc[9]), "v"(acc[11]), "v"(acc[13]), "v"(acc[15]),
                                        "v"(acc[17]), "v"(acc[19]), "v"(acc[21]), "v"(acc[23]), "v"(acc[25]), "v"(acc[27]), "v"(acc[29]), "v"(acc[31]));
#define V4_STEP(j, i) { const f32x2 r = __builtin_amdgcn_cvt_scalef32_pk_f32_fp4(ra[k][j], 1.0f, i); \
            acc[8 * (j) + 2 * (i)] = fmaf(wk, r[0], acc[8 * (j) + 2 * (i)]); acc[8 * (j) + 2 * (i) + 1] = fmaf(wk, r[1], acc[8 * (j) + 2 * (i) + 1]); }
#pragma unroll
        for (int j = 0; j < 4; ++j) { V4_STEP(j, 0) V4_STEP(j, 1) V4_STEP(j, 2) V4_STEP(j, 3) }
#undef V4_STEP
      }
    }
    float ss = 0.f;
#pragma unroll
    for (int i = 0; i < 32; ++i) { acc[i] += xf[i]; ss += acc[i] * acc[i]; }
    ss = wave_sum(ss);
    const float rf = rsqrtf(ss * (1.f / DM) + EPS);
#pragma unroll
    for (int j = 0; j < 8; ++j) {
      const f32x4 lw = *(const f32x4*)(p.ln_final + 256 * j + lane * 4);
      const f32x4 o = {acc[4 * j] * rf * lw[0], acc[4 * j + 1] * rf * lw[1], acc[4 * j + 2] * rf * lw[2], acc[4 * j + 3] * rf * lw[3]};
      __builtin_nontemporal_store(o, (f32x4*)(p.out + (size_t)t * DM + 256 * j + lane * 4));
    }
  }
}

typedef float f32x16 __attribute__((ext_vector_type(16)));
__device__ __forceinline__ void unpack8(const u32x4 a, float (&v)[8]) {
  v[0] = bflo(a.x); v[1] = bfhi(a.x); v[2] = bflo(a.y); v[3] = bfhi(a.y); v[4] = bflo(a.z); v[5] = bfhi(a.z); v[6] = bflo(a.w); v[7] = bfhi(a.w);
}
constexpr int VT_LD = 196;
constexpr int ATT_VT_BYTES = 4 * 64 * VT_LD * 2;
__device__ __forceinline__ void attn_item(const Params& p, unsigned char* lds, int item) {
  const int tid = threadIdx.x, lane = tid & 63, wid = __builtin_amdgcn_readfirstlane(tid >> 6);
  const int b = item >> 6, q0 = (item & 63) * 32;
  bf16_t* VT = (bf16_t*)lds;
  float* biasL = (float*)(lds + ATT_VT_BYTES);
  float* ssqw = biasL + 16 * 132;
  const bf16_t* proj = (const bf16_t*)(p.ws + WS_PROJ);
  const float* projm = (const float*)(p.ws + WS_PROJM);
  bf16_t* mixin = (bf16_t*)(p.ws + WS_HNB);
#pragma unroll
  for (int it = 0; it < 5; ++it) {
    const int idx = it * NTHREADS + tid;
    if (idx >= 16 * 129) break;
    const int hq = idx / 129, d = idx - hq * 129;
    const int bk = d < 128 ? (int)kBucket[d] : 31;
    biasL[hq * 132 + d] = p.rel_bias[bk * 16 + hq];
  }
  const int ql = lane & 31, ql0 = ql, hh = lane >> 5, kvh = wid >> 1;
  const int trow = b * SEQ + q0 + ql;
  bf16x8 qf[4];
  u32x4 kf[6][4];
#define ATT_LOAD_Q(hq_)                                                                                                           \
  { _Pragma("unroll") for (int ks = 0; ks < 4; ++ks) qf[ks] = *(const bf16x8*)(proj + (size_t)trow * NPROJ + OFF_Q + (hq_) * 64 + ks * 16 + hh * 8); }
#define ATT_LOAD_K()                                                                                                              \
  {                                                                                                                               \
    int ql = ql0; asm volatile("" : "+v"(ql));     \
    const float* kr_ = projm + (size_t)(ql & 15) * DPROJ + OFF_K + kvh * 64 + hh * 8;                                             \
    _Pragma("unroll") for (int ks = 0; ks < 4; ++ks) {                                                                            \
      const f32x4 a_ = *(const f32x4*)(kr_ + ks * 16), c_ = *(const f32x4*)(kr_ + ks * 16 + 4);                                   \
      kf[0][ks].x = pack_bf16(a_[0], a_[1]); kf[0][ks].y = pack_bf16(a_[2], a_[3]); kf[0][ks].z = pack_bf16(c_[0], c_[1]); kf[0][ks].w = pack_bf16(c_[2], c_[3]); } \
    _Pragma("unroll") for (int jt = 1; jt < 6; ++jt) {                                                                            \
      int sp_ = q0 - 128 + 32 * (jt - 1) + ql; sp_ = sp_ < 0 ? 0 : sp_;                                                           \
      const bf16_t* kp_ = proj + (size_t)(b * SEQ + sp_) * NPROJ + OFF_K + kvh * 64 + hh * 8;                                     \
      _Pragma("unroll") for (int ks = 0; ks < 4; ++ks) kf[jt][ks] = *(const u32x4*)(kp_ + ks * 16); }                             \
  }
  ATT_LOAD_Q(2 * wid)
#pragma unroll 1
  for (int rep_ = 0; rep_ < (REP_SUB == 2 ? 2 : 1); ++rep_) {
    u32x4 ra[5], rc[5];
#pragma unroll
    for (int q = 0; q < 5; ++q) {
      const int task = q * NTHREADS + tid, ch = task / 80, pi = task - ch * 80;
      int s0 = q0 - 128 + 2 * pi;
      s0 = s0 < 0 ? 0 : s0;
      const bf16_t* r0 = proj + (size_t)(b * SEQ + s0) * NPROJ + OFF_V + ch * 8;
      ra[q] = *(const u32x4*)r0; rc[q] = *(const u32x4*)(r0 + NPROJ);
    }
    float m0[8], m1[8];
    {
      const int pi = tid & 7, ch = (tid >> 3) & 31;
      const float* r0 = projm + (size_t)(2 * pi) * DPROJ + OFF_V + ch * 8;
      const f32x4 ma = *(const f32x4*)r0, mb = *(const f32x4*)(r0 + 4), mc = *(const f32x4*)(r0 + DPROJ), md = *(const f32x4*)(r0 + DPROJ + 4);
      const float keep = tid < 256 ? 1.f : 0.f;
#pragma unroll
      for (int i = 0; i < 4; ++i) { m0[i] = ma[i] * keep; m0[4 + i] = mb[i] * keep; m1[i] = mc[i] * keep; m1[4 + i] = md[i] * keep; }
      bf16_t* dst = VT + (size_t)((ch >> 3) * 64 + (ch & 7) * 8) * VT_LD + 2 * pi + (tid < 256 ? 0 : 16);
#pragma unroll
      for (int i = 0; i < 8; ++i) *(unsigned*)(dst + i * VT_LD) = pack_bf16(m0[i], m1[i]);
    }
#pragma unroll
    for (int q = 0; q < 5; ++q) {
      const int task = q * NTHREADS + tid, ch = task / 80, pi = task - ch * 80;
      float v0[8], v1[8];
      unpack8(ra[q], v0); unpack8(rc[q], v1);
      bf16_t* dst = VT + (size_t)((ch >> 3) * 64 + (ch & 7) * 8) * VT_LD + 32 + 2 * pi;
#pragma unroll
      for (int i = 0; i < 8; ++i) *(unsigned*)(dst + i * VT_LD) = pack_bf16(v0[i], v1[i]);
    }
  }
  __syncthreads();
  float ssq = 0.f;
#pragma unroll 1
  for (int rep_ = 0; rep_ < (REP_SUB == 3 ? 2 : 1); ++rep_) {
  ssq = 0.f;
  auto do_head = [&](const int hsel) __attribute__((always_inline)) {
    const int hq = 2 * wid + hsel;
    f32x16 sacc[6];
#pragma unroll
    for (int jt = 0; jt < 6; ++jt) {
      f32x16 acc;
#pragma unroll
      for (int r = 0; r < 16; ++r) acc[r] = 0.f;
#pragma unroll
      for (int ks = 0; ks < 4; ++ks) acc = __builtin_amdgcn_mfma_f32_32x32x16_bf16(*(bf16x8*)&kf[jt][ks], qf[ks], acc, 0, 0, 0);
      sacc[jt] = acc;
    }
    if (hsel == 0) { ATT_LOAD_Q(2 * wid + 1) }
    const float* bl = biasL + hq * 132;
    int sq = q0 + ql, qh = ql - 4 * hh;
    asm volatile("" : "+v"(sq), "+v"(qh));
    const float sink = p.sinks[hq];
    float m = sink;
#pragma unroll
    for (int jt = 0; jt < 6; ++jt) {
      asm volatile("" ::: "memory");
#pragma unroll
      for (int r = 0; r < 16; ++r) {
        const int kr = (r & 3) + 8 * (r >> 2) + 4 * hh;
        int dist; bool valid;
        if (jt == 0) { dist = sq + (16 - ((r & 3) + 8 * (r >> 2))) - 4 * hh; valid = kr < 16; }
        else { dist = qh + (128 - 32 * (jt - 1) - ((r & 3) + 8 * (r >> 2))); valid = (dist >= 0) && (dist < 128) && (dist <= sq); }
        const int dc = dist < 0 ? 0 : (dist > 128 ? 128 : dist);
        const float l = valid ? 0.125f * sacc[jt][r] + bl[dc] : -1e30f;
        sacc[jt][r] = l;
        m = fmaxf(m, l);
      }
    }
    m = fmaxf(m, __shfl_xor(m, 32));
    float sum = 0.f;
    f32x16 oacc0, oacc1;
#pragma unroll
    for (int r = 0; r < 16; ++r) { oacc0[r] = 0.f; oacc1[r] = 0.f; }
    const bf16_t* vrow0 = VT + (size_t)(kvh * 64 + ql) * VT_LD + 4 * hh;
    const bf16_t* vrow1 = vrow0 + 32 * VT_LD;
#pragma unroll
    for (int jt = 0; jt < 6; ++jt) {
      u32x4 pw[2];
#pragma unroll
      for (int s2 = 0; s2 < 2; ++s2) {
        float e[8];
#pragma unroll
        for (int i = 0; i < 8; ++i) { e[i] = __expf(sacc[jt][8 * s2 + i] - m); sum += e[i]; }
        pw[s2].x = pack_bf16(e[0], e[1]); pw[s2].y = pack_bf16(e[2], e[3]); pw[s2].z = pack_bf16(e[4], e[5]); pw[s2].w = pack_bf16(e[6], e[7]);
      }
#pragma unroll
      for (int s2 = 0; s2 < 2; ++s2) {
        const u32x2 va = *(const u32x2*)(vrow0 + 32 * jt + 16 * s2), vc = *(const u32x2*)(vrow0 + 32 * jt + 16 * s2 + 8);
        const u32x2 vd = *(const u32x2*)(vrow1 + 32 * jt + 16 * s2), ve = *(const u32x2*)(vrow1 + 32 * jt + 16 * s2 + 8);
        u32x4 v0w; v0w.x = va.x; v0w.y = va.y; v0w.z = vc.x; v0w.w = vc.y;
        u32x4 v1w; v1w.x = vd.x; v1w.y = vd.y; v1w.z = ve.x; v1w.w = ve.y;
        oacc0 = __builtin_amdgcn_mfma_f32_32x32x16_bf16(*(bf16x8*)&v0w, *(bf16x8*)&pw[s2], oacc0, 0, 0, 0);
        oacc1 = __builtin_amdgcn_mfma_f32_32x32x16_bf16(*(bf16x8*)&v1w, *(bf16x8*)&pw[s2], oacc1, 0, 0, 0);
      }
    }
    sum += __shfl_xor(sum, 32);
    const float inv = 1.f / (sum + __expf(sink - m));
#pragma unroll
    for (int r = 0; r < 16; ++r) { oacc0[r] *= inv; oacc1[r] *= inv; ssq += oacc0[r] * oacc0[r] + oacc1[r] * oacc1[r]; }
#pragma unroll
    for (int rg = 0; rg < 4; ++rg) {
      u32x2 w; w.x = pack_bf16(oacc0[rg * 4 + 0], oacc0[rg * 4 + 1]); w.y = pack_bf16(oacc0[rg * 4 + 2], oacc0[rg * 4 + 3]);
      *(u32x2*)(mixin + (size_t)trow * DM + hq * 64 + 8 * rg + 4 * hh) = w;
      u32x2 w1; w1.x = pack_bf16(oacc1[rg * 4 + 0], oacc1[rg * 4 + 1]); w1.y = pack_bf16(oacc1[rg * 4 + 2], oacc1[rg * 4 + 3]);
      *(u32x2*)(mixin + (size_t)trow * DM + hq * 64 + 32 + 8 * rg + 4 * hh) = w1;
    }
  };
  ATT_LOAD_K()
  do_head(0);
  asm volatile("" ::: "memory");
  ATT_LOAD_K()
  do_head(1);
  }
  ssq += __shfl_xor(ssq, 32);
  if (lane < 32) ssqw[wid * 32 + lane] = ssq;
  __syncthreads();
  float tot = 0.f;
#pragma unroll
  for (int w = 0; w < 8; ++w) tot += ssqw[w * 32 + ql];
  const float ra = rsqrtf(tot * (1.f / 1024) + EPS);
#pragma unroll
  for (int hsel = 0; hsel < 2; ++hsel)
#pragma unroll
    for (int dt = 0; dt < 2; ++dt)
#pragma unroll
      for (int rg = 0; rg < 4; ++rg) {
        bf16_t* op = mixin + (size_t)trow * DM + (2 * wid + hsel) * 64 + 32 * dt + 8 * rg + 4 * hh;
        const u32x2 v = *(const u32x2*)op;
        u32x2 w; w.x = pack_bf16(bflo(v.x) * ra, bfhi(v.x) * ra); w.y = pack_bf16(bflo(v.y) * ra, bfhi(v.y) * ra);
        *(u32x2*)op = w;
      }
  __syncthreads();
}
#undef ATT_LOAD_Q
#undef ATT_LOAD_K
__device__ __forceinline__ void phase2_attn(const Params& p, unsigned char* lds, int bid, int nblk) {
  for (int item = bid; item < 256; item += nblk) attn_item(p, lds, item);
}

constexpr int SLD = 136;
__device__ __forceinline__ float conv_silu(const float (&raw)[11], int i, float w0, float w1, float w2, float w3, float cb) {
  return silu_f(cb + w0 * raw[i] + w1 * raw[i + 1] + w2 * raw[i + 2] + w3 * raw[i + 3]);
}
__device__ __forceinline__ void ssd_a_item(const Params& p, unsigned char* lds, int item) {
  const int tid = threadIdx.x, lane = tid & 63, wid = __builtin_amdgcn_readfirstlane(tid >> 6);
  const int b = item >> 5, c = (item >> 1) & 15, g = item & 1;
  const int h0 = g * 8;
  const int t0 = b * SEQ + c * 128;
  bf16_t* Bc = (bf16_t*)lds;
  bf16_t* Cc = Bc + 128 * SLD;
  bf16_t* BcT = Cc + 128 * SLD;
  bf16_t* xT = BcT + 128 * SLD;
  float* dtl = (float*)(xT + 2 * 64 * SLD);
  float* acs = dtl + 256;
  float* wl = acs + 256;
  float* scan = wl + 256;
  const bf16_t* __restrict__ proj = (const bf16_t*)(p.ws + WS_PROJ);
  const bf16_t* __restrict__ projmb = (const bf16_t*)(p.ws + WS_PROJMB);
  const float* __restrict__ dtraw = (const float*)(p.ws + WS_DTRAW);
  float* __restrict__ acsg = (float*)(p.ws + WS_ACSG);
  bf16_t* __restrict__ ccb = (bf16_t*)(p.ws + WS_CCB);
  bf16_t* __restrict__ ypart = (bf16_t*)(p.ws + WS_YPART);
  float* __restrict__ sg = (float*)(p.ws + WS_SG);
  {
    unsigned raw[4][11];
#pragma unroll
    for (int q = 0; q < 4; ++q) {
      const int task = q * NTHREADS + tid;
      const int tg = task >> 7, cp = task & 127;
      const int cch = 1024 + (cp >> 6) * 256 + g * 128 + 2 * (cp & 63);
#pragma unroll
      for (int i = 0; i < 11; ++i) {
        const int l = tg * 8 + i - 3;
        const bf16_t* src = (l >= 0 || c > 0) ? proj + (size_t)(t0 + l) * NPROJ : projmb + (size_t)(16 + l) * DPROJ;
        raw[q][i] = *(const unsigned*)(src + OFF_XBC + cch);
      }
    }
#pragma unroll
    for (int q = 0; q < 4; ++q) {
      const int task = q * NTHREADS + tid;
      const int tg = task >> 7, cp = task & 127, n = 2 * (cp & 63);
      const int cch = 1024 + (cp >> 6) * 256 + g * 128 + n;
      float o0[8], o1[8];
      {
        float r0[11], r1[11];
#pragma unroll
        for (int i = 0; i < 11; ++i) { r0[i] = bflo(raw[q][i]); r1[i] = bfhi(raw[q][i]); }
        const float w0 = p.conv_w[cch], w1 = p.conv_w[D_XBC + cch], w2 = p.conv_w[2 * D_XBC + cch], w3 = p.conv_w[3 * D_XBC + cch], cb = p.conv_b[cch];
        const float v0 = p.conv_w[cch + 1], v1 = p.conv_w[D_XBC + cch + 1], v2 = p.conv_w[2 * D_XBC + cch + 1], v3 = p.conv_w[3 * D_XBC + cch + 1], vb_ = p.conv_b[cch + 1];
#pragma unroll
        for (int i = 0; i < 8; ++i) { o0[i] = conv_silu(r0, i, w0, w1, w2, w3, cb); o1[i] = conv_silu(r1, i, v0, v1, v2, v3, vb_); }
      }
      bf16_t* rowm = (cp < 64 ? Bc : Cc) + (tg * 8) * SLD + n;
#pragma unroll
      for (int i = 0; i < 8; ++i) *(unsigned*)(rowm + i * SLD) = pack_bf16(o0[i], o1[i]);
      if (cp < 64) {
        u32x4 w; w.x = pack_bf16(o0[0], o0[1]); w.y = pack_bf16(o0[2], o0[3]); w.z = pack_bf16(o0[4], o0[5]); w.w = pack_bf16(o0[6], o0[7]);
        *(u32x4*)(BcT + n * SLD + tg * 8) = w;
        u32x4 w2_; w2_.x = pack_bf16(o1[0], o1[1]); w2_.y = pack_bf16(o1[2], o1[3]); w2_.z = pack_bf16(o1[4], o1[5]); w2_.w = pack_bf16(o1[6], o1[7]);
        *(u32x4*)(BcT + (n + 1) * SLD + tg * 8) = w2_;
      }
    }
  }
  float xraw[4][11];
#define SSD_LOAD_X(r_)                                                                                              \
  _Pragma("unroll") for (int q = 0; q < 4; ++q) {                                                                   \
    const int task = (q & 1) * NTHREADS + tid; const int tg = task >> 6, cch = (h0 + 2 * (r_) + (q >> 1)) * 64 + (task & 63); \
    _Pragma("unroll") for (int i = 0; i < 11; ++i) { const int l = tg * 8 + i - 3;                                  \
      const bf16_t* src = (l >= 0 || c > 0) ? proj + (size_t)(t0 + l) * NPROJ : projmb + (size_t)(16 + l) * DPROJ;  \
      xraw[q][i] = bf2f(src[OFF_XBC + cch]); } }
  SSD_LOAD_X(0)
  __syncthreads();
  {
#pragma unroll
    for (int q = 0; q < 4; ++q) {
      const int idx = q * NTHREADS + tid, row = idx >> 4, ck = idx & 15;
      *(u32x4*)(ccb + (size_t)(t0 + row) * 256 + g * 128 + ck * 8) = *(const u32x4*)(Cc + row * SLD + ck * 8);
    }
  }
  const int ql = lane & 31, hh = lane >> 5;
  int rnd = 0;
  auto ydiag = [&](const int hi, const int il) __attribute__((always_inline)) {
    const int h = h0 + 2 * rnd + hi, ip = wid & 1;
    const bf16_t* xTb = xT + (hi & 1) * 64 * SLD;
    const float dskip = p.d_skip[h];
    const float* acsh = acs + hi * 128;
    const float* dtlh = dtl + hi * 128;
    const int l = 32 * il + ql;
    const float acl = acsh[l];
    f32x16 yacc;
#pragma unroll
    for (int r = 0; r < 16; ++r) yacc[r] = 0.f;
    const bf16_t* xrow = xTb + (32 * ip + ql) * SLD + 4 * hh;
#pragma unroll 1
    for (int is = 0; is <= il; ++is) {
      f32x16 x;
#pragma unroll
      for (int r = 0; r < 16; ++r) x[r] = 0.f;
      const bf16_t* ap = Bc + (32 * is + ql) * SLD + 8 * hh;
      const bf16_t* bp = Cc + l * SLD + 8 * hh;
#pragma unroll
      for (int ks = 0; ks < 8; ++ks) x = __builtin_amdgcn_mfma_f32_32x32x16_bf16(*(const bf16x8*)(ap + 16 * ks), *(const bf16x8*)(bp + 16 * ks), x, 0, 0, 0);
      u32x4 pw[2];
#pragma unroll
      for (int s2 = 0; s2 < 2; ++s2) {
        float mv[8];
#pragma unroll
        for (int q = 0; q < 2; ++q) {
          const int sb = 32 * is + 16 * s2 + 8 * q + 4 * hh;
          const f32x4 as4 = *(const f32x4*)(acsh + sb), dt4 = *(const f32x4*)(dtlh + sb);
#pragma unroll
          for (int j = 0; j < 4; ++j) {
            const int sr = sb + j;
            float v = sr <= l ? x[8 * s2 + 4 * q + j] * __expf(acl - as4[j]) * dt4[j] : 0.f;
            if (sr == l) v += dskip;
            mv[4 * q + j] = v;
          }
        }
        pw[s2].x = pack_bf16(mv[0], mv[1]); pw[s2].y = pack_bf16(mv[2], mv[3]); pw[s2].z = pack_bf16(mv[4], mv[5]); pw[s2].w = pack_bf16(mv[6], mv[7]);
      }
#pragma unroll
      for (int s2 = 0; s2 < 2; ++s2) {
        const u32x2 va = *(const u32x2*)(xrow + 32 * is + 16 * s2), vc = *(const u32x2*)(xrow + 32 * is + 16 * s2 + 8);
        u32x4 aw; aw.x = va.x; aw.y = va.y; aw.z = vc.x; aw.w = vc.y;
        yacc = __builtin_amdgcn_mfma_f32_32x32x16_bf16(*(bf16x8*)&aw, *(bf16x8*)&pw[s2], yacc, 0, 0, 0);
      }
    }
    bf16_t* yp = ypart + (size_t)(t0 + l) * 1024 + h * 64 + 32 * ip + 4 * hh;
#pragma unroll
    for (int rg = 0; rg < 4; ++rg) { u32x2 w; w.x = pack_bf16(yacc[4 * rg], yacc[4 * rg + 1]); w.y = pack_bf16(yacc[4 * rg + 2], yacc[4 * rg + 3]); *(u32x2*)(yp + 8 * rg) = w; }
  };
  auto states = [&](const int hi) __attribute__((always_inline)) {
    const int h = h0 + 2 * rnd + hi, ip = wid & 1, in = wid >> 1;
    const bf16_t* xTb = xT + (hi & 1) * 64 * SLD;
    const float* wlh = wl + hi * 128;
    f32x16 sacc;
#pragma unroll
    for (int r = 0; r < 16; ++r) sacc[r] = 0.f;
    const bf16_t* ap = xTb + (32 * ip + ql) * SLD + 8 * hh;
    const bf16_t* bp = BcT + (32 * in + ql) * SLD + 8 * hh;
#pragma unroll
    for (int ks = 0; ks < 8; ++ks) {
      const u32x4 xa = *(const u32x4*)(ap + 16 * ks);
      const f32x4 wa = *(const f32x4*)(wlh + 16 * ks + 8 * hh), wb = *(const f32x4*)(wlh + 16 * ks + 8 * hh + 4);
      u32x4 aw;
      aw.x = pack_bf16(bflo(xa.x) * wa[0], bfhi(xa.x) * wa[1]); aw.y = pack_bf16(bflo(xa.y) * wa[2], bfhi(xa.y) * wa[3]);
      aw.z = pack_bf16(bflo(xa.z) * wb[0], bfhi(xa.z) * wb[1]); aw.w = pack_bf16(bflo(xa.w) * wb[2], bfhi(xa.w) * wb[3]);
      sacc = __builtin_amdgcn_mfma_f32_32x32x16_bf16(*(bf16x8*)&aw, *(const bf16x8*)(bp + 16 * ks), sacc, 0, 0, 0);
    }
    float* sp = sg + ((size_t)((b * 16 + c) * 16 + h) * 64 + 32 * ip + 4 * hh) * 128 + 32 * in + ql;
#pragma unroll
    for (int r = 0; r < 16; ++r) sp[((r & 3) + 8 * (r >> 2)) * 128] = sacc[r];
  };
#pragma unroll 1
  for (int rnd_ = 0; rnd_ < 4; ++rnd_) {
    rnd = rnd_;
    float dtv = 0.f, cum = 0.f;
    const int hi2 = (tid >> 7) & 1, ltok = tid & 127;
    if (tid < 256) {
      const int h = h0 + 2 * rnd + hi2;
      const float Ah = -expf(p.a_log[h]);
      dtv = softplus_f(dtraw[(size_t)(t0 + ltok) * 16 + h] + p.dt_bias[h]);
      dtl[tid] = dtv;
      cum = dtv * Ah;
#pragma unroll
      for (int o = 1; o < 64; o <<= 1) { const float nb = __shfl_up(cum, o); if (lane >= o) cum += nb; }
      if (lane == 63) scan[hi2 * 2 + (ltok >> 6)] = cum;
    }
#pragma unroll
    for (int q = 0; q < 4; ++q) {
      const int task = (q & 1) * NTHREADS + tid; const int tg = task >> 6, pch = task & 63, cch = (h0 + 2 * rnd + (q >> 1)) * 64 + pch;
      const float w0 = p.conv_w[cch], w1 = p.conv_w[D_XBC + cch], w2 = p.conv_w[2 * D_XBC + cch], w3 = p.conv_w[3 * D_XBC + cch], cb = p.conv_b[cch];
      float o[8];
#pragma unroll
      for (int i = 0; i < 8; ++i) o[i] = conv_silu(xraw[q], i, w0, w1, w2, w3, cb);
      u32x4 w; w.x = pack_bf16(o[0], o[1]); w.y = pack_bf16(o[2], o[3]); w.z = pack_bf16(o[4], o[5]); w.w = pack_bf16(o[6], o[7]);
      *(u32x4*)(xT + (q >> 1) * 64 * SLD + pch * SLD + tg * 8) = w;
    }
    { SSD_LOAD_X((rnd + 1) & 3) }
    __syncthreads();
    if (tid < 256) {
      const int h = h0 + 2 * rnd + hi2;
      const float s0 = scan[hi2 * 2], s1 = scan[hi2 * 2 + 1];
      if (ltok >= 64) cum += s0;
      acs[tid] = cum;
      acsg[(size_t)(t0 + ltok) * 16 + h] = cum;
      wl[tid] = dtv * __expf(s0 + s1 - cum);
    }
    __syncthreads();
    ydiag(0, wid >> 1);
    ydiag(1, 3 - (wid >> 1));
    states(0);
    states(1);
    __syncthreads();
  }
#undef SSD_LOAD_X
  __syncthreads();
}

__device__ __forceinline__ void meta_state_item(const Params& p, unsigned char* lds, int h) {
  const int tid = threadIdx.x, g = h >> 3;
  float* xm = (float*)lds;
  float* bm = xm + 16 * 64;
  float* dtm = bm + 16 * 128;
  const float* projm = (const float*)(p.ws + WS_PROJM);
  float* smeta = (float*)(p.ws + WS_SMETA);
  for (int task = tid; task < 16 * 192; task += NTHREADS) {
    const int i = task / 192, ch = task - i * 192;
    const int cch = ch < 64 ? h * 64 + ch : 1024 + g * 128 + (ch - 64);
    float acc = p.conv_b[cch];
#pragma unroll
    for (int j = 0; j < 4; ++j) { const int mi = i - j; if (mi >= 0) acc += p.conv_w[(3 - j) * D_XBC + cch] * projm[(size_t)mi * DPROJ + OFF_XBC + cch]; }
    const float v = silu_f(acc);
    if (ch < 64) xm[i * 64 + ch] = v; else bm[i * 128 + ch - 64] = v;
  }
  if (tid < 16) dtm[tid] = softplus_f(projm[(size_t)tid * DPROJ + OFF_DT + h] + p.dt_bias[h]);
  __syncthreads();
  const float Ah = -expf(p.a_log[h]);
  const int pr = tid >> 3, n0 = (tid & 7) * 16;
  float st[16];
#pragma unroll
  for (int k = 0; k < 16; ++k) st[k] = 0.f;
  for (int i = 0; i < 16; ++i) {
    const float dtv = dtm[i], dA = expf(dtv * Ah), xdt = xm[i * 64 + pr] * dtv;
#pragma unroll
    for (int k = 0; k < 16; ++k) st[k] = fmaf(st[k], dA, xdt * bm[i * 128 + n0 + k]);
  }
#pragma unroll
  for (int k = 0; k < 16; ++k) smeta[(size_t)(h * 64 + pr) * 128 + n0 + k] = st[k];
  __syncthreads();
}

__device__ __forceinline__ void phase2(const Params& p, unsigned char* lds, int bid, int nblk) {
  const bool roles = (nblk == 256);
  const int a = (bid >> 4) * 8 + (bid & 7);
  const bool ssd_role = ((bid >> 3) & 1) == 0;
  const int ab = roles ? (ssd_role ? 0 : 2 * a) : bid, ae = roles ? (ssd_role ? 0 : 2 * a + 2) : 256, as_ = roles ? 1 : nblk;
  const int sb = roles ? (ssd_role ? a : 0) : bid, se = roles ? (ssd_role ? a + 1 : 0) : 128, ss = roles ? 1 : nblk;
  const int mb = roles ? (ssd_role ? a : 16) : bid, ms = roles ? 128 : nblk;
#pragma unroll 1
  for (int it = ab; it < ae; it += as_) attn_item(p, lds, it);
#pragma unroll 1
  for (int it = sb; it < se; it += ss) ssd_a_item(p, lds, it);
#pragma unroll 1
  for (int it = mb; it < 16; it += ms) meta_state_item(p, lds, it);
}

__device__ __forceinline__ void phase_scan(const Params& p, int bid, int nblk) {
  const float* __restrict__ sg = (const float*)(p.ws + WS_SG);
  const float* __restrict__ smeta = (const float*)(p.ws + WS_SMETA);
  const float* __restrict__ acsg = (const float*)(p.ws + WS_ACSG);
  bf16_t* __restrict__ hprev = (bf16_t*)(p.ws + WS_HPREV);
  for (int task = bid * NTHREADS + threadIdx.x; task < 64 * 2048; task += nblk * NTHREADS) {
    const int bh = task >> 11, e4 = (task & 2047) * 4;
    const int b = bh >> 4, h = bh & 15;
    f32x4 sv[16];
    float dv[16];
#pragma unroll
    for (int c = 0; c < 16; ++c) {
      sv[c] = *(const f32x4*)(sg + (size_t)((b * 16 + c) * 16 + h) * 8192 + e4);
      dv[c] = acsg[(size_t)(b * SEQ + c * 128 + 127) * 16 + h];
    }
    f32x4 H = *(const f32x4*)(smeta + (size_t)h * 8192 + e4);
#pragma unroll
    for (int c = 0; c < 16; ++c) {
      u32x2 w; w.x = pack_bf16(H[0], H[1]); w.y = pack_bf16(H[2], H[3]);
      *(u32x2*)(hprev + (size_t)((b * 16 + c) * 16 + h) * 8192 + e4) = w;
      H = H * __expf(dv[c]) + sv[c];
    }
  }
}

__device__ __forceinline__ void ssd_b_item(const Params& p, unsigned char* lds, int item) {
  const int tid = threadIdx.x, lane = tid & 63, wid = __builtin_amdgcn_readfirstlane(tid >> 6);
  const int b = item >> 6, c = (item >> 2) & 15, g = (item >> 1) & 1, lh = item & 1, h = g * 8 + wid;
  const int t0 = b * SEQ + c * 128 + lh * 64;
  const int ql = lane & 31, hh = lane >> 5;
  constexpr int YLD = 520;
  bf16_t* yoff = (bf16_t*)lds;
  const bf16_t* __restrict__ proj = (const bf16_t*)(p.ws + WS_PROJ);
  const float* __restrict__ acsg = (const float*)(p.ws + WS_ACSG);
  const bf16_t* __restrict__ ccb = (const bf16_t*)(p.ws + WS_CCB);
  const bf16_t* __restrict__ ypart = (const bf16_t*)(p.ws + WS_YPART);
  const bf16_t* __restrict__ hprev = (const bf16_t*)(p.ws + WS_HPREV);
  bf16_t* __restrict__ mixin = (bf16_t*)(p.ws + WS_HNB);
  {
    const bf16_t* hp = hprev + (size_t)((b * 16 + c) * 16 + h) * 8192 + (size_t)ql * 128 + 8 * hh;
    u32x4 hf0[8], hf1[8];
#pragma unroll
    for (int ks = 0; ks < 8; ++ks) { hf0[ks] = *(const u32x4*)(hp + 16 * ks); hf1[ks] = *(const u32x4*)(hp + 32 * 128 + 16 * ks); }
#pragma unroll
    for (int il = 0; il < 2; ++il) {
      const int lt = 32 * il + ql, t = t0 + lt;
      const bf16_t* cp = ccb + (size_t)t * 256 + g * 128 + 8 * hh;
      u32x4 cf[8];
#pragma unroll
      for (int ks = 0; ks < 8; ++ks) cf[ks] = *(const u32x4*)(cp + 16 * ks);
      const float ea = __expf(acsg[(size_t)t * 16 + h]);
      f32x16 a0, a1;
#pragma unroll
      for (int r = 0; r < 16; ++r) { a0[r] = 0.f; a1[r] = 0.f; }
#pragma unroll
      for (int ks = 0; ks < 8; ++ks) {
        a0 = __builtin_amdgcn_mfma_f32_32x32x16_bf16(*(bf16x8*)&hf0[ks], *(bf16x8*)&cf[ks], a0, 0, 0, 0);
        a1 = __builtin_amdgcn_mfma_f32_32x32x16_bf16(*(bf16x8*)&hf1[ks], *(bf16x8*)&cf[ks], a1, 0, 0, 0);
      }
      bf16_t* yr = yoff + lt * YLD + wid * 64 + 4 * hh;
#pragma unroll
      for (int rg = 0; rg < 4; ++rg) {
        u32x2 w0; w0.x = pack_bf16(ea * a0[4 * rg], ea * a0[4 * rg + 1]); w0.y = pack_bf16(ea * a0[4 * rg + 2], ea * a0[4 * rg + 3]);
        u32x2 w1; w1.x = pack_bf16(ea * a1[4 * rg], ea * a1[4 * rg + 1]); w1.y = pack_bf16(ea * a1[4 * rg + 2], ea * a1[4 * rg + 3]);
        *(u32x2*)(yr + 8 * rg) = w0;
        *(u32x2*)(yr + 32 + 8 * rg) = w1;
      }
    }
  }
  __syncthreads();
#pragma unroll
  for (int bt = 0; bt < 2; ++bt) {
    u32x4 yy[4], zz[4], yo[4];
#pragma unroll
    for (int q = 0; q < 4; ++q) {
      const int lt = wid * 8 + bt * 4 + q, t = t0 + lt;
      yy[q] = __builtin_nontemporal_load((const u32x4*)(ypart + (size_t)t * 1024 + g * 512 + lane * 8));
      zz[q] = __builtin_nontemporal_load((const u32x4*)(proj + (size_t)t * NPROJ + OFF_Z + g * 512 + lane * 8));
      yo[q] = *(const u32x4*)(yoff + lt * YLD + lane * 8);
    }
#pragma unroll
    for (int q = 0; q < 4; ++q) {
      const int t = t0 + wid * 8 + bt * 4 + q;
      float zv[8], ov[8], yv[8], y[8];
      unpack8(zz[q], zv); unpack8(yo[q], ov); unpack8(yy[q], yv);
#pragma unroll
      for (int i = 0; i < 8; ++i) y[i] = (yv[i] + ov[i]) * silu_f(zv[i]);
      float ss = 0.f;
#pragma unroll
      for (int i = 0; i < 8; ++i) ss += y[i] * y[i];
      ss = wave_sum(ss);
      const float rn = rsqrtf(ss * (1.f / 512) + EPS);
      u32x4 w; w.x = pack_bf16(y[0] * rn, y[1] * rn); w.y = pack_bf16(y[2] * rn, y[3] * rn); w.z = pack_bf16(y[4] * rn, y[5] * rn); w.w = pack_bf16(y[6] * rn, y[7] * rn);
      *(u32x4*)(mixin + (size_t)t * DM + 1024 + g * 512 + lane * 8) = w;
    }
  }
  __syncthreads();
}
__device__ __forceinline__ void phase3(const Params& p, unsigned char* lds, int bid, int nblk) {
  for (int it = bid; it < 256; it += nblk) ssd_b_item(p, lds, (nblk == 256) ? ((it & 7) * 32 + (it >> 3)) : it);
}

constexpr int LDS_BYTES = 144 * 1024;

typedef const Params __attribute__((address_space(4))) * KArgPtr;
__device__ __forceinline__ Params load_params(KArgPtr k) {
  Params q;
#if defined(__HIP_DEVICE_COMPILE__)
  __builtin_memcpy(&q, k, sizeof(Params));
#endif
  return q;
}
#define PARAMS_PTR(pp) KArgPtr pp##_k = (KArgPtr)__builtin_amdgcn_kernarg_segment_ptr(); asm volatile("" : "+s"(pp##_k)); const Params pp##_v = load_params(pp##_k); const Params* pp = &pp##_v
__global__ __launch_bounds__(512, 2) void k_mega(Params p_unused) {
  extern __shared__ __attribute__((aligned(16))) unsigned char shm[];
  const int bid = blockIdx.x, nblk = gridDim.x;
  volatile LAS unsigned* xst = (volatile LAS unsigned*)(LAS unsigned char*)(shm + LDS_BYTES - 16);
  if (threadIdx.x == 0) { xst[0] = 0u; xst[1] = 0u; }
  __syncthreads();
  XcdBarrier xb;
  { PARAMS_PTR(pp); xb = xcd_barrier_post((unsigned*)(pp->ws + WS_CTL), xst); }
#ifndef REP_PHASE
#define REP_PHASE -1
#endif
#define NREP(k) ((REP_PHASE == (k)) ? 2 : 1)
#ifndef REP_ALL
#define REP_ALL 1
#endif
#pragma unroll 1
  for (int pass = 0; pass < REP_ALL; ++pass) {
  if (pass) xcd_barrier(xb);
#pragma unroll 1
  for (int rep = 0; rep < NREP(0); ++rep) { { PARAMS_PTR(pp); phase0(*pp, (float*)shm, bid, nblk); } if (rep + 1 < NREP(0)) xcd_barrier(xb); }
  xcd_barrier(xb);
#pragma unroll 1
  for (int rep = 0; rep < NREP(1); ++rep) { { PARAMS_PTR(pp); phase1(*pp, shm, bid, nblk); } xcd_barrier(xb); }
#pragma unroll 1
  for (int rep = 0; rep < NREP(2); ++rep) { { PARAMS_PTR(pp); phase2(*pp, shm, bid, nblk); } xcd_barrier(xb); }
#pragma unroll 1
  for (int rep = 0; rep < NREP(7); ++rep) { { PARAMS_PTR(pp); phase_scan(*pp, bid, nblk); } xcd_barrier(xb); }
#pragma unroll 1
  for (int rep = 0; rep < NREP(3); ++rep) { { PARAMS_PTR(pp); phase3(*pp, shm, bid, nblk); } xcd_barrier(xb); }
#pragma unroll 1
  for (int rep = 0; rep < NREP(4); ++rep) { { PARAMS_PTR(pp); phase4(*pp, shm, bid, nblk); } xcd_barrier(xb); }
#pragma unroll 1
  for (int rep = 0; rep < NREP(5); ++rep) { { PARAMS_PTR(pp); phase5(*pp, shm, bid, nblk); } xcd_barrier(xb); }
#pragma unroll 1
  for (int rep = 0; rep < NREP(6); ++rep) { { PARAMS_PTR(pp); phase6(*pp, shm, bid, nblk); } if (rep + 1 < NREP(6)) xcd_barrier(xb); }
  }
}

}

extern "C" void kernel_launch(void* const* d_in, const int* in_sizes, int n_in, void* d_out, int out_size, void* d_ws,
                              size_t ws_size, hipStream_t stream) {
  Params p{};
  p.x = (const float*)d_in[0]; p.meta = (const float*)d_in[1]; p.rel_bias = (const float*)d_in[2];
  p.ln_mix = (const float*)d_in[3]; p.w_in = (const float*)d_in[4]; p.sinks = (const float*)d_in[5];
  p.conv_w = (const float*)d_in[6]; p.conv_b = (const float*)d_in[7]; p.dt_bias = (const float*)d_in[8];
  p.a_log = (const float*)d_in[9]; p.d_skip = (const float*)d_in[10]; p.attn_norm_w = (const float*)d_in[11];
  p.ssm_norm_w = (const float*)d_in[12]; p.w_out = (const float*)d_in[13]; p.ln_ffn = (const float*)d_in[14];
  p.wq = (const float*)d_in[15]; p.keys = (const float*)d_in[16]; p.U = (const float*)d_in[17];
  p.V = (const float*)d_in[18]; p.ln_final = (const float*)d_in[19];
  p.out = (float*)d_out;
  p.ws = (unsigned char*)d_ws;

  static int grid_blocks = 0;
  if (!grid_blocks) {
    int dev = 0, cus = 0, per_cu = 0;
    (void)hipGetDevice(&dev);
    (void)hipDeviceGetAttribute(&cus, hipDeviceAttributeMultiprocessorCount, dev);
    (void)hipFuncSetAttribute((const void*)k_mega, hipFuncAttributeMaxDynamicSharedMemorySize, LDS_BYTES);
    (void)hipOccupancyMaxActiveBlocksPerMultiprocessor(&per_cu, (const void*)k_mega, NTHREADS, LDS_BYTES);
    if (per_cu > 1) per_cu = 1;
    grid_blocks = cus * per_cu;
    if (grid_blocks != 256) fprintf(stderr, "kernel_launch: expected a 256-workgroup resident grid, got %d (cus %d, per_cu %d)\n", grid_blocks, cus, per_cu);
  }
  (void)hipMemsetAsync(p.ws + WS_CTL, 0, XCD_BAR_WORDS * 4, stream);
  void* args[] = {&p};
  hipError_t e = hipLaunchCooperativeKernel((const void*)k_mega, dim3(grid_blocks), dim3(NTHREADS), args, LDS_BYTES, stream);
  if (e != hipSuccess) fprintf(stderr, "cooperative launch failed: %s (grid %d)\n", hipGetErrorString(e), grid_blocks);
}
```

```cpp
#include <hip/hip_runtime.h>
#include <math.h>
#include <stdio.h>
#include <stdint.h>

#ifndef REP_SUB
#define REP_SUB -1
#endif
namespace {
constexpr int BATCH = 4, SEQ = 2048, DM = 2048, NMETA = 16;
constexpr int T = BATCH * SEQ;
constexpr int TA = T + NMETA;
constexpr int DPROJ = 4112;
constexpr int NPROJ = 4096;
constexpr int OFF_Q = 0, OFF_K = 1024, OFF_V = 1280, OFF_Z = 1536, OFF_XBC = 2560, OFF_DT = 4096;
constexpr int D_XBC = 1536;
constexpr int NEXP = 16384;
constexpr int ROW4 = 1024;
constexpr int ROW6 = 1536;
constexpr float EPS = 1e-6f;
constexpr int NTHREADS = 512;

typedef unsigned short bf16_t;
typedef short bf16x8 __attribute__((ext_vector_type(8)));
typedef float f32x4 __attribute__((ext_vector_type(4)));
typedef float f32x2 __attribute__((ext_vector_type(2)));
typedef unsigned u32x4 __attribute__((ext_vector_type(4)));
typedef unsigned u32x2 __attribute__((ext_vector_type(2)));
typedef __bf16 bf16v2 __attribute__((ext_vector_type(2)));
typedef float f32x16v __attribute__((ext_vector_type(16)));
typedef float f32x32v __attribute__((ext_vector_type(32)));
typedef unsigned u32x6 __attribute__((ext_vector_type(6)));
#define LAS __attribute__((address_space(3)))

__device__ __forceinline__ unsigned pack_bf16(float lo, float hi) {
  f32x2 v = {lo, hi};
  bf16v2 b = __builtin_convertvector(v, bf16v2);
  return *(unsigned*)&b;
}
__device__ __forceinline__ bf16_t f2bf(float f) { return (bf16_t)(pack_bf16(f, 0.f) & 0xffffu); }
__device__ __forceinline__ float bf2f(bf16_t b) { return __uint_as_float(((unsigned)b) << 16); }
__device__ __forceinline__ float bflo(unsigned u) { return __uint_as_float(u << 16); }
__device__ __forceinline__ float bfhi(unsigned u) { return __uint_as_float(u & 0xffff0000u); }

__constant__ unsigned char kBucket[128] = {
    0, 1, 2, 3, 4, 5, 6, 7, 8, 9, 10, 11, 12, 13, 14, 15, 16, 16, 16, 17, 17, 18, 18, 18, 19, 19, 19, 20, 20, 20, 20, 21,
    21, 21, 21, 22, 22, 22, 22, 22, 23, 23, 23, 23, 23, 23, 24, 24, 24, 24, 24, 24, 25, 25, 25, 25, 25, 25, 25, 26, 26, 26, 26, 26,
    26, 26, 26, 27, 27, 27, 27, 27, 27, 27, 27, 27, 27, 28, 28, 28, 28, 28, 28, 28, 28, 28, 28, 29, 29, 29, 29, 29, 29, 29, 29, 29,
    29, 29, 29, 30, 30, 30, 30, 30, 30, 30, 30, 30, 30, 30, 30, 30, 30, 31, 31, 31, 31, 31, 31, 31, 31, 31, 31, 31, 31, 31, 31, 31};

__constant__ unsigned char kCandI[64] = {0, 0, 0, 0, 0, 0, 0, 0, 0, 0, 0, 0, 0, 0, 0, 0, 1, 1, 1, 1, 1, 1, 1, 1, 2, 2, 2, 2, 2, 3, 3, 3, 3, 4, 4, 4, 5, 5, 6, 6, 7, 7, 8, 9, 10, 11, 12, 13, 14, 15, 15, 15, 15, 15, 15, 15, 15, 15, 15, 15, 15, 15, 15, 15};
__constant__ unsigned char kCandJ[64] = {0, 1, 2, 3, 4, 5, 6, 7, 8, 9, 10, 11, 12, 13, 14, 15, 0, 1, 2, 3, 4, 5, 6, 7, 0, 1, 2, 3, 4, 0, 1, 2, 3, 0, 1, 2, 0, 1, 0, 1, 0, 1, 0, 0, 0, 0, 0, 0, 0, 0, 15, 15, 15, 15, 15, 15, 15, 15, 15, 15, 15, 15, 15, 15};

__device__ __forceinline__ float wave_sum(float v) {
  for (int o = 32; o > 0; o >>= 1) v += __shfl_xor(v, o);
  return v;
}
__device__ __forceinline__ float wave_max(float v) {
  for (int o = 32; o > 0; o >>= 1) v = fmaxf(v, __shfl_xor(v, o));
  return v;
}
__device__ __forceinline__ float silu_f(float x) { return x / (1.f + expf(-x)); }
__device__ __forceinline__ float softplus_f(float x) { return fmaxf(x, 0.f) + log1pf(expf(-fabsf(x))); }

constexpr size_t al256(size_t x) { return (x + 255) & ~(size_t)255; }
constexpr size_t WS_CTL = 0;
constexpr size_t WS_WINT = 65536;
constexpr size_t WS_WDTT = WS_WINT + (size_t)NPROJ * DM * 2;
constexpr size_t WS_WOUTT = WS_WDTT + (size_t)16 * DM * 2;
constexpr size_t WS_WQT = WS_WOUTT + (size_t)DM * DM * 2;
constexpr size_t WS_KEYS = WS_WQT + (size_t)DM * DM * 2;
constexpr size_t WS_UB = WS_KEYS + (size_t)16 * 128 * 128 * 2;
constexpr size_t WS_VB = WS_UB + (size_t)NEXP * DM * 2;
constexpr size_t WS_HNB = WS_VB + (size_t)NEXP * DM * 2;
constexpr size_t WS_PROJ = WS_HNB + (size_t)(T + 16) * DM * 2;
constexpr size_t WS_DTRAW = WS_PROJ + (size_t)T * NPROJ * 2;
constexpr size_t WS_PROJM = WS_DTRAW + (size_t)T * 16 * 4;
constexpr size_t WS_PROJMB = al256(WS_PROJM + (size_t)16 * DPROJ * 4);
constexpr size_t WS_H1B = al256(WS_PROJMB + (size_t)16 * DPROJ * 2);
constexpr size_t WS_SSQH1 = WS_H1B + (size_t)T * DM * 2;
constexpr size_t WS_STOP = al256(WS_SSQH1 + (size_t)T * 32 * 4);
constexpr size_t WS_ITOP = WS_STOP + (size_t)T * 256 * 4;
constexpr size_t WS_ACSG = al256(WS_ITOP + (size_t)T * 256 * 4);
constexpr size_t WS_CCB = WS_ACSG + (size_t)T * 16 * 4;
constexpr size_t WS_YPART = WS_CCB + (size_t)T * 256 * 2;
constexpr size_t WS_SG = WS_YPART + (size_t)T * 1024 * 4;
constexpr size_t WS_SMETA = WS_SG + (size_t)1024 * 8192 * 4;
constexpr size_t WS_HPREV = al256(WS_SMETA + (size_t)16 * 8192 * 4);
constexpr size_t WS_USC = al256(WS_HPREV + (size_t)1024 * 8192 * 2);
constexpr size_t WS_VSC = WS_USC + (size_t)NEXP * 4;
constexpr size_t WS_SCR = al256(WS_VSC + (size_t)NEXP * 4);
}

namespace pg8 {
#define PG8_LAS __attribute__((address_space(3)))
constexpr int BM = 256, BK = 64, HALF = 128, HTB = HALF * BK * 2, STAGE_BYTES = 8 * HTB, NXCD = 8, WGM = 8;
__host__ __device__ __forceinline__ int lds_byte(int r, int c) { const int st = (r >> 4) * 2 + (c >> 5), rr = r & 15, cc = c & 31, ob = rr * 64 + cc * 2; return st * 1024 + (ob ^ (((ob >> 9) & 1) << 5)); }
__host__ __device__ __forceinline__ void stage_rc(int b, int& R, int& C) { const int st = b / 1024, sb = b % 1024, swz = sb ^ (((sb >> 9) & 1) << 5); R = (st >> 1) * 16 + swz / 64; C = (st & 1) * 32 + (swz % 64) / 2; }
__host__ __device__ __forceinline__ int perm32(int rho) { const int n = rho >> 4, i = rho & 15; return 8 * (i >> 2) + 4 * n + (i & 3); }
struct Unit { int pm, pn; };
struct Gemm { const bf16_t* A; const bf16_t* Bt; int M, N, K; };
struct StaticOrder {
    int nM, nN, nwg, G, c;
    __host__ __device__ void init(int M, int N, int G_, int c_) { nM = M / BM; nN = N / BM; nwg = nM * nN; G = G_; c = c_; }
    __host__ __device__ bool next(int i, Unit& u) const {
        const long L = (long)i * G + c; if (L >= nwg) return false;
        int wgid = (int)L; { const int q = nwg / NXCD, r = nwg % NXCD, xcd = wgid % NXCD, off = wgid / NXCD; wgid = (xcd < r ? xcd * (q + 1) : r * (q + 1) + (xcd - r) * q) + off; }
        const int nig = WGM * nN, gid = wgid / nig, fm = gid * WGM, gsz = (nM - fm) < WGM ? (nM - fm) : WGM;
        u.pm = fm + ((wgid % nig) % gsz); u.pn = (wgid % nig) / gsz; return true;
    }
    __device__ __forceinline__ void a_ready(const Unit&) const {}
    __device__ __forceinline__ void done(const Unit&) const {}
};
struct EpiBf16 {
    static constexpr bool PERM = true, AFTER_DRAIN = false;
    bf16_t* O; int ldc;
    __device__ __forceinline__ void operator()(const f32x4 (&acc)[2][2][4][2], const Unit& u, int wr, int wc, int fr, int fq) const {
        const int row0 = u.pm * BM + wr * 64 + fr; const int col0 = u.pn * BM + wc * 32 + 8 * fq;
        const __amdgpu_buffer_rsrc_t rsrc = __builtin_amdgcn_make_buffer_rsrc(O, 0, 0x7fffffff, 0x00020000);
#pragma unroll
        for (int ai = 0; ai < 2; ++ai)
#pragma unroll
            for (int m = 0; m < 4; ++m) { const unsigned boff = (unsigned)(((size_t)(row0 + ai * HALF + m * 16) * ldc + col0) * 2);
#pragma unroll
                for (int bj = 0; bj < 2; ++bj) { const f32x4 v0 = acc[ai][bj][m][0], v1 = acc[ai][bj][m][1];
                    u32x4 w; w.x = pack_bf16(v0[0], v0[1]); w.y = pack_bf16(v0[2], v0[3]); w.z = pack_bf16(v1[0], v1[1]); w.w = pack_bf16(v1[2], v1[3]);
                    __builtin_amdgcn_raw_buffer_store_b128(w, rsrc, boff + bj * HALF * 2, 0, 16); } }
    }
};

struct EpiRes {
    static constexpr bool PERM = true, AFTER_DRAIN = false;
    const float* X; bf16_t* HB; float* SSQ;
    __device__ __forceinline__ void operator()(const f32x4 (&acc)[2][2][4][2], const Unit& u, int wr, int wc, int fr, int fq) const {
        const int row0 = u.pm * BM + wr * 64 + fr; const int col0 = u.pn * BM + wc * 32 + 8 * fq;
#pragma unroll
        for (int ai = 0; ai < 2; ++ai) {
            f32x4 xr[4][2][2];
#pragma unroll
            for (int m = 0; m < 4; ++m) { const size_t off = (size_t)(row0 + ai * HALF + m * 16) * DM + col0;
#pragma unroll
                for (int bj = 0; bj < 2; ++bj) { xr[m][bj][0] = __builtin_nontemporal_load((const f32x4*)(X + off + bj * HALF)); xr[m][bj][1] = __builtin_nontemporal_load((const f32x4*)(X + off + bj * HALF + 4)); } }
#pragma unroll
            for (int m = 0; m < 4; ++m) { const int row = row0 + ai * HALF + m * 16; const size_t off = (size_t)row * DM + col0; float ss = 0.f;
#pragma unroll
                for (int bj = 0; bj < 2; ++bj) {
                    const f32x4 v0 = acc[ai][bj][m][0] + xr[m][bj][0], v1 = acc[ai][bj][m][1] + xr[m][bj][1];
                    u32x4 w; w.x = pack_bf16(v0[0], v0[1]); w.y = pack_bf16(v0[2], v0[3]); w.z = pack_bf16(v1[0], v1[1]); w.w = pack_bf16(v1[2], v1[3]);
                    *(u32x4*)(HB + off + bj * HALF) = w;
                    ss += v0[0] * v0[0] + v0[1] * v0[1] + v0[2] * v0[2] + v0[3] * v0[3] + v1[0] * v1[0] + v1[1] * v1[1] + v1[2] * v1[2] + v1[3] * v1[3]; }
                ss += __shfl_xor(ss, 16); ss += __shfl_xor(ss, 32);
                if (fq == 0) SSQ[(size_t)row * 32 + u.pn * 4 + wc] = ss; }
        }
    }
};
struct EpiF32 {
    static constexpr bool PERM = true, AFTER_DRAIN = false;
    float* C; int ldc;
    __device__ __forceinline__ void operator()(const f32x4 (&acc)[2][2][4][2], const Unit& u, int wr, int wc, int fr, int fq) const {
        const int row0 = u.pm * BM + wr * 64 + fr; const int col0 = u.pn * BM + wc * 32 + 8 * fq;
#pragma unroll
        for (int ai = 0; ai < 2; ++ai)
#pragma unroll
            for (int m = 0; m < 4; ++m) { float* rowp = C + (size_t)(row0 + ai * HALF + m * 16) * ldc + col0;
#pragma unroll
                for (int bj = 0; bj < 2; ++bj) { *(f32x4*)(rowp + bj * HALF) = acc[ai][bj][m][0]; *(f32x4*)(rowp + bj * HALF + 4) = acc[ai][bj][m][1]; } }
    }
};

struct EpiScores {
    static constexpr bool PERM = true, AFTER_DRAIN = true;
    const bf16_t* KEYS;
    float* STOP; int* ITOP;
    static constexpr int QLD = 264;
    __device__ __forceinline__ void fused(f32x4 (&acc)[2][2][4][2], const Unit& u, int wr, int wc, int fr, int fq, PG8_LAS unsigned char* lds, int wid, int lane) const {
        PG8_LAS bf16_t* Q = (PG8_LAS bf16_t*)lds;
#pragma unroll
        for (int ai = 0; ai < 2; ++ai)
#pragma unroll
            for (int m = 0; m < 4; ++m) { const int row = ai * HALF + wr * 64 + m * 16 + fr;
#pragma unroll
                for (int bj = 0; bj < 2; ++bj) { const f32x4 v0 = acc[ai][bj][m][0], v1 = acc[ai][bj][m][1];
                    u32x4 w; w.x = pack_bf16(v0[0], v0[1]); w.y = pack_bf16(v0[2], v0[3]); w.z = pack_bf16(v1[0], v1[1]); w.w = pack_bf16(v1[2], v1[3]);
                    *(PG8_LAS u32x4*)(Q + row * QLD + bj * HALF + wc * 32 + 8 * fq) = w; } }
        __syncthreads();
        const int h = u.pn;
#pragma unroll 1
        for (int c = 0; c < 2; ++c) {
            f32x4 sc[8][2];
#pragma unroll
            for (int kf = 0; kf < 8; ++kf) { sc[kf][0] = (f32x4){0.f, 0.f, 0.f, 0.f}; sc[kf][1] = (f32x4){0.f, 0.f, 0.f, 0.f}; }
            const bf16_t* kb = KEYS + (size_t)((h * 2 + c) * 128 + fr) * 128 + 8 * fq;
            const PG8_LAS bf16_t* qb = Q + (wid * 32 + fr) * QLD + c * 128 + 8 * fq;
#pragma unroll
            for (int ks = 0; ks < 4; ++ks) {
                const bf16x8 q0 = *(const PG8_LAS bf16x8*)(qb + 32 * ks), q1 = *(const PG8_LAS bf16x8*)(qb + 16 * QLD + 32 * ks);
#pragma unroll
                for (int kf = 0; kf < 8; ++kf) { const bf16x8 kv = *(const bf16x8*)(kb + (size_t)kf * 16 * 128 + 32 * ks);
                    sc[kf][0] = __builtin_amdgcn_mfma_f32_16x16x32_bf16(kv, q0, sc[kf][0], 0, 0, 0);
                    sc[kf][1] = __builtin_amdgcn_mfma_f32_16x16x32_bf16(kv, q1, sc[kf][1], 0, 0, 0); }
            }
#pragma unroll
            for (int tf = 0; tf < 2; ++tf) {
                int v[32];
#pragma unroll
                for (int kf = 0; kf < 8; ++kf)
#pragma unroll
                    for (int r = 0; r < 4; ++r) {
                        const int bts = (int)__float_as_uint(sc[kf][tf][r]);
                        const int srt = bts ^ ((bts >> 31) & 0x7fffffff);
                        v[kf * 4 + r] = (srt & ~127) | (16 * kf + 4 * fq + r);
                    }
#pragma unroll
                for (int k = 2; k <= 32; k <<= 1)
#pragma unroll
                    for (int j = k >> 1; j > 0; j >>= 1)
#pragma unroll
                        for (int i = 0; i < 32; ++i) {
                            const int l = i ^ j;
                            if (l > i) {
                                const int x = v[i], y = v[l];
                                const int hi_ = x > y ? x : y, lo_ = x > y ? y : x;
                                if ((i & k) == 0) { v[i] = hi_; v[l] = lo_; } else { v[i] = lo_; v[l] = hi_; }
                            }
                        }
#pragma unroll
                for (int step = 0; step < 2; ++step) {
                    const int xm = step == 0 ? 16 : 32;
                    int m[16];
#pragma unroll
                    for (int i = 0; i < 16; ++i) { const int o = __shfl_xor(v[15 - i], xm); m[i] = v[i] > o ? v[i] : o; }
#pragma unroll
                    for (int j = 8; j > 0; j >>= 1)
#pragma unroll
                        for (int i = 0; i < 16; ++i) {
                            const int l = i ^ j;
                            if (l > i) { const int x = m[i], y = m[l]; m[i] = x > y ? x : y; m[l] = x > y ? y : x; }
                        }
#pragma unroll
                    for (int i = 0; i < 16; ++i) v[i] = m[i];
                }
                if (fq == 0) {
                    const size_t obase = ((size_t)(u.pm * BM + wid * 32 + tf * 16 + fr) * 16 + h * 2 + c) * 16;
#pragma unroll
                    for (int q4 = 0; q4 < 4; ++q4) {
                        f32x4 sv; u32x4 iv;
#pragma unroll
                        for (int i = 0; i < 4; ++i) {
                            const int key = v[4 * q4 + i], srt = key & ~127;
                            sv[i] = __uint_as_float((unsigned)(srt ^ ((srt >> 31) & 0x7fffffff)));
                            iv[i] = (unsigned)(key & 127);
                        }
                        *(f32x4*)(STOP + obase + 4 * q4) = sv;
                        *(u32x4*)(ITOP + obase + 4 * q4) = iv;
                    }
                }
            }
        }
    }
};

template <class Epi, class Sched>
__device__ __forceinline__ void gemm_phase(PG8_LAS unsigned char* lds, const Gemm g, const Sched& S, const Epi& E) {
    int tid_ = threadIdx.x; asm volatile("" : "+v"(tid_));
    const int tid = tid_, wid = __builtin_amdgcn_readfirstlane(tid >> 6), lane = tid & 63, wr = wid >> 2, wc = wid & 3, fr = lane & 15, fq = lane >> 4;
    const int K = g.K, nt = K / BK;
    unsigned voffA[2], voffB[2];
#pragma unroll
    for (int i = 0; i < 2; ++i) { int R, C; stage_rc(tid * 16 + i * 8192, R, C); const int Rb = Epi::PERM ? ((R & ~31) + perm32(R & 31)) : R;
        voffA[i] = (unsigned)(R * K + C) * 2u; voffB[i] = (unsigned)(Rb * K + C) * 2u; }
    const size_t kstep = (size_t)(BK * 2);
    const size_t hstep = (size_t)HALF * K * 2;
    const size_t tstep = 2 * hstep;
    const unsigned ldsw = (unsigned)wid * 1024u;
    const int aoff = lds_byte(wr * 64 + fr, fq * 8), boff = lds_byte(wc * 32 + fr, fq * 8);
#define PG8_SA(b, h) (((b) * 2 + (h)) * HTB)
#define PG8_SB(b, h) ((4 + (b) * 2 + (h)) * HTB)
#define PG8_STAGE(bufoff, gbase, voff) do { _Pragma("unroll") for (int _i = 0; _i < 2; ++_i) \
        __builtin_amdgcn_global_load_lds((const unsigned*)((const char*)(gbase) + (voff)[_i]), (PG8_LAS unsigned*)(lds + (bufoff) + ldsw + _i * 8192), 16, 0, 0); } while (0)
#define PG8_LDA(dst, b, h) do { _Pragma("unroll") for (int m = 0; m < 4; ++m) _Pragma("unroll") for (int k = 0; k < 2; ++k) dst[m][k] = *(const PG8_LAS bf16x8*)(lds + PG8_SA(b, h) + aoff + m * 2048 + k * 1024); } while (0)
#define PG8_LDB(dst, b, h) do { _Pragma("unroll") for (int n = 0; n < 2; ++n) _Pragma("unroll") for (int k = 0; k < 2; ++k) dst[n][k] = *(const PG8_LAS bf16x8*)(lds + PG8_SB(b, h) + boff + n * 2048 + k * 1024); } while (0)
#define PG8_MMA(ai, bj, At, Bt) do { __builtin_amdgcn_s_setprio(1); _Pragma("unroll") for (int m = 0; m < 4; ++m) _Pragma("unroll") for (int n = 0; n < 2; ++n) _Pragma("unroll") for (int k = 0; k < 2; ++k) \
        acc[ai][bj][m][n] = __builtin_amdgcn_mfma_f32_16x16x32_bf16(Bt[n][k], At[m][k], acc[ai][bj][m][n], 0, 0, 0); __builtin_amdgcn_s_setprio(0); } while (0)
#define PG8_WAIT_V(n) asm volatile("s_waitcnt vmcnt(" #n ")" ::: "memory")
#define PG8_WAIT_L(n) asm volatile("s_waitcnt lgkmcnt(" #n ")" ::: "memory")
#define PG8_BAR __builtin_amdgcn_s_barrier()
#define PG8_SCHED __builtin_amdgcn_sched_barrier(0)
    Unit cur, nxt; int ui = 0;
    if (!S.next(0, cur)) return;
    f32x4 acc[2][2][4][2];
#pragma unroll
    for (int a = 0; a < 2; ++a)
#pragma unroll
        for (int b = 0; b < 2; ++b)
#pragma unroll
            for (int m = 0; m < 4; ++m)
#pragma unroll
                for (int n = 0; n < 2; ++n) acc[a][b][m][n] = (f32x4){0.f, 0.f, 0.f, 0.f};
    bf16x8 At[4][2], B0[2][2], B1[2][2];
    const char* cA = (const char*)g.A + (size_t)cur.pm * tstep; const char* cB = (const char*)g.Bt + (size_t)cur.pn * tstep;
    S.a_ready(cur);
    PG8_STAGE(PG8_SB(0, 0), cB, voffB); PG8_STAGE(PG8_SA(0, 0), cA, voffA); PG8_STAGE(PG8_SB(0, 1), cB + hstep, voffB); PG8_STAGE(PG8_SA(0, 1), cA + hstep, voffA);
    if (wr == 1) PG8_BAR;
    PG8_WAIT_V(4); PG8_BAR;
    PG8_STAGE(PG8_SB(1, 0), cB + kstep, voffB); PG8_STAGE(PG8_SA(1, 0), cA + kstep, voffA); PG8_STAGE(PG8_SB(1, 1), cB + hstep + kstep, voffB);
    PG8_WAIT_V(6); PG8_BAR;
    for (;;) {
        const bool has_next = S.next(ui + 1, nxt);
        const char* nA = has_next ? (const char*)g.A + (size_t)nxt.pm * tstep : cA; const char* nB = has_next ? (const char*)g.Bt + (size_t)nxt.pn * tstep : cB;
        for (int t = 0; t < nt; t += 2) {
            const bool last = (t == nt - 2);
            const char* a1 = cA + (size_t)(t + 1) * kstep;
            const char* a2 = last ? nA : cA + (size_t)(t + 2) * kstep; const char* b2 = last ? nB : cB + (size_t)(t + 2) * kstep;
            const char* a3 = a2 + kstep; const char* b3 = b2 + kstep;
            if (last && has_next) S.a_ready(nxt);
            PG8_LDB(B0, 0, 0); PG8_SCHED; PG8_LDA(At, 0, 0); PG8_STAGE(PG8_SA(1, 1), a1 + hstep, voffA);
            PG8_WAIT_L(8); PG8_BAR; PG8_WAIT_L(0); PG8_MMA(0, 0, At, B0); PG8_BAR; PG8_SCHED;
            PG8_LDB(B1, 0, 1); PG8_STAGE(PG8_SB(0, 0), b2, voffB);
            PG8_BAR; PG8_WAIT_L(0); PG8_MMA(0, 1, At, B1); PG8_BAR;
            PG8_LDA(At, 0, 1); PG8_STAGE(PG8_SA(0, 0), a2, voffA);
            PG8_BAR; PG8_WAIT_L(0); PG8_MMA(1, 0, At, B0); PG8_BAR; PG8_SCHED;
            PG8_STAGE(PG8_SB(0, 1), b2 + hstep, voffB);
            PG8_WAIT_V(6); PG8_BAR; PG8_MMA(1, 1, At, B1); PG8_BAR;
            PG8_LDB(B0, 1, 0); PG8_SCHED; PG8_LDA(At, 1, 0); PG8_STAGE(PG8_SA(0, 1), a2 + hstep, voffA);
            PG8_WAIT_L(8); PG8_BAR; PG8_WAIT_L(0); PG8_MMA(0, 0, At, B0); PG8_BAR; PG8_SCHED;
            PG8_LDB(B1, 1, 1); PG8_STAGE(PG8_SB(1, 0), b3, voffB);
            PG8_BAR; PG8_WAIT_L(0); PG8_MMA(0, 1, At, B1); PG8_BAR;
            PG8_LDA(At, 1, 1); PG8_STAGE(PG8_SA(1, 0), a3, voffA);
            PG8_BAR; PG8_WAIT_L(0); PG8_MMA(1, 0, At, B0); PG8_BAR; PG8_SCHED;
            PG8_STAGE(PG8_SB(1, 1), b3 + hstep, voffB);
            PG8_WAIT_V(6); PG8_BAR; PG8_MMA(1, 1, At, B1); PG8_BAR;
        }
        if constexpr (!Epi::AFTER_DRAIN) { E(acc, cur, wr, wc, fr, fq); S.done(cur); }
        if (!has_next) break;
#pragma unroll
        for (int a = 0; a < 2; ++a)
#pragma unroll
            for (int b = 0; b < 2; ++b)
#pragma unroll
                for (int m = 0; m < 4; ++m)
#pragma unroll
                    for (int n = 0; n < 2; ++n) acc[a][b][m][n] = (f32x4){0.f, 0.f, 0.f, 0.f};
        cur = nxt; cA = nA; cB = nB; ++ui;
    }
    PG8_WAIT_V(0);
    if (wr == 0) PG8_BAR;
    PG8_BAR;
    if constexpr (Epi::AFTER_DRAIN) { E.fused(acc, cur, wr, wc, fr, fq, lds, wid, lane); S.done(cur); }
#undef PG8_SA
#undef PG8_SB
#undef PG8_STAGE
#undef PG8_LDA
#undef PG8_LDB
#undef PG8_MMA
#undef PG8_WAIT_V
#undef PG8_WAIT_L
#undef PG8_BAR
#undef PG8_SCHED
}
}

#define XB_TMO      128
#define XB_XCNT(j)  (256  + 64 * (j))
#define XB_XSUB(j)  (1280 + 64 * (j))
#define XB_XGEN(j)  (2304 + 64 * (j))
#define XB_TOP      3328
#define XB_TOPGEN   3392
#define XCD_BAR_WORDS 3456
#define XB_SPIN_CAP (1u << 22)
__device__ __forceinline__ unsigned xb_ld(unsigned* p)              { return __hip_atomic_load(p, __ATOMIC_RELAXED, __HIP_MEMORY_SCOPE_AGENT); }
__device__ __forceinline__ unsigned xb_add(unsigned* p, unsigned v) { return __hip_atomic_fetch_add(p, v, __ATOMIC_RELAXED, __HIP_MEMORY_SCOPE_AGENT); }
__device__ __forceinline__ unsigned xb_xcc_id() { return (unsigned)__builtin_amdgcn_s_getreg((3 << 11) | 20) & 0xFu; }
#define XB_SPIN(cond, bar) do { unsigned _sp = 0; while (cond) { __builtin_amdgcn_s_sleep(1); \
    if ((++_sp & 255u) == 0u) { if (xb_ld(&(bar)[XB_TMO])) break; if (_sp > XB_SPIN_CAP) { atomicAdd(&(bar)[XB_TMO], 1u); break; } } } } while (0)
struct XcdBarrier { unsigned* bar; unsigned x; volatile LAS unsigned* st; };
__device__ __forceinline__ XcdBarrier xcd_barrier_post(unsigned* bar, volatile LAS unsigned* st) {
    XcdBarrier b; b.bar = bar; b.x = xb_xcc_id(); b.st = st;
    if (threadIdx.x == 0) (void)xb_add(&bar[XB_XCNT(b.x)], 1u);
    return b;
}
__device__ __forceinline__ void xcd_barrier_complete(unsigned* bar, unsigned x, unsigned& nloc, unsigned& nx) {
    const unsigned G = gridDim.x * gridDim.y * gridDim.z;
    unsigned sum, cnt, mine, sp = 0u;
    for (;;) {
        sum = 0u; cnt = 0u; mine = 0u;
#pragma unroll
        for (unsigned j = 0; j < 16; ++j) { const unsigned c = xb_ld(&bar[XB_XCNT(j)]); sum += c; cnt += (c > 0u) ? 1u : 0u; mine = (j == x) ? c : mine; }
        if (sum == G) break;
        __builtin_amdgcn_s_sleep(1);
        if ((++sp & 255u) == 0u) { if (xb_ld(&bar[XB_TMO])) break; if (sp > XB_SPIN_CAP) { atomicAdd(&bar[XB_TMO], 1u); break; } }
    }
    nloc = mine > 0u ? mine : 1u; nx = cnt > 0u ? cnt : 1u;
}
__device__ __forceinline__ void xcd_barrier(const XcdBarrier& b) {
    asm volatile("s_waitcnt vmcnt(0)" ::: "memory");
    __syncthreads();
    if (threadIdx.x == 0) {
        unsigned* bar = b.bar;
        const unsigned bx = xb_xcc_id();
        __builtin_amdgcn_s_waitcnt(0);
        unsigned nloc = b.st[0], nx = b.st[1];
        if (nloc == 0u) { xcd_barrier_complete(bar, bx, nloc, nx); b.st[0] = nloc; b.st[1] = nx; }
        const unsigned old = xb_add(&bar[XB_XSUB(bx)], 1u);
        const unsigned gen = old / nloc;
        if (old + 1u == (gen + 1u) * nloc) {
            __builtin_amdgcn_fence(__ATOMIC_RELEASE, "agent");
            asm volatile("s_waitcnt vmcnt(0)" ::: "memory");
            const unsigned og = xb_add(&bar[XB_TOP], 1u);
            const unsigned tg = og / nx;
            if (og + 1u == (tg + 1u) * nx) xb_add(&bar[XB_TOPGEN], 1u);
            else XB_SPIN(xb_ld(&bar[XB_TOPGEN]) == tg, bar);
            __builtin_amdgcn_fence(__ATOMIC_ACQUIRE, "agent");
            xb_add(&bar[XB_XGEN(bx)], 1u);
            asm volatile("s_waitcnt vmcnt(0)" ::: "memory");
        } else {
            XB_SPIN(xb_ld(&bar[XB_XGEN(bx)]) == gen, bar);
            __builtin_amdgcn_fence(__ATOMIC_ACQUIRE, "agent");
            asm volatile("s_waitcnt vmcnt(0)" ::: "memory");
        }
    }
    __syncthreads();
}

namespace {
struct Params {
  const float *x, *meta, *rel_bias, *ln_mix, *w_in, *sinks, *conv_w, *conv_b, *dt_bias, *a_log, *d_skip, *attn_norm_w,
      *ssm_norm_w, *w_out, *ln_ffn, *wq, *keys, *U, *V, *ln_final;
  float* out;
  unsigned char* ws;
};

__device__ __forceinline__ void p0_transpose_tile(const float* __restrict__ W, int ldw, bf16_t* __restrict__ Wt, const float* sc0,
                                                  const float* sc1, int k0, int n0, float* tile) {
  int tid = threadIdx.x; asm volatile("" : "+v"(tid));
  {
    const int r = tid >> 6, c4 = (tid & 63) * 4;
    f32x4 v[8];
#pragma unroll
    for (int i = 0; i < 8; ++i) v[i] = __builtin_nontemporal_load((const f32x4*)(W + (size_t)(k0 + r + 8 * i) * ldw + n0 + c4));
#pragma unroll
    for (int i = 0; i < 8; ++i) {
      float s = 1.f;
      const int k = k0 + r + 8 * i;
      if (sc0) s = k < 1024 ? sc0[k] : sc1[k - 1024];
      float* q = tile + (r + 8 * i) * 257 + c4;
      q[0] = v[i][0] * s; q[1] = v[i][1] * s; q[2] = v[i][2] * s; q[3] = v[i][3] * s;
    }
  }
  __syncthreads();
#pragma unroll
  for (int it = 0; it < 4; ++it) {
    const int task = it * NTHREADS + tid;
    const int n = task >> 3, kc = (task & 7) * 8;
    float v[8];
#pragma unroll
    for (int j = 0; j < 8; ++j) v[j] = tile[(kc + j) * 257 + n];
    u32x4 w; w.x = pack_bf16(v[0], v[1]); w.y = pack_bf16(v[2], v[3]); w.z = pack_bf16(v[4], v[5]); w.w = pack_bf16(v[6], v[7]);
    *(u32x4*)(Wt + (size_t)(n0 + n) * DM + k0 + kc) = w;
  }
  __syncthreads();
}

__device__ __forceinline__ void phase0(const Params& p, float* ldsf, int bid, int nblk) {
  int tid = threadIdx.x; asm volatile("" : "+v"(tid));
  const int lane = tid & 63, wid = tid >> 6;
  bf16_t* w_inT = (bf16_t*)(p.ws + WS_WINT);
  bf16_t* w_dtT = (bf16_t*)(p.ws + WS_WDTT);
  bf16_t* w_outT = (bf16_t*)(p.ws + WS_WOUTT);
  bf16_t* wqT = (bf16_t*)(p.ws + WS_WQT);
  bf16_t* keysb = (bf16_t*)(p.ws + WS_KEYS);
  unsigned char* ub = p.ws + WS_UB;
  unsigned char* vb = p.ws + WS_VB;
  bf16_t* hnb = (bf16_t*)(p.ws + WS_HNB);
  constexpr int U_HN = (TA + 7) / 8;
  constexpr int U_WIN = 32 * 16, U_WOUT = 32 * 8, U_WQ = 32 * 8, U_WDT = 1, U_KEYS = 64;
  constexpr int B_WIN = U_HN, B_WOUT = B_WIN + U_WIN, B_WQ = B_WOUT + U_WOUT, B_WDT = B_WQ + U_WQ, B_KEYS = B_WDT + U_WDT,
                B_U = B_KEYS + U_KEYS, B_END = B_U;
  for (int u = bid; u < B_END; u += nblk) {
    if (u < B_WIN) {
      const int t = u * 8 + wid;
      if (t < TA) {
        const float* src = t < T ? p.x + (size_t)t * DM : p.meta + (size_t)(t - T) * DM;
        float4 v[8];
        float ss = 0.f;
#pragma unroll
        for (int i = 0; i < 8; ++i) {
          { const f32x4 q_ = __builtin_nontemporal_load((const f32x4*)(src + (i * 64 + lane) * 4)); v[i].x = q_[0]; v[i].y = q_[1]; v[i].z = q_[2]; v[i].w = q_[3]; }
          ss += v[i].x * v[i].x + v[i].y * v[i].y + v[i].z * v[i].z + v[i].w * v[i].w;
        }
        ss = wave_sum(ss);
        const float r = rsqrtf(ss * (1.f / DM) + EPS);
#pragma unroll
        for (int i = 0; i < 8; ++i) {
          const float4 w = *(const float4*)(p.ln_mix + (i * 64 + lane) * 4);
          u32x2 o; o.x = pack_bf16(v[i].x * r * w.x, v[i].y * r * w.y); o.y = pack_bf16(v[i].z * r * w.z, v[i].w * r * w.w);
          *(u32x2*)(hnb + (size_t)t * DM + (i * 64 + lane) * 4) = o;
        }
      }
    } else if (u < B_WOUT) {
      const int i = u - B_WIN;
      p0_transpose_tile(p.w_in, DPROJ, w_inT, nullptr, nullptr, (i & 31) * 64, (i >> 5) * 256, ldsf);
    } else if (u < B_WQ) {
      const int i = u - B_WOUT;
      p0_transpose_tile(p.w_out, DM, w_outT, p.attn_norm_w, p.ssm_norm_w, (i & 31) * 64, (i >> 5) * 256, ldsf);
    } else if (u < B_WDT) {
      const int i = u - B_WQ;
      p0_transpose_tile(p.wq, DM, wqT, p.ln_ffn, p.ln_ffn + 1024, (i & 31) * 64, (i >> 5) * 256, ldsf);
    } else if (u < B_KEYS) {
      for (int idx = tid; idx < DM * 16; idx += NTHREADS) {
        const int k = idx >> 4, j = idx & 15;
        w_dtT[(size_t)j * DM + k] = f2bf(p.w_in[(size_t)k * DPROJ + NPROJ + j]);
      }
    } else if (u < B_U) {
      int tk = tid;
      asm volatile("" : "+v"(tk));
      const unsigned base = (unsigned)(u - B_KEYS) * 4096u + (unsigned)tk * 8u;
      const float4 a = *(const float4*)(p.keys + base), b = *(const float4*)(p.keys + base + 4);
      u32x4 w; w.x = pack_bf16(a.x, a.y); w.y = pack_bf16(a.z, a.w); w.z = pack_bf16(b.x, b.y); w.w = pack_bf16(b.z, b.w);
      *(u32x4*)(keysb + base) = w;
    }
  }
}

__device__ __forceinline__ void convert_tables(const Params& p, int bid, int nblk) {
  int tid = threadIdx.x; asm volatile("" : "+v"(tid));
  const int lane = tid & 63, wid = tid >> 6;
  unsigned char* ub = p.ws + WS_UB;
  unsigned char* vb = p.ws + WS_VB;
  {
    const int gw = bid * 8 + wid, nw = nblk * 8;
    auto load_row = [&](f32x4 (&a)[8], const int r2) __attribute__((always_inline)) {
      const float* src = (r2 < NEXP ? p.U + (size_t)r2 * DM : p.V + (size_t)(r2 - NEXP) * DM) + lane * 4;
#pragma unroll
      for (int j = 0; j < 8; ++j) a[j] = __builtin_nontemporal_load((const f32x4*)(src + 256 * j));
    };
    auto conv_row = [&](f32x4 (&a)[8], const int r2) __attribute__((always_inline)) {
      const bool isU = r2 < NEXP;
      const int row = isU ? r2 : r2 - NEXP;
      if (isU) {
#pragma unroll
        for (int j = 0; j < 8; ++j) a[j] *= *(const f32x4*)(p.ln_ffn + lane * 4 + 256 * j);
      }
      float amax = 0.f;
#pragma unroll
      for (int j = 0; j < 8; ++j) amax = fmaxf(amax, fmaxf(fmaxf(fabsf(a[j][0]), fabsf(a[j][1])), fmaxf(fabsf(a[j][2]), fabsf(a[j][3]))));
      amax = wave_max(amax);
      const float s4 = amax > 0.f ? 6.f / amax : 1.f;
      u32x4 w4;
#pragma unroll
      for (int j = 0; j < 4; ++j) {
        unsigned w = 0;
        w = __builtin_amdgcn_cvt_scalef32_pk_fp4_f32(w, a[2 * j][0] * s4, a[2 * j][1] * s4, 1.0f, 0);
        w = __builtin_amdgcn_cvt_scalef32_pk_fp4_f32(w, a[2 * j][2] * s4, a[2 * j][3] * s4, 1.0f, 1);
        w = __builtin_amdgcn_cvt_scalef32_pk_fp4_f32(w, a[2 * j + 1][0] * s4, a[2 * j + 1][1] * s4, 1.0f, 2);
        w = __builtin_amdgcn_cvt_scalef32_pk_fp4_f32(w, a[2 * j + 1][2] * s4, a[2 * j + 1][3] * s4, 1.0f, 3);
        w4[j] = w;
      }
      *(u32x4*)((isU ? ub : vb) + (size_t)row * ROW4 + lane * 16) = w4;
      if (lane == 0) ((float*)(p.ws + (isU ? WS_USC : WS_VSC)))[row] = amax > 0.f ? amax * (1.f / 6.f) : 1.f;
    };
    f32x4 ra[8], rb[8];
    int r2 = gw;
    if (r2 < 2 * NEXP) load_row(ra, r2);
#pragma unroll 1
    for (; r2 < 2 * NEXP; r2 += 2 * nw) {
      if (r2 + nw < 2 * NEXP) load_row(rb, r2 + nw);
      conv_row(ra, r2);
      if (r2 + nw < 2 * NEXP) {
        if (r2 + 2 * nw < 2 * NEXP) load_row(ra, r2 + 2 * nw);
        conv_row(rb, r2 + nw);
      }
    }
  }
}

__device__ __forceinline__ void mini_gemm(const bf16_t* __restrict__ A, const bf16_t* __restrict__ Bt, float* __restrict__ out, int ldo,
                                          float* red, bf16_t* __restrict__ outb = nullptr) {
  int tid = threadIdx.x; asm volatile("" : "+v"(tid));
  const int lane = tid & 63, wid = tid >> 6, fr = lane & 15, fq = lane >> 4;
  f32x4 acc = {0.f, 0.f, 0.f, 0.f};
  const bf16_t* ap = A + (size_t)fr * DM + wid * 256 + fq * 8;
  const bf16_t* bp = Bt + (size_t)fr * DM + wid * 256 + fq * 8;
#pragma unroll
  for (int ks = 0; ks < 8; ++ks) {
    const bf16x8 a = *(const bf16x8*)(ap + ks * 32);
    const bf16x8 b = *(const bf16x8*)(bp + ks * 32);
    acc = __builtin_amdgcn_mfma_f32_16x16x32_bf16(a, b, acc, 0, 0, 0);
  }
#pragma unroll
  for (int r = 0; r < 4; ++r) red[wid * 256 + (4 * fq + r) * 16 + fr] = acc[r];
  __syncthreads();
  if (tid < 256) {
    float s = 0.f;
#pragma unroll
    for (int w = 0; w < 8; ++w) s += red[w * 256 + tid];
    out[(size_t)(tid >> 4) * ldo + (tid & 15)] = s;
    if (outb) outb[(size_t)(tid >> 4) * ldo + (tid & 15)] = f2bf(s);
  }
  __syncthreads();
}

__device__ __forceinline__ void phase1(const Params& p, unsigned char* lds, int bid, int nblk) {
  const bool stream_first = ((bid >> 3) & 1) != 0;
  if (stream_first) convert_tables(p, bid, nblk);
  const bf16_t* hnb = (const bf16_t*)(p.ws + WS_HNB);
  const bf16_t* w_inT = (const bf16_t*)(p.ws + WS_WINT);
  const bf16_t* w_dtT = (const bf16_t*)(p.ws + WS_WDTT);
  float* dtraw = (float*)(p.ws + WS_DTRAW);
  float* projm = (float*)(p.ws + WS_PROJM);
  constexpr int NU = 512 + 32 + 96 + 1;
  for (int u = bid; u < NU; u += nblk) {
    if (u < 512) {
      mini_gemm(hnb + (size_t)u * 16 * DM, w_dtT, dtraw + (size_t)u * 16 * 16, 16, (float*)lds);
    } else {
      const int j = u - 512;
      const int cf = j < 32 ? 64 + j : (j < 128 ? 160 + (j - 32) : 256);
      const bf16_t* bt = cf < 256 ? w_inT + (size_t)cf * 16 * DM : w_dtT;
      mini_gemm(hnb + (size_t)T * DM, bt, projm + cf * 16, DPROJ, (float*)lds, (bf16_t*)(p.ws + WS_PROJMB) + cf * 16);
    }
  }
  pg8::Gemm g{hnb, w_inT, T, NPROJ, DM};
  pg8::StaticOrder S; S.init(T, NPROJ, nblk, bid);
  pg8::EpiBf16 E{(bf16_t*)(p.ws + WS_PROJ), NPROJ};
  pg8::gemm_phase<pg8::EpiBf16, pg8::StaticOrder>((PG8_LAS unsigned char*)lds, g, S, E);
  if (!stream_first) convert_tables(p, bid, nblk);
}

__device__ __forceinline__ void phase4(const Params& p, unsigned char* lds, int bid, int nblk) {
  pg8::Gemm g{(const bf16_t*)(p.ws + WS_HNB), (const bf16_t*)(p.ws + WS_WOUTT), T, DM, DM};
  pg8::StaticOrder S; S.init(T, DM, nblk, bid);
  pg8::EpiRes E{p.x, (bf16_t*)(p.ws + WS_H1B), (float*)(p.ws + WS_SSQH1)};
  pg8::gemm_phase<pg8::EpiRes, pg8::StaticOrder>((PG8_LAS unsigned char*)lds, g, S, E);
}
__device__ __forceinline__ void phase5(const Params& p, unsigned char* lds, int bid, int nblk) {
  pg8::Gemm g{(const bf16_t*)(p.ws + WS_H1B), (const bf16_t*)(p.ws + WS_WQT), T, DM, DM};
  pg8::StaticOrder S; S.init(T, DM, nblk, bid);
  pg8::EpiScores E{(const bf16_t*)(p.ws + WS_KEYS), (float*)(p.ws + WS_STOP), (int*)(p.ws + WS_ITOP)};
  pg8::gemm_phase<pg8::EpiScores, pg8::StaticOrder>((PG8_LAS unsigned char*)lds, g, S, E);
}

__device__ __forceinline__ float dot2bf(unsigned a, unsigned b, float c) {
  return __builtin_amdgcn_fdot2_f32_bf16(*(bf16v2*)&a, *(bf16v2*)&b, c, false);
}
__device__ __forceinline__ void phase6(const Params& p, unsigned char* lds, int bid, int nblk) {
  const int tid0 = threadIdx.x, lane0 = tid0 & 63, wid = __builtin_amdgcn_readfirstlane(tid0 >> 6);
  int* ids = (int*)(lds + wid * 2048);
  float* gts = (float*)(lds + wid * 2048 + 512);
  float* wts = (float*)(lds + wid * 2048 + 1024);
  int* rid = (int*)(lds + 16384 + wid * 1024);
  float* rgt = (float*)(lds + 16384 + wid * 1024 + 512);
  const unsigned char* ub = p.ws + WS_UB;
  const unsigned char* vb = p.ws + WS_VB;
  const bf16_t* h1b = (const bf16_t*)(p.ws + WS_H1B);
  const float* usc = (const float*)(p.ws + WS_USC);
  const float* vsc = (const float*)(p.ws + WS_VSC);
  const float* ssq = (const float*)(p.ws + WS_SSQH1);
  const float* stop = (const float*)(p.ws + WS_STOP);
  const int* itop = (const int*)(p.ws + WS_ITOP);
  const int ci = kCandI[lane0], cj = kCandJ[lane0];
#pragma unroll 1
  for (int t = bid * 8 + wid; t < T; t += nblk * 8) {
    int tid = tid0; asm volatile("" : "+v"(tid));
    const int lane = tid & 63;
    const int kcode = 8 * ((lane >> 2) & 1) + 4 * ((lane >> 3) & 1) + 2 * ((lane >> 4) & 1) + ((lane >> 5) & 1);
    const float part0 = lane < 32 ? ssq[(size_t)t * 32 + lane] : 0.f;
    const float rr = rsqrtf(wave_sum(part0) * (1.f / DM) + EPS);
#pragma unroll 1
    for (int h = 0; h < 8; ++h) {
      const size_t lbase = ((size_t)t * 16 + h * 2) * 16;
      const float sv = lane < 32 ? __builtin_nontemporal_load(stop + lbase + lane) : 0.f;
      const int iv = lane < 32 ? __builtin_nontemporal_load(itop + lbase + lane) : 0;
      float cand = (__shfl(sv, ci) + __shfl(sv, 16 + cj)) * rr;
      if (lane >= 50) cand = -INFINITY;
      unsigned key = __float_as_uint(cand);
      key = (key & 0x80000000u) ? ~key : (key | 0x80000000u);
      key = (key & ~63u) | (unsigned)(63 - lane);
      int rank = 0;
#pragma unroll
      for (int k = 0; k < 50; ++k) {
        const unsigned kk = (unsigned)__builtin_amdgcn_readlane((int)key, k);
        rank += kk > key ? 1 : 0;
      }
      const float cmax = wave_max(cand);
      const float ex = rank < 16 ? __expf(cand - cmax) : 0.f;
      const float den = wave_sum(ex);
      const int eidx = __shfl(iv, ci) * 128 + __shfl(iv, 16 + cj);
      if (rank < 16) { rid[h * 16 + rank] = eidx; rgt[h * 16 + rank] = ex / den; }
    }
    {
      const int e0 = rid[lane], e1 = rid[lane + 64];
      const float g0 = rgt[lane], g1 = rgt[lane + 64];
      const int r0 = e0 >> 10, r1 = e1 >> 10;
      const unsigned long long ltm = (1ull << lane) - 1ull;
      int run = 0, pos0 = 0, pos1 = 0;
#pragma unroll
      for (int R = 0; R < 16; ++R) {
        const unsigned long long m0 = __ballot(r0 == R), m1 = __ballot(r1 == R);
        const int c0 = __popcll(m0), c1 = __popcll(m1);
        if (r0 == R) pos0 = run + __popcll(m0 & ltm);
        if (r1 == R) pos1 = run + c0 + __popcll(m1 & ltm);
        run += c0 + c1;
      }
      ids[pos0] = e0; gts[pos0] = g0;
      ids[pos1] = e1; gts[pos1] = g1;
    }
    float xf[32];
    {
      const bf16_t* xp = h1b + (size_t)t * DM + lane * 4;
#pragma unroll
      for (int j = 0; j < 8; ++j) {
        const u32x2 xa = *(const u32x2*)(xp + 256 * j);
        xf[4 * j + 0] = bflo(xa.x); xf[4 * j + 1] = bfhi(xa.x); xf[4 * j + 2] = bflo(xa.y); xf[4 * j + 3] = bfhi(xa.y);
      }
    }
#pragma unroll 1
    for (int rnd = 0; rnd < 8; ++rnd) {
      u32x4 ra[16];
#pragma unroll
      for (int k = 0; k < 16; ++k) {
        const int e = __builtin_amdgcn_readfirstlane(ids[rnd * 16 + k]);
        ra[k] = *(const u32x4*)(ub + (size_t)e * ROW4 + lane * 16);
      }
      float part[16];
      float prev = 0.f;
#pragma unroll
      for (int k = 0; k < 16; ++k) {
        asm volatile("" : "+v"(ra[k]) : "v"(prev));
        float d0 = 0.f, d1 = 0.f;
#define U4_STEP(j, i) { const f32x2 r = __builtin_amdgcn_cvt_scalef32_pk_f32_fp4(ra[k][j], 1.0f, i); \
          d0 = fmaf(r[0], xf[8 * (j) + 2 * (i)], d0); d1 = fmaf(r[1], xf[8 * (j) + 2 * (i) + 1], d1); }
#pragma unroll
        for (int j = 0; j < 4; ++j) { U4_STEP(j, 0) U4_STEP(j, 1) U4_STEP(j, 2) U4_STEP(j, 3) }
#undef U4_STEP
        prev = d0 + d1;
        part[k] = prev;
      }
      float q8[8], q4[4], q2[2], q1;
      { const bool hi = (lane >> 5) & 1;
#pragma unroll
        for (int i = 0; i < 8; ++i) { const float keep = hi ? part[2 * i + 1] : part[2 * i], send = hi ? part[2 * i] : part[2 * i + 1]; q8[i] = keep + __shfl_xor(send, 32); } }
      { const bool hi = (lane >> 4) & 1;
#pragma unroll
        for (int i = 0; i < 4; ++i) { const float keep = hi ? q8[2 * i + 1] : q8[2 * i], send = hi ? q8[2 * i] : q8[2 * i + 1]; q4[i] = keep + __shfl_xor(send, 16); } }
      { const bool hi = (lane >> 3) & 1;
#pragma unroll
        for (int i = 0; i < 2; ++i) { const float keep = hi ? q4[2 * i + 1] : q4[2 * i], send = hi ? q4[2 * i] : q4[2 * i + 1]; q2[i] = keep + __shfl_xor(send, 8); } }
      { const bool hi = (lane >> 2) & 1;
        const float keep = hi ? q2[1] : q2[0], send = hi ? q2[0] : q2[1]; q1 = keep + __shfl_xor(send, 4); }
      q1 += __shfl_xor(q1, 2);
      q1 += __shfl_xor(q1, 1);
      {
        const int kk = rnd * 16 + kcode;
        const int eid = ids[kk];
        const float a = q1 * rr * usc[eid];
        const float ge = 0.5f * a * (1.f + erff(a * 0.70710678118654752f));
        if ((lane & 3) == 0) wts[kk] = gts[kk] * ge * vsc[eid];
      }
    }
    float acc[32];
#pragma unroll
    for (int i = 0; i < 32; ++i) acc[i] = 0.f;
#pragma unroll 1
    for (int rnd = 0; rnd < 8; ++rnd) {
      u32x4 ra[16];
#pragma unroll
      for (int k = 0; k < 16; ++k) {
        const int e = __builtin_amdgcn_readfirstlane(ids[rnd * 16 + k]);
        ra[k] = *(const u32x4*)(vb + (size_t)e * ROW4 + lane * 16);
      }
      f32x4 wv[4];
#pragma unroll
      for (int j = 0; j < 4; ++j) wv[j] = *(const f32x4*)(wts + rnd * 16 + 4 * j);
#pragma unroll
      for (int k = 0; k < 16; ++k) {
        const float wk = wv[k >> 2][k & 3];
        asm volatile("" : "+v"(ra[k]) : "v"(acc[1]), "v"(acc[3]), "v"(acc[5]), "v"(acc[7]), "v"(acc[9]), "v"(acc[11]), "v"(acc[13]), "v"(acc[15]),
                                        "v"(acc[17]), "v"(acc[19]), "v"(acc[21]), "v"(acc[23]), "v"(acc[25]), "v"(acc[27]), "v"(acc[29]), "v"(acc[31]));
#define V4_STEP(j, i) { const f32x2 r = __builtin_amdgcn_cvt_scalef32_pk_f32_fp4(ra[k][j], 1.0f, i); \
            acc[8 * (j) + 2 * (i)] = fmaf(wk, r[0], acc[8 * (j) + 2 * (i)]); acc[8 * (j) + 2 * (i) + 1] = fmaf(wk, r[1], acc[8 * (j) + 2 * (i) + 1]); }
#pragma unroll
        for (int j = 0; j < 4; ++j) { V4_STEP(j, 0) V4_STEP(j, 1) V4_STEP(j, 2) V4_STEP(j, 3) }
#undef V4_STEP
      }
    }
    float ss = 0.f;
#pragma unroll
    for (int i = 0; i < 32; ++i) { acc[i] += xf[i]; ss += acc[i] * acc[i]; }
    ss = wave_sum(ss);
    const float rf = rsqrtf(ss * (1.f / DM) + EPS);
#pragma unroll
    for (int j = 0; j < 8; ++j) {
      const f32x4 lw = *(const f32x4*)(p.ln_final + 256 * j + lane * 4);
      const f32x4 o = {acc[4 * j] * rf * lw[0], acc[4 * j + 1] * rf * lw[1], acc[4 * j + 2] * rf * lw[2], acc[4 * j + 3] * rf * lw[3]};
      __builtin_nontemporal_store(o, (f32x4*)(p.out + (size_t)t * DM + 256 * j + lane * 4));
    }
  }
}

typedef float f32x16 __attribute__((ext_vector_type(16)));
__device__ __forceinline__ void unpack8(const u32x4 a, float (&v)[8]) {
  v[0] = bflo(a.x); v[1] = bfhi(a.x); v[2] = bflo(a.y); v[3] = bfhi(a.y); v[4] = bflo(a.z); v[5] = bfhi(a.z); v[6] = bflo(a.w); v[7] = bfhi(a.w);
}
constexpr int VT_LD = 196;
constexpr int ATT_VT_BYTES = 4 * 64 * VT_LD * 2;
__device__ __forceinline__ void attn_item(const Params& p, unsigned char* lds, int item, const bool first) {
  int tid = threadIdx.x; asm volatile("" : "+v"(tid));
  const int lane = tid & 63, wid = __builtin_amdgcn_readfirstlane(tid >> 6);
  const int b = item >> 6, qb = item & 63, q0 = qb * 32;
  bf16_t* VT = (bf16_t*)lds;
  float* biasL = (float*)(lds + ATT_VT_BYTES);
  float* ssqw = biasL + 16 * 132;
  const bf16_t* proj = (const bf16_t*)(p.ws + WS_PROJ);
  const float* projm = (const float*)(p.ws + WS_PROJM);
  bf16_t* mixin = (bf16_t*)(p.ws + WS_HNB);
  if (first) {
#pragma unroll
  for (int it = 0; it < 5; ++it) {
    const int idx = it * NTHREADS + tid;
    if (idx >= 16 * 129) break;
    const int hq = idx / 129, d = idx - hq * 129;
    int bk = d;
    if (d >= 16) bk = 16 + (d >= 19) + (d >= 21) + (d >= 24) + (d >= 27) + (d >= 31) + (d >= 35) + (d >= 40) + (d >= 46) + (d >= 52) + (d >= 59) +
                      (d >= 67) + (d >= 77) + (d >= 87) + (d >= 99) + (d >= 113);
    biasL[hq * 132 + d] = p.rel_bias[bk * 16 + hq];
  }
  }
  const int ql = lane & 31, ql0 = ql, hh = lane >> 5, kvh = wid >> 1;
  const int trow = b * SEQ + q0 + ql;
  bf16x8 qf[4];
  u32x4 kf[6][4];
#define ATT_LOAD_Q(hq_)                                                                                                           \
  { _Pragma("unroll") for (int ks = 0; ks < 4; ++ks) qf[ks] = *(const bf16x8*)(proj + (size_t)trow * NPROJ + OFF_Q + (hq_) * 64 + ks * 16 + hh * 8); }
#define ATT_LOAD_K()                                                                                                              \
  {                                                                                                                               \
    int ql = ql0; asm volatile("" : "+v"(ql));     \
    const float* kr_ = projm + (size_t)(ql & 15) * DPROJ + OFF_K + kvh * 64 + hh * 8;                                             \
    _Pragma("unroll") for (int ks = 0; ks < 4; ++ks) {                                                                            \
      const f32x4 a_ = *(const f32x4*)(kr_ + ks * 16), c_ = *(const f32x4*)(kr_ + ks * 16 + 4);                                   \
      kf[0][ks].x = pack_bf16(a_[0], a_[1]); kf[0][ks].y = pack_bf16(a_[2], a_[3]); kf[0][ks].z = pack_bf16(c_[0], c_[1]); kf[0][ks].w = pack_bf16(c_[2], c_[3]); } \
    _Pragma("unroll") for (int jt = 1; jt < 6; ++jt) {                                                                            \
      int sp_ = q0 - 128 + 32 * (jt - 1) + ql; sp_ = sp_ < 0 ? 0 : sp_;                                                           \
      const bf16_t* kp_ = proj + (size_t)(b * SEQ + sp_) * NPROJ + OFF_K + kvh * 64 + hh * 8;                                     \
      _Pragma("unroll") for (int ks = 0; ks < 4; ++ks) kf[jt][ks] = *(const u32x4*)(kp_ + ks * 16); }                             \
  }
  const int qb4 = (qb + 4) % 5;
  if (first) {
    u32x4 ra[5], rc[5];
#pragma unroll
    for (int q = 0; q < 5; ++q) {
      const int task = q * NTHREADS + tid, ch = task / 80, pi = task - ch * 80;
      int s0 = q0 - 128 + 2 * pi;
      s0 = s0 < 0 ? 0 : s0;
      const unsigned off = (unsigned)((b * SEQ + s0) * NPROJ + OFF_V + ch * 8);
      ra[q] = *(const u32x4*)(proj + off); rc[q] = *(const u32x4*)(proj + off + NPROJ);
    }
    float m0[8], m1[8];
    {
      const int pi = tid & 7, ch = (tid >> 3) & 31;
      const float* r0 = projm + (size_t)(2 * pi) * DPROJ + OFF_V + ch * 8;
      const f32x4 ma = *(const f32x4*)r0, mb = *(const f32x4*)(r0 + 4), mc = *(const f32x4*)(r0 + DPROJ), md = *(const f32x4*)(r0 + DPROJ + 4);
      const float keep = tid < 256 ? 1.f : 0.f;
#pragma unroll
      for (int i = 0; i < 4; ++i) { m0[i] = ma[i] * keep; m0[4 + i] = mb[i] * keep; m1[i] = mc[i] * keep; m1[4 + i] = md[i] * keep; }
      bf16_t* dst = VT + (size_t)((ch >> 3) * 64 + (ch & 7) * 8) * VT_LD + 2 * pi + (tid < 256 ? 0 : 16);
#pragma unroll
      for (int i = 0; i < 8; ++i) *(unsigned*)(dst + i * VT_LD) = pack_bf16(m0[i], m1[i]);
    }
#pragma unroll
    for (int q = 0; q < 5; ++q) {
      const int task = q * NTHREADS + tid, ch = task / 80, pi = task - ch * 80;
      float v0[8], v1[8];
      unpack8(ra[q], v0); unpack8(rc[q], v1);
      int rp = qb4 + (pi >> 4); rp = rp >= 5 ? rp - 5 : rp;
      const int slot = 32 + rp * 32 + 2 * (pi & 15);
      bf16_t* dst = VT + (size_t)((ch >> 3) * 64 + (ch & 7) * 8) * VT_LD + slot;
#pragma unroll
      for (int i = 0; i < 8; ++i) *(unsigned*)(dst + i * VT_LD) = pack_bf16(v0[i], v1[i]);
    }
  } else {
    const int ch = tid >> 4, pw = tid & 15;
    const bf16_t* r0 = proj + (size_t)(b * SEQ + q0 + 2 * pw) * NPROJ + OFF_V + ch * 8;
    const u32x4 ra = *(const u32x4*)r0, rc = *(const u32x4*)(r0 + NPROJ);
    float v0[8], v1[8];
    unpack8(ra, v0); unpack8(rc, v1);
    const int slot = 32 + ((qb4 + 4) % 5) * 32 + 2 * pw;
    bf16_t* dst = VT + (size_t)((ch >> 3) * 64 + (ch & 7) * 8) * VT_LD + slot;
#pragma unroll
    for (int i = 0; i < 8; ++i) *(unsigned*)(dst + i * VT_LD) = pack_bf16(v0[i], v1[i]);
  }
  __syncthreads();
  float ssq = 0.f;
#pragma unroll 1
  for (int rep_ = 0; rep_ < (REP_SUB == 3 ? 2 : 1); ++rep_) {
  ssq = 0.f;
  auto do_head = [&](const int hsel) __attribute__((always_inline)) {
    const int hq = 2 * wid + hsel;
    f32x16 sacc[6];
#pragma unroll
    for (int jt = 0; jt < 6; ++jt) {
      f32x16 acc;
#pragma unroll
      for (int r = 0; r < 16; ++r) acc[r] = 0.f;
#pragma unroll
      for (int ks = 0; ks < 4; ++ks) acc = __builtin_amdgcn_mfma_f32_32x32x16_bf16(*(bf16x8*)&kf[jt][ks], qf[ks], acc, 0, 0, 0);
      sacc[jt] = acc;
    }
    if (hsel == 0) { ATT_LOAD_Q(2 * wid + 1) }
    const float* bl = biasL + hq * 132;
    int sq = q0 + ql, qh = ql - 4 * hh;
    asm volatile("" : "+v"(sq), "+v"(qh));
    const float sink = p.sinks[hq];
    float m = sink;
#pragma unroll
    for (int jt = 0; jt < 6; ++jt) {
      asm volatile("" ::: "memory");
#pragma unroll
      for (int r = 0; r < 16; ++r) {
        const int kr = (r & 3) + 8 * (r >> 2) + 4 * hh;
        int dist; bool valid;
        if (jt == 0) { dist = sq + (16 - ((r & 3) + 8 * (r >> 2))) - 4 * hh; valid = kr < 16; }
        else { dist = qh + (128 - 32 * (jt - 1) - ((r & 3) + 8 * (r >> 2))); valid = (dist >= 0) && (dist < 128) && (dist <= sq); }
        const int dc = dist < 0 ? 0 : (dist > 128 ? 128 : dist);
        const float l = valid ? 0.125f * sacc[jt][r] + bl[dc] : -1e30f;
        sacc[jt][r] = l;
        m = fmaxf(m, l);
      }
    }
    m = fmaxf(m, __shfl_xor(m, 32));
    float sum = 0.f;
    f32x16 oacc0, oacc1;
#pragma unroll
    for (int r = 0; r < 16; ++r) { oacc0[r] = 0.f; oacc1[r] = 0.f; }
    const bf16_t* vrow0 = VT + (size_t)(kvh * 64 + ql) * VT_LD + 4 * hh;
    const bf16_t* vrow1 = vrow0 + 32 * VT_LD;
#pragma unroll
    for (int jt = 0; jt < 6; ++jt) {
      u32x4 pw[2];
#pragma unroll
      for (int s2 = 0; s2 < 2; ++s2) {
        float e[8];
#pragma unroll
        for (int i = 0; i < 8; ++i) { e[i] = __expf(sacc[jt][8 * s2 + i] - m); sum += e[i]; }
        pw[s2].x = pack_bf16(e[0], e[1]); pw[s2].y = pack_bf16(e[2], e[3]); pw[s2].z = pack_bf16(e[4], e[5]); pw[s2].w = pack_bf16(e[6], e[7]);
      }
#pragma unroll
      for (int s2 = 0; s2 < 2; ++s2) {
        const int sl = (jt == 0 ? 0 : 32 + ((qb4 + jt - 1) % 5) * 32) + 16 * s2;
        const u32x2 va = *(const u32x2*)(vrow0 + sl), vc = *(const u32x2*)(vrow0 + sl + 8);
        const u32x2 vd = *(const u32x2*)(vrow1 + sl), ve = *(const u32x2*)(vrow1 + sl + 8);
        u32x4 v0w; v0w.x = va.x; v0w.y = va.y; v0w.z = vc.x; v0w.w = vc.y;
        u32x4 v1w; v1w.x = vd.x; v1w.y = vd.y; v1w.z = ve.x; v1w.w = ve.y;
        oacc0 = __builtin_amdgcn_mfma_f32_32x32x16_bf16(*(bf16x8*)&v0w, *(bf16x8*)&pw[s2], oacc0, 0, 0, 0);
        oacc1 = __builtin_amdgcn_mfma_f32_32x32x16_bf16(*(bf16x8*)&v1w, *(bf16x8*)&pw[s2], oacc1, 0, 0, 0);
      }
    }
    sum += __shfl_xor(sum, 32);
    const float inv = 1.f / (sum + __expf(sink - m));
#pragma unroll
    for (int r = 0; r < 16; ++r) { oacc0[r] *= inv; oacc1[r] *= inv; ssq += oacc0[r] * oacc0[r] + oacc1[r] * oacc1[r]; }
#pragma unroll
    for (int rg = 0; rg < 4; ++rg) {
      u32x2 w; w.x = pack_bf16(oacc0[rg * 4 + 0], oacc0[rg * 4 + 1]); w.y = pack_bf16(oacc0[rg * 4 + 2], oacc0[rg * 4 + 3]);
      *(u32x2*)(mixin + (size_t)trow * DM + hq * 64 + 8 * rg + 4 * hh) = w;
      u32x2 w1; w1.x = pack_bf16(oacc1[rg * 4 + 0], oacc1[rg * 4 + 1]); w1.y = pack_bf16(oacc1[rg * 4 + 2], oacc1[rg * 4 + 3]);
      *(u32x2*)(mixin + (size_t)trow * DM + hq * 64 + 32 + 8 * rg + 4 * hh) = w1;
    }
  };
  ATT_LOAD_Q(2 * wid)
  ATT_LOAD_K()
  do_head(0);
  asm volatile("" ::: "memory");
  ATT_LOAD_K()
  do_head(1);
  }
  ssq += __shfl_xor(ssq, 32);
  if (lane < 32) ssqw[wid * 32 + lane] = ssq;
  __syncthreads();
  float tot = 0.f;
#pragma unroll
  for (int w = 0; w < 8; ++w) tot += ssqw[w * 32 + ql];
  const float ra = rsqrtf(tot * (1.f / 1024) + EPS);
#pragma unroll
  for (int hsel = 0; hsel < 2; ++hsel)
#pragma unroll
    for (int dt = 0; dt < 2; ++dt)
#pragma unroll
      for (int rg = 0; rg < 4; ++rg) {
        bf16_t* op = mixin + (size_t)trow * DM + (2 * wid + hsel) * 64 + 32 * dt + 8 * rg + 4 * hh;
        const u32x2 v = *(const u32x2*)op;
        u32x2 w; w.x = pack_bf16(bflo(v.x) * ra, bfhi(v.x) * ra); w.y = pack_bf16(bflo(v.y) * ra, bfhi(v.y) * ra);
        *(u32x2*)op = w;
      }
  __syncthreads();
}
#undef ATT_LOAD_Q
#undef ATT_LOAD_K

constexpr int SLD = 136;
__device__ __forceinline__ float conv_silu(const float (&raw)[11], int i, float w0, float w1, float w2, float w3, float cb) {
  return silu_f(cb + w0 * raw[i] + w1 * raw[i + 1] + w2 * raw[i + 2] + w3 * raw[i + 3]);
}
__device__ __forceinline__ void ssd_a_item(const Params& p, unsigned char* lds, int item) {
  int tid = threadIdx.x; asm volatile("" : "+v"(tid));
  const int lane = tid & 63, wid = __builtin_amdgcn_readfirstlane(tid >> 6);
  const int b = item >> 5, c = (item >> 1) & 15, g = item & 1;
  const int h0 = g * 8;
  const int t0 = b * SEQ + c * 128;
  bf16_t* Bc = (bf16_t*)lds;
  bf16_t* Cc = Bc + 128 * SLD;
  bf16_t* BcT = Cc + 128 * SLD;
  bf16_t* xT = BcT + 128 * SLD;
  float* dtl = (float*)(xT + 2 * 64 * SLD);
  float* acs = dtl + 256;
  float* wl = acs + 256;
  float* scan = wl + 256;
  const bf16_t* __restrict__ proj = (const bf16_t*)(p.ws + WS_PROJ);
  const bf16_t* __restrict__ projmb = (const bf16_t*)(p.ws + WS_PROJMB);
  const float* __restrict__ dtraw = (const float*)(p.ws + WS_DTRAW);
  float* __restrict__ acsg = (float*)(p.ws + WS_ACSG);
  bf16_t* __restrict__ ccb = (bf16_t*)(p.ws + WS_CCB);
  bf16_t* __restrict__ ypart = (bf16_t*)(p.ws + WS_YPART);
  float* __restrict__ sg = (float*)(p.ws + WS_SG);
  {
    unsigned raw[4][11];
#pragma unroll
    for (int q = 0; q < 4; ++q) {
      const int task = q * NTHREADS + tid;
      const int tg = task >> 7, cp = task & 127;
      const int cch = 1024 + (cp >> 6) * 256 + g * 128 + 2 * (cp & 63);
#pragma unroll
      for (int i = 0; i < 11; ++i) {
        const int l = tg * 8 + i - 3;
        const bf16_t* src = (l >= 0 || c > 0) ? proj + (size_t)(t0 + l) * NPROJ : projmb + (size_t)(16 + l) * DPROJ;
        raw[q][i] = *(const unsigned*)(src + OFF_XBC + cch);
      }
    }
#pragma unroll
    for (int q = 0; q < 4; ++q) {
      const int task = q * NTHREADS + tid;
      const int tg = task >> 7, cp = task & 127, n = 2 * (cp & 63);
      const int cch = 1024 + (cp >> 6) * 256 + g * 128 + n;
      float o0[8], o1[8];
      {
        float r0[11], r1[11];
#pragma unroll
        for (int i = 0; i < 11; ++i) { r0[i] = bflo(raw[q][i]); r1[i] = bfhi(raw[q][i]); }
        const float w0 = p.conv_w[cch], w1 = p.conv_w[D_XBC + cch], w2 = p.conv_w[2 * D_XBC + cch], w3 = p.conv_w[3 * D_XBC + cch], cb = p.conv_b[cch];
        const float v0 = p.conv_w[cch + 1], v1 = p.conv_w[D_XBC + cch + 1], v2 = p.conv_w[2 * D_XBC + cch + 1], v3 = p.conv_w[3 * D_XBC + cch + 1], vb_ = p.conv_b[cch + 1];
#pragma unroll
        for (int i = 0; i < 8; ++i) { o0[i] = conv_silu(r0, i, w0, w1, w2, w3, cb); o1[i] = conv_silu(r1, i, v0, v1, v2, v3, vb_); }
      }
      bf16_t* rowm = (cp < 64 ? Bc : Cc) + (tg * 8) * SLD + n;
#pragma unroll
      for (int i = 0; i < 8; ++i) *(unsigned*)(rowm + i * SLD) = pack_bf16(o0[i], o1[i]);
      if (cp < 64) {
        u32x4 w; w.x = pack_bf16(o0[0], o0[1]); w.y = pack_bf16(o0[2], o0[3]); w.z = pack_bf16(o0[4], o0[5]); w.w = pack_bf16(o0[6], o0[7]);
        *(u32x4*)(BcT + n * SLD + tg * 8) = w;
        u32x4 w2_; w2_.x = pack_bf16(o1[0], o1[1]); w2_.y = pack_bf16(o1[2], o1[3]); w2_.z = pack_bf16(o1[4], o1[5]); w2_.w = pack_bf16(o1[6], o1[7]);
        *(u32x4*)(BcT + (n + 1) * SLD + tg * 8) = w2_;
      }
    }
  }
  float xraw[4][11];
#define SSD_LOAD_X(r_)                                                                                              \
  _Pragma("unroll") for (int q = 0; q < 4; ++q) {                                                                   \
    const int task = (q & 1) * NTHREADS + tid; const int tg = task >> 6, cch = (h0 + 2 * (r_) + (q >> 1)) * 64 + (task & 63); \
    _Pragma("unroll") for (int i = 0; i < 11; ++i) { const int l = tg * 8 + i - 3;                                  \
      const bf16_t* src = (l >= 0 || c > 0) ? proj + (size_t)(t0 + l) * NPROJ : projmb + (size_t)(16 + l) * DPROJ;  \
      xraw[q][i] = bf2f(src[OFF_XBC + cch]); } }
  SSD_LOAD_X(0)
  __syncthreads();
  {
#pragma unroll
    for (int q = 0; q < 4; ++q) {
      const int idx = q * NTHREADS + tid, row = idx >> 4, ck = idx & 15;
      *(u32x4*)(ccb + (size_t)(t0 + row) * 256 + g * 128 + ck * 8) = *(const u32x4*)(Cc + row * SLD + ck * 8);
    }
  }
  const int ql = lane & 31, hh = lane >> 5;
  int rnd = 0;
  auto ydiag = [&](const int hi, const int il) __attribute__((always_inline)) {
    const int h = h0 + 2 * rnd + hi, ip = wid & 1;
    const bf16_t* xTb = xT + (hi & 1) * 64 * SLD;
    const float dskip = p.d_skip[h];
    const float* acsh = acs + hi * 128;
    const float* dtlh = dtl + hi * 128;
    const int l = 32 * il + ql;
    const float acl = acsh[l];
    f32x16 yacc;
#pragma unroll
    for (int r = 0; r < 16; ++r) yacc[r] = 0.f;
    const bf16_t* xrow = xTb + (32 * ip + ql) * SLD + 4 * hh;
#pragma unroll 1
    for (int is = 0; is <= il; ++is) {
      f32x16 x;
#pragma unroll
      for (int r = 0; r < 16; ++r) x[r] = 0.f;
      const bf16_t* ap = Bc + (32 * is + ql) * SLD + 8 * hh;
      const bf16_t* bp = Cc + l * SLD + 8 * hh;
#pragma unroll
      for (int ks = 0; ks < 8; ++ks) x = __builtin_amdgcn_mfma_f32_32x32x16_bf16(*(const bf16x8*)(ap + 16 * ks), *(const bf16x8*)(bp + 16 * ks), x, 0, 0, 0);
      u32x4 pw[2];
#pragma unroll
      for (int s2 = 0; s2 < 2; ++s2) {
        float mv[8];
#pragma unroll
        for (int q = 0; q < 2; ++q) {
          const int sb = 32 * is + 16 * s2 + 8 * q + 4 * hh;
          const f32x4 as4 = *(const f32x4*)(acsh + sb), dt4 = *(const f32x4*)(dtlh + sb);
#pragma unroll
          for (int j = 0; j < 4; ++j) {
            const int sr = sb + j;
            float v = sr <= l ? x[8 * s2 + 4 * q + j] * __expf(acl - as4[j]) * dt4[j] : 0.f;
            if (sr == l) v += dskip;
            mv[4 * q + j] = v;
          }
        }
        pw[s2].x = pack_bf16(mv[0], mv[1]); pw[s2].y = pack_bf16(mv[2], mv[3]); pw[s2].z = pack_bf16(mv[4], mv[5]); pw[s2].w = pack_bf16(mv[6], mv[7]);
      }
#pragma unroll
      for (int s2 = 0; s2 < 2; ++s2) {
        const u32x2 va = *(const u32x2*)(xrow + 32 * is + 16 * s2), vc = *(const u32x2*)(xrow + 32 * is + 16 * s2 + 8);
        u32x4 aw; aw.x = va.x; aw.y = va.y; aw.z = vc.x; aw.w = vc.y;
        yacc = __builtin_amdgcn_mfma_f32_32x32x16_bf16(*(bf16x8*)&aw, *(bf16x8*)&pw[s2], yacc, 0, 0, 0);
      }
    }
    bf16_t* yp = ypart + (size_t)(t0 + l) * 1024 + h * 64 + 32 * ip + 4 * hh;
#pragma unroll
    for (int rg = 0; rg < 4; ++rg) { u32x2 w; w.x = pack_bf16(yacc[4 * rg], yacc[4 * rg + 1]); w.y = pack_bf16(yacc[4 * rg + 2], yacc[4 * rg + 3]); *(u32x2*)(yp + 8 * rg) = w; }
  };
  auto states = [&](const int hi) __attribute__((always_inline)) {
    const int h = h0 + 2 * rnd + hi, ip = wid & 1, in = wid >> 1;
    const bf16_t* xTb = xT + (hi & 1) * 64 * SLD;
    const float* wlh = wl + hi * 128;
    f32x16 sacc;
#pragma unroll
    for (int r = 0; r < 16; ++r) sacc[r] = 0.f;
    const bf16_t* ap = xTb + (32 * ip + ql) * SLD + 8 * hh;
    const bf16_t* bp = BcT + (32 * in + ql) * SLD + 8 * hh;
#pragma unroll
    for (int ks = 0; ks < 8; ++ks) {
      const u32x4 xa = *(const u32x4*)(ap + 16 * ks);
      const f32x4 wa = *(const f32x4*)(wlh + 16 * ks + 8 * hh), wb = *(const f32x4*)(wlh + 16 * ks + 8 * hh + 4);
      u32x4 aw;
      aw.x = pack_bf16(bflo(xa.x) * wa[0], bfhi(xa.x) * wa[1]); aw.y = pack_bf16(bflo(xa.y) * wa[2], bfhi(xa.y) * wa[3]);
      aw.z = pack_bf16(bflo(xa.z) * wb[0], bfhi(xa.z) * wb[1]); aw.w = pack_bf16(bflo(xa.w) * wb[2], bfhi(xa.w) * wb[3]);
      sacc = __builtin_amdgcn_mfma_f32_32x32x16_bf16(*(bf16x8*)&aw, *(const bf16x8*)(bp + 16 * ks), sacc, 0, 0, 0);
    }
    float* sp = sg + ((size_t)((b * 16 + c) * 16 + h) * 64 + 32 * ip + 4 * hh) * 128 + 32 * in + ql;
#pragma unroll
    for (int r = 0; r < 16; ++r) sp[((r & 3) + 8 * (r >> 2)) * 128] = sacc[r];
  };
#pragma unroll 1
  for (int rnd_ = 0; rnd_ < 4; ++rnd_) {
    rnd = rnd_;
    float dtv = 0.f, cum = 0.f;
    const int hi2 = (tid >> 7) & 1, ltok = tid & 127;
    if (tid < 256) {
      const int h = h0 + 2 * rnd + hi2;
      const float Ah = -expf(p.a_log[h]);
      dtv = softplus_f(dtraw[(size_t)(t0 + ltok) * 16 + h] + p.dt_bias[h]);
      dtl[tid] = dtv;
      cum = dtv * Ah;
#pragma unroll
      for (int o = 1; o < 64; o <<= 1) { const float nb = __shfl_up(cum, o); if (lane >= o) cum += nb; }
      if (lane == 63) scan[hi2 * 2 + (ltok >> 6)] = cum;
    }
#pragma unroll
    for (int q = 0; q < 4; ++q) {
      const int task = (q & 1) * NTHREADS + tid; const int tg = task >> 6, pch = task & 63, cch = (h0 + 2 * rnd + (q >> 1)) * 64 + pch;
      const float w0 = p.conv_w[cch], w1 = p.conv_w[D_XBC + cch], w2 = p.conv_w[2 * D_XBC + cch], w3 = p.conv_w[3 * D_XBC + cch], cb = p.conv_b[cch];
      float o[8];
#pragma unroll
      for (int i = 0; i < 8; ++i) o[i] = conv_silu(xraw[q], i, w0, w1, w2, w3, cb);
      u32x4 w; w.x = pack_bf16(o[0], o[1]); w.y = pack_bf16(o[2], o[3]); w.z = pack_bf16(o[4], o[5]); w.w = pack_bf16(o[6], o[7]);
      *(u32x4*)(xT + (q >> 1) * 64 * SLD + pch * SLD + tg * 8) = w;
    }
    { SSD_LOAD_X((rnd + 1) & 3) }
    __syncthreads();
    if (tid < 256) {
      const int h = h0 + 2 * rnd + hi2;
      const float s0 = scan[hi2 * 2], s1 = scan[hi2 * 2 + 1];
      if (ltok >= 64) cum += s0;
      acs[tid] = cum;
      acsg[(size_t)(t0 + ltok) * 16 + h] = cum;
      wl[tid] = dtv * __expf(s0 + s1 - cum);
    }
    __syncthreads();
    ydiag(0, wid >> 1);
    ydiag(1, 3 - (wid >> 1));
    states(0);
    states(1);
    __syncthreads();
  }
#undef SSD_LOAD_X
  __syncthreads();
}

__device__ __forceinline__ void meta_state_item(const Params& p, unsigned char* lds, int h) {
  int tid = threadIdx.x; asm volatile("" : "+v"(tid));
  const int g = h >> 3;
  float* xm = (float*)lds;
  float* bm = xm + 16 * 64;
  float* dtm = bm + 16 * 128;
  const float* projm = (const float*)(p.ws + WS_PROJM);
  float* smeta = (float*)(p.ws + WS_SMETA);
  for (int task = tid; task < 16 * 192; task += NTHREADS) {
    const int i = task / 192, ch = task - i * 192;
    const int cch = ch < 64 ? h * 64 + ch : 1024 + g * 128 + (ch - 64);
    float acc = p.conv_b[cch];
#pragma unroll
    for (int j = 0; j < 4; ++j) { const int mi = i - j; if (mi >= 0) acc += p.conv_w[(3 - j) * D_XBC + cch] * projm[(size_t)mi * DPROJ + OFF_XBC + cch]; }
    const float v = silu_f(acc);
    if (ch < 64) xm[i * 64 + ch] = v; else bm[i * 128 + ch - 64] = v;
  }
  if (tid < 16) dtm[tid] = softplus_f(projm[(size_t)tid * DPROJ + OFF_DT + h] + p.dt_bias[h]);
  __syncthreads();
  const float Ah = -expf(p.a_log[h]);
  const int pr = tid >> 3, n0 = (tid & 7) * 16;
  float st[16];
#pragma unroll
  for (int k = 0; k < 16; ++k) st[k] = 0.f;
  for (int i = 0; i < 16; ++i) {
    const float dtv = dtm[i], dA = expf(dtv * Ah), xdt = xm[i * 64 + pr] * dtv;
#pragma unroll
    for (int k = 0; k < 16; ++k) st[k] = fmaf(st[k], dA, xdt * bm[i * 128 + n0 + k]);
  }
#pragma unroll
  for (int k = 0; k < 16; ++k) smeta[(size_t)(h * 64 + pr) * 128 + n0 + k] = st[k];
  __syncthreads();
}

__device__ __forceinline__ void phase2(const Params& p, unsigned char* lds, int bid, int nblk) {
  const bool roles = (nblk == 256);
  const int a = (bid >> 4) * 8 + (bid & 7);
  const bool ssd_role = ((bid >> 3) & 1) == 0;
  const int ab = roles ? (ssd_role ? 0 : 2 * a) : bid, ae = roles ? (ssd_role ? 0 : 2 * a + 2) : 256, as_ = roles ? 1 : nblk;
  const int sb = roles ? (ssd_role ? a : 0) : bid, se = roles ? (ssd_role ? a + 1 : 0) : 128, ss = roles ? 1 : nblk;
  const int mb = roles ? (ssd_role ? a : 16) : bid, ms = roles ? 128 : nblk;
#pragma unroll 1
  for (int it = ab; it < ae; it += as_) attn_item(p, lds, it, !(roles && it != ab));
#pragma unroll 1
  for (int it = sb; it < se; it += ss) ssd_a_item(p, lds, it);
#pragma unroll 1
  for (int it = mb; it < 16; it += ms) meta_state_item(p, lds, it);
}

__device__ __forceinline__ void phase_scan(const Params& p, int bid, int nblk) {
  const float* __restrict__ sg = (const float*)(p.ws + WS_SG);
  const float* __restrict__ smeta = (const float*)(p.ws + WS_SMETA);
  const float* __restrict__ acsg = (const float*)(p.ws + WS_ACSG);
  bf16_t* __restrict__ hprev = (bf16_t*)(p.ws + WS_HPREV);
  for (int task = bid * NTHREADS + threadIdx.x; task < 64 * 2048; task += nblk * NTHREADS) {
    const int bh = task >> 11, e4 = (task & 2047) * 4;
    const int b = bh >> 4, h = bh & 15;
    f32x4 sv[16];
    float dv[16];
#pragma unroll
    for (int c = 0; c < 16; ++c) {
      sv[c] = *(const f32x4*)(sg + (size_t)((b * 16 + c) * 16 + h) * 8192 + e4);
      dv[c] = acsg[(size_t)(b * SEQ + c * 128 + 127) * 16 + h];
    }
    f32x4 H = *(const f32x4*)(smeta + (size_t)h * 8192 + e4);
#pragma unroll
    for (int c = 0; c < 16; ++c) {
      u32x2 w; w.x = pack_bf16(H[0], H[1]); w.y = pack_bf16(H[2], H[3]);
      *(u32x2*)(hprev + (size_t)((b * 16 + c) * 16 + h) * 8192 + e4) = w;
      H = H * __expf(dv[c]) + sv[c];
    }
  }
}

__device__ __forceinline__ void ssd_b_item(const Params& p, unsigned char* lds, int item) {
  int tid = threadIdx.x; asm volatile("" : "+v"(tid));
  const int lane = tid & 63, wid = __builtin_amdgcn_readfirstlane(tid >> 6);
  const int b = item >> 6, c = (item >> 2) & 15, g = (item >> 1) & 1, lh = item & 1, h = g * 8 + wid;
  const int t0 = b * SEQ + c * 128 + lh * 64;
  const int ql = lane & 31, hh = lane >> 5;
  constexpr int YLD = 520;
  bf16_t* yoff = (bf16_t*)lds;
  const bf16_t* __restrict__ proj = (const bf16_t*)(p.ws + WS_PROJ);
  const float* __restrict__ acsg = (const float*)(p.ws + WS_ACSG);
  const bf16_t* __restrict__ ccb = (const bf16_t*)(p.ws + WS_CCB);
  const bf16_t* __restrict__ ypart = (const bf16_t*)(p.ws + WS_YPART);
  const bf16_t* __restrict__ hprev = (const bf16_t*)(p.ws + WS_HPREV);
  bf16_t* __restrict__ mixin = (bf16_t*)(p.ws + WS_HNB);
  {
    const bf16_t* hp = hprev + (size_t)((b * 16 + c) * 16 + h) * 8192 + (size_t)ql * 128 + 8 * hh;
    u32x4 hf0[8], hf1[8];
#pragma unroll
    for (int ks = 0; ks < 8; ++ks) { hf0[ks] = *(const u32x4*)(hp + 16 * ks); hf1[ks] = *(const u32x4*)(hp + 32 * 128 + 16 * ks); }
#pragma unroll
    for (int il = 0; il < 2; ++il) {
      const int lt = 32 * il + ql, t = t0 + lt;
      const bf16_t* cp = ccb + (size_t)t * 256 + g * 128 + 8 * hh;
      u32x4 cf[8];
#pragma unroll
      for (int ks = 0; ks < 8; ++ks) cf[ks] = *(const u32x4*)(cp + 16 * ks);
      const float ea = __expf(acsg[(size_t)t * 16 + h]);
      f32x16 a0, a1;
#pragma unroll
      for (int r = 0; r < 16; ++r) { a0[r] = 0.f; a1[r] = 0.f; }
#pragma unroll
      for (int ks = 0; ks < 8; ++ks) {
        a0 = __builtin_amdgcn_mfma_f32_32x32x16_bf16(*(bf16x8*)&hf0[ks], *(bf16x8*)&cf[ks], a0, 0, 0, 0);
        a1 = __builtin_amdgcn_mfma_f32_32x32x16_bf16(*(bf16x8*)&hf1[ks], *(bf16x8*)&cf[ks], a1, 0, 0, 0);
      }
      bf16_t* yr = yoff + lt * YLD + wid * 64 + 4 * hh;
#pragma unroll
      for (int rg = 0; rg < 4; ++rg) {
        u32x2 w0; w0.x = pack_bf16(ea * a0[4 * rg], ea * a0[4 * rg + 1]); w0.y = pack_bf16(ea * a0[4 * rg + 2], ea * a0[4 * rg + 3]);
        u32x2 w1; w1.x = pack_bf16(ea * a1[4 * rg], ea * a1[4 * rg + 1]); w1.y = pack_bf16(ea * a1[4 * rg + 2], ea * a1[4 * rg + 3]);
        *(u32x2*)(yr + 8 * rg) = w0;
        *(u32x2*)(yr + 32 + 8 * rg) = w1;
      }
    }
  }
  __syncthreads();
#pragma unroll
  for (int bt = 0; bt < 2; ++bt) {
    u32x4 yy[4], zz[4], yo[4];
#pragma unroll
    for (int q = 0; q < 4; ++q) {
      const int lt = wid * 8 + bt * 4 + q, t = t0 + lt;
      yy[q] = __builtin_nontemporal_load((const u32x4*)(ypart + (size_t)t * 1024 + g * 512 + lane * 8));
      zz[q] = __builtin_nontemporal_load((const u32x4*)(proj + (size_t)t * NPROJ + OFF_Z + g * 512 + lane * 8));
      yo[q] = *(const u32x4*)(yoff + lt * YLD + lane * 8);
    }
#pragma unroll
    for (int q = 0; q < 4; ++q) {
      const int t = t0 + wid * 8 + bt * 4 + q;
      float zv[8], ov[8], yv[8], y[8];
      unpack8(zz[q], zv); unpack8(yo[q], ov); unpack8(yy[q], yv);
#pragma unroll
      for (int i = 0; i < 8; ++i) y[i] = (yv[i] + ov[i]) * silu_f(zv[i]);
      float ss = 0.f;
#pragma unroll
      for (int i = 0; i < 8; ++i) ss += y[i] * y[i];
      ss = wave_sum(ss);
      const float rn = rsqrtf(ss * (1.f / 512) + EPS);
      u32x4 w; w.x = pack_bf16(y[0] * rn, y[1] * rn); w.y = pack_bf16(y[2] * rn, y[3] * rn); w.z = pack_bf16(y[4] * rn, y[5] * rn); w.w = pack_bf16(y[6] * rn, y[7] * rn);
      *(u32x4*)(mixin + (size_t)t * DM + 1024 + g * 512 + lane * 8) = w;
    }
  }
  __syncthreads();
}
__device__ __forceinline__ void phase3(const Params& p, unsigned char* lds, int bid, int nblk) {
  for (int it = bid; it < 256; it += nblk) ssd_b_item(p, lds, (nblk == 256) ? ((it & 7) * 32 + (it >> 3)) : it);
}

constexpr int LDS_BYTES = 144 * 1024;

typedef const Params __attribute__((address_space(4))) * KArgPtr;
__device__ __forceinline__ Params load_params(KArgPtr k) {
  Params q;
#if defined(__HIP_DEVICE_COMPILE__)
  __builtin_memcpy(&q, k, sizeof(Params));
#endif
  return q;
}
#define PARAMS_PTR(pp) KArgPtr pp##_k = (KArgPtr)__builtin_amdgcn_kernarg_segment_ptr(); asm volatile("" : "+s"(pp##_k)); const Params pp##_v = load_params(pp##_k); const Params* pp = &pp##_v
__global__ __launch_bounds__(512, 2) void k_mega(Params p_unused) {
  extern __shared__ __attribute__((aligned(16))) unsigned char shm[];
  const int bid = blockIdx.x, nblk = gridDim.x;
  volatile LAS unsigned* xst = (volatile LAS unsigned*)(LAS unsigned char*)(shm + LDS_BYTES - 16);
  if (threadIdx.x == 0) { xst[0] = 0u; xst[1] = 0u; }
  __syncthreads();
  XcdBarrier xb;
  { PARAMS_PTR(pp); xb = xcd_barrier_post((unsigned*)(pp->ws + WS_CTL), xst); }
#ifndef REP_PHASE
#define REP_PHASE -1
#endif
#define NREP(k) ((REP_PHASE == (k)) ? 2 : 1)
#ifndef REP_ALL
#define REP_ALL 1
#endif
#pragma unroll 1
  for (int pass = 0; pass < REP_ALL; ++pass) {
  if (pass) xcd_barrier(xb);
#pragma unroll 1
  for (int rep = 0; rep < NREP(0); ++rep) { { PARAMS_PTR(pp); phase0(*pp, (float*)shm, bid, nblk); } if (rep + 1 < NREP(0)) xcd_barrier(xb); }
  xcd_barrier(xb);
#pragma unroll 1
  for (int rep = 0; rep < NREP(1); ++rep) { { PARAMS_PTR(pp); phase1(*pp, shm, bid, nblk); } xcd_barrier(xb); }
#pragma unroll 1
  for (int rep = 0; rep < NREP(2); ++rep) { { PARAMS_PTR(pp); phase2(*pp, shm, bid, nblk); } xcd_barrier(xb); }
#pragma unroll 1
  for (int rep = 0; rep < NREP(7); ++rep) { { PARAMS_PTR(pp); phase_scan(*pp, bid, nblk); } xcd_barrier(xb); }
#pragma unroll 1
  for (int rep = 0; rep < NREP(3); ++rep) { { PARAMS_PTR(pp); phase3(*pp, shm, bid, nblk); } xcd_barrier(xb); }
#pragma unroll 1
  for (int rep = 0; rep < NREP(4); ++rep) { { PARAMS_PTR(pp); phase4(*pp, shm, bid, nblk); } xcd_barrier(xb); }
#pragma unroll 1
  for (int rep = 0; rep < NREP(5); ++rep) { { PARAMS_PTR(pp); phase5(*pp, shm, bid, nblk); } xcd_barrier(xb); }
#pragma unroll 1
  for (int rep = 0; rep < NREP(6); ++rep) { { PARAMS_PTR(pp); phase6(*pp, shm, bid, nblk); } if (rep + 1 < NREP(6)) xcd_barrier(xb); }
  }
}

}

extern "C" void kernel_launch(void* const* d_in, const int* in_sizes, int n_in, void* d_out, int out_size, void* d_ws,
                              size_t ws_size, hipStream_t stream) {
  Params p{};
  p.x = (const float*)d_in[0]; p.meta = (const float*)d_in[1]; p.rel_bias = (const float*)d_in[2];
  p.ln_mix = (const float*)d_in[3]; p.w_in = (const float*)d_in[4]; p.sinks = (const float*)d_in[5];
  p.conv_w = (const float*)d_in[6]; p.conv_b = (const float*)d_in[7]; p.dt_bias = (const float*)d_in[8];
  p.a_log = (const float*)d_in[9]; p.d_skip = (const float*)d_in[10]; p.attn_norm_w = (const float*)d_in[11];
  p.ssm_norm_w = (const float*)d_in[12]; p.w_out = (const float*)d_in[13]; p.ln_ffn = (const float*)d_in[14];
  p.wq = (const float*)d_in[15]; p.keys = (const float*)d_in[16]; p.U = (const float*)d_in[17];
  p.V = (const float*)d_in[18]; p.ln_final = (const float*)d_in[19];
  p.out = (float*)d_out;
  p.ws = (unsigned char*)d_ws;

  static int grid_blocks = 0;
  if (!grid_blocks) {
    int dev = 0, cus = 0, per_cu = 0;
    (void)hipGetDevice(&dev);
    (void)hipDeviceGetAttribute(&cus, hipDeviceAttributeMultiprocessorCount, dev);
    (void)hipFuncSetAttribute((const void*)k_mega, hipFuncAttributeMaxDynamicSharedMemorySize, LDS_BYTES);
    (void)hipOccupancyMaxActiveBlocksPerMultiprocessor(&per_cu, (const void*)k_mega, NTHREADS, LDS_BYTES);
    if (per_cu > 1) per_cu = 1;
    grid_blocks = cus * per_cu;
    if (grid_blocks != 256) fprintf(stderr, "kernel_launch: expected a 256-workgroup resident grid, got %d (cus %d, per_cu %d)\n", grid_blocks, cus, per_cu);
  }
  (void)hipMemsetAsync(p.ws + WS_CTL, 0, XCD_BAR_WORDS * 4, stream);
  void* args[] = {&p};
  hipError_t e = hipLaunchCooperativeKernel((const void*)k_mega, dim3(grid_blocks), dim3(NTHREADS), args, LDS_BYTES, stream);
  if (e != hipSuccess) fprintf(stderr, "cooperative launch failed: %s (grid %d)\n", hipGetErrorString(e), grid_blocks);
}
```

```cpp
#include <hip/hip_runtime.h>
#include <math.h>
#include <stdio.h>
#include <stdint.h>

#ifndef REP_SUB
#define REP_SUB -1
#endif
namespace {
constexpr int BATCH = 4, SEQ = 2048, DM = 2048, NMETA = 16;
constexpr int T = BATCH * SEQ;
constexpr int TA = T + NMETA;
constexpr int DPROJ = 4112;
constexpr int NPROJ = 4096;
constexpr int OFF_Q = 0, OFF_K = 1024, OFF_V = 1280, OFF_Z = 1536, OFF_XBC = 2560, OFF_DT = 4096;
constexpr int D_XBC = 1536;
constexpr int NEXP = 16384;
constexpr int ROW4 = 1024;
constexpr int ROW6 = 1536;
constexpr float EPS = 1e-6f;
constexpr int NTHREADS = 512;

typedef unsigned short bf16_t;
typedef short bf16x8 __attribute__((ext_vector_type(8)));
typedef float f32x4 __attribute__((ext_vector_type(4)));
typedef float f32x2 __attribute__((ext_vector_type(2)));
typedef unsigned u32x4 __attribute__((ext_vector_type(4)));
typedef unsigned u32x2 __attribute__((ext_vector_type(2)));
typedef __bf16 bf16v2 __attribute__((ext_vector_type(2)));
typedef float f32x16v __attribute__((ext_vector_type(16)));
typedef float f32x32v __attribute__((ext_vector_type(32)));
typedef unsigned u32x6 __attribute__((ext_vector_type(6)));
#define LAS __attribute__((address_space(3)))

__device__ __forceinline__ unsigned pack_bf16(float lo, float hi) {
  f32x2 v = {lo, hi};
  bf16v2 b = __builtin_convertvector(v, bf16v2);
  return *(unsigned*)&b;
}
__device__ __forceinline__ bf16_t f2bf(float f) { return (bf16_t)(pack_bf16(f, 0.f) & 0xffffu); }
__device__ __forceinline__ float bf2f(bf16_t b) { return __uint_as_float(((unsigned)b) << 16); }
__device__ __forceinline__ float bflo(unsigned u) { return __uint_as_float(u << 16); }
__device__ __forceinline__ float bfhi(unsigned u) { return __uint_as_float(u & 0xffff0000u); }

__constant__ unsigned char kBucket[128] = {
    0, 1, 2, 3, 4, 5, 6, 7, 8, 9, 10, 11, 12, 13, 14, 15, 16, 16, 16, 17, 17, 18, 18, 18, 19, 19, 19, 20, 20, 20, 20, 21,
    21, 21, 21, 22, 22, 22, 22, 22, 23, 23, 23, 23, 23, 23, 24, 24, 24, 24, 24, 24, 25, 25, 25, 25, 25, 25, 25, 26, 26, 26, 26, 26,
    26, 26, 26, 27, 27, 27, 27, 27, 27, 27, 27, 27, 27, 28, 28, 28, 28, 28, 28, 28, 28, 28, 28, 29, 29, 29, 29, 29, 29, 29, 29, 29,
    29, 29, 29, 30, 30, 30, 30, 30, 30, 30, 30, 30, 30, 30, 30, 30, 30, 31, 31, 31, 31, 31, 31, 31, 31, 31, 31, 31, 31, 31, 31, 31};

__constant__ unsigned char kCandI[64] = {0, 0, 0, 0, 0, 0, 0, 0, 0, 0, 0, 0, 0, 0, 0, 0, 1, 1, 1, 1, 1, 1, 1, 1, 2, 2, 2, 2, 2, 3, 3, 3, 3, 4, 4, 4, 5, 5, 6, 6, 7, 7, 8, 9, 10, 11, 12, 13, 14, 15, 15, 15, 15, 15, 15, 15, 15, 15, 15, 15, 15, 15, 15, 15};
__constant__ unsigned char kCandJ[64] = {0, 1, 2, 3, 4, 5, 6, 7, 8, 9, 10, 11, 12, 13, 14, 15, 0, 1, 2, 3, 4, 5, 6, 7, 0, 1, 2, 3, 4, 0, 1, 2, 3, 0, 1, 2, 0, 1, 0, 1, 0, 1, 0, 0, 0, 0, 0, 0, 0, 0, 15, 15, 15, 15, 15, 15, 15, 15, 15, 15, 15, 15, 15, 15};

__device__ __forceinline__ float wave_sum(float v) {
  for (int o = 32; o > 0; o >>= 1) v += __shfl_xor(v, o);
  return v;
}
__device__ __forceinline__ float wave_max(float v) {
  for (int o = 32; o > 0; o >>= 1) v = fmaxf(v, __shfl_xor(v, o));
  return v;
}
__device__ __forceinline__ float silu_f(float x) { return x / (1.f + expf(-x)); }
__device__ __forceinline__ float softplus_f(float x) { return fmaxf(x, 0.f) + log1pf(expf(-fabsf(x))); }

constexpr size_t al256(size_t x) { return (x + 255) & ~(size_t)255; }
constexpr size_t WS_CTL = 0;
constexpr size_t WS_WINT = 65536;
constexpr size_t WS_WDTT = WS_WINT + (size_t)NPROJ * DM * 2;
constexpr size_t WS_WOUTT = WS_WDTT + (size_t)16 * DM * 2;
constexpr size_t WS_WQT = WS_WOUTT + (size_t)DM * DM * 2;
constexpr size_t WS_KEYS = WS_WQT + (size_t)DM * DM * 2;
constexpr size_t WS_UB = WS_KEYS + (size_t)16 * 128 * 128 * 2;
constexpr size_t WS_VB = WS_UB + (size_t)NEXP * DM * 2;
constexpr size_t WS_HNB = WS_VB + (size_t)NEXP * DM * 2;
constexpr size_t WS_PROJ = WS_HNB + (size_t)(T + 16) * DM * 2;
constexpr size_t WS_DTRAW = WS_PROJ + (size_t)T * NPROJ * 2;
constexpr size_t WS_PROJM = WS_DTRAW + (size_t)T * 16 * 4;
constexpr size_t WS_PROJMB = al256(WS_PROJM + (size_t)16 * DPROJ * 4);
constexpr size_t WS_H1B = al256(WS_PROJMB + (size_t)16 * DPROJ * 2);
constexpr size_t WS_SSQH1 = WS_H1B + (size_t)T * DM * 2;
constexpr size_t WS_STOP = al256(WS_SSQH1 + (size_t)T * 32 * 4);
constexpr size_t WS_ITOP = WS_STOP + (size_t)T * 256 * 4;
constexpr size_t WS_ACSG = al256(WS_ITOP + (size_t)T * 256 * 4);
constexpr size_t WS_CCB = WS_ACSG + (size_t)T * 16 * 4;
constexpr size_t WS_YPART = WS_CCB + (size_t)T * 256 * 2;
constexpr size_t WS_SG = WS_YPART + (size_t)T * 1024 * 4;
constexpr size_t WS_SMETA = WS_SG + (size_t)1024 * 8192 * 4;
constexpr size_t WS_HPREV = al256(WS_SMETA + (size_t)16 * 8192 * 4);
constexpr size_t WS_USC = al256(WS_HPREV + (size_t)1024 * 8192 * 2);
constexpr size_t WS_VSC = WS_USC + (size_t)NEXP * 4;
constexpr size_t WS_SCR = al256(WS_VSC + (size_t)NEXP * 4);
}

namespace pg8 {
#define PG8_LAS __attribute__((address_space(3)))
constexpr int BM = 256, BK = 64, HALF = 128, HTB = HALF * BK * 2, STAGE_BYTES = 8 * HTB, NXCD = 8, WGM = 8;
__host__ __device__ __forceinline__ int lds_byte(int r, int c) { const int st = (r >> 4) * 2 + (c >> 5), rr = r & 15, cc = c & 31, ob = rr * 64 + cc * 2; return st * 1024 + (ob ^ (((ob >> 9) & 1) << 5)); }
__host__ __device__ __forceinline__ void stage_rc(int b, int& R, int& C) { const int st = b / 1024, sb = b % 1024, swz = sb ^ (((sb >> 9) & 1) << 5); R = (st >> 1) * 16 + swz / 64; C = (st & 1) * 32 + (swz % 64) / 2; }
__host__ __device__ __forceinline__ int perm32(int rho) { const int n = rho >> 4, i = rho & 15; return 8 * (i >> 2) + 4 * n + (i & 3); }
struct Unit { int pm, pn; };
struct Gemm { const bf16_t* A; const bf16_t* Bt; int M, N, K; };
struct StaticOrder {
    int nM, nN, nwg, G, c;
    __host__ __device__ void init(int M, int N, int G_, int c_) { nM = M / BM; nN = N / BM; nwg = nM * nN; G = G_; c = c_; }
    __host__ __device__ bool next(int i, Unit& u) const {
        const long L = (long)i * G + c; if (L >= nwg) return false;
        int wgid = (int)L; { const int q = nwg / NXCD, r = nwg % NXCD, xcd = wgid % NXCD, off = wgid / NXCD; wgid = (xcd < r ? xcd * (q + 1) : r * (q + 1) + (xcd - r) * q) + off; }
        const int nig = WGM * nN, gid = wgid / nig, fm = gid * WGM, gsz = (nM - fm) < WGM ? (nM - fm) : WGM;
        u.pm = fm + ((wgid % nig) % gsz); u.pn = (wgid % nig) / gsz; return true;
    }
    __device__ __forceinline__ void a_ready(const Unit&) const {}
    __device__ __forceinline__ void done(const Unit&) const {}
};
struct EpiBf16 {
    static constexpr bool PERM = true, AFTER_DRAIN = false;
    bf16_t* O; int ldc;
    __device__ __forceinline__ void operator()(const f32x4 (&acc)[2][2][4][2], const Unit& u, int wr, int wc, int fr, int fq) const {
        const int row0 = u.pm * BM + wr * 64 + fr; const int col0 = u.pn * BM + wc * 32 + 8 * fq;
        const __amdgpu_buffer_rsrc_t rsrc = __builtin_amdgcn_make_buffer_rsrc(O, 0, 0x7fffffff, 0x00020000);
#pragma unroll
        for (int ai = 0; ai < 2; ++ai)
#pragma unroll
            for (int m = 0; m < 4; ++m) { const unsigned boff = (unsigned)(((size_t)(row0 + ai * HALF + m * 16) * ldc + col0) * 2);
#pragma unroll
                for (int bj = 0; bj < 2; ++bj) { const f32x4 v0 = acc[ai][bj][m][0], v1 = acc[ai][bj][m][1];
                    u32x4 w; w.x = pack_bf16(v0[0], v0[1]); w.y = pack_bf16(v0[2], v0[3]); w.z = pack_bf16(v1[0], v1[1]); w.w = pack_bf16(v1[2], v1[3]);
                    __builtin_amdgcn_raw_buffer_store_b128(w, rsrc, boff + bj * HALF * 2, 0, 16); } }
    }
};

struct EpiRes {
    static constexpr bool PERM = true, AFTER_DRAIN = false;
    const float* X; bf16_t* HB; float* SSQ;
    __device__ __forceinline__ void operator()(const f32x4 (&acc)[2][2][4][2], const Unit& u, int wr, int wc, int fr, int fq) const {
        const int row0 = u.pm * BM + wr * 64 + fr; const int col0 = u.pn * BM + wc * 32 + 8 * fq;
#pragma unroll
        for (int ai = 0; ai < 2; ++ai) {
            f32x4 xr[4][2][2];
#pragma unroll
            for (int m = 0; m < 4; ++m) { const size_t off = (size_t)(row0 + ai * HALF + m * 16) * DM + col0;
#pragma unroll
                for (int bj = 0; bj < 2; ++bj) { xr[m][bj][0] = __builtin_nontemporal_load((const f32x4*)(X + off + bj * HALF)); xr[m][bj][1] = __builtin_nontemporal_load((const f32x4*)(X + off + bj * HALF + 4)); } }
#pragma unroll
            for (int m = 0; m < 4; ++m) { const int row = row0 + ai * HALF + m * 16; const size_t off = (size_t)row * DM + col0; float ss = 0.f;
#pragma unroll
                for (int bj = 0; bj < 2; ++bj) {
                    const f32x4 v0 = acc[ai][bj][m][0] + xr[m][bj][0], v1 = acc[ai][bj][m][1] + xr[m][bj][1];
                    u32x4 w; w.x = pack_bf16(v0[0], v0[1]); w.y = pack_bf16(v0[2], v0[3]); w.z = pack_bf16(v1[0], v1[1]); w.w = pack_bf16(v1[2], v1[3]);
                    *(u32x4*)(HB + off + bj * HALF) = w;
                    ss += v0[0] * v0[0] + v0[1] * v0[1] + v0[2] * v0[2] + v0[3] * v0[3] + v1[0] * v1[0] + v1[1] * v1[1] + v1[2] * v1[2] + v1[3] * v1[3]; }
                ss += __shfl_xor(ss, 16); ss += __shfl_xor(ss, 32);
                if (fq == 0) SSQ[(size_t)row * 32 + u.pn * 4 + wc] = ss; }
        }
    }
};
struct EpiF32 {
    static constexpr bool PERM = true, AFTER_DRAIN = false;
    float* C; int ldc;
    __device__ __forceinline__ void operator()(const f32x4 (&acc)[2][2][4][2], const Unit& u, int wr, int wc, int fr, int fq) const {
        const int row0 = u.pm * BM + wr * 64 + fr; const int col0 = u.pn * BM + wc * 32 + 8 * fq;
#pragma unroll
        for (int ai = 0; ai < 2; ++ai)
#pragma unroll
            for (int m = 0; m < 4; ++m) { float* rowp = C + (size_t)(row0 + ai * HALF + m * 16) * ldc + col0;
#pragma unroll
                for (int bj = 0; bj < 2; ++bj) { *(f32x4*)(rowp + bj * HALF) = acc[ai][bj][m][0]; *(f32x4*)(rowp + bj * HALF + 4) = acc[ai][bj][m][1]; } }
    }
};

struct EpiScores {
    static constexpr bool PERM = true, AFTER_DRAIN = true;
    const bf16_t* KEYS;
    float* STOP; int* ITOP;
    static constexpr int QLD = 264;
    __device__ __forceinline__ void fused(f32x4 (&acc)[2][2][4][2], const Unit& u, int wr, int wc, int fr, int fq, PG8_LAS unsigned char* lds, int wid, int lane) const {
        PG8_LAS bf16_t* Q = (PG8_LAS bf16_t*)lds;
#pragma unroll
        for (int ai = 0; ai < 2; ++ai)
#pragma unroll
            for (int m = 0; m < 4; ++m) { const int row = ai * HALF + wr * 64 + m * 16 + fr;
#pragma unroll
                for (int bj = 0; bj < 2; ++bj) { const f32x4 v0 = acc[ai][bj][m][0], v1 = acc[ai][bj][m][1];
                    u32x4 w; w.x = pack_bf16(v0[0], v0[1]); w.y = pack_bf16(v0[2], v0[3]); w.z = pack_bf16(v1[0], v1[1]); w.w = pack_bf16(v1[2], v1[3]);
                    *(PG8_LAS u32x4*)(Q + row * QLD + bj * HALF + wc * 32 + 8 * fq) = w; } }
        __syncthreads();
        const int h = u.pn;
#pragma unroll 1
        for (int c = 0; c < 2; ++c) {
            f32x4 sc[8][2];
#pragma unroll
            for (int kf = 0; kf < 8; ++kf) { sc[kf][0] = (f32x4){0.f, 0.f, 0.f, 0.f}; sc[kf][1] = (f32x4){0.f, 0.f, 0.f, 0.f}; }
            const bf16_t* kb = KEYS + (size_t)((h * 2 + c) * 128 + fr) * 128 + 8 * fq;
            const PG8_LAS bf16_t* qb = Q + (wid * 32 + fr) * QLD + c * 128 + 8 * fq;
#pragma unroll
            for (int ks = 0; ks < 4; ++ks) {
                const bf16x8 q0 = *(const PG8_LAS bf16x8*)(qb + 32 * ks), q1 = *(const PG8_LAS bf16x8*)(qb + 16 * QLD + 32 * ks);
#pragma unroll
                for (int kf = 0; kf < 8; ++kf) { const bf16x8 kv = *(const bf16x8*)(kb + (size_t)kf * 16 * 128 + 32 * ks);
                    sc[kf][0] = __builtin_amdgcn_mfma_f32_16x16x32_bf16(kv, q0, sc[kf][0], 0, 0, 0);
                    sc[kf][1] = __builtin_amdgcn_mfma_f32_16x16x32_bf16(kv, q1, sc[kf][1], 0, 0, 0); }
            }
#pragma unroll
            for (int tf = 0; tf < 2; ++tf) {
                int v[32];
#pragma unroll
                for (int kf = 0; kf < 8; ++kf)
#pragma unroll
                    for (int r = 0; r < 4; ++r) {
                        const int bts = (int)__float_as_uint(sc[kf][tf][r]);
                        const int srt = bts ^ ((bts >> 31) & 0x7fffffff);
                        v[kf * 4 + r] = (srt & ~127) | (16 * kf + 4 * fq + r);
                    }
#pragma unroll
                for (int k = 2; k <= 32; k <<= 1)
#pragma unroll
                    for (int j = k >> 1; j > 0; j >>= 1)
#pragma unroll
                        for (int i = 0; i < 32; ++i) {
                            const int l = i ^ j;
                            if (l > i) {
                                const int x = v[i], y = v[l];
                                const int hi_ = x > y ? x : y, lo_ = x > y ? y : x;
                                if ((i & k) == 0) { v[i] = hi_; v[l] = lo_; } else { v[i] = lo_; v[l] = hi_; }
                            }
                        }
#pragma unroll
                for (int step = 0; step < 2; ++step) {
                    const int xm = step == 0 ? 16 : 32;
                    int m[16];
#pragma unroll
                    for (int i = 0; i < 16; ++i) { const int o = __shfl_xor(v[15 - i], xm); m[i] = v[i] > o ? v[i] : o; }
#pragma unroll
                    for (int j = 8; j > 0; j >>= 1)
#pragma unroll
                        for (int i = 0; i < 16; ++i) {
                            const int l = i ^ j;
                            if (l > i) { const int x = m[i], y = m[l]; m[i] = x > y ? x : y; m[l] = x > y ? y : x; }
                        }
#pragma unroll
                    for (int i = 0; i < 16; ++i) v[i] = m[i];
                }
                if (fq == 0) {
                    const size_t obase = ((size_t)(u.pm * BM + wid * 32 + tf * 16 + fr) * 16 + h * 2 + c) * 16;
#pragma unroll
                    for (int q4 = 0; q4 < 4; ++q4) {
                        f32x4 sv; u32x4 iv;
#pragma unroll
                        for (int i = 0; i < 4; ++i) {
                            const int key = v[4 * q4 + i], srt = key & ~127;
                            sv[i] = __uint_as_float((unsigned)(srt ^ ((srt >> 31) & 0x7fffffff)));
                            iv[i] = (unsigned)(key & 127);
                        }
                        *(f32x4*)(STOP + obase + 4 * q4) = sv;
                        *(u32x4*)(ITOP + obase + 4 * q4) = iv;
                    }
                }
            }
        }
    }
};

template <class Epi, class Sched>
__device__ __forceinline__ void gemm_phase(PG8_LAS unsigned char* lds, const Gemm g, const Sched& S, const Epi& E) {
    int tid_ = threadIdx.x; asm volatile("" : "+v"(tid_));
    const int tid = tid_, wid = __builtin_amdgcn_readfirstlane(tid >> 6), lane = tid & 63, wr = wid >> 2, wc = wid & 3, fr = lane & 15, fq = lane >> 4;
    const int K = g.K, nt = K / BK;
    unsigned voffA[2], voffB[2];
#pragma unroll
    for (int i = 0; i < 2; ++i) { int R, C; stage_rc(tid * 16 + i * 8192, R, C); const int Rb = Epi::PERM ? ((R & ~31) + perm32(R & 31)) : R;
        voffA[i] = (unsigned)(R * K + C) * 2u; voffB[i] = (unsigned)(Rb * K + C) * 2u; }
    const size_t kstep = (size_t)(BK * 2);
    const size_t hstep = (size_t)HALF * K * 2;
    const size_t tstep = 2 * hstep;
    const unsigned ldsw = (unsigned)wid * 1024u;
    const int aoff = lds_byte(wr * 64 + fr, fq * 8), boff = lds_byte(wc * 32 + fr, fq * 8);
#define PG8_SA(b, h) (((b) * 2 + (h)) * HTB)
#define PG8_SB(b, h) ((4 + (b) * 2 + (h)) * HTB)
#define PG8_STAGE(bufoff, gbase, voff) do { _Pragma("unroll") for (int _i = 0; _i < 2; ++_i) \
        __builtin_amdgcn_global_load_lds((const unsigned*)((const char*)(gbase) + (voff)[_i]), (PG8_LAS unsigned*)(lds + (bufoff) + ldsw + _i * 8192), 16, 0, 0); } while (0)
#define PG8_LDA(dst, b, h) do { _Pragma("unroll") for (int m = 0; m < 4; ++m) _Pragma("unroll") for (int k = 0; k < 2; ++k) dst[m][k] = *(const PG8_LAS bf16x8*)(lds + PG8_SA(b, h) + aoff + m * 2048 + k * 1024); } while (0)
#define PG8_LDB(dst, b, h) do { _Pragma("unroll") for (int n = 0; n < 2; ++n) _Pragma("unroll") for (int k = 0; k < 2; ++k) dst[n][k] = *(const PG8_LAS bf16x8*)(lds + PG8_SB(b, h) + boff + n * 2048 + k * 1024); } while (0)
#define PG8_MMA(ai, bj, At, Bt) do { __builtin_amdgcn_s_setprio(1); _Pragma("unroll") for (int m = 0; m < 4; ++m) _Pragma("unroll") for (int n = 0; n < 2; ++n) _Pragma("unroll") for (int k = 0; k < 2; ++k) \
        acc[ai][bj][m][n] = __builtin_amdgcn_mfma_f32_16x16x32_bf16(Bt[n][k], At[m][k], acc[ai][bj][m][n], 0, 0, 0); __builtin_amdgcn_s_setprio(0); } while (0)
#define PG8_WAIT_V(n) asm volatile("s_waitcnt vmcnt(" #n ")" ::: "memory")
#define PG8_WAIT_L(n) asm volatile("s_waitcnt lgkmcnt(" #n ")" ::: "memory")
#define PG8_BAR __builtin_amdgcn_s_barrier()
#define PG8_SCHED __builtin_amdgcn_sched_barrier(0)
    Unit cur, nxt; int ui = 0;
    if (!S.next(0, cur)) return;
    f32x4 acc[2][2][4][2];
#pragma unroll
    for (int a = 0; a < 2; ++a)
#pragma unroll
        for (int b = 0; b < 2; ++b)
#pragma unroll
            for (int m = 0; m < 4; ++m)
#pragma unroll
                for (int n = 0; n < 2; ++n) acc[a][b][m][n] = (f32x4){0.f, 0.f, 0.f, 0.f};
    bf16x8 At[4][2], B0[2][2], B1[2][2];
    const char* cA = (const char*)g.A + (size_t)cur.pm * tstep; const char* cB = (const char*)g.Bt + (size_t)cur.pn * tstep;
    S.a_ready(cur);
    PG8_STAGE(PG8_SB(0, 0), cB, voffB); PG8_STAGE(PG8_SA(0, 0), cA, voffA); PG8_STAGE(PG8_SB(0, 1), cB + hstep, voffB); PG8_STAGE(PG8_SA(0, 1), cA + hstep, voffA);
    if (wr == 1) PG8_BAR;
    PG8_WAIT_V(4); PG8_BAR;
    PG8_STAGE(PG8_SB(1, 0), cB + kstep, voffB); PG8_STAGE(PG8_SA(1, 0), cA + kstep, voffA); PG8_STAGE(PG8_SB(1, 1), cB + hstep + kstep, voffB);
    PG8_WAIT_V(6); PG8_BAR;
    for (;;) {
        const bool has_next = S.next(ui + 1, nxt);
        const char* nA = has_next ? (const char*)g.A + (size_t)nxt.pm * tstep : cA; const char* nB = has_next ? (const char*)g.Bt + (size_t)nxt.pn * tstep : cB;
        for (int t = 0; t < nt; t += 2) {
            const bool last = (t == nt - 2);
            const char* a1 = cA + (size_t)(t + 1) * kstep;
            const char* a2 = last ? nA : cA + (size_t)(t + 2) * kstep; const char* b2 = last ? nB : cB + (size_t)(t + 2) * kstep;
            const char* a3 = a2 + kstep; const char* b3 = b2 + kstep;
            if (last && has_next) S.a_ready(nxt);
            PG8_LDB(B0, 0, 0); PG8_SCHED; PG8_LDA(At, 0, 0); PG8_STAGE(PG8_SA(1, 1), a1 + hstep, voffA);
            PG8_WAIT_L(8); PG8_BAR; PG8_WAIT_L(0); PG8_MMA(0, 0, At, B0); PG8_BAR; PG8_SCHED;
            PG8_LDB(B1, 0, 1); PG8_STAGE(PG8_SB(0, 0), b2, voffB);
            PG8_BAR; PG8_WAIT_L(0); PG8_MMA(0, 1, At, B1); PG8_BAR;
            PG8_LDA(At, 0, 1); PG8_STAGE(PG8_SA(0, 0), a2, voffA);
            PG8_BAR; PG8_WAIT_L(0); PG8_MMA(1, 0, At, B0); PG8_BAR; PG8_SCHED;
            PG8_STAGE(PG8_SB(0, 1), b2 + hstep, voffB);
            PG8_WAIT_V(6); PG8_BAR; PG8_MMA(1, 1, At, B1); PG8_BAR;
            PG8_LDB(B0, 1, 0); PG8_SCHED; PG8_LDA(At, 1, 0); PG8_STAGE(PG8_SA(0, 1), a2 + hstep, voffA);
            PG8_WAIT_L(8); PG8_BAR; PG8_WAIT_L(0); PG8_MMA(0, 0, At, B0); PG8_BAR; PG8_SCHED;
            PG8_LDB(B1, 1, 1); PG8_STAGE(PG8_SB(1, 0), b3, voffB);
            PG8_BAR; PG8_WAIT_L(0); PG8_MMA(0, 1, At, B1); PG8_BAR;
            PG8_LDA(At, 1, 1); PG8_STAGE(PG8_SA(1, 0), a3, voffA);
            PG8_BAR; PG8_WAIT_L(0); PG8_MMA(1, 0, At, B0); PG8_BAR; PG8_SCHED;
            PG8_STAGE(PG8_SB(1, 1), b3 + hstep, voffB);
            PG8_WAIT_V(6); PG8_BAR; PG8_MMA(1, 1, At, B1); PG8_BAR;
        }
        if constexpr (!Epi::AFTER_DRAIN) { E(acc, cur, wr, wc, fr, fq); S.done(cur); }
        if (!has_next) break;
#pragma unroll
        for (int a = 0; a < 2; ++a)
#pragma unroll
            for (int b = 0; b < 2; ++b)
#pragma unroll
                for (int m = 0; m < 4; ++m)
#pragma unroll
                    for (int n = 0; n < 2; ++n) acc[a][b][m][n] = (f32x4){0.f, 0.f, 0.f, 0.f};
        cur = nxt; cA = nA; cB = nB; ++ui;
    }
    PG8_WAIT_V(0);
    if (wr == 0) PG8_BAR;
    PG8_BAR;
    if constexpr (Epi::AFTER_DRAIN) { E.fused(acc, cur, wr, wc, fr, fq, lds, wid, lane); S.done(cur); }
#undef PG8_SA
#undef PG8_SB
#undef PG8_STAGE
#undef PG8_LDA
#undef PG8_LDB
#undef PG8_MMA
#undef PG8_WAIT_V
#undef PG8_WAIT_L
#undef PG8_BAR
#undef PG8_SCHED
}
}

#define XB_TMO      128
#define XB_XCNT(j)  (256  + 64 * (j))
#define XB_XSUB(j)  (1280 + 64 * (j))
#define XB_XGEN(j)  (2304 + 64 * (j))
#define XB_TOP      3328
#define XB_TOPGEN   3392
#define XCD_BAR_WORDS 3456
#define XB_SPIN_CAP (1u << 22)
__device__ __forceinline__ unsigned xb_ld(unsigned* p)              { return __hip_atomic_load(p, __ATOMIC_RELAXED, __HIP_MEMORY_SCOPE_AGENT); }
__device__ __forceinline__ unsigned xb_add(unsigned* p, unsigned v) { return __hip_atomic_fetch_add(p, v, __ATOMIC_RELAXED, __HIP_MEMORY_SCOPE_AGENT); }
__device__ __forceinline__ unsigned xb_xcc_id() { return (unsigned)__builtin_amdgcn_s_getreg((3 << 11) | 20) & 0xFu; }
#define XB_SPIN(cond, bar) do { unsigned _sp = 0; while (cond) { __builtin_amdgcn_s_sleep(1); \
    if ((++_sp & 255u) == 0u) { if (xb_ld(&(bar)[XB_TMO])) break; if (_sp > XB_SPIN_CAP) { atomicAdd(&(bar)[XB_TMO], 1u); break; } } } } while (0)
struct XcdBarrier { unsigned* bar; unsigned x; volatile LAS unsigned* st; };
__device__ __forceinline__ XcdBarrier xcd_barrier_post(unsigned* bar, volatile LAS unsigned* st) {
    XcdBarrier b; b.bar = bar; b.x = xb_xcc_id(); b.st = st;
    if (threadIdx.x == 0) (void)xb_add(&bar[XB_XCNT(b.x)], 1u);
    return b;
}
__device__ __forceinline__ void xcd_barrier_complete(unsigned* bar, unsigned x, unsigned& nloc, unsigned& nx) {
    const unsigned G = gridDim.x * gridDim.y * gridDim.z;
    unsigned sum, cnt, mine, sp = 0u;
    for (;;) {
        sum = 0u; cnt = 0u; mine = 0u;
#pragma unroll
        for (unsigned j = 0; j < 16; ++j) { const unsigned c = xb_ld(&bar[XB_XCNT(j)]); sum += c; cnt += (c > 0u) ? 1u : 0u; mine = (j == x) ? c : mine; }
        if (sum == G) break;
        __builtin_amdgcn_s_sleep(1);
        if ((++sp & 255u) == 0u) { if (xb_ld(&bar[XB_TMO])) break; if (sp > XB_SPIN_CAP) { atomicAdd(&bar[XB_TMO], 1u); break; } }
    }
    nloc = mine > 0u ? mine : 1u; nx = cnt > 0u ? cnt : 1u;
}
__device__ __forceinline__ void xcd_barrier(const XcdBarrier& b) {
    asm volatile("s_waitcnt vmcnt(0)" ::: "memory");
    __syncthreads();
    if (threadIdx.x == 0) {
        unsigned* bar = b.bar;
        const unsigned bx = xb_xcc_id();
        __builtin_amdgcn_s_waitcnt(0);
        unsigned nloc = b.st[0], nx = b.st[1];
        if (nloc == 0u) { xcd_barrier_complete(bar, bx, nloc, nx); b.st[0] = nloc; b.st[1] = nx; }
        const unsigned old = xb_add(&bar[XB_XSUB(bx)], 1u);
        const unsigned gen = old / nloc;
        if (old + 1u == (gen + 1u) * nloc) {
            __builtin_amdgcn_fence(__ATOMIC_RELEASE, "agent");
            asm volatile("s_waitcnt vmcnt(0)" ::: "memory");
            const unsigned og = xb_add(&bar[XB_TOP], 1u);
            const unsigned tg = og / nx;
            if (og + 1u == (tg + 1u) * nx) xb_add(&bar[XB_TOPGEN], 1u);
            else XB_SPIN(xb_ld(&bar[XB_TOPGEN]) == tg, bar);
            __builtin_amdgcn_fence(__ATOMIC_ACQUIRE, "agent");
            xb_add(&bar[XB_XGEN(bx)], 1u);
            asm volatile("s_waitcnt vmcnt(0)" ::: "memory");
        } else {
            XB_SPIN(xb_ld(&bar[XB_XGEN(bx)]) == gen, bar);
            __builtin_amdgcn_fence(__ATOMIC_ACQUIRE, "agent");
            asm volatile("s_waitcnt vmcnt(0)" ::: "memory");
        }
    }
    __syncthreads();
}

namespace {
struct Params {
  const float *x, *meta, *rel_bias, *ln_mix, *w_in, *sinks, *conv_w, *conv_b, *dt_bias, *a_log, *d_skip, *attn_norm_w,
      *ssm_norm_w, *w_out, *ln_ffn, *wq, *keys, *U, *V, *ln_final;
  float* out;
  unsigned char* ws;
};

__device__ __forceinline__ void p0_transpose_tile(const float* __restrict__ W, int ldw, bf16_t* __restrict__ Wt, const float* sc0,
                                                  const float* sc1, int k0, int n0, float* tile) {
  int tid = threadIdx.x; asm volatile("" : "+v"(tid));
  {
    const int r = tid >> 6, c4 = (tid & 63) * 4;
    f32x4 v[8];
#pragma unroll
    for (int i = 0; i < 8; ++i) v[i] = __builtin_nontemporal_load((const f32x4*)(W + (size_t)(k0 + r + 8 * i) * ldw + n0 + c4));
#pragma unroll
    for (int i = 0; i < 8; ++i) {
      float s = 1.f;
      const int k = k0 + r + 8 * i;
      if (sc0) s = k < 1024 ? sc0[k] : sc1[k - 1024];
      float* q = tile + (r + 8 * i) * 257 + c4;
      q[0] = v[i][0] * s; q[1] = v[i][1] * s; q[2] = v[i][2] * s; q[3] = v[i][3] * s;
    }
  }
  __syncthreads();
#pragma unroll
  for (int it = 0; it < 4; ++it) {
    const int task = it * NTHREADS + tid;
    const int n = task >> 3, kc = (task & 7) * 8;
    float v[8];
#pragma unroll
    for (int j = 0; j < 8; ++j) v[j] = tile[(kc + j) * 257 + n];
    u32x4 w; w.x = pack_bf16(v[0], v[1]); w.y = pack_bf16(v[2], v[3]); w.z = pack_bf16(v[4], v[5]); w.w = pack_bf16(v[6], v[7]);
    *(u32x4*)(Wt + (size_t)(n0 + n) * DM + k0 + kc) = w;
  }
  __syncthreads();
}

__device__ __forceinline__ void phase0(const Params& p, float* ldsf, int bid, int nblk) {
  int tid = threadIdx.x; asm volatile("" : "+v"(tid));
  const int lane = tid & 63, wid = tid >> 6;
  bf16_t* w_inT = (bf16_t*)(p.ws + WS_WINT);
  bf16_t* w_dtT = (bf16_t*)(p.ws + WS_WDTT);
  bf16_t* w_outT = (bf16_t*)(p.ws + WS_WOUTT);
  bf16_t* wqT = (bf16_t*)(p.ws + WS_WQT);
  bf16_t* keysb = (bf16_t*)(p.ws + WS_KEYS);
  unsigned char* ub = p.ws + WS_UB;
  unsigned char* vb = p.ws + WS_VB;
  bf16_t* hnb = (bf16_t*)(p.ws + WS_HNB);
  constexpr int U_HN = (TA + 7) / 8;
  constexpr int U_WIN = 32 * 16, U_WOUT = 32 * 8, U_WQ = 32 * 8, U_WDT = 1, U_KEYS = 64;
  constexpr int B_WIN = U_HN, B_WOUT = B_WIN + U_WIN, B_WQ = B_WOUT + U_WOUT, B_WDT = B_WQ + U_WQ, B_KEYS = B_WDT + U_WDT,
                B_U = B_KEYS + U_KEYS, B_END = B_U;
  for (int u = bid; u < B_END; u += nblk) {
    if (u < B_WIN) {
      const int t = u * 8 + wid;
      if (t < TA) {
        const float* src = t < T ? p.x + (size_t)t * DM : p.meta + (size_t)(t - T) * DM;
        float4 v[8];
        float ss = 0.f;
#pragma unroll
        for (int i = 0; i < 8; ++i) {
          { const f32x4 q_ = __builtin_nontemporal_load((const f32x4*)(src + (i * 64 + lane) * 4)); v[i].x = q_[0]; v[i].y = q_[1]; v[i].z = q_[2]; v[i].w = q_[3]; }
          ss += v[i].x * v[i].x + v[i].y * v[i].y + v[i].z * v[i].z + v[i].w * v[i].w;
        }
        ss = wave_sum(ss);
        const float r = rsqrtf(ss * (1.f / DM) + EPS);
#pragma unroll
        for (int i = 0; i < 8; ++i) {
          const float4 w = *(const float4*)(p.ln_mix + (i * 64 + lane) * 4);
          u32x2 o; o.x = pack_bf16(v[i].x * r * w.x, v[i].y * r * w.y); o.y = pack_bf16(v[i].z * r * w.z, v[i].w * r * w.w);
          *(u32x2*)(hnb + (size_t)t * DM + (i * 64 + lane) * 4) = o;
        }
      }
    } else if (u < B_WOUT) {
      const int i = u - B_WIN;
      p0_transpose_tile(p.w_in, DPROJ, w_inT, nullptr, nullptr, (i & 31) * 64, (i >> 5) * 256, ldsf);
    } else if (u < B_WQ) {
      const int i = u - B_WOUT;
      p0_transpose_tile(p.w_out, DM, w_outT, p.attn_norm_w, p.ssm_norm_w, (i & 31) * 64, (i >> 5) * 256, ldsf);
    } else if (u < B_WDT) {
      const int i = u - B_WQ;
      p0_transpose_tile(p.wq, DM, wqT, p.ln_ffn, p.ln_ffn + 1024, (i & 31) * 64, (i >> 5) * 256, ldsf);
    } else if (u < B_KEYS) {
      for (int idx = tid; idx < DM * 16; idx += NTHREADS) {
        const int k = idx >> 4, j = idx & 15;
        w_dtT[(size_t)j * DM + k] = f2bf(p.w_in[(size_t)k * DPROJ + NPROJ + j]);
      }
    } else if (u < B_U) {
      int tk = tid;
      asm volatile("" : "+v"(tk));
      const unsigned base = (unsigned)(u - B_KEYS) * 4096u + (unsigned)tk * 8u;
      const float4 a = *(const float4*)(p.keys + base), b = *(const float4*)(p.keys + base + 4);
      u32x4 w; w.x = pack_bf16(a.x, a.y); w.y = pack_bf16(a.z, a.w); w.z = pack_bf16(b.x, b.y); w.w = pack_bf16(b.z, b.w);
      *(u32x4*)(keysb + base) = w;
    }
  }
}

__device__ __forceinline__ void convert_tables(const Params& p, int bid, int nblk) {
  int tid = threadIdx.x; asm volatile("" : "+v"(tid));
  const int lane = tid & 63, wid = tid >> 6;
  unsigned char* ub = p.ws + WS_UB;
  unsigned char* vb = p.ws + WS_VB;
  {
    const int gw = bid * 8 + wid, nw = nblk * 8;
    auto load_row = [&](f32x4 (&a)[8], const int r2) __attribute__((always_inline)) {
      const float* src = (r2 < NEXP ? p.U + (size_t)r2 * DM : p.V + (size_t)(r2 - NEXP) * DM) + lane * 4;
#pragma unroll
      for (int j = 0; j < 8; ++j) a[j] = __builtin_nontemporal_load((const f32x4*)(src + 256 * j));
    };
    auto conv_row = [&](f32x4 (&a)[8], const int r2) __attribute__((always_inline)) {
      const bool isU = r2 < NEXP;
      const int row = isU ? r2 : r2 - NEXP;
      if (isU) {
#pragma unroll
        for (int j = 0; j < 8; ++j) a[j] *= *(const f32x4*)(p.ln_ffn + lane * 4 + 256 * j);
      }
      float amax = 0.f;
#pragma unroll
      for (int j = 0; j < 8; ++j) amax = fmaxf(amax, fmaxf(fmaxf(fabsf(a[j][0]), fabsf(a[j][1])), fmaxf(fabsf(a[j][2]), fabsf(a[j][3]))));
      amax = wave_max(amax);
      const float s4 = amax > 0.f ? 6.f / amax : 1.f;
      u32x4 w4;
#pragma unroll
      for (int j = 0; j < 4; ++j) {
        unsigned w = 0;
        w = __builtin_amdgcn_cvt_scalef32_pk_fp4_f32(w, a[2 * j][0] * s4, a[2 * j][1] * s4, 1.0f, 0);
        w = __builtin_amdgcn_cvt_scalef32_pk_fp4_f32(w, a[2 * j][2] * s4, a[2 * j][3] * s4, 1.0f, 1);
        w = __builtin_amdgcn_cvt_scalef32_pk_fp4_f32(w, a[2 * j + 1][0] * s4, a[2 * j + 1][1] * s4, 1.0f, 2);
        w = __builtin_amdgcn_cvt_scalef32_pk_fp4_f32(w, a[2 * j + 1][2] * s4, a[2 * j + 1][3] * s4, 1.0f, 3);
        w4[j] = w;
      }
      *(u32x4*)((isU ? ub : vb) + (size_t)row * ROW4 + lane * 16) = w4;
      if (lane == 0) ((float*)(p.ws + (isU ? WS_USC : WS_VSC)))[row] = amax > 0.f ? amax * (1.f / 6.f) : 1.f;
    };
    f32x4 ra[8], rb[8];
    int r2 = gw;
    if (r2 < 2 * NEXP) load_row(ra, r2);
#pragma unroll 1
    for (; r2 < 2 * NEXP; r2 += 2 * nw) {
      if (r2 + nw < 2 * NEXP) load_row(rb, r2 + nw);
      conv_row(ra, r2);
      if (r2 + nw < 2 * NEXP) {
        if (r2 + 2 * nw < 2 * NEXP) load_row(ra, r2 + 2 * nw);
        conv_row(rb, r2 + nw);
      }
    }
  }
}

__device__ __forceinline__ void mini_gemm(const bf16_t* __restrict__ A, const bf16_t* __restrict__ Bt, float* __restrict__ out, int ldo,
                                          float* red, bf16_t* __restrict__ outb = nullptr) {
  int tid = threadIdx.x; asm volatile("" : "+v"(tid));
  const int lane = tid & 63, wid = tid >> 6, fr = lane & 15, fq = lane >> 4;
  f32x4 acc = {0.f, 0.f, 0.f, 0.f};
  const bf16_t* ap = A + (size_t)fr * DM + wid * 256 + fq * 8;
  const bf16_t* bp = Bt + (size_t)fr * DM + wid * 256 + fq * 8;
#pragma unroll
  for (int ks = 0; ks < 8; ++ks) {
    const bf16x8 a = *(const bf16x8*)(ap + ks * 32);
    const bf16x8 b = *(const bf16x8*)(bp + ks * 32);
    acc = __builtin_amdgcn_mfma_f32_16x16x32_bf16(a, b, acc, 0, 0, 0);
  }
#pragma unroll
  for (int r = 0; r < 4; ++r) red[wid * 256 + (4 * fq + r) * 16 + fr] = acc[r];
  __syncthreads();
  if (tid < 256) {
    float s = 0.f;
#pragma unroll
    for (int w = 0; w < 8; ++w) s += red[w * 256 + tid];
    out[(size_t)(tid >> 4) * ldo + (tid & 15)] = s;
    if (outb) outb[(size_t)(tid >> 4) * ldo + (tid & 15)] = f2bf(s);
  }
  __syncthreads();
}

__device__ __forceinline__ void phase1(const Params& p, unsigned char* lds, int bid, int nblk) {
  const bool stream_first = ((bid >> 3) & 1) != 0;
  if (stream_first) convert_tables(p, bid, nblk);
  const bf16_t* hnb = (const bf16_t*)(p.ws + WS_HNB);
  const bf16_t* w_inT = (const bf16_t*)(p.ws + WS_WINT);
  const bf16_t* w_dtT = (const bf16_t*)(p.ws + WS_WDTT);
  float* dtraw = (float*)(p.ws + WS_DTRAW);
  float* projm = (float*)(p.ws + WS_PROJM);
  constexpr int NU = 512 + 32 + 96 + 1;
  for (int u = bid; u < NU; u += nblk) {
    if (u < 512) {
      mini_gemm(hnb + (size_t)u * 16 * DM, w_dtT, dtraw + (size_t)u * 16 * 16, 16, (float*)lds);
    } else {
      const int j = u - 512;
      const int cf = j < 32 ? 64 + j : (j < 128 ? 160 + (j - 32) : 256);
      const bf16_t* bt = cf < 256 ? w_inT + (size_t)cf * 16 * DM : w_dtT;
      mini_gemm(hnb + (size_t)T * DM, bt, projm + cf * 16, DPROJ, (float*)lds, (bf16_t*)(p.ws + WS_PROJMB) + cf * 16);
    }
  }
  pg8::Gemm g{hnb, w_inT, T, NPROJ, DM};
  pg8::StaticOrder S; S.init(T, NPROJ, nblk, bid);
  pg8::EpiBf16 E{(bf16_t*)(p.ws + WS_PROJ), NPROJ};
  pg8::gemm_phase<pg8::EpiBf16, pg8::StaticOrder>((PG8_LAS unsigned char*)lds, g, S, E);
  if (!stream_first) convert_tables(p, bid, nblk);
}

__device__ __forceinline__ void phase4(const Params& p, unsigned char* lds, int bid, int nblk) {
  pg8::Gemm g{(const bf16_t*)(p.ws + WS_HNB), (const bf16_t*)(p.ws + WS_WOUTT), T, DM, DM};
  pg8::StaticOrder S; S.init(T, DM, nblk, bid);
  pg8::EpiRes E{p.x, (bf16_t*)(p.ws + WS_H1B), (float*)(p.ws + WS_SSQH1)};
  pg8::gemm_phase<pg8::EpiRes, pg8::StaticOrder>((PG8_LAS unsigned char*)lds, g, S, E);
}
__device__ __forceinline__ void phase5(const Params& p, unsigned char* lds, int bid, int nblk) {
  pg8::Gemm g{(const bf16_t*)(p.ws + WS_H1B), (const bf16_t*)(p.ws + WS_WQT), T, DM, DM};
  pg8::StaticOrder S; S.init(T, DM, nblk, bid);
  pg8::EpiScores E{(const bf16_t*)(p.ws + WS_KEYS), (float*)(p.ws + WS_STOP), (int*)(p.ws + WS_ITOP)};
  pg8::gemm_phase<pg8::EpiScores, pg8::StaticOrder>((PG8_LAS unsigned char*)lds, g, S, E);
}

__device__ __forceinline__ float dot2bf(unsigned a, unsigned b, float c) {
  return __builtin_amdgcn_fdot2_f32_bf16(*(bf16v2*)&a, *(bf16v2*)&b, c, false);
}
__device__ __forceinline__ void phase6(const Params& p, unsigned char* lds, int bid, int nblk) {
  const int tid0 = threadIdx.x, lane0 = tid0 & 63, wid = __builtin_amdgcn_readfirstlane(tid0 >> 6);
  int* ids = (int*)(lds + wid * 2048);
  float* gts = (float*)(lds + wid * 2048 + 512);
  float* wts = (float*)(lds + wid * 2048 + 1024);
  int* rid = (int*)(lds + 16384 + wid * 1024);
  float* rgt = (float*)(lds + 16384 + wid * 1024 + 512);
  const unsigned char* ub = p.ws + WS_UB;
  const unsigned char* vb = p.ws + WS_VB;
  const bf16_t* h1b = (const bf16_t*)(p.ws + WS_H1B);
  const float* usc = (const float*)(p.ws + WS_USC);
  const float* vsc = (const float*)(p.ws + WS_VSC);
  const float* ssq = (const float*)(p.ws + WS_SSQH1);
  const float* stop = (const float*)(p.ws + WS_STOP);
  const int* itop = (const int*)(p.ws + WS_ITOP);
  const int ci = kCandI[lane0], cj = kCandJ[lane0];
#pragma unroll 1
  for (int t = bid * 8 + wid; t < T; t += nblk * 8) {
    int tid = tid0; asm volatile("" : "+v"(tid));
    const int lane = tid & 63;
    const int kcode = 8 * ((lane >> 2) & 1) + 4 * ((lane >> 3) & 1) + 2 * ((lane >> 4) & 1) + ((lane >> 5) & 1);
    const float part0 = lane < 32 ? ssq[(size_t)t * 32 + lane] : 0.f;
    const float rr = rsqrtf(wave_sum(part0) * (1.f / DM) + EPS);
#pragma unroll 1
    for (int h = 0; h < 8; ++h) {
      const size_t lbase = ((size_t)t * 16 + h * 2) * 16;
      const float sv = lane < 32 ? __builtin_nontemporal_load(stop + lbase + lane) : 0.f;
      const int iv = lane < 32 ? __builtin_nontemporal_load(itop + lbase + lane) : 0;
      float cand = (__shfl(sv, ci) + __shfl(sv, 16 + cj)) * rr;
      if (lane >= 50) cand = -INFINITY;
      unsigned key = __float_as_uint(cand);
      key = (key & 0x80000000u) ? ~key : (key | 0x80000000u);
      key = (key & ~63u) | (unsigned)(63 - lane);
      int rank = 0;
#pragma unroll
      for (int k = 0; k < 50; ++k) {
        const unsigned kk = (unsigned)__builtin_amdgcn_readlane((int)key, k);
        rank += kk > key ? 1 : 0;
      }
      const float cmax = wave_max(cand);
      const float ex = rank < 16 ? __expf(cand - cmax) : 0.f;
      const float den = wave_sum(ex);
      const int eidx = __shfl(iv, ci) * 128 + __shfl(iv, 16 + cj);
      if (rank < 16) { rid[h * 16 + rank] = eidx; rgt[h * 16 + rank] = ex / den; }
    }
    {
      const int e0 = rid[lane], e1 = rid[lane + 64];
      const float g0 = rgt[lane], g1 = rgt[lane + 64];
      const int r0 = e0 >> 10, r1 = e1 >> 10;
      const unsigned long long ltm = (1ull << lane) - 1ull;
      int run = 0, pos0 = 0, pos1 = 0;
#pragma unroll
      for (int R = 0; R < 16; ++R) {
        const unsigned long long m0 = __ballot(r0 == R), m1 = __ballot(r1 == R);
        const int c0 = __popcll(m0), c1 = __popcll(m1);
        if (r0 == R) pos0 = run + __popcll(m0 & ltm);
        if (r1 == R) pos1 = run + c0 + __popcll(m1 & ltm);
        run += c0 + c1;
      }
      ids[pos0] = e0; gts[pos0] = g0;
      ids[pos1] = e1; gts[pos1] = g1;
    }
    unsigned xw[16];
    {
      const bf16_t* xp = h1b + (size_t)t * DM + lane * 4;
#pragma unroll
      for (int j = 0; j < 8; ++j) {
        const u32x2 xa = *(const u32x2*)(xp + 256 * j);
        xw[2 * j] = xa.x; xw[2 * j + 1] = xa.y;
      }
    }
#pragma unroll 1
    for (int rnd = 0; rnd < 8; ++rnd) {
      u32x4 ra[16];
#pragma unroll
      for (int k = 0; k < 16; ++k) {
        const int e = __builtin_amdgcn_readfirstlane(ids[rnd * 16 + k]);
        ra[k] = *(const u32x4*)(ub + (size_t)e * ROW4 + lane * 16);
      }
      float part[16];
      float prev = 0.f;
#pragma unroll
      for (int k = 0; k < 16; ++k) {
        asm volatile("" : "+v"(ra[k]) : "v"(prev));
        float d0 = 0.f, d1 = 0.f;
#define U4_STEP(j, i, d) { const bf16v2 r = __builtin_amdgcn_cvt_scalef32_pk_bf16_fp4(ra[k][j], 1.0f, i); \
          d = __builtin_amdgcn_fdot2_f32_bf16(r, *(const bf16v2*)&xw[4 * (j) + (i)], d, false); }
#pragma unroll
        for (int j = 0; j < 4; ++j) { U4_STEP(j, 0, d0) U4_STEP(j, 1, d1) U4_STEP(j, 2, d0) U4_STEP(j, 3, d1) }
#undef U4_STEP
        prev = d0 + d1;
        part[k] = prev;
      }
      float q8[8], q4[4], q2[2], q1;
      { const bool hi = (lane >> 5) & 1;
#pragma unroll
        for (int i = 0; i < 8; ++i) { const float keep = hi ? part[2 * i + 1] : part[2 * i], send = hi ? part[2 * i] : part[2 * i + 1]; q8[i] = keep + __shfl_xor(send, 32); } }
      { const bool hi = (lane >> 4) & 1;
#pragma unroll
        for (int i = 0; i < 4; ++i) { const float keep = hi ? q8[2 * i + 1] : q8[2 * i], send = hi ? q8[2 * i] : q8[2 * i + 1]; q4[i] = keep + __shfl_xor(send, 16); } }
      { const bool hi = (lane >> 3) & 1;
#pragma unroll
        for (int i = 0; i < 2; ++i) { const float keep = hi ? q4[2 * i + 1] : q4[2 * i], send = hi ? q4[2 * i] : q4[2 * i + 1]; q2[i] = keep + __shfl_xor(send, 8); } }
      { const bool hi = (lane >> 2) & 1;
        const float keep = hi ? q2[1] : q2[0], send = hi ? q2[0] : q2[1]; q1 = keep + __shfl_xor(send, 4); }
      q1 += __shfl_xor(q1, 2);
      q1 += __shfl_xor(q1, 1);
      {
        const int kk = rnd * 16 + kcode;
        const int eid = ids[kk];
        const float a = q1 * rr * usc[eid];
        const float ge = 0.5f * a * (1.f + erff(a * 0.70710678118654752f));
        if ((lane & 3) == 0) wts[kk] = gts[kk] * ge * vsc[eid];
      }
    }
    float acc[32];
#pragma unroll
    for (int i = 0; i < 32; ++i) acc[i] = 0.f;
#pragma unroll 1
    for (int rnd = 0; rnd < 8; ++rnd) {
      u32x4 ra[16];
#pragma unroll
      for (int k = 0; k < 16; ++k) {
        const int e = __builtin_amdgcn_readfirstlane(ids[rnd * 16 + k]);
        ra[k] = *(const u32x4*)(vb + (size_t)e * ROW4 + lane * 16);
      }
      f32x4 wv[4];
#pragma unroll
      for (int j = 0; j < 4; ++j) wv[j] = *(const f32x4*)(wts + rnd * 16 + 4 * j);
#pragma unroll
      for (int k = 0; k < 16; ++k) {
        const float wk = wv[k >> 2][k & 3];
        asm volatile("" : "+v"(ra[k]) : "v"(acc[1]), "v"(acc[3]), "v"(acc[5]), "v"(acc[7]), "v"(acc[9]), "v"(acc[11]), "v"(acc[13]), "v"(acc[15]),
                                        "v"(acc[17]), "v"(acc[19]), "v"(acc[21]), "v"(acc[23]), "v"(acc[25]), "v"(acc[27]), "v"(acc[29]), "v"(acc[31]));
#define V4_STEP(j, i) { const f32x2 r = __builtin_amdgcn_cvt_scalef32_pk_f32_fp4(ra[k][j], 1.0f, i); \
            acc[8 * (j) + 2 * (i)] = fmaf(wk, r[0], acc[8 * (j) + 2 * (i)]); acc[8 * (j) + 2 * (i) + 1] = fmaf(wk, r[1], acc[8 * (j) + 2 * (i) + 1]); }
#pragma unroll
        for (int j = 0; j < 4; ++j) { V4_STEP(j, 0) V4_STEP(j, 1) V4_STEP(j, 2) V4_STEP(j, 3) }
#undef V4_STEP
      }
    }
    float ss = 0.f;
#pragma unroll
    for (int i = 0; i < 32; ++i) { acc[i] += (i & 1) ? bfhi(xw[i >> 1]) : bflo(xw[i >> 1]); ss += acc[i] * acc[i]; }
    ss = wave_sum(ss);
    const float rf = rsqrtf(ss * (1.f / DM) + EPS);
#pragma unroll
    for (int j = 0; j < 8; ++j) {
      const f32x4 lw = *(const f32x4*)(p.ln_final + 256 * j + lane * 4);
      const f32x4 o = {acc[4 * j] * rf * lw[0], acc[4 * j + 1] * rf * lw[1], acc[4 * j + 2] * rf * lw[2], acc[4 * j + 3] * rf * lw[3]};
      __builtin_nontemporal_store(o, (f32x4*)(p.out + (size_t)t * DM + 256 * j + lane * 4));
    }
  }
}

typedef float f32x16 __attribute__((ext_vector_type(16)));
__device__ __forceinline__ void unpack8(const u32x4 a, float (&v)[8]) {
  v[0] = bflo(a.x); v[1] = bfhi(a.x); v[2] = bflo(a.y); v[3] = bfhi(a.y); v[4] = bflo(a.z); v[5] = bfhi(a.z); v[6] = bflo(a.w); v[7] = bfhi(a.w);
}
constexpr int VT_LD = 196;
constexpr int ATT_VT_BYTES = 4 * 64 * VT_LD * 2;
__device__ __forceinline__ void attn_item(const Params& p, unsigned char* lds, int item, const bool first) {
  int tid = threadIdx.x; asm volatile("" : "+v"(tid));
  const int lane = tid & 63, wid = __builtin_amdgcn_readfirstlane(tid >> 6);
  const int b = item >> 6, qb = item & 63, q0 = qb * 32;
  bf16_t* VT = (bf16_t*)lds;
  float* biasL = (float*)(lds + ATT_VT_BYTES);
  float* ssqw = biasL + 16 * 132;
  const bf16_t* proj = (const bf16_t*)(p.ws + WS_PROJ);
  const float* projm = (const float*)(p.ws + WS_PROJM);
  bf16_t* mixin = (bf16_t*)(p.ws + WS_HNB);
  if (first) {
#pragma unroll
  for (int it = 0; it < 5; ++it) {
    const int idx = it * NTHREADS + tid;
    if (idx >= 16 * 129) break;
    const int hq = idx / 129, d = idx - hq * 129;
    int bk = d;
    if (d >= 16) bk = 16 + (d >= 19) + (d >= 21) + (d >= 24) + (d >= 27) + (d >= 31) + (d >= 35) + (d >= 40) + (d >= 46) + (d >= 52) + (d >= 59) +
                      (d >= 67) + (d >= 77) + (d >= 87) + (d >= 99) + (d >= 113);
    biasL[hq * 132 + d] = p.rel_bias[bk * 16 + hq];
  }
  }
  const int ql = lane & 31, ql0 = ql, hh = lane >> 5, kvh = wid >> 1;
  const int trow = b * SEQ + q0 + ql;
  bf16x8 qf[4];
  u32x4 kf[6][4];
#define ATT_LOAD_Q(hq_)                                                                                                           \
  { _Pragma("unroll") for (int ks = 0; ks < 4; ++ks) qf[ks] = *(const bf16x8*)(proj + (size_t)trow * NPROJ + OFF_Q + (hq_) * 64 + ks * 16 + hh * 8); }
#define ATT_LOAD_K()                                                                                                              \
  {                                                                                                                               \
    int ql = ql0; asm volatile("" : "+v"(ql));     \
    const float* kr_ = projm + (size_t)(ql & 15) * DPROJ + OFF_K + kvh * 64 + hh * 8;                                             \
    _Pragma("unroll") for (int ks = 0; ks < 4; ++ks) {                                                                            \
      const f32x4 a_ = *(const f32x4*)(kr_ + ks * 16), c_ = *(const f32x4*)(kr_ + ks * 16 + 4);                                   \
      kf[0][ks].x = pack_bf16(a_[0], a_[1]); kf[0][ks].y = pack_bf16(a_[2], a_[3]); kf[0][ks].z = pack_bf16(c_[0], c_[1]); kf[0][ks].w = pack_bf16(c_[2], c_[3]); } \
    _Pragma("unroll") for (int jt = 1; jt < 6; ++jt) {                                                                            \
      int sp_ = q0 - 128 + 32 * (jt - 1) + ql; sp_ = sp_ < 0 ? 0 : sp_;                                                           \
      const bf16_t* kp_ = proj + (size_t)(b * SEQ + sp_) * NPROJ + OFF_K + kvh * 64 + hh * 8;                                     \
      _Pragma("unroll") for (int ks = 0; ks < 4; ++ks) kf[jt][ks] = *(const u32x4*)(kp_ + ks * 16); }                             \
  }
  const int qb4 = (qb + 4) % 5;
  if (first) {
    u32x4 ra[5], rc[5];
#pragma unroll
    for (int q = 0; q < 5; ++q) {
      const int task = q * NTHREADS + tid, ch = task / 80, pi = task - ch * 80;
      int s0 = q0 - 128 + 2 * pi;
      s0 = s0 < 0 ? 0 : s0;
      const unsigned off = (unsigned)((b * SEQ + s0) * NPROJ + OFF_V + ch * 8);
      ra[q] = *(const u32x4*)(proj + off); rc[q] = *(const u32x4*)(proj + off + NPROJ);
    }
    float m0[8], m1[8];
    {
      const int pi = tid & 7, ch = (tid >> 3) & 31;
      const float* r0 = projm + (size_t)(2 * pi) * DPROJ + OFF_V + ch * 8;
      const f32x4 ma = *(const f32x4*)r0, mb = *(const f32x4*)(r0 + 4), mc = *(const f32x4*)(r0 + DPROJ), md = *(const f32x4*)(r0 + DPROJ + 4);
      const float keep = tid < 256 ? 1.f : 0.f;
#pragma unroll
      for (int i = 0; i < 4; ++i) { m0[i] = ma[i] * keep; m0[4 + i] = mb[i] * keep; m1[i] = mc[i] * keep; m1[4 + i] = md[i] * keep; }
      bf16_t* dst = VT + (size_t)((ch >> 3) * 64 + (ch & 7) * 8) * VT_LD + 2 * pi + (tid < 256 ? 0 : 16);
#pragma unroll
      for (int i = 0; i < 8; ++i) *(unsigned*)(dst + i * VT_LD) = pack_bf16(m0[i], m1[i]);
    }
#pragma unroll
    for (int q = 0; q < 5; ++q) {
      const int task = q * NTHREADS + tid, ch = task / 80, pi = task - ch * 80;
      float v0[8], v1[8];
      unpack8(ra[q], v0); unpack8(rc[q], v1);
      int rp = qb4 + (pi >> 4); rp = rp >= 5 ? rp - 5 : rp;
      const int slot = 32 + rp * 32 + 2 * (pi & 15);
      bf16_t* dst = VT + (size_t)((ch >> 3) * 64 + (ch & 7) * 8) * VT_LD + slot;
#pragma unroll
      for (int i = 0; i < 8; ++i) *(unsigned*)(dst + i * VT_LD) = pack_bf16(v0[i], v1[i]);
    }
  } else {
    const int ch = tid >> 4, pw = tid & 15;
    const bf16_t* r0 = proj + (size_t)(b * SEQ + q0 + 2 * pw) * NPROJ + OFF_V + ch * 8;
    const u32x4 ra = *(const u32x4*)r0, rc = *(const u32x4*)(r0 + NPROJ);
    float v0[8], v1[8];
    unpack8(ra, v0); unpack8(rc, v1);
    const int slot = 32 + ((qb4 + 4) % 5) * 32 + 2 * pw;
    bf16_t* dst = VT + (size_t)((ch >> 3) * 64 + (ch & 7) * 8) * VT_LD + slot;
#pragma unroll
    for (int i = 0; i < 8; ++i) *(unsigned*)(dst + i * VT_LD) = pack_bf16(v0[i], v1[i]);
  }
  __syncthreads();
  float ssq = 0.f;
#pragma unroll 1
  for (int rep_ = 0; rep_ < (REP_SUB == 3 ? 2 : 1); ++rep_) {
  ssq = 0.f;
  auto do_head = [&](const int hsel) __attribute__((always_inline)) {
    const int hq = 2 * wid + hsel;
    f32x16 sacc[6];
#pragma unroll
    for (int jt = 0; jt < 6; ++jt) {
      f32x16 acc;
#pragma unroll
      for (int r = 0; r < 16; ++r) acc[r] = 0.f;
#pragma unroll
      for (int ks = 0; ks < 4; ++ks) acc = __builtin_amdgcn_mfma_f32_32x32x16_bf16(*(bf16x8*)&kf[jt][ks], qf[ks], acc, 0, 0, 0);
      sacc[jt] = acc;
    }
    if (hsel == 0) { ATT_LOAD_Q(2 * wid + 1) }
    const float* bl = biasL + hq * 132;
    int sq = q0 + ql, qh = ql - 4 * hh;
    asm volatile("" : "+v"(sq), "+v"(qh));
    const float sink = p.sinks[hq];
    float m = sink;
#pragma unroll
    for (int jt = 0; jt < 6; ++jt) {
      asm volatile("" ::: "memory");
#pragma unroll
      for (int r = 0; r < 16; ++r) {
        const int kr = (r & 3) + 8 * (r >> 2) + 4 * hh;
        int dist; bool valid;
        if (jt == 0) { dist = sq + (16 - ((r & 3) + 8 * (r >> 2))) - 4 * hh; valid = kr < 16; }
        else { dist = qh + (128 - 32 * (jt - 1) - ((r & 3) + 8 * (r >> 2))); valid = (dist >= 0) && (dist < 128) && (dist <= sq); }
        const int dc = dist < 0 ? 0 : (dist > 128 ? 128 : dist);
        const float l = valid ? 0.125f * sacc[jt][r] + bl[dc] : -1e30f;
        sacc[jt][r] = l;
        m = fmaxf(m, l);
      }
    }
    m = fmaxf(m, __shfl_xor(m, 32));
    float sum = 0.f;
    f32x16 oacc0, oacc1;
#pragma unroll
    for (int r = 0; r < 16; ++r) { oacc0[r] = 0.f; oacc1[r] = 0.f; }
    const bf16_t* vrow0 = VT + (size_t)(kvh * 64 + ql) * VT_LD + 4 * hh;
    const bf16_t* vrow1 = vrow0 + 32 * VT_LD;
#pragma unroll
    for (int jt = 0; jt < 6; ++jt) {
      u32x4 pw[2];
#pragma unroll
      for (int s2 = 0; s2 < 2; ++s2) {
        float e[8];
#pragma unroll
        for (int i = 0; i < 8; ++i) { e[i] = __expf(sacc[jt][8 * s2 + i] - m); sum += e[i]; }
        pw[s2].x = pack_bf16(e[0], e[1]); pw[s2].y = pack_bf16(e[2], e[3]); pw[s2].z = pack_bf16(e[4], e[5]); pw[s2].w = pack_bf16(e[6], e[7]);
      }
#pragma unroll
      for (int s2 = 0; s2 < 2; ++s2) {
        const int sl = (jt == 0 ? 0 : 32 + ((qb4 + jt - 1) % 5) * 32) + 16 * s2;
        const u32x2 va = *(const u32x2*)(vrow0 + sl), vc = *(const u32x2*)(vrow0 + sl + 8);
        const u32x2 vd = *(const u32x2*)(vrow1 + sl), ve = *(const u32x2*)(vrow1 + sl + 8);
        u32x4 v0w; v0w.x = va.x; v0w.y = va.y; v0w.z = vc.x; v0w.w = vc.y;
        u32x4 v1w; v1w.x = vd.x; v1w.y = vd.y; v1w.z = ve.x; v1w.w = ve.y;
        oacc0 = __builtin_amdgcn_mfma_f32_32x32x16_bf16(*(bf16x8*)&v0w, *(bf16x8*)&pw[s2], oacc0, 0, 0, 0);
        oacc1 = __builtin_amdgcn_mfma_f32_32x32x16_bf16(*(bf16x8*)&v1w, *(bf16x8*)&pw[s2], oacc1, 0, 0, 0);
      }
    }
    sum += __shfl_xor(sum, 32);
    const float inv = 1.f / (sum + __expf(sink - m));
#pragma unroll
    for (int r = 0; r < 16; ++r) { oacc0[r] *= inv; oacc1[r] *= inv; ssq += oacc0[r] * oacc0[r] + oacc1[r] * oacc1[r]; }
#pragma unroll
    for (int rg = 0; rg < 4; ++rg) {
      u32x2 w; w.x = pack_bf16(oacc0[rg * 4 + 0], oacc0[rg * 4 + 1]); w.y = pack_bf16(oacc0[rg * 4 + 2], oacc0[rg * 4 + 3]);
      *(u32x2*)(mixin + (size_t)trow * DM + hq * 64 + 8 * rg + 4 * hh) = w;
      u32x2 w1; w1.x = pack_bf16(oacc1[rg * 4 + 0], oacc1[rg * 4 + 1]); w1.y = pack_bf16(oacc1[rg * 4 + 2], oacc1[rg * 4 + 3]);
      *(u32x2*)(mixin + (size_t)trow * DM + hq * 64 + 32 + 8 * rg + 4 * hh) = w1;
    }
  };
  ATT_LOAD_Q(2 * wid)
  ATT_LOAD_K()
  do_head(0);
  asm volatile("" ::: "memory");
  ATT_LOAD_K()
  do_head(1);
  }
  ssq += __shfl_xor(ssq, 32);
  if (lane < 32) ssqw[wid * 32 + lane] = ssq;
  __syncthreads();
  float tot = 0.f;
#pragma unroll
  for (int w = 0; w < 8; ++w) tot += ssqw[w * 32 + ql];
  const float ra = rsqrtf(tot * (1.f / 1024) + EPS);
#pragma unroll
  for (int hsel = 0; hsel < 2; ++hsel)
#pragma unroll
    for (int dt = 0; dt < 2; ++dt)
#pragma unroll
      for (int rg = 0; rg < 4; ++rg) {
        bf16_t* op = mixin + (size_t)trow * DM + (2 * wid + hsel) * 64 + 32 * dt + 8 * rg + 4 * hh;
        const u32x2 v = *(const u32x2*)op;
        u32x2 w; w.x = pack_bf16(bflo(v.x) * ra, bfhi(v.x) * ra); w.y = pack_bf16(bflo(v.y) * ra, bfhi(v.y) * ra);
        *(u32x2*)op = w;
      }
  __syncthreads();
}
#undef ATT_LOAD_Q
#undef ATT_LOAD_K

constexpr int SLD = 136;
__device__ __forceinline__ float conv_silu(const float (&raw)[11], int i, float w0, float w1, float w2, float w3, float cb) {
  return silu_f(cb + w0 * raw[i] + w1 * raw[i + 1] + w2 * raw[i + 2] + w3 * raw[i + 3]);
}
__device__ __forceinline__ void ssd_a_item(const Params& p, unsigned char* lds, int item) {
  int tid = threadIdx.x; asm volatile("" : "+v"(tid));
  const int lane = tid & 63, wid = __builtin_amdgcn_readfirstlane(tid >> 6);
  const int b = item >> 5, c = (item >> 1) & 15, g = item & 1;
  const int h0 = g * 8;
  const int t0 = b * SEQ + c * 128;
  bf16_t* Bc = (bf16_t*)lds;
  bf16_t* Cc = Bc + 128 * SLD;
  bf16_t* BcT = Cc + 128 * SLD;
  bf16_t* xT = BcT + 128 * SLD;
  float* dtl = (float*)(xT + 2 * 64 * SLD);
  float* acs = dtl + 256;
  float* wl = acs + 256;
  float* scan = wl + 256;
  const bf16_t* __restrict__ proj = (const bf16_t*)(p.ws + WS_PROJ);
  const bf16_t* __restrict__ projmb = (const bf16_t*)(p.ws + WS_PROJMB);
  const float* __restrict__ dtraw = (const float*)(p.ws + WS_DTRAW);
  float* __restrict__ acsg = (float*)(p.ws + WS_ACSG);
  bf16_t* __restrict__ ccb = (bf16_t*)(p.ws + WS_CCB);
  bf16_t* __restrict__ ypart = (bf16_t*)(p.ws + WS_YPART);
  float* __restrict__ sg = (float*)(p.ws + WS_SG);
  {
    unsigned raw[4][11];
#pragma unroll
    for (int q = 0; q < 4; ++q) {
      const int task = q * NTHREADS + tid;
      const int tg = task >> 7, cp = task & 127;
      const int cch = 1024 + (cp >> 6) * 256 + g * 128 + 2 * (cp & 63);
#pragma unroll
      for (int i = 0; i < 11; ++i) {
        const int l = tg * 8 + i - 3;
        const bf16_t* src = (l >= 0 || c > 0) ? proj + (size_t)(t0 + l) * NPROJ : projmb + (size_t)(16 + l) * DPROJ;
        raw[q][i] = *(const unsigned*)(src + OFF_XBC + cch);
      }
    }
#pragma unroll
    for (int q = 0; q < 4; ++q) {
      const int task = q * NTHREADS + tid;
      const int tg = task >> 7, cp = task & 127, n = 2 * (cp & 63);
      const int cch = 1024 + (cp >> 6) * 256 + g * 128 + n;
      float o0[8], o1[8];
      {
        float r0[11], r1[11];
#pragma unroll
        for (int i = 0; i < 11; ++i) { r0[i] = bflo(raw[q][i]); r1[i] = bfhi(raw[q][i]); }
        const float w0 = p.conv_w[cch], w1 = p.conv_w[D_XBC + cch], w2 = p.conv_w[2 * D_XBC + cch], w3 = p.conv_w[3 * D_XBC + cch], cb = p.conv_b[cch];
        const float v0 = p.conv_w[cch + 1], v1 = p.conv_w[D_XBC + cch + 1], v2 = p.conv_w[2 * D_XBC + cch + 1], v3 = p.conv_w[3 * D_XBC + cch + 1], vb_ = p.conv_b[cch + 1];
#pragma unroll
        for (int i = 0; i < 8; ++i) { o0[i] = conv_silu(r0, i, w0, w1, w2, w3, cb); o1[i] = conv_silu(r1, i, v0, v1, v2, v3, vb_); }
      }
      bf16_t* rowm = (cp < 64 ? Bc : Cc) + (tg * 8) * SLD + n;
#pragma unroll
      for (int i = 0; i < 8; ++i) *(unsigned*)(rowm + i * SLD) = pack_bf16(o0[i], o1[i]);
      if (cp < 64) {
        u32x4 w; w.x = pack_bf16(o0[0], o0[1]); w.y = pack_bf16(o0[2], o0[3]); w.z = pack_bf16(o0[4], o0[5]); w.w = pack_bf16(o0[6], o0[7]);
        *(u32x4*)(BcT + n * SLD + tg * 8) = w;
        u32x4 w2_; w2_.x = pack_bf16(o1[0], o1[1]); w2_.y = pack_bf16(o1[2], o1[3]); w2_.z = pack_bf16(o1[4], o1[5]); w2_.w = pack_bf16(o1[6], o1[7]);
        *(u32x4*)(BcT + (n + 1) * SLD + tg * 8) = w2_;
      }
    }
  }
  float xraw[4][11];
#define SSD_LOAD_X(r_)                                                                                              \
  _Pragma("unroll") for (int q = 0; q < 4; ++q) {                                                                   \
    const int task = (q & 1) * NTHREADS + tid; const int tg = task >> 6, cch = (h0 + 2 * (r_) + (q >> 1)) * 64 + (task & 63); \
    _Pragma("unroll") for (int i = 0; i < 11; ++i) { const int l = tg * 8 + i - 3;                                  \
      const bf16_t* src = (l >= 0 || c > 0) ? proj + (size_t)(t0 + l) * NPROJ : projmb + (size_t)(16 + l) * DPROJ;  \
      xraw[q][i] = bf2f(src[OFF_XBC + cch]); } }
  SSD_LOAD_X(0)
  __syncthreads();
  {
#pragma unroll
    for (int q = 0; q < 4; ++q) {
      const int idx = q * NTHREADS + tid, row = idx >> 4, ck = idx & 15;
      *(u32x4*)(ccb + (size_t)(t0 + row) * 256 + g * 128 + ck * 8) = *(const u32x4*)(Cc + row * SLD + ck * 8);
    }
  }
  const int ql = lane & 31, hh = lane >> 5;
  int rnd = 0;
  auto ydiag = [&](const int hi, const int il) __attribute__((always_inline)) {
    const int h = h0 + 2 * rnd + hi, ip = wid & 1;
    const bf16_t* xTb = xT + (hi & 1) * 64 * SLD;
    const float dskip = p.d_skip[h];
    const float* acsh = acs + hi * 128;
    const float* dtlh = dtl + hi * 128;
    const int l = 32 * il + ql;
    const float acl = acsh[l];
    f32x16 yacc;
#pragma unroll
    for (int r = 0; r < 16; ++r) yacc[r] = 0.f;
    const bf16_t* xrow = xTb + (32 * ip + ql) * SLD + 4 * hh;
#pragma unroll 1
    for (int is = 0; is <= il; ++is) {
      f32x16 x;
#pragma unroll
      for (int r = 0; r < 16; ++r) x[r] = 0.f;
      const bf16_t* ap = Bc + (32 * is + ql) * SLD + 8 * hh;
      const bf16_t* bp = Cc + l * SLD + 8 * hh;
#pragma unroll
      for (int ks = 0; ks < 8; ++ks) x = __builtin_amdgcn_mfma_f32_32x32x16_bf16(*(const bf16x8*)(ap + 16 * ks), *(const bf16x8*)(bp + 16 * ks), x, 0, 0, 0);
      u32x4 pw[2];
#pragma unroll
      for (int s2 = 0; s2 < 2; ++s2) {
        float mv[8];
#pragma unroll
        for (int q = 0; q < 2; ++q) {
          const int sb = 32 * is + 16 * s2 + 8 * q + 4 * hh;
          const f32x4 as4 = *(const f32x4*)(acsh + sb), dt4 = *(const f32x4*)(dtlh + sb);
#pragma unroll
          for (int j = 0; j < 4; ++j) {
            const int sr = sb + j;
            float v = sr <= l ? x[8 * s2 + 4 * q + j] * __expf(acl - as4[j]) * dt4[j] : 0.f;
            if (sr == l) v += dskip;
            mv[4 * q + j] = v;
          }
        }
        pw[s2].x = pack_bf16(mv[0], mv[1]); pw[s2].y = pack_bf16(mv[2], mv[3]); pw[s2].z = pack_bf16(mv[4], mv[5]); pw[s2].w = pack_bf16(mv[6], mv[7]);
      }
#pragma unroll
      for (int s2 = 0; s2 < 2; ++s2) {
        const u32x2 va = *(const u32x2*)(xrow + 32 * is + 16 * s2), vc = *(const u32x2*)(xrow + 32 * is + 16 * s2 + 8);
        u32x4 aw; aw.x = va.x; aw.y = va.y; aw.z = vc.x; aw.w = vc.y;
        yacc = __builtin_amdgcn_mfma_f32_32x32x16_bf16(*(bf16x8*)&aw, *(bf16x8*)&pw[s2], yacc, 0, 0, 0);
      }
    }
    bf16_t* yp = ypart + (size_t)(t0 + l) * 1024 + h * 64 + 32 * ip + 4 * hh;
#pragma unroll
    for (int rg = 0; rg < 4; ++rg) { u32x2 w; w.x = pack_bf16(yacc[4 * rg], yacc[4 * rg + 1]); w.y = pack_bf16(yacc[4 * rg + 2], yacc[4 * rg + 3]); *(u32x2*)(yp + 8 * rg) = w; }
  };
  auto states = [&](const int hi) __attribute__((always_inline)) {
    const int h = h0 + 2 * rnd + hi, ip = wid & 1, in = wid >> 1;
    const bf16_t* xTb = xT + (hi & 1) * 64 * SLD;
    const float* wlh = wl + hi * 128;
    f32x16 sacc;
#pragma unroll
    for (int r = 0; r < 16; ++r) sacc[r] = 0.f;
    const bf16_t* ap = xTb + (32 * ip + ql) * SLD + 8 * hh;
    const bf16_t* bp = BcT + (32 * in + ql) * SLD + 8 * hh;
#pragma unroll
    for (int ks = 0; ks < 8; ++ks) {
      const u32x4 xa = *(const u32x4*)(ap + 16 * ks);
      const f32x4 wa = *(const f32x4*)(wlh + 16 * ks + 8 * hh), wb = *(const f32x4*)(wlh + 16 * ks + 8 * hh + 4);
      u32x4 aw;
      aw.x = pack_bf16(bflo(xa.x) * wa[0], bfhi(xa.x) * wa[1]); aw.y = pack_bf16(bflo(xa.y) * wa[2], bfhi(xa.y) * wa[3]);
      aw.z = pack_bf16(bflo(xa.z) * wb[0], bfhi(xa.z) * wb[1]); aw.w = pack_bf16(bflo(xa.w) * wb[2], bfhi(xa.w) * wb[3]);
      sacc = __builtin_amdgcn_mfma_f32_32x32x16_bf16(*(bf16x8*)&aw, *(const bf16x8*)(bp + 16 * ks), sacc, 0, 0, 0);
    }
    float* sp = sg + ((size_t)((b * 16 + c) * 16 + h) * 64 + 32 * ip + 4 * hh) * 128 + 32 * in + ql;
#pragma unroll
    for (int r = 0; r < 16; ++r) sp[((r & 3) + 8 * (r >> 2)) * 128] = sacc[r];
  };
#pragma unroll 1
  for (int rnd_ = 0; rnd_ < 4; ++rnd_) {
    rnd = rnd_;
    float dtv = 0.f, cum = 0.f;
    const int hi2 = (tid >> 7) & 1, ltok = tid & 127;
    if (tid < 256) {
      const int h = h0 + 2 * rnd + hi2;
      const float Ah = -expf(p.a_log[h]);
      dtv = softplus_f(dtraw[(size_t)(t0 + ltok) * 16 + h] + p.dt_bias[h]);
      dtl[tid] = dtv;
      cum = dtv * Ah;
#pragma unroll
      for (int o = 1; o < 64; o <<= 1) { const float nb = __shfl_up(cum, o); if (lane >= o) cum += nb; }
      if (lane == 63) scan[hi2 * 2 + (ltok >> 6)] = cum;
    }
#pragma unroll
    for (int q = 0; q < 4; ++q) {
      const int task = (q & 1) * NTHREADS + tid; const int tg = task >> 6, pch = task & 63, cch = (h0 + 2 * rnd + (q >> 1)) * 64 + pch;
      const float w0 = p.conv_w[cch], w1 = p.conv_w[D_XBC + cch], w2 = p.conv_w[2 * D_XBC + cch], w3 = p.conv_w[3 * D_XBC + cch], cb = p.conv_b[cch];
      float o[8];
#pragma unroll
      for (int i = 0; i < 8; ++i) o[i] = conv_silu(xraw[q], i, w0, w1, w2, w3, cb);
      u32x4 w; w.x = pack_bf16(o[0], o[1]); w.y = pack_bf16(o[2], o[3]); w.z = pack_bf16(o[4], o[5]); w.w = pack_bf16(o[6], o[7]);
      *(u32x4*)(xT + (q >> 1) * 64 * SLD + pch * SLD + tg * 8) = w;
    }
    { SSD_LOAD_X((rnd + 1) & 3) }
    __syncthreads();
    if (tid < 256) {
      const int h = h0 + 2 * rnd + hi2;
      const float s0 = scan[hi2 * 2], s1 = scan[hi2 * 2 + 1];
      if (ltok >= 64) cum += s0;
      acs[tid] = cum;
      acsg[(size_t)(t0 + ltok) * 16 + h] = cum;
      wl[tid] = dtv * __expf(s0 + s1 - cum);
    }
    __syncthreads();
    ydiag(0, wid >> 1);
    ydiag(1, 3 - (wid >> 1));
    states(0);
    states(1);
    __syncthreads();
  }
#undef SSD_LOAD_X
  __syncthreads();
}

__device__ __forceinline__ void meta_state_item(const Params& p, unsigned char* lds, int h) {
  int tid = threadIdx.x; asm volatile("" : "+v"(tid));
  const int g = h >> 3;
  float* xm = (float*)lds;
  float* bm = xm + 16 * 64;
  float* dtm = bm + 16 * 128;
  const float* projm = (const float*)(p.ws + WS_PROJM);
  float* smeta = (float*)(p.ws + WS_SMETA);
  for (int task = tid; task < 16 * 192; task += NTHREADS) {
    const int i = task / 192, ch = task - i * 192;
    const int cch = ch < 64 ? h * 64 + ch : 1024 + g * 128 + (ch - 64);
    float acc = p.conv_b[cch];
#pragma unroll
    for (int j = 0; j < 4; ++j) { const int mi = i - j; if (mi >= 0) acc += p.conv_w[(3 - j) * D_XBC + cch] * projm[(size_t)mi * DPROJ + OFF_XBC + cch]; }
    const float v = silu_f(acc);
    if (ch < 64) xm[i * 64 + ch] = v; else bm[i * 128 + ch - 64] = v;
  }
  if (tid < 16) dtm[tid] = softplus_f(projm[(size_t)tid * DPROJ + OFF_DT + h] + p.dt_bias[h]);
  __syncthreads();
  const float Ah = -expf(p.a_log[h]);
  const int pr = tid >> 3, n0 = (tid & 7) * 16;
  float st[16];
#pragma unroll
  for (int k = 0; k < 16; ++k) st[k] = 0.f;
  for (int i = 0; i < 16; ++i) {
    const float dtv = dtm[i], dA = expf(dtv * Ah), xdt = xm[i * 64 + pr] * dtv;
#pragma unroll
    for (int k = 0; k < 16; ++k) st[k] = fmaf(st[k], dA, xdt * bm[i * 128 + n0 + k]);
  }
#pragma unroll
  for (int k = 0; k < 16; ++k) smeta[(size_t)(h * 64 + pr) * 128 + n0 + k] = st[k];
  __syncthreads();
}

__device__ __forceinline__ void phase2(const Params& p, unsigned char* lds, int bid, int nblk) {
  const bool roles = (nblk == 256);
  const int a = (bid >> 4) * 8 + (bid & 7);
  const bool ssd_role = ((bid >> 3) & 1) == 0;
  const int ab = roles ? (ssd_role ? 0 : 2 * a) : bid, ae = roles ? (ssd_role ? 0 : 2 * a + 2) : 256, as_ = roles ? 1 : nblk;
  const int sb = roles ? (ssd_role ? a : 0) : bid, se = roles ? (ssd_role ? a + 1 : 0) : 128, ss = roles ? 1 : nblk;
  const int mb = roles ? (ssd_role ? a : 16) : bid, ms = roles ? 128 : nblk;
#pragma unroll 1
  for (int it = ab; it < ae; it += as_) attn_item(p, lds, it, !(roles && it != ab));
#pragma unroll 1
  for (int it = sb; it < se; it += ss) ssd_a_item(p, lds, it);
#pragma unroll 1
  for (int it = mb; it < 16; it += ms) meta_state_item(p, lds, it);
}

__device__ __forceinline__ void phase_scan(const Params& p, int bid, int nblk) {
  const float* __restrict__ sg = (const float*)(p.ws + WS_SG);
  const float* __restrict__ smeta = (const float*)(p.ws + WS_SMETA);
  const float* __restrict__ acsg = (const float*)(p.ws + WS_ACSG);
  bf16_t* __restrict__ hprev = (bf16_t*)(p.ws + WS_HPREV);
  for (int task = bid * NTHREADS + threadIdx.x; task < 64 * 2048; task += nblk * NTHREADS) {
    const int bh = task >> 11, e4 = (task & 2047) * 4;
    const int b = bh >> 4, h = bh & 15;
    f32x4 sv[16];
    float dv[16];
#pragma unroll
    for (int c = 0; c < 16; ++c) {
      sv[c] = *(const f32x4*)(sg + (size_t)((b * 16 + c) * 16 + h) * 8192 + e4);
      dv[c] = acsg[(size_t)(b * SEQ + c * 128 + 127) * 16 + h];
    }
    f32x4 H = *(const f32x4*)(smeta + (size_t)h * 8192 + e4);
#pragma unroll
    for (int c = 0; c < 16; ++c) {
      u32x2 w; w.x = pack_bf16(H[0], H[1]); w.y = pack_bf16(H[2], H[3]);
      *(u32x2*)(hprev + (size_t)((b * 16 + c) * 16 + h) * 8192 + e4) = w;
      H = H * __expf(dv[c]) + sv[c];
    }
  }
}

__device__ __forceinline__ void ssd_b_item(const Params& p, unsigned char* lds, int item) {
  int tid = threadIdx.x; asm volatile("" : "+v"(tid));
  const int lane = tid & 63, wid = __builtin_amdgcn_readfirstlane(tid >> 6);
  const int b = item >> 6, c = (item >> 2) & 15, g = (item >> 1) & 1, lh = item & 1, h = g * 8 + wid;
  const int t0 = b * SEQ + c * 128 + lh * 64;
  const int ql = lane & 31, hh = lane >> 5;
  constexpr int YLD = 520;
  bf16_t* yoff = (bf16_t*)lds;
  const bf16_t* __restrict__ proj = (const bf16_t*)(p.ws + WS_PROJ);
  const float* __restrict__ acsg = (const float*)(p.ws + WS_ACSG);
  const bf16_t* __restrict__ ccb = (const bf16_t*)(p.ws + WS_CCB);
  const bf16_t* __restrict__ ypart = (const bf16_t*)(p.ws + WS_YPART);
  const bf16_t* __restrict__ hprev = (const bf16_t*)(p.ws + WS_HPREV);
  bf16_t* __restrict__ mixin = (bf16_t*)(p.ws + WS_HNB);
  {
    const bf16_t* hp = hprev + (size_t)((b * 16 + c) * 16 + h) * 8192 + (size_t)ql * 128 + 8 * hh;
    u32x4 hf0[8], hf1[8];
#pragma unroll
    for (int ks = 0; ks < 8; ++ks) { hf0[ks] = *(const u32x4*)(hp + 16 * ks); hf1[ks] = *(const u32x4*)(hp + 32 * 128 + 16 * ks); }
#pragma unroll
    for (int il = 0; il < 2; ++il) {
      const int lt = 32 * il + ql, t = t0 + lt;
      const bf16_t* cp = ccb + (size_t)t * 256 + g * 128 + 8 * hh;
      u32x4 cf[8];
#pragma unroll
      for (int ks = 0; ks < 8; ++ks) cf[ks] = *(const u32x4*)(cp + 16 * ks);
      const float ea = __expf(acsg[(size_t)t * 16 + h]);
      f32x16 a0, a1;
#pragma unroll
      for (int r = 0; r < 16; ++r) { a0[r] = 0.f; a1[r] = 0.f; }
#pragma unroll
      for (int ks = 0; ks < 8; ++ks) {
        a0 = __builtin_amdgcn_mfma_f32_32x32x16_bf16(*(bf16x8*)&hf0[ks], *(bf16x8*)&cf[ks], a0, 0, 0, 0);
        a1 = __builtin_amdgcn_mfma_f32_32x32x16_bf16(*(bf16x8*)&hf1[ks], *(bf16x8*)&cf[ks], a1, 0, 0, 0);
      }
      bf16_t* yr = yoff + lt * YLD + wid * 64 + 4 * hh;
#pragma unroll
      for (int rg = 0; rg < 4; ++rg) {
        u32x2 w0; w0.x = pack_bf16(ea * a0[4 * rg], ea * a0[4 * rg + 1]); w0.y = pack_bf16(ea * a0[4 * rg + 2], ea * a0[4 * rg + 3]);
        u32x2 w1; w1.x = pack_bf16(ea * a1[4 * rg], ea * a1[4 * rg + 1]); w1.y = pack_bf16(ea * a1[4 * rg + 2], ea * a1[4 * rg + 3]);
        *(u32x2*)(yr + 8 * rg) = w0;
        *(u32x2*)(yr + 32 + 8 * rg) = w1;
      }
    }
  }
  __syncthreads();
#pragma unroll
  for (int bt = 0; bt < 2; ++bt) {
    u32x4 yy[4], zz[4], yo[4];
#pragma unroll
    for (int q = 0; q < 4; ++q) {
      const int lt = wid * 8 + bt * 4 + q, t = t0 + lt;
      yy[q] = __builtin_nontemporal_load((const u32x4*)(ypart + (size_t)t * 1024 + g * 512 + lane * 8));
      zz[q] = __builtin_nontemporal_load((const u32x4*)(proj + (size_t)t * NPROJ + OFF_Z + g * 512 + lane * 8));
      yo[q] = *(const u32x4*)(yoff + lt * YLD + lane * 8);
    }
#pragma unroll
    for (int q = 0; q < 4; ++q) {
      const int t = t0 + wid * 8 + bt * 4 + q;
      float zv[8], ov[8], yv[8], y[8];
      unpack8(zz[q], zv); unpack8(yo[q], ov); unpack8(yy[q], yv);
#pragma unroll
      for (int i = 0; i < 8; ++i) y[i] = (yv[i] + ov[i]) * silu_f(zv[i]);
      float ss = 0.f;
#pragma unroll
      for (int i = 0; i < 8; ++i) ss += y[i] * y[i];
      ss = wave_sum(ss);
      const float rn = rsqrtf(ss * (1.f / 512) + EPS);
      u32x4 w; w.x = pack_bf16(y[0] * rn, y[1] * rn); w.y = pack_bf16(y[2] * rn, y[3] * rn); w.z = pack_bf16(y[4] * rn, y[5] * rn); w.w = pack_bf16(y[6] * rn, y[7] * rn);
      *(u32x4*)(mixin + (size_t)t * DM + 1024 + g * 512 + lane * 8) = w;
    }
  }
  __syncthreads();
}
__device__ __forceinline__ void phase3(const Params& p, unsigned char* lds, int bid, int nblk) {
  for (int it = bid; it < 256; it += nblk) ssd_b_item(p, lds, (nblk == 256) ? ((it & 7) * 32 + (it >> 3)) : it);
}

constexpr int LDS_BYTES = 144 * 1024;

typedef const Params __attribute__((address_space(4))) * KArgPtr;
__device__ __forceinline__ Params load_params(KArgPtr k) {
  Params q;
#if defined(__HIP_DEVICE_COMPILE__)
  __builtin_memcpy(&q, k, sizeof(Params));
#endif
  return q;
}
#define PARAMS_PTR(pp) KArgPtr pp##_k = (KArgPtr)__builtin_amdgcn_kernarg_segment_ptr(); asm volatile("" : "+s"(pp##_k)); const Params pp##_v = load_params(pp##_k); const Params* pp = &pp##_v
__global__ __launch_bounds__(512, 2) void k_mega(Params p_unused) {
  extern __shared__ __attribute__((aligned(16))) unsigned char shm[];
  const int bid = blockIdx.x, nblk = gridDim.x;
  volatile LAS unsigned* xst = (volatile LAS unsigned*)(LAS unsigned char*)(shm + LDS_BYTES - 16);
  if (threadIdx.x == 0) { xst[0] = 0u; xst[1] = 0u; }
  __syncthreads();
  XcdBarrier xb;
  { PARAMS_PTR(pp); xb = xcd_barrier_post((unsigned*)(pp->ws + WS_CTL), xst); }
#ifndef REP_PHASE
#define REP_PHASE -1
#endif
#define NREP(k) ((REP_PHASE == (k)) ? 2 : 1)
#ifndef REP_ALL
#define REP_ALL 1
#endif
#pragma unroll 1
  for (int pass = 0; pass < REP_ALL; ++pass) {
  if (pass) xcd_barrier(xb);
#pragma unroll 1
  for (int rep = 0; rep < NREP(0); ++rep) { { PARAMS_PTR(pp); phase0(*pp, (float*)shm, bid, nblk); } if (rep + 1 < NREP(0)) xcd_barrier(xb); }
  xcd_barrier(xb);
#pragma unroll 1
  for (int rep = 0; rep < NREP(1); ++rep) { { PARAMS_PTR(pp); phase1(*pp, shm, bid, nblk); } xcd_barrier(xb); }
#pragma unroll 1
  for (int rep = 0; rep < NREP(2); ++rep) { { PARAMS_PTR(pp); phase2(*pp, shm, bid, nblk); } xcd_barrier(xb); }
#pragma unroll 1
  for (int rep = 0; rep < NREP(7); ++rep) { { PARAMS_PTR(pp); phase_scan(*pp, bid, nblk); } xcd_barrier(xb); }
#pragma unroll 1
  for (int rep = 0; rep < NREP(3); ++rep) { { PARAMS_PTR(pp); phase3(*pp, shm, bid, nblk); } xcd_barrier(xb); }
#pragma unroll 1
  for (int rep = 0; rep < NREP(4); ++rep) { { PARAMS_PTR(pp); phase4(*pp, shm, bid, nblk); } xcd_barrier(xb); }
#pragma unroll 1
  for (int rep = 0; rep < NREP(5); ++rep) { { PARAMS_PTR(pp); phase5(*pp, shm, bid, nblk); } xcd_barrier(xb); }
#pragma unroll 1
  for (int rep = 0; rep < NREP(6); ++rep) { { PARAMS_PTR(pp); phase6(*pp, shm, bid, nblk); } if (rep + 1 < NREP(6)) xcd_barrier(xb); }
  }
}

}

extern "C" void kernel_launch(void* const* d_in, const int* in_sizes, int n_in, void* d_out, int out_size, void* d_ws,
                              size_t ws_size, hipStream_t stream) {
  Params p{};
  p.x = (const float*)d_in[0]; p.meta = (const float*)d_in[1]; p.rel_bias = (const float*)d_in[2];
  p.ln_mix = (const float*)d_in[3]; p.w_in = (const float*)d_in[4]; p.sinks = (const float*)d_in[5];
  p.conv_w = (const float*)d_in[6]; p.conv_b = (const float*)d_in[7]; p.dt_bias = (const float*)d_in[8];
  p.a_log = (const float*)d_in[9]; p.d_skip = (const float*)d_in[10]; p.attn_norm_w = (const float*)d_in[11];
  p.ssm_norm_w = (const float*)d_in[12]; p.w_out = (const float*)d_in[13]; p.ln_ffn = (const float*)d_in[14];
  p.wq = (const float*)d_in[15]; p.keys = (const float*)d_in[16]; p.U = (const float*)d_in[17];
  p.V = (const float*)d_in[18]; p.ln_final = (const float*)d_in[19];
  p.out = (float*)d_out;
  p.ws = (unsigned char*)d_ws;

  static int grid_blocks = 0;
  if (!grid_blocks) {
    int dev = 0, cus = 0, per_cu = 0;
    (void)hipGetDevice(&dev);
    (void)hipDeviceGetAttribute(&cus, hipDeviceAttributeMultiprocessorCount, dev);
    (void)hipFuncSetAttribute((const void*)k_mega, hipFuncAttributeMaxDynamicSharedMemorySize, LDS_BYTES);
    (void)hipOccupancyMaxActiveBlocksPerMultiprocessor(&per_cu, (const void*)k_mega, NTHREADS, LDS_BYTES);
    if (per_cu > 1) per_cu = 1;
    grid_blocks = cus * per_cu;
    if (grid_blocks != 256) fprintf(stderr, "kernel_launch: expected a 256-workgroup resident grid, got %d (cus %d, per_cu %d)\n", grid_blocks, cus, per_cu);
  }
  (void)hipMemsetAsync(p.ws + WS_CTL, 0, XCD_BAR_WORDS * 4, stream);
  void* args[] = {&p};
  hipError_t e = hipLaunchCooperativeKernel((const void*)k_mega, dim3(grid_blocks), dim3(NTHREADS), args, LDS_BYTES, stream);
  if (e != hipSuccess) fprintf(stderr, "cooperative launch failed: %s (grid %d)\n", hipGetErrorString(e), grid_blocks);
}
```

```cpp
#include <hip/hip_runtime.h>
#include <math.h>
#include <stdio.h>
#include <stdint.h>

#ifndef REP_SUB
#define REP_SUB -1
#endif
namespace {
constexpr int BATCH = 4, SEQ = 2048, DM = 2048, NMETA = 16;
constexpr int T = BATCH * SEQ;
constexpr int TA = T + NMETA;
constexpr int DPROJ = 4112;
constexpr int NPROJ = 4096;
constexpr int OFF_Q = 0, OFF_K = 1024, OFF_V = 1280, OFF_Z = 1536, OFF_XBC = 2560, OFF_DT = 4096;
constexpr int D_XBC = 1536;
constexpr int NEXP = 16384;
constexpr int ROW4 = 1024;
constexpr int ROW6 = 1536;
constexpr float EPS = 1e-6f;
constexpr int NTHREADS = 512;

typedef unsigned short bf16_t;
typedef short bf16x8 __attribute__((ext_vector_type(8)));
typedef float f32x4 __attribute__((ext_vector_type(4)));
typedef float f32x2 __attribute__((ext_vector_type(2)));
typedef unsigned u32x4 __attribute__((ext_vector_type(4)));
typedef unsigned u32x2 __attribute__((ext_vector_type(2)));
typedef __bf16 bf16v2 __attribute__((ext_vector_type(2)));
typedef float f32x16v __attribute__((ext_vector_type(16)));
typedef float f32x32v __attribute__((ext_vector_type(32)));
typedef float f32x16 __attribute__((ext_vector_type(16)));
typedef int i32x8 __attribute__((ext_vector_type(8)));
typedef unsigned u32x6 __attribute__((ext_vector_type(6)));
#define LAS __attribute__((address_space(3)))

__device__ __forceinline__ unsigned pack_bf16(float lo, float hi) {
  f32x2 v = {lo, hi};
  bf16v2 b = __builtin_convertvector(v, bf16v2);
  return *(unsigned*)&b;
}
__device__ __forceinline__ bf16_t f2bf(float f) { return (bf16_t)(pack_bf16(f, 0.f) & 0xffffu); }
__device__ __forceinline__ float bf2f(bf16_t b) { return __uint_as_float(((unsigned)b) << 16); }
__device__ __forceinline__ float bflo(unsigned u) { return __uint_as_float(u << 16); }
__device__ __forceinline__ float bfhi(unsigned u) { return __uint_as_float(u & 0xffff0000u); }

__constant__ unsigned char kBucket[128] = {
    0, 1, 2, 3, 4, 5, 6, 7, 8, 9, 10, 11, 12, 13, 14, 15, 16, 16, 16, 17, 17, 18, 18, 18, 19, 19, 19, 20, 20, 20, 20, 21,
    21, 21, 21, 22, 22, 22, 22, 22, 23, 23, 23, 23, 23, 23, 24, 24, 24, 24, 24, 24, 25, 25, 25, 25, 25, 25, 25, 26, 26, 26, 26, 26,
    26, 26, 26, 27, 27, 27, 27, 27, 27, 27, 27, 27, 27, 28, 28, 28, 28, 28, 28, 28, 28, 28, 28, 29, 29, 29, 29, 29, 29, 29, 29, 29,
    29, 29, 29, 30, 30, 30, 30, 30, 30, 30, 30, 30, 30, 30, 30, 30, 30, 31, 31, 31, 31, 31, 31, 31, 31, 31, 31, 31, 31, 31, 31, 31};

__constant__ unsigned char kCandI[64] = {0, 0, 0, 0, 0, 0, 0, 0, 0, 0, 0, 0, 0, 0, 0, 0, 1, 1, 1, 1, 1, 1, 1, 1, 2, 2, 2, 2, 2, 3, 3, 3, 3, 4, 4, 4, 5, 5, 6, 6, 7, 7, 8, 9, 10, 11, 12, 13, 14, 15, 15, 15, 15, 15, 15, 15, 15, 15, 15, 15, 15, 15, 15, 15};
__constant__ unsigned char kCandJ[64] = {0, 1, 2, 3, 4, 5, 6, 7, 8, 9, 10, 11, 12, 13, 14, 15, 0, 1, 2, 3, 4, 5, 6, 7, 0, 1, 2, 3, 4, 0, 1, 2, 3, 0, 1, 2, 0, 1, 0, 1, 0, 1, 0, 0, 0, 0, 0, 0, 0, 0, 15, 15, 15, 15, 15, 15, 15, 15, 15, 15, 15, 15, 15, 15};

__device__ __forceinline__ float wave_sum(float v) {
  for (int o = 32; o > 0; o >>= 1) v += __shfl_xor(v, o);
  return v;
}
__device__ __forceinline__ float wave_max(float v) {
  for (int o = 32; o > 0; o >>= 1) v = fmaxf(v, __shfl_xor(v, o));
  return v;
}
__device__ __forceinline__ float silu_f(float x) { return x / (1.f + expf(-x)); }
__device__ __forceinline__ float softplus_f(float x) { return fmaxf(x, 0.f) + log1pf(expf(-fabsf(x))); }

constexpr size_t al256(size_t x) { return (x + 255) & ~(size_t)255; }
constexpr size_t WS_CTL = 0;
constexpr size_t WS_WINT = 65536;
constexpr size_t WS_WDTT = WS_WINT + (size_t)NPROJ * DM * 2;
constexpr size_t WS_WOUTT = WS_WDTT + (size_t)16 * DM * 2;
constexpr size_t WS_WQT = WS_WOUTT + (size_t)DM * DM * 2;
constexpr size_t WS_KEYS = WS_WQT + (size_t)DM * DM * 2;
constexpr size_t WS_UB = WS_KEYS + (size_t)16 * 128 * 128 * 2;
constexpr size_t WS_VB = WS_UB + (size_t)NEXP * DM * 2;
constexpr size_t WS_HNB = WS_VB + (size_t)NEXP * DM * 2;
constexpr size_t WS_PROJ = WS_HNB + (size_t)(T + 16) * DM * 2;
constexpr size_t WS_DTRAW = WS_PROJ + (size_t)T * NPROJ * 2;
constexpr size_t WS_PROJM = WS_DTRAW + (size_t)T * 16 * 4;
constexpr size_t WS_PROJMB = al256(WS_PROJM + (size_t)16 * DPROJ * 4);
constexpr size_t WS_H1B = al256(WS_PROJMB + (size_t)16 * DPROJ * 2);
constexpr size_t WS_SSQH1 = WS_H1B + (size_t)T * DM * 2;
constexpr size_t WS_STOP = al256(WS_SSQH1 + (size_t)T * 32 * 4);
constexpr size_t WS_ITOP = WS_STOP + (size_t)T * 256 * 4;
constexpr size_t WS_ACSG = al256(WS_ITOP + (size_t)T * 256 * 4);
constexpr size_t WS_CCB = WS_ACSG + (size_t)T * 16 * 4;
constexpr size_t WS_YPART = WS_CCB + (size_t)T * 256 * 2;
constexpr size_t WS_SG = WS_YPART + (size_t)T * 1024 * 4;
constexpr size_t WS_SMETA = WS_SG + (size_t)1024 * 8192 * 4;
constexpr size_t WS_HPREV = al256(WS_SMETA + (size_t)16 * 8192 * 4);
constexpr size_t WS_USC = al256(WS_HPREV + (size_t)1024 * 8192 * 2);
constexpr size_t WS_VSC = WS_USC + (size_t)NEXP * 4;
constexpr size_t WS_SCR = al256(WS_VSC + (size_t)NEXP * 4);
}

namespace pg8 {
#define PG8_LAS __attribute__((address_space(3)))
constexpr int BM = 256, BK = 64, HALF = 128, HTB = HALF * BK * 2, STAGE_BYTES = 8 * HTB, NXCD = 8, WGM = 8;
__host__ __device__ __forceinline__ int lds_byte(int r, int c) { const int st = (r >> 4) * 2 + (c >> 5), rr = r & 15, cc = c & 31, ob = rr * 64 + cc * 2; return st * 1024 + (ob ^ (((ob >> 9) & 1) << 5)); }
__host__ __device__ __forceinline__ void stage_rc(int b, int& R, int& C) { const int st = b / 1024, sb = b % 1024, swz = sb ^ (((sb >> 9) & 1) << 5); R = (st >> 1) * 16 + swz / 64; C = (st & 1) * 32 + (swz % 64) / 2; }
__host__ __device__ __forceinline__ int perm32(int rho) { const int n = rho >> 4, i = rho & 15; return 8 * (i >> 2) + 4 * n + (i & 3); }
struct Unit { int pm, pn; };
struct Gemm { const bf16_t* A; const bf16_t* Bt; int M, N, K; };
struct StaticOrder {
    int nM, nN, nwg, G, c;
    __host__ __device__ void init(int M, int N, int G_, int c_) { nM = M / BM; nN = N / BM; nwg = nM * nN; G = G_; c = c_; }
    __host__ __device__ bool next(int i, Unit& u) const {
        const long L = (long)i * G + c; if (L >= nwg) return false;
        int wgid = (int)L; { const int q = nwg / NXCD, r = nwg % NXCD, xcd = wgid % NXCD, off = wgid / NXCD; wgid = (xcd < r ? xcd * (q + 1) : r * (q + 1) + (xcd - r) * q) + off; }
        const int nig = WGM * nN, gid = wgid / nig, fm = gid * WGM, gsz = (nM - fm) < WGM ? (nM - fm) : WGM;
        u.pm = fm + ((wgid % nig) % gsz); u.pn = (wgid % nig) / gsz; return true;
    }
    __device__ __forceinline__ void a_ready(const Unit&) const {}
    __device__ __forceinline__ void done(const Unit&) const {}
};
struct EpiBf16 {
    static constexpr bool PERM = true, AFTER_DRAIN = false;
    bf16_t* O; int ldc;
    __device__ __forceinline__ void operator()(const f32x4 (&acc)[2][2][4][2], const Unit& u, int wr, int wc, int fr, int fq) const {
        const int row0 = u.pm * BM + wr * 64 + fr; const int col0 = u.pn * BM + wc * 32 + 8 * fq;
        const __amdgpu_buffer_rsrc_t rsrc = __builtin_amdgcn_make_buffer_rsrc(O, 0, 0x7fffffff, 0x00020000);
#pragma unroll
        for (int ai = 0; ai < 2; ++ai)
#pragma unroll
            for (int m = 0; m < 4; ++m) { const unsigned boff = (unsigned)(((size_t)(row0 + ai * HALF + m * 16) * ldc + col0) * 2);
#pragma unroll
                for (int bj = 0; bj < 2; ++bj) { const f32x4 v0 = acc[ai][bj][m][0], v1 = acc[ai][bj][m][1];
                    u32x4 w; w.x = pack_bf16(v0[0], v0[1]); w.y = pack_bf16(v0[2], v0[3]); w.z = pack_bf16(v1[0], v1[1]); w.w = pack_bf16(v1[2], v1[3]);
                    __builtin_amdgcn_raw_buffer_store_b128(w, rsrc, boff + bj * HALF * 2, 0, 16); } }
    }
};

struct EpiRes {
    static constexpr bool PERM = true, AFTER_DRAIN = false;
    const float* X; bf16_t* HB; float* SSQ;
    __device__ __forceinline__ void operator()(const f32x4 (&acc)[2][2][4][2], const Unit& u, int wr, int wc, int fr, int fq) const {
        const int row0 = u.pm * BM + wr * 64 + fr; const int col0 = u.pn * BM + wc * 32 + 8 * fq;
#pragma unroll
        for (int ai = 0; ai < 2; ++ai) {
            f32x4 xr[4][2][2];
#pragma unroll
            for (int m = 0; m < 4; ++m) { const size_t off = (size_t)(row0 + ai * HALF + m * 16) * DM + col0;
#pragma unroll
                for (int bj = 0; bj < 2; ++bj) { xr[m][bj][0] = __builtin_nontemporal_load((const f32x4*)(X + off + bj * HALF)); xr[m][bj][1] = __builtin_nontemporal_load((const f32x4*)(X + off + bj * HALF + 4)); } }
#pragma unroll
            for (int m = 0; m < 4; ++m) { const int row = row0 + ai * HALF + m * 16; const size_t off = (size_t)row * DM + col0; float ss = 0.f;
#pragma unroll
                for (int bj = 0; bj < 2; ++bj) {
                    const f32x4 v0 = acc[ai][bj][m][0] + xr[m][bj][0], v1 = acc[ai][bj][m][1] + xr[m][bj][1];
                    u32x4 w; w.x = pack_bf16(v0[0], v0[1]); w.y = pack_bf16(v0[2], v0[3]); w.z = pack_bf16(v1[0], v1[1]); w.w = pack_bf16(v1[2], v1[3]);
                    *(u32x4*)(HB + off + bj * HALF) = w;
                    ss += v0[0] * v0[0] + v0[1] * v0[1] + v0[2] * v0[2] + v0[3] * v0[3] + v1[0] * v1[0] + v1[1] * v1[1] + v1[2] * v1[2] + v1[3] * v1[3]; }
                ss += __shfl_xor(ss, 16); ss += __shfl_xor(ss, 32);
                if (fq == 0) SSQ[(size_t)row * 32 + u.pn * 4 + wc] = ss; }
        }
    }
};
struct EpiF32 {
    static constexpr bool PERM = true, AFTER_DRAIN = false;
    float* C; int ldc;
    __device__ __forceinline__ void operator()(const f32x4 (&acc)[2][2][4][2], const Unit& u, int wr, int wc, int fr, int fq) const {
        const int row0 = u.pm * BM + wr * 64 + fr; const int col0 = u.pn * BM + wc * 32 + 8 * fq;
#pragma unroll
        for (int ai = 0; ai < 2; ++ai)
#pragma unroll
            for (int m = 0; m < 4; ++m) { float* rowp = C + (size_t)(row0 + ai * HALF + m * 16) * ldc + col0;
#pragma unroll
                for (int bj = 0; bj < 2; ++bj) { *(f32x4*)(rowp + bj * HALF) = acc[ai][bj][m][0]; *(f32x4*)(rowp + bj * HALF + 4) = acc[ai][bj][m][1]; } }
    }
};

struct EpiScores {
    static constexpr bool PERM = true, AFTER_DRAIN = true;
    const bf16_t* KEYS;
    float* STOP; int* ITOP;
    static constexpr int QLD = 264;
    __device__ __forceinline__ void fused(f32x4 (&acc)[2][2][4][2], const Unit& u, int wr, int wc, int fr, int fq, PG8_LAS unsigned char* lds, int wid, int lane) const {
        PG8_LAS bf16_t* Q = (PG8_LAS bf16_t*)lds;
#pragma unroll
        for (int ai = 0; ai < 2; ++ai)
#pragma unroll
            for (int m = 0; m < 4; ++m) { const int row = ai * HALF + wr * 64 + m * 16 + fr;
#pragma unroll
                for (int bj = 0; bj < 2; ++bj) { const f32x4 v0 = acc[ai][bj][m][0], v1 = acc[ai][bj][m][1];
                    u32x4 w; w.x = pack_bf16(v0[0], v0[1]); w.y = pack_bf16(v0[2], v0[3]); w.z = pack_bf16(v1[0], v1[1]); w.w = pack_bf16(v1[2], v1[3]);
                    *(PG8_LAS u32x4*)(Q + row * QLD + bj * HALF + wc * 32 + 8 * fq) = w; } }
        __syncthreads();
        const int h = u.pn;
#pragma unroll 1
        for (int c = 0; c < 2; ++c) {
            f32x4 sc[8][2];
#pragma unroll
            for (int kf = 0; kf < 8; ++kf) { sc[kf][0] = (f32x4){0.f, 0.f, 0.f, 0.f}; sc[kf][1] = (f32x4){0.f, 0.f, 0.f, 0.f}; }
            const bf16_t* kb = KEYS + (size_t)((h * 2 + c) * 128 + fr) * 128 + 8 * fq;
            const PG8_LAS bf16_t* qb = Q + (wid * 32 + fr) * QLD + c * 128 + 8 * fq;
#pragma unroll
            for (int ks = 0; ks < 4; ++ks) {
                const bf16x8 q0 = *(const PG8_LAS bf16x8*)(qb + 32 * ks), q1 = *(const PG8_LAS bf16x8*)(qb + 16 * QLD + 32 * ks);
#pragma unroll
                for (int kf = 0; kf < 8; ++kf) { const bf16x8 kv = *(const bf16x8*)(kb + (size_t)kf * 16 * 128 + 32 * ks);
                    sc[kf][0] = __builtin_amdgcn_mfma_f32_16x16x32_bf16(kv, q0, sc[kf][0], 0, 0, 0);
                    sc[kf][1] = __builtin_amdgcn_mfma_f32_16x16x32_bf16(kv, q1, sc[kf][1], 0, 0, 0); }
            }
#pragma unroll
            for (int tf = 0; tf < 2; ++tf) {
                int v[32];
#pragma unroll
                for (int kf = 0; kf < 8; ++kf)
#pragma unroll
                    for (int r = 0; r < 4; ++r) {
                        const int bts = (int)__float_as_uint(sc[kf][tf][r]);
                        const int srt = bts ^ ((bts >> 31) & 0x7fffffff);
                        v[kf * 4 + r] = (srt & ~127) | (16 * kf + 4 * fq + r);
                    }
#pragma unroll
                for (int k = 2; k <= 32; k <<= 1)
#pragma unroll
                    for (int j = k >> 1; j > 0; j >>= 1)
#pragma unroll
                        for (int i = 0; i < 32; ++i) {
                            const int l = i ^ j;
                            if (l > i) {
                                const int x = v[i], y = v[l];
                                const int hi_ = x > y ? x : y, lo_ = x > y ? y : x;
                                if ((i & k) == 0) { v[i] = hi_; v[l] = lo_; } else { v[i] = lo_; v[l] = hi_; }
                            }
                        }
#pragma unroll
                for (int step = 0; step < 2; ++step) {
                    const int xm = step == 0 ? 16 : 32;
                    int m[16];
#pragma unroll
                    for (int i = 0; i < 16; ++i) { const int o = __shfl_xor(v[15 - i], xm); m[i] = v[i] > o ? v[i] : o; }
#pragma unroll
                    for (int j = 8; j > 0; j >>= 1)
#pragma unroll
                        for (int i = 0; i < 16; ++i) {
                            const int l = i ^ j;
                            if (l > i) { const int x = m[i], y = m[l]; m[i] = x > y ? x : y; m[l] = x > y ? y : x; }
                        }
#pragma unroll
                    for (int i = 0; i < 16; ++i) v[i] = m[i];
                }
                if (fq == 0) {
                    const size_t obase = ((size_t)(u.pm * BM + wid * 32 + tf * 16 + fr) * 16 + h * 2 + c) * 16;
#pragma unroll
                    for (int q4 = 0; q4 < 4; ++q4) {
                        f32x4 sv; u32x4 iv;
#pragma unroll
                        for (int i = 0; i < 4; ++i) {
                            const int key = v[4 * q4 + i], srt = key & ~127;
                            sv[i] = __uint_as_float((unsigned)(srt ^ ((srt >> 31) & 0x7fffffff)));
                            iv[i] = (unsigned)(key & 127);
                        }
                        *(f32x4*)(STOP + obase + 4 * q4) = sv;
                        *(u32x4*)(ITOP + obase + 4 * q4) = iv;
                    }
                }
            }
        }
    }
};

template <class Epi, class Sched>
__device__ __forceinline__ void gemm_phase(PG8_LAS unsigned char* lds, const Gemm g, const Sched& S, const Epi& E) {
    int tid_ = threadIdx.x; asm volatile("" : "+v"(tid_));
    const int tid = tid_, wid = __builtin_amdgcn_readfirstlane(tid >> 6), lane = tid & 63, wr = wid >> 2, wc = wid & 3, fr = lane & 15, fq = lane >> 4;
    const int K = g.K, nt = K / BK;
    unsigned voffA[2], voffB[2];
#pragma unroll
    for (int i = 0; i < 2; ++i) { int R, C; stage_rc(tid * 16 + i * 8192, R, C); const int Rb = Epi::PERM ? ((R & ~31) + perm32(R & 31)) : R;
        voffA[i] = (unsigned)(R * K + C) * 2u; voffB[i] = (unsigned)(Rb * K + C) * 2u; }
    const size_t kstep = (size_t)(BK * 2);
    const size_t hstep = (size_t)HALF * K * 2;
    const size_t tstep = 2 * hstep;
    const unsigned ldsw = (unsigned)wid * 1024u;
    const int aoff = lds_byte(wr * 64 + fr, fq * 8), boff = lds_byte(wc * 32 + fr, fq * 8);
#define PG8_SA(b, h) (((b) * 2 + (h)) * HTB)
#define PG8_SB(b, h) ((4 + (b) * 2 + (h)) * HTB)
#define PG8_STAGE(bufoff, gbase, voff) do { _Pragma("unroll") for (int _i = 0; _i < 2; ++_i) \
        __builtin_amdgcn_global_load_lds((const unsigned*)((const char*)(gbase) + (voff)[_i]), (PG8_LAS unsigned*)(lds + (bufoff) + ldsw + _i * 8192), 16, 0, 0); } while (0)
#define PG8_LDA(dst, b, h) do { _Pragma("unroll") for (int m = 0; m < 4; ++m) _Pragma("unroll") for (int k = 0; k < 2; ++k) dst[m][k] = *(const PG8_LAS bf16x8*)(lds + PG8_SA(b, h) + aoff + m * 2048 + k * 1024); } while (0)
#define PG8_LDB(dst, b, h) do { _Pragma("unroll") for (int n = 0; n < 2; ++n) _Pragma("unroll") for (int k = 0; k < 2; ++k) dst[n][k] = *(const PG8_LAS bf16x8*)(lds + PG8_SB(b, h) + boff + n * 2048 + k * 1024); } while (0)
#define PG8_MMA(ai, bj, At, Bt) do { __builtin_amdgcn_s_setprio(1); _Pragma("unroll") for (int m = 0; m < 4; ++m) _Pragma("unroll") for (int n = 0; n < 2; ++n) _Pragma("unroll") for (int k = 0; k < 2; ++k) \
        acc[ai][bj][m][n] = __builtin_amdgcn_mfma_f32_16x16x32_bf16(Bt[n][k], At[m][k], acc[ai][bj][m][n], 0, 0, 0); __builtin_amdgcn_s_setprio(0); } while (0)
#define PG8_WAIT_V(n) asm volatile("s_waitcnt vmcnt(" #n ")" ::: "memory")
#define PG8_WAIT_L(n) asm volatile("s_waitcnt lgkmcnt(" #n ")" ::: "memory")
#define PG8_BAR __builtin_amdgcn_s_barrier()
#define PG8_SCHED __builtin_amdgcn_sched_barrier(0)
    Unit cur, nxt; int ui = 0;
    if (!S.next(0, cur)) return;
    f32x4 acc[2][2][4][2];
#pragma unroll
    for (int a = 0; a < 2; ++a)
#pragma unroll
        for (int b = 0; b < 2; ++b)
#pragma unroll
            for (int m = 0; m < 4; ++m)
#pragma unroll
                for (int n = 0; n < 2; ++n) acc[a][b][m][n] = (f32x4){0.f, 0.f, 0.f, 0.f};
    bf16x8 At[4][2], B0[2][2], B1[2][2];
    const char* cA = (const char*)g.A + (size_t)cur.pm * tstep; const char* cB = (const char*)g.Bt + (size_t)cur.pn * tstep;
    S.a_ready(cur);
    PG8_STAGE(PG8_SB(0, 0), cB, voffB); PG8_STAGE(PG8_SA(0, 0), cA, voffA); PG8_STAGE(PG8_SB(0, 1), cB + hstep, voffB); PG8_STAGE(PG8_SA(0, 1), cA + hstep, voffA);
    if (wr == 1) PG8_BAR;
    PG8_WAIT_V(4); PG8_BAR;
    PG8_STAGE(PG8_SB(1, 0), cB + kstep, voffB); PG8_STAGE(PG8_SA(1, 0), cA + kstep, voffA); PG8_STAGE(PG8_SB(1, 1), cB + hstep + kstep, voffB);
    PG8_WAIT_V(6); PG8_BAR;
    for (;;) {
        const bool has_next = S.next(ui + 1, nxt);
        const char* nA = has_next ? (const char*)g.A + (size_t)nxt.pm * tstep : cA; const char* nB = has_next ? (const char*)g.Bt + (size_t)nxt.pn * tstep : cB;
        for (int t = 0; t < nt; t += 2) {
            const bool last = (t == nt - 2);
            const char* a1 = cA + (size_t)(t + 1) * kstep;
            const char* a2 = last ? nA : cA + (size_t)(t + 2) * kstep; const char* b2 = last ? nB : cB + (size_t)(t + 2) * kstep;
            const char* a3 = a2 + kstep; const char* b3 = b2 + kstep;
            if (last && has_next) S.a_ready(nxt);
            PG8_LDB(B0, 0, 0); PG8_SCHED; PG8_LDA(At, 0, 0); PG8_STAGE(PG8_SA(1, 1), a1 + hstep, voffA);
            PG8_WAIT_L(8); PG8_BAR; PG8_WAIT_L(0); PG8_MMA(0, 0, At, B0); PG8_BAR; PG8_SCHED;
            PG8_LDB(B1, 0, 1); PG8_STAGE(PG8_SB(0, 0), b2, voffB);
            PG8_BAR; PG8_WAIT_L(0); PG8_MMA(0, 1, At, B1); PG8_BAR;
            PG8_LDA(At, 0, 1); PG8_STAGE(PG8_SA(0, 0), a2, voffA);
            PG8_BAR; PG8_WAIT_L(0); PG8_MMA(1, 0, At, B0); PG8_BAR; PG8_SCHED;
            PG8_STAGE(PG8_SB(0, 1), b2 + hstep, voffB);
            PG8_WAIT_V(6); PG8_BAR; PG8_MMA(1, 1, At, B1); PG8_BAR;
            PG8_LDB(B0, 1, 0); PG8_SCHED; PG8_LDA(At, 1, 0); PG8_STAGE(PG8_SA(0, 1), a2 + hstep, voffA);
            PG8_WAIT_L(8); PG8_BAR; PG8_WAIT_L(0); PG8_MMA(0, 0, At, B0); PG8_BAR; PG8_SCHED;
            PG8_LDB(B1, 1, 1); PG8_STAGE(PG8_SB(1, 0), b3, voffB);
            PG8_BAR; PG8_WAIT_L(0); PG8_MMA(0, 1, At, B1); PG8_BAR;
            PG8_LDA(At, 1, 1); PG8_STAGE(PG8_SA(1, 0), a3, voffA);
            PG8_BAR; PG8_WAIT_L(0); PG8_MMA(1, 0, At, B0); PG8_BAR; PG8_SCHED;
            PG8_STAGE(PG8_SB(1, 1), b3 + hstep, voffB);
            PG8_WAIT_V(6); PG8_BAR; PG8_MMA(1, 1, At, B1); PG8_BAR;
        }
        if constexpr (!Epi::AFTER_DRAIN) { E(acc, cur, wr, wc, fr, fq); S.done(cur); }
        if (!has_next) break;
#pragma unroll
        for (int a = 0; a < 2; ++a)
#pragma unroll
            for (int b = 0; b < 2; ++b)
#pragma unroll
                for (int m = 0; m < 4; ++m)
#pragma unroll
                    for (int n = 0; n < 2; ++n) acc[a][b][m][n] = (f32x4){0.f, 0.f, 0.f, 0.f};
        cur = nxt; cA = nA; cB = nB; ++ui;
    }
    PG8_WAIT_V(0);
    if (wr == 0) PG8_BAR;
    PG8_BAR;
    if constexpr (Epi::AFTER_DRAIN) { E.fused(acc, cur, wr, wc, fr, fq, lds, wid, lane); S.done(cur); }
#undef PG8_SA
#undef PG8_SB
#undef PG8_STAGE
#undef PG8_LDA
#undef PG8_LDB
#undef PG8_MMA
#undef PG8_WAIT_V
#undef PG8_WAIT_L
#undef PG8_BAR
#undef PG8_SCHED
}
}

#define XB_TMO      128
#define XB_XCNT(j)  (256  + 64 * (j))
#define XB_XSUB(j)  (1280 + 64 * (j))
#define XB_XGEN(j)  (2304 + 64 * (j))
#define XB_TOP      3328
#define XB_TOPGEN   3392
#define XCD_BAR_WORDS 3456
#define XB_SPIN_CAP (1u << 22)
__device__ __forceinline__ unsigned xb_ld(unsigned* p)              { return __hip_atomic_load(p, __ATOMIC_RELAXED, __HIP_MEMORY_SCOPE_AGENT); }
__device__ __forceinline__ unsigned xb_add(unsigned* p, unsigned v) { return __hip_atomic_fetch_add(p, v, __ATOMIC_RELAXED, __HIP_MEMORY_SCOPE_AGENT); }
__device__ __forceinline__ unsigned xb_xcc_id() { return (unsigned)__builtin_amdgcn_s_getreg((3 << 11) | 20) & 0xFu; }
#define XB_SPIN(cond, bar) do { unsigned _sp = 0; while (cond) { __builtin_amdgcn_s_sleep(1); \
    if ((++_sp & 255u) == 0u) { if (xb_ld(&(bar)[XB_TMO])) break; if (_sp > XB_SPIN_CAP) { atomicAdd(&(bar)[XB_TMO], 1u); break; } } } } while (0)
struct XcdBarrier { unsigned* bar; unsigned x; volatile LAS unsigned* st; };
__device__ __forceinline__ XcdBarrier xcd_barrier_post(unsigned* bar, volatile LAS unsigned* st) {
    XcdBarrier b; b.bar = bar; b.x = xb_xcc_id(); b.st = st;
    if (threadIdx.x == 0) (void)xb_add(&bar[XB_XCNT(b.x)], 1u);
    return b;
}
__device__ __forceinline__ void xcd_barrier_complete(unsigned* bar, unsigned x, unsigned& nloc, unsigned& nx) {
    const unsigned G = gridDim.x * gridDim.y * gridDim.z;
    unsigned sum, cnt, mine, sp = 0u;
    for (;;) {
        sum = 0u; cnt = 0u; mine = 0u;
#pragma unroll
        for (unsigned j = 0; j < 16; ++j) { const unsigned c = xb_ld(&bar[XB_XCNT(j)]); sum += c; cnt += (c > 0u) ? 1u : 0u; mine = (j == x) ? c : mine; }
        if (sum == G) break;
        __builtin_amdgcn_s_sleep(1);
        if ((++sp & 255u) == 0u) { if (xb_ld(&bar[XB_TMO])) break; if (sp > XB_SPIN_CAP) { atomicAdd(&bar[XB_TMO], 1u); break; } }
    }
    nloc = mine > 0u ? mine : 1u; nx = cnt > 0u ? cnt : 1u;
}
__device__ __forceinline__ void xcd_barrier(const XcdBarrier& b) {
    asm volatile("s_waitcnt vmcnt(0)" ::: "memory");
    __syncthreads();
    if (threadIdx.x == 0) {
        unsigned* bar = b.bar;
        const unsigned bx = xb_xcc_id();
        __builtin_amdgcn_s_waitcnt(0);
        unsigned nloc = b.st[0], nx = b.st[1];
        if (nloc == 0u) { xcd_barrier_complete(bar, bx, nloc, nx); b.st[0] = nloc; b.st[1] = nx; }
        const unsigned old = xb_add(&bar[XB_XSUB(bx)], 1u);
        const unsigned gen = old / nloc;
        if (old + 1u == (gen + 1u) * nloc) {
            __builtin_amdgcn_fence(__ATOMIC_RELEASE, "agent");
            asm volatile("s_waitcnt vmcnt(0)" ::: "memory");
            const unsigned og = xb_add(&bar[XB_TOP], 1u);
            const unsigned tg = og / nx;
            if (og + 1u == (tg + 1u) * nx) xb_add(&bar[XB_TOPGEN], 1u);
            else XB_SPIN(xb_ld(&bar[XB_TOPGEN]) == tg, bar);
            __builtin_amdgcn_fence(__ATOMIC_ACQUIRE, "agent");
            xb_add(&bar[XB_XGEN(bx)], 1u);
            asm volatile("s_waitcnt vmcnt(0)" ::: "memory");
        } else {
            XB_SPIN(xb_ld(&bar[XB_XGEN(bx)]) == gen, bar);
            __builtin_amdgcn_fence(__ATOMIC_ACQUIRE, "agent");
            asm volatile("s_waitcnt vmcnt(0)" ::: "memory");
        }
    }
    __syncthreads();
}

namespace {
struct Params {
  const float *x, *meta, *rel_bias, *ln_mix, *w_in, *sinks, *conv_w, *conv_b, *dt_bias, *a_log, *d_skip, *attn_norm_w,
      *ssm_norm_w, *w_out, *ln_ffn, *wq, *keys, *U, *V, *ln_final;
  float* out;
  unsigned char* ws;
};

__device__ __forceinline__ void p0_transpose_tile(const float* __restrict__ W, int ldw, bf16_t* __restrict__ Wt, const float* sc0,
                                                  const float* sc1, int k0, int n0, float* tile) {
  int tid = threadIdx.x; asm volatile("" : "+v"(tid));
  {
    const int r = tid >> 6, c4 = (tid & 63) * 4;
    f32x4 v[8];
#pragma unroll
    for (int i = 0; i < 8; ++i) v[i] = __builtin_nontemporal_load((const f32x4*)(W + (size_t)(k0 + r + 8 * i) * ldw + n0 + c4));
#pragma unroll
    for (int i = 0; i < 8; ++i) {
      float s = 1.f;
      const int k = k0 + r + 8 * i;
      if (sc0) s = k < 1024 ? sc0[k] : sc1[k - 1024];
      float* q = tile + (r + 8 * i) * 257 + c4;
      q[0] = v[i][0] * s; q[1] = v[i][1] * s; q[2] = v[i][2] * s; q[3] = v[i][3] * s;
    }
  }
  __syncthreads();
#pragma unroll
  for (int it = 0; it < 4; ++it) {
    const int task = it * NTHREADS + tid;
    const int n = task >> 3, kc = (task & 7) * 8;
    float v[8];
#pragma unroll
    for (int j = 0; j < 8; ++j) v[j] = tile[(kc + j) * 257 + n];
    u32x4 w; w.x = pack_bf16(v[0], v[1]); w.y = pack_bf16(v[2], v[3]); w.z = pack_bf16(v[4], v[5]); w.w = pack_bf16(v[6], v[7]);
    *(u32x4*)(Wt + (size_t)(n0 + n) * DM + k0 + kc) = w;
  }
  __syncthreads();
}

__device__ __forceinline__ void phase0(const Params& p, float* ldsf, int bid, int nblk) {
  int tid = threadIdx.x; asm volatile("" : "+v"(tid));
  const int lane = tid & 63, wid = tid >> 6;
  bf16_t* w_inT = (bf16_t*)(p.ws + WS_WINT);
  bf16_t* w_dtT = (bf16_t*)(p.ws + WS_WDTT);
  bf16_t* w_outT = (bf16_t*)(p.ws + WS_WOUTT);
  bf16_t* wqT = (bf16_t*)(p.ws + WS_WQT);
  bf16_t* keysb = (bf16_t*)(p.ws + WS_KEYS);
  unsigned char* ub = p.ws + WS_UB;
  unsigned char* vb = p.ws + WS_VB;
  bf16_t* hnb = (bf16_t*)(p.ws + WS_HNB);
  constexpr int U_HN = (TA + 7) / 8;
  constexpr int U_WIN = 32 * 16, U_WOUT = 32 * 8, U_WQ = 32 * 8, U_WDT = 1, U_KEYS = 64;
  constexpr int B_WIN = U_HN, B_WOUT = B_WIN + U_WIN, B_WQ = B_WOUT + U_WOUT, B_WDT = B_WQ + U_WQ, B_KEYS = B_WDT + U_WDT,
                B_U = B_KEYS + U_KEYS, B_END = B_U;
  for (int u = bid; u < B_END; u += nblk) {
    if (u < B_WIN) {
      const int t = u * 8 + wid;
      if (t < TA) {
        const float* src = t < T ? p.x + (size_t)t * DM : p.meta + (size_t)(t - T) * DM;
        float4 v[8];
        float ss = 0.f;
#pragma unroll
        for (int i = 0; i < 8; ++i) {
          { const f32x4 q_ = __builtin_nontemporal_load((const f32x4*)(src + (i * 64 + lane) * 4)); v[i].x = q_[0]; v[i].y = q_[1]; v[i].z = q_[2]; v[i].w = q_[3]; }
          ss += v[i].x * v[i].x + v[i].y * v[i].y + v[i].z * v[i].z + v[i].w * v[i].w;
        }
        ss = wave_sum(ss);
        const float r = rsqrtf(ss * (1.f / DM) + EPS);
#pragma unroll
        for (int i = 0; i < 8; ++i) {
          const float4 w = *(const float4*)(p.ln_mix + (i * 64 + lane) * 4);
          u32x2 o; o.x = pack_bf16(v[i].x * r * w.x, v[i].y * r * w.y); o.y = pack_bf16(v[i].z * r * w.z, v[i].w * r * w.w);
          *(u32x2*)(hnb + (size_t)t * DM + (i * 64 + lane) * 4) = o;
        }
      }
    } else if (u < B_WOUT) {
      const int i = u - B_WIN;
      p0_transpose_tile(p.w_in, DPROJ, w_inT, nullptr, nullptr, (i & 31) * 64, (i >> 5) * 256, ldsf);
    } else if (u < B_WQ) {
      const int i = u - B_WOUT;
      p0_transpose_tile(p.w_out, DM, w_outT, p.attn_norm_w, p.ssm_norm_w, (i & 31) * 64, (i >> 5) * 256, ldsf);
    } else if (u < B_WDT) {
      const int i = u - B_WQ;
      p0_transpose_tile(p.wq, DM, wqT, p.ln_ffn, p.ln_ffn + 1024, (i & 31) * 64, (i >> 5) * 256, ldsf);
    } else if (u < B_KEYS) {
      for (int idx = tid; idx < DM * 16; idx += NTHREADS) {
        const int k = idx >> 4, j = idx & 15;
        w_dtT[(size_t)j * DM + k] = f2bf(p.w_in[(size_t)k * DPROJ + NPROJ + j]);
      }
    } else if (u < B_U) {
      int tk = tid;
      asm volatile("" : "+v"(tk));
      const unsigned base = (unsigned)(u - B_KEYS) * 4096u + (unsigned)tk * 8u;
      const float4 a = *(const float4*)(p.keys + base), b = *(const float4*)(p.keys + base + 4);
      u32x4 w; w.x = pack_bf16(a.x, a.y); w.y = pack_bf16(a.z, a.w); w.z = pack_bf16(b.x, b.y); w.w = pack_bf16(b.z, b.w);
      *(u32x4*)(keysb + base) = w;
    }
  }
}

__device__ __forceinline__ void convert_tables(const Params& p, int bid, int nblk) {
  int tid = threadIdx.x; asm volatile("" : "+v"(tid));
  const int lane = tid & 63, wid = tid >> 6;
  unsigned char* ub = p.ws + WS_UB;
  unsigned char* vb = p.ws + WS_VB;
  {
    const int gw = bid * 8 + wid, nw = nblk * 8;
    auto load_row = [&](f32x4 (&a)[8], const int r2) __attribute__((always_inline)) {
      const float* src = (r2 < NEXP ? p.U + (size_t)r2 * DM : p.V + (size_t)(r2 - NEXP) * DM) + lane * 4;
#pragma unroll
      for (int j = 0; j < 8; ++j) a[j] = __builtin_nontemporal_load((const f32x4*)(src + 256 * j));
    };
    auto conv_row = [&](f32x4 (&a)[8], const int r2) __attribute__((always_inline)) {
      const bool isU = r2 < NEXP;
      const int row = isU ? r2 : r2 - NEXP;
      if (isU) {
#pragma unroll
        for (int j = 0; j < 8; ++j) a[j] *= *(const f32x4*)(p.ln_ffn + lane * 4 + 256 * j);
      }
      float amax = 0.f;
#pragma unroll
      for (int j = 0; j < 8; ++j) amax = fmaxf(amax, fmaxf(fmaxf(fabsf(a[j][0]), fabsf(a[j][1])), fmaxf(fabsf(a[j][2]), fabsf(a[j][3]))));
      amax = wave_max(amax);
      const float s4 = amax > 0.f ? 6.f / amax : 1.f;
      u32x4 w4;
#pragma unroll
      for (int j = 0; j < 4; ++j) {
        unsigned w = 0;
        w = __builtin_amdgcn_cvt_scalef32_pk_fp4_f32(w, a[2 * j][0] * s4, a[2 * j][1] * s4, 1.0f, 0);
        w = __builtin_amdgcn_cvt_scalef32_pk_fp4_f32(w, a[2 * j][2] * s4, a[2 * j][3] * s4, 1.0f, 1);
        w = __builtin_amdgcn_cvt_scalef32_pk_fp4_f32(w, a[2 * j + 1][0] * s4, a[2 * j + 1][1] * s4, 1.0f, 2);
        w = __builtin_amdgcn_cvt_scalef32_pk_fp4_f32(w, a[2 * j + 1][2] * s4, a[2 * j + 1][3] * s4, 1.0f, 3);
        w4[j] = w;
      }
      *(u32x4*)((isU ? ub : vb) + (size_t)row * ROW4 + lane * 16) = w4;
      if (lane == 0) ((float*)(p.ws + (isU ? WS_USC : WS_VSC)))[row] = amax > 0.f ? amax * (1.f / 6.f) : 1.f;
    };
    f32x4 ra[8], rb[8];
    int r2 = gw;
    if (r2 < 2 * NEXP) load_row(ra, r2);
#pragma unroll 1
    for (; r2 < 2 * NEXP; r2 += 2 * nw) {
      if (r2 + nw < 2 * NEXP) load_row(rb, r2 + nw);
      conv_row(ra, r2);
      if (r2 + nw < 2 * NEXP) {
        if (r2 + 2 * nw < 2 * NEXP) load_row(ra, r2 + 2 * nw);
        conv_row(rb, r2 + nw);
      }
    }
  }
}

__device__ __forceinline__ void mini_gemm(const bf16_t* __restrict__ A, const bf16_t* __restrict__ Bt, float* __restrict__ out, int ldo,
                                          float* red, bf16_t* __restrict__ outb = nullptr) {
  int tid = threadIdx.x; asm volatile("" : "+v"(tid));
  const int lane = tid & 63, wid = tid >> 6, fr = lane & 15, fq = lane >> 4;
  f32x4 acc = {0.f, 0.f, 0.f, 0.f};
  const bf16_t* ap = A + (size_t)fr * DM + wid * 256 + fq * 8;
  const bf16_t* bp = Bt + (size_t)fr * DM + wid * 256 + fq * 8;
#pragma unroll
  for (int ks = 0; ks < 8; ++ks) {
    const bf16x8 a = *(const bf16x8*)(ap + ks * 32);
    const bf16x8 b = *(const bf16x8*)(bp + ks * 32);
    acc = __builtin_amdgcn_mfma_f32_16x16x32_bf16(a, b, acc, 0, 0, 0);
  }
#pragma unroll
  for (int r = 0; r < 4; ++r) red[wid * 256 + (4 * fq + r) * 16 + fr] = acc[r];
  __syncthreads();
  if (tid < 256) {
    float s = 0.f;
#pragma unroll
    for (int w = 0; w < 8; ++w) s += red[w * 256 + tid];
    out[(size_t)(tid >> 4) * ldo + (tid & 15)] = s;
    if (outb) outb[(size_t)(tid >> 4) * ldo + (tid & 15)] = f2bf(s);
  }
  __syncthreads();
}

__device__ __forceinline__ void phase1(const Params& p, unsigned char* lds, int bid, int nblk) {
  const bool stream_first = ((bid >> 3) & 1) != 0;
  if (stream_first) convert_tables(p, bid, nblk);
  const bf16_t* hnb = (const bf16_t*)(p.ws + WS_HNB);
  const bf16_t* w_inT = (const bf16_t*)(p.ws + WS_WINT);
  const bf16_t* w_dtT = (const bf16_t*)(p.ws + WS_WDTT);
  float* dtraw = (float*)(p.ws + WS_DTRAW);
  float* projm = (float*)(p.ws + WS_PROJM);
  constexpr int NU = 512 + 32 + 96 + 1;
  for (int u = bid; u < NU; u += nblk) {
    if (u < 512) {
      mini_gemm(hnb + (size_t)u * 16 * DM, w_dtT, dtraw + (size_t)u * 16 * 16, 16, (float*)lds);
    } else {
      const int j = u - 512;
      const int cf = j < 32 ? 64 + j : (j < 128 ? 160 + (j - 32) : 256);
      const bf16_t* bt = cf < 256 ? w_inT + (size_t)cf * 16 * DM : w_dtT;
      mini_gemm(hnb + (size_t)T * DM, bt, projm + cf * 16, DPROJ, (float*)lds, (bf16_t*)(p.ws + WS_PROJMB) + cf * 16);
    }
  }
  pg8::Gemm g{hnb, w_inT, T, NPROJ, DM};
  pg8::StaticOrder S; S.init(T, NPROJ, nblk, bid);
  pg8::EpiBf16 E{(bf16_t*)(p.ws + WS_PROJ), NPROJ};
  pg8::gemm_phase<pg8::EpiBf16, pg8::StaticOrder>((PG8_LAS unsigned char*)lds, g, S, E);
  if (!stream_first) convert_tables(p, bid, nblk);
}

__device__ __forceinline__ void phase4(const Params& p, unsigned char* lds, int bid, int nblk) {
  pg8::Gemm g{(const bf16_t*)(p.ws + WS_HNB), (const bf16_t*)(p.ws + WS_WOUTT), T, DM, DM};
  pg8::StaticOrder S; S.init(T, DM, nblk, bid);
  pg8::EpiRes E{p.x, (bf16_t*)(p.ws + WS_H1B), (float*)(p.ws + WS_SSQH1)};
  pg8::gemm_phase<pg8::EpiRes, pg8::StaticOrder>((PG8_LAS unsigned char*)lds, g, S, E);
}
__device__ __forceinline__ void phase5(const Params& p, unsigned char* lds, int bid, int nblk) {
  pg8::Gemm g{(const bf16_t*)(p.ws + WS_H1B), (const bf16_t*)(p.ws + WS_WQT), T, DM, DM};
  pg8::StaticOrder S; S.init(T, DM, nblk, bid);
  pg8::EpiScores E{(const bf16_t*)(p.ws + WS_KEYS), (float*)(p.ws + WS_STOP), (int*)(p.ws + WS_ITOP)};
  pg8::gemm_phase<pg8::EpiScores, pg8::StaticOrder>((PG8_LAS unsigned char*)lds, g, S, E);
}

__device__ __forceinline__ float dot2bf(unsigned a, unsigned b, float c) {
  return __builtin_amdgcn_fdot2_f32_bf16(*(bf16v2*)&a, *(bf16v2*)&b, c, false);
}
__device__ __forceinline__ void phase6(const Params& p, unsigned char* lds, int bid, int nblk) {
  const int tid0 = threadIdx.x, lane0 = tid0 & 63, wid = __builtin_amdgcn_readfirstlane(tid0 >> 6);
  int* ids = (int*)(lds + wid * 2048);
  float* gts = (float*)(lds + wid * 2048 + 512);
  float* wts = (float*)(lds + wid * 2048 + 1024);
  int* rid = (int*)(lds + 16384 + wid * 1024);
  float* rgt = (float*)(lds + 16384 + wid * 1024 + 512);
  float* uscl = (float*)(lds + wid * 2048 + 1536);
  const unsigned char* ub = p.ws + WS_UB;
  const unsigned char* vb = p.ws + WS_VB;
  const bf16_t* h1b = (const bf16_t*)(p.ws + WS_H1B);
  const float* usc = (const float*)(p.ws + WS_USC);
  const float* vsc = (const float*)(p.ws + WS_VSC);
  const float* ssq = (const float*)(p.ws + WS_SSQH1);
  const float* stop = (const float*)(p.ws + WS_STOP);
  const int* itop = (const int*)(p.ws + WS_ITOP);
  const int ci = kCandI[lane0], cj = kCandJ[lane0];
#pragma unroll 1
  for (int t = bid * 8 + wid; t < T; t += nblk * 8) {
    int tid = tid0; asm volatile("" : "+v"(tid));
    const int lane = tid & 63;
    const int kcode = 8 * ((lane >> 2) & 1) + 4 * ((lane >> 3) & 1) + 2 * ((lane >> 4) & 1) + ((lane >> 5) & 1);
    const float part0 = lane < 32 ? ssq[(size_t)t * 32 + lane] : 0.f;
    const float rr = rsqrtf(wave_sum(part0) * (1.f / DM) + EPS);
#pragma unroll 1
    for (int h = 0; h < 8; ++h) {
      const size_t lbase = ((size_t)t * 16 + h * 2) * 16;
      const float sv = lane < 32 ? __builtin_nontemporal_load(stop + lbase + lane) : 0.f;
      const int iv = lane < 32 ? __builtin_nontemporal_load(itop + lbase + lane) : 0;
      float cand = (__shfl(sv, ci) + __shfl(sv, 16 + cj)) * rr;
      if (lane >= 50) cand = -INFINITY;
      unsigned key = __float_as_uint(cand);
      key = (key & 0x80000000u) ? ~key : (key | 0x80000000u);
      key = (key & ~63u) | (unsigned)(63 - lane);
      int rank = 0;
#pragma unroll
      for (int k = 0; k < 50; ++k) {
        const unsigned kk = (unsigned)__builtin_amdgcn_readlane((int)key, k);
        rank += kk > key ? 1 : 0;
      }
      const float cmax = wave_max(cand);
      const float ex = rank < 16 ? __expf(cand - cmax) : 0.f;
      const float den = wave_sum(ex);
      const int eidx = __shfl(iv, ci) * 128 + __shfl(iv, 16 + cj);
      if (rank < 16) { rid[h * 16 + rank] = eidx; rgt[h * 16 + rank] = ex / den; }
    }
    {
      const int e0 = rid[lane], e1 = rid[lane + 64];
      const float g0 = rgt[lane], g1 = rgt[lane + 64];
      const int r0 = e0 >> 10, r1 = e1 >> 10;
      const unsigned long long ltm = (1ull << lane) - 1ull;
      int run = 0, pos0 = 0, pos1 = 0;
#pragma unroll
      for (int R = 0; R < 16; ++R) {
        const unsigned long long m0 = __ballot(r0 == R), m1 = __ballot(r1 == R);
        const int c0 = __popcll(m0), c1 = __popcll(m1);
        if (r0 == R) pos0 = run + __popcll(m0 & ltm);
        if (r1 == R) pos1 = run + c0 + __popcll(m1 & ltm);
        run += c0 + c1;
      }
      ids[pos0] = e0; gts[pos0] = g0 * vsc[e0]; uscl[pos0] = rr * usc[e0];
      ids[pos1] = e1; gts[pos1] = g1 * vsc[e1]; uscl[pos1] = rr * usc[e1];
    }
    u32x6 bq0, bq1;
    int es0, es1;
    {
      float r[32];
      {
        const bf16_t* xp = h1b + (size_t)t * DM + lane * 4;
#pragma unroll
        for (int j = 0; j < 8; ++j) {
          const u32x2 xa = *(const u32x2*)(xp + 256 * j);
          r[4 * j + 0] = bflo(xa.x); r[4 * j + 1] = bfhi(xa.x); r[4 * j + 2] = bflo(xa.y); r[4 * j + 3] = bfhi(xa.y);
        }
      }
      auto term = [&](u32x6& q, int& es, const bool last) __attribute__((always_inline)) {
        float m = 0.f;
#pragma unroll
        for (int j = 0; j < 32; ++j) m = fmaxf(m, fabsf(r[j]));
        const unsigned mb = __float_as_uint(m);
        es = (int)(mb >> 23) - 1 - ((mb & 0x7fffffu) <= 0x700000u ? 1 : 0);
        es = es < 1 ? 1 : es;
        const float S = __uint_as_float((unsigned)es << 23), iS = __uint_as_float((unsigned)(254 - es) << 23);
        f32x16 v0, v1;
#pragma unroll
        for (int i = 0; i < 16; ++i) { v0[i] = r[2 * i] * iS; v1[i] = r[2 * i + 1] * iS; }
        q = __builtin_amdgcn_cvt_scalef32_2xpk16_fp6_f32(v0, v1, 1.0f);
        if (!last) {
          const f32x32v d = __builtin_amdgcn_cvt_scalef32_pk32_f32_fp6(q, 1.0f);
#pragma unroll
          for (int j = 0; j < 32; ++j) r[j] = fmaf(-S, d[j], r[j]);
        }
      };
      term(bq0, es0, false);
      term(bq1, es1, true);
    }
    const bool isdiag = ((lane & 15) >> 2) == (lane >> 4);
    auto load_rows = [&](u32x4 (&ra)[16], const unsigned char* tb, const int rnd) __attribute__((always_inline)) {
#pragma unroll
      for (int k = 0; k < 16; ++k) {
        const int e = __builtin_amdgcn_readfirstlane(ids[rnd * 16 + k]);
        ra[k] = *(const u32x4*)(tb + (size_t)e * ROW4 + lane * 16);
      }
    };
    auto compute_u = [&](u32x4 (&ra)[16], const int rnd) __attribute__((always_inline)) {
      float part[16];
#pragma unroll
      for (int k = 0; k < 16; ++k) {
        const i32x8 A_ = {(int)ra[k][0], (int)ra[k][1], (int)ra[k][2], (int)ra[k][3], 0, 0, 0, 0};
        const i32x8 B0_ = {(int)bq0[0], (int)bq0[1], (int)bq0[2], (int)bq0[3], (int)bq0[4], (int)bq0[5], 0, 0};
        const i32x8 B1_ = {(int)bq1[0], (int)bq1[1], (int)bq1[2], (int)bq1[3], (int)bq1[4], (int)bq1[5], 0, 0};
        f32x4 c = {0.f, 0.f, 0.f, 0.f};
        c = __builtin_amdgcn_mfma_scale_f32_16x16x128_f8f6f4(A_, B0_, c, 4, 2, 0, 0x7f7f7f7f, 0, es0);
        c = __builtin_amdgcn_mfma_scale_f32_16x16x128_f8f6f4(A_, B1_, c, 4, 2, 0, 0x7f7f7f7f, 0, es1);
        const int js = lane & 3;
        const float dv = js == 0 ? c[0] : js == 1 ? c[1] : js == 2 ? c[2] : c[3];
        part[k] = isdiag ? dv : 0.f;
      }
      float q8[8], q4[4], q2[2], q1;
      { const bool hi = (lane >> 5) & 1;
#pragma unroll
        for (int i = 0; i < 8; ++i) { const float keep = hi ? part[2 * i + 1] : part[2 * i], send = hi ? part[2 * i] : part[2 * i + 1]; q8[i] = keep + __shfl_xor(send, 32); } }
      { const bool hi = (lane >> 4) & 1;
#pragma unroll
        for (int i = 0; i < 4; ++i) { const float keep = hi ? q8[2 * i + 1] : q8[2 * i], send = hi ? q8[2 * i] : q8[2 * i + 1]; q4[i] = keep + __shfl_xor(send, 16); } }
      { const bool hi = (lane >> 3) & 1;
#pragma unroll
        for (int i = 0; i < 2; ++i) { const float keep = hi ? q4[2 * i + 1] : q4[2 * i], send = hi ? q4[2 * i] : q4[2 * i + 1]; q2[i] = keep + __shfl_xor(send, 8); } }
      { const bool hi = (lane >> 2) & 1;
        const float keep = hi ? q2[1] : q2[0], send = hi ? q2[0] : q2[1]; q1 = keep + __shfl_xor(send, 4); }
      q1 += __shfl_xor(q1, 2);
      q1 += __shfl_xor(q1, 1);
      {
        const int kk = rnd * 16 + kcode;
        const float a = q1 * uscl[kk];
        const float ge = 0.5f * a * (1.f + erff(a * 0.70710678118654752f));
        if ((lane & 3) == 0) wts[kk] = gts[kk] * ge;
      }
    };
    float acc[32];
#pragma unroll
    for (int i = 0; i < 32; ++i) acc[i] = 0.f;
    auto compute_v = [&](u32x4 (&ra)[16], const int rnd) __attribute__((always_inline)) {
      f32x4 wv[4];
#pragma unroll
      for (int j = 0; j < 4; ++j) wv[j] = *(const f32x4*)(wts + rnd * 16 + 4 * j);
#pragma unroll
      for (int k = 0; k < 16; ++k) {
        const float wk = wv[k >> 2][k & 3];
        asm volatile("" : "+v"(ra[k]) : "v"(acc[1]), "v"(acc[3]), "v"(acc[5]), "v"(acc[7]), "v"(acc[9]), "v"(acc[11]), "v"(acc[13]), "v"(acc[15]),
                                        "v"(acc[17]), "v"(acc[19]), "v"(acc[21]), "v"(acc[23]), "v"(acc[25]), "v"(acc[27]), "v"(acc[29]), "v"(acc[31]));
#define V4_STEP(j, i) { const f32x2 r = __builtin_amdgcn_cvt_scalef32_pk_f32_fp4(ra[k][j], 1.0f, i); \
            acc[8 * (j) + 2 * (i)] = fmaf(wk, r[0], acc[8 * (j) + 2 * (i)]); acc[8 * (j) + 2 * (i) + 1] = fmaf(wk, r[1], acc[8 * (j) + 2 * (i) + 1]); }
#pragma unroll
        for (int j = 0; j < 4; ++j) { V4_STEP(j, 0) V4_STEP(j, 1) V4_STEP(j, 2) V4_STEP(j, 3) }
#undef V4_STEP
      }
    };
    {
      u32x4 raA[16], raB[16];
      load_rows(raA, ub, 0);
#pragma unroll 1
      for (int rnd = 0; rnd < 8; rnd += 2) {
        load_rows(raB, ub, rnd + 1);
        compute_u(raA, rnd);
        load_rows(raA, rnd + 2 < 8 ? ub : vb, (rnd + 2) & 7);
        compute_u(raB, rnd + 1);
      }
#pragma unroll 1
      for (int rnd = 0; rnd < 6; rnd += 2) {
        load_rows(raB, vb, rnd + 1);
        compute_v(raA, rnd);
        load_rows(raA, vb, rnd + 2);
        compute_v(raB, rnd + 1);
      }
      load_rows(raB, vb, 7);
      compute_v(raA, 6);
      compute_v(raB, 7);
    }
    float ss = 0.f;
#pragma unroll
    for (int j = 0; j < 8; ++j) {
      const u32x2 xa = *(const u32x2*)(h1b + (size_t)t * DM + lane * 4 + 256 * j);
      acc[4 * j + 0] += bflo(xa.x); acc[4 * j + 1] += bfhi(xa.x); acc[4 * j + 2] += bflo(xa.y); acc[4 * j + 3] += bfhi(xa.y);
    }
#pragma unroll
    for (int i = 0; i < 32; ++i) ss += acc[i] * acc[i];
    ss = wave_sum(ss);
    const float rf = rsqrtf(ss * (1.f / DM) + EPS);
#pragma unroll
    for (int j = 0; j < 8; ++j) {
      const f32x4 lw = *(const f32x4*)(p.ln_final + 256 * j + lane * 4);
      const f32x4 o = {acc[4 * j] * rf * lw[0], acc[4 * j + 1] * rf * lw[1], acc[4 * j + 2] * rf * lw[2], acc[4 * j + 3] * rf * lw[3]};
      __builtin_nontemporal_store(o, (f32x4*)(p.out + (size_t)t * DM + 256 * j + lane * 4));
    }
  }
}

__device__ __forceinline__ void unpack8(const u32x4 a, float (&v)[8]) {
  v[0] = bflo(a.x); v[1] = bfhi(a.x); v[2] = bflo(a.y); v[3] = bfhi(a.y); v[4] = bflo(a.z); v[5] = bfhi(a.z); v[6] = bflo(a.w); v[7] = bfhi(a.w);
}
constexpr int VT_LD = 196;
constexpr int ATT_VT_BYTES = 4 * 64 * VT_LD * 2;
__device__ __forceinline__ void attn_item(const Params& p, unsigned char* lds, int item, const bool first) {
  int tid = threadIdx.x; asm volatile("" : "+v"(tid));
  const int lane = tid & 63, wid = __builtin_amdgcn_readfirstlane(tid >> 6);
  const int b = item >> 6, qb = item & 63, q0 = qb * 32;
  bf16_t* VT = (bf16_t*)lds;
  float* biasL = (float*)(lds + ATT_VT_BYTES);
  float* ssqw = biasL + 16 * 132;
  const bf16_t* proj = (const bf16_t*)(p.ws + WS_PROJ);
  const float* projm = (const float*)(p.ws + WS_PROJM);
  bf16_t* mixin = (bf16_t*)(p.ws + WS_HNB);
  if (first) {
#pragma unroll
  for (int it = 0; it < 5; ++it) {
    const int idx = it * NTHREADS + tid;
    if (idx >= 16 * 129) break;
    const int hq = idx / 129, d = idx - hq * 129;
    int bk = d;
    if (d >= 16) bk = 16 + (d >= 19) + (d >= 21) + (d >= 24) + (d >= 27) + (d >= 31) + (d >= 35) + (d >= 40) + (d >= 46) + (d >= 52) + (d >= 59) +
                      (d >= 67) + (d >= 77) + (d >= 87) + (d >= 99) + (d >= 113);
    biasL[hq * 132 + d] = p.rel_bias[bk * 16 + hq];
  }
  }
  const int ql = lane & 31, ql0 = ql, hh = lane >> 5, kvh = wid >> 1;
  const int trow = b * SEQ + q0 + ql;
  bf16x8 qf[4];
  u32x4 kf[6][4];
#define ATT_LOAD_Q(hq_)                                                                                                           \
  { _Pragma("unroll") for (int ks = 0; ks < 4; ++ks) qf[ks] = *(const bf16x8*)(proj + (size_t)trow * NPROJ + OFF_Q + (hq_) * 64 + ks * 16 + hh * 8); }
#define ATT_LOAD_K()                                                                                                              \
  {                                                                                                                               \
    int ql = ql0; asm volatile("" : "+v"(ql));     \
    const float* kr_ = projm + (size_t)(ql & 15) * DPROJ + OFF_K + kvh * 64 + hh * 8;                                             \
    _Pragma("unroll") for (int ks = 0; ks < 4; ++ks) {                                                                            \
      const f32x4 a_ = *(const f32x4*)(kr_ + ks * 16), c_ = *(const f32x4*)(kr_ + ks * 16 + 4);                                   \
      kf[0][ks].x = pack_bf16(a_[0], a_[1]); kf[0][ks].y = pack_bf16(a_[2], a_[3]); kf[0][ks].z = pack_bf16(c_[0], c_[1]); kf[0][ks].w = pack_bf16(c_[2], c_[3]); } \
    _Pragma("unroll") for (int jt = 1; jt < 6; ++jt) {                                                                            \
      int sp_ = q0 - 128 + 32 * (jt - 1) + ql; sp_ = sp_ < 0 ? 0 : sp_;                                                           \
      const bf16_t* kp_ = proj + (size_t)(b * SEQ + sp_) * NPROJ + OFF_K + kvh * 64 + hh * 8;                                     \
      _Pragma("unroll") for (int ks = 0; ks < 4; ++ks) kf[jt][ks] = *(const u32x4*)(kp_ + ks * 16); }                             \
  }
  const int qb4 = (qb + 4) % 5;
  if (first) {
    u32x4 ra[5], rc[5];
#pragma unroll
    for (int q = 0; q < 5; ++q) {
      const int task = q * NTHREADS + tid, ch = task / 80, pi = task - ch * 80;
      int s0 = q0 - 128 + 2 * pi;
      s0 = s0 < 0 ? 0 : s0;
      const unsigned off = (unsigned)((b * SEQ + s0) * NPROJ + OFF_V + ch * 8);
      ra[q] = *(const u32x4*)(proj + off); rc[q] = *(const u32x4*)(proj + off + NPROJ);
    }
    float m0[8], m1[8];
    {
      const int pi = tid & 7, ch = (tid >> 3) & 31;
      const float* r0 = projm + (size_t)(2 * pi) * DPROJ + OFF_V + ch * 8;
      const f32x4 ma = *(const f32x4*)r0, mb = *(const f32x4*)(r0 + 4), mc = *(const f32x4*)(r0 + DPROJ), md = *(const f32x4*)(r0 + DPROJ + 4);
      const float keep = tid < 256 ? 1.f : 0.f;
#pragma unroll
      for (int i = 0; i < 4; ++i) { m0[i] = ma[i] * keep; m0[4 + i] = mb[i] * keep; m1[i] = mc[i] * keep; m1[4 + i] = md[i] * keep; }
      bf16_t* dst = VT + (size_t)((ch >> 3) * 64 + (ch & 7) * 8) * VT_LD + 2 * pi + (tid < 256 ? 0 : 16);
#pragma unroll
      for (int i = 0; i < 8; ++i) *(unsigned*)(dst + i * VT_LD) = pack_bf16(m0[i], m1[i]);
    }
#pragma unroll
    for (int q = 0; q < 5; ++q) {
      const int task = q * NTHREADS + tid, ch = task / 80, pi = task - ch * 80;
      float v0[8], v1[8];
      unpack8(ra[q], v0); unpack8(rc[q], v1);
      int rp = qb4 + (pi >> 4); rp = rp >= 5 ? rp - 5 : rp;
      const int slot = 32 + rp * 32 + 2 * (pi & 15);
      bf16_t* dst = VT + (size_t)((ch >> 3) * 64 + (ch & 7) * 8) * VT_LD + slot;
#pragma unroll
      for (int i = 0; i < 8; ++i) *(unsigned*)(dst + i * VT_LD) = pack_bf16(v0[i], v1[i]);
    }
  } else {
    const int ch = tid >> 4, pw = tid & 15;
    const bf16_t* r0 = proj + (size_t)(b * SEQ + q0 + 2 * pw) * NPROJ + OFF_V + ch * 8;
    const u32x4 ra = *(const u32x4*)r0, rc = *(const u32x4*)(r0 + NPROJ);
    float v0[8], v1[8];
    unpack8(ra, v0); unpack8(rc, v1);
    const int slot = 32 + ((qb4 + 4) % 5) * 32 + 2 * pw;
    bf16_t* dst = VT + (size_t)((ch >> 3) * 64 + (ch & 7) * 8) * VT_LD + slot;
#pragma unroll
    for (int i = 0; i < 8; ++i) *(unsigned*)(dst + i * VT_LD) = pack_bf16(v0[i], v1[i]);
  }
  __syncthreads();
  float ssq = 0.f;
#pragma unroll 1
  for (int rep_ = 0; rep_ < (REP_SUB == 3 ? 2 : 1); ++rep_) {
  ssq = 0.f;
  auto do_head = [&](const int hsel) __attribute__((always_inline)) {
    const int hq = 2 * wid + hsel;
    f32x16 sacc[6];
#pragma unroll
    for (int jt = 0; jt < 6; ++jt) {
      f32x16 acc;
#pragma unroll
      for (int r = 0; r < 16; ++r) acc[r] = 0.f;
#pragma unroll
      for (int ks = 0; ks < 4; ++ks) acc = __builtin_amdgcn_mfma_f32_32x32x16_bf16(*(bf16x8*)&kf[jt][ks], qf[ks], acc, 0, 0, 0);
      sacc[jt] = acc;
    }
    if (hsel == 0) { ATT_LOAD_Q(2 * wid + 1) }
    const float* bl = biasL + hq * 132;
    int sq = q0 + ql, qh = ql - 4 * hh;
    asm volatile("" : "+v"(sq), "+v"(qh));
    const float sink = p.sinks[hq];
    float m = sink;
#pragma unroll
    for (int jt = 0; jt < 6; ++jt) {
      asm volatile("" ::: "memory");
#pragma unroll
      for (int r = 0; r < 16; ++r) {
        const int kr = (r & 3) + 8 * (r >> 2) + 4 * hh;
        int dist; bool valid;
        if (jt == 0) { dist = sq + (16 - ((r & 3) + 8 * (r >> 2))) - 4 * hh; valid = kr < 16; }
        else { dist = qh + (128 - 32 * (jt - 1) - ((r & 3) + 8 * (r >> 2))); valid = (dist >= 0) && (dist < 128) && (dist <= sq); }
        const int dc = dist < 0 ? 0 : (dist > 128 ? 128 : dist);
        const float l = valid ? 0.125f * sacc[jt][r] + bl[dc] : -1e30f;
        sacc[jt][r] = l;
        m = fmaxf(m, l);
      }
    }
    m = fmaxf(m, __shfl_xor(m, 32));
    float sum = 0.f;
    f32x16 oacc0, oacc1;
#pragma unroll
    for (int r = 0; r < 16; ++r) { oacc0[r] = 0.f; oacc1[r] = 0.f; }
    const bf16_t* vrow0 = VT + (size_t)(kvh * 64 + ql) * VT_LD + 4 * hh;
    const bf16_t* vrow1 = vrow0 + 32 * VT_LD;
#pragma unroll
    for (int jt = 0; jt < 6; ++jt) {
      u32x4 pw[2];
#pragma unroll
      for (int s2 = 0; s2 < 2; ++s2) {
        float e[8];
#pragma unroll
        for (int i = 0; i < 8; ++i) { e[i] = __expf(sacc[jt][8 * s2 + i] - m); sum += e[i]; }
        pw[s2].x = pack_bf16(e[0], e[1]); pw[s2].y = pack_bf16(e[2], e[3]); pw[s2].z = pack_bf16(e[4], e[5]); pw[s2].w = pack_bf16(e[6], e[7]);
      }
#pragma unroll
      for (int s2 = 0; s2 < 2; ++s2) {
        const int sl = (jt == 0 ? 0 : 32 + ((qb4 + jt - 1) % 5) * 32) + 16 * s2;
        const u32x2 va = *(const u32x2*)(vrow0 + sl), vc = *(const u32x2*)(vrow0 + sl + 8);
        const u32x2 vd = *(const u32x2*)(vrow1 + sl), ve = *(const u32x2*)(vrow1 + sl + 8);
        u32x4 v0w; v0w.x = va.x; v0w.y = va.y; v0w.z = vc.x; v0w.w = vc.y;
        u32x4 v1w; v1w.x = vd.x; v1w.y = vd.y; v1w.z = ve.x; v1w.w = ve.y;
        oacc0 = __builtin_amdgcn_mfma_f32_32x32x16_bf16(*(bf16x8*)&v0w, *(bf16x8*)&pw[s2], oacc0, 0, 0, 0);
        oacc1 = __builtin_amdgcn_mfma_f32_32x32x16_bf16(*(bf16x8*)&v1w, *(bf16x8*)&pw[s2], oacc1, 0, 0, 0);
      }
    }
    sum += __shfl_xor(sum, 32);
    const float inv = 1.f / (sum + __expf(sink - m));
#pragma unroll
    for (int r = 0; r < 16; ++r) { oacc0[r] *= inv; oacc1[r] *= inv; ssq += oacc0[r] * oacc0[r] + oacc1[r] * oacc1[r]; }
#pragma unroll
    for (int rg = 0; rg < 4; ++rg) {
      u32x2 w; w.x = pack_bf16(oacc0[rg * 4 + 0], oacc0[rg * 4 + 1]); w.y = pack_bf16(oacc0[rg * 4 + 2], oacc0[rg * 4 + 3]);
      *(u32x2*)(mixin + (size_t)trow * DM + hq * 64 + 8 * rg + 4 * hh) = w;
      u32x2 w1; w1.x = pack_bf16(oacc1[rg * 4 + 0], oacc1[rg * 4 + 1]); w1.y = pack_bf16(oacc1[rg * 4 + 2], oacc1[rg * 4 + 3]);
      *(u32x2*)(mixin + (size_t)trow * DM + hq * 64 + 32 + 8 * rg + 4 * hh) = w1;
    }
  };
  ATT_LOAD_Q(2 * wid)
  ATT_LOAD_K()
  do_head(0);
  asm volatile("" ::: "memory");
  ATT_LOAD_K()
  do_head(1);
  }
  ssq += __shfl_xor(ssq, 32);
  if (lane < 32) ssqw[wid * 32 + lane] = ssq;
  __syncthreads();
  float tot = 0.f;
#pragma unroll
  for (int w = 0; w < 8; ++w) tot += ssqw[w * 32 + ql];
  const float ra = rsqrtf(tot * (1.f / 1024) + EPS);
#pragma unroll
  for (int hsel = 0; hsel < 2; ++hsel)
#pragma unroll
    for (int dt = 0; dt < 2; ++dt)
#pragma unroll
      for (int rg = 0; rg < 4; ++rg) {
        bf16_t* op = mixin + (size_t)trow * DM + (2 * wid + hsel) * 64 + 32 * dt + 8 * rg + 4 * hh;
        const u32x2 v = *(const u32x2*)op;
        u32x2 w; w.x = pack_bf16(bflo(v.x) * ra, bfhi(v.x) * ra); w.y = pack_bf16(bflo(v.y) * ra, bfhi(v.y) * ra);
        *(u32x2*)op = w;
      }
  __syncthreads();
}
#undef ATT_LOAD_Q
#undef ATT_LOAD_K

constexpr int SLD = 136;
__device__ __forceinline__ float conv_silu(const float (&raw)[11], int i, float w0, float w1, float w2, float w3, float cb) {
  return silu_f(cb + w0 * raw[i] + w1 * raw[i + 1] + w2 * raw[i + 2] + w3 * raw[i + 3]);
}
__device__ __forceinline__ void ssd_a_item(const Params& p, unsigned char* lds, int item) {
  int tid = threadIdx.x; asm volatile("" : "+v"(tid));
  const int lane = tid & 63, wid = __builtin_amdgcn_readfirstlane(tid >> 6);
  const int b = item >> 5, c = (item >> 1) & 15, g = item & 1;
  const int h0 = g * 8;
  const int t0 = b * SEQ + c * 128;
  bf16_t* Bc = (bf16_t*)lds;
  bf16_t* Cc = Bc + 128 * SLD;
  bf16_t* BcT = Cc + 128 * SLD;
  bf16_t* xT = BcT + 128 * SLD;
  float* dtl = (float*)(xT + 2 * 64 * SLD);
  float* acs = dtl + 256;
  float* wl = acs + 256;
  float* scan = wl + 256;
  const bf16_t* __restrict__ proj = (const bf16_t*)(p.ws + WS_PROJ);
  const bf16_t* __restrict__ projmb = (const bf16_t*)(p.ws + WS_PROJMB);
  const float* __restrict__ dtraw = (const float*)(p.ws + WS_DTRAW);
  float* __restrict__ acsg = (float*)(p.ws + WS_ACSG);
  bf16_t* __restrict__ ccb = (bf16_t*)(p.ws + WS_CCB);
  bf16_t* __restrict__ ypart = (bf16_t*)(p.ws + WS_YPART);
  float* __restrict__ sg = (float*)(p.ws + WS_SG);
  {
    unsigned raw[4][11];
#pragma unroll
    for (int q = 0; q < 4; ++q) {
      const int task = q * NTHREADS + tid;
      const int tg = task >> 7, cp = task & 127;
      const int cch = 1024 + (cp >> 6) * 256 + g * 128 + 2 * (cp & 63);
#pragma unroll
      for (int i = 0; i < 11; ++i) {
        const int l = tg * 8 + i - 3;
        const bf16_t* src = (l >= 0 || c > 0) ? proj + (size_t)(t0 + l) * NPROJ : projmb + (size_t)(16 + l) * DPROJ;
        raw[q][i] = *(const unsigned*)(src + OFF_XBC + cch);
      }
    }
#pragma unroll
    for (int q = 0; q < 4; ++q) {
      const int task = q * NTHREADS + tid;
      const int tg = task >> 7, cp = task & 127, n = 2 * (cp & 63);
      const int cch = 1024 + (cp >> 6) * 256 + g * 128 + n;
      float o0[8], o1[8];
      {
        float r0[11], r1[11];
#pragma unroll
        for (int i = 0; i < 11; ++i) { r0[i] = bflo(raw[q][i]); r1[i] = bfhi(raw[q][i]); }
        const float w0 = p.conv_w[cch], w1 = p.conv_w[D_XBC + cch], w2 = p.conv_w[2 * D_XBC + cch], w3 = p.conv_w[3 * D_XBC + cch], cb = p.conv_b[cch];
        const float v0 = p.conv_w[cch + 1], v1 = p.conv_w[D_XBC + cch + 1], v2 = p.conv_w[2 * D_XBC + cch + 1], v3 = p.conv_w[3 * D_XBC + cch + 1], vb_ = p.conv_b[cch + 1];
#pragma unroll
        for (int i = 0; i < 8; ++i) { o0[i] = conv_silu(r0, i, w0, w1, w2, w3, cb); o1[i] = conv_silu(r1, i, v0, v1, v2, v3, vb_); }
      }
      bf16_t* rowm = (cp < 64 ? Bc : Cc) + (tg * 8) * SLD + n;
#pragma unroll
      for (int i = 0; i < 8; ++i) *(unsigned*)(rowm + i * SLD) = pack_bf16(o0[i], o1[i]);
      if (cp < 64) {
        u32x4 w; w.x = pack_bf16(o0[0], o0[1]); w.y = pack_bf16(o0[2], o0[3]); w.z = pack_bf16(o0[4], o0[5]); w.w = pack_bf16(o0[6], o0[7]);
        *(u32x4*)(BcT + n * SLD + tg * 8) = w;
        u32x4 w2_; w2_.x = pack_bf16(o1[0], o1[1]); w2_.y = pack_bf16(o1[2], o1[3]); w2_.z = pack_bf16(o1[4], o1[5]); w2_.w = pack_bf16(o1[6], o1[7]);
        *(u32x4*)(BcT + (n + 1) * SLD + tg * 8) = w2_;
      }
    }
  }
  float xraw[4][11];
#define SSD_LOAD_X(r_)                                                                                              \
  _Pragma("unroll") for (int q = 0; q < 4; ++q) {                                                                   \
    const int task = (q & 1) * NTHREADS + tid; const int tg = task >> 6, cch = (h0 + 2 * (r_) + (q >> 1)) * 64 + (task & 63); \
    _Pragma("unroll") for (int i = 0; i < 11; ++i) { const int l = tg * 8 + i - 3;                                  \
      const bf16_t* src = (l >= 0 || c > 0) ? proj + (size_t)(t0 + l) * NPROJ : projmb + (size_t)(16 + l) * DPROJ;  \
      xraw[q][i] = bf2f(src[OFF_XBC + cch]); } }
  SSD_LOAD_X(0)
  __syncthreads();
  {
#pragma unroll
    for (int q = 0; q < 4; ++q) {
      const int idx = q * NTHREADS + tid, row = idx >> 4, ck = idx & 15;
      *(u32x4*)(ccb + (size_t)(t0 + row) * 256 + g * 128 + ck * 8) = *(const u32x4*)(Cc + row * SLD + ck * 8);
    }
  }
  const int ql = lane & 31, hh = lane >> 5;
  int rnd = 0;
  auto ydiag = [&](const int hi, const int il) __attribute__((always_inline)) {
    const int h = h0 + 2 * rnd + hi, ip = wid & 1;
    const bf16_t* xTb = xT + (hi & 1) * 64 * SLD;
    const float dskip = p.d_skip[h];
    const float* acsh = acs + hi * 128;
    const float* dtlh = dtl + hi * 128;
    const int l = 32 * il + ql;
    const float acl = acsh[l];
    f32x16 yacc;
#pragma unroll
    for (int r = 0; r < 16; ++r) yacc[r] = 0.f;
    const bf16_t* xrow = xTb + (32 * ip + ql) * SLD + 4 * hh;
#pragma unroll 1
    for (int is = 0; is <= il; ++is) {
      f32x16 x;
#pragma unroll
      for (int r = 0; r < 16; ++r) x[r] = 0.f;
      const bf16_t* ap = Bc + (32 * is + ql) * SLD + 8 * hh;
      const bf16_t* bp = Cc + l * SLD + 8 * hh;
#pragma unroll
      for (int ks = 0; ks < 8; ++ks) x = __builtin_amdgcn_mfma_f32_32x32x16_bf16(*(const bf16x8*)(ap + 16 * ks), *(const bf16x8*)(bp + 16 * ks), x, 0, 0, 0);
      u32x4 pw[2];
#pragma unroll
      for (int s2 = 0; s2 < 2; ++s2) {
        float mv[8];
#pragma unroll
        for (int q = 0; q < 2; ++q) {
          const int sb = 32 * is + 16 * s2 + 8 * q + 4 * hh;
          const f32x4 as4 = *(const f32x4*)(acsh + sb), dt4 = *(const f32x4*)(dtlh + sb);
#pragma unroll
          for (int j = 0; j < 4; ++j) {
            const int sr = sb + j;
            float v = sr <= l ? x[8 * s2 + 4 * q + j] * __expf(acl - as4[j]) * dt4[j] : 0.f;
            if (sr == l) v += dskip;
            mv[4 * q + j] = v;
          }
        }
        pw[s2].x = pack_bf16(mv[0], mv[1]); pw[s2].y = pack_bf16(mv[2], mv[3]); pw[s2].z = pack_bf16(mv[4], mv[5]); pw[s2].w = pack_bf16(mv[6], mv[7]);
      }
#pragma unroll
      for (int s2 = 0; s2 < 2; ++s2) {
        const u32x2 va = *(const u32x2*)(xrow + 32 * is + 16 * s2), vc = *(const u32x2*)(xrow + 32 * is + 16 * s2 + 8);
        u32x4 aw; aw.x = va.x; aw.y = va.y; aw.z = vc.x; aw.w = vc.y;
        yacc = __builtin_amdgcn_mfma_f32_32x32x16_bf16(*(bf16x8*)&aw, *(bf16x8*)&pw[s2], yacc, 0, 0, 0);
      }
    }
    bf16_t* yp = ypart + (size_t)(t0 + l) * 1024 + h * 64 + 32 * ip + 4 * hh;
#pragma unroll
    for (int rg = 0; rg < 4; ++rg) { u32x2 w; w.x = pack_bf16(yacc[4 * rg], yacc[4 * rg + 1]); w.y = pack_bf16(yacc[4 * rg + 2], yacc[4 * rg + 3]); *(u32x2*)(yp + 8 * rg) = w; }
  };
  auto states = [&](const int hi) __attribute__((always_inline)) {
    const int h = h0 + 2 * rnd + hi, ip = wid & 1, in = wid >> 1;
    const bf16_t* xTb = xT + (hi & 1) * 64 * SLD;
    const float* wlh = wl + hi * 128;
    f32x16 sacc;
#pragma unroll
    for (int r = 0; r < 16; ++r) sacc[r] = 0.f;
    const bf16_t* ap = xTb + (32 * ip + ql) * SLD + 8 * hh;
    const bf16_t* bp = BcT + (32 * in + ql) * SLD + 8 * hh;
#pragma unroll
    for (int ks = 0; ks < 8; ++ks) {
      const u32x4 xa = *(const u32x4*)(ap + 16 * ks);
      const f32x4 wa = *(const f32x4*)(wlh + 16 * ks + 8 * hh), wb = *(const f32x4*)(wlh + 16 * ks + 8 * hh + 4);
      u32x4 aw;
      aw.x = pack_bf16(bflo(xa.x) * wa[0], bfhi(xa.x) * wa[1]); aw.y = pack_bf16(bflo(xa.y) * wa[2], bfhi(xa.y) * wa[3]);
      aw.z = pack_bf16(bflo(xa.z) * wb[0], bfhi(xa.z) * wb[1]); aw.w = pack_bf16(bflo(xa.w) * wb[2], bfhi(xa.w) * wb[3]);
      sacc = __builtin_amdgcn_mfma_f32_32x32x16_bf16(*(bf16x8*)&aw, *(const bf16x8*)(bp + 16 * ks), sacc, 0, 0, 0);
    }
    float* sp = sg + ((size_t)((b * 16 + c) * 16 + h) * 64 + 32 * ip + 4 * hh) * 128 + 32 * in + ql;
#pragma unroll
    for (int r = 0; r < 16; ++r) sp[((r & 3) + 8 * (r >> 2)) * 128] = sacc[r];
  };
#pragma unroll 1
  for (int rnd_ = 0; rnd_ < 4; ++rnd_) {
    rnd = rnd_;
    float dtv = 0.f, cum = 0.f;
    const int hi2 = (tid >> 7) & 1, ltok = tid & 127;
    if (tid < 256) {
      const int h = h0 + 2 * rnd + hi2;
      const float Ah = -expf(p.a_log[h]);
      dtv = softplus_f(dtraw[(size_t)(t0 + ltok) * 16 + h] + p.dt_bias[h]);
      dtl[tid] = dtv;
      cum = dtv * Ah;
#pragma unroll
      for (int o = 1; o < 64; o <<= 1) { const float nb = __shfl_up(cum, o); if (lane >= o) cum += nb; }
      if (lane == 63) scan[hi2 * 2 + (ltok >> 6)] = cum;
    }
#pragma unroll
    for (int q = 0; q < 4; ++q) {
      const int task = (q & 1) * NTHREADS + tid; const int tg = task >> 6, pch = task & 63, cch = (h0 + 2 * rnd + (q >> 1)) * 64 + pch;
      const float w0 = p.conv_w[cch], w1 = p.conv_w[D_XBC + cch], w2 = p.conv_w[2 * D_XBC + cch], w3 = p.conv_w[3 * D_XBC + cch], cb = p.conv_b[cch];
      float o[8];
#pragma unroll
      for (int i = 0; i < 8; ++i) o[i] = conv_silu(xraw[q], i, w0, w1, w2, w3, cb);
      u32x4 w; w.x = pack_bf16(o[0], o[1]); w.y = pack_bf16(o[2], o[3]); w.z = pack_bf16(o[4], o[5]); w.w = pack_bf16(o[6], o[7]);
      *(u32x4*)(xT + (q >> 1) * 64 * SLD + pch * SLD + tg * 8) = w;
    }
    { SSD_LOAD_X((rnd + 1) & 3) }
    __syncthreads();
    if (tid < 256) {
      const int h = h0 + 2 * rnd + hi2;
      const float s0 = scan[hi2 * 2], s1 = scan[hi2 * 2 + 1];
      if (ltok >= 64) cum += s0;
      acs[tid] = cum;
      acsg[(size_t)(t0 + ltok) * 16 + h] = cum;
      wl[tid] = dtv * __expf(s0 + s1 - cum);
    }
    __syncthreads();
    ydiag(0, wid >> 1);
    ydiag(1, 3 - (wid >> 1));
    states(0);
    states(1);
    __syncthreads();
  }
#undef SSD_LOAD_X
  __syncthreads();
}

__device__ __forceinline__ void meta_state_item(const Params& p, unsigned char* lds, int h) {
  int tid = threadIdx.x; asm volatile("" : "+v"(tid));
  const int g = h >> 3;
  float* xm = (float*)lds;
  float* bm = xm + 16 * 64;
  float* dtm = bm + 16 * 128;
  const float* projm = (const float*)(p.ws + WS_PROJM);
  float* smeta = (float*)(p.ws + WS_SMETA);
  for (int task = tid; task < 16 * 192; task += NTHREADS) {
    const int i = task / 192, ch = task - i * 192;
    const int cch = ch < 64 ? h * 64 + ch : 1024 + g * 128 + (ch - 64);
    float acc = p.conv_b[cch];
#pragma unroll
    for (int j = 0; j < 4; ++j) { const int mi = i - j; if (mi >= 0) acc += p.conv_w[(3 - j) * D_XBC + cch] * projm[(size_t)mi * DPROJ + OFF_XBC + cch]; }
    const float v = silu_f(acc);
    if (ch < 64) xm[i * 64 + ch] = v; else bm[i * 128 + ch - 64] = v;
  }
  if (tid < 16) dtm[tid] = softplus_f(projm[(size_t)tid * DPROJ + OFF_DT + h] + p.dt_bias[h]);
  __syncthreads();
  const float Ah = -expf(p.a_log[h]);
  const int pr = tid >> 3, n0 = (tid & 7) * 16;
  float st[16];
#pragma unroll
  for (int k = 0; k < 16; ++k) st[k] = 0.f;
  for (int i = 0; i < 16; ++i) {
    const float dtv = dtm[i], dA = expf(dtv * Ah), xdt = xm[i * 64 + pr] * dtv;
#pragma unroll
    for (int k = 0; k < 16; ++k) st[k] = fmaf(st[k], dA, xdt * bm[i * 128 + n0 + k]);
  }
#pragma unroll
  for (int k = 0; k < 16; ++k) smeta[(size_t)(h * 64 + pr) * 128 + n0 + k] = st[k];
  __syncthreads();
}

__device__ __forceinline__ void phase2(const Params& p, unsigned char* lds, int bid, int nblk) {
  const bool roles = (nblk == 256);
  const int a = (bid >> 4) * 8 + (bid & 7);
  const bool ssd_role = ((bid >> 3) & 1) == 0;
  const int ab = roles ? (ssd_role ? 0 : 2 * a) : bid, ae = roles ? (ssd_role ? 0 : 2 * a + 2) : 256, as_ = roles ? 1 : nblk;
  const int sb = roles ? (ssd_role ? a : 0) : bid, se = roles ? (ssd_role ? a + 1 : 0) : 128, ss = roles ? 1 : nblk;
  const int mb = roles ? (ssd_role ? a : 16) : bid, ms = roles ? 128 : nblk;
#pragma unroll 1
  for (int it = ab; it < ae; it += as_) attn_item(p, lds, it, !(roles && it != ab));
#pragma unroll 1
  for (int it = sb; it < se; it += ss) ssd_a_item(p, lds, it);
#pragma unroll 1
  for (int it = mb; it < 16; it += ms) meta_state_item(p, lds, it);
}

__device__ __forceinline__ void phase_scan(const Params& p, int bid, int nblk) {
  const float* __restrict__ sg = (const float*)(p.ws + WS_SG);
  const float* __restrict__ smeta = (const float*)(p.ws + WS_SMETA);
  const float* __restrict__ acsg = (const float*)(p.ws + WS_ACSG);
  bf16_t* __restrict__ hprev = (bf16_t*)(p.ws + WS_HPREV);
  for (int task = bid * NTHREADS + threadIdx.x; task < 64 * 2048; task += nblk * NTHREADS) {
    const int bh = task >> 11, e4 = (task & 2047) * 4;
    const int b = bh >> 4, h = bh & 15;
    f32x4 sv[16];
    float dv[16];
#pragma unroll
    for (int c = 0; c < 16; ++c) {
      sv[c] = *(const f32x4*)(sg + (size_t)((b * 16 + c) * 16 + h) * 8192 + e4);
      dv[c] = acsg[(size_t)(b * SEQ + c * 128 + 127) * 16 + h];
    }
    f32x4 H = *(const f32x4*)(smeta + (size_t)h * 8192 + e4);
#pragma unroll
    for (int c = 0; c < 16; ++c) {
      u32x2 w; w.x = pack_bf16(H[0], H[1]); w.y = pack_bf16(H[2], H[3]);
      *(u32x2*)(hprev + (size_t)((b * 16 + c) * 16 + h) * 8192 + e4) = w;
      H = H * __expf(dv[c]) + sv[c];
    }
  }
}

__device__ __forceinline__ void ssd_b_item(const Params& p, unsigned char* lds, int item) {
  int tid = threadIdx.x; asm volatile("" : "+v"(tid));
  const int lane = tid & 63, wid = __builtin_amdgcn_readfirstlane(tid >> 6);
  const int b = item >> 6, c = (item >> 2) & 15, g = (item >> 1) & 1, lh = item & 1, h = g * 8 + wid;
  const int t0 = b * SEQ + c * 128 + lh * 64;
  const int ql = lane & 31, hh = lane >> 5;
  constexpr int YLD = 520;
  bf16_t* yoff = (bf16_t*)lds;
  const bf16_t* __restrict__ proj = (const bf16_t*)(p.ws + WS_PROJ);
  const float* __restrict__ acsg = (const float*)(p.ws + WS_ACSG);
  const bf16_t* __restrict__ ccb = (const bf16_t*)(p.ws + WS_CCB);
  const bf16_t* __restrict__ ypart = (const bf16_t*)(p.ws + WS_YPART);
  const bf16_t* __restrict__ hprev = (const bf16_t*)(p.ws + WS_HPREV);
  bf16_t* __restrict__ mixin = (bf16_t*)(p.ws + WS_HNB);
  {
    const bf16_t* hp = hprev + (size_t)((b * 16 + c) * 16 + h) * 8192 + (size_t)ql * 128 + 8 * hh;
    u32x4 hf0[8], hf1[8];
#pragma unroll
    for (int ks = 0; ks < 8; ++ks) { hf0[ks] = *(const u32x4*)(hp + 16 * ks); hf1[ks] = *(const u32x4*)(hp + 32 * 128 + 16 * ks); }
#pragma unroll
    for (int il = 0; il < 2; ++il) {
      const int lt = 32 * il + ql, t = t0 + lt;
      const bf16_t* cp = ccb + (size_t)t * 256 + g * 128 + 8 * hh;
      u32x4 cf[8];
#pragma unroll
      for (int ks = 0; ks < 8; ++ks) cf[ks] = *(const u32x4*)(cp + 16 * ks);
      const float ea = __expf(acsg[(size_t)t * 16 + h]);
      f32x16 a0, a1;
#pragma unroll
      for (int r = 0; r < 16; ++r) { a0[r] = 0.f; a1[r] = 0.f; }
#pragma unroll
      for (int ks = 0; ks < 8; ++ks) {
        a0 = __builtin_amdgcn_mfma_f32_32x32x16_bf16(*(bf16x8*)&hf0[ks], *(bf16x8*)&cf[ks], a0, 0, 0, 0);
        a1 = __builtin_amdgcn_mfma_f32_32x32x16_bf16(*(bf16x8*)&hf1[ks], *(bf16x8*)&cf[ks], a1, 0, 0, 0);
      }
      bf16_t* yr = yoff + lt * YLD + wid * 64 + 4 * hh;
#pragma unroll
      for (int rg = 0; rg < 4; ++rg) {
        u32x2 w0; w0.x = pack_bf16(ea * a0[4 * rg], ea * a0[4 * rg + 1]); w0.y = pack_bf16(ea * a0[4 * rg + 2], ea * a0[4 * rg + 3]);
        u32x2 w1; w1.x = pack_bf16(ea * a1[4 * rg], ea * a1[4 * rg + 1]); w1.y = pack_bf16(ea * a1[4 * rg + 2], ea * a1[4 * rg + 3]);
        *(u32x2*)(yr + 8 * rg) = w0;
        *(u32x2*)(yr + 32 + 8 * rg) = w1;
      }
    }
  }
  __syncthreads();
#pragma unroll
  for (int bt = 0; bt < 2; ++bt) {
    u32x4 yy[4], zz[4], yo[4];
#pragma unroll
    for (int q = 0; q < 4; ++q) {
      const int lt = wid * 8 + bt * 4 + q, t = t0 + lt;
      yy[q] = __builtin_nontemporal_load((const u32x4*)(ypart + (size_t)t * 1024 + g * 512 + lane * 8));
      zz[q] = __builtin_nontemporal_load((const u32x4*)(proj + (size_t)t * NPROJ + OFF_Z + g * 512 + lane * 8));
      yo[q] = *(const u32x4*)(yoff + lt * YLD + lane * 8);
    }
#pragma unroll
    for (int q = 0; q < 4; ++q) {
      const int t = t0 + wid * 8 + bt * 4 + q;
      float zv[8], ov[8], yv[8], y[8];
      unpack8(zz[q], zv); unpack8(yo[q], ov); unpack8(yy[q], yv);
#pragma unroll
      for (int i = 0; i < 8; ++i) y[i] = (yv[i] + ov[i]) * silu_f(zv[i]);
      float ss = 0.f;
#pragma unroll
      for (int i = 0; i < 8; ++i) ss += y[i] * y[i];
      ss = wave_sum(ss);
      const float rn = rsqrtf(ss * (1.f / 512) + EPS);
      u32x4 w; w.x = pack_bf16(y[0] * rn, y[1] * rn); w.y = pack_bf16(y[2] * rn, y[3] * rn); w.z = pack_bf16(y[4] * rn, y[5] * rn); w.w = pack_bf16(y[6] * rn, y[7] * rn);
      *(u32x4*)(mixin + (size_t)t * DM + 1024 + g * 512 + lane * 8) = w;
    }
  }
  __syncthreads();
}
__device__ __forceinline__ void phase3(const Params& p, unsigned char* lds, int bid, int nblk) {
  for (int it = bid; it < 256; it += nblk) ssd_b_item(p, lds, (nblk == 256) ? ((it & 7) * 32 + (it >> 3)) : it);
}

constexpr int LDS_BYTES = 144 * 1024;

typedef const Params __attribute__((address_space(4))) * KArgPtr;
__device__ __forceinline__ Params load_params(KArgPtr k) {
  Params q;
#if defined(__HIP_DEVICE_COMPILE__)
  __builtin_memcpy(&q, k, sizeof(Params));
#endif
  return q;
}
#define PARAMS_PTR(pp) KArgPtr pp##_k = (KArgPtr)__builtin_amdgcn_kernarg_segment_ptr(); asm volatile("" : "+s"(pp##_k)); const Params pp##_v = load_params(pp##_k); const Params* pp = &pp##_v
__global__ __launch_bounds__(512, 2) void k_mega(Params p_unused) {
  extern __shared__ __attribute__((aligned(16))) unsigned char shm[];
  const int bid = blockIdx.x, nblk = gridDim.x;
  volatile LAS unsigned* xst = (volatile LAS unsigned*)(LAS unsigned char*)(shm + LDS_BYTES - 16);
  if (threadIdx.x == 0) { xst[0] = 0u; xst[1] = 0u; }
  __syncthreads();
  XcdBarrier xb;
  { PARAMS_PTR(pp); xb = xcd_barrier_post((unsigned*)(pp->ws + WS_CTL), xst); }
#ifndef REP_PHASE
#define REP_PHASE -1
#endif
#define NREP(k) ((REP_PHASE == (k)) ? 2 : 1)
#ifndef REP_ALL
#define REP_ALL 1
#endif
#pragma unroll 1
  for (int pass = 0; pass < REP_ALL; ++pass) {
  if (pass) xcd_barrier(xb);
#pragma unroll 1
  for (int rep = 0; rep < NREP(0); ++rep) { { PARAMS_PTR(pp); phase0(*pp, (float*)shm, bid, nblk); } if (rep + 1 < NREP(0)) xcd_barrier(xb); }
  xcd_barrier(xb);
#pragma unroll 1
  for (int rep = 0; rep < NREP(1); ++rep) { { PARAMS_PTR(pp); phase1(*pp, shm, bid, nblk); } xcd_barrier(xb); }
#pragma unroll 1
  for (int rep = 0; rep < NREP(2); ++rep) { { PARAMS_PTR(pp); phase2(*pp, shm, bid, nblk); } xcd_barrier(xb); }
#pragma unroll 1
  for (int rep = 0; rep < NREP(7); ++rep) { { PARAMS_PTR(pp); phase_scan(*pp, bid, nblk); } xcd_barrier(xb); }
#pragma unroll 1
  for (int rep = 0; rep < NREP(3); ++rep) { { PARAMS_PTR(pp); phase3(*pp, shm, bid, nblk); } xcd_barrier(xb); }
#pragma unroll 1
  for (int rep = 0; rep < NREP(4); ++rep) { { PARAMS_PTR(pp); phase4(*pp, shm, bid, nblk); } xcd_barrier(xb); }
#pragma unroll 1
  for (int rep = 0; rep < NREP(5); ++rep) { { PARAMS_PTR(pp); phase5(*pp, shm, bid, nblk); } xcd_barrier(xb); }
#pragma unroll 1
  for (int rep = 0; rep < NREP(6); ++rep) { { PARAMS_PTR(pp); phase6(*pp, shm, bid, nblk); } if (rep + 1 < NREP(6)) xcd_barrier(xb); }
  }
}

}

extern "C" void kernel_launch(void* const* d_in, const int* in_sizes, int n_in, void* d_out, int out_size, void* d_ws,
                              size_t ws_size, hipStream_t stream) {
  Params p{};
  p.x = (const float*)d_in[0]; p.meta = (const float*)d_in[1]; p.rel_bias = (const float*)d_in[2];
  p.ln_mix = (const float*)d_in[3]; p.w_in = (const float*)d_in[4]; p.sinks = (const float*)d_in[5];
  p.conv_w = (const float*)d_in[6]; p.conv_b = (const float*)d_in[7]; p.dt_bias = (const float*)d_in[8];
  p.a_log = (const float*)d_in[9]; p.d_skip = (const float*)d_in[10]; p.attn_norm_w = (const float*)d_in[11];
  p.ssm_norm_w = (const float*)d_in[12]; p.w_out = (const float*)d_in[13]; p.ln_ffn = (const float*)d_in[14];
  p.wq = (const float*)d_in[15]; p.keys = (const float*)d_in[16]; p.U = (const float*)d_in[17];
  p.V = (const float*)d_in[18]; p.ln_final = (const float*)d_in[19];
  p.out = (float*)d_out;
  p.ws = (unsigned char*)d_ws;

  static int grid_blocks = 0;
  if (!grid_blocks) {
    int dev = 0, cus = 0, per_cu = 0;
    (void)hipGetDevice(&dev);
    (void)hipDeviceGetAttribute(&cus, hipDeviceAttributeMultiprocessorCount, dev);
    (void)hipFuncSetAttribute((const void*)k_mega, hipFuncAttributeMaxDynamicSharedMemorySize, LDS_BYTES);
    (void)hipOccupancyMaxActiveBlocksPerMultiprocessor(&per_cu, (const void*)k_mega, NTHREADS, LDS_BYTES);
    if (per_cu > 1) per_cu = 1;
    grid_blocks = cus * per_cu;
    if (grid_blocks != 256) fprintf(stderr, "kernel_launch: expected a 256-workgroup resident grid, got %d (cus %d, per_cu %d)\n", grid_blocks, cus, per_cu);
  }
  (void)hipMemsetAsync(p.ws + WS_CTL, 0, XCD_BAR_WORDS * 4, stream);
  void* args[] = {&p};
  hipError_t e = hipLaunchCooperativeKernel((const void*)k_mega, dim3(grid_blocks), dim3(NTHREADS), args, LDS_BYTES, stream);
  if (e != hipSuccess) fprintf(stderr, "cooperative launch failed: %s (grid %d)\n", hipGetErrorString(e), grid_blocks);
}
```

```cpp
#include <hip/hip_runtime.h>
#include <math.h>
#include <stdio.h>
#include <stdint.h>

#ifndef REP_SUB
#define REP_SUB -1
#endif
namespace {
constexpr int BATCH = 4, SEQ = 2048, DM = 2048, NMETA = 16;
constexpr int T = BATCH * SEQ;
constexpr int TA = T + NMETA;
constexpr int DPROJ = 4112;
constexpr int NPROJ = 4096;
constexpr int OFF_Q = 0, OFF_K = 1024, OFF_V = 1280, OFF_Z = 1536, OFF_XBC = 2560, OFF_DT = 4096;
constexpr int D_XBC = 1536;
constexpr int NEXP = 16384;
constexpr int ROW4 = 1024;
constexpr int ROW6 = 1536;
constexpr float EPS = 1e-6f;
constexpr int NTHREADS = 512;

typedef unsigned short bf16_t;
typedef short bf16x8 __attribute__((ext_vector_type(8)));
typedef float f32x4 __attribute__((ext_vector_type(4)));
typedef float f32x2 __attribute__((ext_vector_type(2)));
typedef unsigned u32x4 __attribute__((ext_vector_type(4)));
typedef unsigned u32x2 __attribute__((ext_vector_type(2)));
typedef __bf16 bf16v2 __attribute__((ext_vector_type(2)));
typedef float f32x16v __attribute__((ext_vector_type(16)));
typedef float f32x32v __attribute__((ext_vector_type(32)));
typedef float f32x16 __attribute__((ext_vector_type(16)));
typedef int i32x8 __attribute__((ext_vector_type(8)));
typedef int i32x4 __attribute__((ext_vector_type(4)));
typedef unsigned u32x6 __attribute__((ext_vector_type(6)));
#define LAS __attribute__((address_space(3)))

__device__ __forceinline__ unsigned pack_bf16(float lo, float hi) {
  f32x2 v = {lo, hi};
  bf16v2 b = __builtin_convertvector(v, bf16v2);
  return *(unsigned*)&b;
}
__device__ __forceinline__ bf16_t f2bf(float f) { return (bf16_t)(pack_bf16(f, 0.f) & 0xffffu); }
__device__ __forceinline__ float bf2f(bf16_t b) { return __uint_as_float(((unsigned)b) << 16); }
__device__ __forceinline__ float bflo(unsigned u) { return __uint_as_float(u << 16); }
__device__ __forceinline__ float bfhi(unsigned u) { return __uint_as_float(u & 0xffff0000u); }

__constant__ unsigned char kBucket[128] = {
    0, 1, 2, 3, 4, 5, 6, 7, 8, 9, 10, 11, 12, 13, 14, 15, 16, 16, 16, 17, 17, 18, 18, 18, 19, 19, 19, 20, 20, 20, 20, 21,
    21, 21, 21, 22, 22, 22, 22, 22, 23, 23, 23, 23, 23, 23, 24, 24, 24, 24, 24, 24, 25, 25, 25, 25, 25, 25, 25, 26, 26, 26, 26, 26,
    26, 26, 26, 27, 27, 27, 27, 27, 27, 27, 27, 27, 27, 28, 28, 28, 28, 28, 28, 28, 28, 28, 28, 29, 29, 29, 29, 29, 29, 29, 29, 29,
    29, 29, 29, 30, 30, 30, 30, 30, 30, 30, 30, 30, 30, 30, 30, 30, 30, 31, 31, 31, 31, 31, 31, 31, 31, 31, 31, 31, 31, 31, 31, 31};

__constant__ unsigned char kCandI[64] = {0, 0, 0, 0, 0, 0, 0, 0, 0, 0, 0, 0, 0, 0, 0, 0, 1, 1, 1, 1, 1, 1, 1, 1, 2, 2, 2, 2, 2, 3, 3, 3, 3, 4, 4, 4, 5, 5, 6, 6, 7, 7, 8, 9, 10, 11, 12, 13, 14, 15, 15, 15, 15, 15, 15, 15, 15, 15, 15, 15, 15, 15, 15, 15};
__constant__ unsigned char kCandJ[64] = {0, 1, 2, 3, 4, 5, 6, 7, 8, 9, 10, 11, 12, 13, 14, 15, 0, 1, 2, 3, 4, 5, 6, 7, 0, 1, 2, 3, 4, 0, 1, 2, 3, 0, 1, 2, 0, 1, 0, 1, 0, 1, 0, 0, 0, 0, 0, 0, 0, 0, 15, 15, 15, 15, 15, 15, 15, 15, 15, 15, 15, 15, 15, 15};

__device__ __forceinline__ float wave_sum(float v) {
  for (int o = 32; o > 0; o >>= 1) v += __shfl_xor(v, o);
  return v;
}
__device__ __forceinline__ float wave_max(float v) {
  for (int o = 32; o > 0; o >>= 1) v = fmaxf(v, __shfl_xor(v, o));
  return v;
}
__device__ __forceinline__ float silu_f(float x) { return x / (1.f + expf(-x)); }
__device__ __forceinline__ float softplus_f(float x) { return fmaxf(x, 0.f) + log1pf(expf(-fabsf(x))); }

constexpr size_t al256(size_t x) { return (x + 255) & ~(size_t)255; }
constexpr size_t WS_CTL = 0;
constexpr size_t WS_WINT = 65536;
constexpr size_t WS_WDTT = WS_WINT + (size_t)NPROJ * DM * 2;
constexpr size_t WS_WOUTT = WS_WDTT + (size_t)16 * DM * 2;
constexpr size_t WS_WQT = WS_WOUTT + (size_t)DM * DM * 2;
constexpr size_t WS_KEYS = WS_WQT + (size_t)DM * DM * 2;
constexpr size_t WS_UB = WS_KEYS + (size_t)16 * 128 * 128 * 2;
constexpr size_t WS_VB = WS_UB + (size_t)NEXP * DM * 2;
constexpr size_t WS_HNB = WS_VB + (size_t)NEXP * DM * 2;
constexpr size_t WS_PROJ = WS_HNB + (size_t)(T + 16) * DM * 2;
constexpr size_t WS_DTRAW = WS_PROJ + (size_t)T * NPROJ * 2;
constexpr size_t WS_PROJM = WS_DTRAW + (size_t)T * 16 * 4;
constexpr size_t WS_PROJMB = al256(WS_PROJM + (size_t)16 * DPROJ * 4);
constexpr size_t WS_H1B = al256(WS_PROJMB + (size_t)16 * DPROJ * 2);
constexpr size_t WS_SSQH1 = WS_H1B + (size_t)T * DM * 2;
constexpr size_t WS_STOP = al256(WS_SSQH1 + (size_t)T * 32 * 4);
constexpr size_t WS_ITOP = WS_STOP + (size_t)T * 256 * 4;
constexpr size_t WS_ACSG = al256(WS_ITOP + (size_t)T * 256 * 4);
constexpr size_t WS_CCB = WS_ACSG + (size_t)T * 16 * 4;
constexpr size_t WS_YPART = WS_CCB + (size_t)T * 256 * 2;
constexpr size_t WS_SG = WS_YPART + (size_t)T * 1024 * 4;
constexpr size_t WS_SMETA = WS_SG + (size_t)1024 * 8192 * 4;
constexpr size_t WS_HPREV = al256(WS_SMETA + (size_t)16 * 8192 * 4);
constexpr size_t WS_USC = al256(WS_HPREV + (size_t)1024 * 8192 * 2);
constexpr size_t WS_VSC = WS_USC + (size_t)NEXP * 4;
constexpr size_t WS_SCR = al256(WS_VSC + (size_t)NEXP * 4);
constexpr size_t WS_P6IDS = WS_YPART;
constexpr size_t WS_P6GTS = WS_P6IDS + (size_t)T * 128 * 4;
constexpr size_t WS_P6USC = WS_P6GTS + (size_t)T * 128 * 4;
constexpr size_t WS_P6XES = WS_P6USC + (size_t)T * 128 * 4;
constexpr size_t WS_P6XQ = WS_PROJ;
constexpr size_t WS_HPART = WS_SG;
}

namespace pg8 {
#define PG8_LAS __attribute__((address_space(3)))
constexpr int BM = 256, BK = 64, HALF = 128, HTB = HALF * BK * 2, STAGE_BYTES = 8 * HTB, NXCD = 8, WGM = 8;
__host__ __device__ __forceinline__ int lds_byte(int r, int c) { const int st = (r >> 4) * 2 + (c >> 5), rr = r & 15, cc = c & 31, ob = rr * 64 + cc * 2; return st * 1024 + (ob ^ (((ob >> 9) & 1) << 5)); }
__host__ __device__ __forceinline__ void stage_rc(int b, int& R, int& C) { const int st = b / 1024, sb = b % 1024, swz = sb ^ (((sb >> 9) & 1) << 5); R = (st >> 1) * 16 + swz / 64; C = (st & 1) * 32 + (swz % 64) / 2; }
__host__ __device__ __forceinline__ int perm32(int rho) { const int n = rho >> 4, i = rho & 15; return 8 * (i >> 2) + 4 * n + (i & 3); }
struct Unit { int pm, pn; };
struct Gemm { const bf16_t* A; const bf16_t* Bt; int M, N, K; };
struct StaticOrder {
    int nM, nN, nwg, G, c;
    __host__ __device__ void init(int M, int N, int G_, int c_) { nM = M / BM; nN = N / BM; nwg = nM * nN; G = G_; c = c_; }
    __host__ __device__ bool next(int i, Unit& u) const {
        const long L = (long)i * G + c; if (L >= nwg) return false;
        int wgid = (int)L; { const int q = nwg / NXCD, r = nwg % NXCD, xcd = wgid % NXCD, off = wgid / NXCD; wgid = (xcd < r ? xcd * (q + 1) : r * (q + 1) + (xcd - r) * q) + off; }
        const int nig = WGM * nN, gid = wgid / nig, fm = gid * WGM, gsz = (nM - fm) < WGM ? (nM - fm) : WGM;
        u.pm = fm + ((wgid % nig) % gsz); u.pn = (wgid % nig) / gsz; return true;
    }
    __device__ __forceinline__ void a_ready(const Unit&) const {}
    __device__ __forceinline__ void done(const Unit&) const {}
};
struct EpiBf16 {
    static constexpr bool PERM = true, AFTER_DRAIN = false;
    bf16_t* O; int ldc;
    __device__ __forceinline__ void operator()(const f32x4 (&acc)[2][2][4][2], const Unit& u, int wr, int wc, int fr, int fq) const {
        const int row0 = u.pm * BM + wr * 64 + fr; const int col0 = u.pn * BM + wc * 32 + 8 * fq;
        const __amdgpu_buffer_rsrc_t rsrc = __builtin_amdgcn_make_buffer_rsrc(O, 0, 0x7fffffff, 0x00020000);
#pragma unroll
        for (int ai = 0; ai < 2; ++ai)
#pragma unroll
            for (int m = 0; m < 4; ++m) { const unsigned boff = (unsigned)(((size_t)(row0 + ai * HALF + m * 16) * ldc + col0) * 2);
#pragma unroll
                for (int bj = 0; bj < 2; ++bj) { const f32x4 v0 = acc[ai][bj][m][0], v1 = acc[ai][bj][m][1];
                    u32x4 w; w.x = pack_bf16(v0[0], v0[1]); w.y = pack_bf16(v0[2], v0[3]); w.z = pack_bf16(v1[0], v1[1]); w.w = pack_bf16(v1[2], v1[3]);
                    __builtin_amdgcn_raw_buffer_store_b128(w, rsrc, boff + bj * HALF * 2, 0, 16); } }
    }
};

struct EpiRes {
    static constexpr bool PERM = true, AFTER_DRAIN = false;
    const float* X; bf16_t* HB; float* SSQ;
    __device__ __forceinline__ void operator()(const f32x4 (&acc)[2][2][4][2], const Unit& u, int wr, int wc, int fr, int fq) const {
        const int row0 = u.pm * BM + wr * 64 + fr; const int col0 = u.pn * BM + wc * 32 + 8 * fq;
#pragma unroll
        for (int ai = 0; ai < 2; ++ai) {
            f32x4 xr[4][2][2];
#pragma unroll
            for (int m = 0; m < 4; ++m) { const size_t off = (size_t)(row0 + ai * HALF + m * 16) * DM + col0;
#pragma unroll
                for (int bj = 0; bj < 2; ++bj) { xr[m][bj][0] = __builtin_nontemporal_load((const f32x4*)(X + off + bj * HALF)); xr[m][bj][1] = __builtin_nontemporal_load((const f32x4*)(X + off + bj * HALF + 4)); } }
#pragma unroll
            for (int m = 0; m < 4; ++m) { const int row = row0 + ai * HALF + m * 16; const size_t off = (size_t)row * DM + col0; float ss = 0.f;
#pragma unroll
                for (int bj = 0; bj < 2; ++bj) {
                    const f32x4 v0 = acc[ai][bj][m][0] + xr[m][bj][0], v1 = acc[ai][bj][m][1] + xr[m][bj][1];
                    u32x4 w; w.x = pack_bf16(v0[0], v0[1]); w.y = pack_bf16(v0[2], v0[3]); w.z = pack_bf16(v1[0], v1[1]); w.w = pack_bf16(v1[2], v1[3]);
                    *(u32x4*)(HB + off + bj * HALF) = w;
                    ss += v0[0] * v0[0] + v0[1] * v0[1] + v0[2] * v0[2] + v0[3] * v0[3] + v1[0] * v1[0] + v1[1] * v1[1] + v1[2] * v1[2] + v1[3] * v1[3]; }
                ss += __shfl_xor(ss, 16); ss += __shfl_xor(ss, 32);
                if (fq == 0) SSQ[(size_t)row * 32 + u.pn * 4 + wc] = ss; }
        }
    }
};
struct EpiF32 {
    static constexpr bool PERM = true, AFTER_DRAIN = false;
    float* C; int ldc;
    __device__ __forceinline__ void operator()(const f32x4 (&acc)[2][2][4][2], const Unit& u, int wr, int wc, int fr, int fq) const {
        const int row0 = u.pm * BM + wr * 64 + fr; const int col0 = u.pn * BM + wc * 32 + 8 * fq;
#pragma unroll
        for (int ai = 0; ai < 2; ++ai)
#pragma unroll
            for (int m = 0; m < 4; ++m) { float* rowp = C + (size_t)(row0 + ai * HALF + m * 16) * ldc + col0;
#pragma unroll
                for (int bj = 0; bj < 2; ++bj) { *(f32x4*)(rowp + bj * HALF) = acc[ai][bj][m][0]; *(f32x4*)(rowp + bj * HALF + 4) = acc[ai][bj][m][1]; } }
    }
};

struct EpiScores {
    static constexpr bool PERM = true, AFTER_DRAIN = true;
    const bf16_t* KEYS;
    float* STOP; int* ITOP;
    static constexpr int QLD = 264;
    __device__ __forceinline__ void fused(f32x4 (&acc)[2][2][4][2], const Unit& u, int wr, int wc, int fr, int fq, PG8_LAS unsigned char* lds, int wid, int lane) const {
        PG8_LAS bf16_t* Q = (PG8_LAS bf16_t*)lds;
#pragma unroll
        for (int ai = 0; ai < 2; ++ai)
#pragma unroll
            for (int m = 0; m < 4; ++m) { const int row = ai * HALF + wr * 64 + m * 16 + fr;
#pragma unroll
                for (int bj = 0; bj < 2; ++bj) { const f32x4 v0 = acc[ai][bj][m][0], v1 = acc[ai][bj][m][1];
                    u32x4 w; w.x = pack_bf16(v0[0], v0[1]); w.y = pack_bf16(v0[2], v0[3]); w.z = pack_bf16(v1[0], v1[1]); w.w = pack_bf16(v1[2], v1[3]);
                    *(PG8_LAS u32x4*)(Q + row * QLD + bj * HALF + wc * 32 + 8 * fq) = w; } }
        __syncthreads();
        const int h = u.pn;
#pragma unroll 1
        for (int c = 0; c < 2; ++c) {
            f32x4 sc[8][2];
#pragma unroll
            for (int kf = 0; kf < 8; ++kf) { sc[kf][0] = (f32x4){0.f, 0.f, 0.f, 0.f}; sc[kf][1] = (f32x4){0.f, 0.f, 0.f, 0.f}; }
            const bf16_t* kb = KEYS + (size_t)((h * 2 + c) * 128 + fr) * 128 + 8 * fq;
            const PG8_LAS bf16_t* qb = Q + (wid * 32 + fr) * QLD + c * 128 + 8 * fq;
#pragma unroll
            for (int ks = 0; ks < 4; ++ks) {
                const bf16x8 q0 = *(const PG8_LAS bf16x8*)(qb + 32 * ks), q1 = *(const PG8_LAS bf16x8*)(qb + 16 * QLD + 32 * ks);
#pragma unroll
                for (int kf = 0; kf < 8; ++kf) { const bf16x8 kv = *(const bf16x8*)(kb + (size_t)kf * 16 * 128 + 32 * ks);
                    sc[kf][0] = __builtin_amdgcn_mfma_f32_16x16x32_bf16(kv, q0, sc[kf][0], 0, 0, 0);
                    sc[kf][1] = __builtin_amdgcn_mfma_f32_16x16x32_bf16(kv, q1, sc[kf][1], 0, 0, 0); }
            }
#pragma unroll
            for (int tf = 0; tf < 2; ++tf) {
                int v[32];
#pragma unroll
                for (int kf = 0; kf < 8; ++kf)
#pragma unroll
                    for (int r = 0; r < 4; ++r) {
                        const int bts = (int)__float_as_uint(sc[kf][tf][r]);
                        const int srt = bts ^ ((bts >> 31) & 0x7fffffff);
                        v[kf * 4 + r] = (srt & ~127) | (16 * kf + 4 * fq + r);
                    }
#pragma unroll
                for (int k = 2; k <= 32; k <<= 1)
#pragma unroll
                    for (int j = k >> 1; j > 0; j >>= 1)
#pragma unroll
                        for (int i = 0; i < 32; ++i) {
                            const int l = i ^ j;
                            if (l > i) {
                                const int x = v[i], y = v[l];
                                const int hi_ = x > y ? x : y, lo_ = x > y ? y : x;
                                if ((i & k) == 0) { v[i] = hi_; v[l] = lo_; } else { v[i] = lo_; v[l] = hi_; }
                            }
                        }
#pragma unroll
                for (int step = 0; step < 2; ++step) {
                    const int xm = step == 0 ? 16 : 32;
                    int m[16];
#pragma unroll
                    for (int i = 0; i < 16; ++i) { const int o = __shfl_xor(v[15 - i], xm); m[i] = v[i] > o ? v[i] : o; }
#pragma unroll
                    for (int j = 8; j > 0; j >>= 1)
#pragma unroll
                        for (int i = 0; i < 16; ++i) {
                            const int l = i ^ j;
                            if (l > i) { const int x = m[i], y = m[l]; m[i] = x > y ? x : y; m[l] = x > y ? y : x; }
                        }
#pragma unroll
                    for (int i = 0; i < 16; ++i) v[i] = m[i];
                }
                if (fq == 0) {
                    const size_t obase = ((size_t)(u.pm * BM + wid * 32 + tf * 16 + fr) * 16 + h * 2 + c) * 16;
#pragma unroll
                    for (int q4 = 0; q4 < 4; ++q4) {
                        f32x4 sv; u32x4 iv;
#pragma unroll
                        for (int i = 0; i < 4; ++i) {
                            const int key = v[4 * q4 + i], srt = key & ~127;
                            sv[i] = __uint_as_float((unsigned)(srt ^ ((srt >> 31) & 0x7fffffff)));
                            iv[i] = (unsigned)(key & 127);
                        }
                        *(f32x4*)(STOP + obase + 4 * q4) = sv;
                        *(u32x4*)(ITOP + obase + 4 * q4) = iv;
                    }
                }
            }
        }
    }
};

template <class Epi, class Sched>
__device__ __forceinline__ void gemm_phase(PG8_LAS unsigned char* lds, const Gemm g, const Sched& S, const Epi& E) {
    int tid_ = threadIdx.x; asm volatile("" : "+v"(tid_));
    const int tid = tid_, wid = __builtin_amdgcn_readfirstlane(tid >> 6), lane = tid & 63, wr = wid >> 2, wc = wid & 3, fr = lane & 15, fq = lane >> 4;
    const int K = g.K, nt = K / BK;
    unsigned voffA[2], voffB[2];
#pragma unroll
    for (int i = 0; i < 2; ++i) { int R, C; stage_rc(tid * 16 + i * 8192, R, C); const int Rb = Epi::PERM ? ((R & ~31) + perm32(R & 31)) : R;
        voffA[i] = (unsigned)(R * K + C) * 2u; voffB[i] = (unsigned)(Rb * K + C) * 2u; }
    const size_t kstep = (size_t)(BK * 2);
    const size_t hstep = (size_t)HALF * K * 2;
    const size_t tstep = 2 * hstep;
    const unsigned ldsw = (unsigned)wid * 1024u;
    const int aoff = lds_byte(wr * 64 + fr, fq * 8), boff = lds_byte(wc * 32 + fr, fq * 8);
#define PG8_SA(b, h) (((b) * 2 + (h)) * HTB)
#define PG8_SB(b, h) ((4 + (b) * 2 + (h)) * HTB)
#define PG8_STAGE(bufoff, gbase, voff) do { _Pragma("unroll") for (int _i = 0; _i < 2; ++_i) \
        __builtin_amdgcn_global_load_lds((const unsigned*)((const char*)(gbase) + (voff)[_i]), (PG8_LAS unsigned*)(lds + (bufoff) + ldsw + _i * 8192), 16, 0, 0); } while (0)
#define PG8_LDA(dst, b, h) do { _Pragma("unroll") for (int m = 0; m < 4; ++m) _Pragma("unroll") for (int k = 0; k < 2; ++k) dst[m][k] = *(const PG8_LAS bf16x8*)(lds + PG8_SA(b, h) + aoff + m * 2048 + k * 1024); } while (0)
#define PG8_LDB(dst, b, h) do { _Pragma("unroll") for (int n = 0; n < 2; ++n) _Pragma("unroll") for (int k = 0; k < 2; ++k) dst[n][k] = *(const PG8_LAS bf16x8*)(lds + PG8_SB(b, h) + boff + n * 2048 + k * 1024); } while (0)
#define PG8_MMA(ai, bj, At, Bt) do { __builtin_amdgcn_s_setprio(1); _Pragma("unroll") for (int m = 0; m < 4; ++m) _Pragma("unroll") for (int n = 0; n < 2; ++n) _Pragma("unroll") for (int k = 0; k < 2; ++k) \
        acc[ai][bj][m][n] = __builtin_amdgcn_mfma_f32_16x16x32_bf16(Bt[n][k], At[m][k], acc[ai][bj][m][n], 0, 0, 0); __builtin_amdgcn_s_setprio(0); } while (0)
#define PG8_WAIT_V(n) asm volatile("s_waitcnt vmcnt(" #n ")" ::: "memory")
#define PG8_WAIT_L(n) asm volatile("s_waitcnt lgkmcnt(" #n ")" ::: "memory")
#define PG8_BAR __builtin_amdgcn_s_barrier()
#define PG8_SCHED __builtin_amdgcn_sched_barrier(0)
    Unit cur, nxt; int ui = 0;
    if (!S.next(0, cur)) return;
    f32x4 acc[2][2][4][2];
#pragma unroll
    for (int a = 0; a < 2; ++a)
#pragma unroll
        for (int b = 0; b < 2; ++b)
#pragma unroll
            for (int m = 0; m < 4; ++m)
#pragma unroll
                for (int n = 0; n < 2; ++n) acc[a][b][m][n] = (f32x4){0.f, 0.f, 0.f, 0.f};
    bf16x8 At[4][2], B0[2][2], B1[2][2];
    const char* cA = (const char*)g.A + (size_t)cur.pm * tstep; const char* cB = (const char*)g.Bt + (size_t)cur.pn * tstep;
    S.a_ready(cur);
    PG8_STAGE(PG8_SB(0, 0), cB, voffB); PG8_STAGE(PG8_SA(0, 0), cA, voffA); PG8_STAGE(PG8_SB(0, 1), cB + hstep, voffB); PG8_STAGE(PG8_SA(0, 1), cA + hstep, voffA);
    if (wr == 1) PG8_BAR;
    PG8_WAIT_V(4); PG8_BAR;
    PG8_STAGE(PG8_SB(1, 0), cB + kstep, voffB); PG8_STAGE(PG8_SA(1, 0), cA + kstep, voffA); PG8_STAGE(PG8_SB(1, 1), cB + hstep + kstep, voffB);
    PG8_WAIT_V(6); PG8_BAR;
    for (;;) {
        const bool has_next = S.next(ui + 1, nxt);
        const char* nA = has_next ? (const char*)g.A + (size_t)nxt.pm * tstep : cA; const char* nB = has_next ? (const char*)g.Bt + (size_t)nxt.pn * tstep : cB;
        for (int t = 0; t < nt; t += 2) {
            const bool last = (t == nt - 2);
            const char* a1 = cA + (size_t)(t + 1) * kstep;
            const char* a2 = last ? nA : cA + (size_t)(t + 2) * kstep; const char* b2 = last ? nB : cB + (size_t)(t + 2) * kstep;
            const char* a3 = a2 + kstep; const char* b3 = b2 + kstep;
            if (last && has_next) S.a_ready(nxt);
            PG8_LDB(B0, 0, 0); PG8_SCHED; PG8_LDA(At, 0, 0); PG8_STAGE(PG8_SA(1, 1), a1 + hstep, voffA);
            PG8_WAIT_L(8); PG8_BAR; PG8_WAIT_L(0); PG8_MMA(0, 0, At, B0); PG8_BAR; PG8_SCHED;
            PG8_LDB(B1, 0, 1); PG8_STAGE(PG8_SB(0, 0), b2, voffB);
            PG8_BAR; PG8_WAIT_L(0); PG8_MMA(0, 1, At, B1); PG8_BAR;
            PG8_LDA(At, 0, 1); PG8_STAGE(PG8_SA(0, 0), a2, voffA);
            PG8_BAR; PG8_WAIT_L(0); PG8_MMA(1, 0, At, B0); PG8_BAR; PG8_SCHED;
            PG8_STAGE(PG8_SB(0, 1), b2 + hstep, voffB);
            PG8_WAIT_V(6); PG8_BAR; PG8_MMA(1, 1, At, B1); PG8_BAR;
            PG8_LDB(B0, 1, 0); PG8_SCHED; PG8_LDA(At, 1, 0); PG8_STAGE(PG8_SA(0, 1), a2 + hstep, voffA);
            PG8_WAIT_L(8); PG8_BAR; PG8_WAIT_L(0); PG8_MMA(0, 0, At, B0); PG8_BAR; PG8_SCHED;
            PG8_LDB(B1, 1, 1); PG8_STAGE(PG8_SB(1, 0), b3, voffB);
            PG8_BAR; PG8_WAIT_L(0); PG8_MMA(0, 1, At, B1); PG8_BAR;
            PG8_LDA(At, 1, 1); PG8_STAGE(PG8_SA(1, 0), a3, voffA);
            PG8_BAR; PG8_WAIT_L(0); PG8_MMA(1, 0, At, B0); PG8_BAR; PG8_SCHED;
            PG8_STAGE(PG8_SB(1, 1), b3 + hstep, voffB);
            PG8_WAIT_V(6); PG8_BAR; PG8_MMA(1, 1, At, B1); PG8_BAR;
        }
        if constexpr (!Epi::AFTER_DRAIN) { E(acc, cur, wr, wc, fr, fq); S.done(cur); }
        if (!has_next) break;
#pragma unroll
        for (int a = 0; a < 2; ++a)
#pragma unroll
            for (int b = 0; b < 2; ++b)
#pragma unroll
                for (int m = 0; m < 4; ++m)
#pragma unroll
                    for (int n = 0; n < 2; ++n) acc[a][b][m][n] = (f32x4){0.f, 0.f, 0.f, 0.f};
        cur = nxt; cA = nA; cB = nB; ++ui;
    }
    PG8_WAIT_V(0);
    if (wr == 0) PG8_BAR;
    PG8_BAR;
    if constexpr (Epi::AFTER_DRAIN) { E.fused(acc, cur, wr, wc, fr, fq, lds, wid, lane); S.done(cur); }
#undef PG8_SA
#undef PG8_SB
#undef PG8_STAGE
#undef PG8_LDA
#undef PG8_LDB
#undef PG8_MMA
#undef PG8_WAIT_V
#undef PG8_WAIT_L
#undef PG8_BAR
#undef PG8_SCHED
}
}

#define XB_TMO      128
#define XB_XCNT(j)  (256  + 64 * (j))
#define XB_XSUB(j)  (1280 + 64 * (j))
#define XB_XGEN(j)  (2304 + 64 * (j))
#define XB_TOP      3328
#define XB_TOPGEN   3392
#define XCD_BAR_WORDS 3456
#define XB_SPIN_CAP (1u << 22)
__device__ __forceinline__ unsigned xb_ld(unsigned* p)              { return __hip_atomic_load(p, __ATOMIC_RELAXED, __HIP_MEMORY_SCOPE_AGENT); }
__device__ __forceinline__ unsigned xb_add(unsigned* p, unsigned v) { return __hip_atomic_fetch_add(p, v, __ATOMIC_RELAXED, __HIP_MEMORY_SCOPE_AGENT); }
__device__ __forceinline__ unsigned xb_xcc_id() { return (unsigned)__builtin_amdgcn_s_getreg((3 << 11) | 20) & 0xFu; }
#define XB_SPIN(cond, bar) do { unsigned _sp = 0; while (cond) { __builtin_amdgcn_s_sleep(1); \
    if ((++_sp & 255u) == 0u) { if (xb_ld(&(bar)[XB_TMO])) break; if (_sp > XB_SPIN_CAP) { atomicAdd(&(bar)[XB_TMO], 1u); break; } } } } while (0)
struct XcdBarrier { unsigned* bar; unsigned x; volatile LAS unsigned* st; };
__device__ __forceinline__ XcdBarrier xcd_barrier_post(unsigned* bar, volatile LAS unsigned* st) {
    XcdBarrier b; b.bar = bar; b.x = xb_xcc_id(); b.st = st;
    if (threadIdx.x == 0) (void)xb_add(&bar[XB_XCNT(b.x)], 1u);
    return b;
}
__device__ __forceinline__ void xcd_barrier_complete(unsigned* bar, unsigned x, unsigned& nloc, unsigned& nx) {
    const unsigned G = gridDim.x * gridDim.y * gridDim.z;
    unsigned sum, cnt, mine, sp = 0u;
    for (;;) {
        sum = 0u; cnt = 0u; mine = 0u;
#pragma unroll
        for (unsigned j = 0; j < 16; ++j) { const unsigned c = xb_ld(&bar[XB_XCNT(j)]); sum += c; cnt += (c > 0u) ? 1u : 0u; mine = (j == x) ? c : mine; }
        if (sum == G) break;
        __builtin_amdgcn_s_sleep(1);
        if ((++sp & 255u) == 0u) { if (xb_ld(&bar[XB_TMO])) break; if (sp > XB_SPIN_CAP) { atomicAdd(&bar[XB_TMO], 1u); break; } }
    }
    nloc = mine > 0u ? mine : 1u; nx = cnt > 0u ? cnt : 1u;
}
__device__ __forceinline__ void xcd_barrier(const XcdBarrier& b) {
    asm volatile("s_waitcnt vmcnt(0)" ::: "memory");
    __syncthreads();
    if (threadIdx.x == 0) {
        unsigned* bar = b.bar;
        const unsigned bx = xb_xcc_id();
        __builtin_amdgcn_s_waitcnt(0);
        unsigned nloc = b.st[0], nx = b.st[1];
        if (nloc == 0u) { xcd_barrier_complete(bar, bx, nloc, nx); b.st[0] = nloc; b.st[1] = nx; }
        const unsigned old = xb_add(&bar[XB_XSUB(bx)], 1u);
        const unsigned gen = old / nloc;
        if (old + 1u == (gen + 1u) * nloc) {
            __builtin_amdgcn_fence(__ATOMIC_RELEASE, "agent");
            asm volatile("s_waitcnt vmcnt(0)" ::: "memory");
            const unsigned og = xb_add(&bar[XB_TOP], 1u);
            const unsigned tg = og / nx;
            if (og + 1u == (tg + 1u) * nx) xb_add(&bar[XB_TOPGEN], 1u);
            else XB_SPIN(xb_ld(&bar[XB_TOPGEN]) == tg, bar);
            __builtin_amdgcn_fence(__ATOMIC_ACQUIRE, "agent");
            xb_add(&bar[XB_XGEN(bx)], 1u);
            asm volatile("s_waitcnt vmcnt(0)" ::: "memory");
        } else {
            XB_SPIN(xb_ld(&bar[XB_XGEN(bx)]) == gen, bar);
            __builtin_amdgcn_fence(__ATOMIC_ACQUIRE, "agent");
            asm volatile("s_waitcnt vmcnt(0)" ::: "memory");
        }
    }
    __syncthreads();
}

namespace {
struct Params {
  const float *x, *meta, *rel_bias, *ln_mix, *w_in, *sinks, *conv_w, *conv_b, *dt_bias, *a_log, *d_skip, *attn_norm_w,
      *ssm_norm_w, *w_out, *ln_ffn, *wq, *keys, *U, *V, *ln_final;
  float* out;
  unsigned char* ws;
};

__device__ __forceinline__ void p0_transpose_tile(const float* __restrict__ W, int ldw, bf16_t* __restrict__ Wt, const float* sc0,
                                                  const float* sc1, int k0, int n0, float* tile) {
  int tid = threadIdx.x; asm volatile("" : "+v"(tid));
  {
    const int r = tid >> 6, c4 = (tid & 63) * 4;
    f32x4 v[8];
#pragma unroll
    for (int i = 0; i < 8; ++i) v[i] = __builtin_nontemporal_load((const f32x4*)(W + (size_t)(k0 + r + 8 * i) * ldw + n0 + c4));
#pragma unroll
    for (int i = 0; i < 8; ++i) {
      float s = 1.f;
      const int k = k0 + r + 8 * i;
      if (sc0) s = k < 1024 ? sc0[k] : sc1[k - 1024];
      float* q = tile + (r + 8 * i) * 257 + c4;
      q[0] = v[i][0] * s; q[1] = v[i][1] * s; q[2] = v[i][2] * s; q[3] = v[i][3] * s;
    }
  }
  __syncthreads();
#pragma unroll
  for (int it = 0; it < 4; ++it) {
    const int task = it * NTHREADS + tid;
    const int n = task >> 3, kc = (task & 7) * 8;
    float v[8];
#pragma unroll
    for (int j = 0; j < 8; ++j) v[j] = tile[(kc + j) * 257 + n];
    u32x4 w; w.x = pack_bf16(v[0], v[1]); w.y = pack_bf16(v[2], v[3]); w.z = pack_bf16(v[4], v[5]); w.w = pack_bf16(v[6], v[7]);
    *(u32x4*)(Wt + (size_t)(n0 + n) * DM + k0 + kc) = w;
  }
  __syncthreads();
}

__device__ __forceinline__ void phase0(const Params& p, float* ldsf, int bid, int nblk) {
  int tid = threadIdx.x; asm volatile("" : "+v"(tid));
  const int lane = tid & 63, wid = tid >> 6;
  bf16_t* w_inT = (bf16_t*)(p.ws + WS_WINT);
  bf16_t* w_dtT = (bf16_t*)(p.ws + WS_WDTT);
  bf16_t* w_outT = (bf16_t*)(p.ws + WS_WOUTT);
  bf16_t* wqT = (bf16_t*)(p.ws + WS_WQT);
  bf16_t* keysb = (bf16_t*)(p.ws + WS_KEYS);
  unsigned char* ub = p.ws + WS_UB;
  unsigned char* vb = p.ws + WS_VB;
  bf16_t* hnb = (bf16_t*)(p.ws + WS_HNB);
  constexpr int U_HN = (TA + 7) / 8;
  constexpr int U_WIN = 32 * 16, U_WOUT = 32 * 8, U_WQ = 32 * 8, U_WDT = 1, U_KEYS = 64;
  constexpr int B_WIN = U_HN, B_WOUT = B_WIN + U_WIN, B_WQ = B_WOUT + U_WOUT, B_WDT = B_WQ + U_WQ, B_KEYS = B_WDT + U_WDT,
                B_U = B_KEYS + U_KEYS, B_END = B_U;
  for (int u = bid; u < B_END; u += nblk) {
    if (u < B_WIN) {
      const int t = u * 8 + wid;
      if (t < TA) {
        const float* src = t < T ? p.x + (size_t)t * DM : p.meta + (size_t)(t - T) * DM;
        float4 v[8];
        float ss = 0.f;
#pragma unroll
        for (int i = 0; i < 8; ++i) {
          { const f32x4 q_ = __builtin_nontemporal_load((const f32x4*)(src + (i * 64 + lane) * 4)); v[i].x = q_[0]; v[i].y = q_[1]; v[i].z = q_[2]; v[i].w = q_[3]; }
          ss += v[i].x * v[i].x + v[i].y * v[i].y + v[i].z * v[i].z + v[i].w * v[i].w;
        }
        ss = wave_sum(ss);
        const float r = rsqrtf(ss * (1.f / DM) + EPS);
#pragma unroll
        for (int i = 0; i < 8; ++i) {
          const float4 w = *(const float4*)(p.ln_mix + (i * 64 + lane) * 4);
          u32x2 o; o.x = pack_bf16(v[i].x * r * w.x, v[i].y * r * w.y); o.y = pack_bf16(v[i].z * r * w.z, v[i].w * r * w.w);
          *(u32x2*)(hnb + (size_t)t * DM + (i * 64 + lane) * 4) = o;
        }
      }
    } else if (u < B_WOUT) {
      const int i = u - B_WIN;
      p0_transpose_tile(p.w_in, DPROJ, w_inT, nullptr, nullptr, (i & 31) * 64, (i >> 5) * 256, ldsf);
    } else if (u < B_WQ) {
      const int i = u - B_WOUT;
      p0_transpose_tile(p.w_out, DM, w_outT, p.attn_norm_w, p.ssm_norm_w, (i & 31) * 64, (i >> 5) * 256, ldsf);
    } else if (u < B_WDT) {
      const int i = u - B_WQ;
      p0_transpose_tile(p.wq, DM, wqT, p.ln_ffn, p.ln_ffn + 1024, (i & 31) * 64, (i >> 5) * 256, ldsf);
    } else if (u < B_KEYS) {
      for (int idx = tid; idx < DM * 16; idx += NTHREADS) {
        const int k = idx >> 4, j = idx & 15;
        w_dtT[(size_t)j * DM + k] = f2bf(p.w_in[(size_t)k * DPROJ + NPROJ + j]);
      }
    } else if (u < B_U) {
      int tk = tid;
      asm volatile("" : "+v"(tk));
      const unsigned base = (unsigned)(u - B_KEYS) * 4096u + (unsigned)tk * 8u;
      const float4 a = *(const float4*)(p.keys + base), b = *(const float4*)(p.keys + base + 4);
      u32x4 w; w.x = pack_bf16(a.x, a.y); w.y = pack_bf16(a.z, a.w); w.z = pack_bf16(b.x, b.y); w.w = pack_bf16(b.z, b.w);
      *(u32x4*)(keysb + base) = w;
    }
  }
}

__device__ __forceinline__ void convert_tables(const Params& p, int bid, int nblk) {
  int tid = threadIdx.x; asm volatile("" : "+v"(tid));
  const int lane = tid & 63, wid = tid >> 6;
  unsigned char* ub = p.ws + WS_UB;
  unsigned char* vb = p.ws + WS_VB;
  {
    const int gw = bid * 8 + wid, nw = nblk * 8;
    auto load_row = [&](f32x4 (&a)[8], const int r2) __attribute__((always_inline)) {
      const float* src = (r2 < NEXP ? p.U + (size_t)r2 * DM : p.V + (size_t)(r2 - NEXP) * DM) + lane * 4;
#pragma unroll
      for (int j = 0; j < 8; ++j) a[j] = __builtin_nontemporal_load((const f32x4*)(src + 256 * j));
    };
    auto conv_row = [&](f32x4 (&a)[8], const int r2) __attribute__((always_inline)) {
      const bool isU = r2 < NEXP;
      const int row = isU ? r2 : r2 - NEXP;
      if (isU) {
#pragma unroll
        for (int j = 0; j < 8; ++j) a[j] *= *(const f32x4*)(p.ln_ffn + lane * 4 + 256 * j);
      }
      float amax = 0.f;
#pragma unroll
      for (int j = 0; j < 8; ++j) amax = fmaxf(amax, fmaxf(fmaxf(fabsf(a[j][0]), fabsf(a[j][1])), fmaxf(fabsf(a[j][2]), fabsf(a[j][3]))));
      amax = wave_max(amax);
      const float s4 = amax > 0.f ? 6.f / amax : 1.f;
      u32x4 w4;
#pragma unroll
      for (int j = 0; j < 4; ++j) {
        unsigned w = 0;
        w = __builtin_amdgcn_cvt_scalef32_pk_fp4_f32(w, a[2 * j][0] * s4, a[2 * j][1] * s4, 1.0f, 0);
        w = __builtin_amdgcn_cvt_scalef32_pk_fp4_f32(w, a[2 * j][2] * s4, a[2 * j][3] * s4, 1.0f, 1);
        w = __builtin_amdgcn_cvt_scalef32_pk_fp4_f32(w, a[2 * j + 1][0] * s4, a[2 * j + 1][1] * s4, 1.0f, 2);
        w = __builtin_amdgcn_cvt_scalef32_pk_fp4_f32(w, a[2 * j + 1][2] * s4, a[2 * j + 1][3] * s4, 1.0f, 3);
        w4[j] = w;
      }
      if (isU) *(u32x4*)(ub + (size_t)(lane >> 3) * ((size_t)NEXP * 128) + (size_t)row * 128 + (lane & 7) * 16) = w4;
      else *(u32x4*)(vb + (size_t)row * ROW4 + lane * 16) = w4;
      if (lane == 0) ((float*)(p.ws + (isU ? WS_USC : WS_VSC)))[row] = amax > 0.f ? amax * (1.f / 6.f) : 1.f;
    };
    f32x4 ra[8], rb[8];
    int r2 = gw;
    if (r2 < 2 * NEXP) load_row(ra, r2);
#pragma unroll 1
    for (; r2 < 2 * NEXP; r2 += 2 * nw) {
      if (r2 + nw < 2 * NEXP) load_row(rb, r2 + nw);
      conv_row(ra, r2);
      if (r2 + nw < 2 * NEXP) {
        if (r2 + 2 * nw < 2 * NEXP) load_row(ra, r2 + 2 * nw);
        conv_row(rb, r2 + nw);
      }
    }
  }
}

__device__ __forceinline__ void mini_gemm(const bf16_t* __restrict__ A, const bf16_t* __restrict__ Bt, float* __restrict__ out, int ldo,
                                          float* red, bf16_t* __restrict__ outb = nullptr) {
  int tid = threadIdx.x; asm volatile("" : "+v"(tid));
  const int lane = tid & 63, wid = tid >> 6, fr = lane & 15, fq = lane >> 4;
  f32x4 acc = {0.f, 0.f, 0.f, 0.f};
  const bf16_t* ap = A + (size_t)fr * DM + wid * 256 + fq * 8;
  const bf16_t* bp = Bt + (size_t)fr * DM + wid * 256 + fq * 8;
#pragma unroll
  for (int ks = 0; ks < 8; ++ks) {
    const bf16x8 a = *(const bf16x8*)(ap + ks * 32);
    const bf16x8 b = *(const bf16x8*)(bp + ks * 32);
    acc = __builtin_amdgcn_mfma_f32_16x16x32_bf16(a, b, acc, 0, 0, 0);
  }
#pragma unroll
  for (int r = 0; r < 4; ++r) red[wid * 256 + (4 * fq + r) * 16 + fr] = acc[r];
  __syncthreads();
  if (tid < 256) {
    float s = 0.f;
#pragma unroll
    for (int w = 0; w < 8; ++w) s += red[w * 256 + tid];
    out[(size_t)(tid >> 4) * ldo + (tid & 15)] = s;
    if (outb) outb[(size_t)(tid >> 4) * ldo + (tid & 15)] = f2bf(s);
  }
  __syncthreads();
}

__device__ __forceinline__ void phase1(const Params& p, unsigned char* lds, int bid, int nblk) {
  const bool stream_first = ((bid >> 3) & 1) != 0;
  if (stream_first) convert_tables(p, bid, nblk);
  const bf16_t* hnb = (const bf16_t*)(p.ws + WS_HNB);
  const bf16_t* w_inT = (const bf16_t*)(p.ws + WS_WINT);
  const bf16_t* w_dtT = (const bf16_t*)(p.ws + WS_WDTT);
  float* dtraw = (float*)(p.ws + WS_DTRAW);
  float* projm = (float*)(p.ws + WS_PROJM);
  constexpr int NU = 512 + 32 + 96 + 1;
  for (int u = bid; u < NU; u += nblk) {
    if (u < 512) {
      mini_gemm(hnb + (size_t)u * 16 * DM, w_dtT, dtraw + (size_t)u * 16 * 16, 16, (float*)lds);
    } else {
      const int j = u - 512;
      const int cf = j < 32 ? 64 + j : (j < 128 ? 160 + (j - 32) : 256);
      const bf16_t* bt = cf < 256 ? w_inT + (size_t)cf * 16 * DM : w_dtT;
      mini_gemm(hnb + (size_t)T * DM, bt, projm + cf * 16, DPROJ, (float*)lds, (bf16_t*)(p.ws + WS_PROJMB) + cf * 16);
    }
  }
  pg8::Gemm g{hnb, w_inT, T, NPROJ, DM};
  pg8::StaticOrder S; S.init(T, NPROJ, nblk, bid);
  pg8::EpiBf16 E{(bf16_t*)(p.ws + WS_PROJ), NPROJ};
  pg8::gemm_phase<pg8::EpiBf16, pg8::StaticOrder>((PG8_LAS unsigned char*)lds, g, S, E);
  if (!stream_first) convert_tables(p, bid, nblk);
}

__device__ __forceinline__ void phase4(const Params& p, unsigned char* lds, int bid, int nblk) {
  pg8::Gemm g{(const bf16_t*)(p.ws + WS_HNB), (const bf16_t*)(p.ws + WS_WOUTT), T, DM, DM};
  pg8::StaticOrder S; S.init(T, DM, nblk, bid);
  pg8::EpiRes E{p.x, (bf16_t*)(p.ws + WS_H1B), (float*)(p.ws + WS_SSQH1)};
  pg8::gemm_phase<pg8::EpiRes, pg8::StaticOrder>((PG8_LAS unsigned char*)lds, g, S, E);
}
__device__ __forceinline__ void phase5(const Params& p, unsigned char* lds, int bid, int nblk) {
  pg8::Gemm g{(const bf16_t*)(p.ws + WS_H1B), (const bf16_t*)(p.ws + WS_WQT), T, DM, DM};
  pg8::StaticOrder S; S.init(T, DM, nblk, bid);
  pg8::EpiScores E{(const bf16_t*)(p.ws + WS_KEYS), (float*)(p.ws + WS_STOP), (int*)(p.ws + WS_ITOP)};
  pg8::gemm_phase<pg8::EpiScores, pg8::StaticOrder>((PG8_LAS unsigned char*)lds, g, S, E);
}

__device__ __forceinline__ float dot2bf(unsigned a, unsigned b, float c) {
  return __builtin_amdgcn_fdot2_f32_bf16(*(bf16v2*)&a, *(bf16v2*)&b, c, false);
}
__device__ __forceinline__ void phase6a(const Params& p, unsigned char* lds, int bid, int nblk) {
  const int tid0 = threadIdx.x, lane0 = tid0 & 63, wid = __builtin_amdgcn_readfirstlane(tid0 >> 6);
  int* rid = (int*)(lds + wid * 1024);
  float* rgt = (float*)(lds + wid * 1024 + 512);
  unsigned* kbuf = (unsigned*)(lds + 8192 + wid * 256);
  const bf16_t* h1b = (const bf16_t*)(p.ws + WS_H1B);
  const float* usc = (const float*)(p.ws + WS_USC);
  const float* vsc = (const float*)(p.ws + WS_VSC);
  const float* ssq = (const float*)(p.ws + WS_SSQH1);
  const float* stop = (const float*)(p.ws + WS_STOP);
  const int* itop = (const int*)(p.ws + WS_ITOP);
  int* idsg = (int*)(p.ws + WS_P6IDS);
  float* gtsg = (float*)(p.ws + WS_P6GTS);
  float* usclg = (float*)(p.ws + WS_P6USC);
  unsigned char* xq = p.ws + WS_P6XQ;
  unsigned char* xes = p.ws + WS_P6XES;
  const int ci = kCandI[lane0], cj = kCandJ[lane0];
#pragma unroll 1
  for (int t = bid * 8 + wid; t < T; t += nblk * 8) {
    int tid = tid0; asm volatile("" : "+v"(tid));
    const int lane = tid & 63;
    const float part0 = lane < 32 ? ssq[(size_t)t * 32 + lane] : 0.f;
    const float rr = rsqrtf(wave_sum(part0) * (1.f / DM) + EPS);
    float svh[8];
    int ivh[8];
    u32x2 xrow[8];
#pragma unroll
    for (int j = 0; j < 8; ++j) xrow[j] = *(const u32x2*)(h1b + (size_t)t * DM + lane * 4 + 256 * j);
#pragma unroll
    for (int h = 0; h < 8; ++h) {
      const size_t lbase = ((size_t)t * 16 + h * 2) * 16 + (lane & 31);
      svh[h] = __builtin_nontemporal_load(stop + lbase);
      ivh[h] = __builtin_nontemporal_load(itop + lbase);
    }
#pragma unroll
    for (int h = 0; h < 8; ++h) {
      const float sv = svh[h];
      const int iv = ivh[h];
      float cand = (__shfl(sv, ci) + __shfl(sv, 16 + cj)) * rr;
      if (lane >= 50) cand = -INFINITY;
      unsigned key = __float_as_uint(cand);
      key = (key & 0x80000000u) ? ~key : (key | 0x80000000u);
      key = ((key >> 1) & ~63u) | (unsigned)(63 - lane);
      kbuf[lane] = key;
      unsigned rank = 0;
#pragma unroll
      for (int k4 = 0; k4 < 13; ++k4) {
        const u32x4 kk = *(const u32x4*)(kbuf + 4 * k4);
        rank += ((key - kk.x) >> 31) + ((key - kk.y) >> 31) + ((key - kk.z) >> 31) + ((key - kk.w) >> 31);
      }
      const float cmax = __int_as_float(__builtin_amdgcn_readfirstlane(__float_as_int(cand)));
      const float ex = __expf(cand - cmax);
      const int eidx = __shfl(iv, ci) * 128 + __shfl(iv, 16 + cj);
      if (rank < 16) { rid[h * 16 + rank] = eidx; rgt[h * 16 + rank] = ex; }
    }
    {
      const int e0 = rid[lane], e1 = rid[lane + 64];
      float g0 = rgt[lane], g1 = rgt[lane + 64];
      {
        float d0 = g0, d1 = g1;
#pragma unroll
        for (int o = 1; o < 16; o <<= 1) { d0 += __shfl_xor(d0, o); d1 += __shfl_xor(d1, o); }
        g0 /= d0; g1 /= d1;
      }
      const int r0 = e0 >> 10, r1 = e1 >> 10;
      const unsigned long long ltm = (1ull << lane) - 1ull;
      int run = 0, pos0 = 0, pos1 = 0;
#pragma unroll
      for (int R = 0; R < 16; ++R) {
        const unsigned long long m0 = __ballot(r0 == R), m1 = __ballot(r1 == R);
        const int c0 = __popcll(m0), c1 = __popcll(m1);
        if (r0 == R) pos0 = run + __popcll(m0 & ltm);
        if (r1 == R) pos1 = run + c0 + __popcll(m1 & ltm);
        run += c0 + c1;
      }
      const size_t tb = (size_t)t * 128;
      idsg[tb + pos0] = e0; gtsg[tb + pos0] = g0 * vsc[e0]; usclg[tb + pos0] = rr * usc[e0];
      idsg[tb + pos1] = e1; gtsg[tb + pos1] = g1 * vsc[e1]; usclg[tb + pos1] = rr * usc[e1];
    }
    {
      float r[32];
#pragma unroll
      for (int j = 0; j < 8; ++j) {
        r[4 * j + 0] = bflo(xrow[j].x); r[4 * j + 1] = bfhi(xrow[j].x); r[4 * j + 2] = bflo(xrow[j].y); r[4 * j + 3] = bfhi(xrow[j].y);
      }
#pragma unroll
      for (int term = 0; term < 2; ++term) {
        float m = 0.f;
#pragma unroll
        for (int j = 0; j < 32; ++j) m = fmaxf(m, fabsf(r[j]));
        const unsigned mb = __float_as_uint(m);
        int es = (int)(mb >> 23) - 1 - ((mb & 0x7fffffu) <= 0x700000u ? 1 : 0);
        es = es < 1 ? 1 : es;
        const float S = __uint_as_float((unsigned)es << 23), iS = __uint_as_float((unsigned)(254 - es) << 23);
        f32x16 v0, v1;
#pragma unroll
        for (int i = 0; i < 16; ++i) { v0[i] = r[2 * i] * iS; v1[i] = r[2 * i + 1] * iS; }
        const u32x6 q = __builtin_amdgcn_cvt_scalef32_2xpk16_fp6_f32(v0, v1, 1.0f);
        unsigned char* qp = xq + ((size_t)(t * 2 + term) * 64 + lane) * 24;
        { u32x2 w0 = {q[0], q[1]}, w1 = {q[2], q[3]}, w2 = {q[4], q[5]}; *(u32x2*)qp = w0; *(u32x2*)(qp + 8) = w1; *(u32x2*)(qp + 16) = w2; }
        xes[(size_t)(t * 2 + term) * 64 + lane] = (unsigned char)es;
        if (term == 0) {
          const f32x32v d = __builtin_amdgcn_cvt_scalef32_pk32_f32_fp6(q, 1.0f);
#pragma unroll
          for (int j = 0; j < 32; ++j) r[j] = fmaf(-S, d[j], r[j]);
        }
      }
    }
  }
}

__device__ __forceinline__ void phase6b(const Params& p, unsigned char* lds, int bid, int nblk) {
  int tid = threadIdx.x; asm volatile("" : "+v"(tid));
  const int lane = tid & 63, wid = __builtin_amdgcn_readfirstlane(tid >> 6);
  const unsigned char* ub = p.ws + WS_UB;
  const int* idsg = (const int*)(p.ws + WS_P6IDS);
  const unsigned char* xq = p.ws + WS_P6XQ;
  const unsigned char* xes = p.ws + WS_P6XES;
  float* hpart = (float*)(p.ws + WS_HPART);
  int* idl = (int*)(lds + wid * 16384);
  constexpr int NU = T * 8;
  const int us = nblk * 8;
  const int u0 = (nblk & 7) == 0 ? (((bid >> 3) * 8 + wid) * 8 + (bid & 7)) : (bid * 8 + wid);
  const int nun = u0 < NU ? (NU - u0 + us - 1) / us : 0;
  const int rho = (lane & 15) >> 1, cch = 4 * (lane & 1) + (lane >> 4);
  const bool st = (((lane & 15) >> 2) == (lane >> 4)) && !(lane & 1);
  const int paddr = 4 * ((((lane & 15) << 2) | (lane >> 4)));
  const float m0 = (lane & 3) == 0 ? 1.f : 0.f, m1 = (lane & 3) == 1 ? 1.f : 0.f, m2 = (lane & 3) == 2 ? 1.f : 0.f, m3 = (lane & 3) == 3 ? 1.f : 0.f;
#pragma unroll 1
  for (int base = 0; base < nun; base += 32) {
    const int nb = nun - base < 32 ? nun - base : 32;
#pragma unroll 1
    for (int i0 = 0; i0 < nb; i0 += 8) {
      u32x2 v[8];
#pragma unroll
      for (int j = 0; j < 8; ++j) {
        const int ic = i0 + j < nb ? i0 + j : nb - 1;
        v[j] = *(const u32x2*)(idsg + (size_t)((u0 + (base + ic) * us) >> 3) * 128 + lane * 2);
      }
#pragma unroll
      for (int j = 0; j < 8; ++j) if (i0 + j < nb) *(u32x2*)(idl + (i0 + j) * 128 + lane * 2) = v[j];
    }
    auto unit_of = [&](int i) __attribute__((always_inline)) { return u0 + (base + (i < nb ? i : nb - 1)) * us; };
    auto load_b = [&](u32x6& b0, u32x6& b1, int& e0, int& e1, const int i) __attribute__((always_inline)) {
      const int u = unit_of(i);
      const int t = u >> 3, L = 8 * (u & 7) + cch;
      const unsigned char* q0 = xq + ((size_t)(t * 2) * 64 + L) * 24;
      { const u32x2 w0 = *(const u32x2*)q0, w1 = *(const u32x2*)(q0 + 8), w2 = *(const u32x2*)(q0 + 16);
        b0[0] = w0.x; b0[1] = w0.y; b0[2] = w1.x; b0[3] = w1.y; b0[4] = w2.x; b0[5] = w2.y; }
      { const u32x2 w0 = *(const u32x2*)(q0 + 1536), w1 = *(const u32x2*)(q0 + 1536 + 8), w2 = *(const u32x2*)(q0 + 1536 + 16);
        b1[0] = w0.x; b1[1] = w0.y; b1[2] = w1.x; b1[3] = w1.y; b1[4] = w2.x; b1[5] = w2.y; }
      e0 = xes[(size_t)(t * 2) * 64 + L];
      e1 = xes[(size_t)(t * 2 + 1) * 64 + L];
    };
    auto issue_grp = [&](u32x4 (&ra)[16], const int g, const int i) __attribute__((always_inline)) {
      const int ic = i < nb ? i : nb - 1;
      const i32x4 idq = *(const i32x4*)(idl + ic * 128 + (lane >> 3) * 16 + 4 * g);
      const unsigned char* rb = ub + (size_t)(unit_of(i) & 7) * ((size_t)NEXP * 128);
#pragma unroll
      for (int k = 0; k < 4; ++k) ra[4 * g + k] = *(const u32x4*)(rb + (((unsigned)idq[k] << 7) + (unsigned)(lane & 7) * 16u));
    };
    auto comp_grp = [&](u32x4 (&ra)[16], const int g, const u32x6& b0, const u32x6& b1, const int e0, const int e1, float (&part)[16]) __attribute__((always_inline)) {
      const i32x8 B0_ = {(int)b0[0], (int)b0[1], (int)b0[2], (int)b0[3], (int)b0[4], (int)b0[5], 0, 0};
      const i32x8 B1_ = {(int)b1[0], (int)b1[1], (int)b1[2], (int)b1[3], (int)b1[4], (int)b1[5], 0, 0};
#pragma unroll
      for (int k = 4 * g; k < 4 * g + 4; ++k) {
        const i32x8 A_ = {__builtin_amdgcn_ds_bpermute(paddr, (int)ra[k][0]), __builtin_amdgcn_ds_bpermute(paddr, (int)ra[k][1]),
                          __builtin_amdgcn_ds_bpermute(paddr, (int)ra[k][2]), __builtin_amdgcn_ds_bpermute(paddr, (int)ra[k][3]), 0, 0, 0, 0};
        f32x4 c = {0.f, 0.f, 0.f, 0.f};
        c = __builtin_amdgcn_mfma_scale_f32_16x16x128_f8f6f4(A_, B0_, c, 4, 2, 0, 0x7f7f7f7f, 0, e0);
        c = __builtin_amdgcn_mfma_scale_f32_16x16x128_f8f6f4(A_, B1_, c, 4, 2, 0, 0x7f7f7f7f, 0, e1);
        float dv = fmaf(c[3], m3, fmaf(c[2], m2, fmaf(c[1], m1, c[0] * m0)));
        dv += __int_as_float(__builtin_amdgcn_mov_dpp(__float_as_int(dv), 0xB1, 0xF, 0xF, true));
        part[k] = dv;
      }
    };
    auto store_part = [&](const float (&part)[16], const int i) __attribute__((always_inline)) {
      if (st) {
        float* hp = hpart + (size_t)unit_of(i) * 128 + rho * 16;
#pragma unroll
        for (int q = 0; q < 4; ++q) { const f32x4 o = {part[4 * q], part[4 * q + 1], part[4 * q + 2], part[4 * q + 3]}; *(f32x4*)(hp + 4 * q) = o; }
      }
    };
    u32x4 raA[16], raB[16];
    u32x6 bA0, bA1, bB0, bB1, bN0, bN1;
    int eA0, eA1, eB0, eB1, eN0, eN1;
#define P6B_PIN() __builtin_amdgcn_sched_barrier(0)
    load_b(bA0, bA1, eA0, eA1, 0);
    P6B_PIN();
#pragma unroll
    for (int g = 0; g < 4; ++g) { issue_grp(raA, g, 0); P6B_PIN(); }
    load_b(bB0, bB1, eB0, eB1, 1);
    P6B_PIN();
#pragma unroll
    for (int g = 0; g < 4; ++g) { issue_grp(raB, g, 1); P6B_PIN(); }
#pragma unroll 1
    for (int i = 0; i < nb; i += 2) {
      float part[16];
      load_b(bN0, bN1, eN0, eN1, i + 2);
      P6B_PIN();
#pragma unroll
      for (int g = 0; g < 4; ++g) { comp_grp(raA, g, bA0, bA1, eA0, eA1, part); P6B_PIN(); issue_grp(raA, g, i + 2); P6B_PIN(); }
      store_part(part, i);
      bA0 = bN0; bA1 = bN1; eA0 = eN0; eA1 = eN1;
      P6B_PIN();
      load_b(bN0, bN1, eN0, eN1, i + 3);
      P6B_PIN();
#pragma unroll
      for (int g = 0; g < 4; ++g) { comp_grp(raB, g, bB0, bB1, eB0, eB1, part); P6B_PIN(); issue_grp(raB, g, i + 3); P6B_PIN(); }
      store_part(part, i + 1);
      bB0 = bN0; bB1 = bN1; eB0 = eN0; eB1 = eN1;
      P6B_PIN();
    }
#undef P6B_PIN
  }
}

__device__ __forceinline__ void phase6c(const Params& p, unsigned char* lds, int bid, int nblk) {
  const int tid0 = threadIdx.x, wid = __builtin_amdgcn_readfirstlane(tid0 >> 6);
  int* ids = (int*)(lds + wid * 1024);
  float* wts = (float*)(lds + wid * 1024 + 512);
  const unsigned char* vb = p.ws + WS_VB;
  const bf16_t* h1b = (const bf16_t*)(p.ws + WS_H1B);
  const int* idsg = (const int*)(p.ws + WS_P6IDS);
  const float* gtsg = (const float*)(p.ws + WS_P6GTS);
  const float* usclg = (const float*)(p.ws + WS_P6USC);
  const float* hpart = (const float*)(p.ws + WS_HPART);
#pragma unroll 1
  for (int t = bid * 8 + wid; t < T; t += nblk * 8) {
    int tid = tid0; asm volatile("" : "+v"(tid));
    const int lane = tid & 63;
    auto load_rows = [&](u32x4 (&ra)[16], const unsigned char* tb, const int rnd) __attribute__((always_inline)) {
#pragma unroll
      for (int k = 0; k < 16; ++k) {
        const int e = __builtin_amdgcn_readfirstlane(ids[rnd * 16 + k]);
        ra[k] = *(const u32x4*)(tb + (size_t)e * ROW4 + lane * 16);
      }
    };
    float acc[32];
#pragma unroll
    for (int i = 0; i < 32; ++i) acc[i] = 0.f;
    auto compute_v = [&](u32x4 (&ra)[16], const int rnd) __attribute__((always_inline)) {
      f32x4 wv[4];
#pragma unroll
      for (int j = 0; j < 4; ++j) wv[j] = *(const f32x4*)(wts + rnd * 16 + 4 * j);
#pragma unroll
      for (int k = 0; k < 16; ++k) {
        const float wk = wv[k >> 2][k & 3];
        asm volatile("" : "+v"(ra[k]) : "v"(acc[1]), "v"(acc[3]), "v"(acc[5]), "v"(acc[7]), "v"(acc[9]), "v"(acc[11]), "v"(acc[13]), "v"(acc[15]),
                                        "v"(acc[17]), "v"(acc[19]), "v"(acc[21]), "v"(acc[23]), "v"(acc[25]), "v"(acc[27]), "v"(acc[29]), "v"(acc[31]));
#define V4_STEP(j, i) { const f32x2 r = __builtin_amdgcn_cvt_scalef32_pk_f32_fp4(ra[k][j], 1.0f, i); \
            acc[8 * (j) + 2 * (i)] = fmaf(wk, r[0], acc[8 * (j) + 2 * (i)]); acc[8 * (j) + 2 * (i) + 1] = fmaf(wk, r[1], acc[8 * (j) + 2 * (i) + 1]); }
#pragma unroll
        for (int j = 0; j < 4; ++j) { V4_STEP(j, 0) V4_STEP(j, 1) V4_STEP(j, 2) V4_STEP(j, 3) }
#undef V4_STEP
      }
    };
    {
      u32x4 raA[16], raB[16];
      {
        const size_t tb = (size_t)t * 128;
        float pa0[8], pa1[8];
#pragma unroll
        for (int x = 0; x < 8; ++x) { pa0[x] = hpart[((size_t)t * 8 + x) * 128 + lane]; pa1[x] = hpart[((size_t)t * 8 + x) * 128 + 64 + lane]; }
        const float g0 = gtsg[tb + lane], g1 = gtsg[tb + 64 + lane], s0 = usclg[tb + lane], s1 = usclg[tb + 64 + lane];
        const int e0 = idsg[tb + lane], e1 = idsg[tb + 64 + lane];
        ids[lane] = e0; ids[lane + 64] = e1;
        load_rows(raA, vb, 0);
        const float a0 = (((pa0[0] + pa0[1]) + (pa0[2] + pa0[3])) + ((pa0[4] + pa0[5]) + (pa0[6] + pa0[7]))) * s0;
        const float a1 = (((pa1[0] + pa1[1]) + (pa1[2] + pa1[3])) + ((pa1[4] + pa1[5]) + (pa1[6] + pa1[7]))) * s1;
        wts[lane] = g0 * 0.5f * a0 * (1.f + erff(a0 * 0.70710678118654752f));
        wts[lane + 64] = g1 * 0.5f * a1 * (1.f + erff(a1 * 0.70710678118654752f));
      }
#pragma unroll 1
      for (int rnd = 0; rnd < 6; rnd += 2) {
        load_rows(raB, vb, rnd + 1);
        compute_v(raA, rnd);
        load_rows(raA, vb, rnd + 2);
        compute_v(raB, rnd + 1);
      }
      load_rows(raB, vb, 7);
      compute_v(raA, 6);
      compute_v(raB, 7);
    }
    float ss = 0.f;
#pragma unroll
    for (int j = 0; j < 8; ++j) {
      const u32x2 xa = *(const u32x2*)(h1b + (size_t)t * DM + lane * 4 + 256 * j);
      acc[4 * j + 0] += bflo(xa.x); acc[4 * j + 1] += bfhi(xa.x); acc[4 * j + 2] += bflo(xa.y); acc[4 * j + 3] += bfhi(xa.y);
    }
#pragma unroll
    for (int i = 0; i < 32; ++i) ss += acc[i] * acc[i];
    ss = wave_sum(ss);
    const float rf = rsqrtf(ss * (1.f / DM) + EPS);
#pragma unroll
    for (int j = 0; j < 8; ++j) {
      const f32x4 lw = *(const f32x4*)(p.ln_final + 256 * j + lane * 4);
      const f32x4 o = {acc[4 * j] * rf * lw[0], acc[4 * j + 1] * rf * lw[1], acc[4 * j + 2] * rf * lw[2], acc[4 * j + 3] * rf * lw[3]};
      __builtin_nontemporal_store(o, (f32x4*)(p.out + (size_t)t * DM + 256 * j + lane * 4));
    }
  }
}

__device__ __forceinline__ void unpack8(const u32x4 a, float (&v)[8]) {
  v[0] = bflo(a.x); v[1] = bfhi(a.x); v[2] = bflo(a.y); v[3] = bfhi(a.y); v[4] = bflo(a.z); v[5] = bfhi(a.z); v[6] = bflo(a.w); v[7] = bfhi(a.w);
}
constexpr int VT_LD = 196;
constexpr int ATT_VT_BYTES = 4 * 64 * VT_LD * 2;
__device__ __forceinline__ void attn_item(const Params& p, unsigned char* lds, int item, const bool first) {
  int tid = threadIdx.x; asm volatile("" : "+v"(tid));
  const int lane = tid & 63, wid = __builtin_amdgcn_readfirstlane(tid >> 6);
  const int b = item >> 6, qb = item & 63, q0 = qb * 32;
  bf16_t* VT = (bf16_t*)lds;
  float* biasL = (float*)(lds + ATT_VT_BYTES);
  float* ssqw = biasL + 16 * 132;
  const bf16_t* proj = (const bf16_t*)(p.ws + WS_PROJ);
  const float* projm = (const float*)(p.ws + WS_PROJM);
  bf16_t* mixin = (bf16_t*)(p.ws + WS_HNB);
  if (first) {
#pragma unroll
  for (int it = 0; it < 5; ++it) {
    const int idx = it * NTHREADS + tid;
    if (idx >= 16 * 129) break;
    const int hq = idx / 129, d = idx - hq * 129;
    int bk = d;
    if (d >= 16) bk = 16 + (d >= 19) + (d >= 21) + (d >= 24) + (d >= 27) + (d >= 31) + (d >= 35) + (d >= 40) + (d >= 46) + (d >= 52) + (d >= 59) +
                      (d >= 67) + (d >= 77) + (d >= 87) + (d >= 99) + (d >= 113);
    biasL[hq * 132 + d] = p.rel_bias[bk * 16 + hq];
  }
  }
  const int ql = lane & 31, ql0 = ql, hh = lane >> 5, kvh = wid >> 1;
  const int trow = b * SEQ + q0 + ql;
  bf16x8 qf[4];
  u32x4 kf[6][4];
#define ATT_LOAD_Q(hq_)                                                                                                           \
  { _Pragma("unroll") for (int ks = 0; ks < 4; ++ks) qf[ks] = *(const bf16x8*)(proj + (size_t)trow * NPROJ + OFF_Q + (hq_) * 64 + ks * 16 + hh * 8); }
#define ATT_LOAD_K()                                                                                                              \
  {                                                                                                                               \
    int ql = ql0; asm volatile("" : "+v"(ql));     \
    const float* kr_ = projm + (size_t)(ql & 15) * DPROJ + OFF_K + kvh * 64 + hh * 8;                                             \
    _Pragma("unroll") for (int ks = 0; ks < 4; ++ks) {                                                                            \
      const f32x4 a_ = *(const f32x4*)(kr_ + ks * 16), c_ = *(const f32x4*)(kr_ + ks * 16 + 4);                                   \
      kf[0][ks].x = pack_bf16(a_[0], a_[1]); kf[0][ks].y = pack_bf16(a_[2], a_[3]); kf[0][ks].z = pack_bf16(c_[0], c_[1]); kf[0][ks].w = pack_bf16(c_[2], c_[3]); } \
    _Pragma("unroll") for (int jt = 1; jt < 6; ++jt) {                                                                            \
      int sp_ = q0 - 128 + 32 * (jt - 1) + ql; sp_ = sp_ < 0 ? 0 : sp_;                                                           \
      const bf16_t* kp_ = proj + (size_t)(b * SEQ + sp_) * NPROJ + OFF_K + kvh * 64 + hh * 8;                                     \
      _Pragma("unroll") for (int ks = 0; ks < 4; ++ks) kf[jt][ks] = *(const u32x4*)(kp_ + ks * 16); }                             \
  }
  const int qb4 = (qb + 4) % 5;
  if (first) {
    u32x4 ra[5], rc[5];
#pragma unroll
    for (int q = 0; q < 5; ++q) {
      const int task = q * NTHREADS + tid, ch = task / 80, pi = task - ch * 80;
      int s0 = q0 - 128 + 2 * pi;
      s0 = s0 < 0 ? 0 : s0;
      const unsigned off = (unsigned)((b * SEQ + s0) * NPROJ + OFF_V + ch * 8);
      ra[q] = *(const u32x4*)(proj + off); rc[q] = *(const u32x4*)(proj + off + NPROJ);
    }
    float m0[8], m1[8];
    {
      const int pi = tid & 7, ch = (tid >> 3) & 31;
      const float* r0 = projm + (size_t)(2 * pi) * DPROJ + OFF_V + ch * 8;
      const f32x4 ma = *(const f32x4*)r0, mb = *(const f32x4*)(r0 + 4), mc = *(const f32x4*)(r0 + DPROJ), md = *(const f32x4*)(r0 + DPROJ + 4);
      const float keep = tid < 256 ? 1.f : 0.f;
#pragma unroll
      for (int i = 0; i < 4; ++i) { m0[i] = ma[i] * keep; m0[4 + i] = mb[i] * keep; m1[i] = mc[i] * keep; m1[4 + i] = md[i] * keep; }
      bf16_t* dst = VT + (size_t)((ch >> 3) * 64 + (ch & 7) * 8) * VT_LD + 2 * pi + (tid < 256 ? 0 : 16);
#pragma unroll
      for (int i = 0; i < 8; ++i) *(unsigned*)(dst + i * VT_LD) = pack_bf16(m0[i], m1[i]);
    }
#pragma unroll
    for (int q = 0; q < 5; ++q) {
      const int task = q * NTHREADS + tid, ch = task / 80, pi = task - ch * 80;
      float v0[8], v1[8];
      unpack8(ra[q], v0); unpack8(rc[q], v1);
      int rp = qb4 + (pi >> 4); rp = rp >= 5 ? rp - 5 : rp;
      const int slot = 32 + rp * 32 + 2 * (pi & 15);
      bf16_t* dst = VT + (size_t)((ch >> 3) * 64 + (ch & 7) * 8) * VT_LD + slot;
#pragma unroll
      for (int i = 0; i < 8; ++i) *(unsigned*)(dst + i * VT_LD) = pack_bf16(v0[i], v1[i]);
    }
  } else {
    const int ch = tid >> 4, pw = tid & 15;
    const bf16_t* r0 = proj + (size_t)(b * SEQ + q0 + 2 * pw) * NPROJ + OFF_V + ch * 8;
    const u32x4 ra = *(const u32x4*)r0, rc = *(const u32x4*)(r0 + NPROJ);
    float v0[8], v1[8];
    unpack8(ra, v0); unpack8(rc, v1);
    const int slot = 32 + ((qb4 + 4) % 5) * 32 + 2 * pw;
    bf16_t* dst = VT + (size_t)((ch >> 3) * 64 + (ch & 7) * 8) * VT_LD + slot;
#pragma unroll
    for (int i = 0; i < 8; ++i) *(unsigned*)(dst + i * VT_LD) = pack_bf16(v0[i], v1[i]);
  }
  __syncthreads();
  float ssq = 0.f;
#pragma unroll 1
  for (int rep_ = 0; rep_ < (REP_SUB == 3 ? 2 : 1); ++rep_) {
  ssq = 0.f;
  auto do_head = [&](const int hsel) __attribute__((always_inline)) {
    const int hq = 2 * wid + hsel;
    f32x16 sacc[6];
#pragma unroll
    for (int jt = 0; jt < 6; ++jt) {
      f32x16 acc;
#pragma unroll
      for (int r = 0; r < 16; ++r) acc[r] = 0.f;
#pragma unroll
      for (int ks = 0; ks < 4; ++ks) acc = __builtin_amdgcn_mfma_f32_32x32x16_bf16(*(bf16x8*)&kf[jt][ks], qf[ks], acc, 0, 0, 0);
      sacc[jt] = acc;
    }
    if (hsel == 0) { ATT_LOAD_Q(2 * wid + 1) }
    const float* bl = biasL + hq * 132;
    int sq = q0 + ql, qh = ql - 4 * hh;
    asm volatile("" : "+v"(sq), "+v"(qh));
    const float sink = p.sinks[hq];
    float m = sink;
#pragma unroll
    for (int jt = 0; jt < 6; ++jt) {
      asm volatile("" ::: "memory");
#pragma unroll
      for (int r = 0; r < 16; ++r) {
        const int kr = (r & 3) + 8 * (r >> 2) + 4 * hh;
        int dist; bool valid;
        if (jt == 0) { dist = sq + (16 - ((r & 3) + 8 * (r >> 2))) - 4 * hh; valid = kr < 16; }
        else { dist = qh + (128 - 32 * (jt - 1) - ((r & 3) + 8 * (r >> 2))); valid = (dist >= 0) && (dist < 128) && (dist <= sq); }
        const int dc = dist < 0 ? 0 : (dist > 128 ? 128 : dist);
        const float l = valid ? 0.125f * sacc[jt][r] + bl[dc] : -1e30f;
        sacc[jt][r] = l;
        m = fmaxf(m, l);
      }
    }
    m = fmaxf(m, __shfl_xor(m, 32));
    float sum = 0.f;
    f32x16 oacc0, oacc1;
#pragma unroll
    for (int r = 0; r < 16; ++r) { oacc0[r] = 0.f; oacc1[r] = 0.f; }
    const bf16_t* vrow0 = VT + (size_t)(kvh * 64 + ql) * VT_LD + 4 * hh;
    const bf16_t* vrow1 = vrow0 + 32 * VT_LD;
#pragma unroll
    for (int jt = 0; jt < 6; ++jt) {
      u32x4 pw[2];
#pragma unroll
      for (int s2 = 0; s2 < 2; ++s2) {
        float e[8];
#pragma unroll
        for (int i = 0; i < 8; ++i) { e[i] = __expf(sacc[jt][8 * s2 + i] - m); sum += e[i]; }
        pw[s2].x = pack_bf16(e[0], e[1]); pw[s2].y = pack_bf16(e[2], e[3]); pw[s2].z = pack_bf16(e[4], e[5]); pw[s2].w = pack_bf16(e[6], e[7]);
      }
#pragma unroll
      for (int s2 = 0; s2 < 2; ++s2) {
        const int sl = (jt == 0 ? 0 : 32 + ((qb4 + jt - 1) % 5) * 32) + 16 * s2;
        const u32x2 va = *(const u32x2*)(vrow0 + sl), vc = *(const u32x2*)(vrow0 + sl + 8);
        const u32x2 vd = *(const u32x2*)(vrow1 + sl), ve = *(const u32x2*)(vrow1 + sl + 8);
        u32x4 v0w; v0w.x = va.x; v0w.y = va.y; v0w.z = vc.x; v0w.w = vc.y;
        u32x4 v1w; v1w.x = vd.x; v1w.y = vd.y; v1w.z = ve.x; v1w.w = ve.y;
        oacc0 = __builtin_amdgcn_mfma_f32_32x32x16_bf16(*(bf16x8*)&v0w, *(bf16x8*)&pw[s2], oacc0, 0, 0, 0);
        oacc1 = __builtin_amdgcn_mfma_f32_32x32x16_bf16(*(bf16x8*)&v1w, *(bf16x8*)&pw[s2], oacc1, 0, 0, 0);
      }
    }
    sum += __shfl_xor(sum, 32);
    const float inv = 1.f / (sum + __expf(sink - m));
#pragma unroll
    for (int r = 0; r < 16; ++r) { oacc0[r] *= inv; oacc1[r] *= inv; ssq += oacc0[r] * oacc0[r] + oacc1[r] * oacc1[r]; }
#pragma unroll
    for (int rg = 0; rg < 4; ++rg) {
      u32x2 w; w.x = pack_bf16(oacc0[rg * 4 + 0], oacc0[rg * 4 + 1]); w.y = pack_bf16(oacc0[rg * 4 + 2], oacc0[rg * 4 + 3]);
      *(u32x2*)(mixin + (size_t)trow * DM + hq * 64 + 8 * rg + 4 * hh) = w;
      u32x2 w1; w1.x = pack_bf16(oacc1[rg * 4 + 0], oacc1[rg * 4 + 1]); w1.y = pack_bf16(oacc1[rg * 4 + 2], oacc1[rg * 4 + 3]);
      *(u32x2*)(mixin + (size_t)trow * DM + hq * 64 + 32 + 8 * rg + 4 * hh) = w1;
    }
  };
  ATT_LOAD_Q(2 * wid)
  ATT_LOAD_K()
  do_head(0);
  asm volatile("" ::: "memory");
  ATT_LOAD_K()
  do_head(1);
  }
  ssq += __shfl_xor(ssq, 32);
  if (lane < 32) ssqw[wid * 32 + lane] = ssq;
  __syncthreads();
  float tot = 0.f;
#pragma unroll
  for (int w = 0; w < 8; ++w) tot += ssqw[w * 32 + ql];
  const float ra = rsqrtf(tot * (1.f / 1024) + EPS);
#pragma unroll
  for (int hsel = 0; hsel < 2; ++hsel)
#pragma unroll
    for (int dt = 0; dt < 2; ++dt)
#pragma unroll
      for (int rg = 0; rg < 4; ++rg) {
        bf16_t* op = mixin + (size_t)trow * DM + (2 * wid + hsel) * 64 + 32 * dt + 8 * rg + 4 * hh;
        const u32x2 v = *(const u32x2*)op;
        u32x2 w; w.x = pack_bf16(bflo(v.x) * ra, bfhi(v.x) * ra); w.y = pack_bf16(bflo(v.y) * ra, bfhi(v.y) * ra);
        *(u32x2*)op = w;
      }
  __syncthreads();
}
#undef ATT_LOAD_Q
#undef ATT_LOAD_K

constexpr int SLD = 136;
__device__ __forceinline__ float conv_silu(const float (&raw)[11], int i, float w0, float w1, float w2, float w3, float cb) {
  return silu_f(cb + w0 * raw[i] + w1 * raw[i + 1] + w2 * raw[i + 2] + w3 * raw[i + 3]);
}
__device__ __forceinline__ void ssd_a_item(const Params& p, unsigned char* lds, int item) {
  int tid = threadIdx.x; asm volatile("" : "+v"(tid));
  const int lane = tid & 63, wid = __builtin_amdgcn_readfirstlane(tid >> 6);
  const int b = item >> 5, c = (item >> 1) & 15, g = item & 1;
  const int h0 = g * 8;
  const int t0 = b * SEQ + c * 128;
  bf16_t* Bc = (bf16_t*)lds;
  bf16_t* Cc = Bc + 128 * SLD;
  bf16_t* BcT = Cc + 128 * SLD;
  bf16_t* xT = BcT + 128 * SLD;
  float* dtl = (float*)(xT + 2 * 64 * SLD);
  float* acs = dtl + 256;
  float* wl = acs + 256;
  float* scan = wl + 256;
  const bf16_t* __restrict__ proj = (const bf16_t*)(p.ws + WS_PROJ);
  const bf16_t* __restrict__ projmb = (const bf16_t*)(p.ws + WS_PROJMB);
  const float* __restrict__ dtraw = (const float*)(p.ws + WS_DTRAW);
  float* __restrict__ acsg = (float*)(p.ws + WS_ACSG);
  bf16_t* __restrict__ ccb = (bf16_t*)(p.ws + WS_CCB);
  bf16_t* __restrict__ ypart = (bf16_t*)(p.ws + WS_YPART);
  float* __restrict__ sg = (float*)(p.ws + WS_SG);
  {
    unsigned raw[4][11];
#pragma unroll
    for (int q = 0; q < 4; ++q) {
      const int task = q * NTHREADS + tid;
      const int tg = task >> 7, cp = task & 127;
      const int cch = 1024 + (cp >> 6) * 256 + g * 128 + 2 * (cp & 63);
#pragma unroll
      for (int i = 0; i < 11; ++i) {
        const int l = tg * 8 + i - 3;
        const bf16_t* src = (l >= 0 || c > 0) ? proj + (size_t)(t0 + l) * NPROJ : projmb + (size_t)(16 + l) * DPROJ;
        raw[q][i] = *(const unsigned*)(src + OFF_XBC + cch);
      }
    }
#pragma unroll
    for (int q = 0; q < 4; ++q) {
      const int task = q * NTHREADS + tid;
      const int tg = task >> 7, cp = task & 127, n = 2 * (cp & 63);
      const int cch = 1024 + (cp >> 6) * 256 + g * 128 + n;
      float o0[8], o1[8];
      {
        float r0[11], r1[11];
#pragma unroll
        for (int i = 0; i < 11; ++i) { r0[i] = bflo(raw[q][i]); r1[i] = bfhi(raw[q][i]); }
        const float w0 = p.conv_w[cch], w1 = p.conv_w[D_XBC + cch], w2 = p.conv_w[2 * D_XBC + cch], w3 = p.conv_w[3 * D_XBC + cch], cb = p.conv_b[cch];
        const float v0 = p.conv_w[cch + 1], v1 = p.conv_w[D_XBC + cch + 1], v2 = p.conv_w[2 * D_XBC + cch + 1], v3 = p.conv_w[3 * D_XBC + cch + 1], vb_ = p.conv_b[cch + 1];
#pragma unroll
        for (int i = 0; i < 8; ++i) { o0[i] = conv_silu(r0, i, w0, w1, w2, w3, cb); o1[i] = conv_silu(r1, i, v0, v1, v2, v3, vb_); }
      }
      bf16_t* rowm = (cp < 64 ? Bc : Cc) + (tg * 8) * SLD + n;
#pragma unroll
      for (int i = 0; i < 8; ++i) *(unsigned*)(rowm + i * SLD) = pack_bf16(o0[i], o1[i]);
      if (cp < 64) {
        u32x4 w; w.x = pack_bf16(o0[0], o0[1]); w.y = pack_bf16(o0[2], o0[3]); w.z = pack_bf16(o0[4], o0[5]); w.w = pack_bf16(o0[6], o0[7]);
        *(u32x4*)(BcT + n * SLD + tg * 8) = w;
        u32x4 w2_; w2_.x = pack_bf16(o1[0], o1[1]); w2_.y = pack_bf16(o1[2], o1[3]); w2_.z = pack_bf16(o1[4], o1[5]); w2_.w = pack_bf16(o1[6], o1[7]);
        *(u32x4*)(BcT + (n + 1) * SLD + tg * 8) = w2_;
      }
    }
  }
  float xraw[4][11];
#define SSD_LOAD_X(r_)                                                                                              \
  _Pragma("unroll") for (int q = 0; q < 4; ++q) {                                                                   \
    const int task = (q & 1) * NTHREADS + tid; const int tg = task >> 6, cch = (h0 + 2 * (r_) + (q >> 1)) * 64 + (task & 63); \
    _Pragma("unroll") for (int i = 0; i < 11; ++i) { const int l = tg * 8 + i - 3;                                  \
      const bf16_t* src = (l >= 0 || c > 0) ? proj + (size_t)(t0 + l) * NPROJ : projmb + (size_t)(16 + l) * DPROJ;  \
      xraw[q][i] = bf2f(src[OFF_XBC + cch]); } }
  SSD_LOAD_X(0)
  __syncthreads();
  {
#pragma unroll
    for (int q = 0; q < 4; ++q) {
      const int idx = q * NTHREADS + tid, row = idx >> 4, ck = idx & 15;
      *(u32x4*)(ccb + (size_t)(t0 + row) * 256 + g * 128 + ck * 8) = *(const u32x4*)(Cc + row * SLD + ck * 8);
    }
  }
  const int ql = lane & 31, hh = lane >> 5;
  int rnd = 0;
  auto ydiag = [&](const int hi, const int il) __attribute__((always_inline)) {
    const int h = h0 + 2 * rnd + hi, ip = wid & 1;
    const bf16_t* xTb = xT + (hi & 1) * 64 * SLD;
    const float dskip = p.d_skip[h];
    const float* acsh = acs + hi * 128;
    const float* dtlh = dtl + hi * 128;
    const int l = 32 * il + ql;
    const float acl = acsh[l];
    f32x16 yacc;
#pragma unroll
    for (int r = 0; r < 16; ++r) yacc[r] = 0.f;
    const bf16_t* xrow = xTb + (32 * ip + ql) * SLD + 4 * hh;
#pragma unroll 1
    for (int is = 0; is <= il; ++is) {
      f32x16 x;
#pragma unroll
      for (int r = 0; r < 16; ++r) x[r] = 0.f;
      const bf16_t* ap = Bc + (32 * is + ql) * SLD + 8 * hh;
      const bf16_t* bp = Cc + l * SLD + 8 * hh;
#pragma unroll
      for (int ks = 0; ks < 8; ++ks) x = __builtin_amdgcn_mfma_f32_32x32x16_bf16(*(const bf16x8*)(ap + 16 * ks), *(const bf16x8*)(bp + 16 * ks), x, 0, 0, 0);
      u32x4 pw[2];
#pragma unroll
      for (int s2 = 0; s2 < 2; ++s2) {
        float mv[8];
#pragma unroll
        for (int q = 0; q < 2; ++q) {
          const int sb = 32 * is + 16 * s2 + 8 * q + 4 * hh;
          const f32x4 as4 = *(const f32x4*)(acsh + sb), dt4 = *(const f32x4*)(dtlh + sb);
#pragma unroll
          for (int j = 0; j < 4; ++j) {
            const int sr = sb + j;
            float v = sr <= l ? x[8 * s2 + 4 * q + j] * __expf(acl - as4[j]) * dt4[j] : 0.f;
            if (sr == l) v += dskip;
            mv[4 * q + j] = v;
          }
        }
        pw[s2].x = pack_bf16(mv[0], mv[1]); pw[s2].y = pack_bf16(mv[2], mv[3]); pw[s2].z = pack_bf16(mv[4], mv[5]); pw[s2].w = pack_bf16(mv[6], mv[7]);
      }
#pragma unroll
      for (int s2 = 0; s2 < 2; ++s2) {
        const u32x2 va = *(const u32x2*)(xrow + 32 * is + 16 * s2), vc = *(const u32x2*)(xrow + 32 * is + 16 * s2 + 8);
        u32x4 aw; aw.x = va.x; aw.y = va.y; aw.z = vc.x; aw.w = vc.y;
        yacc = __builtin_amdgcn_mfma_f32_32x32x16_bf16(*(bf16x8*)&aw, *(bf16x8*)&pw[s2], yacc, 0, 0, 0);
      }
    }
    bf16_t* yp = ypart + (size_t)(t0 + l) * 1024 + h * 64 + 32 * ip + 4 * hh;
#pragma unroll
    for (int rg = 0; rg < 4; ++rg) { u32x2 w; w.x = pack_bf16(yacc[4 * rg], yacc[4 * rg + 1]); w.y = pack_bf16(yacc[4 * rg + 2], yacc[4 * rg + 3]); *(u32x2*)(yp + 8 * rg) = w; }
  };
  auto states = [&](const int hi) __attribute__((always_inline)) {
    const int h = h0 + 2 * rnd + hi, ip = wid & 1, in = wid >> 1;
    const bf16_t* xTb = xT + (hi & 1) * 64 * SLD;
    const float* wlh = wl + hi * 128;
    f32x16 sacc;
#pragma unroll
    for (int r = 0; r < 16; ++r) sacc[r] = 0.f;
    const bf16_t* ap = xTb + (32 * ip + ql) * SLD + 8 * hh;
    const bf16_t* bp = BcT + (32 * in + ql) * SLD + 8 * hh;
#pragma unroll
    for (int ks = 0; ks < 8; ++ks) {
      const u32x4 xa = *(const u32x4*)(ap + 16 * ks);
      const f32x4 wa = *(const f32x4*)(wlh + 16 * ks + 8 * hh), wb = *(const f32x4*)(wlh + 16 * ks + 8 * hh + 4);
      u32x4 aw;
      aw.x = pack_bf16(bflo(xa.x) * wa[0], bfhi(xa.x) * wa[1]); aw.y = pack_bf16(bflo(xa.y) * wa[2], bfhi(xa.y) * wa[3]);
      aw.z = pack_bf16(bflo(xa.z) * wb[0], bfhi(xa.z) * wb[1]); aw.w = pack_bf16(bflo(xa.w) * wb[2], bfhi(xa.w) * wb[3]);
      sacc = __builtin_amdgcn_mfma_f32_32x32x16_bf16(*(bf16x8*)&aw, *(const bf16x8*)(bp + 16 * ks), sacc, 0, 0, 0);
    }
    float* sp = sg + ((size_t)((b * 16 + c) * 16 + h) * 64 + 32 * ip + 4 * hh) * 128 + 32 * in + ql;
#pragma unroll
    for (int r = 0; r < 16; ++r) sp[((r & 3) + 8 * (r >> 2)) * 128] = sacc[r];
  };
#pragma unroll 1
  for (int rnd_ = 0; rnd_ < 4; ++rnd_) {
    rnd = rnd_;
    float dtv = 0.f, cum = 0.f;
    const int hi2 = (tid >> 7) & 1, ltok = tid & 127;
    if (tid < 256) {
      const int h = h0 + 2 * rnd + hi2;
      const float Ah = -expf(p.a_log[h]);
      dtv = softplus_f(dtraw[(size_t)(t0 + ltok) * 16 + h] + p.dt_bias[h]);
      dtl[tid] = dtv;
      cum = dtv * Ah;
#pragma unroll
      for (int o = 1; o < 64; o <<= 1) { const float nb = __shfl_up(cum, o); if (lane >= o) cum += nb; }
      if (lane == 63) scan[hi2 * 2 + (ltok >> 6)] = cum;
    }
#pragma unroll
    for (int q = 0; q < 4; ++q) {
      const int task = (q & 1) * NTHREADS + tid; const int tg = task >> 6, pch = task & 63, cch = (h0 + 2 * rnd + (q >> 1)) * 64 + pch;
      const float w0 = p.conv_w[cch], w1 = p.conv_w[D_XBC + cch], w2 = p.conv_w[2 * D_XBC + cch], w3 = p.conv_w[3 * D_XBC + cch], cb = p.conv_b[cch];
      float o[8];
#pragma unroll
      for (int i = 0; i < 8; ++i) o[i] = conv_silu(xraw[q], i, w0, w1, w2, w3, cb);
      u32x4 w; w.x = pack_bf16(o[0], o[1]); w.y = pack_bf16(o[2], o[3]); w.z = pack_bf16(o[4], o[5]); w.w = pack_bf16(o[6], o[7]);
      *(u32x4*)(xT + (q >> 1) * 64 * SLD + pch * SLD + tg * 8) = w;
    }
    { SSD_LOAD_X((rnd + 1) & 3) }
    __syncthreads();
    if (tid < 256) {
      const int h = h0 + 2 * rnd + hi2;
      const float s0 = scan[hi2 * 2], s1 = scan[hi2 * 2 + 1];
      if (ltok >= 64) cum += s0;
      acs[tid] = cum;
      acsg[(size_t)(t0 + ltok) * 16 + h] = cum;
      wl[tid] = dtv * __expf(s0 + s1 - cum);
    }
    __syncthreads();
    ydiag(0, wid >> 1);
    ydiag(1, 3 - (wid >> 1));
    states(0);
    states(1);
    __syncthreads();
  }
#undef SSD_LOAD_X
  __syncthreads();
}

__device__ __forceinline__ void meta_state_item(const Params& p, unsigned char* lds, int h) {
  int tid = threadIdx.x; asm volatile("" : "+v"(tid));
  const int g = h >> 3;
  float* xm = (float*)lds;
  float* bm = xm + 16 * 64;
  float* dtm = bm + 16 * 128;
  const float* projm = (const float*)(p.ws + WS_PROJM);
  float* smeta = (float*)(p.ws + WS_SMETA);
  for (int task = tid; task < 16 * 192; task += NTHREADS) {
    const int i = task / 192, ch = task - i * 192;
    const int cch = ch < 64 ? h * 64 + ch : 1024 + g * 128 + (ch - 64);
    float acc = p.conv_b[cch];
#pragma unroll
    for (int j = 0; j < 4; ++j) { const int mi = i - j; if (mi >= 0) acc += p.conv_w[(3 - j) * D_XBC + cch] * projm[(size_t)mi * DPROJ + OFF_XBC + cch]; }
    const float v = silu_f(acc);
    if (ch < 64) xm[i * 64 + ch] = v; else bm[i * 128 + ch - 64] = v;
  }
  if (tid < 16) dtm[tid] = softplus_f(projm[(size_t)tid * DPROJ + OFF_DT + h] + p.dt_bias[h]);
  __syncthreads();
  const float Ah = -expf(p.a_log[h]);
  const int pr = tid >> 3, n0 = (tid & 7) * 16;
  float st[16];
#pragma unroll
  for (int k = 0; k < 16; ++k) st[k] = 0.f;
  for (int i = 0; i < 16; ++i) {
    const float dtv = dtm[i], dA = expf(dtv * Ah), xdt = xm[i * 64 + pr] * dtv;
#pragma unroll
    for (int k = 0; k < 16; ++k) st[k] = fmaf(st[k], dA, xdt * bm[i * 128 + n0 + k]);
  }
#pragma unroll
  for (int k = 0; k < 16; ++k) smeta[(size_t)(h * 64 + pr) * 128 + n0 + k] = st[k];
  __syncthreads();
}

__device__ __forceinline__ void phase2(const Params& p, unsigned char* lds, int bid, int nblk) {
  const bool roles = (nblk == 256);
  const int a = (bid >> 4) * 8 + (bid & 7);
  const bool ssd_role = ((bid >> 3) & 1) == 0;
  const int ab = roles ? (ssd_role ? 0 : 2 * a) : bid, ae = roles ? (ssd_role ? 0 : 2 * a + 2) : 256, as_ = roles ? 1 : nblk;
  const int sb = roles ? (ssd_role ? a : 0) : bid, se = roles ? (ssd_role ? a + 1 : 0) : 128, ss = roles ? 1 : nblk;
  const int mb = roles ? (ssd_role ? a : 16) : bid, ms = roles ? 128 : nblk;
#pragma unroll 1
  for (int it = ab; it < ae; it += as_) attn_item(p, lds, it, !(roles && it != ab));
#pragma unroll 1
  for (int it = sb; it < se; it += ss) ssd_a_item(p, lds, it);
#pragma unroll 1
  for (int it = mb; it < 16; it += ms) meta_state_item(p, lds, it);
}

__device__ __forceinline__ void phase_scan(const Params& p, int bid, int nblk) {
  const float* __restrict__ sg = (const float*)(p.ws + WS_SG);
  const float* __restrict__ smeta = (const float*)(p.ws + WS_SMETA);
  const float* __restrict__ acsg = (const float*)(p.ws + WS_ACSG);
  bf16_t* __restrict__ hprev = (bf16_t*)(p.ws + WS_HPREV);
  for (int task = bid * NTHREADS + threadIdx.x; task < 64 * 2048; task += nblk * NTHREADS) {
    const int bh = task >> 11, e4 = (task & 2047) * 4;
    const int b = bh >> 4, h = bh & 15;
    f32x4 sv[16];
    float dv[16];
#pragma unroll
    for (int c = 0; c < 16; ++c) {
      sv[c] = *(const f32x4*)(sg + (size_t)((b * 16 + c) * 16 + h) * 8192 + e4);
      dv[c] = acsg[(size_t)(b * SEQ + c * 128 + 127) * 16 + h];
    }
    f32x4 H = *(const f32x4*)(smeta + (size_t)h * 8192 + e4);
#pragma unroll
    for (int c = 0; c < 16; ++c) {
      u32x2 w; w.x = pack_bf16(H[0], H[1]); w.y = pack_bf16(H[2], H[3]);
      *(u32x2*)(hprev + (size_t)((b * 16 + c) * 16 + h) * 8192 + e4) = w;
      H = H * __expf(dv[c]) + sv[c];
    }
  }
}

__device__ __forceinline__ void ssd_b_item(const Params& p, unsigned char* lds, int item) {
  int tid = threadIdx.x; asm volatile("" : "+v"(tid));
  const int lane = tid & 63, wid = __builtin_amdgcn_readfirstlane(tid >> 6);
  const int b = item >> 6, c = (item >> 2) & 15, g = (item >> 1) & 1, lh = item & 1, h = g * 8 + wid;
  const int t0 = b * SEQ + c * 128 + lh * 64;
  const int ql = lane & 31, hh = lane >> 5;
  constexpr int YLD = 520;
  bf16_t* yoff = (bf16_t*)lds;
  const bf16_t* __restrict__ proj = (const bf16_t*)(p.ws + WS_PROJ);
  const float* __restrict__ acsg = (const float*)(p.ws + WS_ACSG);
  const bf16_t* __restrict__ ccb = (const bf16_t*)(p.ws + WS_CCB);
  const bf16_t* __restrict__ ypart = (const bf16_t*)(p.ws + WS_YPART);
  const bf16_t* __restrict__ hprev = (const bf16_t*)(p.ws + WS_HPREV);
  bf16_t* __restrict__ mixin = (bf16_t*)(p.ws + WS_HNB);
  {
    const bf16_t* hp = hprev + (size_t)((b * 16 + c) * 16 + h) * 8192 + (size_t)ql * 128 + 8 * hh;
    u32x4 hf0[8], hf1[8];
#pragma unroll
    for (int ks = 0; ks < 8; ++ks) { hf0[ks] = *(const u32x4*)(hp + 16 * ks); hf1[ks] = *(const u32x4*)(hp + 32 * 128 + 16 * ks); }
#pragma unroll
    for (int il = 0; il < 2; ++il) {
      const int lt = 32 * il + ql, t = t0 + lt;
      const bf16_t* cp = ccb + (size_t)t * 256 + g * 128 + 8 * hh;
      u32x4 cf[8];
#pragma unroll
      for (int ks = 0; ks < 8; ++ks) cf[ks] = *(const u32x4*)(cp + 16 * ks);
      const float ea = __expf(acsg[(size_t)t * 16 + h]);
      f32x16 a0, a1;
#pragma unroll
      for (int r = 0; r < 16; ++r) { a0[r] = 0.f; a1[r] = 0.f; }
#pragma unroll
      for (int ks = 0; ks < 8; ++ks) {
        a0 = __builtin_amdgcn_mfma_f32_32x32x16_bf16(*(bf16x8*)&hf0[ks], *(bf16x8*)&cf[ks], a0, 0, 0, 0);
        a1 = __builtin_amdgcn_mfma_f32_32x32x16_bf16(*(bf16x8*)&hf1[ks], *(bf16x8*)&cf[ks], a1, 0, 0, 0);
      }
      bf16_t* yr = yoff + lt * YLD + wid * 64 + 4 * hh;
#pragma unroll
      for (int rg = 0; rg < 4; ++rg) {
        u32x2 w0; w0.x = pack_bf16(ea * a0[4 * rg], ea * a0[4 * rg + 1]); w0.y = pack_bf16(ea * a0[4 * rg + 2], ea * a0[4 * rg + 3]);
        u32x2 w1; w1.x = pack_bf16(ea * a1[4 * rg], ea * a1[4 * rg + 1]); w1.y = pack_bf16(ea * a1[4 * rg + 2], ea * a1[4 * rg + 3]);
        *(u32x2*)(yr + 8 * rg) = w0;
        *(u32x2*)(yr + 32 + 8 * rg) = w1;
      }
    }
  }
  __syncthreads();
#pragma unroll
  for (int bt = 0; bt < 2; ++bt) {
    u32x4 yy[4], zz[4], yo[4];
#pragma unroll
    for (int q = 0; q < 4; ++q) {
      const int lt = wid * 8 + bt * 4 + q, t = t0 + lt;
      yy[q] = __builtin_nontemporal_load((const u32x4*)(ypart + (size_t)t * 1024 + g * 512 + lane * 8));
      zz[q] = __builtin_nontemporal_load((const u32x4*)(proj + (size_t)t * NPROJ + OFF_Z + g * 512 + lane * 8));
      yo[q] = *(const u32x4*)(yoff + lt * YLD + lane * 8);
    }
#pragma unroll
    for (int q = 0; q < 4; ++q) {
      const int t = t0 + wid * 8 + bt * 4 + q;
      float zv[8], ov[8], yv[8], y[8];
      unpack8(zz[q], zv); unpack8(yo[q], ov); unpack8(yy[q], yv);
#pragma unroll
      for (int i = 0; i < 8; ++i) y[i] = (yv[i] + ov[i]) * silu_f(zv[i]);
      float ss = 0.f;
#pragma unroll
      for (int i = 0; i < 8; ++i) ss += y[i] * y[i];
      ss = wave_sum(ss);
      const float rn = rsqrtf(ss * (1.f / 512) + EPS);
      u32x4 w; w.x = pack_bf16(y[0] * rn, y[1] * rn); w.y = pack_bf16(y[2] * rn, y[3] * rn); w.z = pack_bf16(y[4] * rn, y[5] * rn); w.w = pack_bf16(y[6] * rn, y[7] * rn);
      *(u32x4*)(mixin + (size_t)t * DM + 1024 + g * 512 + lane * 8) = w;
    }
  }
  __syncthreads();
}
__device__ __forceinline__ void phase3(const Params& p, unsigned char* lds, int bid, int nblk) {
  for (int it = bid; it < 256; it += nblk) ssd_b_item(p, lds, (nblk == 256) ? ((it & 7) * 32 + (it >> 3)) : it);
}

constexpr int LDS_BYTES = 144 * 1024;

typedef const Params __attribute__((address_space(4))) * KArgPtr;
__device__ __forceinline__ Params load_params(KArgPtr k) {
  Params q;
#if defined(__HIP_DEVICE_COMPILE__)
  __builtin_memcpy(&q, k, sizeof(Params));
#endif
  return q;
}
#define PARAMS_PTR(pp) KArgPtr pp##_k = (KArgPtr)__builtin_amdgcn_kernarg_segment_ptr(); asm volatile("" : "+s"(pp##_k)); const Params pp##_v = load_params(pp##_k); const Params* pp = &pp##_v
__global__ __launch_bounds__(512, 2) void k_mega(Params p_unused) {
  extern __shared__ __attribute__((aligned(16))) unsigned char shm[];
  const int bid = blockIdx.x, nblk = gridDim.x;
  volatile LAS unsigned* xst = (volatile LAS unsigned*)(LAS unsigned char*)(shm + LDS_BYTES - 16);
  if (threadIdx.x == 0) { xst[0] = 0u; xst[1] = 0u; }
  __syncthreads();
  XcdBarrier xb;
  { PARAMS_PTR(pp); xb = xcd_barrier_post((unsigned*)(pp->ws + WS_CTL), xst); }
#ifndef REP_PHASE
#define REP_PHASE -1
#define P6B_MASK 0xffffu
#define P6B_VAR 0
#endif
#define NREP(k) ((REP_PHASE == (k)) ? 2 : 1)
#ifndef REP_ALL
#define REP_ALL 1
#endif
#pragma unroll 1
  for (int pass = 0; pass < REP_ALL; ++pass) {
  if (pass) xcd_barrier(xb);
#pragma unroll 1
  for (int rep = 0; rep < NREP(0); ++rep) { { PARAMS_PTR(pp); phase0(*pp, (float*)shm, bid, nblk); } if (rep + 1 < NREP(0)) xcd_barrier(xb); }
  xcd_barrier(xb);
#pragma unroll 1
  for (int rep = 0; rep < NREP(1); ++rep) { { PARAMS_PTR(pp); phase1(*pp, shm, bid, nblk); } xcd_barrier(xb); }
#pragma unroll 1
  for (int rep = 0; rep < NREP(2); ++rep) { { PARAMS_PTR(pp); phase2(*pp, shm, bid, nblk); } xcd_barrier(xb); }
#pragma unroll 1
  for (int rep = 0; rep < NREP(7); ++rep) { { PARAMS_PTR(pp); phase_scan(*pp, bid, nblk); } xcd_barrier(xb); }
#pragma unroll 1
  for (int rep = 0; rep < NREP(3); ++rep) { { PARAMS_PTR(pp); phase3(*pp, shm, bid, nblk); } xcd_barrier(xb); }
#pragma unroll 1
  for (int rep = 0; rep < NREP(4); ++rep) { { PARAMS_PTR(pp); phase4(*pp, shm, bid, nblk); } xcd_barrier(xb); }
#pragma unroll 1
  for (int rep = 0; rep < NREP(5); ++rep) { { PARAMS_PTR(pp); phase5(*pp, shm, bid, nblk); } xcd_barrier(xb); }
#pragma unroll 1
  for (int rep = 0; rep < NREP(8); ++rep) { { PARAMS_PTR(pp); phase6a(*pp, shm, bid, nblk); } xcd_barrier(xb); }
#pragma unroll 1
  for (int rep = 0; rep < NREP(6); ++rep) { { PARAMS_PTR(pp); phase6b(*pp, shm, bid, nblk); } xcd_barrier(xb); }
#pragma unroll 1
  for (int rep = 0; rep < NREP(9); ++rep) { { PARAMS_PTR(pp); phase6c(*pp, shm, bid, nblk); } if (rep + 1 < NREP(9)) xcd_barrier(xb); }
  }
}

}

extern "C" void kernel_launch(void* const* d_in, const int* in_sizes, int n_in, void* d_out, int out_size, void* d_ws,
                              size_t ws_size, hipStream_t stream) {
  Params p{};
  p.x = (const float*)d_in[0]; p.meta = (const float*)d_in[1]; p.rel_bias = (const float*)d_in[2];
  p.ln_mix = (const float*)d_in[3]; p.w_in = (const float*)d_in[4]; p.sinks = (const float*)d_in[5];
  p.conv_w = (const float*)d_in[6]; p.conv_b = (const float*)d_in[7]; p.dt_bias = (const float*)d_in[8];
  p.a_log = (const float*)d_in[9]; p.d_skip = (const float*)d_in[10]; p.attn_norm_w = (const float*)d_in[11];
  p.ssm_norm_w = (const float*)d_in[12]; p.w_out = (const float*)d_in[13]; p.ln_ffn = (const float*)d_in[14];
  p.wq = (const float*)d_in[15]; p.keys = (const float*)d_in[16]; p.U = (const float*)d_in[17];
  p.V = (const float*)d_in[18]; p.ln_final = (const float*)d_in[19];
  p.out = (float*)d_out;
  p.ws = (unsigned char*)d_ws;

  static int grid_blocks = 0;
  if (!grid_blocks) {
    int dev = 0, cus = 0, per_cu = 0;
    (void)hipGetDevice(&dev);
    (void)hipDeviceGetAttribute(&cus, hipDeviceAttributeMultiprocessorCount, dev);
    (void)hipFuncSetAttribute((const void*)k_mega, hipFuncAttributeMaxDynamicSharedMemorySize, LDS_BYTES);
    (void)hipOccupancyMaxActiveBlocksPerMultiprocessor(&per_cu, (const void*)k_mega, NTHREADS, LDS_BYTES);
    if (per_cu > 1) per_cu = 1;
    grid_blocks = cus * per_cu;
    if (grid_blocks != 256) fprintf(stderr, "kernel_launch: expected a 256-workgroup resident grid, got %d (cus %d, per_cu %d)\n", grid_blocks, cus, per_cu);
  }
  (void)hipMemsetAsync(p.ws + WS_CTL, 0, XCD_BAR_WORDS * 4, stream);
  void* args[] = {&p};
  hipError_t e = hipLaunchCooperativeKernel((const void*)k_mega, dim3(grid_blocks), dim3(NTHREADS), args, LDS_BYTES, stream);
  if (e != hipSuccess) fprintf(stderr, "cooperative launch failed: %s (grid %d)\n", hipGetErrorString(e), grid_blocks);
}
```

```cpp
#include <hip/hip_runtime.h>
#include <math.h>
#include <stdio.h>
#include <stdint.h>

#ifndef REP_SUB
#define REP_SUB -1
#endif
namespace {
constexpr int BATCH = 4, SEQ = 2048, DM = 2048, NMETA = 16;
constexpr int T = BATCH * SEQ;
constexpr int TA = T + NMETA;
constexpr int DPROJ = 4112;
constexpr int NPROJ = 4096;
constexpr int OFF_Q = 0, OFF_K = 1024, OFF_V = 1280, OFF_Z = 1536, OFF_XBC = 2560, OFF_DT = 4096;
constexpr int D_XBC = 1536;
constexpr int NEXP = 16384;
constexpr int ROW4 = 1024;
constexpr int ROW6 = 1536;
constexpr float EPS = 1e-6f;
constexpr int NTHREADS = 512;

typedef unsigned short bf16_t;
typedef short bf16x8 __attribute__((ext_vector_type(8)));
typedef float f32x4 __attribute__((ext_vector_type(4)));
typedef float f32x2 __attribute__((ext_vector_type(2)));
typedef unsigned u32x4 __attribute__((ext_vector_type(4)));
typedef unsigned u32x2 __attribute__((ext_vector_type(2)));
typedef __bf16 bf16v2 __attribute__((ext_vector_type(2)));
typedef float f32x16v __attribute__((ext_vector_type(16)));
typedef float f32x32v __attribute__((ext_vector_type(32)));
typedef float f32x16 __attribute__((ext_vector_type(16)));
typedef int i32x8 __attribute__((ext_vector_type(8)));
typedef int i32x4 __attribute__((ext_vector_type(4)));
typedef unsigned u32x6 __attribute__((ext_vector_type(6)));
#define LAS __attribute__((address_space(3)))

__device__ __forceinline__ unsigned pack_bf16(float lo, float hi) {
  f32x2 v = {lo, hi};
  bf16v2 b = __builtin_convertvector(v, bf16v2);
  return *(unsigned*)&b;
}
__device__ __forceinline__ bf16_t f2bf(float f) { return (bf16_t)(pack_bf16(f, 0.f) & 0xffffu); }
__device__ __forceinline__ float bf2f(bf16_t b) { return __uint_as_float(((unsigned)b) << 16); }
__device__ __forceinline__ float bflo(unsigned u) { return __uint_as_float(u << 16); }
__device__ __forceinline__ float bfhi(unsigned u) { return __uint_as_float(u & 0xffff0000u); }

__constant__ unsigned char kBucket[128] = {
    0, 1, 2, 3, 4, 5, 6, 7, 8, 9, 10, 11, 12, 13, 14, 15, 16, 16, 16, 17, 17, 18, 18, 18, 19, 19, 19, 20, 20, 20, 20, 21,
    21, 21, 21, 22, 22, 22, 22, 22, 23, 23, 23, 23, 23, 23, 24, 24, 24, 24, 24, 24, 25, 25, 25, 25, 25, 25, 25, 26, 26, 26, 26, 26,
    26, 26, 26, 27, 27, 27, 27, 27, 27, 27, 27, 27, 27, 28, 28, 28, 28, 28, 28, 28, 28, 28, 28, 29, 29, 29, 29, 29, 29, 29, 29, 29,
    29, 29, 29, 30, 30, 30, 30, 30, 30, 30, 30, 30, 30, 30, 30, 30, 30, 31, 31, 31, 31, 31, 31, 31, 31, 31, 31, 31, 31, 31, 31, 31};

__constant__ unsigned char kCandI[64] = {0, 0, 0, 0, 0, 0, 0, 0, 0, 0, 0, 0, 0, 0, 0, 0, 1, 1, 1, 1, 1, 1, 1, 1, 2, 2, 2, 2, 2, 3, 3, 3, 3, 4, 4, 4, 5, 5, 6, 6, 7, 7, 8, 9, 10, 11, 12, 13, 14, 15, 15, 15, 15, 15, 15, 15, 15, 15, 15, 15, 15, 15, 15, 15};
__constant__ unsigned char kCandJ[64] = {0, 1, 2, 3, 4, 5, 6, 7, 8, 9, 10, 11, 12, 13, 14, 15, 0, 1, 2, 3, 4, 5, 6, 7, 0, 1, 2, 3, 4, 0, 1, 2, 3, 0, 1, 2, 0, 1, 0, 1, 0, 1, 0, 0, 0, 0, 0, 0, 0, 0, 15, 15, 15, 15, 15, 15, 15, 15, 15, 15, 15, 15, 15, 15};

__device__ __forceinline__ float wave_sum(float v) {
  for (int o = 32; o > 0; o >>= 1) v += __shfl_xor(v, o);
  return v;
}
__device__ __forceinline__ float wave_max(float v) {
  for (int o = 32; o > 0; o >>= 1) v = fmaxf(v, __shfl_xor(v, o));
  return v;
}
__device__ __forceinline__ float silu_f(float x) { return x / (1.f + expf(-x)); }
__device__ __forceinline__ float softplus_f(float x) { return fmaxf(x, 0.f) + log1pf(expf(-fabsf(x))); }

constexpr size_t al256(size_t x) { return (x + 255) & ~(size_t)255; }
constexpr size_t WS_CTL = 0;
constexpr size_t WS_WINT = 65536;
constexpr size_t WS_WDTT = WS_WINT + (size_t)NPROJ * DM * 2;
constexpr size_t WS_WOUTT = WS_WDTT + (size_t)16 * DM * 2;
constexpr size_t WS_WQT = WS_WOUTT + (size_t)DM * DM * 2;
constexpr size_t WS_KEYS = WS_WQT + (size_t)DM * DM * 2;
constexpr size_t WS_UB = WS_KEYS + (size_t)16 * 128 * 128 * 2;
constexpr size_t WS_VB = WS_UB + (size_t)NEXP * DM * 2;
constexpr size_t WS_HNB = WS_VB + (size_t)NEXP * DM * 2;
constexpr size_t WS_PROJ = WS_HNB + (size_t)(T + 16) * DM * 2;
constexpr size_t WS_DTRAW = WS_PROJ + (size_t)T * NPROJ * 2;
constexpr size_t WS_PROJM = WS_DTRAW + (size_t)T * 16 * 4;
constexpr size_t WS_PROJMB = al256(WS_PROJM + (size_t)16 * DPROJ * 4);
constexpr size_t WS_H1B = al256(WS_PROJMB + (size_t)16 * DPROJ * 2);
constexpr size_t WS_SSQH1 = WS_H1B + (size_t)T * DM * 2;
constexpr size_t WS_STOP = al256(WS_SSQH1 + (size_t)T * 32 * 4);
constexpr size_t WS_ITOP = WS_STOP + (size_t)T * 256 * 4;
constexpr size_t WS_ACSG = al256(WS_ITOP + (size_t)T * 256 * 4);
constexpr size_t WS_CCB = WS_ACSG + (size_t)T * 16 * 4;
constexpr size_t WS_YPART = WS_CCB + (size_t)T * 256 * 2;
constexpr size_t WS_SG = WS_YPART + (size_t)T * 1024 * 4;
constexpr size_t WS_SMETA = WS_SG + (size_t)1024 * 8192 * 4;
constexpr size_t WS_HPREV = al256(WS_SMETA + (size_t)16 * 8192 * 4);
constexpr size_t WS_USC = al256(WS_HPREV + (size_t)1024 * 8192 * 2);
constexpr size_t WS_VSC = WS_USC + (size_t)NEXP * 4;
constexpr size_t WS_SCR = al256(WS_VSC + (size_t)NEXP * 4);
constexpr size_t WS_P6IDS = WS_YPART;
constexpr size_t WS_P6GTS = WS_P6IDS + (size_t)T * 128 * 4;
constexpr size_t WS_P6USC = WS_P6GTS + (size_t)T * 128 * 4;
constexpr size_t WS_P6XES = WS_P6USC + (size_t)T * 128 * 4;
constexpr size_t WS_P6XQ = WS_PROJ;
constexpr size_t WS_HPART = WS_SG;
}

namespace pg8 {
#define PG8_LAS __attribute__((address_space(3)))
constexpr int BM = 256, BK = 64, HALF = 128, HTB = HALF * BK * 2, STAGE_BYTES = 8 * HTB, NXCD = 8, WGM = 8;
__host__ __device__ __forceinline__ int lds_byte(int r, int c) { const int st = (r >> 4) * 2 + (c >> 5), rr = r & 15, cc = c & 31, ob = rr * 64 + cc * 2; return st * 1024 + (ob ^ (((ob >> 9) & 1) << 5)); }
__host__ __device__ __forceinline__ void stage_rc(int b, int& R, int& C) { const int st = b / 1024, sb = b % 1024, swz = sb ^ (((sb >> 9) & 1) << 5); R = (st >> 1) * 16 + swz / 64; C = (st & 1) * 32 + (swz % 64) / 2; }
__host__ __device__ __forceinline__ int perm32(int rho) { const int n = rho >> 4, i = rho & 15; return 8 * (i >> 2) + 4 * n + (i & 3); }
struct Unit { int pm, pn; };
struct Gemm { const bf16_t* A; const bf16_t* Bt; int M, N, K; };
struct StaticOrder {
    int nM, nN, nwg, G, c;
    __host__ __device__ void init(int M, int N, int G_, int c_) { nM = M / BM; nN = N / BM; nwg = nM * nN; G = G_; c = c_; }
    __host__ __device__ bool next(int i, Unit& u) const {
        const long L = (long)i * G + c; if (L >= nwg) return false;
        int wgid = (int)L; { const int q = nwg / NXCD, r = nwg % NXCD, xcd = wgid % NXCD, off = wgid / NXCD; wgid = (xcd < r ? xcd * (q + 1) : r * (q + 1) + (xcd - r) * q) + off; }
        const int nig = WGM * nN, gid = wgid / nig, fm = gid * WGM, gsz = (nM - fm) < WGM ? (nM - fm) : WGM;
        u.pm = fm + ((wgid % nig) % gsz); u.pn = (wgid % nig) / gsz; return true;
    }
    __device__ __forceinline__ void a_ready(const Unit&) const {}
    __device__ __forceinline__ void done(const Unit&) const {}
};
struct EpiBf16 {
    static constexpr bool PERM = true, AFTER_DRAIN = false;
    bf16_t* O; int ldc;
    __device__ __forceinline__ void operator()(const f32x4 (&acc)[2][2][4][2], const Unit& u, int wr, int wc, int fr, int fq) const {
        const int row0 = u.pm * BM + wr * 64 + fr; const int col0 = u.pn * BM + wc * 32 + 8 * fq;
        const __amdgpu_buffer_rsrc_t rsrc = __builtin_amdgcn_make_buffer_rsrc(O, 0, 0x7fffffff, 0x00020000);
#pragma unroll
        for (int ai = 0; ai < 2; ++ai)
#pragma unroll
            for (int m = 0; m < 4; ++m) { const unsigned boff = (unsigned)(((size_t)(row0 + ai * HALF + m * 16) * ldc + col0) * 2);
#pragma unroll
                for (int bj = 0; bj < 2; ++bj) { const f32x4 v0 = acc[ai][bj][m][0], v1 = acc[ai][bj][m][1];
                    u32x4 w; w.x = pack_bf16(v0[0], v0[1]); w.y = pack_bf16(v0[2], v0[3]); w.z = pack_bf16(v1[0], v1[1]); w.w = pack_bf16(v1[2], v1[3]);
                    __builtin_amdgcn_raw_buffer_store_b128(w, rsrc, boff + bj * HALF * 2, 0, 16); } }
    }
};

struct EpiRes {
    static constexpr bool PERM = true, AFTER_DRAIN = false;
    const float* X; bf16_t* HB; float* SSQ;
    __device__ __forceinline__ void operator()(const f32x4 (&acc)[2][2][4][2], const Unit& u, int wr, int wc, int fr, int fq) const {
        const int row0 = u.pm * BM + wr * 64 + fr; const int col0 = u.pn * BM + wc * 32 + 8 * fq;
#pragma unroll
        for (int ai = 0; ai < 2; ++ai) {
            f32x4 xr[4][2][2];
#pragma unroll
            for (int m = 0; m < 4; ++m) { const size_t off = (size_t)(row0 + ai * HALF + m * 16) * DM + col0;
#pragma unroll
                for (int bj = 0; bj < 2; ++bj) { xr[m][bj][0] = __builtin_nontemporal_load((const f32x4*)(X + off + bj * HALF)); xr[m][bj][1] = __builtin_nontemporal_load((const f32x4*)(X + off + bj * HALF + 4)); } }
#pragma unroll
            for (int m = 0; m < 4; ++m) { const int row = row0 + ai * HALF + m * 16; const size_t off = (size_t)row * DM + col0; float ss = 0.f;
#pragma unroll
                for (int bj = 0; bj < 2; ++bj) {
                    const f32x4 v0 = acc[ai][bj][m][0] + xr[m][bj][0], v1 = acc[ai][bj][m][1] + xr[m][bj][1];
                    u32x4 w; w.x = pack_bf16(v0[0], v0[1]); w.y = pack_bf16(v0[2], v0[3]); w.z = pack_bf16(v1[0], v1[1]); w.w = pack_bf16(v1[2], v1[3]);
                    *(u32x4*)(HB + off + bj * HALF) = w;
                    ss += v0[0] * v0[0] + v0[1] * v0[1] + v0[2] * v0[2] + v0[3] * v0[3] + v1[0] * v1[0] + v1[1] * v1[1] + v1[2] * v1[2] + v1[3] * v1[3]; }
                ss += __shfl_xor(ss, 16); ss += __shfl_xor(ss, 32);
                if (fq == 0) SSQ[(size_t)row * 32 + u.pn * 4 + wc] = ss; }
        }
    }
};
struct EpiF32 {
    static constexpr bool PERM = true, AFTER_DRAIN = false;
    float* C; int ldc;
    __device__ __forceinline__ void operator()(const f32x4 (&acc)[2][2][4][2], const Unit& u, int wr, int wc, int fr, int fq) const {
        const int row0 = u.pm * BM + wr * 64 + fr; const int col0 = u.pn * BM + wc * 32 + 8 * fq;
#pragma unroll
        for (int ai = 0; ai < 2; ++ai)
#pragma unroll
            for (int m = 0; m < 4; ++m) { float* rowp = C + (size_t)(row0 + ai * HALF + m * 16) * ldc + col0;
#pragma unroll
                for (int bj = 0; bj < 2; ++bj) { *(f32x4*)(rowp + bj * HALF) = acc[ai][bj][m][0]; *(f32x4*)(rowp + bj * HALF + 4) = acc[ai][bj][m][1]; } }
    }
};

struct EpiScores {
    static constexpr bool PERM = true, AFTER_DRAIN = true;
    const bf16_t* KEYS;
    float* STOP; int* ITOP;
    static constexpr int QLD = 264;
    __device__ __forceinline__ void fused(f32x4 (&acc)[2][2][4][2], const Unit& u, int wr, int wc, int fr, int fq, PG8_LAS unsigned char* lds, int wid, int lane) const {
        PG8_LAS bf16_t* Q = (PG8_LAS bf16_t*)lds;
#pragma unroll
        for (int ai = 0; ai < 2; ++ai)
#pragma unroll
            for (int m = 0; m < 4; ++m) { const int row = ai * HALF + wr * 64 + m * 16 + fr;
#pragma unroll
                for (int bj = 0; bj < 2; ++bj) { const f32x4 v0 = acc[ai][bj][m][0], v1 = acc[ai][bj][m][1];
                    u32x4 w; w.x = pack_bf16(v0[0], v0[1]); w.y = pack_bf16(v0[2], v0[3]); w.z = pack_bf16(v1[0], v1[1]); w.w = pack_bf16(v1[2], v1[3]);
                    *(PG8_LAS u32x4*)(Q + row * QLD + bj * HALF + wc * 32 + 8 * fq) = w; } }
        __syncthreads();
        const int h = u.pn;
#pragma unroll 1
        for (int c = 0; c < 2; ++c) {
            f32x4 sc[8][2];
#pragma unroll
            for (int kf = 0; kf < 8; ++kf) { sc[kf][0] = (f32x4){0.f, 0.f, 0.f, 0.f}; sc[kf][1] = (f32x4){0.f, 0.f, 0.f, 0.f}; }
            const bf16_t* kb = KEYS + (size_t)((h * 2 + c) * 128 + fr) * 128 + 8 * fq;
            const PG8_LAS bf16_t* qb = Q + (wid * 32 + fr) * QLD + c * 128 + 8 * fq;
#pragma unroll
            for (int ks = 0; ks < 4; ++ks) {
                const bf16x8 q0 = *(const PG8_LAS bf16x8*)(qb + 32 * ks), q1 = *(const PG8_LAS bf16x8*)(qb + 16 * QLD + 32 * ks);
#pragma unroll
                for (int kf = 0; kf < 8; ++kf) { const bf16x8 kv = *(const bf16x8*)(kb + (size_t)kf * 16 * 128 + 32 * ks);
                    sc[kf][0] = __builtin_amdgcn_mfma_f32_16x16x32_bf16(kv, q0, sc[kf][0], 0, 0, 0);
                    sc[kf][1] = __builtin_amdgcn_mfma_f32_16x16x32_bf16(kv, q1, sc[kf][1], 0, 0, 0); }
            }
#pragma unroll
            for (int tf = 0; tf < 2; ++tf) {
                int v[32];
#pragma unroll
                for (int kf = 0; kf < 8; ++kf)
#pragma unroll
                    for (int r = 0; r < 4; ++r) {
                        const int bts = (int)__float_as_uint(sc[kf][tf][r]);
                        const int srt = bts ^ ((bts >> 31) & 0x7fffffff);
                        v[kf * 4 + r] = (srt & ~127) | (16 * kf + 4 * fq + r);
                    }
#pragma unroll
                for (int k = 2; k <= 32; k <<= 1)
#pragma unroll
                    for (int j = k >> 1; j > 0; j >>= 1)
#pragma unroll
                        for (int i = 0; i < 32; ++i) {
                            const int l = i ^ j;
                            if (l > i) {
                                const int x = v[i], y = v[l];
                                const int hi_ = x > y ? x : y, lo_ = x > y ? y : x;
                                if ((i & k) == 0) { v[i] = hi_; v[l] = lo_; } else { v[i] = lo_; v[l] = hi_; }
                            }
                        }
#pragma unroll
                for (int step = 0; step < 2; ++step) {
                    const int xm = step == 0 ? 16 : 32;
                    int m[16];
#pragma unroll
                    for (int i = 0; i < 16; ++i) { const int o = __shfl_xor(v[15 - i], xm); m[i] = v[i] > o ? v[i] : o; }
#pragma unroll
                    for (int j = 8; j > 0; j >>= 1)
#pragma unroll
                        for (int i = 0; i < 16; ++i) {
                            const int l = i ^ j;
                            if (l > i) { const int x = m[i], y = m[l]; m[i] = x > y ? x : y; m[l] = x > y ? y : x; }
                        }
#pragma unroll
                    for (int i = 0; i < 16; ++i) v[i] = m[i];
                }
                if (fq == 0) {
                    const size_t obase = ((size_t)(u.pm * BM + wid * 32 + tf * 16 + fr) * 16 + h * 2 + c) * 16;
#pragma unroll
                    for (int q4 = 0; q4 < 4; ++q4) {
                        f32x4 sv; u32x4 iv;
#pragma unroll
                        for (int i = 0; i < 4; ++i) {
                            const int key = v[4 * q4 + i], srt = key & ~127;
                            sv[i] = __uint_as_float((unsigned)(srt ^ ((srt >> 31) & 0x7fffffff)));
                            iv[i] = (unsigned)(key & 127);
                        }
                        *(f32x4*)(STOP + obase + 4 * q4) = sv;
                        *(u32x4*)(ITOP + obase + 4 * q4) = iv;
                    }
                }
            }
        }
    }
};

template <class Epi, class Sched>
__device__ __forceinline__ void gemm_phase(PG8_LAS unsigned char* lds, const Gemm g, const Sched& S, const Epi& E) {
    int tid_ = threadIdx.x; asm volatile("" : "+v"(tid_));
    const int tid = tid_, wid = __builtin_amdgcn_readfirstlane(tid >> 6), lane = tid & 63, wr = wid >> 2, wc = wid & 3, fr = lane & 15, fq = lane >> 4;
    const int K = g.K, nt = K / BK;
    unsigned voffA[2], voffB[2];
#pragma unroll
    for (int i = 0; i < 2; ++i) { int R, C; stage_rc(tid * 16 + i * 8192, R, C); const int Rb = Epi::PERM ? ((R & ~31) + perm32(R & 31)) : R;
        voffA[i] = (unsigned)(R * K + C) * 2u; voffB[i] = (unsigned)(Rb * K + C) * 2u; }
    const size_t kstep = (size_t)(BK * 2);
    const size_t hstep = (size_t)HALF * K * 2;
    const size_t tstep = 2 * hstep;
    const unsigned ldsw = (unsigned)wid * 1024u;
    const int aoff = lds_byte(wr * 64 + fr, fq * 8), boff = lds_byte(wc * 32 + fr, fq * 8);
#define PG8_SA(b, h) (((b) * 2 + (h)) * HTB)
#define PG8_SB(b, h) ((4 + (b) * 2 + (h)) * HTB)
#define PG8_STAGE(bufoff, gbase, voff) do { _Pragma("unroll") for (int _i = 0; _i < 2; ++_i) \
        __builtin_amdgcn_global_load_lds((const unsigned*)((const char*)(gbase) + (voff)[_i]), (PG8_LAS unsigned*)(lds + (bufoff) + ldsw + _i * 8192), 16, 0, 0); } while (0)
#define PG8_LDA(dst, b, h) do { _Pragma("unroll") for (int m = 0; m < 4; ++m) _Pragma("unroll") for (int k = 0; k < 2; ++k) dst[m][k] = *(const PG8_LAS bf16x8*)(lds + PG8_SA(b, h) + aoff + m * 2048 + k * 1024); } while (0)
#define PG8_LDB(dst, b, h) do { _Pragma("unroll") for (int n = 0; n < 2; ++n) _Pragma("unroll") for (int k = 0; k < 2; ++k) dst[n][k] = *(const PG8_LAS bf16x8*)(lds + PG8_SB(b, h) + boff + n * 2048 + k * 1024); } while (0)
#define PG8_MMA(ai, bj, At, Bt) do { __builtin_amdgcn_s_setprio(1); _Pragma("unroll") for (int m = 0; m < 4; ++m) _Pragma("unroll") for (int n = 0; n < 2; ++n) _Pragma("unroll") for (int k = 0; k < 2; ++k) \
        acc[ai][bj][m][n] = __builtin_amdgcn_mfma_f32_16x16x32_bf16(Bt[n][k], At[m][k], acc[ai][bj][m][n], 0, 0, 0); __builtin_amdgcn_s_setprio(0); } while (0)
#define PG8_WAIT_V(n) asm volatile("s_waitcnt vmcnt(" #n ")" ::: "memory")
#define PG8_WAIT_L(n) asm volatile("s_waitcnt lgkmcnt(" #n ")" ::: "memory")
#define PG8_BAR __builtin_amdgcn_s_barrier()
#define PG8_SCHED __builtin_amdgcn_sched_barrier(0)
    Unit cur, nxt; int ui = 0;
    if (!S.next(0, cur)) return;
    f32x4 acc[2][2][4][2];
#pragma unroll
    for (int a = 0; a < 2; ++a)
#pragma unroll
        for (int b = 0; b < 2; ++b)
#pragma unroll
            for (int m = 0; m < 4; ++m)
#pragma unroll
                for (int n = 0; n < 2; ++n) acc[a][b][m][n] = (f32x4){0.f, 0.f, 0.f, 0.f};
    bf16x8 At[4][2], B0[2][2], B1[2][2];
    const char* cA = (const char*)g.A + (size_t)cur.pm * tstep; const char* cB = (const char*)g.Bt + (size_t)cur.pn * tstep;
    S.a_ready(cur);
    PG8_STAGE(PG8_SB(0, 0), cB, voffB); PG8_STAGE(PG8_SA(0, 0), cA, voffA); PG8_STAGE(PG8_SB(0, 1), cB + hstep, voffB); PG8_STAGE(PG8_SA(0, 1), cA + hstep, voffA);
    if (wr == 1) PG8_BAR;
    PG8_WAIT_V(4); PG8_BAR;
    PG8_STAGE(PG8_SB(1, 0), cB + kstep, voffB); PG8_STAGE(PG8_SA(1, 0), cA + kstep, voffA); PG8_STAGE(PG8_SB(1, 1), cB + hstep + kstep, voffB);
    PG8_WAIT_V(6); PG8_BAR;
    for (;;) {
        const bool has_next = S.next(ui + 1, nxt);
        const char* nA = has_next ? (const char*)g.A + (size_t)nxt.pm * tstep : cA; const char* nB = has_next ? (const char*)g.Bt + (size_t)nxt.pn * tstep : cB;
        for (int t = 0; t < nt; t += 2) {
            const bool last = (t == nt - 2);
            const char* a1 = cA + (size_t)(t + 1) * kstep;
            const char* a2 = last ? nA : cA + (size_t)(t + 2) * kstep; const char* b2 = last ? nB : cB + (size_t)(t + 2) * kstep;
            const char* a3 = a2 + kstep; const char* b3 = b2 + kstep;
            if (last && has_next) S.a_ready(nxt);
            PG8_LDB(B0, 0, 0); PG8_SCHED; PG8_LDA(At, 0, 0); PG8_STAGE(PG8_SA(1, 1), a1 + hstep, voffA);
            PG8_WAIT_L(8); PG8_BAR; PG8_WAIT_L(0); PG8_MMA(0, 0, At, B0); PG8_BAR; PG8_SCHED;
            PG8_LDB(B1, 0, 1); PG8_STAGE(PG8_SB(0, 0), b2, voffB);
            PG8_BAR; PG8_WAIT_L(0); PG8_MMA(0, 1, At, B1); PG8_BAR;
            PG8_LDA(At, 0, 1); PG8_STAGE(PG8_SA(0, 0), a2, voffA);
            PG8_BAR; PG8_WAIT_L(0); PG8_MMA(1, 0, At, B0); PG8_BAR; PG8_SCHED;
            PG8_STAGE(PG8_SB(0, 1), b2 + hstep, voffB);
            PG8_WAIT_V(6); PG8_BAR; PG8_MMA(1, 1, At, B1); PG8_BAR;
            PG8_LDB(B0, 1, 0); PG8_SCHED; PG8_LDA(At, 1, 0); PG8_STAGE(PG8_SA(0, 1), a2 + hstep, voffA);
            PG8_WAIT_L(8); PG8_BAR; PG8_WAIT_L(0); PG8_MMA(0, 0, At, B0); PG8_BAR; PG8_SCHED;
            PG8_LDB(B1, 1, 1); PG8_STAGE(PG8_SB(1, 0), b3, voffB);
            PG8_BAR; PG8_WAIT_L(0); PG8_MMA(0, 1, At, B1); PG8_BAR;
            PG8_LDA(At, 1, 1); PG8_STAGE(PG8_SA(1, 0), a3, voffA);
            PG8_BAR; PG8_WAIT_L(0); PG8_MMA(1, 0, At, B0); PG8_BAR; PG8_SCHED;
            PG8_STAGE(PG8_SB(1, 1), b3 + hstep, voffB);
            PG8_WAIT_V(6); PG8_BAR; PG8_MMA(1, 1, At, B1); PG8_BAR;
        }
        if constexpr (!Epi::AFTER_DRAIN) { E(acc, cur, wr, wc, fr, fq); S.done(cur); }
        if (!has_next) break;
#pragma unroll
        for (int a = 0; a < 2; ++a)
#pragma unroll
            for (int b = 0; b < 2; ++b)
#pragma unroll
                for (int m = 0; m < 4; ++m)
#pragma unroll
                    for (int n = 0; n < 2; ++n) acc[a][b][m][n] = (f32x4){0.f, 0.f, 0.f, 0.f};
        cur = nxt; cA = nA; cB = nB; ++ui;
    }
    PG8_WAIT_V(0);
    if (wr == 0) PG8_BAR;
    PG8_BAR;
    if constexpr (Epi::AFTER_DRAIN) { E.fused(acc, cur, wr, wc, fr, fq, lds, wid, lane); S.done(cur); }
#undef PG8_SA
#undef PG8_SB
#undef PG8_STAGE
#undef PG8_LDA
#undef PG8_LDB
#undef PG8_MMA
#undef PG8_WAIT_V
#undef PG8_WAIT_L
#undef PG8_BAR
#undef PG8_SCHED
}
}

#define XB_TMO      128
#define XB_XCNT(j)  (256  + 64 * (j))
#define XB_XSUB(j)  (1280 + 64 * (j))
#define XB_XGEN(j)  (2304 + 64 * (j))
#define XB_TOP      3328
#define XB_TOPGEN   3392
#define XCD_BAR_WORDS 3456
#define XB_SPIN_CAP (1u << 22)
__device__ __forceinline__ unsigned xb_ld(unsigned* p)              { return __hip_atomic_load(p, __ATOMIC_RELAXED, __HIP_MEMORY_SCOPE_AGENT); }
__device__ __forceinline__ unsigned xb_add(unsigned* p, unsigned v) { return __hip_atomic_fetch_add(p, v, __ATOMIC_RELAXED, __HIP_MEMORY_SCOPE_AGENT); }
__device__ __forceinline__ unsigned xb_xcc_id() { return (unsigned)__builtin_amdgcn_s_getreg((3 << 11) | 20) & 0xFu; }
#define XB_SPIN(cond, bar) do { unsigned _sp = 0; while (cond) { __builtin_amdgcn_s_sleep(1); \
    if ((++_sp & 255u) == 0u) { if (xb_ld(&(bar)[XB_TMO])) break; if (_sp > XB_SPIN_CAP) { atomicAdd(&(bar)[XB_TMO], 1u); break; } } } } while (0)
struct XcdBarrier { unsigned* bar; unsigned x; volatile LAS unsigned* st; };
__device__ __forceinline__ XcdBarrier xcd_barrier_post(unsigned* bar, volatile LAS unsigned* st) {
    XcdBarrier b; b.bar = bar; b.x = xb_xcc_id(); b.st = st;
    if (threadIdx.x == 0) (void)xb_add(&bar[XB_XCNT(b.x)], 1u);
    return b;
}
__device__ __forceinline__ void xcd_barrier_complete(unsigned* bar, unsigned x, unsigned& nloc, unsigned& nx) {
    const unsigned G = gridDim.x * gridDim.y * gridDim.z;
    unsigned sum, cnt, mine, sp = 0u;
    for (;;) {
        sum = 0u; cnt = 0u; mine = 0u;
#pragma unroll
        for (unsigned j = 0; j < 16; ++j) { const unsigned c = xb_ld(&bar[XB_XCNT(j)]); sum += c; cnt += (c > 0u) ? 1u : 0u; mine = (j == x) ? c : mine; }
        if (sum == G) break;
        __builtin_amdgcn_s_sleep(1);
        if ((++sp & 255u) == 0u) { if (xb_ld(&bar[XB_TMO])) break; if (sp > XB_SPIN_CAP) { atomicAdd(&bar[XB_TMO], 1u); break; } }
    }
    nloc = mine > 0u ? mine : 1u; nx = cnt > 0u ? cnt : 1u;
}
__device__ __forceinline__ void xcd_barrier(const XcdBarrier& b) {
    asm volatile("s_waitcnt vmcnt(0)" ::: "memory");
    __syncthreads();
    if (threadIdx.x == 0) {
        unsigned* bar = b.bar;
        const unsigned bx = xb_xcc_id();
        __builtin_amdgcn_s_waitcnt(0);
        unsigned nloc = b.st[0], nx = b.st[1];
        if (nloc == 0u) { xcd_barrier_complete(bar, bx, nloc, nx); b.st[0] = nloc; b.st[1] = nx; }
        const unsigned old = xb_add(&bar[XB_XSUB(bx)], 1u);
        const unsigned gen = old / nloc;
        if (old + 1u == (gen + 1u) * nloc) {
            __builtin_amdgcn_fence(__ATOMIC_RELEASE, "agent");
            asm volatile("s_waitcnt vmcnt(0)" ::: "memory");
            const unsigned og = xb_add(&bar[XB_TOP], 1u);
            const unsigned tg = og / nx;
            if (og + 1u == (tg + 1u) * nx) xb_add(&bar[XB_TOPGEN], 1u);
            else XB_SPIN(xb_ld(&bar[XB_TOPGEN]) == tg, bar);
            __builtin_amdgcn_fence(__ATOMIC_ACQUIRE, "agent");
            xb_add(&bar[XB_XGEN(bx)], 1u);
            asm volatile("s_waitcnt vmcnt(0)" ::: "memory");
        } else {
            XB_SPIN(xb_ld(&bar[XB_XGEN(bx)]) == gen, bar);
            __builtin_amdgcn_fence(__ATOMIC_ACQUIRE, "agent");
            asm volatile("s_waitcnt vmcnt(0)" ::: "memory");
        }
    }
    __syncthreads();
}

namespace {
struct Params {
  const float *x, *meta, *rel_bias, *ln_mix, *w_in, *sinks, *conv_w, *conv_b, *dt_bias, *a_log, *d_skip, *attn_norm_w,
      *ssm_norm_w, *w_out, *ln_ffn, *wq, *keys, *U, *V, *ln_final;
  float* out;
  unsigned char* ws;
};

__device__ __forceinline__ void p0_transpose_tile(const float* __restrict__ W, int ldw, bf16_t* __restrict__ Wt, const float* sc0,
                                                  const float* sc1, int k0, int n0, float* tile) {
  int tid = threadIdx.x; asm volatile("" : "+v"(tid));
  {
    const int r = tid >> 6, c4 = (tid & 63) * 4;
    f32x4 v[8];
#pragma unroll
    for (int i = 0; i < 8; ++i) v[i] = __builtin_nontemporal_load((const f32x4*)(W + (size_t)(k0 + r + 8 * i) * ldw + n0 + c4));
#pragma unroll
    for (int i = 0; i < 8; ++i) {
      float s = 1.f;
      const int k = k0 + r + 8 * i;
      if (sc0) s = k < 1024 ? sc0[k] : sc1[k - 1024];
      float* q = tile + (r + 8 * i) * 257 + c4;
      q[0] = v[i][0] * s; q[1] = v[i][1] * s; q[2] = v[i][2] * s; q[3] = v[i][3] * s;
    }
  }
  __syncthreads();
#pragma unroll
  for (int it = 0; it < 4; ++it) {
    const int task = it * NTHREADS + tid;
    const int n = task >> 3, kc = (task & 7) * 8;
    float v[8];
#pragma unroll
    for (int j = 0; j < 8; ++j) v[j] = tile[(kc + j) * 257 + n];
    u32x4 w; w.x = pack_bf16(v[0], v[1]); w.y = pack_bf16(v[2], v[3]); w.z = pack_bf16(v[4], v[5]); w.w = pack_bf16(v[6], v[7]);
    *(u32x4*)(Wt + (size_t)(n0 + n) * DM + k0 + kc) = w;
  }
  __syncthreads();
}

__device__ __forceinline__ void phase0(const Params& p, float* ldsf, int bid, int nblk) {
  int tid = threadIdx.x; asm volatile("" : "+v"(tid));
  const int lane = tid & 63, wid = tid >> 6;
  bf16_t* w_inT = (bf16_t*)(p.ws + WS_WINT);
  bf16_t* w_dtT = (bf16_t*)(p.ws + WS_WDTT);
  bf16_t* w_outT = (bf16_t*)(p.ws + WS_WOUTT);
  bf16_t* wqT = (bf16_t*)(p.ws + WS_WQT);
  bf16_t* keysb = (bf16_t*)(p.ws + WS_KEYS);
  unsigned char* ub = p.ws + WS_UB;
  unsigned char* vb = p.ws + WS_VB;
  bf16_t* hnb = (bf16_t*)(p.ws + WS_HNB);
  constexpr int U_HN = (TA + 7) / 8;
  constexpr int U_WIN = 32 * 16, U_WOUT = 32 * 8, U_WQ = 32 * 8, U_WDT = 1, U_KEYS = 64;
  constexpr int B_WIN = U_HN, B_WOUT = B_WIN + U_WIN, B_WQ = B_WOUT + U_WOUT, B_WDT = B_WQ + U_WQ, B_KEYS = B_WDT + U_WDT,
                B_U = B_KEYS + U_KEYS, B_END = B_U;
  for (int u = bid; u < B_END; u += nblk) {
    if (u < B_WIN) {
      const int t = u * 8 + wid;
      if (t < TA) {
        const float* src = t < T ? p.x + (size_t)t * DM : p.meta + (size_t)(t - T) * DM;
        float4 v[8];
        float ss = 0.f;
#pragma unroll
        for (int i = 0; i < 8; ++i) {
          { const f32x4 q_ = __builtin_nontemporal_load((const f32x4*)(src + (i * 64 + lane) * 4)); v[i].x = q_[0]; v[i].y = q_[1]; v[i].z = q_[2]; v[i].w = q_[3]; }
          ss += v[i].x * v[i].x + v[i].y * v[i].y + v[i].z * v[i].z + v[i].w * v[i].w;
        }
        ss = wave_sum(ss);
        const float r = rsqrtf(ss * (1.f / DM) + EPS);
#pragma unroll
        for (int i = 0; i < 8; ++i) {
          const float4 w = *(const float4*)(p.ln_mix + (i * 64 + lane) * 4);
          u32x2 o; o.x = pack_bf16(v[i].x * r * w.x, v[i].y * r * w.y); o.y = pack_bf16(v[i].z * r * w.z, v[i].w * r * w.w);
          *(u32x2*)(hnb + (size_t)t * DM + (i * 64 + lane) * 4) = o;
        }
      }
    } else if (u < B_WOUT) {
      const int i = u - B_WIN;
      p0_transpose_tile(p.w_in, DPROJ, w_inT, nullptr, nullptr, (i & 31) * 64, (i >> 5) * 256, ldsf);
    } else if (u < B_WQ) {
      const int i = u - B_WOUT;
      p0_transpose_tile(p.w_out, DM, w_outT, p.attn_norm_w, p.ssm_norm_w, (i & 31) * 64, (i >> 5) * 256, ldsf);
    } else if (u < B_WDT) {
      const int i = u - B_WQ;
      p0_transpose_tile(p.wq, DM, wqT, p.ln_ffn, p.ln_ffn + 1024, (i & 31) * 64, (i >> 5) * 256, ldsf);
    } else if (u < B_KEYS) {
      for (int idx = tid; idx < DM * 16; idx += NTHREADS) {
        const int k = idx >> 4, j = idx & 15;
        w_dtT[(size_t)j * DM + k] = f2bf(p.w_in[(size_t)k * DPROJ + NPROJ + j]);
      }
    } else if (u < B_U) {
      int tk = tid;
      asm volatile("" : "+v"(tk));
      const unsigned base = (unsigned)(u - B_KEYS) * 4096u + (unsigned)tk * 8u;
      const float4 a = *(const float4*)(p.keys + base), b = *(const float4*)(p.keys + base + 4);
      u32x4 w; w.x = pack_bf16(a.x, a.y); w.y = pack_bf16(a.z, a.w); w.z = pack_bf16(b.x, b.y); w.w = pack_bf16(b.z, b.w);
      *(u32x4*)(keysb + base) = w;
    }
  }
}

__device__ __forceinline__ void convert_tables(const Params& p, int bid, int nblk) {
  int tid = threadIdx.x; asm volatile("" : "+v"(tid));
  const int lane = tid & 63, wid = tid >> 6;
  unsigned char* ub = p.ws + WS_UB;
  unsigned char* vb = p.ws + WS_VB;
  {
    const int gw = bid * 8 + wid, nw = nblk * 8;
    auto load_row = [&](f32x4 (&a)[8], const int r2) __attribute__((always_inline)) {
      const float* src = (r2 < NEXP ? p.U + (size_t)r2 * DM : p.V + (size_t)(r2 - NEXP) * DM) + lane * 4;
#pragma unroll
      for (int j = 0; j < 8; ++j) a[j] = __builtin_nontemporal_load((const f32x4*)(src + 256 * j));
    };
    auto conv_row = [&](f32x4 (&a)[8], const int r2) __attribute__((always_inline)) {
      const bool isU = r2 < NEXP;
      const int row = isU ? r2 : r2 - NEXP;
      if (isU) {
#pragma unroll
        for (int j = 0; j < 8; ++j) a[j] *= *(const f32x4*)(p.ln_ffn + lane * 4 + 256 * j);
      }
      float amax = 0.f;
#pragma unroll
      for (int j = 0; j < 8; ++j) amax = fmaxf(amax, fmaxf(fmaxf(fabsf(a[j][0]), fabsf(a[j][1])), fmaxf(fabsf(a[j][2]), fabsf(a[j][3]))));
      amax = wave_max(amax);
      const float s4 = amax > 0.f ? 6.f / amax : 1.f;
      u32x4 w4;
#pragma unroll
      for (int j = 0; j < 4; ++j) {
        unsigned w = 0;
        w = __builtin_amdgcn_cvt_scalef32_pk_fp4_f32(w, a[2 * j][0] * s4, a[2 * j][1] * s4, 1.0f, 0);
        w = __builtin_amdgcn_cvt_scalef32_pk_fp4_f32(w, a[2 * j][2] * s4, a[2 * j][3] * s4, 1.0f, 1);
        w = __builtin_amdgcn_cvt_scalef32_pk_fp4_f32(w, a[2 * j + 1][0] * s4, a[2 * j + 1][1] * s4, 1.0f, 2);
        w = __builtin_amdgcn_cvt_scalef32_pk_fp4_f32(w, a[2 * j + 1][2] * s4, a[2 * j + 1][3] * s4, 1.0f, 3);
        w4[j] = w;
      }
      if (isU) *(u32x4*)(ub + (size_t)(lane >> 3) * ((size_t)NEXP * 128) + (size_t)row * 128 + (lane & 7) * 16) = w4;
      else *(u32x4*)(vb + (size_t)row * ROW4 + lane * 16) = w4;
      if (lane == 0) ((float*)(p.ws + (isU ? WS_USC : WS_VSC)))[row] = amax > 0.f ? amax * (1.f / 6.f) : 1.f;
    };
    f32x4 ra[8], rb[8];
    int r2 = gw;
    if (r2 < 2 * NEXP) load_row(ra, r2);
#pragma unroll 1
    for (; r2 < 2 * NEXP; r2 += 2 * nw) {
      if (r2 + nw < 2 * NEXP) load_row(rb, r2 + nw);
      conv_row(ra, r2);
      if (r2 + nw < 2 * NEXP) {
        if (r2 + 2 * nw < 2 * NEXP) load_row(ra, r2 + 2 * nw);
        conv_row(rb, r2 + nw);
      }
    }
  }
}

__device__ __forceinline__ void mini_gemm(const bf16_t* __restrict__ A, const bf16_t* __restrict__ Bt, float* __restrict__ out, int ldo,
                                          float* red, bf16_t* __restrict__ outb = nullptr) {
  int tid = threadIdx.x; asm volatile("" : "+v"(tid));
  const int lane = tid & 63, wid = tid >> 6, fr = lane & 15, fq = lane >> 4;
  f32x4 acc = {0.f, 0.f, 0.f, 0.f};
  const bf16_t* ap = A + (size_t)fr * DM + wid * 256 + fq * 8;
  const bf16_t* bp = Bt + (size_t)fr * DM + wid * 256 + fq * 8;
#pragma unroll
  for (int ks = 0; ks < 8; ++ks) {
    const bf16x8 a = *(const bf16x8*)(ap + ks * 32);
    const bf16x8 b = *(const bf16x8*)(bp + ks * 32);
    acc = __builtin_amdgcn_mfma_f32_16x16x32_bf16(a, b, acc, 0, 0, 0);
  }
#pragma unroll
  for (int r = 0; r < 4; ++r) red[wid * 256 + (4 * fq + r) * 16 + fr] = acc[r];
  __syncthreads();
  if (tid < 256) {
    float s = 0.f;
#pragma unroll
    for (int w = 0; w < 8; ++w) s += red[w * 256 + tid];
    out[(size_t)(tid >> 4) * ldo + (tid & 15)] = s;
    if (outb) outb[(size_t)(tid >> 4) * ldo + (tid & 15)] = f2bf(s);
  }
  __syncthreads();
}

__device__ __forceinline__ void phase1(const Params& p, unsigned char* lds, int bid, int nblk) {
  const bool stream_first = ((bid >> 3) & 1) != 0;
  if (stream_first) convert_tables(p, bid, nblk);
  const bf16_t* hnb = (const bf16_t*)(p.ws + WS_HNB);
  const bf16_t* w_inT = (const bf16_t*)(p.ws + WS_WINT);
  const bf16_t* w_dtT = (const bf16_t*)(p.ws + WS_WDTT);
  float* dtraw = (float*)(p.ws + WS_DTRAW);
  float* projm = (float*)(p.ws + WS_PROJM);
  constexpr int NU = 512 + 32 + 96 + 1;
  for (int u = bid; u < NU; u += nblk) {
    if (u < 512) {
      mini_gemm(hnb + (size_t)u * 16 * DM, w_dtT, dtraw + (size_t)u * 16 * 16, 16, (float*)lds);
    } else {
      const int j = u - 512;
      const int cf = j < 32 ? 64 + j : (j < 128 ? 160 + (j - 32) : 256);
      const bf16_t* bt = cf < 256 ? w_inT + (size_t)cf * 16 * DM : w_dtT;
      mini_gemm(hnb + (size_t)T * DM, bt, projm + cf * 16, DPROJ, (float*)lds, (bf16_t*)(p.ws + WS_PROJMB) + cf * 16);
    }
  }
  pg8::Gemm g{hnb, w_inT, T, NPROJ, DM};
  pg8::StaticOrder S; S.init(T, NPROJ, nblk, bid);
  pg8::EpiBf16 E{(bf16_t*)(p.ws + WS_PROJ), NPROJ};
  pg8::gemm_phase<pg8::EpiBf16, pg8::StaticOrder>((PG8_LAS unsigned char*)lds, g, S, E);
  if (!stream_first) convert_tables(p, bid, nblk);
}

__device__ __forceinline__ void phase4(const Params& p, unsigned char* lds, int bid, int nblk) {
  pg8::Gemm g{(const bf16_t*)(p.ws + WS_HNB), (const bf16_t*)(p.ws + WS_WOUTT), T, DM, DM};
  pg8::StaticOrder S; S.init(T, DM, nblk, bid);
  pg8::EpiRes E{p.x, (bf16_t*)(p.ws + WS_H1B), (float*)(p.ws + WS_SSQH1)};
  pg8::gemm_phase<pg8::EpiRes, pg8::StaticOrder>((PG8_LAS unsigned char*)lds, g, S, E);
}
__device__ __forceinline__ void phase5(const Params& p, unsigned char* lds, int bid, int nblk) {
  pg8::Gemm g{(const bf16_t*)(p.ws + WS_H1B), (const bf16_t*)(p.ws + WS_WQT), T, DM, DM};
  pg8::StaticOrder S; S.init(T, DM, nblk, bid);
  pg8::EpiScores E{(const bf16_t*)(p.ws + WS_KEYS), (float*)(p.ws + WS_STOP), (int*)(p.ws + WS_ITOP)};
  pg8::gemm_phase<pg8::EpiScores, pg8::StaticOrder>((PG8_LAS unsigned char*)lds, g, S, E);
}

__device__ __forceinline__ float dot2bf(unsigned a, unsigned b, float c) {
  return __builtin_amdgcn_fdot2_f32_bf16(*(bf16v2*)&a, *(bf16v2*)&b, c, false);
}
__device__ __forceinline__ void phase6a(const Params& p, unsigned char* lds, int bid, int nblk) {
  const int tid0 = threadIdx.x, lane0 = tid0 & 63, wid = __builtin_amdgcn_readfirstlane(tid0 >> 6);
  int* rid = (int*)(lds + wid * 2048);
  float* rgt = (float*)(lds + wid * 2048 + 1024);
  unsigned* kbuf0 = (unsigned*)(lds + 16384 + wid * 2048);
  const bf16_t* h1b = (const bf16_t*)(p.ws + WS_H1B);
  const float* usc = (const float*)(p.ws + WS_USC);
  const float* vsc = (const float*)(p.ws + WS_VSC);
  const float* ssq = (const float*)(p.ws + WS_SSQH1);
  const float* stop = (const float*)(p.ws + WS_STOP);
  const int* itop = (const int*)(p.ws + WS_ITOP);
  int* idsg = (int*)(p.ws + WS_P6IDS);
  float* gtsg = (float*)(p.ws + WS_P6GTS);
  float* usclg = (float*)(p.ws + WS_P6USC);
  unsigned char* xq = p.ws + WS_P6XQ;
  unsigned char* xes = p.ws + WS_P6XES;
  const int ci = kCandI[lane0], cj = kCandJ[lane0];
#pragma unroll 1
  for (int t = bid * 8 + wid; t < T; t += nblk * 8) {
    int tid = tid0; asm volatile("" : "+v"(tid));
    const int lane = tid & 63;
    const float part0 = lane < 32 ? ssq[(size_t)t * 32 + lane] : 0.f;
    const float rr = rsqrtf(wave_sum(part0) * (1.f / DM) + EPS);
    float svh[8];
    int ivh[8];
    u32x2 xrow[8];
#pragma unroll
    for (int j = 0; j < 8; ++j) xrow[j] = *(const u32x2*)(h1b + (size_t)t * DM + lane * 4 + 256 * j);
#pragma unroll
    for (int h = 0; h < 8; ++h) {
      const size_t lbase = ((size_t)t * 16 + h * 2) * 16 + (lane & 31);
      svh[h] = __builtin_nontemporal_load(stop + lbase);
      ivh[h] = __builtin_nontemporal_load(itop + lbase);
    }
#pragma unroll
    for (int h = 0; h < 8; ++h) {
      const float sv = svh[h];
      const int iv = ivh[h];
      float cand = (__shfl(sv, ci) + __shfl(sv, 16 + cj)) * rr;
      if (lane >= 50) cand = -INFINITY;
      unsigned key = __float_as_uint(cand);
      key = (key & 0x80000000u) ? ~key : (key | 0x80000000u);
      key = ((key >> 1) & ~63u) | (unsigned)(63 - lane);
      unsigned* kbuf = kbuf0 + h * 64;
      kbuf[lane] = key;
      unsigned rank = 0;
#pragma unroll
      for (int k4 = 0; k4 < 13; ++k4) {
        const u32x4 kk = *(const u32x4*)(kbuf + 4 * k4);
        rank += ((key - kk.x) >> 31) + ((key - kk.y) >> 31) + ((key - kk.z) >> 31) + ((key - kk.w) >> 31);
      }
      const float cmax = __int_as_float(__builtin_amdgcn_readfirstlane(__float_as_int(cand)));
      const float ex = __expf(cand - cmax);
      const int eidx = __shfl(iv, ci) * 128 + __shfl(iv, 16 + cj);
      {
        const int slot = rank < 16 ? h * 16 + (int)rank : 128 + lane;
        rid[slot] = eidx; rgt[slot] = ex;
      }
    }
    {
      const int e0 = rid[lane], e1 = rid[lane + 64];
      float g0 = rgt[lane], g1 = rgt[lane + 64];
      {
        float d0 = g0, d1 = g1;
#pragma unroll
        for (int o = 1; o < 16; o <<= 1) { d0 += __shfl_xor(d0, o); d1 += __shfl_xor(d1, o); }
        g0 /= d0; g1 /= d1;
      }
      const int r0 = e0 >> 10, r1 = e1 >> 10;
      const unsigned long long ltm = (1ull << lane) - 1ull;
      int run = 0, pos0 = 0, pos1 = 0;
#pragma unroll
      for (int R = 0; R < 16; ++R) {
        const unsigned long long m0 = __ballot(r0 == R), m1 = __ballot(r1 == R);
        const int c0 = __popcll(m0), c1 = __popcll(m1);
        if (r0 == R) pos0 = run + __popcll(m0 & ltm);
        if (r1 == R) pos1 = run + c0 + __popcll(m1 & ltm);
        run += c0 + c1;
      }
      const size_t tb = (size_t)t * 128;
      idsg[tb + pos0] = e0; gtsg[tb + pos0] = g0 * vsc[e0]; usclg[tb + pos0] = rr * usc[e0];
      idsg[tb + pos1] = e1; gtsg[tb + pos1] = g1 * vsc[e1]; usclg[tb + pos1] = rr * usc[e1];
    }
    {
      float r[32];
#pragma unroll
      for (int j = 0; j < 8; ++j) {
        r[4 * j + 0] = bflo(xrow[j].x); r[4 * j + 1] = bfhi(xrow[j].x); r[4 * j + 2] = bflo(xrow[j].y); r[4 * j + 3] = bfhi(xrow[j].y);
      }
#pragma unroll
      for (int term = 0; term < 2; ++term) {
        float m = 0.f;
#pragma unroll
        for (int j = 0; j < 32; ++j) m = fmaxf(m, fabsf(r[j]));
        const unsigned mb = __float_as_uint(m);
        int es = (int)(mb >> 23) - 1 - ((mb & 0x7fffffu) <= 0x700000u ? 1 : 0);
        es = es < 1 ? 1 : es;
        const float S = __uint_as_float((unsigned)es << 23), iS = __uint_as_float((unsigned)(254 - es) << 23);
        f32x16 v0, v1;
#pragma unroll
        for (int i = 0; i < 16; ++i) { v0[i] = r[2 * i] * iS; v1[i] = r[2 * i + 1] * iS; }
        const u32x6 q = __builtin_amdgcn_cvt_scalef32_2xpk16_fp6_f32(v0, v1, 1.0f);
        unsigned char* qp = xq + ((size_t)(t * 2 + term) * 64 + lane) * 24;
        { u32x2 w0 = {q[0], q[1]}, w1 = {q[2], q[3]}, w2 = {q[4], q[5]}; *(u32x2*)qp = w0; *(u32x2*)(qp + 8) = w1; *(u32x2*)(qp + 16) = w2; }
        xes[(size_t)(t * 2 + term) * 64 + lane] = (unsigned char)es;
        if (term == 0) {
          const f32x32v d = __builtin_amdgcn_cvt_scalef32_pk32_f32_fp6(q, 1.0f);
#pragma unroll
          for (int j = 0; j < 32; ++j) r[j] = fmaf(-S, d[j], r[j]);
        }
      }
    }
  }
}

__device__ __forceinline__ void phase6b(const Params& p, unsigned char* lds, int bid, int nblk) {
  int tid = threadIdx.x; asm volatile("" : "+v"(tid));
  const int lane = tid & 63, wid = __builtin_amdgcn_readfirstlane(tid >> 6);
  const unsigned char* ub = p.ws + WS_UB;
  const int* idsg = (const int*)(p.ws + WS_P6IDS);
  const unsigned char* xq = p.ws + WS_P6XQ;
  const unsigned char* xes = p.ws + WS_P6XES;
  float* hpart = (float*)(p.ws + WS_HPART);
  int* idl = (int*)(lds + wid * 16384);
  constexpr int NU = T * 8;
  const int us = nblk * 8;
  const int u0 = (nblk & 7) == 0 ? (((bid >> 3) * 8 + wid) * 8 + (bid & 7)) : (bid * 8 + wid);
  const int nun = u0 < NU ? (NU - u0 + us - 1) / us : 0;
  const int rho = (lane & 15) >> 1, cch = 4 * (lane & 1) + (lane >> 4);
  const bool st = (((lane & 15) >> 2) == (lane >> 4)) && !(lane & 1);
  const int paddr = 4 * ((((lane & 15) << 2) | (lane >> 4)));
  const float m0 = (lane & 3) == 0 ? 1.f : 0.f, m1 = (lane & 3) == 1 ? 1.f : 0.f, m2 = (lane & 3) == 2 ? 1.f : 0.f, m3 = (lane & 3) == 3 ? 1.f : 0.f;
#pragma unroll 1
  for (int base = 0; base < nun; base += 32) {
    const int nb = nun - base < 32 ? nun - base : 32;
#pragma unroll 1
    for (int i0 = 0; i0 < nb; i0 += 8) {
      u32x2 v[8];
#pragma unroll
      for (int j = 0; j < 8; ++j) {
        const int ic = i0 + j < nb ? i0 + j : nb - 1;
        v[j] = *(const u32x2*)(idsg + (size_t)((u0 + (base + ic) * us) >> 3) * 128 + lane * 2);
      }
#pragma unroll
      for (int j = 0; j < 8; ++j) if (i0 + j < nb) *(u32x2*)(idl + (i0 + j) * 128 + lane * 2) = v[j];
    }
    auto unit_of = [&](int i) __attribute__((always_inline)) { return u0 + (base + (i < nb ? i : nb - 1)) * us; };
    auto load_b = [&](u32x6& b0, u32x6& b1, int& e0, int& e1, const int i) __attribute__((always_inline)) {
      const int u = unit_of(i);
      const int t = u >> 3, L = 8 * (u & 7) + cch;
      const unsigned char* q0 = xq + ((size_t)(t * 2) * 64 + L) * 24;
      { const u32x2 w0 = *(const u32x2*)q0, w1 = *(const u32x2*)(q0 + 8), w2 = *(const u32x2*)(q0 + 16);
        b0[0] = w0.x; b0[1] = w0.y; b0[2] = w1.x; b0[3] = w1.y; b0[4] = w2.x; b0[5] = w2.y; }
      { const u32x2 w0 = *(const u32x2*)(q0 + 1536), w1 = *(const u32x2*)(q0 + 1536 + 8), w2 = *(const u32x2*)(q0 + 1536 + 16);
        b1[0] = w0.x; b1[1] = w0.y; b1[2] = w1.x; b1[3] = w1.y; b1[4] = w2.x; b1[5] = w2.y; }
      e0 = xes[(size_t)(t * 2) * 64 + L];
      e1 = xes[(size_t)(t * 2 + 1) * 64 + L];
    };
    auto issue_grp = [&](u32x4 (&ra)[16], const int g, const int i) __attribute__((always_inline)) {
      const int ic = i < nb ? i : nb - 1;
      const i32x4 idq = *(const i32x4*)(idl + ic * 128 + (lane >> 3) * 16 + 4 * g);
      const unsigned char* rb = ub + (size_t)(unit_of(i) & 7) * ((size_t)NEXP * 128);
#pragma unroll
      for (int k = 0; k < 4; ++k) ra[4 * g + k] = *(const u32x4*)(rb + (((unsigned)idq[k] << 7) + (unsigned)(lane & 7) * 16u));
    };
    auto comp_grp = [&](u32x4 (&ra)[16], const int g, const u32x6& b0, const u32x6& b1, const int e0, const int e1, float (&part)[16]) __attribute__((always_inline)) {
      const i32x8 B0_ = {(int)b0[0], (int)b0[1], (int)b0[2], (int)b0[3], (int)b0[4], (int)b0[5], 0, 0};
      const i32x8 B1_ = {(int)b1[0], (int)b1[1], (int)b1[2], (int)b1[3], (int)b1[4], (int)b1[5], 0, 0};
#pragma unroll
      for (int k = 4 * g; k < 4 * g + 4; ++k) {
        const i32x8 A_ = {__builtin_amdgcn_ds_bpermute(paddr, (int)ra[k][0]), __builtin_amdgcn_ds_bpermute(paddr, (int)ra[k][1]),
                          __builtin_amdgcn_ds_bpermute(paddr, (int)ra[k][2]), __builtin_amdgcn_ds_bpermute(paddr, (int)ra[k][3]), 0, 0, 0, 0};
        f32x4 c = {0.f, 0.f, 0.f, 0.f};
        c = __builtin_amdgcn_mfma_scale_f32_16x16x128_f8f6f4(A_, B0_, c, 4, 2, 0, 0x7f7f7f7f, 0, e0);
        c = __builtin_amdgcn_mfma_scale_f32_16x16x128_f8f6f4(A_, B1_, c, 4, 2, 0, 0x7f7f7f7f, 0, e1);
        float dv = fmaf(c[3], m3, fmaf(c[2], m2, fmaf(c[1], m1, c[0] * m0)));
        dv += __int_as_float(__builtin_amdgcn_mov_dpp(__float_as_int(dv), 0xB1, 0xF, 0xF, true));
        part[k] = dv;
      }
    };
    auto store_part = [&](const float (&part)[16], const int i) __attribute__((always_inline)) {
      if (st) {
        float* hp = hpart + (size_t)unit_of(i) * 128 + rho * 16;
#pragma unroll
        for (int q = 0; q < 4; ++q) { const f32x4 o = {part[4 * q], part[4 * q + 1], part[4 * q + 2], part[4 * q + 3]}; *(f32x4*)(hp + 4 * q) = o; }
      }
    };
    u32x4 raA[16], raB[16];
    u32x6 bA0, bA1, bB0, bB1, bN0, bN1;
    int eA0, eA1, eB0, eB1, eN0, eN1;
#define P6B_PIN() __builtin_amdgcn_sched_barrier(0)
    load_b(bA0, bA1, eA0, eA1, 0);
    P6B_PIN();
#pragma unroll
    for (int g = 0; g < 4; ++g) { issue_grp(raA, g, 0); P6B_PIN(); }
    load_b(bB0, bB1, eB0, eB1, 1);
    P6B_PIN();
#pragma unroll
    for (int g = 0; g < 4; ++g) { issue_grp(raB, g, 1); P6B_PIN(); }
#pragma unroll 1
    for (int i = 0; i < nb; i += 2) {
      float part[16];
      load_b(bN0, bN1, eN0, eN1, i + 2);
      P6B_PIN();
#pragma unroll
      for (int g = 0; g < 4; ++g) { comp_grp(raA, g, bA0, bA1, eA0, eA1, part); P6B_PIN(); issue_grp(raA, g, i + 2); P6B_PIN(); }
      store_part(part, i);
      bA0 = bN0; bA1 = bN1; eA0 = eN0; eA1 = eN1;
      P6B_PIN();
      load_b(bN0, bN1, eN0, eN1, i + 3);
      P6B_PIN();
#pragma unroll
      for (int g = 0; g < 4; ++g) { comp_grp(raB, g, bB0, bB1, eB0, eB1, part); P6B_PIN(); issue_grp(raB, g, i + 3); P6B_PIN(); }
      store_part(part, i + 1);
      bB0 = bN0; bB1 = bN1; eB0 = eN0; eB1 = eN1;
      P6B_PIN();
    }
#undef P6B_PIN
  }
}

__device__ __forceinline__ void phase6c(const Params& p, unsigned char* lds, int bid, int nblk) {
  int tid = threadIdx.x; asm volatile("" : "+v"(tid));
  const int lane = tid & 63, wid = __builtin_amdgcn_readfirstlane(tid >> 6);
  constexpr int TB = 4;
  int* ids = (int*)(lds + wid * (TB * 1024));
  float* wts = (float*)(lds + wid * (TB * 1024) + TB * 512);
  float* lnf = (float*)(lds + 8 * TB * 1024);
  const unsigned char* vb = p.ws + WS_VB;
  const bf16_t* h1b = (const bf16_t*)(p.ws + WS_H1B);
  const int* idsg = (const int*)(p.ws + WS_P6IDS);
  const float* gtsg = (const float*)(p.ws + WS_P6GTS);
  const float* usclg = (const float*)(p.ws + WS_P6USC);
  const float* hpart = (const float*)(p.ws + WS_HPART);
  *(f32x4*)(lnf + 4 * tid) = *(const f32x4*)(p.ln_final + 4 * tid);
  __syncthreads();
  const int t0 = bid * 8 + wid, ts = nblk * 8;
  const int nt = t0 < T ? (T - t0 + ts - 1) / ts : 0;
#pragma unroll 1
  for (int base = 0; base < nt; base += TB) {
    const int nb = nt - base < TB ? nt - base : TB;
    {
      int lf = lane; asm volatile("" : "+v"(lf));
      float pa0[TB][8], pa1[TB][8], g0[TB], g1[TB], s0[TB], s1[TB];
      int e0[TB], e1[TB];
#pragma unroll
      for (int j = 0; j < TB; ++j) {
        const int t = t0 + (base + (j < nb ? j : nb - 1)) * ts;
        const size_t tb = (size_t)t * 128;
#pragma unroll
        for (int x = 0; x < 8; ++x) { pa0[j][x] = hpart[((size_t)t * 8 + x) * 128 + lf]; pa1[j][x] = hpart[((size_t)t * 8 + x) * 128 + 64 + lf]; }
        g0[j] = gtsg[tb + lf]; g1[j] = gtsg[tb + 64 + lf]; s0[j] = usclg[tb + lf]; s1[j] = usclg[tb + 64 + lf];
        e0[j] = idsg[tb + lf]; e1[j] = idsg[tb + 64 + lf];
      }
#pragma unroll
      for (int j = 0; j < TB; ++j) {
        ids[j * 128 + lf] = e0[j]; ids[j * 128 + lf + 64] = e1[j];
        const float a0 = (((pa0[j][0] + pa0[j][1]) + (pa0[j][2] + pa0[j][3])) + ((pa0[j][4] + pa0[j][5]) + (pa0[j][6] + pa0[j][7]))) * s0[j];
        const float a1 = (((pa1[j][0] + pa1[j][1]) + (pa1[j][2] + pa1[j][3])) + ((pa1[j][4] + pa1[j][5]) + (pa1[j][6] + pa1[j][7]))) * s1[j];
        const float vld = j < nb ? 1.f : 0.f;
        wts[j * 128 + lf] = vld * g0[j] * 0.5f * a0 * (1.f + erff(a0 * 0.70710678118654752f));
        wts[j * 128 + lf + 64] = vld * g1[j] * 0.5f * a1 * (1.f + erff(a1 * 0.70710678118654752f));
      }
    }
    const int np = (nb + 1) >> 1;
    auto load_rows = [&](u32x4 (&ra)[16], int j, int rnd) __attribute__((always_inline)) {
      if (j >= 2 * np) { j = 2 * np - 1; rnd = 7; }
#pragma unroll
      for (int k = 0; k < 16; ++k) {
        const int e = __builtin_amdgcn_readfirstlane(ids[j * 128 + rnd * 16 + k]);
        ra[k] = *(const u32x4*)(vb + (size_t)e * ROW4 + lane * 16);
      }
    };
    float acc0[32], acc1[32];
#define P6C_COMPUTE(acc, ra, j, rnd) { \
      f32x4 wq = *(const f32x4*)(wts + (j) * 128 + (rnd) * 16), wn = wq; \
      _Pragma("unroll") for (int k = 0; k < 16; ++k) { \
        if ((k & 3) == 0) { wq = wn; if (k < 12) wn = *(const f32x4*)(wts + (j) * 128 + (rnd) * 16 + k + 4); } \
        const float wk = wq[k & 3]; \
        asm volatile("" : "+v"(ra[k]) : "v"(acc[1]), "v"(acc[3]), "v"(acc[5]), "v"(acc[7]), "v"(acc[9]), "v"(acc[11]), "v"(acc[13]), "v"(acc[15]), \
                                        "v"(acc[17]), "v"(acc[19]), "v"(acc[21]), "v"(acc[23]), "v"(acc[25]), "v"(acc[27]), "v"(acc[29]), "v"(acc[31])); \
        _Pragma("unroll") for (int jj = 0; jj < 4; ++jj) { P6C_STEP(acc, ra, jj, 0) P6C_STEP(acc, ra, jj, 1) P6C_STEP(acc, ra, jj, 2) P6C_STEP(acc, ra, jj, 3) } \
      } }
#define P6C_STEP(acc, ra, j, i) { const f32x2 r_ = __builtin_amdgcn_cvt_scalef32_pk_f32_fp4(ra[k][j], 1.0f, i); \
        acc[8 * (j) + 2 * (i)] = fmaf(wk, r_[0], acc[8 * (j) + 2 * (i)]); acc[8 * (j) + 2 * (i) + 1] = fmaf(wk, r_[1], acc[8 * (j) + 2 * (i) + 1]); }
    auto finalize = [&](float (&acc)[32], const int t) __attribute__((always_inline)) {
      float ss = 0.f;
#pragma unroll
      for (int q = 0; q < 8; ++q) {
        const u32x2 xa = *(const u32x2*)(h1b + (size_t)t * DM + lane * 4 + 256 * q);
        acc[4 * q + 0] += bflo(xa.x); acc[4 * q + 1] += bfhi(xa.x); acc[4 * q + 2] += bflo(xa.y); acc[4 * q + 3] += bfhi(xa.y);
      }
#pragma unroll
      for (int i = 0; i < 32; ++i) ss += acc[i] * acc[i];
      ss = wave_sum(ss);
      const float rf = rsqrtf(ss * (1.f / DM) + EPS);
#pragma unroll
      for (int q = 0; q < 8; ++q) {
        const f32x4 lw = *(const f32x4*)(lnf + 256 * q + lane * 4);
        const f32x4 o = {acc[4 * q] * rf * lw[0], acc[4 * q + 1] * rf * lw[1], acc[4 * q + 2] * rf * lw[2], acc[4 * q + 3] * rf * lw[3]};
        __builtin_nontemporal_store(o, (f32x4*)(p.out + (size_t)t * DM + 256 * q + lane * 4));
      }
    };
    u32x4 raA[16], raB[16];
    load_rows(raA, 0, 0);
#pragma unroll 1
    for (int pr = 0; pr < np; ++pr) {
#pragma unroll
      for (int i = 0; i < 32; ++i) { acc0[i] = 0.f; acc1[i] = 0.f; }
#pragma unroll 1
      for (int q = 0; q < 8; ++q) {
        load_rows(raB, 2 * pr + 1, q);
        P6C_COMPUTE(acc0, raA, 2 * pr, q)
        load_rows(raA, q < 7 ? 2 * pr : 2 * pr + 2, q < 7 ? q + 1 : 0);
        P6C_COMPUTE(acc1, raB, 2 * pr + 1, q)
      }
      finalize(acc0, t0 + (base + 2 * pr) * ts);
      if (2 * pr + 1 < nb) finalize(acc1, t0 + (base + 2 * pr + 1) * ts);
    }
#undef P6C_COMPUTE
#undef P6C_STEP
  }
}

__device__ __forceinline__ void unpack8(const u32x4 a, float (&v)[8]) {
  v[0] = bflo(a.x); v[1] = bfhi(a.x); v[2] = bflo(a.y); v[3] = bfhi(a.y); v[4] = bflo(a.z); v[5] = bfhi(a.z); v[6] = bflo(a.w); v[7] = bfhi(a.w);
}
constexpr int VT_LD = 196;
constexpr int ATT_VT_BYTES = 4 * 64 * VT_LD * 2;
__device__ __forceinline__ void attn_item(const Params& p, unsigned char* lds, int item, const bool first) {
  int tid = threadIdx.x; asm volatile("" : "+v"(tid));
  const int lane = tid & 63, wid = __builtin_amdgcn_readfirstlane(tid >> 6);
  const int b = item >> 6, qb = item & 63, q0 = qb * 32;
  bf16_t* VT = (bf16_t*)lds;
  float* biasL = (float*)(lds + ATT_VT_BYTES);
  float* ssqw = biasL + 16 * 132;
  const bf16_t* proj = (const bf16_t*)(p.ws + WS_PROJ);
  const float* projm = (const float*)(p.ws + WS_PROJM);
  bf16_t* mixin = (bf16_t*)(p.ws + WS_HNB);
  if (first) {
#pragma unroll
  for (int it = 0; it < 5; ++it) {
    const int idx = it * NTHREADS + tid;
    if (idx >= 16 * 129) break;
    const int hq = idx / 129, d = idx - hq * 129;
    int bk = d;
    if (d >= 16) bk = 16 + (d >= 19) + (d >= 21) + (d >= 24) + (d >= 27) + (d >= 31) + (d >= 35) + (d >= 40) + (d >= 46) + (d >= 52) + (d >= 59) +
                      (d >= 67) + (d >= 77) + (d >= 87) + (d >= 99) + (d >= 113);
    biasL[hq * 132 + d] = p.rel_bias[bk * 16 + hq];
  }
  }
  const int ql = lane & 31, ql0 = ql, hh = lane >> 5, kvh = wid >> 1;
  const int trow = b * SEQ + q0 + ql;
  bf16x8 qf[4];
  u32x4 kf[6][4];
#define ATT_LOAD_Q(hq_)                                                                                                           \
  { _Pragma("unroll") for (int ks = 0; ks < 4; ++ks) qf[ks] = *(const bf16x8*)(proj + (size_t)trow * NPROJ + OFF_Q + (hq_) * 64 + ks * 16 + hh * 8); }
#define ATT_LOAD_K()                                                                                                              \
  {                                                                                                                               \
    int ql = ql0; asm volatile("" : "+v"(ql));     \
    const float* kr_ = projm + (size_t)(ql & 15) * DPROJ + OFF_K + kvh * 64 + hh * 8;                                             \
    _Pragma("unroll") for (int ks = 0; ks < 4; ++ks) {                                                                            \
      const f32x4 a_ = *(const f32x4*)(kr_ + ks * 16), c_ = *(const f32x4*)(kr_ + ks * 16 + 4);                                   \
      kf[0][ks].x = pack_bf16(a_[0], a_[1]); kf[0][ks].y = pack_bf16(a_[2], a_[3]); kf[0][ks].z = pack_bf16(c_[0], c_[1]); kf[0][ks].w = pack_bf16(c_[2], c_[3]); } \
    _Pragma("unroll") for (int jt = 1; jt < 6; ++jt) {                                                                            \
      int sp_ = q0 - 128 + 32 * (jt - 1) + ql; sp_ = sp_ < 0 ? 0 : sp_;                                                           \
      const bf16_t* kp_ = proj + (size_t)(b * SEQ + sp_) * NPROJ + OFF_K + kvh * 64 + hh * 8;                                     \
      _Pragma("unroll") for (int ks = 0; ks < 4; ++ks) kf[jt][ks] = *(const u32x4*)(kp_ + ks * 16); }                             \
  }
  const int qb4 = (qb + 4) % 5;
  if (first) {
    u32x4 ra[5], rc[5];
#pragma unroll
    for (int q = 0; q < 5; ++q) {
      const int task = q * NTHREADS + tid, ch = task / 80, pi = task - ch * 80;
      int s0 = q0 - 128 + 2 * pi;
      s0 = s0 < 0 ? 0 : s0;
      const unsigned off = (unsigned)((b * SEQ + s0) * NPROJ + OFF_V + ch * 8);
      ra[q] = *(const u32x4*)(proj + off); rc[q] = *(const u32x4*)(proj + off + NPROJ);
    }
    float m0[8], m1[8];
    {
      const int pi = tid & 7, ch = (tid >> 3) & 31;
      const float* r0 = projm + (size_t)(2 * pi) * DPROJ + OFF_V + ch * 8;
      const f32x4 ma = *(const f32x4*)r0, mb = *(const f32x4*)(r0 + 4), mc = *(const f32x4*)(r0 + DPROJ), md = *(const f32x4*)(r0 + DPROJ + 4);
      const float keep = tid < 256 ? 1.f : 0.f;
#pragma unroll
      for (int i = 0; i < 4; ++i) { m0[i] = ma[i] * keep; m0[4 + i] = mb[i] * keep; m1[i] = mc[i] * keep; m1[4 + i] = md[i] * keep; }
      bf16_t* dst = VT + (size_t)((ch >> 3) * 64 + (ch & 7) * 8) * VT_LD + 2 * pi + (tid < 256 ? 0 : 16);
#pragma unroll
      for (int i = 0; i < 8; ++i) *(unsigned*)(dst + i * VT_LD) = pack_bf16(m0[i], m1[i]);
    }
#pragma unroll
    for (int q = 0; q < 5; ++q) {
      const int task = q * NTHREADS + tid, ch = task / 80, pi = task - ch * 80;
      float v0[8], v1[8];
      unpack8(ra[q], v0); unpack8(rc[q], v1);
      int rp = qb4 + (pi >> 4); rp = rp >= 5 ? rp - 5 : rp;
      const int slot = 32 + rp * 32 + 2 * (pi & 15);
      bf16_t* dst = VT + (size_t)((ch >> 3) * 64 + (ch & 7) * 8) * VT_LD + slot;
#pragma unroll
      for (int i = 0; i < 8; ++i) *(unsigned*)(dst + i * VT_LD) = pack_bf16(v0[i], v1[i]);
    }
  } else {
    const int ch = tid >> 4, pw = tid & 15;
    const bf16_t* r0 = proj + (size_t)(b * SEQ + q0 + 2 * pw) * NPROJ + OFF_V + ch * 8;
    const u32x4 ra = *(const u32x4*)r0, rc = *(const u32x4*)(r0 + NPROJ);
    float v0[8], v1[8];
    unpack8(ra, v0); unpack8(rc, v1);
    const int slot = 32 + ((qb4 + 4) % 5) * 32 + 2 * pw;
    bf16_t* dst = VT + (size_t)((ch >> 3) * 64 + (ch & 7) * 8) * VT_LD + slot;
#pragma unroll
    for (int i = 0; i < 8; ++i) *(unsigned*)(dst + i * VT_LD) = pack_bf16(v0[i], v1[i]);
  }
  __syncthreads();
  float ssq = 0.f;
#pragma unroll 1
  for (int rep_ = 0; rep_ < (REP_SUB == 3 ? 2 : 1); ++rep_) {
  ssq = 0.f;
  auto do_head = [&](const int hsel) __attribute__((always_inline)) {
    const int hq = 2 * wid + hsel;
    f32x16 sacc[6];
#pragma unroll
    for (int jt = 0; jt < 6; ++jt) {
      f32x16 acc;
#pragma unroll
      for (int r = 0; r < 16; ++r) acc[r] = 0.f;
#pragma unroll
      for (int ks = 0; ks < 4; ++ks) acc = __builtin_amdgcn_mfma_f32_32x32x16_bf16(*(bf16x8*)&kf[jt][ks], qf[ks], acc, 0, 0, 0);
      sacc[jt] = acc;
    }
    if (hsel == 0) { ATT_LOAD_Q(2 * wid + 1) }
    const float* bl = biasL + hq * 132;
    int sq = q0 + ql, qh = ql - 4 * hh;
    asm volatile("" : "+v"(sq), "+v"(qh));
    const float sink = p.sinks[hq];
    float m = sink;
#pragma unroll
    for (int jt = 0; jt < 6; ++jt) {
      asm volatile("" ::: "memory");
#pragma unroll
      for (int r = 0; r < 16; ++r) {
        const int kr = (r & 3) + 8 * (r >> 2) + 4 * hh;
        int dist; bool valid;
        if (jt == 0) { dist = sq + (16 - ((r & 3) + 8 * (r >> 2))) - 4 * hh; valid = kr < 16; }
        else { dist = qh + (128 - 32 * (jt - 1) - ((r & 3) + 8 * (r >> 2))); valid = (dist >= 0) && (dist < 128) && (dist <= sq); }
        const int dc = dist < 0 ? 0 : (dist > 128 ? 128 : dist);
        const float l = valid ? 0.125f * sacc[jt][r] + bl[dc] : -1e30f;
        sacc[jt][r] = l;
        m = fmaxf(m, l);
      }
    }
    m = fmaxf(m, __shfl_xor(m, 32));
    float sum = 0.f;
    f32x16 oacc0, oacc1;
#pragma unroll
    for (int r = 0; r < 16; ++r) { oacc0[r] = 0.f; oacc1[r] = 0.f; }
    const bf16_t* vrow0 = VT + (size_t)(kvh * 64 + ql) * VT_LD + 4 * hh;
    const bf16_t* vrow1 = vrow0 + 32 * VT_LD;
#pragma unroll
    for (int jt = 0; jt < 6; ++jt) {
      u32x4 pw[2];
#pragma unroll
      for (int s2 = 0; s2 < 2; ++s2) {
        float e[8];
#pragma unroll
        for (int i = 0; i < 8; ++i) { e[i] = __expf(sacc[jt][8 * s2 + i] - m); sum += e[i]; }
        pw[s2].x = pack_bf16(e[0], e[1]); pw[s2].y = pack_bf16(e[2], e[3]); pw[s2].z = pack_bf16(e[4], e[5]); pw[s2].w = pack_bf16(e[6], e[7]);
      }
#pragma unroll
      for (int s2 = 0; s2 < 2; ++s2) {
        const int sl = (jt == 0 ? 0 : 32 + ((qb4 + jt - 1) % 5) * 32) + 16 * s2;
        const u32x2 va = *(const u32x2*)(vrow0 + sl), vc = *(const u32x2*)(vrow0 + sl + 8);
        const u32x2 vd = *(const u32x2*)(vrow1 + sl), ve = *(const u32x2*)(vrow1 + sl + 8);
        u32x4 v0w; v0w.x = va.x; v0w.y = va.y; v0w.z = vc.x; v0w.w = vc.y;
        u32x4 v1w; v1w.x = vd.x; v1w.y = vd.y; v1w.z = ve.x; v1w.w = ve.y;
        oacc0 = __builtin_amdgcn_mfma_f32_32x32x16_bf16(*(bf16x8*)&v0w, *(bf16x8*)&pw[s2], oacc0, 0, 0, 0);
        oacc1 = __builtin_amdgcn_mfma_f32_32x32x16_bf16(*(bf16x8*)&v1w, *(bf16x8*)&pw[s2], oacc1, 0, 0, 0);
      }
    }
    sum += __shfl_xor(sum, 32);
    const float inv = 1.f / (sum + __expf(sink - m));
#pragma unroll
    for (int r = 0; r < 16; ++r) { oacc0[r] *= inv; oacc1[r] *= inv; ssq += oacc0[r] * oacc0[r] + oacc1[r] * oacc1[r]; }
#pragma unroll
    for (int rg = 0; rg < 4; ++rg) {
      u32x2 w; w.x = pack_bf16(oacc0[rg * 4 + 0], oacc0[rg * 4 + 1]); w.y = pack_bf16(oacc0[rg * 4 + 2], oacc0[rg * 4 + 3]);
      *(u32x2*)(mixin + (size_t)trow * DM + hq * 64 + 8 * rg + 4 * hh) = w;
      u32x2 w1; w1.x = pack_bf16(oacc1[rg * 4 + 0], oacc1[rg * 4 + 1]); w1.y = pack_bf16(oacc1[rg * 4 + 2], oacc1[rg * 4 + 3]);
      *(u32x2*)(mixin + (size_t)trow * DM + hq * 64 + 32 + 8 * rg + 4 * hh) = w1;
    }
  };
  ATT_LOAD_Q(2 * wid)
  ATT_LOAD_K()
  do_head(0);
  asm volatile("" ::: "memory");
  ATT_LOAD_K()
  do_head(1);
  }
  ssq += __shfl_xor(ssq, 32);
  if (lane < 32) ssqw[wid * 32 + lane] = ssq;
  __syncthreads();
  float tot = 0.f;
#pragma unroll
  for (int w = 0; w < 8; ++w) tot += ssqw[w * 32 + ql];
  const float ra = rsqrtf(tot * (1.f / 1024) + EPS);
#pragma unroll
  for (int hsel = 0; hsel < 2; ++hsel)
#pragma unroll
    for (int dt = 0; dt < 2; ++dt)
#pragma unroll
      for (int rg = 0; rg < 4; ++rg) {
        bf16_t* op = mixin + (size_t)trow * DM + (2 * wid + hsel) * 64 + 32 * dt + 8 * rg + 4 * hh;
        const u32x2 v = *(const u32x2*)op;
        u32x2 w; w.x = pack_bf16(bflo(v.x) * ra, bfhi(v.x) * ra); w.y = pack_bf16(bflo(v.y) * ra, bfhi(v.y) * ra);
        *(u32x2*)op = w;
      }
  __syncthreads();
}
#undef ATT_LOAD_Q
#undef ATT_LOAD_K

constexpr int SLD = 136;
__device__ __forceinline__ float conv_silu(const float (&raw)[11], int i, float w0, float w1, float w2, float w3, float cb) {
  return silu_f(cb + w0 * raw[i] + w1 * raw[i + 1] + w2 * raw[i + 2] + w3 * raw[i + 3]);
}
__device__ __forceinline__ void ssd_a_item(const Params& p, unsigned char* lds, int item) {
  int tid = threadIdx.x; asm volatile("" : "+v"(tid));
  const int lane = tid & 63, wid = __builtin_amdgcn_readfirstlane(tid >> 6);
  const int b = item >> 5, c = (item >> 1) & 15, g = item & 1;
  const int h0 = g * 8;
  const int t0 = b * SEQ + c * 128;
  bf16_t* Bc = (bf16_t*)lds;
  bf16_t* Cc = Bc + 128 * SLD;
  bf16_t* BcT = Cc + 128 * SLD;
  bf16_t* xT = BcT + 128 * SLD;
  float* dtl = (float*)(xT + 2 * 64 * SLD);
  float* acs = dtl + 256;
  float* wl = acs + 256;
  float* scan = wl + 256;
  const bf16_t* __restrict__ proj = (const bf16_t*)(p.ws + WS_PROJ);
  const bf16_t* __restrict__ projmb = (const bf16_t*)(p.ws + WS_PROJMB);
  const float* __restrict__ dtraw = (const float*)(p.ws + WS_DTRAW);
  float* __restrict__ acsg = (float*)(p.ws + WS_ACSG);
  bf16_t* __restrict__ ccb = (bf16_t*)(p.ws + WS_CCB);
  bf16_t* __restrict__ ypart = (bf16_t*)(p.ws + WS_YPART);
  float* __restrict__ sg = (float*)(p.ws + WS_SG);
  {
    unsigned raw[4][11];
#pragma unroll
    for (int q = 0; q < 4; ++q) {
      const int task = q * NTHREADS + tid;
      const int tg = task >> 7, cp = task & 127;
      const int cch = 1024 + (cp >> 6) * 256 + g * 128 + 2 * (cp & 63);
#pragma unroll
      for (int i = 0; i < 11; ++i) {
        const int l = tg * 8 + i - 3;
        const bf16_t* src = (l >= 0 || c > 0) ? proj + (size_t)(t0 + l) * NPROJ : projmb + (size_t)(16 + l) * DPROJ;
        raw[q][i] = *(const unsigned*)(src + OFF_XBC + cch);
      }
    }
#pragma unroll
    for (int q = 0; q < 4; ++q) {
      const int task = q * NTHREADS + tid;
      const int tg = task >> 7, cp = task & 127, n = 2 * (cp & 63);
      const int cch = 1024 + (cp >> 6) * 256 + g * 128 + n;
      float o0[8], o1[8];
      {
        float r0[11], r1[11];
#pragma unroll
        for (int i = 0; i < 11; ++i) { r0[i] = bflo(raw[q][i]); r1[i] = bfhi(raw[q][i]); }
        const float w0 = p.conv_w[cch], w1 = p.conv_w[D_XBC + cch], w2 = p.conv_w[2 * D_XBC + cch], w3 = p.conv_w[3 * D_XBC + cch], cb = p.conv_b[cch];
        const float v0 = p.conv_w[cch + 1], v1 = p.conv_w[D_XBC + cch + 1], v2 = p.conv_w[2 * D_XBC + cch + 1], v3 = p.conv_w[3 * D_XBC + cch + 1], vb_ = p.conv_b[cch + 1];
#pragma unroll
        for (int i = 0; i < 8; ++i) { o0[i] = conv_silu(r0, i, w0, w1, w2, w3, cb); o1[i] = conv_silu(r1, i, v0, v1, v2, v3, vb_); }
      }
      bf16_t* rowm = (cp < 64 ? Bc : Cc) + (tg * 8) * SLD + n;
#pragma unroll
      for (int i = 0; i < 8; ++i) *(unsigned*)(rowm + i * SLD) = pack_bf16(o0[i], o1[i]);
      if (cp < 64) {
        u32x4 w; w.x = pack_bf16(o0[0], o0[1]); w.y = pack_bf16(o0[2], o0[3]); w.z = pack_bf16(o0[4], o0[5]); w.w = pack_bf16(o0[6], o0[7]);
        *(u32x4*)(BcT + n * SLD + tg * 8) = w;
        u32x4 w2_; w2_.x = pack_bf16(o1[0], o1[1]); w2_.y = pack_bf16(o1[2], o1[3]); w2_.z = pack_bf16(o1[4], o1[5]); w2_.w = pack_bf16(o1[6], o1[7]);
        *(u32x4*)(BcT + (n + 1) * SLD + tg * 8) = w2_;
      }
    }
  }
  float xraw[4][11];
#define SSD_LOAD_X(r_)                                                                                              \
  _Pragma("unroll") for (int q = 0; q < 4; ++q) {                                                                   \
    const int task = (q & 1) * NTHREADS + tid; const int tg = task >> 6, cch = (h0 + 2 * (r_) + (q >> 1)) * 64 + (task & 63); \
    _Pragma("unroll") for (int i = 0; i < 11; ++i) { const int l = tg * 8 + i - 3;                                  \
      const bf16_t* src = (l >= 0 || c > 0) ? proj + (size_t)(t0 + l) * NPROJ : projmb + (size_t)(16 + l) * DPROJ;  \
      xraw[q][i] = bf2f(src[OFF_XBC + cch]); } }
  SSD_LOAD_X(0)
  __syncthreads();
  {
#pragma unroll
    for (int q = 0; q < 4; ++q) {
      const int idx = q * NTHREADS + tid, row = idx >> 4, ck = idx & 15;
      *(u32x4*)(ccb + (size_t)(t0 + row) * 256 + g * 128 + ck * 8) = *(const u32x4*)(Cc + row * SLD + ck * 8);
    }
  }
  const int ql = lane & 31, hh = lane >> 5;
  int rnd = 0;
  auto ydiag = [&](const int hi, const int il) __attribute__((always_inline)) {
    const int h = h0 + 2 * rnd + hi, ip = wid & 1;
    const bf16_t* xTb = xT + (hi & 1) * 64 * SLD;
    const float dskip = p.d_skip[h];
    const float* acsh = acs + hi * 128;
    const float* dtlh = dtl + hi * 128;
    const int l = 32 * il + ql;
    const float acl = acsh[l];
    f32x16 yacc;
#pragma unroll
    for (int r = 0; r < 16; ++r) yacc[r] = 0.f;
    const bf16_t* xrow = xTb + (32 * ip + ql) * SLD + 4 * hh;
#pragma unroll 1
    for (int is = 0; is <= il; ++is) {
      f32x16 x;
#pragma unroll
      for (int r = 0; r < 16; ++r) x[r] = 0.f;
      const bf16_t* ap = Bc + (32 * is + ql) * SLD + 8 * hh;
      const bf16_t* bp = Cc + l * SLD + 8 * hh;
#pragma unroll
      for (int ks = 0; ks < 8; ++ks) x = __builtin_amdgcn_mfma_f32_32x32x16_bf16(*(const bf16x8*)(ap + 16 * ks), *(const bf16x8*)(bp + 16 * ks), x, 0, 0, 0);
      u32x4 pw[2];
#pragma unroll
      for (int s2 = 0; s2 < 2; ++s2) {
        float mv[8];
#pragma unroll
        for (int q = 0; q < 2; ++q) {
          const int sb = 32 * is + 16 * s2 + 8 * q + 4 * hh;
          const f32x4 as4 = *(const f32x4*)(acsh + sb), dt4 = *(const f32x4*)(dtlh + sb);
#pragma unroll
          for (int j = 0; j < 4; ++j) {
            const int sr = sb + j;
            float v = sr <= l ? x[8 * s2 + 4 * q + j] * __expf(acl - as4[j]) * dt4[j] : 0.f;
            if (sr == l) v += dskip;
            mv[4 * q + j] = v;
          }
        }
        pw[s2].x = pack_bf16(mv[0], mv[1]); pw[s2].y = pack_bf16(mv[2], mv[3]); pw[s2].z = pack_bf16(mv[4], mv[5]); pw[s2].w = pack_bf16(mv[6], mv[7]);
      }
#pragma unroll
      for (int s2 = 0; s2 < 2; ++s2) {
        const u32x2 va = *(const u32x2*)(xrow + 32 * is + 16 * s2), vc = *(const u32x2*)(xrow + 32 * is + 16 * s2 + 8);
        u32x4 aw; aw.x = va.x; aw.y = va.y; aw.z = vc.x; aw.w = vc.y;
        yacc = __builtin_amdgcn_mfma_f32_32x32x16_bf16(*(bf16x8*)&aw, *(bf16x8*)&pw[s2], yacc, 0, 0, 0);
      }
    }
    bf16_t* yp = ypart + (size_t)(t0 + l) * 1024 + h * 64 + 32 * ip + 4 * hh;
#pragma unroll
    for (int rg = 0; rg < 4; ++rg) { u32x2 w; w.x = pack_bf16(yacc[4 * rg], yacc[4 * rg + 1]); w.y = pack_bf16(yacc[4 * rg + 2], yacc[4 * rg + 3]); *(u32x2*)(yp + 8 * rg) = w; }
  };
  auto states = [&](const int hi) __attribute__((always_inline)) {
    const int h = h0 + 2 * rnd + hi, ip = wid & 1, in = wid >> 1;
    const bf16_t* xTb = xT + (hi & 1) * 64 * SLD;
    const float* wlh = wl + hi * 128;
    f32x16 sacc;
#pragma unroll
    for (int r = 0; r < 16; ++r) sacc[r] = 0.f;
    const bf16_t* ap = xTb + (32 * ip + ql) * SLD + 8 * hh;
    const bf16_t* bp = BcT + (32 * in + ql) * SLD + 8 * hh;
#pragma unroll
    for (int ks = 0; ks < 8; ++ks) {
      const u32x4 xa = *(const u32x4*)(ap + 16 * ks);
      const f32x4 wa = *(const f32x4*)(wlh + 16 * ks + 8 * hh), wb = *(const f32x4*)(wlh + 16 * ks + 8 * hh + 4);
      u32x4 aw;
      aw.x = pack_bf16(bflo(xa.x) * wa[0], bfhi(xa.x) * wa[1]); aw.y = pack_bf16(bflo(xa.y) * wa[2], bfhi(xa.y) * wa[3]);
      aw.z = pack_bf16(bflo(xa.z) * wb[0], bfhi(xa.z) * wb[1]); aw.w = pack_bf16(bflo(xa.w) * wb[2], bfhi(xa.w) * wb[3]);
      sacc = __builtin_amdgcn_mfma_f32_32x32x16_bf16(*(bf16x8*)&aw, *(const bf16x8*)(bp + 16 * ks), sacc, 0, 0, 0);
    }
    float* sp = sg + ((size_t)((b * 16 + c) * 16 + h) * 64 + 32 * ip + 4 * hh) * 128 + 32 * in + ql;
#pragma unroll
    for (int r = 0; r < 16; ++r) sp[((r & 3) + 8 * (r >> 2)) * 128] = sacc[r];
  };
#pragma unroll 1
  for (int rnd_ = 0; rnd_ < 4; ++rnd_) {
    rnd = rnd_;
    float dtv = 0.f, cum = 0.f;
    const int hi2 = (tid >> 7) & 1, ltok = tid & 127;
    if (tid < 256) {
      const int h = h0 + 2 * rnd + hi2;
      const float Ah = -expf(p.a_log[h]);
      dtv = softplus_f(dtraw[(size_t)(t0 + ltok) * 16 + h] + p.dt_bias[h]);
      dtl[tid] = dtv;
      cum = dtv * Ah;
#pragma unroll
      for (int o = 1; o < 64; o <<= 1) { const float nb = __shfl_up(cum, o); if (lane >= o) cum += nb; }
      if (lane == 63) scan[hi2 * 2 + (ltok >> 6)] = cum;
    }
#pragma unroll
    for (int q = 0; q < 4; ++q) {
      const int task = (q & 1) * NTHREADS + tid; const int tg = task >> 6, pch = task & 63, cch = (h0 + 2 * rnd + (q >> 1)) * 64 + pch;
      const float w0 = p.conv_w[cch], w1 = p.conv_w[D_XBC + cch], w2 = p.conv_w[2 * D_XBC + cch], w3 = p.conv_w[3 * D_XBC + cch], cb = p.conv_b[cch];
      float o[8];
#pragma unroll
      for (int i = 0; i < 8; ++i) o[i] = conv_silu(xraw[q], i, w0, w1, w2, w3, cb);
      u32x4 w; w.x = pack_bf16(o[0], o[1]); w.y = pack_bf16(o[2], o[3]); w.z = pack_bf16(o[4], o[5]); w.w = pack_bf16(o[6], o[7]);
      *(u32x4*)(xT + (q >> 1) * 64 * SLD + pch * SLD + tg * 8) = w;
    }
    { SSD_LOAD_X((rnd + 1) & 3) }
    __syncthreads();
    if (tid < 256) {
      const int h = h0 + 2 * rnd + hi2;
      const float s0 = scan[hi2 * 2], s1 = scan[hi2 * 2 + 1];
      if (ltok >= 64) cum += s0;
      acs[tid] = cum;
      acsg[(size_t)(t0 + ltok) * 16 + h] = cum;
      wl[tid] = dtv * __expf(s0 + s1 - cum);
    }
    __syncthreads();
    ydiag(0, wid >> 1);
    ydiag(1, 3 - (wid >> 1));
    states(0);
    states(1);
    __syncthreads();
  }
#undef SSD_LOAD_X
  __syncthreads();
}

__device__ __forceinline__ void meta_state_item(const Params& p, unsigned char* lds, int h) {
  int tid = threadIdx.x; asm volatile("" : "+v"(tid));
  const int g = h >> 3;
  float* xm = (float*)lds;
  float* bm = xm + 16 * 64;
  float* dtm = bm + 16 * 128;
  const float* projm = (const float*)(p.ws + WS_PROJM);
  float* smeta = (float*)(p.ws + WS_SMETA);
  for (int task = tid; task < 16 * 192; task += NTHREADS) {
    const int i = task / 192, ch = task - i * 192;
    const int cch = ch < 64 ? h * 64 + ch : 1024 + g * 128 + (ch - 64);
    float acc = p.conv_b[cch];
#pragma unroll
    for (int j = 0; j < 4; ++j) { const int mi = i - j; if (mi >= 0) acc += p.conv_w[(3 - j) * D_XBC + cch] * projm[(size_t)mi * DPROJ + OFF_XBC + cch]; }
    const float v = silu_f(acc);
    if (ch < 64) xm[i * 64 + ch] = v; else bm[i * 128 + ch - 64] = v;
  }
  if (tid < 16) dtm[tid] = softplus_f(projm[(size_t)tid * DPROJ + OFF_DT + h] + p.dt_bias[h]);
  __syncthreads();
  const float Ah = -expf(p.a_log[h]);
  const int pr = tid >> 3, n0 = (tid & 7) * 16;
  float st[16];
#pragma unroll
  for (int k = 0; k < 16; ++k) st[k] = 0.f;
  for (int i = 0; i < 16; ++i) {
    const float dtv = dtm[i], dA = expf(dtv * Ah), xdt = xm[i * 64 + pr] * dtv;
#pragma unroll
    for (int k = 0; k < 16; ++k) st[k] = fmaf(st[k], dA, xdt * bm[i * 128 + n0 + k]);
  }
#pragma unroll
  for (int k = 0; k < 16; ++k) smeta[(size_t)(h * 64 + pr) * 128 + n0 + k] = st[k];
  __syncthreads();
}

__device__ __forceinline__ void phase2(const Params& p, unsigned char* lds, int bid, int nblk) {
  const bool roles = (nblk == 256);
  const int a = (bid >> 4) * 8 + (bid & 7);
  const bool ssd_role = ((bid >> 3) & 1) == 0;
  const int ab = roles ? (ssd_role ? 0 : 2 * a) : bid, ae = roles ? (ssd_role ? 0 : 2 * a + 2) : 256, as_ = roles ? 1 : nblk;
  const int sb = roles ? (ssd_role ? a : 0) : bid, se = roles ? (ssd_role ? a + 1 : 0) : 128, ss = roles ? 1 : nblk;
  const int mb = roles ? (ssd_role ? a : 16) : bid, ms = roles ? 128 : nblk;
#pragma unroll 1
  for (int it = ab; it < ae; it += as_) attn_item(p, lds, it, !(roles && it != ab));
#pragma unroll 1
  for (int it = sb; it < se; it += ss) ssd_a_item(p, lds, it);
#pragma unroll 1
  for (int it = mb; it < 16; it += ms) meta_state_item(p, lds, it);
}

__device__ __forceinline__ void phase_scan(const Params& p, int bid, int nblk) {
  const float* __restrict__ sg = (const float*)(p.ws + WS_SG);
  const float* __restrict__ smeta = (const float*)(p.ws + WS_SMETA);
  const float* __restrict__ acsg = (const float*)(p.ws + WS_ACSG);
  bf16_t* __restrict__ hprev = (bf16_t*)(p.ws + WS_HPREV);
  for (int task = bid * NTHREADS + threadIdx.x; task < 64 * 2048; task += nblk * NTHREADS) {
    const int bh = task >> 11, e4 = (task & 2047) * 4;
    const int b = bh >> 4, h = bh & 15;
    f32x4 sv[16];
    float dv[16];
#pragma unroll
    for (int c = 0; c < 16; ++c) {
      sv[c] = *(const f32x4*)(sg + (size_t)((b * 16 + c) * 16 + h) * 8192 + e4);
      dv[c] = acsg[(size_t)(b * SEQ + c * 128 + 127) * 16 + h];
    }
    f32x4 H = *(const f32x4*)(smeta + (size_t)h * 8192 + e4);
#pragma unroll
    for (int c = 0; c < 16; ++c) {
      u32x2 w; w.x = pack_bf16(H[0], H[1]); w.y = pack_bf16(H[2], H[3]);
      *(u32x2*)(hprev + (size_t)((b * 16 + c) * 16 + h) * 8192 + e4) = w;
      H = H * __expf(dv[c]) + sv[c];
    }
  }
}

__device__ __forceinline__ void ssd_b_item(const Params& p, unsigned char* lds, int item) {
  int tid = threadIdx.x; asm volatile("" : "+v"(tid));
  const int lane = tid & 63, wid = __builtin_amdgcn_readfirstlane(tid >> 6);
  const int b = item >> 6, c = (item >> 2) & 15, g = (item >> 1) & 1, lh = item & 1, h = g * 8 + wid;
  const int t0 = b * SEQ + c * 128 + lh * 64;
  const int ql = lane & 31, hh = lane >> 5;
  constexpr int YLD = 520;
  bf16_t* yoff = (bf16_t*)lds;
  const bf16_t* __restrict__ proj = (const bf16_t*)(p.ws + WS_PROJ);
  const float* __restrict__ acsg = (const float*)(p.ws + WS_ACSG);
  const bf16_t* __restrict__ ccb = (const bf16_t*)(p.ws + WS_CCB);
  const bf16_t* __restrict__ ypart = (const bf16_t*)(p.ws + WS_YPART);
  const bf16_t* __restrict__ hprev = (const bf16_t*)(p.ws + WS_HPREV);
  bf16_t* __restrict__ mixin = (bf16_t*)(p.ws + WS_HNB);
  {
    const bf16_t* hp = hprev + (size_t)((b * 16 + c) * 16 + h) * 8192 + (size_t)ql * 128 + 8 * hh;
    u32x4 hf0[8], hf1[8];
#pragma unroll
    for (int ks = 0; ks < 8; ++ks) { hf0[ks] = *(const u32x4*)(hp + 16 * ks); hf1[ks] = *(const u32x4*)(hp + 32 * 128 + 16 * ks); }
#pragma unroll
    for (int il = 0; il < 2; ++il) {
      const int lt = 32 * il + ql, t = t0 + lt;
      const bf16_t* cp = ccb + (size_t)t * 256 + g * 128 + 8 * hh;
      u32x4 cf[8];
#pragma unroll
      for (int ks = 0; ks < 8; ++ks) cf[ks] = *(const u32x4*)(cp + 16 * ks);
      const float ea = __expf(acsg[(size_t)t * 16 + h]);
      f32x16 a0, a1;
#pragma unroll
      for (int r = 0; r < 16; ++r) { a0[r] = 0.f; a1[r] = 0.f; }
#pragma unroll
      for (int ks = 0; ks < 8; ++ks) {
        a0 = __builtin_amdgcn_mfma_f32_32x32x16_bf16(*(bf16x8*)&hf0[ks], *(bf16x8*)&cf[ks], a0, 0, 0, 0);
        a1 = __builtin_amdgcn_mfma_f32_32x32x16_bf16(*(bf16x8*)&hf1[ks], *(bf16x8*)&cf[ks], a1, 0, 0, 0);
      }
      bf16_t* yr = yoff + lt * YLD + wid * 64 + 4 * hh;
#pragma unroll
      for (int rg = 0; rg < 4; ++rg) {
        u32x2 w0; w0.x = pack_bf16(ea * a0[4 * rg], ea * a0[4 * rg + 1]); w0.y = pack_bf16(ea * a0[4 * rg + 2], ea * a0[4 * rg + 3]);
        u32x2 w1; w1.x = pack_bf16(ea * a1[4 * rg], ea * a1[4 * rg + 1]); w1.y = pack_bf16(ea * a1[4 * rg + 2], ea * a1[4 * rg + 3]);
        *(u32x2*)(yr + 8 * rg) = w0;
        *(u32x2*)(yr + 32 + 8 * rg) = w1;
      }
    }
  }
  __syncthreads();
#pragma unroll
  for (int bt = 0; bt < 2; ++bt) {
    u32x4 yy[4], zz[4], yo[4];
#pragma unroll
    for (int q = 0; q < 4; ++q) {
      const int lt = wid * 8 + bt * 4 + q, t = t0 + lt;
      yy[q] = __builtin_nontemporal_load((const u32x4*)(ypart + (size_t)t * 1024 + g * 512 + lane * 8));
      zz[q] = __builtin_nontemporal_load((const u32x4*)(proj + (size_t)t * NPROJ + OFF_Z + g * 512 + lane * 8));
      yo[q] = *(const u32x4*)(yoff + lt * YLD + lane * 8);
    }
#pragma unroll
    for (int q = 0; q < 4; ++q) {
      const int t = t0 + wid * 8 + bt * 4 + q;
      float zv[8], ov[8], yv[8], y[8];
      unpack8(zz[q], zv); unpack8(yo[q], ov); unpack8(yy[q], yv);
#pragma unroll
      for (int i = 0; i < 8; ++i) y[i] = (yv[i] + ov[i]) * silu_f(zv[i]);
      float ss = 0.f;
#pragma unroll
      for (int i = 0; i < 8; ++i) ss += y[i] * y[i];
      ss = wave_sum(ss);
      const float rn = rsqrtf(ss * (1.f / 512) + EPS);
      u32x4 w; w.x = pack_bf16(y[0] * rn, y[1] * rn); w.y = pack_bf16(y[2] * rn, y[3] * rn); w.z = pack_bf16(y[4] * rn, y[5] * rn); w.w = pack_bf16(y[6] * rn, y[7] * rn);
      *(u32x4*)(mixin + (size_t)t * DM + 1024 + g * 512 + lane * 8) = w;
    }
  }
  __syncthreads();
}
__device__ __forceinline__ void phase3(const Params& p, unsigned char* lds, int bid, int nblk) {
  for (int it = bid; it < 256; it += nblk) ssd_b_item(p, lds, (nblk == 256) ? ((it & 7) * 32 + (it >> 3)) : it);
}

constexpr int LDS_BYTES = 144 * 1024;

typedef const Params __attribute__((address_space(4))) * KArgPtr;
__device__ __forceinline__ Params load_params(KArgPtr k) {
  Params q;
#if defined(__HIP_DEVICE_COMPILE__)
  __builtin_memcpy(&q, k, sizeof(Params));
#endif
  return q;
}
#define PARAMS_PTR(pp) KArgPtr pp##_k = (KArgPtr)__builtin_amdgcn_kernarg_segment_ptr(); asm volatile("" : "+s"(pp##_k)); const Params pp##_v = load_params(pp##_k); const Params* pp = &pp##_v
__global__ __launch_bounds__(512, 2) void k_mega(Params p_unused) {
  extern __shared__ __attribute__((aligned(16))) unsigned char shm[];
  const int bid = blockIdx.x, nblk = gridDim.x;
  volatile LAS unsigned* xst = (volatile LAS unsigned*)(LAS unsigned char*)(shm + LDS_BYTES - 16);
  if (threadIdx.x == 0) { xst[0] = 0u; xst[1] = 0u; }
  __syncthreads();
  XcdBarrier xb;
  { PARAMS_PTR(pp); xb = xcd_barrier_post((unsigned*)(pp->ws + WS_CTL), xst); }
#ifndef REP_PHASE
#define REP_PHASE -1
#define P6B_MASK 0xffffu
#define P6B_VAR 0
#endif
#define NREP(k) ((REP_PHASE == (k)) ? 2 : 1)
#ifndef REP_ALL
#define REP_ALL 1
#endif
#pragma unroll 1
  for (int pass = 0; pass < REP_ALL; ++pass) {
  if (pass) xcd_barrier(xb);
#pragma unroll 1
  for (int rep = 0; rep < NREP(0); ++rep) { { PARAMS_PTR(pp); phase0(*pp, (float*)shm, bid, nblk); } if (rep + 1 < NREP(0)) xcd_barrier(xb); }
  xcd_barrier(xb);
#pragma unroll 1
  for (int rep = 0; rep < NREP(1); ++rep) { { PARAMS_PTR(pp); phase1(*pp, shm, bid, nblk); } xcd_barrier(xb); }
#pragma unroll 1
  for (int rep = 0; rep < NREP(2); ++rep) { { PARAMS_PTR(pp); phase2(*pp, shm, bid, nblk); } xcd_barrier(xb); }
#pragma unroll 1
  for (int rep = 0; rep < NREP(7); ++rep) { { PARAMS_PTR(pp); phase_scan(*pp, bid, nblk); } xcd_barrier(xb); }
#pragma unroll 1
  for (int rep = 0; rep < NREP(3); ++rep) { { PARAMS_PTR(pp); phase3(*pp, shm, bid, nblk); } xcd_barrier(xb); }
#pragma unroll 1
  for (int rep = 0; rep < NREP(4); ++rep) { { PARAMS_PTR(pp); phase4(*pp, shm, bid, nblk); } xcd_barrier(xb); }
#pragma unroll 1
  for (int rep = 0; rep < NREP(5); ++rep) { { PARAMS_PTR(pp); phase5(*pp, shm, bid, nblk); } xcd_barrier(xb); }
#pragma unroll 1
  for (int rep = 0; rep < NREP(8); ++rep) { { PARAMS_PTR(pp); phase6a(*pp, shm, bid, nblk); } xcd_barrier(xb); }
#pragma unroll 1
  for (int rep = 0; rep < NREP(6); ++rep) { { PARAMS_PTR(pp); phase6b(*pp, shm, bid, nblk); } xcd_barrier(xb); }
#pragma unroll 1
  for (int rep = 0; rep < NREP(9); ++rep) { { PARAMS_PTR(pp); phase6c(*pp, shm, bid, nblk); } if (rep + 1 < NREP(9)) xcd_barrier(xb); }
  }
}

}

extern "C" void kernel_launch(void* const* d_in, const int* in_sizes, int n_in, void* d_out, int out_size, void* d_ws,
                              size_t ws_size, hipStream_t stream) {
  Params p{};
  p.x = (const float*)d_in[0]; p.meta = (const float*)d_in[1]; p.rel_bias = (const float*)d_in[2];
  p.ln_mix = (const float*)d_in[3]; p.w_in = (const float*)d_in[4]; p.sinks = (const float*)d_in[5];
  p.conv_w = (const float*)d_in[6]; p.conv_b = (const float*)d_in[7]; p.dt_bias = (const float*)d_in[8];
  p.a_log = (const float*)d_in[9]; p.d_skip = (const float*)d_in[10]; p.attn_norm_w = (const float*)d_in[11];
  p.ssm_norm_w = (const float*)d_in[12]; p.w_out = (const float*)d_in[13]; p.ln_ffn = (const float*)d_in[14];
  p.wq = (const float*)d_in[15]; p.keys = (const float*)d_in[16]; p.U = (const float*)d_in[17];
  p.V = (const float*)d_in[18]; p.ln_final = (const float*)d_in[19];
  p.out = (float*)d_out;
  p.ws = (unsigned char*)d_ws;

  static int grid_blocks = 0;
  if (!grid_blocks) {
    int dev = 0, cus = 0, per_cu = 0;
    (void)hipGetDevice(&dev);
    (void)hipDeviceGetAttribute(&cus, hipDeviceAttributeMultiprocessorCount, dev);
    (void)hipFuncSetAttribute((const void*)k_mega, hipFuncAttributeMaxDynamicSharedMemorySize, LDS_BYTES);
    (void)hipOccupancyMaxActiveBlocksPerMultiprocessor(&per_cu, (const void*)k_mega, NTHREADS, LDS_BYTES);
    if (per_cu > 1) per_cu = 1;
    grid_blocks = cus * per_cu;
    if (grid_blocks != 256) fprintf(stderr, "kernel_launch: expected a 256-workgroup resident grid, got %d (cus %d, per_cu %d)\n", grid_blocks, cus, per_cu);
  }
  (void)hipMemsetAsync(p.ws + WS_CTL, 0, XCD_BAR_WORDS * 4, stream);
  void* args[] = {&p};
  hipError_t e = hipLaunchCooperativeKernel((const void*)k_mega, dim3(grid_blocks), dim3(NTHREADS), args, LDS_BYTES, stream);
  if (e != hipSuccess) fprintf(stderr, "cooperative launch failed: %s (grid %d)\n", hipGetErrorString(e), grid_blocks);
}
```
